# Optimizing an MI355X kernel written in HIP

```python
import jax, jax.numpy as jnp
from jax import lax
import numpy as np

D_MODEL = 1024
BATCH = 2
SEQ = 8192
DEPTH = 4

N_MEM = 256
HEAD_DIM = 64
FOX_HEADS = D_MODEL // HEAD_DIM
FOX_W = FOX_HEADS * HEAD_DIM
SB_HEADS = D_MODEL // HEAD_DIM
SB_W = SB_HEADS * HEAD_DIM
LRU_W = D_MODEL
LRU_BLOCKS = D_MODEL // HEAD_DIM
LRU_BW = LRU_W // LRU_BLOCKS
LRU_CONV = 4
LRU_C = 8.0
MEM_HEADS = 4
MEM_HD = D_MODEL // MEM_HEADS
MEM_W = MEM_HEADS * MEM_HD
N_BRANCH = 4
BRANCH_W = D_MODEL
D_FF = ((8 * D_MODEL // 3 + 255) // 256) * 256
FFN_CONV = 3
Q_BLOCK = 128
EPS = 1e-6
N_IN = 3 * FOX_W + FOX_HEADS + 2 * LRU_W + 3 * SB_W + MEM_W + N_BRANCH * D_MODEL

kernel_name = "hybrid_fox_rglru_stickbreak_memory_trunk"


def _column_slices():
    widths = (("fox_q", FOX_W), ("fox_k", FOX_W), ("fox_v", FOX_W), ("fox_f", FOX_HEADS),
              ("lru_x", LRU_W), ("lru_g", LRU_W),
              ("sb_q", SB_W), ("sb_k", SB_W), ("sb_v", SB_W),
              ("mem_q", MEM_W), ("gates", N_BRANCH * D_MODEL))
    out, start = {}, 0
    for name, w in widths:
        out[name] = (start, start + w)
        start += w
    return out


def _rms(x, g):
    x32 = x.astype(jnp.float32)
    y = x32 * lax.rsqrt(jnp.mean(x32 * x32, axis=-1, keepdims=True) + EPS)
    return (y * g.astype(jnp.float32)).astype(x.dtype)


def _causal_dwconv(x, w, b):
    k, s = w.shape[0], x.shape[1]
    xp = jnp.pad(x, ((0, 0), (k - 1, 0), (0, 0)))
    out = b
    for i in range(k):
        out = out + xp[:, i:i + s] * w[i]
    return out


def _heads(t, n):
    b, s, _ = t.shape
    return t.reshape(b, s, n, -1).transpose(0, 2, 1, 3)


def _merge_heads(t):
    b, h, s, d = t.shape
    return t.transpose(0, 2, 1, 3).reshape(b, s, h * d)


def _fox_attention(q, k, v, log_f):
    b, h, s, d = q.shape
    nb = s // Q_BLOCK
    scale = d ** -0.5
    cum_f = jnp.cumsum(log_f, axis=-1)
    q_blk = q.reshape(b, h, nb, Q_BLOCK, d).transpose(2, 0, 1, 3, 4)
    f_blk = cum_f.reshape(b, h, nb, Q_BLOCK).transpose(2, 0, 1, 3)
    k_pos = jnp.arange(s)

    def block(args):
        qi, fi, bi = args
        q_pos = bi * Q_BLOCK + jnp.arange(Q_BLOCK)
        logits = jnp.einsum('bhqd,bhkd->bhqk', qi, k) * scale + (fi[..., :, None] - cum_f[..., None, :])
        logits = jnp.where(k_pos[None, :] <= q_pos[:, None], logits, -jnp.inf)
        p = jax.nn.softmax(logits, axis=-1)
        return jnp.einsum('bhqk,bhkd->bhqd', p, v)

    out = lax.map(block, (q_blk, f_blk, jnp.arange(nb)))
    return out.transpose(1, 2, 0, 3, 4).reshape(b, h, s, d)


def _stick_breaking_attention(q, k, v):
    b, h, s, d = q.shape
    nb = s // Q_BLOCK
    scale = d ** -0.5
    q_blk = q.reshape(b, h, nb, Q_BLOCK, d).transpose(2, 0, 1, 3, 4)
    k_pos = jnp.arange(s)

    def block(args):
        qi, bi = args
        q_pos = bi * Q_BLOCK + jnp.arange(Q_BLOCK)
        causal = k_pos[None, :] < q_pos[:, None]
        z = jnp.einsum('bhqd,bhkd->bhqk', qi, k) * scale
        log_1m_beta = jnp.where(causal, jax.nn.log_sigmoid(-z), 0.0)
        excl = lax.cumsum(log_1m_beta, axis=3, reverse=True) - log_1m_beta
        weights = jnp.where(causal, jnp.exp(jax.nn.log_sigmoid(z) + excl), 0.0)
        return jnp.einsum('bhqk,bhkd->bhqd', weights, v)

    out = lax.map(block, (q_blk, jnp.arange(nb)))
    return out.transpose(1, 2, 0, 3, 4).reshape(b, h, s, d)


def _mem_attention(q, k, v):
    scale = q.shape[-1] ** -0.5
    p = jax.nn.softmax(jnp.einsum('bhsd,bhmd->bhsm', q, k) * scale, axis=-1)
    return jnp.einsum('bhsm,bhmd->bhsd', p, v)


def _rg_lru_branch(x, gate, conv_w, conv_b, w_a, b_a, w_x, b_x, lam):
    b, s, w = x.shape
    xc = _causal_dwconv(x, conv_w, conv_b).astype(jnp.float32)
    xg = xc.reshape(b, s, LRU_BLOCKS, LRU_BW)
    r = jax.nn.sigmoid(jnp.einsum('bsnd,nde->bsne', xg, w_a).reshape(b, s, w) + b_a)
    i = jax.nn.sigmoid(jnp.einsum('bsnd,nde->bsne', xg, w_x).reshape(b, s, w) + b_x)
    log_a = -LRU_C * r * jax.nn.softplus(-lam)
    a = jnp.exp(log_a)
    u = jnp.sqrt(-jnp.expm1(2.0 * log_a)) * (i * xc)

    def combine(c1, c2):
        a1, h1 = c1
        a2, h2 = c2
        return a1 * a2, a2 * h1 + h2

    _, hs = lax.associative_scan(combine, (a, u), axis=1)
    return hs * jax.nn.gelu(gate.astype(jnp.float32))


def setup_inputs(seed: int = 0) -> dict:
    key = jax.random.key(seed)
    ks = jax.random.split(key, 32)
    f32 = jnp.float32

    def nrm(k, shape, scale):
        return jax.random.normal(k, shape, f32) * scale

    def gain(k, shape):
        return 1.0 + 0.02 * jax.random.normal(k, shape, f32)

    res_scale = (2 * DEPTH) ** -0.5
    u = jax.random.uniform(ks[12], (DEPTH, LRU_W), f32, 0.9, 0.999)
    sig = u ** (1.0 / LRU_C)
    lru_lambda = jnp.log(sig) - jnp.log1p(-sig)
    return {
        "x": nrm(ks[0], (BATCH, SEQ, D_MODEL), 1.0),
        "mem": nrm(ks[1], (BATCH, N_MEM, D_MODEL), 1.0),
        "attn_norm_g": gain(ks[2], (DEPTH, D_MODEL)),
        "mem_norm_g": gain(ks[3], (DEPTH, D_MODEL)),
        "w_in": nrm(ks[4], (DEPTH, D_MODEL, N_IN), D_MODEL ** -0.5),
        "b_forget": jax.random.uniform(ks[5], (DEPTH, FOX_HEADS), f32, 2.0, 6.0),
        "fox_q_norm_g": gain(ks[6], (DEPTH, HEAD_DIM)),
        "fox_k_norm_g": gain(ks[7], (DEPTH, HEAD_DIM)),
        "lru_conv_w": nrm(ks[8], (DEPTH, LRU_CONV, LRU_W), LRU_CONV ** -0.5),
        "lru_conv_b": nrm(ks[9], (DEPTH, LRU_W), 0.01),
        "lru_w_a": nrm(ks[10], (DEPTH, LRU_BLOCKS, LRU_BW, LRU_BW), LRU_BW ** -0.5),
        "lru_b_a": nrm(ks[11], (DEPTH, LRU_W), 0.01),
        "lru_w_x": nrm(ks[13], (DEPTH, LRU_BLOCKS, LRU_BW, LRU_BW), LRU_BW ** -0.5),
        "lru_b_x": nrm(ks[14], (DEPTH, LRU_W), 0.01),
        "lru_lambda": lru_lambda,
        "w_mem_kv": nrm(ks[15], (DEPTH, D_MODEL, 2 * MEM_W), D_MODEL ** -0.5),
        "mem_q_norm_g": gain(ks[16], (DEPTH, MEM_HD)),
        "mem_k_norm_g": gain(ks[17], (DEPTH, MEM_HD)),
        "b_gate": nrm(ks[18], (DEPTH, N_BRANCH, D_MODEL), 0.01),
        "w_branch": nrm(ks[19], (DEPTH, N_BRANCH, BRANCH_W, D_MODEL), BRANCH_W ** -0.5),
        "w_out": nrm(ks[20], (DEPTH, D_MODEL, D_MODEL), D_MODEL ** -0.5 * res_scale),
        "ffn_norm_g": gain(ks[21], (DEPTH, D_MODEL)),
        "w_up": nrm(ks[22], (DEPTH, D_MODEL, 2 * D_FF), D_MODEL ** -0.5),
        "ffn_conv_w": nrm(ks[23], (DEPTH, FFN_CONV, D_FF), FFN_CONV ** -0.5),
        "ffn_conv_b": nrm(ks[24], (DEPTH, D_FF), 0.01),
        "w_down": nrm(ks[25], (DEPTH, D_FF, D_MODEL), D_FF ** -0.5 * res_scale),
    }


def reference(x, mem, attn_norm_g, mem_norm_g, w_in, b_forget, fox_q_norm_g, fox_k_norm_g,
              lru_conv_w, lru_conv_b, lru_w_a, lru_b_a, lru_w_x, lru_b_x, lru_lambda,
              w_mem_kv, mem_q_norm_g, mem_k_norm_g, b_gate, w_branch, w_out,
              ffn_norm_g, w_up, ffn_conv_w, ffn_conv_b, w_down):
    f32 = jnp.float32
    cols = _column_slices()
    b, s, _ = x.shape
    for l in range(DEPTH):
        h = _rms(x, attn_norm_g[l])
        w_l = w_in[l]

        def proj(name):
            lo, hi = cols[name]
            return h @ w_l[:, lo:hi]

        fq = _rms(_heads(proj("fox_q"), FOX_HEADS), fox_q_norm_g[l]).astype(f32)
        fk = _rms(_heads(proj("fox_k"), FOX_HEADS), fox_k_norm_g[l]).astype(f32)
        fv = _heads(proj("fox_v"), FOX_HEADS).astype(f32)
        log_f = jax.nn.log_sigmoid(proj("fox_f").astype(f32) + b_forget[l]).transpose(0, 2, 1)
        y_fox = _merge_heads(_fox_attention(fq, fk, fv, log_f))

        y_lru = _rg_lru_branch(proj("lru_x"), proj("lru_g"), lru_conv_w[l], lru_conv_b[l],
                               lru_w_a[l], lru_b_a[l], lru_w_x[l], lru_b_x[l], lru_lambda[l])

        sq = _heads(proj("sb_q"), SB_HEADS).astype(f32)
        sk = _heads(proj("sb_k"), SB_HEADS).astype(f32)
        sv = _heads(proj("sb_v"), SB_HEADS).astype(f32)
        y_sb = _merge_heads(_stick_breaking_attention(sq, sk, sv))

        mem_n = _rms(mem, mem_norm_g[l])
        w_kv = w_mem_kv[l]
        mk = _rms(_heads(mem_n @ w_kv[:, :MEM_W], MEM_HEADS), mem_k_norm_g[l]).astype(f32)
        mv = _heads(mem_n @ w_kv[:, MEM_W:], MEM_HEADS).astype(f32)
        mq = _rms(_heads(proj("mem_q"), MEM_HEADS), mem_q_norm_g[l]).astype(f32)
        y_mem = _merge_heads(_mem_attention(mq, mk, mv))

        branches = jnp.stack([y_fox, y_lru, y_sb, y_mem], axis=2).astype(x.dtype)
        gates = jax.nn.sigmoid(proj("gates").reshape(b, s, N_BRANCH, D_MODEL) + b_gate[l])
        projected = jnp.einsum('bsnc,ncd->bsnd', branches, w_branch[l])
        mixed = jnp.sum(gates * projected, axis=2)
        x = x + mixed @ w_out[l]

        h2 = _rms(x, ffn_norm_g[l])
        w_u = w_up[l]
        gate_pre = _causal_dwconv(h2 @ w_u[:, :D_FF], ffn_conv_w[l], ffn_conv_b[l])
        val = h2 @ w_u[:, D_FF:]
        x = x + (jax.nn.silu(gate_pre) * val) @ w_down[l]
    return x
```

```cpp
#include <hip/hip_runtime.h>
#include <cstdio>
#include <cstdint>

typedef unsigned short bf16_t;
constexpr int BATCH = 2, SEQ = 8192, DM = 1024, DEPTH = 4, T = BATCH * SEQ;
constexpr int NMEM = 256, NIN = 13328, DFF = 2816;
constexpr float EPS = 1e-6f;
constexpr float LOG2E = 1.4426950408889634f;
constexpr float C2 = 0.125f * LOG2E;
constexpr float SB_THR = -104.0f;

__device__ __forceinline__ float bf2f(bf16_t b) { return __uint_as_float(((unsigned)b) << 16); }
__device__ __forceinline__ bf16_t f2bf(float f) { unsigned u = __float_as_uint(f); return (bf16_t)((u + 0x7fffu + ((u >> 16) & 1u)) >> 16); }
__device__ __forceinline__ float bfr(float f) { return bf2f(f2bf(f)); }
__device__ __forceinline__ float wave_sum(float v) {
#pragma unroll
    for (int o = 1; o < 64; o <<= 1) v += __shfl_xor(v, o);
    return v;
}
__device__ __forceinline__ float softplusf(float x) { return fmaxf(x, 0.f) + log1pf(__expf(-fabsf(x))); }
__device__ __forceinline__ float logsigmoidf(float x) { return -softplusf(-x); }
__device__ __forceinline__ float sigmoidf_(float x) { return 1.f / (1.f + __expf(-x)); }
__device__ __forceinline__ float gelu_tanh(float x) { const float u = 0.7978845608028654f * (x + 0.044715f * x * x * x); return 0.5f * x * (1.f + tanhf(u)); }

constexpr size_t MiB = 1u << 20;
constexpr size_t SZ_ACT = (size_t)T * DM * 2;
constexpr size_t WS_CTL = 0;
constexpr size_t WS_H = 1 * MiB;
constexpr size_t WS_PROJ = WS_H + SZ_ACT;
constexpr size_t WS_GATES = WS_PROJ + 9 * SZ_ACT;
constexpr size_t WS_E = WS_GATES + 4 * SZ_ACT;
constexpr size_t WS_LOGF = WS_E + SZ_ACT;
constexpr size_t WS_FB = WS_LOGF + 1 * MiB;
constexpr size_t WS_MQSS = WS_FB + 1 * MiB;
constexpr size_t WS_ESUM = WS_MQSS + 1 * MiB;
constexpr size_t WS_MEMN = WS_ESUM + 1 * MiB;
constexpr size_t WS_MEMRAW = WS_MEMN + 4 * MiB;
constexpr size_t WS_MK = WS_MEMRAW + 16 * MiB;
constexpr size_t WS_MVT = WS_MK + 4 * MiB;
constexpr size_t WS_LRU = WS_MVT + 4 * MiB;
constexpr size_t WS_WT = WS_LRU + 2 * MiB;
constexpr size_t WS_END = WS_WT + 72 * MiB;
constexpr size_t WS_YL = WS_PROJ + 3 * SZ_ACT, WS_YS = WS_PROJ + 5 * SZ_ACT, WS_YM = WS_PROJ + 8 * SZ_ACT;
constexpr size_t WS_GV = WS_PROJ;
constexpr size_t WS_ACT = WS_GV + (size_t)T * 2 * DFF * 2;
static_assert(WS_ACT + (size_t)T * DFF * 2 <= WS_GATES, "ffn alias");

struct Ptrs {
    const float* in[26];
    float* out;
    unsigned char* ws;
};

__global__ void __launch_bounds__(256) n_rmsnorm(const float* __restrict__ x, const float* __restrict__ g, bf16_t* __restrict__ H,
                                                 const float* __restrict__ Wf, const float* __restrict__ bfg, float* __restrict__ LOGF, int nrows) {
    const int lane = threadIdx.x & 63, row = blockIdx.x * 4 + (threadIdx.x >> 6);
    if (row >= nrows) return;
    const float4* xr = (const float4*)(x + (size_t)row * DM);
    const float4* gr = (const float4*)g;
    float4 v[4]; float ss = 0.f;
#pragma unroll
    for (int j = 0; j < 4; ++j) { v[j] = xr[lane + 64 * j]; ss += v[j].x * v[j].x + v[j].y * v[j].y + v[j].z * v[j].z + v[j].w * v[j].w; }
    ss = wave_sum(ss);
    const float rstd = rsqrtf(ss * (1.f / DM) + EPS);
#pragma unroll
    for (int j = 0; j < 4; ++j) { const float4 gg = gr[lane + 64 * j]; v[j].x *= rstd * gg.x; v[j].y *= rstd * gg.y; v[j].z *= rstd * gg.z; v[j].w *= rstd * gg.w;
        ushort4 o; o.x = f2bf(v[j].x); o.y = f2bf(v[j].y); o.z = f2bf(v[j].z); o.w = f2bf(v[j].w);
        ((ushort4*)(H + (size_t)row * DM))[lane + 64 * j] = o; }
    if (Wf) {
        float mine = 0.f;
        for (int h = 0; h < 16; ++h) {
            float p = 0.f;
#pragma unroll
            for (int j = 0; j < 4; ++j) { const int k = (lane + 64 * j) * 4;
                p += v[j].x * Wf[(size_t)k * NIN + h] + v[j].y * Wf[(size_t)(k + 1) * NIN + h] + v[j].z * Wf[(size_t)(k + 2) * NIN + h] + v[j].w * Wf[(size_t)(k + 3) * NIN + h]; }
            p = wave_sum(p);
            if (lane == h) mine = p;
        }
        if (lane < 16) { const int b = row / SEQ, t = row % SEQ; LOGF[((size_t)b * 16 + lane) * SEQ + t] = logsigmoidf(mine + bfg[lane]); }
    }
}

struct EStoreBf16 { bf16_t* O; int ldc; int pad; __device__ void operator()(int m, int n, float a) const { O[(size_t)m * ldc + n] = f2bf(a); } };
struct EStoreF32 { float* O; int ldc; int pad; __device__ void operator()(int m, int n, float a) const { O[(size_t)m * ldc + n] = a; } };
struct EBranch { bf16_t* G; const float* bg; int i; int pad; __device__ void operator()(int m, int n, float a) const { bf16_t* p = G + (size_t)m * 4096 + i * 1024 + n; *p = f2bf(sigmoidf_(bf2f(*p) + bg[n]) * a); } };
struct EResid { const float* base; float* out; __device__ void operator()(int m, int n, float a) const { out[(size_t)m * DM + n] = base[(size_t)m * DM + n] + a; } };

template <class Epi> __global__ void __launch_bounds__(256) n_gemm(const bf16_t* __restrict__ A, const float* __restrict__ W, int lda, int ldw, int K, int kmask, Epi epi) {
    __shared__ float As[16][68], Bs[16][68];
    const int tx = threadIdx.x & 15, ty = threadIdx.x >> 4, m0 = blockIdx.y * 64, n0 = blockIdx.x * 64;
    float acc[4][4];
#pragma unroll
    for (int i = 0; i < 4; ++i)
#pragma unroll
        for (int j = 0; j < 4; ++j) acc[i][j] = 0.f;
    for (int k0 = 0; k0 < K; k0 += 16) {
#pragma unroll
        for (int i = 0; i < 4; ++i) { const int idx = threadIdx.x + i * 256; { const int r = idx >> 4, c = idx & 15; As[c][r] = bf2f(A[(size_t)(m0 + r) * lda + k0 + c]); }
            { const int r = idx >> 6, c = idx & 63; Bs[r][c] = bfr(W[(size_t)((k0 + r) & kmask) * ldw + n0 + c]); } }
        __syncthreads();
#pragma unroll
        for (int kk = 0; kk < 16; ++kk) { float a[4], b[4];
#pragma unroll
            for (int i = 0; i < 4; ++i) { a[i] = As[kk][ty * 4 + i]; b[i] = Bs[kk][tx * 4 + i]; }
#pragma unroll
            for (int i = 0; i < 4; ++i)
#pragma unroll
                for (int j = 0; j < 4; ++j) acc[i][j] += a[i] * b[j]; }
        __syncthreads();
    }
#pragma unroll
    for (int i = 0; i < 4; ++i)
#pragma unroll
        for (int j = 0; j < 4; ++j) epi(m0 + ty * 4 + i, n0 + tx * 4 + j, acc[i][j]);
}

__global__ void __launch_bounds__(256) n_headnorm(bf16_t* X, const float* __restrict__ g, int HD, float scale) {
    const int idx = blockIdx.x * 256 + threadIdx.x, nh = DM / HD, row = idx / nh, h = idx % nh;
    if (row >= T) return;
    bf16_t* p = X + (size_t)row * DM + h * HD; float ss = 0.f;
    for (int d = 0; d < HD; ++d) { const float v = bf2f(p[d]); ss += v * v; }
    const float rstd = rsqrtf(ss / HD + EPS) * scale;
    for (int d = 0; d < HD; ++d) p[d] = f2bf(bf2f(p[d]) * rstd * g[d]);
}

__global__ void __launch_bounds__(1024) n_cumsum(const float* __restrict__ LOGF, float* __restrict__ FB) {
    __shared__ float part[1024];
    const int bh = blockIdx.x, tid = threadIdx.x; const float* src = LOGF + (size_t)bh * SEQ + tid * 8; float v[8]; float s = 0.f;
#pragma unroll
    for (int i = 0; i < 8; ++i) { s += src[i]; v[i] = s; }
    part[tid] = s; __syncthreads();
    if (tid == 0) { float run = 0.f; for (int i = 0; i < 1024; ++i) { const float t_ = part[i]; part[i] = run; run += t_; } }
    __syncthreads();
    const float off = part[tid]; float* dst = FB + (size_t)bh * SEQ + tid * 8;
#pragma unroll
    for (int i = 0; i < 8; ++i) dst[i] = off + v[i];
}

__global__ void __launch_bounds__(256) n_fox_attn(const bf16_t* Q, const bf16_t* __restrict__ K, const bf16_t* __restrict__ V, const float* __restrict__ FB, bf16_t* O) {
    __shared__ float Ks[64][64], Vs[64][64], Fs[64];
    const int bh = blockIdx.y, b = bh >> 4, h = bh & 15, tq = blockIdx.x * 256 + threadIdx.x;
    const size_t rowq = (size_t)b * SEQ + tq;
    float q[64], o[64];
#pragma unroll
    for (int d = 0; d < 64; ++d) { q[d] = bf2f(Q[rowq * DM + h * 64 + d]); o[d] = 0.f; }
    const float Ft = FB[(size_t)bh * SEQ + tq];
    float m = -INFINITY, l = 0.f;
    const int ntile = (blockIdx.x * 256 + 256) / 64;
    for (int kt = 0; kt < ntile; ++kt) {
        __syncthreads();
        for (int i = threadIdx.x; i < 64 * 64; i += 256) { const int r = i >> 6, c = i & 63; const size_t rk = ((size_t)b * SEQ + kt * 64 + r) * DM + h * 64 + c; Ks[r][c] = bf2f(K[rk]); Vs[r][c] = bf2f(V[rk]); }
        if (threadIdx.x < 64) Fs[threadIdx.x] = FB[(size_t)bh * SEQ + kt * 64 + threadIdx.x];
        __syncthreads();
        for (int j = 0; j < 64; ++j) {
            const int s = kt * 64 + j; if (s > tq) break;
            float z = 0.f;
#pragma unroll
            for (int d = 0; d < 64; ++d) z += q[d] * Ks[j][d];
            z += (Ft - Fs[j]) * LOG2E;
            if (z > m) { const float c = exp2f(m - z); l *= c;
#pragma unroll
                for (int d = 0; d < 64; ++d) o[d] *= c;
                m = z; }
            const float p = exp2f(z - m); l += p;
#pragma unroll
            for (int d = 0; d < 64; ++d) o[d] += p * Vs[j][d];
        }
    }
    const float il = 1.f / l;
#pragma unroll
    for (int d = 0; d < 64; ++d) O[rowq * DM + h * 64 + d] = f2bf(o[d] * il);
}

__global__ void __launch_bounds__(256) n_sb_attn(const bf16_t* Q, const bf16_t* __restrict__ K, const bf16_t* __restrict__ V, bf16_t* O) {
    __shared__ float Ks[64][64], Vs[64][64];
    const int bh = blockIdx.y, b = bh >> 4, h = bh & 15, tq = blockIdx.x * 256 + threadIdx.x;
    const size_t rowq = (size_t)b * SEQ + tq;
    float q[64], o[64];
#pragma unroll
    for (int d = 0; d < 64; ++d) { q[d] = bf2f(Q[rowq * DM + h * 64 + d]) * 0.125f; o[d] = 0.f; }
    float R = 0.f;
    for (int kt = (blockIdx.x * 256 + 255) / 64; kt >= 0; --kt) {
        if (__syncthreads_and(R < SB_THR)) break;
        for (int i = threadIdx.x; i < 64 * 64; i += 256) { const int r = i >> 6, c = i & 63; const size_t rk = ((size_t)b * SEQ + kt * 64 + r) * DM + h * 64 + c; Ks[r][c] = bf2f(K[rk]); Vs[r][c] = bf2f(V[rk]); }
        __syncthreads();
        for (int j = 63; j >= 0; --j) {
            const int s = kt * 64 + j; if (s >= tq) continue;
            float z = 0.f;
#pragma unroll
            for (int d = 0; d < 64; ++d) z += q[d] * Ks[j][d];
            const float sp = softplusf(z);
            const float w = __expf((z - sp) + R);
            R -= sp;
#pragma unroll
            for (int d = 0; d < 64; ++d) o[d] += w * Vs[j][d];
        }
    }
#pragma unroll
    for (int d = 0; d < 64; ++d) O[rowq * DM + h * 64 + d] = f2bf(o[d]);
}

__global__ void __launch_bounds__(64) n_lru(const bf16_t* LX, const bf16_t* __restrict__ LG, const float* __restrict__ cw, const float* __restrict__ cb,
                                            const float* __restrict__ wa, const float* __restrict__ ba, const float* __restrict__ wx, const float* __restrict__ bx,
                                            const float* __restrict__ lam, bf16_t* YL) {
    __shared__ float xs[64];
    const int b = blockIdx.x >> 4, n = blockIdx.x & 15, e = threadIdx.x, ch = n * 64 + e;
    float wA[64], wX[64];
#pragma unroll
    for (int d = 0; d < 64; ++d) { wA[d] = wa[((size_t)n * 64 + d) * 64 + e]; wX[d] = wx[((size_t)n * 64 + d) * 64 + e]; }
    const float w0 = cw[ch], w1 = cw[DM + ch], w2 = cw[2 * DM + ch], w3 = cw[3 * DM + ch], bc = cb[ch], bA = ba[ch], bX = bx[ch];
    const float spl = softplusf(-lam[ch]);
    float x1 = 0.f, x2 = 0.f, x3 = 0.f, hs = 0.f;
    for (int t = 0; t < SEQ; ++t) {
        const size_t r = ((size_t)b * SEQ + t) * DM + ch;
        const float x0 = bf2f(LX[r]);
        const float xc = bc + w3 * x0 + w2 * x1 + w1 * x2 + w0 * x3;
        x3 = x2; x2 = x1; x1 = x0;
        __syncthreads();
        xs[e] = xc;
        __syncthreads();
        float ra = bA, ri = bX;
#pragma unroll
        for (int d = 0; d < 64; ++d) { const float xv = xs[d]; ra += xv * wA[d]; ri += xv * wX[d]; }
        const float rr = sigmoidf_(ra), ii = sigmoidf_(ri);
        const float la = -8.f * rr * spl;
        const float a = __expf(la);
        const float u = sqrtf(-expm1f(2.f * la)) * (ii * xc);
        hs = a * hs + u;
        YL[r] = f2bf(hs * gelu_tanh(bf2f(LG[r])));
    }
}

__global__ void __launch_bounds__(256) n_memkv_post(const float* __restrict__ raw, const float* __restrict__ gk, const float* __restrict__ gq, bf16_t* __restrict__ MK, bf16_t* __restrict__ MVT) {
    const int row = blockIdx.x, b = row >> 8, m = row & 255, d = threadIdx.x;
    __shared__ float red[4];
    for (int h = 0; h < 4; ++h) {
        const float k = raw[(size_t)row * 2048 + h * 256 + d];
        float ss = wave_sum(k * k);
        __syncthreads();
        if ((threadIdx.x & 63) == 0) red[threadIdx.x >> 6] = ss;
        __syncthreads();
        ss = red[0] + red[1] + red[2] + red[3];
        const float rstd = rsqrtf(ss * (1.f / 256.f) + EPS);
        MK[((size_t)b * 256 + m) * DM + h * 256 + d] = f2bf(k * rstd * gk[d] * gq[d]);
        MVT[(((size_t)b * 4 + h) * 256 + d) * 256 + m] = f2bf(raw[(size_t)row * 2048 + 1024 + h * 256 + d]);
    }
}

__global__ void __launch_bounds__(256) n_mem_attn(const bf16_t* MQ, const bf16_t* __restrict__ MK, const bf16_t* __restrict__ MVT, bf16_t* YM) {
    __shared__ float qs[256], ps[256], red[4];
    const int row = blockIdx.x >> 2, h = blockIdx.x & 3, b = row / SEQ, tid = threadIdx.x;
    const float qv = bf2f(MQ[(size_t)row * DM + h * 256 + tid]);
    float ss = wave_sum(qv * qv);
    if ((tid & 63) == 0) red[tid >> 6] = ss;
    qs[tid] = qv;
    __syncthreads();
    const float rstd = rsqrtf((red[0] + red[1] + red[2] + red[3]) * (1.f / 256.f) + EPS);
    const bf16_t* kr = MK + ((size_t)b * 256 + tid) * DM + h * 256;
    float s = 0.f;
    for (int d = 0; d < 256; ++d) s += qs[d] * bf2f(kr[d]);
    s *= rstd * (1.f / 16.f);
    __syncthreads();
    float mx = s;
#pragma unroll
    for (int o = 1; o < 64; o <<= 1) mx = fmaxf(mx, __shfl_xor(mx, o));
    if ((tid & 63) == 0) red[tid >> 6] = mx;
    __syncthreads();
    mx = fmaxf(fmaxf(red[0], red[1]), fmaxf(red[2], red[3]));
    const float p = __expf(s - mx);
    ps[tid] = p;
    float sum = wave_sum(p);
    __syncthreads();
    if ((tid & 63) == 0) red[tid >> 6] = sum;
    __syncthreads();
    sum = red[0] + red[1] + red[2] + red[3];
    const bf16_t* vr = MVT + (((size_t)b * 4 + h) * 256 + tid) * 256;
    float o = 0.f;
    for (int m = 0; m < 256; ++m) o += ps[m] * bf2f(vr[m]);
    YM[(size_t)row * DM + h * 256 + tid] = f2bf(o / sum);
}

__global__ void __launch_bounds__(256) n_act(const bf16_t* __restrict__ GV, const float* __restrict__ cw, const float* __restrict__ cb, bf16_t* __restrict__ ACT) {
    const size_t idx = (size_t)blockIdx.x * 256 + threadIdx.x; if (idx >= (size_t)T * DFF) return;
    const int r = (int)(idx / DFF), c = (int)(idx % DFF), t = r % SEQ;
    const float g0 = bf2f(GV[(size_t)r * 2 * DFF + c]);
    const float g1 = t >= 1 ? bf2f(GV[(size_t)(r - 1) * 2 * DFF + c]) : 0.f;
    const float g2 = t >= 2 ? bf2f(GV[(size_t)(r - 2) * 2 * DFF + c]) : 0.f;
    const float pre = cb[c] + cw[2 * DFF + c] * g0 + cw[DFF + c] * g1 + cw[c] * g2;
    const float val = bf2f(GV[(size_t)r * 2 * DFF + DFF + c]);
    ACT[(size_t)r * DFF + c] = f2bf(pre * sigmoidf_(pre) * val);
}

static void run_naive(const Ptrs& P, hipStream_t st) {
    unsigned char* ws = P.ws;
    bf16_t* H = (bf16_t*)(ws + WS_H);
    bf16_t* PR[9]; for (int i = 0; i < 9; ++i) PR[i] = (bf16_t*)(ws + WS_PROJ + i * SZ_ACT);
    bf16_t *FQ = PR[0], *FK = PR[1], *FV = PR[2], *LX = PR[3], *LG = PR[4], *SQ = PR[5], *SK = PR[6], *SV = PR[7], *MQ = PR[8];
    bf16_t* GATES = (bf16_t*)(ws + WS_GATES);
    bf16_t *YL = (bf16_t*)(ws + WS_YL), *YS = (bf16_t*)(ws + WS_YS), *YM = (bf16_t*)(ws + WS_YM);
    float *LOGF = (float*)(ws + WS_LOGF), *FB = (float*)(ws + WS_FB);
    bf16_t* MEMN = (bf16_t*)(ws + WS_MEMN); float* MEMRAW = (float*)(ws + WS_MEMRAW);
    bf16_t *MK = (bf16_t*)(ws + WS_MK), *MVT = (bf16_t*)(ws + WS_MVT);
    bf16_t *GV = (bf16_t*)(ws + WS_GV), *ACT = (bf16_t*)(ws + WS_ACT);
    const float* const* in = P.in;
    for (int l = 0; l < DEPTH; ++l) {
        n_rmsnorm<<<512 / 4, 256, 0, st>>>(in[1], in[3] + l * DM, MEMN + (size_t)l * 512 * DM, nullptr, nullptr, nullptr, 512);
        n_gemm<EStoreF32><<<dim3(2048 / 64, 512 / 64), 256, 0, st>>>(MEMN + (size_t)l * 512 * DM, in[15] + (size_t)l * DM * 2048, DM, 2048, DM, 0x7fffffff, EStoreF32{MEMRAW + (size_t)l * 512 * 2048, 2048, 0});
        n_memkv_post<<<512, 256, 0, st>>>(MEMRAW + (size_t)l * 512 * 2048, in[17] + l * 256, in[16] + l * 256, MK + (size_t)l * 512 * DM, MVT + (size_t)l * 512 * DM);
    }
    for (int l = 0; l < DEPTH; ++l) {
        const float* xcur = l == 0 ? in[0] : P.out;
        const float* win = in[4] + (size_t)l * DM * NIN;
        n_rmsnorm<<<T / 4, 256, 0, st>>>(xcur, in[2] + l * DM, H, win + 3072, in[5] + l * 16, LOGF, T);
        for (int gI = 0; gI < 9; ++gI) { const int coff = gI < 3 ? gI * 1024 : gI * 1024 + 16;
            n_gemm<EStoreBf16><<<dim3(1024 / 64, T / 64), 256, 0, st>>>(H, win + coff, DM, NIN, DM, 0x7fffffff, EStoreBf16{PR[gI], DM, 0}); }
        n_gemm<EStoreBf16><<<dim3(4096 / 64, T / 64), 256, 0, st>>>(H, win + 9232, DM, NIN, DM, 0x7fffffff, EStoreBf16{GATES, 4096, 0});
        n_headnorm<<<T * 16 / 256, 256, 0, st>>>(FQ, in[6] + l * 64, 64, C2);
        n_headnorm<<<T * 16 / 256, 256, 0, st>>>(FK, in[7] + l * 64, 64, 1.f);
        n_cumsum<<<32, 1024, 0, st>>>(LOGF, FB);
        n_lru<<<32, 64, 0, st>>>(LX, LG, in[8] + (size_t)l * 4 * DM, in[9] + l * DM, in[10] + (size_t)l * 16 * 64 * 64, in[11] + l * DM, in[12] + (size_t)l * 16 * 64 * 64, in[13] + l * DM, in[14] + l * DM, YL);
        n_sb_attn<<<dim3(SEQ / 256, 32), 256, 0, st>>>(SQ, SK, SV, YS);
        n_mem_attn<<<T * 4, 256, 0, st>>>(MQ, MK + (size_t)l * 512 * DM, MVT + (size_t)l * 512 * DM, YM);
        n_fox_attn<<<dim3(SEQ / 256, 32), 256, 0, st>>>(FQ, FK, FV, FB, FQ);
        const bf16_t* Y[4] = {FQ, YL, YS, YM};
        for (int i = 0; i < 4; ++i)
            n_gemm<EBranch><<<dim3(1024 / 64, T / 64), 256, 0, st>>>(Y[i], in[19] + ((size_t)l * 4 + i) * DM * DM, DM, DM, DM, 0x7fffffff, EBranch{GATES, in[18] + ((size_t)l * 4 + i) * DM, i, 0});
        n_gemm<EResid><<<dim3(1024 / 64, T / 64), 256, 0, st>>>(GATES, in[20] + (size_t)l * DM * DM, 4096, DM, 4096, 1023, EResid{xcur, P.out});
        n_rmsnorm<<<T / 4, 256, 0, st>>>(P.out, in[21] + l * DM, H, nullptr, nullptr, nullptr, T);
        n_gemm<EStoreBf16><<<dim3(2 * DFF / 64, T / 64), 256, 0, st>>>(H, in[22] + (size_t)l * DM * 2 * DFF, DM, 2 * DFF, DM, 0x7fffffff, EStoreBf16{GV, 2 * DFF, 0});
        n_act<<<(unsigned)(((size_t)T * DFF + 255) / 256), 256, 0, st>>>(GV, in[23] + (size_t)l * 3 * DFF, in[24] + l * DFF, ACT);
        n_gemm<EResid><<<dim3(1024 / 64, T / 64), 256, 0, st>>>(ACT, in[25] + (size_t)l * DFF * DM, DFF, DM, DFF, 0x7fffffff, EResid{P.out, P.out});
    }
}

extern "C" void kernel_launch(void* const* d_in, const int* in_sizes, int n_in, void* d_out, int out_size, void* d_ws, size_t ws_size, hipStream_t stream) {
    if (n_in != 26 || out_size != T * DM || ws_size < WS_END) { fprintf(stderr, "kernel_launch: unexpected sizes n_in %d out %d ws %zu (need %zu)\n", n_in, out_size, ws_size, (size_t)WS_END); return; }
    Ptrs P{};
    for (int i = 0; i < 26; ++i) P.in[i] = (const float*)d_in[i];
    P.out = (float*)d_out; P.ws = (unsigned char*)d_ws;
    run_naive(P, stream);
}
```

```cpp
#include <hip/hip_runtime.h>
#include <cstdio>
#include <cstdint>
#include <hip/hip_cooperative_groups.h>

typedef unsigned short bf16_t;
constexpr int BATCH = 2, SEQ = 8192, DM = 1024, DEPTH = 4, T = BATCH * SEQ;
constexpr int NMEM = 256, NIN = 13328, DFF = 2816;
constexpr float EPS = 1e-6f;
constexpr float LOG2E = 1.4426950408889634f;
constexpr float C2 = 0.125f * LOG2E;
constexpr float SB_THR = -104.0f;

__device__ __forceinline__ float bf2f(bf16_t b) { return __uint_as_float(((unsigned)b) << 16); }
__device__ __forceinline__ bf16_t f2bf(float f) { unsigned u = __float_as_uint(f); return (bf16_t)((u + 0x7fffu + ((u >> 16) & 1u)) >> 16); }
__device__ __forceinline__ float bfr(float f) { return bf2f(f2bf(f)); }
__device__ __forceinline__ float wave_sum(float v) {
#pragma unroll
    for (int o = 1; o < 64; o <<= 1) v += __shfl_xor(v, o);
    return v;
}
__device__ __forceinline__ float softplusf(float x) { return fmaxf(x, 0.f) + log1pf(__expf(-fabsf(x))); }
__device__ __forceinline__ float logsigmoidf(float x) { return -softplusf(-x); }
__device__ __forceinline__ float sigmoidf_(float x) { return 1.f / (1.f + __expf(-x)); }
__device__ __forceinline__ float gelu_tanh(float x) { const float u = 0.7978845608028654f * (x + 0.044715f * x * x * x); return 0.5f * x * (1.f + tanhf(u)); }

__device__ __forceinline__ int mk_tid() { int t = threadIdx.x; asm volatile("" : "+v"(t)); return t; }

constexpr size_t MiB = 1u << 20;
constexpr size_t SZ_ACT = (size_t)T * DM * 2;
constexpr size_t WS_CTL = 0;
constexpr size_t WS_H = 1 * MiB;
constexpr size_t WS_PROJ = WS_H + SZ_ACT;
constexpr size_t WS_GATES = WS_PROJ + 9 * SZ_ACT;
constexpr size_t WS_E = WS_GATES + 4 * SZ_ACT;
constexpr size_t WS_LOGF = WS_E + SZ_ACT;
constexpr size_t WS_FB = WS_LOGF + 1 * MiB;
constexpr size_t WS_MQSS = WS_FB + 1 * MiB;
constexpr size_t WS_ESUM = WS_MQSS + 1 * MiB;
constexpr size_t WS_MEMN = WS_ESUM + 1 * MiB;
constexpr size_t WS_MEMRAW = WS_MEMN + 4 * MiB;
constexpr size_t WS_MK = WS_MEMRAW + 16 * MiB;
constexpr size_t WS_MVT = WS_MK + 4 * MiB;
constexpr size_t WS_LRU = WS_MVT + 4 * MiB;
constexpr size_t WS_WT = WS_LRU + 2 * MiB;
constexpr size_t WS_END = WS_WT + 72 * MiB;
constexpr size_t WS_YL = WS_PROJ + 6 * SZ_ACT, WS_YS = WS_PROJ + 5 * SZ_ACT, WS_YM = WS_PROJ + 8 * SZ_ACT;
constexpr size_t WS_GV = WS_PROJ;
constexpr size_t WS_ACT = WS_GV + (size_t)T * 2 * DFF * 2;
static_assert(WS_ACT + (size_t)T * DFF * 2 <= WS_GATES, "ffn alias");

struct Ptrs {
    const float* in[26];
    float* out;
    unsigned char* ws;
};

__global__ void __launch_bounds__(256) n_rmsnorm(const float* __restrict__ x, const float* __restrict__ g, bf16_t* __restrict__ H,
                                                 const float* __restrict__ Wf, const float* __restrict__ bfg, float* __restrict__ LOGF, int nrows) {
    const int lane = threadIdx.x & 63, row = blockIdx.x * 4 + (threadIdx.x >> 6);
    if (row >= nrows) return;
    const float4* xr = (const float4*)(x + (size_t)row * DM);
    const float4* gr = (const float4*)g;
    float4 v[4]; float ss = 0.f;
#pragma unroll
    for (int j = 0; j < 4; ++j) { v[j] = xr[lane + 64 * j]; ss += v[j].x * v[j].x + v[j].y * v[j].y + v[j].z * v[j].z + v[j].w * v[j].w; }
    ss = wave_sum(ss);
    const float rstd = rsqrtf(ss * (1.f / DM) + EPS);
#pragma unroll
    for (int j = 0; j < 4; ++j) { const float4 gg = gr[lane + 64 * j]; v[j].x *= rstd * gg.x; v[j].y *= rstd * gg.y; v[j].z *= rstd * gg.z; v[j].w *= rstd * gg.w;
        ushort4 o; o.x = f2bf(v[j].x); o.y = f2bf(v[j].y); o.z = f2bf(v[j].z); o.w = f2bf(v[j].w);
        ((ushort4*)(H + (size_t)row * DM))[lane + 64 * j] = o; }
    if (Wf) {
        float mine = 0.f;
        for (int h = 0; h < 16; ++h) {
            float p = 0.f;
#pragma unroll
            for (int j = 0; j < 4; ++j) { const int k = (lane + 64 * j) * 4;
                p += v[j].x * Wf[(size_t)k * NIN + h] + v[j].y * Wf[(size_t)(k + 1) * NIN + h] + v[j].z * Wf[(size_t)(k + 2) * NIN + h] + v[j].w * Wf[(size_t)(k + 3) * NIN + h]; }
            p = wave_sum(p);
            if (lane == h) mine = p;
        }
        if (lane < 16) { const int b = row / SEQ, t = row % SEQ; LOGF[((size_t)b * 16 + lane) * SEQ + t] = logsigmoidf(mine + bfg[lane]); }
    }
}

struct EStoreBf16 { bf16_t* O; int ldc; int pad; __device__ void operator()(int m, int n, float a) const { O[(size_t)m * ldc + n] = f2bf(a); } };
struct EStoreF32 { float* O; int ldc; int pad; __device__ void operator()(int m, int n, float a) const { O[(size_t)m * ldc + n] = a; } };
struct EBranch { bf16_t* G; const float* bg; int i; int pad; __device__ void operator()(int m, int n, float a) const { bf16_t* p = G + (size_t)m * 4096 + i * 1024 + n; *p = f2bf(sigmoidf_(bf2f(*p) + bg[n]) * a); } };
struct EResid { const float* base; float* out; __device__ void operator()(int m, int n, float a) const { out[(size_t)m * DM + n] = base[(size_t)m * DM + n] + a; } };

template <class Epi> __global__ void __launch_bounds__(256) n_gemm(const bf16_t* __restrict__ A, const float* __restrict__ W, int lda, int ldw, int K, int kmask, Epi epi) {
    __shared__ float As[16][68], Bs[16][68];
    const int tx = threadIdx.x & 15, ty = threadIdx.x >> 4, m0 = blockIdx.y * 64, n0 = blockIdx.x * 64;
    float acc[4][4];
#pragma unroll
    for (int i = 0; i < 4; ++i)
#pragma unroll
        for (int j = 0; j < 4; ++j) acc[i][j] = 0.f;
    for (int k0 = 0; k0 < K; k0 += 16) {
#pragma unroll
        for (int i = 0; i < 4; ++i) { const int idx = threadIdx.x + i * 256; { const int r = idx >> 4, c = idx & 15; As[c][r] = bf2f(A[(size_t)(m0 + r) * lda + k0 + c]); }
            { const int r = idx >> 6, c = idx & 63; Bs[r][c] = bfr(W[(size_t)((k0 + r) & kmask) * ldw + n0 + c]); } }
        __syncthreads();
#pragma unroll
        for (int kk = 0; kk < 16; ++kk) { float a[4], b[4];
#pragma unroll
            for (int i = 0; i < 4; ++i) { a[i] = As[kk][ty * 4 + i]; b[i] = Bs[kk][tx * 4 + i]; }
#pragma unroll
            for (int i = 0; i < 4; ++i)
#pragma unroll
                for (int j = 0; j < 4; ++j) acc[i][j] += a[i] * b[j]; }
        __syncthreads();
    }
#pragma unroll
    for (int i = 0; i < 4; ++i)
#pragma unroll
        for (int j = 0; j < 4; ++j) epi(m0 + ty * 4 + i, n0 + tx * 4 + j, acc[i][j]);
}

__global__ void __launch_bounds__(256) n_headnorm(bf16_t* X, const float* __restrict__ g, int HD, float scale) {
    const int idx = blockIdx.x * 256 + threadIdx.x, nh = DM / HD, row = idx / nh, h = idx % nh;
    if (row >= T) return;
    bf16_t* p = X + (size_t)row * DM + h * HD; float ss = 0.f;
    for (int d = 0; d < HD; ++d) { const float v = bf2f(p[d]); ss += v * v; }
    const float rstd = rsqrtf(ss / HD + EPS) * scale;
    for (int d = 0; d < HD; ++d) p[d] = f2bf(bf2f(p[d]) * rstd * g[d]);
}

__global__ void __launch_bounds__(1024) n_cumsum(const float* __restrict__ LOGF, float* __restrict__ FB) {
    __shared__ float part[1024];
    const int bh = blockIdx.x, tid = threadIdx.x; const float* src = LOGF + (size_t)bh * SEQ + tid * 8; float v[8]; float s = 0.f;
#pragma unroll
    for (int i = 0; i < 8; ++i) { s += src[i]; v[i] = s; }
    part[tid] = s; __syncthreads();
    if (tid == 0) { float run = 0.f; for (int i = 0; i < 1024; ++i) { const float t_ = part[i]; part[i] = run; run += t_; } }
    __syncthreads();
    const float off = part[tid]; float* dst = FB + (size_t)bh * SEQ + tid * 8;
#pragma unroll
    for (int i = 0; i < 8; ++i) dst[i] = off + v[i];
}

__global__ void __launch_bounds__(256) n_fox_attn(const bf16_t* Q, const bf16_t* __restrict__ K, const bf16_t* __restrict__ V, const float* __restrict__ FB, bf16_t* O) {
    __shared__ float Ks[64][64], Vs[64][64], Fs[64];
    const int bh = blockIdx.y, b = bh >> 4, h = bh & 15, tq = blockIdx.x * 256 + threadIdx.x;
    const size_t rowq = (size_t)b * SEQ + tq;
    float q[64], o[64];
#pragma unroll
    for (int d = 0; d < 64; ++d) { q[d] = bf2f(Q[rowq * DM + h * 64 + d]); o[d] = 0.f; }
    const float Ft = FB[(size_t)bh * SEQ + tq];
    float m = -INFINITY, l = 0.f;
    const int ntile = (blockIdx.x * 256 + 256) / 64;
    for (int kt = 0; kt < ntile; ++kt) {
        __syncthreads();
        for (int i = threadIdx.x; i < 64 * 64; i += 256) { const int r = i >> 6, c = i & 63; const size_t rk = ((size_t)b * SEQ + kt * 64 + r) * DM + h * 64 + c; Ks[r][c] = bf2f(K[rk]); Vs[r][c] = bf2f(V[rk]); }
        if (threadIdx.x < 64) Fs[threadIdx.x] = FB[(size_t)bh * SEQ + kt * 64 + threadIdx.x];
        __syncthreads();
        for (int j = 0; j < 64; ++j) {
            const int s = kt * 64 + j; if (s > tq) break;
            float z = 0.f;
#pragma unroll
            for (int d = 0; d < 64; ++d) z += q[d] * Ks[j][d];
            z += (Ft - Fs[j]) * LOG2E;
            if (z > m) { const float c = exp2f(m - z); l *= c;
#pragma unroll
                for (int d = 0; d < 64; ++d) o[d] *= c;
                m = z; }
            const float p = exp2f(z - m); l += p;
#pragma unroll
            for (int d = 0; d < 64; ++d) o[d] += p * Vs[j][d];
        }
    }
    const float il = 1.f / l;
#pragma unroll
    for (int d = 0; d < 64; ++d) O[rowq * DM + h * 64 + d] = f2bf(o[d] * il);
}

__global__ void __launch_bounds__(256) n_sb_attn(const bf16_t* Q, const bf16_t* __restrict__ K, const bf16_t* __restrict__ V, bf16_t* O) {
    __shared__ float Ks[64][64], Vs[64][64];
    const int bh = blockIdx.y, b = bh >> 4, h = bh & 15, tq = blockIdx.x * 256 + threadIdx.x;
    const size_t rowq = (size_t)b * SEQ + tq;
    float q[64], o[64];
#pragma unroll
    for (int d = 0; d < 64; ++d) { q[d] = bf2f(Q[rowq * DM + h * 64 + d]) * 0.125f; o[d] = 0.f; }
    float R = 0.f;
    for (int kt = (blockIdx.x * 256 + 255) / 64; kt >= 0; --kt) {
        if (__syncthreads_and(R < SB_THR)) break;
        for (int i = threadIdx.x; i < 64 * 64; i += 256) { const int r = i >> 6, c = i & 63; const size_t rk = ((size_t)b * SEQ + kt * 64 + r) * DM + h * 64 + c; Ks[r][c] = bf2f(K[rk]); Vs[r][c] = bf2f(V[rk]); }
        __syncthreads();
        for (int j = 63; j >= 0; --j) {
            const int s = kt * 64 + j; if (s >= tq) continue;
            float z = 0.f;
#pragma unroll
            for (int d = 0; d < 64; ++d) z += q[d] * Ks[j][d];
            const float sp = softplusf(z);
            const float w = __expf((z - sp) + R);
            R -= sp;
#pragma unroll
            for (int d = 0; d < 64; ++d) o[d] += w * Vs[j][d];
        }
    }
#pragma unroll
    for (int d = 0; d < 64; ++d) O[rowq * DM + h * 64 + d] = f2bf(o[d]);
}

__global__ void __launch_bounds__(64) n_lru(const bf16_t* LX, const bf16_t* __restrict__ LG, const float* __restrict__ cw, const float* __restrict__ cb,
                                            const float* __restrict__ wa, const float* __restrict__ ba, const float* __restrict__ wx, const float* __restrict__ bx,
                                            const float* __restrict__ lam, bf16_t* YL) {
    __shared__ float xs[64];
    const int b = blockIdx.x >> 4, n = blockIdx.x & 15, e = threadIdx.x, ch = n * 64 + e;
    float wA[64], wX[64];
#pragma unroll
    for (int d = 0; d < 64; ++d) { wA[d] = wa[((size_t)n * 64 + d) * 64 + e]; wX[d] = wx[((size_t)n * 64 + d) * 64 + e]; }
    const float w0 = cw[ch], w1 = cw[DM + ch], w2 = cw[2 * DM + ch], w3 = cw[3 * DM + ch], bc = cb[ch], bA = ba[ch], bX = bx[ch];
    const float spl = softplusf(-lam[ch]);
    float x1 = 0.f, x2 = 0.f, x3 = 0.f, hs = 0.f;
    for (int t = 0; t < SEQ; ++t) {
        const size_t r = ((size_t)b * SEQ + t) * DM + ch;
        const float x0 = bf2f(LX[r]);
        const float xc = bc + w3 * x0 + w2 * x1 + w1 * x2 + w0 * x3;
        x3 = x2; x2 = x1; x1 = x0;
        __syncthreads();
        xs[e] = xc;
        __syncthreads();
        float ra = bA, ri = bX;
#pragma unroll
        for (int d = 0; d < 64; ++d) { const float xv = xs[d]; ra += xv * wA[d]; ri += xv * wX[d]; }
        const float rr = sigmoidf_(ra), ii = sigmoidf_(ri);
        const float la = -8.f * rr * spl;
        const float a = __expf(la);
        const float u = sqrtf(-expm1f(2.f * la)) * (ii * xc);
        hs = a * hs + u;
        YL[r] = f2bf(hs * gelu_tanh(bf2f(LG[r])));
    }
}

__global__ void __launch_bounds__(256) n_memkv_post(const float* __restrict__ raw, const float* __restrict__ gk, const float* __restrict__ gq, bf16_t* __restrict__ MK, bf16_t* __restrict__ MVT) {
    const int row = blockIdx.x, b = row >> 8, m = row & 255, d = threadIdx.x;
    __shared__ float red[4];
    for (int h = 0; h < 4; ++h) {
        const float k = raw[(size_t)row * 2048 + h * 256 + d];
        float ss = wave_sum(k * k);
        __syncthreads();
        if ((threadIdx.x & 63) == 0) red[threadIdx.x >> 6] = ss;
        __syncthreads();
        ss = red[0] + red[1] + red[2] + red[3];
        const float rstd = rsqrtf(ss * (1.f / 256.f) + EPS);
        MK[((size_t)b * 256 + m) * DM + h * 256 + d] = f2bf(k * rstd * gk[d] * gq[d]);
        MVT[(((size_t)b * 4 + h) * 256 + d) * 256 + m] = f2bf(raw[(size_t)row * 2048 + 1024 + h * 256 + d]);
    }
}

__global__ void __launch_bounds__(256) n_mem_attn(const bf16_t* MQ, const bf16_t* __restrict__ MK, const bf16_t* __restrict__ MVT, bf16_t* YM) {
    __shared__ float qs[256], ps[256], red[4];
    const int row = blockIdx.x >> 2, h = blockIdx.x & 3, b = row / SEQ, tid = threadIdx.x;
    const float qv = bf2f(MQ[(size_t)row * DM + h * 256 + tid]);
    float ss = wave_sum(qv * qv);
    if ((tid & 63) == 0) red[tid >> 6] = ss;
    qs[tid] = qv;
    __syncthreads();
    const float rstd = rsqrtf((red[0] + red[1] + red[2] + red[3]) * (1.f / 256.f) + EPS);
    const bf16_t* kr = MK + ((size_t)b * 256 + tid) * DM + h * 256;
    float s = 0.f;
    for (int d = 0; d < 256; ++d) s += qs[d] * bf2f(kr[d]);
    s *= rstd * (1.f / 16.f);
    __syncthreads();
    float mx = s;
#pragma unroll
    for (int o = 1; o < 64; o <<= 1) mx = fmaxf(mx, __shfl_xor(mx, o));
    if ((tid & 63) == 0) red[tid >> 6] = mx;
    __syncthreads();
    mx = fmaxf(fmaxf(red[0], red[1]), fmaxf(red[2], red[3]));
    const float p = __expf(s - mx);
    ps[tid] = p;
    float sum = wave_sum(p);
    __syncthreads();
    if ((tid & 63) == 0) red[tid >> 6] = sum;
    __syncthreads();
    sum = red[0] + red[1] + red[2] + red[3];
    const bf16_t* vr = MVT + (((size_t)b * 4 + h) * 256 + tid) * 256;
    float o = 0.f;
    for (int m = 0; m < 256; ++m) o += ps[m] * bf2f(vr[m]);
    YM[(size_t)row * DM + h * 256 + tid] = f2bf(o / sum);
}

__global__ void __launch_bounds__(256) n_act(const bf16_t* __restrict__ GV, const float* __restrict__ cw, const float* __restrict__ cb, bf16_t* __restrict__ ACT) {
    const size_t idx = (size_t)blockIdx.x * 256 + threadIdx.x; if (idx >= (size_t)T * DFF) return;
    const int r = (int)(idx / DFF), c = (int)(idx % DFF), t = r % SEQ;
    const float g0 = bf2f(GV[(size_t)r * 2 * DFF + c]);
    const float g1 = t >= 1 ? bf2f(GV[(size_t)(r - 1) * 2 * DFF + c]) : 0.f;
    const float g2 = t >= 2 ? bf2f(GV[(size_t)(r - 2) * 2 * DFF + c]) : 0.f;
    const float pre = cb[c] + cw[2 * DFF + c] * g0 + cw[DFF + c] * g1 + cw[c] * g2;
    const float val = bf2f(GV[(size_t)r * 2 * DFF + DFF + c]);
    ACT[(size_t)r * DFF + c] = f2bf(pre * sigmoidf_(pre) * val);
}

#define CFG 32767
namespace pg8 {
#define PG8_LAS __attribute__((address_space(3)))
typedef unsigned short bf16_t;
typedef short bf16x8 __attribute__((ext_vector_type(8)));
typedef float f32x4 __attribute__((ext_vector_type(4)));
typedef unsigned u32x4 __attribute__((ext_vector_type(4)));
constexpr int BM = 256, BK = 64, HALF = 128, HTB = HALF * BK * 2  , STAGE_BYTES = 8 * HTB, NXCD = 8, WGM = 8;

__host__ __device__ __forceinline__ int lds_byte(int r, int c) { const int st = (r >> 4) * 2 + (c >> 5), rr = r & 15, cc = c & 31, ob = rr * 64 + cc * 2; return st * 1024 + (ob ^ (((ob >> 9) & 1) << 5)); }
__host__ __device__ __forceinline__ void stage_rc(int b, int& R, int& C) { const int st = b / 1024, sb = b % 1024, swz = sb ^ (((sb >> 9) & 1) << 5); R = (st >> 1) * 16 + swz / 64; C = (st & 1) * 32 + (swz % 64) / 2; }
__host__ __device__ __forceinline__ int perm32(int rho) { const int n = rho >> 4, i = rho & 15; return 8 * (i >> 2) + 4 * n + (i & 3); }

struct Unit { int pm, pn; };
struct Gemm { int lda, ldb, K; };

struct StaticOrder {
    int nM, nN, nwg, G, c;
    __host__ __device__ void init(int M, int N, int G_, int c_) { nM = M / BM; nN = N / BM; nwg = nM * nN; G = G_; c = c_; }
    __host__ __device__ bool next(int i, Unit& u) const {
        const long L = (long)i * G + c; if (L >= nwg) return false;
        int wgid = (int)L; { const int q = nwg / NXCD, r = nwg % NXCD, xcd = wgid % NXCD, off = wgid / NXCD; wgid = (xcd < r ? xcd * (q + 1) : r * (q + 1) + (xcd - r) * q) + off; }
        const int nig = WGM * nN, gid = wgid / nig, fm = gid * WGM, gsz = (nM - fm) < WGM ? (nM - fm) : WGM;
        u.pm = fm + ((wgid % nig) % gsz); u.pn = (wgid % nig) / gsz; return true;
    }
    __device__ __forceinline__ void a_ready(const Unit&) const {}
    __device__ __forceinline__ void done(const Unit&) const {}
};

__device__ __forceinline__ unsigned cvt_pk_bf16(float lo, float hi) { unsigned r; asm volatile("v_cvt_pk_bf16_f32 %0, %1, %2" : "=v"(r) : "v"(lo), "v"(hi)); return r; }
typedef float f32x2 __attribute__((ext_vector_type(2)));
__device__ __forceinline__ f32x2 gelu_pk(f32x2 v) {
    const f32x2 av = __builtin_elementwise_abs(v), d = av * 0.2316418882f + 1.0f;
    f32x2 t; t.x = __builtin_amdgcn_rcpf(d.x); t.y = __builtin_amdgcn_rcpf(d.y);
    f32x2 q = t * 0.5307027145f + (-0.7265760135f); q = q * t + 0.7107068705f; q = q * t + (-0.142248368f); q = q * t + 0.127414796f; q = q * t;
    const f32x2 s = (v * v) * (-0.72134752044f);
    f32x2 e; e.x = __builtin_amdgcn_exp2f(s.x); e.y = __builtin_amdgcn_exp2f(s.y);
    const f32x2 m = v * (q * e), r = v - m;
    f32x2 o; o.x = v.x < 0.f ? m.x : r.x; o.y = v.y < 0.f ? m.y : r.y; return o;
}

template <class Epi, class Sched, bool ALIGN_EPI = false, bool SP2 = false>
__device__ __forceinline__ void gemm_phase(PG8_LAS unsigned char* lds, const Gemm g, const Sched& S, const Epi& E) {
    const int tid = mk_tid(), wid = __builtin_amdgcn_readfirstlane(tid >> 6), lane = tid & 63, wr = wid >> 2, wc = wid & 3, fr = lane & 15, fq = lane >> 4;
    const int K = g.K, nt = K / BK;
    unsigned voffA[2], voffB[2];
#pragma unroll
    for (int i = 0; i < 2; ++i) { int R, C; stage_rc(tid * 16 + i * 8192, R, C); const int Rb = Epi::PERM ? ((R & ~31) + perm32(R & 31)) : R;
        voffA[i] = (unsigned)(R * g.lda + C) * 2u; voffB[i] = (unsigned)(Rb * g.ldb + C) * 2u; }
    const size_t kstep = (size_t)(BK * 2);
    const size_t hstepA = (size_t)HALF * g.lda * 2, hstepB = (size_t)HALF * g.ldb * 2;
    const unsigned ldsw = (unsigned)wid * 1024u;
    const int aoff = lds_byte(wr * 64 + fr, fq * 8), boff = lds_byte(wc * 32 + fr, fq * 8);
#define PG8_SA(b, h) (((b) * 2 + (h)) * HTB)
#define PG8_SB(b, h) ((4 + (b) * 2 + (h)) * HTB)
#define PG8_STAGE(bufoff, gbase, voff) do { _Pragma("unroll") for (int _i = 0; _i < 2; ++_i) \
        __builtin_amdgcn_global_load_lds((const unsigned*)((const char*)(gbase) + (voff)[_i]), (PG8_LAS unsigned*)(lds + (bufoff) + ldsw + _i * 8192), 16, 0, 0); } while (0)
#define PG8_LDA(dst, b, h) do { _Pragma("unroll") for (int m = 0; m < 4; ++m) _Pragma("unroll") for (int k = 0; k < 2; ++k) dst[m][k] = *(const PG8_LAS bf16x8*)(lds + PG8_SA(b, h) + aoff + m * 2048 + k * 1024); } while (0)
#define PG8_LDB(dst, b, h) do { _Pragma("unroll") for (int n = 0; n < 2; ++n) _Pragma("unroll") for (int k = 0; k < 2; ++k) dst[n][k] = *(const PG8_LAS bf16x8*)(lds + PG8_SB(b, h) + boff + n * 2048 + k * 1024); } while (0)
#define PG8_MMA(ai, bj, At, Bt) do { __builtin_amdgcn_s_setprio(1); _Pragma("unroll") for (int m = 0; m < 4; ++m) _Pragma("unroll") for (int n = 0; n < 2; ++n) _Pragma("unroll") for (int k = 0; k < 2; ++k) \
        acc[ai][bj][m][n] = __builtin_amdgcn_mfma_f32_16x16x32_bf16(Bt[n][k], At[m][k], acc[ai][bj][m][n], 0, 0, 0); __builtin_amdgcn_s_setprio(0); } while (0)
#define PG8_WAIT_V(n) asm volatile("s_waitcnt vmcnt(" #n ")" ::: "memory")
#define PG8_WAIT_L(n) asm volatile("s_waitcnt lgkmcnt(" #n ")" ::: "memory")
#define PG8_BAR __builtin_amdgcn_s_barrier()
#define PG8_SCHED __builtin_amdgcn_sched_barrier(0)
    Unit cur, nxt; int ui = 0;
    if (!S.next(0, cur)) return;
    f32x4 acc[2][2][4][2];
#pragma unroll
    for (int a = 0; a < 2; ++a)
#pragma unroll
        for (int b = 0; b < 2; ++b)
#pragma unroll
            for (int m = 0; m < 4; ++m)
#pragma unroll
                for (int n = 0; n < 2; ++n) acc[a][b][m][n] = (f32x4){0.f, 0.f, 0.f, 0.f};
    bf16x8 At[4][2], B0[2][2], B1[2][2];
    const char* cA = S.aptr(cur); const char* cB = S.bptr(cur);
    S.a_ready(cur);
    if constexpr (SP2) {
        PG8_STAGE(PG8_SB(0, 0), cB, voffB); PG8_STAGE(PG8_SB(0, 1), cB + hstepB, voffB); PG8_STAGE(PG8_SA(0, 0), cA, voffA); PG8_STAGE(PG8_SA(0, 1), cA + hstepA, voffA);
        if (wr == 1) PG8_BAR;
        PG8_WAIT_V(2); PG8_BAR;
        PG8_STAGE(PG8_SB(1, 0), cB + kstep, voffB); PG8_STAGE(PG8_SA(1, 0), cA + kstep, voffA); PG8_STAGE(PG8_SB(1, 1), cB + hstepB + kstep, voffB);
        PG8_WAIT_V(6); PG8_BAR;
    } else {
        PG8_STAGE(PG8_SB(0, 0), cB, voffB); PG8_STAGE(PG8_SA(0, 0), cA, voffA); PG8_STAGE(PG8_SB(0, 1), cB + hstepB, voffB); PG8_STAGE(PG8_SA(0, 1), cA + hstepA, voffA);
        if (wr == 1) PG8_BAR;
        PG8_WAIT_V(4); PG8_BAR;
        PG8_STAGE(PG8_SB(1, 0), cB + kstep, voffB); PG8_STAGE(PG8_SA(1, 0), cA + kstep, voffA); PG8_STAGE(PG8_SB(1, 1), cB + hstepB + kstep, voffB);
        PG8_WAIT_V(6); PG8_BAR;
    }
    for (;;) {
        const bool has_next = S.next(ui + 1, nxt);
        const char* nA = has_next ? S.aptr(nxt) : cA; const char* nB = has_next ? S.bptr(nxt) : cB;
        for (int t = 0; t < nt; t += 2) {
            const bool last = (t == nt - 2);
            const char* a1 = cA + (size_t)(t + 1) * kstep;
            const char* a2 = last ? nA : cA + (size_t)(t + 2) * kstep; const char* b2 = last ? nB : cB + (size_t)(t + 2) * kstep;
            const char* a3 = a2 + kstep; const char* b3 = b2 + kstep;
            if (last && has_next) S.a_ready(nxt);
            if constexpr (SP2) {
            PG8_LDB(B0, 0, 0); PG8_LDB(B1, 0, 1); PG8_SCHED; PG8_LDA(At, 0, 0); PG8_STAGE(PG8_SA(1, 1), a1 + hstepA, voffA);
            PG8_WAIT_V(8); PG8_WAIT_L(0); PG8_BAR; PG8_MMA(0, 0, At, B0); PG8_MMA(0, 1, At, B1); PG8_BAR; PG8_SCHED;
            PG8_LDA(At, 0, 1); PG8_STAGE(PG8_SB(0, 0), b2, voffB); PG8_STAGE(PG8_SB(0, 1), b2 + hstepB, voffB); PG8_STAGE(PG8_SA(0, 0), a2, voffA);
            PG8_WAIT_V(8); PG8_WAIT_L(0); PG8_BAR; PG8_MMA(1, 0, At, B0); PG8_MMA(1, 1, At, B1); PG8_BAR; PG8_SCHED;
            PG8_LDB(B0, 1, 0); PG8_LDB(B1, 1, 1); PG8_SCHED; PG8_LDA(At, 1, 0); PG8_STAGE(PG8_SA(0, 1), a2 + hstepA, voffA);
            PG8_WAIT_V(8); PG8_WAIT_L(0); PG8_BAR; PG8_MMA(0, 0, At, B0); PG8_MMA(0, 1, At, B1); PG8_BAR; PG8_SCHED;
            PG8_LDA(At, 1, 1); PG8_STAGE(PG8_SB(1, 0), b3, voffB); PG8_STAGE(PG8_SB(1, 1), b3 + hstepB, voffB); PG8_STAGE(PG8_SA(1, 0), a3, voffA);
            PG8_WAIT_V(8); PG8_WAIT_L(0); PG8_BAR; PG8_MMA(1, 0, At, B0); PG8_MMA(1, 1, At, B1); PG8_BAR; PG8_SCHED;
            } else {
            PG8_LDB(B0, 0, 0); PG8_SCHED; PG8_LDA(At, 0, 0); PG8_STAGE(PG8_SA(1, 1), a1 + hstepA, voffA);
            PG8_WAIT_L(8); PG8_BAR; PG8_WAIT_L(0); PG8_MMA(0, 0, At, B0); PG8_BAR; PG8_SCHED;
            PG8_LDB(B1, 0, 1); PG8_STAGE(PG8_SB(0, 0), b2, voffB);
            PG8_BAR; PG8_WAIT_L(0); PG8_MMA(0, 1, At, B1); PG8_BAR;
            PG8_LDA(At, 0, 1); PG8_STAGE(PG8_SA(0, 0), a2, voffA);
            PG8_BAR; PG8_WAIT_L(0); PG8_MMA(1, 0, At, B0); PG8_BAR; PG8_SCHED;
            PG8_STAGE(PG8_SB(0, 1), b2 + hstepB, voffB);
            PG8_WAIT_V(6); PG8_BAR; PG8_MMA(1, 1, At, B1); PG8_BAR;
            PG8_LDB(B0, 1, 0); PG8_SCHED; PG8_LDA(At, 1, 0); PG8_STAGE(PG8_SA(0, 1), a2 + hstepA, voffA);
            PG8_WAIT_L(8); PG8_BAR; PG8_WAIT_L(0); PG8_MMA(0, 0, At, B0); PG8_BAR; PG8_SCHED;
            PG8_LDB(B1, 1, 1); PG8_STAGE(PG8_SB(1, 0), b3, voffB);
            PG8_BAR; PG8_WAIT_L(0); PG8_MMA(0, 1, At, B1); PG8_BAR;
            PG8_LDA(At, 1, 1); PG8_STAGE(PG8_SA(1, 0), a3, voffA);
            PG8_BAR; PG8_WAIT_L(0); PG8_MMA(1, 0, At, B0); PG8_BAR; PG8_SCHED;
            PG8_STAGE(PG8_SB(1, 1), b3 + hstepB, voffB);
            PG8_WAIT_V(6); PG8_BAR; PG8_MMA(1, 1, At, B1); PG8_BAR;
            }
        }
        if constexpr (ALIGN_EPI) { if (wr == 0) PG8_BAR; }
        if constexpr (!Epi::AFTER_DRAIN) { int fr_ = fr, fq_ = fq; asm volatile("" : "+v"(fr_), "+v"(fq_));   E(acc, cur, wr, wc, fr_, fq_); S.done(cur); }
        if (!has_next) break;
#pragma unroll
        for (int a = 0; a < 2; ++a)
#pragma unroll
            for (int b = 0; b < 2; ++b)
#pragma unroll
                for (int m = 0; m < 4; ++m)
#pragma unroll
                    for (int n = 0; n < 2; ++n) acc[a][b][m][n] = (f32x4){0.f, 0.f, 0.f, 0.f};
        cur = nxt; cA = nA; cB = nB; ++ui;
        if constexpr (ALIGN_EPI) { if (wr == 1) PG8_BAR; }
    }
    PG8_WAIT_V(0);
    if constexpr (!ALIGN_EPI) { if (wr == 0) PG8_BAR; }
    PG8_BAR;
    if constexpr (Epi::AFTER_DRAIN) { E.fused(acc, cur, wr, wc, fr, fq, lds, wid, lane); S.done(cur); }
#undef PG8_SA
#undef PG8_SB
#undef PG8_STAGE
#undef PG8_LDA
#undef PG8_LDB
#undef PG8_MMA
#undef PG8_WAIT_V
#undef PG8_WAIT_L
#undef PG8_BAR
#undef PG8_SCHED
}
}
#include <hip/hip_bf16.h>
#include <cmath>
namespace attn_body {
using bf16=__hip_bfloat16;
using bf16x8=__attribute__((ext_vector_type(8)))short;
using s16x4=__attribute__((ext_vector_type(4)))short;
using f32x16=__attribute__((ext_vector_type(16)))float;
using u32x4=__attribute__((ext_vector_type(4)))unsigned;
constexpr int BATCH=2,NHEAD=16,SEQ=8192,D=64,DM=NHEAD*D;
constexpr int NW=8,QBLK=32,QB=QBLK*NW,KVBLK=64,NQB=SEQ/QB;
constexpr int ATTN_PITCH=DM, ATTN_UNIT_ROWS=QB;
__device__ __forceinline__ int crow(int r,int hi){return (r&3)+8*(r>>2)+4*hi;}
#define SBAR() __builtin_amdgcn_sched_barrier(0)
__device__ __forceinline__ void cmask(f32x16&p0,f32x16&p1,int jb,int qrel,int hi){
  const float NEG=-INFINITY; int kb=64*jb+4*hi;
  #pragma unroll
  for(int r=0;r<16;++r){int kv=kb+(r&3)+8*(r>>2); if(kv>qrel)p0[r]=NEG; if(kv+32>qrel)p1[r]=NEG;}
}

constexpr int NSLOT=3, SLOTB=8192;
constexpr int LDS_K=0, LDS_V=NSLOT*SLOTB, LDS_WS=2*NSLOT*SLOTB, LDS_OST=LDS_WS+NW*64*4, LDS_BYTES=LDS_OST+NW*4096;
constexpr int BIAS_OFF=86016;
constexpr float C2=0.125f*1.4426950408889634f;
__device__ __forceinline__ void glds16(const void*gsrc,unsigned lds_dst){unsigned keep;
  asm volatile("s_mov_b32 %0, m0\n\ts_mov_b32 m0, %2\n\ts_nop 0\n\tglobal_load_lds_dwordx4 %1, off\n\ts_mov_b32 m0, %0":"=&s"(keep):"v"(gsrc),"s"(lds_dst):"memory");}
__device__ __forceinline__ float max3f(float a,float b,float c){float r;asm("v_max3_f32 %0, %1, %2, %3":"=v"(r):"v"(a),"v"(b),"v"(c));return r;}
__device__ __forceinline__ float max2f(float a,float b){float r;asm("v_max_f32_e32 %0, %1, %2":"=v"(r):"v"(a),"v"(b));return r;}
__device__ __forceinline__ float fadd_s(float a,float b){float r;asm("v_add_f32_e32 %0, %1, %2":"=v"(r):"v"(a),"v"(b));return r;}
__device__ __forceinline__ float fsub_s(float a,float b){float r;asm("v_sub_f32_e32 %0, %1, %2":"=v"(r):"v"(a),"v"(b));return r;}
typedef float f32x2_t __attribute__((ext_vector_type(2))); typedef __bf16 bf16x2_t __attribute__((ext_vector_type(2)));
__device__ __forceinline__ unsigned cvtpk_s(float lo,float hi){f32x2_t v={lo,hi};bf16x2_t b=__builtin_convertvector(v,bf16x2_t);return __builtin_bit_cast(unsigned,b);}
#define WAIT_BAR(N) asm volatile("s_waitcnt vmcnt(" #N ") lgkmcnt(0)\n\ts_barrier":::"memory")

__device__ __forceinline__ void qkt(f32x16&p0,f32x16&p1,const char*Kslot,const bf16x8*qr,const f32x16&negm,int r32,int hi){
  const char*kb=Kslot+hi*1024+r32*16;
  #pragma unroll
  for(int d0=0;d0<4;++d0){
    const bf16x8 b0=*reinterpret_cast<const bf16x8*>(kb+d0*2048);
    const bf16x8 b1=*reinterpret_cast<const bf16x8*>(kb+d0*2048+512);
    if(d0==0){p0=__builtin_amdgcn_mfma_f32_32x32x16_bf16(b0,qr[0],negm,0,0,0);p1=__builtin_amdgcn_mfma_f32_32x32x16_bf16(b1,qr[0],negm,0,0,0);}
    else{p0=__builtin_amdgcn_mfma_f32_32x32x16_bf16(b0,qr[d0],p0,0,0,0);p1=__builtin_amdgcn_mfma_f32_32x32x16_bf16(b1,qr[d0],p1,0,0,0);}}
}
typedef __attribute__((address_space(3))) const char* lds_cptr;
typedef short v4i16_t __attribute__((ext_vector_type(4)));
__device__ __forceinline__ void kload8(bf16x8*kf,lds_cptr kp){
  kf[0]=*(const __attribute__((address_space(3))) bf16x8*)(kp);      kf[1]=*(const __attribute__((address_space(3))) bf16x8*)(kp+512);
  kf[2]=*(const __attribute__((address_space(3))) bf16x8*)(kp+2048); kf[3]=*(const __attribute__((address_space(3))) bf16x8*)(kp+2560);
  kf[4]=*(const __attribute__((address_space(3))) bf16x8*)(kp+4096); kf[5]=*(const __attribute__((address_space(3))) bf16x8*)(kp+4608);
  kf[6]=*(const __attribute__((address_space(3))) bf16x8*)(kp+6144); kf[7]=*(const __attribute__((address_space(3))) bf16x8*)(kp+6656);
}
__device__ __forceinline__ void kload2(bf16x8*kf,lds_cptr kp,int j){ kf[2*j]=*(const __attribute__((address_space(3))) bf16x8*)(kp+j*2048); kf[2*j+1]=*(const __attribute__((address_space(3))) bf16x8*)(kp+j*2048+512); }
__device__ __forceinline__ s16x4 vtr(lds_cptr p){ return __builtin_bit_cast(s16x4,__builtin_amdgcn_ds_read_tr16_b64_v4i16((__attribute__((address_space(3))) v4i16_t*)p)); }
__device__ __forceinline__ float rowmax(const f32x16&p0,const f32x16&p1){
  float a=max3f(p0[0],p0[1],p1[0]),b=max3f(p0[2],p0[3],p1[1]);a=max3f(a,p1[2],p1[3]);
  #pragma unroll
  for(int r=4;r<16;r+=4){a=max3f(a,p0[r],p0[r+1]);b=max3f(b,p0[r+2],p0[r+3]);a=max3f(a,p1[r],p1[r+1]);b=max3f(b,p1[r+2],p1[r+3]);}
  const float m=max2f(a,b);
  auto rr=__builtin_amdgcn_permlane32_swap(__float_as_uint(m),__float_as_uint(m),false,false);
  return max2f(__uint_as_float(rr[0]),__uint_as_float(rr[1]));
}
__device__ __forceinline__ void pv(f32x16*o,int vb,bf16x8 pa0,bf16x8 pa1,bf16x8 pa2,bf16x8 pa3){
  #pragma unroll
  for(int d0=0;d0<2;++d0){s16x4 lo[4],hi[4];
    #pragma unroll
    for(int ks=0;ks<4;++ks){
      asm volatile("ds_read_b64_tr_b16 %0,%1 offset:%c2":"=&v"(lo[ks]):"v"(vb),"i"(d0*4096+ks*1024):"memory");
      asm volatile("ds_read_b64_tr_b16 %0,%1 offset:%c2":"=&v"(hi[ks]):"v"(vb),"i"(d0*4096+ks*1024+512):"memory");}
    asm volatile("s_waitcnt lgkmcnt(0)":::"memory");SBAR();
    #define PK(k) (bf16x8){lo[k][0],lo[k][1],lo[k][2],lo[k][3],hi[k][0],hi[k][1],hi[k][2],hi[k][3]}
    o[d0]=__builtin_amdgcn_mfma_f32_32x32x16_bf16(pa0,PK(0),o[d0],0,0,0);
    o[d0]=__builtin_amdgcn_mfma_f32_32x32x16_bf16(pa1,PK(1),o[d0],0,0,0);
    o[d0]=__builtin_amdgcn_mfma_f32_32x32x16_bf16(pa2,PK(2),o[d0],0,0,0);
    o[d0]=__builtin_amdgcn_mfma_f32_32x32x16_bf16(pa3,PK(3),o[d0],0,0,0);
    #undef PK
  }
}

#ifndef ATTN_STORE16
#define ATTN_STORE16(p,v) (*(u32x4*)(p)=(v))
#endif
template<int THRL> __device__ __forceinline__ void attn_unit(int b,int h,int qb,const bf16*Q,const bf16*__restrict__ K,const bf16*__restrict__ V,bf16*O,const float*__restrict__ FBrow,char*shm){
  const int tid=mk_tid(),lane=tid&63,r32=lane&31,hi=lane>>5; const int wid=__builtin_amdgcn_readfirstlane(tid>>6);
  const long rowbase=(long)b*SEQ; const int q0=qb*QB;
  const bf16*Qw=Q+(rowbase+q0+wid*QBLK)*DM+h*D;
  const bf16*Kh=K+rowbase*DM+h*D,*Vh=V+rowbase*DM+h*D;
  const lds_cptr shm3=(lds_cptr)shm;
  const unsigned lds0=(unsigned)(uintptr_t)shm;
  float*wsf=(float*)(shm+LDS_WS)+wid*64;
  const bf16*ksrc=Kh+(long)lane*DM+wid*8;
  const bf16*vsrc=Vh+(long)(16*(wid&3)+(lane>>2))*DM+(wid>>2)*32+(lane&3)*8;
  const unsigned kdst=lds0+LDS_K+wid*1024, vdst=lds0+LDS_V+wid*1024;
  #define DMA_K(t,slot) glds16(ksrc+(long)(t)*KVBLK*DM,(unsigned)__builtin_amdgcn_readfirstlane(kdst+(slot)))
  #define DMA_V(t,slot) glds16(vsrc+(long)(t)*KVBLK*DM,(unsigned)__builtin_amdgcn_readfirstlane(vdst+(slot)))
  const int vb0=(int)(lds0+LDS_V)+((lane>>4)&1)*32+(lane&3)*8+(4*hi+((lane&15)>>2))*64;
  const char*Kbase=shm+LDS_K; bf16x8 kf[8];
  const lds_cptr kp0=shm3+LDS_K+hi*1024+r32*16; const lds_cptr vp0=shm3+LDS_V+((lane>>4)&1)*32+(lane&3)*8+(4*hi+((lane&15)>>2))*64;
  const int NT=(q0+QB)/KVBLK;
  {
    typedef __attribute__((address_space(3))) float lds_f32; lds_f32* bl=(lds_f32*)(shm3+BIAS_OFF);
    const int nb=q0+QB; const float Fl=FBrow[nb-1];
    for(int i=tid;i<nb;i+=NW*64) bl[i]=(Fl-FBrow[i])*1.4426950408889634f;
    asm volatile("s_waitcnt vmcnt(0) lgkmcnt(0)\n\ts_barrier":::"memory"); }
  typedef float f32x4v __attribute__((ext_vector_type(4)));
  #define BIAS(P0,P1,t) do{ const __attribute__((address_space(3))) f32x4v* bp_=(const __attribute__((address_space(3))) f32x4v*)(shm3+BIAS_OFF)+(t)*16+hi; \
    _Pragma("unroll") for(int g_=0;g_<4;++g_){ const f32x4v f0_=bp_[2*g_]+nm, f1_=bp_[8+2*g_]+nm; \
      P0[4*g_]+=f0_[0];P0[4*g_+1]+=f0_[1];P0[4*g_+2]+=f0_[2];P0[4*g_+3]+=f0_[3]; P1[4*g_]+=f1_[0];P1[4*g_+1]+=f1_[1];P1[4*g_+2]+=f1_[2];P1[4*g_+3]+=f1_[3]; } }while(0)
  DMA_K(0,0);DMA_V(0,0);DMA_K(1,SLOTB);
  bf16x8 qr[4];
  #pragma unroll
  for(int d0=0;d0<4;++d0)qr[d0]=*reinterpret_cast<const bf16x8*>(&Qw[(long)r32*DM+d0*16+hi*8]);
  float mhat=0.f,l_reg=0.f;f32x16 o[2];o[0]=f32x16{};o[1]=f32x16{};const f32x16 negm=f32x16{}; float nm=0.f;
  const int qrel=wid*QBLK+r32;
  #define CMASK(P0,P1,t) do{int jb_=(t)-(NT-4); if(jb_>=0)cmask(P0,P1,jb_,qrel,hi);}while(0)
  bool resc=false;
  #define START(P0,P1) do{ const float rm=rowmax(P0,P1); resc=false; \
    { const float dl=rm; mhat=fadd_s(mhat,dl); \
      _Pragma("unroll") for(int r=0;r<16;++r){P0[r]=fsub_s(P0[r],dl);P1[r]=fsub_s(P1[r],dl);} \
      nm=-mhat; } \
    _Pragma("unroll") for(int r=0;r<16;++r)P0[r]=__builtin_amdgcn_exp2f(P0[r]); }while(0)
  #define RESC() do{ if(resc){ asm volatile("s_waitcnt lgkmcnt(0)":::"memory"); \
      _Pragma("unroll") for(int d_=0;d_<2;++d_) _Pragma("unroll") for(int r=0;r<16;++r)o[d_][r]*=wsf[crow(r,hi)]; } }while(0)
  f32x16 pA0,pA1,pB0,pB1;
  int sl_prev=0,sl_cur=0,sl_next=SLOTB;
  #define ROT() do{sl_prev=sl_cur;sl_cur=sl_next;sl_next=(sl_next==(NSLOT-1)*SLOTB)?0:sl_next+SLOTB;}while(0)
  DMA_K(2,2*SLOTB);
  WAIT_BAR(3);
  qkt(pA0,pA1,Kbase,qr,negm,r32,hi);asm volatile("s_nop 15\n\ts_nop 7":"+v"(pA0),"+v"(pA1));BIAS(pA0,pA1,0);CMASK(pA0,pA1,0);
  START(pA0,pA1);
  _Pragma("unroll") for(int r=0;r<16;++r)pA1[r]=__builtin_amdgcn_exp2f(pA1[r]);
  WAIT_BAR(0);
  DMA_K(3,0);DMA_V(1,SLOTB);
  ROT();
  kload8(kf,kp0+sl_cur);
  WAIT_BAR(2);
  s16x4 vlo[8],vhi[8]; u32x4 pw0,pw1,pw2,pw3;
  #define PKW(P,B) cvtpk_s(P[B],P[B+1])
  #define PAF(k) __builtin_bit_cast(bf16x8,pw##k)
  #define VFR(i) (bf16x8){vlo[i][0],vlo[i][1],vlo[i][2],vlo[i][3],vhi[i][0],vhi[i][1],vhi[i][2],vhi[i][3]}
  #define PIN(x) asm volatile("":"+v"(x))
  #define MX3(a,b,c) __builtin_fmaxf(__builtin_fmaxf((a),(b)),(c))
  #define GAPA(MF,A0,A1,A2,A3,W0,W1,PW) do{ MF; sacc+=A0; sacc+=A1; sacc+=A2; sacc+=A3; PIN(sacc); W0; W1; PIN(PW); SBAR(); }while(0)
  #define EX(v) __builtin_amdgcn_exp2f(v)
  #define GAPB(MF,X,B) do{ MF; X[B]=EX(X[B]); X[B+1]=EX(X[B+1]); X[B+2]=EX(X[B+2]); X[B+3]=EX(X[B+3]); PIN(X); SBAR(); }while(0)
  #define VRD(i) do{ vlo[i]=vtr(vp_+(((i)>>2)*4096+((i)&3)*1024)); vhi[i]=vtr(vp_+(((i)>>2)*4096+((i)&3)*1024+512)); }while(0)
  #define KRD(G,j) do{ if(G){ kload2(kf,kp0+sl_next,j); SBAR(); } }while(0)
  #define STEP(C0,C1,P0,P1,t,GK,GV,GL) do{ SBAR(); \
    const lds_cptr vp_=vp0+sl_prev; \
    VRD(0); SBAR(); float sacc=(P0[0]+P0[1]); \
    GAPA(C0=__builtin_amdgcn_mfma_f32_32x32x16_bf16(kf[0],qr[0],negm,0,0,0), P0[2],P0[3],P0[4],P0[5],     pw0[0]=PKW(P0,0), pw0[1]=PKW(P0,2), pw0); \
    VRD(4); SBAR(); GAPA(C1=__builtin_amdgcn_mfma_f32_32x32x16_bf16(kf[1],qr[0],negm,0,0,0), P0[6],P0[7],P0[8],P0[9],     pw0[2]=PKW(P0,4), pw0[3]=PKW(P0,6), pw0); \
    VRD(1); SBAR(); GAPA(C0=__builtin_amdgcn_mfma_f32_32x32x16_bf16(kf[2],qr[1],C0,0,0,0),   P0[10],P0[11],P0[12],P0[13], pw1[0]=PKW(P0,8), pw1[1]=PKW(P0,10), pw1); \
    VRD(5); SBAR(); GAPA(C1=__builtin_amdgcn_mfma_f32_32x32x16_bf16(kf[3],qr[1],C1,0,0,0),   P0[14],P0[15],P1[0],P1[1],   pw1[2]=PKW(P0,12),pw1[3]=PKW(P0,14), pw1); \
    VRD(2); SBAR(); GAPA(C0=__builtin_amdgcn_mfma_f32_32x32x16_bf16(kf[4],qr[2],C0,0,0,0),   P1[2],P1[3],P1[4],P1[5],     pw2[0]=PKW(P1,0), pw2[1]=PKW(P1,2), pw2); \
    VRD(6); SBAR(); GAPA(C1=__builtin_amdgcn_mfma_f32_32x32x16_bf16(kf[5],qr[2],C1,0,0,0),   P1[6],P1[7],P1[8],P1[9],     pw2[2]=PKW(P1,4), pw2[3]=PKW(P1,6), pw2); \
    VRD(3); SBAR(); GAPA(C0=__builtin_amdgcn_mfma_f32_32x32x16_bf16(kf[6],qr[3],C0,0,0,0),   P1[10],P1[11],P1[12],P1[13], pw3[0]=PKW(P1,8), pw3[1]=PKW(P1,10), pw3); \
    VRD(7); SBAR(); GAPA(C1=__builtin_amdgcn_mfma_f32_32x32x16_bf16(kf[7],qr[3],C1,0,0,0),   P1[14],P1[15],0.f,0.f,       pw3[2]=PKW(P1,12),pw3[3]=PKW(P1,14), pw3); \
    l_reg+=sacc; \
    if(GK){DMA_K((t)+3,sl_cur);} if(GV){DMA_V((t)+1,sl_next);} \
    BIAS(C0,C1,t); CMASK(C0,C1,t); \
    { float a=MX3(C0[0],C0[1],C1[0]),b=MX3(C0[2],C0[3],C1[1]); a=MX3(a,C1[2],C1[3]); \
      _Pragma("unroll") for(int r=4;r<16;r+=4){a=MX3(a,C0[r],C0[r+1]);b=MX3(b,C0[r+2],C0[r+3]);a=MX3(a,C1[r],C1[r+1]);b=MX3(b,C1[r+2],C1[r+3]);} \
      float rm=__builtin_fmaxf(a,b); { auto rr=__builtin_amdgcn_permlane32_swap(__float_as_uint(rm),__float_as_uint(rm),false,false); rm=__builtin_fmaxf(__uint_as_float(rr[0]),__uint_as_float(rr[1])); } \
      resc=false; \
      if(__builtin_expect(__any(rm>(float)THRL),0)){ const float dl=__builtin_fmaxf(rm,0.f); mhat+=dl; \
        _Pragma("unroll") for(int r=0;r<16;++r){C0[r]-=dl;C1[r]-=dl;} \
        nm=-mhat; \
        const float f=__builtin_amdgcn_exp2f(-dl); l_reg*=f; if(hi==0)wsf[r32]=f; resc=true; } } \
    SBAR(); \
    GAPB(o[0]=__builtin_amdgcn_mfma_f32_32x32x16_bf16(PAF(0),VFR(0),o[0],0,0,0), C0,0); \
    GAPB(o[1]=__builtin_amdgcn_mfma_f32_32x32x16_bf16(PAF(0),VFR(4),o[1],0,0,0), C0,4); \
    KRD(GL,0); GAPB(o[0]=__builtin_amdgcn_mfma_f32_32x32x16_bf16(PAF(1),VFR(1),o[0],0,0,0), C0,8); \
    KRD(GL,1); GAPB(o[1]=__builtin_amdgcn_mfma_f32_32x32x16_bf16(PAF(1),VFR(5),o[1],0,0,0), C0,12); \
    KRD(GL,2); GAPB(o[0]=__builtin_amdgcn_mfma_f32_32x32x16_bf16(PAF(2),VFR(2),o[0],0,0,0), C1,0); \
    KRD(GL,3); GAPB(o[1]=__builtin_amdgcn_mfma_f32_32x32x16_bf16(PAF(2),VFR(6),o[1],0,0,0), C1,4); \
    GAPB(o[0]=__builtin_amdgcn_mfma_f32_32x32x16_bf16(PAF(3),VFR(3),o[0],0,0,0), C1,8); \
    GAPB(o[1]=__builtin_amdgcn_mfma_f32_32x32x16_bf16(PAF(3),VFR(7),o[1],0,0,0), C1,12); \
    }while(0)
  int t=1;
  #undef CMASK
  #define CMASK(P0,P1,t) do{}while(0)
  for(;t+5<NT;t+=2){
    STEP(pB0,pB1,pA0,pA1,t,true,true,true);     WAIT_BAR(2); RESC(); ROT();
    STEP(pA0,pA1,pB0,pB1,t+1,true,true,true);   WAIT_BAR(2); RESC(); ROT();
  }
  #undef CMASK
  #define CMASK(P0,P1,t) do{int jb_=(t)-(NT-4); if(jb_>=0)cmask(P0,P1,jb_,qrel,hi);}while(0)
  #define ENDW(tt) do{ if((tt)+3<NT){WAIT_BAR(2);} else if((tt)+2<NT){WAIT_BAR(1);} else {WAIT_BAR(0);} }while(0)
  for(;t+1<NT;t+=2){
    STEP(pB0,pB1,pA0,pA1,t,(t+3<NT),(t+1<NT),(t+1<NT));       ENDW(t);   RESC(); ROT();
    STEP(pA0,pA1,pB0,pB1,t+1,(t+4<NT),(t+2<NT),(t+2<NT));     ENDW(t+1); RESC(); ROT();
  }
  STEP(pB0,pB1,pA0,pA1,NT-1,false,false,false); RESC();
  { float sacc=pB0[0]+pB0[1]; _Pragma("unroll") for(int r=2;r<16;++r)sacc+=pB0[r]; _Pragma("unroll") for(int r=0;r<16;++r)sacc+=pB1[r]; l_reg+=sacc;
    pw0=(u32x4){PKW(pB0,0),PKW(pB0,2),PKW(pB0,4),PKW(pB0,6)};pw1=(u32x4){PKW(pB0,8),PKW(pB0,10),PKW(pB0,12),PKW(pB0,14)};pw2=(u32x4){PKW(pB1,0),PKW(pB1,2),PKW(pB1,4),PKW(pB1,6)};pw3=(u32x4){PKW(pB1,8),PKW(pB1,10),PKW(pB1,12),PKW(pB1,14)};
    SBAR(); pv(o,vb0+sl_cur,PAF(0),PAF(1),PAF(2),PAF(3)); }
  #undef PKW
  #undef PAF
  #undef VFR
  #undef PIN
  #undef MX3
  #undef GAPA
  #undef GAPB
  #undef EX
  #undef VRD
  #undef KRD
  #undef STEP
  #undef ENDW
  {auto rr=__builtin_amdgcn_permlane32_swap(__float_as_uint(l_reg),__float_as_uint(l_reg),false,false);l_reg=__uint_as_float(rr[0])+__uint_as_float(rr[1]);}
  if(hi==0)wsf[32+r32]=l_reg;asm volatile("s_waitcnt lgkmcnt(0)":::"memory");
  float rli[16];
  #pragma unroll
  for(int r=0;r<16;++r)rli[r]=__builtin_amdgcn_rcpf(wsf[32+crow(r,hi)]);
  bf16*Ow=O+(rowbase+q0+wid*QBLK)*DM+h*D;
  { bf16*stg=(bf16*)(shm+LDS_OST)+wid*2048;
    #pragma unroll
    for(int r=0;r<16;++r){const int orow=crow(r,hi);
      #pragma unroll
      for(int d0=0;d0<2;++d0)stg[orow*64+d0*32+r32]=__float2bfloat16(o[d0][r]*rli[r]);}
    asm volatile("s_waitcnt lgkmcnt(0)":::"memory");
    #pragma unroll
    for(int i=0;i<4;++i){const int row=i*8+(lane>>3),ch=lane&7; const u32x4 v=*(const u32x4*)(stg+row*64+ch*8); ATTN_STORE16(Ow+(long)row*DM+ch*8,v);} }
  asm volatile("s_waitcnt lgkmcnt(0)\n\ts_barrier":::"memory");
  #undef BIAS
  #undef DMA_K
  #undef DMA_V
  #undef CMASK
  #undef START
  #undef RESC
  #undef ROT
}
constexpr int ATTN_LDS_BYTES=86016+32768;
struct AttnTensors { const bf16* Q; const bf16* K; const bf16* V; bf16* O; const float* FB; };
struct AttnUnit { int bh; int qb; };
struct StaticOrder {
  int vcu;
  __device__ __forceinline__ explicit StaticOrder(int grid,int block):vcu((block%8)*(grid/8)+block/8){}
  __device__ __forceinline__ bool next(int i,AttnUnit&u)const{ if(i>=4)return false; const int s=vcu&7; u.bh=vcu>>3; u.qb=(i==0)?s:(i==1)?15-s:(i==2)?16+s:31-s; return true; }
  __device__ __forceinline__ void a_ready(const AttnUnit&)const{}
  __device__ __forceinline__ void done(const AttnUnit&)const{}
};
template<class Sched,int THRL=8> __device__ __forceinline__ void attn_phase(char*lds,const AttnTensors&T,const Sched&S){
  AttnUnit u;
  for(int i=0;S.next(i,u);++i){ S.a_ready(u); attn_unit<THRL>(u.bh/NHEAD,u.bh%NHEAD,u.qb,T.Q,T.K,T.V,T.O,T.FB+(size_t)u.bh*SEQ,lds); S.done(u); }
}
#undef SBAR
#undef WAIT_BAR
}
namespace cg = cooperative_groups;
#define LAS __attribute__((address_space(3)))
#define LDS_WAIT() asm volatile("s_waitcnt lgkmcnt(0)" ::: "memory")
constexpr int MEGA_THREADS = 512, MEGA_LDS = 147456, NWV = 8;
constexpr size_t WT_IN = 0;
constexpr size_t WT_BR = WT_IN + (size_t)13312 * 1024 * 2;
constexpr size_t WT_OUT = WT_BR + (size_t)4096 * 1024 * 2;
constexpr size_t WT_UP = WT_OUT + (size_t)1024 * 4096 * 2;
constexpr size_t WT_DN = WT_UP + (size_t)5632 * 1024 * 2;
static_assert(WT_DN + (size_t)1024 * 2816 * 2 <= 72 * MiB, "weight copies");
constexpr size_t WS_WKVT = WS_GATES;
constexpr size_t WS_CB = WS_CTL + 4096;

typedef float f32x4 __attribute__((ext_vector_type(4)));
typedef unsigned u32x4 __attribute__((ext_vector_type(4)));
typedef short bf16x8_t __attribute__((ext_vector_type(8)));
typedef float f32x16_t __attribute__((ext_vector_type(16)));
__device__ __forceinline__ unsigned pk2(float lo, float hi) { return (unsigned)f2bf(lo) | ((unsigned)f2bf(hi) << 16); }
__device__ __forceinline__ float blo(unsigned u) { return __uint_as_float(u << 16); }
__device__ __forceinline__ float bhi(unsigned u) { return __uint_as_float(u & 0xffff0000u); }
__device__ __forceinline__ float fast_softplus(float x) { return fmaxf(x, 0.f) + __logf(1.f + __expf(-fabsf(x))); }
__device__ __forceinline__ float fast_sigmoid(float x) { return __builtin_amdgcn_rcpf(1.f + __expf(-x)); }
__device__ __forceinline__ float fast_tanh(float x) { const float e = __expf(-2.f * fabsf(x)); const float t = (1.f - e) * __builtin_amdgcn_rcpf(1.f + e); return x < 0.f ? -t : t; }
__device__ __forceinline__ float fast_gelu(float x) { const float u = 0.7978845608028654f * (x + 0.044715f * x * x * x); return 0.5f * x * (1.f + fast_tanh(u)); }

template <class Loc> struct LocOrder {
    pg8::StaticOrder so; Loc loc;
    __device__ __forceinline__ bool next(int i, pg8::Unit& u) const { return so.next(i, u); }
    __device__ __forceinline__ const char* aptr(const pg8::Unit& u) const { return loc.a(u); }
    __device__ __forceinline__ const char* bptr(const pg8::Unit& u) const { return loc.b(u); }
    __device__ __forceinline__ void a_ready(const pg8::Unit&) const {}
    __device__ __forceinline__ void done(const pg8::Unit&) const {}
};
struct LocStd { const char* A; const char* Bt; size_t astep, bstep;
    __device__ __forceinline__ const char* a(const pg8::Unit& u) const { return A + (size_t)u.pm * astep; }
    __device__ __forceinline__ const char* b(const pg8::Unit& u) const { return Bt + (size_t)u.pn * bstep; } };
struct LocBranch { const char* Y0; const char* Y1; const char* Y2; const char* Y3; const char* Bt;
    __device__ __forceinline__ const char* a(const pg8::Unit& u) const { const int i = u.pn >> 2; const char* y = i == 0 ? Y0 : i == 1 ? Y1 : i == 2 ? Y2 : Y3; return y + (size_t)u.pm * (256 * 1024 * 2); }
    __device__ __forceinline__ const char* b(const pg8::Unit& u) const { return Bt + (size_t)u.pn * (256 * 1024 * 2); } };
struct LocMemKV { const char* A; const char* Bt;
    __device__ __forceinline__ const char* a(const pg8::Unit& u) const { return A + (size_t)u.pm * (256 * 1024 * 2); }
    __device__ __forceinline__ const char* b(const pg8::Unit& u) const { return Bt + ((size_t)(u.pm >> 1) * 2048 + (size_t)u.pn * 256) * 2048; } };
struct LocMemS { const char* MQ; const char* MK;
    __device__ __forceinline__ const char* a(const pg8::Unit& u) const { return MQ + (size_t)u.pm * (256 * 2048) + u.pn * 512; }
    __device__ __forceinline__ const char* b(const pg8::Unit& u) const { return MK + (size_t)(u.pm >> 5) * (256 * 2048) + u.pn * 512; } };
struct LocMemPV { const char* E; const char* MVT;
    __device__ __forceinline__ const char* a(const pg8::Unit& u) const { return E + (size_t)u.pm * (256 * 2048) + u.pn * 512; }
    __device__ __forceinline__ const char* b(const pg8::Unit& u) const { return MVT + ((size_t)(u.pm >> 5) * 4 + u.pn) * (256 * 256 * 2); } };

typedef f32x4 AccT[2][2][4][2];
struct EpiProj { static constexpr bool PERM = true, AFTER_DRAIN = false; bf16_t* proj; bf16_t* gates; float* mqss;
    __device__ __forceinline__ void operator()(const AccT& acc, const pg8::Unit& u, int wr, int wc, int fr, int fq) const {
        int colt = u.pn * 256; const int grp = colt >> 10; bf16_t* base; int ldc;
        if (grp < 9) { base = proj + (size_t)grp * T * DM; ldc = DM; colt &= 1023; } else { base = gates; ldc = 4096; colt -= 9216; }
        const int row0 = u.pm * 256 + wr * 64 + fr, col0 = colt + wc * 32 + 8 * fq;
#pragma unroll
        for (int ai = 0; ai < 2; ++ai)
#pragma unroll
            for (int m = 0; m < 4; ++m) { const int row = row0 + ai * 128 + m * 16; bf16_t* rowp = base + (size_t)row * ldc + col0; float ss = 0.f;
#pragma unroll
                for (int bj = 0; bj < 2; ++bj) { const f32x4 v0 = acc[ai][bj][m][0], v1 = acc[ai][bj][m][1]; u32x4 w; w.x = pk2(v0[0], v0[1]); w.y = pk2(v0[2], v0[3]); w.z = pk2(v1[0], v1[1]); w.w = pk2(v1[2], v1[3]);
                    *(u32x4*)(rowp + bj * 128) = w;
                    if (grp == 8) { ss += blo(w.x) * blo(w.x) + bhi(w.x) * bhi(w.x) + blo(w.y) * blo(w.y) + bhi(w.y) * bhi(w.y) + blo(w.z) * blo(w.z) + bhi(w.z) * bhi(w.z) + blo(w.w) * blo(w.w) + bhi(w.w) * bhi(w.w); } }
                if (grp == 8) { ss += __shfl_xor(ss, 16); ss += __shfl_xor(ss, 32); if (fq == 0) mqss[(size_t)row * 16 + (colt >> 8) * 4 + wc] = ss; } }
    } };
struct EpiBf16P { static constexpr bool PERM = true, AFTER_DRAIN = false; bf16_t* O; int ldc; int pad;
    __device__ __forceinline__ void operator()(const AccT& acc, const pg8::Unit& u, int wr, int wc, int fr, int fq) const {
        const int row0 = u.pm * 256 + wr * 64 + fr, col0 = u.pn * 256 + wc * 32 + 8 * fq;
#pragma unroll
        for (int ai = 0; ai < 2; ++ai)
#pragma unroll
            for (int m = 0; m < 4; ++m) { bf16_t* rowp = O + (size_t)(row0 + ai * 128 + m * 16) * ldc + col0;
#pragma unroll
                for (int bj = 0; bj < 2; ++bj) { const f32x4 v0 = acc[ai][bj][m][0], v1 = acc[ai][bj][m][1]; u32x4 w; w.x = pk2(v0[0], v0[1]); w.y = pk2(v0[2], v0[3]); w.z = pk2(v1[0], v1[1]); w.w = pk2(v1[2], v1[3]);
                    *(u32x4*)(rowp + bj * 128) = w; } }
    } };
struct EpiF32 { static constexpr bool PERM = false, AFTER_DRAIN = false; float* O; int ldc; int pad;
    __device__ __forceinline__ void operator()(const AccT& acc, const pg8::Unit& u, int wr, int wc, int fr, int fq) const {
        const int row0 = u.pm * 256 + wr * 64 + fr, col0 = u.pn * 256 + wc * 32 + 4 * fq;
#pragma unroll
        for (int ai = 0; ai < 2; ++ai)
#pragma unroll
            for (int m = 0; m < 4; ++m) { float* rowp = O + (size_t)(row0 + ai * 128 + m * 16) * ldc + col0;
#pragma unroll
                for (int bj = 0; bj < 2; ++bj)
#pragma unroll
                    for (int n = 0; n < 2; ++n) *(f32x4*)(rowp + bj * 128 + n * 16) = acc[ai][bj][m][n]; }
    } };
struct EpiResid { static constexpr bool PERM = false, AFTER_DRAIN = false; const float* base; float* out;
    __device__ __forceinline__ void operator()(const AccT& acc, const pg8::Unit& u, int wr, int wc, int fr, int fq) const {
        const int row0 = u.pm * 256 + wr * 64 + fr, col0 = u.pn * 256 + wc * 32 + 4 * fq;
#pragma unroll
        for (int ai = 0; ai < 2; ++ai)
#pragma unroll
            for (int m = 0; m < 4; ++m) { const size_t off = (size_t)(row0 + ai * 128 + m * 16) * DM + col0;
#pragma unroll
                for (int bj = 0; bj < 2; ++bj)
#pragma unroll
                    for (int n = 0; n < 2; ++n) { const f32x4 b = *(const f32x4*)(base + off + bj * 128 + n * 16); *(f32x4*)(out + off + bj * 128 + n * 16) = b + acc[ai][bj][m][n]; } }
    } };
struct EpiBranch { static constexpr bool PERM = true, AFTER_DRAIN = false; bf16_t* G; const float* bg;
    __device__ __forceinline__ void operator()(const AccT& acc, const pg8::Unit& u, int wr, int wc, int fr, int fq) const {
        const int row0 = u.pm * 256 + wr * 64 + fr, col0 = u.pn * 256 + wc * 32 + 8 * fq;
#pragma unroll
        for (int ai = 0; ai < 2; ++ai)
#pragma unroll
            for (int m = 0; m < 4; ++m) { bf16_t* rowp = G + (size_t)(row0 + ai * 128 + m * 16) * 4096 + col0;
#pragma unroll
                for (int bj = 0; bj < 2; ++bj) { const u32x4 gw = *(const u32x4*)(rowp + bj * 128); const f32x4 b0 = *(const f32x4*)(bg + col0 + bj * 128), b1 = *(const f32x4*)(bg + col0 + bj * 128 + 4);
                    const f32x4 v0 = acc[ai][bj][m][0], v1 = acc[ai][bj][m][1]; u32x4 w;
                    w.x = pk2(fast_sigmoid(blo(gw.x) + b0[0]) * v0[0], fast_sigmoid(bhi(gw.x) + b0[1]) * v0[1]); w.y = pk2(fast_sigmoid(blo(gw.y) + b0[2]) * v0[2], fast_sigmoid(bhi(gw.y) + b0[3]) * v0[3]);
                    w.z = pk2(fast_sigmoid(blo(gw.z) + b1[0]) * v1[0], fast_sigmoid(bhi(gw.z) + b1[1]) * v1[1]); w.w = pk2(fast_sigmoid(blo(gw.w) + b1[2]) * v1[2], fast_sigmoid(bhi(gw.w) + b1[3]) * v1[3]);
                    *(u32x4*)(rowp + bj * 128) = w; } }
    } };
struct EpiSexp { static constexpr bool PERM = true, AFTER_DRAIN = false; bf16_t* E; const float* mqss; float* esum; const float* cb;
    __device__ __forceinline__ void operator()(const AccT& acc, const pg8::Unit& u, int wr, int wc, int fr, int fq) const {
        const int row0 = u.pm * 256 + wr * 64 + fr, col0 = u.pn * 256 + wc * 32 + 8 * fq; const float shift = cb[0];
#pragma unroll
        for (int ai = 0; ai < 2; ++ai)
#pragma unroll
            for (int m = 0; m < 4; ++m) { const int row = row0 + ai * 128 + m * 16; const f32x4 p = *(const f32x4*)(mqss + (size_t)row * 16 + u.pn * 4);
                const float sc = rsqrtf(((p[0] + p[1]) + (p[2] + p[3])) * (1.f / 256.f) + EPS) * (1.f / 16.f); bf16_t* rowp = E + (size_t)row * DM + col0; float sum = 0.f;
#pragma unroll
                for (int bj = 0; bj < 2; ++bj) { const f32x4 v0 = acc[ai][bj][m][0], v1 = acc[ai][bj][m][1]; u32x4 w;
                    w.x = pk2(__expf(v0[0] * sc - shift), __expf(v0[1] * sc - shift)); w.y = pk2(__expf(v0[2] * sc - shift), __expf(v0[3] * sc - shift));
                    w.z = pk2(__expf(v1[0] * sc - shift), __expf(v1[1] * sc - shift)); w.w = pk2(__expf(v1[2] * sc - shift), __expf(v1[3] * sc - shift));
                    *(u32x4*)(rowp + bj * 128) = w;
                    sum += (blo(w.x) + bhi(w.x)) + (blo(w.y) + bhi(w.y)) + (blo(w.z) + bhi(w.z)) + (blo(w.w) + bhi(w.w)); }
                sum += __shfl_xor(sum, 16); sum += __shfl_xor(sum, 32); if (fq == 0) esum[(size_t)row * 16 + u.pn * 4 + wc] = sum;
                asm volatile("" ::: "memory"); }
    } };
struct EpiMemPV { static constexpr bool PERM = true, AFTER_DRAIN = false; bf16_t* Y; const float* esum;
    __device__ __forceinline__ void operator()(const AccT& acc, const pg8::Unit& u, int wr, int wc, int fr, int fq) const {
        const int row0 = u.pm * 256 + wr * 64 + fr, col0 = u.pn * 256 + wc * 32 + 8 * fq;
#pragma unroll
        for (int ai = 0; ai < 2; ++ai)
#pragma unroll
            for (int m = 0; m < 4; ++m) { const int row = row0 + ai * 128 + m * 16; const f32x4 p = *(const f32x4*)(esum + (size_t)row * 16 + u.pn * 4);
                const float il = 1.f / ((p[0] + p[1]) + (p[2] + p[3])); bf16_t* rowp = Y + (size_t)row * DM + col0;
#pragma unroll
                for (int bj = 0; bj < 2; ++bj) { const f32x4 v0 = acc[ai][bj][m][0] * il, v1 = acc[ai][bj][m][1] * il; u32x4 w; w.x = pk2(v0[0], v0[1]); w.y = pk2(v0[2], v0[3]); w.z = pk2(v1[0], v1[1]); w.w = pk2(v1[2], v1[3]);
                    *(u32x4*)(rowp + bj * 128) = w; }
                asm volatile("" ::: "memory"); }
    } };

__device__ __forceinline__ void tr_item(const float* __restrict__ W, int ldw, bf16_t* __restrict__ WT, int ldk, int nblk, LAS float* scr, int item, int lane, int ncopies, int cstride) {
    const int kb = item / nblk, nb = item % nblk, k0 = 64 * kb, n0 = 32 * nb;
#pragma unroll 8
    for (int i = 0; i < 32; ++i) { const int kk = 2 * i + (lane >> 5); scr[kk * 33 + (lane & 31)] = W[(size_t)(k0 + kk) * ldw + n0 + (lane & 31)]; }
    LDS_WAIT(); asm volatile("" ::: "memory");
    const int c = lane & 7;
#pragma unroll
    for (int j = 0; j < 4; ++j) { const int n = (lane >> 3) + 8 * j; const LAS float* s = scr + (8 * c) * 33 + n;
        u32x4 o; o.x = pk2(s[0 * 33], s[1 * 33]); o.y = pk2(s[2 * 33], s[3 * 33]); o.z = pk2(s[4 * 33], s[5 * 33]); o.w = pk2(s[6 * 33], s[7 * 33]);
        for (int cp = 0; cp < ncopies; ++cp) *(u32x4*)(WT + (size_t)(n0 + n) * ldk + k0 + 8 * c + cp * cstride) = o; }
    LDS_WAIT(); asm volatile("" ::: "memory");
}
__device__ __forceinline__ void norm_row(const float* __restrict__ xrow, const float* __restrict__ g, bf16_t* __restrict__ hrow, const LAS float* WfT, bool do_logf, const float* __restrict__ bfg, float* __restrict__ LOGF, int row, int lane) {
    const f32x4* xr = (const f32x4*)xrow; const f32x4* gr = (const f32x4*)g;
    f32x4 v[4]; float ss = 0.f;
#pragma unroll
    for (int j = 0; j < 4; ++j) { v[j] = xr[lane + 64 * j]; ss += (v[j][0] * v[j][0] + v[j][1] * v[j][1]) + (v[j][2] * v[j][2] + v[j][3] * v[j][3]); }
    ss = wave_sum(ss);
    const float rstd = rsqrtf(ss * (1.f / DM) + EPS);
#pragma unroll
    for (int j = 0; j < 4; ++j) { v[j] = v[j] * rstd * gr[lane + 64 * j];
        uint2 o; o.x = pk2(v[j][0], v[j][1]); o.y = pk2(v[j][2], v[j][3]); ((uint2*)hrow)[lane + 64 * j] = o; }
    if (do_logf) {
        float mine = 0.f;
#pragma unroll 4
        for (int h = 0; h < 16; ++h) { float p = 0.f;
#pragma unroll
            for (int j = 0; j < 4; ++j) { const f32x4 w = *(const LAS f32x4*)(WfT + h * 1024 + (lane + 64 * j) * 4); p += (v[j][0] * w[0] + v[j][1] * w[1]) + (v[j][2] * w[2] + v[j][3] * w[3]); }
            p = wave_sum(p); if (lane == h) mine = p; }
        if (lane < 16) { const int b = row / SEQ, t = row % SEQ; LOGF[((size_t)b * 16 + lane) * SEQ + t] = logsigmoidf(mine + bfg[lane]); }
    }
}
__device__ __forceinline__ void headnorm64_row(bf16_t* row, const float* __restrict__ g, float scale, int lane) {
    u32x4* p = (u32x4*)row + lane * 2; u32x4 a = p[0], b = p[1];
    float v[16] = {blo(a.x), bhi(a.x), blo(a.y), bhi(a.y), blo(a.z), bhi(a.z), blo(a.w), bhi(a.w), blo(b.x), bhi(b.x), blo(b.y), bhi(b.y), blo(b.z), bhi(b.z), blo(b.w), bhi(b.w)};
    float ss = 0.f;
#pragma unroll
    for (int i = 0; i < 16; ++i) ss += v[i] * v[i];
    ss += __shfl_xor(ss, 1); ss += __shfl_xor(ss, 2);
    const float rstd = rsqrtf(ss * (1.f / 64.f) + EPS) * scale; const f32x4* gp = (const f32x4*)(g + (lane & 3) * 16);
#pragma unroll
    for (int i = 0; i < 4; ++i) { const f32x4 gg = gp[i]; v[4 * i] *= rstd * gg[0]; v[4 * i + 1] *= rstd * gg[1]; v[4 * i + 2] *= rstd * gg[2]; v[4 * i + 3] *= rstd * gg[3]; }
    a.x = pk2(v[0], v[1]); a.y = pk2(v[2], v[3]); a.z = pk2(v[4], v[5]); a.w = pk2(v[6], v[7]); b.x = pk2(v[8], v[9]); b.y = pk2(v[10], v[11]); b.z = pk2(v[12], v[13]); b.w = pk2(v[14], v[15]);
    p[0] = a; p[1] = b;
}
__device__ __forceinline__ void cumsum_block(const float* __restrict__ src, float* __restrict__ dst, LAS float* part, int tid) {
    const int lane = tid & 63, wave = tid >> 6; const f32x4* s4 = (const f32x4*)(src + tid * 16); float v[16]; float s = 0.f;
#pragma unroll
    for (int i = 0; i < 4; ++i) { const f32x4 x = s4[i]; s += x[0]; v[4 * i] = s; s += x[1]; v[4 * i + 1] = s; s += x[2]; v[4 * i + 2] = s; s += x[3]; v[4 * i + 3] = s; }
    float incl = s;
#pragma unroll
    for (int o = 1; o < 64; o <<= 1) { const float t_ = __shfl_up(incl, o); if (lane >= o) incl += t_; }
    __syncthreads();
    if (lane == 63) part[wave] = incl;
    __syncthreads();
    float off = incl - s;
    for (int w = 0; w < wave; ++w) off += part[w];
    f32x4* d4 = (f32x4*)(dst + tid * 16);
#pragma unroll
    for (int i = 0; i < 4; ++i) d4[i] = (f32x4){off + v[4 * i], off + v[4 * i + 1], off + v[4 * i + 2], off + v[4 * i + 3]};
}

template <bool FINAL> __device__ __forceinline__ void lru_item(int b, int c, int n, const bf16_t* __restrict__ LX, const bf16_t* __restrict__ LG, bf16_t* __restrict__ YL,
        const float* __restrict__ cw, const float* __restrict__ cbias, const float* __restrict__ wa, const float* __restrict__ ba, const float* __restrict__ wx, const float* __restrict__ bx,
        const float* __restrict__ lam, float* APROD, float* HEND, LAS unsigned char* lds, int tid) {
    const int e = tid & 63, tg = tid >> 6, ch = n * 64 + e;
    LAS float* xcT = (LAS float*)lds;
    LAS float* segP = xcT + 64 * 68;
    LAS float* segH = segP + 512, *carP = segH + 512, *carH = carP + 512;
    const int t0 = c * 64 + tg * 8; const size_t row0 = (size_t)b * SEQ + t0;
    float xw[11];
#pragma unroll
    for (int j = 0; j < 11; ++j) { const int t = t0 + j - 3; xw[j] = t >= 0 ? bf2f(LX[((size_t)b * SEQ + t) * DM + ch]) : 0.f; }
    const float w0 = cw[ch], w1 = cw[DM + ch], w2 = cw[2 * DM + ch], w3 = cw[3 * DM + ch], bc = cbias[ch];
    float xc[8];
#pragma unroll
    for (int j = 0; j < 8; ++j) xc[j] = bc + w3 * xw[j + 3] + w2 * xw[j + 2] + w1 * xw[j + 1] + w0 * xw[j];
    *(LAS f32x4*)(xcT + e * 68 + tg * 8) = (f32x4){xc[0], xc[1], xc[2], xc[3]};
    *(LAS f32x4*)(xcT + e * 68 + tg * 8 + 4) = (f32x4){xc[4], xc[5], xc[6], xc[7]};
    float cp = 1.f, chh = 0.f;
    if (FINAL) { const int per = (c + 7) >> 3; const int lo = tg * per; int hi = lo + per; if (hi > c) hi = c;
        for (int cc = lo; cc < hi; ++cc) { const size_t si = ((size_t)b * 128 + cc) * DM + ch; const float A = APROD[si], Hc = HEND[si]; chh = A * chh + Hc; cp *= A; }
        carP[tg * 64 + e] = cp; carH[tg * 64 + e] = chh; }
    __syncthreads();
    const float bA = ba[ch], bX = bx[ch];
    float ra[8], ri[8];
#pragma unroll
    for (int j = 0; j < 8; ++j) { ra[j] = bA; ri[j] = bX; }
    const float* wap = wa + (size_t)n * 4096 + e; const float* wxp = wx + (size_t)n * 4096 + e;
#pragma unroll 4
    for (int d = 0; d < 64; ++d) { const float wad = wap[d * 64], wxd = wxp[d * 64];
        const f32x4 x0 = *(const LAS f32x4*)(xcT + d * 68 + tg * 8), x1 = *(const LAS f32x4*)(xcT + d * 68 + tg * 8 + 4);
        ra[0] += x0[0] * wad; ra[1] += x0[1] * wad; ra[2] += x0[2] * wad; ra[3] += x0[3] * wad; ra[4] += x1[0] * wad; ra[5] += x1[1] * wad; ra[6] += x1[2] * wad; ra[7] += x1[3] * wad;
        ri[0] += x0[0] * wxd; ri[1] += x0[1] * wxd; ri[2] += x0[2] * wxd; ri[3] += x0[3] * wxd; ri[4] += x1[0] * wxd; ri[5] += x1[1] * wxd; ri[6] += x1[2] * wxd; ri[7] += x1[3] * wxd; }
    const float spl = softplusf(-lam[ch]);
    float av[8], uv[8]; float P = 1.f, Hh = 0.f;
#pragma unroll
    for (int j = 0; j < 8; ++j) { const float rr = fast_sigmoid(ra[j]), ii = fast_sigmoid(ri[j]); const float la = -8.f * rr * spl; av[j] = __expf(la); uv[j] = sqrtf(-expm1f(2.f * la)) * (ii * xc[j]);
        Hh = av[j] * Hh + uv[j]; P *= av[j]; }
    segP[tg * 64 + e] = P; segH[tg * 64 + e] = Hh;
    __syncthreads();
    if (FINAL) {
        float h = 0.f;
#pragma unroll
        for (int s = 0; s < 8; ++s) h = carP[s * 64 + e] * h + carH[s * 64 + e];
        for (int t2 = 0; t2 < tg; ++t2) h = segP[t2 * 64 + e] * h + segH[t2 * 64 + e];
#pragma unroll
        for (int j = 0; j < 8; ++j) { h = av[j] * h + uv[j]; const size_t r = (row0 + j) * DM + ch; YL[r] = f2bf(h * fast_gelu(bf2f(LG[r]))); }
    } else if (tg == 7) {
        float h = 0.f, p = 1.f;
#pragma unroll
        for (int s = 0; s < 8; ++s) { h = segP[s * 64 + e] * h + segH[s * 64 + e]; p *= segP[s * 64 + e]; }
        const size_t si = ((size_t)b * 128 + c) * DM + ch; APROD[si] = p; HEND[si] = h;
    }
    __syncthreads();
}

__device__ __forceinline__ void sb_wave(int b, int h, int qw0, const bf16_t* Q, const bf16_t* __restrict__ K, const bf16_t* __restrict__ V, bf16_t* O, LAS unsigned char* vl, int lane) {
    const int r32 = lane & 31, hi = lane >> 5; const size_t rowbase = (size_t)b * SEQ;
    const bf16_t* Qw = Q + (rowbase + qw0) * DM + h * 64;
    bf16x8_t qr[4];
#pragma unroll
    for (int d0 = 0; d0 < 4; ++d0) qr[d0] = *(const bf16x8_t*)(Qw + (size_t)r32 * DM + d0 * 16 + hi * 8);
    const bf16_t* Kh = K + rowbase * DM + h * 64; const bf16_t* Vh = V + rowbase * DM + h * 64;
    f32x16_t o0 = {}, o1 = {}; float R = 0.f; const int qabs = qw0 + r32;
    int kt = qw0 >> 5;
    bf16x8_t kf[4]; u32x4 vr[4];
#define SB_LOAD(KF, VR, kt_) do { _Pragma("unroll") for (int d0 = 0; d0 < 4; ++d0) KF[d0] = *(const bf16x8_t*)(Kh + (size_t)((kt_) * 32 + r32) * DM + d0 * 16 + hi * 8); \
        _Pragma("unroll") for (int it = 0; it < 4; ++it) { const int chunk = lane + 64 * it; VR[it] = *(const u32x4*)(Vh + (size_t)((kt_) * 32 + (chunk >> 3)) * DM + (chunk & 7) * 8); } } while (0)
    SB_LOAD(kf, vr, kt);
    const unsigned vbase = (unsigned)(size_t)vl;
    for (;;) {
        bf16x8_t kn[4]; u32x4 vn[4]; const bool more = kt > 0;
        if (more) SB_LOAD(kn, vn, kt - 1); else {
#pragma unroll
            for (int i = 0; i < 4; ++i) { kn[i] = kf[i]; vn[i] = vr[i]; } }
        f32x16_t st = {};
#pragma unroll
        for (int d0 = 0; d0 < 4; ++d0) st = __builtin_amdgcn_mfma_f32_32x32x16_bf16(kf[d0], qr[d0], st, 0, 0, 0);
#pragma unroll
        for (int it = 0; it < 4; ++it) { const int chunk = lane + 64 * it, row = chunk >> 3, c16 = chunk & 7; *(LAS u32x4*)(vl + (c16 >> 2) * 2048 + row * 64 + (c16 & 3) * 16) = vr[it]; }
        float l1[16], lb[16]; bool val[16];
#pragma unroll
        for (int r = 0; r < 16; ++r) { const int kv = kt * 32 + (r & 3) + 8 * (r >> 2) + 4 * hi; val[r] = kv < qabs; const float z = st[r] * 0.125f; const float sp = fast_softplus(z); l1[r] = val[r] ? -sp : 0.f; lb[r] = z - sp; }
        float w[16]; float tail = 0.f;
#pragma unroll
        for (int g = 3; g >= 0; --g) { const float qs = (l1[4 * g] + l1[4 * g + 1]) + (l1[4 * g + 2] + l1[4 * g + 3]); const float pq = __shfl_xor(qs, 32);
            const float after = tail + (hi == 0 ? pq : 0.f) + R; tail += qs + pq;
            const float e2 = l1[4 * g + 3], e1 = e2 + l1[4 * g + 2], e0 = e1 + l1[4 * g + 1];
            w[4 * g + 3] = val[4 * g + 3] ? __expf(lb[4 * g + 3] + after) : 0.f; w[4 * g + 2] = val[4 * g + 2] ? __expf(lb[4 * g + 2] + after + e2) : 0.f;
            w[4 * g + 1] = val[4 * g + 1] ? __expf(lb[4 * g + 1] + after + e1) : 0.f; w[4 * g] = val[4 * g] ? __expf(lb[4 * g] + after + e0) : 0.f; }
        R += tail;
        u32x4 p0, p1; p0.x = attn_body::cvtpk_s(w[0], w[1]); p0.y = attn_body::cvtpk_s(w[2], w[3]); p0.z = attn_body::cvtpk_s(w[4], w[5]); p0.w = attn_body::cvtpk_s(w[6], w[7]);
        p1.x = attn_body::cvtpk_s(w[8], w[9]); p1.y = attn_body::cvtpk_s(w[10], w[11]); p1.z = attn_body::cvtpk_s(w[12], w[13]); p1.w = attn_body::cvtpk_s(w[14], w[15]);
        const bf16x8_t pa0 = __builtin_bit_cast(bf16x8_t, p0), pa1 = __builtin_bit_cast(bf16x8_t, p1);
        const attn_body::lds_cptr vp = (attn_body::lds_cptr)vl + (4 * hi + ((lane & 15) >> 2)) * 64 + ((lane >> 4) & 1) * 32 + (lane & 3) * 8;
#define SB_VF(d0, s) ({ const attn_body::s16x4 lo_ = attn_body::vtr(vp + (d0) * 2048 + (s) * 1024), hi_ = attn_body::vtr(vp + (d0) * 2048 + (s) * 1024 + 512); \
            (bf16x8_t){lo_[0], lo_[1], lo_[2], lo_[3], hi_[0], hi_[1], hi_[2], hi_[3]}; })
        o0 = __builtin_amdgcn_mfma_f32_32x32x16_bf16(pa0, SB_VF(0, 0), o0, 0, 0, 0);
        o1 = __builtin_amdgcn_mfma_f32_32x32x16_bf16(pa0, SB_VF(1, 0), o1, 0, 0, 0);
        o0 = __builtin_amdgcn_mfma_f32_32x32x16_bf16(pa1, SB_VF(0, 1), o0, 0, 0, 0);
        o1 = __builtin_amdgcn_mfma_f32_32x32x16_bf16(pa1, SB_VF(1, 1), o1, 0, 0, 0);
        if (!more) break;
        if (__all(R < SB_THR)) break;
#pragma unroll
        for (int i = 0; i < 4; ++i) { kf[i] = kn[i]; vr[i] = vn[i]; }
        --kt;
    }
#undef SB_LOAD
#undef SB_VF
    (void)vbase;
    bf16_t* Ow = O + (rowbase + qw0) * DM + h * 64;
#pragma unroll
    for (int r = 0; r < 16; ++r) { const int q = (r & 3) + 8 * (r >> 2) + 4 * hi; Ow[(size_t)q * DM + r32] = f2bf(o0[r]); Ow[(size_t)q * DM + 32 + r32] = f2bf(o1[r]); }
}

#ifndef DBG_NOLOGF
#define DBG_NOLOGF 0
#endif
#ifndef EN_FOX
#define EN_FOX 1
#endif
#ifndef EN_SB
#define EN_SB 1
#endif
#ifndef EN_LRU
#define EN_LRU 1
#endif
#ifndef EN_GEMM
#define EN_GEMM 1
#endif
#ifndef EN_THIN
#define EN_THIN 1
#endif
enum { SUB_CONV = 1, SUB_NORM = 2, SUB_HEADNORM = 4, SUB_CUMSUM = 8, SUB_LRU = 16, SUB_SB = 32, SUB_MEM = 64, SUB_FOX = 128, SUB_ALL = 255 };
constexpr int N_PRO = 3, N_PER_LAYER = 10, N_PHASES = N_PRO + DEPTH * N_PER_LAYER;
struct MArgs { Ptrs P; int ph_lo, ph_hi, sub, pad; };

__global__ void __launch_bounds__(MEGA_THREADS, 2) mega(MArgs a) {
    extern __shared__ __attribute__((aligned(16))) unsigned char lds_raw[];
    LAS unsigned char* lds = (LAS unsigned char*)lds_raw;
    cg::grid_group grid = cg::this_grid();
    for (int ph = a.ph_lo; ph < a.ph_hi; ++ph) {
    int tid = threadIdx.x; asm volatile("" : "+v"(tid));
    const int lane = tid & 63, wave = __builtin_amdgcn_readfirstlane(tid >> 6);
    int zs = 0; asm volatile("" : "+s"(zs));
    const int G = gridDim.x + zs, bx = blockIdx.x + zs, sub = a.sub + zs, vcu = (G % 8 == 0) ? (bx % 8) * (G / 8) + bx / 8 : bx;
    const int gw = vcu * NWV + wave, NGW = G * NWV;
    unsigned char* ws = a.P.ws + zs; const float* const* in = a.P.in + zs; float* out = a.P.out + zs;
    bf16_t* H = (bf16_t*)(ws + WS_H); bf16_t* PROJ = (bf16_t*)(ws + WS_PROJ); bf16_t* GATES = (bf16_t*)(ws + WS_GATES); bf16_t* Eb = (bf16_t*)(ws + WS_E);
    bf16_t *FQ = PROJ, *FK = PROJ + (size_t)T * DM, *FV = PROJ + 2 * (size_t)T * DM, *LX = PROJ + 3 * (size_t)T * DM, *LG = PROJ + 4 * (size_t)T * DM, *SQ = PROJ + 5 * (size_t)T * DM,
           *SK = PROJ + 6 * (size_t)T * DM, *SV = PROJ + 7 * (size_t)T * DM, *MQ = PROJ + 8 * (size_t)T * DM;
    bf16_t* YL = (bf16_t*)(ws + WS_YL);
    float *LOGF = (float*)(ws + WS_LOGF), *FB = (float*)(ws + WS_FB), *MQSS = (float*)(ws + WS_MQSS), *ESUM = (float*)(ws + WS_ESUM), *CB = (float*)(ws + WS_CB);
    bf16_t* MEMN = (bf16_t*)(ws + WS_MEMN); float* MEMRAW = (float*)(ws + WS_MEMRAW); bf16_t *MK = (bf16_t*)(ws + WS_MK), *MVT = (bf16_t*)(ws + WS_MVT);
    float *APROD = (float*)(ws + WS_LRU), *HEND = APROD + (size_t)BATCH * 128 * DM;
    bf16_t* WKVT = (bf16_t*)(ws + WS_WKVT);
    bf16_t *WIN_T = (bf16_t*)(ws + WS_WT + WT_IN), *WBR_T = (bf16_t*)(ws + WS_WT + WT_BR), *WOUT_T = (bf16_t*)(ws + WS_WT + WT_OUT), *WUP_T = (bf16_t*)(ws + WS_WT + WT_UP), *WDN_T = (bf16_t*)(ws + WS_WT + WT_DN);
    bf16_t *GV = (bf16_t*)(ws + WS_GV), *ACT = (bf16_t*)(ws + WS_ACT);

        if (ph < N_PRO) {
            if (ph == 0) {
                LAS float* scr = (LAS float*)(lds + wave * 8448);
                for (int it = gw; it < 4 * 1024; it += NGW) { const int l = it >> 10; tr_item(in[15] + (size_t)l * DM * 2048, 2048, WKVT + (size_t)l * 2048 * DM, DM, 64, scr, it & 1023, lane, 1, 0); }
                for (int m = gw; m < 4 * 512; m += NGW) { const int l = m >> 9, r = m & 511; norm_row(in[1] + (size_t)r * DM, in[3] + l * DM, MEMN + (size_t)m * DM, (const LAS float*)lds, false, nullptr, nullptr, 0, lane); }
            } else if (ph == 1) {
                LocOrder<LocMemKV> S; S.so.init(4 * 512, 2048, G, bx); S.loc = LocMemKV{(const char*)MEMN, (const char*)WKVT};
                if (EN_GEMM) pg8::gemm_phase<EpiF32, LocOrder<LocMemKV>, true, true>(lds, pg8::Gemm{DM, DM, DM}, S, EpiF32{MEMRAW, 2048, 0});
            } else {
                for (int m = gw; m < 4 * 512; m += NGW) { const int l = m >> 9, r = m & 511, b = r >> 8, mi = r & 255; const float* raw = MEMRAW + (size_t)m * 2048;
                    const f32x4 gk = *(const f32x4*)(in[17] + l * 256 + lane * 4), gq = *(const f32x4*)(in[16] + l * 256 + lane * 4); const f32x4 gg = gk * gq;
#pragma unroll
                    for (int h = 0; h < 4; ++h) { const f32x4 k = *(const f32x4*)(raw + h * 256 + lane * 4); const float ss = wave_sum((k[0] * k[0] + k[1] * k[1]) + (k[2] * k[2] + k[3] * k[3]));
                        const float rstd = rsqrtf(ss * (1.f / 256.f) + EPS); uint2 o; o.x = pk2(k[0] * rstd * gg[0], k[1] * rstd * gg[1]); o.y = pk2(k[2] * rstd * gg[2], k[3] * rstd * gg[3]);
                        *(uint2*)(MK + ((size_t)l * 512 + (size_t)b * 256 + mi) * DM + h * 256 + lane * 4) = o;
                        const f32x4 v = *(const f32x4*)(raw + 1024 + h * 256 + lane * 4); bf16_t* vt = MVT + (size_t)l * 512 * DM + (((size_t)b * 4 + h) * 256 + lane * 4) * 256 + mi;
                        vt[0] = f2bf(v[0]); vt[256] = f2bf(v[1]); vt[512] = f2bf(v[2]); vt[768] = f2bf(v[3]); }
                    if (r == 0) { float mx = fmaxf(fmaxf(fabsf(gg[0]), fabsf(gg[1])), fmaxf(fabsf(gg[2]), fabsf(gg[3])));
#pragma unroll
                        for (int o = 1; o < 64; o <<= 1) mx = fmaxf(mx, __shfl_xor(mx, o));
                        if (lane == 0) CB[l] = 16.f * mx; } }
            }
        } else {
            const int l = (ph - N_PRO) / N_PER_LAYER, sp = (ph - N_PRO) % N_PER_LAYER;
            const float* xcur = l == 0 ? in[0] : out;
            if (sp == 0) {
                if (sub & SUB_NORM) { LAS float* WfT = (LAS float*)lds; const float* wf = in[4] + (size_t)l * DM * NIN + 3072;
                    for (int i = tid; i < 16 * 1024; i += MEGA_THREADS) { const int k = i >> 4, h = i & 15; WfT[h * 1024 + k] = wf[(size_t)k * NIN + h]; } }
                __syncthreads();
                if (sub & SUB_CONV) { LAS float* scr = (LAS float*)(lds + 65536 + wave * 8448);
                    const float* win = in[4] + (size_t)l * DM * NIN;
                    for (int it = gw; it < 13440; it += NGW) { int r = it;
                        if (r < 1536) { tr_item(win, NIN, WIN_T, DM, 96, scr, r, lane, 1, 0); continue; } r -= 1536;
                        if (r < 5120) { tr_item(win + 3088, NIN, WIN_T + (size_t)3072 * DM, DM, 320, scr, r, lane, 1, 0); continue; } r -= 5120;
                        if (r < 2048) { const int i = r >> 9; tr_item(in[19] + ((size_t)l * 4 + i) * DM * DM, DM, WBR_T + (size_t)i * DM * DM, DM, 32, scr, r & 511, lane, 1, 0); continue; } r -= 2048;
                        if (r < 512) { tr_item(in[20] + (size_t)l * DM * DM, DM, WOUT_T, 4096, 32, scr, r, lane, 4, 1024); continue; } r -= 512;
                        if (r < 2816) { tr_item(in[22] + (size_t)l * DM * 2 * DFF, 2 * DFF, WUP_T, DM, 176, scr, r, lane, 1, 0); continue; } r -= 2816;
                        tr_item(in[25] + (size_t)l * DFF * DM, DM, WDN_T, DFF, 32, scr, r, lane, 1, 0); } }
                if (sub & SUB_NORM) for (int m = gw; m < T; m += NGW) norm_row(xcur + (size_t)m * DM, in[2] + l * DM, H + (size_t)m * DM, (const LAS float*)lds, !DBG_NOLOGF, in[5] + l * 16, LOGF, m, lane);
            } else if (sp == 1) {
                LocOrder<LocStd> S; S.so.init(T, 13312, G, bx); S.loc = LocStd{(const char*)H, (const char*)WIN_T, 256 * 1024 * 2, 256 * 1024 * 2};
                if (EN_GEMM) pg8::gemm_phase<EpiProj, LocOrder<LocStd>, true, true>(lds, pg8::Gemm{DM, DM, DM}, S, EpiProj{PROJ, GATES, MQSS});
            } else if (sp == 2) {
                if (sub & SUB_HEADNORM) { for (int m = gw; m < 2 * T; m += NGW) { if (m < T) headnorm64_row(FQ + (size_t)m * DM, in[6] + l * 64, C2, lane); else headnorm64_row(FK + (size_t)(m - T) * DM, in[7] + l * 64, 1.f, lane); } }
                if ((sub & SUB_CUMSUM) && bx < 32) cumsum_block(LOGF + (size_t)bx * SEQ, FB + (size_t)bx * SEQ, (LAS float*)lds, tid);
                __syncthreads();
                if (EN_LRU && (sub & SUB_LRU)) for (int it = bx; it < 4096; it += G) lru_item<false>(it >> 11, (it >> 4) & 127, it & 15, LX, LG, YL, in[8] + (size_t)l * 4 * DM, in[9] + l * DM, in[10] + (size_t)l * 65536, in[11] + l * DM,
                                                                                      in[12] + (size_t)l * 65536, in[13] + l * DM, in[14] + l * DM, APROD, HEND, lds, tid);
                if (EN_SB && (sub & SUB_SB)) for (int k = 0; k < 4; ++k) { const int bh = vcu >> 3, qb = (vcu & 7) * 4 + k; sb_wave(bh >> 4, bh & 15, qb * 256 + wave * 32, SQ, SK, SV, SQ, lds + wave * 4096, lane); }
                __syncthreads();
                if (sub & SUB_MEM) { LocOrder<LocMemS> S; S.so.init(T, 1024, G, bx); S.loc = LocMemS{(const char*)MQ, (const char*)(MK + (size_t)l * 512 * DM)};
                    if (EN_GEMM) pg8::gemm_phase<EpiSexp, LocOrder<LocMemS>, true, true>(lds, pg8::Gemm{DM, DM, 256 + zs}, S, EpiSexp{Eb, MQSS, ESUM, CB + l}); }
            } else if (sp == 3) {
                if (EN_FOX && (sub & SUB_FOX)) { const attn_body::AttnTensors AT{(const attn_body::bf16*)FQ, (const attn_body::bf16*)FK, (const attn_body::bf16*)FV, (attn_body::bf16*)FQ, FB};
                    const attn_body::StaticOrder S(G, bx); attn_body::attn_phase<attn_body::StaticOrder>((char*)lds_raw, AT, S); }
                __syncthreads();
                if (EN_LRU && (sub & SUB_LRU)) for (int it = bx; it < 4096; it += G) lru_item<true>(it >> 11, (it >> 4) & 127, it & 15, LX, LG, YL, in[8] + (size_t)l * 4 * DM, in[9] + l * DM, in[10] + (size_t)l * 65536, in[11] + l * DM,
                                                                                     in[12] + (size_t)l * 65536, in[13] + l * DM, in[14] + l * DM, APROD, HEND, lds, tid);
                if (sub & SUB_MEM) { LocOrder<LocMemPV> S; S.so.init(T, 1024, G, bx); S.loc = LocMemPV{(const char*)Eb, (const char*)(MVT + (size_t)l * 512 * DM)};
                    if (EN_GEMM) pg8::gemm_phase<EpiMemPV, LocOrder<LocMemPV>, true, true>(lds, pg8::Gemm{DM, 256, 256 + zs}, S, EpiMemPV{MQ, ESUM}); }
            } else if (sp == 4) {
                LocOrder<LocBranch> S; S.so.init(T, 4096, G, bx); S.loc = LocBranch{(const char*)FQ, (const char*)YL, (const char*)SQ, (const char*)MQ, (const char*)WBR_T};
                if (EN_GEMM) pg8::gemm_phase<EpiBranch, LocOrder<LocBranch>, true, true>(lds, pg8::Gemm{DM, DM, DM}, S, EpiBranch{GATES, in[18] + (size_t)l * 4 * DM});
            } else if (sp == 5) {
                LocOrder<LocStd> S; S.so.init(T, DM, G, bx); S.loc = LocStd{(const char*)GATES, (const char*)WOUT_T, 256 * 4096 * 2, 256 * 4096 * 2};
                if (EN_GEMM) pg8::gemm_phase<EpiResid, LocOrder<LocStd>, true, true>(lds, pg8::Gemm{4096, 4096, 4096}, S, EpiResid{xcur, out});
            } else if (sp == 6) {
                for (int m = gw; m < T; m += NGW) norm_row(out + (size_t)m * DM, in[21] + l * DM, H + (size_t)m * DM, (const LAS float*)lds, false, nullptr, nullptr, m, lane);
            } else if (sp == 7) {
                LocOrder<LocStd> S; S.so.init(T, 2 * DFF, G, bx); S.loc = LocStd{(const char*)H, (const char*)WUP_T, 256 * 1024 * 2, 256 * 1024 * 2};
                if (EN_GEMM) pg8::gemm_phase<EpiBf16P, LocOrder<LocStd>, true, true>(lds, pg8::Gemm{DM, DM, DM}, S, EpiBf16P{GV, 2 * DFF, 0});
            } else if (sp == 8) {
                const float* cw = in[23] + (size_t)l * 3 * DFF; const float* cbv = in[24] + l * DFF;
                for (int i = bx * MEGA_THREADS + tid; i < T * (DFF / 8); i += G * MEGA_THREADS) { const int r = i / (DFF / 8), c = (i % (DFF / 8)) * 8, t = r % SEQ;
                    const bf16_t* gp = GV + (size_t)r * 2 * DFF + c; const u32x4 z4 = {0u, 0u, 0u, 0u};
                    const u32x4 g0 = *(const u32x4*)gp, g1 = t >= 1 ? *(const u32x4*)(gp - 2 * DFF) : z4, g2 = t >= 2 ? *(const u32x4*)(gp - 4 * DFF) : z4, vv = *(const u32x4*)(gp + DFF);
                    const f32x4 wa0 = *(const f32x4*)(cw + c), wa1 = *(const f32x4*)(cw + c + 4), wb0 = *(const f32x4*)(cw + DFF + c), wb1 = *(const f32x4*)(cw + DFF + c + 4), wc0 = *(const f32x4*)(cw + 2 * DFF + c), wc1 = *(const f32x4*)(cw + 2 * DFF + c + 4);
                    const f32x4 bb0 = *(const f32x4*)(cbv + c), bb1 = *(const f32x4*)(cbv + c + 4);
#define ACT1(G0, G1, G2, VV, W0, W1, W2, BB) ({ const float pre_ = (BB) + (W2) * (G0) + (W1) * (G1) + (W0) * (G2); pre_ * fast_sigmoid(pre_) * (VV); })
                    u32x4 o;
                    o.x = pk2(ACT1(blo(g0.x), blo(g1.x), blo(g2.x), blo(vv.x), wa0[0], wb0[0], wc0[0], bb0[0]), ACT1(bhi(g0.x), bhi(g1.x), bhi(g2.x), bhi(vv.x), wa0[1], wb0[1], wc0[1], bb0[1]));
                    o.y = pk2(ACT1(blo(g0.y), blo(g1.y), blo(g2.y), blo(vv.y), wa0[2], wb0[2], wc0[2], bb0[2]), ACT1(bhi(g0.y), bhi(g1.y), bhi(g2.y), bhi(vv.y), wa0[3], wb0[3], wc0[3], bb0[3]));
                    o.z = pk2(ACT1(blo(g0.z), blo(g1.z), blo(g2.z), blo(vv.z), wa1[0], wb1[0], wc1[0], bb1[0]), ACT1(bhi(g0.z), bhi(g1.z), bhi(g2.z), bhi(vv.z), wa1[1], wb1[1], wc1[1], bb1[1]));
                    o.w = pk2(ACT1(blo(g0.w), blo(g1.w), blo(g2.w), blo(vv.w), wa1[2], wb1[2], wc1[2], bb1[2]), ACT1(bhi(g0.w), bhi(g1.w), bhi(g2.w), bhi(vv.w), wa1[3], wb1[3], wc1[3], bb1[3]));
#undef ACT1
                    *(u32x4*)(ACT + (size_t)r * DFF + c) = o; }
            } else {
                LocOrder<LocStd> S; S.so.init(T, DM, G, bx); S.loc = LocStd{(const char*)ACT, (const char*)WDN_T, 256 * DFF * 2, 256 * DFF * 2};
                if (EN_GEMM) pg8::gemm_phase<EpiResid, LocOrder<LocStd>, true, true>(lds, pg8::Gemm{DFF, DFF, DFF}, S, EpiResid{out, out});
            }
        }
        if (ph + 1 < a.ph_hi) grid.sync();
    }
}
enum { C_PRO = 1, C_NORM = 2, C_WIN = 4, C_HN = 8, C_LRU = 16, C_SB = 32, C_MEM = 64, C_FOX = 128, C_BR = 256, C_WOUT = 512, C_NORM2 = 1024, C_UP = 2048, C_ACT = 4096, C_DOWN = 8192, C_ONE = 16384 };
#ifndef CFG
#define CFG 32767
#endif
static int g_grid = 0;
static void launch_mega(const Ptrs& P, int lo, int hi, int sub, hipStream_t st, bool coop) {
    MArgs a{}; a.P = P; a.ph_lo = lo; a.ph_hi = hi; a.sub = sub; a.pad = 0;
    if (coop) { void* args[] = {&a}; const hipError_t e = hipLaunchCooperativeKernel((const void*)mega, dim3(g_grid), dim3(MEGA_THREADS), args, MEGA_LDS, st);
        if (e != hipSuccess) fprintf(stderr, "cooperative launch failed: %s (grid %d)\n", hipGetErrorString(e), g_grid); }
    else hipLaunchKernelGGL(mega, dim3(g_grid), dim3(MEGA_THREADS), MEGA_LDS, st, a);
}
static void run_hybrid(const Ptrs& P, hipStream_t st) {
    unsigned char* ws = P.ws;
    bf16_t* H = (bf16_t*)(ws + WS_H);
    bf16_t* PR[9]; for (int i = 0; i < 9; ++i) PR[i] = (bf16_t*)(ws + WS_PROJ + i * SZ_ACT);
    bf16_t *FQ = PR[0], *FK = PR[1], *FV = PR[2], *LX = PR[3], *LG = PR[4], *SQ = PR[5], *SK = PR[6], *SV = PR[7], *MQ = PR[8];
    bf16_t* GATES = (bf16_t*)(ws + WS_GATES);
    bf16_t *YL = (bf16_t*)(ws + WS_YL), *YS = (bf16_t*)(ws + WS_YS), *YM = (bf16_t*)(ws + WS_YM);
    float *LOGF = (float*)(ws + WS_LOGF), *FB = (float*)(ws + WS_FB);
    bf16_t* MEMN = (bf16_t*)(ws + WS_MEMN); float* MEMRAW = (float*)(ws + WS_MEMRAW);
    bf16_t *MK = (bf16_t*)(ws + WS_MK), *MVT = (bf16_t*)(ws + WS_MVT);
    bf16_t *GV = (bf16_t*)(ws + WS_GV), *ACT = (bf16_t*)(ws + WS_ACT);
    const float* const* in = P.in;
    const int cfg = CFG;
    const bool anygemm = cfg & (C_WIN | C_BR | C_WOUT | C_UP | C_DOWN);
    if (cfg & C_PRO) { for (int p = 0; p < 3; ++p) launch_mega(P, p, p + 1, SUB_ALL, st, false); }
    else for (int l = 0; l < DEPTH; ++l) {
        n_rmsnorm<<<512 / 4, 256, 0, st>>>(in[1], in[3] + l * DM, MEMN + (size_t)l * 512 * DM, nullptr, nullptr, nullptr, 512);
        n_gemm<EStoreF32><<<dim3(2048 / 64, 512 / 64), 256, 0, st>>>(MEMN + (size_t)l * 512 * DM, in[15] + (size_t)l * DM * 2048, DM, 2048, DM, 0x7fffffff, EStoreF32{MEMRAW + (size_t)l * 512 * 2048, 2048, 0});
        n_memkv_post<<<512, 256, 0, st>>>(MEMRAW + (size_t)l * 512 * 2048, in[17] + l * 256, in[16] + l * 256, MK + (size_t)l * 512 * DM, MVT + (size_t)l * 512 * DM);
    }
    for (int l = 0; l < DEPTH; ++l) {
        const int p0 = N_PRO + l * N_PER_LAYER;
        const float* xcur = l == 0 ? in[0] : P.out;
        const float* win = in[4] + (size_t)l * DM * NIN;
        if (DBG_NOLOGF) n_rmsnorm<<<T / 4, 256, 0, st>>>(xcur, in[2] + l * DM, H, win + 3072, in[5] + l * 16, LOGF, T);
        { const int sub = (anygemm ? SUB_CONV : 0) | ((cfg & C_NORM) ? SUB_NORM : 0); if (sub) launch_mega(P, p0, p0 + 1, sub, st, false); }
        if (!(cfg & C_NORM)) n_rmsnorm<<<T / 4, 256, 0, st>>>(xcur, in[2] + l * DM, H, win + 3072, in[5] + l * 16, LOGF, T);
        if (cfg & C_WIN) launch_mega(P, p0 + 1, p0 + 2, SUB_ALL, st, false);
        else { for (int gI = 0; gI < 9; ++gI) { const int coff = gI < 3 ? gI * 1024 : gI * 1024 + 16;
                n_gemm<EStoreBf16><<<dim3(1024 / 64, T / 64), 256, 0, st>>>(H, win + coff, DM, NIN, DM, 0x7fffffff, EStoreBf16{PR[gI], DM, 0}); }
            n_gemm<EStoreBf16><<<dim3(4096 / 64, T / 64), 256, 0, st>>>(H, win + 9232, DM, NIN, DM, 0x7fffffff, EStoreBf16{GATES, 4096, 0}); }
        if (!(cfg & C_HN)) { n_headnorm<<<T * 16 / 256, 256, 0, st>>>(FQ, in[6] + l * 64, 64, C2); n_headnorm<<<T * 16 / 256, 256, 0, st>>>(FK, in[7] + l * 64, 64, 1.f); n_cumsum<<<32, 1024, 0, st>>>(LOGF, FB); }
        const int sub23 = ((cfg & C_HN) ? (SUB_HEADNORM | SUB_CUMSUM) : 0) | ((cfg & C_LRU) ? SUB_LRU : 0) | ((cfg & C_SB) ? SUB_SB : 0) | ((cfg & C_MEM) ? SUB_MEM : 0) | ((cfg & C_FOX) ? SUB_FOX : 0);
        if (sub23 & ~SUB_FOX) launch_mega(P, p0 + 2, p0 + 3, sub23, st, false);
        if (!(cfg & C_SB)) n_sb_attn<<<dim3(SEQ / 256, 32), 256, 0, st>>>(SQ, SK, SV, YS);
        if (!(cfg & C_LRU)) n_lru<<<32, 64, 0, st>>>(LX, LG, in[8] + (size_t)l * 4 * DM, in[9] + l * DM, in[10] + (size_t)l * 16 * 64 * 64, in[11] + l * DM, in[12] + (size_t)l * 16 * 64 * 64, in[13] + l * DM, in[14] + l * DM, YL);
        if (!(cfg & C_MEM)) n_mem_attn<<<T * 4, 256, 0, st>>>(MQ, MK + (size_t)l * 512 * DM, MVT + (size_t)l * 512 * DM, YM);
        if (sub23 & (SUB_FOX | SUB_LRU | SUB_MEM)) launch_mega(P, p0 + 3, p0 + 4, sub23, st, false);
        if (!(cfg & C_FOX)) n_fox_attn<<<dim3(SEQ / 256, 32), 256, 0, st>>>(FQ, FK, FV, FB, FQ);
        if (cfg & C_BR) launch_mega(P, p0 + 4, p0 + 5, SUB_ALL, st, false);
        else { const bf16_t* Y[4] = {FQ, YL, YS, YM};
            for (int i = 0; i < 4; ++i) n_gemm<EBranch><<<dim3(1024 / 64, T / 64), 256, 0, st>>>(Y[i], in[19] + ((size_t)l * 4 + i) * DM * DM, DM, DM, DM, 0x7fffffff, EBranch{GATES, in[18] + ((size_t)l * 4 + i) * DM, i, 0}); }
        if (cfg & C_WOUT) launch_mega(P, p0 + 5, p0 + 6, SUB_ALL, st, false);
        else n_gemm<EResid><<<dim3(1024 / 64, T / 64), 256, 0, st>>>(GATES, in[20] + (size_t)l * DM * DM, 4096, DM, 4096, 1023, EResid{xcur, P.out});
        if (cfg & C_NORM2) launch_mega(P, p0 + 6, p0 + 7, SUB_ALL, st, false);
        else n_rmsnorm<<<T / 4, 256, 0, st>>>(P.out, in[21] + l * DM, H, nullptr, nullptr, nullptr, T);
        if (cfg & C_UP) launch_mega(P, p0 + 7, p0 + 8, SUB_ALL, st, false);
        else n_gemm<EStoreBf16><<<dim3(2 * DFF / 64, T / 64), 256, 0, st>>>(H, in[22] + (size_t)l * DM * 2 * DFF, DM, 2 * DFF, DM, 0x7fffffff, EStoreBf16{GV, 2 * DFF, 0});
        if (cfg & C_ACT) launch_mega(P, p0 + 8, p0 + 9, SUB_ALL, st, false);
        else n_act<<<(unsigned)(((size_t)T * DFF + 255) / 256), 256, 0, st>>>(GV, in[23] + (size_t)l * 3 * DFF, in[24] + l * DFF, ACT);
        if (cfg & C_DOWN) launch_mega(P, p0 + 9, p0 + 10, SUB_ALL, st, false);
        else n_gemm<EResid><<<dim3(1024 / 64, T / 64), 256, 0, st>>>(ACT, in[25] + (size_t)l * DFF * DM, DFF, DM, DFF, 0x7fffffff, EResid{P.out, P.out});
    }
}

extern "C" void kernel_launch(void* const* d_in, const int* in_sizes, int n_in, void* d_out, int out_size, void* d_ws, size_t ws_size, hipStream_t stream) {
    if (n_in != 26 || out_size != T * DM || ws_size < WS_END) { fprintf(stderr, "kernel_launch: unexpected sizes n_in %d out %d ws %zu (need %zu)\n", n_in, out_size, ws_size, (size_t)WS_END); return; }
    if (g_grid == 0) {
        int dev = 0, cus = 0, per_cu = 0;
        hipGetDevice(&dev); hipDeviceGetAttribute(&cus, hipDeviceAttributeMultiprocessorCount, dev);
        if (hipFuncSetAttribute((const void*)mega, hipFuncAttributeMaxDynamicSharedMemorySize, MEGA_LDS) != hipSuccess) fprintf(stderr, "kernel_launch: hipFuncSetAttribute failed\n");
        if (hipOccupancyMaxActiveBlocksPerMultiprocessor(&per_cu, (const void*)mega, MEGA_THREADS, MEGA_LDS) != hipSuccess || per_cu < 1) fprintf(stderr, "kernel_launch: occupancy query says %d\n", per_cu);
        (void)hipGetLastError();
        g_grid = cus;
        if (g_grid != 256) fprintf(stderr, "kernel_launch: %d CUs; the attention phase's static order assumes 256\n", g_grid);
    }
    Ptrs P{};
    for (int i = 0; i < 26; ++i) P.in[i] = (const float*)d_in[i];
    P.out = (float*)d_out; P.ws = (unsigned char*)d_ws;
    if ((CFG) & C_ONE) launch_mega(P, 0, N_PHASES, SUB_ALL, stream, true);
    else run_hybrid(P, stream);
}
```

```cpp
#include <hip/hip_runtime.h>
#include <cstdio>
#include <cstdint>
#include <hip/hip_cooperative_groups.h>

typedef unsigned short bf16_t;
constexpr int BATCH = 2, SEQ = 8192, DM = 1024, DEPTH = 4, T = BATCH * SEQ;
constexpr int NMEM = 256, NIN = 13328, DFF = 2816;
constexpr float EPS = 1e-6f;
constexpr float LOG2E = 1.4426950408889634f;
constexpr float C2 = 0.125f * LOG2E;
constexpr float SB_THR = -104.0f;

__device__ __forceinline__ float bf2f(bf16_t b) { return __uint_as_float(((unsigned)b) << 16); }
__device__ __forceinline__ bf16_t f2bf(float f) { unsigned u = __float_as_uint(f); return (bf16_t)((u + 0x7fffu + ((u >> 16) & 1u)) >> 16); }
__device__ __forceinline__ float bfr(float f) { return bf2f(f2bf(f)); }
__device__ __forceinline__ float wave_sum(float v) {
#pragma unroll
    for (int o = 1; o < 64; o <<= 1) v += __shfl_xor(v, o);
    return v;
}
__device__ __forceinline__ float softplusf(float x) { return fmaxf(x, 0.f) + log1pf(__expf(-fabsf(x))); }
__device__ __forceinline__ float logsigmoidf(float x) { return -softplusf(-x); }
__device__ __forceinline__ float sigmoidf_(float x) { return 1.f / (1.f + __expf(-x)); }
__device__ __forceinline__ float gelu_tanh(float x) { const float u = 0.7978845608028654f * (x + 0.044715f * x * x * x); return 0.5f * x * (1.f + tanhf(u)); }

__device__ __forceinline__ int mk_tid() { int t = threadIdx.x; asm volatile("" : "+v"(t)); return t; }

constexpr size_t MiB = 1u << 20;
constexpr size_t SZ_ACT = (size_t)T * DM * 2;
constexpr size_t WS_CTL = 0;
constexpr size_t WS_H = 1 * MiB;
constexpr size_t WS_PROJ = WS_H + SZ_ACT;
constexpr size_t WS_GATES = WS_PROJ + 9 * SZ_ACT;
constexpr size_t WS_E = WS_GATES + 4 * SZ_ACT;
constexpr size_t WS_LOGF = WS_E + SZ_ACT;
constexpr size_t WS_FB = WS_LOGF + 1 * MiB;
constexpr size_t WS_MQSS = WS_FB + 1 * MiB;
constexpr size_t WS_ESUM = WS_MQSS + 1 * MiB;
constexpr size_t WS_MEMN = WS_ESUM + 1 * MiB;
constexpr size_t WS_MEMRAW = WS_MEMN + 4 * MiB;
constexpr size_t WS_MK = WS_MEMRAW + 16 * MiB;
constexpr size_t WS_MVT = WS_MK + 4 * MiB;
constexpr size_t WS_LRU = WS_MVT + 4 * MiB;
constexpr size_t WS_WT = WS_LRU + 2 * MiB;
constexpr size_t WS_END = WS_WT + 72 * MiB;
constexpr size_t WS_YL = WS_PROJ + 6 * SZ_ACT, WS_YS = WS_H, WS_YM = WS_PROJ + 8 * SZ_ACT, WS_YF = WS_PROJ + 7 * SZ_ACT;
constexpr size_t WS_GV = WS_PROJ;
constexpr size_t WS_ACT = WS_GV + (size_t)T * 2 * DFF * 2;
static_assert(WS_ACT + (size_t)T * DFF * 2 <= WS_GATES, "ffn alias");

struct Ptrs {
    const float* in[26];
    float* out;
    unsigned char* ws;
};

__global__ void __launch_bounds__(256) n_rmsnorm(const float* __restrict__ x, const float* __restrict__ g, bf16_t* __restrict__ H,
                                                 const float* __restrict__ Wf, const float* __restrict__ bfg, float* __restrict__ LOGF, int nrows) {
    const int lane = threadIdx.x & 63, row = blockIdx.x * 4 + (threadIdx.x >> 6);
    if (row >= nrows) return;
    const float4* xr = (const float4*)(x + (size_t)row * DM);
    const float4* gr = (const float4*)g;
    float4 v[4]; float ss = 0.f;
#pragma unroll
    for (int j = 0; j < 4; ++j) { v[j] = xr[lane + 64 * j]; ss += v[j].x * v[j].x + v[j].y * v[j].y + v[j].z * v[j].z + v[j].w * v[j].w; }
    ss = wave_sum(ss);
    const float rstd = rsqrtf(ss * (1.f / DM) + EPS);
#pragma unroll
    for (int j = 0; j < 4; ++j) { const float4 gg = gr[lane + 64 * j]; v[j].x *= rstd * gg.x; v[j].y *= rstd * gg.y; v[j].z *= rstd * gg.z; v[j].w *= rstd * gg.w;
        ushort4 o; o.x = f2bf(v[j].x); o.y = f2bf(v[j].y); o.z = f2bf(v[j].z); o.w = f2bf(v[j].w);
        ((ushort4*)(H + (size_t)row * DM))[lane + 64 * j] = o; }
    if (Wf) {
        float mine = 0.f;
        for (int h = 0; h < 16; ++h) {
            float p = 0.f;
#pragma unroll
            for (int j = 0; j < 4; ++j) { const int k = (lane + 64 * j) * 4;
                p += v[j].x * Wf[(size_t)k * NIN + h] + v[j].y * Wf[(size_t)(k + 1) * NIN + h] + v[j].z * Wf[(size_t)(k + 2) * NIN + h] + v[j].w * Wf[(size_t)(k + 3) * NIN + h]; }
            p = wave_sum(p);
            if (lane == h) mine = p;
        }
        if (lane < 16) { const int b = row / SEQ, t = row % SEQ; LOGF[((size_t)b * 16 + lane) * SEQ + t] = logsigmoidf(mine + bfg[lane]); }
    }
}

struct EStoreBf16 { bf16_t* O; int ldc; int pad; __device__ void operator()(int m, int n, float a) const { O[(size_t)m * ldc + n] = f2bf(a); } };
struct EStoreF32 { float* O; int ldc; int pad; __device__ void operator()(int m, int n, float a) const { O[(size_t)m * ldc + n] = a; } };
struct EBranch { bf16_t* G; const float* bg; int i; int pad; __device__ void operator()(int m, int n, float a) const { bf16_t* p = G + (size_t)m * 4096 + i * 1024 + n; *p = f2bf(sigmoidf_(bf2f(*p) + bg[n]) * a); } };
struct EResid { const float* base; float* out; __device__ void operator()(int m, int n, float a) const { out[(size_t)m * DM + n] = base[(size_t)m * DM + n] + a; } };

template <class Epi> __global__ void __launch_bounds__(256) n_gemm(const bf16_t* __restrict__ A, const float* __restrict__ W, int lda, int ldw, int K, int kmask, Epi epi) {
    __shared__ float As[16][68], Bs[16][68];
    const int tx = threadIdx.x & 15, ty = threadIdx.x >> 4, m0 = blockIdx.y * 64, n0 = blockIdx.x * 64;
    float acc[4][4];
#pragma unroll
    for (int i = 0; i < 4; ++i)
#pragma unroll
        for (int j = 0; j < 4; ++j) acc[i][j] = 0.f;
    for (int k0 = 0; k0 < K; k0 += 16) {
#pragma unroll
        for (int i = 0; i < 4; ++i) { const int idx = threadIdx.x + i * 256; { const int r = idx >> 4, c = idx & 15; As[c][r] = bf2f(A[(size_t)(m0 + r) * lda + k0 + c]); }
            { const int r = idx >> 6, c = idx & 63; Bs[r][c] = bfr(W[(size_t)((k0 + r) & kmask) * ldw + n0 + c]); } }
        __syncthreads();
#pragma unroll
        for (int kk = 0; kk < 16; ++kk) { float a[4], b[4];
#pragma unroll
            for (int i = 0; i < 4; ++i) { a[i] = As[kk][ty * 4 + i]; b[i] = Bs[kk][tx * 4 + i]; }
#pragma unroll
            for (int i = 0; i < 4; ++i)
#pragma unroll
                for (int j = 0; j < 4; ++j) acc[i][j] += a[i] * b[j]; }
        __syncthreads();
    }
#pragma unroll
    for (int i = 0; i < 4; ++i)
#pragma unroll
        for (int j = 0; j < 4; ++j) epi(m0 + ty * 4 + i, n0 + tx * 4 + j, acc[i][j]);
}

__global__ void __launch_bounds__(256) n_headnorm(bf16_t* X, const float* __restrict__ g, int HD, float scale) {
    const int idx = blockIdx.x * 256 + threadIdx.x, nh = DM / HD, row = idx / nh, h = idx % nh;
    if (row >= T) return;
    bf16_t* p = X + (size_t)row * DM + h * HD; float ss = 0.f;
    for (int d = 0; d < HD; ++d) { const float v = bf2f(p[d]); ss += v * v; }
    const float rstd = rsqrtf(ss / HD + EPS) * scale;
    for (int d = 0; d < HD; ++d) p[d] = f2bf(bf2f(p[d]) * rstd * g[d]);
}

__global__ void __launch_bounds__(1024) n_cumsum(const float* __restrict__ LOGF, float* __restrict__ FB) {
    __shared__ float part[1024];
    const int bh = blockIdx.x, tid = threadIdx.x; const float* src = LOGF + (size_t)bh * SEQ + tid * 8; float v[8]; float s = 0.f;
#pragma unroll
    for (int i = 0; i < 8; ++i) { s += src[i]; v[i] = s; }
    part[tid] = s; __syncthreads();
    if (tid == 0) { float run = 0.f; for (int i = 0; i < 1024; ++i) { const float t_ = part[i]; part[i] = run; run += t_; } }
    __syncthreads();
    const float off = part[tid]; float* dst = FB + (size_t)bh * SEQ + tid * 8;
#pragma unroll
    for (int i = 0; i < 8; ++i) dst[i] = off + v[i];
}

__global__ void __launch_bounds__(256) n_fox_attn(const bf16_t* Q, const bf16_t* __restrict__ K, const bf16_t* __restrict__ V, const float* __restrict__ FB, bf16_t* O) {
    __shared__ float Ks[64][64], Vs[64][64], Fs[64];
    const int bh = blockIdx.y, b = bh >> 4, h = bh & 15, tq = blockIdx.x * 256 + threadIdx.x;
    const size_t rowq = (size_t)b * SEQ + tq;
    float q[64], o[64];
#pragma unroll
    for (int d = 0; d < 64; ++d) { q[d] = bf2f(Q[rowq * DM + h * 64 + d]); o[d] = 0.f; }
    const float Ft = FB[(size_t)bh * SEQ + tq];
    float m = -INFINITY, l = 0.f;
    const int ntile = (blockIdx.x * 256 + 256) / 64;
    for (int kt = 0; kt < ntile; ++kt) {
        __syncthreads();
        for (int i = threadIdx.x; i < 64 * 64; i += 256) { const int r = i >> 6, c = i & 63; const size_t rk = ((size_t)b * SEQ + kt * 64 + r) * DM + h * 64 + c; Ks[r][c] = bf2f(K[rk]); Vs[r][c] = bf2f(V[rk]); }
        if (threadIdx.x < 64) Fs[threadIdx.x] = FB[(size_t)bh * SEQ + kt * 64 + threadIdx.x];
        __syncthreads();
        for (int j = 0; j < 64; ++j) {
            const int s = kt * 64 + j; if (s > tq) break;
            float z = 0.f;
#pragma unroll
            for (int d = 0; d < 64; ++d) z += q[d] * Ks[j][d];
            z += (Ft - Fs[j]) * LOG2E;
            if (z > m) { const float c = exp2f(m - z); l *= c;
#pragma unroll
                for (int d = 0; d < 64; ++d) o[d] *= c;
                m = z; }
            const float p = exp2f(z - m); l += p;
#pragma unroll
            for (int d = 0; d < 64; ++d) o[d] += p * Vs[j][d];
        }
    }
    const float il = 1.f / l;
#pragma unroll
    for (int d = 0; d < 64; ++d) O[rowq * DM + h * 64 + d] = f2bf(o[d] * il);
}

__global__ void __launch_bounds__(256) n_sb_attn(const bf16_t* Q, const bf16_t* __restrict__ K, const bf16_t* __restrict__ V, bf16_t* O) {
    __shared__ float Ks[64][64], Vs[64][64];
    const int bh = blockIdx.y, b = bh >> 4, h = bh & 15, tq = blockIdx.x * 256 + threadIdx.x;
    const size_t rowq = (size_t)b * SEQ + tq;
    float q[64], o[64];
#pragma unroll
    for (int d = 0; d < 64; ++d) { q[d] = bf2f(Q[rowq * DM + h * 64 + d]) * 0.125f; o[d] = 0.f; }
    float R = 0.f;
    for (int kt = (blockIdx.x * 256 + 255) / 64; kt >= 0; --kt) {
        if (__syncthreads_and(R < SB_THR)) break;
        for (int i = threadIdx.x; i < 64 * 64; i += 256) { const int r = i >> 6, c = i & 63; const size_t rk = ((size_t)b * SEQ + kt * 64 + r) * DM + h * 64 + c; Ks[r][c] = bf2f(K[rk]); Vs[r][c] = bf2f(V[rk]); }
        __syncthreads();
        for (int j = 63; j >= 0; --j) {
            const int s = kt * 64 + j; if (s >= tq) continue;
            float z = 0.f;
#pragma unroll
            for (int d = 0; d < 64; ++d) z += q[d] * Ks[j][d];
            const float sp = softplusf(z);
            const float w = __expf((z - sp) + R);
            R -= sp;
#pragma unroll
            for (int d = 0; d < 64; ++d) o[d] += w * Vs[j][d];
        }
    }
#pragma unroll
    for (int d = 0; d < 64; ++d) O[rowq * DM + h * 64 + d] = f2bf(o[d]);
}

__global__ void __launch_bounds__(64) n_lru(const bf16_t* LX, const bf16_t* __restrict__ LG, const float* __restrict__ cw, const float* __restrict__ cb,
                                            const float* __restrict__ wa, const float* __restrict__ ba, const float* __restrict__ wx, const float* __restrict__ bx,
                                            const float* __restrict__ lam, bf16_t* YL) {
    __shared__ float xs[64];
    const int b = blockIdx.x >> 4, n = blockIdx.x & 15, e = threadIdx.x, ch = n * 64 + e;
    float wA[64], wX[64];
#pragma unroll
    for (int d = 0; d < 64; ++d) { wA[d] = wa[((size_t)n * 64 + d) * 64 + e]; wX[d] = wx[((size_t)n * 64 + d) * 64 + e]; }
    const float w0 = cw[ch], w1 = cw[DM + ch], w2 = cw[2 * DM + ch], w3 = cw[3 * DM + ch], bc = cb[ch], bA = ba[ch], bX = bx[ch];
    const float spl = softplusf(-lam[ch]);
    float x1 = 0.f, x2 = 0.f, x3 = 0.f, hs = 0.f;
    for (int t = 0; t < SEQ; ++t) {
        const size_t r = ((size_t)b * SEQ + t) * DM + ch;
        const float x0 = bf2f(LX[r]);
        const float xc = bc + w3 * x0 + w2 * x1 + w1 * x2 + w0 * x3;
        x3 = x2; x2 = x1; x1 = x0;
        __syncthreads();
        xs[e] = xc;
        __syncthreads();
        float ra = bA, ri = bX;
#pragma unroll
        for (int d = 0; d < 64; ++d) { const float xv = xs[d]; ra += xv * wA[d]; ri += xv * wX[d]; }
        const float rr = sigmoidf_(ra), ii = sigmoidf_(ri);
        const float la = -8.f * rr * spl;
        const float a = __expf(la);
        const float u = sqrtf(-expm1f(2.f * la)) * (ii * xc);
        hs = a * hs + u;
        YL[r] = f2bf(hs * gelu_tanh(bf2f(LG[r])));
    }
}

__global__ void __launch_bounds__(256) n_memkv_post(const float* __restrict__ raw, const float* __restrict__ gk, const float* __restrict__ gq, bf16_t* __restrict__ MK, bf16_t* __restrict__ MVT) {
    const int row = blockIdx.x, b = row >> 8, m = row & 255, d = threadIdx.x;
    __shared__ float red[4];
    for (int h = 0; h < 4; ++h) {
        const float k = raw[(size_t)row * 2048 + h * 256 + d];
        float ss = wave_sum(k * k);
        __syncthreads();
        if ((threadIdx.x & 63) == 0) red[threadIdx.x >> 6] = ss;
        __syncthreads();
        ss = red[0] + red[1] + red[2] + red[3];
        const float rstd = rsqrtf(ss * (1.f / 256.f) + EPS);
        MK[((size_t)b * 256 + m) * DM + h * 256 + d] = f2bf(k * rstd * gk[d] * gq[d]);
        MVT[(((size_t)b * 4 + h) * 256 + d) * 256 + m] = f2bf(raw[(size_t)row * 2048 + 1024 + h * 256 + d]);
    }
}

__global__ void __launch_bounds__(256) n_mem_attn(const bf16_t* MQ, const bf16_t* __restrict__ MK, const bf16_t* __restrict__ MVT, bf16_t* YM) {
    __shared__ float qs[256], ps[256], red[4];
    const int row = blockIdx.x >> 2, h = blockIdx.x & 3, b = row / SEQ, tid = threadIdx.x;
    const float qv = bf2f(MQ[(size_t)row * DM + h * 256 + tid]);
    float ss = wave_sum(qv * qv);
    if ((tid & 63) == 0) red[tid >> 6] = ss;
    qs[tid] = qv;
    __syncthreads();
    const float rstd = rsqrtf((red[0] + red[1] + red[2] + red[3]) * (1.f / 256.f) + EPS);
    const bf16_t* kr = MK + ((size_t)b * 256 + tid) * DM + h * 256;
    float s = 0.f;
    for (int d = 0; d < 256; ++d) s += qs[d] * bf2f(kr[d]);
    s *= rstd * (1.f / 16.f);
    __syncthreads();
    float mx = s;
#pragma unroll
    for (int o = 1; o < 64; o <<= 1) mx = fmaxf(mx, __shfl_xor(mx, o));
    if ((tid & 63) == 0) red[tid >> 6] = mx;
    __syncthreads();
    mx = fmaxf(fmaxf(red[0], red[1]), fmaxf(red[2], red[3]));
    const float p = __expf(s - mx);
    ps[tid] = p;
    float sum = wave_sum(p);
    __syncthreads();
    if ((tid & 63) == 0) red[tid >> 6] = sum;
    __syncthreads();
    sum = red[0] + red[1] + red[2] + red[3];
    const bf16_t* vr = MVT + (((size_t)b * 4 + h) * 256 + tid) * 256;
    float o = 0.f;
    for (int m = 0; m < 256; ++m) o += ps[m] * bf2f(vr[m]);
    YM[(size_t)row * DM + h * 256 + tid] = f2bf(o / sum);
}

__global__ void __launch_bounds__(256) n_act(const bf16_t* __restrict__ GV, const float* __restrict__ cw, const float* __restrict__ cb, bf16_t* __restrict__ ACT) {
    const size_t idx = (size_t)blockIdx.x * 256 + threadIdx.x; if (idx >= (size_t)T * DFF) return;
    const int r = (int)(idx / DFF), c = (int)(idx % DFF), t = r % SEQ;
    const float g0 = bf2f(GV[(size_t)r * 2 * DFF + c]);
    const float g1 = t >= 1 ? bf2f(GV[(size_t)(r - 1) * 2 * DFF + c]) : 0.f;
    const float g2 = t >= 2 ? bf2f(GV[(size_t)(r - 2) * 2 * DFF + c]) : 0.f;
    const float pre = cb[c] + cw[2 * DFF + c] * g0 + cw[DFF + c] * g1 + cw[c] * g2;
    const float val = bf2f(GV[(size_t)r * 2 * DFF + DFF + c]);
    ACT[(size_t)r * DFF + c] = f2bf(pre * sigmoidf_(pre) * val);
}

#define CFG 32767
namespace pg8 {
#define PG8_LAS __attribute__((address_space(3)))
typedef unsigned short bf16_t;
typedef short bf16x8 __attribute__((ext_vector_type(8)));
typedef float f32x4 __attribute__((ext_vector_type(4)));
typedef unsigned u32x4 __attribute__((ext_vector_type(4)));
constexpr int BM = 256, BK = 64, HALF = 128, HTB = HALF * BK * 2  , STAGE_BYTES = 8 * HTB, NXCD = 8, WGM = 8;

__host__ __device__ __forceinline__ int lds_byte(int r, int c) { const int st = (r >> 4) * 2 + (c >> 5), rr = r & 15, cc = c & 31, ob = rr * 64 + cc * 2; return st * 1024 + (ob ^ (((ob >> 9) & 1) << 5)); }
__host__ __device__ __forceinline__ void stage_rc(int b, int& R, int& C) { const int st = b / 1024, sb = b % 1024, swz = sb ^ (((sb >> 9) & 1) << 5); R = (st >> 1) * 16 + swz / 64; C = (st & 1) * 32 + (swz % 64) / 2; }
__host__ __device__ __forceinline__ int perm32(int rho) { const int n = rho >> 4, i = rho & 15; return 8 * (i >> 2) + 4 * n + (i & 3); }

struct Unit { int pm, pn; };
struct Gemm { int lda, ldb, K; };

struct StaticOrder {
    int nM, nN, nwg, G, c;
    __host__ __device__ void init(int M, int N, int G_, int c_) { nM = M / BM; nN = N / BM; nwg = nM * nN; G = G_; c = c_; }
    __host__ __device__ bool next(int i, Unit& u) const {
        const long L = (long)i * G + c; if (L >= nwg) return false;
        int wgid = (int)L; { const int q = nwg / NXCD, r = nwg % NXCD, xcd = wgid % NXCD, off = wgid / NXCD; wgid = (xcd < r ? xcd * (q + 1) : r * (q + 1) + (xcd - r) * q) + off; }
        const int nig = WGM * nN, gid = wgid / nig, fm = gid * WGM, gsz = (nM - fm) < WGM ? (nM - fm) : WGM;
        u.pm = fm + ((wgid % nig) % gsz); u.pn = (wgid % nig) / gsz; return true;
    }
    __device__ __forceinline__ void a_ready(const Unit&) const {}
    __device__ __forceinline__ void done(const Unit&) const {}
};

__device__ __forceinline__ unsigned cvt_pk_bf16(float lo, float hi) { unsigned r; asm volatile("v_cvt_pk_bf16_f32 %0, %1, %2" : "=v"(r) : "v"(lo), "v"(hi)); return r; }
typedef float f32x2 __attribute__((ext_vector_type(2)));
__device__ __forceinline__ f32x2 gelu_pk(f32x2 v) {
    const f32x2 av = __builtin_elementwise_abs(v), d = av * 0.2316418882f + 1.0f;
    f32x2 t; t.x = __builtin_amdgcn_rcpf(d.x); t.y = __builtin_amdgcn_rcpf(d.y);
    f32x2 q = t * 0.5307027145f + (-0.7265760135f); q = q * t + 0.7107068705f; q = q * t + (-0.142248368f); q = q * t + 0.127414796f; q = q * t;
    const f32x2 s = (v * v) * (-0.72134752044f);
    f32x2 e; e.x = __builtin_amdgcn_exp2f(s.x); e.y = __builtin_amdgcn_exp2f(s.y);
    const f32x2 m = v * (q * e), r = v - m;
    f32x2 o; o.x = v.x < 0.f ? m.x : r.x; o.y = v.y < 0.f ? m.y : r.y; return o;
}

template <class Epi, class Sched, bool ALIGN_EPI = false, bool SP2 = false>
__device__ __forceinline__ void gemm_phase(PG8_LAS unsigned char* lds, const Gemm g, const Sched& S, const Epi& E) {
    const int tid = mk_tid(), wid = __builtin_amdgcn_readfirstlane(tid >> 6), lane = tid & 63, wr = wid >> 2, wc = wid & 3, fr = lane & 15, fq = lane >> 4;
    const int K = g.K, nt = K / BK;
    unsigned voffA[2], voffB[2];
#pragma unroll
    for (int i = 0; i < 2; ++i) { int R, C; stage_rc(tid * 16 + i * 8192, R, C); const int Rb = Epi::PERM ? ((R & ~31) + perm32(R & 31)) : R;
        voffA[i] = (unsigned)(R * g.lda + C) * 2u; voffB[i] = (unsigned)(Rb * g.ldb + C) * 2u; }
    const size_t kstep = (size_t)(BK * 2);
    const size_t hstepA = (size_t)HALF * g.lda * 2, hstepB = (size_t)HALF * g.ldb * 2;
    const unsigned ldsw = (unsigned)wid * 1024u;
    const int aoff = lds_byte(wr * 64 + fr, fq * 8), boff = lds_byte(wc * 32 + fr, fq * 8);
#define PG8_SA(b, h) (((b) * 2 + (h)) * HTB)
#define PG8_SB(b, h) ((4 + (b) * 2 + (h)) * HTB)
#define PG8_STAGE(bufoff, gbase, voff) do { _Pragma("unroll") for (int _i = 0; _i < 2; ++_i) \
        __builtin_amdgcn_global_load_lds((const unsigned*)((const char*)(gbase) + (voff)[_i]), (PG8_LAS unsigned*)(lds + (bufoff) + ldsw + _i * 8192), 16, 0, 0); } while (0)
#define PG8_LDA(dst, b, h) do { _Pragma("unroll") for (int m = 0; m < 4; ++m) _Pragma("unroll") for (int k = 0; k < 2; ++k) dst[m][k] = *(const PG8_LAS bf16x8*)(lds + PG8_SA(b, h) + aoff + m * 2048 + k * 1024); } while (0)
#define PG8_LDB(dst, b, h) do { _Pragma("unroll") for (int n = 0; n < 2; ++n) _Pragma("unroll") for (int k = 0; k < 2; ++k) dst[n][k] = *(const PG8_LAS bf16x8*)(lds + PG8_SB(b, h) + boff + n * 2048 + k * 1024); } while (0)
#define PG8_MMA(ai, bj, At, Bt) do { __builtin_amdgcn_s_setprio(1); _Pragma("unroll") for (int m = 0; m < 4; ++m) _Pragma("unroll") for (int n = 0; n < 2; ++n) _Pragma("unroll") for (int k = 0; k < 2; ++k) \
        acc[ai][bj][m][n] = __builtin_amdgcn_mfma_f32_16x16x32_bf16(Bt[n][k], At[m][k], acc[ai][bj][m][n], 0, 0, 0); __builtin_amdgcn_s_setprio(0); } while (0)
#define PG8_WAIT_V(n) asm volatile("s_waitcnt vmcnt(" #n ")" ::: "memory")
#define PG8_WAIT_L(n) asm volatile("s_waitcnt lgkmcnt(" #n ")" ::: "memory")
#define PG8_BAR __builtin_amdgcn_s_barrier()
#define PG8_SCHED __builtin_amdgcn_sched_barrier(0)
    Unit cur, nxt; int ui = 0;
    if (!S.next(0, cur)) return;
    f32x4 acc[2][2][4][2];
#pragma unroll
    for (int a = 0; a < 2; ++a)
#pragma unroll
        for (int b = 0; b < 2; ++b)
#pragma unroll
            for (int m = 0; m < 4; ++m)
#pragma unroll
                for (int n = 0; n < 2; ++n) acc[a][b][m][n] = (f32x4){0.f, 0.f, 0.f, 0.f};
    bf16x8 At[4][2], B0[2][2], B1[2][2];
    const char* cA = S.aptr(cur); const char* cB = S.bptr(cur);
    S.a_ready(cur);
    if constexpr (SP2) {
        PG8_STAGE(PG8_SB(0, 0), cB, voffB); PG8_STAGE(PG8_SB(0, 1), cB + hstepB, voffB); PG8_STAGE(PG8_SA(0, 0), cA, voffA); PG8_STAGE(PG8_SA(0, 1), cA + hstepA, voffA);
        if (wr == 1) PG8_BAR;
        PG8_WAIT_V(2); PG8_BAR;
        PG8_STAGE(PG8_SB(1, 0), cB + kstep, voffB); PG8_STAGE(PG8_SA(1, 0), cA + kstep, voffA); PG8_STAGE(PG8_SB(1, 1), cB + hstepB + kstep, voffB);
        PG8_WAIT_V(6); PG8_BAR;
    } else {
        PG8_STAGE(PG8_SB(0, 0), cB, voffB); PG8_STAGE(PG8_SA(0, 0), cA, voffA); PG8_STAGE(PG8_SB(0, 1), cB + hstepB, voffB); PG8_STAGE(PG8_SA(0, 1), cA + hstepA, voffA);
        if (wr == 1) PG8_BAR;
        PG8_WAIT_V(4); PG8_BAR;
        PG8_STAGE(PG8_SB(1, 0), cB + kstep, voffB); PG8_STAGE(PG8_SA(1, 0), cA + kstep, voffA); PG8_STAGE(PG8_SB(1, 1), cB + hstepB + kstep, voffB);
        PG8_WAIT_V(6); PG8_BAR;
    }
    for (;;) {
        const bool has_next = S.next(ui + 1, nxt);
        const char* nA = has_next ? S.aptr(nxt) : cA; const char* nB = has_next ? S.bptr(nxt) : cB;
        for (int t = 0; t < nt; t += 2) {
            const bool last = (t == nt - 2);
            const char* a1 = cA + (size_t)(t + 1) * kstep;
            const char* a2 = last ? nA : cA + (size_t)(t + 2) * kstep; const char* b2 = last ? nB : cB + (size_t)(t + 2) * kstep;
            const char* a3 = a2 + kstep; const char* b3 = b2 + kstep;
            if (last && has_next) S.a_ready(nxt);
            if constexpr (SP2) {
            PG8_LDB(B0, 0, 0); PG8_LDB(B1, 0, 1); PG8_SCHED; PG8_LDA(At, 0, 0); PG8_STAGE(PG8_SA(1, 1), a1 + hstepA, voffA);
            PG8_WAIT_V(8); PG8_WAIT_L(0); PG8_BAR; PG8_MMA(0, 0, At, B0); PG8_MMA(0, 1, At, B1); PG8_BAR; PG8_SCHED;
            PG8_LDA(At, 0, 1); PG8_STAGE(PG8_SB(0, 0), b2, voffB); PG8_STAGE(PG8_SB(0, 1), b2 + hstepB, voffB); PG8_STAGE(PG8_SA(0, 0), a2, voffA);
            PG8_WAIT_V(8); PG8_WAIT_L(0); PG8_BAR; PG8_MMA(1, 0, At, B0); PG8_MMA(1, 1, At, B1); PG8_BAR; PG8_SCHED;
            PG8_LDB(B0, 1, 0); PG8_LDB(B1, 1, 1); PG8_SCHED; PG8_LDA(At, 1, 0); PG8_STAGE(PG8_SA(0, 1), a2 + hstepA, voffA);
            PG8_WAIT_V(8); PG8_WAIT_L(0); PG8_BAR; PG8_MMA(0, 0, At, B0); PG8_MMA(0, 1, At, B1); PG8_BAR; PG8_SCHED;
            PG8_LDA(At, 1, 1); PG8_STAGE(PG8_SB(1, 0), b3, voffB); PG8_STAGE(PG8_SB(1, 1), b3 + hstepB, voffB); PG8_STAGE(PG8_SA(1, 0), a3, voffA);
            PG8_WAIT_V(8); PG8_WAIT_L(0); PG8_BAR; PG8_MMA(1, 0, At, B0); PG8_MMA(1, 1, At, B1); PG8_BAR; PG8_SCHED;
            } else {
            PG8_LDB(B0, 0, 0); PG8_SCHED; PG8_LDA(At, 0, 0); PG8_STAGE(PG8_SA(1, 1), a1 + hstepA, voffA);
            PG8_WAIT_L(8); PG8_BAR; PG8_WAIT_L(0); PG8_MMA(0, 0, At, B0); PG8_BAR; PG8_SCHED;
            PG8_LDB(B1, 0, 1); PG8_STAGE(PG8_SB(0, 0), b2, voffB);
            PG8_BAR; PG8_WAIT_L(0); PG8_MMA(0, 1, At, B1); PG8_BAR;
            PG8_LDA(At, 0, 1); PG8_STAGE(PG8_SA(0, 0), a2, voffA);
            PG8_BAR; PG8_WAIT_L(0); PG8_MMA(1, 0, At, B0); PG8_BAR; PG8_SCHED;
            PG8_STAGE(PG8_SB(0, 1), b2 + hstepB, voffB);
            PG8_WAIT_V(6); PG8_BAR; PG8_MMA(1, 1, At, B1); PG8_BAR;
            PG8_LDB(B0, 1, 0); PG8_SCHED; PG8_LDA(At, 1, 0); PG8_STAGE(PG8_SA(0, 1), a2 + hstepA, voffA);
            PG8_WAIT_L(8); PG8_BAR; PG8_WAIT_L(0); PG8_MMA(0, 0, At, B0); PG8_BAR; PG8_SCHED;
            PG8_LDB(B1, 1, 1); PG8_STAGE(PG8_SB(1, 0), b3, voffB);
            PG8_BAR; PG8_WAIT_L(0); PG8_MMA(0, 1, At, B1); PG8_BAR;
            PG8_LDA(At, 1, 1); PG8_STAGE(PG8_SA(1, 0), a3, voffA);
            PG8_BAR; PG8_WAIT_L(0); PG8_MMA(1, 0, At, B0); PG8_BAR; PG8_SCHED;
            PG8_STAGE(PG8_SB(1, 1), b3 + hstepB, voffB);
            PG8_WAIT_V(6); PG8_BAR; PG8_MMA(1, 1, At, B1); PG8_BAR;
            }
        }
        if constexpr (ALIGN_EPI) { if (wr == 0) PG8_BAR; }
        if constexpr (!Epi::AFTER_DRAIN) { int fr_ = fr, fq_ = fq; asm volatile("" : "+v"(fr_), "+v"(fq_));   E(acc, cur, wr, wc, fr_, fq_); S.done(cur); }
        if (!has_next) break;
#pragma unroll
        for (int a = 0; a < 2; ++a)
#pragma unroll
            for (int b = 0; b < 2; ++b)
#pragma unroll
                for (int m = 0; m < 4; ++m)
#pragma unroll
                    for (int n = 0; n < 2; ++n) acc[a][b][m][n] = (f32x4){0.f, 0.f, 0.f, 0.f};
        cur = nxt; cA = nA; cB = nB; ++ui;
        if constexpr (ALIGN_EPI) { if (wr == 1) PG8_BAR; }
    }
    PG8_WAIT_V(0);
    if constexpr (!ALIGN_EPI) { if (wr == 0) PG8_BAR; }
    PG8_BAR;
    if constexpr (Epi::AFTER_DRAIN) { E.fused(acc, cur, wr, wc, fr, fq, lds, wid, lane); S.done(cur); }
#undef PG8_SA
#undef PG8_SB
#undef PG8_STAGE
#undef PG8_LDA
#undef PG8_LDB
#undef PG8_MMA
#undef PG8_WAIT_V
#undef PG8_WAIT_L
#undef PG8_BAR
#undef PG8_SCHED
}
}
#include <hip/hip_bf16.h>
#include <cmath>
namespace attn_body {
using bf16=__hip_bfloat16;
using bf16x8=__attribute__((ext_vector_type(8)))short;
using s16x4=__attribute__((ext_vector_type(4)))short;
using f32x16=__attribute__((ext_vector_type(16)))float;
using u32x4=__attribute__((ext_vector_type(4)))unsigned;
constexpr int BATCH=2,NHEAD=16,SEQ=8192,D=64,DM=NHEAD*D;
constexpr int NW=8,QBLK=32,QB=QBLK*NW,KVBLK=64,NQB=SEQ/QB;
constexpr int ATTN_PITCH=DM, ATTN_UNIT_ROWS=QB;
__device__ __forceinline__ int crow(int r,int hi){return (r&3)+8*(r>>2)+4*hi;}
#define SBAR() __builtin_amdgcn_sched_barrier(0)
__device__ __forceinline__ void cmask(f32x16&p0,f32x16&p1,int jb,int qrel,int hi){
  const float NEG=-INFINITY; int kb=64*jb+4*hi;
  #pragma unroll
  for(int r=0;r<16;++r){int kv=kb+(r&3)+8*(r>>2); if(kv>qrel)p0[r]=NEG; if(kv+32>qrel)p1[r]=NEG;}
}

constexpr int NSLOT=3, SLOTB=8192;
constexpr int LDS_K=0, LDS_V=NSLOT*SLOTB, LDS_WS=2*NSLOT*SLOTB, LDS_OST=LDS_WS+NW*64*4, LDS_BYTES=LDS_OST+NW*4096;
constexpr int BIAS_OFF=86016;
constexpr float C2=0.125f*1.4426950408889634f;
__device__ __forceinline__ void glds16(const void*gsrc,unsigned lds_dst){unsigned keep;
  asm volatile("s_mov_b32 %0, m0\n\ts_mov_b32 m0, %2\n\ts_nop 0\n\tglobal_load_lds_dwordx4 %1, off\n\ts_mov_b32 m0, %0":"=&s"(keep):"v"(gsrc),"s"(lds_dst):"memory");}
__device__ __forceinline__ float max3f(float a,float b,float c){float r;asm("v_max3_f32 %0, %1, %2, %3":"=v"(r):"v"(a),"v"(b),"v"(c));return r;}
__device__ __forceinline__ float max2f(float a,float b){float r;asm("v_max_f32_e32 %0, %1, %2":"=v"(r):"v"(a),"v"(b));return r;}
__device__ __forceinline__ float fadd_s(float a,float b){float r;asm("v_add_f32_e32 %0, %1, %2":"=v"(r):"v"(a),"v"(b));return r;}
__device__ __forceinline__ float fsub_s(float a,float b){float r;asm("v_sub_f32_e32 %0, %1, %2":"=v"(r):"v"(a),"v"(b));return r;}
typedef float f32x2_t __attribute__((ext_vector_type(2))); typedef __bf16 bf16x2_t __attribute__((ext_vector_type(2)));
__device__ __forceinline__ unsigned cvtpk_s(float lo,float hi){f32x2_t v={lo,hi};bf16x2_t b=__builtin_convertvector(v,bf16x2_t);return __builtin_bit_cast(unsigned,b);}
#define WAIT_BAR(N) asm volatile("s_waitcnt vmcnt(" #N ") lgkmcnt(0)\n\ts_barrier":::"memory")

__device__ __forceinline__ void qkt(f32x16&p0,f32x16&p1,const char*Kslot,const bf16x8*qr,const f32x16&negm,int r32,int hi){
  const char*kb=Kslot+hi*1024+r32*16;
  #pragma unroll
  for(int d0=0;d0<4;++d0){
    const bf16x8 b0=*reinterpret_cast<const bf16x8*>(kb+d0*2048);
    const bf16x8 b1=*reinterpret_cast<const bf16x8*>(kb+d0*2048+512);
    if(d0==0){p0=__builtin_amdgcn_mfma_f32_32x32x16_bf16(b0,qr[0],negm,0,0,0);p1=__builtin_amdgcn_mfma_f32_32x32x16_bf16(b1,qr[0],negm,0,0,0);}
    else{p0=__builtin_amdgcn_mfma_f32_32x32x16_bf16(b0,qr[d0],p0,0,0,0);p1=__builtin_amdgcn_mfma_f32_32x32x16_bf16(b1,qr[d0],p1,0,0,0);}}
}
typedef __attribute__((address_space(3))) const char* lds_cptr;
typedef short v4i16_t __attribute__((ext_vector_type(4)));
__device__ __forceinline__ void kload8(bf16x8*kf,lds_cptr kp){
  kf[0]=*(const __attribute__((address_space(3))) bf16x8*)(kp);      kf[1]=*(const __attribute__((address_space(3))) bf16x8*)(kp+512);
  kf[2]=*(const __attribute__((address_space(3))) bf16x8*)(kp+2048); kf[3]=*(const __attribute__((address_space(3))) bf16x8*)(kp+2560);
  kf[4]=*(const __attribute__((address_space(3))) bf16x8*)(kp+4096); kf[5]=*(const __attribute__((address_space(3))) bf16x8*)(kp+4608);
  kf[6]=*(const __attribute__((address_space(3))) bf16x8*)(kp+6144); kf[7]=*(const __attribute__((address_space(3))) bf16x8*)(kp+6656);
}
__device__ __forceinline__ void kload2(bf16x8*kf,lds_cptr kp,int j){ kf[2*j]=*(const __attribute__((address_space(3))) bf16x8*)(kp+j*2048); kf[2*j+1]=*(const __attribute__((address_space(3))) bf16x8*)(kp+j*2048+512); }
__device__ __forceinline__ s16x4 vtr(lds_cptr p){ return __builtin_bit_cast(s16x4,__builtin_amdgcn_ds_read_tr16_b64_v4i16((__attribute__((address_space(3))) v4i16_t*)p)); }
__device__ __forceinline__ float rowmax(const f32x16&p0,const f32x16&p1){
  float a=max3f(p0[0],p0[1],p1[0]),b=max3f(p0[2],p0[3],p1[1]);a=max3f(a,p1[2],p1[3]);
  #pragma unroll
  for(int r=4;r<16;r+=4){a=max3f(a,p0[r],p0[r+1]);b=max3f(b,p0[r+2],p0[r+3]);a=max3f(a,p1[r],p1[r+1]);b=max3f(b,p1[r+2],p1[r+3]);}
  const float m=max2f(a,b);
  auto rr=__builtin_amdgcn_permlane32_swap(__float_as_uint(m),__float_as_uint(m),false,false);
  return max2f(__uint_as_float(rr[0]),__uint_as_float(rr[1]));
}
__device__ __forceinline__ void pv(f32x16*o,int vb,bf16x8 pa0,bf16x8 pa1,bf16x8 pa2,bf16x8 pa3){
  #pragma unroll
  for(int d0=0;d0<2;++d0){s16x4 lo[4],hi[4];
    #pragma unroll
    for(int ks=0;ks<4;++ks){
      asm volatile("ds_read_b64_tr_b16 %0,%1 offset:%c2":"=&v"(lo[ks]):"v"(vb),"i"(d0*4096+ks*1024):"memory");
      asm volatile("ds_read_b64_tr_b16 %0,%1 offset:%c2":"=&v"(hi[ks]):"v"(vb),"i"(d0*4096+ks*1024+512):"memory");}
    asm volatile("s_waitcnt lgkmcnt(0)":::"memory");SBAR();
    #define PK(k) (bf16x8){lo[k][0],lo[k][1],lo[k][2],lo[k][3],hi[k][0],hi[k][1],hi[k][2],hi[k][3]}
    o[d0]=__builtin_amdgcn_mfma_f32_32x32x16_bf16(pa0,PK(0),o[d0],0,0,0);
    o[d0]=__builtin_amdgcn_mfma_f32_32x32x16_bf16(pa1,PK(1),o[d0],0,0,0);
    o[d0]=__builtin_amdgcn_mfma_f32_32x32x16_bf16(pa2,PK(2),o[d0],0,0,0);
    o[d0]=__builtin_amdgcn_mfma_f32_32x32x16_bf16(pa3,PK(3),o[d0],0,0,0);
    #undef PK
  }
}

#ifndef ATTN_STORE16
#define ATTN_STORE16(p,v) (*(u32x4*)(p)=(v))
#endif
template<int THRL> __device__ __forceinline__ void attn_unit(int b,int h,int qb,const bf16*Q,const bf16*__restrict__ K,const bf16*__restrict__ V,bf16*O,const float*__restrict__ FBrow,char*shm){
  const int tid=mk_tid(),lane=tid&63,r32=lane&31,hi=lane>>5; const int wid=__builtin_amdgcn_readfirstlane(tid>>6);
  const long rowbase=(long)b*SEQ; const int q0=qb*QB;
  const bf16*Qw=Q+(rowbase+q0+wid*QBLK)*DM+h*D;
  const bf16*Kh=K+rowbase*DM+h*D,*Vh=V+rowbase*DM+h*D;
  const lds_cptr shm3=(lds_cptr)shm;
  const unsigned lds0=(unsigned)(uintptr_t)shm;
  float*wsf=(float*)(shm+LDS_WS)+wid*64;
  const bf16*ksrc=Kh+(long)lane*DM+wid*8;
  const bf16*vsrc=Vh+(long)(16*(wid&3)+(lane>>2))*DM+(wid>>2)*32+(lane&3)*8;
  const unsigned kdst=lds0+LDS_K+wid*1024, vdst=lds0+LDS_V+wid*1024;
  #define DMA_K(t,slot) glds16(ksrc+(long)(t)*KVBLK*DM,(unsigned)__builtin_amdgcn_readfirstlane(kdst+(slot)))
  #define DMA_V(t,slot) glds16(vsrc+(long)(t)*KVBLK*DM,(unsigned)__builtin_amdgcn_readfirstlane(vdst+(slot)))
  const int vb0=(int)(lds0+LDS_V)+((lane>>4)&1)*32+(lane&3)*8+(4*hi+((lane&15)>>2))*64;
  const char*Kbase=shm+LDS_K; bf16x8 kf[8];
  const lds_cptr kp0=shm3+LDS_K+hi*1024+r32*16; const lds_cptr vp0=shm3+LDS_V+((lane>>4)&1)*32+(lane&3)*8+(4*hi+((lane&15)>>2))*64;
  const int NT=(q0+QB)/KVBLK;
  {
    typedef __attribute__((address_space(3))) float lds_f32; lds_f32* bl=(lds_f32*)(shm3+BIAS_OFF);
    const int nb=q0+QB; const float Fl=FBrow[nb-1];
    for(int i=tid;i<nb;i+=NW*64) bl[i]=(Fl-FBrow[i])*1.4426950408889634f;
    asm volatile("s_waitcnt vmcnt(0) lgkmcnt(0)\n\ts_barrier":::"memory"); }
  typedef float f32x4v __attribute__((ext_vector_type(4)));
  #define BIAS(P0,P1,t) do{ const __attribute__((address_space(3))) f32x4v* bp_=(const __attribute__((address_space(3))) f32x4v*)(shm3+BIAS_OFF)+(t)*16+hi; \
    _Pragma("unroll") for(int g_=0;g_<4;++g_){ const f32x4v f0_=bp_[2*g_]+nm, f1_=bp_[8+2*g_]+nm; \
      P0[4*g_]+=f0_[0];P0[4*g_+1]+=f0_[1];P0[4*g_+2]+=f0_[2];P0[4*g_+3]+=f0_[3]; P1[4*g_]+=f1_[0];P1[4*g_+1]+=f1_[1];P1[4*g_+2]+=f1_[2];P1[4*g_+3]+=f1_[3]; } }while(0)
  DMA_K(0,0);DMA_V(0,0);DMA_K(1,SLOTB);
  bf16x8 qr[4];
  #pragma unroll
  for(int d0=0;d0<4;++d0)qr[d0]=*reinterpret_cast<const bf16x8*>(&Qw[(long)r32*DM+d0*16+hi*8]);
  float mhat=0.f,l_reg=0.f;f32x16 o[2];o[0]=f32x16{};o[1]=f32x16{};const f32x16 negm=f32x16{}; float nm=0.f;
  const int qrel=wid*QBLK+r32;
  #define CMASK(P0,P1,t) do{int jb_=(t)-(NT-4); if(jb_>=0)cmask(P0,P1,jb_,qrel,hi);}while(0)
  bool resc=false;
  #define START(P0,P1) do{ const float rm=rowmax(P0,P1); resc=false; \
    { const float dl=rm; mhat=fadd_s(mhat,dl); \
      _Pragma("unroll") for(int r=0;r<16;++r){P0[r]=fsub_s(P0[r],dl);P1[r]=fsub_s(P1[r],dl);} \
      nm=-mhat; } \
    _Pragma("unroll") for(int r=0;r<16;++r)P0[r]=__builtin_amdgcn_exp2f(P0[r]); }while(0)
  #define RESC() do{ if(resc){ asm volatile("s_waitcnt lgkmcnt(0)":::"memory"); \
      _Pragma("unroll") for(int d_=0;d_<2;++d_) _Pragma("unroll") for(int r=0;r<16;++r)o[d_][r]*=wsf[crow(r,hi)]; } }while(0)
  f32x16 pA0,pA1,pB0,pB1;
  int sl_prev=0,sl_cur=0,sl_next=SLOTB;
  #define ROT() do{sl_prev=sl_cur;sl_cur=sl_next;sl_next=(sl_next==(NSLOT-1)*SLOTB)?0:sl_next+SLOTB;}while(0)
  DMA_K(2,2*SLOTB);
  WAIT_BAR(3);
  qkt(pA0,pA1,Kbase,qr,negm,r32,hi);asm volatile("s_nop 15\n\ts_nop 7":"+v"(pA0),"+v"(pA1));BIAS(pA0,pA1,0);CMASK(pA0,pA1,0);
  START(pA0,pA1);
  _Pragma("unroll") for(int r=0;r<16;++r)pA1[r]=__builtin_amdgcn_exp2f(pA1[r]);
  WAIT_BAR(0);
  DMA_K(3,0);DMA_V(1,SLOTB);
  ROT();
  kload8(kf,kp0+sl_cur);
  WAIT_BAR(2);
  s16x4 vlo[8],vhi[8]; u32x4 pw0,pw1,pw2,pw3;
  #define PKW(P,B) cvtpk_s(P[B],P[B+1])
  #define PAF(k) __builtin_bit_cast(bf16x8,pw##k)
  #define VFR(i) (bf16x8){vlo[i][0],vlo[i][1],vlo[i][2],vlo[i][3],vhi[i][0],vhi[i][1],vhi[i][2],vhi[i][3]}
  #define PIN(x) asm volatile("":"+v"(x))
  #define MX3(a,b,c) __builtin_fmaxf(__builtin_fmaxf((a),(b)),(c))
  #define GAPA(MF,A0,A1,A2,A3,W0,W1,PW) do{ MF; sacc+=A0; sacc+=A1; sacc+=A2; sacc+=A3; PIN(sacc); W0; W1; PIN(PW); SBAR(); }while(0)
  #define EX(v) __builtin_amdgcn_exp2f(v)
  #define GAPB(MF,X,B) do{ MF; X[B]=EX(X[B]); X[B+1]=EX(X[B+1]); X[B+2]=EX(X[B+2]); X[B+3]=EX(X[B+3]); PIN(X); SBAR(); }while(0)
  #define VRD(i) do{ vlo[i]=vtr(vp_+(((i)>>2)*4096+((i)&3)*1024)); vhi[i]=vtr(vp_+(((i)>>2)*4096+((i)&3)*1024+512)); }while(0)
  #define KRD(G,j) do{ if(G){ kload2(kf,kp0+sl_next,j); SBAR(); } }while(0)
  #define STEP(C0,C1,P0,P1,t,GK,GV,GL) do{ SBAR(); \
    const lds_cptr vp_=vp0+sl_prev; \
    VRD(0); SBAR(); float sacc=(P0[0]+P0[1]); \
    GAPA(C0=__builtin_amdgcn_mfma_f32_32x32x16_bf16(kf[0],qr[0],negm,0,0,0), P0[2],P0[3],P0[4],P0[5],     pw0[0]=PKW(P0,0), pw0[1]=PKW(P0,2), pw0); \
    VRD(4); SBAR(); GAPA(C1=__builtin_amdgcn_mfma_f32_32x32x16_bf16(kf[1],qr[0],negm,0,0,0), P0[6],P0[7],P0[8],P0[9],     pw0[2]=PKW(P0,4), pw0[3]=PKW(P0,6), pw0); \
    VRD(1); SBAR(); GAPA(C0=__builtin_amdgcn_mfma_f32_32x32x16_bf16(kf[2],qr[1],C0,0,0,0),   P0[10],P0[11],P0[12],P0[13], pw1[0]=PKW(P0,8), pw1[1]=PKW(P0,10), pw1); \
    VRD(5); SBAR(); GAPA(C1=__builtin_amdgcn_mfma_f32_32x32x16_bf16(kf[3],qr[1],C1,0,0,0),   P0[14],P0[15],P1[0],P1[1],   pw1[2]=PKW(P0,12),pw1[3]=PKW(P0,14), pw1); \
    VRD(2); SBAR(); GAPA(C0=__builtin_amdgcn_mfma_f32_32x32x16_bf16(kf[4],qr[2],C0,0,0,0),   P1[2],P1[3],P1[4],P1[5],     pw2[0]=PKW(P1,0), pw2[1]=PKW(P1,2), pw2); \
    VRD(6); SBAR(); GAPA(C1=__builtin_amdgcn_mfma_f32_32x32x16_bf16(kf[5],qr[2],C1,0,0,0),   P1[6],P1[7],P1[8],P1[9],     pw2[2]=PKW(P1,4), pw2[3]=PKW(P1,6), pw2); \
    VRD(3); SBAR(); GAPA(C0=__builtin_amdgcn_mfma_f32_32x32x16_bf16(kf[6],qr[3],C0,0,0,0),   P1[10],P1[11],P1[12],P1[13], pw3[0]=PKW(P1,8), pw3[1]=PKW(P1,10), pw3); \
    VRD(7); SBAR(); GAPA(C1=__builtin_amdgcn_mfma_f32_32x32x16_bf16(kf[7],qr[3],C1,0,0,0),   P1[14],P1[15],0.f,0.f,       pw3[2]=PKW(P1,12),pw3[3]=PKW(P1,14), pw3); \
    l_reg+=sacc; \
    if(GK){DMA_K((t)+3,sl_cur);} if(GV){DMA_V((t)+1,sl_next);} \
    BIAS(C0,C1,t); CMASK(C0,C1,t); \
    { float a=MX3(C0[0],C0[1],C1[0]),b=MX3(C0[2],C0[3],C1[1]); a=MX3(a,C1[2],C1[3]); \
      _Pragma("unroll") for(int r=4;r<16;r+=4){a=MX3(a,C0[r],C0[r+1]);b=MX3(b,C0[r+2],C0[r+3]);a=MX3(a,C1[r],C1[r+1]);b=MX3(b,C1[r+2],C1[r+3]);} \
      float rm=__builtin_fmaxf(a,b); { auto rr=__builtin_amdgcn_permlane32_swap(__float_as_uint(rm),__float_as_uint(rm),false,false); rm=__builtin_fmaxf(__uint_as_float(rr[0]),__uint_as_float(rr[1])); } \
      resc=false; \
      if(__builtin_expect(__any(rm>(float)THRL),0)){ const float dl=__builtin_fmaxf(rm,0.f); mhat+=dl; \
        _Pragma("unroll") for(int r=0;r<16;++r){C0[r]-=dl;C1[r]-=dl;} \
        nm=-mhat; \
        const float f=__builtin_amdgcn_exp2f(-dl); l_reg*=f; if(hi==0)wsf[r32]=f; resc=true; } } \
    SBAR(); \
    GAPB(o[0]=__builtin_amdgcn_mfma_f32_32x32x16_bf16(PAF(0),VFR(0),o[0],0,0,0), C0,0); \
    GAPB(o[1]=__builtin_amdgcn_mfma_f32_32x32x16_bf16(PAF(0),VFR(4),o[1],0,0,0), C0,4); \
    KRD(GL,0); GAPB(o[0]=__builtin_amdgcn_mfma_f32_32x32x16_bf16(PAF(1),VFR(1),o[0],0,0,0), C0,8); \
    KRD(GL,1); GAPB(o[1]=__builtin_amdgcn_mfma_f32_32x32x16_bf16(PAF(1),VFR(5),o[1],0,0,0), C0,12); \
    KRD(GL,2); GAPB(o[0]=__builtin_amdgcn_mfma_f32_32x32x16_bf16(PAF(2),VFR(2),o[0],0,0,0), C1,0); \
    KRD(GL,3); GAPB(o[1]=__builtin_amdgcn_mfma_f32_32x32x16_bf16(PAF(2),VFR(6),o[1],0,0,0), C1,4); \
    GAPB(o[0]=__builtin_amdgcn_mfma_f32_32x32x16_bf16(PAF(3),VFR(3),o[0],0,0,0), C1,8); \
    GAPB(o[1]=__builtin_amdgcn_mfma_f32_32x32x16_bf16(PAF(3),VFR(7),o[1],0,0,0), C1,12); \
    }while(0)
  int t=1;
  #undef CMASK
  #define CMASK(P0,P1,t) do{}while(0)
  for(;t+5<NT;t+=2){
    STEP(pB0,pB1,pA0,pA1,t,true,true,true);     WAIT_BAR(2); RESC(); ROT();
    STEP(pA0,pA1,pB0,pB1,t+1,true,true,true);   WAIT_BAR(2); RESC(); ROT();
  }
  #undef CMASK
  #define CMASK(P0,P1,t) do{int jb_=(t)-(NT-4); if(jb_>=0)cmask(P0,P1,jb_,qrel,hi);}while(0)
  #define ENDW(tt) do{ if((tt)+3<NT){WAIT_BAR(2);} else if((tt)+2<NT){WAIT_BAR(1);} else {WAIT_BAR(0);} }while(0)
  for(;t+1<NT;t+=2){
    STEP(pB0,pB1,pA0,pA1,t,(t+3<NT),(t+1<NT),(t+1<NT));       ENDW(t);   RESC(); ROT();
    STEP(pA0,pA1,pB0,pB1,t+1,(t+4<NT),(t+2<NT),(t+2<NT));     ENDW(t+1); RESC(); ROT();
  }
  STEP(pB0,pB1,pA0,pA1,NT-1,false,false,false); RESC();
  { float sacc=pB0[0]+pB0[1]; _Pragma("unroll") for(int r=2;r<16;++r)sacc+=pB0[r]; _Pragma("unroll") for(int r=0;r<16;++r)sacc+=pB1[r]; l_reg+=sacc;
    pw0=(u32x4){PKW(pB0,0),PKW(pB0,2),PKW(pB0,4),PKW(pB0,6)};pw1=(u32x4){PKW(pB0,8),PKW(pB0,10),PKW(pB0,12),PKW(pB0,14)};pw2=(u32x4){PKW(pB1,0),PKW(pB1,2),PKW(pB1,4),PKW(pB1,6)};pw3=(u32x4){PKW(pB1,8),PKW(pB1,10),PKW(pB1,12),PKW(pB1,14)};
    SBAR(); pv(o,vb0+sl_cur,PAF(0),PAF(1),PAF(2),PAF(3)); }
  #undef PKW
  #undef PAF
  #undef VFR
  #undef PIN
  #undef MX3
  #undef GAPA
  #undef GAPB
  #undef EX
  #undef VRD
  #undef KRD
  #undef STEP
  #undef ENDW
  {auto rr=__builtin_amdgcn_permlane32_swap(__float_as_uint(l_reg),__float_as_uint(l_reg),false,false);l_reg=__uint_as_float(rr[0])+__uint_as_float(rr[1]);}
  if(hi==0)wsf[32+r32]=l_reg;asm volatile("s_waitcnt lgkmcnt(0)":::"memory");
  float rli[16];
  #pragma unroll
  for(int r=0;r<16;++r)rli[r]=__builtin_amdgcn_rcpf(wsf[32+crow(r,hi)]);
  bf16*Ow=O+(rowbase+q0+wid*QBLK)*DM+h*D;
  { bf16*stg=(bf16*)(shm+LDS_OST)+wid*2048;
    #pragma unroll
    for(int r=0;r<16;++r){const int orow=crow(r,hi);
      #pragma unroll
      for(int d0=0;d0<2;++d0)stg[orow*64+d0*32+r32]=__float2bfloat16(o[d0][r]*rli[r]);}
    asm volatile("s_waitcnt lgkmcnt(0)":::"memory");
    #pragma unroll
    for(int i=0;i<4;++i){const int row=i*8+(lane>>3),ch=lane&7; const u32x4 v=*(const u32x4*)(stg+row*64+ch*8); ATTN_STORE16(Ow+(long)row*DM+ch*8,v);} }
  asm volatile("s_waitcnt lgkmcnt(0)\n\ts_barrier":::"memory");
  #undef BIAS
  #undef DMA_K
  #undef DMA_V
  #undef CMASK
  #undef START
  #undef RESC
  #undef ROT
}
constexpr int ATTN_LDS_BYTES=86016+32768;
struct AttnTensors { const bf16* Q; const bf16* K; const bf16* V; bf16* O; const float* FB; };
struct AttnUnit { int bh; int qb; };
struct StaticOrder {
  int vcu;
  __device__ __forceinline__ explicit StaticOrder(int grid,int block):vcu((block%8)*(grid/8)+block/8){}
  __device__ __forceinline__ bool next(int i,AttnUnit&u)const{ if(i>=4)return false; const int s=vcu&7; u.bh=vcu>>3; u.qb=(i==0)?s:(i==1)?15-s:(i==2)?16+s:31-s; return true; }
  __device__ __forceinline__ void a_ready(const AttnUnit&)const{}
  __device__ __forceinline__ void done(const AttnUnit&)const{}
};
template<class Sched,int THRL=8> __device__ __forceinline__ void attn_phase(char*lds,const AttnTensors&T,const Sched&S){
  AttnUnit u;
  for(int i=0;S.next(i,u);++i){ S.a_ready(u); attn_unit<THRL>(u.bh/NHEAD,u.bh%NHEAD,u.qb,T.Q,T.K,T.V,T.O,T.FB+(size_t)u.bh*SEQ,lds); S.done(u); }
}
#undef SBAR
#undef WAIT_BAR
}
namespace cg = cooperative_groups;
#define LAS __attribute__((address_space(3)))
#define LDS_WAIT() asm volatile("s_waitcnt lgkmcnt(0)" ::: "memory")
constexpr int MEGA_THREADS = 512, MEGA_LDS = 147456, NWV = 8;
constexpr size_t WT_IN = 0;
constexpr size_t WT_BR = WT_IN + (size_t)13312 * 1024 * 2;
constexpr size_t WT_OUT = WT_BR + (size_t)4096 * 1024 * 2;
constexpr size_t WT_UP = WT_OUT + (size_t)1024 * 4096 * 2;
constexpr size_t WT_DN = WT_UP + (size_t)5632 * 1024 * 2;
static_assert(WT_DN + (size_t)1024 * 2816 * 2 <= 72 * MiB, "weight copies");
constexpr size_t WS_WKVT = WS_GATES;
constexpr size_t WS_CB = WS_CTL + 4096;

typedef float f32x4 __attribute__((ext_vector_type(4)));
typedef unsigned u32x4 __attribute__((ext_vector_type(4)));
typedef short bf16x8_t __attribute__((ext_vector_type(8)));
typedef float f32x16_t __attribute__((ext_vector_type(16)));
__device__ __forceinline__ unsigned pk2(float lo, float hi) { return (unsigned)f2bf(lo) | ((unsigned)f2bf(hi) << 16); }
__device__ __forceinline__ float blo(unsigned u) { return __uint_as_float(u << 16); }
__device__ __forceinline__ float bhi(unsigned u) { return __uint_as_float(u & 0xffff0000u); }
__device__ __forceinline__ float fast_softplus(float x) { return fmaxf(x, 0.f) + __logf(1.f + __expf(-fabsf(x))); }
__device__ __forceinline__ float fast_sigmoid(float x) { return __builtin_amdgcn_rcpf(1.f + __expf(-x)); }
__device__ __forceinline__ float fast_tanh(float x) { const float e = __expf(-2.f * fabsf(x)); const float t = (1.f - e) * __builtin_amdgcn_rcpf(1.f + e); return x < 0.f ? -t : t; }
__device__ __forceinline__ float fast_gelu(float x) { const float u = 0.7978845608028654f * (x + 0.044715f * x * x * x); return 0.5f * x * (1.f + fast_tanh(u)); }

template <class Loc> struct LocOrder {
    pg8::StaticOrder so; Loc loc;
    __device__ __forceinline__ bool next(int i, pg8::Unit& u) const { return so.next(i, u); }
    __device__ __forceinline__ const char* aptr(const pg8::Unit& u) const { return loc.a(u); }
    __device__ __forceinline__ const char* bptr(const pg8::Unit& u) const { return loc.b(u); }
    __device__ __forceinline__ void a_ready(const pg8::Unit&) const {}
    __device__ __forceinline__ void done(const pg8::Unit&) const {}
};
struct LocStd { const char* A; const char* Bt; size_t astep, bstep;
    __device__ __forceinline__ const char* a(const pg8::Unit& u) const { return A + (size_t)u.pm * astep; }
    __device__ __forceinline__ const char* b(const pg8::Unit& u) const { return Bt + (size_t)u.pn * bstep; } };
struct LocBranch { const char* Y0; const char* Y1; const char* Y2; const char* Y3; const char* Bt;
    __device__ __forceinline__ const char* a(const pg8::Unit& u) const { const int i = u.pn >> 2; const char* y = i == 0 ? Y0 : i == 1 ? Y1 : i == 2 ? Y2 : Y3; return y + (size_t)u.pm * (256 * 1024 * 2); }
    __device__ __forceinline__ const char* b(const pg8::Unit& u) const { return Bt + (size_t)u.pn * (256 * 1024 * 2); } };
struct LocMemKV { const char* A; const char* Bt;
    __device__ __forceinline__ const char* a(const pg8::Unit& u) const { return A + (size_t)u.pm * (256 * 1024 * 2); }
    __device__ __forceinline__ const char* b(const pg8::Unit& u) const { return Bt + ((size_t)(u.pm >> 1) * 2048 + (size_t)u.pn * 256) * 2048; } };
struct LocMemS { const char* MQ; const char* MK;
    __device__ __forceinline__ const char* a(const pg8::Unit& u) const { return MQ + (size_t)u.pm * (256 * 2048) + u.pn * 512; }
    __device__ __forceinline__ const char* b(const pg8::Unit& u) const { return MK + (size_t)(u.pm >> 5) * (256 * 2048) + u.pn * 512; } };
struct LocMemPV { const char* E; const char* MVT;
    __device__ __forceinline__ const char* a(const pg8::Unit& u) const { return E + (size_t)u.pm * (256 * 2048) + u.pn * 512; }
    __device__ __forceinline__ const char* b(const pg8::Unit& u) const { return MVT + ((size_t)(u.pm >> 5) * 4 + u.pn) * (256 * 256 * 2); } };

typedef f32x4 AccT[2][2][4][2];
struct EpiProj { static constexpr bool PERM = true, AFTER_DRAIN = false; bf16_t* proj; bf16_t* gates; float* mqss;
    __device__ __forceinline__ void operator()(const AccT& acc, const pg8::Unit& u, int wr, int wc, int fr, int fq) const {
        int colt = u.pn * 256; const int grp = colt >> 10; bf16_t* base; int ldc;
        if (grp < 9) { base = proj + (size_t)grp * T * DM; ldc = DM; colt &= 1023; } else { base = gates; ldc = 4096; colt -= 9216; }
        const int row0 = u.pm * 256 + wr * 64 + fr, col0 = colt + wc * 32 + 8 * fq;
#pragma unroll
        for (int ai = 0; ai < 2; ++ai)
#pragma unroll
            for (int m = 0; m < 4; ++m) { const int row = row0 + ai * 128 + m * 16; bf16_t* rowp = base + (size_t)row * ldc + col0; float ss = 0.f;
#pragma unroll
                for (int bj = 0; bj < 2; ++bj) { const f32x4 v0 = acc[ai][bj][m][0], v1 = acc[ai][bj][m][1]; u32x4 w; w.x = pk2(v0[0], v0[1]); w.y = pk2(v0[2], v0[3]); w.z = pk2(v1[0], v1[1]); w.w = pk2(v1[2], v1[3]);
                    *(u32x4*)(rowp + bj * 128) = w;
                    if (grp == 8) { ss += blo(w.x) * blo(w.x) + bhi(w.x) * bhi(w.x) + blo(w.y) * blo(w.y) + bhi(w.y) * bhi(w.y) + blo(w.z) * blo(w.z) + bhi(w.z) * bhi(w.z) + blo(w.w) * blo(w.w) + bhi(w.w) * bhi(w.w); } }
                if (grp == 8) { ss += __shfl_xor(ss, 16); ss += __shfl_xor(ss, 32); if (fq == 0) mqss[(size_t)row * 16 + (colt >> 8) * 4 + wc] = ss; } }
    } };
struct EpiBf16P { static constexpr bool PERM = true, AFTER_DRAIN = false; bf16_t* O; int ldc; int pad;
    __device__ __forceinline__ void operator()(const AccT& acc, const pg8::Unit& u, int wr, int wc, int fr, int fq) const {
        const int row0 = u.pm * 256 + wr * 64 + fr, col0 = u.pn * 256 + wc * 32 + 8 * fq;
#pragma unroll
        for (int ai = 0; ai < 2; ++ai)
#pragma unroll
            for (int m = 0; m < 4; ++m) { bf16_t* rowp = O + (size_t)(row0 + ai * 128 + m * 16) * ldc + col0;
#pragma unroll
                for (int bj = 0; bj < 2; ++bj) { const f32x4 v0 = acc[ai][bj][m][0], v1 = acc[ai][bj][m][1]; u32x4 w; w.x = pk2(v0[0], v0[1]); w.y = pk2(v0[2], v0[3]); w.z = pk2(v1[0], v1[1]); w.w = pk2(v1[2], v1[3]);
                    *(u32x4*)(rowp + bj * 128) = w; } }
    } };
struct EpiF32 { static constexpr bool PERM = false, AFTER_DRAIN = false; float* O; int ldc; int pad;
    __device__ __forceinline__ void operator()(const AccT& acc, const pg8::Unit& u, int wr, int wc, int fr, int fq) const {
        const int row0 = u.pm * 256 + wr * 64 + fr, col0 = u.pn * 256 + wc * 32 + 4 * fq;
#pragma unroll
        for (int ai = 0; ai < 2; ++ai)
#pragma unroll
            for (int m = 0; m < 4; ++m) { float* rowp = O + (size_t)(row0 + ai * 128 + m * 16) * ldc + col0;
#pragma unroll
                for (int bj = 0; bj < 2; ++bj)
#pragma unroll
                    for (int n = 0; n < 2; ++n) *(f32x4*)(rowp + bj * 128 + n * 16) = acc[ai][bj][m][n]; }
    } };
struct EpiResid { static constexpr bool PERM = false, AFTER_DRAIN = false; const float* base; float* out;
    __device__ __forceinline__ void operator()(const AccT& acc, const pg8::Unit& u, int wr, int wc, int fr, int fq) const {
        const int row0 = u.pm * 256 + wr * 64 + fr, col0 = u.pn * 256 + wc * 32 + 4 * fq;
#pragma unroll
        for (int ai = 0; ai < 2; ++ai)
#pragma unroll
            for (int m = 0; m < 4; ++m) { const size_t off = (size_t)(row0 + ai * 128 + m * 16) * DM + col0;
#pragma unroll
                for (int bj = 0; bj < 2; ++bj)
#pragma unroll
                    for (int n = 0; n < 2; ++n) { const f32x4 b = *(const f32x4*)(base + off + bj * 128 + n * 16); *(f32x4*)(out + off + bj * 128 + n * 16) = b + acc[ai][bj][m][n]; } }
    } };
struct EpiBranch { static constexpr bool PERM = true, AFTER_DRAIN = false; bf16_t* G; const float* bg;
    __device__ __forceinline__ void operator()(const AccT& acc, const pg8::Unit& u, int wr, int wc, int fr, int fq) const {
        const int row0 = u.pm * 256 + wr * 64 + fr, col0 = u.pn * 256 + wc * 32 + 8 * fq;
#pragma unroll
        for (int ai = 0; ai < 2; ++ai)
#pragma unroll
            for (int m = 0; m < 4; ++m) { bf16_t* rowp = G + (size_t)(row0 + ai * 128 + m * 16) * 4096 + col0;
#pragma unroll
                for (int bj = 0; bj < 2; ++bj) { const u32x4 gw = *(const u32x4*)(rowp + bj * 128); const f32x4 b0 = *(const f32x4*)(bg + col0 + bj * 128), b1 = *(const f32x4*)(bg + col0 + bj * 128 + 4);
                    const f32x4 v0 = acc[ai][bj][m][0], v1 = acc[ai][bj][m][1]; u32x4 w;
                    w.x = pk2(fast_sigmoid(blo(gw.x) + b0[0]) * v0[0], fast_sigmoid(bhi(gw.x) + b0[1]) * v0[1]); w.y = pk2(fast_sigmoid(blo(gw.y) + b0[2]) * v0[2], fast_sigmoid(bhi(gw.y) + b0[3]) * v0[3]);
                    w.z = pk2(fast_sigmoid(blo(gw.z) + b1[0]) * v1[0], fast_sigmoid(bhi(gw.z) + b1[1]) * v1[1]); w.w = pk2(fast_sigmoid(blo(gw.w) + b1[2]) * v1[2], fast_sigmoid(bhi(gw.w) + b1[3]) * v1[3]);
                    *(u32x4*)(rowp + bj * 128) = w; } }
    } };
struct EpiSexp { static constexpr bool PERM = true, AFTER_DRAIN = false; bf16_t* E; const float* mqss; float* esum; const float* cb;
    __device__ __forceinline__ void operator()(const AccT& acc, const pg8::Unit& u, int wr, int wc, int fr, int fq) const {
        const int row0 = u.pm * 256 + wr * 64 + fr, col0 = u.pn * 256 + wc * 32 + 8 * fq; const float shift = cb[0];
#pragma unroll
        for (int ai = 0; ai < 2; ++ai)
#pragma unroll
            for (int m = 0; m < 4; ++m) { const int row = row0 + ai * 128 + m * 16; const f32x4 p = *(const f32x4*)(mqss + (size_t)row * 16 + u.pn * 4);
                const float sc = rsqrtf(((p[0] + p[1]) + (p[2] + p[3])) * (1.f / 256.f) + EPS) * (1.f / 16.f); bf16_t* rowp = E + (size_t)row * DM + col0; float sum = 0.f;
#pragma unroll
                for (int bj = 0; bj < 2; ++bj) { const f32x4 v0 = acc[ai][bj][m][0], v1 = acc[ai][bj][m][1]; u32x4 w;
                    w.x = pk2(__expf(v0[0] * sc - shift), __expf(v0[1] * sc - shift)); w.y = pk2(__expf(v0[2] * sc - shift), __expf(v0[3] * sc - shift));
                    w.z = pk2(__expf(v1[0] * sc - shift), __expf(v1[1] * sc - shift)); w.w = pk2(__expf(v1[2] * sc - shift), __expf(v1[3] * sc - shift));
                    *(u32x4*)(rowp + bj * 128) = w;
                    sum += (blo(w.x) + bhi(w.x)) + (blo(w.y) + bhi(w.y)) + (blo(w.z) + bhi(w.z)) + (blo(w.w) + bhi(w.w)); }
                sum += __shfl_xor(sum, 16); sum += __shfl_xor(sum, 32); if (fq == 0) esum[(size_t)row * 16 + u.pn * 4 + wc] = sum;
                asm volatile("" ::: "memory"); }
    } };
struct EpiMemPV { static constexpr bool PERM = true, AFTER_DRAIN = false; bf16_t* Y; const float* esum;
    __device__ __forceinline__ void operator()(const AccT& acc, const pg8::Unit& u, int wr, int wc, int fr, int fq) const {
        const int row0 = u.pm * 256 + wr * 64 + fr, col0 = u.pn * 256 + wc * 32 + 8 * fq;
#pragma unroll
        for (int ai = 0; ai < 2; ++ai)
#pragma unroll
            for (int m = 0; m < 4; ++m) { const int row = row0 + ai * 128 + m * 16; const f32x4 p = *(const f32x4*)(esum + (size_t)row * 16 + u.pn * 4);
                const float il = 1.f / ((p[0] + p[1]) + (p[2] + p[3])); bf16_t* rowp = Y + (size_t)row * DM + col0;
#pragma unroll
                for (int bj = 0; bj < 2; ++bj) { const f32x4 v0 = acc[ai][bj][m][0] * il, v1 = acc[ai][bj][m][1] * il; u32x4 w; w.x = pk2(v0[0], v0[1]); w.y = pk2(v0[2], v0[3]); w.z = pk2(v1[0], v1[1]); w.w = pk2(v1[2], v1[3]);
                    *(u32x4*)(rowp + bj * 128) = w; }
                asm volatile("" ::: "memory"); }
    } };

__device__ __forceinline__ void tr_item(const float* __restrict__ W, int ldw, bf16_t* __restrict__ WT, int ldk, int nblk, LAS float* scr, int item, int lane, int ncopies, int cstride) {
    const int kb = item / nblk, nb = item % nblk, k0 = 64 * kb, n0 = 32 * nb;
#pragma unroll
    for (int i = 0; i < 32; ++i) { const int kk = 2 * i + (lane >> 5); scr[kk * 33 + (lane & 31)] = W[(size_t)(k0 + kk) * ldw + n0 + (lane & 31)]; }
    LDS_WAIT(); asm volatile("" ::: "memory");
    const int c = lane & 7;
#pragma unroll
    for (int j = 0; j < 4; ++j) { const int n = (lane >> 3) + 8 * j; const LAS float* s = scr + (8 * c) * 33 + n;
        u32x4 o; o.x = pk2(s[0 * 33], s[1 * 33]); o.y = pk2(s[2 * 33], s[3 * 33]); o.z = pk2(s[4 * 33], s[5 * 33]); o.w = pk2(s[6 * 33], s[7 * 33]);
        for (int cp = 0; cp < ncopies; ++cp) *(u32x4*)(WT + (size_t)(n0 + n) * ldk + k0 + 8 * c + cp * cstride) = o; }
    LDS_WAIT(); asm volatile("" ::: "memory");
}
__device__ __forceinline__ void norm_row(const float* __restrict__ xrow, const float* __restrict__ g, bf16_t* __restrict__ hrow, const LAS float* WfT, bool do_logf, const float* __restrict__ bfg, float* __restrict__ LOGF, int row, int lane) {
    const f32x4* xr = (const f32x4*)xrow; const f32x4* gr = (const f32x4*)g;
    f32x4 v[4]; float ss = 0.f;
#pragma unroll
    for (int j = 0; j < 4; ++j) { v[j] = xr[lane + 64 * j]; ss += (v[j][0] * v[j][0] + v[j][1] * v[j][1]) + (v[j][2] * v[j][2] + v[j][3] * v[j][3]); }
    ss = wave_sum(ss);
    const float rstd = rsqrtf(ss * (1.f / DM) + EPS);
#pragma unroll
    for (int j = 0; j < 4; ++j) { v[j] = v[j] * rstd * gr[lane + 64 * j];
        uint2 o; o.x = pk2(v[j][0], v[j][1]); o.y = pk2(v[j][2], v[j][3]); ((uint2*)hrow)[lane + 64 * j] = o; }
    if (do_logf) {
        float mine = 0.f;
#pragma unroll 4
        for (int h = 0; h < 16; ++h) { float p = 0.f;
#pragma unroll
            for (int j = 0; j < 4; ++j) { const f32x4 w = *(const LAS f32x4*)(WfT + h * 1024 + (lane + 64 * j) * 4); p += (v[j][0] * w[0] + v[j][1] * w[1]) + (v[j][2] * w[2] + v[j][3] * w[3]); }
            p = wave_sum(p); if (lane == h) mine = p; }
        if (lane < 16) { const int b = row / SEQ, t = row % SEQ; LOGF[((size_t)b * 16 + lane) * SEQ + t] = logsigmoidf(mine + bfg[lane]); }
    }
}
__device__ __forceinline__ void headnorm64_row(bf16_t* row, const float* __restrict__ g, float scale, int lane) {
    u32x4* p = (u32x4*)row + lane * 2; u32x4 a = p[0], b = p[1];
    float v[16] = {blo(a.x), bhi(a.x), blo(a.y), bhi(a.y), blo(a.z), bhi(a.z), blo(a.w), bhi(a.w), blo(b.x), bhi(b.x), blo(b.y), bhi(b.y), blo(b.z), bhi(b.z), blo(b.w), bhi(b.w)};
    float ss = 0.f;
#pragma unroll
    for (int i = 0; i < 16; ++i) ss += v[i] * v[i];
    ss += __shfl_xor(ss, 1); ss += __shfl_xor(ss, 2);
    const float rstd = rsqrtf(ss * (1.f / 64.f) + EPS) * scale; const f32x4* gp = (const f32x4*)(g + (lane & 3) * 16);
#pragma unroll
    for (int i = 0; i < 4; ++i) { const f32x4 gg = gp[i]; v[4 * i] *= rstd * gg[0]; v[4 * i + 1] *= rstd * gg[1]; v[4 * i + 2] *= rstd * gg[2]; v[4 * i + 3] *= rstd * gg[3]; }
    a.x = pk2(v[0], v[1]); a.y = pk2(v[2], v[3]); a.z = pk2(v[4], v[5]); a.w = pk2(v[6], v[7]); b.x = pk2(v[8], v[9]); b.y = pk2(v[10], v[11]); b.z = pk2(v[12], v[13]); b.w = pk2(v[14], v[15]);
    p[0] = a; p[1] = b;
}
__device__ __forceinline__ void cumsum_block(const float* __restrict__ src, float* __restrict__ dst, LAS float* part, int tid) {
    const int lane = tid & 63, wave = tid >> 6; const f32x4* s4 = (const f32x4*)(src + tid * 16); float v[16]; float s = 0.f;
#pragma unroll
    for (int i = 0; i < 4; ++i) { const f32x4 x = s4[i]; s += x[0]; v[4 * i] = s; s += x[1]; v[4 * i + 1] = s; s += x[2]; v[4 * i + 2] = s; s += x[3]; v[4 * i + 3] = s; }
    float incl = s;
#pragma unroll
    for (int o = 1; o < 64; o <<= 1) { const float t_ = __shfl_up(incl, o); if (lane >= o) incl += t_; }
    __syncthreads();
    if (lane == 63) part[wave] = incl;
    __syncthreads();
    float off = incl - s;
    for (int w = 0; w < wave; ++w) off += part[w];
    f32x4* d4 = (f32x4*)(dst + tid * 16);
#pragma unroll
    for (int i = 0; i < 4; ++i) d4[i] = (f32x4){off + v[4 * i], off + v[4 * i + 1], off + v[4 * i + 2], off + v[4 * i + 3]};
}

__device__ __forceinline__ float neg_expm1_small(float x) {
    const float p = -x * (1.f + x * (0.5f + x * (0.16666667f + x * (0.041666668f + x * (0.0083333338f + x * 0.0013888889f)))));
    return x > -0.25f ? p : 1.f - __expf(x);
}
template <bool FINAL> __device__ __forceinline__ void lru_item(int b, int c, int n, const bf16_t* __restrict__ LX, const bf16_t* __restrict__ LG, bf16_t* __restrict__ YL,
        const float* __restrict__ cw, const float* __restrict__ cbias, const float bA, const float bX,
        const float spl, float* APROD, float* HEND, LAS unsigned char* lds, int tid) {
    const int e = tid & 63, tg = tid >> 6, ch = n * 64 + e;
    LAS float* xcT = (LAS float*)lds;
    LAS float* segP = xcT + 64 * 68;
    LAS float* segH = segP + 512, *carP = segH + 512, *carH = carP + 512;
    const LAS float* wAl = (const LAS float*)(lds + 32768);
    const int t0 = c * 64 + tg * 8; const size_t row0 = (size_t)b * SEQ + t0;
    float xw[11];
#pragma unroll
    for (int j = 0; j < 11; ++j) { const int t = t0 + j - 3; xw[j] = t >= 0 ? bf2f(LX[((size_t)b * SEQ + t) * DM + ch]) : 0.f; }
    const float w0 = cw[ch], w1 = cw[DM + ch], w2 = cw[2 * DM + ch], w3 = cw[3 * DM + ch], bc = cbias[ch];
    float xc[8];
#pragma unroll
    for (int j = 0; j < 8; ++j) xc[j] = bc + w3 * xw[j + 3] + w2 * xw[j + 2] + w1 * xw[j + 1] + w0 * xw[j];
    *(LAS f32x4*)(xcT + e * 68 + tg * 8) = (f32x4){xc[0], xc[1], xc[2], xc[3]};
    *(LAS f32x4*)(xcT + e * 68 + tg * 8 + 4) = (f32x4){xc[4], xc[5], xc[6], xc[7]};
    float gl[8];
    if (FINAL) {
#pragma unroll
        for (int j = 0; j < 8; ++j) gl[j] = bf2f(LG[(row0 + j) * DM + ch]);
        float cp = 1.f, chh = 0.f; const int per = (c + 7) >> 3; const int lo = tg * per; int hi = lo + per; if (hi > c) hi = c;
        for (int cc = lo; cc < hi; ++cc) { const size_t si = ((size_t)b * 128 + cc) * DM + ch; const float A = APROD[si], Hc = HEND[si]; chh = A * chh + Hc; cp *= A; }
        carP[tg * 64 + e] = cp; carH[tg * 64 + e] = chh; }
    __syncthreads();
    float ra[8], ri[8];
#pragma unroll
    for (int j = 0; j < 8; ++j) { ra[j] = bA; ri[j] = bX; }
#pragma unroll 8
    for (int d = 0; d < 64; ++d) { const float wad = wAl[d * 64 + e], wxd = wAl[4096 + d * 64 + e];
        const f32x4 x0 = *(const LAS f32x4*)(xcT + d * 68 + tg * 8), x1 = *(const LAS f32x4*)(xcT + d * 68 + tg * 8 + 4);
        ra[0] += x0[0] * wad; ra[1] += x0[1] * wad; ra[2] += x0[2] * wad; ra[3] += x0[3] * wad; ra[4] += x1[0] * wad; ra[5] += x1[1] * wad; ra[6] += x1[2] * wad; ra[7] += x1[3] * wad;
        ri[0] += x0[0] * wxd; ri[1] += x0[1] * wxd; ri[2] += x0[2] * wxd; ri[3] += x0[3] * wxd; ri[4] += x1[0] * wxd; ri[5] += x1[1] * wxd; ri[6] += x1[2] * wxd; ri[7] += x1[3] * wxd; }
    float av[8], uv[8]; float P = 1.f, Hh = 0.f;
#pragma unroll
    for (int j = 0; j < 8; ++j) { const float rr = fast_sigmoid(ra[j]), ii = fast_sigmoid(ri[j]); const float la = -8.f * rr * spl; av[j] = __expf(la); uv[j] = __builtin_amdgcn_sqrtf(neg_expm1_small(2.f * la)) * (ii * xc[j]);
        Hh = av[j] * Hh + uv[j]; P *= av[j]; }
    segP[tg * 64 + e] = P; segH[tg * 64 + e] = Hh;
    __syncthreads();
    if (FINAL) {
        float h = 0.f;
#pragma unroll
        for (int s = 0; s < 8; ++s) h = carP[s * 64 + e] * h + carH[s * 64 + e];
        for (int t2 = 0; t2 < tg; ++t2) h = segP[t2 * 64 + e] * h + segH[t2 * 64 + e];
#pragma unroll
        for (int j = 0; j < 8; ++j) { h = av[j] * h + uv[j]; YL[(row0 + j) * DM + ch] = f2bf(h * fast_gelu(gl[j])); }
    } else if (tg == 7) {
        float h = 0.f, p = 1.f;
#pragma unroll
        for (int s = 0; s < 8; ++s) { h = segP[s * 64 + e] * h + segH[s * 64 + e]; p *= segP[s * 64 + e]; }
        const size_t si = ((size_t)b * 128 + c) * DM + ch; APROD[si] = p; HEND[si] = h;
    }
    __syncthreads();
}
template <bool FINAL> __device__ __forceinline__ void lru_pass(int l, int bx, int G, const float* const* in, const bf16_t* LX, const bf16_t* LG, bf16_t* YL, float* APROD, float* HEND, LAS unsigned char* lds, int tid) {
    const int n = bx & 15, e = tid & 63, ch = n * 64 + e;
    { const float* wa = in[10] + (size_t)l * 65536 + (size_t)n * 4096; const float* wx = in[12] + (size_t)l * 65536 + (size_t)n * 4096; LAS float* wl = (LAS float*)(lds + 32768);
        for (int i = tid; i < 4096; i += MEGA_THREADS) { wl[i] = wa[i]; wl[4096 + i] = wx[i]; } }
    __syncthreads();
    const float bA = in[11][l * DM + ch], bX = in[13][l * DM + ch], spl = softplusf(-in[14][l * DM + ch]);
    for (int it = bx; it < 4096; it += G) lru_item<FINAL>(it >> 11, (it >> 4) & 127, n, LX, LG, YL, in[8] + (size_t)l * 4 * DM, in[9] + l * DM, bA, bX, spl, APROD, HEND, lds, tid);
}

__device__ __forceinline__ void sb_wave(int b, int h, int qw0, const bf16_t* Q, const bf16_t* __restrict__ K, const bf16_t* __restrict__ V, bf16_t* O, LAS unsigned char* vl, int lane) {
    const int r32 = lane & 31, hi = lane >> 5; const size_t rowbase = (size_t)b * SEQ;
    const bf16_t* Qw = Q + (rowbase + qw0) * DM + h * 64;
    bf16x8_t qr[4];
#pragma unroll
    for (int d0 = 0; d0 < 4; ++d0) qr[d0] = *(const bf16x8_t*)(Qw + (size_t)r32 * DM + d0 * 16 + hi * 8);
    const bf16_t* Kh = K + rowbase * DM + h * 64; const bf16_t* Vh = V + rowbase * DM + h * 64;
    f32x16_t o0 = {}, o1 = {}; float R = 0.f; const int qabs = qw0 + r32;
    int kt = qw0 >> 5;
    bf16x8_t kf[4]; u32x4 vr[4];
#define SB_LOAD(KF, VR, kt_) do { _Pragma("unroll") for (int d0 = 0; d0 < 4; ++d0) KF[d0] = *(const bf16x8_t*)(Kh + (size_t)((kt_) * 32 + r32) * DM + d0 * 16 + hi * 8); \
        _Pragma("unroll") for (int it = 0; it < 4; ++it) { const int chunk = lane + 64 * it; VR[it] = *(const u32x4*)(Vh + (size_t)((kt_) * 32 + (chunk >> 3)) * DM + (chunk & 7) * 8); } } while (0)
    SB_LOAD(kf, vr, kt);
    const unsigned vbase = (unsigned)(size_t)vl;
    for (;;) {
        bf16x8_t kn[4]; u32x4 vn[4]; const bool more = kt > 0;
        if (more) SB_LOAD(kn, vn, kt - 1); else {
#pragma unroll
            for (int i = 0; i < 4; ++i) { kn[i] = kf[i]; vn[i] = vr[i]; } }
        f32x16_t st = {};
#pragma unroll
        for (int d0 = 0; d0 < 4; ++d0) st = __builtin_amdgcn_mfma_f32_32x32x16_bf16(kf[d0], qr[d0], st, 0, 0, 0);
#pragma unroll
        for (int it = 0; it < 4; ++it) { const int chunk = lane + 64 * it, row = chunk >> 3, c16 = chunk & 7; *(LAS u32x4*)(vl + (c16 >> 2) * 2048 + row * 64 + (c16 & 3) * 16) = vr[it]; }
        float l1[16], lb[16]; bool val[16];
#pragma unroll
        for (int r = 0; r < 16; ++r) { const int kv = kt * 32 + (r & 3) + 8 * (r >> 2) + 4 * hi; val[r] = kv < qabs; const float z = st[r] * 0.125f; const float sp = fast_softplus(z); l1[r] = val[r] ? -sp : 0.f; lb[r] = z - sp; }
        float w[16]; float tail = 0.f;
#pragma unroll
        for (int g = 3; g >= 0; --g) { const float qs = (l1[4 * g] + l1[4 * g + 1]) + (l1[4 * g + 2] + l1[4 * g + 3]); const float pq = __shfl_xor(qs, 32);
            const float after = tail + (hi == 0 ? pq : 0.f) + R; tail += qs + pq;
            const float e2 = l1[4 * g + 3], e1 = e2 + l1[4 * g + 2], e0 = e1 + l1[4 * g + 1];
            w[4 * g + 3] = val[4 * g + 3] ? __expf(lb[4 * g + 3] + after) : 0.f; w[4 * g + 2] = val[4 * g + 2] ? __expf(lb[4 * g + 2] + after + e2) : 0.f;
            w[4 * g + 1] = val[4 * g + 1] ? __expf(lb[4 * g + 1] + after + e1) : 0.f; w[4 * g] = val[4 * g] ? __expf(lb[4 * g] + after + e0) : 0.f; }
        R += tail;
        u32x4 p0, p1; p0.x = attn_body::cvtpk_s(w[0], w[1]); p0.y = attn_body::cvtpk_s(w[2], w[3]); p0.z = attn_body::cvtpk_s(w[4], w[5]); p0.w = attn_body::cvtpk_s(w[6], w[7]);
        p1.x = attn_body::cvtpk_s(w[8], w[9]); p1.y = attn_body::cvtpk_s(w[10], w[11]); p1.z = attn_body::cvtpk_s(w[12], w[13]); p1.w = attn_body::cvtpk_s(w[14], w[15]);
        const bf16x8_t pa0 = __builtin_bit_cast(bf16x8_t, p0), pa1 = __builtin_bit_cast(bf16x8_t, p1);
        const attn_body::lds_cptr vp = (attn_body::lds_cptr)vl + (4 * hi + ((lane & 15) >> 2)) * 64 + ((lane >> 4) & 1) * 32 + (lane & 3) * 8;
#define SB_VF(d0, s) ({ const attn_body::s16x4 lo_ = attn_body::vtr(vp + (d0) * 2048 + (s) * 1024), hi_ = attn_body::vtr(vp + (d0) * 2048 + (s) * 1024 + 512); \
            (bf16x8_t){lo_[0], lo_[1], lo_[2], lo_[3], hi_[0], hi_[1], hi_[2], hi_[3]}; })
        o0 = __builtin_amdgcn_mfma_f32_32x32x16_bf16(pa0, SB_VF(0, 0), o0, 0, 0, 0);
        o1 = __builtin_amdgcn_mfma_f32_32x32x16_bf16(pa0, SB_VF(1, 0), o1, 0, 0, 0);
        o0 = __builtin_amdgcn_mfma_f32_32x32x16_bf16(pa1, SB_VF(0, 1), o0, 0, 0, 0);
        o1 = __builtin_amdgcn_mfma_f32_32x32x16_bf16(pa1, SB_VF(1, 1), o1, 0, 0, 0);
        if (!more) break;
        if (__all(R < SB_THR)) break;
#pragma unroll
        for (int i = 0; i < 4; ++i) { kf[i] = kn[i]; vr[i] = vn[i]; }
        --kt;
    }
#undef SB_LOAD
#undef SB_VF
    (void)vbase;
    bf16_t* Ow = O + (rowbase + qw0) * DM + h * 64;
#pragma unroll
    for (int r = 0; r < 16; ++r) { const int q = (r & 3) + 8 * (r >> 2) + 4 * hi; Ow[(size_t)q * DM + r32] = f2bf(o0[r]); Ow[(size_t)q * DM + 32 + r32] = f2bf(o1[r]); }
}

#ifndef DBG_NOLOGF
#define DBG_NOLOGF 0
#endif
#ifndef EN_FOX
#define EN_FOX 1
#endif
#ifndef EN_SB
#define EN_SB 1
#endif
#ifndef EN_LRU
#define EN_LRU 1
#endif
#ifndef EN_GEMM
#define EN_GEMM 1
#endif
#ifndef EN_THIN
#define EN_THIN 1
#endif
enum { SUB_CONV = 1, SUB_NORM = 2, SUB_HEADNORM = 4, SUB_CUMSUM = 8, SUB_LRU = 16, SUB_SB = 32, SUB_MEM = 64, SUB_FOX = 128, SUB_ALL = 255 };
constexpr int N_PRO = 3, N_PER_LAYER = 10, N_PHASES = N_PRO + DEPTH * N_PER_LAYER;
struct MArgs { Ptrs P; int ph_lo, ph_hi, sub, pad; };

__global__ void __launch_bounds__(MEGA_THREADS, 2) mega(MArgs a) {
    extern __shared__ __attribute__((aligned(16))) unsigned char lds_raw[];
    LAS unsigned char* lds = (LAS unsigned char*)lds_raw;
    cg::grid_group grid = cg::this_grid();
    for (int ph = a.ph_lo; ph < a.ph_hi; ++ph) {
    int tid = threadIdx.x; asm volatile("" : "+v"(tid));
    const int lane = tid & 63, wave = __builtin_amdgcn_readfirstlane(tid >> 6);
    int zs = 0; asm volatile("" : "+s"(zs));
    const int G = gridDim.x + zs, bx = blockIdx.x + zs, sub = a.sub + zs, vcu = (G % 8 == 0) ? (bx % 8) * (G / 8) + bx / 8 : bx;
    const int gw = vcu * NWV + wave, NGW = G * NWV;
    unsigned char* ws = a.P.ws + zs; const float* const* in = a.P.in + zs; float* out = a.P.out + zs;
    bf16_t* H = (bf16_t*)(ws + WS_H); bf16_t* PROJ = (bf16_t*)(ws + WS_PROJ); bf16_t* GATES = (bf16_t*)(ws + WS_GATES); bf16_t* Eb = (bf16_t*)(ws + WS_E);
    bf16_t *FQ = PROJ, *FK = PROJ + (size_t)T * DM, *FV = PROJ + 2 * (size_t)T * DM, *LX = PROJ + 3 * (size_t)T * DM, *LG = PROJ + 4 * (size_t)T * DM, *SQ = PROJ + 5 * (size_t)T * DM,
           *SK = PROJ + 6 * (size_t)T * DM, *SV = PROJ + 7 * (size_t)T * DM, *MQ = PROJ + 8 * (size_t)T * DM;
    bf16_t* YL = (bf16_t*)(ws + WS_YL);
    float *LOGF = (float*)(ws + WS_LOGF), *FB = (float*)(ws + WS_FB), *MQSS = (float*)(ws + WS_MQSS), *ESUM = (float*)(ws + WS_ESUM), *CB = (float*)(ws + WS_CB);
    bf16_t* MEMN = (bf16_t*)(ws + WS_MEMN); float* MEMRAW = (float*)(ws + WS_MEMRAW); bf16_t *MK = (bf16_t*)(ws + WS_MK), *MVT = (bf16_t*)(ws + WS_MVT);
    float *APROD = (float*)(ws + WS_LRU), *HEND = APROD + (size_t)BATCH * 128 * DM;
    bf16_t* WKVT = (bf16_t*)(ws + WS_WKVT);
    bf16_t *WIN_T = (bf16_t*)(ws + WS_WT + WT_IN), *WBR_T = (bf16_t*)(ws + WS_WT + WT_BR), *WOUT_T = (bf16_t*)(ws + WS_WT + WT_OUT), *WUP_T = (bf16_t*)(ws + WS_WT + WT_UP), *WDN_T = (bf16_t*)(ws + WS_WT + WT_DN);
    bf16_t *GV = (bf16_t*)(ws + WS_GV), *ACT = (bf16_t*)(ws + WS_ACT);

        if (ph < N_PRO) {
            if (ph == 0) {
                LAS float* scr = (LAS float*)(lds + wave * 8448);
                for (int it = gw; it < 4 * 1024; it += NGW) { const int l = it >> 10; tr_item(in[15] + (size_t)l * DM * 2048, 2048, WKVT + (size_t)l * 2048 * DM, DM, 64, scr, it & 1023, lane, 1, 0); }
                for (int m = gw; m < 4 * 512; m += NGW) { const int l = m >> 9, r = m & 511; norm_row(in[1] + (size_t)r * DM, in[3] + l * DM, MEMN + (size_t)m * DM, (const LAS float*)lds, false, nullptr, nullptr, 0, lane); }
            } else if (ph == 1) {
                LocOrder<LocMemKV> S; S.so.init(4 * 512, 2048, G, bx); S.loc = LocMemKV{(const char*)MEMN, (const char*)WKVT};
                if (EN_GEMM) pg8::gemm_phase<EpiF32, LocOrder<LocMemKV>, true, true>(lds, pg8::Gemm{DM, DM, DM}, S, EpiF32{MEMRAW, 2048, 0});
            } else {
                for (int m = gw; m < 4 * 512; m += NGW) { const int l = m >> 9, r = m & 511, b = r >> 8, mi = r & 255; const float* raw = MEMRAW + (size_t)m * 2048;
                    const f32x4 gk = *(const f32x4*)(in[17] + l * 256 + lane * 4), gq = *(const f32x4*)(in[16] + l * 256 + lane * 4); const f32x4 gg = gk * gq;
#pragma unroll
                    for (int h = 0; h < 4; ++h) { const f32x4 k = *(const f32x4*)(raw + h * 256 + lane * 4); const float ss = wave_sum((k[0] * k[0] + k[1] * k[1]) + (k[2] * k[2] + k[3] * k[3]));
                        const float rstd = rsqrtf(ss * (1.f / 256.f) + EPS); uint2 o; o.x = pk2(k[0] * rstd * gg[0], k[1] * rstd * gg[1]); o.y = pk2(k[2] * rstd * gg[2], k[3] * rstd * gg[3]);
                        *(uint2*)(MK + ((size_t)l * 512 + (size_t)b * 256 + mi) * DM + h * 256 + lane * 4) = o;
                        const f32x4 v = *(const f32x4*)(raw + 1024 + h * 256 + lane * 4); bf16_t* vt = MVT + (size_t)l * 512 * DM + (((size_t)b * 4 + h) * 256 + lane * 4) * 256 + mi;
                        vt[0] = f2bf(v[0]); vt[256] = f2bf(v[1]); vt[512] = f2bf(v[2]); vt[768] = f2bf(v[3]); }
                    if (r == 0) { float mx = fmaxf(fmaxf(fabsf(gg[0]), fabsf(gg[1])), fmaxf(fabsf(gg[2]), fabsf(gg[3])));
#pragma unroll
                        for (int o = 1; o < 64; o <<= 1) mx = fmaxf(mx, __shfl_xor(mx, o));
                        if (lane == 0) CB[l] = 16.f * mx; } }
            }
        } else {
            const int l = (ph - N_PRO) / N_PER_LAYER, sp = (ph - N_PRO) % N_PER_LAYER;
            const float* xcur = l == 0 ? in[0] : out;
            if (sp == 0) {
                if (sub & SUB_NORM) { LAS float* WfT = (LAS float*)lds; const float* wf = in[4] + (size_t)l * DM * NIN + 3072;
                    for (int i = tid; i < 16 * 1024; i += MEGA_THREADS) { const int k = i >> 4, h = i & 15; WfT[h * 1024 + k] = wf[(size_t)k * NIN + h]; } }
                __syncthreads();
                if (sub & SUB_CONV) { LAS float* scr = (LAS float*)(lds + 65536 + wave * 8448);
                    const float* win = in[4] + (size_t)l * DM * NIN;
                    for (int it = gw; it < 13440; it += NGW) { int r = it;
                        if (r < 1536) { tr_item(win, NIN, WIN_T, DM, 96, scr, r, lane, 1, 0); continue; } r -= 1536;
                        if (r < 5120) { tr_item(win + 3088, NIN, WIN_T + (size_t)3072 * DM, DM, 320, scr, r, lane, 1, 0); continue; } r -= 5120;
                        if (r < 2048) { const int i = r >> 9; tr_item(in[19] + ((size_t)l * 4 + i) * DM * DM, DM, WBR_T + (size_t)i * DM * DM, DM, 32, scr, r & 511, lane, 1, 0); continue; } r -= 2048;
                        if (r < 512) { tr_item(in[20] + (size_t)l * DM * DM, DM, WOUT_T, 4096, 32, scr, r, lane, 4, 1024); continue; } r -= 512;
                        if (r < 2816) { tr_item(in[22] + (size_t)l * DM * 2 * DFF, 2 * DFF, WUP_T, DM, 176, scr, r, lane, 1, 0); continue; } r -= 2816;
                        tr_item(in[25] + (size_t)l * DFF * DM, DM, WDN_T, DFF, 32, scr, r, lane, 1, 0); } }
                if (sub & SUB_NORM) for (int m = gw; m < T; m += NGW) norm_row(xcur + (size_t)m * DM, in[2] + l * DM, H + (size_t)m * DM, (const LAS float*)lds, !DBG_NOLOGF, in[5] + l * 16, LOGF, m, lane);
            } else if (sp == 1) {
                LocOrder<LocStd> S; S.so.init(T, 13312, G, bx); S.loc = LocStd{(const char*)H, (const char*)WIN_T, 256 * 1024 * 2, 256 * 1024 * 2};
                if (EN_GEMM) pg8::gemm_phase<EpiProj, LocOrder<LocStd>, true, true>(lds, pg8::Gemm{DM, DM, DM}, S, EpiProj{PROJ, GATES, MQSS});
            } else if (sp == 2) {
                if (sub & SUB_HEADNORM) { for (int m = gw; m < 2 * T; m += NGW) { if (m < T) headnorm64_row(FQ + (size_t)m * DM, in[6] + l * 64, C2, lane); else headnorm64_row(FK + (size_t)(m - T) * DM, in[7] + l * 64, 1.f, lane); } }
                if ((sub & SUB_CUMSUM) && bx < 32) cumsum_block(LOGF + (size_t)bx * SEQ, FB + (size_t)bx * SEQ, (LAS float*)lds, tid);
                __syncthreads();
                if (EN_LRU && (sub & SUB_LRU)) lru_pass<false>(l, bx, G, in, LX, LG, YL, APROD, HEND, lds, tid);
                if (EN_SB && (sub & SUB_SB)) for (int k = 0; k < 4; ++k) { const int bh = vcu >> 3, qb = (vcu & 7) * 4 + k; sb_wave(bh >> 4, bh & 15, qb * 256 + wave * 32, SQ, SK, SV, H, lds + wave * 4096, lane); }
                __syncthreads();
                if (sub & SUB_MEM) { LocOrder<LocMemS> S; S.so.init(T, 1024, G, bx); S.loc = LocMemS{(const char*)MQ, (const char*)(MK + (size_t)l * 512 * DM)};
                    if (EN_GEMM) pg8::gemm_phase<EpiSexp, LocOrder<LocMemS>, true, true>(lds, pg8::Gemm{DM, DM, 256 + zs}, S, EpiSexp{Eb, MQSS, ESUM, CB + l}); }
            } else if (sp == 3) {
                if (EN_FOX && (sub & SUB_FOX)) { const attn_body::AttnTensors AT{(const attn_body::bf16*)FQ, (const attn_body::bf16*)FK, (const attn_body::bf16*)FV, (attn_body::bf16*)SV, FB};
                    const attn_body::StaticOrder S(G, bx); attn_body::attn_phase<attn_body::StaticOrder, 20>((char*)lds_raw, AT, S); }
                __syncthreads();
                if (EN_LRU && (sub & SUB_LRU)) lru_pass<true>(l, bx, G, in, LX, LG, YL, APROD, HEND, lds, tid);
                if (sub & SUB_MEM) { LocOrder<LocMemPV> S; S.so.init(T, 1024, G, bx); S.loc = LocMemPV{(const char*)Eb, (const char*)(MVT + (size_t)l * 512 * DM)};
                    if (EN_GEMM) pg8::gemm_phase<EpiMemPV, LocOrder<LocMemPV>, true, true>(lds, pg8::Gemm{DM, 256, 256 + zs}, S, EpiMemPV{MQ, ESUM}); }
            } else if (sp == 4) {
                LocOrder<LocBranch> S; S.so.init(T, 4096, G, bx); S.loc = LocBranch{(const char*)SV, (const char*)YL, (const char*)H, (const char*)MQ, (const char*)WBR_T};
                if (EN_GEMM) pg8::gemm_phase<EpiBranch, LocOrder<LocBranch>, true, true>(lds, pg8::Gemm{DM, DM, DM}, S, EpiBranch{GATES, in[18] + (size_t)l * 4 * DM});
            } else if (sp == 5) {
                LocOrder<LocStd> S; S.so.init(T, DM, G, bx); S.loc = LocStd{(const char*)GATES, (const char*)WOUT_T, 256 * 4096 * 2, 256 * 4096 * 2};
                if (EN_GEMM) pg8::gemm_phase<EpiResid, LocOrder<LocStd>, true, true>(lds, pg8::Gemm{4096, 4096, 4096}, S, EpiResid{xcur, out});
            } else if (sp == 6) {
                for (int m = gw; m < T; m += NGW) norm_row(out + (size_t)m * DM, in[21] + l * DM, H + (size_t)m * DM, (const LAS float*)lds, false, nullptr, nullptr, m, lane);
            } else if (sp == 7) {
                LocOrder<LocStd> S; S.so.init(T, 2 * DFF, G, bx); S.loc = LocStd{(const char*)H, (const char*)WUP_T, 256 * 1024 * 2, 256 * 1024 * 2};
                if (EN_GEMM) pg8::gemm_phase<EpiBf16P, LocOrder<LocStd>, true, true>(lds, pg8::Gemm{DM, DM, DM}, S, EpiBf16P{GV, 2 * DFF, 0});
            } else if (sp == 8) {
                const float* cw = in[23] + (size_t)l * 3 * DFF; const float* cbv = in[24] + l * DFF;
                for (int i = bx * MEGA_THREADS + tid; i < T * (DFF / 8); i += G * MEGA_THREADS) { const int r = i / (DFF / 8), c = (i % (DFF / 8)) * 8, t = r % SEQ;
                    const bf16_t* gp = GV + (size_t)r * 2 * DFF + c; const u32x4 z4 = {0u, 0u, 0u, 0u};
                    const u32x4 g0 = *(const u32x4*)gp, g1 = t >= 1 ? *(const u32x4*)(gp - 2 * DFF) : z4, g2 = t >= 2 ? *(const u32x4*)(gp - 4 * DFF) : z4, vv = *(const u32x4*)(gp + DFF);
                    const f32x4 wa0 = *(const f32x4*)(cw + c), wa1 = *(const f32x4*)(cw + c + 4), wb0 = *(const f32x4*)(cw + DFF + c), wb1 = *(const f32x4*)(cw + DFF + c + 4), wc0 = *(const f32x4*)(cw + 2 * DFF + c), wc1 = *(const f32x4*)(cw + 2 * DFF + c + 4);
                    const f32x4 bb0 = *(const f32x4*)(cbv + c), bb1 = *(const f32x4*)(cbv + c + 4);
#define ACT1(G0, G1, G2, VV, W0, W1, W2, BB) ({ const float pre_ = (BB) + (W2) * (G0) + (W1) * (G1) + (W0) * (G2); pre_ * fast_sigmoid(pre_) * (VV); })
                    u32x4 o;
                    o.x = pk2(ACT1(blo(g0.x), blo(g1.x), blo(g2.x), blo(vv.x), wa0[0], wb0[0], wc0[0], bb0[0]), ACT1(bhi(g0.x), bhi(g1.x), bhi(g2.x), bhi(vv.x), wa0[1], wb0[1], wc0[1], bb0[1]));
                    o.y = pk2(ACT1(blo(g0.y), blo(g1.y), blo(g2.y), blo(vv.y), wa0[2], wb0[2], wc0[2], bb0[2]), ACT1(bhi(g0.y), bhi(g1.y), bhi(g2.y), bhi(vv.y), wa0[3], wb0[3], wc0[3], bb0[3]));
                    o.z = pk2(ACT1(blo(g0.z), blo(g1.z), blo(g2.z), blo(vv.z), wa1[0], wb1[0], wc1[0], bb1[0]), ACT1(bhi(g0.z), bhi(g1.z), bhi(g2.z), bhi(vv.z), wa1[1], wb1[1], wc1[1], bb1[1]));
                    o.w = pk2(ACT1(blo(g0.w), blo(g1.w), blo(g2.w), blo(vv.w), wa1[2], wb1[2], wc1[2], bb1[2]), ACT1(bhi(g0.w), bhi(g1.w), bhi(g2.w), bhi(vv.w), wa1[3], wb1[3], wc1[3], bb1[3]));
#undef ACT1
                    *(u32x4*)(ACT + (size_t)r * DFF + c) = o; }
            } else {
                LocOrder<LocStd> S; S.so.init(T, DM, G, bx); S.loc = LocStd{(const char*)ACT, (const char*)WDN_T, 256 * DFF * 2, 256 * DFF * 2};
                if (EN_GEMM) pg8::gemm_phase<EpiResid, LocOrder<LocStd>, true, true>(lds, pg8::Gemm{DFF, DFF, DFF}, S, EpiResid{out, out});
            }
        }
        if (ph + 1 < a.ph_hi) grid.sync();
    }
}
enum { C_PRO = 1, C_NORM = 2, C_WIN = 4, C_HN = 8, C_LRU = 16, C_SB = 32, C_MEM = 64, C_FOX = 128, C_BR = 256, C_WOUT = 512, C_NORM2 = 1024, C_UP = 2048, C_ACT = 4096, C_DOWN = 8192, C_ONE = 16384 };
#ifndef CFG
#define CFG 32767
#endif
#ifndef REPEAT_SP
#define REPEAT_SP (-1)
#define REPEAT_N 0
#define REPEAT_SUB 0
#endif
static int g_grid = 0;
static void launch_mega(const Ptrs& P, int lo, int hi, int sub, hipStream_t st, bool coop) {
    MArgs a{}; a.P = P; a.ph_lo = lo; a.ph_hi = hi; a.sub = sub; a.pad = 0;
    if (coop) { void* args[] = {&a}; const hipError_t e = hipLaunchCooperativeKernel((const void*)mega, dim3(g_grid), dim3(MEGA_THREADS), args, MEGA_LDS, st);
        if (e != hipSuccess) fprintf(stderr, "cooperative launch failed: %s (grid %d)\n", hipGetErrorString(e), g_grid); }
    else { hipLaunchKernelGGL(mega, dim3(g_grid), dim3(MEGA_THREADS), MEGA_LDS, st, a);
        if (REPEAT_N > 0 && hi == lo + 1 && lo >= N_PRO && (lo - N_PRO) % N_PER_LAYER == (REPEAT_SP)) { a.sub = (REPEAT_SUB); for (int r = 0; r < (REPEAT_N); ++r) hipLaunchKernelGGL(mega, dim3(g_grid), dim3(MEGA_THREADS), MEGA_LDS, st, a); } }
}
static void run_hybrid(const Ptrs& P, hipStream_t st) {
    unsigned char* ws = P.ws;
    bf16_t* H = (bf16_t*)(ws + WS_H);
    bf16_t* PR[9]; for (int i = 0; i < 9; ++i) PR[i] = (bf16_t*)(ws + WS_PROJ + i * SZ_ACT);
    bf16_t *FQ = PR[0], *FK = PR[1], *FV = PR[2], *LX = PR[3], *LG = PR[4], *SQ = PR[5], *SK = PR[6], *SV = PR[7], *MQ = PR[8];
    bf16_t* GATES = (bf16_t*)(ws + WS_GATES);
    bf16_t *YL = (bf16_t*)(ws + WS_YL), *YS = (bf16_t*)(ws + WS_YS), *YM = (bf16_t*)(ws + WS_YM), *YF = (bf16_t*)(ws + WS_YF);
    float *LOGF = (float*)(ws + WS_LOGF), *FB = (float*)(ws + WS_FB);
    bf16_t* MEMN = (bf16_t*)(ws + WS_MEMN); float* MEMRAW = (float*)(ws + WS_MEMRAW);
    bf16_t *MK = (bf16_t*)(ws + WS_MK), *MVT = (bf16_t*)(ws + WS_MVT);
    bf16_t *GV = (bf16_t*)(ws + WS_GV), *ACT = (bf16_t*)(ws + WS_ACT);
    const float* const* in = P.in;
    const int cfg = CFG;
    const bool anygemm = cfg & (C_WIN | C_BR | C_WOUT | C_UP | C_DOWN);
    if (cfg & C_PRO) { for (int p = 0; p < 3; ++p) launch_mega(P, p, p + 1, SUB_ALL, st, false); }
    else for (int l = 0; l < DEPTH; ++l) {
        n_rmsnorm<<<512 / 4, 256, 0, st>>>(in[1], in[3] + l * DM, MEMN + (size_t)l * 512 * DM, nullptr, nullptr, nullptr, 512);
        n_gemm<EStoreF32><<<dim3(2048 / 64, 512 / 64), 256, 0, st>>>(MEMN + (size_t)l * 512 * DM, in[15] + (size_t)l * DM * 2048, DM, 2048, DM, 0x7fffffff, EStoreF32{MEMRAW + (size_t)l * 512 * 2048, 2048, 0});
        n_memkv_post<<<512, 256, 0, st>>>(MEMRAW + (size_t)l * 512 * 2048, in[17] + l * 256, in[16] + l * 256, MK + (size_t)l * 512 * DM, MVT + (size_t)l * 512 * DM);
    }
    for (int l = 0; l < DEPTH; ++l) {
        const int p0 = N_PRO + l * N_PER_LAYER;
        const float* xcur = l == 0 ? in[0] : P.out;
        const float* win = in[4] + (size_t)l * DM * NIN;
        if (DBG_NOLOGF) n_rmsnorm<<<T / 4, 256, 0, st>>>(xcur, in[2] + l * DM, H, win + 3072, in[5] + l * 16, LOGF, T);
        { const int sub = (anygemm ? SUB_CONV : 0) | ((cfg & C_NORM) ? SUB_NORM : 0); if (sub) launch_mega(P, p0, p0 + 1, sub, st, false); }
        if (!(cfg & C_NORM)) n_rmsnorm<<<T / 4, 256, 0, st>>>(xcur, in[2] + l * DM, H, win + 3072, in[5] + l * 16, LOGF, T);
        if (cfg & C_WIN) launch_mega(P, p0 + 1, p0 + 2, SUB_ALL, st, false);
        else { for (int gI = 0; gI < 9; ++gI) { const int coff = gI < 3 ? gI * 1024 : gI * 1024 + 16;
                n_gemm<EStoreBf16><<<dim3(1024 / 64, T / 64), 256, 0, st>>>(H, win + coff, DM, NIN, DM, 0x7fffffff, EStoreBf16{PR[gI], DM, 0}); }
            n_gemm<EStoreBf16><<<dim3(4096 / 64, T / 64), 256, 0, st>>>(H, win + 9232, DM, NIN, DM, 0x7fffffff, EStoreBf16{GATES, 4096, 0}); }
        if (!(cfg & C_HN)) { n_headnorm<<<T * 16 / 256, 256, 0, st>>>(FQ, in[6] + l * 64, 64, C2); n_headnorm<<<T * 16 / 256, 256, 0, st>>>(FK, in[7] + l * 64, 64, 1.f); n_cumsum<<<32, 1024, 0, st>>>(LOGF, FB); }
        const int sub23 = ((cfg & C_HN) ? (SUB_HEADNORM | SUB_CUMSUM) : 0) | ((cfg & C_LRU) ? SUB_LRU : 0) | ((cfg & C_SB) ? SUB_SB : 0) | ((cfg & C_MEM) ? SUB_MEM : 0) | ((cfg & C_FOX) ? SUB_FOX : 0);
        if (sub23 & ~SUB_FOX) launch_mega(P, p0 + 2, p0 + 3, sub23, st, false);
        if (!(cfg & C_SB)) n_sb_attn<<<dim3(SEQ / 256, 32), 256, 0, st>>>(SQ, SK, SV, YS);
        if (!(cfg & C_LRU)) n_lru<<<32, 64, 0, st>>>(LX, LG, in[8] + (size_t)l * 4 * DM, in[9] + l * DM, in[10] + (size_t)l * 16 * 64 * 64, in[11] + l * DM, in[12] + (size_t)l * 16 * 64 * 64, in[13] + l * DM, in[14] + l * DM, YL);
        if (!(cfg & C_MEM)) n_mem_attn<<<T * 4, 256, 0, st>>>(MQ, MK + (size_t)l * 512 * DM, MVT + (size_t)l * 512 * DM, YM);
        if (sub23 & (SUB_FOX | SUB_LRU | SUB_MEM)) launch_mega(P, p0 + 3, p0 + 4, sub23, st, false);
        if (!(cfg & C_FOX)) n_fox_attn<<<dim3(SEQ / 256, 32), 256, 0, st>>>(FQ, FK, FV, FB, YF);
        if (cfg & C_BR) launch_mega(P, p0 + 4, p0 + 5, SUB_ALL, st, false);
        else { const bf16_t* Y[4] = {YF, YL, YS, YM};
            for (int i = 0; i < 4; ++i) n_gemm<EBranch><<<dim3(1024 / 64, T / 64), 256, 0, st>>>(Y[i], in[19] + ((size_t)l * 4 + i) * DM * DM, DM, DM, DM, 0x7fffffff, EBranch{GATES, in[18] + ((size_t)l * 4 + i) * DM, i, 0}); }
        if (cfg & C_WOUT) launch_mega(P, p0 + 5, p0 + 6, SUB_ALL, st, false);
        else n_gemm<EResid><<<dim3(1024 / 64, T / 64), 256, 0, st>>>(GATES, in[20] + (size_t)l * DM * DM, 4096, DM, 4096, 1023, EResid{xcur, P.out});
        if (cfg & C_NORM2) launch_mega(P, p0 + 6, p0 + 7, SUB_ALL, st, false);
        else n_rmsnorm<<<T / 4, 256, 0, st>>>(P.out, in[21] + l * DM, H, nullptr, nullptr, nullptr, T);
        if (cfg & C_UP) launch_mega(P, p0 + 7, p0 + 8, SUB_ALL, st, false);
        else n_gemm<EStoreBf16><<<dim3(2 * DFF / 64, T / 64), 256, 0, st>>>(H, in[22] + (size_t)l * DM * 2 * DFF, DM, 2 * DFF, DM, 0x7fffffff, EStoreBf16{GV, 2 * DFF, 0});
        if (cfg & C_ACT) launch_mega(P, p0 + 8, p0 + 9, SUB_ALL, st, false);
        else n_act<<<(unsigned)(((size_t)T * DFF + 255) / 256), 256, 0, st>>>(GV, in[23] + (size_t)l * 3 * DFF, in[24] + l * DFF, ACT);
        if (cfg & C_DOWN) launch_mega(P, p0 + 9, p0 + 10, SUB_ALL, st, false);
        else n_gemm<EResid><<<dim3(1024 / 64, T / 64), 256, 0, st>>>(ACT, in[25] + (size_t)l * DFF * DM, DFF, DM, DFF, 0x7fffffff, EResid{P.out, P.out});
    }
}

extern "C" void kernel_launch(void* const* d_in, const int* in_sizes, int n_in, void* d_out, int out_size, void* d_ws, size_t ws_size, hipStream_t stream) {
    if (n_in != 26 || out_size != T * DM || ws_size < WS_END) { fprintf(stderr, "kernel_launch: unexpected sizes n_in %d out %d ws %zu (need %zu)\n", n_in, out_size, ws_size, (size_t)WS_END); return; }
    if (g_grid == 0) {
        int dev = 0, cus = 0, per_cu = 0;
        hipGetDevice(&dev); hipDeviceGetAttribute(&cus, hipDeviceAttributeMultiprocessorCount, dev);
        if (hipFuncSetAttribute((const void*)mega, hipFuncAttributeMaxDynamicSharedMemorySize, MEGA_LDS) != hipSuccess) fprintf(stderr, "kernel_launch: hipFuncSetAttribute failed\n");
        if (hipOccupancyMaxActiveBlocksPerMultiprocessor(&per_cu, (const void*)mega, MEGA_THREADS, MEGA_LDS) != hipSuccess || per_cu < 1) fprintf(stderr, "kernel_launch: occupancy query says %d\n", per_cu);
        (void)hipGetLastError();
        g_grid = cus;
        if (g_grid != 256) fprintf(stderr, "kernel_launch: %d CUs; the attention phase's static order assumes 256\n", g_grid);
    }
    Ptrs P{};
    for (int i = 0; i < 26; ++i) P.in[i] = (const float*)d_in[i];
    P.out = (float*)d_out; P.ws = (unsigned char*)d_ws;
    if ((CFG) & C_ONE) launch_mega(P, 0, N_PHASES, SUB_ALL, stream, true);
    else run_hybrid(P, stream);
}
```

```cpp
#include <hip/hip_runtime.h>
#include <cstdio>
#include <cstdint>
#include <hip/hip_cooperative_groups.h>

typedef unsigned short bf16_t;
constexpr int BATCH = 2, SEQ = 8192, DM = 1024, DEPTH = 4, T = BATCH * SEQ;
constexpr int NMEM = 256, NIN = 13328, DFF = 2816;
constexpr float EPS = 1e-6f;
constexpr float LOG2E = 1.4426950408889634f;
constexpr float C2 = 0.125f * LOG2E;
constexpr float SB_THR = -104.0f;

__device__ __forceinline__ float bf2f(bf16_t b) { return __uint_as_float(((unsigned)b) << 16); }
__device__ __forceinline__ bf16_t f2bf(float f) { unsigned u = __float_as_uint(f); return (bf16_t)((u + 0x7fffu + ((u >> 16) & 1u)) >> 16); }
__device__ __forceinline__ float bfr(float f) { return bf2f(f2bf(f)); }
__device__ __forceinline__ float wave_sum(float v) {
#pragma unroll
    for (int o = 1; o < 64; o <<= 1) v += __shfl_xor(v, o);
    return v;
}
__device__ __forceinline__ float softplusf(float x) { return fmaxf(x, 0.f) + log1pf(__expf(-fabsf(x))); }
__device__ __forceinline__ float logsigmoidf(float x) { return -softplusf(-x); }
__device__ __forceinline__ float sigmoidf_(float x) { return 1.f / (1.f + __expf(-x)); }
__device__ __forceinline__ float gelu_tanh(float x) { const float u = 0.7978845608028654f * (x + 0.044715f * x * x * x); return 0.5f * x * (1.f + tanhf(u)); }

__device__ __forceinline__ int mk_tid() { int t = threadIdx.x; asm volatile("" : "+v"(t)); return t; }

constexpr size_t MiB = 1u << 20;
constexpr size_t SZ_ACT = (size_t)T * DM * 2;
constexpr size_t WS_CTL = 0;
constexpr size_t WS_H = 1 * MiB;
constexpr size_t WS_PROJ = WS_H + SZ_ACT;
constexpr size_t WS_GATES = WS_PROJ + 9 * SZ_ACT;
constexpr size_t WS_E = WS_GATES + 4 * SZ_ACT;
constexpr size_t WS_LOGF = WS_E + SZ_ACT;
constexpr size_t WS_FB = WS_LOGF + 1 * MiB;
constexpr size_t WS_MQSS = WS_FB + 1 * MiB;
constexpr size_t WS_ESUM = WS_MQSS + 1 * MiB;
constexpr size_t WS_MEMN = WS_ESUM + 1 * MiB;
constexpr size_t WS_MEMRAW = WS_MEMN + 4 * MiB;
constexpr size_t WS_MK = WS_MEMRAW + 16 * MiB;
constexpr size_t WS_MVT = WS_MK + 4 * MiB;
constexpr size_t WS_LRU = WS_MVT + 4 * MiB;
constexpr size_t WS_WT = WS_LRU + 2 * MiB;
constexpr size_t WS_END = WS_WT + 72 * MiB;
constexpr size_t WS_YL = WS_PROJ + 6 * SZ_ACT, WS_YS = WS_H, WS_YM = WS_PROJ + 8 * SZ_ACT, WS_YF = WS_PROJ + 7 * SZ_ACT;
constexpr size_t WS_GV = WS_PROJ;
constexpr size_t WS_ACT = WS_GV + (size_t)T * 2 * DFF * 2;
static_assert(WS_ACT + (size_t)T * DFF * 2 <= WS_GATES, "ffn alias");

struct Ptrs {
    const float* in[26];
    float* out;
    unsigned char* ws;
};

__global__ void __launch_bounds__(256) n_rmsnorm(const float* __restrict__ x, const float* __restrict__ g, bf16_t* __restrict__ H,
                                                 const float* __restrict__ Wf, const float* __restrict__ bfg, float* __restrict__ LOGF, int nrows) {
    const int lane = threadIdx.x & 63, row = blockIdx.x * 4 + (threadIdx.x >> 6);
    if (row >= nrows) return;
    const float4* xr = (const float4*)(x + (size_t)row * DM);
    const float4* gr = (const float4*)g;
    float4 v[4]; float ss = 0.f;
#pragma unroll
    for (int j = 0; j < 4; ++j) { v[j] = xr[lane + 64 * j]; ss += v[j].x * v[j].x + v[j].y * v[j].y + v[j].z * v[j].z + v[j].w * v[j].w; }
    ss = wave_sum(ss);
    const float rstd = rsqrtf(ss * (1.f / DM) + EPS);
#pragma unroll
    for (int j = 0; j < 4; ++j) { const float4 gg = gr[lane + 64 * j]; v[j].x *= rstd * gg.x; v[j].y *= rstd * gg.y; v[j].z *= rstd * gg.z; v[j].w *= rstd * gg.w;
        ushort4 o; o.x = f2bf(v[j].x); o.y = f2bf(v[j].y); o.z = f2bf(v[j].z); o.w = f2bf(v[j].w);
        ((ushort4*)(H + (size_t)row * DM))[lane + 64 * j] = o; }
    if (Wf) {
        float mine = 0.f;
        for (int h = 0; h < 16; ++h) {
            float p = 0.f;
#pragma unroll
            for (int j = 0; j < 4; ++j) { const int k = (lane + 64 * j) * 4;
                p += v[j].x * Wf[(size_t)k * NIN + h] + v[j].y * Wf[(size_t)(k + 1) * NIN + h] + v[j].z * Wf[(size_t)(k + 2) * NIN + h] + v[j].w * Wf[(size_t)(k + 3) * NIN + h]; }
            p = wave_sum(p);
            if (lane == h) mine = p;
        }
        if (lane < 16) { const int b = row / SEQ, t = row % SEQ; LOGF[((size_t)b * 16 + lane) * SEQ + t] = logsigmoidf(mine + bfg[lane]); }
    }
}

struct EStoreBf16 { bf16_t* O; int ldc; int pad; __device__ void operator()(int m, int n, float a) const { O[(size_t)m * ldc + n] = f2bf(a); } };
struct EStoreF32 { float* O; int ldc; int pad; __device__ void operator()(int m, int n, float a) const { O[(size_t)m * ldc + n] = a; } };
struct EBranch { bf16_t* G; const float* bg; int i; int pad; __device__ void operator()(int m, int n, float a) const { bf16_t* p = G + (size_t)m * 4096 + i * 1024 + n; *p = f2bf(sigmoidf_(bf2f(*p) + bg[n]) * a); } };
struct EResid { const float* base; float* out; __device__ void operator()(int m, int n, float a) const { out[(size_t)m * DM + n] = base[(size_t)m * DM + n] + a; } };

template <class Epi> __global__ void __launch_bounds__(256) n_gemm(const bf16_t* __restrict__ A, const float* __restrict__ W, int lda, int ldw, int K, int kmask, Epi epi) {
    __shared__ float As[16][68], Bs[16][68];
    const int tx = threadIdx.x & 15, ty = threadIdx.x >> 4, m0 = blockIdx.y * 64, n0 = blockIdx.x * 64;
    float acc[4][4];
#pragma unroll
    for (int i = 0; i < 4; ++i)
#pragma unroll
        for (int j = 0; j < 4; ++j) acc[i][j] = 0.f;
    for (int k0 = 0; k0 < K; k0 += 16) {
#pragma unroll
        for (int i = 0; i < 4; ++i) { const int idx = threadIdx.x + i * 256; { const int r = idx >> 4, c = idx & 15; As[c][r] = bf2f(A[(size_t)(m0 + r) * lda + k0 + c]); }
            { const int r = idx >> 6, c = idx & 63; Bs[r][c] = bfr(W[(size_t)((k0 + r) & kmask) * ldw + n0 + c]); } }
        __syncthreads();
#pragma unroll
        for (int kk = 0; kk < 16; ++kk) { float a[4], b[4];
#pragma unroll
            for (int i = 0; i < 4; ++i) { a[i] = As[kk][ty * 4 + i]; b[i] = Bs[kk][tx * 4 + i]; }
#pragma unroll
            for (int i = 0; i < 4; ++i)
#pragma unroll
                for (int j = 0; j < 4; ++j) acc[i][j] += a[i] * b[j]; }
        __syncthreads();
    }
#pragma unroll
    for (int i = 0; i < 4; ++i)
#pragma unroll
        for (int j = 0; j < 4; ++j) epi(m0 + ty * 4 + i, n0 + tx * 4 + j, acc[i][j]);
}

__global__ void __launch_bounds__(256) n_headnorm(bf16_t* X, const float* __restrict__ g, int HD, float scale) {
    const int idx = blockIdx.x * 256 + threadIdx.x, nh = DM / HD, row = idx / nh, h = idx % nh;
    if (row >= T) return;
    bf16_t* p = X + (size_t)row * DM + h * HD; float ss = 0.f;
    for (int d = 0; d < HD; ++d) { const float v = bf2f(p[d]); ss += v * v; }
    const float rstd = rsqrtf(ss / HD + EPS) * scale;
    for (int d = 0; d < HD; ++d) p[d] = f2bf(bf2f(p[d]) * rstd * g[d]);
}

__global__ void __launch_bounds__(1024) n_cumsum(const float* __restrict__ LOGF, float* __restrict__ FB) {
    __shared__ float part[1024];
    const int bh = blockIdx.x, tid = threadIdx.x; const float* src = LOGF + (size_t)bh * SEQ + tid * 8; float v[8]; float s = 0.f;
#pragma unroll
    for (int i = 0; i < 8; ++i) { s += src[i]; v[i] = s; }
    part[tid] = s; __syncthreads();
    if (tid == 0) { float run = 0.f; for (int i = 0; i < 1024; ++i) { const float t_ = part[i]; part[i] = run; run += t_; } }
    __syncthreads();
    const float off = part[tid]; float* dst = FB + (size_t)bh * SEQ + tid * 8;
#pragma unroll
    for (int i = 0; i < 8; ++i) dst[i] = off + v[i];
}

__global__ void __launch_bounds__(256) n_fox_attn(const bf16_t* Q, const bf16_t* __restrict__ K, const bf16_t* __restrict__ V, const float* __restrict__ FB, bf16_t* O) {
    __shared__ float Ks[64][64], Vs[64][64], Fs[64];
    const int bh = blockIdx.y, b = bh >> 4, h = bh & 15, tq = blockIdx.x * 256 + threadIdx.x;
    const size_t rowq = (size_t)b * SEQ + tq;
    float q[64], o[64];
#pragma unroll
    for (int d = 0; d < 64; ++d) { q[d] = bf2f(Q[rowq * DM + h * 64 + d]); o[d] = 0.f; }
    const float Ft = FB[(size_t)bh * SEQ + tq];
    float m = -INFINITY, l = 0.f;
    const int ntile = (blockIdx.x * 256 + 256) / 64;
    for (int kt = 0; kt < ntile; ++kt) {
        __syncthreads();
        for (int i = threadIdx.x; i < 64 * 64; i += 256) { const int r = i >> 6, c = i & 63; const size_t rk = ((size_t)b * SEQ + kt * 64 + r) * DM + h * 64 + c; Ks[r][c] = bf2f(K[rk]); Vs[r][c] = bf2f(V[rk]); }
        if (threadIdx.x < 64) Fs[threadIdx.x] = FB[(size_t)bh * SEQ + kt * 64 + threadIdx.x];
        __syncthreads();
        for (int j = 0; j < 64; ++j) {
            const int s = kt * 64 + j; if (s > tq) break;
            float z = 0.f;
#pragma unroll
            for (int d = 0; d < 64; ++d) z += q[d] * Ks[j][d];
            z += (Ft - Fs[j]) * LOG2E;
            if (z > m) { const float c = exp2f(m - z); l *= c;
#pragma unroll
                for (int d = 0; d < 64; ++d) o[d] *= c;
                m = z; }
            const float p = exp2f(z - m); l += p;
#pragma unroll
            for (int d = 0; d < 64; ++d) o[d] += p * Vs[j][d];
        }
    }
    const float il = 1.f / l;
#pragma unroll
    for (int d = 0; d < 64; ++d) O[rowq * DM + h * 64 + d] = f2bf(o[d] * il);
}

__global__ void __launch_bounds__(256) n_sb_attn(const bf16_t* Q, const bf16_t* __restrict__ K, const bf16_t* __restrict__ V, bf16_t* O) {
    __shared__ float Ks[64][64], Vs[64][64];
    const int bh = blockIdx.y, b = bh >> 4, h = bh & 15, tq = blockIdx.x * 256 + threadIdx.x;
    const size_t rowq = (size_t)b * SEQ + tq;
    float q[64], o[64];
#pragma unroll
    for (int d = 0; d < 64; ++d) { q[d] = bf2f(Q[rowq * DM + h * 64 + d]) * 0.125f; o[d] = 0.f; }
    float R = 0.f;
    for (int kt = (blockIdx.x * 256 + 255) / 64; kt >= 0; --kt) {
        if (__syncthreads_and(R < SB_THR)) break;
        for (int i = threadIdx.x; i < 64 * 64; i += 256) { const int r = i >> 6, c = i & 63; const size_t rk = ((size_t)b * SEQ + kt * 64 + r) * DM + h * 64 + c; Ks[r][c] = bf2f(K[rk]); Vs[r][c] = bf2f(V[rk]); }
        __syncthreads();
        for (int j = 63; j >= 0; --j) {
            const int s = kt * 64 + j; if (s >= tq) continue;
            float z = 0.f;
#pragma unroll
            for (int d = 0; d < 64; ++d) z += q[d] * Ks[j][d];
            const float sp = softplusf(z);
            const float w = __expf((z - sp) + R);
            R -= sp;
#pragma unroll
            for (int d = 0; d < 64; ++d) o[d] += w * Vs[j][d];
        }
    }
#pragma unroll
    for (int d = 0; d < 64; ++d) O[rowq * DM + h * 64 + d] = f2bf(o[d]);
}

__global__ void __launch_bounds__(64) n_lru(const bf16_t* LX, const bf16_t* __restrict__ LG, const float* __restrict__ cw, const float* __restrict__ cb,
                                            const float* __restrict__ wa, const float* __restrict__ ba, const float* __restrict__ wx, const float* __restrict__ bx,
                                            const float* __restrict__ lam, bf16_t* YL) {
    __shared__ float xs[64];
    const int b = blockIdx.x >> 4, n = blockIdx.x & 15, e = threadIdx.x, ch = n * 64 + e;
    float wA[64], wX[64];
#pragma unroll
    for (int d = 0; d < 64; ++d) { wA[d] = wa[((size_t)n * 64 + d) * 64 + e]; wX[d] = wx[((size_t)n * 64 + d) * 64 + e]; }
    const float w0 = cw[ch], w1 = cw[DM + ch], w2 = cw[2 * DM + ch], w3 = cw[3 * DM + ch], bc = cb[ch], bA = ba[ch], bX = bx[ch];
    const float spl = softplusf(-lam[ch]);
    float x1 = 0.f, x2 = 0.f, x3 = 0.f, hs = 0.f;
    for (int t = 0; t < SEQ; ++t) {
        const size_t r = ((size_t)b * SEQ + t) * DM + ch;
        const float x0 = bf2f(LX[r]);
        const float xc = bc + w3 * x0 + w2 * x1 + w1 * x2 + w0 * x3;
        x3 = x2; x2 = x1; x1 = x0;
        __syncthreads();
        xs[e] = xc;
        __syncthreads();
        float ra = bA, ri = bX;
#pragma unroll
        for (int d = 0; d < 64; ++d) { const float xv = xs[d]; ra += xv * wA[d]; ri += xv * wX[d]; }
        const float rr = sigmoidf_(ra), ii = sigmoidf_(ri);
        const float la = -8.f * rr * spl;
        const float a = __expf(la);
        const float u = sqrtf(-expm1f(2.f * la)) * (ii * xc);
        hs = a * hs + u;
        YL[r] = f2bf(hs * gelu_tanh(bf2f(LG[r])));
    }
}

__global__ void __launch_bounds__(256) n_memkv_post(const float* __restrict__ raw, const float* __restrict__ gk, const float* __restrict__ gq, bf16_t* __restrict__ MK, bf16_t* __restrict__ MVT) {
    const int row = blockIdx.x, b = row >> 8, m = row & 255, d = threadIdx.x;
    __shared__ float red[4];
    for (int h = 0; h < 4; ++h) {
        const float k = raw[(size_t)row * 2048 + h * 256 + d];
        float ss = wave_sum(k * k);
        __syncthreads();
        if ((threadIdx.x & 63) == 0) red[threadIdx.x >> 6] = ss;
        __syncthreads();
        ss = red[0] + red[1] + red[2] + red[3];
        const float rstd = rsqrtf(ss * (1.f / 256.f) + EPS);
        MK[((size_t)b * 256 + m) * DM + h * 256 + d] = f2bf(k * rstd * gk[d] * gq[d]);
        MVT[(((size_t)b * 4 + h) * 256 + d) * 256 + m] = f2bf(raw[(size_t)row * 2048 + 1024 + h * 256 + d]);
    }
}

__global__ void __launch_bounds__(256) n_mem_attn(const bf16_t* MQ, const bf16_t* __restrict__ MK, const bf16_t* __restrict__ MVT, bf16_t* YM) {
    __shared__ float qs[256], ps[256], red[4];
    const int row = blockIdx.x >> 2, h = blockIdx.x & 3, b = row / SEQ, tid = threadIdx.x;
    const float qv = bf2f(MQ[(size_t)row * DM + h * 256 + tid]);
    float ss = wave_sum(qv * qv);
    if ((tid & 63) == 0) red[tid >> 6] = ss;
    qs[tid] = qv;
    __syncthreads();
    const float rstd = rsqrtf((red[0] + red[1] + red[2] + red[3]) * (1.f / 256.f) + EPS);
    const bf16_t* kr = MK + ((size_t)b * 256 + tid) * DM + h * 256;
    float s = 0.f;
    for (int d = 0; d < 256; ++d) s += qs[d] * bf2f(kr[d]);
    s *= rstd * (1.f / 16.f);
    __syncthreads();
    float mx = s;
#pragma unroll
    for (int o = 1; o < 64; o <<= 1) mx = fmaxf(mx, __shfl_xor(mx, o));
    if ((tid & 63) == 0) red[tid >> 6] = mx;
    __syncthreads();
    mx = fmaxf(fmaxf(red[0], red[1]), fmaxf(red[2], red[3]));
    const float p = __expf(s - mx);
    ps[tid] = p;
    float sum = wave_sum(p);
    __syncthreads();
    if ((tid & 63) == 0) red[tid >> 6] = sum;
    __syncthreads();
    sum = red[0] + red[1] + red[2] + red[3];
    const bf16_t* vr = MVT + (((size_t)b * 4 + h) * 256 + tid) * 256;
    float o = 0.f;
    for (int m = 0; m < 256; ++m) o += ps[m] * bf2f(vr[m]);
    YM[(size_t)row * DM + h * 256 + tid] = f2bf(o / sum);
}

__global__ void __launch_bounds__(256) n_act(const bf16_t* __restrict__ GV, const float* __restrict__ cw, const float* __restrict__ cb, bf16_t* __restrict__ ACT) {
    const size_t idx = (size_t)blockIdx.x * 256 + threadIdx.x; if (idx >= (size_t)T * DFF) return;
    const int r = (int)(idx / DFF), c = (int)(idx % DFF), t = r % SEQ;
    const float g0 = bf2f(GV[(size_t)r * 2 * DFF + c]);
    const float g1 = t >= 1 ? bf2f(GV[(size_t)(r - 1) * 2 * DFF + c]) : 0.f;
    const float g2 = t >= 2 ? bf2f(GV[(size_t)(r - 2) * 2 * DFF + c]) : 0.f;
    const float pre = cb[c] + cw[2 * DFF + c] * g0 + cw[DFF + c] * g1 + cw[c] * g2;
    const float val = bf2f(GV[(size_t)r * 2 * DFF + DFF + c]);
    ACT[(size_t)r * DFF + c] = f2bf(pre * sigmoidf_(pre) * val);
}

#define CFG 32767
namespace pg8 {
#define PG8_LAS __attribute__((address_space(3)))
typedef unsigned short bf16_t;
typedef short bf16x8 __attribute__((ext_vector_type(8)));
typedef float f32x4 __attribute__((ext_vector_type(4)));
typedef unsigned u32x4 __attribute__((ext_vector_type(4)));
constexpr int BM = 256, BK = 64, HALF = 128, HTB = HALF * BK * 2  , STAGE_BYTES = 8 * HTB, NXCD = 8, WGM = 8;

__host__ __device__ __forceinline__ int lds_byte(int r, int c) { const int st = (r >> 4) * 2 + (c >> 5), rr = r & 15, cc = c & 31, ob = rr * 64 + cc * 2; return st * 1024 + (ob ^ (((ob >> 9) & 1) << 5)); }
__host__ __device__ __forceinline__ void stage_rc(int b, int& R, int& C) { const int st = b / 1024, sb = b % 1024, swz = sb ^ (((sb >> 9) & 1) << 5); R = (st >> 1) * 16 + swz / 64; C = (st & 1) * 32 + (swz % 64) / 2; }
__host__ __device__ __forceinline__ int perm32(int rho) { const int n = rho >> 4, i = rho & 15; return 8 * (i >> 2) + 4 * n + (i & 3); }

struct Unit { int pm, pn; };
struct Gemm { int lda, ldb, K; };

struct StaticOrder {
    int nM, nN, nwg, G, c;
    __host__ __device__ void init(int M, int N, int G_, int c_) { nM = M / BM; nN = N / BM; nwg = nM * nN; G = G_; c = c_; }
    __host__ __device__ bool next(int i, Unit& u) const {
        const long L = (long)i * G + c; if (L >= nwg) return false;
        int wgid = (int)L; { const int q = nwg / NXCD, r = nwg % NXCD, xcd = wgid % NXCD, off = wgid / NXCD; wgid = (xcd < r ? xcd * (q + 1) : r * (q + 1) + (xcd - r) * q) + off; }
        const int nig = WGM * nN, gid = wgid / nig, fm = gid * WGM, gsz = (nM - fm) < WGM ? (nM - fm) : WGM;
        u.pm = fm + ((wgid % nig) % gsz); u.pn = (wgid % nig) / gsz; return true;
    }
    __device__ __forceinline__ void a_ready(const Unit&) const {}
    __device__ __forceinline__ void done(const Unit&) const {}
};

__device__ __forceinline__ unsigned cvt_pk_bf16(float lo, float hi) { unsigned r; asm volatile("v_cvt_pk_bf16_f32 %0, %1, %2" : "=v"(r) : "v"(lo), "v"(hi)); return r; }
typedef float f32x2 __attribute__((ext_vector_type(2)));
__device__ __forceinline__ f32x2 gelu_pk(f32x2 v) {
    const f32x2 av = __builtin_elementwise_abs(v), d = av * 0.2316418882f + 1.0f;
    f32x2 t; t.x = __builtin_amdgcn_rcpf(d.x); t.y = __builtin_amdgcn_rcpf(d.y);
    f32x2 q = t * 0.5307027145f + (-0.7265760135f); q = q * t + 0.7107068705f; q = q * t + (-0.142248368f); q = q * t + 0.127414796f; q = q * t;
    const f32x2 s = (v * v) * (-0.72134752044f);
    f32x2 e; e.x = __builtin_amdgcn_exp2f(s.x); e.y = __builtin_amdgcn_exp2f(s.y);
    const f32x2 m = v * (q * e), r = v - m;
    f32x2 o; o.x = v.x < 0.f ? m.x : r.x; o.y = v.y < 0.f ? m.y : r.y; return o;
}

template <class Epi, class Sched, bool ALIGN_EPI = false, bool SP2 = false>
__device__ __forceinline__ void gemm_phase(PG8_LAS unsigned char* lds, const Gemm g, const Sched& S, const Epi& E) {
    const int tid = mk_tid(), wid = __builtin_amdgcn_readfirstlane(tid >> 6), lane = tid & 63, wr = wid >> 2, wc = wid & 3, fr = lane & 15, fq = lane >> 4;
    const int K = g.K, nt = K / BK;
    unsigned voffA[2], voffB[2];
#pragma unroll
    for (int i = 0; i < 2; ++i) { int R, C; stage_rc(tid * 16 + i * 8192, R, C); const int Rb = Epi::PERM ? ((R & ~31) + perm32(R & 31)) : R;
        voffA[i] = (unsigned)(R * g.lda + C) * 2u; voffB[i] = (unsigned)(Rb * g.ldb + C) * 2u; }
    const size_t kstep = (size_t)(BK * 2);
    const size_t hstepA = (size_t)HALF * g.lda * 2, hstepB = (size_t)HALF * g.ldb * 2;
    const unsigned ldsw = (unsigned)wid * 1024u;
    const int aoff = lds_byte(wr * 64 + fr, fq * 8), boff = lds_byte(wc * 32 + fr, fq * 8);
#define PG8_SA(b, h) (((b) * 2 + (h)) * HTB)
#define PG8_SB(b, h) ((4 + (b) * 2 + (h)) * HTB)
#define PG8_STAGE(bufoff, gbase, voff) do { _Pragma("unroll") for (int _i = 0; _i < 2; ++_i) \
        __builtin_amdgcn_global_load_lds((const unsigned*)((const char*)(gbase) + (voff)[_i]), (PG8_LAS unsigned*)(lds + (bufoff) + ldsw + _i * 8192), 16, 0, 0); } while (0)
#define PG8_LDA(dst, b, h) do { _Pragma("unroll") for (int m = 0; m < 4; ++m) _Pragma("unroll") for (int k = 0; k < 2; ++k) dst[m][k] = *(const PG8_LAS bf16x8*)(lds + PG8_SA(b, h) + aoff + m * 2048 + k * 1024); } while (0)
#define PG8_LDB(dst, b, h) do { _Pragma("unroll") for (int n = 0; n < 2; ++n) _Pragma("unroll") for (int k = 0; k < 2; ++k) dst[n][k] = *(const PG8_LAS bf16x8*)(lds + PG8_SB(b, h) + boff + n * 2048 + k * 1024); } while (0)
#define PG8_MMA(ai, bj, At, Bt) do { __builtin_amdgcn_s_setprio(1); _Pragma("unroll") for (int m = 0; m < 4; ++m) _Pragma("unroll") for (int n = 0; n < 2; ++n) _Pragma("unroll") for (int k = 0; k < 2; ++k) \
        acc[ai][bj][m][n] = __builtin_amdgcn_mfma_f32_16x16x32_bf16(Bt[n][k], At[m][k], acc[ai][bj][m][n], 0, 0, 0); __builtin_amdgcn_s_setprio(0); } while (0)
#define PG8_WAIT_V(n) asm volatile("s_waitcnt vmcnt(" #n ")" ::: "memory")
#define PG8_WAIT_L(n) asm volatile("s_waitcnt lgkmcnt(" #n ")" ::: "memory")
#define PG8_BAR __builtin_amdgcn_s_barrier()
#define PG8_SCHED __builtin_amdgcn_sched_barrier(0)
    Unit cur, nxt; int ui = 0;
    if (!S.next(0, cur)) return;
    f32x4 acc[2][2][4][2];
#pragma unroll
    for (int a = 0; a < 2; ++a)
#pragma unroll
        for (int b = 0; b < 2; ++b)
#pragma unroll
            for (int m = 0; m < 4; ++m)
#pragma unroll
                for (int n = 0; n < 2; ++n) acc[a][b][m][n] = (f32x4){0.f, 0.f, 0.f, 0.f};
    bf16x8 At[4][2], B0[2][2], B1[2][2];
    const char* cA = S.aptr(cur); const char* cB = S.bptr(cur);
    S.a_ready(cur);
    if constexpr (SP2) {
        PG8_STAGE(PG8_SB(0, 0), cB, voffB); PG8_STAGE(PG8_SB(0, 1), cB + hstepB, voffB); PG8_STAGE(PG8_SA(0, 0), cA, voffA); PG8_STAGE(PG8_SA(0, 1), cA + hstepA, voffA);
        if (wr == 1) PG8_BAR;
        PG8_WAIT_V(2); PG8_BAR;
        PG8_STAGE(PG8_SB(1, 0), cB + kstep, voffB); PG8_STAGE(PG8_SA(1, 0), cA + kstep, voffA); PG8_STAGE(PG8_SB(1, 1), cB + hstepB + kstep, voffB);
        PG8_WAIT_V(6); PG8_BAR;
    } else {
        PG8_STAGE(PG8_SB(0, 0), cB, voffB); PG8_STAGE(PG8_SA(0, 0), cA, voffA); PG8_STAGE(PG8_SB(0, 1), cB + hstepB, voffB); PG8_STAGE(PG8_SA(0, 1), cA + hstepA, voffA);
        if (wr == 1) PG8_BAR;
        PG8_WAIT_V(4); PG8_BAR;
        PG8_STAGE(PG8_SB(1, 0), cB + kstep, voffB); PG8_STAGE(PG8_SA(1, 0), cA + kstep, voffA); PG8_STAGE(PG8_SB(1, 1), cB + hstepB + kstep, voffB);
        PG8_WAIT_V(6); PG8_BAR;
    }
    for (;;) {
        const bool has_next = S.next(ui + 1, nxt);
        const char* nA = has_next ? S.aptr(nxt) : cA; const char* nB = has_next ? S.bptr(nxt) : cB;
        for (int t = 0; t < nt; t += 2) {
            const bool last = (t == nt - 2);
            const char* a1 = cA + (size_t)(t + 1) * kstep;
            const char* a2 = last ? nA : cA + (size_t)(t + 2) * kstep; const char* b2 = last ? nB : cB + (size_t)(t + 2) * kstep;
            const char* a3 = a2 + kstep; const char* b3 = b2 + kstep;
            if (last && has_next) S.a_ready(nxt);
            if constexpr (SP2) {
            PG8_LDB(B0, 0, 0); PG8_LDB(B1, 0, 1); PG8_SCHED; PG8_LDA(At, 0, 0); PG8_STAGE(PG8_SA(1, 1), a1 + hstepA, voffA);
            PG8_WAIT_V(8); PG8_WAIT_L(0); PG8_BAR; PG8_MMA(0, 0, At, B0); PG8_MMA(0, 1, At, B1); PG8_BAR; PG8_SCHED;
            PG8_LDA(At, 0, 1); PG8_STAGE(PG8_SB(0, 0), b2, voffB); PG8_STAGE(PG8_SB(0, 1), b2 + hstepB, voffB); PG8_STAGE(PG8_SA(0, 0), a2, voffA);
            PG8_WAIT_V(8); PG8_WAIT_L(0); PG8_BAR; PG8_MMA(1, 0, At, B0); PG8_MMA(1, 1, At, B1); PG8_BAR; PG8_SCHED;
            PG8_LDB(B0, 1, 0); PG8_LDB(B1, 1, 1); PG8_SCHED; PG8_LDA(At, 1, 0); PG8_STAGE(PG8_SA(0, 1), a2 + hstepA, voffA);
            PG8_WAIT_V(8); PG8_WAIT_L(0); PG8_BAR; PG8_MMA(0, 0, At, B0); PG8_MMA(0, 1, At, B1); PG8_BAR; PG8_SCHED;
            PG8_LDA(At, 1, 1); PG8_STAGE(PG8_SB(1, 0), b3, voffB); PG8_STAGE(PG8_SB(1, 1), b3 + hstepB, voffB); PG8_STAGE(PG8_SA(1, 0), a3, voffA);
            PG8_WAIT_V(8); PG8_WAIT_L(0); PG8_BAR; PG8_MMA(1, 0, At, B0); PG8_MMA(1, 1, At, B1); PG8_BAR; PG8_SCHED;
            } else {
            PG8_LDB(B0, 0, 0); PG8_SCHED; PG8_LDA(At, 0, 0); PG8_STAGE(PG8_SA(1, 1), a1 + hstepA, voffA);
            PG8_WAIT_L(8); PG8_BAR; PG8_WAIT_L(0); PG8_MMA(0, 0, At, B0); PG8_BAR; PG8_SCHED;
            PG8_LDB(B1, 0, 1); PG8_STAGE(PG8_SB(0, 0), b2, voffB);
            PG8_BAR; PG8_WAIT_L(0); PG8_MMA(0, 1, At, B1); PG8_BAR;
            PG8_LDA(At, 0, 1); PG8_STAGE(PG8_SA(0, 0), a2, voffA);
            PG8_BAR; PG8_WAIT_L(0); PG8_MMA(1, 0, At, B0); PG8_BAR; PG8_SCHED;
            PG8_STAGE(PG8_SB(0, 1), b2 + hstepB, voffB);
            PG8_WAIT_V(6); PG8_BAR; PG8_MMA(1, 1, At, B1); PG8_BAR;
            PG8_LDB(B0, 1, 0); PG8_SCHED; PG8_LDA(At, 1, 0); PG8_STAGE(PG8_SA(0, 1), a2 + hstepA, voffA);
            PG8_WAIT_L(8); PG8_BAR; PG8_WAIT_L(0); PG8_MMA(0, 0, At, B0); PG8_BAR; PG8_SCHED;
            PG8_LDB(B1, 1, 1); PG8_STAGE(PG8_SB(1, 0), b3, voffB);
            PG8_BAR; PG8_WAIT_L(0); PG8_MMA(0, 1, At, B1); PG8_BAR;
            PG8_LDA(At, 1, 1); PG8_STAGE(PG8_SA(1, 0), a3, voffA);
            PG8_BAR; PG8_WAIT_L(0); PG8_MMA(1, 0, At, B0); PG8_BAR; PG8_SCHED;
            PG8_STAGE(PG8_SB(1, 1), b3 + hstepB, voffB);
            PG8_WAIT_V(6); PG8_BAR; PG8_MMA(1, 1, At, B1); PG8_BAR;
            }
        }
        if constexpr (ALIGN_EPI) { if (wr == 0) PG8_BAR; }
        if constexpr (!Epi::AFTER_DRAIN) { int fr_ = fr, fq_ = fq; asm volatile("" : "+v"(fr_), "+v"(fq_));   E(acc, cur, wr, wc, fr_, fq_); S.done(cur); }
        if (!has_next) break;
#pragma unroll
        for (int a = 0; a < 2; ++a)
#pragma unroll
            for (int b = 0; b < 2; ++b)
#pragma unroll
                for (int m = 0; m < 4; ++m)
#pragma unroll
                    for (int n = 0; n < 2; ++n) acc[a][b][m][n] = (f32x4){0.f, 0.f, 0.f, 0.f};
        cur = nxt; cA = nA; cB = nB; ++ui;
        if constexpr (ALIGN_EPI) { if (wr == 1) PG8_BAR; }
    }
    PG8_WAIT_V(0);
    if constexpr (!ALIGN_EPI) { if (wr == 0) PG8_BAR; }
    PG8_BAR;
    if constexpr (Epi::AFTER_DRAIN) { E.fused(acc, cur, wr, wc, fr, fq, lds, wid, lane); S.done(cur); }
#undef PG8_SA
#undef PG8_SB
#undef PG8_STAGE
#undef PG8_LDA
#undef PG8_LDB
#undef PG8_MMA
#undef PG8_WAIT_V
#undef PG8_WAIT_L
#undef PG8_BAR
#undef PG8_SCHED
}
}
#include <hip/hip_bf16.h>
#include <cmath>
namespace attn_body {
using bf16=__hip_bfloat16;
using bf16x8=__attribute__((ext_vector_type(8)))short;
using s16x4=__attribute__((ext_vector_type(4)))short;
using f32x16=__attribute__((ext_vector_type(16)))float;
using u32x4=__attribute__((ext_vector_type(4)))unsigned;
constexpr int BATCH=2,NHEAD=16,SEQ=8192,D=64,DM=NHEAD*D;
constexpr int NW=8,QBLK=32,QB=QBLK*NW,KVBLK=64,NQB=SEQ/QB;
constexpr int ATTN_PITCH=DM, ATTN_UNIT_ROWS=QB;
__device__ __forceinline__ int crow(int r,int hi){return (r&3)+8*(r>>2)+4*hi;}
#define SBAR() __builtin_amdgcn_sched_barrier(0)
__device__ __forceinline__ void cmask(f32x16&p0,f32x16&p1,int jb,int qrel,int hi){
  const float NEG=-INFINITY; int kb=64*jb+4*hi;
  #pragma unroll
  for(int r=0;r<16;++r){int kv=kb+(r&3)+8*(r>>2); if(kv>qrel)p0[r]=NEG; if(kv+32>qrel)p1[r]=NEG;}
}

constexpr int NSLOT=3, SLOTB=8192;
constexpr int LDS_K=0, LDS_V=NSLOT*SLOTB, LDS_WS=2*NSLOT*SLOTB, LDS_OST=LDS_WS+NW*64*4, LDS_BYTES=LDS_OST+NW*4096;
constexpr int BIAS_OFF=86016;
constexpr float C2=0.125f*1.4426950408889634f;
__device__ __forceinline__ void glds16(const void*gsrc,unsigned lds_dst){unsigned keep;
  asm volatile("s_mov_b32 %0, m0\n\ts_mov_b32 m0, %2\n\ts_nop 0\n\tglobal_load_lds_dwordx4 %1, off\n\ts_mov_b32 m0, %0":"=&s"(keep):"v"(gsrc),"s"(lds_dst):"memory");}
__device__ __forceinline__ float max3f(float a,float b,float c){float r;asm("v_max3_f32 %0, %1, %2, %3":"=v"(r):"v"(a),"v"(b),"v"(c));return r;}
__device__ __forceinline__ float max2f(float a,float b){float r;asm("v_max_f32_e32 %0, %1, %2":"=v"(r):"v"(a),"v"(b));return r;}
__device__ __forceinline__ float fadd_s(float a,float b){float r;asm("v_add_f32_e32 %0, %1, %2":"=v"(r):"v"(a),"v"(b));return r;}
__device__ __forceinline__ float fsub_s(float a,float b){float r;asm("v_sub_f32_e32 %0, %1, %2":"=v"(r):"v"(a),"v"(b));return r;}
typedef float f32x2_t __attribute__((ext_vector_type(2))); typedef __bf16 bf16x2_t __attribute__((ext_vector_type(2)));
__device__ __forceinline__ unsigned cvtpk_s(float lo,float hi){f32x2_t v={lo,hi};bf16x2_t b=__builtin_convertvector(v,bf16x2_t);return __builtin_bit_cast(unsigned,b);}
#define WAIT_BAR(N) asm volatile("s_waitcnt vmcnt(" #N ") lgkmcnt(0)\n\ts_barrier":::"memory")

__device__ __forceinline__ void qkt(f32x16&p0,f32x16&p1,const char*Kslot,const bf16x8*qr,const f32x16&negm,int r32,int hi){
  const char*kb=Kslot+hi*1024+r32*16;
  #pragma unroll
  for(int d0=0;d0<4;++d0){
    const bf16x8 b0=*reinterpret_cast<const bf16x8*>(kb+d0*2048);
    const bf16x8 b1=*reinterpret_cast<const bf16x8*>(kb+d0*2048+512);
    if(d0==0){p0=__builtin_amdgcn_mfma_f32_32x32x16_bf16(b0,qr[0],negm,0,0,0);p1=__builtin_amdgcn_mfma_f32_32x32x16_bf16(b1,qr[0],negm,0,0,0);}
    else{p0=__builtin_amdgcn_mfma_f32_32x32x16_bf16(b0,qr[d0],p0,0,0,0);p1=__builtin_amdgcn_mfma_f32_32x32x16_bf16(b1,qr[d0],p1,0,0,0);}}
}
typedef __attribute__((address_space(3))) const char* lds_cptr;
typedef short v4i16_t __attribute__((ext_vector_type(4)));
__device__ __forceinline__ void kload8(bf16x8*kf,lds_cptr kp){
  kf[0]=*(const __attribute__((address_space(3))) bf16x8*)(kp);      kf[1]=*(const __attribute__((address_space(3))) bf16x8*)(kp+512);
  kf[2]=*(const __attribute__((address_space(3))) bf16x8*)(kp+2048); kf[3]=*(const __attribute__((address_space(3))) bf16x8*)(kp+2560);
  kf[4]=*(const __attribute__((address_space(3))) bf16x8*)(kp+4096); kf[5]=*(const __attribute__((address_space(3))) bf16x8*)(kp+4608);
  kf[6]=*(const __attribute__((address_space(3))) bf16x8*)(kp+6144); kf[7]=*(const __attribute__((address_space(3))) bf16x8*)(kp+6656);
}
__device__ __forceinline__ void kload2(bf16x8*kf,lds_cptr kp,int j){ kf[2*j]=*(const __attribute__((address_space(3))) bf16x8*)(kp+j*2048); kf[2*j+1]=*(const __attribute__((address_space(3))) bf16x8*)(kp+j*2048+512); }
__device__ __forceinline__ s16x4 vtr(lds_cptr p){ return __builtin_bit_cast(s16x4,__builtin_amdgcn_ds_read_tr16_b64_v4i16((__attribute__((address_space(3))) v4i16_t*)p)); }
__device__ __forceinline__ float rowmax(const f32x16&p0,const f32x16&p1){
  float a=max3f(p0[0],p0[1],p1[0]),b=max3f(p0[2],p0[3],p1[1]);a=max3f(a,p1[2],p1[3]);
  #pragma unroll
  for(int r=4;r<16;r+=4){a=max3f(a,p0[r],p0[r+1]);b=max3f(b,p0[r+2],p0[r+3]);a=max3f(a,p1[r],p1[r+1]);b=max3f(b,p1[r+2],p1[r+3]);}
  const float m=max2f(a,b);
  auto rr=__builtin_amdgcn_permlane32_swap(__float_as_uint(m),__float_as_uint(m),false,false);
  return max2f(__uint_as_float(rr[0]),__uint_as_float(rr[1]));
}
__device__ __forceinline__ void pv(f32x16*o,int vb,bf16x8 pa0,bf16x8 pa1,bf16x8 pa2,bf16x8 pa3){
  #pragma unroll
  for(int d0=0;d0<2;++d0){s16x4 lo[4],hi[4];
    #pragma unroll
    for(int ks=0;ks<4;++ks){
      asm volatile("ds_read_b64_tr_b16 %0,%1 offset:%c2":"=&v"(lo[ks]):"v"(vb),"i"(d0*4096+ks*1024):"memory");
      asm volatile("ds_read_b64_tr_b16 %0,%1 offset:%c2":"=&v"(hi[ks]):"v"(vb),"i"(d0*4096+ks*1024+512):"memory");}
    asm volatile("s_waitcnt lgkmcnt(0)":::"memory");SBAR();
    #define PK(k) (bf16x8){lo[k][0],lo[k][1],lo[k][2],lo[k][3],hi[k][0],hi[k][1],hi[k][2],hi[k][3]}
    o[d0]=__builtin_amdgcn_mfma_f32_32x32x16_bf16(pa0,PK(0),o[d0],0,0,0);
    o[d0]=__builtin_amdgcn_mfma_f32_32x32x16_bf16(pa1,PK(1),o[d0],0,0,0);
    o[d0]=__builtin_amdgcn_mfma_f32_32x32x16_bf16(pa2,PK(2),o[d0],0,0,0);
    o[d0]=__builtin_amdgcn_mfma_f32_32x32x16_bf16(pa3,PK(3),o[d0],0,0,0);
    #undef PK
  }
}

#ifndef ATTN_STORE16
#define ATTN_STORE16(p,v) (*(u32x4*)(p)=(v))
#endif
template<int THRL> __device__ __forceinline__ void attn_unit(int b,int h,int qb,const bf16*Q,const bf16*__restrict__ K,const bf16*__restrict__ V,bf16*O,const float*__restrict__ FBrow,char*shm){
  const int tid=mk_tid(),lane=tid&63,r32=lane&31,hi=lane>>5; const int wid=__builtin_amdgcn_readfirstlane(tid>>6);
  const long rowbase=(long)b*SEQ; const int q0=qb*QB;
  const bf16*Qw=Q+(rowbase+q0+wid*QBLK)*DM+h*D;
  const bf16*Kh=K+rowbase*DM+h*D,*Vh=V+rowbase*DM+h*D;
  const lds_cptr shm3=(lds_cptr)shm;
  const unsigned lds0=(unsigned)(uintptr_t)shm;
  float*wsf=(float*)(shm+LDS_WS)+wid*64;
  const bf16*ksrc=Kh+(long)lane*DM+wid*8;
  const bf16*vsrc=Vh+(long)(16*(wid&3)+(lane>>2))*DM+(wid>>2)*32+(lane&3)*8;
  const unsigned kdst=lds0+LDS_K+wid*1024, vdst=lds0+LDS_V+wid*1024;
  #define DMA_K(t,slot) glds16(ksrc+(long)(t)*KVBLK*DM,(unsigned)__builtin_amdgcn_readfirstlane(kdst+(slot)))
  #define DMA_V(t,slot) glds16(vsrc+(long)(t)*KVBLK*DM,(unsigned)__builtin_amdgcn_readfirstlane(vdst+(slot)))
  const int vb0=(int)(lds0+LDS_V)+((lane>>4)&1)*32+(lane&3)*8+(4*hi+((lane&15)>>2))*64;
  const char*Kbase=shm+LDS_K; bf16x8 kf[8];
  const lds_cptr kp0=shm3+LDS_K+hi*1024+r32*16; const lds_cptr vp0=shm3+LDS_V+((lane>>4)&1)*32+(lane&3)*8+(4*hi+((lane&15)>>2))*64;
  const int NT=(q0+QB)/KVBLK;
  {
    typedef __attribute__((address_space(3))) float lds_f32; lds_f32* bl=(lds_f32*)(shm3+BIAS_OFF);
    const int nb=q0+QB; const float Fl=FBrow[nb-1];
    for(int i=tid;i<nb;i+=NW*64) bl[i]=(Fl-FBrow[i])*1.4426950408889634f;
    asm volatile("s_waitcnt vmcnt(0) lgkmcnt(0)\n\ts_barrier":::"memory"); }
  typedef float f32x4v __attribute__((ext_vector_type(4)));
  #define BIAS(P0,P1,t) do{ const __attribute__((address_space(3))) f32x4v* bp_=(const __attribute__((address_space(3))) f32x4v*)(shm3+BIAS_OFF)+(t)*16+hi; \
    _Pragma("unroll") for(int g_=0;g_<4;++g_){ const f32x4v f0_=bp_[2*g_]+nm, f1_=bp_[8+2*g_]+nm; \
      P0[4*g_]+=f0_[0];P0[4*g_+1]+=f0_[1];P0[4*g_+2]+=f0_[2];P0[4*g_+3]+=f0_[3]; P1[4*g_]+=f1_[0];P1[4*g_+1]+=f1_[1];P1[4*g_+2]+=f1_[2];P1[4*g_+3]+=f1_[3]; } }while(0)
  DMA_K(0,0);DMA_V(0,0);DMA_K(1,SLOTB);
  bf16x8 qr[4];
  #pragma unroll
  for(int d0=0;d0<4;++d0)qr[d0]=*reinterpret_cast<const bf16x8*>(&Qw[(long)r32*DM+d0*16+hi*8]);
  float mhat=0.f,l_reg=0.f;f32x16 o[2];o[0]=f32x16{};o[1]=f32x16{};const f32x16 negm=f32x16{}; float nm=0.f;
  const int qrel=wid*QBLK+r32;
  #define CMASK(P0,P1,t) do{int jb_=(t)-(NT-4); if(jb_>=0)cmask(P0,P1,jb_,qrel,hi);}while(0)
  bool resc=false;
  #define START(P0,P1) do{ const float rm=rowmax(P0,P1); resc=false; \
    { const float dl=rm; mhat=fadd_s(mhat,dl); \
      _Pragma("unroll") for(int r=0;r<16;++r){P0[r]=fsub_s(P0[r],dl);P1[r]=fsub_s(P1[r],dl);} \
      nm=-mhat; } \
    _Pragma("unroll") for(int r=0;r<16;++r)P0[r]=__builtin_amdgcn_exp2f(P0[r]); }while(0)
  #define RESC() do{ if(resc){ asm volatile("s_waitcnt lgkmcnt(0)":::"memory"); \
      _Pragma("unroll") for(int d_=0;d_<2;++d_) _Pragma("unroll") for(int r=0;r<16;++r)o[d_][r]*=wsf[crow(r,hi)]; } }while(0)
  f32x16 pA0,pA1,pB0,pB1;
  int sl_prev=0,sl_cur=0,sl_next=SLOTB;
  #define ROT() do{sl_prev=sl_cur;sl_cur=sl_next;sl_next=(sl_next==(NSLOT-1)*SLOTB)?0:sl_next+SLOTB;}while(0)
  DMA_K(2,2*SLOTB);
  WAIT_BAR(3);
  qkt(pA0,pA1,Kbase,qr,negm,r32,hi);asm volatile("s_nop 15\n\ts_nop 7":"+v"(pA0),"+v"(pA1));BIAS(pA0,pA1,0);CMASK(pA0,pA1,0);
  START(pA0,pA1);
  _Pragma("unroll") for(int r=0;r<16;++r)pA1[r]=__builtin_amdgcn_exp2f(pA1[r]);
  WAIT_BAR(0);
  DMA_K(3,0);DMA_V(1,SLOTB);
  ROT();
  kload8(kf,kp0+sl_cur);
  WAIT_BAR(2);
  s16x4 vlo[8],vhi[8]; u32x4 pw0,pw1,pw2,pw3;
  #define PKW(P,B) cvtpk_s(P[B],P[B+1])
  #define PAF(k) __builtin_bit_cast(bf16x8,pw##k)
  #define VFR(i) (bf16x8){vlo[i][0],vlo[i][1],vlo[i][2],vlo[i][3],vhi[i][0],vhi[i][1],vhi[i][2],vhi[i][3]}
  #define PIN(x) asm volatile("":"+v"(x))
  #define MX3(a,b,c) __builtin_fmaxf(__builtin_fmaxf((a),(b)),(c))
  #define GAPA(MF,A0,A1,A2,A3,W0,W1,PW) do{ MF; sacc+=A0; sacc+=A1; sacc+=A2; sacc+=A3; PIN(sacc); W0; W1; PIN(PW); SBAR(); }while(0)
  #define EX(v) __builtin_amdgcn_exp2f(v)
  #define GAPB(MF,X,B) do{ MF; X[B]=EX(X[B]); X[B+1]=EX(X[B+1]); X[B+2]=EX(X[B+2]); X[B+3]=EX(X[B+3]); PIN(X); SBAR(); }while(0)
  #define VRD(i) do{ vlo[i]=vtr(vp_+(((i)>>2)*4096+((i)&3)*1024)); vhi[i]=vtr(vp_+(((i)>>2)*4096+((i)&3)*1024+512)); }while(0)
  #define KRD(G,j) do{ if(G){ kload2(kf,kp0+sl_next,j); SBAR(); } }while(0)
  #define STEP(C0,C1,P0,P1,t,GK,GV,GL) do{ SBAR(); \
    const lds_cptr vp_=vp0+sl_prev; \
    VRD(0); SBAR(); float sacc=(P0[0]+P0[1]); \
    GAPA(C0=__builtin_amdgcn_mfma_f32_32x32x16_bf16(kf[0],qr[0],negm,0,0,0), P0[2],P0[3],P0[4],P0[5],     pw0[0]=PKW(P0,0), pw0[1]=PKW(P0,2), pw0); \
    VRD(4); SBAR(); GAPA(C1=__builtin_amdgcn_mfma_f32_32x32x16_bf16(kf[1],qr[0],negm,0,0,0), P0[6],P0[7],P0[8],P0[9],     pw0[2]=PKW(P0,4), pw0[3]=PKW(P0,6), pw0); \
    VRD(1); SBAR(); GAPA(C0=__builtin_amdgcn_mfma_f32_32x32x16_bf16(kf[2],qr[1],C0,0,0,0),   P0[10],P0[11],P0[12],P0[13], pw1[0]=PKW(P0,8), pw1[1]=PKW(P0,10), pw1); \
    VRD(5); SBAR(); GAPA(C1=__builtin_amdgcn_mfma_f32_32x32x16_bf16(kf[3],qr[1],C1,0,0,0),   P0[14],P0[15],P1[0],P1[1],   pw1[2]=PKW(P0,12),pw1[3]=PKW(P0,14), pw1); \
    VRD(2); SBAR(); GAPA(C0=__builtin_amdgcn_mfma_f32_32x32x16_bf16(kf[4],qr[2],C0,0,0,0),   P1[2],P1[3],P1[4],P1[5],     pw2[0]=PKW(P1,0), pw2[1]=PKW(P1,2), pw2); \
    VRD(6); SBAR(); GAPA(C1=__builtin_amdgcn_mfma_f32_32x32x16_bf16(kf[5],qr[2],C1,0,0,0),   P1[6],P1[7],P1[8],P1[9],     pw2[2]=PKW(P1,4), pw2[3]=PKW(P1,6), pw2); \
    VRD(3); SBAR(); GAPA(C0=__builtin_amdgcn_mfma_f32_32x32x16_bf16(kf[6],qr[3],C0,0,0,0),   P1[10],P1[11],P1[12],P1[13], pw3[0]=PKW(P1,8), pw3[1]=PKW(P1,10), pw3); \
    VRD(7); SBAR(); GAPA(C1=__builtin_amdgcn_mfma_f32_32x32x16_bf16(kf[7],qr[3],C1,0,0,0),   P1[14],P1[15],0.f,0.f,       pw3[2]=PKW(P1,12),pw3[3]=PKW(P1,14), pw3); \
    l_reg+=sacc; \
    if(GK){DMA_K((t)+3,sl_cur);} if(GV){DMA_V((t)+1,sl_next);} \
    BIAS(C0,C1,t); CMASK(C0,C1,t); \
    { float a=MX3(C0[0],C0[1],C1[0]),b=MX3(C0[2],C0[3],C1[1]); a=MX3(a,C1[2],C1[3]); \
      _Pragma("unroll") for(int r=4;r<16;r+=4){a=MX3(a,C0[r],C0[r+1]);b=MX3(b,C0[r+2],C0[r+3]);a=MX3(a,C1[r],C1[r+1]);b=MX3(b,C1[r+2],C1[r+3]);} \
      float rm=__builtin_fmaxf(a,b); { auto rr=__builtin_amdgcn_permlane32_swap(__float_as_uint(rm),__float_as_uint(rm),false,false); rm=__builtin_fmaxf(__uint_as_float(rr[0]),__uint_as_float(rr[1])); } \
      resc=false; \
      if(__builtin_expect(__any(rm>(float)THRL),0)){ const float dl=__builtin_fmaxf(rm,0.f); mhat+=dl; \
        _Pragma("unroll") for(int r=0;r<16;++r){C0[r]-=dl;C1[r]-=dl;} \
        nm=-mhat; \
        const float f=__builtin_amdgcn_exp2f(-dl); l_reg*=f; if(hi==0)wsf[r32]=f; resc=true; } } \
    SBAR(); \
    GAPB(o[0]=__builtin_amdgcn_mfma_f32_32x32x16_bf16(PAF(0),VFR(0),o[0],0,0,0), C0,0); \
    GAPB(o[1]=__builtin_amdgcn_mfma_f32_32x32x16_bf16(PAF(0),VFR(4),o[1],0,0,0), C0,4); \
    KRD(GL,0); GAPB(o[0]=__builtin_amdgcn_mfma_f32_32x32x16_bf16(PAF(1),VFR(1),o[0],0,0,0), C0,8); \
    KRD(GL,1); GAPB(o[1]=__builtin_amdgcn_mfma_f32_32x32x16_bf16(PAF(1),VFR(5),o[1],0,0,0), C0,12); \
    KRD(GL,2); GAPB(o[0]=__builtin_amdgcn_mfma_f32_32x32x16_bf16(PAF(2),VFR(2),o[0],0,0,0), C1,0); \
    KRD(GL,3); GAPB(o[1]=__builtin_amdgcn_mfma_f32_32x32x16_bf16(PAF(2),VFR(6),o[1],0,0,0), C1,4); \
    GAPB(o[0]=__builtin_amdgcn_mfma_f32_32x32x16_bf16(PAF(3),VFR(3),o[0],0,0,0), C1,8); \
    GAPB(o[1]=__builtin_amdgcn_mfma_f32_32x32x16_bf16(PAF(3),VFR(7),o[1],0,0,0), C1,12); \
    }while(0)
  int t=1;
  #undef CMASK
  #define CMASK(P0,P1,t) do{}while(0)
  for(;t+5<NT;t+=2){
    STEP(pB0,pB1,pA0,pA1,t,true,true,true);     WAIT_BAR(2); RESC(); ROT();
    STEP(pA0,pA1,pB0,pB1,t+1,true,true,true);   WAIT_BAR(2); RESC(); ROT();
  }
  #undef CMASK
  #define CMASK(P0,P1,t) do{int jb_=(t)-(NT-4); if(jb_>=0)cmask(P0,P1,jb_,qrel,hi);}while(0)
  #define ENDW(tt) do{ if((tt)+3<NT){WAIT_BAR(2);} else if((tt)+2<NT){WAIT_BAR(1);} else {WAIT_BAR(0);} }while(0)
  for(;t+1<NT;t+=2){
    STEP(pB0,pB1,pA0,pA1,t,(t+3<NT),(t+1<NT),(t+1<NT));       ENDW(t);   RESC(); ROT();
    STEP(pA0,pA1,pB0,pB1,t+1,(t+4<NT),(t+2<NT),(t+2<NT));     ENDW(t+1); RESC(); ROT();
  }
  STEP(pB0,pB1,pA0,pA1,NT-1,false,false,false); RESC();
  { float sacc=pB0[0]+pB0[1]; _Pragma("unroll") for(int r=2;r<16;++r)sacc+=pB0[r]; _Pragma("unroll") for(int r=0;r<16;++r)sacc+=pB1[r]; l_reg+=sacc;
    pw0=(u32x4){PKW(pB0,0),PKW(pB0,2),PKW(pB0,4),PKW(pB0,6)};pw1=(u32x4){PKW(pB0,8),PKW(pB0,10),PKW(pB0,12),PKW(pB0,14)};pw2=(u32x4){PKW(pB1,0),PKW(pB1,2),PKW(pB1,4),PKW(pB1,6)};pw3=(u32x4){PKW(pB1,8),PKW(pB1,10),PKW(pB1,12),PKW(pB1,14)};
    SBAR(); pv(o,vb0+sl_cur,PAF(0),PAF(1),PAF(2),PAF(3)); }
  #undef PKW
  #undef PAF
  #undef VFR
  #undef PIN
  #undef MX3
  #undef GAPA
  #undef GAPB
  #undef EX
  #undef VRD
  #undef KRD
  #undef STEP
  #undef ENDW
  {auto rr=__builtin_amdgcn_permlane32_swap(__float_as_uint(l_reg),__float_as_uint(l_reg),false,false);l_reg=__uint_as_float(rr[0])+__uint_as_float(rr[1]);}
  if(hi==0)wsf[32+r32]=l_reg;asm volatile("s_waitcnt lgkmcnt(0)":::"memory");
  float rli[16];
  #pragma unroll
  for(int r=0;r<16;++r)rli[r]=__builtin_amdgcn_rcpf(wsf[32+crow(r,hi)]);
  bf16*Ow=O+(rowbase+q0+wid*QBLK)*DM+h*D;
  { bf16*stg=(bf16*)(shm+LDS_OST)+wid*2048;
    #pragma unroll
    for(int r=0;r<16;++r){const int orow=crow(r,hi);
      #pragma unroll
      for(int d0=0;d0<2;++d0)stg[orow*64+d0*32+r32]=__float2bfloat16(o[d0][r]*rli[r]);}
    asm volatile("s_waitcnt lgkmcnt(0)":::"memory");
    #pragma unroll
    for(int i=0;i<4;++i){const int row=i*8+(lane>>3),ch=lane&7; const u32x4 v=*(const u32x4*)(stg+row*64+ch*8); ATTN_STORE16(Ow+(long)row*DM+ch*8,v);} }
  asm volatile("s_waitcnt lgkmcnt(0)\n\ts_barrier":::"memory");
  #undef BIAS
  #undef DMA_K
  #undef DMA_V
  #undef CMASK
  #undef START
  #undef RESC
  #undef ROT
}
constexpr int ATTN_LDS_BYTES=86016+32768;
struct AttnTensors { const bf16* Q; const bf16* K; const bf16* V; bf16* O; const float* FB; };
struct AttnUnit { int bh; int qb; };
struct StaticOrder {
  int vcu;
  __device__ __forceinline__ explicit StaticOrder(int grid,int block):vcu((block%8)*(grid/8)+block/8){}
  __device__ __forceinline__ bool next(int i,AttnUnit&u)const{ if(i>=4)return false; const int s=vcu&7; u.bh=vcu>>3; u.qb=(i==0)?s:(i==1)?15-s:(i==2)?16+s:31-s; return true; }
  __device__ __forceinline__ void a_ready(const AttnUnit&)const{}
  __device__ __forceinline__ void done(const AttnUnit&)const{}
};
template<class Sched,int THRL=8> __device__ __forceinline__ void attn_phase(char*lds,const AttnTensors&T,const Sched&S){
  AttnUnit u;
  for(int i=0;S.next(i,u);++i){ S.a_ready(u); attn_unit<THRL>(u.bh/NHEAD,u.bh%NHEAD,u.qb,T.Q,T.K,T.V,T.O,T.FB+(size_t)u.bh*SEQ,lds); S.done(u); }
}
#undef SBAR
#undef WAIT_BAR
}
namespace cg = cooperative_groups;
#define LAS __attribute__((address_space(3)))
#define LDS_WAIT() asm volatile("s_waitcnt lgkmcnt(0)" ::: "memory")
constexpr int MEGA_THREADS = 512, MEGA_LDS = 147456, NWV = 8;
#define GAS __attribute__((address_space(1)))
#define XB_TMO      128
#define XB_XCNT(j)  (256  + 64 * (j))
#define XB_XSUB(j)  (1280 + 64 * (j))
#define XB_XGEN(j)  (2304 + 64 * (j))
#define XB_TOP      3328
#define XB_TOPGEN   3392
#define XCD_BAR_WORDS 3456
#define XB_SPIN_CAP (1u << 18)

__device__ __forceinline__ unsigned xb_ld(unsigned* p)              { return __hip_atomic_load(p, __ATOMIC_RELAXED, __HIP_MEMORY_SCOPE_AGENT); }
__device__ __forceinline__ unsigned xb_add(unsigned* p, unsigned v) { return __hip_atomic_fetch_add(p, v, __ATOMIC_RELAXED, __HIP_MEMORY_SCOPE_AGENT); }
__device__ __forceinline__ unsigned xb_xcc_id() { return (unsigned)__builtin_amdgcn_s_getreg((3 << 11) | 20) & 0xFu; }
#define XB_SPIN(cond, bar) do { unsigned _sp = 0; while (cond) { __builtin_amdgcn_s_sleep(1); \
    if ((++_sp & 255u) == 0u) { if (xb_ld(&(bar)[XB_TMO])) break; if (_sp > XB_SPIN_CAP) { atomicAdd(&(bar)[XB_TMO], 1u); break; } } } } while (0)

struct XcdBarrier {
    unsigned* bar; unsigned x;
    volatile LAS unsigned* st;
};

__device__ __forceinline__ XcdBarrier xcd_barrier_post(unsigned* bar, volatile LAS unsigned* st) {
    XcdBarrier b; b.bar = bar; b.x = xb_xcc_id(); b.st = st;
    if (threadIdx.x == 0) (void)xb_add(&bar[XB_XCNT(b.x)], 1u);
    return b;
}
__device__ __forceinline__ void xcd_barrier_complete(unsigned* bar, unsigned x, unsigned& nloc, unsigned& nx) {
    const unsigned G = gridDim.x * gridDim.y * gridDim.z;
    unsigned sum, cnt, mine, sp = 0u;
    for (;;) {
        sum = 0u; cnt = 0u; mine = 0u;
#pragma unroll
        for (unsigned j = 0; j < 16; ++j) { const unsigned c = xb_ld(&bar[XB_XCNT(j)]); sum += c; cnt += (c > 0u) ? 1u : 0u; mine = (j == x) ? c : mine; }
        if (sum == G) break;
        __builtin_amdgcn_s_sleep(1);
        if ((++sp & 255u) == 0u) { if (xb_ld(&bar[XB_TMO])) break; if (sp > XB_SPIN_CAP) { atomicAdd(&bar[XB_TMO], 1u); break; } }
    }
    nloc = mine > 0u ? mine : 1u; nx = cnt > 0u ? cnt : 1u;
}

__device__ __forceinline__ void xcd_barrier(const XcdBarrier& b) {
    asm volatile("s_waitcnt vmcnt(0)" ::: "memory");
    __syncthreads();
    if (threadIdx.x == 0) {
        unsigned* bar = b.bar;
        __builtin_amdgcn_s_waitcnt(0);
        unsigned nloc = b.st[0], nx = b.st[1];
        if (nloc == 0u) { xcd_barrier_complete(bar, b.x, nloc, nx); b.st[0] = nloc; b.st[1] = nx; }
        const unsigned old = xb_add(&bar[XB_XSUB(b.x)], 1u);
        const unsigned gen = old / nloc;
        if (old + 1u == (gen + 1u) * nloc) {
            __builtin_amdgcn_fence(__ATOMIC_RELEASE, "agent");
            asm volatile("s_waitcnt vmcnt(0)" ::: "memory");
            const unsigned og = xb_add(&bar[XB_TOP], 1u);
            const unsigned tg = og / nx;
            if (og + 1u == (tg + 1u) * nx) xb_add(&bar[XB_TOPGEN], 1u);
            else XB_SPIN(xb_ld(&bar[XB_TOPGEN]) == tg, bar);
            __builtin_amdgcn_fence(__ATOMIC_ACQUIRE, "agent");
            xb_add(&bar[XB_XGEN(b.x)], 1u);
            asm volatile("s_waitcnt vmcnt(0)" ::: "memory");
        } else {
            XB_SPIN(xb_ld(&bar[XB_XGEN(b.x)]) == gen, bar);
            __builtin_amdgcn_fence(__ATOMIC_ACQUIRE, "agent");
            asm volatile("s_waitcnt vmcnt(0)" ::: "memory");
        }
    }
    __syncthreads();
}
constexpr size_t WS_BAR = WS_CTL + 16384;
constexpr int XB_LDS_OFF = MEGA_LDS - 64;
constexpr size_t WT_IN = 0;
constexpr size_t WT_BR = WT_IN + (size_t)13312 * 1024 * 2;
constexpr size_t WT_OUT = WT_BR + (size_t)4096 * 1024 * 2;
constexpr size_t WT_UP = WT_OUT + (size_t)1024 * 4096 * 2;
constexpr size_t WT_DN = WT_UP + (size_t)5632 * 1024 * 2;
static_assert(WT_DN + (size_t)1024 * 2816 * 2 <= 72 * MiB, "weight copies");
constexpr size_t WS_WKVT = WS_GATES;
constexpr size_t WS_CB = WS_CTL + 4096;

typedef float f32x4 __attribute__((ext_vector_type(4)));
typedef unsigned u32x4 __attribute__((ext_vector_type(4)));
typedef short bf16x8_t __attribute__((ext_vector_type(8)));
typedef float f32x16_t __attribute__((ext_vector_type(16)));
__device__ __forceinline__ unsigned pk2(float lo, float hi) { return (unsigned)f2bf(lo) | ((unsigned)f2bf(hi) << 16); }
__device__ __forceinline__ float blo(unsigned u) { return __uint_as_float(u << 16); }
__device__ __forceinline__ float bhi(unsigned u) { return __uint_as_float(u & 0xffff0000u); }
__device__ __forceinline__ float fast_softplus(float x) { return fmaxf(x, 0.f) + __logf(1.f + __expf(-fabsf(x))); }
__device__ __forceinline__ float fast_sigmoid(float x) { return __builtin_amdgcn_rcpf(1.f + __expf(-x)); }
__device__ __forceinline__ float fast_tanh(float x) { const float e = __expf(-2.f * fabsf(x)); const float t = (1.f - e) * __builtin_amdgcn_rcpf(1.f + e); return x < 0.f ? -t : t; }
__device__ __forceinline__ float fast_gelu(float x) { const float u = 0.7978845608028654f * (x + 0.044715f * x * x * x); return 0.5f * x * (1.f + fast_tanh(u)); }

template <class Loc> struct LocOrder {
    pg8::StaticOrder so; Loc loc;
    __device__ __forceinline__ bool next(int i, pg8::Unit& u) const { return so.next(i, u); }
    __device__ __forceinline__ const char* aptr(const pg8::Unit& u) const { return loc.a(u); }
    __device__ __forceinline__ const char* bptr(const pg8::Unit& u) const { return loc.b(u); }
    __device__ __forceinline__ void a_ready(const pg8::Unit&) const {}
    __device__ __forceinline__ void done(const pg8::Unit&) const {}
};
struct LocStd { const char* A; const char* Bt; size_t astep, bstep;
    __device__ __forceinline__ const char* a(const pg8::Unit& u) const { return A + (size_t)u.pm * astep; }
    __device__ __forceinline__ const char* b(const pg8::Unit& u) const { return Bt + (size_t)u.pn * bstep; } };
struct LocBranch { const char* Y0; const char* Y1; const char* Y2; const char* Y3; const char* Bt;
    __device__ __forceinline__ const char* a(const pg8::Unit& u) const { const int i = u.pn >> 2; const char* y = i == 0 ? Y0 : i == 1 ? Y1 : i == 2 ? Y2 : Y3; return y + (size_t)u.pm * (256 * 1024 * 2); }
    __device__ __forceinline__ const char* b(const pg8::Unit& u) const { return Bt + (size_t)u.pn * (256 * 1024 * 2); } };
struct LocMemKV { const char* A; const char* Bt;
    __device__ __forceinline__ const char* a(const pg8::Unit& u) const { return A + (size_t)u.pm * (256 * 1024 * 2); }
    __device__ __forceinline__ const char* b(const pg8::Unit& u) const { return Bt + ((size_t)(u.pm >> 1) * 2048 + (size_t)u.pn * 256) * 2048; } };
struct LocMemS { const char* MQ; const char* MK;
    __device__ __forceinline__ const char* a(const pg8::Unit& u) const { return MQ + (size_t)u.pm * (256 * 2048) + u.pn * 512; }
    __device__ __forceinline__ const char* b(const pg8::Unit& u) const { return MK + (size_t)(u.pm >> 5) * (256 * 2048) + u.pn * 512; } };
struct LocMemPV { const char* E; const char* MVT;
    __device__ __forceinline__ const char* a(const pg8::Unit& u) const { return E + (size_t)u.pm * (256 * 2048) + u.pn * 512; }
    __device__ __forceinline__ const char* b(const pg8::Unit& u) const { return MVT + ((size_t)(u.pm >> 5) * 4 + u.pn) * (256 * 256 * 2); } };

typedef f32x4 AccT[2][2][4][2];
struct EpiProj { static constexpr bool PERM = true, AFTER_DRAIN = false; bf16_t* proj; bf16_t* gates; float* mqss;
    __device__ __forceinline__ void operator()(const AccT& acc, const pg8::Unit& u, int wr, int wc, int fr, int fq) const {
        int colt = u.pn * 256; const int grp = colt >> 10; bf16_t* base; int ldc;
        if (grp < 9) { base = proj + (size_t)grp * T * DM; ldc = DM; colt &= 1023; } else { base = gates; ldc = 4096; colt -= 9216; }
        const int row0 = u.pm * 256 + wr * 64 + fr, col0 = colt + wc * 32 + 8 * fq;
#pragma unroll
        for (int ai = 0; ai < 2; ++ai)
#pragma unroll
            for (int m = 0; m < 4; ++m) { const int row = row0 + ai * 128 + m * 16; bf16_t* rowp = base + (size_t)row * ldc + col0; float ss = 0.f;
#pragma unroll
                for (int bj = 0; bj < 2; ++bj) { const f32x4 v0 = acc[ai][bj][m][0], v1 = acc[ai][bj][m][1]; u32x4 w; w.x = pk2(v0[0], v0[1]); w.y = pk2(v0[2], v0[3]); w.z = pk2(v1[0], v1[1]); w.w = pk2(v1[2], v1[3]);
                    *(u32x4*)(rowp + bj * 128) = w;
                    if (grp == 8) { ss += blo(w.x) * blo(w.x) + bhi(w.x) * bhi(w.x) + blo(w.y) * blo(w.y) + bhi(w.y) * bhi(w.y) + blo(w.z) * blo(w.z) + bhi(w.z) * bhi(w.z) + blo(w.w) * blo(w.w) + bhi(w.w) * bhi(w.w); } }
                if (grp == 8) { ss += __shfl_xor(ss, 16); ss += __shfl_xor(ss, 32); if (fq == 0) mqss[(size_t)row * 16 + (colt >> 8) * 4 + wc] = ss; } }
    } };
struct EpiBf16P { static constexpr bool PERM = true, AFTER_DRAIN = false; bf16_t* O; int ldc; int pad;
    __device__ __forceinline__ void operator()(const AccT& acc, const pg8::Unit& u, int wr, int wc, int fr, int fq) const {
        const int row0 = u.pm * 256 + wr * 64 + fr, col0 = u.pn * 256 + wc * 32 + 8 * fq;
#pragma unroll
        for (int ai = 0; ai < 2; ++ai)
#pragma unroll
            for (int m = 0; m < 4; ++m) { bf16_t* rowp = O + (size_t)(row0 + ai * 128 + m * 16) * ldc + col0;
#pragma unroll
                for (int bj = 0; bj < 2; ++bj) { const f32x4 v0 = acc[ai][bj][m][0], v1 = acc[ai][bj][m][1]; u32x4 w; w.x = pk2(v0[0], v0[1]); w.y = pk2(v0[2], v0[3]); w.z = pk2(v1[0], v1[1]); w.w = pk2(v1[2], v1[3]);
                    *(u32x4*)(rowp + bj * 128) = w; } }
    } };
struct EpiF32 { static constexpr bool PERM = false, AFTER_DRAIN = false; float* O; int ldc; int pad;
    __device__ __forceinline__ void operator()(const AccT& acc, const pg8::Unit& u, int wr, int wc, int fr, int fq) const {
        const int row0 = u.pm * 256 + wr * 64 + fr, col0 = u.pn * 256 + wc * 32 + 4 * fq;
#pragma unroll
        for (int ai = 0; ai < 2; ++ai)
#pragma unroll
            for (int m = 0; m < 4; ++m) { float* rowp = O + (size_t)(row0 + ai * 128 + m * 16) * ldc + col0;
#pragma unroll
                for (int bj = 0; bj < 2; ++bj)
#pragma unroll
                    for (int n = 0; n < 2; ++n) *(f32x4*)(rowp + bj * 128 + n * 16) = acc[ai][bj][m][n]; }
    } };
struct EpiResid { static constexpr bool PERM = false, AFTER_DRAIN = false; const float* base; float* out;
    __device__ __forceinline__ void operator()(const AccT& acc, const pg8::Unit& u, int wr, int wc, int fr, int fq) const {
        const int row0 = u.pm * 256 + wr * 64 + fr, col0 = u.pn * 256 + wc * 32 + 4 * fq;
#pragma unroll
        for (int ai = 0; ai < 2; ++ai)
#pragma unroll
            for (int m = 0; m < 4; ++m) { const size_t off = (size_t)(row0 + ai * 128 + m * 16) * DM + col0;
#pragma unroll
                for (int bj = 0; bj < 2; ++bj)
#pragma unroll
                    for (int n = 0; n < 2; ++n) { const f32x4 b = *(const f32x4*)(base + off + bj * 128 + n * 16); *(f32x4*)(out + off + bj * 128 + n * 16) = b + acc[ai][bj][m][n]; } }
    } };
struct EpiBranch { static constexpr bool PERM = true, AFTER_DRAIN = false; bf16_t* G; const float* bg;
    __device__ __forceinline__ void operator()(const AccT& acc, const pg8::Unit& u, int wr, int wc, int fr, int fq) const {
        const int row0 = u.pm * 256 + wr * 64 + fr, col0 = u.pn * 256 + wc * 32 + 8 * fq;
#pragma unroll
        for (int ai = 0; ai < 2; ++ai)
#pragma unroll
            for (int m = 0; m < 4; ++m) { bf16_t* rowp = G + (size_t)(row0 + ai * 128 + m * 16) * 4096 + col0;
#pragma unroll
                for (int bj = 0; bj < 2; ++bj) { const u32x4 gw = *(const u32x4*)(rowp + bj * 128); const f32x4 b0 = *(const f32x4*)(bg + col0 + bj * 128), b1 = *(const f32x4*)(bg + col0 + bj * 128 + 4);
                    const f32x4 v0 = acc[ai][bj][m][0], v1 = acc[ai][bj][m][1]; u32x4 w;
                    w.x = pk2(fast_sigmoid(blo(gw.x) + b0[0]) * v0[0], fast_sigmoid(bhi(gw.x) + b0[1]) * v0[1]); w.y = pk2(fast_sigmoid(blo(gw.y) + b0[2]) * v0[2], fast_sigmoid(bhi(gw.y) + b0[3]) * v0[3]);
                    w.z = pk2(fast_sigmoid(blo(gw.z) + b1[0]) * v1[0], fast_sigmoid(bhi(gw.z) + b1[1]) * v1[1]); w.w = pk2(fast_sigmoid(blo(gw.w) + b1[2]) * v1[2], fast_sigmoid(bhi(gw.w) + b1[3]) * v1[3]);
                    *(u32x4*)(rowp + bj * 128) = w; } }
    } };
struct EpiSexp { static constexpr bool PERM = true, AFTER_DRAIN = false; bf16_t* E; const float* mqss; float* esum; const float* cb;
    __device__ __forceinline__ void operator()(const AccT& acc, const pg8::Unit& u, int wr, int wc, int fr, int fq) const {
        const int row0 = u.pm * 256 + wr * 64 + fr, col0 = u.pn * 256 + wc * 32 + 8 * fq; const float shift = cb[0];
#pragma unroll
        for (int ai = 0; ai < 2; ++ai)
#pragma unroll
            for (int m = 0; m < 4; ++m) { const int row = row0 + ai * 128 + m * 16; const f32x4 p = *(const f32x4*)(mqss + (size_t)row * 16 + u.pn * 4);
                const float sc = rsqrtf(((p[0] + p[1]) + (p[2] + p[3])) * (1.f / 256.f) + EPS) * (1.f / 16.f); bf16_t* rowp = E + (size_t)row * DM + col0; float sum = 0.f;
#pragma unroll
                for (int bj = 0; bj < 2; ++bj) { const f32x4 v0 = acc[ai][bj][m][0], v1 = acc[ai][bj][m][1]; u32x4 w;
                    w.x = pk2(__expf(v0[0] * sc - shift), __expf(v0[1] * sc - shift)); w.y = pk2(__expf(v0[2] * sc - shift), __expf(v0[3] * sc - shift));
                    w.z = pk2(__expf(v1[0] * sc - shift), __expf(v1[1] * sc - shift)); w.w = pk2(__expf(v1[2] * sc - shift), __expf(v1[3] * sc - shift));
                    *(u32x4*)(rowp + bj * 128) = w;
                    sum += (blo(w.x) + bhi(w.x)) + (blo(w.y) + bhi(w.y)) + (blo(w.z) + bhi(w.z)) + (blo(w.w) + bhi(w.w)); }
                sum += __shfl_xor(sum, 16); sum += __shfl_xor(sum, 32); if (fq == 0) esum[(size_t)row * 16 + u.pn * 4 + wc] = sum;
                asm volatile("" ::: "memory"); }
    } };
struct EpiMemPV { static constexpr bool PERM = true, AFTER_DRAIN = false; bf16_t* Y; const float* esum;
    __device__ __forceinline__ void operator()(const AccT& acc, const pg8::Unit& u, int wr, int wc, int fr, int fq) const {
        const int row0 = u.pm * 256 + wr * 64 + fr, col0 = u.pn * 256 + wc * 32 + 8 * fq;
#pragma unroll
        for (int ai = 0; ai < 2; ++ai)
#pragma unroll
            for (int m = 0; m < 4; ++m) { const int row = row0 + ai * 128 + m * 16; const f32x4 p = *(const f32x4*)(esum + (size_t)row * 16 + u.pn * 4);
                const float il = 1.f / ((p[0] + p[1]) + (p[2] + p[3])); bf16_t* rowp = Y + (size_t)row * DM + col0;
#pragma unroll
                for (int bj = 0; bj < 2; ++bj) { const f32x4 v0 = acc[ai][bj][m][0] * il, v1 = acc[ai][bj][m][1] * il; u32x4 w; w.x = pk2(v0[0], v0[1]); w.y = pk2(v0[2], v0[3]); w.z = pk2(v1[0], v1[1]); w.w = pk2(v1[2], v1[3]);
                    *(u32x4*)(rowp + bj * 128) = w; }
                asm volatile("" ::: "memory"); }
    } };

__device__ __forceinline__ void tr_item(const float* __restrict__ W, int ldw, bf16_t* __restrict__ WT, int ldk, int nblk, LAS float* scr, int item, int lane, int ncopies, int cstride) {
    const int kb = item / nblk, nb = item % nblk, k0 = 64 * kb, n0 = 32 * nb;
#pragma unroll
    for (int i = 0; i < 32; ++i) { const int kk = 2 * i + (lane >> 5); scr[kk * 33 + (lane & 31)] = W[(size_t)(k0 + kk) * ldw + n0 + (lane & 31)]; }
    LDS_WAIT(); asm volatile("" ::: "memory");
    const int c = lane & 7;
#pragma unroll
    for (int j = 0; j < 4; ++j) { const int n = (lane >> 3) + 8 * j; const LAS float* s = scr + (8 * c) * 33 + n;
        u32x4 o; o.x = pk2(s[0 * 33], s[1 * 33]); o.y = pk2(s[2 * 33], s[3 * 33]); o.z = pk2(s[4 * 33], s[5 * 33]); o.w = pk2(s[6 * 33], s[7 * 33]);
        for (int cp = 0; cp < ncopies; ++cp) *(u32x4*)(WT + (size_t)(n0 + n) * ldk + k0 + 8 * c + cp * cstride) = o; }
    LDS_WAIT(); asm volatile("" ::: "memory");
}
__device__ __forceinline__ void norm_row(const float* __restrict__ xrow, const float* __restrict__ g, bf16_t* __restrict__ hrow, const LAS float* WfT, bool do_logf, const float* __restrict__ bfg, float* __restrict__ LOGF, int row, int lane) {
    const f32x4* xr = (const f32x4*)xrow; const f32x4* gr = (const f32x4*)g;
    f32x4 v[4]; float ss = 0.f;
#pragma unroll
    for (int j = 0; j < 4; ++j) { v[j] = xr[lane + 64 * j]; ss += (v[j][0] * v[j][0] + v[j][1] * v[j][1]) + (v[j][2] * v[j][2] + v[j][3] * v[j][3]); }
    ss = wave_sum(ss);
    const float rstd = rsqrtf(ss * (1.f / DM) + EPS);
#pragma unroll
    for (int j = 0; j < 4; ++j) { v[j] = v[j] * rstd * gr[lane + 64 * j];
        uint2 o; o.x = pk2(v[j][0], v[j][1]); o.y = pk2(v[j][2], v[j][3]); ((uint2*)hrow)[lane + 64 * j] = o; }
    if (do_logf) {
        float mine = 0.f;
#pragma unroll 4
        for (int h = 0; h < 16; ++h) { float p = 0.f;
#pragma unroll
            for (int j = 0; j < 4; ++j) { const f32x4 w = *(const LAS f32x4*)(WfT + h * 1024 + (lane + 64 * j) * 4); p += (v[j][0] * w[0] + v[j][1] * w[1]) + (v[j][2] * w[2] + v[j][3] * w[3]); }
            p = wave_sum(p); if (lane == h) mine = p; }
        if (lane < 16) { const int b = row / SEQ, t = row % SEQ; LOGF[((size_t)b * 16 + lane) * SEQ + t] = logsigmoidf(mine + bfg[lane]); }
    }
}
__device__ __forceinline__ void headnorm64_row(bf16_t* row, const float* __restrict__ g, float scale, int lane) {
    u32x4* p = (u32x4*)row + lane * 2; u32x4 a = p[0], b = p[1];
    float v[16] = {blo(a.x), bhi(a.x), blo(a.y), bhi(a.y), blo(a.z), bhi(a.z), blo(a.w), bhi(a.w), blo(b.x), bhi(b.x), blo(b.y), bhi(b.y), blo(b.z), bhi(b.z), blo(b.w), bhi(b.w)};
    float ss = 0.f;
#pragma unroll
    for (int i = 0; i < 16; ++i) ss += v[i] * v[i];
    ss += __shfl_xor(ss, 1); ss += __shfl_xor(ss, 2);
    const float rstd = rsqrtf(ss * (1.f / 64.f) + EPS) * scale; const f32x4* gp = (const f32x4*)(g + (lane & 3) * 16);
#pragma unroll
    for (int i = 0; i < 4; ++i) { const f32x4 gg = gp[i]; v[4 * i] *= rstd * gg[0]; v[4 * i + 1] *= rstd * gg[1]; v[4 * i + 2] *= rstd * gg[2]; v[4 * i + 3] *= rstd * gg[3]; }
    a.x = pk2(v[0], v[1]); a.y = pk2(v[2], v[3]); a.z = pk2(v[4], v[5]); a.w = pk2(v[6], v[7]); b.x = pk2(v[8], v[9]); b.y = pk2(v[10], v[11]); b.z = pk2(v[12], v[13]); b.w = pk2(v[14], v[15]);
    p[0] = a; p[1] = b;
}
__device__ __forceinline__ void cumsum_block(const float* __restrict__ src, float* __restrict__ dst, LAS float* part, int tid) {
    const int lane = tid & 63, wave = tid >> 6; const f32x4* s4 = (const f32x4*)(src + tid * 16); float v[16]; float s = 0.f;
#pragma unroll
    for (int i = 0; i < 4; ++i) { const f32x4 x = s4[i]; s += x[0]; v[4 * i] = s; s += x[1]; v[4 * i + 1] = s; s += x[2]; v[4 * i + 2] = s; s += x[3]; v[4 * i + 3] = s; }
    float incl = s;
#pragma unroll
    for (int o = 1; o < 64; o <<= 1) { const float t_ = __shfl_up(incl, o); if (lane >= o) incl += t_; }
    __syncthreads();
    if (lane == 63) part[wave] = incl;
    __syncthreads();
    float off = incl - s;
    for (int w = 0; w < wave; ++w) off += part[w];
    f32x4* d4 = (f32x4*)(dst + tid * 16);
#pragma unroll
    for (int i = 0; i < 4; ++i) d4[i] = (f32x4){off + v[4 * i], off + v[4 * i + 1], off + v[4 * i + 2], off + v[4 * i + 3]};
}

__device__ __forceinline__ float neg_expm1_small(float x) {
    const float p = -x * (1.f + x * (0.5f + x * (0.16666667f + x * (0.041666668f + x * (0.0083333338f + x * 0.0013888889f)))));
    return x > -0.25f ? p : 1.f - __expf(x);
}
template <bool FINAL> __device__ __forceinline__ void lru_item(int b, int c, int n, const bf16_t* __restrict__ LX, const bf16_t* __restrict__ LG, bf16_t* __restrict__ YL,
        const float* __restrict__ cw, const float* __restrict__ cbias, const float bA, const float bX,
        const float spl, float* APROD, float* HEND, LAS unsigned char* lds, int tid) {
    const int e = tid & 63, tg = tid >> 6, ch = n * 64 + e;
    LAS float* xcT = (LAS float*)lds;
    LAS float* segP = xcT + 64 * 68;
    LAS float* segH = segP + 512, *carP = segH + 512, *carH = carP + 512;
    const LAS float* wAl = (const LAS float*)(lds + 32768);
    const int t0 = c * 64 + tg * 8; const size_t row0 = (size_t)b * SEQ + t0;
    float xw[11];
#pragma unroll
    for (int j = 0; j < 11; ++j) { const int t = t0 + j - 3; xw[j] = t >= 0 ? bf2f(LX[((size_t)b * SEQ + t) * DM + ch]) : 0.f; }
    const float w0 = cw[ch], w1 = cw[DM + ch], w2 = cw[2 * DM + ch], w3 = cw[3 * DM + ch], bc = cbias[ch];
    float xc[8];
#pragma unroll
    for (int j = 0; j < 8; ++j) xc[j] = bc + w3 * xw[j + 3] + w2 * xw[j + 2] + w1 * xw[j + 1] + w0 * xw[j];
    *(LAS f32x4*)(xcT + e * 68 + tg * 8) = (f32x4){xc[0], xc[1], xc[2], xc[3]};
    *(LAS f32x4*)(xcT + e * 68 + tg * 8 + 4) = (f32x4){xc[4], xc[5], xc[6], xc[7]};
    float gl[8];
    if (FINAL) {
#pragma unroll
        for (int j = 0; j < 8; ++j) gl[j] = bf2f(LG[(row0 + j) * DM + ch]);
        float cp = 1.f, chh = 0.f; const int per = (c + 7) >> 3; const int lo = tg * per; int hi = lo + per; if (hi > c) hi = c;
        for (int cc = lo; cc < hi; ++cc) { const size_t si = ((size_t)b * 128 + cc) * DM + ch; const float A = APROD[si], Hc = HEND[si]; chh = A * chh + Hc; cp *= A; }
        carP[tg * 64 + e] = cp; carH[tg * 64 + e] = chh; }
    __syncthreads();
    float ra[8], ri[8];
#pragma unroll
    for (int j = 0; j < 8; ++j) { ra[j] = bA; ri[j] = bX; }
#pragma unroll 8
    for (int d = 0; d < 64; ++d) { const float wad = wAl[d * 64 + e], wxd = wAl[4096 + d * 64 + e];
        const f32x4 x0 = *(const LAS f32x4*)(xcT + d * 68 + tg * 8), x1 = *(const LAS f32x4*)(xcT + d * 68 + tg * 8 + 4);
        ra[0] += x0[0] * wad; ra[1] += x0[1] * wad; ra[2] += x0[2] * wad; ra[3] += x0[3] * wad; ra[4] += x1[0] * wad; ra[5] += x1[1] * wad; ra[6] += x1[2] * wad; ra[7] += x1[3] * wad;
        ri[0] += x0[0] * wxd; ri[1] += x0[1] * wxd; ri[2] += x0[2] * wxd; ri[3] += x0[3] * wxd; ri[4] += x1[0] * wxd; ri[5] += x1[1] * wxd; ri[6] += x1[2] * wxd; ri[7] += x1[3] * wxd; }
    float av[8], uv[8]; float P = 1.f, Hh = 0.f;
#pragma unroll
    for (int j = 0; j < 8; ++j) { const float rr = fast_sigmoid(ra[j]), ii = fast_sigmoid(ri[j]); const float la = -8.f * rr * spl; av[j] = __expf(la); uv[j] = __builtin_amdgcn_sqrtf(neg_expm1_small(2.f * la)) * (ii * xc[j]);
        Hh = av[j] * Hh + uv[j]; P *= av[j]; }
    segP[tg * 64 + e] = P; segH[tg * 64 + e] = Hh;
    __syncthreads();
    if (FINAL) {
        float h = 0.f;
#pragma unroll
        for (int s = 0; s < 8; ++s) h = carP[s * 64 + e] * h + carH[s * 64 + e];
        for (int t2 = 0; t2 < tg; ++t2) h = segP[t2 * 64 + e] * h + segH[t2 * 64 + e];
#pragma unroll
        for (int j = 0; j < 8; ++j) { h = av[j] * h + uv[j]; YL[(row0 + j) * DM + ch] = f2bf(h * fast_gelu(gl[j])); }
    } else if (tg == 7) {
        float h = 0.f, p = 1.f;
#pragma unroll
        for (int s = 0; s < 8; ++s) { h = segP[s * 64 + e] * h + segH[s * 64 + e]; p *= segP[s * 64 + e]; }
        const size_t si = ((size_t)b * 128 + c) * DM + ch; APROD[si] = p; HEND[si] = h;
    }
    __syncthreads();
}
template <bool FINAL> __device__ __forceinline__ void lru_pass(int l, int bx, int G, const float* const* in, const bf16_t* LX, const bf16_t* LG, bf16_t* YL, float* APROD, float* HEND, LAS unsigned char* lds, int tid) {
    const int n = bx & 15, e = tid & 63, ch = n * 64 + e;
    { const float* wa = in[10] + (size_t)l * 65536 + (size_t)n * 4096; const float* wx = in[12] + (size_t)l * 65536 + (size_t)n * 4096; LAS float* wl = (LAS float*)(lds + 32768);
        for (int i = tid; i < 4096; i += MEGA_THREADS) { wl[i] = wa[i]; wl[4096 + i] = wx[i]; } }
    __syncthreads();
    const float bA = in[11][l * DM + ch], bX = in[13][l * DM + ch], spl = softplusf(-in[14][l * DM + ch]);
    for (int it = bx; it < 4096; it += G) lru_item<FINAL>(it >> 11, (it >> 4) & 127, n, LX, LG, YL, in[8] + (size_t)l * 4 * DM, in[9] + l * DM, bA, bX, spl, APROD, HEND, lds, tid);
}

__device__ __forceinline__ void sb_wave(int b, int h, int qw0, const bf16_t* Q, const bf16_t* __restrict__ K, const bf16_t* __restrict__ V, bf16_t* O, LAS unsigned char* vl, int lane) {
    const int r32 = lane & 31, hi = lane >> 5; const size_t rowbase = (size_t)b * SEQ;
    const bf16_t* Qw = Q + (rowbase + qw0) * DM + h * 64;
    bf16x8_t qr[4];
#pragma unroll
    for (int d0 = 0; d0 < 4; ++d0) qr[d0] = *(const bf16x8_t*)(Qw + (size_t)r32 * DM + d0 * 16 + hi * 8);
    const bf16_t* Kh = K + rowbase * DM + h * 64; const bf16_t* Vh = V + rowbase * DM + h * 64;
    f32x16_t o0 = {}, o1 = {}; float R = 0.f; const int qabs = qw0 + r32;
    int kt = qw0 >> 5;
    bf16x8_t kf[4]; u32x4 vr[4];
#define SB_LOAD(KF, VR, kt_) do { _Pragma("unroll") for (int d0 = 0; d0 < 4; ++d0) KF[d0] = *(const bf16x8_t*)(Kh + (size_t)((kt_) * 32 + r32) * DM + d0 * 16 + hi * 8); \
        _Pragma("unroll") for (int it = 0; it < 4; ++it) { const int chunk = lane + 64 * it; VR[it] = *(const u32x4*)(Vh + (size_t)((kt_) * 32 + (chunk >> 3)) * DM + (chunk & 7) * 8); } } while (0)
    SB_LOAD(kf, vr, kt);
    const unsigned vbase = (unsigned)(size_t)vl;
    for (;;) {
        bf16x8_t kn[4]; u32x4 vn[4]; const bool more = kt > 0;
        if (more) SB_LOAD(kn, vn, kt - 1); else {
#pragma unroll
            for (int i = 0; i < 4; ++i) { kn[i] = kf[i]; vn[i] = vr[i]; } }
        f32x16_t st = {};
#pragma unroll
        for (int d0 = 0; d0 < 4; ++d0) st = __builtin_amdgcn_mfma_f32_32x32x16_bf16(kf[d0], qr[d0], st, 0, 0, 0);
#pragma unroll
        for (int it = 0; it < 4; ++it) { const int chunk = lane + 64 * it, row = chunk >> 3, c16 = chunk & 7; *(LAS u32x4*)(vl + (c16 >> 2) * 2048 + row * 64 + (c16 & 3) * 16) = vr[it]; }
        float l1[16], lb[16]; bool val[16];
#pragma unroll
        for (int r = 0; r < 16; ++r) { const int kv = kt * 32 + (r & 3) + 8 * (r >> 2) + 4 * hi; val[r] = kv < qabs; const float z = st[r] * 0.125f; const float sp = fast_softplus(z); l1[r] = val[r] ? -sp : 0.f; lb[r] = z - sp; }
        float w[16]; float tail = 0.f;
#pragma unroll
        for (int g = 3; g >= 0; --g) { const float qs = (l1[4 * g] + l1[4 * g + 1]) + (l1[4 * g + 2] + l1[4 * g + 3]); const float pq = __shfl_xor(qs, 32);
            const float after = tail + (hi == 0 ? pq : 0.f) + R; tail += qs + pq;
            const float e2 = l1[4 * g + 3], e1 = e2 + l1[4 * g + 2], e0 = e1 + l1[4 * g + 1];
            w[4 * g + 3] = val[4 * g + 3] ? __expf(lb[4 * g + 3] + after) : 0.f; w[4 * g + 2] = val[4 * g + 2] ? __expf(lb[4 * g + 2] + after + e2) : 0.f;
            w[4 * g + 1] = val[4 * g + 1] ? __expf(lb[4 * g + 1] + after + e1) : 0.f; w[4 * g] = val[4 * g] ? __expf(lb[4 * g] + after + e0) : 0.f; }
        R += tail;
        u32x4 p0, p1; p0.x = attn_body::cvtpk_s(w[0], w[1]); p0.y = attn_body::cvtpk_s(w[2], w[3]); p0.z = attn_body::cvtpk_s(w[4], w[5]); p0.w = attn_body::cvtpk_s(w[6], w[7]);
        p1.x = attn_body::cvtpk_s(w[8], w[9]); p1.y = attn_body::cvtpk_s(w[10], w[11]); p1.z = attn_body::cvtpk_s(w[12], w[13]); p1.w = attn_body::cvtpk_s(w[14], w[15]);
        const bf16x8_t pa0 = __builtin_bit_cast(bf16x8_t, p0), pa1 = __builtin_bit_cast(bf16x8_t, p1);
        const attn_body::lds_cptr vp = (attn_body::lds_cptr)vl + (4 * hi + ((lane & 15) >> 2)) * 64 + ((lane >> 4) & 1) * 32 + (lane & 3) * 8;
#define SB_VF(d0, s) ({ const attn_body::s16x4 lo_ = attn_body::vtr(vp + (d0) * 2048 + (s) * 1024), hi_ = attn_body::vtr(vp + (d0) * 2048 + (s) * 1024 + 512); \
            (bf16x8_t){lo_[0], lo_[1], lo_[2], lo_[3], hi_[0], hi_[1], hi_[2], hi_[3]}; })
        o0 = __builtin_amdgcn_mfma_f32_32x32x16_bf16(pa0, SB_VF(0, 0), o0, 0, 0, 0);
        o1 = __builtin_amdgcn_mfma_f32_32x32x16_bf16(pa0, SB_VF(1, 0), o1, 0, 0, 0);
        o0 = __builtin_amdgcn_mfma_f32_32x32x16_bf16(pa1, SB_VF(0, 1), o0, 0, 0, 0);
        o1 = __builtin_amdgcn_mfma_f32_32x32x16_bf16(pa1, SB_VF(1, 1), o1, 0, 0, 0);
        if (!more) break;
        if (__all(R < SB_THR)) break;
#pragma unroll
        for (int i = 0; i < 4; ++i) { kf[i] = kn[i]; vr[i] = vn[i]; }
        --kt;
    }
#undef SB_LOAD
#undef SB_VF
    (void)vbase;
    bf16_t* Ow = O + (rowbase + qw0) * DM + h * 64;
#pragma unroll
    for (int r = 0; r < 16; ++r) { const int q = (r & 3) + 8 * (r >> 2) + 4 * hi; Ow[(size_t)q * DM + r32] = f2bf(o0[r]); Ow[(size_t)q * DM + 32 + r32] = f2bf(o1[r]); }
}

#ifndef DBG_NOLOGF
#define DBG_NOLOGF 0
#endif
#ifndef EN_FOX
#define EN_FOX 1
#endif
#ifndef EN_SB
#define EN_SB 1
#endif
#ifndef EN_LRU
#define EN_LRU 1
#endif
#ifndef EN_GEMM
#define EN_GEMM 1
#endif
#ifndef EN_THIN
#define EN_THIN 1
#endif
enum { SUB_CONV = 1, SUB_NORM = 2, SUB_HEADNORM = 4, SUB_CUMSUM = 8, SUB_LRU = 16, SUB_SB = 32, SUB_MEM = 64, SUB_FOX = 128, SUB_ALL = 255 };
constexpr int N_PRO = 3, N_PER_LAYER = 10, N_PHASES = N_PRO + DEPTH * N_PER_LAYER;
struct MArgs { Ptrs P; int ph_lo, ph_hi, sub, pad; };

__global__ void __launch_bounds__(MEGA_THREADS, 2) mega(MArgs a) {
    extern __shared__ __attribute__((aligned(16))) unsigned char lds_raw[];
    LAS unsigned char* lds = (LAS unsigned char*)lds_raw;
    cg::grid_group grid = cg::this_grid();
    { volatile LAS unsigned* st0 = (volatile LAS unsigned*)(lds + XB_LDS_OFF); if (threadIdx.x == 0) { st0[0] = 0u; st0[1] = 0u; } __syncthreads();
      if (a.ph_hi - a.ph_lo > 2) (void)xcd_barrier_post((unsigned*)(a.P.ws + WS_BAR), st0); }
    for (int ph = a.ph_lo; ph < a.ph_hi; ++ph) {
    int tid = threadIdx.x; asm volatile("" : "+v"(tid));
    const int lane = tid & 63, wave = __builtin_amdgcn_readfirstlane(tid >> 6);
    int zs = 0; asm volatile("" : "+s"(zs));
    const int G = gridDim.x + zs, bx = blockIdx.x + zs, sub = a.sub + zs, vcu = (G % 8 == 0) ? (bx % 8) * (G / 8) + bx / 8 : bx;
    const int gw = vcu * NWV + wave, NGW = G * NWV;
    unsigned char* ws = a.P.ws + zs; const float* const* in = a.P.in + zs; float* out = a.P.out + zs;
    bf16_t* H = (bf16_t*)(ws + WS_H); bf16_t* PROJ = (bf16_t*)(ws + WS_PROJ); bf16_t* GATES = (bf16_t*)(ws + WS_GATES); bf16_t* Eb = (bf16_t*)(ws + WS_E);
    bf16_t *FQ = PROJ, *FK = PROJ + (size_t)T * DM, *FV = PROJ + 2 * (size_t)T * DM, *LX = PROJ + 3 * (size_t)T * DM, *LG = PROJ + 4 * (size_t)T * DM, *SQ = PROJ + 5 * (size_t)T * DM,
           *SK = PROJ + 6 * (size_t)T * DM, *SV = PROJ + 7 * (size_t)T * DM, *MQ = PROJ + 8 * (size_t)T * DM;
    bf16_t* YL = (bf16_t*)(ws + WS_YL);
    float *LOGF = (float*)(ws + WS_LOGF), *FB = (float*)(ws + WS_FB), *MQSS = (float*)(ws + WS_MQSS), *ESUM = (float*)(ws + WS_ESUM), *CB = (float*)(ws + WS_CB);
    bf16_t* MEMN = (bf16_t*)(ws + WS_MEMN); float* MEMRAW = (float*)(ws + WS_MEMRAW); bf16_t *MK = (bf16_t*)(ws + WS_MK), *MVT = (bf16_t*)(ws + WS_MVT);
    float *APROD = (float*)(ws + WS_LRU), *HEND = APROD + (size_t)BATCH * 128 * DM;
    bf16_t* WKVT = (bf16_t*)(ws + WS_WKVT);
    bf16_t *WIN_T = (bf16_t*)(ws + WS_WT + WT_IN), *WBR_T = (bf16_t*)(ws + WS_WT + WT_BR), *WOUT_T = (bf16_t*)(ws + WS_WT + WT_OUT), *WUP_T = (bf16_t*)(ws + WS_WT + WT_UP), *WDN_T = (bf16_t*)(ws + WS_WT + WT_DN);
    bf16_t *GV = (bf16_t*)(ws + WS_GV), *ACT = (bf16_t*)(ws + WS_ACT);

        if (ph < N_PRO) {
            if (ph == 0) {
                LAS float* scr = (LAS float*)(lds + wave * 8448);
                for (int it = gw; it < 4 * 1024; it += NGW) { const int l = it >> 10; tr_item(in[15] + (size_t)l * DM * 2048, 2048, WKVT + (size_t)l * 2048 * DM, DM, 64, scr, it & 1023, lane, 1, 0); }
                for (int m = gw; m < 4 * 512; m += NGW) { const int l = m >> 9, r = m & 511; norm_row(in[1] + (size_t)r * DM, in[3] + l * DM, MEMN + (size_t)m * DM, (const LAS float*)lds, false, nullptr, nullptr, 0, lane); }
            } else if (ph == 1) {
                LocOrder<LocMemKV> S; S.so.init(4 * 512, 2048, G, bx); S.loc = LocMemKV{(const char*)MEMN, (const char*)WKVT};
                if (EN_GEMM) pg8::gemm_phase<EpiF32, LocOrder<LocMemKV>, true, true>(lds, pg8::Gemm{DM, DM, DM}, S, EpiF32{MEMRAW, 2048, 0});
            } else {
                for (int m = gw; m < 4 * 512; m += NGW) { const int l = m >> 9, r = m & 511, b = r >> 8, mi = r & 255; const float* raw = MEMRAW + (size_t)m * 2048;
                    const f32x4 gk = *(const f32x4*)(in[17] + l * 256 + lane * 4), gq = *(const f32x4*)(in[16] + l * 256 + lane * 4); const f32x4 gg = gk * gq;
#pragma unroll
                    for (int h = 0; h < 4; ++h) { const f32x4 k = *(const f32x4*)(raw + h * 256 + lane * 4); const float ss = wave_sum((k[0] * k[0] + k[1] * k[1]) + (k[2] * k[2] + k[3] * k[3]));
                        const float rstd = rsqrtf(ss * (1.f / 256.f) + EPS); uint2 o; o.x = pk2(k[0] * rstd * gg[0], k[1] * rstd * gg[1]); o.y = pk2(k[2] * rstd * gg[2], k[3] * rstd * gg[3]);
                        *(uint2*)(MK + ((size_t)l * 512 + (size_t)b * 256 + mi) * DM + h * 256 + lane * 4) = o;
                        const f32x4 v = *(const f32x4*)(raw + 1024 + h * 256 + lane * 4); bf16_t* vt = MVT + (size_t)l * 512 * DM + (((size_t)b * 4 + h) * 256 + lane * 4) * 256 + mi;
                        vt[0] = f2bf(v[0]); vt[256] = f2bf(v[1]); vt[512] = f2bf(v[2]); vt[768] = f2bf(v[3]); }
                    if (r == 0) { float mx = fmaxf(fmaxf(fabsf(gg[0]), fabsf(gg[1])), fmaxf(fabsf(gg[2]), fabsf(gg[3])));
#pragma unroll
                        for (int o = 1; o < 64; o <<= 1) mx = fmaxf(mx, __shfl_xor(mx, o));
                        if (lane == 0) CB[l] = 16.f * mx; } }
            }
        } else {
            const int l = (ph - N_PRO) / N_PER_LAYER, sp = (ph - N_PRO) % N_PER_LAYER;
            const float* xcur = l == 0 ? in[0] : out;
            if (sp == 0) {
                if (sub & SUB_NORM) { LAS float* WfT = (LAS float*)lds; const float* wf = in[4] + (size_t)l * DM * NIN + 3072;
                    for (int i = tid; i < 16 * 1024; i += MEGA_THREADS) { const int k = i >> 4, h = i & 15; WfT[h * 1024 + k] = wf[(size_t)k * NIN + h]; } }
                __syncthreads();
                if (sub & SUB_CONV) { LAS float* scr = (LAS float*)(lds + 65536 + wave * 8448);
                    const float* win = in[4] + (size_t)l * DM * NIN;
                    for (int it = gw; it < 13440; it += NGW) { int r = it;
                        if (r < 1536) { tr_item(win, NIN, WIN_T, DM, 96, scr, r, lane, 1, 0); continue; } r -= 1536;
                        if (r < 5120) { tr_item(win + 3088, NIN, WIN_T + (size_t)3072 * DM, DM, 320, scr, r, lane, 1, 0); continue; } r -= 5120;
                        if (r < 2048) { const int i = r >> 9; tr_item(in[19] + ((size_t)l * 4 + i) * DM * DM, DM, WBR_T + (size_t)i * DM * DM, DM, 32, scr, r & 511, lane, 1, 0); continue; } r -= 2048;
                        if (r < 512) { tr_item(in[20] + (size_t)l * DM * DM, DM, WOUT_T, 4096, 32, scr, r, lane, 4, 1024); continue; } r -= 512;
                        if (r < 2816) { tr_item(in[22] + (size_t)l * DM * 2 * DFF, 2 * DFF, WUP_T, DM, 176, scr, r, lane, 1, 0); continue; } r -= 2816;
                        tr_item(in[25] + (size_t)l * DFF * DM, DM, WDN_T, DFF, 32, scr, r, lane, 1, 0); } }
                if (sub & SUB_NORM) for (int m = gw; m < T; m += NGW) norm_row(xcur + (size_t)m * DM, in[2] + l * DM, H + (size_t)m * DM, (const LAS float*)lds, !DBG_NOLOGF, in[5] + l * 16, LOGF, m, lane);
            } else if (sp == 1) {
                LocOrder<LocStd> S; S.so.init(T, 13312, G, bx); S.loc = LocStd{(const char*)H, (const char*)WIN_T, 256 * 1024 * 2, 256 * 1024 * 2};
                if (EN_GEMM) pg8::gemm_phase<EpiProj, LocOrder<LocStd>, true, true>(lds, pg8::Gemm{DM, DM, DM}, S, EpiProj{PROJ, GATES, MQSS});
            } else if (sp == 2) {
                if (sub & SUB_HEADNORM) { for (int m = gw; m < 2 * T; m += NGW) { if (m < T) headnorm64_row(FQ + (size_t)m * DM, in[6] + l * 64, C2, lane); else headnorm64_row(FK + (size_t)(m - T) * DM, in[7] + l * 64, 1.f, lane); } }
                if ((sub & SUB_CUMSUM) && bx < 32) cumsum_block(LOGF + (size_t)bx * SEQ, FB + (size_t)bx * SEQ, (LAS float*)lds, tid);
                __syncthreads();
                if (EN_LRU && (sub & SUB_LRU)) lru_pass<false>(l, bx, G, in, LX, LG, YL, APROD, HEND, lds, tid);
                if (EN_SB && (sub & SUB_SB)) for (int k = 0; k < 4; ++k) { const int bh = vcu >> 3, qb = (vcu & 7) * 4 + k; sb_wave(bh >> 4, bh & 15, qb * 256 + wave * 32, SQ, SK, SV, H, lds + wave * 4096, lane); }
                __syncthreads();
                if (sub & SUB_MEM) { LocOrder<LocMemS> S; S.so.init(T, 1024, G, bx); S.loc = LocMemS{(const char*)MQ, (const char*)(MK + (size_t)l * 512 * DM)};
                    if (EN_GEMM) pg8::gemm_phase<EpiSexp, LocOrder<LocMemS>, true, true>(lds, pg8::Gemm{DM, DM, 256 + zs}, S, EpiSexp{Eb, MQSS, ESUM, CB + l}); }
            } else if (sp == 3) {
                if (EN_FOX && (sub & SUB_FOX)) { const attn_body::AttnTensors AT{(const attn_body::bf16*)FQ, (const attn_body::bf16*)FK, (const attn_body::bf16*)FV, (attn_body::bf16*)SV, FB};
                    const attn_body::StaticOrder S(G, bx); attn_body::attn_phase<attn_body::StaticOrder, 20>((char*)lds_raw, AT, S); }
                __syncthreads();
                if (EN_LRU && (sub & SUB_LRU)) lru_pass<true>(l, bx, G, in, LX, LG, YL, APROD, HEND, lds, tid);
                if (sub & SUB_MEM) { LocOrder<LocMemPV> S; S.so.init(T, 1024, G, bx); S.loc = LocMemPV{(const char*)Eb, (const char*)(MVT + (size_t)l * 512 * DM)};
                    if (EN_GEMM) pg8::gemm_phase<EpiMemPV, LocOrder<LocMemPV>, true, true>(lds, pg8::Gemm{DM, 256, 256 + zs}, S, EpiMemPV{MQ, ESUM}); }
            } else if (sp == 4) {
                LocOrder<LocBranch> S; S.so.init(T, 4096, G, bx); S.loc = LocBranch{(const char*)SV, (const char*)YL, (const char*)H, (const char*)MQ, (const char*)WBR_T};
                if (EN_GEMM) pg8::gemm_phase<EpiBranch, LocOrder<LocBranch>, true, true>(lds, pg8::Gemm{DM, DM, DM}, S, EpiBranch{GATES, in[18] + (size_t)l * 4 * DM});
            } else if (sp == 5) {
                LocOrder<LocStd> S; S.so.init(T, DM, G, bx); S.loc = LocStd{(const char*)GATES, (const char*)WOUT_T, 256 * 4096 * 2, 256 * 4096 * 2};
                if (EN_GEMM) pg8::gemm_phase<EpiResid, LocOrder<LocStd>, true, true>(lds, pg8::Gemm{4096, 4096, 4096}, S, EpiResid{xcur, out});
            } else if (sp == 6) {
                for (int m = gw; m < T; m += NGW) norm_row(out + (size_t)m * DM, in[21] + l * DM, H + (size_t)m * DM, (const LAS float*)lds, false, nullptr, nullptr, m, lane);
            } else if (sp == 7) {
                LocOrder<LocStd> S; S.so.init(T, 2 * DFF, G, bx); S.loc = LocStd{(const char*)H, (const char*)WUP_T, 256 * 1024 * 2, 256 * 1024 * 2};
                if (EN_GEMM) pg8::gemm_phase<EpiBf16P, LocOrder<LocStd>, true, true>(lds, pg8::Gemm{DM, DM, DM}, S, EpiBf16P{GV, 2 * DFF, 0});
            } else if (sp == 8) {
                const float* cw = in[23] + (size_t)l * 3 * DFF; const float* cbv = in[24] + l * DFF;
                for (int i = bx * MEGA_THREADS + tid; i < T * (DFF / 8); i += G * MEGA_THREADS) { const int r = i / (DFF / 8), c = (i % (DFF / 8)) * 8, t = r % SEQ;
                    const bf16_t* gp = GV + (size_t)r * 2 * DFF + c; const u32x4 z4 = {0u, 0u, 0u, 0u};
                    const u32x4 g0 = *(const u32x4*)gp, g1 = t >= 1 ? *(const u32x4*)(gp - 2 * DFF) : z4, g2 = t >= 2 ? *(const u32x4*)(gp - 4 * DFF) : z4, vv = *(const u32x4*)(gp + DFF);
                    const f32x4 wa0 = *(const f32x4*)(cw + c), wa1 = *(const f32x4*)(cw + c + 4), wb0 = *(const f32x4*)(cw + DFF + c), wb1 = *(const f32x4*)(cw + DFF + c + 4), wc0 = *(const f32x4*)(cw + 2 * DFF + c), wc1 = *(const f32x4*)(cw + 2 * DFF + c + 4);
                    const f32x4 bb0 = *(const f32x4*)(cbv + c), bb1 = *(const f32x4*)(cbv + c + 4);
#define ACT1(G0, G1, G2, VV, W0, W1, W2, BB) ({ const float pre_ = (BB) + (W2) * (G0) + (W1) * (G1) + (W0) * (G2); pre_ * fast_sigmoid(pre_) * (VV); })
                    u32x4 o;
                    o.x = pk2(ACT1(blo(g0.x), blo(g1.x), blo(g2.x), blo(vv.x), wa0[0], wb0[0], wc0[0], bb0[0]), ACT1(bhi(g0.x), bhi(g1.x), bhi(g2.x), bhi(vv.x), wa0[1], wb0[1], wc0[1], bb0[1]));
                    o.y = pk2(ACT1(blo(g0.y), blo(g1.y), blo(g2.y), blo(vv.y), wa0[2], wb0[2], wc0[2], bb0[2]), ACT1(bhi(g0.y), bhi(g1.y), bhi(g2.y), bhi(vv.y), wa0[3], wb0[3], wc0[3], bb0[3]));
                    o.z = pk2(ACT1(blo(g0.z), blo(g1.z), blo(g2.z), blo(vv.z), wa1[0], wb1[0], wc1[0], bb1[0]), ACT1(bhi(g0.z), bhi(g1.z), bhi(g2.z), bhi(vv.z), wa1[1], wb1[1], wc1[1], bb1[1]));
                    o.w = pk2(ACT1(blo(g0.w), blo(g1.w), blo(g2.w), blo(vv.w), wa1[2], wb1[2], wc1[2], bb1[2]), ACT1(bhi(g0.w), bhi(g1.w), bhi(g2.w), bhi(vv.w), wa1[3], wb1[3], wc1[3], bb1[3]));
#undef ACT1
                    *(u32x4*)(ACT + (size_t)r * DFF + c) = o; }
            } else {
                LocOrder<LocStd> S; S.so.init(T, DM, G, bx); S.loc = LocStd{(const char*)ACT, (const char*)WDN_T, 256 * DFF * 2, 256 * DFF * 2};
                if (EN_GEMM) pg8::gemm_phase<EpiResid, LocOrder<LocStd>, true, true>(lds, pg8::Gemm{DFF, DFF, DFF}, S, EpiResid{out, out});
            }
        }
        if (ph + 1 < a.ph_hi) {
            if (ph == a.ph_lo) grid.sync();
            else { XcdBarrier xb; xb.bar = (unsigned*)(ws + WS_BAR); xb.x = xb_xcc_id(); xb.st = (volatile LAS unsigned*)(lds + XB_LDS_OFF); xcd_barrier(xb); }
        }
    }
}
enum { C_PRO = 1, C_NORM = 2, C_WIN = 4, C_HN = 8, C_LRU = 16, C_SB = 32, C_MEM = 64, C_FOX = 128, C_BR = 256, C_WOUT = 512, C_NORM2 = 1024, C_UP = 2048, C_ACT = 4096, C_DOWN = 8192, C_ONE = 16384 };
#ifndef CFG
#define CFG 32767
#endif
#ifndef REPEAT_SP
#define REPEAT_SP (-1)
#define REPEAT_N 0
#define REPEAT_SUB 0
#endif
static int g_grid = 0;
static void launch_mega(const Ptrs& P, int lo, int hi, int sub, hipStream_t st, bool coop) {
    MArgs a{}; a.P = P; a.ph_lo = lo; a.ph_hi = hi; a.sub = sub; a.pad = 0;
    if (coop) { void* args[] = {&a}; const hipError_t e = hipLaunchCooperativeKernel((const void*)mega, dim3(g_grid), dim3(MEGA_THREADS), args, MEGA_LDS, st);
        if (e != hipSuccess) fprintf(stderr, "cooperative launch failed: %s (grid %d)\n", hipGetErrorString(e), g_grid); }
    else { hipLaunchKernelGGL(mega, dim3(g_grid), dim3(MEGA_THREADS), MEGA_LDS, st, a);
        if (REPEAT_N > 0 && hi == lo + 1 && lo >= N_PRO && (lo - N_PRO) % N_PER_LAYER == (REPEAT_SP)) { a.sub = (REPEAT_SUB); for (int r = 0; r < (REPEAT_N); ++r) hipLaunchKernelGGL(mega, dim3(g_grid), dim3(MEGA_THREADS), MEGA_LDS, st, a); } }
}
static void run_hybrid(const Ptrs& P, hipStream_t st) {
    unsigned char* ws = P.ws;
    bf16_t* H = (bf16_t*)(ws + WS_H);
    bf16_t* PR[9]; for (int i = 0; i < 9; ++i) PR[i] = (bf16_t*)(ws + WS_PROJ + i * SZ_ACT);
    bf16_t *FQ = PR[0], *FK = PR[1], *FV = PR[2], *LX = PR[3], *LG = PR[4], *SQ = PR[5], *SK = PR[6], *SV = PR[7], *MQ = PR[8];
    bf16_t* GATES = (bf16_t*)(ws + WS_GATES);
    bf16_t *YL = (bf16_t*)(ws + WS_YL), *YS = (bf16_t*)(ws + WS_YS), *YM = (bf16_t*)(ws + WS_YM), *YF = (bf16_t*)(ws + WS_YF);
    float *LOGF = (float*)(ws + WS_LOGF), *FB = (float*)(ws + WS_FB);
    bf16_t* MEMN = (bf16_t*)(ws + WS_MEMN); float* MEMRAW = (float*)(ws + WS_MEMRAW);
    bf16_t *MK = (bf16_t*)(ws + WS_MK), *MVT = (bf16_t*)(ws + WS_MVT);
    bf16_t *GV = (bf16_t*)(ws + WS_GV), *ACT = (bf16_t*)(ws + WS_ACT);
    const float* const* in = P.in;
    const int cfg = CFG;
    const bool anygemm = cfg & (C_WIN | C_BR | C_WOUT | C_UP | C_DOWN);
    if (cfg & C_PRO) { for (int p = 0; p < 3; ++p) launch_mega(P, p, p + 1, SUB_ALL, st, false); }
    else for (int l = 0; l < DEPTH; ++l) {
        n_rmsnorm<<<512 / 4, 256, 0, st>>>(in[1], in[3] + l * DM, MEMN + (size_t)l * 512 * DM, nullptr, nullptr, nullptr, 512);
        n_gemm<EStoreF32><<<dim3(2048 / 64, 512 / 64), 256, 0, st>>>(MEMN + (size_t)l * 512 * DM, in[15] + (size_t)l * DM * 2048, DM, 2048, DM, 0x7fffffff, EStoreF32{MEMRAW + (size_t)l * 512 * 2048, 2048, 0});
        n_memkv_post<<<512, 256, 0, st>>>(MEMRAW + (size_t)l * 512 * 2048, in[17] + l * 256, in[16] + l * 256, MK + (size_t)l * 512 * DM, MVT + (size_t)l * 512 * DM);
    }
    for (int l = 0; l < DEPTH; ++l) {
        const int p0 = N_PRO + l * N_PER_LAYER;
        const float* xcur = l == 0 ? in[0] : P.out;
        const float* win = in[4] + (size_t)l * DM * NIN;
        if (DBG_NOLOGF) n_rmsnorm<<<T / 4, 256, 0, st>>>(xcur, in[2] + l * DM, H, win + 3072, in[5] + l * 16, LOGF, T);
        { const int sub = (anygemm ? SUB_CONV : 0) | ((cfg & C_NORM) ? SUB_NORM : 0); if (sub) launch_mega(P, p0, p0 + 1, sub, st, false); }
        if (!(cfg & C_NORM)) n_rmsnorm<<<T / 4, 256, 0, st>>>(xcur, in[2] + l * DM, H, win + 3072, in[5] + l * 16, LOGF, T);
        if (cfg & C_WIN) launch_mega(P, p0 + 1, p0 + 2, SUB_ALL, st, false);
        else { for (int gI = 0; gI < 9; ++gI) { const int coff = gI < 3 ? gI * 1024 : gI * 1024 + 16;
                n_gemm<EStoreBf16><<<dim3(1024 / 64, T / 64), 256, 0, st>>>(H, win + coff, DM, NIN, DM, 0x7fffffff, EStoreBf16{PR[gI], DM, 0}); }
            n_gemm<EStoreBf16><<<dim3(4096 / 64, T / 64), 256, 0, st>>>(H, win + 9232, DM, NIN, DM, 0x7fffffff, EStoreBf16{GATES, 4096, 0}); }
        if (!(cfg & C_HN)) { n_headnorm<<<T * 16 / 256, 256, 0, st>>>(FQ, in[6] + l * 64, 64, C2); n_headnorm<<<T * 16 / 256, 256, 0, st>>>(FK, in[7] + l * 64, 64, 1.f); n_cumsum<<<32, 1024, 0, st>>>(LOGF, FB); }
        const int sub23 = ((cfg & C_HN) ? (SUB_HEADNORM | SUB_CUMSUM) : 0) | ((cfg & C_LRU) ? SUB_LRU : 0) | ((cfg & C_SB) ? SUB_SB : 0) | ((cfg & C_MEM) ? SUB_MEM : 0) | ((cfg & C_FOX) ? SUB_FOX : 0);
        if (sub23 & ~SUB_FOX) launch_mega(P, p0 + 2, p0 + 3, sub23, st, false);
        if (!(cfg & C_SB)) n_sb_attn<<<dim3(SEQ / 256, 32), 256, 0, st>>>(SQ, SK, SV, YS);
        if (!(cfg & C_LRU)) n_lru<<<32, 64, 0, st>>>(LX, LG, in[8] + (size_t)l * 4 * DM, in[9] + l * DM, in[10] + (size_t)l * 16 * 64 * 64, in[11] + l * DM, in[12] + (size_t)l * 16 * 64 * 64, in[13] + l * DM, in[14] + l * DM, YL);
        if (!(cfg & C_MEM)) n_mem_attn<<<T * 4, 256, 0, st>>>(MQ, MK + (size_t)l * 512 * DM, MVT + (size_t)l * 512 * DM, YM);
        if (sub23 & (SUB_FOX | SUB_LRU | SUB_MEM)) launch_mega(P, p0 + 3, p0 + 4, sub23, st, false);
        if (!(cfg & C_FOX)) n_fox_attn<<<dim3(SEQ / 256, 32), 256, 0, st>>>(FQ, FK, FV, FB, YF);
        if (cfg & C_BR) launch_mega(P, p0 + 4, p0 + 5, SUB_ALL, st, false);
        else { const bf16_t* Y[4] = {YF, YL, YS, YM};
            for (int i = 0; i < 4; ++i) n_gemm<EBranch><<<dim3(1024 / 64, T / 64), 256, 0, st>>>(Y[i], in[19] + ((size_t)l * 4 + i) * DM * DM, DM, DM, DM, 0x7fffffff, EBranch{GATES, in[18] + ((size_t)l * 4 + i) * DM, i, 0}); }
        if (cfg & C_WOUT) launch_mega(P, p0 + 5, p0 + 6, SUB_ALL, st, false);
        else n_gemm<EResid><<<dim3(1024 / 64, T / 64), 256, 0, st>>>(GATES, in[20] + (size_t)l * DM * DM, 4096, DM, 4096, 1023, EResid{xcur, P.out});
        if (cfg & C_NORM2) launch_mega(P, p0 + 6, p0 + 7, SUB_ALL, st, false);
        else n_rmsnorm<<<T / 4, 256, 0, st>>>(P.out, in[21] + l * DM, H, nullptr, nullptr, nullptr, T);
        if (cfg & C_UP) launch_mega(P, p0 + 7, p0 + 8, SUB_ALL, st, false);
        else n_gemm<EStoreBf16><<<dim3(2 * DFF / 64, T / 64), 256, 0, st>>>(H, in[22] + (size_t)l * DM * 2 * DFF, DM, 2 * DFF, DM, 0x7fffffff, EStoreBf16{GV, 2 * DFF, 0});
        if (cfg & C_ACT) launch_mega(P, p0 + 8, p0 + 9, SUB_ALL, st, false);
        else n_act<<<(unsigned)(((size_t)T * DFF + 255) / 256), 256, 0, st>>>(GV, in[23] + (size_t)l * 3 * DFF, in[24] + l * DFF, ACT);
        if (cfg & C_DOWN) launch_mega(P, p0 + 9, p0 + 10, SUB_ALL, st, false);
        else n_gemm<EResid><<<dim3(1024 / 64, T / 64), 256, 0, st>>>(ACT, in[25] + (size_t)l * DFF * DM, DFF, DM, DFF, 0x7fffffff, EResid{P.out, P.out});
    }
}

extern "C" void kernel_launch(void* const* d_in, const int* in_sizes, int n_in, void* d_out, int out_size, void* d_ws, size_t ws_size, hipStream_t stream) {
    if (n_in != 26 || out_size != T * DM || ws_size < WS_END) { fprintf(stderr, "kernel_launch: unexpected sizes n_in %d out %d ws %zu (need %zu)\n", n_in, out_size, ws_size, (size_t)WS_END); return; }
    if (g_grid == 0) {
        int dev = 0, cus = 0, per_cu = 0;
        hipGetDevice(&dev); hipDeviceGetAttribute(&cus, hipDeviceAttributeMultiprocessorCount, dev);
        if (hipFuncSetAttribute((const void*)mega, hipFuncAttributeMaxDynamicSharedMemorySize, MEGA_LDS) != hipSuccess) fprintf(stderr, "kernel_launch: hipFuncSetAttribute failed\n");
        if (hipOccupancyMaxActiveBlocksPerMultiprocessor(&per_cu, (const void*)mega, MEGA_THREADS, MEGA_LDS) != hipSuccess || per_cu < 1) fprintf(stderr, "kernel_launch: occupancy query says %d\n", per_cu);
        (void)hipGetLastError();
        g_grid = cus;
        if (g_grid != 256) fprintf(stderr, "kernel_launch: %d CUs; the attention phase's static order assumes 256\n", g_grid);
    }
    Ptrs P{};
    for (int i = 0; i < 26; ++i) P.in[i] = (const float*)d_in[i];
    P.out = (float*)d_out; P.ws = (unsigned char*)d_ws;
    if ((CFG) & C_ONE) { (void)hipMemsetAsync((char*)d_ws + WS_BAR, 0, XCD_BAR_WORDS * 4, stream);
        launch_mega(P, 0, N_PHASES, SUB_ALL, stream, true); }
    else run_hybrid(P, stream);
}
```

```cpp
#include <hip/hip_runtime.h>
#include <cstdio>
#include <cstdint>
#include <hip/hip_cooperative_groups.h>

typedef unsigned short bf16_t;
constexpr int BATCH = 2, SEQ = 8192, DM = 1024, DEPTH = 4, T = BATCH * SEQ;
constexpr int NMEM = 256, NIN = 13328, DFF = 2816;
constexpr float EPS = 1e-6f;
constexpr float LOG2E = 1.4426950408889634f;
constexpr float C2 = 0.125f * LOG2E;
constexpr float SB_THR = -104.0f;

__device__ __forceinline__ float bf2f(bf16_t b) { return __uint_as_float(((unsigned)b) << 16); }
__device__ __forceinline__ bf16_t f2bf(float f) { unsigned u = __float_as_uint(f); return (bf16_t)((u + 0x7fffu + ((u >> 16) & 1u)) >> 16); }
__device__ __forceinline__ float bfr(float f) { return bf2f(f2bf(f)); }
__device__ __forceinline__ float wave_sum(float v) {
#pragma unroll
    for (int o = 1; o < 64; o <<= 1) v += __shfl_xor(v, o);
    return v;
}
__device__ __forceinline__ float softplusf(float x) { return fmaxf(x, 0.f) + log1pf(__expf(-fabsf(x))); }
__device__ __forceinline__ float logsigmoidf(float x) { return -softplusf(-x); }
__device__ __forceinline__ float sigmoidf_(float x) { return 1.f / (1.f + __expf(-x)); }
__device__ __forceinline__ float gelu_tanh(float x) { const float u = 0.7978845608028654f * (x + 0.044715f * x * x * x); return 0.5f * x * (1.f + tanhf(u)); }

__device__ __forceinline__ int mk_tid() { int t = threadIdx.x; asm volatile("" : "+v"(t)); return t; }

constexpr size_t MiB = 1u << 20;
constexpr size_t SZ_ACT = (size_t)T * DM * 2;
constexpr size_t WS_CTL = 0;
constexpr size_t WS_H = 1 * MiB;
constexpr size_t WS_PROJ = WS_H + SZ_ACT;
constexpr size_t WS_GATES = WS_PROJ + 9 * SZ_ACT;
constexpr size_t WS_E = WS_GATES + 4 * SZ_ACT;
constexpr size_t WS_LOGF = WS_E + SZ_ACT;
constexpr size_t WS_FB = WS_LOGF + 1 * MiB;
constexpr size_t WS_MQSS = WS_FB + 1 * MiB;
constexpr size_t WS_ESUM = WS_MQSS + 1 * MiB;
constexpr size_t WS_MEMN = WS_ESUM + 1 * MiB;
constexpr size_t WS_MEMRAW = WS_MEMN + 4 * MiB;
constexpr size_t WS_MK = WS_MEMRAW + 16 * MiB;
constexpr size_t WS_MVT = WS_MK + 4 * MiB;
constexpr size_t WS_LRU = WS_MVT + 4 * MiB;
constexpr size_t WS_WT = WS_LRU + 2 * MiB;
constexpr size_t WS_END = WS_WT + 72 * MiB;
constexpr size_t WS_YL = WS_PROJ + 6 * SZ_ACT, WS_YS = WS_H, WS_YM = WS_PROJ + 8 * SZ_ACT, WS_YF = WS_PROJ + 7 * SZ_ACT;
constexpr size_t WS_GV = WS_PROJ;
constexpr size_t WS_ACT = WS_GV + (size_t)T * 2 * DFF * 2;
static_assert(WS_ACT + (size_t)T * DFF * 2 <= WS_GATES, "ffn alias");
constexpr size_t WS_MIXF = WS_END;
constexpr size_t WS_MIXED = WS_PROJ;
constexpr size_t WS_NEED = WS_MIXF + (size_t)T * DM * 4;

struct Ptrs {
    const float* in[26];
    float* out;
    unsigned char* ws;
};

__global__ void __launch_bounds__(256) n_rmsnorm(const float* __restrict__ x, const float* __restrict__ g, bf16_t* __restrict__ H,
                                                 const float* __restrict__ Wf, const float* __restrict__ bfg, float* __restrict__ LOGF, int nrows) {
    const int lane = threadIdx.x & 63, row = blockIdx.x * 4 + (threadIdx.x >> 6);
    if (row >= nrows) return;
    const float4* xr = (const float4*)(x + (size_t)row * DM);
    const float4* gr = (const float4*)g;
    float4 v[4]; float ss = 0.f;
#pragma unroll
    for (int j = 0; j < 4; ++j) { v[j] = xr[lane + 64 * j]; ss += v[j].x * v[j].x + v[j].y * v[j].y + v[j].z * v[j].z + v[j].w * v[j].w; }
    ss = wave_sum(ss);
    const float rstd = rsqrtf(ss * (1.f / DM) + EPS);
#pragma unroll
    for (int j = 0; j < 4; ++j) { const float4 gg = gr[lane + 64 * j]; v[j].x *= rstd * gg.x; v[j].y *= rstd * gg.y; v[j].z *= rstd * gg.z; v[j].w *= rstd * gg.w;
        ushort4 o; o.x = f2bf(v[j].x); o.y = f2bf(v[j].y); o.z = f2bf(v[j].z); o.w = f2bf(v[j].w);
        ((ushort4*)(H + (size_t)row * DM))[lane + 64 * j] = o; }
    if (Wf) {
        float mine = 0.f;
        for (int h = 0; h < 16; ++h) {
            float p = 0.f;
#pragma unroll
            for (int j = 0; j < 4; ++j) { const int k = (lane + 64 * j) * 4;
                p += v[j].x * Wf[(size_t)k * NIN + h] + v[j].y * Wf[(size_t)(k + 1) * NIN + h] + v[j].z * Wf[(size_t)(k + 2) * NIN + h] + v[j].w * Wf[(size_t)(k + 3) * NIN + h]; }
            p = wave_sum(p);
            if (lane == h) mine = p;
        }
        if (lane < 16) { const int b = row / SEQ, t = row % SEQ; LOGF[((size_t)b * 16 + lane) * SEQ + t] = logsigmoidf(mine + bfg[lane]); }
    }
}

struct EStoreBf16 { bf16_t* O; int ldc; int pad; __device__ void operator()(int m, int n, float a) const { O[(size_t)m * ldc + n] = f2bf(a); } };
struct EStoreF32 { float* O; int ldc; int pad; __device__ void operator()(int m, int n, float a) const { O[(size_t)m * ldc + n] = a; } };
struct EBranch { const bf16_t* G; const float* bg; float* MIXF; bf16_t* MIXED; int i; int pad; __device__ void operator()(int m, int n, float a) const { float v = sigmoidf_(bf2f(G[(size_t)m * 4096 + i * 1024 + n]) + bg[n]) * a; const size_t o = (size_t)m * DM + n; if (i > 0) v += MIXF[o]; if (i < 3) MIXF[o] = v; else MIXED[o] = f2bf(v); } };
struct EResid { const float* base; float* out; __device__ void operator()(int m, int n, float a) const { out[(size_t)m * DM + n] = base[(size_t)m * DM + n] + a; } };

template <class Epi> __global__ void __launch_bounds__(256) n_gemm(const bf16_t* __restrict__ A, const float* __restrict__ W, int lda, int ldw, int K, int kmask, Epi epi) {
    __shared__ float As[16][68], Bs[16][68];
    const int tx = threadIdx.x & 15, ty = threadIdx.x >> 4, m0 = blockIdx.y * 64, n0 = blockIdx.x * 64;
    float acc[4][4];
#pragma unroll
    for (int i = 0; i < 4; ++i)
#pragma unroll
        for (int j = 0; j < 4; ++j) acc[i][j] = 0.f;
    for (int k0 = 0; k0 < K; k0 += 16) {
#pragma unroll
        for (int i = 0; i < 4; ++i) { const int idx = threadIdx.x + i * 256; { const int r = idx >> 4, c = idx & 15; As[c][r] = bf2f(A[(size_t)(m0 + r) * lda + k0 + c]); }
            { const int r = idx >> 6, c = idx & 63; Bs[r][c] = bfr(W[(size_t)((k0 + r) & kmask) * ldw + n0 + c]); } }
        __syncthreads();
#pragma unroll
        for (int kk = 0; kk < 16; ++kk) { float a[4], b[4];
#pragma unroll
            for (int i = 0; i < 4; ++i) { a[i] = As[kk][ty * 4 + i]; b[i] = Bs[kk][tx * 4 + i]; }
#pragma unroll
            for (int i = 0; i < 4; ++i)
#pragma unroll
                for (int j = 0; j < 4; ++j) acc[i][j] += a[i] * b[j]; }
        __syncthreads();
    }
#pragma unroll
    for (int i = 0; i < 4; ++i)
#pragma unroll
        for (int j = 0; j < 4; ++j) epi(m0 + ty * 4 + i, n0 + tx * 4 + j, acc[i][j]);
}

__global__ void __launch_bounds__(256) n_headnorm(bf16_t* X, const float* __restrict__ g, int HD, float scale) {
    const int idx = blockIdx.x * 256 + threadIdx.x, nh = DM / HD, row = idx / nh, h = idx % nh;
    if (row >= T) return;
    bf16_t* p = X + (size_t)row * DM + h * HD; float ss = 0.f;
    for (int d = 0; d < HD; ++d) { const float v = bf2f(p[d]); ss += v * v; }
    const float rstd = rsqrtf(ss / HD + EPS) * scale;
    for (int d = 0; d < HD; ++d) p[d] = f2bf(bf2f(p[d]) * rstd * g[d]);
}

__global__ void __launch_bounds__(1024) n_cumsum(const float* __restrict__ LOGF, float* __restrict__ FB) {
    __shared__ float part[1024];
    const int bh = blockIdx.x, tid = threadIdx.x; const float* src = LOGF + (size_t)bh * SEQ + tid * 8; float v[8]; float s = 0.f;
#pragma unroll
    for (int i = 0; i < 8; ++i) { s += src[i]; v[i] = s; }
    part[tid] = s; __syncthreads();
    if (tid == 0) { float run = 0.f; for (int i = 0; i < 1024; ++i) { const float t_ = part[i]; part[i] = run; run += t_; } }
    __syncthreads();
    const float off = part[tid]; float* dst = FB + (size_t)bh * SEQ + tid * 8;
#pragma unroll
    for (int i = 0; i < 8; ++i) dst[i] = off + v[i];
}

__global__ void __launch_bounds__(256) n_fox_attn(const bf16_t* Q, const bf16_t* __restrict__ K, const bf16_t* __restrict__ V, const float* __restrict__ FB, bf16_t* O) {
    __shared__ float Ks[64][64], Vs[64][64], Fs[64];
    const int bh = blockIdx.y, b = bh >> 4, h = bh & 15, tq = blockIdx.x * 256 + threadIdx.x;
    const size_t rowq = (size_t)b * SEQ + tq;
    float q[64], o[64];
#pragma unroll
    for (int d = 0; d < 64; ++d) { q[d] = bf2f(Q[rowq * DM + h * 64 + d]); o[d] = 0.f; }
    const float Ft = FB[(size_t)bh * SEQ + tq];
    float m = -INFINITY, l = 0.f;
    const int ntile = (blockIdx.x * 256 + 256) / 64;
    for (int kt = 0; kt < ntile; ++kt) {
        __syncthreads();
        for (int i = threadIdx.x; i < 64 * 64; i += 256) { const int r = i >> 6, c = i & 63; const size_t rk = ((size_t)b * SEQ + kt * 64 + r) * DM + h * 64 + c; Ks[r][c] = bf2f(K[rk]); Vs[r][c] = bf2f(V[rk]); }
        if (threadIdx.x < 64) Fs[threadIdx.x] = FB[(size_t)bh * SEQ + kt * 64 + threadIdx.x];
        __syncthreads();
        for (int j = 0; j < 64; ++j) {
            const int s = kt * 64 + j; if (s > tq) break;
            float z = 0.f;
#pragma unroll
            for (int d = 0; d < 64; ++d) z += q[d] * Ks[j][d];
            z += (Ft - Fs[j]) * LOG2E;
            if (z > m) { const float c = exp2f(m - z); l *= c;
#pragma unroll
                for (int d = 0; d < 64; ++d) o[d] *= c;
                m = z; }
            const float p = exp2f(z - m); l += p;
#pragma unroll
            for (int d = 0; d < 64; ++d) o[d] += p * Vs[j][d];
        }
    }
    const float il = 1.f / l;
#pragma unroll
    for (int d = 0; d < 64; ++d) O[rowq * DM + h * 64 + d] = f2bf(o[d] * il);
}

__global__ void __launch_bounds__(256) n_sb_attn(const bf16_t* Q, const bf16_t* __restrict__ K, const bf16_t* __restrict__ V, bf16_t* O) {
    __shared__ float Ks[64][64], Vs[64][64];
    const int bh = blockIdx.y, b = bh >> 4, h = bh & 15, tq = blockIdx.x * 256 + threadIdx.x;
    const size_t rowq = (size_t)b * SEQ + tq;
    float q[64], o[64];
#pragma unroll
    for (int d = 0; d < 64; ++d) { q[d] = bf2f(Q[rowq * DM + h * 64 + d]) * 0.125f; o[d] = 0.f; }
    float R = 0.f;
    for (int kt = (blockIdx.x * 256 + 255) / 64; kt >= 0; --kt) {
        if (__syncthreads_and(R < SB_THR)) break;
        for (int i = threadIdx.x; i < 64 * 64; i += 256) { const int r = i >> 6, c = i & 63; const size_t rk = ((size_t)b * SEQ + kt * 64 + r) * DM + h * 64 + c; Ks[r][c] = bf2f(K[rk]); Vs[r][c] = bf2f(V[rk]); }
        __syncthreads();
        for (int j = 63; j >= 0; --j) {
            const int s = kt * 64 + j; if (s >= tq) continue;
            float z = 0.f;
#pragma unroll
            for (int d = 0; d < 64; ++d) z += q[d] * Ks[j][d];
            const float sp = softplusf(z);
            const float w = __expf((z - sp) + R);
            R -= sp;
#pragma unroll
            for (int d = 0; d < 64; ++d) o[d] += w * Vs[j][d];
        }
    }
#pragma unroll
    for (int d = 0; d < 64; ++d) O[rowq * DM + h * 64 + d] = f2bf(o[d]);
}

__global__ void __launch_bounds__(64) n_lru(const bf16_t* LX, const bf16_t* __restrict__ LG, const float* __restrict__ cw, const float* __restrict__ cb,
                                            const float* __restrict__ wa, const float* __restrict__ ba, const float* __restrict__ wx, const float* __restrict__ bx,
                                            const float* __restrict__ lam, bf16_t* YL) {
    __shared__ float xs[64];
    const int b = blockIdx.x >> 4, n = blockIdx.x & 15, e = threadIdx.x, ch = n * 64 + e;
    float wA[64], wX[64];
#pragma unroll
    for (int d = 0; d < 64; ++d) { wA[d] = wa[((size_t)n * 64 + d) * 64 + e]; wX[d] = wx[((size_t)n * 64 + d) * 64 + e]; }
    const float w0 = cw[ch], w1 = cw[DM + ch], w2 = cw[2 * DM + ch], w3 = cw[3 * DM + ch], bc = cb[ch], bA = ba[ch], bX = bx[ch];
    const float spl = softplusf(-lam[ch]);
    float x1 = 0.f, x2 = 0.f, x3 = 0.f, hs = 0.f;
    for (int t = 0; t < SEQ; ++t) {
        const size_t r = ((size_t)b * SEQ + t) * DM + ch;
        const float x0 = bf2f(LX[r]);
        const float xc = bc + w3 * x0 + w2 * x1 + w1 * x2 + w0 * x3;
        x3 = x2; x2 = x1; x1 = x0;
        __syncthreads();
        xs[e] = xc;
        __syncthreads();
        float ra = bA, ri = bX;
#pragma unroll
        for (int d = 0; d < 64; ++d) { const float xv = xs[d]; ra += xv * wA[d]; ri += xv * wX[d]; }
        const float rr = sigmoidf_(ra), ii = sigmoidf_(ri);
        const float la = -8.f * rr * spl;
        const float a = __expf(la);
        const float u = sqrtf(-expm1f(2.f * la)) * (ii * xc);
        hs = a * hs + u;
        YL[r] = f2bf(hs * gelu_tanh(bf2f(LG[r])));
    }
}

__global__ void __launch_bounds__(256) n_memkv_post(const float* __restrict__ raw, const float* __restrict__ gk, const float* __restrict__ gq, bf16_t* __restrict__ MK, bf16_t* __restrict__ MVT) {
    const int row = blockIdx.x, b = row >> 8, m = row & 255, d = threadIdx.x;
    __shared__ float red[4];
    for (int h = 0; h < 4; ++h) {
        const float k = raw[(size_t)row * 2048 + h * 256 + d];
        float ss = wave_sum(k * k);
        __syncthreads();
        if ((threadIdx.x & 63) == 0) red[threadIdx.x >> 6] = ss;
        __syncthreads();
        ss = red[0] + red[1] + red[2] + red[3];
        const float rstd = rsqrtf(ss * (1.f / 256.f) + EPS);
        MK[((size_t)b * 256 + m) * DM + h * 256 + d] = f2bf(k * rstd * gk[d] * gq[d]);
        MVT[(((size_t)b * 4 + h) * 256 + d) * 256 + m] = f2bf(raw[(size_t)row * 2048 + 1024 + h * 256 + d]);
    }
}

__global__ void __launch_bounds__(256) n_mem_attn(const bf16_t* MQ, const bf16_t* __restrict__ MK, const bf16_t* __restrict__ MVT, bf16_t* YM) {
    __shared__ float qs[256], ps[256], red[4];
    const int row = blockIdx.x >> 2, h = blockIdx.x & 3, b = row / SEQ, tid = threadIdx.x;
    const float qv = bf2f(MQ[(size_t)row * DM + h * 256 + tid]);
    float ss = wave_sum(qv * qv);
    if ((tid & 63) == 0) red[tid >> 6] = ss;
    qs[tid] = qv;
    __syncthreads();
    const float rstd = rsqrtf((red[0] + red[1] + red[2] + red[3]) * (1.f / 256.f) + EPS);
    const bf16_t* kr = MK + ((size_t)b * 256 + tid) * DM + h * 256;
    float s = 0.f;
    for (int d = 0; d < 256; ++d) s += qs[d] * bf2f(kr[d]);
    s *= rstd * (1.f / 16.f);
    __syncthreads();
    float mx = s;
#pragma unroll
    for (int o = 1; o < 64; o <<= 1) mx = fmaxf(mx, __shfl_xor(mx, o));
    if ((tid & 63) == 0) red[tid >> 6] = mx;
    __syncthreads();
    mx = fmaxf(fmaxf(red[0], red[1]), fmaxf(red[2], red[3]));
    const float p = __expf(s - mx);
    ps[tid] = p;
    float sum = wave_sum(p);
    __syncthreads();
    if ((tid & 63) == 0) red[tid >> 6] = sum;
    __syncthreads();
    sum = red[0] + red[1] + red[2] + red[3];
    const bf16_t* vr = MVT + (((size_t)b * 4 + h) * 256 + tid) * 256;
    float o = 0.f;
    for (int m = 0; m < 256; ++m) o += ps[m] * bf2f(vr[m]);
    YM[(size_t)row * DM + h * 256 + tid] = f2bf(o / sum);
}

__global__ void __launch_bounds__(256) n_act(const bf16_t* __restrict__ GV, const float* __restrict__ cw, const float* __restrict__ cb, bf16_t* __restrict__ ACT) {
    const size_t idx = (size_t)blockIdx.x * 256 + threadIdx.x; if (idx >= (size_t)T * DFF) return;
    const int r = (int)(idx / DFF), c = (int)(idx % DFF), t = r % SEQ;
    const float g0 = bf2f(GV[(size_t)r * 2 * DFF + c]);
    const float g1 = t >= 1 ? bf2f(GV[(size_t)(r - 1) * 2 * DFF + c]) : 0.f;
    const float g2 = t >= 2 ? bf2f(GV[(size_t)(r - 2) * 2 * DFF + c]) : 0.f;
    const float pre = cb[c] + cw[2 * DFF + c] * g0 + cw[DFF + c] * g1 + cw[c] * g2;
    const float val = bf2f(GV[(size_t)r * 2 * DFF + DFF + c]);
    ACT[(size_t)r * DFF + c] = f2bf(pre * sigmoidf_(pre) * val);
}

#define CFG 32767
namespace pg8 {
#define PG8_LAS __attribute__((address_space(3)))
typedef unsigned short bf16_t;
typedef short bf16x8 __attribute__((ext_vector_type(8)));
typedef float f32x4 __attribute__((ext_vector_type(4)));
typedef unsigned u32x4 __attribute__((ext_vector_type(4)));
constexpr int BM = 256, BK = 64, HALF = 128, HTB = HALF * BK * 2  , STAGE_BYTES = 8 * HTB, NXCD = 8, WGM = 8;

__host__ __device__ __forceinline__ int lds_byte(int r, int c) { const int st = (r >> 4) * 2 + (c >> 5), rr = r & 15, cc = c & 31, ob = rr * 64 + cc * 2; return st * 1024 + (ob ^ (((ob >> 9) & 1) << 5)); }
__host__ __device__ __forceinline__ void stage_rc(int b, int& R, int& C) { const int st = b / 1024, sb = b % 1024, swz = sb ^ (((sb >> 9) & 1) << 5); R = (st >> 1) * 16 + swz / 64; C = (st & 1) * 32 + (swz % 64) / 2; }
__host__ __device__ __forceinline__ int perm32(int rho) { const int n = rho >> 4, i = rho & 15; return 8 * (i >> 2) + 4 * n + (i & 3); }

struct Unit { int pm, pn; };
struct Gemm { int lda, ldb, K; };

struct StaticOrder {
    int nM, nN, nwg, G, c;
    __host__ __device__ void init(int M, int N, int G_, int c_) { nM = M / BM; nN = N / BM; nwg = nM * nN; G = G_; c = c_; }
    __host__ __device__ bool next(int i, Unit& u) const {
        const long L = (long)i * G + c; if (L >= nwg) return false;
        int wgid = (int)L; { const int q = nwg / NXCD, r = nwg % NXCD, xcd = wgid % NXCD, off = wgid / NXCD; wgid = (xcd < r ? xcd * (q + 1) : r * (q + 1) + (xcd - r) * q) + off; }
        const int nig = WGM * nN, gid = wgid / nig, fm = gid * WGM, gsz = (nM - fm) < WGM ? (nM - fm) : WGM;
        u.pm = fm + ((wgid % nig) % gsz); u.pn = (wgid % nig) / gsz; return true;
    }
    __device__ __forceinline__ void a_ready(const Unit&) const {}
    __device__ __forceinline__ void done(const Unit&) const {}
};

__device__ __forceinline__ unsigned cvt_pk_bf16(float lo, float hi) { unsigned r; asm volatile("v_cvt_pk_bf16_f32 %0, %1, %2" : "=v"(r) : "v"(lo), "v"(hi)); return r; }
typedef float f32x2 __attribute__((ext_vector_type(2)));
__device__ __forceinline__ f32x2 gelu_pk(f32x2 v) {
    const f32x2 av = __builtin_elementwise_abs(v), d = av * 0.2316418882f + 1.0f;
    f32x2 t; t.x = __builtin_amdgcn_rcpf(d.x); t.y = __builtin_amdgcn_rcpf(d.y);
    f32x2 q = t * 0.5307027145f + (-0.7265760135f); q = q * t + 0.7107068705f; q = q * t + (-0.142248368f); q = q * t + 0.127414796f; q = q * t;
    const f32x2 s = (v * v) * (-0.72134752044f);
    f32x2 e; e.x = __builtin_amdgcn_exp2f(s.x); e.y = __builtin_amdgcn_exp2f(s.y);
    const f32x2 m = v * (q * e), r = v - m;
    f32x2 o; o.x = v.x < 0.f ? m.x : r.x; o.y = v.y < 0.f ? m.y : r.y; return o;
}

template <class Epi, class Sched, bool ALIGN_EPI = false, bool SP2 = false>
__device__ __forceinline__ void gemm_phase(PG8_LAS unsigned char* lds, const Gemm g, const Sched& S, const Epi& E) {
    const int tid = mk_tid(), wid = __builtin_amdgcn_readfirstlane(tid >> 6), lane = tid & 63, wr = wid >> 2, wc = wid & 3, fr = lane & 15, fq = lane >> 4;
    const int K = g.K, nt = K / BK;
    unsigned voffA[2], voffB[2];
#pragma unroll
    for (int i = 0; i < 2; ++i) { int R, C; stage_rc(tid * 16 + i * 8192, R, C); const int Rb = Epi::PERM ? ((R & ~31) + perm32(R & 31)) : R;
        voffA[i] = (unsigned)(R * g.lda + C) * 2u; voffB[i] = (unsigned)(Rb * g.ldb + C) * 2u; }
    const size_t kstep = (size_t)(BK * 2);
    const size_t hstepA = (size_t)HALF * g.lda * 2, hstepB = (size_t)HALF * g.ldb * 2;
    const unsigned ldsw = (unsigned)wid * 1024u;
    const int aoff = lds_byte(wr * 64 + fr, fq * 8), boff = lds_byte(wc * 32 + fr, fq * 8);
#define PG8_SA(b, h) (((b) * 2 + (h)) * HTB)
#define PG8_SB(b, h) ((4 + (b) * 2 + (h)) * HTB)
#define PG8_STAGE(bufoff, gbase, voff) do { _Pragma("unroll") for (int _i = 0; _i < 2; ++_i) \
        __builtin_amdgcn_global_load_lds((const unsigned*)((const char*)(gbase) + (voff)[_i]), (PG8_LAS unsigned*)(lds + (bufoff) + ldsw + _i * 8192), 16, 0, 0); } while (0)
#define PG8_LDA(dst, b, h) do { _Pragma("unroll") for (int m = 0; m < 4; ++m) _Pragma("unroll") for (int k = 0; k < 2; ++k) dst[m][k] = *(const PG8_LAS bf16x8*)(lds + PG8_SA(b, h) + aoff + m * 2048 + k * 1024); } while (0)
#define PG8_LDB(dst, b, h) do { _Pragma("unroll") for (int n = 0; n < 2; ++n) _Pragma("unroll") for (int k = 0; k < 2; ++k) dst[n][k] = *(const PG8_LAS bf16x8*)(lds + PG8_SB(b, h) + boff + n * 2048 + k * 1024); } while (0)
#define PG8_MMA(ai, bj, At, Bt) do { __builtin_amdgcn_s_setprio(1); _Pragma("unroll") for (int m = 0; m < 4; ++m) _Pragma("unroll") for (int n = 0; n < 2; ++n) _Pragma("unroll") for (int k = 0; k < 2; ++k) \
        acc[ai][bj][m][n] = __builtin_amdgcn_mfma_f32_16x16x32_bf16(Bt[n][k], At[m][k], acc[ai][bj][m][n], 0, 0, 0); __builtin_amdgcn_s_setprio(0); } while (0)
#define PG8_WAIT_V(n) asm volatile("s_waitcnt vmcnt(" #n ")" ::: "memory")
#define PG8_WAIT_L(n) asm volatile("s_waitcnt lgkmcnt(" #n ")" ::: "memory")
#define PG8_BAR __builtin_amdgcn_s_barrier()
#define PG8_SCHED __builtin_amdgcn_sched_barrier(0)
    Unit cur, nxt; int ui = 0;
    if (!S.next(0, cur)) return;
    f32x4 acc[2][2][4][2];
#pragma unroll
    for (int a = 0; a < 2; ++a)
#pragma unroll
        for (int b = 0; b < 2; ++b)
#pragma unroll
            for (int m = 0; m < 4; ++m)
#pragma unroll
                for (int n = 0; n < 2; ++n) acc[a][b][m][n] = (f32x4){0.f, 0.f, 0.f, 0.f};
    bf16x8 At[4][2], B0[2][2], B1[2][2];
    const char* cA = S.aptr(cur); const char* cB = S.bptr(cur);
    S.a_ready(cur);
    if constexpr (SP2) {
        PG8_STAGE(PG8_SB(0, 0), cB, voffB); PG8_STAGE(PG8_SB(0, 1), cB + hstepB, voffB); PG8_STAGE(PG8_SA(0, 0), cA, voffA); PG8_STAGE(PG8_SA(0, 1), cA + hstepA, voffA);
        if (wr == 1) PG8_BAR;
        PG8_WAIT_V(2); PG8_BAR;
        PG8_STAGE(PG8_SB(1, 0), cB + kstep, voffB); PG8_STAGE(PG8_SA(1, 0), cA + kstep, voffA); PG8_STAGE(PG8_SB(1, 1), cB + hstepB + kstep, voffB);
        PG8_WAIT_V(6); PG8_BAR;
    } else {
        PG8_STAGE(PG8_SB(0, 0), cB, voffB); PG8_STAGE(PG8_SA(0, 0), cA, voffA); PG8_STAGE(PG8_SB(0, 1), cB + hstepB, voffB); PG8_STAGE(PG8_SA(0, 1), cA + hstepA, voffA);
        if (wr == 1) PG8_BAR;
        PG8_WAIT_V(4); PG8_BAR;
        PG8_STAGE(PG8_SB(1, 0), cB + kstep, voffB); PG8_STAGE(PG8_SA(1, 0), cA + kstep, voffA); PG8_STAGE(PG8_SB(1, 1), cB + hstepB + kstep, voffB);
        PG8_WAIT_V(6); PG8_BAR;
    }
    for (;;) {
        const bool has_next = S.next(ui + 1, nxt);
        const char* nA = has_next ? S.aptr(nxt) : cA; const char* nB = has_next ? S.bptr(nxt) : cB;
        for (int t = 0; t < nt; t += 2) {
            const bool last = (t == nt - 2);
            const char* a1 = cA + (size_t)(t + 1) * kstep;
            const char* a2 = last ? nA : cA + (size_t)(t + 2) * kstep; const char* b2 = last ? nB : cB + (size_t)(t + 2) * kstep;
            const char* a3 = a2 + kstep; const char* b3 = b2 + kstep;
            if (last && has_next) S.a_ready(nxt);
            if constexpr (SP2) {
            PG8_LDB(B0, 0, 0); PG8_LDB(B1, 0, 1); PG8_SCHED; PG8_LDA(At, 0, 0); PG8_STAGE(PG8_SA(1, 1), a1 + hstepA, voffA);
            PG8_WAIT_V(8); PG8_WAIT_L(0); PG8_BAR; PG8_MMA(0, 0, At, B0); PG8_MMA(0, 1, At, B1); PG8_BAR; PG8_SCHED;
            PG8_LDA(At, 0, 1); PG8_STAGE(PG8_SB(0, 0), b2, voffB); PG8_STAGE(PG8_SB(0, 1), b2 + hstepB, voffB); PG8_STAGE(PG8_SA(0, 0), a2, voffA);
            PG8_WAIT_V(8); PG8_WAIT_L(0); PG8_BAR; PG8_MMA(1, 0, At, B0); PG8_MMA(1, 1, At, B1); PG8_BAR; PG8_SCHED;
            PG8_LDB(B0, 1, 0); PG8_LDB(B1, 1, 1); PG8_SCHED; PG8_LDA(At, 1, 0); PG8_STAGE(PG8_SA(0, 1), a2 + hstepA, voffA);
            PG8_WAIT_V(8); PG8_WAIT_L(0); PG8_BAR; PG8_MMA(0, 0, At, B0); PG8_MMA(0, 1, At, B1); PG8_BAR; PG8_SCHED;
            PG8_LDA(At, 1, 1); PG8_STAGE(PG8_SB(1, 0), b3, voffB); PG8_STAGE(PG8_SB(1, 1), b3 + hstepB, voffB); PG8_STAGE(PG8_SA(1, 0), a3, voffA);
            PG8_WAIT_V(8); PG8_WAIT_L(0); PG8_BAR; PG8_MMA(1, 0, At, B0); PG8_MMA(1, 1, At, B1); PG8_BAR; PG8_SCHED;
            } else {
            PG8_LDB(B0, 0, 0); PG8_SCHED; PG8_LDA(At, 0, 0); PG8_STAGE(PG8_SA(1, 1), a1 + hstepA, voffA);
            PG8_WAIT_L(8); PG8_BAR; PG8_WAIT_L(0); PG8_MMA(0, 0, At, B0); PG8_BAR; PG8_SCHED;
            PG8_LDB(B1, 0, 1); PG8_STAGE(PG8_SB(0, 0), b2, voffB);
            PG8_BAR; PG8_WAIT_L(0); PG8_MMA(0, 1, At, B1); PG8_BAR;
            PG8_LDA(At, 0, 1); PG8_STAGE(PG8_SA(0, 0), a2, voffA);
            PG8_BAR; PG8_WAIT_L(0); PG8_MMA(1, 0, At, B0); PG8_BAR; PG8_SCHED;
            PG8_STAGE(PG8_SB(0, 1), b2 + hstepB, voffB);
            PG8_WAIT_V(6); PG8_BAR; PG8_MMA(1, 1, At, B1); PG8_BAR;
            PG8_LDB(B0, 1, 0); PG8_SCHED; PG8_LDA(At, 1, 0); PG8_STAGE(PG8_SA(0, 1), a2 + hstepA, voffA);
            PG8_WAIT_L(8); PG8_BAR; PG8_WAIT_L(0); PG8_MMA(0, 0, At, B0); PG8_BAR; PG8_SCHED;
            PG8_LDB(B1, 1, 1); PG8_STAGE(PG8_SB(1, 0), b3, voffB);
            PG8_BAR; PG8_WAIT_L(0); PG8_MMA(0, 1, At, B1); PG8_BAR;
            PG8_LDA(At, 1, 1); PG8_STAGE(PG8_SA(1, 0), a3, voffA);
            PG8_BAR; PG8_WAIT_L(0); PG8_MMA(1, 0, At, B0); PG8_BAR; PG8_SCHED;
            PG8_STAGE(PG8_SB(1, 1), b3 + hstepB, voffB);
            PG8_WAIT_V(6); PG8_BAR; PG8_MMA(1, 1, At, B1); PG8_BAR;
            }
        }
        if constexpr (ALIGN_EPI) { if (wr == 0) PG8_BAR; }
        if constexpr (!Epi::AFTER_DRAIN) { int fr_ = fr, fq_ = fq; asm volatile("" : "+v"(fr_), "+v"(fq_));   E(acc, cur, wr, wc, fr_, fq_); S.done(cur); }
        if (!has_next) break;
#pragma unroll
        for (int a = 0; a < 2; ++a)
#pragma unroll
            for (int b = 0; b < 2; ++b)
#pragma unroll
                for (int m = 0; m < 4; ++m)
#pragma unroll
                    for (int n = 0; n < 2; ++n) acc[a][b][m][n] = (f32x4){0.f, 0.f, 0.f, 0.f};
        cur = nxt; cA = nA; cB = nB; ++ui;
        if constexpr (ALIGN_EPI) { if (wr == 1) PG8_BAR; }
    }
    PG8_WAIT_V(0);
    if constexpr (!ALIGN_EPI) { if (wr == 0) PG8_BAR; }
    PG8_BAR;
    if constexpr (Epi::AFTER_DRAIN) { E.fused(acc, cur, wr, wc, fr, fq, lds, wid, lane); S.done(cur); }
#undef PG8_SA
#undef PG8_SB
#undef PG8_STAGE
#undef PG8_LDA
#undef PG8_LDB
#undef PG8_MMA
#undef PG8_WAIT_V
#undef PG8_WAIT_L
#undef PG8_BAR
#undef PG8_SCHED
}
}
#include <hip/hip_bf16.h>
#include <cmath>
namespace attn_body {
using bf16=__hip_bfloat16;
using bf16x8=__attribute__((ext_vector_type(8)))short;
using s16x4=__attribute__((ext_vector_type(4)))short;
using f32x16=__attribute__((ext_vector_type(16)))float;
using u32x4=__attribute__((ext_vector_type(4)))unsigned;
constexpr int BATCH=2,NHEAD=16,SEQ=8192,D=64,DM=NHEAD*D;
constexpr int NW=8,QBLK=32,QB=QBLK*NW,KVBLK=64,NQB=SEQ/QB;
constexpr int ATTN_PITCH=DM, ATTN_UNIT_ROWS=QB;
__device__ __forceinline__ int crow(int r,int hi){return (r&3)+8*(r>>2)+4*hi;}
#define SBAR() __builtin_amdgcn_sched_barrier(0)
__device__ __forceinline__ void cmask(f32x16&p0,f32x16&p1,int jb,int qrel,int hi){
  const float NEG=-INFINITY; int kb=64*jb+4*hi;
  #pragma unroll
  for(int r=0;r<16;++r){int kv=kb+(r&3)+8*(r>>2); if(kv>qrel)p0[r]=NEG; if(kv+32>qrel)p1[r]=NEG;}
}

constexpr int NSLOT=3, SLOTB=8192;
constexpr int LDS_K=0, LDS_V=NSLOT*SLOTB, LDS_WS=2*NSLOT*SLOTB, LDS_OST=LDS_WS+NW*64*4, LDS_BYTES=LDS_OST+NW*4096;
constexpr int BIAS_OFF=86016;
constexpr float C2=0.125f*1.4426950408889634f;
__device__ __forceinline__ void glds16(const void*gsrc,unsigned lds_dst){unsigned keep;
  asm volatile("s_mov_b32 %0, m0\n\ts_mov_b32 m0, %2\n\ts_nop 0\n\tglobal_load_lds_dwordx4 %1, off\n\ts_mov_b32 m0, %0":"=&s"(keep):"v"(gsrc),"s"(lds_dst):"memory");}
__device__ __forceinline__ float max3f(float a,float b,float c){float r;asm("v_max3_f32 %0, %1, %2, %3":"=v"(r):"v"(a),"v"(b),"v"(c));return r;}
__device__ __forceinline__ float max2f(float a,float b){float r;asm("v_max_f32_e32 %0, %1, %2":"=v"(r):"v"(a),"v"(b));return r;}
__device__ __forceinline__ float fadd_s(float a,float b){float r;asm("v_add_f32_e32 %0, %1, %2":"=v"(r):"v"(a),"v"(b));return r;}
__device__ __forceinline__ float fsub_s(float a,float b){float r;asm("v_sub_f32_e32 %0, %1, %2":"=v"(r):"v"(a),"v"(b));return r;}
typedef float f32x2_t __attribute__((ext_vector_type(2))); typedef __bf16 bf16x2_t __attribute__((ext_vector_type(2)));
__device__ __forceinline__ unsigned cvtpk_s(float lo,float hi){f32x2_t v={lo,hi};bf16x2_t b=__builtin_convertvector(v,bf16x2_t);return __builtin_bit_cast(unsigned,b);}
#define WAIT_BAR(N) asm volatile("s_waitcnt vmcnt(" #N ") lgkmcnt(0)\n\ts_barrier":::"memory")

__device__ __forceinline__ void qkt(f32x16&p0,f32x16&p1,const char*Kslot,const bf16x8*qr,const f32x16&negm,int r32,int hi){
  const char*kb=Kslot+hi*1024+r32*16;
  #pragma unroll
  for(int d0=0;d0<4;++d0){
    const bf16x8 b0=*reinterpret_cast<const bf16x8*>(kb+d0*2048);
    const bf16x8 b1=*reinterpret_cast<const bf16x8*>(kb+d0*2048+512);
    if(d0==0){p0=__builtin_amdgcn_mfma_f32_32x32x16_bf16(b0,qr[0],negm,0,0,0);p1=__builtin_amdgcn_mfma_f32_32x32x16_bf16(b1,qr[0],negm,0,0,0);}
    else{p0=__builtin_amdgcn_mfma_f32_32x32x16_bf16(b0,qr[d0],p0,0,0,0);p1=__builtin_amdgcn_mfma_f32_32x32x16_bf16(b1,qr[d0],p1,0,0,0);}}
}
typedef __attribute__((address_space(3))) const char* lds_cptr;
typedef short v4i16_t __attribute__((ext_vector_type(4)));
__device__ __forceinline__ void kload8(bf16x8*kf,lds_cptr kp){
  kf[0]=*(const __attribute__((address_space(3))) bf16x8*)(kp);      kf[1]=*(const __attribute__((address_space(3))) bf16x8*)(kp+512);
  kf[2]=*(const __attribute__((address_space(3))) bf16x8*)(kp+2048); kf[3]=*(const __attribute__((address_space(3))) bf16x8*)(kp+2560);
  kf[4]=*(const __attribute__((address_space(3))) bf16x8*)(kp+4096); kf[5]=*(const __attribute__((address_space(3))) bf16x8*)(kp+4608);
  kf[6]=*(const __attribute__((address_space(3))) bf16x8*)(kp+6144); kf[7]=*(const __attribute__((address_space(3))) bf16x8*)(kp+6656);
}
__device__ __forceinline__ void kload2(bf16x8*kf,lds_cptr kp,int j){ kf[2*j]=*(const __attribute__((address_space(3))) bf16x8*)(kp+j*2048); kf[2*j+1]=*(const __attribute__((address_space(3))) bf16x8*)(kp+j*2048+512); }
__device__ __forceinline__ s16x4 vtr(lds_cptr p){ return __builtin_bit_cast(s16x4,__builtin_amdgcn_ds_read_tr16_b64_v4i16((__attribute__((address_space(3))) v4i16_t*)p)); }
__device__ __forceinline__ float rowmax(const f32x16&p0,const f32x16&p1){
  float a=max3f(p0[0],p0[1],p1[0]),b=max3f(p0[2],p0[3],p1[1]);a=max3f(a,p1[2],p1[3]);
  #pragma unroll
  for(int r=4;r<16;r+=4){a=max3f(a,p0[r],p0[r+1]);b=max3f(b,p0[r+2],p0[r+3]);a=max3f(a,p1[r],p1[r+1]);b=max3f(b,p1[r+2],p1[r+3]);}
  const float m=max2f(a,b);
  auto rr=__builtin_amdgcn_permlane32_swap(__float_as_uint(m),__float_as_uint(m),false,false);
  return max2f(__uint_as_float(rr[0]),__uint_as_float(rr[1]));
}
__device__ __forceinline__ void pv(f32x16*o,int vb,bf16x8 pa0,bf16x8 pa1,bf16x8 pa2,bf16x8 pa3){
  #pragma unroll
  for(int d0=0;d0<2;++d0){s16x4 lo[4],hi[4];
    #pragma unroll
    for(int ks=0;ks<4;++ks){
      asm volatile("ds_read_b64_tr_b16 %0,%1 offset:%c2":"=&v"(lo[ks]):"v"(vb),"i"(d0*4096+ks*1024):"memory");
      asm volatile("ds_read_b64_tr_b16 %0,%1 offset:%c2":"=&v"(hi[ks]):"v"(vb),"i"(d0*4096+ks*1024+512):"memory");}
    asm volatile("s_waitcnt lgkmcnt(0)":::"memory");SBAR();
    #define PK(k) (bf16x8){lo[k][0],lo[k][1],lo[k][2],lo[k][3],hi[k][0],hi[k][1],hi[k][2],hi[k][3]}
    o[d0]=__builtin_amdgcn_mfma_f32_32x32x16_bf16(pa0,PK(0),o[d0],0,0,0);
    o[d0]=__builtin_amdgcn_mfma_f32_32x32x16_bf16(pa1,PK(1),o[d0],0,0,0);
    o[d0]=__builtin_amdgcn_mfma_f32_32x32x16_bf16(pa2,PK(2),o[d0],0,0,0);
    o[d0]=__builtin_amdgcn_mfma_f32_32x32x16_bf16(pa3,PK(3),o[d0],0,0,0);
    #undef PK
  }
}

#ifndef ATTN_STORE16
#define ATTN_STORE16(p,v) (*(u32x4*)(p)=(v))
#endif
template<int THRL> __device__ __forceinline__ void attn_unit(int b,int h,int qb,const bf16*Q,const bf16*__restrict__ K,const bf16*__restrict__ V,bf16*O,const float*__restrict__ FBrow,char*shm){
  const int tid=mk_tid(),lane=tid&63,r32=lane&31,hi=lane>>5; const int wid=__builtin_amdgcn_readfirstlane(tid>>6);
  const long rowbase=(long)b*SEQ; const int q0=qb*QB;
  const bf16*Qw=Q+(rowbase+q0+wid*QBLK)*DM+h*D;
  const bf16*Kh=K+rowbase*DM+h*D,*Vh=V+rowbase*DM+h*D;
  const lds_cptr shm3=(lds_cptr)shm;
  const unsigned lds0=(unsigned)(uintptr_t)shm;
  float*wsf=(float*)(shm+LDS_WS)+wid*64;
  const bf16*ksrc=Kh+(long)lane*DM+wid*8;
  const bf16*vsrc=Vh+(long)(16*(wid&3)+(lane>>2))*DM+(wid>>2)*32+(lane&3)*8;
  const unsigned kdst=lds0+LDS_K+wid*1024, vdst=lds0+LDS_V+wid*1024;
  #define DMA_K(t,slot) glds16(ksrc+(long)(t)*KVBLK*DM,(unsigned)__builtin_amdgcn_readfirstlane(kdst+(slot)))
  #define DMA_V(t,slot) glds16(vsrc+(long)(t)*KVBLK*DM,(unsigned)__builtin_amdgcn_readfirstlane(vdst+(slot)))
  const int vb0=(int)(lds0+LDS_V)+((lane>>4)&1)*32+(lane&3)*8+(4*hi+((lane&15)>>2))*64;
  const char*Kbase=shm+LDS_K; bf16x8 kf[8];
  const lds_cptr kp0=shm3+LDS_K+hi*1024+r32*16; const lds_cptr vp0=shm3+LDS_V+((lane>>4)&1)*32+(lane&3)*8+(4*hi+((lane&15)>>2))*64;
  const int NT=(q0+QB)/KVBLK;
  {
    typedef __attribute__((address_space(3))) float lds_f32; lds_f32* bl=(lds_f32*)(shm3+BIAS_OFF);
    const int nb=q0+QB; const float Fl=FBrow[nb-1];
    for(int i=tid;i<nb;i+=NW*64) bl[i]=(Fl-FBrow[i])*1.4426950408889634f;
    asm volatile("s_waitcnt vmcnt(0) lgkmcnt(0)\n\ts_barrier":::"memory"); }
  typedef float f32x4v __attribute__((ext_vector_type(4)));
  #define BIAS(P0,P1,t) do{ const __attribute__((address_space(3))) f32x4v* bp_=(const __attribute__((address_space(3))) f32x4v*)(shm3+BIAS_OFF)+(t)*16+hi; \
    _Pragma("unroll") for(int g_=0;g_<4;++g_){ const f32x4v f0_=bp_[2*g_]+nm, f1_=bp_[8+2*g_]+nm; \
      P0[4*g_]+=f0_[0];P0[4*g_+1]+=f0_[1];P0[4*g_+2]+=f0_[2];P0[4*g_+3]+=f0_[3]; P1[4*g_]+=f1_[0];P1[4*g_+1]+=f1_[1];P1[4*g_+2]+=f1_[2];P1[4*g_+3]+=f1_[3]; } }while(0)
  DMA_K(0,0);DMA_V(0,0);DMA_K(1,SLOTB);
  bf16x8 qr[4];
  #pragma unroll
  for(int d0=0;d0<4;++d0)qr[d0]=*reinterpret_cast<const bf16x8*>(&Qw[(long)r32*DM+d0*16+hi*8]);
  float mhat=0.f,l_reg=0.f;f32x16 o[2];o[0]=f32x16{};o[1]=f32x16{};const f32x16 negm=f32x16{}; float nm=0.f;
  const int qrel=wid*QBLK+r32;
  #define CMASK(P0,P1,t) do{int jb_=(t)-(NT-4); if(jb_>=0)cmask(P0,P1,jb_,qrel,hi);}while(0)
  bool resc=false;
  #define START(P0,P1) do{ const float rm=rowmax(P0,P1); resc=false; \
    { const float dl=rm; mhat=fadd_s(mhat,dl); \
      _Pragma("unroll") for(int r=0;r<16;++r){P0[r]=fsub_s(P0[r],dl);P1[r]=fsub_s(P1[r],dl);} \
      nm=-mhat; } \
    _Pragma("unroll") for(int r=0;r<16;++r)P0[r]=__builtin_amdgcn_exp2f(P0[r]); }while(0)
  #define RESC() do{ if(resc){ asm volatile("s_waitcnt lgkmcnt(0)":::"memory"); \
      _Pragma("unroll") for(int d_=0;d_<2;++d_) _Pragma("unroll") for(int r=0;r<16;++r)o[d_][r]*=wsf[crow(r,hi)]; } }while(0)
  f32x16 pA0,pA1,pB0,pB1;
  int sl_prev=0,sl_cur=0,sl_next=SLOTB;
  #define ROT() do{sl_prev=sl_cur;sl_cur=sl_next;sl_next=(sl_next==(NSLOT-1)*SLOTB)?0:sl_next+SLOTB;}while(0)
  DMA_K(2,2*SLOTB);
  WAIT_BAR(3);
  qkt(pA0,pA1,Kbase,qr,negm,r32,hi);asm volatile("s_nop 15\n\ts_nop 7":"+v"(pA0),"+v"(pA1));BIAS(pA0,pA1,0);CMASK(pA0,pA1,0);
  START(pA0,pA1);
  _Pragma("unroll") for(int r=0;r<16;++r)pA1[r]=__builtin_amdgcn_exp2f(pA1[r]);
  WAIT_BAR(0);
  DMA_K(3,0);DMA_V(1,SLOTB);
  ROT();
  kload8(kf,kp0+sl_cur);
  WAIT_BAR(2);
  s16x4 vlo[8],vhi[8]; u32x4 pw0,pw1,pw2,pw3;
  #define PKW(P,B) cvtpk_s(P[B],P[B+1])
  #define PAF(k) __builtin_bit_cast(bf16x8,pw##k)
  #define VFR(i) (bf16x8){vlo[i][0],vlo[i][1],vlo[i][2],vlo[i][3],vhi[i][0],vhi[i][1],vhi[i][2],vhi[i][3]}
  #define PIN(x) asm volatile("":"+v"(x))
  #define MX3(a,b,c) __builtin_fmaxf(__builtin_fmaxf((a),(b)),(c))
  #define GAPA(MF,A0,A1,A2,A3,W0,W1,PW) do{ MF; sacc+=A0; sacc+=A1; sacc+=A2; sacc+=A3; PIN(sacc); W0; W1; PIN(PW); SBAR(); }while(0)
  #define EX(v) __builtin_amdgcn_exp2f(v)
  #define GAPB(MF,X,B) do{ MF; X[B]=EX(X[B]); X[B+1]=EX(X[B+1]); X[B+2]=EX(X[B+2]); X[B+3]=EX(X[B+3]); PIN(X); SBAR(); }while(0)
  #define VRD(i) do{ vlo[i]=vtr(vp_+(((i)>>2)*4096+((i)&3)*1024)); vhi[i]=vtr(vp_+(((i)>>2)*4096+((i)&3)*1024+512)); }while(0)
  #define KRD(G,j) do{ if(G){ kload2(kf,kp0+sl_next,j); SBAR(); } }while(0)
  #define STEP(C0,C1,P0,P1,t,GK,GV,GL) do{ SBAR(); \
    const lds_cptr vp_=vp0+sl_prev; \
    VRD(0); SBAR(); float sacc=(P0[0]+P0[1]); \
    GAPA(C0=__builtin_amdgcn_mfma_f32_32x32x16_bf16(kf[0],qr[0],negm,0,0,0), P0[2],P0[3],P0[4],P0[5],     pw0[0]=PKW(P0,0), pw0[1]=PKW(P0,2), pw0); \
    VRD(4); SBAR(); GAPA(C1=__builtin_amdgcn_mfma_f32_32x32x16_bf16(kf[1],qr[0],negm,0,0,0), P0[6],P0[7],P0[8],P0[9],     pw0[2]=PKW(P0,4), pw0[3]=PKW(P0,6), pw0); \
    VRD(1); SBAR(); GAPA(C0=__builtin_amdgcn_mfma_f32_32x32x16_bf16(kf[2],qr[1],C0,0,0,0),   P0[10],P0[11],P0[12],P0[13], pw1[0]=PKW(P0,8), pw1[1]=PKW(P0,10), pw1); \
    VRD(5); SBAR(); GAPA(C1=__builtin_amdgcn_mfma_f32_32x32x16_bf16(kf[3],qr[1],C1,0,0,0),   P0[14],P0[15],P1[0],P1[1],   pw1[2]=PKW(P0,12),pw1[3]=PKW(P0,14), pw1); \
    VRD(2); SBAR(); GAPA(C0=__builtin_amdgcn_mfma_f32_32x32x16_bf16(kf[4],qr[2],C0,0,0,0),   P1[2],P1[3],P1[4],P1[5],     pw2[0]=PKW(P1,0), pw2[1]=PKW(P1,2), pw2); \
    VRD(6); SBAR(); GAPA(C1=__builtin_amdgcn_mfma_f32_32x32x16_bf16(kf[5],qr[2],C1,0,0,0),   P1[6],P1[7],P1[8],P1[9],     pw2[2]=PKW(P1,4), pw2[3]=PKW(P1,6), pw2); \
    VRD(3); SBAR(); GAPA(C0=__builtin_amdgcn_mfma_f32_32x32x16_bf16(kf[6],qr[3],C0,0,0,0),   P1[10],P1[11],P1[12],P1[13], pw3[0]=PKW(P1,8), pw3[1]=PKW(P1,10), pw3); \
    VRD(7); SBAR(); GAPA(C1=__builtin_amdgcn_mfma_f32_32x32x16_bf16(kf[7],qr[3],C1,0,0,0),   P1[14],P1[15],0.f,0.f,       pw3[2]=PKW(P1,12),pw3[3]=PKW(P1,14), pw3); \
    l_reg+=sacc; \
    if(GK){DMA_K((t)+3,sl_cur);} if(GV){DMA_V((t)+1,sl_next);} \
    BIAS(C0,C1,t); CMASK(C0,C1,t); \
    { float a=MX3(C0[0],C0[1],C1[0]),b=MX3(C0[2],C0[3],C1[1]); a=MX3(a,C1[2],C1[3]); \
      _Pragma("unroll") for(int r=4;r<16;r+=4){a=MX3(a,C0[r],C0[r+1]);b=MX3(b,C0[r+2],C0[r+3]);a=MX3(a,C1[r],C1[r+1]);b=MX3(b,C1[r+2],C1[r+3]);} \
      float rm=__builtin_fmaxf(a,b); { auto rr=__builtin_amdgcn_permlane32_swap(__float_as_uint(rm),__float_as_uint(rm),false,false); rm=__builtin_fmaxf(__uint_as_float(rr[0]),__uint_as_float(rr[1])); } \
      resc=false; \
      if(__builtin_expect(__any(rm>(float)THRL),0)){ const float dl=__builtin_fmaxf(rm,0.f); mhat+=dl; \
        _Pragma("unroll") for(int r=0;r<16;++r){C0[r]-=dl;C1[r]-=dl;} \
        nm=-mhat; \
        const float f=__builtin_amdgcn_exp2f(-dl); l_reg*=f; if(hi==0)wsf[r32]=f; resc=true; } } \
    SBAR(); \
    GAPB(o[0]=__builtin_amdgcn_mfma_f32_32x32x16_bf16(PAF(0),VFR(0),o[0],0,0,0), C0,0); \
    GAPB(o[1]=__builtin_amdgcn_mfma_f32_32x32x16_bf16(PAF(0),VFR(4),o[1],0,0,0), C0,4); \
    KRD(GL,0); GAPB(o[0]=__builtin_amdgcn_mfma_f32_32x32x16_bf16(PAF(1),VFR(1),o[0],0,0,0), C0,8); \
    KRD(GL,1); GAPB(o[1]=__builtin_amdgcn_mfma_f32_32x32x16_bf16(PAF(1),VFR(5),o[1],0,0,0), C0,12); \
    KRD(GL,2); GAPB(o[0]=__builtin_amdgcn_mfma_f32_32x32x16_bf16(PAF(2),VFR(2),o[0],0,0,0), C1,0); \
    KRD(GL,3); GAPB(o[1]=__builtin_amdgcn_mfma_f32_32x32x16_bf16(PAF(2),VFR(6),o[1],0,0,0), C1,4); \
    GAPB(o[0]=__builtin_amdgcn_mfma_f32_32x32x16_bf16(PAF(3),VFR(3),o[0],0,0,0), C1,8); \
    GAPB(o[1]=__builtin_amdgcn_mfma_f32_32x32x16_bf16(PAF(3),VFR(7),o[1],0,0,0), C1,12); \
    }while(0)
  int t=1;
  #undef CMASK
  #define CMASK(P0,P1,t) do{}while(0)
  for(;t+5<NT;t+=2){
    STEP(pB0,pB1,pA0,pA1,t,true,true,true);     WAIT_BAR(2); RESC(); ROT();
    STEP(pA0,pA1,pB0,pB1,t+1,true,true,true);   WAIT_BAR(2); RESC(); ROT();
  }
  #undef CMASK
  #define CMASK(P0,P1,t) do{int jb_=(t)-(NT-4); if(jb_>=0)cmask(P0,P1,jb_,qrel,hi);}while(0)
  #define ENDW(tt) do{ if((tt)+3<NT){WAIT_BAR(2);} else if((tt)+2<NT){WAIT_BAR(1);} else {WAIT_BAR(0);} }while(0)
  for(;t+1<NT;t+=2){
    STEP(pB0,pB1,pA0,pA1,t,(t+3<NT),(t+1<NT),(t+1<NT));       ENDW(t);   RESC(); ROT();
    STEP(pA0,pA1,pB0,pB1,t+1,(t+4<NT),(t+2<NT),(t+2<NT));     ENDW(t+1); RESC(); ROT();
  }
  STEP(pB0,pB1,pA0,pA1,NT-1,false,false,false); RESC();
  { float sacc=pB0[0]+pB0[1]; _Pragma("unroll") for(int r=2;r<16;++r)sacc+=pB0[r]; _Pragma("unroll") for(int r=0;r<16;++r)sacc+=pB1[r]; l_reg+=sacc;
    pw0=(u32x4){PKW(pB0,0),PKW(pB0,2),PKW(pB0,4),PKW(pB0,6)};pw1=(u32x4){PKW(pB0,8),PKW(pB0,10),PKW(pB0,12),PKW(pB0,14)};pw2=(u32x4){PKW(pB1,0),PKW(pB1,2),PKW(pB1,4),PKW(pB1,6)};pw3=(u32x4){PKW(pB1,8),PKW(pB1,10),PKW(pB1,12),PKW(pB1,14)};
    SBAR(); pv(o,vb0+sl_cur,PAF(0),PAF(1),PAF(2),PAF(3)); }
  #undef PKW
  #undef PAF
  #undef VFR
  #undef PIN
  #undef MX3
  #undef GAPA
  #undef GAPB
  #undef EX
  #undef VRD
  #undef KRD
  #undef STEP
  #undef ENDW
  {auto rr=__builtin_amdgcn_permlane32_swap(__float_as_uint(l_reg),__float_as_uint(l_reg),false,false);l_reg=__uint_as_float(rr[0])+__uint_as_float(rr[1]);}
  if(hi==0)wsf[32+r32]=l_reg;asm volatile("s_waitcnt lgkmcnt(0)":::"memory");
  float rli[16];
  #pragma unroll
  for(int r=0;r<16;++r)rli[r]=__builtin_amdgcn_rcpf(wsf[32+crow(r,hi)]);
  bf16*Ow=O+(rowbase+q0+wid*QBLK)*DM+h*D;
  { bf16*stg=(bf16*)(shm+LDS_OST)+wid*2048;
    #pragma unroll
    for(int r=0;r<16;++r){const int orow=crow(r,hi);
      #pragma unroll
      for(int d0=0;d0<2;++d0)stg[orow*64+d0*32+r32]=__float2bfloat16(o[d0][r]*rli[r]);}
    asm volatile("s_waitcnt lgkmcnt(0)":::"memory");
    #pragma unroll
    for(int i=0;i<4;++i){const int row=i*8+(lane>>3),ch=lane&7; const u32x4 v=*(const u32x4*)(stg+row*64+ch*8); ATTN_STORE16(Ow+(long)row*DM+ch*8,v);} }
  asm volatile("s_waitcnt lgkmcnt(0)\n\ts_barrier":::"memory");
  #undef BIAS
  #undef DMA_K
  #undef DMA_V
  #undef CMASK
  #undef START
  #undef RESC
  #undef ROT
}
constexpr int ATTN_LDS_BYTES=86016+32768;
struct AttnTensors { const bf16* Q; const bf16* K; const bf16* V; bf16* O; const float* FB; };
struct AttnUnit { int bh; int qb; };
struct StaticOrder {
  int vcu;
  __device__ __forceinline__ explicit StaticOrder(int grid,int block):vcu((block%8)*(grid/8)+block/8){}
  __device__ __forceinline__ bool next(int i,AttnUnit&u)const{ if(i>=4)return false; const int s=vcu&7; u.bh=vcu>>3; u.qb=(i==0)?s:(i==1)?15-s:(i==2)?16+s:31-s; return true; }
  __device__ __forceinline__ void a_ready(const AttnUnit&)const{}
  __device__ __forceinline__ void done(const AttnUnit&)const{}
};
template<class Sched,int THRL=8> __device__ __forceinline__ void attn_phase(char*lds,const AttnTensors&T,const Sched&S){
  AttnUnit u;
  for(int i=0;S.next(i,u);++i){ S.a_ready(u); attn_unit<THRL>(u.bh/NHEAD,u.bh%NHEAD,u.qb,T.Q,T.K,T.V,T.O,T.FB+(size_t)u.bh*SEQ,lds); S.done(u); }
}
#undef SBAR
#undef WAIT_BAR
}
namespace cg = cooperative_groups;
#define LAS __attribute__((address_space(3)))
#define LDS_WAIT() asm volatile("s_waitcnt lgkmcnt(0)" ::: "memory")
constexpr int MEGA_THREADS = 512, MEGA_LDS = 147456, NWV = 8;
#define GAS __attribute__((address_space(1)))
#define XB_TMO      128
#define XB_XCNT(j)  (256  + 64 * (j))
#define XB_XSUB(j)  (1280 + 64 * (j))
#define XB_XGEN(j)  (2304 + 64 * (j))
#define XB_TOP      3328
#define XB_TOPGEN   3392
#define XCD_BAR_WORDS 3456
#define XB_SPIN_CAP (1u << 18)

__device__ __forceinline__ unsigned xb_ld(unsigned* p)              { return __hip_atomic_load(p, __ATOMIC_RELAXED, __HIP_MEMORY_SCOPE_AGENT); }
__device__ __forceinline__ unsigned xb_add(unsigned* p, unsigned v) { return __hip_atomic_fetch_add(p, v, __ATOMIC_RELAXED, __HIP_MEMORY_SCOPE_AGENT); }
__device__ __forceinline__ unsigned xb_xcc_id() { return (unsigned)__builtin_amdgcn_s_getreg((3 << 11) | 20) & 0xFu; }
#define XB_SPIN(cond, bar) do { unsigned _sp = 0; while (cond) { __builtin_amdgcn_s_sleep(1); \
    if ((++_sp & 255u) == 0u) { if (xb_ld(&(bar)[XB_TMO])) break; if (_sp > XB_SPIN_CAP) { atomicAdd(&(bar)[XB_TMO], 1u); break; } } } } while (0)

struct XcdBarrier {
    unsigned* bar; unsigned x;
    volatile LAS unsigned* st;
};

__device__ __forceinline__ XcdBarrier xcd_barrier_post(unsigned* bar, volatile LAS unsigned* st) {
    XcdBarrier b; b.bar = bar; b.x = xb_xcc_id(); b.st = st;
    if (threadIdx.x == 0) (void)xb_add(&bar[XB_XCNT(b.x)], 1u);
    return b;
}
__device__ __forceinline__ void xcd_barrier_complete(unsigned* bar, unsigned x, unsigned& nloc, unsigned& nx) {
    const unsigned G = gridDim.x * gridDim.y * gridDim.z;
    unsigned sum, cnt, mine, sp = 0u;
    for (;;) {
        sum = 0u; cnt = 0u; mine = 0u;
#pragma unroll
        for (unsigned j = 0; j < 16; ++j) { const unsigned c = xb_ld(&bar[XB_XCNT(j)]); sum += c; cnt += (c > 0u) ? 1u : 0u; mine = (j == x) ? c : mine; }
        if (sum == G) break;
        __builtin_amdgcn_s_sleep(1);
        if ((++sp & 255u) == 0u) { if (xb_ld(&bar[XB_TMO])) break; if (sp > XB_SPIN_CAP) { atomicAdd(&bar[XB_TMO], 1u); break; } }
    }
    nloc = mine > 0u ? mine : 1u; nx = cnt > 0u ? cnt : 1u;
}

__device__ __forceinline__ void xcd_barrier(const XcdBarrier& b) {
    asm volatile("s_waitcnt vmcnt(0)" ::: "memory");
    __syncthreads();
    if (threadIdx.x == 0) {
        unsigned* bar = b.bar;
        __builtin_amdgcn_s_waitcnt(0);
        unsigned nloc = b.st[0], nx = b.st[1];
        if (nloc == 0u) { xcd_barrier_complete(bar, b.x, nloc, nx); b.st[0] = nloc; b.st[1] = nx; }
        const unsigned old = xb_add(&bar[XB_XSUB(b.x)], 1u);
        const unsigned gen = old / nloc;
        if (old + 1u == (gen + 1u) * nloc) {
            __builtin_amdgcn_fence(__ATOMIC_RELEASE, "agent");
            asm volatile("s_waitcnt vmcnt(0)" ::: "memory");
            const unsigned og = xb_add(&bar[XB_TOP], 1u);
            const unsigned tg = og / nx;
            if (og + 1u == (tg + 1u) * nx) xb_add(&bar[XB_TOPGEN], 1u);
            else XB_SPIN(xb_ld(&bar[XB_TOPGEN]) == tg, bar);
            __builtin_amdgcn_fence(__ATOMIC_ACQUIRE, "agent");
            xb_add(&bar[XB_XGEN(b.x)], 1u);
            asm volatile("s_waitcnt vmcnt(0)" ::: "memory");
        } else {
            XB_SPIN(xb_ld(&bar[XB_XGEN(b.x)]) == gen, bar);
            __builtin_amdgcn_fence(__ATOMIC_ACQUIRE, "agent");
            asm volatile("s_waitcnt vmcnt(0)" ::: "memory");
        }
    }
    __syncthreads();
}
constexpr size_t WS_BAR = WS_CTL + 16384;
constexpr int XB_LDS_OFF = MEGA_LDS - 64;
constexpr size_t WT_IN = 0;
constexpr size_t WT_BR = WT_IN + (size_t)13312 * 1024 * 2;
constexpr size_t WT_OUT = WT_BR + (size_t)4096 * 1024 * 2;
constexpr size_t WT_UP = WT_OUT + (size_t)1024 * 1024 * 2;
constexpr size_t WT_DN = WT_UP + (size_t)5632 * 1024 * 2;
static_assert(WT_DN + (size_t)1024 * 2816 * 2 <= 72 * MiB, "weight copies");
constexpr size_t WS_WKVT = WS_GATES;
constexpr size_t WS_CB = WS_CTL + 4096;

typedef float f32x4 __attribute__((ext_vector_type(4)));
typedef unsigned u32x4 __attribute__((ext_vector_type(4)));
typedef short bf16x8_t __attribute__((ext_vector_type(8)));
typedef float f32x16_t __attribute__((ext_vector_type(16)));
__device__ __forceinline__ unsigned pk2(float lo, float hi) { return (unsigned)f2bf(lo) | ((unsigned)f2bf(hi) << 16); }
__device__ __forceinline__ float blo(unsigned u) { return __uint_as_float(u << 16); }
__device__ __forceinline__ float bhi(unsigned u) { return __uint_as_float(u & 0xffff0000u); }
__device__ __forceinline__ float fast_softplus(float x) { return fmaxf(x, 0.f) + __logf(1.f + __expf(-fabsf(x))); }
__device__ __forceinline__ float fast_sigmoid(float x) { return __builtin_amdgcn_rcpf(1.f + __expf(-x)); }
__device__ __forceinline__ float fast_tanh(float x) { const float e = __expf(-2.f * fabsf(x)); const float t = (1.f - e) * __builtin_amdgcn_rcpf(1.f + e); return x < 0.f ? -t : t; }
__device__ __forceinline__ float fast_gelu(float x) { const float u = 0.7978845608028654f * (x + 0.044715f * x * x * x); return 0.5f * x * (1.f + fast_tanh(u)); }

template <class Loc> struct LocOrder {
    pg8::StaticOrder so; Loc loc;
    __device__ __forceinline__ bool next(int i, pg8::Unit& u) const { return so.next(i, u); }
    __device__ __forceinline__ const char* aptr(const pg8::Unit& u) const { return loc.a(u); }
    __device__ __forceinline__ const char* bptr(const pg8::Unit& u) const { return loc.b(u); }
    __device__ __forceinline__ void a_ready(const pg8::Unit&) const {}
    __device__ __forceinline__ void done(const pg8::Unit&) const {}
};
struct LocStd { const char* A; const char* Bt; size_t astep, bstep;
    __device__ __forceinline__ const char* a(const pg8::Unit& u) const { return A + (size_t)u.pm * astep; }
    __device__ __forceinline__ const char* b(const pg8::Unit& u) const { return Bt + (size_t)u.pn * bstep; } };
struct LocBranch { const char* Y0; const char* Y1; const char* Y2; const char* Y3; const char* Bt;
    __device__ __forceinline__ const char* a(const pg8::Unit& u) const { const int i = u.pn >> 2; const char* y = i == 0 ? Y0 : i == 1 ? Y1 : i == 2 ? Y2 : Y3; return y + (size_t)u.pm * (256 * 1024 * 2); }
    __device__ __forceinline__ const char* b(const pg8::Unit& u) const { return Bt + (size_t)u.pn * (256 * 1024 * 2); } };
struct LocMemKV { const char* A; const char* Bt;
    __device__ __forceinline__ const char* a(const pg8::Unit& u) const { return A + (size_t)u.pm * (256 * 1024 * 2); }
    __device__ __forceinline__ const char* b(const pg8::Unit& u) const { return Bt + ((size_t)(u.pm >> 1) * 2048 + (size_t)u.pn * 256) * 2048; } };
struct LocMemS { const char* MQ; const char* MK;
    __device__ __forceinline__ const char* a(const pg8::Unit& u) const { return MQ + (size_t)u.pm * (256 * 2048) + u.pn * 512; }
    __device__ __forceinline__ const char* b(const pg8::Unit& u) const { return MK + (size_t)(u.pm >> 5) * (256 * 2048) + u.pn * 512; } };
struct LocMemPV { const char* E; const char* MVT;
    __device__ __forceinline__ const char* a(const pg8::Unit& u) const { return E + (size_t)u.pm * (256 * 2048) + u.pn * 512; }
    __device__ __forceinline__ const char* b(const pg8::Unit& u) const { return MVT + ((size_t)(u.pm >> 5) * 4 + u.pn) * (256 * 256 * 2); } };

struct BranchSched { int vcu; LocBranch loc;
    __device__ __forceinline__ bool next(int i, pg8::Unit& u) const { if (i >= 4) return false; u.pm = vcu >> 2; u.pn = i * 4 + (vcu & 3); return true; }
    __device__ __forceinline__ const char* aptr(const pg8::Unit& u) const { return loc.a(u); }
    __device__ __forceinline__ const char* bptr(const pg8::Unit& u) const { return loc.b(u); }
    __device__ __forceinline__ void a_ready(const pg8::Unit&) const {}
    __device__ __forceinline__ void done(const pg8::Unit&) const {}
};
typedef f32x4 AccT[2][2][4][2];
struct EpiProj { static constexpr bool PERM = true, AFTER_DRAIN = false; bf16_t* proj; bf16_t* gates; float* mqss;
    __device__ __forceinline__ void operator()(const AccT& acc, const pg8::Unit& u, int wr, int wc, int fr, int fq) const {
        int colt = u.pn * 256; const int grp = colt >> 10; bf16_t* base; int ldc;
        if (grp < 9) { base = proj + (size_t)grp * T * DM; ldc = DM; colt &= 1023; } else { base = gates; ldc = 4096; colt -= 9216; }
        const int row0 = u.pm * 256 + wr * 64 + fr, col0 = colt + wc * 32 + 8 * fq;
#pragma unroll
        for (int ai = 0; ai < 2; ++ai)
#pragma unroll
            for (int m = 0; m < 4; ++m) { const int row = row0 + ai * 128 + m * 16; bf16_t* rowp = base + (size_t)row * ldc + col0; float ss = 0.f;
#pragma unroll
                for (int bj = 0; bj < 2; ++bj) { const f32x4 v0 = acc[ai][bj][m][0], v1 = acc[ai][bj][m][1]; u32x4 w; w.x = pk2(v0[0], v0[1]); w.y = pk2(v0[2], v0[3]); w.z = pk2(v1[0], v1[1]); w.w = pk2(v1[2], v1[3]);
                    *(u32x4*)(rowp + bj * 128) = w;
                    if (grp == 8) { ss += blo(w.x) * blo(w.x) + bhi(w.x) * bhi(w.x) + blo(w.y) * blo(w.y) + bhi(w.y) * bhi(w.y) + blo(w.z) * blo(w.z) + bhi(w.z) * bhi(w.z) + blo(w.w) * blo(w.w) + bhi(w.w) * bhi(w.w); } }
                if (grp == 8) { ss += __shfl_xor(ss, 16); ss += __shfl_xor(ss, 32); if (fq == 0) mqss[(size_t)row * 16 + (colt >> 8) * 4 + wc] = ss; } }
    } };
struct EpiBf16P { static constexpr bool PERM = true, AFTER_DRAIN = false; bf16_t* O; int ldc; int pad;
    __device__ __forceinline__ void operator()(const AccT& acc, const pg8::Unit& u, int wr, int wc, int fr, int fq) const {
        const int row0 = u.pm * 256 + wr * 64 + fr, col0 = u.pn * 256 + wc * 32 + 8 * fq;
#pragma unroll
        for (int ai = 0; ai < 2; ++ai)
#pragma unroll
            for (int m = 0; m < 4; ++m) { bf16_t* rowp = O + (size_t)(row0 + ai * 128 + m * 16) * ldc + col0;
#pragma unroll
                for (int bj = 0; bj < 2; ++bj) { const f32x4 v0 = acc[ai][bj][m][0], v1 = acc[ai][bj][m][1]; u32x4 w; w.x = pk2(v0[0], v0[1]); w.y = pk2(v0[2], v0[3]); w.z = pk2(v1[0], v1[1]); w.w = pk2(v1[2], v1[3]);
                    *(u32x4*)(rowp + bj * 128) = w; } }
    } };
struct EpiF32 { static constexpr bool PERM = false, AFTER_DRAIN = false; float* O; int ldc; int pad;
    __device__ __forceinline__ void operator()(const AccT& acc, const pg8::Unit& u, int wr, int wc, int fr, int fq) const {
        const int row0 = u.pm * 256 + wr * 64 + fr, col0 = u.pn * 256 + wc * 32 + 4 * fq;
#pragma unroll
        for (int ai = 0; ai < 2; ++ai)
#pragma unroll
            for (int m = 0; m < 4; ++m) { float* rowp = O + (size_t)(row0 + ai * 128 + m * 16) * ldc + col0;
#pragma unroll
                for (int bj = 0; bj < 2; ++bj)
#pragma unroll
                    for (int n = 0; n < 2; ++n) *(f32x4*)(rowp + bj * 128 + n * 16) = acc[ai][bj][m][n]; }
    } };
struct EpiResid { static constexpr bool PERM = false, AFTER_DRAIN = false; const float* base; float* out;
    __device__ __forceinline__ void operator()(const AccT& acc, const pg8::Unit& u, int wr, int wc, int fr, int fq) const {
        const int row0 = u.pm * 256 + wr * 64 + fr, col0 = u.pn * 256 + wc * 32 + 4 * fq;
#pragma unroll
        for (int ai = 0; ai < 2; ++ai)
#pragma unroll
            for (int m = 0; m < 4; ++m) { const size_t off = (size_t)(row0 + ai * 128 + m * 16) * DM + col0;
#pragma unroll
                for (int bj = 0; bj < 2; ++bj)
#pragma unroll
                    for (int n = 0; n < 2; ++n) { const f32x4 b = *(const f32x4*)(base + off + bj * 128 + n * 16); *(f32x4*)(out + off + bj * 128 + n * 16) = b + acc[ai][bj][m][n]; } }
    } };
struct EpiBranch { static constexpr bool PERM = true, AFTER_DRAIN = false; const bf16_t* G; const float* bg; float* MIXF; bf16_t* MIXED;
    __device__ __forceinline__ void operator()(const AccT& acc, const pg8::Unit& u, int wr, int wc, int fr, int fq) const {
        const int i = u.pn >> 2, row0 = u.pm * 256 + wr * 64 + fr, gcol0 = u.pn * 256 + wc * 32 + 8 * fq, mcol0 = (u.pn & 3) * 256 + wc * 32 + 8 * fq;
#pragma unroll
        for (int ai = 0; ai < 2; ++ai)
#pragma unroll
            for (int m = 0; m < 4; ++m) { const int row = row0 + ai * 128 + m * 16; const bf16_t* gp = G + (size_t)row * 4096 + gcol0; const size_t mo = (size_t)row * DM + mcol0;
#pragma unroll
                for (int bj = 0; bj < 2; ++bj) { const u32x4 gw = *(const u32x4*)(gp + bj * 128); const f32x4 b0 = *(const f32x4*)(bg + gcol0 + bj * 128), b1 = *(const f32x4*)(bg + gcol0 + bj * 128 + 4);
                    f32x4 v0 = acc[ai][bj][m][0], v1 = acc[ai][bj][m][1];
                    v0[0] *= fast_sigmoid(blo(gw.x) + b0[0]); v0[1] *= fast_sigmoid(bhi(gw.x) + b0[1]); v0[2] *= fast_sigmoid(blo(gw.y) + b0[2]); v0[3] *= fast_sigmoid(bhi(gw.y) + b0[3]);
                    v1[0] *= fast_sigmoid(blo(gw.z) + b1[0]); v1[1] *= fast_sigmoid(bhi(gw.z) + b1[1]); v1[2] *= fast_sigmoid(blo(gw.w) + b1[2]); v1[3] *= fast_sigmoid(bhi(gw.w) + b1[3]);
                    if (i > 0) { v0 += *(const f32x4*)(MIXF + mo + bj * 128); v1 += *(const f32x4*)(MIXF + mo + bj * 128 + 4); }
                    if (i < 3) { *(f32x4*)(MIXF + mo + bj * 128) = v0; *(f32x4*)(MIXF + mo + bj * 128 + 4) = v1; }
                    else { u32x4 w; w.x = pk2(v0[0], v0[1]); w.y = pk2(v0[2], v0[3]); w.z = pk2(v1[0], v1[1]); w.w = pk2(v1[2], v1[3]); *(u32x4*)(MIXED + mo + bj * 128) = w; } }
                asm volatile("" ::: "memory"); }
    } };
struct EpiSexp { static constexpr bool PERM = true, AFTER_DRAIN = false; bf16_t* E; const float* mqss; float* esum; const float* cb;
    __device__ __forceinline__ void operator()(const AccT& acc, const pg8::Unit& u, int wr, int wc, int fr, int fq) const {
        const int row0 = u.pm * 256 + wr * 64 + fr, col0 = u.pn * 256 + wc * 32 + 8 * fq; const float shift = cb[0];
#pragma unroll
        for (int ai = 0; ai < 2; ++ai)
#pragma unroll
            for (int m = 0; m < 4; ++m) { const int row = row0 + ai * 128 + m * 16; const f32x4 p = *(const f32x4*)(mqss + (size_t)row * 16 + u.pn * 4);
                const float sc = rsqrtf(((p[0] + p[1]) + (p[2] + p[3])) * (1.f / 256.f) + EPS) * (1.f / 16.f); bf16_t* rowp = E + (size_t)row * DM + col0; float sum = 0.f;
#pragma unroll
                for (int bj = 0; bj < 2; ++bj) { const f32x4 v0 = acc[ai][bj][m][0], v1 = acc[ai][bj][m][1]; u32x4 w;
                    w.x = pk2(__expf(v0[0] * sc - shift), __expf(v0[1] * sc - shift)); w.y = pk2(__expf(v0[2] * sc - shift), __expf(v0[3] * sc - shift));
                    w.z = pk2(__expf(v1[0] * sc - shift), __expf(v1[1] * sc - shift)); w.w = pk2(__expf(v1[2] * sc - shift), __expf(v1[3] * sc - shift));
                    *(u32x4*)(rowp + bj * 128) = w;
                    sum += (blo(w.x) + bhi(w.x)) + (blo(w.y) + bhi(w.y)) + (blo(w.z) + bhi(w.z)) + (blo(w.w) + bhi(w.w)); }
                sum += __shfl_xor(sum, 16); sum += __shfl_xor(sum, 32); if (fq == 0) esum[(size_t)row * 16 + u.pn * 4 + wc] = sum;
                asm volatile("" ::: "memory"); }
    } };
struct EpiMemPV { static constexpr bool PERM = true, AFTER_DRAIN = false; bf16_t* Y; const float* esum;
    __device__ __forceinline__ void operator()(const AccT& acc, const pg8::Unit& u, int wr, int wc, int fr, int fq) const {
        const int row0 = u.pm * 256 + wr * 64 + fr, col0 = u.pn * 256 + wc * 32 + 8 * fq;
#pragma unroll
        for (int ai = 0; ai < 2; ++ai)
#pragma unroll
            for (int m = 0; m < 4; ++m) { const int row = row0 + ai * 128 + m * 16; const f32x4 p = *(const f32x4*)(esum + (size_t)row * 16 + u.pn * 4);
                const float il = 1.f / ((p[0] + p[1]) + (p[2] + p[3])); bf16_t* rowp = Y + (size_t)row * DM + col0;
#pragma unroll
                for (int bj = 0; bj < 2; ++bj) { const f32x4 v0 = acc[ai][bj][m][0] * il, v1 = acc[ai][bj][m][1] * il; u32x4 w; w.x = pk2(v0[0], v0[1]); w.y = pk2(v0[2], v0[3]); w.z = pk2(v1[0], v1[1]); w.w = pk2(v1[2], v1[3]);
                    *(u32x4*)(rowp + bj * 128) = w; }
                asm volatile("" ::: "memory"); }
    } };

__device__ __forceinline__ void tr_item(const float* __restrict__ W, int ldw, bf16_t* __restrict__ WT, int ldk, int nblk, LAS float* scr, int item, int lane, int ncopies, int cstride) {
    const int kb = item / nblk, nb = item % nblk, k0 = 64 * kb, n0 = 32 * nb;
#pragma unroll
    for (int i = 0; i < 32; ++i) { const int kk = 2 * i + (lane >> 5); scr[kk * 33 + (lane & 31)] = W[(size_t)(k0 + kk) * ldw + n0 + (lane & 31)]; }
    LDS_WAIT(); asm volatile("" ::: "memory");
    const int c = lane & 7;
#pragma unroll
    for (int j = 0; j < 4; ++j) { const int n = (lane >> 3) + 8 * j; const LAS float* s = scr + (8 * c) * 33 + n;
        u32x4 o; o.x = pk2(s[0 * 33], s[1 * 33]); o.y = pk2(s[2 * 33], s[3 * 33]); o.z = pk2(s[4 * 33], s[5 * 33]); o.w = pk2(s[6 * 33], s[7 * 33]);
        for (int cp = 0; cp < ncopies; ++cp) *(u32x4*)(WT + (size_t)(n0 + n) * ldk + k0 + 8 * c + cp * cstride) = o; }
    LDS_WAIT(); asm volatile("" ::: "memory");
}
__device__ __forceinline__ void norm_row(const float* __restrict__ xrow, const float* __restrict__ g, bf16_t* __restrict__ hrow, const LAS float* WfT, bool do_logf, const float* __restrict__ bfg, float* __restrict__ LOGF, int row, int lane) {
    const f32x4* xr = (const f32x4*)xrow; const f32x4* gr = (const f32x4*)g;
    f32x4 v[4]; float ss = 0.f;
#pragma unroll
    for (int j = 0; j < 4; ++j) { v[j] = xr[lane + 64 * j]; ss += (v[j][0] * v[j][0] + v[j][1] * v[j][1]) + (v[j][2] * v[j][2] + v[j][3] * v[j][3]); }
    ss = wave_sum(ss);
    const float rstd = rsqrtf(ss * (1.f / DM) + EPS);
#pragma unroll
    for (int j = 0; j < 4; ++j) { v[j] = v[j] * rstd * gr[lane + 64 * j];
        uint2 o; o.x = pk2(v[j][0], v[j][1]); o.y = pk2(v[j][2], v[j][3]); ((uint2*)hrow)[lane + 64 * j] = o; }
    if (do_logf) {
        float mine = 0.f;
#pragma unroll 4
        for (int h = 0; h < 16; ++h) { float p = 0.f;
#pragma unroll
            for (int j = 0; j < 4; ++j) { const f32x4 w = *(const LAS f32x4*)(WfT + h * 1024 + (lane + 64 * j) * 4); p += (v[j][0] * w[0] + v[j][1] * w[1]) + (v[j][2] * w[2] + v[j][3] * w[3]); }
            p = wave_sum(p); if (lane == h) mine = p; }
        if (lane < 16) { const int b = row / SEQ, t = row % SEQ; LOGF[((size_t)b * 16 + lane) * SEQ + t] = logsigmoidf(mine + bfg[lane]); }
    }
}
__device__ __forceinline__ void headnorm64_row(bf16_t* row, const float* __restrict__ g, float scale, int lane) {
    u32x4* p = (u32x4*)row + lane * 2; u32x4 a = p[0], b = p[1];
    float v[16] = {blo(a.x), bhi(a.x), blo(a.y), bhi(a.y), blo(a.z), bhi(a.z), blo(a.w), bhi(a.w), blo(b.x), bhi(b.x), blo(b.y), bhi(b.y), blo(b.z), bhi(b.z), blo(b.w), bhi(b.w)};
    float ss = 0.f;
#pragma unroll
    for (int i = 0; i < 16; ++i) ss += v[i] * v[i];
    ss += __shfl_xor(ss, 1); ss += __shfl_xor(ss, 2);
    const float rstd = rsqrtf(ss * (1.f / 64.f) + EPS) * scale; const f32x4* gp = (const f32x4*)(g + (lane & 3) * 16);
#pragma unroll
    for (int i = 0; i < 4; ++i) { const f32x4 gg = gp[i]; v[4 * i] *= rstd * gg[0]; v[4 * i + 1] *= rstd * gg[1]; v[4 * i + 2] *= rstd * gg[2]; v[4 * i + 3] *= rstd * gg[3]; }
    a.x = pk2(v[0], v[1]); a.y = pk2(v[2], v[3]); a.z = pk2(v[4], v[5]); a.w = pk2(v[6], v[7]); b.x = pk2(v[8], v[9]); b.y = pk2(v[10], v[11]); b.z = pk2(v[12], v[13]); b.w = pk2(v[14], v[15]);
    p[0] = a; p[1] = b;
}
__device__ __forceinline__ void cumsum_block(const float* __restrict__ src, float* __restrict__ dst, LAS float* part, int tid) {
    const int lane = tid & 63, wave = tid >> 6; const f32x4* s4 = (const f32x4*)(src + tid * 16); float v[16]; float s = 0.f;
#pragma unroll
    for (int i = 0; i < 4; ++i) { const f32x4 x = s4[i]; s += x[0]; v[4 * i] = s; s += x[1]; v[4 * i + 1] = s; s += x[2]; v[4 * i + 2] = s; s += x[3]; v[4 * i + 3] = s; }
    float incl = s;
#pragma unroll
    for (int o = 1; o < 64; o <<= 1) { const float t_ = __shfl_up(incl, o); if (lane >= o) incl += t_; }
    __syncthreads();
    if (lane == 63) part[wave] = incl;
    __syncthreads();
    float off = incl - s;
    for (int w = 0; w < wave; ++w) off += part[w];
    f32x4* d4 = (f32x4*)(dst + tid * 16);
#pragma unroll
    for (int i = 0; i < 4; ++i) d4[i] = (f32x4){off + v[4 * i], off + v[4 * i + 1], off + v[4 * i + 2], off + v[4 * i + 3]};
}

__device__ __forceinline__ float neg_expm1_small(float x) {
    const float p = -x * (1.f + x * (0.5f + x * (0.16666667f + x * (0.041666668f + x * (0.0083333338f + x * 0.0013888889f)))));
    return x > -0.25f ? p : 1.f - __expf(x);
}
template <bool FINAL> __device__ __forceinline__ void lru_item(int b, int c, int n, const bf16_t* __restrict__ LX, const bf16_t* __restrict__ LG, bf16_t* __restrict__ YL,
        const float* __restrict__ cw, const float* __restrict__ cbias, const float bA, const float bX,
        const float spl, float* APROD, float* HEND, LAS unsigned char* lds, int tid) {
    const int e = tid & 63, tg = tid >> 6, ch = n * 64 + e;
    LAS float* xcT = (LAS float*)lds;
    LAS float* segP = xcT + 64 * 68;
    LAS float* segH = segP + 512, *carP = segH + 512, *carH = carP + 512;
    const LAS float* wAl = (const LAS float*)(lds + 32768);
    const int t0 = c * 64 + tg * 8; const size_t row0 = (size_t)b * SEQ + t0;
    float xw[11];
#pragma unroll
    for (int j = 0; j < 11; ++j) { const int t = t0 + j - 3; xw[j] = t >= 0 ? bf2f(LX[((size_t)b * SEQ + t) * DM + ch]) : 0.f; }
    const float w0 = cw[ch], w1 = cw[DM + ch], w2 = cw[2 * DM + ch], w3 = cw[3 * DM + ch], bc = cbias[ch];
    float xc[8];
#pragma unroll
    for (int j = 0; j < 8; ++j) xc[j] = bc + w3 * xw[j + 3] + w2 * xw[j + 2] + w1 * xw[j + 1] + w0 * xw[j];
    *(LAS f32x4*)(xcT + e * 68 + tg * 8) = (f32x4){xc[0], xc[1], xc[2], xc[3]};
    *(LAS f32x4*)(xcT + e * 68 + tg * 8 + 4) = (f32x4){xc[4], xc[5], xc[6], xc[7]};
    float gl[8];
    if (FINAL) {
#pragma unroll
        for (int j = 0; j < 8; ++j) gl[j] = bf2f(LG[(row0 + j) * DM + ch]);
        float cp = 1.f, chh = 0.f; const int per = (c + 7) >> 3; const int lo = tg * per; int hi = lo + per; if (hi > c) hi = c;
        for (int cc = lo; cc < hi; ++cc) { const size_t si = ((size_t)b * 128 + cc) * DM + ch; const float A = APROD[si], Hc = HEND[si]; chh = A * chh + Hc; cp *= A; }
        carP[tg * 64 + e] = cp; carH[tg * 64 + e] = chh; }
    __syncthreads();
    float ra[8], ri[8];
#pragma unroll
    for (int j = 0; j < 8; ++j) { ra[j] = bA; ri[j] = bX; }
#pragma unroll 8
    for (int d = 0; d < 64; ++d) { const float wad = wAl[d * 64 + e], wxd = wAl[4096 + d * 64 + e];
        const f32x4 x0 = *(const LAS f32x4*)(xcT + d * 68 + tg * 8), x1 = *(const LAS f32x4*)(xcT + d * 68 + tg * 8 + 4);
        ra[0] += x0[0] * wad; ra[1] += x0[1] * wad; ra[2] += x0[2] * wad; ra[3] += x0[3] * wad; ra[4] += x1[0] * wad; ra[5] += x1[1] * wad; ra[6] += x1[2] * wad; ra[7] += x1[3] * wad;
        ri[0] += x0[0] * wxd; ri[1] += x0[1] * wxd; ri[2] += x0[2] * wxd; ri[3] += x0[3] * wxd; ri[4] += x1[0] * wxd; ri[5] += x1[1] * wxd; ri[6] += x1[2] * wxd; ri[7] += x1[3] * wxd; }
    float av[8], uv[8]; float P = 1.f, Hh = 0.f;
#pragma unroll
    for (int j = 0; j < 8; ++j) { const float rr = fast_sigmoid(ra[j]), ii = fast_sigmoid(ri[j]); const float la = -8.f * rr * spl; av[j] = __expf(la); uv[j] = __builtin_amdgcn_sqrtf(neg_expm1_small(2.f * la)) * (ii * xc[j]);
        Hh = av[j] * Hh + uv[j]; P *= av[j]; }
    segP[tg * 64 + e] = P; segH[tg * 64 + e] = Hh;
    __syncthreads();
    if (FINAL) {
        float h = 0.f;
#pragma unroll
        for (int s = 0; s < 8; ++s) h = carP[s * 64 + e] * h + carH[s * 64 + e];
        for (int t2 = 0; t2 < tg; ++t2) h = segP[t2 * 64 + e] * h + segH[t2 * 64 + e];
#pragma unroll
        for (int j = 0; j < 8; ++j) { h = av[j] * h + uv[j]; YL[(row0 + j) * DM + ch] = f2bf(h * fast_gelu(gl[j])); }
    } else if (tg == 7) {
        float h = 0.f, p = 1.f;
#pragma unroll
        for (int s = 0; s < 8; ++s) { h = segP[s * 64 + e] * h + segH[s * 64 + e]; p *= segP[s * 64 + e]; }
        const size_t si = ((size_t)b * 128 + c) * DM + ch; APROD[si] = p; HEND[si] = h;
    }
    __syncthreads();
}
template <bool FINAL> __device__ __forceinline__ void lru_pass(int l, int bx, int G, const float* const* in, const bf16_t* LX, const bf16_t* LG, bf16_t* YL, float* APROD, float* HEND, LAS unsigned char* lds, int tid) {
    const int n = bx & 15, e = tid & 63, ch = n * 64 + e;
    { const float* wa = in[10] + (size_t)l * 65536 + (size_t)n * 4096; const float* wx = in[12] + (size_t)l * 65536 + (size_t)n * 4096; LAS float* wl = (LAS float*)(lds + 32768);
        for (int i = tid; i < 4096; i += MEGA_THREADS) { wl[i] = wa[i]; wl[4096 + i] = wx[i]; } }
    __syncthreads();
    const float bA = in[11][l * DM + ch], bX = in[13][l * DM + ch], spl = softplusf(-in[14][l * DM + ch]);
    for (int it = bx; it < 4096; it += G) lru_item<FINAL>(it >> 11, (it >> 4) & 127, n, LX, LG, YL, in[8] + (size_t)l * 4 * DM, in[9] + l * DM, bA, bX, spl, APROD, HEND, lds, tid);
}

__device__ __forceinline__ void sb_wave(int b, int h, int qw0, const bf16_t* Q, const bf16_t* __restrict__ K, const bf16_t* __restrict__ V, bf16_t* O, LAS unsigned char* vl, int lane) {
    const int r32 = lane & 31, hi = lane >> 5; const size_t rowbase = (size_t)b * SEQ;
    const bf16_t* Qw = Q + (rowbase + qw0) * DM + h * 64;
    bf16x8_t qr[4];
#pragma unroll
    for (int d0 = 0; d0 < 4; ++d0) qr[d0] = *(const bf16x8_t*)(Qw + (size_t)r32 * DM + d0 * 16 + hi * 8);
    const bf16_t* Kh = K + rowbase * DM + h * 64; const bf16_t* Vh = V + rowbase * DM + h * 64;
    f32x16_t o0 = {}, o1 = {}; float R = 0.f; const int qabs = qw0 + r32;
    int kt = qw0 >> 5;
    bf16x8_t kf[4]; u32x4 vr[4];
#define SB_LOAD(KF, VR, kt_) do { _Pragma("unroll") for (int d0 = 0; d0 < 4; ++d0) KF[d0] = *(const bf16x8_t*)(Kh + (size_t)((kt_) * 32 + r32) * DM + d0 * 16 + hi * 8); \
        _Pragma("unroll") for (int it = 0; it < 4; ++it) { const int chunk = lane + 64 * it; VR[it] = *(const u32x4*)(Vh + (size_t)((kt_) * 32 + (chunk >> 3)) * DM + (chunk & 7) * 8); } } while (0)
    SB_LOAD(kf, vr, kt);
    const unsigned vbase = (unsigned)(size_t)vl;
    for (;;) {
        bf16x8_t kn[4]; u32x4 vn[4]; const bool more = kt > 0;
        if (more) SB_LOAD(kn, vn, kt - 1); else {
#pragma unroll
            for (int i = 0; i < 4; ++i) { kn[i] = kf[i]; vn[i] = vr[i]; } }
        f32x16_t st = {};
#pragma unroll
        for (int d0 = 0; d0 < 4; ++d0) st = __builtin_amdgcn_mfma_f32_32x32x16_bf16(kf[d0], qr[d0], st, 0, 0, 0);
#pragma unroll
        for (int it = 0; it < 4; ++it) { const int chunk = lane + 64 * it, row = chunk >> 3, c16 = chunk & 7; *(LAS u32x4*)(vl + (c16 >> 2) * 2048 + row * 64 + (c16 & 3) * 16) = vr[it]; }
        float l1[16], lb[16]; bool val[16];
#pragma unroll
        for (int r = 0; r < 16; ++r) { const int kv = kt * 32 + (r & 3) + 8 * (r >> 2) + 4 * hi; val[r] = kv < qabs; const float z = st[r] * 0.125f; const float sp = fast_softplus(z); l1[r] = val[r] ? -sp : 0.f; lb[r] = z - sp; }
        float w[16]; float tail = 0.f;
#pragma unroll
        for (int g = 3; g >= 0; --g) { const float qs = (l1[4 * g] + l1[4 * g + 1]) + (l1[4 * g + 2] + l1[4 * g + 3]); const float pq = __shfl_xor(qs, 32);
            const float after = tail + (hi == 0 ? pq : 0.f) + R; tail += qs + pq;
            const float e2 = l1[4 * g + 3], e1 = e2 + l1[4 * g + 2], e0 = e1 + l1[4 * g + 1];
            w[4 * g + 3] = val[4 * g + 3] ? __expf(lb[4 * g + 3] + after) : 0.f; w[4 * g + 2] = val[4 * g + 2] ? __expf(lb[4 * g + 2] + after + e2) : 0.f;
            w[4 * g + 1] = val[4 * g + 1] ? __expf(lb[4 * g + 1] + after + e1) : 0.f; w[4 * g] = val[4 * g] ? __expf(lb[4 * g] + after + e0) : 0.f; }
        R += tail;
        u32x4 p0, p1; p0.x = attn_body::cvtpk_s(w[0], w[1]); p0.y = attn_body::cvtpk_s(w[2], w[3]); p0.z = attn_body::cvtpk_s(w[4], w[5]); p0.w = attn_body::cvtpk_s(w[6], w[7]);
        p1.x = attn_body::cvtpk_s(w[8], w[9]); p1.y = attn_body::cvtpk_s(w[10], w[11]); p1.z = attn_body::cvtpk_s(w[12], w[13]); p1.w = attn_body::cvtpk_s(w[14], w[15]);
        const bf16x8_t pa0 = __builtin_bit_cast(bf16x8_t, p0), pa1 = __builtin_bit_cast(bf16x8_t, p1);
        const attn_body::lds_cptr vp = (attn_body::lds_cptr)vl + (4 * hi + ((lane & 15) >> 2)) * 64 + ((lane >> 4) & 1) * 32 + (lane & 3) * 8;
#define SB_VF(d0, s) ({ const attn_body::s16x4 lo_ = attn_body::vtr(vp + (d0) * 2048 + (s) * 1024), hi_ = attn_body::vtr(vp + (d0) * 2048 + (s) * 1024 + 512); \
            (bf16x8_t){lo_[0], lo_[1], lo_[2], lo_[3], hi_[0], hi_[1], hi_[2], hi_[3]}; })
        o0 = __builtin_amdgcn_mfma_f32_32x32x16_bf16(pa0, SB_VF(0, 0), o0, 0, 0, 0);
        o1 = __builtin_amdgcn_mfma_f32_32x32x16_bf16(pa0, SB_VF(1, 0), o1, 0, 0, 0);
        o0 = __builtin_amdgcn_mfma_f32_32x32x16_bf16(pa1, SB_VF(0, 1), o0, 0, 0, 0);
        o1 = __builtin_amdgcn_mfma_f32_32x32x16_bf16(pa1, SB_VF(1, 1), o1, 0, 0, 0);
        if (!more) break;
        if (__all(R < SB_THR)) break;
#pragma unroll
        for (int i = 0; i < 4; ++i) { kf[i] = kn[i]; vr[i] = vn[i]; }
        --kt;
    }
#undef SB_LOAD
#undef SB_VF
    (void)vbase;
    bf16_t* Ow = O + (rowbase + qw0) * DM + h * 64;
#pragma unroll
    for (int r = 0; r < 16; ++r) { const int q = (r & 3) + 8 * (r >> 2) + 4 * hi; Ow[(size_t)q * DM + r32] = f2bf(o0[r]); Ow[(size_t)q * DM + 32 + r32] = f2bf(o1[r]); }
}

#ifndef DBG_NOLOGF
#define DBG_NOLOGF 0
#endif
#ifndef EN_FOX
#define EN_FOX 1
#endif
#ifndef EN_SB
#define EN_SB 1
#endif
#ifndef EN_LRU
#define EN_LRU 1
#endif
#ifndef EN_GEMM
#define EN_GEMM 1
#endif
#ifndef EN_THIN
#define EN_THIN 1
#endif
enum { SUB_CONV = 1, SUB_NORM = 2, SUB_HEADNORM = 4, SUB_CUMSUM = 8, SUB_LRU = 16, SUB_SB = 32, SUB_MEM = 64, SUB_FOX = 128, SUB_ALL = 255 };
constexpr int N_PRO = 3, N_PER_LAYER = 10, N_PHASES = N_PRO + DEPTH * N_PER_LAYER;
struct MArgs { Ptrs P; int ph_lo, ph_hi, sub, pad; };

__global__ void __launch_bounds__(MEGA_THREADS, 2) mega(MArgs a) {
    extern __shared__ __attribute__((aligned(16))) unsigned char lds_raw[];
    LAS unsigned char* lds = (LAS unsigned char*)lds_raw;
    cg::grid_group grid = cg::this_grid();
    { volatile LAS unsigned* st0 = (volatile LAS unsigned*)(lds + XB_LDS_OFF); if (threadIdx.x == 0) { st0[0] = 0u; st0[1] = 0u; } __syncthreads();
      if (a.ph_hi - a.ph_lo > 2) (void)xcd_barrier_post((unsigned*)(a.P.ws + WS_BAR), st0); }
    for (int ph = a.ph_lo; ph < a.ph_hi; ++ph) {
    int tid = threadIdx.x; asm volatile("" : "+v"(tid));
    const int lane = tid & 63, wave = __builtin_amdgcn_readfirstlane(tid >> 6);
    int zs = 0; asm volatile("" : "+s"(zs));
    const int G = gridDim.x + zs, bx = blockIdx.x + zs, sub = a.sub + zs, vcu = (G % 8 == 0) ? (bx % 8) * (G / 8) + bx / 8 : bx;
    const int gw = vcu * NWV + wave, NGW = G * NWV;
    unsigned char* ws = a.P.ws + zs; const float* const* in = a.P.in + zs; float* out = a.P.out + zs;
    bf16_t* H = (bf16_t*)(ws + WS_H); bf16_t* PROJ = (bf16_t*)(ws + WS_PROJ); bf16_t* GATES = (bf16_t*)(ws + WS_GATES); bf16_t* Eb = (bf16_t*)(ws + WS_E);
    bf16_t *FQ = PROJ, *FK = PROJ + (size_t)T * DM, *FV = PROJ + 2 * (size_t)T * DM, *LX = PROJ + 3 * (size_t)T * DM, *LG = PROJ + 4 * (size_t)T * DM, *SQ = PROJ + 5 * (size_t)T * DM,
           *SK = PROJ + 6 * (size_t)T * DM, *SV = PROJ + 7 * (size_t)T * DM, *MQ = PROJ + 8 * (size_t)T * DM;
    bf16_t* YL = (bf16_t*)(ws + WS_YL);
    float *LOGF = (float*)(ws + WS_LOGF), *FB = (float*)(ws + WS_FB), *MQSS = (float*)(ws + WS_MQSS), *ESUM = (float*)(ws + WS_ESUM), *CB = (float*)(ws + WS_CB);
    bf16_t* MEMN = (bf16_t*)(ws + WS_MEMN); float* MEMRAW = (float*)(ws + WS_MEMRAW); bf16_t *MK = (bf16_t*)(ws + WS_MK), *MVT = (bf16_t*)(ws + WS_MVT);
    float *APROD = (float*)(ws + WS_LRU), *HEND = APROD + (size_t)BATCH * 128 * DM;
    bf16_t* WKVT = (bf16_t*)(ws + WS_WKVT);
    bf16_t *WIN_T = (bf16_t*)(ws + WS_WT + WT_IN), *WBR_T = (bf16_t*)(ws + WS_WT + WT_BR), *WOUT_T = (bf16_t*)(ws + WS_WT + WT_OUT), *WUP_T = (bf16_t*)(ws + WS_WT + WT_UP), *WDN_T = (bf16_t*)(ws + WS_WT + WT_DN);
    bf16_t *GV = (bf16_t*)(ws + WS_GV), *ACT = (bf16_t*)(ws + WS_ACT);

        if (ph < N_PRO) {
            if (ph == 0) {
                LAS float* scr = (LAS float*)(lds + wave * 8448);
                for (int it = gw; it < 4 * 1024; it += NGW) { const int l = it >> 10; tr_item(in[15] + (size_t)l * DM * 2048, 2048, WKVT + (size_t)l * 2048 * DM, DM, 64, scr, it & 1023, lane, 1, 0); }
                for (int m = gw; m < 4 * 512; m += NGW) { const int l = m >> 9, r = m & 511; norm_row(in[1] + (size_t)r * DM, in[3] + l * DM, MEMN + (size_t)m * DM, (const LAS float*)lds, false, nullptr, nullptr, 0, lane); }
            } else if (ph == 1) {
                LocOrder<LocMemKV> S; S.so.init(4 * 512, 2048, G, bx); S.loc = LocMemKV{(const char*)MEMN, (const char*)WKVT};
                if (EN_GEMM) pg8::gemm_phase<EpiF32, LocOrder<LocMemKV>, true, true>(lds, pg8::Gemm{DM, DM, DM}, S, EpiF32{MEMRAW, 2048, 0});
            } else {
                for (int m = gw; m < 4 * 512; m += NGW) { const int l = m >> 9, r = m & 511, b = r >> 8, mi = r & 255; const float* raw = MEMRAW + (size_t)m * 2048;
                    const f32x4 gk = *(const f32x4*)(in[17] + l * 256 + lane * 4), gq = *(const f32x4*)(in[16] + l * 256 + lane * 4); const f32x4 gg = gk * gq;
#pragma unroll
                    for (int h = 0; h < 4; ++h) { const f32x4 k = *(const f32x4*)(raw + h * 256 + lane * 4); const float ss = wave_sum((k[0] * k[0] + k[1] * k[1]) + (k[2] * k[2] + k[3] * k[3]));
                        const float rstd = rsqrtf(ss * (1.f / 256.f) + EPS); uint2 o; o.x = pk2(k[0] * rstd * gg[0], k[1] * rstd * gg[1]); o.y = pk2(k[2] * rstd * gg[2], k[3] * rstd * gg[3]);
                        *(uint2*)(MK + ((size_t)l * 512 + (size_t)b * 256 + mi) * DM + h * 256 + lane * 4) = o;
                        const f32x4 v = *(const f32x4*)(raw + 1024 + h * 256 + lane * 4); bf16_t* vt = MVT + (size_t)l * 512 * DM + (((size_t)b * 4 + h) * 256 + lane * 4) * 256 + mi;
                        vt[0] = f2bf(v[0]); vt[256] = f2bf(v[1]); vt[512] = f2bf(v[2]); vt[768] = f2bf(v[3]); }
                    if (r == 0) { float mx = fmaxf(fmaxf(fabsf(gg[0]), fabsf(gg[1])), fmaxf(fabsf(gg[2]), fabsf(gg[3])));
#pragma unroll
                        for (int o = 1; o < 64; o <<= 1) mx = fmaxf(mx, __shfl_xor(mx, o));
                        if (lane == 0) CB[l] = 16.f * mx; } }
            }
        } else {
            const int l = (ph - N_PRO) / N_PER_LAYER, sp = (ph - N_PRO) % N_PER_LAYER;
            const float* xcur = l == 0 ? in[0] : out;
            if (sp == 0) {
                if (sub & SUB_NORM) { LAS float* WfT = (LAS float*)lds; const float* wf = in[4] + (size_t)l * DM * NIN + 3072;
                    for (int i = tid; i < 16 * 1024; i += MEGA_THREADS) { const int k = i >> 4, h = i & 15; WfT[h * 1024 + k] = wf[(size_t)k * NIN + h]; } }
                __syncthreads();
                if (sub & SUB_CONV) { LAS float* scr = (LAS float*)(lds + 65536 + wave * 8448);
                    const float* win = in[4] + (size_t)l * DM * NIN;
                    for (int it = gw; it < 13440; it += NGW) { int r = it;
                        if (r < 1536) { tr_item(win, NIN, WIN_T, DM, 96, scr, r, lane, 1, 0); continue; } r -= 1536;
                        if (r < 5120) { tr_item(win + 3088, NIN, WIN_T + (size_t)3072 * DM, DM, 320, scr, r, lane, 1, 0); continue; } r -= 5120;
                        if (r < 2048) { const int i = r >> 9; tr_item(in[19] + ((size_t)l * 4 + i) * DM * DM, DM, WBR_T + (size_t)i * DM * DM, DM, 32, scr, r & 511, lane, 1, 0); continue; } r -= 2048;
                        if (r < 512) { tr_item(in[20] + (size_t)l * DM * DM, DM, WOUT_T, DM, 32, scr, r, lane, 1, 0); continue; } r -= 512;
                        if (r < 2816) { tr_item(in[22] + (size_t)l * DM * 2 * DFF, 2 * DFF, WUP_T, DM, 176, scr, r, lane, 1, 0); continue; } r -= 2816;
                        tr_item(in[25] + (size_t)l * DFF * DM, DM, WDN_T, DFF, 32, scr, r, lane, 1, 0); } }
                if (sub & SUB_NORM) for (int m = gw; m < T; m += NGW) norm_row(xcur + (size_t)m * DM, in[2] + l * DM, H + (size_t)m * DM, (const LAS float*)lds, !DBG_NOLOGF, in[5] + l * 16, LOGF, m, lane);
            } else if (sp == 1) {
                LocOrder<LocStd> S; S.so.init(T, 13312, G, bx); S.loc = LocStd{(const char*)H, (const char*)WIN_T, 256 * 1024 * 2, 256 * 1024 * 2};
                if (EN_GEMM) pg8::gemm_phase<EpiProj, LocOrder<LocStd>, true, true>(lds, pg8::Gemm{DM, DM, DM}, S, EpiProj{PROJ, GATES, MQSS});
            } else if (sp == 2) {
                if (sub & SUB_HEADNORM) { for (int m = gw; m < 2 * T; m += NGW) { if (m < T) headnorm64_row(FQ + (size_t)m * DM, in[6] + l * 64, C2, lane); else headnorm64_row(FK + (size_t)(m - T) * DM, in[7] + l * 64, 1.f, lane); } }
                if ((sub & SUB_CUMSUM) && bx < 32) cumsum_block(LOGF + (size_t)bx * SEQ, FB + (size_t)bx * SEQ, (LAS float*)lds, tid);
                __syncthreads();
                if (EN_LRU && (sub & SUB_LRU)) lru_pass<false>(l, bx, G, in, LX, LG, YL, APROD, HEND, lds, tid);
                if (EN_SB && (sub & SUB_SB)) for (int k = 0; k < 4; ++k) { const int bh = vcu >> 3, qb = (vcu & 7) * 4 + k; sb_wave(bh >> 4, bh & 15, qb * 256 + wave * 32, SQ, SK, SV, H, lds + wave * 4096, lane); }
                __syncthreads();
                if (sub & SUB_MEM) { LocOrder<LocMemS> S; S.so.init(T, 1024, G, bx); S.loc = LocMemS{(const char*)MQ, (const char*)(MK + (size_t)l * 512 * DM)};
                    if (EN_GEMM) pg8::gemm_phase<EpiSexp, LocOrder<LocMemS>, true, true>(lds, pg8::Gemm{DM, DM, 256 + zs}, S, EpiSexp{Eb, MQSS, ESUM, CB + l}); }
            } else if (sp == 3) {
                if (EN_FOX && (sub & SUB_FOX)) { const attn_body::AttnTensors AT{(const attn_body::bf16*)FQ, (const attn_body::bf16*)FK, (const attn_body::bf16*)FV, (attn_body::bf16*)SV, FB};
                    const attn_body::StaticOrder S(G, bx); attn_body::attn_phase<attn_body::StaticOrder, 20>((char*)lds_raw, AT, S); }
                __syncthreads();
                if (EN_LRU && (sub & SUB_LRU)) lru_pass<true>(l, bx, G, in, LX, LG, YL, APROD, HEND, lds, tid);
                if (sub & SUB_MEM) { LocOrder<LocMemPV> S; S.so.init(T, 1024, G, bx); S.loc = LocMemPV{(const char*)Eb, (const char*)(MVT + (size_t)l * 512 * DM)};
                    if (EN_GEMM) pg8::gemm_phase<EpiMemPV, LocOrder<LocMemPV>, true, true>(lds, pg8::Gemm{DM, 256, 256 + zs}, S, EpiMemPV{MQ, ESUM}); }
            } else if (sp == 4) {
                BranchSched S; S.vcu = vcu; S.loc = LocBranch{(const char*)SV, (const char*)YL, (const char*)H, (const char*)MQ, (const char*)WBR_T};
                if (EN_GEMM) pg8::gemm_phase<EpiBranch, BranchSched, true, true>(lds, pg8::Gemm{DM, DM, DM}, S, EpiBranch{GATES, in[18] + (size_t)l * 4 * DM, (float*)(ws + WS_MIXF), (bf16_t*)(ws + WS_MIXED)});
            } else if (sp == 5) {
                LocOrder<LocStd> S; S.so.init(T, DM, G, bx); S.loc = LocStd{(const char*)(ws + WS_MIXED), (const char*)WOUT_T, 256 * 1024 * 2, 256 * 1024 * 2};
                if (EN_GEMM) pg8::gemm_phase<EpiResid, LocOrder<LocStd>, true, true>(lds, pg8::Gemm{DM, DM, DM}, S, EpiResid{xcur, out});
            } else if (sp == 6) {
                for (int m = gw; m < T; m += NGW) norm_row(out + (size_t)m * DM, in[21] + l * DM, H + (size_t)m * DM, (const LAS float*)lds, false, nullptr, nullptr, m, lane);
            } else if (sp == 7) {
                LocOrder<LocStd> S; S.so.init(T, 2 * DFF, G, bx); S.loc = LocStd{(const char*)H, (const char*)WUP_T, 256 * 1024 * 2, 256 * 1024 * 2};
                if (EN_GEMM) pg8::gemm_phase<EpiBf16P, LocOrder<LocStd>, true, true>(lds, pg8::Gemm{DM, DM, DM}, S, EpiBf16P{GV, 2 * DFF, 0});
            } else if (sp == 8) {
                const float* cw = in[23] + (size_t)l * 3 * DFF; const float* cbv = in[24] + l * DFF;
                for (int i = bx * MEGA_THREADS + tid; i < T * (DFF / 8); i += G * MEGA_THREADS) { const int r = i / (DFF / 8), c = (i % (DFF / 8)) * 8, t = r % SEQ;
                    const bf16_t* gp = GV + (size_t)r * 2 * DFF + c; const u32x4 z4 = {0u, 0u, 0u, 0u};
                    const u32x4 g0 = *(const u32x4*)gp, g1 = t >= 1 ? *(const u32x4*)(gp - 2 * DFF) : z4, g2 = t >= 2 ? *(const u32x4*)(gp - 4 * DFF) : z4, vv = *(const u32x4*)(gp + DFF);
                    const f32x4 wa0 = *(const f32x4*)(cw + c), wa1 = *(const f32x4*)(cw + c + 4), wb0 = *(const f32x4*)(cw + DFF + c), wb1 = *(const f32x4*)(cw + DFF + c + 4), wc0 = *(const f32x4*)(cw + 2 * DFF + c), wc1 = *(const f32x4*)(cw + 2 * DFF + c + 4);
                    const f32x4 bb0 = *(const f32x4*)(cbv + c), bb1 = *(const f32x4*)(cbv + c + 4);
#define ACT1(G0, G1, G2, VV, W0, W1, W2, BB) ({ const float pre_ = (BB) + (W2) * (G0) + (W1) * (G1) + (W0) * (G2); pre_ * fast_sigmoid(pre_) * (VV); })
                    u32x4 o;
                    o.x = pk2(ACT1(blo(g0.x), blo(g1.x), blo(g2.x), blo(vv.x), wa0[0], wb0[0], wc0[0], bb0[0]), ACT1(bhi(g0.x), bhi(g1.x), bhi(g2.x), bhi(vv.x), wa0[1], wb0[1], wc0[1], bb0[1]));
                    o.y = pk2(ACT1(blo(g0.y), blo(g1.y), blo(g2.y), blo(vv.y), wa0[2], wb0[2], wc0[2], bb0[2]), ACT1(bhi(g0.y), bhi(g1.y), bhi(g2.y), bhi(vv.y), wa0[3], wb0[3], wc0[3], bb0[3]));
                    o.z = pk2(ACT1(blo(g0.z), blo(g1.z), blo(g2.z), blo(vv.z), wa1[0], wb1[0], wc1[0], bb1[0]), ACT1(bhi(g0.z), bhi(g1.z), bhi(g2.z), bhi(vv.z), wa1[1], wb1[1], wc1[1], bb1[1]));
                    o.w = pk2(ACT1(blo(g0.w), blo(g1.w), blo(g2.w), blo(vv.w), wa1[2], wb1[2], wc1[2], bb1[2]), ACT1(bhi(g0.w), bhi(g1.w), bhi(g2.w), bhi(vv.w), wa1[3], wb1[3], wc1[3], bb1[3]));
#undef ACT1
                    *(u32x4*)(ACT + (size_t)r * DFF + c) = o; }
            } else {
                LocOrder<LocStd> S; S.so.init(T, DM, G, bx); S.loc = LocStd{(const char*)ACT, (const char*)WDN_T, 256 * DFF * 2, 256 * DFF * 2};
                if (EN_GEMM) pg8::gemm_phase<EpiResid, LocOrder<LocStd>, true, true>(lds, pg8::Gemm{DFF, DFF, DFF}, S, EpiResid{out, out});
            }
        }
        if (ph + 1 < a.ph_hi) {
            if (ph == a.ph_lo) grid.sync();
            else { XcdBarrier xb; xb.bar = (unsigned*)(ws + WS_BAR); xb.x = xb_xcc_id(); xb.st = (volatile LAS unsigned*)(lds + XB_LDS_OFF); xcd_barrier(xb); }
        }
    }
}
enum { C_PRO = 1, C_NORM = 2, C_WIN = 4, C_HN = 8, C_LRU = 16, C_SB = 32, C_MEM = 64, C_FOX = 128, C_BR = 256, C_WOUT = 512, C_NORM2 = 1024, C_UP = 2048, C_ACT = 4096, C_DOWN = 8192, C_ONE = 16384 };
#ifndef CFG
#define CFG 32767
#endif
#ifndef REPEAT_SP
#define REPEAT_SP (-1)
#define REPEAT_N 0
#define REPEAT_SUB 0
#endif
static int g_grid = 0;
static void launch_mega(const Ptrs& P, int lo, int hi, int sub, hipStream_t st, bool coop) {
    MArgs a{}; a.P = P; a.ph_lo = lo; a.ph_hi = hi; a.sub = sub; a.pad = 0;
    if (coop) { void* args[] = {&a}; const hipError_t e = hipLaunchCooperativeKernel((const void*)mega, dim3(g_grid), dim3(MEGA_THREADS), args, MEGA_LDS, st);
        if (e != hipSuccess) fprintf(stderr, "cooperative launch failed: %s (grid %d)\n", hipGetErrorString(e), g_grid); }
    else { hipLaunchKernelGGL(mega, dim3(g_grid), dim3(MEGA_THREADS), MEGA_LDS, st, a);
        if (REPEAT_N > 0 && hi == lo + 1 && lo >= N_PRO && (lo - N_PRO) % N_PER_LAYER == (REPEAT_SP)) { a.sub = (REPEAT_SUB); for (int r = 0; r < (REPEAT_N); ++r) hipLaunchKernelGGL(mega, dim3(g_grid), dim3(MEGA_THREADS), MEGA_LDS, st, a); } }
}
static void run_hybrid(const Ptrs& P, hipStream_t st) {
    unsigned char* ws = P.ws;
    bf16_t* H = (bf16_t*)(ws + WS_H);
    bf16_t* PR[9]; for (int i = 0; i < 9; ++i) PR[i] = (bf16_t*)(ws + WS_PROJ + i * SZ_ACT);
    bf16_t *FQ = PR[0], *FK = PR[1], *FV = PR[2], *LX = PR[3], *LG = PR[4], *SQ = PR[5], *SK = PR[6], *SV = PR[7], *MQ = PR[8];
    bf16_t* GATES = (bf16_t*)(ws + WS_GATES);
    bf16_t *YL = (bf16_t*)(ws + WS_YL), *YS = (bf16_t*)(ws + WS_YS), *YM = (bf16_t*)(ws + WS_YM), *YF = (bf16_t*)(ws + WS_YF);
    float *LOGF = (float*)(ws + WS_LOGF), *FB = (float*)(ws + WS_FB);
    bf16_t* MEMN = (bf16_t*)(ws + WS_MEMN); float* MEMRAW = (float*)(ws + WS_MEMRAW);
    bf16_t *MK = (bf16_t*)(ws + WS_MK), *MVT = (bf16_t*)(ws + WS_MVT);
    bf16_t *GV = (bf16_t*)(ws + WS_GV), *ACT = (bf16_t*)(ws + WS_ACT);
    const float* const* in = P.in;
    const int cfg = CFG;
    const bool anygemm = cfg & (C_WIN | C_BR | C_WOUT | C_UP | C_DOWN);
    if (cfg & C_PRO) { for (int p = 0; p < 3; ++p) launch_mega(P, p, p + 1, SUB_ALL, st, false); }
    else for (int l = 0; l < DEPTH; ++l) {
        n_rmsnorm<<<512 / 4, 256, 0, st>>>(in[1], in[3] + l * DM, MEMN + (size_t)l * 512 * DM, nullptr, nullptr, nullptr, 512);
        n_gemm<EStoreF32><<<dim3(2048 / 64, 512 / 64), 256, 0, st>>>(MEMN + (size_t)l * 512 * DM, in[15] + (size_t)l * DM * 2048, DM, 2048, DM, 0x7fffffff, EStoreF32{MEMRAW + (size_t)l * 512 * 2048, 2048, 0});
        n_memkv_post<<<512, 256, 0, st>>>(MEMRAW + (size_t)l * 512 * 2048, in[17] + l * 256, in[16] + l * 256, MK + (size_t)l * 512 * DM, MVT + (size_t)l * 512 * DM);
    }
    for (int l = 0; l < DEPTH; ++l) {
        const int p0 = N_PRO + l * N_PER_LAYER;
        const float* xcur = l == 0 ? in[0] : P.out;
        const float* win = in[4] + (size_t)l * DM * NIN;
        if (DBG_NOLOGF) n_rmsnorm<<<T / 4, 256, 0, st>>>(xcur, in[2] + l * DM, H, win + 3072, in[5] + l * 16, LOGF, T);
        { const int sub = (anygemm ? SUB_CONV : 0) | ((cfg & C_NORM) ? SUB_NORM : 0); if (sub) launch_mega(P, p0, p0 + 1, sub, st, false); }
        if (!(cfg & C_NORM)) n_rmsnorm<<<T / 4, 256, 0, st>>>(xcur, in[2] + l * DM, H, win + 3072, in[5] + l * 16, LOGF, T);
        if (cfg & C_WIN) launch_mega(P, p0 + 1, p0 + 2, SUB_ALL, st, false);
        else { for (int gI = 0; gI < 9; ++gI) { const int coff = gI < 3 ? gI * 1024 : gI * 1024 + 16;
                n_gemm<EStoreBf16><<<dim3(1024 / 64, T / 64), 256, 0, st>>>(H, win + coff, DM, NIN, DM, 0x7fffffff, EStoreBf16{PR[gI], DM, 0}); }
            n_gemm<EStoreBf16><<<dim3(4096 / 64, T / 64), 256, 0, st>>>(H, win + 9232, DM, NIN, DM, 0x7fffffff, EStoreBf16{GATES, 4096, 0}); }
        if (!(cfg & C_HN)) { n_headnorm<<<T * 16 / 256, 256, 0, st>>>(FQ, in[6] + l * 64, 64, C2); n_headnorm<<<T * 16 / 256, 256, 0, st>>>(FK, in[7] + l * 64, 64, 1.f); n_cumsum<<<32, 1024, 0, st>>>(LOGF, FB); }
        const int sub23 = ((cfg & C_HN) ? (SUB_HEADNORM | SUB_CUMSUM) : 0) | ((cfg & C_LRU) ? SUB_LRU : 0) | ((cfg & C_SB) ? SUB_SB : 0) | ((cfg & C_MEM) ? SUB_MEM : 0) | ((cfg & C_FOX) ? SUB_FOX : 0);
        if (sub23 & ~SUB_FOX) launch_mega(P, p0 + 2, p0 + 3, sub23, st, false);
        if (!(cfg & C_SB)) n_sb_attn<<<dim3(SEQ / 256, 32), 256, 0, st>>>(SQ, SK, SV, YS);
        if (!(cfg & C_LRU)) n_lru<<<32, 64, 0, st>>>(LX, LG, in[8] + (size_t)l * 4 * DM, in[9] + l * DM, in[10] + (size_t)l * 16 * 64 * 64, in[11] + l * DM, in[12] + (size_t)l * 16 * 64 * 64, in[13] + l * DM, in[14] + l * DM, YL);
        if (!(cfg & C_MEM)) n_mem_attn<<<T * 4, 256, 0, st>>>(MQ, MK + (size_t)l * 512 * DM, MVT + (size_t)l * 512 * DM, YM);
        if (sub23 & (SUB_FOX | SUB_LRU | SUB_MEM)) launch_mega(P, p0 + 3, p0 + 4, sub23, st, false);
        if (!(cfg & C_FOX)) n_fox_attn<<<dim3(SEQ / 256, 32), 256, 0, st>>>(FQ, FK, FV, FB, YF);
        if (cfg & C_BR) launch_mega(P, p0 + 4, p0 + 5, SUB_ALL, st, false);
        else { const bf16_t* Y[4] = {YF, YL, YS, YM};
            for (int i = 0; i < 4; ++i) n_gemm<EBranch><<<dim3(1024 / 64, T / 64), 256, 0, st>>>(Y[i], in[19] + ((size_t)l * 4 + i) * DM * DM, DM, DM, DM, 0x7fffffff, EBranch{GATES, in[18] + ((size_t)l * 4 + i) * DM, (float*)(ws + WS_MIXF), (bf16_t*)(ws + WS_MIXED), i, 0}); }
        if (cfg & C_WOUT) launch_mega(P, p0 + 5, p0 + 6, SUB_ALL, st, false);
        else n_gemm<EResid><<<dim3(1024 / 64, T / 64), 256, 0, st>>>((const bf16_t*)(ws + WS_MIXED), in[20] + (size_t)l * DM * DM, DM, DM, DM, 0x7fffffff, EResid{xcur, P.out});
        if (cfg & C_NORM2) launch_mega(P, p0 + 6, p0 + 7, SUB_ALL, st, false);
        else n_rmsnorm<<<T / 4, 256, 0, st>>>(P.out, in[21] + l * DM, H, nullptr, nullptr, nullptr, T);
        if (cfg & C_UP) launch_mega(P, p0 + 7, p0 + 8, SUB_ALL, st, false);
        else n_gemm<EStoreBf16><<<dim3(2 * DFF / 64, T / 64), 256, 0, st>>>(H, in[22] + (size_t)l * DM * 2 * DFF, DM, 2 * DFF, DM, 0x7fffffff, EStoreBf16{GV, 2 * DFF, 0});
        if (cfg & C_ACT) launch_mega(P, p0 + 8, p0 + 9, SUB_ALL, st, false);
        else n_act<<<(unsigned)(((size_t)T * DFF + 255) / 256), 256, 0, st>>>(GV, in[23] + (size_t)l * 3 * DFF, in[24] + l * DFF, ACT);
        if (cfg & C_DOWN) launch_mega(P, p0 + 9, p0 + 10, SUB_ALL, st, false);
        else n_gemm<EResid><<<dim3(1024 / 64, T / 64), 256, 0, st>>>(ACT, in[25] + (size_t)l * DFF * DM, DFF, DM, DFF, 0x7fffffff, EResid{P.out, P.out});
    }
}

extern "C" void kernel_launch(void* const* d_in, const int* in_sizes, int n_in, void* d_out, int out_size, void* d_ws, size_t ws_size, hipStream_t stream) {
    if (n_in != 26 || out_size != T * DM || ws_size < WS_NEED) { fprintf(stderr, "kernel_launch: unexpected sizes n_in %d out %d ws %zu (need %zu)\n", n_in, out_size, ws_size, (size_t)WS_NEED); return; }
    if (g_grid == 0) {
        int dev = 0, cus = 0, per_cu = 0;
        hipGetDevice(&dev); hipDeviceGetAttribute(&cus, hipDeviceAttributeMultiprocessorCount, dev);
        if (hipFuncSetAttribute((const void*)mega, hipFuncAttributeMaxDynamicSharedMemorySize, MEGA_LDS) != hipSuccess) fprintf(stderr, "kernel_launch: hipFuncSetAttribute failed\n");
        if (hipOccupancyMaxActiveBlocksPerMultiprocessor(&per_cu, (const void*)mega, MEGA_THREADS, MEGA_LDS) != hipSuccess || per_cu < 1) fprintf(stderr, "kernel_launch: occupancy query says %d\n", per_cu);
        (void)hipGetLastError();
        g_grid = cus;
        if (g_grid != 256) fprintf(stderr, "kernel_launch: %d CUs; the attention phase's static order assumes 256\n", g_grid);
    }
    Ptrs P{};
    for (int i = 0; i < 26; ++i) P.in[i] = (const float*)d_in[i];
    P.out = (float*)d_out; P.ws = (unsigned char*)d_ws;
    if ((CFG) & C_ONE) { (void)hipMemsetAsync((char*)d_ws + WS_BAR, 0, XCD_BAR_WORDS * 4, stream);
        launch_mega(P, 0, N_PHASES, SUB_ALL, stream, true); }
    else run_hybrid(P, stream);
}
```

```cpp
#include <hip/hip_runtime.h>
#include <cstdio>
#include <cstdint>
#include <hip/hip_cooperative_groups.h>

typedef unsigned short bf16_t;
constexpr int BATCH = 2, SEQ = 8192, DM = 1024, DEPTH = 4, T = BATCH * SEQ;
constexpr int NMEM = 256, NIN = 13328, DFF = 2816;
constexpr float EPS = 1e-6f;
constexpr float LOG2E = 1.4426950408889634f;
constexpr float C2 = 0.125f * LOG2E;
constexpr float SB_THR = -104.0f;

__device__ __forceinline__ float bf2f(bf16_t b) { return __uint_as_float(((unsigned)b) << 16); }
__device__ __forceinline__ bf16_t f2bf(float f) { unsigned u = __float_as_uint(f); return (bf16_t)((u + 0x7fffu + ((u >> 16) & 1u)) >> 16); }
__device__ __forceinline__ float bfr(float f) { return bf2f(f2bf(f)); }
__device__ __forceinline__ float wave_sum(float v) {
#pragma unroll
    for (int o = 1; o < 64; o <<= 1) v += __shfl_xor(v, o);
    return v;
}
__device__ __forceinline__ float softplusf(float x) { return fmaxf(x, 0.f) + log1pf(__expf(-fabsf(x))); }
__device__ __forceinline__ float logsigmoidf(float x) { return -softplusf(-x); }
__device__ __forceinline__ float sigmoidf_(float x) { return 1.f / (1.f + __expf(-x)); }
__device__ __forceinline__ float gelu_tanh(float x) { const float u = 0.7978845608028654f * (x + 0.044715f * x * x * x); return 0.5f * x * (1.f + tanhf(u)); }

__device__ __forceinline__ int mk_tid() { int t = threadIdx.x; asm volatile("" : "+v"(t)); return t; }

constexpr size_t MiB = 1u << 20;
constexpr size_t SZ_ACT = (size_t)T * DM * 2;
constexpr size_t WS_CTL = 0;
constexpr size_t WS_H = 1 * MiB;
constexpr size_t WS_PROJ = WS_H + SZ_ACT;
constexpr size_t WS_GATES = WS_PROJ + 9 * SZ_ACT;
constexpr size_t WS_E = WS_GATES + 4 * SZ_ACT;
constexpr size_t WS_LOGF = WS_E + SZ_ACT;
constexpr size_t WS_FB = WS_LOGF + 1 * MiB;
constexpr size_t WS_MQSS = WS_FB + 1 * MiB;
constexpr size_t WS_ESUM = WS_MQSS + 1 * MiB;
constexpr size_t WS_MEMN = WS_ESUM + 1 * MiB;
constexpr size_t WS_MEMRAW = WS_MEMN + 4 * MiB;
constexpr size_t WS_MK = WS_MEMRAW + 16 * MiB;
constexpr size_t WS_MVT = WS_MK + 4 * MiB;
constexpr size_t WS_LRU = WS_MVT + 4 * MiB;
constexpr size_t WS_WT = WS_LRU + 2 * MiB;
constexpr size_t WS_END = WS_WT + 72 * MiB;
constexpr size_t WS_YL = WS_PROJ + 6 * SZ_ACT, WS_YS = WS_H, WS_YM = WS_PROJ + 8 * SZ_ACT, WS_YF = WS_PROJ + 7 * SZ_ACT;
constexpr size_t WS_GV = WS_PROJ;
constexpr size_t WS_ACT = WS_GV + (size_t)T * 2 * DFF * 2;
static_assert(WS_ACT + (size_t)T * DFF * 2 <= WS_GATES, "ffn alias");
constexpr size_t WS_MIXF = WS_END;
constexpr size_t WS_MIXED = WS_PROJ;
constexpr size_t WS_NEED = WS_MIXF + (size_t)T * DM * 4;

struct Ptrs {
    const float* in[26];
    float* out;
    unsigned char* ws;
};

__global__ void __launch_bounds__(256) n_rmsnorm(const float* __restrict__ x, const float* __restrict__ g, bf16_t* __restrict__ H,
                                                 const float* __restrict__ Wf, const float* __restrict__ bfg, float* __restrict__ LOGF, int nrows) {
    const int lane = threadIdx.x & 63, row = blockIdx.x * 4 + (threadIdx.x >> 6);
    if (row >= nrows) return;
    const float4* xr = (const float4*)(x + (size_t)row * DM);
    const float4* gr = (const float4*)g;
    float4 v[4]; float ss = 0.f;
#pragma unroll
    for (int j = 0; j < 4; ++j) { v[j] = xr[lane + 64 * j]; ss += v[j].x * v[j].x + v[j].y * v[j].y + v[j].z * v[j].z + v[j].w * v[j].w; }
    ss = wave_sum(ss);
    const float rstd = rsqrtf(ss * (1.f / DM) + EPS);
#pragma unroll
    for (int j = 0; j < 4; ++j) { const float4 gg = gr[lane + 64 * j]; v[j].x *= rstd * gg.x; v[j].y *= rstd * gg.y; v[j].z *= rstd * gg.z; v[j].w *= rstd * gg.w;
        ushort4 o; o.x = f2bf(v[j].x); o.y = f2bf(v[j].y); o.z = f2bf(v[j].z); o.w = f2bf(v[j].w);
        ((ushort4*)(H + (size_t)row * DM))[lane + 64 * j] = o; }
    if (Wf) {
        float mine = 0.f;
        for (int h = 0; h < 16; ++h) {
            float p = 0.f;
#pragma unroll
            for (int j = 0; j < 4; ++j) { const int k = (lane + 64 * j) * 4;
                p += v[j].x * Wf[(size_t)k * NIN + h] + v[j].y * Wf[(size_t)(k + 1) * NIN + h] + v[j].z * Wf[(size_t)(k + 2) * NIN + h] + v[j].w * Wf[(size_t)(k + 3) * NIN + h]; }
            p = wave_sum(p);
            if (lane == h) mine = p;
        }
        if (lane < 16) { const int b = row / SEQ, t = row % SEQ; LOGF[((size_t)b * 16 + lane) * SEQ + t] = logsigmoidf(mine + bfg[lane]); }
    }
}

struct EStoreBf16 { bf16_t* O; int ldc; int pad; __device__ void operator()(int m, int n, float a) const { O[(size_t)m * ldc + n] = f2bf(a); } };
struct EStoreF32 { float* O; int ldc; int pad; __device__ void operator()(int m, int n, float a) const { O[(size_t)m * ldc + n] = a; } };
struct EBranch { const bf16_t* G; const float* bg; float* MIXF; bf16_t* MIXED; int i; int pad; __device__ void operator()(int m, int n, float a) const { float v = sigmoidf_(bf2f(G[(size_t)m * 4096 + i * 1024 + n]) + bg[n]) * a; const size_t o = (size_t)m * DM + n; if (i > 0) v += MIXF[o]; if (i < 3) MIXF[o] = v; else MIXED[o] = f2bf(v); } };
struct EResid { const float* base; float* out; __device__ void operator()(int m, int n, float a) const { out[(size_t)m * DM + n] = base[(size_t)m * DM + n] + a; } };

template <class Epi> __global__ void __launch_bounds__(256) n_gemm(const bf16_t* __restrict__ A, const float* __restrict__ W, int lda, int ldw, int K, int kmask, Epi epi) {
    __shared__ float As[16][68], Bs[16][68];
    const int tx = threadIdx.x & 15, ty = threadIdx.x >> 4, m0 = blockIdx.y * 64, n0 = blockIdx.x * 64;
    float acc[4][4];
#pragma unroll
    for (int i = 0; i < 4; ++i)
#pragma unroll
        for (int j = 0; j < 4; ++j) acc[i][j] = 0.f;
    for (int k0 = 0; k0 < K; k0 += 16) {
#pragma unroll
        for (int i = 0; i < 4; ++i) { const int idx = threadIdx.x + i * 256; { const int r = idx >> 4, c = idx & 15; As[c][r] = bf2f(A[(size_t)(m0 + r) * lda + k0 + c]); }
            { const int r = idx >> 6, c = idx & 63; Bs[r][c] = bfr(W[(size_t)((k0 + r) & kmask) * ldw + n0 + c]); } }
        __syncthreads();
#pragma unroll
        for (int kk = 0; kk < 16; ++kk) { float a[4], b[4];
#pragma unroll
            for (int i = 0; i < 4; ++i) { a[i] = As[kk][ty * 4 + i]; b[i] = Bs[kk][tx * 4 + i]; }
#pragma unroll
            for (int i = 0; i < 4; ++i)
#pragma unroll
                for (int j = 0; j < 4; ++j) acc[i][j] += a[i] * b[j]; }
        __syncthreads();
    }
#pragma unroll
    for (int i = 0; i < 4; ++i)
#pragma unroll
        for (int j = 0; j < 4; ++j) epi(m0 + ty * 4 + i, n0 + tx * 4 + j, acc[i][j]);
}

__global__ void __launch_bounds__(256) n_headnorm(bf16_t* X, const float* __restrict__ g, int HD, float scale) {
    const int idx = blockIdx.x * 256 + threadIdx.x, nh = DM / HD, row = idx / nh, h = idx % nh;
    if (row >= T) return;
    bf16_t* p = X + (size_t)row * DM + h * HD; float ss = 0.f;
    for (int d = 0; d < HD; ++d) { const float v = bf2f(p[d]); ss += v * v; }
    const float rstd = rsqrtf(ss / HD + EPS) * scale;
    for (int d = 0; d < HD; ++d) p[d] = f2bf(bf2f(p[d]) * rstd * g[d]);
}

__global__ void __launch_bounds__(1024) n_cumsum(const float* __restrict__ LOGF, float* __restrict__ FB) {
    __shared__ float part[1024];
    const int bh = blockIdx.x, tid = threadIdx.x; const float* src = LOGF + (size_t)bh * SEQ + tid * 8; float v[8]; float s = 0.f;
#pragma unroll
    for (int i = 0; i < 8; ++i) { s += src[i]; v[i] = s; }
    part[tid] = s; __syncthreads();
    if (tid == 0) { float run = 0.f; for (int i = 0; i < 1024; ++i) { const float t_ = part[i]; part[i] = run; run += t_; } }
    __syncthreads();
    const float off = part[tid]; float* dst = FB + (size_t)bh * SEQ + tid * 8;
#pragma unroll
    for (int i = 0; i < 8; ++i) dst[i] = off + v[i];
}

__global__ void __launch_bounds__(256) n_fox_attn(const bf16_t* Q, const bf16_t* __restrict__ K, const bf16_t* __restrict__ V, const float* __restrict__ FB, bf16_t* O) {
    __shared__ float Ks[64][64], Vs[64][64], Fs[64];
    const int bh = blockIdx.y, b = bh >> 4, h = bh & 15, tq = blockIdx.x * 256 + threadIdx.x;
    const size_t rowq = (size_t)b * SEQ + tq;
    float q[64], o[64];
#pragma unroll
    for (int d = 0; d < 64; ++d) { q[d] = bf2f(Q[rowq * DM + h * 64 + d]); o[d] = 0.f; }
    const float Ft = FB[(size_t)bh * SEQ + tq];
    float m = -INFINITY, l = 0.f;
    const int ntile = (blockIdx.x * 256 + 256) / 64;
    for (int kt = 0; kt < ntile; ++kt) {
        __syncthreads();
        for (int i = threadIdx.x; i < 64 * 64; i += 256) { const int r = i >> 6, c = i & 63; const size_t rk = ((size_t)b * SEQ + kt * 64 + r) * DM + h * 64 + c; Ks[r][c] = bf2f(K[rk]); Vs[r][c] = bf2f(V[rk]); }
        if (threadIdx.x < 64) Fs[threadIdx.x] = FB[(size_t)bh * SEQ + kt * 64 + threadIdx.x];
        __syncthreads();
        for (int j = 0; j < 64; ++j) {
            const int s = kt * 64 + j; if (s > tq) break;
            float z = 0.f;
#pragma unroll
            for (int d = 0; d < 64; ++d) z += q[d] * Ks[j][d];
            z += (Ft - Fs[j]) * LOG2E;
            if (z > m) { const float c = exp2f(m - z); l *= c;
#pragma unroll
                for (int d = 0; d < 64; ++d) o[d] *= c;
                m = z; }
            const float p = exp2f(z - m); l += p;
#pragma unroll
            for (int d = 0; d < 64; ++d) o[d] += p * Vs[j][d];
        }
    }
    const float il = 1.f / l;
#pragma unroll
    for (int d = 0; d < 64; ++d) O[rowq * DM + h * 64 + d] = f2bf(o[d] * il);
}

__global__ void __launch_bounds__(256) n_sb_attn(const bf16_t* Q, const bf16_t* __restrict__ K, const bf16_t* __restrict__ V, bf16_t* O) {
    __shared__ float Ks[64][64], Vs[64][64];
    const int bh = blockIdx.y, b = bh >> 4, h = bh & 15, tq = blockIdx.x * 256 + threadIdx.x;
    const size_t rowq = (size_t)b * SEQ + tq;
    float q[64], o[64];
#pragma unroll
    for (int d = 0; d < 64; ++d) { q[d] = bf2f(Q[rowq * DM + h * 64 + d]) * 0.125f; o[d] = 0.f; }
    float R = 0.f;
    for (int kt = (blockIdx.x * 256 + 255) / 64; kt >= 0; --kt) {
        if (__syncthreads_and(R < SB_THR)) break;
        for (int i = threadIdx.x; i < 64 * 64; i += 256) { const int r = i >> 6, c = i & 63; const size_t rk = ((size_t)b * SEQ + kt * 64 + r) * DM + h * 64 + c; Ks[r][c] = bf2f(K[rk]); Vs[r][c] = bf2f(V[rk]); }
        __syncthreads();
        for (int j = 63; j >= 0; --j) {
            const int s = kt * 64 + j; if (s >= tq) continue;
            float z = 0.f;
#pragma unroll
            for (int d = 0; d < 64; ++d) z += q[d] * Ks[j][d];
            const float sp = softplusf(z);
            const float w = __expf((z - sp) + R);
            R -= sp;
#pragma unroll
            for (int d = 0; d < 64; ++d) o[d] += w * Vs[j][d];
        }
    }
#pragma unroll
    for (int d = 0; d < 64; ++d) O[rowq * DM + h * 64 + d] = f2bf(o[d]);
}

__global__ void __launch_bounds__(64) n_lru(const bf16_t* LX, const bf16_t* __restrict__ LG, const float* __restrict__ cw, const float* __restrict__ cb,
                                            const float* __restrict__ wa, const float* __restrict__ ba, const float* __restrict__ wx, const float* __restrict__ bx,
                                            const float* __restrict__ lam, bf16_t* YL) {
    __shared__ float xs[64];
    const int b = blockIdx.x >> 4, n = blockIdx.x & 15, e = threadIdx.x, ch = n * 64 + e;
    float wA[64], wX[64];
#pragma unroll
    for (int d = 0; d < 64; ++d) { wA[d] = wa[((size_t)n * 64 + d) * 64 + e]; wX[d] = wx[((size_t)n * 64 + d) * 64 + e]; }
    const float w0 = cw[ch], w1 = cw[DM + ch], w2 = cw[2 * DM + ch], w3 = cw[3 * DM + ch], bc = cb[ch], bA = ba[ch], bX = bx[ch];
    const float spl = softplusf(-lam[ch]);
    float x1 = 0.f, x2 = 0.f, x3 = 0.f, hs = 0.f;
    for (int t = 0; t < SEQ; ++t) {
        const size_t r = ((size_t)b * SEQ + t) * DM + ch;
        const float x0 = bf2f(LX[r]);
        const float xc = bc + w3 * x0 + w2 * x1 + w1 * x2 + w0 * x3;
        x3 = x2; x2 = x1; x1 = x0;
        __syncthreads();
        xs[e] = xc;
        __syncthreads();
        float ra = bA, ri = bX;
#pragma unroll
        for (int d = 0; d < 64; ++d) { const float xv = xs[d]; ra += xv * wA[d]; ri += xv * wX[d]; }
        const float rr = sigmoidf_(ra), ii = sigmoidf_(ri);
        const float la = -8.f * rr * spl;
        const float a = __expf(la);
        const float u = sqrtf(-expm1f(2.f * la)) * (ii * xc);
        hs = a * hs + u;
        YL[r] = f2bf(hs * gelu_tanh(bf2f(LG[r])));
    }
}

__global__ void __launch_bounds__(256) n_memkv_post(const float* __restrict__ raw, const float* __restrict__ gk, const float* __restrict__ gq, bf16_t* __restrict__ MK, bf16_t* __restrict__ MVT) {
    const int row = blockIdx.x, b = row >> 8, m = row & 255, d = threadIdx.x;
    __shared__ float red[4];
    for (int h = 0; h < 4; ++h) {
        const float k = raw[(size_t)row * 2048 + h * 256 + d];
        float ss = wave_sum(k * k);
        __syncthreads();
        if ((threadIdx.x & 63) == 0) red[threadIdx.x >> 6] = ss;
        __syncthreads();
        ss = red[0] + red[1] + red[2] + red[3];
        const float rstd = rsqrtf(ss * (1.f / 256.f) + EPS);
        MK[((size_t)b * 256 + m) * DM + h * 256 + d] = f2bf(k * rstd * gk[d] * gq[d]);
        MVT[(((size_t)b * 4 + h) * 256 + d) * 256 + m] = f2bf(raw[(size_t)row * 2048 + 1024 + h * 256 + d]);
    }
}

__global__ void __launch_bounds__(256) n_mem_attn(const bf16_t* MQ, const bf16_t* __restrict__ MK, const bf16_t* __restrict__ MVT, bf16_t* YM) {
    __shared__ float qs[256], ps[256], red[4];
    const int row = blockIdx.x >> 2, h = blockIdx.x & 3, b = row / SEQ, tid = threadIdx.x;
    const float qv = bf2f(MQ[(size_t)row * DM + h * 256 + tid]);
    float ss = wave_sum(qv * qv);
    if ((tid & 63) == 0) red[tid >> 6] = ss;
    qs[tid] = qv;
    __syncthreads();
    const float rstd = rsqrtf((red[0] + red[1] + red[2] + red[3]) * (1.f / 256.f) + EPS);
    const bf16_t* kr = MK + ((size_t)b * 256 + tid) * DM + h * 256;
    float s = 0.f;
    for (int d = 0; d < 256; ++d) s += qs[d] * bf2f(kr[d]);
    s *= rstd * (1.f / 16.f);
    __syncthreads();
    float mx = s;
#pragma unroll
    for (int o = 1; o < 64; o <<= 1) mx = fmaxf(mx, __shfl_xor(mx, o));
    if ((tid & 63) == 0) red[tid >> 6] = mx;
    __syncthreads();
    mx = fmaxf(fmaxf(red[0], red[1]), fmaxf(red[2], red[3]));
    const float p = __expf(s - mx);
    ps[tid] = p;
    float sum = wave_sum(p);
    __syncthreads();
    if ((tid & 63) == 0) red[tid >> 6] = sum;
    __syncthreads();
    sum = red[0] + red[1] + red[2] + red[3];
    const bf16_t* vr = MVT + (((size_t)b * 4 + h) * 256 + tid) * 256;
    float o = 0.f;
    for (int m = 0; m < 256; ++m) o += ps[m] * bf2f(vr[m]);
    YM[(size_t)row * DM + h * 256 + tid] = f2bf(o / sum);
}

__global__ void __launch_bounds__(256) n_act(const bf16_t* __restrict__ GV, const float* __restrict__ cw, const float* __restrict__ cb, bf16_t* __restrict__ ACT) {
    const size_t idx = (size_t)blockIdx.x * 256 + threadIdx.x; if (idx >= (size_t)T * DFF) return;
    const int r = (int)(idx / DFF), c = (int)(idx % DFF), t = r % SEQ;
    const float g0 = bf2f(GV[(size_t)r * 2 * DFF + c]);
    const float g1 = t >= 1 ? bf2f(GV[(size_t)(r - 1) * 2 * DFF + c]) : 0.f;
    const float g2 = t >= 2 ? bf2f(GV[(size_t)(r - 2) * 2 * DFF + c]) : 0.f;
    const float pre = cb[c] + cw[2 * DFF + c] * g0 + cw[DFF + c] * g1 + cw[c] * g2;
    const float val = bf2f(GV[(size_t)r * 2 * DFF + DFF + c]);
    ACT[(size_t)r * DFF + c] = f2bf(pre * sigmoidf_(pre) * val);
}

#define CFG 32767
namespace pg8 {
#define PG8_LAS __attribute__((address_space(3)))
typedef unsigned short bf16_t;
typedef short bf16x8 __attribute__((ext_vector_type(8)));
typedef float f32x4 __attribute__((ext_vector_type(4)));
typedef unsigned u32x4 __attribute__((ext_vector_type(4)));
constexpr int BM = 256, BK = 64, HALF = 128, HTB = HALF * BK * 2  , STAGE_BYTES = 8 * HTB, NXCD = 8, WGM = 8;

__host__ __device__ __forceinline__ int lds_byte(int r, int c) { const int st = (r >> 4) * 2 + (c >> 5), rr = r & 15, cc = c & 31, ob = rr * 64 + cc * 2; return st * 1024 + (ob ^ (((ob >> 9) & 1) << 5)); }
__host__ __device__ __forceinline__ void stage_rc(int b, int& R, int& C) { const int st = b / 1024, sb = b % 1024, swz = sb ^ (((sb >> 9) & 1) << 5); R = (st >> 1) * 16 + swz / 64; C = (st & 1) * 32 + (swz % 64) / 2; }
__host__ __device__ __forceinline__ int perm32(int rho) { const int n = rho >> 4, i = rho & 15; return 8 * (i >> 2) + 4 * n + (i & 3); }

struct Unit { int pm, pn; };
struct Gemm { int lda, ldb, K; };

struct StaticOrder {
    int nM, nN, nwg, G, c;
    __host__ __device__ void init(int M, int N, int G_, int c_) { nM = M / BM; nN = N / BM; nwg = nM * nN; G = G_; c = c_; }
    __host__ __device__ bool next(int i, Unit& u) const {
        const long L = (long)i * G + c; if (L >= nwg) return false;
        int wgid = (int)L; { const int q = nwg / NXCD, r = nwg % NXCD, xcd = wgid % NXCD, off = wgid / NXCD; wgid = (xcd < r ? xcd * (q + 1) : r * (q + 1) + (xcd - r) * q) + off; }
        const int nig = WGM * nN, gid = wgid / nig, fm = gid * WGM, gsz = (nM - fm) < WGM ? (nM - fm) : WGM;
        u.pm = fm + ((wgid % nig) % gsz); u.pn = (wgid % nig) / gsz; return true;
    }
    __device__ __forceinline__ void a_ready(const Unit&) const {}
    __device__ __forceinline__ void done(const Unit&) const {}
};

__device__ __forceinline__ unsigned cvt_pk_bf16(float lo, float hi) { unsigned r; asm volatile("v_cvt_pk_bf16_f32 %0, %1, %2" : "=v"(r) : "v"(lo), "v"(hi)); return r; }
typedef float f32x2 __attribute__((ext_vector_type(2)));
__device__ __forceinline__ f32x2 gelu_pk(f32x2 v) {
    const f32x2 av = __builtin_elementwise_abs(v), d = av * 0.2316418882f + 1.0f;
    f32x2 t; t.x = __builtin_amdgcn_rcpf(d.x); t.y = __builtin_amdgcn_rcpf(d.y);
    f32x2 q = t * 0.5307027145f + (-0.7265760135f); q = q * t + 0.7107068705f; q = q * t + (-0.142248368f); q = q * t + 0.127414796f; q = q * t;
    const f32x2 s = (v * v) * (-0.72134752044f);
    f32x2 e; e.x = __builtin_amdgcn_exp2f(s.x); e.y = __builtin_amdgcn_exp2f(s.y);
    const f32x2 m = v * (q * e), r = v - m;
    f32x2 o; o.x = v.x < 0.f ? m.x : r.x; o.y = v.y < 0.f ? m.y : r.y; return o;
}

template <class Epi, class Sched, bool ALIGN_EPI = false, bool SP2 = false>
__device__ __forceinline__ void gemm_phase(PG8_LAS unsigned char* lds, const Gemm g, const Sched& S, const Epi& E) {
    const int tid = mk_tid(), wid = __builtin_amdgcn_readfirstlane(tid >> 6), lane = tid & 63, wr = wid >> 2, wc = wid & 3, fr = lane & 15, fq = lane >> 4;
    const int K = g.K, nt = K / BK;
    unsigned voffA[2], voffB[2];
#pragma unroll
    for (int i = 0; i < 2; ++i) { int R, C; stage_rc(tid * 16 + i * 8192, R, C); const int Rb = Epi::PERM ? ((R & ~31) + perm32(R & 31)) : R;
        voffA[i] = (unsigned)(R * g.lda + C) * 2u; voffB[i] = (unsigned)(Rb * g.ldb + C) * 2u; }
    const size_t kstep = (size_t)(BK * 2);
    const size_t hstepA = (size_t)HALF * g.lda * 2, hstepB = (size_t)HALF * g.ldb * 2;
    const unsigned ldsw = (unsigned)wid * 1024u;
    const int aoff = lds_byte(wr * 64 + fr, fq * 8), boff = lds_byte(wc * 32 + fr, fq * 8);
#define PG8_SA(b, h) (((b) * 2 + (h)) * HTB)
#define PG8_SB(b, h) ((4 + (b) * 2 + (h)) * HTB)
#define PG8_STAGE(bufoff, gbase, voff) do { _Pragma("unroll") for (int _i = 0; _i < 2; ++_i) \
        __builtin_amdgcn_global_load_lds((const unsigned*)((const char*)(gbase) + (voff)[_i]), (PG8_LAS unsigned*)(lds + (bufoff) + ldsw + _i * 8192), 16, 0, 0); } while (0)
#define PG8_LDA(dst, b, h) do { _Pragma("unroll") for (int m = 0; m < 4; ++m) _Pragma("unroll") for (int k = 0; k < 2; ++k) dst[m][k] = *(const PG8_LAS bf16x8*)(lds + PG8_SA(b, h) + aoff + m * 2048 + k * 1024); } while (0)
#define PG8_LDB(dst, b, h) do { _Pragma("unroll") for (int n = 0; n < 2; ++n) _Pragma("unroll") for (int k = 0; k < 2; ++k) dst[n][k] = *(const PG8_LAS bf16x8*)(lds + PG8_SB(b, h) + boff + n * 2048 + k * 1024); } while (0)
#define PG8_MMA(ai, bj, At, Bt) do { __builtin_amdgcn_s_setprio(1); _Pragma("unroll") for (int m = 0; m < 4; ++m) _Pragma("unroll") for (int n = 0; n < 2; ++n) _Pragma("unroll") for (int k = 0; k < 2; ++k) \
        acc[ai][bj][m][n] = __builtin_amdgcn_mfma_f32_16x16x32_bf16(Bt[n][k], At[m][k], acc[ai][bj][m][n], 0, 0, 0); __builtin_amdgcn_s_setprio(0); } while (0)
#define PG8_WAIT_V(n) asm volatile("s_waitcnt vmcnt(" #n ")" ::: "memory")
#define PG8_WAIT_L(n) asm volatile("s_waitcnt lgkmcnt(" #n ")" ::: "memory")
#define PG8_BAR __builtin_amdgcn_s_barrier()
#define PG8_SCHED __builtin_amdgcn_sched_barrier(0)
    Unit cur, nxt; int ui = 0;
    if (!S.next(0, cur)) return;
    f32x4 acc[2][2][4][2];
#pragma unroll
    for (int a = 0; a < 2; ++a)
#pragma unroll
        for (int b = 0; b < 2; ++b)
#pragma unroll
            for (int m = 0; m < 4; ++m)
#pragma unroll
                for (int n = 0; n < 2; ++n) acc[a][b][m][n] = (f32x4){0.f, 0.f, 0.f, 0.f};
    bf16x8 At[4][2], B0[2][2], B1[2][2];
    const char* cA = S.aptr(cur); const char* cB = S.bptr(cur);
    S.a_ready(cur);
    if constexpr (SP2) {
        PG8_STAGE(PG8_SB(0, 0), cB, voffB); PG8_STAGE(PG8_SB(0, 1), cB + hstepB, voffB); PG8_STAGE(PG8_SA(0, 0), cA, voffA); PG8_STAGE(PG8_SA(0, 1), cA + hstepA, voffA);
        if (wr == 1) PG8_BAR;
        PG8_WAIT_V(2); PG8_BAR;
        PG8_STAGE(PG8_SB(1, 0), cB + kstep, voffB); PG8_STAGE(PG8_SA(1, 0), cA + kstep, voffA); PG8_STAGE(PG8_SB(1, 1), cB + hstepB + kstep, voffB);
        PG8_WAIT_V(6); PG8_BAR;
    } else {
        PG8_STAGE(PG8_SB(0, 0), cB, voffB); PG8_STAGE(PG8_SA(0, 0), cA, voffA); PG8_STAGE(PG8_SB(0, 1), cB + hstepB, voffB); PG8_STAGE(PG8_SA(0, 1), cA + hstepA, voffA);
        if (wr == 1) PG8_BAR;
        PG8_WAIT_V(4); PG8_BAR;
        PG8_STAGE(PG8_SB(1, 0), cB + kstep, voffB); PG8_STAGE(PG8_SA(1, 0), cA + kstep, voffA); PG8_STAGE(PG8_SB(1, 1), cB + hstepB + kstep, voffB);
        PG8_WAIT_V(6); PG8_BAR;
    }
    for (;;) {
        const bool has_next = S.next(ui + 1, nxt);
        const char* nA = has_next ? S.aptr(nxt) : cA; const char* nB = has_next ? S.bptr(nxt) : cB;
        for (int t = 0; t < nt; t += 2) {
            const bool last = (t == nt - 2);
            const char* a1 = cA + (size_t)(t + 1) * kstep;
            const char* a2 = last ? nA : cA + (size_t)(t + 2) * kstep; const char* b2 = last ? nB : cB + (size_t)(t + 2) * kstep;
            const char* a3 = a2 + kstep; const char* b3 = b2 + kstep;
            if (last && has_next) S.a_ready(nxt);
            if constexpr (SP2) {
            PG8_LDB(B0, 0, 0); PG8_LDB(B1, 0, 1); PG8_SCHED; PG8_LDA(At, 0, 0); PG8_STAGE(PG8_SA(1, 1), a1 + hstepA, voffA);
            PG8_WAIT_V(8); PG8_WAIT_L(0); PG8_BAR; PG8_MMA(0, 0, At, B0); PG8_MMA(0, 1, At, B1); PG8_BAR; PG8_SCHED;
            PG8_LDA(At, 0, 1); PG8_STAGE(PG8_SB(0, 0), b2, voffB); PG8_STAGE(PG8_SB(0, 1), b2 + hstepB, voffB); PG8_STAGE(PG8_SA(0, 0), a2, voffA);
            PG8_WAIT_V(8); PG8_WAIT_L(0); PG8_BAR; PG8_MMA(1, 0, At, B0); PG8_MMA(1, 1, At, B1); PG8_BAR; PG8_SCHED;
            PG8_LDB(B0, 1, 0); PG8_LDB(B1, 1, 1); PG8_SCHED; PG8_LDA(At, 1, 0); PG8_STAGE(PG8_SA(0, 1), a2 + hstepA, voffA);
            PG8_WAIT_V(8); PG8_WAIT_L(0); PG8_BAR; PG8_MMA(0, 0, At, B0); PG8_MMA(0, 1, At, B1); PG8_BAR; PG8_SCHED;
            PG8_LDA(At, 1, 1); PG8_STAGE(PG8_SB(1, 0), b3, voffB); PG8_STAGE(PG8_SB(1, 1), b3 + hstepB, voffB); PG8_STAGE(PG8_SA(1, 0), a3, voffA);
            PG8_WAIT_V(8); PG8_WAIT_L(0); PG8_BAR; PG8_MMA(1, 0, At, B0); PG8_MMA(1, 1, At, B1); PG8_BAR; PG8_SCHED;
            } else {
            PG8_LDB(B0, 0, 0); PG8_SCHED; PG8_LDA(At, 0, 0); PG8_STAGE(PG8_SA(1, 1), a1 + hstepA, voffA);
            PG8_WAIT_L(8); PG8_BAR; PG8_WAIT_L(0); PG8_MMA(0, 0, At, B0); PG8_BAR; PG8_SCHED;
            PG8_LDB(B1, 0, 1); PG8_STAGE(PG8_SB(0, 0), b2, voffB);
            PG8_BAR; PG8_WAIT_L(0); PG8_MMA(0, 1, At, B1); PG8_BAR;
            PG8_LDA(At, 0, 1); PG8_STAGE(PG8_SA(0, 0), a2, voffA);
            PG8_BAR; PG8_WAIT_L(0); PG8_MMA(1, 0, At, B0); PG8_BAR; PG8_SCHED;
            PG8_STAGE(PG8_SB(0, 1), b2 + hstepB, voffB);
            PG8_WAIT_V(6); PG8_BAR; PG8_MMA(1, 1, At, B1); PG8_BAR;
            PG8_LDB(B0, 1, 0); PG8_SCHED; PG8_LDA(At, 1, 0); PG8_STAGE(PG8_SA(0, 1), a2 + hstepA, voffA);
            PG8_WAIT_L(8); PG8_BAR; PG8_WAIT_L(0); PG8_MMA(0, 0, At, B0); PG8_BAR; PG8_SCHED;
            PG8_LDB(B1, 1, 1); PG8_STAGE(PG8_SB(1, 0), b3, voffB);
            PG8_BAR; PG8_WAIT_L(0); PG8_MMA(0, 1, At, B1); PG8_BAR;
            PG8_LDA(At, 1, 1); PG8_STAGE(PG8_SA(1, 0), a3, voffA);
            PG8_BAR; PG8_WAIT_L(0); PG8_MMA(1, 0, At, B0); PG8_BAR; PG8_SCHED;
            PG8_STAGE(PG8_SB(1, 1), b3 + hstepB, voffB);
            PG8_WAIT_V(6); PG8_BAR; PG8_MMA(1, 1, At, B1); PG8_BAR;
            }
        }
        if constexpr (ALIGN_EPI) { if (wr == 0) PG8_BAR; }
        if constexpr (!Epi::AFTER_DRAIN) { int fr_ = fr, fq_ = fq; asm volatile("" : "+v"(fr_), "+v"(fq_));   E(acc, cur, wr, wc, fr_, fq_); S.done(cur); }
        if (!has_next) break;
#pragma unroll
        for (int a = 0; a < 2; ++a)
#pragma unroll
            for (int b = 0; b < 2; ++b)
#pragma unroll
                for (int m = 0; m < 4; ++m)
#pragma unroll
                    for (int n = 0; n < 2; ++n) acc[a][b][m][n] = (f32x4){0.f, 0.f, 0.f, 0.f};
        cur = nxt; cA = nA; cB = nB; ++ui;
        if constexpr (ALIGN_EPI) { if (wr == 1) PG8_BAR; }
    }
    PG8_WAIT_V(0);
    if constexpr (!ALIGN_EPI) { if (wr == 0) PG8_BAR; }
    PG8_BAR;
    if constexpr (Epi::AFTER_DRAIN) { E.fused(acc, cur, wr, wc, fr, fq, lds, wid, lane); S.done(cur); }
#undef PG8_SA
#undef PG8_SB
#undef PG8_STAGE
#undef PG8_LDA
#undef PG8_LDB
#undef PG8_MMA
#undef PG8_WAIT_V
#undef PG8_WAIT_L
#undef PG8_BAR
#undef PG8_SCHED
}
}
#include <hip/hip_bf16.h>
#include <cmath>
namespace attn_body {
using bf16=__hip_bfloat16;
using bf16x8=__attribute__((ext_vector_type(8)))short;
using s16x4=__attribute__((ext_vector_type(4)))short;
using f32x16=__attribute__((ext_vector_type(16)))float;
using u32x4=__attribute__((ext_vector_type(4)))unsigned;
constexpr int BATCH=2,NHEAD=16,SEQ=8192,D=64,DM=NHEAD*D;
constexpr int NW=8,QBLK=32,QB=QBLK*NW,KVBLK=64,NQB=SEQ/QB;
constexpr int ATTN_PITCH=DM, ATTN_UNIT_ROWS=QB;
__device__ __forceinline__ int crow(int r,int hi){return (r&3)+8*(r>>2)+4*hi;}
#define SBAR() __builtin_amdgcn_sched_barrier(0)
__device__ __forceinline__ void cmask(f32x16&p0,f32x16&p1,int jb,int qrel,int hi){
  const float NEG=-INFINITY; int kb=64*jb+4*hi;
  #pragma unroll
  for(int r=0;r<16;++r){int kv=kb+(r&3)+8*(r>>2); if(kv>qrel)p0[r]=NEG; if(kv+32>qrel)p1[r]=NEG;}
}

constexpr int NSLOT=3, SLOTB=8192;
constexpr int LDS_K=0, LDS_V=NSLOT*SLOTB, LDS_WS=2*NSLOT*SLOTB, LDS_OST=LDS_WS+NW*64*4, LDS_BYTES=LDS_OST+NW*4096;
constexpr int BIAS_OFF=86016;
constexpr float C2=0.125f*1.4426950408889634f;
__device__ __forceinline__ void glds16(const void*gsrc,unsigned lds_dst){unsigned keep;
  asm volatile("s_mov_b32 %0, m0\n\ts_mov_b32 m0, %2\n\ts_nop 0\n\tglobal_load_lds_dwordx4 %1, off\n\ts_mov_b32 m0, %0":"=&s"(keep):"v"(gsrc),"s"(lds_dst):"memory");}
__device__ __forceinline__ float max3f(float a,float b,float c){float r;asm("v_max3_f32 %0, %1, %2, %3":"=v"(r):"v"(a),"v"(b),"v"(c));return r;}
__device__ __forceinline__ float max2f(float a,float b){float r;asm("v_max_f32_e32 %0, %1, %2":"=v"(r):"v"(a),"v"(b));return r;}
__device__ __forceinline__ float fadd_s(float a,float b){float r;asm("v_add_f32_e32 %0, %1, %2":"=v"(r):"v"(a),"v"(b));return r;}
__device__ __forceinline__ float fsub_s(float a,float b){float r;asm("v_sub_f32_e32 %0, %1, %2":"=v"(r):"v"(a),"v"(b));return r;}
typedef float f32x2_t __attribute__((ext_vector_type(2))); typedef __bf16 bf16x2_t __attribute__((ext_vector_type(2)));
__device__ __forceinline__ unsigned cvtpk_s(float lo,float hi){f32x2_t v={lo,hi};bf16x2_t b=__builtin_convertvector(v,bf16x2_t);return __builtin_bit_cast(unsigned,b);}
#define WAIT_BAR(N) asm volatile("s_waitcnt vmcnt(" #N ") lgkmcnt(0)\n\ts_barrier":::"memory")

__device__ __forceinline__ void qkt(f32x16&p0,f32x16&p1,const char*Kslot,const bf16x8*qr,const f32x16&negm,int r32,int hi){
  const char*kb=Kslot+hi*1024+r32*16;
  #pragma unroll
  for(int d0=0;d0<4;++d0){
    const bf16x8 b0=*reinterpret_cast<const bf16x8*>(kb+d0*2048);
    const bf16x8 b1=*reinterpret_cast<const bf16x8*>(kb+d0*2048+512);
    if(d0==0){p0=__builtin_amdgcn_mfma_f32_32x32x16_bf16(b0,qr[0],negm,0,0,0);p1=__builtin_amdgcn_mfma_f32_32x32x16_bf16(b1,qr[0],negm,0,0,0);}
    else{p0=__builtin_amdgcn_mfma_f32_32x32x16_bf16(b0,qr[d0],p0,0,0,0);p1=__builtin_amdgcn_mfma_f32_32x32x16_bf16(b1,qr[d0],p1,0,0,0);}}
}
typedef __attribute__((address_space(3))) const char* lds_cptr;
typedef short v4i16_t __attribute__((ext_vector_type(4)));
__device__ __forceinline__ void kload8(bf16x8*kf,lds_cptr kp){
  kf[0]=*(const __attribute__((address_space(3))) bf16x8*)(kp);      kf[1]=*(const __attribute__((address_space(3))) bf16x8*)(kp+512);
  kf[2]=*(const __attribute__((address_space(3))) bf16x8*)(kp+2048); kf[3]=*(const __attribute__((address_space(3))) bf16x8*)(kp+2560);
  kf[4]=*(const __attribute__((address_space(3))) bf16x8*)(kp+4096); kf[5]=*(const __attribute__((address_space(3))) bf16x8*)(kp+4608);
  kf[6]=*(const __attribute__((address_space(3))) bf16x8*)(kp+6144); kf[7]=*(const __attribute__((address_space(3))) bf16x8*)(kp+6656);
}
__device__ __forceinline__ void kload2(bf16x8*kf,lds_cptr kp,int j){ kf[2*j]=*(const __attribute__((address_space(3))) bf16x8*)(kp+j*2048); kf[2*j+1]=*(const __attribute__((address_space(3))) bf16x8*)(kp+j*2048+512); }
__device__ __forceinline__ s16x4 vtr(lds_cptr p){ return __builtin_bit_cast(s16x4,__builtin_amdgcn_ds_read_tr16_b64_v4i16((__attribute__((address_space(3))) v4i16_t*)p)); }
__device__ __forceinline__ float rowmax(const f32x16&p0,const f32x16&p1){
  float a=max3f(p0[0],p0[1],p1[0]),b=max3f(p0[2],p0[3],p1[1]);a=max3f(a,p1[2],p1[3]);
  #pragma unroll
  for(int r=4;r<16;r+=4){a=max3f(a,p0[r],p0[r+1]);b=max3f(b,p0[r+2],p0[r+3]);a=max3f(a,p1[r],p1[r+1]);b=max3f(b,p1[r+2],p1[r+3]);}
  const float m=max2f(a,b);
  auto rr=__builtin_amdgcn_permlane32_swap(__float_as_uint(m),__float_as_uint(m),false,false);
  return max2f(__uint_as_float(rr[0]),__uint_as_float(rr[1]));
}
__device__ __forceinline__ void pv(f32x16*o,int vb,bf16x8 pa0,bf16x8 pa1,bf16x8 pa2,bf16x8 pa3){
  #pragma unroll
  for(int d0=0;d0<2;++d0){s16x4 lo[4],hi[4];
    #pragma unroll
    for(int ks=0;ks<4;++ks){
      asm volatile("ds_read_b64_tr_b16 %0,%1 offset:%c2":"=&v"(lo[ks]):"v"(vb),"i"(d0*4096+ks*1024):"memory");
      asm volatile("ds_read_b64_tr_b16 %0,%1 offset:%c2":"=&v"(hi[ks]):"v"(vb),"i"(d0*4096+ks*1024+512):"memory");}
    asm volatile("s_waitcnt lgkmcnt(0)":::"memory");SBAR();
    #define PK(k) (bf16x8){lo[k][0],lo[k][1],lo[k][2],lo[k][3],hi[k][0],hi[k][1],hi[k][2],hi[k][3]}
    o[d0]=__builtin_amdgcn_mfma_f32_32x32x16_bf16(pa0,PK(0),o[d0],0,0,0);
    o[d0]=__builtin_amdgcn_mfma_f32_32x32x16_bf16(pa1,PK(1),o[d0],0,0,0);
    o[d0]=__builtin_amdgcn_mfma_f32_32x32x16_bf16(pa2,PK(2),o[d0],0,0,0);
    o[d0]=__builtin_amdgcn_mfma_f32_32x32x16_bf16(pa3,PK(3),o[d0],0,0,0);
    #undef PK
  }
}

#ifndef ATTN_STORE16
#define ATTN_STORE16(p,v) (*(u32x4*)(p)=(v))
#endif
template<int THRL> __device__ __forceinline__ void attn_unit(int b,int h,int qb,const bf16*Q,const bf16*__restrict__ K,const bf16*__restrict__ V,bf16*O,const float*__restrict__ FBrow,float skip_thr,char*shm){
  const int tid=mk_tid(),lane=tid&63,r32=lane&31,hi=lane>>5; const int wid=__builtin_amdgcn_readfirstlane(tid>>6);
  const long rowbase=(long)b*SEQ; const int q0=qb*QB;
  int t_start=0;
  { const int ntf=(q0+QB)/KVBLK; const float Fq0=FBrow[q0];
    const bool c0=lane<ntf&&(Fq0-FBrow[64*(lane<ntf?lane:0)+63])*1.4426950408889634f<skip_thr;
    const bool c1=(lane+64)<ntf&&(Fq0-FBrow[64*((lane+64)<ntf?lane+64:0)+63])*1.4426950408889634f<skip_thr;
    int cnt=__popcll(__ballot(c0))+__popcll(__ballot(c1)); cnt&=~1; if(cnt>ntf-4)cnt=ntf-4; t_start=__builtin_amdgcn_readfirstlane(cnt); }
  const bf16*Qw=Q+(rowbase+q0+wid*QBLK)*DM+h*D;
  const bf16*Kh=K+(rowbase+(long)t_start*KVBLK)*DM+h*D,*Vh=V+(rowbase+(long)t_start*KVBLK)*DM+h*D;
  const lds_cptr shm3=(lds_cptr)shm;
  const unsigned lds0=(unsigned)(uintptr_t)shm;
  float*wsf=(float*)(shm+LDS_WS)+wid*64;
  const bf16*ksrc=Kh+(long)lane*DM+wid*8;
  const bf16*vsrc=Vh+(long)(16*(wid&3)+(lane>>2))*DM+(wid>>2)*32+(lane&3)*8;
  const unsigned kdst=lds0+LDS_K+wid*1024, vdst=lds0+LDS_V+wid*1024;
  #define DMA_K(t,slot) glds16(ksrc+(long)(t)*KVBLK*DM,(unsigned)__builtin_amdgcn_readfirstlane(kdst+(slot)))
  #define DMA_V(t,slot) glds16(vsrc+(long)(t)*KVBLK*DM,(unsigned)__builtin_amdgcn_readfirstlane(vdst+(slot)))
  const int vb0=(int)(lds0+LDS_V)+((lane>>4)&1)*32+(lane&3)*8+(4*hi+((lane&15)>>2))*64;
  const char*Kbase=shm+LDS_K; bf16x8 kf[8];
  const lds_cptr kp0=shm3+LDS_K+hi*1024+r32*16; const lds_cptr vp0=shm3+LDS_V+((lane>>4)&1)*32+(lane&3)*8+(4*hi+((lane&15)>>2))*64;
  const int NT=(q0+QB)/KVBLK-t_start;
  {
    typedef __attribute__((address_space(3))) float lds_f32; lds_f32* bl=(lds_f32*)(shm3+BIAS_OFF);
    const int nb=q0+QB; const float Fl=FBrow[nb-1];
    for(int i=t_start*KVBLK+tid;i<nb;i+=NW*64) bl[i]=(Fl-FBrow[i])*1.4426950408889634f;
    asm volatile("s_waitcnt vmcnt(0) lgkmcnt(0)\n\ts_barrier":::"memory"); }
  typedef float f32x4v __attribute__((ext_vector_type(4)));
  #define BIAS(P0,P1,t) do{ const __attribute__((address_space(3))) f32x4v* bp_=(const __attribute__((address_space(3))) f32x4v*)(shm3+BIAS_OFF)+((t)+t_start)*16+hi; \
    _Pragma("unroll") for(int g_=0;g_<4;++g_){ const f32x4v f0_=bp_[2*g_]+nm, f1_=bp_[8+2*g_]+nm; \
      P0[4*g_]+=f0_[0];P0[4*g_+1]+=f0_[1];P0[4*g_+2]+=f0_[2];P0[4*g_+3]+=f0_[3]; P1[4*g_]+=f1_[0];P1[4*g_+1]+=f1_[1];P1[4*g_+2]+=f1_[2];P1[4*g_+3]+=f1_[3]; } }while(0)
  DMA_K(0,0);DMA_V(0,0);DMA_K(1,SLOTB);
  bf16x8 qr[4];
  #pragma unroll
  for(int d0=0;d0<4;++d0)qr[d0]=*reinterpret_cast<const bf16x8*>(&Qw[(long)r32*DM+d0*16+hi*8]);
  float mhat=0.f,l_reg=0.f;f32x16 o[2];o[0]=f32x16{};o[1]=f32x16{};const f32x16 negm=f32x16{}; float nm=0.f;
  const int qrel=wid*QBLK+r32;
  #define CMASK(P0,P1,t) do{int jb_=(t)-(NT-4); if(jb_>=0)cmask(P0,P1,jb_,qrel,hi);}while(0)
  bool resc=false;
  #define START(P0,P1) do{ const float rm=rowmax(P0,P1); resc=false; \
    { const float dl=rm; mhat=fadd_s(mhat,dl); \
      _Pragma("unroll") for(int r=0;r<16;++r){P0[r]=fsub_s(P0[r],dl);P1[r]=fsub_s(P1[r],dl);} \
      nm=-mhat; } \
    _Pragma("unroll") for(int r=0;r<16;++r)P0[r]=__builtin_amdgcn_exp2f(P0[r]); }while(0)
  #define RESC() do{ if(resc){ asm volatile("s_waitcnt lgkmcnt(0)":::"memory"); \
      _Pragma("unroll") for(int d_=0;d_<2;++d_) _Pragma("unroll") for(int r=0;r<16;++r)o[d_][r]*=wsf[crow(r,hi)]; } }while(0)
  f32x16 pA0,pA1,pB0,pB1;
  int sl_prev=0,sl_cur=0,sl_next=SLOTB;
  #define ROT() do{sl_prev=sl_cur;sl_cur=sl_next;sl_next=(sl_next==(NSLOT-1)*SLOTB)?0:sl_next+SLOTB;}while(0)
  DMA_K(2,2*SLOTB);
  WAIT_BAR(3);
  qkt(pA0,pA1,Kbase,qr,negm,r32,hi);asm volatile("s_nop 15\n\ts_nop 7":"+v"(pA0),"+v"(pA1));BIAS(pA0,pA1,0);CMASK(pA0,pA1,0);
  START(pA0,pA1);
  _Pragma("unroll") for(int r=0;r<16;++r)pA1[r]=__builtin_amdgcn_exp2f(pA1[r]);
  WAIT_BAR(0);
  DMA_K(3,0);DMA_V(1,SLOTB);
  ROT();
  kload8(kf,kp0+sl_cur);
  WAIT_BAR(2);
  s16x4 vlo[8],vhi[8]; u32x4 pw0,pw1,pw2,pw3;
  #define PKW(P,B) cvtpk_s(P[B],P[B+1])
  #define PAF(k) __builtin_bit_cast(bf16x8,pw##k)
  #define VFR(i) (bf16x8){vlo[i][0],vlo[i][1],vlo[i][2],vlo[i][3],vhi[i][0],vhi[i][1],vhi[i][2],vhi[i][3]}
  #define PIN(x) asm volatile("":"+v"(x))
  #define MX3(a,b,c) __builtin_fmaxf(__builtin_fmaxf((a),(b)),(c))
  #define GAPA(MF,A0,A1,A2,A3,W0,W1,PW) do{ MF; sacc+=A0; sacc+=A1; sacc+=A2; sacc+=A3; PIN(sacc); W0; W1; PIN(PW); SBAR(); }while(0)
  #define EX(v) __builtin_amdgcn_exp2f(v)
  #define GAPB(MF,X,B) do{ MF; X[B]=EX(X[B]); X[B+1]=EX(X[B+1]); X[B+2]=EX(X[B+2]); X[B+3]=EX(X[B+3]); PIN(X); SBAR(); }while(0)
  #define VRD(i) do{ vlo[i]=vtr(vp_+(((i)>>2)*4096+((i)&3)*1024)); vhi[i]=vtr(vp_+(((i)>>2)*4096+((i)&3)*1024+512)); }while(0)
  #define KRD(G,j) do{ if(G){ kload2(kf,kp0+sl_next,j); SBAR(); } }while(0)
  #define STEP(C0,C1,P0,P1,t,GK,GV,GL) do{ SBAR(); \
    const lds_cptr vp_=vp0+sl_prev; \
    VRD(0); SBAR(); float sacc=(P0[0]+P0[1]); \
    GAPA(C0=__builtin_amdgcn_mfma_f32_32x32x16_bf16(kf[0],qr[0],negm,0,0,0), P0[2],P0[3],P0[4],P0[5],     pw0[0]=PKW(P0,0), pw0[1]=PKW(P0,2), pw0); \
    VRD(4); SBAR(); GAPA(C1=__builtin_amdgcn_mfma_f32_32x32x16_bf16(kf[1],qr[0],negm,0,0,0), P0[6],P0[7],P0[8],P0[9],     pw0[2]=PKW(P0,4), pw0[3]=PKW(P0,6), pw0); \
    VRD(1); SBAR(); GAPA(C0=__builtin_amdgcn_mfma_f32_32x32x16_bf16(kf[2],qr[1],C0,0,0,0),   P0[10],P0[11],P0[12],P0[13], pw1[0]=PKW(P0,8), pw1[1]=PKW(P0,10), pw1); \
    VRD(5); SBAR(); GAPA(C1=__builtin_amdgcn_mfma_f32_32x32x16_bf16(kf[3],qr[1],C1,0,0,0),   P0[14],P0[15],P1[0],P1[1],   pw1[2]=PKW(P0,12),pw1[3]=PKW(P0,14), pw1); \
    VRD(2); SBAR(); GAPA(C0=__builtin_amdgcn_mfma_f32_32x32x16_bf16(kf[4],qr[2],C0,0,0,0),   P1[2],P1[3],P1[4],P1[5],     pw2[0]=PKW(P1,0), pw2[1]=PKW(P1,2), pw2); \
    VRD(6); SBAR(); GAPA(C1=__builtin_amdgcn_mfma_f32_32x32x16_bf16(kf[5],qr[2],C1,0,0,0),   P1[6],P1[7],P1[8],P1[9],     pw2[2]=PKW(P1,4), pw2[3]=PKW(P1,6), pw2); \
    VRD(3); SBAR(); GAPA(C0=__builtin_amdgcn_mfma_f32_32x32x16_bf16(kf[6],qr[3],C0,0,0,0),   P1[10],P1[11],P1[12],P1[13], pw3[0]=PKW(P1,8), pw3[1]=PKW(P1,10), pw3); \
    VRD(7); SBAR(); GAPA(C1=__builtin_amdgcn_mfma_f32_32x32x16_bf16(kf[7],qr[3],C1,0,0,0),   P1[14],P1[15],0.f,0.f,       pw3[2]=PKW(P1,12),pw3[3]=PKW(P1,14), pw3); \
    l_reg+=sacc; \
    if(GK){DMA_K((t)+3,sl_cur);} if(GV){DMA_V((t)+1,sl_next);} \
    BIAS(C0,C1,t); CMASK(C0,C1,t); \
    { float a=MX3(C0[0],C0[1],C1[0]),b=MX3(C0[2],C0[3],C1[1]); a=MX3(a,C1[2],C1[3]); \
      _Pragma("unroll") for(int r=4;r<16;r+=4){a=MX3(a,C0[r],C0[r+1]);b=MX3(b,C0[r+2],C0[r+3]);a=MX3(a,C1[r],C1[r+1]);b=MX3(b,C1[r+2],C1[r+3]);} \
      float rm=__builtin_fmaxf(a,b); { auto rr=__builtin_amdgcn_permlane32_swap(__float_as_uint(rm),__float_as_uint(rm),false,false); rm=__builtin_fmaxf(__uint_as_float(rr[0]),__uint_as_float(rr[1])); } \
      resc=false; \
      if(__builtin_expect(__any(rm>(float)THRL),0)){ const float dl=__builtin_fmaxf(rm,0.f); mhat+=dl; \
        _Pragma("unroll") for(int r=0;r<16;++r){C0[r]-=dl;C1[r]-=dl;} \
        nm=-mhat; \
        const float f=__builtin_amdgcn_exp2f(-dl); l_reg*=f; if(hi==0)wsf[r32]=f; resc=true; } } \
    SBAR(); \
    GAPB(o[0]=__builtin_amdgcn_mfma_f32_32x32x16_bf16(PAF(0),VFR(0),o[0],0,0,0), C0,0); \
    GAPB(o[1]=__builtin_amdgcn_mfma_f32_32x32x16_bf16(PAF(0),VFR(4),o[1],0,0,0), C0,4); \
    KRD(GL,0); GAPB(o[0]=__builtin_amdgcn_mfma_f32_32x32x16_bf16(PAF(1),VFR(1),o[0],0,0,0), C0,8); \
    KRD(GL,1); GAPB(o[1]=__builtin_amdgcn_mfma_f32_32x32x16_bf16(PAF(1),VFR(5),o[1],0,0,0), C0,12); \
    KRD(GL,2); GAPB(o[0]=__builtin_amdgcn_mfma_f32_32x32x16_bf16(PAF(2),VFR(2),o[0],0,0,0), C1,0); \
    KRD(GL,3); GAPB(o[1]=__builtin_amdgcn_mfma_f32_32x32x16_bf16(PAF(2),VFR(6),o[1],0,0,0), C1,4); \
    GAPB(o[0]=__builtin_amdgcn_mfma_f32_32x32x16_bf16(PAF(3),VFR(3),o[0],0,0,0), C1,8); \
    GAPB(o[1]=__builtin_amdgcn_mfma_f32_32x32x16_bf16(PAF(3),VFR(7),o[1],0,0,0), C1,12); \
    }while(0)
  int t=1;
  #undef CMASK
  #define CMASK(P0,P1,t) do{}while(0)
  for(;t+5<NT;t+=2){
    STEP(pB0,pB1,pA0,pA1,t,true,true,true);     WAIT_BAR(2); RESC(); ROT();
    STEP(pA0,pA1,pB0,pB1,t+1,true,true,true);   WAIT_BAR(2); RESC(); ROT();
  }
  #undef CMASK
  #define CMASK(P0,P1,t) do{int jb_=(t)-(NT-4); if(jb_>=0)cmask(P0,P1,jb_,qrel,hi);}while(0)
  #define ENDW(tt) do{ if((tt)+3<NT){WAIT_BAR(2);} else if((tt)+2<NT){WAIT_BAR(1);} else {WAIT_BAR(0);} }while(0)
  for(;t+1<NT;t+=2){
    STEP(pB0,pB1,pA0,pA1,t,(t+3<NT),(t+1<NT),(t+1<NT));       ENDW(t);   RESC(); ROT();
    STEP(pA0,pA1,pB0,pB1,t+1,(t+4<NT),(t+2<NT),(t+2<NT));     ENDW(t+1); RESC(); ROT();
  }
  STEP(pB0,pB1,pA0,pA1,NT-1,false,false,false); RESC();
  { float sacc=pB0[0]+pB0[1]; _Pragma("unroll") for(int r=2;r<16;++r)sacc+=pB0[r]; _Pragma("unroll") for(int r=0;r<16;++r)sacc+=pB1[r]; l_reg+=sacc;
    pw0=(u32x4){PKW(pB0,0),PKW(pB0,2),PKW(pB0,4),PKW(pB0,6)};pw1=(u32x4){PKW(pB0,8),PKW(pB0,10),PKW(pB0,12),PKW(pB0,14)};pw2=(u32x4){PKW(pB1,0),PKW(pB1,2),PKW(pB1,4),PKW(pB1,6)};pw3=(u32x4){PKW(pB1,8),PKW(pB1,10),PKW(pB1,12),PKW(pB1,14)};
    SBAR(); pv(o,vb0+sl_cur,PAF(0),PAF(1),PAF(2),PAF(3)); }
  #undef PKW
  #undef PAF
  #undef VFR
  #undef PIN
  #undef MX3
  #undef GAPA
  #undef GAPB
  #undef EX
  #undef VRD
  #undef KRD
  #undef STEP
  #undef ENDW
  {auto rr=__builtin_amdgcn_permlane32_swap(__float_as_uint(l_reg),__float_as_uint(l_reg),false,false);l_reg=__uint_as_float(rr[0])+__uint_as_float(rr[1]);}
  if(hi==0)wsf[32+r32]=l_reg;asm volatile("s_waitcnt lgkmcnt(0)":::"memory");
  float rli[16];
  #pragma unroll
  for(int r=0;r<16;++r)rli[r]=__builtin_amdgcn_rcpf(wsf[32+crow(r,hi)]);
  bf16*Ow=O+(rowbase+q0+wid*QBLK)*DM+h*D;
  { bf16*stg=(bf16*)(shm+LDS_OST)+wid*2048;
    #pragma unroll
    for(int r=0;r<16;++r){const int orow=crow(r,hi);
      #pragma unroll
      for(int d0=0;d0<2;++d0)stg[orow*64+d0*32+r32]=__float2bfloat16(o[d0][r]*rli[r]);}
    asm volatile("s_waitcnt lgkmcnt(0)":::"memory");
    #pragma unroll
    for(int i=0;i<4;++i){const int row=i*8+(lane>>3),ch=lane&7; const u32x4 v=*(const u32x4*)(stg+row*64+ch*8); ATTN_STORE16(Ow+(long)row*DM+ch*8,v);} }
  asm volatile("s_waitcnt lgkmcnt(0)\n\ts_barrier":::"memory");
  #undef BIAS
  #undef DMA_K
  #undef DMA_V
  #undef CMASK
  #undef START
  #undef RESC
  #undef ROT
}
constexpr int ATTN_LDS_BYTES=86016+32768;
struct AttnTensors { const bf16* Q; const bf16* K; const bf16* V; bf16* O; const float* FB; float skip_thr; int pad; };
struct AttnUnit { int bh; int qb; };
struct StaticOrder {
  int vcu;
  __device__ __forceinline__ explicit StaticOrder(int grid,int block):vcu((block%8)*(grid/8)+block/8){}
  __device__ __forceinline__ bool next(int i,AttnUnit&u)const{ if(i>=4)return false; const int s=vcu&7; u.bh=vcu>>3; u.qb=(i==0)?s:(i==1)?15-s:(i==2)?16+s:31-s; return true; }
  __device__ __forceinline__ void a_ready(const AttnUnit&)const{}
  __device__ __forceinline__ void done(const AttnUnit&)const{}
};
struct QueueOrder {
  unsigned* ctr; int xl; volatile __attribute__((address_space(3))) int* slot;
  __device__ __forceinline__ bool next(int,AttnUnit&u)const{
    if(mk_tid()==0){ int got=-1;
      for(int k=0;k<8&&got<0;++k){ const int q=(xl+k)&7; const int j=(int)__hip_atomic_fetch_add(ctr+q*64,1u,__ATOMIC_RELAXED,__HIP_MEMORY_SCOPE_AGENT); if(j<128)got=q*128+j; }
      *slot=got; }
    __syncthreads(); const int g=*slot; if(g<0)return false; const int q=g>>7,j=g&127; u.bh=q*4+(j&3); u.qb=31-(j>>2); return true; }
  __device__ __forceinline__ void a_ready(const AttnUnit&)const{}
  __device__ __forceinline__ void done(const AttnUnit&)const{}
};
template<class Sched,int THRL=8> __device__ __forceinline__ void attn_phase(char*lds,const AttnTensors&T,const Sched&S){
  AttnUnit u;
  for(int i=0;S.next(i,u);++i){ S.a_ready(u); attn_unit<THRL>(u.bh/NHEAD,u.bh%NHEAD,u.qb,T.Q,T.K,T.V,T.O,T.FB+(size_t)u.bh*SEQ,T.skip_thr,lds); S.done(u); }
}
#undef SBAR
#undef WAIT_BAR
}
namespace cg = cooperative_groups;
#define LAS __attribute__((address_space(3)))
#define LDS_WAIT() asm volatile("s_waitcnt lgkmcnt(0)" ::: "memory")
constexpr int MEGA_THREADS = 512, MEGA_LDS = 147456, NWV = 8;
#define GAS __attribute__((address_space(1)))
#define XB_TMO      128
#define XB_XCNT(j)  (256  + 64 * (j))
#define XB_XSUB(j)  (1280 + 64 * (j))
#define XB_XGEN(j)  (2304 + 64 * (j))
#define XB_TOP      3328
#define XB_TOPGEN   3392
#define XCD_BAR_WORDS 3456
#define XB_SPIN_CAP (1u << 18)

__device__ __forceinline__ unsigned xb_ld(unsigned* p)              { return __hip_atomic_load(p, __ATOMIC_RELAXED, __HIP_MEMORY_SCOPE_AGENT); }
__device__ __forceinline__ unsigned xb_add(unsigned* p, unsigned v) { return __hip_atomic_fetch_add(p, v, __ATOMIC_RELAXED, __HIP_MEMORY_SCOPE_AGENT); }
__device__ __forceinline__ unsigned xb_xcc_id() { return (unsigned)__builtin_amdgcn_s_getreg((3 << 11) | 20) & 0xFu; }
#define XB_SPIN(cond, bar) do { unsigned _sp = 0; while (cond) { __builtin_amdgcn_s_sleep(1); \
    if ((++_sp & 255u) == 0u) { if (xb_ld(&(bar)[XB_TMO])) break; if (_sp > XB_SPIN_CAP) { atomicAdd(&(bar)[XB_TMO], 1u); break; } } } } while (0)

struct XcdBarrier {
    unsigned* bar; unsigned x;
    volatile LAS unsigned* st;
};

__device__ __forceinline__ XcdBarrier xcd_barrier_post(unsigned* bar, volatile LAS unsigned* st) {
    XcdBarrier b; b.bar = bar; b.x = xb_xcc_id(); b.st = st;
    if (threadIdx.x == 0) (void)xb_add(&bar[XB_XCNT(b.x)], 1u);
    return b;
}
__device__ __forceinline__ void xcd_barrier_complete(unsigned* bar, unsigned x, unsigned& nloc, unsigned& nx) {
    const unsigned G = gridDim.x * gridDim.y * gridDim.z;
    unsigned sum, cnt, mine, sp = 0u;
    for (;;) {
        sum = 0u; cnt = 0u; mine = 0u;
#pragma unroll
        for (unsigned j = 0; j < 16; ++j) { const unsigned c = xb_ld(&bar[XB_XCNT(j)]); sum += c; cnt += (c > 0u) ? 1u : 0u; mine = (j == x) ? c : mine; }
        if (sum == G) break;
        __builtin_amdgcn_s_sleep(1);
        if ((++sp & 255u) == 0u) { if (xb_ld(&bar[XB_TMO])) break; if (sp > XB_SPIN_CAP) { atomicAdd(&bar[XB_TMO], 1u); break; } }
    }
    nloc = mine > 0u ? mine : 1u; nx = cnt > 0u ? cnt : 1u;
}

__device__ __forceinline__ void xcd_barrier(const XcdBarrier& b) {
    asm volatile("s_waitcnt vmcnt(0)" ::: "memory");
    __syncthreads();
    if (threadIdx.x == 0) {
        unsigned* bar = b.bar;
        __builtin_amdgcn_s_waitcnt(0);
        unsigned nloc = b.st[0], nx = b.st[1];
        if (nloc == 0u) { xcd_barrier_complete(bar, b.x, nloc, nx); b.st[0] = nloc; b.st[1] = nx; }
        const unsigned old = xb_add(&bar[XB_XSUB(b.x)], 1u);
        const unsigned gen = old / nloc;
        if (old + 1u == (gen + 1u) * nloc) {
            __builtin_amdgcn_fence(__ATOMIC_RELEASE, "agent");
            asm volatile("s_waitcnt vmcnt(0)" ::: "memory");
            const unsigned og = xb_add(&bar[XB_TOP], 1u);
            const unsigned tg = og / nx;
            if (og + 1u == (tg + 1u) * nx) xb_add(&bar[XB_TOPGEN], 1u);
            else XB_SPIN(xb_ld(&bar[XB_TOPGEN]) == tg, bar);
            __builtin_amdgcn_fence(__ATOMIC_ACQUIRE, "agent");
            xb_add(&bar[XB_XGEN(b.x)], 1u);
            asm volatile("s_waitcnt vmcnt(0)" ::: "memory");
        } else {
            XB_SPIN(xb_ld(&bar[XB_XGEN(b.x)]) == gen, bar);
            __builtin_amdgcn_fence(__ATOMIC_ACQUIRE, "agent");
            asm volatile("s_waitcnt vmcnt(0)" ::: "memory");
        }
    }
    __syncthreads();
}
constexpr size_t WS_BAR = WS_CTL + 16384;
constexpr size_t WS_QCTR = WS_CTL + 32768;
constexpr size_t CTL_ZERO_BYTES = 65536 - 16384;
constexpr int XB_LDS_OFF = MEGA_LDS - 64;
constexpr size_t WT_IN = 0;
constexpr size_t WT_BR = WT_IN + (size_t)13312 * 1024 * 2;
constexpr size_t WT_OUT = WT_BR + (size_t)4096 * 1024 * 2;
constexpr size_t WT_UP = WT_OUT + (size_t)1024 * 1024 * 2;
constexpr size_t WT_DN = WT_UP + (size_t)5632 * 1024 * 2;
static_assert(WT_DN + (size_t)1024 * 2816 * 2 <= 72 * MiB, "weight copies");
constexpr size_t WS_WKVT = WS_GATES;
constexpr size_t WS_CB = WS_CTL + 4096;

typedef float f32x4 __attribute__((ext_vector_type(4)));
typedef unsigned u32x4 __attribute__((ext_vector_type(4)));
typedef short bf16x8_t __attribute__((ext_vector_type(8)));
typedef float f32x16_t __attribute__((ext_vector_type(16)));
__device__ __forceinline__ unsigned pk2(float lo, float hi) { return (unsigned)f2bf(lo) | ((unsigned)f2bf(hi) << 16); }
__device__ __forceinline__ float blo(unsigned u) { return __uint_as_float(u << 16); }
__device__ __forceinline__ float bhi(unsigned u) { return __uint_as_float(u & 0xffff0000u); }
__device__ __forceinline__ float fast_softplus(float x) { return fmaxf(x, 0.f) + __logf(1.f + __expf(-fabsf(x))); }
__device__ __forceinline__ float fast_sigmoid(float x) { return __builtin_amdgcn_rcpf(1.f + __expf(-x)); }
__device__ __forceinline__ float fast_tanh(float x) { const float e = __expf(-2.f * fabsf(x)); const float t = (1.f - e) * __builtin_amdgcn_rcpf(1.f + e); return x < 0.f ? -t : t; }
__device__ __forceinline__ float fast_gelu(float x) { const float u = 0.7978845608028654f * (x + 0.044715f * x * x * x); return 0.5f * x * (1.f + fast_tanh(u)); }

template <class Loc> struct LocOrder {
    pg8::StaticOrder so; Loc loc;
    __device__ __forceinline__ bool next(int i, pg8::Unit& u) const { return so.next(i, u); }
    __device__ __forceinline__ const char* aptr(const pg8::Unit& u) const { return loc.a(u); }
    __device__ __forceinline__ const char* bptr(const pg8::Unit& u) const { return loc.b(u); }
    __device__ __forceinline__ void a_ready(const pg8::Unit&) const {}
    __device__ __forceinline__ void done(const pg8::Unit&) const {}
};
struct LocStd { const char* A; const char* Bt; size_t astep, bstep;
    __device__ __forceinline__ const char* a(const pg8::Unit& u) const { return A + (size_t)u.pm * astep; }
    __device__ __forceinline__ const char* b(const pg8::Unit& u) const { return Bt + (size_t)u.pn * bstep; } };
struct LocBranch { const char* Y0; const char* Y1; const char* Y2; const char* Y3; const char* Bt;
    __device__ __forceinline__ const char* a(const pg8::Unit& u) const { const int i = u.pn >> 2; const char* y = i == 0 ? Y0 : i == 1 ? Y1 : i == 2 ? Y2 : Y3; return y + (size_t)u.pm * (256 * 1024 * 2); }
    __device__ __forceinline__ const char* b(const pg8::Unit& u) const { return Bt + (size_t)u.pn * (256 * 1024 * 2); } };
struct LocMemKV { const char* A; const char* Bt;
    __device__ __forceinline__ const char* a(const pg8::Unit& u) const { return A + (size_t)u.pm * (256 * 1024 * 2); }
    __device__ __forceinline__ const char* b(const pg8::Unit& u) const { return Bt + ((size_t)(u.pm >> 1) * 2048 + (size_t)u.pn * 256) * 2048; } };
struct LocMemS { const char* MQ; const char* MK;
    __device__ __forceinline__ const char* a(const pg8::Unit& u) const { return MQ + (size_t)u.pm * (256 * 2048) + u.pn * 512; }
    __device__ __forceinline__ const char* b(const pg8::Unit& u) const { return MK + (size_t)(u.pm >> 5) * (256 * 2048) + u.pn * 512; } };
struct LocMemPV { const char* E; const char* MVT;
    __device__ __forceinline__ const char* a(const pg8::Unit& u) const { return E + (size_t)u.pm * (256 * 2048) + u.pn * 512; }
    __device__ __forceinline__ const char* b(const pg8::Unit& u) const { return MVT + ((size_t)(u.pm >> 5) * 4 + u.pn) * (256 * 256 * 2); } };

struct BranchSched { int vcu; LocBranch loc;
    __device__ __forceinline__ bool next(int i, pg8::Unit& u) const { if (i >= 4) return false; u.pm = vcu >> 2; u.pn = i * 4 + (vcu & 3); return true; }
    __device__ __forceinline__ const char* aptr(const pg8::Unit& u) const { return loc.a(u); }
    __device__ __forceinline__ const char* bptr(const pg8::Unit& u) const { return loc.b(u); }
    __device__ __forceinline__ void a_ready(const pg8::Unit&) const {}
    __device__ __forceinline__ void done(const pg8::Unit&) const {}
};
typedef f32x4 AccT[2][2][4][2];
struct EpiProj { static constexpr bool PERM = true, AFTER_DRAIN = false; bf16_t* proj; bf16_t* gates; float* mqss;
    __device__ __forceinline__ void operator()(const AccT& acc, const pg8::Unit& u, int wr, int wc, int fr, int fq) const {
        int colt = u.pn * 256; const int grp = colt >> 10; bf16_t* base; int ldc;
        if (grp < 9) { base = proj + (size_t)grp * T * DM; ldc = DM; colt &= 1023; } else { base = gates; ldc = 4096; colt -= 9216; }
        const int row0 = u.pm * 256 + wr * 64 + fr, col0 = colt + wc * 32 + 8 * fq;
#pragma unroll
        for (int ai = 0; ai < 2; ++ai)
#pragma unroll
            for (int m = 0; m < 4; ++m) { const int row = row0 + ai * 128 + m * 16; bf16_t* rowp = base + (size_t)row * ldc + col0; float ss = 0.f;
#pragma unroll
                for (int bj = 0; bj < 2; ++bj) { const f32x4 v0 = acc[ai][bj][m][0], v1 = acc[ai][bj][m][1]; u32x4 w; w.x = pk2(v0[0], v0[1]); w.y = pk2(v0[2], v0[3]); w.z = pk2(v1[0], v1[1]); w.w = pk2(v1[2], v1[3]);
                    *(u32x4*)(rowp + bj * 128) = w;
                    if (grp == 8) { ss += blo(w.x) * blo(w.x) + bhi(w.x) * bhi(w.x) + blo(w.y) * blo(w.y) + bhi(w.y) * bhi(w.y) + blo(w.z) * blo(w.z) + bhi(w.z) * bhi(w.z) + blo(w.w) * blo(w.w) + bhi(w.w) * bhi(w.w); } }
                if (grp == 8) { ss += __shfl_xor(ss, 16); ss += __shfl_xor(ss, 32); if (fq == 0) mqss[(size_t)row * 16 + (colt >> 8) * 4 + wc] = ss; } }
    } };
struct EpiBf16P { static constexpr bool PERM = true, AFTER_DRAIN = false; bf16_t* O; int ldc; int pad;
    __device__ __forceinline__ void operator()(const AccT& acc, const pg8::Unit& u, int wr, int wc, int fr, int fq) const {
        const int row0 = u.pm * 256 + wr * 64 + fr, col0 = u.pn * 256 + wc * 32 + 8 * fq;
#pragma unroll
        for (int ai = 0; ai < 2; ++ai)
#pragma unroll
            for (int m = 0; m < 4; ++m) { bf16_t* rowp = O + (size_t)(row0 + ai * 128 + m * 16) * ldc + col0;
#pragma unroll
                for (int bj = 0; bj < 2; ++bj) { const f32x4 v0 = acc[ai][bj][m][0], v1 = acc[ai][bj][m][1]; u32x4 w; w.x = pk2(v0[0], v0[1]); w.y = pk2(v0[2], v0[3]); w.z = pk2(v1[0], v1[1]); w.w = pk2(v1[2], v1[3]);
                    *(u32x4*)(rowp + bj * 128) = w; } }
    } };
struct EpiF32 { static constexpr bool PERM = false, AFTER_DRAIN = false; float* O; int ldc; int pad;
    __device__ __forceinline__ void operator()(const AccT& acc, const pg8::Unit& u, int wr, int wc, int fr, int fq) const {
        const int row0 = u.pm * 256 + wr * 64 + fr, col0 = u.pn * 256 + wc * 32 + 4 * fq;
#pragma unroll
        for (int ai = 0; ai < 2; ++ai)
#pragma unroll
            for (int m = 0; m < 4; ++m) { float* rowp = O + (size_t)(row0 + ai * 128 + m * 16) * ldc + col0;
#pragma unroll
                for (int bj = 0; bj < 2; ++bj)
#pragma unroll
                    for (int n = 0; n < 2; ++n) *(f32x4*)(rowp + bj * 128 + n * 16) = acc[ai][bj][m][n]; }
    } };
struct EpiResid { static constexpr bool PERM = false, AFTER_DRAIN = false; const float* base; float* out;
    __device__ __forceinline__ void operator()(const AccT& acc, const pg8::Unit& u, int wr, int wc, int fr, int fq) const {
        const int row0 = u.pm * 256 + wr * 64 + fr, col0 = u.pn * 256 + wc * 32 + 4 * fq;
#pragma unroll
        for (int ai = 0; ai < 2; ++ai)
#pragma unroll
            for (int m = 0; m < 4; ++m) { const size_t off = (size_t)(row0 + ai * 128 + m * 16) * DM + col0;
#pragma unroll
                for (int bj = 0; bj < 2; ++bj)
#pragma unroll
                    for (int n = 0; n < 2; ++n) { const f32x4 b = *(const f32x4*)(base + off + bj * 128 + n * 16); *(f32x4*)(out + off + bj * 128 + n * 16) = b + acc[ai][bj][m][n]; } }
    } };
struct EpiBranch { static constexpr bool PERM = true, AFTER_DRAIN = false; const bf16_t* G; const float* bg; float* MIXF; bf16_t* MIXED;
    __device__ __forceinline__ void operator()(const AccT& acc, const pg8::Unit& u, int wr, int wc, int fr, int fq) const {
        const int i = u.pn >> 2, row0 = u.pm * 256 + wr * 64 + fr, gcol0 = u.pn * 256 + wc * 32 + 8 * fq, mcol0 = (u.pn & 3) * 256 + wc * 32 + 8 * fq;
#pragma unroll
        for (int ai = 0; ai < 2; ++ai)
#pragma unroll
            for (int m = 0; m < 4; ++m) { const int row = row0 + ai * 128 + m * 16; const bf16_t* gp = G + (size_t)row * 4096 + gcol0; const size_t mo = (size_t)row * DM + mcol0;
#pragma unroll
                for (int bj = 0; bj < 2; ++bj) { const u32x4 gw = *(const u32x4*)(gp + bj * 128); const f32x4 b0 = *(const f32x4*)(bg + gcol0 + bj * 128), b1 = *(const f32x4*)(bg + gcol0 + bj * 128 + 4);
                    f32x4 v0 = acc[ai][bj][m][0], v1 = acc[ai][bj][m][1];
                    v0[0] *= fast_sigmoid(blo(gw.x) + b0[0]); v0[1] *= fast_sigmoid(bhi(gw.x) + b0[1]); v0[2] *= fast_sigmoid(blo(gw.y) + b0[2]); v0[3] *= fast_sigmoid(bhi(gw.y) + b0[3]);
                    v1[0] *= fast_sigmoid(blo(gw.z) + b1[0]); v1[1] *= fast_sigmoid(bhi(gw.z) + b1[1]); v1[2] *= fast_sigmoid(blo(gw.w) + b1[2]); v1[3] *= fast_sigmoid(bhi(gw.w) + b1[3]);
                    if (i > 0) { v0 += *(const f32x4*)(MIXF + mo + bj * 128); v1 += *(const f32x4*)(MIXF + mo + bj * 128 + 4); }
                    if (i < 3) { *(f32x4*)(MIXF + mo + bj * 128) = v0; *(f32x4*)(MIXF + mo + bj * 128 + 4) = v1; }
                    else { u32x4 w; w.x = pk2(v0[0], v0[1]); w.y = pk2(v0[2], v0[3]); w.z = pk2(v1[0], v1[1]); w.w = pk2(v1[2], v1[3]); *(u32x4*)(MIXED + mo + bj * 128) = w; } }
                asm volatile("" ::: "memory"); }
    } };
struct EpiSexp { static constexpr bool PERM = true, AFTER_DRAIN = false; bf16_t* E; const float* mqss; float* esum; const float* cb;
    __device__ __forceinline__ void operator()(const AccT& acc, const pg8::Unit& u, int wr, int wc, int fr, int fq) const {
        const int row0 = u.pm * 256 + wr * 64 + fr, col0 = u.pn * 256 + wc * 32 + 8 * fq; const float shift = cb[0];
#pragma unroll
        for (int ai = 0; ai < 2; ++ai)
#pragma unroll
            for (int m = 0; m < 4; ++m) { const int row = row0 + ai * 128 + m * 16; const f32x4 p = *(const f32x4*)(mqss + (size_t)row * 16 + u.pn * 4);
                const float sc = rsqrtf(((p[0] + p[1]) + (p[2] + p[3])) * (1.f / 256.f) + EPS) * (1.f / 16.f); bf16_t* rowp = E + (size_t)row * DM + col0; float sum = 0.f;
#pragma unroll
                for (int bj = 0; bj < 2; ++bj) { const f32x4 v0 = acc[ai][bj][m][0], v1 = acc[ai][bj][m][1]; u32x4 w;
                    w.x = pk2(__expf(v0[0] * sc - shift), __expf(v0[1] * sc - shift)); w.y = pk2(__expf(v0[2] * sc - shift), __expf(v0[3] * sc - shift));
                    w.z = pk2(__expf(v1[0] * sc - shift), __expf(v1[1] * sc - shift)); w.w = pk2(__expf(v1[2] * sc - shift), __expf(v1[3] * sc - shift));
                    *(u32x4*)(rowp + bj * 128) = w;
                    sum += (blo(w.x) + bhi(w.x)) + (blo(w.y) + bhi(w.y)) + (blo(w.z) + bhi(w.z)) + (blo(w.w) + bhi(w.w)); }
                sum += __shfl_xor(sum, 16); sum += __shfl_xor(sum, 32); if (fq == 0) esum[(size_t)row * 16 + u.pn * 4 + wc] = sum;
                asm volatile("" ::: "memory"); }
    } };
struct EpiMemPV { static constexpr bool PERM = true, AFTER_DRAIN = false; bf16_t* Y; const float* esum;
    __device__ __forceinline__ void operator()(const AccT& acc, const pg8::Unit& u, int wr, int wc, int fr, int fq) const {
        const int row0 = u.pm * 256 + wr * 64 + fr, col0 = u.pn * 256 + wc * 32 + 8 * fq;
#pragma unroll
        for (int ai = 0; ai < 2; ++ai)
#pragma unroll
            for (int m = 0; m < 4; ++m) { const int row = row0 + ai * 128 + m * 16; const f32x4 p = *(const f32x4*)(esum + (size_t)row * 16 + u.pn * 4);
                const float il = 1.f / ((p[0] + p[1]) + (p[2] + p[3])); bf16_t* rowp = Y + (size_t)row * DM + col0;
#pragma unroll
                for (int bj = 0; bj < 2; ++bj) { const f32x4 v0 = acc[ai][bj][m][0] * il, v1 = acc[ai][bj][m][1] * il; u32x4 w; w.x = pk2(v0[0], v0[1]); w.y = pk2(v0[2], v0[3]); w.z = pk2(v1[0], v1[1]); w.w = pk2(v1[2], v1[3]);
                    *(u32x4*)(rowp + bj * 128) = w; }
                asm volatile("" ::: "memory"); }
    } };

__device__ __forceinline__ void tr_item(const float* __restrict__ W, int ldw, bf16_t* __restrict__ WT, int ldk, int nblk, LAS float* scr, int item, int lane, int ncopies, int cstride) {
    const int kb = item / nblk, nb = item % nblk, k0 = 64 * kb, n0 = 32 * nb;
#pragma unroll
    for (int i = 0; i < 32; ++i) { const int kk = 2 * i + (lane >> 5); scr[kk * 33 + (lane & 31)] = W[(size_t)(k0 + kk) * ldw + n0 + (lane & 31)]; }
    LDS_WAIT(); asm volatile("" ::: "memory");
    const int c = lane & 7;
#pragma unroll
    for (int j = 0; j < 4; ++j) { const int n = (lane >> 3) + 8 * j; const LAS float* s = scr + (8 * c) * 33 + n;
        u32x4 o; o.x = pk2(s[0 * 33], s[1 * 33]); o.y = pk2(s[2 * 33], s[3 * 33]); o.z = pk2(s[4 * 33], s[5 * 33]); o.w = pk2(s[6 * 33], s[7 * 33]);
        for (int cp = 0; cp < ncopies; ++cp) *(u32x4*)(WT + (size_t)(n0 + n) * ldk + k0 + 8 * c + cp * cstride) = o; }
    LDS_WAIT(); asm volatile("" ::: "memory");
}
__device__ __forceinline__ void norm_row(const float* __restrict__ xrow, const float* __restrict__ g, bf16_t* __restrict__ hrow, const LAS float* WfT, bool do_logf, const float* __restrict__ bfg, float* __restrict__ LOGF, int row, int lane) {
    const f32x4* xr = (const f32x4*)xrow; const f32x4* gr = (const f32x4*)g;
    f32x4 v[4]; float ss = 0.f;
#pragma unroll
    for (int j = 0; j < 4; ++j) { v[j] = xr[lane + 64 * j]; ss += (v[j][0] * v[j][0] + v[j][1] * v[j][1]) + (v[j][2] * v[j][2] + v[j][3] * v[j][3]); }
    ss = wave_sum(ss);
    const float rstd = rsqrtf(ss * (1.f / DM) + EPS);
#pragma unroll
    for (int j = 0; j < 4; ++j) { v[j] = v[j] * rstd * gr[lane + 64 * j];
        uint2 o; o.x = pk2(v[j][0], v[j][1]); o.y = pk2(v[j][2], v[j][3]); ((uint2*)hrow)[lane + 64 * j] = o; }
    if (do_logf) {
        float mine = 0.f;
#pragma unroll 4
        for (int h = 0; h < 16; ++h) { float p = 0.f;
#pragma unroll
            for (int j = 0; j < 4; ++j) { const f32x4 w = *(const LAS f32x4*)(WfT + h * 1024 + (lane + 64 * j) * 4); p += (v[j][0] * w[0] + v[j][1] * w[1]) + (v[j][2] * w[2] + v[j][3] * w[3]); }
            p = wave_sum(p); if (lane == h) mine = p; }
        if (lane < 16) { const int b = row / SEQ, t = row % SEQ; LOGF[((size_t)b * 16 + lane) * SEQ + t] = logsigmoidf(mine + bfg[lane]); }
    }
}
__device__ __forceinline__ void headnorm64_row(bf16_t* row, const float* __restrict__ g, float scale, int lane) {
    u32x4* p = (u32x4*)row + lane * 2; u32x4 a = p[0], b = p[1];
    float v[16] = {blo(a.x), bhi(a.x), blo(a.y), bhi(a.y), blo(a.z), bhi(a.z), blo(a.w), bhi(a.w), blo(b.x), bhi(b.x), blo(b.y), bhi(b.y), blo(b.z), bhi(b.z), blo(b.w), bhi(b.w)};
    float ss = 0.f;
#pragma unroll
    for (int i = 0; i < 16; ++i) ss += v[i] * v[i];
    ss += __shfl_xor(ss, 1); ss += __shfl_xor(ss, 2);
    const float rstd = rsqrtf(ss * (1.f / 64.f) + EPS) * scale; const f32x4* gp = (const f32x4*)(g + (lane & 3) * 16);
#pragma unroll
    for (int i = 0; i < 4; ++i) { const f32x4 gg = gp[i]; v[4 * i] *= rstd * gg[0]; v[4 * i + 1] *= rstd * gg[1]; v[4 * i + 2] *= rstd * gg[2]; v[4 * i + 3] *= rstd * gg[3]; }
    a.x = pk2(v[0], v[1]); a.y = pk2(v[2], v[3]); a.z = pk2(v[4], v[5]); a.w = pk2(v[6], v[7]); b.x = pk2(v[8], v[9]); b.y = pk2(v[10], v[11]); b.z = pk2(v[12], v[13]); b.w = pk2(v[14], v[15]);
    p[0] = a; p[1] = b;
}
__device__ __forceinline__ void cumsum_block(const float* __restrict__ src, float* __restrict__ dst, LAS float* part, int tid) {
    const int lane = tid & 63, wave = tid >> 6; const f32x4* s4 = (const f32x4*)(src + tid * 16); float v[16]; float s = 0.f;
#pragma unroll
    for (int i = 0; i < 4; ++i) { const f32x4 x = s4[i]; s += x[0]; v[4 * i] = s; s += x[1]; v[4 * i + 1] = s; s += x[2]; v[4 * i + 2] = s; s += x[3]; v[4 * i + 3] = s; }
    float incl = s;
#pragma unroll
    for (int o = 1; o < 64; o <<= 1) { const float t_ = __shfl_up(incl, o); if (lane >= o) incl += t_; }
    __syncthreads();
    if (lane == 63) part[wave] = incl;
    __syncthreads();
    float off = incl - s;
    for (int w = 0; w < wave; ++w) off += part[w];
    f32x4* d4 = (f32x4*)(dst + tid * 16);
#pragma unroll
    for (int i = 0; i < 4; ++i) d4[i] = (f32x4){off + v[4 * i], off + v[4 * i + 1], off + v[4 * i + 2], off + v[4 * i + 3]};
}

__device__ __forceinline__ float neg_expm1_small(float x) {
    const float p = -x * (1.f + x * (0.5f + x * (0.16666667f + x * (0.041666668f + x * (0.0083333338f + x * 0.0013888889f)))));
    return x > -0.25f ? p : 1.f - __expf(x);
}
template <bool FINAL> __device__ __forceinline__ void lru_item(int b, int c, int n, const bf16_t* __restrict__ LX, const bf16_t* __restrict__ LG, bf16_t* __restrict__ YL,
        const float* __restrict__ cw, const float* __restrict__ cbias, const float bA, const float bX,
        const float spl, float* APROD, float* HEND, LAS unsigned char* lds, int tid) {
    const int e = tid & 63, tg = tid >> 6, ch = n * 64 + e;
    LAS float* xcT = (LAS float*)lds;
    LAS float* segP = xcT + 64 * 68;
    LAS float* segH = segP + 512, *carP = segH + 512, *carH = carP + 512;
    const LAS float* wAl = (const LAS float*)(lds + 32768);
    const int t0 = c * 64 + tg * 8; const size_t row0 = (size_t)b * SEQ + t0;
    float xw[11];
#pragma unroll
    for (int j = 0; j < 11; ++j) { const int t = t0 + j - 3; xw[j] = t >= 0 ? bf2f(LX[((size_t)b * SEQ + t) * DM + ch]) : 0.f; }
    const float w0 = cw[ch], w1 = cw[DM + ch], w2 = cw[2 * DM + ch], w3 = cw[3 * DM + ch], bc = cbias[ch];
    float xc[8];
#pragma unroll
    for (int j = 0; j < 8; ++j) xc[j] = bc + w3 * xw[j + 3] + w2 * xw[j + 2] + w1 * xw[j + 1] + w0 * xw[j];
    *(LAS f32x4*)(xcT + e * 68 + tg * 8) = (f32x4){xc[0], xc[1], xc[2], xc[3]};
    *(LAS f32x4*)(xcT + e * 68 + tg * 8 + 4) = (f32x4){xc[4], xc[5], xc[6], xc[7]};
    float gl[8];
    if (FINAL) {
#pragma unroll
        for (int j = 0; j < 8; ++j) gl[j] = bf2f(LG[(row0 + j) * DM + ch]);
        float cp = 1.f, chh = 0.f; const int per = (c + 7) >> 3; const int lo = tg * per; int hi = lo + per; if (hi > c) hi = c;
        for (int cc = lo; cc < hi; ++cc) { const size_t si = ((size_t)b * 128 + cc) * DM + ch; const float A = APROD[si], Hc = HEND[si]; chh = A * chh + Hc; cp *= A; }
        carP[tg * 64 + e] = cp; carH[tg * 64 + e] = chh; }
    __syncthreads();
    float ra[8], ri[8];
#pragma unroll
    for (int j = 0; j < 8; ++j) { ra[j] = bA; ri[j] = bX; }
#pragma unroll 8
    for (int d = 0; d < 64; ++d) { const float wad = wAl[d * 64 + e], wxd = wAl[4096 + d * 64 + e];
        const f32x4 x0 = *(const LAS f32x4*)(xcT + d * 68 + tg * 8), x1 = *(const LAS f32x4*)(xcT + d * 68 + tg * 8 + 4);
        ra[0] += x0[0] * wad; ra[1] += x0[1] * wad; ra[2] += x0[2] * wad; ra[3] += x0[3] * wad; ra[4] += x1[0] * wad; ra[5] += x1[1] * wad; ra[6] += x1[2] * wad; ra[7] += x1[3] * wad;
        ri[0] += x0[0] * wxd; ri[1] += x0[1] * wxd; ri[2] += x0[2] * wxd; ri[3] += x0[3] * wxd; ri[4] += x1[0] * wxd; ri[5] += x1[1] * wxd; ri[6] += x1[2] * wxd; ri[7] += x1[3] * wxd; }
    float av[8], uv[8]; float P = 1.f, Hh = 0.f;
#pragma unroll
    for (int j = 0; j < 8; ++j) { const float rr = fast_sigmoid(ra[j]), ii = fast_sigmoid(ri[j]); const float la = -8.f * rr * spl; av[j] = __expf(la); uv[j] = __builtin_amdgcn_sqrtf(neg_expm1_small(2.f * la)) * (ii * xc[j]);
        Hh = av[j] * Hh + uv[j]; P *= av[j]; }
    segP[tg * 64 + e] = P; segH[tg * 64 + e] = Hh;
    __syncthreads();
    if (FINAL) {
        float h = 0.f;
#pragma unroll
        for (int s = 0; s < 8; ++s) h = carP[s * 64 + e] * h + carH[s * 64 + e];
        for (int t2 = 0; t2 < tg; ++t2) h = segP[t2 * 64 + e] * h + segH[t2 * 64 + e];
#pragma unroll
        for (int j = 0; j < 8; ++j) { h = av[j] * h + uv[j]; YL[(row0 + j) * DM + ch] = f2bf(h * fast_gelu(gl[j])); }
    } else if (tg == 7) {
        float h = 0.f, p = 1.f;
#pragma unroll
        for (int s = 0; s < 8; ++s) { h = segP[s * 64 + e] * h + segH[s * 64 + e]; p *= segP[s * 64 + e]; }
        const size_t si = ((size_t)b * 128 + c) * DM + ch; APROD[si] = p; HEND[si] = h;
    }
    __syncthreads();
}
template <bool FINAL> __device__ __forceinline__ void lru_pass(int l, int bx, int G, const float* const* in, const bf16_t* LX, const bf16_t* LG, bf16_t* YL, float* APROD, float* HEND, LAS unsigned char* lds, int tid) {
    const int n = bx & 15, e = tid & 63, ch = n * 64 + e;
    { const float* wa = in[10] + (size_t)l * 65536 + (size_t)n * 4096; const float* wx = in[12] + (size_t)l * 65536 + (size_t)n * 4096; LAS float* wl = (LAS float*)(lds + 32768);
        for (int i = tid; i < 4096; i += MEGA_THREADS) { wl[i] = wa[i]; wl[4096 + i] = wx[i]; } }
    __syncthreads();
    const float bA = in[11][l * DM + ch], bX = in[13][l * DM + ch], spl = softplusf(-in[14][l * DM + ch]);
    for (int it = bx; it < 4096; it += G) lru_item<FINAL>(it >> 11, (it >> 4) & 127, n, LX, LG, YL, in[8] + (size_t)l * 4 * DM, in[9] + l * DM, bA, bX, spl, APROD, HEND, lds, tid);
}

__device__ __forceinline__ void sb_wave(int b, int h, int qw0, const bf16_t* Q, const bf16_t* __restrict__ K, const bf16_t* __restrict__ V, bf16_t* O, LAS unsigned char* vl, int lane) {
    const int r32 = lane & 31, hi = lane >> 5; const size_t rowbase = (size_t)b * SEQ;
    const bf16_t* Qw = Q + (rowbase + qw0) * DM + h * 64;
    bf16x8_t qr[4];
#pragma unroll
    for (int d0 = 0; d0 < 4; ++d0) qr[d0] = *(const bf16x8_t*)(Qw + (size_t)r32 * DM + d0 * 16 + hi * 8);
    const bf16_t* Kh = K + rowbase * DM + h * 64; const bf16_t* Vh = V + rowbase * DM + h * 64;
    f32x16_t o0 = {}, o1 = {}; float R = 0.f; const int qabs = qw0 + r32;
    int kt = qw0 >> 5;
    bf16x8_t kf[4]; u32x4 vr[4];
#define SB_LOAD(KF, VR, kt_) do { _Pragma("unroll") for (int d0 = 0; d0 < 4; ++d0) KF[d0] = *(const bf16x8_t*)(Kh + (size_t)((kt_) * 32 + r32) * DM + d0 * 16 + hi * 8); \
        _Pragma("unroll") for (int it = 0; it < 4; ++it) { const int chunk = lane + 64 * it; VR[it] = *(const u32x4*)(Vh + (size_t)((kt_) * 32 + (chunk >> 3)) * DM + (chunk & 7) * 8); } } while (0)
    SB_LOAD(kf, vr, kt);
    const unsigned vbase = (unsigned)(size_t)vl;
    for (;;) {
        bf16x8_t kn[4]; u32x4 vn[4]; const bool more = kt > 0;
        if (more) SB_LOAD(kn, vn, kt - 1); else {
#pragma unroll
            for (int i = 0; i < 4; ++i) { kn[i] = kf[i]; vn[i] = vr[i]; } }
        f32x16_t st = {};
#pragma unroll
        for (int d0 = 0; d0 < 4; ++d0) st = __builtin_amdgcn_mfma_f32_32x32x16_bf16(kf[d0], qr[d0], st, 0, 0, 0);
#pragma unroll
        for (int it = 0; it < 4; ++it) { const int chunk = lane + 64 * it, row = chunk >> 3, c16 = chunk & 7; *(LAS u32x4*)(vl + (c16 >> 2) * 2048 + row * 64 + (c16 & 3) * 16) = vr[it]; }
        float l1[16], lb[16]; bool val[16];
#pragma unroll
        for (int r = 0; r < 16; ++r) { const int kv = kt * 32 + (r & 3) + 8 * (r >> 2) + 4 * hi; val[r] = kv < qabs; const float z = st[r] * 0.125f; const float sp = fast_softplus(z); l1[r] = val[r] ? -sp : 0.f; lb[r] = z - sp; }
        float w[16]; float tail = 0.f;
#pragma unroll
        for (int g = 3; g >= 0; --g) { const float qs = (l1[4 * g] + l1[4 * g + 1]) + (l1[4 * g + 2] + l1[4 * g + 3]); const float pq = __shfl_xor(qs, 32);
            const float after = tail + (hi == 0 ? pq : 0.f) + R; tail += qs + pq;
            const float e2 = l1[4 * g + 3], e1 = e2 + l1[4 * g + 2], e0 = e1 + l1[4 * g + 1];
            w[4 * g + 3] = val[4 * g + 3] ? __expf(lb[4 * g + 3] + after) : 0.f; w[4 * g + 2] = val[4 * g + 2] ? __expf(lb[4 * g + 2] + after + e2) : 0.f;
            w[4 * g + 1] = val[4 * g + 1] ? __expf(lb[4 * g + 1] + after + e1) : 0.f; w[4 * g] = val[4 * g] ? __expf(lb[4 * g] + after + e0) : 0.f; }
        R += tail;
        u32x4 p0, p1; p0.x = attn_body::cvtpk_s(w[0], w[1]); p0.y = attn_body::cvtpk_s(w[2], w[3]); p0.z = attn_body::cvtpk_s(w[4], w[5]); p0.w = attn_body::cvtpk_s(w[6], w[7]);
        p1.x = attn_body::cvtpk_s(w[8], w[9]); p1.y = attn_body::cvtpk_s(w[10], w[11]); p1.z = attn_body::cvtpk_s(w[12], w[13]); p1.w = attn_body::cvtpk_s(w[14], w[15]);
        const bf16x8_t pa0 = __builtin_bit_cast(bf16x8_t, p0), pa1 = __builtin_bit_cast(bf16x8_t, p1);
        const attn_body::lds_cptr vp = (attn_body::lds_cptr)vl + (4 * hi + ((lane & 15) >> 2)) * 64 + ((lane >> 4) & 1) * 32 + (lane & 3) * 8;
#define SB_VF(d0, s) ({ const attn_body::s16x4 lo_ = attn_body::vtr(vp + (d0) * 2048 + (s) * 1024), hi_ = attn_body::vtr(vp + (d0) * 2048 + (s) * 1024 + 512); \
            (bf16x8_t){lo_[0], lo_[1], lo_[2], lo_[3], hi_[0], hi_[1], hi_[2], hi_[3]}; })
        o0 = __builtin_amdgcn_mfma_f32_32x32x16_bf16(pa0, SB_VF(0, 0), o0, 0, 0, 0);
        o1 = __builtin_amdgcn_mfma_f32_32x32x16_bf16(pa0, SB_VF(1, 0), o1, 0, 0, 0);
        o0 = __builtin_amdgcn_mfma_f32_32x32x16_bf16(pa1, SB_VF(0, 1), o0, 0, 0, 0);
        o1 = __builtin_amdgcn_mfma_f32_32x32x16_bf16(pa1, SB_VF(1, 1), o1, 0, 0, 0);
        if (!more) break;
        if (__all(R < SB_THR)) break;
#pragma unroll
        for (int i = 0; i < 4; ++i) { kf[i] = kn[i]; vr[i] = vn[i]; }
        --kt;
    }
#undef SB_LOAD
#undef SB_VF
    (void)vbase;
    bf16_t* Ow = O + (rowbase + qw0) * DM + h * 64;
#pragma unroll
    for (int r = 0; r < 16; ++r) { const int q = (r & 3) + 8 * (r >> 2) + 4 * hi; Ow[(size_t)q * DM + r32] = f2bf(o0[r]); Ow[(size_t)q * DM + 32 + r32] = f2bf(o1[r]); }
}

#ifndef DBG_NOLOGF
#define DBG_NOLOGF 0
#endif
#ifndef EN_FOX
#define EN_FOX 1
#endif
#ifndef EN_SB
#define EN_SB 1
#endif
#ifndef EN_LRU
#define EN_LRU 1
#endif
#ifndef EN_GEMM
#define EN_GEMM 1
#endif
#ifndef EN_THIN
#define EN_THIN 1
#endif
enum { SUB_CONV = 1, SUB_NORM = 2, SUB_HEADNORM = 4, SUB_CUMSUM = 8, SUB_LRU = 16, SUB_SB = 32, SUB_MEM = 64, SUB_FOX = 128, SUB_ALL = 255 };
constexpr int N_PRO = 3, N_PER_LAYER = 10, N_PHASES = N_PRO + DEPTH * N_PER_LAYER;
struct MArgs { Ptrs P; int ph_lo, ph_hi, sub, pad; };

__global__ void __launch_bounds__(MEGA_THREADS, 2) mega(MArgs a) {
    extern __shared__ __attribute__((aligned(16))) unsigned char lds_raw[];
    LAS unsigned char* lds = (LAS unsigned char*)lds_raw;
    cg::grid_group grid = cg::this_grid();
    { volatile LAS unsigned* st0 = (volatile LAS unsigned*)(lds + XB_LDS_OFF); if (threadIdx.x == 0) { st0[0] = 0u; st0[1] = 0u; } __syncthreads();
      if (a.ph_hi - a.ph_lo > 2) (void)xcd_barrier_post((unsigned*)(a.P.ws + WS_BAR), st0); }
    for (int ph = a.ph_lo; ph < a.ph_hi; ++ph) {
    int tid = threadIdx.x; asm volatile("" : "+v"(tid));
    const int lane = tid & 63, wave = __builtin_amdgcn_readfirstlane(tid >> 6);
    int zs = 0; asm volatile("" : "+s"(zs));
    const int G = gridDim.x + zs, bx = blockIdx.x + zs, sub = a.sub + zs, vcu = (G % 8 == 0) ? (bx % 8) * (G / 8) + bx / 8 : bx;
    const int gw = vcu * NWV + wave, NGW = G * NWV;
    unsigned char* ws = a.P.ws + zs; const float* const* in = a.P.in + zs; float* out = a.P.out + zs;
    bf16_t* H = (bf16_t*)(ws + WS_H); bf16_t* PROJ = (bf16_t*)(ws + WS_PROJ); bf16_t* GATES = (bf16_t*)(ws + WS_GATES); bf16_t* Eb = (bf16_t*)(ws + WS_E);
    bf16_t *FQ = PROJ, *FK = PROJ + (size_t)T * DM, *FV = PROJ + 2 * (size_t)T * DM, *LX = PROJ + 3 * (size_t)T * DM, *LG = PROJ + 4 * (size_t)T * DM, *SQ = PROJ + 5 * (size_t)T * DM,
           *SK = PROJ + 6 * (size_t)T * DM, *SV = PROJ + 7 * (size_t)T * DM, *MQ = PROJ + 8 * (size_t)T * DM;
    bf16_t* YL = (bf16_t*)(ws + WS_YL);
    float *LOGF = (float*)(ws + WS_LOGF), *FB = (float*)(ws + WS_FB), *MQSS = (float*)(ws + WS_MQSS), *ESUM = (float*)(ws + WS_ESUM), *CB = (float*)(ws + WS_CB);
    bf16_t* MEMN = (bf16_t*)(ws + WS_MEMN); float* MEMRAW = (float*)(ws + WS_MEMRAW); bf16_t *MK = (bf16_t*)(ws + WS_MK), *MVT = (bf16_t*)(ws + WS_MVT);
    float *APROD = (float*)(ws + WS_LRU), *HEND = APROD + (size_t)BATCH * 128 * DM;
    bf16_t* WKVT = (bf16_t*)(ws + WS_WKVT);
    bf16_t *WIN_T = (bf16_t*)(ws + WS_WT + WT_IN), *WBR_T = (bf16_t*)(ws + WS_WT + WT_BR), *WOUT_T = (bf16_t*)(ws + WS_WT + WT_OUT), *WUP_T = (bf16_t*)(ws + WS_WT + WT_UP), *WDN_T = (bf16_t*)(ws + WS_WT + WT_DN);
    bf16_t *GV = (bf16_t*)(ws + WS_GV), *ACT = (bf16_t*)(ws + WS_ACT);

        if (ph < N_PRO) {
            if (ph == 0) {
                LAS float* scr = (LAS float*)(lds + wave * 8448);
                for (int it = gw; it < 4 * 1024; it += NGW) { const int l = it >> 10; tr_item(in[15] + (size_t)l * DM * 2048, 2048, WKVT + (size_t)l * 2048 * DM, DM, 64, scr, it & 1023, lane, 1, 0); }
                for (int m = gw; m < 4 * 512; m += NGW) { const int l = m >> 9, r = m & 511; norm_row(in[1] + (size_t)r * DM, in[3] + l * DM, MEMN + (size_t)m * DM, (const LAS float*)lds, false, nullptr, nullptr, 0, lane); }
            } else if (ph == 1) {
                LocOrder<LocMemKV> S; S.so.init(4 * 512, 2048, G, bx); S.loc = LocMemKV{(const char*)MEMN, (const char*)WKVT};
                if (EN_GEMM) pg8::gemm_phase<EpiF32, LocOrder<LocMemKV>, true, true>(lds, pg8::Gemm{DM, DM, DM}, S, EpiF32{MEMRAW, 2048, 0});
            } else {
                for (int m = gw; m < 4 * 512; m += NGW) { const int l = m >> 9, r = m & 511, b = r >> 8, mi = r & 255; const float* raw = MEMRAW + (size_t)m * 2048;
                    const f32x4 gk = *(const f32x4*)(in[17] + l * 256 + lane * 4), gq = *(const f32x4*)(in[16] + l * 256 + lane * 4); const f32x4 gg = gk * gq;
#pragma unroll
                    for (int h = 0; h < 4; ++h) { const f32x4 k = *(const f32x4*)(raw + h * 256 + lane * 4); const float ss = wave_sum((k[0] * k[0] + k[1] * k[1]) + (k[2] * k[2] + k[3] * k[3]));
                        const float rstd = rsqrtf(ss * (1.f / 256.f) + EPS); uint2 o; o.x = pk2(k[0] * rstd * gg[0], k[1] * rstd * gg[1]); o.y = pk2(k[2] * rstd * gg[2], k[3] * rstd * gg[3]);
                        *(uint2*)(MK + ((size_t)l * 512 + (size_t)b * 256 + mi) * DM + h * 256 + lane * 4) = o;
                        const f32x4 v = *(const f32x4*)(raw + 1024 + h * 256 + lane * 4); bf16_t* vt = MVT + (size_t)l * 512 * DM + (((size_t)b * 4 + h) * 256 + lane * 4) * 256 + mi;
                        vt[0] = f2bf(v[0]); vt[256] = f2bf(v[1]); vt[512] = f2bf(v[2]); vt[768] = f2bf(v[3]); }
                    if (r == 0) { float mx = fmaxf(fmaxf(fabsf(gg[0]), fabsf(gg[1])), fmaxf(fabsf(gg[2]), fabsf(gg[3])));
#pragma unroll
                        for (int o = 1; o < 64; o <<= 1) mx = fmaxf(mx, __shfl_xor(mx, o));
                        if (lane == 0) CB[l] = 16.f * mx; } }
            }
        } else {
            const int l = (ph - N_PRO) / N_PER_LAYER, sp = (ph - N_PRO) % N_PER_LAYER;
            const float* xcur = l == 0 ? in[0] : out;
            if (sp == 0) {
                if (sub & SUB_NORM) { LAS float* WfT = (LAS float*)lds; const float* wf = in[4] + (size_t)l * DM * NIN + 3072;
                    for (int i = tid; i < 16 * 1024; i += MEGA_THREADS) { const int k = i >> 4, h = i & 15; WfT[h * 1024 + k] = wf[(size_t)k * NIN + h]; } }
                __syncthreads();
                if (sub & SUB_CONV) { LAS float* scr = (LAS float*)(lds + 65536 + wave * 8448);
                    const float* win = in[4] + (size_t)l * DM * NIN;
                    for (int it = gw; it < 13440; it += NGW) { int r = it;
                        if (r < 1536) { tr_item(win, NIN, WIN_T, DM, 96, scr, r, lane, 1, 0); continue; } r -= 1536;
                        if (r < 5120) { tr_item(win + 3088, NIN, WIN_T + (size_t)3072 * DM, DM, 320, scr, r, lane, 1, 0); continue; } r -= 5120;
                        if (r < 2048) { const int i = r >> 9; tr_item(in[19] + ((size_t)l * 4 + i) * DM * DM, DM, WBR_T + (size_t)i * DM * DM, DM, 32, scr, r & 511, lane, 1, 0); continue; } r -= 2048;
                        if (r < 512) { tr_item(in[20] + (size_t)l * DM * DM, DM, WOUT_T, DM, 32, scr, r, lane, 1, 0); continue; } r -= 512;
                        if (r < 2816) { tr_item(in[22] + (size_t)l * DM * 2 * DFF, 2 * DFF, WUP_T, DM, 176, scr, r, lane, 1, 0); continue; } r -= 2816;
                        tr_item(in[25] + (size_t)l * DFF * DM, DM, WDN_T, DFF, 32, scr, r, lane, 1, 0); } }
                if (sub & SUB_NORM) for (int m = gw; m < T; m += NGW) norm_row(xcur + (size_t)m * DM, in[2] + l * DM, H + (size_t)m * DM, (const LAS float*)lds, !DBG_NOLOGF, in[5] + l * 16, LOGF, m, lane);
            } else if (sp == 1) {
                LocOrder<LocStd> S; S.so.init(T, 13312, G, bx); S.loc = LocStd{(const char*)H, (const char*)WIN_T, 256 * 1024 * 2, 256 * 1024 * 2};
                if (EN_GEMM) pg8::gemm_phase<EpiProj, LocOrder<LocStd>, true, true>(lds, pg8::Gemm{DM, DM, DM}, S, EpiProj{PROJ, GATES, MQSS});
            } else if (sp == 2) {
                if (sub & SUB_HEADNORM) { for (int m = gw; m < 2 * T; m += NGW) { if (m < T) headnorm64_row(FQ + (size_t)m * DM, in[6] + l * 64, C2, lane); else headnorm64_row(FK + (size_t)(m - T) * DM, in[7] + l * 64, 1.f, lane); } }
                if ((sub & SUB_CUMSUM) && bx < 32) cumsum_block(LOGF + (size_t)bx * SEQ, FB + (size_t)bx * SEQ, (LAS float*)lds, tid);
                __syncthreads();
                if (EN_LRU && (sub & SUB_LRU)) lru_pass<false>(l, bx, G, in, LX, LG, YL, APROD, HEND, lds, tid);
                if (EN_SB && (sub & SUB_SB)) for (int k = 0; k < 4; ++k) { const int bh = vcu >> 3, qb = (vcu & 7) * 4 + k; sb_wave(bh >> 4, bh & 15, qb * 256 + wave * 32, SQ, SK, SV, H, lds + wave * 4096, lane); }
                __syncthreads();
                if (sub & SUB_MEM) { LocOrder<LocMemS> S; S.so.init(T, 1024, G, bx); S.loc = LocMemS{(const char*)MQ, (const char*)(MK + (size_t)l * 512 * DM)};
                    if (EN_GEMM) pg8::gemm_phase<EpiSexp, LocOrder<LocMemS>, true, true>(lds, pg8::Gemm{DM, DM, 256 + zs}, S, EpiSexp{Eb, MQSS, ESUM, CB + l}); }
            } else if (sp == 3) {
                if (EN_FOX && (sub & SUB_FOX)) {
                    float gqm = fabsf(in[6][l * 64 + lane]), gkm = fabsf(in[7][l * 64 + lane]);
#pragma unroll
                    for (int o = 1; o < 64; o <<= 1) { gqm = fmaxf(gqm, __shfl_xor(gqm, o)); gkm = fmaxf(gkm, __shfl_xor(gkm, o)); }
                    const float thr = -(160.f + 2.f * C2 * 64.f * gqm * gkm);
                    const attn_body::AttnTensors AT{(const attn_body::bf16*)FQ, (const attn_body::bf16*)FK, (const attn_body::bf16*)FV, (attn_body::bf16*)SV, FB, thr, 0};
                    attn_body::QueueOrder S; S.ctr = (unsigned*)(ws + WS_QCTR) + (l * 8) * 64; S.xl = bx & 7; S.slot = (volatile LAS int*)(lds + XB_LDS_OFF + 16);
                    attn_body::attn_phase<attn_body::QueueOrder, 20>((char*)lds_raw, AT, S); }
                __syncthreads();
                if (EN_LRU && (sub & SUB_LRU)) lru_pass<true>(l, bx, G, in, LX, LG, YL, APROD, HEND, lds, tid);
                if (sub & SUB_MEM) { LocOrder<LocMemPV> S; S.so.init(T, 1024, G, bx); S.loc = LocMemPV{(const char*)Eb, (const char*)(MVT + (size_t)l * 512 * DM)};
                    if (EN_GEMM) pg8::gemm_phase<EpiMemPV, LocOrder<LocMemPV>, true, true>(lds, pg8::Gemm{DM, 256, 256 + zs}, S, EpiMemPV{MQ, ESUM}); }
            } else if (sp == 4) {
                BranchSched S; S.vcu = vcu; S.loc = LocBranch{(const char*)SV, (const char*)YL, (const char*)H, (const char*)MQ, (const char*)WBR_T};
                if (EN_GEMM) pg8::gemm_phase<EpiBranch, BranchSched, true, true>(lds, pg8::Gemm{DM, DM, DM}, S, EpiBranch{GATES, in[18] + (size_t)l * 4 * DM, (float*)(ws + WS_MIXF), (bf16_t*)(ws + WS_MIXED)});
            } else if (sp == 5) {
                LocOrder<LocStd> S; S.so.init(T, DM, G, bx); S.loc = LocStd{(const char*)(ws + WS_MIXED), (const char*)WOUT_T, 256 * 1024 * 2, 256 * 1024 * 2};
                if (EN_GEMM) pg8::gemm_phase<EpiResid, LocOrder<LocStd>, true, true>(lds, pg8::Gemm{DM, DM, DM}, S, EpiResid{xcur, out});
            } else if (sp == 6) {
                for (int m = gw; m < T; m += NGW) norm_row(out + (size_t)m * DM, in[21] + l * DM, H + (size_t)m * DM, (const LAS float*)lds, false, nullptr, nullptr, m, lane);
            } else if (sp == 7) {
                LocOrder<LocStd> S; S.so.init(T, 2 * DFF, G, bx); S.loc = LocStd{(const char*)H, (const char*)WUP_T, 256 * 1024 * 2, 256 * 1024 * 2};
                if (EN_GEMM) pg8::gemm_phase<EpiBf16P, LocOrder<LocStd>, true, true>(lds, pg8::Gemm{DM, DM, DM}, S, EpiBf16P{GV, 2 * DFF, 0});
            } else if (sp == 8) {
                const float* cw = in[23] + (size_t)l * 3 * DFF; const float* cbv = in[24] + l * DFF;
                for (int i = bx * MEGA_THREADS + tid; i < T * (DFF / 8); i += G * MEGA_THREADS) { const int r = i / (DFF / 8), c = (i % (DFF / 8)) * 8, t = r % SEQ;
                    const bf16_t* gp = GV + (size_t)r * 2 * DFF + c; const u32x4 z4 = {0u, 0u, 0u, 0u};
                    const u32x4 g0 = *(const u32x4*)gp, g1 = t >= 1 ? *(const u32x4*)(gp - 2 * DFF) : z4, g2 = t >= 2 ? *(const u32x4*)(gp - 4 * DFF) : z4, vv = *(const u32x4*)(gp + DFF);
                    const f32x4 wa0 = *(const f32x4*)(cw + c), wa1 = *(const f32x4*)(cw + c + 4), wb0 = *(const f32x4*)(cw + DFF + c), wb1 = *(const f32x4*)(cw + DFF + c + 4), wc0 = *(const f32x4*)(cw + 2 * DFF + c), wc1 = *(const f32x4*)(cw + 2 * DFF + c + 4);
                    const f32x4 bb0 = *(const f32x4*)(cbv + c), bb1 = *(const f32x4*)(cbv + c + 4);
#define ACT1(G0, G1, G2, VV, W0, W1, W2, BB) ({ const float pre_ = (BB) + (W2) * (G0) + (W1) * (G1) + (W0) * (G2); pre_ * fast_sigmoid(pre_) * (VV); })
                    u32x4 o;
                    o.x = pk2(ACT1(blo(g0.x), blo(g1.x), blo(g2.x), blo(vv.x), wa0[0], wb0[0], wc0[0], bb0[0]), ACT1(bhi(g0.x), bhi(g1.x), bhi(g2.x), bhi(vv.x), wa0[1], wb0[1], wc0[1], bb0[1]));
                    o.y = pk2(ACT1(blo(g0.y), blo(g1.y), blo(g2.y), blo(vv.y), wa0[2], wb0[2], wc0[2], bb0[2]), ACT1(bhi(g0.y), bhi(g1.y), bhi(g2.y), bhi(vv.y), wa0[3], wb0[3], wc0[3], bb0[3]));
                    o.z = pk2(ACT1(blo(g0.z), blo(g1.z), blo(g2.z), blo(vv.z), wa1[0], wb1[0], wc1[0], bb1[0]), ACT1(bhi(g0.z), bhi(g1.z), bhi(g2.z), bhi(vv.z), wa1[1], wb1[1], wc1[1], bb1[1]));
                    o.w = pk2(ACT1(blo(g0.w), blo(g1.w), blo(g2.w), blo(vv.w), wa1[2], wb1[2], wc1[2], bb1[2]), ACT1(bhi(g0.w), bhi(g1.w), bhi(g2.w), bhi(vv.w), wa1[3], wb1[3], wc1[3], bb1[3]));
#undef ACT1
                    *(u32x4*)(ACT + (size_t)r * DFF + c) = o; }
            } else {
                LocOrder<LocStd> S; S.so.init(T, DM, G, bx); S.loc = LocStd{(const char*)ACT, (const char*)WDN_T, 256 * DFF * 2, 256 * DFF * 2};
                if (EN_GEMM) pg8::gemm_phase<EpiResid, LocOrder<LocStd>, true, true>(lds, pg8::Gemm{DFF, DFF, DFF}, S, EpiResid{out, out});
            }
        }
        if (ph + 1 < a.ph_hi) {
            if (ph == a.ph_lo) grid.sync();
            else { XcdBarrier xb; xb.bar = (unsigned*)(ws + WS_BAR); xb.x = xb_xcc_id(); xb.st = (volatile LAS unsigned*)(lds + XB_LDS_OFF); xcd_barrier(xb); }
        }
    }
}
enum { C_PRO = 1, C_NORM = 2, C_WIN = 4, C_HN = 8, C_LRU = 16, C_SB = 32, C_MEM = 64, C_FOX = 128, C_BR = 256, C_WOUT = 512, C_NORM2 = 1024, C_UP = 2048, C_ACT = 4096, C_DOWN = 8192, C_ONE = 16384 };
#ifndef CFG
#define CFG 32767
#endif
#ifndef REPEAT_SP
#define REPEAT_SP (-1)
#define REPEAT_N 0
#define REPEAT_SUB 0
#endif
static int g_grid = 0;
static void launch_mega(const Ptrs& P, int lo, int hi, int sub, hipStream_t st, bool coop) {
    MArgs a{}; a.P = P; a.ph_lo = lo; a.ph_hi = hi; a.sub = sub; a.pad = 0;
    if (coop) { void* args[] = {&a}; const hipError_t e = hipLaunchCooperativeKernel((const void*)mega, dim3(g_grid), dim3(MEGA_THREADS), args, MEGA_LDS, st);
        if (e != hipSuccess) fprintf(stderr, "cooperative launch failed: %s (grid %d)\n", hipGetErrorString(e), g_grid); }
    else { hipLaunchKernelGGL(mega, dim3(g_grid), dim3(MEGA_THREADS), MEGA_LDS, st, a);
        if (REPEAT_N > 0 && hi == lo + 1 && lo >= N_PRO && (lo - N_PRO) % N_PER_LAYER == (REPEAT_SP)) { a.sub = (REPEAT_SUB); for (int r = 0; r < (REPEAT_N); ++r) hipLaunchKernelGGL(mega, dim3(g_grid), dim3(MEGA_THREADS), MEGA_LDS, st, a); } }
}
static void run_hybrid(const Ptrs& P, hipStream_t st) {
    unsigned char* ws = P.ws;
    bf16_t* H = (bf16_t*)(ws + WS_H);
    bf16_t* PR[9]; for (int i = 0; i < 9; ++i) PR[i] = (bf16_t*)(ws + WS_PROJ + i * SZ_ACT);
    bf16_t *FQ = PR[0], *FK = PR[1], *FV = PR[2], *LX = PR[3], *LG = PR[4], *SQ = PR[5], *SK = PR[6], *SV = PR[7], *MQ = PR[8];
    bf16_t* GATES = (bf16_t*)(ws + WS_GATES);
    bf16_t *YL = (bf16_t*)(ws + WS_YL), *YS = (bf16_t*)(ws + WS_YS), *YM = (bf16_t*)(ws + WS_YM), *YF = (bf16_t*)(ws + WS_YF);
    float *LOGF = (float*)(ws + WS_LOGF), *FB = (float*)(ws + WS_FB);
    bf16_t* MEMN = (bf16_t*)(ws + WS_MEMN); float* MEMRAW = (float*)(ws + WS_MEMRAW);
    bf16_t *MK = (bf16_t*)(ws + WS_MK), *MVT = (bf16_t*)(ws + WS_MVT);
    bf16_t *GV = (bf16_t*)(ws + WS_GV), *ACT = (bf16_t*)(ws + WS_ACT);
    const float* const* in = P.in;
    const int cfg = CFG;
    const bool anygemm = cfg & (C_WIN | C_BR | C_WOUT | C_UP | C_DOWN);
    if (cfg & C_PRO) { for (int p = 0; p < 3; ++p) launch_mega(P, p, p + 1, SUB_ALL, st, false); }
    else for (int l = 0; l < DEPTH; ++l) {
        n_rmsnorm<<<512 / 4, 256, 0, st>>>(in[1], in[3] + l * DM, MEMN + (size_t)l * 512 * DM, nullptr, nullptr, nullptr, 512);
        n_gemm<EStoreF32><<<dim3(2048 / 64, 512 / 64), 256, 0, st>>>(MEMN + (size_t)l * 512 * DM, in[15] + (size_t)l * DM * 2048, DM, 2048, DM, 0x7fffffff, EStoreF32{MEMRAW + (size_t)l * 512 * 2048, 2048, 0});
        n_memkv_post<<<512, 256, 0, st>>>(MEMRAW + (size_t)l * 512 * 2048, in[17] + l * 256, in[16] + l * 256, MK + (size_t)l * 512 * DM, MVT + (size_t)l * 512 * DM);
    }
    for (int l = 0; l < DEPTH; ++l) {
        const int p0 = N_PRO + l * N_PER_LAYER;
        const float* xcur = l == 0 ? in[0] : P.out;
        const float* win = in[4] + (size_t)l * DM * NIN;
        if (DBG_NOLOGF) n_rmsnorm<<<T / 4, 256, 0, st>>>(xcur, in[2] + l * DM, H, win + 3072, in[5] + l * 16, LOGF, T);
        { const int sub = (anygemm ? SUB_CONV : 0) | ((cfg & C_NORM) ? SUB_NORM : 0); if (sub) launch_mega(P, p0, p0 + 1, sub, st, false); }
        if (!(cfg & C_NORM)) n_rmsnorm<<<T / 4, 256, 0, st>>>(xcur, in[2] + l * DM, H, win + 3072, in[5] + l * 16, LOGF, T);
        if (cfg & C_WIN) launch_mega(P, p0 + 1, p0 + 2, SUB_ALL, st, false);
        else { for (int gI = 0; gI < 9; ++gI) { const int coff = gI < 3 ? gI * 1024 : gI * 1024 + 16;
                n_gemm<EStoreBf16><<<dim3(1024 / 64, T / 64), 256, 0, st>>>(H, win + coff, DM, NIN, DM, 0x7fffffff, EStoreBf16{PR[gI], DM, 0}); }
            n_gemm<EStoreBf16><<<dim3(4096 / 64, T / 64), 256, 0, st>>>(H, win + 9232, DM, NIN, DM, 0x7fffffff, EStoreBf16{GATES, 4096, 0}); }
        if (!(cfg & C_HN)) { n_headnorm<<<T * 16 / 256, 256, 0, st>>>(FQ, in[6] + l * 64, 64, C2); n_headnorm<<<T * 16 / 256, 256, 0, st>>>(FK, in[7] + l * 64, 64, 1.f); n_cumsum<<<32, 1024, 0, st>>>(LOGF, FB); }
        const int sub23 = ((cfg & C_HN) ? (SUB_HEADNORM | SUB_CUMSUM) : 0) | ((cfg & C_LRU) ? SUB_LRU : 0) | ((cfg & C_SB) ? SUB_SB : 0) | ((cfg & C_MEM) ? SUB_MEM : 0) | ((cfg & C_FOX) ? SUB_FOX : 0);
        if (sub23 & ~SUB_FOX) launch_mega(P, p0 + 2, p0 + 3, sub23, st, false);
        if (!(cfg & C_SB)) n_sb_attn<<<dim3(SEQ / 256, 32), 256, 0, st>>>(SQ, SK, SV, YS);
        if (!(cfg & C_LRU)) n_lru<<<32, 64, 0, st>>>(LX, LG, in[8] + (size_t)l * 4 * DM, in[9] + l * DM, in[10] + (size_t)l * 16 * 64 * 64, in[11] + l * DM, in[12] + (size_t)l * 16 * 64 * 64, in[13] + l * DM, in[14] + l * DM, YL);
        if (!(cfg & C_MEM)) n_mem_attn<<<T * 4, 256, 0, st>>>(MQ, MK + (size_t)l * 512 * DM, MVT + (size_t)l * 512 * DM, YM);
        if (sub23 & (SUB_FOX | SUB_LRU | SUB_MEM)) launch_mega(P, p0 + 3, p0 + 4, sub23, st, false);
        if (!(cfg & C_FOX)) n_fox_attn<<<dim3(SEQ / 256, 32), 256, 0, st>>>(FQ, FK, FV, FB, YF);
        if (cfg & C_BR) launch_mega(P, p0 + 4, p0 + 5, SUB_ALL, st, false);
        else { const bf16_t* Y[4] = {YF, YL, YS, YM};
            for (int i = 0; i < 4; ++i) n_gemm<EBranch><<<dim3(1024 / 64, T / 64), 256, 0, st>>>(Y[i], in[19] + ((size_t)l * 4 + i) * DM * DM, DM, DM, DM, 0x7fffffff, EBranch{GATES, in[18] + ((size_t)l * 4 + i) * DM, (float*)(ws + WS_MIXF), (bf16_t*)(ws + WS_MIXED), i, 0}); }
        if (cfg & C_WOUT) launch_mega(P, p0 + 5, p0 + 6, SUB_ALL, st, false);
        else n_gemm<EResid><<<dim3(1024 / 64, T / 64), 256, 0, st>>>((const bf16_t*)(ws + WS_MIXED), in[20] + (size_t)l * DM * DM, DM, DM, DM, 0x7fffffff, EResid{xcur, P.out});
        if (cfg & C_NORM2) launch_mega(P, p0 + 6, p0 + 7, SUB_ALL, st, false);
        else n_rmsnorm<<<T / 4, 256, 0, st>>>(P.out, in[21] + l * DM, H, nullptr, nullptr, nullptr, T);
        if (cfg & C_UP) launch_mega(P, p0 + 7, p0 + 8, SUB_ALL, st, false);
        else n_gemm<EStoreBf16><<<dim3(2 * DFF / 64, T / 64), 256, 0, st>>>(H, in[22] + (size_t)l * DM * 2 * DFF, DM, 2 * DFF, DM, 0x7fffffff, EStoreBf16{GV, 2 * DFF, 0});
        if (cfg & C_ACT) launch_mega(P, p0 + 8, p0 + 9, SUB_ALL, st, false);
        else n_act<<<(unsigned)(((size_t)T * DFF + 255) / 256), 256, 0, st>>>(GV, in[23] + (size_t)l * 3 * DFF, in[24] + l * DFF, ACT);
        if (cfg & C_DOWN) launch_mega(P, p0 + 9, p0 + 10, SUB_ALL, st, false);
        else n_gemm<EResid><<<dim3(1024 / 64, T / 64), 256, 0, st>>>(ACT, in[25] + (size_t)l * DFF * DM, DFF, DM, DFF, 0x7fffffff, EResid{P.out, P.out});
    }
}

extern "C" void kernel_launch(void* const* d_in, const int* in_sizes, int n_in, void* d_out, int out_size, void* d_ws, size_t ws_size, hipStream_t stream) {
    if (n_in != 26 || out_size != T * DM || ws_size < WS_NEED) { fprintf(stderr, "kernel_launch: unexpected sizes n_in %d out %d ws %zu (need %zu)\n", n_in, out_size, ws_size, (size_t)WS_NEED); return; }
    if (g_grid == 0) {
        int dev = 0, cus = 0, per_cu = 0;
        hipGetDevice(&dev); hipDeviceGetAttribute(&cus, hipDeviceAttributeMultiprocessorCount, dev);
        if (hipFuncSetAttribute((const void*)mega, hipFuncAttributeMaxDynamicSharedMemorySize, MEGA_LDS) != hipSuccess) fprintf(stderr, "kernel_launch: hipFuncSetAttribute failed\n");
        if (hipOccupancyMaxActiveBlocksPerMultiprocessor(&per_cu, (const void*)mega, MEGA_THREADS, MEGA_LDS) != hipSuccess || per_cu < 1) fprintf(stderr, "kernel_launch: occupancy query says %d\n", per_cu);
        (void)hipGetLastError();
        g_grid = cus;
        if (g_grid != 256) fprintf(stderr, "kernel_launch: %d CUs; the attention phase's static order assumes 256\n", g_grid);
    }
    Ptrs P{};
    for (int i = 0; i < 26; ++i) P.in[i] = (const float*)d_in[i];
    P.out = (float*)d_out; P.ws = (unsigned char*)d_ws;
    if ((CFG) & C_ONE) { (void)hipMemsetAsync((char*)d_ws + WS_BAR, 0, CTL_ZERO_BYTES, stream);
        launch_mega(P, 0, N_PHASES, SUB_ALL, stream, true); }
    else { (void)hipMemsetAsync((char*)d_ws + WS_BAR, 0, CTL_ZERO_BYTES, stream); run_hybrid(P, stream); }
}
```

```cpp
#include <hip/hip_runtime.h>
#include <cstdio>
#include <cstdint>
#include <hip/hip_cooperative_groups.h>

typedef unsigned short bf16_t;
constexpr int BATCH = 2, SEQ = 8192, DM = 1024, DEPTH = 4, T = BATCH * SEQ;
constexpr int NMEM = 256, NIN = 13328, DFF = 2816;
constexpr float EPS = 1e-6f;
constexpr float LOG2E = 1.4426950408889634f;
constexpr float C2 = 0.125f * LOG2E;
constexpr float SB_THR = -104.0f;

__device__ __forceinline__ float bf2f(bf16_t b) { return __uint_as_float(((unsigned)b) << 16); }
__device__ __forceinline__ bf16_t f2bf(float f) { unsigned u = __float_as_uint(f); return (bf16_t)((u + 0x7fffu + ((u >> 16) & 1u)) >> 16); }
__device__ __forceinline__ float bfr(float f) { return bf2f(f2bf(f)); }
__device__ __forceinline__ float wave_sum(float v) {
#pragma unroll
    for (int o = 1; o < 64; o <<= 1) v += __shfl_xor(v, o);
    return v;
}
__device__ __forceinline__ float softplusf(float x) { return fmaxf(x, 0.f) + log1pf(__expf(-fabsf(x))); }
__device__ __forceinline__ float logsigmoidf(float x) { return -softplusf(-x); }
__device__ __forceinline__ float sigmoidf_(float x) { return 1.f / (1.f + __expf(-x)); }
__device__ __forceinline__ float gelu_tanh(float x) { const float u = 0.7978845608028654f * (x + 0.044715f * x * x * x); return 0.5f * x * (1.f + tanhf(u)); }

__device__ __forceinline__ int mk_tid() { int t = threadIdx.x; asm volatile("" : "+v"(t)); return t; }

constexpr size_t MiB = 1u << 20;
constexpr size_t SZ_ACT = (size_t)T * DM * 2;
constexpr size_t WS_CTL = 0;
constexpr size_t WS_H = 1 * MiB;
constexpr size_t WS_PROJ = WS_H + SZ_ACT;
constexpr size_t WS_GATES = WS_PROJ + 9 * SZ_ACT;
constexpr size_t WS_E = WS_GATES + 4 * SZ_ACT;
constexpr size_t WS_LOGF = WS_E + SZ_ACT;
constexpr size_t WS_FB = WS_LOGF + 1 * MiB;
constexpr size_t WS_MQSS = WS_FB + 1 * MiB;
constexpr size_t WS_ESUM = WS_MQSS + 1 * MiB;
constexpr size_t WS_MEMN = WS_ESUM + 1 * MiB;
constexpr size_t WS_MEMRAW = WS_MEMN + 4 * MiB;
constexpr size_t WS_MK = WS_MEMRAW + 16 * MiB;
constexpr size_t WS_MVT = WS_MK + 4 * MiB;
constexpr size_t WS_LRU = WS_MVT + 4 * MiB;
constexpr size_t WS_WT = WS_LRU + 2 * MiB;
constexpr size_t WS_END = WS_WT + 72 * MiB;
constexpr size_t WS_YL = WS_PROJ + 6 * SZ_ACT, WS_YS = WS_H, WS_YM = WS_PROJ + 8 * SZ_ACT, WS_YF = WS_PROJ + 7 * SZ_ACT;
constexpr size_t WS_GV = WS_PROJ;
constexpr size_t WS_ACT = WS_GV + (size_t)T * 2 * DFF * 2;
static_assert(WS_ACT + (size_t)T * DFF * 2 <= WS_GATES, "ffn alias");
constexpr size_t WS_MIXF = WS_END;
constexpr size_t WS_MIXED = WS_PROJ;
constexpr size_t WS_NEED = WS_MIXF + (size_t)T * DM * 4;

struct Ptrs {
    const float* in[26];
    float* out;
    unsigned char* ws;
};

__global__ void __launch_bounds__(256) n_rmsnorm(const float* __restrict__ x, const float* __restrict__ g, bf16_t* __restrict__ H,
                                                 const float* __restrict__ Wf, const float* __restrict__ bfg, float* __restrict__ LOGF, int nrows) {
    const int lane = threadIdx.x & 63, row = blockIdx.x * 4 + (threadIdx.x >> 6);
    if (row >= nrows) return;
    const float4* xr = (const float4*)(x + (size_t)row * DM);
    const float4* gr = (const float4*)g;
    float4 v[4]; float ss = 0.f;
#pragma unroll
    for (int j = 0; j < 4; ++j) { v[j] = xr[lane + 64 * j]; ss += v[j].x * v[j].x + v[j].y * v[j].y + v[j].z * v[j].z + v[j].w * v[j].w; }
    ss = wave_sum(ss);
    const float rstd = rsqrtf(ss * (1.f / DM) + EPS);
#pragma unroll
    for (int j = 0; j < 4; ++j) { const float4 gg = gr[lane + 64 * j]; v[j].x *= rstd * gg.x; v[j].y *= rstd * gg.y; v[j].z *= rstd * gg.z; v[j].w *= rstd * gg.w;
        ushort4 o; o.x = f2bf(v[j].x); o.y = f2bf(v[j].y); o.z = f2bf(v[j].z); o.w = f2bf(v[j].w);
        ((ushort4*)(H + (size_t)row * DM))[lane + 64 * j] = o; }
    if (Wf) {
        float mine = 0.f;
        for (int h = 0; h < 16; ++h) {
            float p = 0.f;
#pragma unroll
            for (int j = 0; j < 4; ++j) { const int k = (lane + 64 * j) * 4;
                p += v[j].x * Wf[(size_t)k * NIN + h] + v[j].y * Wf[(size_t)(k + 1) * NIN + h] + v[j].z * Wf[(size_t)(k + 2) * NIN + h] + v[j].w * Wf[(size_t)(k + 3) * NIN + h]; }
            p = wave_sum(p);
            if (lane == h) mine = p;
        }
        if (lane < 16) { const int b = row / SEQ, t = row % SEQ; LOGF[((size_t)b * 16 + lane) * SEQ + t] = logsigmoidf(mine + bfg[lane]); }
    }
}

struct EStoreBf16 { bf16_t* O; int ldc; int pad; __device__ void operator()(int m, int n, float a) const { O[(size_t)m * ldc + n] = f2bf(a); } };
struct EStoreF32 { float* O; int ldc; int pad; __device__ void operator()(int m, int n, float a) const { O[(size_t)m * ldc + n] = a; } };
struct EBranch { const bf16_t* G; const float* bg; float* MIXF; bf16_t* MIXED; int i; int pad; __device__ void operator()(int m, int n, float a) const { float v = sigmoidf_(bf2f(G[(size_t)m * 4096 + i * 1024 + n]) + bg[n]) * a; const size_t o = (size_t)m * DM + n; if (i > 0) v += MIXF[o]; if (i < 3) MIXF[o] = v; else MIXED[o] = f2bf(v); } };
struct EResid { const float* base; float* out; __device__ void operator()(int m, int n, float a) const { out[(size_t)m * DM + n] = base[(size_t)m * DM + n] + a; } };

template <class Epi> __global__ void __launch_bounds__(256) n_gemm(const bf16_t* __restrict__ A, const float* __restrict__ W, int lda, int ldw, int K, int kmask, Epi epi) {
    __shared__ float As[16][68], Bs[16][68];
    const int tx = threadIdx.x & 15, ty = threadIdx.x >> 4, m0 = blockIdx.y * 64, n0 = blockIdx.x * 64;
    float acc[4][4];
#pragma unroll
    for (int i = 0; i < 4; ++i)
#pragma unroll
        for (int j = 0; j < 4; ++j) acc[i][j] = 0.f;
    for (int k0 = 0; k0 < K; k0 += 16) {
#pragma unroll
        for (int i = 0; i < 4; ++i) { const int idx = threadIdx.x + i * 256; { const int r = idx >> 4, c = idx & 15; As[c][r] = bf2f(A[(size_t)(m0 + r) * lda + k0 + c]); }
            { const int r = idx >> 6, c = idx & 63; Bs[r][c] = bfr(W[(size_t)((k0 + r) & kmask) * ldw + n0 + c]); } }
        __syncthreads();
#pragma unroll
        for (int kk = 0; kk < 16; ++kk) { float a[4], b[4];
#pragma unroll
            for (int i = 0; i < 4; ++i) { a[i] = As[kk][ty * 4 + i]; b[i] = Bs[kk][tx * 4 + i]; }
#pragma unroll
            for (int i = 0; i < 4; ++i)
#pragma unroll
                for (int j = 0; j < 4; ++j) acc[i][j] += a[i] * b[j]; }
        __syncthreads();
    }
#pragma unroll
    for (int i = 0; i < 4; ++i)
#pragma unroll
        for (int j = 0; j < 4; ++j) epi(m0 + ty * 4 + i, n0 + tx * 4 + j, acc[i][j]);
}

__global__ void __launch_bounds__(256) n_headnorm(bf16_t* X, const float* __restrict__ g, int HD, float scale) {
    const int idx = blockIdx.x * 256 + threadIdx.x, nh = DM / HD, row = idx / nh, h = idx % nh;
    if (row >= T) return;
    bf16_t* p = X + (size_t)row * DM + h * HD; float ss = 0.f;
    for (int d = 0; d < HD; ++d) { const float v = bf2f(p[d]); ss += v * v; }
    const float rstd = rsqrtf(ss / HD + EPS) * scale;
    for (int d = 0; d < HD; ++d) p[d] = f2bf(bf2f(p[d]) * rstd * g[d]);
}

__global__ void __launch_bounds__(1024) n_cumsum(const float* __restrict__ LOGF, float* __restrict__ FB) {
    __shared__ float part[1024];
    const int bh = blockIdx.x, tid = threadIdx.x; const float* src = LOGF + (size_t)bh * SEQ + tid * 8; float v[8]; float s = 0.f;
#pragma unroll
    for (int i = 0; i < 8; ++i) { s += src[i]; v[i] = s; }
    part[tid] = s; __syncthreads();
    if (tid == 0) { float run = 0.f; for (int i = 0; i < 1024; ++i) { const float t_ = part[i]; part[i] = run; run += t_; } }
    __syncthreads();
    const float off = part[tid]; float* dst = FB + (size_t)bh * SEQ + tid * 8;
#pragma unroll
    for (int i = 0; i < 8; ++i) dst[i] = off + v[i];
}

__global__ void __launch_bounds__(256) n_fox_attn(const bf16_t* Q, const bf16_t* __restrict__ K, const bf16_t* __restrict__ V, const float* __restrict__ FB, bf16_t* O) {
    __shared__ float Ks[64][64], Vs[64][64], Fs[64];
    const int bh = blockIdx.y, b = bh >> 4, h = bh & 15, tq = blockIdx.x * 256 + threadIdx.x;
    const size_t rowq = (size_t)b * SEQ + tq;
    float q[64], o[64];
#pragma unroll
    for (int d = 0; d < 64; ++d) { q[d] = bf2f(Q[rowq * DM + h * 64 + d]); o[d] = 0.f; }
    const float Ft = FB[(size_t)bh * SEQ + tq];
    float m = -INFINITY, l = 0.f;
    const int ntile = (blockIdx.x * 256 + 256) / 64;
    for (int kt = 0; kt < ntile; ++kt) {
        __syncthreads();
        for (int i = threadIdx.x; i < 64 * 64; i += 256) { const int r = i >> 6, c = i & 63; const size_t rk = ((size_t)b * SEQ + kt * 64 + r) * DM + h * 64 + c; Ks[r][c] = bf2f(K[rk]); Vs[r][c] = bf2f(V[rk]); }
        if (threadIdx.x < 64) Fs[threadIdx.x] = FB[(size_t)bh * SEQ + kt * 64 + threadIdx.x];
        __syncthreads();
        for (int j = 0; j < 64; ++j) {
            const int s = kt * 64 + j; if (s > tq) break;
            float z = 0.f;
#pragma unroll
            for (int d = 0; d < 64; ++d) z += q[d] * Ks[j][d];
            z += (Ft - Fs[j]) * LOG2E;
            if (z > m) { const float c = exp2f(m - z); l *= c;
#pragma unroll
                for (int d = 0; d < 64; ++d) o[d] *= c;
                m = z; }
            const float p = exp2f(z - m); l += p;
#pragma unroll
            for (int d = 0; d < 64; ++d) o[d] += p * Vs[j][d];
        }
    }
    const float il = 1.f / l;
#pragma unroll
    for (int d = 0; d < 64; ++d) O[rowq * DM + h * 64 + d] = f2bf(o[d] * il);
}

__global__ void __launch_bounds__(256) n_sb_attn(const bf16_t* Q, const bf16_t* __restrict__ K, const bf16_t* __restrict__ V, bf16_t* O) {
    __shared__ float Ks[64][64], Vs[64][64];
    const int bh = blockIdx.y, b = bh >> 4, h = bh & 15, tq = blockIdx.x * 256 + threadIdx.x;
    const size_t rowq = (size_t)b * SEQ + tq;
    float q[64], o[64];
#pragma unroll
    for (int d = 0; d < 64; ++d) { q[d] = bf2f(Q[rowq * DM + h * 64 + d]) * 0.125f; o[d] = 0.f; }
    float R = 0.f;
    for (int kt = (blockIdx.x * 256 + 255) / 64; kt >= 0; --kt) {
        if (__syncthreads_and(R < SB_THR)) break;
        for (int i = threadIdx.x; i < 64 * 64; i += 256) { const int r = i >> 6, c = i & 63; const size_t rk = ((size_t)b * SEQ + kt * 64 + r) * DM + h * 64 + c; Ks[r][c] = bf2f(K[rk]); Vs[r][c] = bf2f(V[rk]); }
        __syncthreads();
        for (int j = 63; j >= 0; --j) {
            const int s = kt * 64 + j; if (s >= tq) continue;
            float z = 0.f;
#pragma unroll
            for (int d = 0; d < 64; ++d) z += q[d] * Ks[j][d];
            const float sp = softplusf(z);
            const float w = __expf((z - sp) + R);
            R -= sp;
#pragma unroll
            for (int d = 0; d < 64; ++d) o[d] += w * Vs[j][d];
        }
    }
#pragma unroll
    for (int d = 0; d < 64; ++d) O[rowq * DM + h * 64 + d] = f2bf(o[d]);
}

__global__ void __launch_bounds__(64) n_lru(const bf16_t* LX, const bf16_t* __restrict__ LG, const float* __restrict__ cw, const float* __restrict__ cb,
                                            const float* __restrict__ wa, const float* __restrict__ ba, const float* __restrict__ wx, const float* __restrict__ bx,
                                            const float* __restrict__ lam, bf16_t* YL) {
    __shared__ float xs[64];
    const int b = blockIdx.x >> 4, n = blockIdx.x & 15, e = threadIdx.x, ch = n * 64 + e;
    float wA[64], wX[64];
#pragma unroll
    for (int d = 0; d < 64; ++d) { wA[d] = wa[((size_t)n * 64 + d) * 64 + e]; wX[d] = wx[((size_t)n * 64 + d) * 64 + e]; }
    const float w0 = cw[ch], w1 = cw[DM + ch], w2 = cw[2 * DM + ch], w3 = cw[3 * DM + ch], bc = cb[ch], bA = ba[ch], bX = bx[ch];
    const float spl = softplusf(-lam[ch]);
    float x1 = 0.f, x2 = 0.f, x3 = 0.f, hs = 0.f;
    for (int t = 0; t < SEQ; ++t) {
        const size_t r = ((size_t)b * SEQ + t) * DM + ch;
        const float x0 = bf2f(LX[r]);
        const float xc = bc + w3 * x0 + w2 * x1 + w1 * x2 + w0 * x3;
        x3 = x2; x2 = x1; x1 = x0;
        __syncthreads();
        xs[e] = xc;
        __syncthreads();
        float ra = bA, ri = bX;
#pragma unroll
        for (int d = 0; d < 64; ++d) { const float xv = xs[d]; ra += xv * wA[d]; ri += xv * wX[d]; }
        const float rr = sigmoidf_(ra), ii = sigmoidf_(ri);
        const float la = -8.f * rr * spl;
        const float a = __expf(la);
        const float u = sqrtf(-expm1f(2.f * la)) * (ii * xc);
        hs = a * hs + u;
        YL[r] = f2bf(hs * gelu_tanh(bf2f(LG[r])));
    }
}

__global__ void __launch_bounds__(256) n_memkv_post(const float* __restrict__ raw, const float* __restrict__ gk, const float* __restrict__ gq, bf16_t* __restrict__ MK, bf16_t* __restrict__ MVT) {
    const int row = blockIdx.x, b = row >> 8, m = row & 255, d = threadIdx.x;
    __shared__ float red[4];
    for (int h = 0; h < 4; ++h) {
        const float k = raw[(size_t)row * 2048 + h * 256 + d];
        float ss = wave_sum(k * k);
        __syncthreads();
        if ((threadIdx.x & 63) == 0) red[threadIdx.x >> 6] = ss;
        __syncthreads();
        ss = red[0] + red[1] + red[2] + red[3];
        const float rstd = rsqrtf(ss * (1.f / 256.f) + EPS);
        MK[((size_t)b * 256 + m) * DM + h * 256 + d] = f2bf(k * rstd * gk[d] * gq[d]);
        MVT[(((size_t)b * 4 + h) * 256 + d) * 256 + m] = f2bf(raw[(size_t)row * 2048 + 1024 + h * 256 + d]);
    }
}

__global__ void __launch_bounds__(256) n_mem_attn(const bf16_t* MQ, const bf16_t* __restrict__ MK, const bf16_t* __restrict__ MVT, bf16_t* YM) {
    __shared__ float qs[256], ps[256], red[4];
    const int row = blockIdx.x >> 2, h = blockIdx.x & 3, b = row / SEQ, tid = threadIdx.x;
    const float qv = bf2f(MQ[(size_t)row * DM + h * 256 + tid]);
    float ss = wave_sum(qv * qv);
    if ((tid & 63) == 0) red[tid >> 6] = ss;
    qs[tid] = qv;
    __syncthreads();
    const float rstd = rsqrtf((red[0] + red[1] + red[2] + red[3]) * (1.f / 256.f) + EPS);
    const bf16_t* kr = MK + ((size_t)b * 256 + tid) * DM + h * 256;
    float s = 0.f;
    for (int d = 0; d < 256; ++d) s += qs[d] * bf2f(kr[d]);
    s *= rstd * (1.f / 16.f);
    __syncthreads();
    float mx = s;
#pragma unroll
    for (int o = 1; o < 64; o <<= 1) mx = fmaxf(mx, __shfl_xor(mx, o));
    if ((tid & 63) == 0) red[tid >> 6] = mx;
    __syncthreads();
    mx = fmaxf(fmaxf(red[0], red[1]), fmaxf(red[2], red[3]));
    const float p = __expf(s - mx);
    ps[tid] = p;
    float sum = wave_sum(p);
    __syncthreads();
    if ((tid & 63) == 0) red[tid >> 6] = sum;
    __syncthreads();
    sum = red[0] + red[1] + red[2] + red[3];
    const bf16_t* vr = MVT + (((size_t)b * 4 + h) * 256 + tid) * 256;
    float o = 0.f;
    for (int m = 0; m < 256; ++m) o += ps[m] * bf2f(vr[m]);
    YM[(size_t)row * DM + h * 256 + tid] = f2bf(o / sum);
}

__global__ void __launch_bounds__(256) n_act(const bf16_t* __restrict__ GV, const float* __restrict__ cw, const float* __restrict__ cb, bf16_t* __restrict__ ACT) {
    const size_t idx = (size_t)blockIdx.x * 256 + threadIdx.x; if (idx >= (size_t)T * DFF) return;
    const int r = (int)(idx / DFF), c = (int)(idx % DFF), t = r % SEQ;
    const float g0 = bf2f(GV[(size_t)r * 2 * DFF + c]);
    const float g1 = t >= 1 ? bf2f(GV[(size_t)(r - 1) * 2 * DFF + c]) : 0.f;
    const float g2 = t >= 2 ? bf2f(GV[(size_t)(r - 2) * 2 * DFF + c]) : 0.f;
    const float pre = cb[c] + cw[2 * DFF + c] * g0 + cw[DFF + c] * g1 + cw[c] * g2;
    const float val = bf2f(GV[(size_t)r * 2 * DFF + DFF + c]);
    ACT[(size_t)r * DFF + c] = f2bf(pre * sigmoidf_(pre) * val);
}

#define CFG 32767
namespace pg8 {
#define PG8_LAS __attribute__((address_space(3)))
typedef unsigned short bf16_t;
typedef short bf16x8 __attribute__((ext_vector_type(8)));
typedef float f32x4 __attribute__((ext_vector_type(4)));
typedef unsigned u32x4 __attribute__((ext_vector_type(4)));
constexpr int BM = 256, BK = 64, HALF = 128, HTB = HALF * BK * 2  , STAGE_BYTES = 8 * HTB, NXCD = 8, WGM = 8;

__host__ __device__ __forceinline__ int lds_byte(int r, int c) { const int st = (r >> 4) * 2 + (c >> 5), rr = r & 15, cc = c & 31, ob = rr * 64 + cc * 2; return st * 1024 + (ob ^ (((ob >> 9) & 1) << 5)); }
__host__ __device__ __forceinline__ void stage_rc(int b, int& R, int& C) { const int st = b / 1024, sb = b % 1024, swz = sb ^ (((sb >> 9) & 1) << 5); R = (st >> 1) * 16 + swz / 64; C = (st & 1) * 32 + (swz % 64) / 2; }
__host__ __device__ __forceinline__ int perm32(int rho) { const int n = rho >> 4, i = rho & 15; return 8 * (i >> 2) + 4 * n + (i & 3); }

struct Unit { int pm, pn; };
struct Gemm { int lda, ldb, K; };

struct StaticOrder {
    int nM, nN, nwg, G, c;
    __host__ __device__ void init(int M, int N, int G_, int c_) { nM = M / BM; nN = N / BM; nwg = nM * nN; G = G_; c = c_; }
    __host__ __device__ bool next(int i, Unit& u) const {
        const long L = (long)i * G + c; if (L >= nwg) return false;
        int wgid = (int)L; { const int q = nwg / NXCD, r = nwg % NXCD, xcd = wgid % NXCD, off = wgid / NXCD; wgid = (xcd < r ? xcd * (q + 1) : r * (q + 1) + (xcd - r) * q) + off; }
        const int nig = WGM * nN, gid = wgid / nig, fm = gid * WGM, gsz = (nM - fm) < WGM ? (nM - fm) : WGM;
        u.pm = fm + ((wgid % nig) % gsz); u.pn = (wgid % nig) / gsz; return true;
    }
    __device__ __forceinline__ void a_ready(const Unit&) const {}
    __device__ __forceinline__ void done(const Unit&) const {}
};

__device__ __forceinline__ unsigned cvt_pk_bf16(float lo, float hi) { unsigned r; asm volatile("v_cvt_pk_bf16_f32 %0, %1, %2" : "=v"(r) : "v"(lo), "v"(hi)); return r; }
typedef float f32x2 __attribute__((ext_vector_type(2)));
__device__ __forceinline__ f32x2 gelu_pk(f32x2 v) {
    const f32x2 av = __builtin_elementwise_abs(v), d = av * 0.2316418882f + 1.0f;
    f32x2 t; t.x = __builtin_amdgcn_rcpf(d.x); t.y = __builtin_amdgcn_rcpf(d.y);
    f32x2 q = t * 0.5307027145f + (-0.7265760135f); q = q * t + 0.7107068705f; q = q * t + (-0.142248368f); q = q * t + 0.127414796f; q = q * t;
    const f32x2 s = (v * v) * (-0.72134752044f);
    f32x2 e; e.x = __builtin_amdgcn_exp2f(s.x); e.y = __builtin_amdgcn_exp2f(s.y);
    const f32x2 m = v * (q * e), r = v - m;
    f32x2 o; o.x = v.x < 0.f ? m.x : r.x; o.y = v.y < 0.f ? m.y : r.y; return o;
}

template <class Epi, class Sched, bool ALIGN_EPI = false, bool SP2 = false>
__device__ __forceinline__ void gemm_phase(PG8_LAS unsigned char* lds, const Gemm g, const Sched& S, const Epi& E) {
    const int tid = mk_tid(), wid = __builtin_amdgcn_readfirstlane(tid >> 6), lane = tid & 63, wr = wid >> 2, wc = wid & 3, fr = lane & 15, fq = lane >> 4;
    const int K = g.K, nt = K / BK;
    unsigned voffA[2], voffB[2];
#pragma unroll
    for (int i = 0; i < 2; ++i) { int R, C; stage_rc(tid * 16 + i * 8192, R, C); const int Rb = Epi::PERM ? ((R & ~31) + perm32(R & 31)) : R;
        voffA[i] = (unsigned)(R * g.lda + C) * 2u; voffB[i] = (unsigned)(Rb * g.ldb + C) * 2u; }
    const size_t kstep = (size_t)(BK * 2);
    const size_t hstepA = (size_t)HALF * g.lda * 2, hstepB = (size_t)HALF * g.ldb * 2;
    const unsigned ldsw = (unsigned)wid * 1024u;
    const int aoff = lds_byte(wr * 64 + fr, fq * 8), boff = lds_byte(wc * 32 + fr, fq * 8);
#define PG8_SA(b, h) (((b) * 2 + (h)) * HTB)
#define PG8_SB(b, h) ((4 + (b) * 2 + (h)) * HTB)
#define PG8_STAGE(bufoff, gbase, voff) do { _Pragma("unroll") for (int _i = 0; _i < 2; ++_i) \
        __builtin_amdgcn_global_load_lds((const unsigned*)((const char*)(gbase) + (voff)[_i]), (PG8_LAS unsigned*)(lds + (bufoff) + ldsw + _i * 8192), 16, 0, 0); } while (0)
#define PG8_LDA(dst, b, h) do { _Pragma("unroll") for (int m = 0; m < 4; ++m) _Pragma("unroll") for (int k = 0; k < 2; ++k) dst[m][k] = *(const PG8_LAS bf16x8*)(lds + PG8_SA(b, h) + aoff + m * 2048 + k * 1024); } while (0)
#define PG8_LDB(dst, b, h) do { _Pragma("unroll") for (int n = 0; n < 2; ++n) _Pragma("unroll") for (int k = 0; k < 2; ++k) dst[n][k] = *(const PG8_LAS bf16x8*)(lds + PG8_SB(b, h) + boff + n * 2048 + k * 1024); } while (0)
#define PG8_MMA(ai, bj, At, Bt) do { __builtin_amdgcn_s_setprio(1); _Pragma("unroll") for (int m = 0; m < 4; ++m) _Pragma("unroll") for (int n = 0; n < 2; ++n) _Pragma("unroll") for (int k = 0; k < 2; ++k) \
        acc[ai][bj][m][n] = __builtin_amdgcn_mfma_f32_16x16x32_bf16(Bt[n][k], At[m][k], acc[ai][bj][m][n], 0, 0, 0); __builtin_amdgcn_s_setprio(0); } while (0)
#define PG8_WAIT_V(n) asm volatile("s_waitcnt vmcnt(" #n ")" ::: "memory")
#define PG8_WAIT_L(n) asm volatile("s_waitcnt lgkmcnt(" #n ")" ::: "memory")
#define PG8_BAR __builtin_amdgcn_s_barrier()
#define PG8_SCHED __builtin_amdgcn_sched_barrier(0)
    Unit cur, nxt; int ui = 0;
    if (!S.next(0, cur)) return;
    f32x4 acc[2][2][4][2];
#pragma unroll
    for (int a = 0; a < 2; ++a)
#pragma unroll
        for (int b = 0; b < 2; ++b)
#pragma unroll
            for (int m = 0; m < 4; ++m)
#pragma unroll
                for (int n = 0; n < 2; ++n) acc[a][b][m][n] = (f32x4){0.f, 0.f, 0.f, 0.f};
    bf16x8 At[4][2], B0[2][2], B1[2][2];
    const char* cA = S.aptr(cur); const char* cB = S.bptr(cur);
    S.a_ready(cur);
    if constexpr (SP2) {
        PG8_STAGE(PG8_SB(0, 0), cB, voffB); PG8_STAGE(PG8_SB(0, 1), cB + hstepB, voffB); PG8_STAGE(PG8_SA(0, 0), cA, voffA); PG8_STAGE(PG8_SA(0, 1), cA + hstepA, voffA);
        if (wr == 1) PG8_BAR;
        PG8_WAIT_V(2); PG8_BAR;
        PG8_STAGE(PG8_SB(1, 0), cB + kstep, voffB); PG8_STAGE(PG8_SA(1, 0), cA + kstep, voffA); PG8_STAGE(PG8_SB(1, 1), cB + hstepB + kstep, voffB);
        PG8_WAIT_V(6); PG8_BAR;
    } else {
        PG8_STAGE(PG8_SB(0, 0), cB, voffB); PG8_STAGE(PG8_SA(0, 0), cA, voffA); PG8_STAGE(PG8_SB(0, 1), cB + hstepB, voffB); PG8_STAGE(PG8_SA(0, 1), cA + hstepA, voffA);
        if (wr == 1) PG8_BAR;
        PG8_WAIT_V(4); PG8_BAR;
        PG8_STAGE(PG8_SB(1, 0), cB + kstep, voffB); PG8_STAGE(PG8_SA(1, 0), cA + kstep, voffA); PG8_STAGE(PG8_SB(1, 1), cB + hstepB + kstep, voffB);
        PG8_WAIT_V(6); PG8_BAR;
    }
    for (;;) {
        const bool has_next = S.next(ui + 1, nxt);
        const char* nA = has_next ? S.aptr(nxt) : cA; const char* nB = has_next ? S.bptr(nxt) : cB;
        for (int t = 0; t < nt; t += 2) {
            const bool last = (t == nt - 2);
            const char* a1 = cA + (size_t)(t + 1) * kstep;
            const char* a2 = last ? nA : cA + (size_t)(t + 2) * kstep; const char* b2 = last ? nB : cB + (size_t)(t + 2) * kstep;
            const char* a3 = a2 + kstep; const char* b3 = b2 + kstep;
            if (last && has_next) S.a_ready(nxt);
            if constexpr (SP2) {
            PG8_LDB(B0, 0, 0); PG8_LDB(B1, 0, 1); PG8_SCHED; PG8_LDA(At, 0, 0); PG8_STAGE(PG8_SA(1, 1), a1 + hstepA, voffA);
            PG8_WAIT_V(8); PG8_WAIT_L(0); PG8_BAR; PG8_MMA(0, 0, At, B0); PG8_MMA(0, 1, At, B1); PG8_BAR; PG8_SCHED;
            PG8_LDA(At, 0, 1); PG8_STAGE(PG8_SB(0, 0), b2, voffB); PG8_STAGE(PG8_SB(0, 1), b2 + hstepB, voffB); PG8_STAGE(PG8_SA(0, 0), a2, voffA);
            PG8_WAIT_V(8); PG8_WAIT_L(0); PG8_BAR; PG8_MMA(1, 0, At, B0); PG8_MMA(1, 1, At, B1); PG8_BAR; PG8_SCHED;
            PG8_LDB(B0, 1, 0); PG8_LDB(B1, 1, 1); PG8_SCHED; PG8_LDA(At, 1, 0); PG8_STAGE(PG8_SA(0, 1), a2 + hstepA, voffA);
            PG8_WAIT_V(8); PG8_WAIT_L(0); PG8_BAR; PG8_MMA(0, 0, At, B0); PG8_MMA(0, 1, At, B1); PG8_BAR; PG8_SCHED;
            PG8_LDA(At, 1, 1); PG8_STAGE(PG8_SB(1, 0), b3, voffB); PG8_STAGE(PG8_SB(1, 1), b3 + hstepB, voffB); PG8_STAGE(PG8_SA(1, 0), a3, voffA);
            PG8_WAIT_V(8); PG8_WAIT_L(0); PG8_BAR; PG8_MMA(1, 0, At, B0); PG8_MMA(1, 1, At, B1); PG8_BAR; PG8_SCHED;
            } else {
            PG8_LDB(B0, 0, 0); PG8_SCHED; PG8_LDA(At, 0, 0); PG8_STAGE(PG8_SA(1, 1), a1 + hstepA, voffA);
            PG8_WAIT_L(8); PG8_BAR; PG8_WAIT_L(0); PG8_MMA(0, 0, At, B0); PG8_BAR; PG8_SCHED;
            PG8_LDB(B1, 0, 1); PG8_STAGE(PG8_SB(0, 0), b2, voffB);
            PG8_BAR; PG8_WAIT_L(0); PG8_MMA(0, 1, At, B1); PG8_BAR;
            PG8_LDA(At, 0, 1); PG8_STAGE(PG8_SA(0, 0), a2, voffA);
            PG8_BAR; PG8_WAIT_L(0); PG8_MMA(1, 0, At, B0); PG8_BAR; PG8_SCHED;
            PG8_STAGE(PG8_SB(0, 1), b2 + hstepB, voffB);
            PG8_WAIT_V(6); PG8_BAR; PG8_MMA(1, 1, At, B1); PG8_BAR;
            PG8_LDB(B0, 1, 0); PG8_SCHED; PG8_LDA(At, 1, 0); PG8_STAGE(PG8_SA(0, 1), a2 + hstepA, voffA);
            PG8_WAIT_L(8); PG8_BAR; PG8_WAIT_L(0); PG8_MMA(0, 0, At, B0); PG8_BAR; PG8_SCHED;
            PG8_LDB(B1, 1, 1); PG8_STAGE(PG8_SB(1, 0), b3, voffB);
            PG8_BAR; PG8_WAIT_L(0); PG8_MMA(0, 1, At, B1); PG8_BAR;
            PG8_LDA(At, 1, 1); PG8_STAGE(PG8_SA(1, 0), a3, voffA);
            PG8_BAR; PG8_WAIT_L(0); PG8_MMA(1, 0, At, B0); PG8_BAR; PG8_SCHED;
            PG8_STAGE(PG8_SB(1, 1), b3 + hstepB, voffB);
            PG8_WAIT_V(6); PG8_BAR; PG8_MMA(1, 1, At, B1); PG8_BAR;
            }
        }
        if constexpr (ALIGN_EPI) { if (wr == 0) PG8_BAR; }
        if constexpr (!Epi::AFTER_DRAIN) { int fr_ = fr, fq_ = fq; asm volatile("" : "+v"(fr_), "+v"(fq_));   E(acc, cur, wr, wc, fr_, fq_); S.done(cur); }
        if (!has_next) break;
#pragma unroll
        for (int a = 0; a < 2; ++a)
#pragma unroll
            for (int b = 0; b < 2; ++b)
#pragma unroll
                for (int m = 0; m < 4; ++m)
#pragma unroll
                    for (int n = 0; n < 2; ++n) acc[a][b][m][n] = (f32x4){0.f, 0.f, 0.f, 0.f};
        cur = nxt; cA = nA; cB = nB; ++ui;
        if constexpr (ALIGN_EPI) { if (wr == 1) PG8_BAR; }
    }
    PG8_WAIT_V(0);
    if constexpr (!ALIGN_EPI) { if (wr == 0) PG8_BAR; }
    PG8_BAR;
    if constexpr (Epi::AFTER_DRAIN) { E.fused(acc, cur, wr, wc, fr, fq, lds, wid, lane); S.done(cur); }
#undef PG8_SA
#undef PG8_SB
#undef PG8_STAGE
#undef PG8_LDA
#undef PG8_LDB
#undef PG8_MMA
#undef PG8_WAIT_V
#undef PG8_WAIT_L
#undef PG8_BAR
#undef PG8_SCHED
}
}
#include <hip/hip_bf16.h>
#include <cmath>
namespace attn_body {
using bf16=__hip_bfloat16;
using bf16x8=__attribute__((ext_vector_type(8)))short;
using s16x4=__attribute__((ext_vector_type(4)))short;
using f32x16=__attribute__((ext_vector_type(16)))float;
using u32x4=__attribute__((ext_vector_type(4)))unsigned;
constexpr int BATCH=2,NHEAD=16,SEQ=8192,D=64,DM=NHEAD*D;
constexpr int NW=8,QBLK=32,QB=QBLK*NW,KVBLK=64,NQB=SEQ/QB;
constexpr int ATTN_PITCH=DM, ATTN_UNIT_ROWS=QB;
__device__ __forceinline__ int crow(int r,int hi){return (r&3)+8*(r>>2)+4*hi;}
#define SBAR() __builtin_amdgcn_sched_barrier(0)
__device__ __forceinline__ void cmask(f32x16&p0,f32x16&p1,int jb,int qrel,int hi){
  const float NEG=-INFINITY; int kb=64*jb+4*hi;
  #pragma unroll
  for(int r=0;r<16;++r){int kv=kb+(r&3)+8*(r>>2); if(kv>qrel)p0[r]=NEG; if(kv+32>qrel)p1[r]=NEG;}
}

constexpr int NSLOT=3, SLOTB=8192;
constexpr int LDS_K=0, LDS_V=NSLOT*SLOTB, LDS_WS=2*NSLOT*SLOTB, LDS_OST=LDS_WS+NW*64*4, LDS_BYTES=LDS_OST+NW*4096;
constexpr int BIAS_OFF=86016;
constexpr float C2=0.125f*1.4426950408889634f;
__device__ __forceinline__ void glds16(const void*gsrc,unsigned lds_dst){unsigned keep;
  asm volatile("s_mov_b32 %0, m0\n\ts_mov_b32 m0, %2\n\ts_nop 0\n\tglobal_load_lds_dwordx4 %1, off\n\ts_mov_b32 m0, %0":"=&s"(keep):"v"(gsrc),"s"(lds_dst):"memory");}
__device__ __forceinline__ float max3f(float a,float b,float c){float r;asm("v_max3_f32 %0, %1, %2, %3":"=v"(r):"v"(a),"v"(b),"v"(c));return r;}
__device__ __forceinline__ float max2f(float a,float b){float r;asm("v_max_f32_e32 %0, %1, %2":"=v"(r):"v"(a),"v"(b));return r;}
__device__ __forceinline__ float fadd_s(float a,float b){float r;asm("v_add_f32_e32 %0, %1, %2":"=v"(r):"v"(a),"v"(b));return r;}
__device__ __forceinline__ float fsub_s(float a,float b){float r;asm("v_sub_f32_e32 %0, %1, %2":"=v"(r):"v"(a),"v"(b));return r;}
typedef float f32x2_t __attribute__((ext_vector_type(2))); typedef __bf16 bf16x2_t __attribute__((ext_vector_type(2)));
__device__ __forceinline__ unsigned cvtpk_s(float lo,float hi){f32x2_t v={lo,hi};bf16x2_t b=__builtin_convertvector(v,bf16x2_t);return __builtin_bit_cast(unsigned,b);}
#define WAIT_BAR(N) asm volatile("s_waitcnt vmcnt(" #N ") lgkmcnt(0)\n\ts_barrier":::"memory")

__device__ __forceinline__ void qkt(f32x16&p0,f32x16&p1,const char*Kslot,const bf16x8*qr,const f32x16&negm,int r32,int hi){
  const char*kb=Kslot+hi*1024+r32*16;
  #pragma unroll
  for(int d0=0;d0<4;++d0){
    const bf16x8 b0=*reinterpret_cast<const bf16x8*>(kb+d0*2048);
    const bf16x8 b1=*reinterpret_cast<const bf16x8*>(kb+d0*2048+512);
    if(d0==0){p0=__builtin_amdgcn_mfma_f32_32x32x16_bf16(b0,qr[0],negm,0,0,0);p1=__builtin_amdgcn_mfma_f32_32x32x16_bf16(b1,qr[0],negm,0,0,0);}
    else{p0=__builtin_amdgcn_mfma_f32_32x32x16_bf16(b0,qr[d0],p0,0,0,0);p1=__builtin_amdgcn_mfma_f32_32x32x16_bf16(b1,qr[d0],p1,0,0,0);}}
}
typedef __attribute__((address_space(3))) const char* lds_cptr;
typedef short v4i16_t __attribute__((ext_vector_type(4)));
__device__ __forceinline__ void kload8(bf16x8*kf,lds_cptr kp){
  kf[0]=*(const __attribute__((address_space(3))) bf16x8*)(kp);      kf[1]=*(const __attribute__((address_space(3))) bf16x8*)(kp+512);
  kf[2]=*(const __attribute__((address_space(3))) bf16x8*)(kp+2048); kf[3]=*(const __attribute__((address_space(3))) bf16x8*)(kp+2560);
  kf[4]=*(const __attribute__((address_space(3))) bf16x8*)(kp+4096); kf[5]=*(const __attribute__((address_space(3))) bf16x8*)(kp+4608);
  kf[6]=*(const __attribute__((address_space(3))) bf16x8*)(kp+6144); kf[7]=*(const __attribute__((address_space(3))) bf16x8*)(kp+6656);
}
__device__ __forceinline__ void kload2(bf16x8*kf,lds_cptr kp,int j){ kf[2*j]=*(const __attribute__((address_space(3))) bf16x8*)(kp+j*2048); kf[2*j+1]=*(const __attribute__((address_space(3))) bf16x8*)(kp+j*2048+512); }
__device__ __forceinline__ s16x4 vtr(lds_cptr p){ return __builtin_bit_cast(s16x4,__builtin_amdgcn_ds_read_tr16_b64_v4i16((__attribute__((address_space(3))) v4i16_t*)p)); }
__device__ __forceinline__ float rowmax(const f32x16&p0,const f32x16&p1){
  float a=max3f(p0[0],p0[1],p1[0]),b=max3f(p0[2],p0[3],p1[1]);a=max3f(a,p1[2],p1[3]);
  #pragma unroll
  for(int r=4;r<16;r+=4){a=max3f(a,p0[r],p0[r+1]);b=max3f(b,p0[r+2],p0[r+3]);a=max3f(a,p1[r],p1[r+1]);b=max3f(b,p1[r+2],p1[r+3]);}
  const float m=max2f(a,b);
  auto rr=__builtin_amdgcn_permlane32_swap(__float_as_uint(m),__float_as_uint(m),false,false);
  return max2f(__uint_as_float(rr[0]),__uint_as_float(rr[1]));
}
__device__ __forceinline__ void pv(f32x16*o,int vb,bf16x8 pa0,bf16x8 pa1,bf16x8 pa2,bf16x8 pa3){
  #pragma unroll
  for(int d0=0;d0<2;++d0){s16x4 lo[4],hi[4];
    #pragma unroll
    for(int ks=0;ks<4;++ks){
      asm volatile("ds_read_b64_tr_b16 %0,%1 offset:%c2":"=&v"(lo[ks]):"v"(vb),"i"(d0*4096+ks*1024):"memory");
      asm volatile("ds_read_b64_tr_b16 %0,%1 offset:%c2":"=&v"(hi[ks]):"v"(vb),"i"(d0*4096+ks*1024+512):"memory");}
    asm volatile("s_waitcnt lgkmcnt(0)":::"memory");SBAR();
    #define PK(k) (bf16x8){lo[k][0],lo[k][1],lo[k][2],lo[k][3],hi[k][0],hi[k][1],hi[k][2],hi[k][3]}
    o[d0]=__builtin_amdgcn_mfma_f32_32x32x16_bf16(pa0,PK(0),o[d0],0,0,0);
    o[d0]=__builtin_amdgcn_mfma_f32_32x32x16_bf16(pa1,PK(1),o[d0],0,0,0);
    o[d0]=__builtin_amdgcn_mfma_f32_32x32x16_bf16(pa2,PK(2),o[d0],0,0,0);
    o[d0]=__builtin_amdgcn_mfma_f32_32x32x16_bf16(pa3,PK(3),o[d0],0,0,0);
    #undef PK
  }
}

#ifndef ATTN_STORE16
#define ATTN_STORE16(p,v) (*(u32x4*)(p)=(v))
#endif
template<int THRL> __device__ __forceinline__ void attn_unit(int b,int h,int qb,const bf16*Q,const bf16*__restrict__ K,const bf16*__restrict__ V,bf16*O,const float*__restrict__ FBrow,float skip_thr,char*shm){
  const int tid=mk_tid(),lane=tid&63,r32=lane&31,hi=lane>>5; const int wid=__builtin_amdgcn_readfirstlane(tid>>6);
  const long rowbase=(long)b*SEQ; const int q0=qb*QB;
  int t_start=0;
  { const int ntf=(q0+QB)/KVBLK; const float Fq0=FBrow[q0];
    const bool c0=lane<ntf&&(Fq0-FBrow[64*(lane<ntf?lane:0)+63])*1.4426950408889634f<skip_thr;
    const bool c1=(lane+64)<ntf&&(Fq0-FBrow[64*((lane+64)<ntf?lane+64:0)+63])*1.4426950408889634f<skip_thr;
    int cnt=__popcll(__ballot(c0))+__popcll(__ballot(c1)); cnt&=~1; if(cnt>ntf-4)cnt=ntf-4; t_start=__builtin_amdgcn_readfirstlane(cnt); }
  const bf16*Qw=Q+(rowbase+q0+wid*QBLK)*DM+h*D;
  const bf16*Kh=K+(rowbase+(long)t_start*KVBLK)*DM+h*D,*Vh=V+(rowbase+(long)t_start*KVBLK)*DM+h*D;
  const lds_cptr shm3=(lds_cptr)shm;
  const unsigned lds0=(unsigned)(uintptr_t)shm;
  float*wsf=(float*)(shm+LDS_WS)+wid*64;
  const bf16*ksrc=Kh+(long)lane*DM+wid*8;
  const bf16*vsrc=Vh+(long)(16*(wid&3)+(lane>>2))*DM+(wid>>2)*32+(lane&3)*8;
  const unsigned kdst=lds0+LDS_K+wid*1024, vdst=lds0+LDS_V+wid*1024;
  #define DMA_K(t,slot) glds16(ksrc+(long)(t)*KVBLK*DM,(unsigned)__builtin_amdgcn_readfirstlane(kdst+(slot)))
  #define DMA_V(t,slot) glds16(vsrc+(long)(t)*KVBLK*DM,(unsigned)__builtin_amdgcn_readfirstlane(vdst+(slot)))
  const int vb0=(int)(lds0+LDS_V)+((lane>>4)&1)*32+(lane&3)*8+(4*hi+((lane&15)>>2))*64;
  const char*Kbase=shm+LDS_K; bf16x8 kf[8];
  const lds_cptr kp0=shm3+LDS_K+hi*1024+r32*16; const lds_cptr vp0=shm3+LDS_V+((lane>>4)&1)*32+(lane&3)*8+(4*hi+((lane&15)>>2))*64;
  const int NT=(q0+QB)/KVBLK-t_start;
  {
    typedef __attribute__((address_space(3))) float lds_f32; lds_f32* bl=(lds_f32*)(shm3+BIAS_OFF);
    const int nb=q0+QB; const float Fl=FBrow[nb-1];
    for(int i=t_start*KVBLK+tid;i<nb;i+=NW*64) bl[i]=(Fl-FBrow[i])*1.4426950408889634f;
    asm volatile("s_waitcnt vmcnt(0) lgkmcnt(0)\n\ts_barrier":::"memory"); }
  typedef float f32x4v __attribute__((ext_vector_type(4)));
  #define BIAS(P0,P1,t) do{ const __attribute__((address_space(3))) f32x4v* bp_=(const __attribute__((address_space(3))) f32x4v*)(shm3+BIAS_OFF)+((t)+t_start)*16+hi; \
    _Pragma("unroll") for(int g_=0;g_<4;++g_){ const f32x4v f0_=bp_[2*g_]+nm, f1_=bp_[8+2*g_]+nm; \
      P0[4*g_]+=f0_[0];P0[4*g_+1]+=f0_[1];P0[4*g_+2]+=f0_[2];P0[4*g_+3]+=f0_[3]; P1[4*g_]+=f1_[0];P1[4*g_+1]+=f1_[1];P1[4*g_+2]+=f1_[2];P1[4*g_+3]+=f1_[3]; } }while(0)
  DMA_K(0,0);DMA_V(0,0);DMA_K(1,SLOTB);
  bf16x8 qr[4];
  #pragma unroll
  for(int d0=0;d0<4;++d0)qr[d0]=*reinterpret_cast<const bf16x8*>(&Qw[(long)r32*DM+d0*16+hi*8]);
  float mhat=0.f,l_reg=0.f;f32x16 o[2];o[0]=f32x16{};o[1]=f32x16{};const f32x16 negm=f32x16{}; float nm=0.f;
  const int qrel=wid*QBLK+r32;
  #define CMASK(P0,P1,t) do{int jb_=(t)-(NT-4); if(jb_>=0)cmask(P0,P1,jb_,qrel,hi);}while(0)
  bool resc=false;
  #define START(P0,P1) do{ const float rm=rowmax(P0,P1); resc=false; \
    { const float dl=rm; mhat=fadd_s(mhat,dl); \
      _Pragma("unroll") for(int r=0;r<16;++r){P0[r]=fsub_s(P0[r],dl);P1[r]=fsub_s(P1[r],dl);} \
      nm=-mhat; } \
    _Pragma("unroll") for(int r=0;r<16;++r)P0[r]=__builtin_amdgcn_exp2f(P0[r]); }while(0)
  #define RESC() do{ if(resc){ asm volatile("s_waitcnt lgkmcnt(0)":::"memory"); \
      _Pragma("unroll") for(int d_=0;d_<2;++d_) _Pragma("unroll") for(int r=0;r<16;++r)o[d_][r]*=wsf[crow(r,hi)]; } }while(0)
  f32x16 pA0,pA1,pB0,pB1;
  int sl_prev=0,sl_cur=0,sl_next=SLOTB;
  #define ROT() do{sl_prev=sl_cur;sl_cur=sl_next;sl_next=(sl_next==(NSLOT-1)*SLOTB)?0:sl_next+SLOTB;}while(0)
  DMA_K(2,2*SLOTB);
  WAIT_BAR(3);
  qkt(pA0,pA1,Kbase,qr,negm,r32,hi);asm volatile("s_nop 15\n\ts_nop 7":"+v"(pA0),"+v"(pA1));BIAS(pA0,pA1,0);CMASK(pA0,pA1,0);
  START(pA0,pA1);
  _Pragma("unroll") for(int r=0;r<16;++r)pA1[r]=__builtin_amdgcn_exp2f(pA1[r]);
  WAIT_BAR(0);
  DMA_K(3,0);DMA_V(1,SLOTB);
  ROT();
  kload8(kf,kp0+sl_cur);
  WAIT_BAR(2);
  s16x4 vlo[8],vhi[8]; u32x4 pw0,pw1,pw2,pw3;
  #define PKW(P,B) cvtpk_s(P[B],P[B+1])
  #define PAF(k) __builtin_bit_cast(bf16x8,pw##k)
  #define VFR(i) (bf16x8){vlo[i][0],vlo[i][1],vlo[i][2],vlo[i][3],vhi[i][0],vhi[i][1],vhi[i][2],vhi[i][3]}
  #define PIN(x) asm volatile("":"+v"(x))
  #define MX3(a,b,c) __builtin_fmaxf(__builtin_fmaxf((a),(b)),(c))
  #define GAPA(MF,A0,A1,A2,A3,W0,W1,PW) do{ MF; sacc+=A0; sacc+=A1; sacc+=A2; sacc+=A3; PIN(sacc); W0; W1; PIN(PW); SBAR(); }while(0)
  #define EX(v) __builtin_amdgcn_exp2f(v)
  #define GAPB(MF,X,B) do{ MF; X[B]=EX(X[B]); X[B+1]=EX(X[B+1]); X[B+2]=EX(X[B+2]); X[B+3]=EX(X[B+3]); PIN(X); SBAR(); }while(0)
  #define VRD(i) do{ vlo[i]=vtr(vp_+(((i)>>2)*4096+((i)&3)*1024)); vhi[i]=vtr(vp_+(((i)>>2)*4096+((i)&3)*1024+512)); }while(0)
  #define KRD(G,j) do{ if(G){ kload2(kf,kp0+sl_next,j); SBAR(); } }while(0)
  #define STEP(C0,C1,P0,P1,t,GK,GV,GL) do{ SBAR(); \
    const lds_cptr vp_=vp0+sl_prev; \
    VRD(0); SBAR(); float sacc=(P0[0]+P0[1]); \
    GAPA(C0=__builtin_amdgcn_mfma_f32_32x32x16_bf16(kf[0],qr[0],negm,0,0,0), P0[2],P0[3],P0[4],P0[5],     pw0[0]=PKW(P0,0), pw0[1]=PKW(P0,2), pw0); \
    VRD(4); SBAR(); GAPA(C1=__builtin_amdgcn_mfma_f32_32x32x16_bf16(kf[1],qr[0],negm,0,0,0), P0[6],P0[7],P0[8],P0[9],     pw0[2]=PKW(P0,4), pw0[3]=PKW(P0,6), pw0); \
    VRD(1); SBAR(); GAPA(C0=__builtin_amdgcn_mfma_f32_32x32x16_bf16(kf[2],qr[1],C0,0,0,0),   P0[10],P0[11],P0[12],P0[13], pw1[0]=PKW(P0,8), pw1[1]=PKW(P0,10), pw1); \
    VRD(5); SBAR(); GAPA(C1=__builtin_amdgcn_mfma_f32_32x32x16_bf16(kf[3],qr[1],C1,0,0,0),   P0[14],P0[15],P1[0],P1[1],   pw1[2]=PKW(P0,12),pw1[3]=PKW(P0,14), pw1); \
    VRD(2); SBAR(); GAPA(C0=__builtin_amdgcn_mfma_f32_32x32x16_bf16(kf[4],qr[2],C0,0,0,0),   P1[2],P1[3],P1[4],P1[5],     pw2[0]=PKW(P1,0), pw2[1]=PKW(P1,2), pw2); \
    VRD(6); SBAR(); GAPA(C1=__builtin_amdgcn_mfma_f32_32x32x16_bf16(kf[5],qr[2],C1,0,0,0),   P1[6],P1[7],P1[8],P1[9],     pw2[2]=PKW(P1,4), pw2[3]=PKW(P1,6), pw2); \
    VRD(3); SBAR(); GAPA(C0=__builtin_amdgcn_mfma_f32_32x32x16_bf16(kf[6],qr[3],C0,0,0,0),   P1[10],P1[11],P1[12],P1[13], pw3[0]=PKW(P1,8), pw3[1]=PKW(P1,10), pw3); \
    VRD(7); SBAR(); GAPA(C1=__builtin_amdgcn_mfma_f32_32x32x16_bf16(kf[7],qr[3],C1,0,0,0),   P1[14],P1[15],0.f,0.f,       pw3[2]=PKW(P1,12),pw3[3]=PKW(P1,14), pw3); \
    l_reg+=sacc; \
    if(GK){DMA_K((t)+3,sl_cur);} if(GV){DMA_V((t)+1,sl_next);} \
    BIAS(C0,C1,t); CMASK(C0,C1,t); \
    { float a=MX3(C0[0],C0[1],C1[0]),b=MX3(C0[2],C0[3],C1[1]); a=MX3(a,C1[2],C1[3]); \
      _Pragma("unroll") for(int r=4;r<16;r+=4){a=MX3(a,C0[r],C0[r+1]);b=MX3(b,C0[r+2],C0[r+3]);a=MX3(a,C1[r],C1[r+1]);b=MX3(b,C1[r+2],C1[r+3]);} \
      float rm=__builtin_fmaxf(a,b); { auto rr=__builtin_amdgcn_permlane32_swap(__float_as_uint(rm),__float_as_uint(rm),false,false); rm=__builtin_fmaxf(__uint_as_float(rr[0]),__uint_as_float(rr[1])); } \
      resc=false; \
      if(__builtin_expect(__any(rm>(float)THRL),0)){ const float dl=__builtin_fmaxf(rm,0.f); mhat+=dl; \
        _Pragma("unroll") for(int r=0;r<16;++r){C0[r]-=dl;C1[r]-=dl;} \
        nm=-mhat; \
        const float f=__builtin_amdgcn_exp2f(-dl); l_reg*=f; if(hi==0)wsf[r32]=f; resc=true; } } \
    SBAR(); \
    GAPB(o[0]=__builtin_amdgcn_mfma_f32_32x32x16_bf16(PAF(0),VFR(0),o[0],0,0,0), C0,0); \
    GAPB(o[1]=__builtin_amdgcn_mfma_f32_32x32x16_bf16(PAF(0),VFR(4),o[1],0,0,0), C0,4); \
    KRD(GL,0); GAPB(o[0]=__builtin_amdgcn_mfma_f32_32x32x16_bf16(PAF(1),VFR(1),o[0],0,0,0), C0,8); \
    KRD(GL,1); GAPB(o[1]=__builtin_amdgcn_mfma_f32_32x32x16_bf16(PAF(1),VFR(5),o[1],0,0,0), C0,12); \
    KRD(GL,2); GAPB(o[0]=__builtin_amdgcn_mfma_f32_32x32x16_bf16(PAF(2),VFR(2),o[0],0,0,0), C1,0); \
    KRD(GL,3); GAPB(o[1]=__builtin_amdgcn_mfma_f32_32x32x16_bf16(PAF(2),VFR(6),o[1],0,0,0), C1,4); \
    GAPB(o[0]=__builtin_amdgcn_mfma_f32_32x32x16_bf16(PAF(3),VFR(3),o[0],0,0,0), C1,8); \
    GAPB(o[1]=__builtin_amdgcn_mfma_f32_32x32x16_bf16(PAF(3),VFR(7),o[1],0,0,0), C1,12); \
    }while(0)
  int t=1;
  #undef CMASK
  #define CMASK(P0,P1,t) do{}while(0)
  for(;t+5<NT;t+=2){
    STEP(pB0,pB1,pA0,pA1,t,true,true,true);     WAIT_BAR(2); RESC(); ROT();
    STEP(pA0,pA1,pB0,pB1,t+1,true,true,true);   WAIT_BAR(2); RESC(); ROT();
  }
  #undef CMASK
  #define CMASK(P0,P1,t) do{int jb_=(t)-(NT-4); if(jb_>=0)cmask(P0,P1,jb_,qrel,hi);}while(0)
  #define ENDW(tt) do{ if((tt)+3<NT){WAIT_BAR(2);} else if((tt)+2<NT){WAIT_BAR(1);} else {WAIT_BAR(0);} }while(0)
  for(;t+1<NT;t+=2){
    STEP(pB0,pB1,pA0,pA1,t,(t+3<NT),(t+1<NT),(t+1<NT));       ENDW(t);   RESC(); ROT();
    STEP(pA0,pA1,pB0,pB1,t+1,(t+4<NT),(t+2<NT),(t+2<NT));     ENDW(t+1); RESC(); ROT();
  }
  STEP(pB0,pB1,pA0,pA1,NT-1,false,false,false); RESC();
  { float sacc=pB0[0]+pB0[1]; _Pragma("unroll") for(int r=2;r<16;++r)sacc+=pB0[r]; _Pragma("unroll") for(int r=0;r<16;++r)sacc+=pB1[r]; l_reg+=sacc;
    pw0=(u32x4){PKW(pB0,0),PKW(pB0,2),PKW(pB0,4),PKW(pB0,6)};pw1=(u32x4){PKW(pB0,8),PKW(pB0,10),PKW(pB0,12),PKW(pB0,14)};pw2=(u32x4){PKW(pB1,0),PKW(pB1,2),PKW(pB1,4),PKW(pB1,6)};pw3=(u32x4){PKW(pB1,8),PKW(pB1,10),PKW(pB1,12),PKW(pB1,14)};
    SBAR(); pv(o,vb0+sl_cur,PAF(0),PAF(1),PAF(2),PAF(3)); }
  #undef PKW
  #undef PAF
  #undef VFR
  #undef PIN
  #undef MX3
  #undef GAPA
  #undef GAPB
  #undef EX
  #undef VRD
  #undef KRD
  #undef STEP
  #undef ENDW
  {auto rr=__builtin_amdgcn_permlane32_swap(__float_as_uint(l_reg),__float_as_uint(l_reg),false,false);l_reg=__uint_as_float(rr[0])+__uint_as_float(rr[1]);}
  if(hi==0)wsf[32+r32]=l_reg;asm volatile("s_waitcnt lgkmcnt(0)":::"memory");
  float rli[16];
  #pragma unroll
  for(int r=0;r<16;++r)rli[r]=__builtin_amdgcn_rcpf(wsf[32+crow(r,hi)]);
  bf16*Ow=O+(rowbase+q0+wid*QBLK)*DM+h*D;
  { bf16*stg=(bf16*)(shm+LDS_OST)+wid*2048;
    #pragma unroll
    for(int r=0;r<16;++r){const int orow=crow(r,hi);
      #pragma unroll
      for(int d0=0;d0<2;++d0)stg[orow*64+d0*32+r32]=__float2bfloat16(o[d0][r]*rli[r]);}
    asm volatile("s_waitcnt lgkmcnt(0)":::"memory");
    #pragma unroll
    for(int i=0;i<4;++i){const int row=i*8+(lane>>3),ch=lane&7; const u32x4 v=*(const u32x4*)(stg+row*64+ch*8); ATTN_STORE16(Ow+(long)row*DM+ch*8,v);} }
  asm volatile("s_waitcnt lgkmcnt(0)\n\ts_barrier":::"memory");
  #undef BIAS
  #undef DMA_K
  #undef DMA_V
  #undef CMASK
  #undef START
  #undef RESC
  #undef ROT
}
constexpr int ATTN_LDS_BYTES=86016+32768;
struct AttnTensors { const bf16* Q; const bf16* K; const bf16* V; bf16* O; const float* FB; float skip_thr; int pad; };
struct AttnUnit { int bh; int qb; };
struct StaticOrder {
  int vcu;
  __device__ __forceinline__ explicit StaticOrder(int grid,int block):vcu((block%8)*(grid/8)+block/8){}
  __device__ __forceinline__ bool next(int i,AttnUnit&u)const{ if(i>=4)return false; const int s=vcu&7; u.bh=vcu>>3; u.qb=(i==0)?s:(i==1)?15-s:(i==2)?16+s:31-s; return true; }
  __device__ __forceinline__ void a_ready(const AttnUnit&)const{}
  __device__ __forceinline__ void done(const AttnUnit&)const{}
};
struct QueueOrder {
  unsigned* ctr; int xl; volatile __attribute__((address_space(3))) int* slot;
  __device__ __forceinline__ bool next(int,AttnUnit&u)const{
    if(mk_tid()==0){ int got=-1;
      for(int k=0;k<8&&got<0;++k){ const int q=(xl+k)&7; const int j=(int)__hip_atomic_fetch_add(ctr+q*64,1u,__ATOMIC_RELAXED,__HIP_MEMORY_SCOPE_AGENT); if(j<128)got=q*128+j; }
      *slot=got; }
    __syncthreads(); const int g=*slot; if(g<0)return false; const int q=g>>7,j=g&127; u.bh=q*4+(j&3); u.qb=31-(j>>2); return true; }
  __device__ __forceinline__ void a_ready(const AttnUnit&)const{}
  __device__ __forceinline__ void done(const AttnUnit&)const{}
};
template<class Sched,int THRL=8> __device__ __forceinline__ void attn_phase(char*lds,const AttnTensors&T,const Sched&S){
  AttnUnit u;
  for(int i=0;S.next(i,u);++i){ S.a_ready(u); attn_unit<THRL>(u.bh/NHEAD,u.bh%NHEAD,u.qb,T.Q,T.K,T.V,T.O,T.FB+(size_t)u.bh*SEQ,T.skip_thr,lds); S.done(u); }
}
#undef SBAR
#undef WAIT_BAR
}
namespace cg = cooperative_groups;
#define LAS __attribute__((address_space(3)))
#define LDS_WAIT() asm volatile("s_waitcnt lgkmcnt(0)" ::: "memory")
constexpr int MEGA_THREADS = 512, MEGA_LDS = 147456, NWV = 8;
#define GAS __attribute__((address_space(1)))
#define XB_TMO      128
#define XB_XCNT(j)  (256  + 64 * (j))
#define XB_XSUB(j)  (1280 + 64 * (j))
#define XB_XGEN(j)  (2304 + 64 * (j))
#define XB_TOP      3328
#define XB_TOPGEN   3392
#define XCD_BAR_WORDS 3456
#define XB_SPIN_CAP (1u << 18)

__device__ __forceinline__ unsigned xb_ld(unsigned* p)              { return __hip_atomic_load(p, __ATOMIC_RELAXED, __HIP_MEMORY_SCOPE_AGENT); }
__device__ __forceinline__ unsigned xb_add(unsigned* p, unsigned v) { return __hip_atomic_fetch_add(p, v, __ATOMIC_RELAXED, __HIP_MEMORY_SCOPE_AGENT); }
__device__ __forceinline__ unsigned xb_xcc_id() { return (unsigned)__builtin_amdgcn_s_getreg((3 << 11) | 20) & 0xFu; }
#define XB_SPIN(cond, bar) do { unsigned _sp = 0; while (cond) { __builtin_amdgcn_s_sleep(1); \
    if ((++_sp & 255u) == 0u) { if (xb_ld(&(bar)[XB_TMO])) break; if (_sp > XB_SPIN_CAP) { atomicAdd(&(bar)[XB_TMO], 1u); break; } } } } while (0)

struct XcdBarrier {
    unsigned* bar; unsigned x;
    volatile LAS unsigned* st;
};

__device__ __forceinline__ XcdBarrier xcd_barrier_post(unsigned* bar, volatile LAS unsigned* st) {
    XcdBarrier b; b.bar = bar; b.x = xb_xcc_id(); b.st = st;
    if (threadIdx.x == 0) (void)xb_add(&bar[XB_XCNT(b.x)], 1u);
    return b;
}
__device__ __forceinline__ void xcd_barrier_complete(unsigned* bar, unsigned x, unsigned& nloc, unsigned& nx) {
    const unsigned G = gridDim.x * gridDim.y * gridDim.z;
    unsigned sum, cnt, mine, sp = 0u;
    for (;;) {
        sum = 0u; cnt = 0u; mine = 0u;
#pragma unroll
        for (unsigned j = 0; j < 16; ++j) { const unsigned c = xb_ld(&bar[XB_XCNT(j)]); sum += c; cnt += (c > 0u) ? 1u : 0u; mine = (j == x) ? c : mine; }
        if (sum == G) break;
        __builtin_amdgcn_s_sleep(1);
        if ((++sp & 255u) == 0u) { if (xb_ld(&bar[XB_TMO])) break; if (sp > XB_SPIN_CAP) { atomicAdd(&bar[XB_TMO], 1u); break; } }
    }
    nloc = mine > 0u ? mine : 1u; nx = cnt > 0u ? cnt : 1u;
}

__device__ __forceinline__ void xcd_barrier(const XcdBarrier& b) {
    asm volatile("s_waitcnt vmcnt(0)" ::: "memory");
    __syncthreads();
    if (threadIdx.x == 0) {
        unsigned* bar = b.bar;
        __builtin_amdgcn_s_waitcnt(0);
        unsigned nloc = b.st[0], nx = b.st[1];
        if (nloc == 0u) { xcd_barrier_complete(bar, b.x, nloc, nx); b.st[0] = nloc; b.st[1] = nx; }
        const unsigned old = xb_add(&bar[XB_XSUB(b.x)], 1u);
        const unsigned gen = old / nloc;
        if (old + 1u == (gen + 1u) * nloc) {
            __builtin_amdgcn_fence(__ATOMIC_RELEASE, "agent");
            asm volatile("s_waitcnt vmcnt(0)" ::: "memory");
            const unsigned og = xb_add(&bar[XB_TOP], 1u);
            const unsigned tg = og / nx;
            if (og + 1u == (tg + 1u) * nx) xb_add(&bar[XB_TOPGEN], 1u);
            else XB_SPIN(xb_ld(&bar[XB_TOPGEN]) == tg, bar);
            __builtin_amdgcn_fence(__ATOMIC_ACQUIRE, "agent");
            xb_add(&bar[XB_XGEN(b.x)], 1u);
            asm volatile("s_waitcnt vmcnt(0)" ::: "memory");
        } else {
            XB_SPIN(xb_ld(&bar[XB_XGEN(b.x)]) == gen, bar);
            __builtin_amdgcn_fence(__ATOMIC_ACQUIRE, "agent");
            asm volatile("s_waitcnt vmcnt(0)" ::: "memory");
        }
    }
    __syncthreads();
}
constexpr size_t WS_BAR = WS_CTL + 16384;
constexpr size_t WS_QCTR = WS_CTL + 32768;
constexpr size_t CTL_ZERO_BYTES = 65536 - 16384;
constexpr int XB_LDS_OFF = MEGA_LDS - 64;
constexpr size_t WT_IN = 0;
constexpr size_t WT_BR = WT_IN + (size_t)13312 * 1024 * 2;
constexpr size_t WT_OUT = WT_BR + (size_t)4096 * 1024 * 2;
constexpr size_t WT_UP = WT_OUT + (size_t)1024 * 1024 * 2;
constexpr size_t WT_DN = WT_UP + (size_t)5632 * 1024 * 2;
static_assert(WT_DN + (size_t)1024 * 2816 * 2 <= 72 * MiB, "weight copies");
constexpr size_t WS_WKVT = WS_GATES;
constexpr size_t WS_CB = WS_CTL + 4096;

typedef float f32x4 __attribute__((ext_vector_type(4)));
typedef unsigned u32x4 __attribute__((ext_vector_type(4)));
typedef short bf16x8_t __attribute__((ext_vector_type(8)));
typedef float f32x16_t __attribute__((ext_vector_type(16)));
__device__ __forceinline__ unsigned pk2(float lo, float hi) { return (unsigned)f2bf(lo) | ((unsigned)f2bf(hi) << 16); }
__device__ __forceinline__ float blo(unsigned u) { return __uint_as_float(u << 16); }
__device__ __forceinline__ float bhi(unsigned u) { return __uint_as_float(u & 0xffff0000u); }
__device__ __forceinline__ float fast_softplus(float x) { return fmaxf(x, 0.f) + __logf(1.f + __expf(-fabsf(x))); }
__device__ __forceinline__ float fast_sigmoid(float x) { return __builtin_amdgcn_rcpf(1.f + __expf(-x)); }
__device__ __forceinline__ float fast_tanh(float x) { const float e = __expf(-2.f * fabsf(x)); const float t = (1.f - e) * __builtin_amdgcn_rcpf(1.f + e); return x < 0.f ? -t : t; }
__device__ __forceinline__ float fast_gelu(float x) { const float u = 0.7978845608028654f * (x + 0.044715f * x * x * x); return 0.5f * x * (1.f + fast_tanh(u)); }

template <class Loc> struct LocOrder {
    pg8::StaticOrder so; Loc loc;
    __device__ __forceinline__ bool next(int i, pg8::Unit& u) const { return so.next(i, u); }
    __device__ __forceinline__ const char* aptr(const pg8::Unit& u) const { return loc.a(u); }
    __device__ __forceinline__ const char* bptr(const pg8::Unit& u) const { return loc.b(u); }
    __device__ __forceinline__ void a_ready(const pg8::Unit&) const {}
    __device__ __forceinline__ void done(const pg8::Unit&) const {}
};
struct LocStd { const char* A; const char* Bt; size_t astep, bstep;
    __device__ __forceinline__ const char* a(const pg8::Unit& u) const { return A + (size_t)u.pm * astep; }
    __device__ __forceinline__ const char* b(const pg8::Unit& u) const { return Bt + (size_t)u.pn * bstep; } };
struct LocBranch { const char* Y0; const char* Y1; const char* Y2; const char* Y3; const char* Bt;
    __device__ __forceinline__ const char* a(const pg8::Unit& u) const { const int i = u.pn >> 2; const char* y = i == 0 ? Y0 : i == 1 ? Y1 : i == 2 ? Y2 : Y3; return y + (size_t)u.pm * (256 * 1024 * 2); }
    __device__ __forceinline__ const char* b(const pg8::Unit& u) const { return Bt + (size_t)u.pn * (256 * 1024 * 2); } };
struct LocMemKV { const char* A; const char* Bt;
    __device__ __forceinline__ const char* a(const pg8::Unit& u) const { return A + (size_t)u.pm * (256 * 1024 * 2); }
    __device__ __forceinline__ const char* b(const pg8::Unit& u) const { return Bt + ((size_t)(u.pm >> 1) * 2048 + (size_t)u.pn * 256) * 2048; } };
struct LocMemS { const char* MQ; const char* MK;
    __device__ __forceinline__ const char* a(const pg8::Unit& u) const { return MQ + (size_t)u.pm * (256 * 2048) + u.pn * 512; }
    __device__ __forceinline__ const char* b(const pg8::Unit& u) const { return MK + (size_t)(u.pm >> 5) * (256 * 2048) + u.pn * 512; } };
struct LocMemPV { const char* E; const char* MVT;
    __device__ __forceinline__ const char* a(const pg8::Unit& u) const { return E + (size_t)u.pm * (256 * 2048) + u.pn * 512; }
    __device__ __forceinline__ const char* b(const pg8::Unit& u) const { return MVT + ((size_t)(u.pm >> 5) * 4 + u.pn) * (256 * 256 * 2); } };

struct BranchSched { int vcu; LocBranch loc;
    __device__ __forceinline__ bool next(int i, pg8::Unit& u) const { if (i >= 4) return false; u.pm = vcu >> 2; u.pn = i * 4 + (vcu & 3); return true; }
    __device__ __forceinline__ const char* aptr(const pg8::Unit& u) const { return loc.a(u); }
    __device__ __forceinline__ const char* bptr(const pg8::Unit& u) const { return loc.b(u); }
    __device__ __forceinline__ void a_ready(const pg8::Unit&) const {}
    __device__ __forceinline__ void done(const pg8::Unit&) const {}
};
typedef f32x4 AccT[2][2][4][2];
struct EpiProj { static constexpr bool PERM = true, AFTER_DRAIN = false; bf16_t* proj; bf16_t* gates; float* mqss;
    __device__ __forceinline__ void operator()(const AccT& acc, const pg8::Unit& u, int wr, int wc, int fr, int fq) const {
        int colt = u.pn * 256; const int grp = colt >> 10; bf16_t* base; int ldc;
        if (grp < 9) { base = proj + (size_t)grp * T * DM; ldc = DM; colt &= 1023; } else { base = gates; ldc = 4096; colt -= 9216; }
        const int row0 = u.pm * 256 + wr * 64 + fr, col0 = colt + wc * 32 + 8 * fq;
#pragma unroll
        for (int ai = 0; ai < 2; ++ai)
#pragma unroll
            for (int m = 0; m < 4; ++m) { const int row = row0 + ai * 128 + m * 16; bf16_t* rowp = base + (size_t)row * ldc + col0; float ss = 0.f;
#pragma unroll
                for (int bj = 0; bj < 2; ++bj) { const f32x4 v0 = acc[ai][bj][m][0], v1 = acc[ai][bj][m][1]; u32x4 w; w.x = pk2(v0[0], v0[1]); w.y = pk2(v0[2], v0[3]); w.z = pk2(v1[0], v1[1]); w.w = pk2(v1[2], v1[3]);
                    *(u32x4*)(rowp + bj * 128) = w;
                    if (grp == 8) { ss += blo(w.x) * blo(w.x) + bhi(w.x) * bhi(w.x) + blo(w.y) * blo(w.y) + bhi(w.y) * bhi(w.y) + blo(w.z) * blo(w.z) + bhi(w.z) * bhi(w.z) + blo(w.w) * blo(w.w) + bhi(w.w) * bhi(w.w); } }
                if (grp == 8) { ss += __shfl_xor(ss, 16); ss += __shfl_xor(ss, 32); if (fq == 0) mqss[(size_t)row * 16 + (colt >> 8) * 4 + wc] = ss; } }
    } };
struct EpiBf16P { static constexpr bool PERM = true, AFTER_DRAIN = false; bf16_t* O; int ldc; int pad;
    __device__ __forceinline__ void operator()(const AccT& acc, const pg8::Unit& u, int wr, int wc, int fr, int fq) const {
        const int row0 = u.pm * 256 + wr * 64 + fr, col0 = u.pn * 256 + wc * 32 + 8 * fq;
#pragma unroll
        for (int ai = 0; ai < 2; ++ai)
#pragma unroll
            for (int m = 0; m < 4; ++m) { bf16_t* rowp = O + (size_t)(row0 + ai * 128 + m * 16) * ldc + col0;
#pragma unroll
                for (int bj = 0; bj < 2; ++bj) { const f32x4 v0 = acc[ai][bj][m][0], v1 = acc[ai][bj][m][1]; u32x4 w; w.x = pk2(v0[0], v0[1]); w.y = pk2(v0[2], v0[3]); w.z = pk2(v1[0], v1[1]); w.w = pk2(v1[2], v1[3]);
                    *(u32x4*)(rowp + bj * 128) = w; } }
    } };
struct EpiF32 { static constexpr bool PERM = false, AFTER_DRAIN = false; float* O; int ldc; int pad;
    __device__ __forceinline__ void operator()(const AccT& acc, const pg8::Unit& u, int wr, int wc, int fr, int fq) const {
        const int row0 = u.pm * 256 + wr * 64 + fr, col0 = u.pn * 256 + wc * 32 + 4 * fq;
#pragma unroll
        for (int ai = 0; ai < 2; ++ai)
#pragma unroll
            for (int m = 0; m < 4; ++m) { float* rowp = O + (size_t)(row0 + ai * 128 + m * 16) * ldc + col0;
#pragma unroll
                for (int bj = 0; bj < 2; ++bj)
#pragma unroll
                    for (int n = 0; n < 2; ++n) *(f32x4*)(rowp + bj * 128 + n * 16) = acc[ai][bj][m][n]; }
    } };
struct EpiResid { static constexpr bool PERM = false, AFTER_DRAIN = false; const float* base; float* out;
    __device__ __forceinline__ void operator()(const AccT& acc, const pg8::Unit& u, int wr, int wc, int fr, int fq) const {
        const int row0 = u.pm * 256 + wr * 64 + fr, col0 = u.pn * 256 + wc * 32 + 4 * fq;
#pragma unroll
        for (int ai = 0; ai < 2; ++ai)
#pragma unroll
            for (int m = 0; m < 4; ++m) { const size_t off = (size_t)(row0 + ai * 128 + m * 16) * DM + col0;
#pragma unroll
                for (int bj = 0; bj < 2; ++bj)
#pragma unroll
                    for (int n = 0; n < 2; ++n) { const f32x4 b = *(const f32x4*)(base + off + bj * 128 + n * 16); *(f32x4*)(out + off + bj * 128 + n * 16) = b + acc[ai][bj][m][n]; } }
    } };
struct EpiBranch { static constexpr bool PERM = true, AFTER_DRAIN = false; const bf16_t* G; const float* bg; float* MIXF; bf16_t* MIXED;
    __device__ __forceinline__ void operator()(const AccT& acc, const pg8::Unit& u, int wr, int wc, int fr, int fq) const {
        const int i = u.pn >> 2, row0 = u.pm * 256 + wr * 64 + fr, gcol0 = u.pn * 256 + wc * 32 + 8 * fq, mcol0 = (u.pn & 3) * 256 + wc * 32 + 8 * fq;
#pragma unroll
        for (int ai = 0; ai < 2; ++ai)
#pragma unroll
            for (int m = 0; m < 4; ++m) { const int row = row0 + ai * 128 + m * 16; const bf16_t* gp = G + (size_t)row * 4096 + gcol0; const size_t mo = (size_t)row * DM + mcol0;
#pragma unroll
                for (int bj = 0; bj < 2; ++bj) { const u32x4 gw = *(const u32x4*)(gp + bj * 128); const f32x4 b0 = *(const f32x4*)(bg + gcol0 + bj * 128), b1 = *(const f32x4*)(bg + gcol0 + bj * 128 + 4);
                    f32x4 v0 = acc[ai][bj][m][0], v1 = acc[ai][bj][m][1];
                    v0[0] *= fast_sigmoid(blo(gw.x) + b0[0]); v0[1] *= fast_sigmoid(bhi(gw.x) + b0[1]); v0[2] *= fast_sigmoid(blo(gw.y) + b0[2]); v0[3] *= fast_sigmoid(bhi(gw.y) + b0[3]);
                    v1[0] *= fast_sigmoid(blo(gw.z) + b1[0]); v1[1] *= fast_sigmoid(bhi(gw.z) + b1[1]); v1[2] *= fast_sigmoid(blo(gw.w) + b1[2]); v1[3] *= fast_sigmoid(bhi(gw.w) + b1[3]);
                    if (i > 0) { v0 += *(const f32x4*)(MIXF + mo + bj * 128); v1 += *(const f32x4*)(MIXF + mo + bj * 128 + 4); }
                    if (i < 3) { *(f32x4*)(MIXF + mo + bj * 128) = v0; *(f32x4*)(MIXF + mo + bj * 128 + 4) = v1; }
                    else { u32x4 w; w.x = pk2(v0[0], v0[1]); w.y = pk2(v0[2], v0[3]); w.z = pk2(v1[0], v1[1]); w.w = pk2(v1[2], v1[3]); *(u32x4*)(MIXED + mo + bj * 128) = w; } }
                asm volatile("" ::: "memory"); }
    } };
struct EpiSexp { static constexpr bool PERM = true, AFTER_DRAIN = false; bf16_t* E; const float* mqss; float* esum; const float* cb;
    __device__ __forceinline__ void operator()(const AccT& acc, const pg8::Unit& u, int wr, int wc, int fr, int fq) const {
        const int row0 = u.pm * 256 + wr * 64 + fr, col0 = u.pn * 256 + wc * 32 + 8 * fq; const float shift = cb[0];
#pragma unroll
        for (int ai = 0; ai < 2; ++ai)
#pragma unroll
            for (int m = 0; m < 4; ++m) { const int row = row0 + ai * 128 + m * 16; const f32x4 p = *(const f32x4*)(mqss + (size_t)row * 16 + u.pn * 4);
                const float sc = rsqrtf(((p[0] + p[1]) + (p[2] + p[3])) * (1.f / 256.f) + EPS) * (1.f / 16.f); bf16_t* rowp = E + (size_t)row * DM + col0; float sum = 0.f;
#pragma unroll
                for (int bj = 0; bj < 2; ++bj) { const f32x4 v0 = acc[ai][bj][m][0], v1 = acc[ai][bj][m][1]; u32x4 w;
                    w.x = pk2(__expf(v0[0] * sc - shift), __expf(v0[1] * sc - shift)); w.y = pk2(__expf(v0[2] * sc - shift), __expf(v0[3] * sc - shift));
                    w.z = pk2(__expf(v1[0] * sc - shift), __expf(v1[1] * sc - shift)); w.w = pk2(__expf(v1[2] * sc - shift), __expf(v1[3] * sc - shift));
                    *(u32x4*)(rowp + bj * 128) = w;
                    sum += (blo(w.x) + bhi(w.x)) + (blo(w.y) + bhi(w.y)) + (blo(w.z) + bhi(w.z)) + (blo(w.w) + bhi(w.w)); }
                sum += __shfl_xor(sum, 16); sum += __shfl_xor(sum, 32); if (fq == 0) esum[(size_t)row * 16 + u.pn * 4 + wc] = sum;
                asm volatile("" ::: "memory"); }
    } };
struct EpiMemPV { static constexpr bool PERM = true, AFTER_DRAIN = false; bf16_t* Y; const float* esum;
    __device__ __forceinline__ void operator()(const AccT& acc, const pg8::Unit& u, int wr, int wc, int fr, int fq) const {
        const int row0 = u.pm * 256 + wr * 64 + fr, col0 = u.pn * 256 + wc * 32 + 8 * fq;
#pragma unroll
        for (int ai = 0; ai < 2; ++ai)
#pragma unroll
            for (int m = 0; m < 4; ++m) { const int row = row0 + ai * 128 + m * 16; const f32x4 p = *(const f32x4*)(esum + (size_t)row * 16 + u.pn * 4);
                const float il = 1.f / ((p[0] + p[1]) + (p[2] + p[3])); bf16_t* rowp = Y + (size_t)row * DM + col0;
#pragma unroll
                for (int bj = 0; bj < 2; ++bj) { const f32x4 v0 = acc[ai][bj][m][0] * il, v1 = acc[ai][bj][m][1] * il; u32x4 w; w.x = pk2(v0[0], v0[1]); w.y = pk2(v0[2], v0[3]); w.z = pk2(v1[0], v1[1]); w.w = pk2(v1[2], v1[3]);
                    *(u32x4*)(rowp + bj * 128) = w; }
                asm volatile("" ::: "memory"); }
    } };

__device__ __forceinline__ void tr_item(const float* __restrict__ W, int ldw, bf16_t* __restrict__ WT, int ldk, int nblk, LAS float* scr, int item, int lane, int ncopies, int cstride) {
    const int kb = item / nblk, nb = item % nblk, k0 = 64 * kb, n0 = 32 * nb;
#pragma unroll
    for (int i = 0; i < 32; ++i) { const int kk = 2 * i + (lane >> 5); scr[kk * 33 + (lane & 31)] = W[(size_t)(k0 + kk) * ldw + n0 + (lane & 31)]; }
    LDS_WAIT(); asm volatile("" ::: "memory");
    const int c = lane & 7;
#pragma unroll
    for (int j = 0; j < 4; ++j) { const int n = (lane >> 3) + 8 * j; const LAS float* s = scr + (8 * c) * 33 + n;
        u32x4 o; o.x = pk2(s[0 * 33], s[1 * 33]); o.y = pk2(s[2 * 33], s[3 * 33]); o.z = pk2(s[4 * 33], s[5 * 33]); o.w = pk2(s[6 * 33], s[7 * 33]);
        for (int cp = 0; cp < ncopies; ++cp) *(u32x4*)(WT + (size_t)(n0 + n) * ldk + k0 + 8 * c + cp * cstride) = o; }
    LDS_WAIT(); asm volatile("" ::: "memory");
}
__device__ __forceinline__ void norm_row(const float* __restrict__ xrow, const float* __restrict__ g, bf16_t* __restrict__ hrow, const LAS float* WfT, bool do_logf, const float* __restrict__ bfg, float* __restrict__ LOGF, int row, int lane) {
    const f32x4* xr = (const f32x4*)xrow; const f32x4* gr = (const f32x4*)g;
    f32x4 v[4]; float ss = 0.f;
#pragma unroll
    for (int j = 0; j < 4; ++j) { v[j] = xr[lane + 64 * j]; ss += (v[j][0] * v[j][0] + v[j][1] * v[j][1]) + (v[j][2] * v[j][2] + v[j][3] * v[j][3]); }
    ss = wave_sum(ss);
    const float rstd = rsqrtf(ss * (1.f / DM) + EPS);
#pragma unroll
    for (int j = 0; j < 4; ++j) { v[j] = v[j] * rstd * gr[lane + 64 * j];
        uint2 o; o.x = pk2(v[j][0], v[j][1]); o.y = pk2(v[j][2], v[j][3]); ((uint2*)hrow)[lane + 64 * j] = o; }
    if (do_logf) {
        float mine = 0.f;
#pragma unroll 4
        for (int h = 0; h < 16; ++h) { float p = 0.f;
#pragma unroll
            for (int j = 0; j < 4; ++j) { const f32x4 w = *(const LAS f32x4*)(WfT + h * 1024 + (lane + 64 * j) * 4); p += (v[j][0] * w[0] + v[j][1] * w[1]) + (v[j][2] * w[2] + v[j][3] * w[3]); }
            p = wave_sum(p); if (lane == h) mine = p; }
        if (lane < 16) { const int b = row / SEQ, t = row % SEQ; LOGF[((size_t)b * 16 + lane) * SEQ + t] = logsigmoidf(mine + bfg[lane]); }
    }
}
__device__ __forceinline__ void headnorm64_row(bf16_t* row, const float* __restrict__ g, float scale, int lane) {
    u32x4* p = (u32x4*)row + lane * 2; u32x4 a = p[0], b = p[1];
    float v[16] = {blo(a.x), bhi(a.x), blo(a.y), bhi(a.y), blo(a.z), bhi(a.z), blo(a.w), bhi(a.w), blo(b.x), bhi(b.x), blo(b.y), bhi(b.y), blo(b.z), bhi(b.z), blo(b.w), bhi(b.w)};
    float ss = 0.f;
#pragma unroll
    for (int i = 0; i < 16; ++i) ss += v[i] * v[i];
    ss += __shfl_xor(ss, 1); ss += __shfl_xor(ss, 2);
    const float rstd = rsqrtf(ss * (1.f / 64.f) + EPS) * scale; const f32x4* gp = (const f32x4*)(g + (lane & 3) * 16);
#pragma unroll
    for (int i = 0; i < 4; ++i) { const f32x4 gg = gp[i]; v[4 * i] *= rstd * gg[0]; v[4 * i + 1] *= rstd * gg[1]; v[4 * i + 2] *= rstd * gg[2]; v[4 * i + 3] *= rstd * gg[3]; }
    a.x = pk2(v[0], v[1]); a.y = pk2(v[2], v[3]); a.z = pk2(v[4], v[5]); a.w = pk2(v[6], v[7]); b.x = pk2(v[8], v[9]); b.y = pk2(v[10], v[11]); b.z = pk2(v[12], v[13]); b.w = pk2(v[14], v[15]);
    p[0] = a; p[1] = b;
}
__device__ __forceinline__ void cumsum_block(const float* __restrict__ src, float* __restrict__ dst, LAS float* part, int tid) {
    const int lane = tid & 63, wave = tid >> 6; const f32x4* s4 = (const f32x4*)(src + tid * 16); float v[16]; float s = 0.f;
#pragma unroll
    for (int i = 0; i < 4; ++i) { const f32x4 x = s4[i]; s += x[0]; v[4 * i] = s; s += x[1]; v[4 * i + 1] = s; s += x[2]; v[4 * i + 2] = s; s += x[3]; v[4 * i + 3] = s; }
    float incl = s;
#pragma unroll
    for (int o = 1; o < 64; o <<= 1) { const float t_ = __shfl_up(incl, o); if (lane >= o) incl += t_; }
    __syncthreads();
    if (lane == 63) part[wave] = incl;
    __syncthreads();
    float off = incl - s;
    for (int w = 0; w < wave; ++w) off += part[w];
    f32x4* d4 = (f32x4*)(dst + tid * 16);
#pragma unroll
    for (int i = 0; i < 4; ++i) d4[i] = (f32x4){off + v[4 * i], off + v[4 * i + 1], off + v[4 * i + 2], off + v[4 * i + 3]};
}

__device__ __forceinline__ float neg_expm1_small(float x) {
    const float p = -x * (1.f + x * (0.5f + x * (0.16666667f + x * (0.041666668f + x * (0.0083333338f + x * 0.0013888889f)))));
    return x > -0.25f ? p : 1.f - __expf(x);
}
constexpr int LRU_XCB = 0, LRU_WT = 9216, LRU_R = LRU_WT + 18432, LRU_SEG = LRU_R + 33792;
template <bool FINAL> __device__ __forceinline__ void lru_load(int it, int n, const bf16_t* __restrict__ LX, const bf16_t* __restrict__ LG, float (&xw)[11], float (&gl)[8], int tid) {
    const int b = it >> 11, c = (it >> 4) & 127, e = tid & 63, tg = tid >> 6, ch = n * 64 + e, t0 = c * 64 + tg * 8;
#pragma unroll
    for (int j = 0; j < 11; ++j) { const int t = t0 + j - 3; xw[j] = t >= 0 ? bf2f(LX[((size_t)b * SEQ + t) * DM + ch]) : 0.f; }
    if (FINAL) {
#pragma unroll
        for (int j = 0; j < 8; ++j) gl[j] = bf2f(LG[((size_t)b * SEQ + t0 + j) * DM + ch]); }
}
template <bool FINAL> __device__ __forceinline__ void lru_item(int b, int c, int n, const float (&xw)[11], const float (&gl)[8], bf16_t* __restrict__ YL,
        const float w0, const float w1, const float w2, const float w3, const float bc, const float bA, const float bX,
        const float spl, float* APROD, float* HEND, LAS unsigned char* lds, int tid, int par) {
    const int e = tid & 63, tg = tid >> 6, ch = n * 64 + e, lane = e, wv = tg;
    LAS float* R = (LAS float*)(lds + LRU_R);
    LAS float* segP = (LAS float*)(lds + LRU_SEG);
    LAS float* segH = segP + 512, *carP = segH + 512 + par * 1024, *carH = carP + 512;
    const int t0 = c * 64 + tg * 8; const size_t row0 = (size_t)b * SEQ + t0;
    float xc[8];
#pragma unroll
    for (int j = 0; j < 8; ++j) { xc[j] = bc + w3 * xw[j + 3] + w2 * xw[j + 2] + w1 * xw[j + 1] + w0 * xw[j]; *(LAS bf16_t*)(lds + LRU_XCB + (tg * 8 + j) * 144 + e * 2) = f2bf(xc[j]); }
    if (FINAL) {
        float cp = 1.f, chh = 0.f; const int per = (c + 7) >> 3; const int lo = tg * per; int hi = lo + per; if (hi > c) hi = c;
        for (int cc = lo; cc < hi; ++cc) { const size_t si = ((size_t)b * 128 + cc) * DM + ch; const float A = APROD[si], Hc = HEND[si]; chh = A * chh + Hc; cp *= A; }
        carP[tg * 64 + e] = cp; carH[tg * 64 + e] = chh; }
    __syncthreads();
    { const int th = wv & 1, cb = wv >> 1, r32 = lane & 31, hi = lane >> 5; f32x16_t acc = {};
#pragma unroll
        for (int ks = 0; ks < 4; ++ks) { const bf16x8_t af = *(const LAS bf16x8_t*)(lds + LRU_XCB + (32 * th + r32) * 144 + (16 * ks + 8 * hi) * 2), bfr = *(const LAS bf16x8_t*)(lds + LRU_WT + (32 * cb + r32) * 144 + (16 * ks + 8 * hi) * 2);
            acc = __builtin_amdgcn_mfma_f32_32x32x16_bf16(af, bfr, acc, 0, 0, 0); }
#pragma unroll
        for (int r = 0; r < 16; ++r) R[(32 * th + (r & 3) + 8 * (r >> 2) + 4 * hi) * 132 + 32 * cb + r32] = acc[r]; }
    __syncthreads();
    float av[8], uv[8]; float P = 1.f, Hh = 0.f;
#pragma unroll
    for (int j = 0; j < 8; ++j) { const float ra = bA + R[(tg * 8 + j) * 132 + e], ri = bX + R[(tg * 8 + j) * 132 + 64 + e];
        const float rr = fast_sigmoid(ra), ii = fast_sigmoid(ri); const float la = -8.f * rr * spl; av[j] = __expf(la); uv[j] = __builtin_amdgcn_sqrtf(neg_expm1_small(2.f * la)) * (ii * xc[j]);
        Hh = av[j] * Hh + uv[j]; P *= av[j]; }
    segP[tg * 64 + e] = P; segH[tg * 64 + e] = Hh;
    __syncthreads();
    if (FINAL) {
        float h = 0.f;
#pragma unroll
        for (int s = 0; s < 8; ++s) h = carP[s * 64 + e] * h + carH[s * 64 + e];
        for (int t2 = 0; t2 < tg; ++t2) h = segP[t2 * 64 + e] * h + segH[t2 * 64 + e];
#pragma unroll
        for (int j = 0; j < 8; ++j) { h = av[j] * h + uv[j]; YL[(row0 + j) * DM + ch] = f2bf(h * fast_gelu(gl[j])); }
    } else if (tg == 7) {
        float h = 0.f, p = 1.f;
#pragma unroll
        for (int s = 0; s < 8; ++s) { h = segP[s * 64 + e] * h + segH[s * 64 + e]; p *= segP[s * 64 + e]; }
        const size_t si = ((size_t)b * 128 + c) * DM + ch; APROD[si] = p; HEND[si] = h;
    }
}
template <bool FINAL> __device__ __forceinline__ void lru_pass(int l, int bx, int G, const float* const* in, const bf16_t* LX, const bf16_t* LG, bf16_t* YL, float* APROD, float* HEND, LAS unsigned char* lds, int tid) {
    const int n = bx & 15, e = tid & 63, ch = n * 64 + e;
    { const float* wa = in[10] + (size_t)l * 65536 + (size_t)n * 4096; const float* wx = in[12] + (size_t)l * 65536 + (size_t)n * 4096;
        for (int i = tid; i < 8192; i += MEGA_THREADS) { const int mat = i >> 12, d = (i >> 6) & 63, ee = i & 63; *(LAS bf16_t*)(lds + LRU_WT + (mat * 64 + ee) * 144 + d * 2) = f2bf(mat ? wx[i & 4095] : wa[i & 4095]); } }
    const float* cw = in[8] + (size_t)l * 4 * DM; const float w0 = cw[ch], w1 = cw[DM + ch], w2 = cw[2 * DM + ch], w3 = cw[3 * DM + ch], bc = in[9][l * DM + ch];
    const float bA = in[11][l * DM + ch], bX = in[13][l * DM + ch], spl = softplusf(-in[14][l * DM + ch]);
    float xwn[11], gln[8];
#pragma unroll
    for (int j = 0; j < 8; ++j) gln[j] = 0.f;
    lru_load<FINAL>(bx, n, LX, LG, xwn, gln, tid);
    int par = 0;
    for (int it = bx; it < 4096; it += G) {
        float xw[11], gl[8];
#pragma unroll
        for (int j = 0; j < 11; ++j) xw[j] = xwn[j];
#pragma unroll
        for (int j = 0; j < 8; ++j) gl[j] = gln[j];
        if (it + G < 4096) lru_load<FINAL>(it + G, n, LX, LG, xwn, gln, tid);
        lru_item<FINAL>(it >> 11, (it >> 4) & 127, n, xw, gl, YL, w0, w1, w2, w3, bc, bA, bX, spl, APROD, HEND, lds, tid, par); par ^= 1;
    }
    __syncthreads();
}

__device__ __forceinline__ void sb_wave(int b, int h, int qw0, const bf16_t* Q, const bf16_t* __restrict__ K, const bf16_t* __restrict__ V, bf16_t* O, LAS unsigned char* vl, int lane) {
    const int r32 = lane & 31, hi = lane >> 5; const size_t rowbase = (size_t)b * SEQ;
    const bf16_t* Qw = Q + (rowbase + qw0) * DM + h * 64;
    bf16x8_t qr[4];
#pragma unroll
    for (int d0 = 0; d0 < 4; ++d0) qr[d0] = *(const bf16x8_t*)(Qw + (size_t)r32 * DM + d0 * 16 + hi * 8);
    const bf16_t* Kh = K + rowbase * DM + h * 64; const bf16_t* Vh = V + rowbase * DM + h * 64;
    f32x16_t o0 = {}, o1 = {}; float R = 0.f; const int qabs = qw0 + r32;
    int kt = qw0 >> 5;
    bf16x8_t kf[4]; u32x4 vr[4];
#define SB_LOAD(KF, VR, kt_) do { _Pragma("unroll") for (int d0 = 0; d0 < 4; ++d0) KF[d0] = *(const bf16x8_t*)(Kh + (size_t)((kt_) * 32 + r32) * DM + d0 * 16 + hi * 8); \
        _Pragma("unroll") for (int it = 0; it < 4; ++it) { const int chunk = lane + 64 * it; VR[it] = *(const u32x4*)(Vh + (size_t)((kt_) * 32 + (chunk >> 3)) * DM + (chunk & 7) * 8); } } while (0)
    SB_LOAD(kf, vr, kt);
    const unsigned vbase = (unsigned)(size_t)vl;
    for (;;) {
        bf16x8_t kn[4]; u32x4 vn[4]; const bool more = kt > 0;
        if (more) SB_LOAD(kn, vn, kt - 1); else {
#pragma unroll
            for (int i = 0; i < 4; ++i) { kn[i] = kf[i]; vn[i] = vr[i]; } }
        f32x16_t st = {};
#pragma unroll
        for (int d0 = 0; d0 < 4; ++d0) st = __builtin_amdgcn_mfma_f32_32x32x16_bf16(kf[d0], qr[d0], st, 0, 0, 0);
#pragma unroll
        for (int it = 0; it < 4; ++it) { const int chunk = lane + 64 * it, row = chunk >> 3, c16 = chunk & 7; *(LAS u32x4*)(vl + (c16 >> 2) * 2048 + row * 64 + (c16 & 3) * 16) = vr[it]; }
        float l1[16], lb[16]; bool val[16];
#pragma unroll
        for (int r = 0; r < 16; ++r) { const int kv = kt * 32 + (r & 3) + 8 * (r >> 2) + 4 * hi; val[r] = kv < qabs; const float z = st[r] * 0.125f; const float sp = fast_softplus(z); l1[r] = val[r] ? -sp : 0.f; lb[r] = z - sp; }
        float w[16]; float tail = 0.f;
#pragma unroll
        for (int g = 3; g >= 0; --g) { const float qs = (l1[4 * g] + l1[4 * g + 1]) + (l1[4 * g + 2] + l1[4 * g + 3]); const float pq = __shfl_xor(qs, 32);
            const float after = tail + (hi == 0 ? pq : 0.f) + R; tail += qs + pq;
            const float e2 = l1[4 * g + 3], e1 = e2 + l1[4 * g + 2], e0 = e1 + l1[4 * g + 1];
            w[4 * g + 3] = val[4 * g + 3] ? __expf(lb[4 * g + 3] + after) : 0.f; w[4 * g + 2] = val[4 * g + 2] ? __expf(lb[4 * g + 2] + after + e2) : 0.f;
            w[4 * g + 1] = val[4 * g + 1] ? __expf(lb[4 * g + 1] + after + e1) : 0.f; w[4 * g] = val[4 * g] ? __expf(lb[4 * g] + after + e0) : 0.f; }
        R += tail;
        u32x4 p0, p1; p0.x = attn_body::cvtpk_s(w[0], w[1]); p0.y = attn_body::cvtpk_s(w[2], w[3]); p0.z = attn_body::cvtpk_s(w[4], w[5]); p0.w = attn_body::cvtpk_s(w[6], w[7]);
        p1.x = attn_body::cvtpk_s(w[8], w[9]); p1.y = attn_body::cvtpk_s(w[10], w[11]); p1.z = attn_body::cvtpk_s(w[12], w[13]); p1.w = attn_body::cvtpk_s(w[14], w[15]);
        const bf16x8_t pa0 = __builtin_bit_cast(bf16x8_t, p0), pa1 = __builtin_bit_cast(bf16x8_t, p1);
        const attn_body::lds_cptr vp = (attn_body::lds_cptr)vl + (4 * hi + ((lane & 15) >> 2)) * 64 + ((lane >> 4) & 1) * 32 + (lane & 3) * 8;
#define SB_VF(d0, s) ({ const attn_body::s16x4 lo_ = attn_body::vtr(vp + (d0) * 2048 + (s) * 1024), hi_ = attn_body::vtr(vp + (d0) * 2048 + (s) * 1024 + 512); \
            (bf16x8_t){lo_[0], lo_[1], lo_[2], lo_[3], hi_[0], hi_[1], hi_[2], hi_[3]}; })
        o0 = __builtin_amdgcn_mfma_f32_32x32x16_bf16(pa0, SB_VF(0, 0), o0, 0, 0, 0);
        o1 = __builtin_amdgcn_mfma_f32_32x32x16_bf16(pa0, SB_VF(1, 0), o1, 0, 0, 0);
        o0 = __builtin_amdgcn_mfma_f32_32x32x16_bf16(pa1, SB_VF(0, 1), o0, 0, 0, 0);
        o1 = __builtin_amdgcn_mfma_f32_32x32x16_bf16(pa1, SB_VF(1, 1), o1, 0, 0, 0);
        if (!more) break;
        if (__all(R < SB_THR)) break;
#pragma unroll
        for (int i = 0; i < 4; ++i) { kf[i] = kn[i]; vr[i] = vn[i]; }
        --kt;
    }
#undef SB_LOAD
#undef SB_VF
    (void)vbase;
    bf16_t* Ow = O + (rowbase + qw0) * DM + h * 64;
#pragma unroll
    for (int r = 0; r < 16; ++r) { const int q = (r & 3) + 8 * (r >> 2) + 4 * hi; Ow[(size_t)q * DM + r32] = f2bf(o0[r]); Ow[(size_t)q * DM + 32 + r32] = f2bf(o1[r]); }
}

#ifndef DBG_NOLOGF
#define DBG_NOLOGF 0
#endif
#ifndef EN_FOX
#define EN_FOX 1
#endif
#ifndef EN_SB
#define EN_SB 1
#endif
#ifndef EN_LRU
#define EN_LRU 1
#endif
#ifndef EN_GEMM
#define EN_GEMM 1
#endif
#ifndef EN_THIN
#define EN_THIN 1
#endif
enum { SUB_CONV = 1, SUB_NORM = 2, SUB_HEADNORM = 4, SUB_CUMSUM = 8, SUB_LRU = 16, SUB_SB = 32, SUB_MEM = 64, SUB_FOX = 128, SUB_ALL = 255 };
constexpr int N_PRO = 3, N_PER_LAYER = 10, N_PHASES = N_PRO + DEPTH * N_PER_LAYER;
struct MArgs { Ptrs P; int ph_lo, ph_hi, sub, pad; };

__global__ void __launch_bounds__(MEGA_THREADS, 2) mega(MArgs a) {
    extern __shared__ __attribute__((aligned(16))) unsigned char lds_raw[];
    LAS unsigned char* lds = (LAS unsigned char*)lds_raw;
    cg::grid_group grid = cg::this_grid();
    { volatile LAS unsigned* st0 = (volatile LAS unsigned*)(lds + XB_LDS_OFF); if (threadIdx.x == 0) { st0[0] = 0u; st0[1] = 0u; } __syncthreads();
      if (a.ph_hi - a.ph_lo > 2) (void)xcd_barrier_post((unsigned*)(a.P.ws + WS_BAR), st0); }
    for (int ph = a.ph_lo; ph < a.ph_hi; ++ph) {
    int tid = threadIdx.x; asm volatile("" : "+v"(tid));
    const int lane = tid & 63, wave = __builtin_amdgcn_readfirstlane(tid >> 6);
    int zs = 0; asm volatile("" : "+s"(zs));
    const int G = gridDim.x + zs, bx = blockIdx.x + zs, sub = a.sub + zs, vcu = (G % 8 == 0) ? (bx % 8) * (G / 8) + bx / 8 : bx;
    const int gw = vcu * NWV + wave, NGW = G * NWV;
    unsigned char* ws = a.P.ws + zs; const float* const* in = a.P.in + zs; float* out = a.P.out + zs;
    bf16_t* H = (bf16_t*)(ws + WS_H); bf16_t* PROJ = (bf16_t*)(ws + WS_PROJ); bf16_t* GATES = (bf16_t*)(ws + WS_GATES); bf16_t* Eb = (bf16_t*)(ws + WS_E);
    bf16_t *FQ = PROJ, *FK = PROJ + (size_t)T * DM, *FV = PROJ + 2 * (size_t)T * DM, *LX = PROJ + 3 * (size_t)T * DM, *LG = PROJ + 4 * (size_t)T * DM, *SQ = PROJ + 5 * (size_t)T * DM,
           *SK = PROJ + 6 * (size_t)T * DM, *SV = PROJ + 7 * (size_t)T * DM, *MQ = PROJ + 8 * (size_t)T * DM;
    bf16_t* YL = (bf16_t*)(ws + WS_YL);
    float *LOGF = (float*)(ws + WS_LOGF), *FB = (float*)(ws + WS_FB), *MQSS = (float*)(ws + WS_MQSS), *ESUM = (float*)(ws + WS_ESUM), *CB = (float*)(ws + WS_CB);
    bf16_t* MEMN = (bf16_t*)(ws + WS_MEMN); float* MEMRAW = (float*)(ws + WS_MEMRAW); bf16_t *MK = (bf16_t*)(ws + WS_MK), *MVT = (bf16_t*)(ws + WS_MVT);
    float *APROD = (float*)(ws + WS_LRU), *HEND = APROD + (size_t)BATCH * 128 * DM;
    bf16_t* WKVT = (bf16_t*)(ws + WS_WKVT);
    bf16_t *WIN_T = (bf16_t*)(ws + WS_WT + WT_IN), *WBR_T = (bf16_t*)(ws + WS_WT + WT_BR), *WOUT_T = (bf16_t*)(ws + WS_WT + WT_OUT), *WUP_T = (bf16_t*)(ws + WS_WT + WT_UP), *WDN_T = (bf16_t*)(ws + WS_WT + WT_DN);
    bf16_t *GV = (bf16_t*)(ws + WS_GV), *ACT = (bf16_t*)(ws + WS_ACT);

        if (ph < N_PRO) {
            if (ph == 0) {
                LAS float* scr = (LAS float*)(lds + wave * 8448);
                for (int it = gw; it < 4 * 1024; it += NGW) { const int l = it >> 10; tr_item(in[15] + (size_t)l * DM * 2048, 2048, WKVT + (size_t)l * 2048 * DM, DM, 64, scr, it & 1023, lane, 1, 0); }
                for (int m = gw; m < 4 * 512; m += NGW) { const int l = m >> 9, r = m & 511; norm_row(in[1] + (size_t)r * DM, in[3] + l * DM, MEMN + (size_t)m * DM, (const LAS float*)lds, false, nullptr, nullptr, 0, lane); }
            } else if (ph == 1) {
                LocOrder<LocMemKV> S; S.so.init(4 * 512, 2048, G, bx); S.loc = LocMemKV{(const char*)MEMN, (const char*)WKVT};
                if (EN_GEMM) pg8::gemm_phase<EpiF32, LocOrder<LocMemKV>, true, true>(lds, pg8::Gemm{DM, DM, DM}, S, EpiF32{MEMRAW, 2048, 0});
            } else {
                for (int m = gw; m < 4 * 512; m += NGW) { const int l = m >> 9, r = m & 511, b = r >> 8, mi = r & 255; const float* raw = MEMRAW + (size_t)m * 2048;
                    const f32x4 gk = *(const f32x4*)(in[17] + l * 256 + lane * 4), gq = *(const f32x4*)(in[16] + l * 256 + lane * 4); const f32x4 gg = gk * gq;
#pragma unroll
                    for (int h = 0; h < 4; ++h) { const f32x4 k = *(const f32x4*)(raw + h * 256 + lane * 4); const float ss = wave_sum((k[0] * k[0] + k[1] * k[1]) + (k[2] * k[2] + k[3] * k[3]));
                        const float rstd = rsqrtf(ss * (1.f / 256.f) + EPS); uint2 o; o.x = pk2(k[0] * rstd * gg[0], k[1] * rstd * gg[1]); o.y = pk2(k[2] * rstd * gg[2], k[3] * rstd * gg[3]);
                        *(uint2*)(MK + ((size_t)l * 512 + (size_t)b * 256 + mi) * DM + h * 256 + lane * 4) = o;
                        const f32x4 v = *(const f32x4*)(raw + 1024 + h * 256 + lane * 4); bf16_t* vt = MVT + (size_t)l * 512 * DM + (((size_t)b * 4 + h) * 256 + lane * 4) * 256 + mi;
                        vt[0] = f2bf(v[0]); vt[256] = f2bf(v[1]); vt[512] = f2bf(v[2]); vt[768] = f2bf(v[3]); }
                    if (r == 0) { float mx = fmaxf(fmaxf(fabsf(gg[0]), fabsf(gg[1])), fmaxf(fabsf(gg[2]), fabsf(gg[3])));
#pragma unroll
                        for (int o = 1; o < 64; o <<= 1) mx = fmaxf(mx, __shfl_xor(mx, o));
                        if (lane == 0) CB[l] = 16.f * mx; } }
            }
        } else {
            const int l = (ph - N_PRO) / N_PER_LAYER, sp = (ph - N_PRO) % N_PER_LAYER;
            const float* xcur = l == 0 ? in[0] : out;
            if (sp == 0) {
                if (sub & SUB_NORM) { LAS float* WfT = (LAS float*)lds; const float* wf = in[4] + (size_t)l * DM * NIN + 3072;
                    for (int i = tid; i < 16 * 1024; i += MEGA_THREADS) { const int k = i >> 4, h = i & 15; WfT[h * 1024 + k] = wf[(size_t)k * NIN + h]; } }
                __syncthreads();
                if (sub & SUB_CONV) { LAS float* scr = (LAS float*)(lds + 65536 + wave * 8448);
                    const float* win = in[4] + (size_t)l * DM * NIN;
                    for (int it = gw; it < 13440; it += NGW) { int r = it;
                        if (r < 1536) { tr_item(win, NIN, WIN_T, DM, 96, scr, r, lane, 1, 0); continue; } r -= 1536;
                        if (r < 5120) { tr_item(win + 3088, NIN, WIN_T + (size_t)3072 * DM, DM, 320, scr, r, lane, 1, 0); continue; } r -= 5120;
                        if (r < 2048) { const int i = r >> 9; tr_item(in[19] + ((size_t)l * 4 + i) * DM * DM, DM, WBR_T + (size_t)i * DM * DM, DM, 32, scr, r & 511, lane, 1, 0); continue; } r -= 2048;
                        if (r < 512) { tr_item(in[20] + (size_t)l * DM * DM, DM, WOUT_T, DM, 32, scr, r, lane, 1, 0); continue; } r -= 512;
                        if (r < 2816) { tr_item(in[22] + (size_t)l * DM * 2 * DFF, 2 * DFF, WUP_T, DM, 176, scr, r, lane, 1, 0); continue; } r -= 2816;
                        tr_item(in[25] + (size_t)l * DFF * DM, DM, WDN_T, DFF, 32, scr, r, lane, 1, 0); } }
                if (sub & SUB_NORM) for (int m = gw; m < T; m += NGW) norm_row(xcur + (size_t)m * DM, in[2] + l * DM, H + (size_t)m * DM, (const LAS float*)lds, !DBG_NOLOGF, in[5] + l * 16, LOGF, m, lane);
            } else if (sp == 1) {
                LocOrder<LocStd> S; S.so.init(T, 13312, G, bx); S.loc = LocStd{(const char*)H, (const char*)WIN_T, 256 * 1024 * 2, 256 * 1024 * 2};
                if (EN_GEMM) pg8::gemm_phase<EpiProj, LocOrder<LocStd>, true, true>(lds, pg8::Gemm{DM, DM, DM}, S, EpiProj{PROJ, GATES, MQSS});
            } else if (sp == 2) {
                if (sub & SUB_HEADNORM) { for (int m = gw; m < 2 * T; m += NGW) { if (m < T) headnorm64_row(FQ + (size_t)m * DM, in[6] + l * 64, C2, lane); else headnorm64_row(FK + (size_t)(m - T) * DM, in[7] + l * 64, 1.f, lane); } }
                if ((sub & SUB_CUMSUM) && bx < 32) cumsum_block(LOGF + (size_t)bx * SEQ, FB + (size_t)bx * SEQ, (LAS float*)lds, tid);
                __syncthreads();
                if (EN_LRU && (sub & SUB_LRU)) lru_pass<false>(l, bx, G, in, LX, LG, YL, APROD, HEND, lds, tid);
                if (EN_SB && (sub & SUB_SB)) for (int k = 0; k < 4; ++k) { const int bh = vcu >> 3, qb = (vcu & 7) * 4 + k; sb_wave(bh >> 4, bh & 15, qb * 256 + wave * 32, SQ, SK, SV, H, lds + wave * 4096, lane); }
                __syncthreads();
                if (sub & SUB_MEM) { LocOrder<LocMemS> S; S.so.init(T, 1024, G, bx); S.loc = LocMemS{(const char*)MQ, (const char*)(MK + (size_t)l * 512 * DM)};
                    if (EN_GEMM) pg8::gemm_phase<EpiSexp, LocOrder<LocMemS>, true, true>(lds, pg8::Gemm{DM, DM, 256 + zs}, S, EpiSexp{Eb, MQSS, ESUM, CB + l}); }
            } else if (sp == 3) {
                if (EN_FOX && (sub & SUB_FOX)) {
                    float gqm = fabsf(in[6][l * 64 + lane]), gkm = fabsf(in[7][l * 64 + lane]);
#pragma unroll
                    for (int o = 1; o < 64; o <<= 1) { gqm = fmaxf(gqm, __shfl_xor(gqm, o)); gkm = fmaxf(gkm, __shfl_xor(gkm, o)); }
                    const float thr = -(160.f + 2.f * C2 * 64.f * gqm * gkm);
                    const attn_body::AttnTensors AT{(const attn_body::bf16*)FQ, (const attn_body::bf16*)FK, (const attn_body::bf16*)FV, (attn_body::bf16*)SV, FB, thr, 0};
                    attn_body::QueueOrder S; S.ctr = (unsigned*)(ws + WS_QCTR) + (l * 8) * 64; S.xl = bx & 7; S.slot = (volatile LAS int*)(lds + XB_LDS_OFF + 16);
                    attn_body::attn_phase<attn_body::QueueOrder, 20>((char*)lds_raw, AT, S); }
                __syncthreads();
                if (EN_LRU && (sub & SUB_LRU)) lru_pass<true>(l, bx, G, in, LX, LG, YL, APROD, HEND, lds, tid);
                if (sub & SUB_MEM) { LocOrder<LocMemPV> S; S.so.init(T, 1024, G, bx); S.loc = LocMemPV{(const char*)Eb, (const char*)(MVT + (size_t)l * 512 * DM)};
                    if (EN_GEMM) pg8::gemm_phase<EpiMemPV, LocOrder<LocMemPV>, true, true>(lds, pg8::Gemm{DM, 256, 256 + zs}, S, EpiMemPV{MQ, ESUM}); }
            } else if (sp == 4) {
                BranchSched S; S.vcu = vcu; S.loc = LocBranch{(const char*)SV, (const char*)YL, (const char*)H, (const char*)MQ, (const char*)WBR_T};
                if (EN_GEMM) pg8::gemm_phase<EpiBranch, BranchSched, true, true>(lds, pg8::Gemm{DM, DM, DM}, S, EpiBranch{GATES, in[18] + (size_t)l * 4 * DM, (float*)(ws + WS_MIXF), (bf16_t*)(ws + WS_MIXED)});
            } else if (sp == 5) {
                LocOrder<LocStd> S; S.so.init(T, DM, G, bx); S.loc = LocStd{(const char*)(ws + WS_MIXED), (const char*)WOUT_T, 256 * 1024 * 2, 256 * 1024 * 2};
                if (EN_GEMM) pg8::gemm_phase<EpiResid, LocOrder<LocStd>, true, true>(lds, pg8::Gemm{DM, DM, DM}, S, EpiResid{xcur, out});
            } else if (sp == 6) {
                for (int m = gw; m < T; m += NGW) norm_row(out + (size_t)m * DM, in[21] + l * DM, H + (size_t)m * DM, (const LAS float*)lds, false, nullptr, nullptr, m, lane);
            } else if (sp == 7) {
                LocOrder<LocStd> S; S.so.init(T, 2 * DFF, G, bx); S.loc = LocStd{(const char*)H, (const char*)WUP_T, 256 * 1024 * 2, 256 * 1024 * 2};
                if (EN_GEMM) pg8::gemm_phase<EpiBf16P, LocOrder<LocStd>, true, true>(lds, pg8::Gemm{DM, DM, DM}, S, EpiBf16P{GV, 2 * DFF, 0});
            } else if (sp == 8) {
                const float* cw = in[23] + (size_t)l * 3 * DFF; const float* cbv = in[24] + l * DFF;
                for (int i = bx * MEGA_THREADS + tid; i < T * (DFF / 8); i += G * MEGA_THREADS) { const int r = i / (DFF / 8), c = (i % (DFF / 8)) * 8, t = r % SEQ;
                    const bf16_t* gp = GV + (size_t)r * 2 * DFF + c; const u32x4 z4 = {0u, 0u, 0u, 0u};
                    const u32x4 g0 = *(const u32x4*)gp, g1 = t >= 1 ? *(const u32x4*)(gp - 2 * DFF) : z4, g2 = t >= 2 ? *(const u32x4*)(gp - 4 * DFF) : z4, vv = *(const u32x4*)(gp + DFF);
                    const f32x4 wa0 = *(const f32x4*)(cw + c), wa1 = *(const f32x4*)(cw + c + 4), wb0 = *(const f32x4*)(cw + DFF + c), wb1 = *(const f32x4*)(cw + DFF + c + 4), wc0 = *(const f32x4*)(cw + 2 * DFF + c), wc1 = *(const f32x4*)(cw + 2 * DFF + c + 4);
                    const f32x4 bb0 = *(const f32x4*)(cbv + c), bb1 = *(const f32x4*)(cbv + c + 4);
#define ACT1(G0, G1, G2, VV, W0, W1, W2, BB) ({ const float pre_ = (BB) + (W2) * (G0) + (W1) * (G1) + (W0) * (G2); pre_ * fast_sigmoid(pre_) * (VV); })
                    u32x4 o;
                    o.x = pk2(ACT1(blo(g0.x), blo(g1.x), blo(g2.x), blo(vv.x), wa0[0], wb0[0], wc0[0], bb0[0]), ACT1(bhi(g0.x), bhi(g1.x), bhi(g2.x), bhi(vv.x), wa0[1], wb0[1], wc0[1], bb0[1]));
                    o.y = pk2(ACT1(blo(g0.y), blo(g1.y), blo(g2.y), blo(vv.y), wa0[2], wb0[2], wc0[2], bb0[2]), ACT1(bhi(g0.y), bhi(g1.y), bhi(g2.y), bhi(vv.y), wa0[3], wb0[3], wc0[3], bb0[3]));
                    o.z = pk2(ACT1(blo(g0.z), blo(g1.z), blo(g2.z), blo(vv.z), wa1[0], wb1[0], wc1[0], bb1[0]), ACT1(bhi(g0.z), bhi(g1.z), bhi(g2.z), bhi(vv.z), wa1[1], wb1[1], wc1[1], bb1[1]));
                    o.w = pk2(ACT1(blo(g0.w), blo(g1.w), blo(g2.w), blo(vv.w), wa1[2], wb1[2], wc1[2], bb1[2]), ACT1(bhi(g0.w), bhi(g1.w), bhi(g2.w), bhi(vv.w), wa1[3], wb1[3], wc1[3], bb1[3]));
#undef ACT1
                    *(u32x4*)(ACT + (size_t)r * DFF + c) = o; }
            } else {
                LocOrder<LocStd> S; S.so.init(T, DM, G, bx); S.loc = LocStd{(const char*)ACT, (const char*)WDN_T, 256 * DFF * 2, 256 * DFF * 2};
                if (EN_GEMM) pg8::gemm_phase<EpiResid, LocOrder<LocStd>, true, true>(lds, pg8::Gemm{DFF, DFF, DFF}, S, EpiResid{out, out});
            }
        }
        if (ph + 1 < a.ph_hi) {
            if (ph == a.ph_lo) grid.sync();
            else { XcdBarrier xb; xb.bar = (unsigned*)(ws + WS_BAR); xb.x = xb_xcc_id(); xb.st = (volatile LAS unsigned*)(lds + XB_LDS_OFF); xcd_barrier(xb); }
        }
    }
}
enum { C_PRO = 1, C_NORM = 2, C_WIN = 4, C_HN = 8, C_LRU = 16, C_SB = 32, C_MEM = 64, C_FOX = 128, C_BR = 256, C_WOUT = 512, C_NORM2 = 1024, C_UP = 2048, C_ACT = 4096, C_DOWN = 8192, C_ONE = 16384 };
#ifndef CFG
#define CFG 32767
#endif
#ifndef REPEAT_SP
#define REPEAT_SP (-1)
#define REPEAT_N 0
#define REPEAT_SUB 0
#endif
static int g_grid = 0;
static void launch_mega(const Ptrs& P, int lo, int hi, int sub, hipStream_t st, bool coop) {
    MArgs a{}; a.P = P; a.ph_lo = lo; a.ph_hi = hi; a.sub = sub; a.pad = 0;
    if (coop) { void* args[] = {&a}; const hipError_t e = hipLaunchCooperativeKernel((const void*)mega, dim3(g_grid), dim3(MEGA_THREADS), args, MEGA_LDS, st);
        if (e != hipSuccess) fprintf(stderr, "cooperative launch failed: %s (grid %d)\n", hipGetErrorString(e), g_grid); }
    else { hipLaunchKernelGGL(mega, dim3(g_grid), dim3(MEGA_THREADS), MEGA_LDS, st, a);
        if (REPEAT_N > 0 && hi == lo + 1 && lo >= N_PRO && (lo - N_PRO) % N_PER_LAYER == (REPEAT_SP)) { a.sub = (REPEAT_SUB); for (int r = 0; r < (REPEAT_N); ++r) hipLaunchKernelGGL(mega, dim3(g_grid), dim3(MEGA_THREADS), MEGA_LDS, st, a); } }
}
static void run_hybrid(const Ptrs& P, hipStream_t st) {
    unsigned char* ws = P.ws;
    bf16_t* H = (bf16_t*)(ws + WS_H);
    bf16_t* PR[9]; for (int i = 0; i < 9; ++i) PR[i] = (bf16_t*)(ws + WS_PROJ + i * SZ_ACT);
    bf16_t *FQ = PR[0], *FK = PR[1], *FV = PR[2], *LX = PR[3], *LG = PR[4], *SQ = PR[5], *SK = PR[6], *SV = PR[7], *MQ = PR[8];
    bf16_t* GATES = (bf16_t*)(ws + WS_GATES);
    bf16_t *YL = (bf16_t*)(ws + WS_YL), *YS = (bf16_t*)(ws + WS_YS), *YM = (bf16_t*)(ws + WS_YM), *YF = (bf16_t*)(ws + WS_YF);
    float *LOGF = (float*)(ws + WS_LOGF), *FB = (float*)(ws + WS_FB);
    bf16_t* MEMN = (bf16_t*)(ws + WS_MEMN); float* MEMRAW = (float*)(ws + WS_MEMRAW);
    bf16_t *MK = (bf16_t*)(ws + WS_MK), *MVT = (bf16_t*)(ws + WS_MVT);
    bf16_t *GV = (bf16_t*)(ws + WS_GV), *ACT = (bf16_t*)(ws + WS_ACT);
    const float* const* in = P.in;
    const int cfg = CFG;
    const bool anygemm = cfg & (C_WIN | C_BR | C_WOUT | C_UP | C_DOWN);
    if (cfg & C_PRO) { for (int p = 0; p < 3; ++p) launch_mega(P, p, p + 1, SUB_ALL, st, false); }
    else for (int l = 0; l < DEPTH; ++l) {
        n_rmsnorm<<<512 / 4, 256, 0, st>>>(in[1], in[3] + l * DM, MEMN + (size_t)l * 512 * DM, nullptr, nullptr, nullptr, 512);
        n_gemm<EStoreF32><<<dim3(2048 / 64, 512 / 64), 256, 0, st>>>(MEMN + (size_t)l * 512 * DM, in[15] + (size_t)l * DM * 2048, DM, 2048, DM, 0x7fffffff, EStoreF32{MEMRAW + (size_t)l * 512 * 2048, 2048, 0});
        n_memkv_post<<<512, 256, 0, st>>>(MEMRAW + (size_t)l * 512 * 2048, in[17] + l * 256, in[16] + l * 256, MK + (size_t)l * 512 * DM, MVT + (size_t)l * 512 * DM);
    }
    for (int l = 0; l < DEPTH; ++l) {
        const int p0 = N_PRO + l * N_PER_LAYER;
        const float* xcur = l == 0 ? in[0] : P.out;
        const float* win = in[4] + (size_t)l * DM * NIN;
        if (DBG_NOLOGF) n_rmsnorm<<<T / 4, 256, 0, st>>>(xcur, in[2] + l * DM, H, win + 3072, in[5] + l * 16, LOGF, T);
        { const int sub = (anygemm ? SUB_CONV : 0) | ((cfg & C_NORM) ? SUB_NORM : 0); if (sub) launch_mega(P, p0, p0 + 1, sub, st, false); }
        if (!(cfg & C_NORM)) n_rmsnorm<<<T / 4, 256, 0, st>>>(xcur, in[2] + l * DM, H, win + 3072, in[5] + l * 16, LOGF, T);
        if (cfg & C_WIN) launch_mega(P, p0 + 1, p0 + 2, SUB_ALL, st, false);
        else { for (int gI = 0; gI < 9; ++gI) { const int coff = gI < 3 ? gI * 1024 : gI * 1024 + 16;
                n_gemm<EStoreBf16><<<dim3(1024 / 64, T / 64), 256, 0, st>>>(H, win + coff, DM, NIN, DM, 0x7fffffff, EStoreBf16{PR[gI], DM, 0}); }
            n_gemm<EStoreBf16><<<dim3(4096 / 64, T / 64), 256, 0, st>>>(H, win + 9232, DM, NIN, DM, 0x7fffffff, EStoreBf16{GATES, 4096, 0}); }
        if (!(cfg & C_HN)) { n_headnorm<<<T * 16 / 256, 256, 0, st>>>(FQ, in[6] + l * 64, 64, C2); n_headnorm<<<T * 16 / 256, 256, 0, st>>>(FK, in[7] + l * 64, 64, 1.f); n_cumsum<<<32, 1024, 0, st>>>(LOGF, FB); }
        const int sub23 = ((cfg & C_HN) ? (SUB_HEADNORM | SUB_CUMSUM) : 0) | ((cfg & C_LRU) ? SUB_LRU : 0) | ((cfg & C_SB) ? SUB_SB : 0) | ((cfg & C_MEM) ? SUB_MEM : 0) | ((cfg & C_FOX) ? SUB_FOX : 0);
        if (sub23 & ~SUB_FOX) launch_mega(P, p0 + 2, p0 + 3, sub23, st, false);
        if (!(cfg & C_SB)) n_sb_attn<<<dim3(SEQ / 256, 32), 256, 0, st>>>(SQ, SK, SV, YS);
        if (!(cfg & C_LRU)) n_lru<<<32, 64, 0, st>>>(LX, LG, in[8] + (size_t)l * 4 * DM, in[9] + l * DM, in[10] + (size_t)l * 16 * 64 * 64, in[11] + l * DM, in[12] + (size_t)l * 16 * 64 * 64, in[13] + l * DM, in[14] + l * DM, YL);
        if (!(cfg & C_MEM)) n_mem_attn<<<T * 4, 256, 0, st>>>(MQ, MK + (size_t)l * 512 * DM, MVT + (size_t)l * 512 * DM, YM);
        if (sub23 & (SUB_FOX | SUB_LRU | SUB_MEM)) launch_mega(P, p0 + 3, p0 + 4, sub23, st, false);
        if (!(cfg & C_FOX)) n_fox_attn<<<dim3(SEQ / 256, 32), 256, 0, st>>>(FQ, FK, FV, FB, YF);
        if (cfg & C_BR) launch_mega(P, p0 + 4, p0 + 5, SUB_ALL, st, false);
        else { const bf16_t* Y[4] = {YF, YL, YS, YM};
            for (int i = 0; i < 4; ++i) n_gemm<EBranch><<<dim3(1024 / 64, T / 64), 256, 0, st>>>(Y[i], in[19] + ((size_t)l * 4 + i) * DM * DM, DM, DM, DM, 0x7fffffff, EBranch{GATES, in[18] + ((size_t)l * 4 + i) * DM, (float*)(ws + WS_MIXF), (bf16_t*)(ws + WS_MIXED), i, 0}); }
        if (cfg & C_WOUT) launch_mega(P, p0 + 5, p0 + 6, SUB_ALL, st, false);
        else n_gemm<EResid><<<dim3(1024 / 64, T / 64), 256, 0, st>>>((const bf16_t*)(ws + WS_MIXED), in[20] + (size_t)l * DM * DM, DM, DM, DM, 0x7fffffff, EResid{xcur, P.out});
        if (cfg & C_NORM2) launch_mega(P, p0 + 6, p0 + 7, SUB_ALL, st, false);
        else n_rmsnorm<<<T / 4, 256, 0, st>>>(P.out, in[21] + l * DM, H, nullptr, nullptr, nullptr, T);
        if (cfg & C_UP) launch_mega(P, p0 + 7, p0 + 8, SUB_ALL, st, false);
        else n_gemm<EStoreBf16><<<dim3(2 * DFF / 64, T / 64), 256, 0, st>>>(H, in[22] + (size_t)l * DM * 2 * DFF, DM, 2 * DFF, DM, 0x7fffffff, EStoreBf16{GV, 2 * DFF, 0});
        if (cfg & C_ACT) launch_mega(P, p0 + 8, p0 + 9, SUB_ALL, st, false);
        else n_act<<<(unsigned)(((size_t)T * DFF + 255) / 256), 256, 0, st>>>(GV, in[23] + (size_t)l * 3 * DFF, in[24] + l * DFF, ACT);
        if (cfg & C_DOWN) launch_mega(P, p0 + 9, p0 + 10, SUB_ALL, st, false);
        else n_gemm<EResid><<<dim3(1024 / 64, T / 64), 256, 0, st>>>(ACT, in[25] + (size_t)l * DFF * DM, DFF, DM, DFF, 0x7fffffff, EResid{P.out, P.out});
    }
}

extern "C" void kernel_launch(void* const* d_in, const int* in_sizes, int n_in, void* d_out, int out_size, void* d_ws, size_t ws_size, hipStream_t stream) {
    if (n_in != 26 || out_size != T * DM || ws_size < WS_NEED) { fprintf(stderr, "kernel_launch: unexpected sizes n_in %d out %d ws %zu (need %zu)\n", n_in, out_size, ws_size, (size_t)WS_NEED); return; }
    if (g_grid == 0) {
        int dev = 0, cus = 0, per_cu = 0;
        hipGetDevice(&dev); hipDeviceGetAttribute(&cus, hipDeviceAttributeMultiprocessorCount, dev);
        if (hipFuncSetAttribute((const void*)mega, hipFuncAttributeMaxDynamicSharedMemorySize, MEGA_LDS) != hipSuccess) fprintf(stderr, "kernel_launch: hipFuncSetAttribute failed\n");
        if (hipOccupancyMaxActiveBlocksPerMultiprocessor(&per_cu, (const void*)mega, MEGA_THREADS, MEGA_LDS) != hipSuccess || per_cu < 1) fprintf(stderr, "kernel_launch: occupancy query says %d\n", per_cu);
        (void)hipGetLastError();
        g_grid = cus;
        if (g_grid != 256) fprintf(stderr, "kernel_launch: %d CUs; the attention phase's static order assumes 256\n", g_grid);
    }
    Ptrs P{};
    for (int i = 0; i < 26; ++i) P.in[i] = (const float*)d_in[i];
    P.out = (float*)d_out; P.ws = (unsigned char*)d_ws;
    if ((CFG) & C_ONE) { (void)hipMemsetAsync((char*)d_ws + WS_BAR, 0, CTL_ZERO_BYTES, stream);
        launch_mega(P, 0, N_PHASES, SUB_ALL, stream, true); }
    else { (void)hipMemsetAsync((char*)d_ws + WS_BAR, 0, CTL_ZERO_BYTES, stream); run_hybrid(P, stream); }
}
```

```cpp
#include <hip/hip_runtime.h>
#include <cstdio>
#include <cstdint>
#include <hip/hip_cooperative_groups.h>

typedef unsigned short bf16_t;
constexpr int BATCH = 2, SEQ = 8192, DM = 1024, DEPTH = 4, T = BATCH * SEQ;
constexpr int NMEM = 256, NIN = 13328, DFF = 2816;
constexpr float EPS = 1e-6f;
constexpr float LOG2E = 1.4426950408889634f;
constexpr float C2 = 0.125f * LOG2E;
constexpr float SB_THR = -104.0f;

__device__ __forceinline__ float bf2f(bf16_t b) { return __uint_as_float(((unsigned)b) << 16); }
__device__ __forceinline__ bf16_t f2bf(float f) { unsigned u = __float_as_uint(f); return (bf16_t)((u + 0x7fffu + ((u >> 16) & 1u)) >> 16); }
__device__ __forceinline__ float bfr(float f) { return bf2f(f2bf(f)); }
__device__ __forceinline__ float wave_sum(float v) {
#pragma unroll
    for (int o = 1; o < 64; o <<= 1) v += __shfl_xor(v, o);
    return v;
}
__device__ __forceinline__ float softplusf(float x) { return fmaxf(x, 0.f) + log1pf(__expf(-fabsf(x))); }
__device__ __forceinline__ float logsigmoidf(float x) { return -softplusf(-x); }
__device__ __forceinline__ float sigmoidf_(float x) { return 1.f / (1.f + __expf(-x)); }
__device__ __forceinline__ float gelu_tanh(float x) { const float u = 0.7978845608028654f * (x + 0.044715f * x * x * x); return 0.5f * x * (1.f + tanhf(u)); }

__device__ __forceinline__ int mk_tid() { int t = threadIdx.x; asm volatile("" : "+v"(t)); return t; }

constexpr size_t MiB = 1u << 20;
constexpr size_t SZ_ACT = (size_t)T * DM * 2;
constexpr size_t WS_CTL = 0;
constexpr size_t WS_H = 1 * MiB;
constexpr size_t WS_PROJ = WS_H + SZ_ACT;
constexpr size_t WS_GATES = WS_PROJ + 9 * SZ_ACT;
constexpr size_t WS_E = WS_GATES + 4 * SZ_ACT;
constexpr size_t WS_LOGF = WS_E + SZ_ACT;
constexpr size_t WS_FB = WS_LOGF + 1 * MiB;
constexpr size_t WS_MQSS = WS_FB + 1 * MiB;
constexpr size_t WS_ESUM = WS_MQSS + 1 * MiB;
constexpr size_t WS_MEMN = WS_ESUM + 1 * MiB;
constexpr size_t WS_MEMRAW = WS_MEMN + 4 * MiB;
constexpr size_t WS_MK = WS_MEMRAW + 16 * MiB;
constexpr size_t WS_MVT = WS_MK + 4 * MiB;
constexpr size_t WS_LRU = WS_MVT + 4 * MiB;
constexpr size_t WS_WT = WS_LRU + 2 * MiB;
constexpr size_t WS_END = WS_WT + 72 * MiB;
constexpr size_t WS_YL = WS_PROJ + 6 * SZ_ACT, WS_YS = WS_H, WS_YM = WS_PROJ + 8 * SZ_ACT, WS_YF = WS_PROJ + 7 * SZ_ACT;
constexpr size_t WS_GV = WS_PROJ;
constexpr size_t WS_ACT = WS_GV + (size_t)T * 2 * DFF * 2;
static_assert(WS_ACT + (size_t)T * DFF * 2 <= WS_GATES, "ffn alias");
constexpr size_t WS_MIXF = WS_END;
constexpr size_t WS_MIXED = WS_PROJ;
constexpr size_t WS_NEED = WS_MIXF + (size_t)T * DM * 4;

struct Ptrs {
    const float* in[26];
    float* out;
    unsigned char* ws;
};

__global__ void __launch_bounds__(256) n_rmsnorm(const float* __restrict__ x, const float* __restrict__ g, bf16_t* __restrict__ H,
                                                 const float* __restrict__ Wf, const float* __restrict__ bfg, float* __restrict__ LOGF, int nrows) {
    const int lane = threadIdx.x & 63, row = blockIdx.x * 4 + (threadIdx.x >> 6);
    if (row >= nrows) return;
    const float4* xr = (const float4*)(x + (size_t)row * DM);
    const float4* gr = (const float4*)g;
    float4 v[4]; float ss = 0.f;
#pragma unroll
    for (int j = 0; j < 4; ++j) { v[j] = xr[lane + 64 * j]; ss += v[j].x * v[j].x + v[j].y * v[j].y + v[j].z * v[j].z + v[j].w * v[j].w; }
    ss = wave_sum(ss);
    const float rstd = rsqrtf(ss * (1.f / DM) + EPS);
#pragma unroll
    for (int j = 0; j < 4; ++j) { const float4 gg = gr[lane + 64 * j]; v[j].x *= rstd * gg.x; v[j].y *= rstd * gg.y; v[j].z *= rstd * gg.z; v[j].w *= rstd * gg.w;
        ushort4 o; o.x = f2bf(v[j].x); o.y = f2bf(v[j].y); o.z = f2bf(v[j].z); o.w = f2bf(v[j].w);
        ((ushort4*)(H + (size_t)row * DM))[lane + 64 * j] = o; }
    if (Wf) {
        float mine = 0.f;
        for (int h = 0; h < 16; ++h) {
            float p = 0.f;
#pragma unroll
            for (int j = 0; j < 4; ++j) { const int k = (lane + 64 * j) * 4;
                p += v[j].x * Wf[(size_t)k * NIN + h] + v[j].y * Wf[(size_t)(k + 1) * NIN + h] + v[j].z * Wf[(size_t)(k + 2) * NIN + h] + v[j].w * Wf[(size_t)(k + 3) * NIN + h]; }
            p = wave_sum(p);
            if (lane == h) mine = p;
        }
        if (lane < 16) { const int b = row / SEQ, t = row % SEQ; LOGF[((size_t)b * 16 + lane) * SEQ + t] = logsigmoidf(mine + bfg[lane]); }
    }
}

struct EStoreBf16 { bf16_t* O; int ldc; int pad; __device__ void operator()(int m, int n, float a) const { O[(size_t)m * ldc + n] = f2bf(a); } };
struct EStoreF32 { float* O; int ldc; int pad; __device__ void operator()(int m, int n, float a) const { O[(size_t)m * ldc + n] = a; } };
struct EBranch { const bf16_t* G; const float* bg; float* MIXF; bf16_t* MIXED; int i; int pad; __device__ void operator()(int m, int n, float a) const { float v = sigmoidf_(bf2f(G[(size_t)m * 4096 + i * 1024 + n]) + bg[n]) * a; const size_t o = (size_t)m * DM + n; if (i > 0) v += MIXF[o]; if (i < 3) MIXF[o] = v; else MIXED[o] = f2bf(v); } };
struct EResid { const float* base; float* out; __device__ void operator()(int m, int n, float a) const { out[(size_t)m * DM + n] = base[(size_t)m * DM + n] + a; } };

template <class Epi> __global__ void __launch_bounds__(256) n_gemm(const bf16_t* __restrict__ A, const float* __restrict__ W, int lda, int ldw, int K, int kmask, Epi epi) {
    __shared__ float As[16][68], Bs[16][68];
    const int tx = threadIdx.x & 15, ty = threadIdx.x >> 4, m0 = blockIdx.y * 64, n0 = blockIdx.x * 64;
    float acc[4][4];
#pragma unroll
    for (int i = 0; i < 4; ++i)
#pragma unroll
        for (int j = 0; j < 4; ++j) acc[i][j] = 0.f;
    for (int k0 = 0; k0 < K; k0 += 16) {
#pragma unroll
        for (int i = 0; i < 4; ++i) { const int idx = threadIdx.x + i * 256; { const int r = idx >> 4, c = idx & 15; As[c][r] = bf2f(A[(size_t)(m0 + r) * lda + k0 + c]); }
            { const int r = idx >> 6, c = idx & 63; Bs[r][c] = bfr(W[(size_t)((k0 + r) & kmask) * ldw + n0 + c]); } }
        __syncthreads();
#pragma unroll
        for (int kk = 0; kk < 16; ++kk) { float a[4], b[4];
#pragma unroll
            for (int i = 0; i < 4; ++i) { a[i] = As[kk][ty * 4 + i]; b[i] = Bs[kk][tx * 4 + i]; }
#pragma unroll
            for (int i = 0; i < 4; ++i)
#pragma unroll
                for (int j = 0; j < 4; ++j) acc[i][j] += a[i] * b[j]; }
        __syncthreads();
    }
#pragma unroll
    for (int i = 0; i < 4; ++i)
#pragma unroll
        for (int j = 0; j < 4; ++j) epi(m0 + ty * 4 + i, n0 + tx * 4 + j, acc[i][j]);
}

__global__ void __launch_bounds__(256) n_headnorm(bf16_t* X, const float* __restrict__ g, int HD, float scale) {
    const int idx = blockIdx.x * 256 + threadIdx.x, nh = DM / HD, row = idx / nh, h = idx % nh;
    if (row >= T) return;
    bf16_t* p = X + (size_t)row * DM + h * HD; float ss = 0.f;
    for (int d = 0; d < HD; ++d) { const float v = bf2f(p[d]); ss += v * v; }
    const float rstd = rsqrtf(ss / HD + EPS) * scale;
    for (int d = 0; d < HD; ++d) p[d] = f2bf(bf2f(p[d]) * rstd * g[d]);
}

__global__ void __launch_bounds__(1024) n_cumsum(const float* __restrict__ LOGF, float* __restrict__ FB) {
    __shared__ float part[1024];
    const int bh = blockIdx.x, tid = threadIdx.x; const float* src = LOGF + (size_t)bh * SEQ + tid * 8; float v[8]; float s = 0.f;
#pragma unroll
    for (int i = 0; i < 8; ++i) { s += src[i]; v[i] = s; }
    part[tid] = s; __syncthreads();
    if (tid == 0) { float run = 0.f; for (int i = 0; i < 1024; ++i) { const float t_ = part[i]; part[i] = run; run += t_; } }
    __syncthreads();
    const float off = part[tid]; float* dst = FB + (size_t)bh * SEQ + tid * 8;
#pragma unroll
    for (int i = 0; i < 8; ++i) dst[i] = off + v[i];
}

__global__ void __launch_bounds__(256) n_fox_attn(const bf16_t* Q, const bf16_t* __restrict__ K, const bf16_t* __restrict__ V, const float* __restrict__ FB, bf16_t* O) {
    __shared__ float Ks[64][64], Vs[64][64], Fs[64];
    const int bh = blockIdx.y, b = bh >> 4, h = bh & 15, tq = blockIdx.x * 256 + threadIdx.x;
    const size_t rowq = (size_t)b * SEQ + tq;
    float q[64], o[64];
#pragma unroll
    for (int d = 0; d < 64; ++d) { q[d] = bf2f(Q[rowq * DM + h * 64 + d]); o[d] = 0.f; }
    const float Ft = FB[(size_t)bh * SEQ + tq];
    float m = -INFINITY, l = 0.f;
    const int ntile = (blockIdx.x * 256 + 256) / 64;
    for (int kt = 0; kt < ntile; ++kt) {
        __syncthreads();
        for (int i = threadIdx.x; i < 64 * 64; i += 256) { const int r = i >> 6, c = i & 63; const size_t rk = ((size_t)b * SEQ + kt * 64 + r) * DM + h * 64 + c; Ks[r][c] = bf2f(K[rk]); Vs[r][c] = bf2f(V[rk]); }
        if (threadIdx.x < 64) Fs[threadIdx.x] = FB[(size_t)bh * SEQ + kt * 64 + threadIdx.x];
        __syncthreads();
        for (int j = 0; j < 64; ++j) {
            const int s = kt * 64 + j; if (s > tq) break;
            float z = 0.f;
#pragma unroll
            for (int d = 0; d < 64; ++d) z += q[d] * Ks[j][d];
            z += (Ft - Fs[j]) * LOG2E;
            if (z > m) { const float c = exp2f(m - z); l *= c;
#pragma unroll
                for (int d = 0; d < 64; ++d) o[d] *= c;
                m = z; }
            const float p = exp2f(z - m); l += p;
#pragma unroll
            for (int d = 0; d < 64; ++d) o[d] += p * Vs[j][d];
        }
    }
    const float il = 1.f / l;
#pragma unroll
    for (int d = 0; d < 64; ++d) O[rowq * DM + h * 64 + d] = f2bf(o[d] * il);
}

__global__ void __launch_bounds__(256) n_sb_attn(const bf16_t* Q, const bf16_t* __restrict__ K, const bf16_t* __restrict__ V, bf16_t* O) {
    __shared__ float Ks[64][64], Vs[64][64];
    const int bh = blockIdx.y, b = bh >> 4, h = bh & 15, tq = blockIdx.x * 256 + threadIdx.x;
    const size_t rowq = (size_t)b * SEQ + tq;
    float q[64], o[64];
#pragma unroll
    for (int d = 0; d < 64; ++d) { q[d] = bf2f(Q[rowq * DM + h * 64 + d]) * 0.125f; o[d] = 0.f; }
    float R = 0.f;
    for (int kt = (blockIdx.x * 256 + 255) / 64; kt >= 0; --kt) {
        if (__syncthreads_and(R < SB_THR)) break;
        for (int i = threadIdx.x; i < 64 * 64; i += 256) { const int r = i >> 6, c = i & 63; const size_t rk = ((size_t)b * SEQ + kt * 64 + r) * DM + h * 64 + c; Ks[r][c] = bf2f(K[rk]); Vs[r][c] = bf2f(V[rk]); }
        __syncthreads();
        for (int j = 63; j >= 0; --j) {
            const int s = kt * 64 + j; if (s >= tq) continue;
            float z = 0.f;
#pragma unroll
            for (int d = 0; d < 64; ++d) z += q[d] * Ks[j][d];
            const float sp = softplusf(z);
            const float w = __expf((z - sp) + R);
            R -= sp;
#pragma unroll
            for (int d = 0; d < 64; ++d) o[d] += w * Vs[j][d];
        }
    }
#pragma unroll
    for (int d = 0; d < 64; ++d) O[rowq * DM + h * 64 + d] = f2bf(o[d]);
}

__global__ void __launch_bounds__(64) n_lru(const bf16_t* LX, const bf16_t* __restrict__ LG, const float* __restrict__ cw, const float* __restrict__ cb,
                                            const float* __restrict__ wa, const float* __restrict__ ba, const float* __restrict__ wx, const float* __restrict__ bx,
                                            const float* __restrict__ lam, bf16_t* YL) {
    __shared__ float xs[64];
    const int b = blockIdx.x >> 4, n = blockIdx.x & 15, e = threadIdx.x, ch = n * 64 + e;
    float wA[64], wX[64];
#pragma unroll
    for (int d = 0; d < 64; ++d) { wA[d] = wa[((size_t)n * 64 + d) * 64 + e]; wX[d] = wx[((size_t)n * 64 + d) * 64 + e]; }
    const float w0 = cw[ch], w1 = cw[DM + ch], w2 = cw[2 * DM + ch], w3 = cw[3 * DM + ch], bc = cb[ch], bA = ba[ch], bX = bx[ch];
    const float spl = softplusf(-lam[ch]);
    float x1 = 0.f, x2 = 0.f, x3 = 0.f, hs = 0.f;
    for (int t = 0; t < SEQ; ++t) {
        const size_t r = ((size_t)b * SEQ + t) * DM + ch;
        const float x0 = bf2f(LX[r]);
        const float xc = bc + w3 * x0 + w2 * x1 + w1 * x2 + w0 * x3;
        x3 = x2; x2 = x1; x1 = x0;
        __syncthreads();
        xs[e] = xc;
        __syncthreads();
        float ra = bA, ri = bX;
#pragma unroll
        for (int d = 0; d < 64; ++d) { const float xv = xs[d]; ra += xv * wA[d]; ri += xv * wX[d]; }
        const float rr = sigmoidf_(ra), ii = sigmoidf_(ri);
        const float la = -8.f * rr * spl;
        const float a = __expf(la);
        const float u = sqrtf(-expm1f(2.f * la)) * (ii * xc);
        hs = a * hs + u;
        YL[r] = f2bf(hs * gelu_tanh(bf2f(LG[r])));
    }
}

__global__ void __launch_bounds__(256) n_memkv_post(const float* __restrict__ raw, const float* __restrict__ gk, const float* __restrict__ gq, bf16_t* __restrict__ MK, bf16_t* __restrict__ MVT) {
    const int row = blockIdx.x, b = row >> 8, m = row & 255, d = threadIdx.x;
    __shared__ float red[4];
    for (int h = 0; h < 4; ++h) {
        const float k = raw[(size_t)row * 2048 + h * 256 + d];
        float ss = wave_sum(k * k);
        __syncthreads();
        if ((threadIdx.x & 63) == 0) red[threadIdx.x >> 6] = ss;
        __syncthreads();
        ss = red[0] + red[1] + red[2] + red[3];
        const float rstd = rsqrtf(ss * (1.f / 256.f) + EPS);
        MK[((size_t)b * 256 + m) * DM + h * 256 + d] = f2bf(k * rstd * gk[d] * gq[d]);
        MVT[(((size_t)b * 4 + h) * 256 + d) * 256 + m] = f2bf(raw[(size_t)row * 2048 + 1024 + h * 256 + d]);
    }
}

__global__ void __launch_bounds__(256) n_mem_attn(const bf16_t* MQ, const bf16_t* __restrict__ MK, const bf16_t* __restrict__ MVT, bf16_t* YM) {
    __shared__ float qs[256], ps[256], red[4];
    const int row = blockIdx.x >> 2, h = blockIdx.x & 3, b = row / SEQ, tid = threadIdx.x;
    const float qv = bf2f(MQ[(size_t)row * DM + h * 256 + tid]);
    float ss = wave_sum(qv * qv);
    if ((tid & 63) == 0) red[tid >> 6] = ss;
    qs[tid] = qv;
    __syncthreads();
    const float rstd = rsqrtf((red[0] + red[1] + red[2] + red[3]) * (1.f / 256.f) + EPS);
    const bf16_t* kr = MK + ((size_t)b * 256 + tid) * DM + h * 256;
    float s = 0.f;
    for (int d = 0; d < 256; ++d) s += qs[d] * bf2f(kr[d]);
    s *= rstd * (1.f / 16.f);
    __syncthreads();
    float mx = s;
#pragma unroll
    for (int o = 1; o < 64; o <<= 1) mx = fmaxf(mx, __shfl_xor(mx, o));
    if ((tid & 63) == 0) red[tid >> 6] = mx;
    __syncthreads();
    mx = fmaxf(fmaxf(red[0], red[1]), fmaxf(red[2], red[3]));
    const float p = __expf(s - mx);
    ps[tid] = p;
    float sum = wave_sum(p);
    __syncthreads();
    if ((tid & 63) == 0) red[tid >> 6] = sum;
    __syncthreads();
    sum = red[0] + red[1] + red[2] + red[3];
    const bf16_t* vr = MVT + (((size_t)b * 4 + h) * 256 + tid) * 256;
    float o = 0.f;
    for (int m = 0; m < 256; ++m) o += ps[m] * bf2f(vr[m]);
    YM[(size_t)row * DM + h * 256 + tid] = f2bf(o / sum);
}

__global__ void __launch_bounds__(256) n_act(const bf16_t* __restrict__ GV, const float* __restrict__ cw, const float* __restrict__ cb, bf16_t* __restrict__ ACT) {
    const size_t idx = (size_t)blockIdx.x * 256 + threadIdx.x; if (idx >= (size_t)T * DFF) return;
    const int r = (int)(idx / DFF), c = (int)(idx % DFF), t = r % SEQ;
    const float g0 = bf2f(GV[(size_t)r * 2 * DFF + c]);
    const float g1 = t >= 1 ? bf2f(GV[(size_t)(r - 1) * 2 * DFF + c]) : 0.f;
    const float g2 = t >= 2 ? bf2f(GV[(size_t)(r - 2) * 2 * DFF + c]) : 0.f;
    const float pre = cb[c] + cw[2 * DFF + c] * g0 + cw[DFF + c] * g1 + cw[c] * g2;
    const float val = bf2f(GV[(size_t)r * 2 * DFF + DFF + c]);
    ACT[(size_t)r * DFF + c] = f2bf(pre * sigmoidf_(pre) * val);
}

#define CFG 32767
namespace pg8 {
#define PG8_LAS __attribute__((address_space(3)))
typedef unsigned short bf16_t;
typedef short bf16x8 __attribute__((ext_vector_type(8)));
typedef float f32x4 __attribute__((ext_vector_type(4)));
typedef unsigned u32x4 __attribute__((ext_vector_type(4)));
constexpr int BM = 256, BK = 64, HALF = 128, HTB = HALF * BK * 2  , STAGE_BYTES = 8 * HTB, NXCD = 8, WGM = 8;

__host__ __device__ __forceinline__ int lds_byte(int r, int c) { const int st = (r >> 4) * 2 + (c >> 5), rr = r & 15, cc = c & 31, ob = rr * 64 + cc * 2; return st * 1024 + (ob ^ (((ob >> 9) & 1) << 5)); }
__host__ __device__ __forceinline__ void stage_rc(int b, int& R, int& C) { const int st = b / 1024, sb = b % 1024, swz = sb ^ (((sb >> 9) & 1) << 5); R = (st >> 1) * 16 + swz / 64; C = (st & 1) * 32 + (swz % 64) / 2; }
__host__ __device__ __forceinline__ int perm32(int rho) { const int n = rho >> 4, i = rho & 15; return 8 * (i >> 2) + 4 * n + (i & 3); }

struct Unit { int pm, pn; };
struct Gemm { int lda, ldb, K; };

struct StaticOrder {
    int nM, nN, nwg, G, c;
    __host__ __device__ void init(int M, int N, int G_, int c_) { nM = M / BM; nN = N / BM; nwg = nM * nN; G = G_; c = c_; }
    __host__ __device__ bool next(int i, Unit& u) const {
        const long L = (long)i * G + c; if (L >= nwg) return false;
        int wgid = (int)L; { const int q = nwg / NXCD, r = nwg % NXCD, xcd = wgid % NXCD, off = wgid / NXCD; wgid = (xcd < r ? xcd * (q + 1) : r * (q + 1) + (xcd - r) * q) + off; }
        const int nig = WGM * nN, gid = wgid / nig, fm = gid * WGM, gsz = (nM - fm) < WGM ? (nM - fm) : WGM;
        u.pm = fm + ((wgid % nig) % gsz); u.pn = (wgid % nig) / gsz; return true;
    }
    __device__ __forceinline__ void a_ready(const Unit&) const {}
    __device__ __forceinline__ void done(const Unit&) const {}
};

__device__ __forceinline__ unsigned cvt_pk_bf16(float lo, float hi) { unsigned r; asm volatile("v_cvt_pk_bf16_f32 %0, %1, %2" : "=v"(r) : "v"(lo), "v"(hi)); return r; }
typedef float f32x2 __attribute__((ext_vector_type(2)));
__device__ __forceinline__ f32x2 gelu_pk(f32x2 v) {
    const f32x2 av = __builtin_elementwise_abs(v), d = av * 0.2316418882f + 1.0f;
    f32x2 t; t.x = __builtin_amdgcn_rcpf(d.x); t.y = __builtin_amdgcn_rcpf(d.y);
    f32x2 q = t * 0.5307027145f + (-0.7265760135f); q = q * t + 0.7107068705f; q = q * t + (-0.142248368f); q = q * t + 0.127414796f; q = q * t;
    const f32x2 s = (v * v) * (-0.72134752044f);
    f32x2 e; e.x = __builtin_amdgcn_exp2f(s.x); e.y = __builtin_amdgcn_exp2f(s.y);
    const f32x2 m = v * (q * e), r = v - m;
    f32x2 o; o.x = v.x < 0.f ? m.x : r.x; o.y = v.y < 0.f ? m.y : r.y; return o;
}

template <class Epi, class Sched, bool ALIGN_EPI = false, bool SP2 = false>
__device__ __forceinline__ void gemm_phase(PG8_LAS unsigned char* lds, const Gemm g, const Sched& S, const Epi& E) {
    const int tid = mk_tid(), wid = __builtin_amdgcn_readfirstlane(tid >> 6), lane = tid & 63, wr = wid >> 2, wc = wid & 3, fr = lane & 15, fq = lane >> 4;
    const int K = g.K, nt = K / BK;
    unsigned voffA[2], voffB[2];
#pragma unroll
    for (int i = 0; i < 2; ++i) { int R, C; stage_rc(tid * 16 + i * 8192, R, C); const int Rb = Epi::PERM ? ((R & ~31) + perm32(R & 31)) : R;
        voffA[i] = (unsigned)(R * g.lda + C) * 2u; voffB[i] = (unsigned)(Rb * g.ldb + C) * 2u; }
    const size_t kstep = (size_t)(BK * 2);
    const size_t hstepA = (size_t)HALF * g.lda * 2, hstepB = (size_t)HALF * g.ldb * 2;
    const unsigned ldsw = (unsigned)wid * 1024u;
    const int aoff = lds_byte(wr * 64 + fr, fq * 8), boff = lds_byte(wc * 32 + fr, fq * 8);
#define PG8_SA(b, h) (((b) * 2 + (h)) * HTB)
#define PG8_SB(b, h) ((4 + (b) * 2 + (h)) * HTB)
#define PG8_STAGE(bufoff, gbase, voff) do { _Pragma("unroll") for (int _i = 0; _i < 2; ++_i) \
        __builtin_amdgcn_global_load_lds((const unsigned*)((const char*)(gbase) + (voff)[_i]), (PG8_LAS unsigned*)(lds + (bufoff) + ldsw + _i * 8192), 16, 0, 0); } while (0)
#define PG8_LDA(dst, b, h) do { _Pragma("unroll") for (int m = 0; m < 4; ++m) _Pragma("unroll") for (int k = 0; k < 2; ++k) dst[m][k] = *(const PG8_LAS bf16x8*)(lds + PG8_SA(b, h) + aoff + m * 2048 + k * 1024); } while (0)
#define PG8_LDB(dst, b, h) do { _Pragma("unroll") for (int n = 0; n < 2; ++n) _Pragma("unroll") for (int k = 0; k < 2; ++k) dst[n][k] = *(const PG8_LAS bf16x8*)(lds + PG8_SB(b, h) + boff + n * 2048 + k * 1024); } while (0)
#define PG8_MMA(ai, bj, At, Bt) do { __builtin_amdgcn_s_setprio(1); _Pragma("unroll") for (int m = 0; m < 4; ++m) _Pragma("unroll") for (int n = 0; n < 2; ++n) _Pragma("unroll") for (int k = 0; k < 2; ++k) \
        acc[ai][bj][m][n] = __builtin_amdgcn_mfma_f32_16x16x32_bf16(Bt[n][k], At[m][k], acc[ai][bj][m][n], 0, 0, 0); __builtin_amdgcn_s_setprio(0); } while (0)
#define PG8_WAIT_V(n) asm volatile("s_waitcnt vmcnt(" #n ")" ::: "memory")
#define PG8_WAIT_L(n) asm volatile("s_waitcnt lgkmcnt(" #n ")" ::: "memory")
#define PG8_BAR __builtin_amdgcn_s_barrier()
#define PG8_SCHED __builtin_amdgcn_sched_barrier(0)
    Unit cur, nxt; int ui = 0;
    if (!S.next(0, cur)) return;
    f32x4 acc[2][2][4][2];
#pragma unroll
    for (int a = 0; a < 2; ++a)
#pragma unroll
        for (int b = 0; b < 2; ++b)
#pragma unroll
            for (int m = 0; m < 4; ++m)
#pragma unroll
                for (int n = 0; n < 2; ++n) acc[a][b][m][n] = (f32x4){0.f, 0.f, 0.f, 0.f};
    bf16x8 At[4][2], B0[2][2], B1[2][2];
    const char* cA = S.aptr(cur); const char* cB = S.bptr(cur);
    S.a_ready(cur);
    if constexpr (SP2) {
        PG8_STAGE(PG8_SB(0, 0), cB, voffB); PG8_STAGE(PG8_SB(0, 1), cB + hstepB, voffB); PG8_STAGE(PG8_SA(0, 0), cA, voffA); PG8_STAGE(PG8_SA(0, 1), cA + hstepA, voffA);
        if (wr == 1) PG8_BAR;
        PG8_WAIT_V(2); PG8_BAR;
        PG8_STAGE(PG8_SB(1, 0), cB + kstep, voffB); PG8_STAGE(PG8_SA(1, 0), cA + kstep, voffA); PG8_STAGE(PG8_SB(1, 1), cB + hstepB + kstep, voffB);
        PG8_WAIT_V(6); PG8_BAR;
    } else {
        PG8_STAGE(PG8_SB(0, 0), cB, voffB); PG8_STAGE(PG8_SA(0, 0), cA, voffA); PG8_STAGE(PG8_SB(0, 1), cB + hstepB, voffB); PG8_STAGE(PG8_SA(0, 1), cA + hstepA, voffA);
        if (wr == 1) PG8_BAR;
        PG8_WAIT_V(4); PG8_BAR;
        PG8_STAGE(PG8_SB(1, 0), cB + kstep, voffB); PG8_STAGE(PG8_SA(1, 0), cA + kstep, voffA); PG8_STAGE(PG8_SB(1, 1), cB + hstepB + kstep, voffB);
        PG8_WAIT_V(6); PG8_BAR;
    }
    for (;;) {
        const bool has_next = S.next(ui + 1, nxt);
        const char* nA = has_next ? S.aptr(nxt) : cA; const char* nB = has_next ? S.bptr(nxt) : cB;
        for (int t = 0; t < nt; t += 2) {
            const bool last = (t == nt - 2);
            const char* a1 = cA + (size_t)(t + 1) * kstep;
            const char* a2 = last ? nA : cA + (size_t)(t + 2) * kstep; const char* b2 = last ? nB : cB + (size_t)(t + 2) * kstep;
            const char* a3 = a2 + kstep; const char* b3 = b2 + kstep;
            if (last && has_next) S.a_ready(nxt);
            if constexpr (SP2) {
            PG8_LDB(B0, 0, 0); PG8_LDB(B1, 0, 1); PG8_SCHED; PG8_LDA(At, 0, 0); PG8_STAGE(PG8_SA(1, 1), a1 + hstepA, voffA);
            PG8_WAIT_V(8); PG8_WAIT_L(0); PG8_BAR; PG8_MMA(0, 0, At, B0); PG8_MMA(0, 1, At, B1); PG8_BAR; PG8_SCHED;
            PG8_LDA(At, 0, 1); PG8_STAGE(PG8_SB(0, 0), b2, voffB); PG8_STAGE(PG8_SB(0, 1), b2 + hstepB, voffB); PG8_STAGE(PG8_SA(0, 0), a2, voffA);
            PG8_WAIT_V(8); PG8_WAIT_L(0); PG8_BAR; PG8_MMA(1, 0, At, B0); PG8_MMA(1, 1, At, B1); PG8_BAR; PG8_SCHED;
            PG8_LDB(B0, 1, 0); PG8_LDB(B1, 1, 1); PG8_SCHED; PG8_LDA(At, 1, 0); PG8_STAGE(PG8_SA(0, 1), a2 + hstepA, voffA);
            PG8_WAIT_V(8); PG8_WAIT_L(0); PG8_BAR; PG8_MMA(0, 0, At, B0); PG8_MMA(0, 1, At, B1); PG8_BAR; PG8_SCHED;
            PG8_LDA(At, 1, 1); PG8_STAGE(PG8_SB(1, 0), b3, voffB); PG8_STAGE(PG8_SB(1, 1), b3 + hstepB, voffB); PG8_STAGE(PG8_SA(1, 0), a3, voffA);
            PG8_WAIT_V(8); PG8_WAIT_L(0); PG8_BAR; PG8_MMA(1, 0, At, B0); PG8_MMA(1, 1, At, B1); PG8_BAR; PG8_SCHED;
            } else {
            PG8_LDB(B0, 0, 0); PG8_SCHED; PG8_LDA(At, 0, 0); PG8_STAGE(PG8_SA(1, 1), a1 + hstepA, voffA);
            PG8_WAIT_L(8); PG8_BAR; PG8_WAIT_L(0); PG8_MMA(0, 0, At, B0); PG8_BAR; PG8_SCHED;
            PG8_LDB(B1, 0, 1); PG8_STAGE(PG8_SB(0, 0), b2, voffB);
            PG8_BAR; PG8_WAIT_L(0); PG8_MMA(0, 1, At, B1); PG8_BAR;
            PG8_LDA(At, 0, 1); PG8_STAGE(PG8_SA(0, 0), a2, voffA);
            PG8_BAR; PG8_WAIT_L(0); PG8_MMA(1, 0, At, B0); PG8_BAR; PG8_SCHED;
            PG8_STAGE(PG8_SB(0, 1), b2 + hstepB, voffB);
            PG8_WAIT_V(6); PG8_BAR; PG8_MMA(1, 1, At, B1); PG8_BAR;
            PG8_LDB(B0, 1, 0); PG8_SCHED; PG8_LDA(At, 1, 0); PG8_STAGE(PG8_SA(0, 1), a2 + hstepA, voffA);
            PG8_WAIT_L(8); PG8_BAR; PG8_WAIT_L(0); PG8_MMA(0, 0, At, B0); PG8_BAR; PG8_SCHED;
            PG8_LDB(B1, 1, 1); PG8_STAGE(PG8_SB(1, 0), b3, voffB);
            PG8_BAR; PG8_WAIT_L(0); PG8_MMA(0, 1, At, B1); PG8_BAR;
            PG8_LDA(At, 1, 1); PG8_STAGE(PG8_SA(1, 0), a3, voffA);
            PG8_BAR; PG8_WAIT_L(0); PG8_MMA(1, 0, At, B0); PG8_BAR; PG8_SCHED;
            PG8_STAGE(PG8_SB(1, 1), b3 + hstepB, voffB);
            PG8_WAIT_V(6); PG8_BAR; PG8_MMA(1, 1, At, B1); PG8_BAR;
            }
        }
        if constexpr (ALIGN_EPI) { if (wr == 0) PG8_BAR; }
        if constexpr (!Epi::AFTER_DRAIN) { int fr_ = fr, fq_ = fq; asm volatile("" : "+v"(fr_), "+v"(fq_));   E(acc, cur, wr, wc, fr_, fq_); S.done(cur); }
        if (!has_next) break;
#pragma unroll
        for (int a = 0; a < 2; ++a)
#pragma unroll
            for (int b = 0; b < 2; ++b)
#pragma unroll
                for (int m = 0; m < 4; ++m)
#pragma unroll
                    for (int n = 0; n < 2; ++n) acc[a][b][m][n] = (f32x4){0.f, 0.f, 0.f, 0.f};
        cur = nxt; cA = nA; cB = nB; ++ui;
        if constexpr (ALIGN_EPI) { if (wr == 1) PG8_BAR; }
    }
    PG8_WAIT_V(0);
    if constexpr (!ALIGN_EPI) { if (wr == 0) PG8_BAR; }
    PG8_BAR;
    if constexpr (Epi::AFTER_DRAIN) { E.fused(acc, cur, wr, wc, fr, fq, lds, wid, lane); S.done(cur); }
#undef PG8_SA
#undef PG8_SB
#undef PG8_STAGE
#undef PG8_LDA
#undef PG8_LDB
#undef PG8_MMA
#undef PG8_WAIT_V
#undef PG8_WAIT_L
#undef PG8_BAR
#undef PG8_SCHED
}
}
#include <hip/hip_bf16.h>
#include <cmath>
namespace attn_body {
using bf16=__hip_bfloat16;
using bf16x8=__attribute__((ext_vector_type(8)))short;
using s16x4=__attribute__((ext_vector_type(4)))short;
using f32x16=__attribute__((ext_vector_type(16)))float;
using u32x4=__attribute__((ext_vector_type(4)))unsigned;
constexpr int BATCH=2,NHEAD=16,SEQ=8192,D=64,DM=NHEAD*D;
constexpr int NW=8,QBLK=32,QB=QBLK*NW,KVBLK=64,NQB=SEQ/QB;
constexpr int ATTN_PITCH=DM, ATTN_UNIT_ROWS=QB;
__device__ __forceinline__ int crow(int r,int hi){return (r&3)+8*(r>>2)+4*hi;}
#define SBAR() __builtin_amdgcn_sched_barrier(0)
__device__ __forceinline__ void cmask(f32x16&p0,f32x16&p1,int jb,int qrel,int hi){
  const float NEG=-INFINITY; int kb=64*jb+4*hi;
  #pragma unroll
  for(int r=0;r<16;++r){int kv=kb+(r&3)+8*(r>>2); if(kv>qrel)p0[r]=NEG; if(kv+32>qrel)p1[r]=NEG;}
}

constexpr int NSLOT=3, SLOTB=8192;
constexpr int LDS_K=0, LDS_V=NSLOT*SLOTB, LDS_WS=2*NSLOT*SLOTB, LDS_OST=LDS_WS+NW*64*4, LDS_BYTES=LDS_OST+NW*4096;
constexpr int BIAS_OFF=86016;
constexpr float C2=0.125f*1.4426950408889634f;
__device__ __forceinline__ void glds16(const void*gsrc,unsigned lds_dst){unsigned keep;
  asm volatile("s_mov_b32 %0, m0\n\ts_mov_b32 m0, %2\n\ts_nop 0\n\tglobal_load_lds_dwordx4 %1, off\n\ts_mov_b32 m0, %0":"=&s"(keep):"v"(gsrc),"s"(lds_dst):"memory");}
__device__ __forceinline__ float max3f(float a,float b,float c){float r;asm("v_max3_f32 %0, %1, %2, %3":"=v"(r):"v"(a),"v"(b),"v"(c));return r;}
__device__ __forceinline__ float max2f(float a,float b){float r;asm("v_max_f32_e32 %0, %1, %2":"=v"(r):"v"(a),"v"(b));return r;}
__device__ __forceinline__ float fadd_s(float a,float b){float r;asm("v_add_f32_e32 %0, %1, %2":"=v"(r):"v"(a),"v"(b));return r;}
__device__ __forceinline__ float fsub_s(float a,float b){float r;asm("v_sub_f32_e32 %0, %1, %2":"=v"(r):"v"(a),"v"(b));return r;}
typedef float f32x2_t __attribute__((ext_vector_type(2))); typedef __bf16 bf16x2_t __attribute__((ext_vector_type(2)));
__device__ __forceinline__ unsigned cvtpk_s(float lo,float hi){f32x2_t v={lo,hi};bf16x2_t b=__builtin_convertvector(v,bf16x2_t);return __builtin_bit_cast(unsigned,b);}
#define WAIT_BAR(N) asm volatile("s_waitcnt vmcnt(" #N ") lgkmcnt(0)\n\ts_barrier":::"memory")

__device__ __forceinline__ void qkt(f32x16&p0,f32x16&p1,const char*Kslot,const bf16x8*qr,const f32x16&negm,int r32,int hi){
  const char*kb=Kslot+hi*1024+r32*16;
  #pragma unroll
  for(int d0=0;d0<4;++d0){
    const bf16x8 b0=*reinterpret_cast<const bf16x8*>(kb+d0*2048);
    const bf16x8 b1=*reinterpret_cast<const bf16x8*>(kb+d0*2048+512);
    if(d0==0){p0=__builtin_amdgcn_mfma_f32_32x32x16_bf16(b0,qr[0],negm,0,0,0);p1=__builtin_amdgcn_mfma_f32_32x32x16_bf16(b1,qr[0],negm,0,0,0);}
    else{p0=__builtin_amdgcn_mfma_f32_32x32x16_bf16(b0,qr[d0],p0,0,0,0);p1=__builtin_amdgcn_mfma_f32_32x32x16_bf16(b1,qr[d0],p1,0,0,0);}}
}
typedef __attribute__((address_space(3))) const char* lds_cptr;
typedef short v4i16_t __attribute__((ext_vector_type(4)));
__device__ __forceinline__ void kload8(bf16x8*kf,lds_cptr kp){
  kf[0]=*(const __attribute__((address_space(3))) bf16x8*)(kp);      kf[1]=*(const __attribute__((address_space(3))) bf16x8*)(kp+512);
  kf[2]=*(const __attribute__((address_space(3))) bf16x8*)(kp+2048); kf[3]=*(const __attribute__((address_space(3))) bf16x8*)(kp+2560);
  kf[4]=*(const __attribute__((address_space(3))) bf16x8*)(kp+4096); kf[5]=*(const __attribute__((address_space(3))) bf16x8*)(kp+4608);
  kf[6]=*(const __attribute__((address_space(3))) bf16x8*)(kp+6144); kf[7]=*(const __attribute__((address_space(3))) bf16x8*)(kp+6656);
}
__device__ __forceinline__ void kload2(bf16x8*kf,lds_cptr kp,int j){ kf[2*j]=*(const __attribute__((address_space(3))) bf16x8*)(kp+j*2048); kf[2*j+1]=*(const __attribute__((address_space(3))) bf16x8*)(kp+j*2048+512); }
__device__ __forceinline__ s16x4 vtr(lds_cptr p){ return __builtin_bit_cast(s16x4,__builtin_amdgcn_ds_read_tr16_b64_v4i16((__attribute__((address_space(3))) v4i16_t*)p)); }
__device__ __forceinline__ float rowmax(const f32x16&p0,const f32x16&p1){
  float a=max3f(p0[0],p0[1],p1[0]),b=max3f(p0[2],p0[3],p1[1]);a=max3f(a,p1[2],p1[3]);
  #pragma unroll
  for(int r=4;r<16;r+=4){a=max3f(a,p0[r],p0[r+1]);b=max3f(b,p0[r+2],p0[r+3]);a=max3f(a,p1[r],p1[r+1]);b=max3f(b,p1[r+2],p1[r+3]);}
  const float m=max2f(a,b);
  auto rr=__builtin_amdgcn_permlane32_swap(__float_as_uint(m),__float_as_uint(m),false,false);
  return max2f(__uint_as_float(rr[0]),__uint_as_float(rr[1]));
}
__device__ __forceinline__ void pv(f32x16*o,int vb,bf16x8 pa0,bf16x8 pa1,bf16x8 pa2,bf16x8 pa3){
  #pragma unroll
  for(int d0=0;d0<2;++d0){s16x4 lo[4],hi[4];
    #pragma unroll
    for(int ks=0;ks<4;++ks){
      asm volatile("ds_read_b64_tr_b16 %0,%1 offset:%c2":"=&v"(lo[ks]):"v"(vb),"i"(d0*4096+ks*1024):"memory");
      asm volatile("ds_read_b64_tr_b16 %0,%1 offset:%c2":"=&v"(hi[ks]):"v"(vb),"i"(d0*4096+ks*1024+512):"memory");}
    asm volatile("s_waitcnt lgkmcnt(0)":::"memory");SBAR();
    #define PK(k) (bf16x8){lo[k][0],lo[k][1],lo[k][2],lo[k][3],hi[k][0],hi[k][1],hi[k][2],hi[k][3]}
    o[d0]=__builtin_amdgcn_mfma_f32_32x32x16_bf16(pa0,PK(0),o[d0],0,0,0);
    o[d0]=__builtin_amdgcn_mfma_f32_32x32x16_bf16(pa1,PK(1),o[d0],0,0,0);
    o[d0]=__builtin_amdgcn_mfma_f32_32x32x16_bf16(pa2,PK(2),o[d0],0,0,0);
    o[d0]=__builtin_amdgcn_mfma_f32_32x32x16_bf16(pa3,PK(3),o[d0],0,0,0);
    #undef PK
  }
}

#ifndef ATTN_STORE16
#define ATTN_STORE16(p,v) (*(u32x4*)(p)=(v))
#endif
template<int THRL> __device__ __forceinline__ void attn_unit(int b,int h,int qb,const bf16*Q,const bf16*__restrict__ K,const bf16*__restrict__ V,bf16*O,const float*__restrict__ FBrow,float skip_thr,char*shm){
  const int tid=mk_tid(),lane=tid&63,r32=lane&31,hi=lane>>5; const int wid=__builtin_amdgcn_readfirstlane(tid>>6);
  const long rowbase=(long)b*SEQ; const int q0=qb*QB;
  int t_start=0;
  { const int ntf=(q0+QB)/KVBLK; const float Fq0=FBrow[q0];
    const bool c0=lane<ntf&&(Fq0-FBrow[64*(lane<ntf?lane:0)+63])*1.4426950408889634f<skip_thr;
    const bool c1=(lane+64)<ntf&&(Fq0-FBrow[64*((lane+64)<ntf?lane+64:0)+63])*1.4426950408889634f<skip_thr;
    int cnt=__popcll(__ballot(c0))+__popcll(__ballot(c1)); cnt&=~1; if(cnt>ntf-4)cnt=ntf-4; t_start=__builtin_amdgcn_readfirstlane(cnt); }
  const bf16*Qw=Q+(rowbase+q0+wid*QBLK)*DM+h*D;
  const bf16*Kh=K+(rowbase+(long)t_start*KVBLK)*DM+h*D,*Vh=V+(rowbase+(long)t_start*KVBLK)*DM+h*D;
  const lds_cptr shm3=(lds_cptr)shm;
  const unsigned lds0=(unsigned)(uintptr_t)shm;
  float*wsf=(float*)(shm+LDS_WS)+wid*64;
  const bf16*ksrc=Kh+(long)lane*DM+wid*8;
  const bf16*vsrc=Vh+(long)(16*(wid&3)+(lane>>2))*DM+(wid>>2)*32+(lane&3)*8;
  const unsigned kdst=lds0+LDS_K+wid*1024, vdst=lds0+LDS_V+wid*1024;
  #define DMA_K(t,slot) glds16(ksrc+(long)(t)*KVBLK*DM,(unsigned)__builtin_amdgcn_readfirstlane(kdst+(slot)))
  #define DMA_V(t,slot) glds16(vsrc+(long)(t)*KVBLK*DM,(unsigned)__builtin_amdgcn_readfirstlane(vdst+(slot)))
  const int vb0=(int)(lds0+LDS_V)+((lane>>4)&1)*32+(lane&3)*8+(4*hi+((lane&15)>>2))*64;
  const char*Kbase=shm+LDS_K; bf16x8 kf[8];
  const lds_cptr kp0=shm3+LDS_K+hi*1024+r32*16; const lds_cptr vp0=shm3+LDS_V+((lane>>4)&1)*32+(lane&3)*8+(4*hi+((lane&15)>>2))*64;
  const int NT=(q0+QB)/KVBLK-t_start;
  {
    typedef __attribute__((address_space(3))) float lds_f32; lds_f32* bl=(lds_f32*)(shm3+BIAS_OFF);
    const int nb=q0+QB; const float Fl=FBrow[nb-1];
    for(int i=t_start*KVBLK+tid;i<nb;i+=NW*64) bl[i]=(Fl-FBrow[i])*1.4426950408889634f;
    asm volatile("s_waitcnt vmcnt(0) lgkmcnt(0)\n\ts_barrier":::"memory"); }
  typedef float f32x4v __attribute__((ext_vector_type(4)));
  #define BIAS(P0,P1,t) do{ const __attribute__((address_space(3))) f32x4v* bp_=(const __attribute__((address_space(3))) f32x4v*)(shm3+BIAS_OFF)+((t)+t_start)*16+hi; \
    _Pragma("unroll") for(int g_=0;g_<4;++g_){ const f32x4v f0_=bp_[2*g_]+nm, f1_=bp_[8+2*g_]+nm; \
      P0[4*g_]+=f0_[0];P0[4*g_+1]+=f0_[1];P0[4*g_+2]+=f0_[2];P0[4*g_+3]+=f0_[3]; P1[4*g_]+=f1_[0];P1[4*g_+1]+=f1_[1];P1[4*g_+2]+=f1_[2];P1[4*g_+3]+=f1_[3]; } }while(0)
  DMA_K(0,0);DMA_V(0,0);DMA_K(1,SLOTB);
  bf16x8 qr[4];
  #pragma unroll
  for(int d0=0;d0<4;++d0)qr[d0]=*reinterpret_cast<const bf16x8*>(&Qw[(long)r32*DM+d0*16+hi*8]);
  float mhat=0.f,l_reg=0.f;f32x16 o[2];o[0]=f32x16{};o[1]=f32x16{};const f32x16 negm=f32x16{}; float nm=0.f;
  const int qrel=wid*QBLK+r32;
  #define CMASK(P0,P1,t) do{int jb_=(t)-(NT-4); if(jb_>=0)cmask(P0,P1,jb_,qrel,hi);}while(0)
  bool resc=false;
  #define START(P0,P1) do{ const float rm=rowmax(P0,P1); resc=false; \
    { const float dl=rm; mhat=fadd_s(mhat,dl); \
      _Pragma("unroll") for(int r=0;r<16;++r){P0[r]=fsub_s(P0[r],dl);P1[r]=fsub_s(P1[r],dl);} \
      nm=-mhat; } \
    _Pragma("unroll") for(int r=0;r<16;++r)P0[r]=__builtin_amdgcn_exp2f(P0[r]); }while(0)
  #define RESC() do{ if(resc){ asm volatile("s_waitcnt lgkmcnt(0)":::"memory"); \
      _Pragma("unroll") for(int d_=0;d_<2;++d_) _Pragma("unroll") for(int r=0;r<16;++r)o[d_][r]*=wsf[crow(r,hi)]; } }while(0)
  f32x16 pA0,pA1,pB0,pB1;
  int sl_prev=0,sl_cur=0,sl_next=SLOTB;
  #define ROT() do{sl_prev=sl_cur;sl_cur=sl_next;sl_next=(sl_next==(NSLOT-1)*SLOTB)?0:sl_next+SLOTB;}while(0)
  DMA_K(2,2*SLOTB);
  WAIT_BAR(3);
  qkt(pA0,pA1,Kbase,qr,negm,r32,hi);asm volatile("s_nop 15\n\ts_nop 7":"+v"(pA0),"+v"(pA1));BIAS(pA0,pA1,0);CMASK(pA0,pA1,0);
  START(pA0,pA1);
  _Pragma("unroll") for(int r=0;r<16;++r)pA1[r]=__builtin_amdgcn_exp2f(pA1[r]);
  WAIT_BAR(0);
  DMA_K(3,0);DMA_V(1,SLOTB);
  ROT();
  kload8(kf,kp0+sl_cur);
  WAIT_BAR(2);
  s16x4 vlo[8],vhi[8]; u32x4 pw0,pw1,pw2,pw3;
  #define PKW(P,B) cvtpk_s(P[B],P[B+1])
  #define PAF(k) __builtin_bit_cast(bf16x8,pw##k)
  #define VFR(i) (bf16x8){vlo[i][0],vlo[i][1],vlo[i][2],vlo[i][3],vhi[i][0],vhi[i][1],vhi[i][2],vhi[i][3]}
  #define PIN(x) asm volatile("":"+v"(x))
  #define MX3(a,b,c) __builtin_fmaxf(__builtin_fmaxf((a),(b)),(c))
  #define GAPA(MF,A0,A1,A2,A3,W0,W1,PW) do{ MF; sacc+=A0; sacc+=A1; sacc+=A2; sacc+=A3; PIN(sacc); W0; W1; PIN(PW); SBAR(); }while(0)
  #define EX(v) __builtin_amdgcn_exp2f(v)
  #define GAPB(MF,X,B) do{ MF; X[B]=EX(X[B]); X[B+1]=EX(X[B+1]); X[B+2]=EX(X[B+2]); X[B+3]=EX(X[B+3]); PIN(X); SBAR(); }while(0)
  #define VRD(i) do{ vlo[i]=vtr(vp_+(((i)>>2)*4096+((i)&3)*1024)); vhi[i]=vtr(vp_+(((i)>>2)*4096+((i)&3)*1024+512)); }while(0)
  #define KRD(G,j) do{ if(G){ kload2(kf,kp0+sl_next,j); SBAR(); } }while(0)
  #define STEP(C0,C1,P0,P1,t,GK,GV,GL) do{ SBAR(); \
    const lds_cptr vp_=vp0+sl_prev; \
    VRD(0); SBAR(); float sacc=(P0[0]+P0[1]); \
    GAPA(C0=__builtin_amdgcn_mfma_f32_32x32x16_bf16(kf[0],qr[0],negm,0,0,0), P0[2],P0[3],P0[4],P0[5],     pw0[0]=PKW(P0,0), pw0[1]=PKW(P0,2), pw0); \
    VRD(4); SBAR(); GAPA(C1=__builtin_amdgcn_mfma_f32_32x32x16_bf16(kf[1],qr[0],negm,0,0,0), P0[6],P0[7],P0[8],P0[9],     pw0[2]=PKW(P0,4), pw0[3]=PKW(P0,6), pw0); \
    VRD(1); SBAR(); GAPA(C0=__builtin_amdgcn_mfma_f32_32x32x16_bf16(kf[2],qr[1],C0,0,0,0),   P0[10],P0[11],P0[12],P0[13], pw1[0]=PKW(P0,8), pw1[1]=PKW(P0,10), pw1); \
    VRD(5); SBAR(); GAPA(C1=__builtin_amdgcn_mfma_f32_32x32x16_bf16(kf[3],qr[1],C1,0,0,0),   P0[14],P0[15],P1[0],P1[1],   pw1[2]=PKW(P0,12),pw1[3]=PKW(P0,14), pw1); \
    VRD(2); SBAR(); GAPA(C0=__builtin_amdgcn_mfma_f32_32x32x16_bf16(kf[4],qr[2],C0,0,0,0),   P1[2],P1[3],P1[4],P1[5],     pw2[0]=PKW(P1,0), pw2[1]=PKW(P1,2), pw2); \
    VRD(6); SBAR(); GAPA(C1=__builtin_amdgcn_mfma_f32_32x32x16_bf16(kf[5],qr[2],C1,0,0,0),   P1[6],P1[7],P1[8],P1[9],     pw2[2]=PKW(P1,4), pw2[3]=PKW(P1,6), pw2); \
    VRD(3); SBAR(); GAPA(C0=__builtin_amdgcn_mfma_f32_32x32x16_bf16(kf[6],qr[3],C0,0,0,0),   P1[10],P1[11],P1[12],P1[13], pw3[0]=PKW(P1,8), pw3[1]=PKW(P1,10), pw3); \
    VRD(7); SBAR(); GAPA(C1=__builtin_amdgcn_mfma_f32_32x32x16_bf16(kf[7],qr[3],C1,0,0,0),   P1[14],P1[15],0.f,0.f,       pw3[2]=PKW(P1,12),pw3[3]=PKW(P1,14), pw3); \
    l_reg+=sacc; \
    if(GK){DMA_K((t)+3,sl_cur);} if(GV){DMA_V((t)+1,sl_next);} \
    BIAS(C0,C1,t); CMASK(C0,C1,t); \
    { float a=MX3(C0[0],C0[1],C1[0]),b=MX3(C0[2],C0[3],C1[1]); a=MX3(a,C1[2],C1[3]); \
      _Pragma("unroll") for(int r=4;r<16;r+=4){a=MX3(a,C0[r],C0[r+1]);b=MX3(b,C0[r+2],C0[r+3]);a=MX3(a,C1[r],C1[r+1]);b=MX3(b,C1[r+2],C1[r+3]);} \
      float rm=__builtin_fmaxf(a,b); { auto rr=__builtin_amdgcn_permlane32_swap(__float_as_uint(rm),__float_as_uint(rm),false,false); rm=__builtin_fmaxf(__uint_as_float(rr[0]),__uint_as_float(rr[1])); } \
      resc=false; \
      if(__builtin_expect(__any(rm>(float)THRL),0)){ const float dl=__builtin_fmaxf(rm,0.f); mhat+=dl; \
        _Pragma("unroll") for(int r=0;r<16;++r){C0[r]-=dl;C1[r]-=dl;} \
        nm=-mhat; \
        const float f=__builtin_amdgcn_exp2f(-dl); l_reg*=f; if(hi==0)wsf[r32]=f; resc=true; } } \
    SBAR(); \
    GAPB(o[0]=__builtin_amdgcn_mfma_f32_32x32x16_bf16(PAF(0),VFR(0),o[0],0,0,0), C0,0); \
    GAPB(o[1]=__builtin_amdgcn_mfma_f32_32x32x16_bf16(PAF(0),VFR(4),o[1],0,0,0), C0,4); \
    KRD(GL,0); GAPB(o[0]=__builtin_amdgcn_mfma_f32_32x32x16_bf16(PAF(1),VFR(1),o[0],0,0,0), C0,8); \
    KRD(GL,1); GAPB(o[1]=__builtin_amdgcn_mfma_f32_32x32x16_bf16(PAF(1),VFR(5),o[1],0,0,0), C0,12); \
    KRD(GL,2); GAPB(o[0]=__builtin_amdgcn_mfma_f32_32x32x16_bf16(PAF(2),VFR(2),o[0],0,0,0), C1,0); \
    KRD(GL,3); GAPB(o[1]=__builtin_amdgcn_mfma_f32_32x32x16_bf16(PAF(2),VFR(6),o[1],0,0,0), C1,4); \
    GAPB(o[0]=__builtin_amdgcn_mfma_f32_32x32x16_bf16(PAF(3),VFR(3),o[0],0,0,0), C1,8); \
    GAPB(o[1]=__builtin_amdgcn_mfma_f32_32x32x16_bf16(PAF(3),VFR(7),o[1],0,0,0), C1,12); \
    }while(0)
  int t=1;
  #undef CMASK
  #define CMASK(P0,P1,t) do{}while(0)
  for(;t+5<NT;t+=2){
    STEP(pB0,pB1,pA0,pA1,t,true,true,true);     WAIT_BAR(2); RESC(); ROT();
    STEP(pA0,pA1,pB0,pB1,t+1,true,true,true);   WAIT_BAR(2); RESC(); ROT();
  }
  #undef CMASK
  #define CMASK(P0,P1,t) do{int jb_=(t)-(NT-4); if(jb_>=0)cmask(P0,P1,jb_,qrel,hi);}while(0)
  #define ENDW(tt) do{ if((tt)+3<NT){WAIT_BAR(2);} else if((tt)+2<NT){WAIT_BAR(1);} else {WAIT_BAR(0);} }while(0)
  for(;t+1<NT;t+=2){
    STEP(pB0,pB1,pA0,pA1,t,(t+3<NT),(t+1<NT),(t+1<NT));       ENDW(t);   RESC(); ROT();
    STEP(pA0,pA1,pB0,pB1,t+1,(t+4<NT),(t+2<NT),(t+2<NT));     ENDW(t+1); RESC(); ROT();
  }
  STEP(pB0,pB1,pA0,pA1,NT-1,false,false,false); RESC();
  { float sacc=pB0[0]+pB0[1]; _Pragma("unroll") for(int r=2;r<16;++r)sacc+=pB0[r]; _Pragma("unroll") for(int r=0;r<16;++r)sacc+=pB1[r]; l_reg+=sacc;
    pw0=(u32x4){PKW(pB0,0),PKW(pB0,2),PKW(pB0,4),PKW(pB0,6)};pw1=(u32x4){PKW(pB0,8),PKW(pB0,10),PKW(pB0,12),PKW(pB0,14)};pw2=(u32x4){PKW(pB1,0),PKW(pB1,2),PKW(pB1,4),PKW(pB1,6)};pw3=(u32x4){PKW(pB1,8),PKW(pB1,10),PKW(pB1,12),PKW(pB1,14)};
    SBAR(); pv(o,vb0+sl_cur,PAF(0),PAF(1),PAF(2),PAF(3)); }
  #undef PKW
  #undef PAF
  #undef VFR
  #undef PIN
  #undef MX3
  #undef GAPA
  #undef GAPB
  #undef EX
  #undef VRD
  #undef KRD
  #undef STEP
  #undef ENDW
  {auto rr=__builtin_amdgcn_permlane32_swap(__float_as_uint(l_reg),__float_as_uint(l_reg),false,false);l_reg=__uint_as_float(rr[0])+__uint_as_float(rr[1]);}
  if(hi==0)wsf[32+r32]=l_reg;asm volatile("s_waitcnt lgkmcnt(0)":::"memory");
  float rli[16];
  #pragma unroll
  for(int r=0;r<16;++r)rli[r]=__builtin_amdgcn_rcpf(wsf[32+crow(r,hi)]);
  bf16*Ow=O+(rowbase+q0+wid*QBLK)*DM+h*D;
  { bf16*stg=(bf16*)(shm+LDS_OST)+wid*2048;
    #pragma unroll
    for(int r=0;r<16;++r){const int orow=crow(r,hi);
      #pragma unroll
      for(int d0=0;d0<2;++d0)stg[orow*64+d0*32+r32]=__float2bfloat16(o[d0][r]*rli[r]);}
    asm volatile("s_waitcnt lgkmcnt(0)":::"memory");
    #pragma unroll
    for(int i=0;i<4;++i){const int row=i*8+(lane>>3),ch=lane&7; const u32x4 v=*(const u32x4*)(stg+row*64+ch*8); ATTN_STORE16(Ow+(long)row*DM+ch*8,v);} }
  asm volatile("s_waitcnt lgkmcnt(0)\n\ts_barrier":::"memory");
  #undef BIAS
  #undef DMA_K
  #undef DMA_V
  #undef CMASK
  #undef START
  #undef RESC
  #undef ROT
}
constexpr int ATTN_LDS_BYTES=86016+32768;
struct AttnTensors { const bf16* Q; const bf16* K; const bf16* V; bf16* O; const float* FB; float skip_thr; int pad; };
struct AttnUnit { int bh; int qb; };
struct StaticOrder {
  int vcu;
  __device__ __forceinline__ explicit StaticOrder(int grid,int block):vcu((block%8)*(grid/8)+block/8){}
  __device__ __forceinline__ bool next(int i,AttnUnit&u)const{ if(i>=4)return false; const int s=vcu&7; u.bh=vcu>>3; u.qb=(i==0)?s:(i==1)?15-s:(i==2)?16+s:31-s; return true; }
  __device__ __forceinline__ void a_ready(const AttnUnit&)const{}
  __device__ __forceinline__ void done(const AttnUnit&)const{}
};
struct QueueOrder {
  unsigned* ctr; int xl; volatile __attribute__((address_space(3))) int* slot;
  __device__ __forceinline__ bool next(int,AttnUnit&u)const{
    if(mk_tid()==0){ int got=-1;
      for(int k=0;k<8&&got<0;++k){ const int q=(xl+k)&7; const int j=(int)__hip_atomic_fetch_add(ctr+q*64,1u,__ATOMIC_RELAXED,__HIP_MEMORY_SCOPE_AGENT); if(j<128)got=q*128+j; }
      *slot=got; }
    __syncthreads(); const int g=*slot; if(g<0)return false; const int q=g>>7,j=g&127; u.bh=q*4+(j&3); u.qb=31-(j>>2); return true; }
  __device__ __forceinline__ void a_ready(const AttnUnit&)const{}
  __device__ __forceinline__ void done(const AttnUnit&)const{}
};
template<class Sched,int THRL=8> __device__ __forceinline__ void attn_phase(char*lds,const AttnTensors&T,const Sched&S){
  AttnUnit u;
  for(int i=0;S.next(i,u);++i){ S.a_ready(u); attn_unit<THRL>(u.bh/NHEAD,u.bh%NHEAD,u.qb,T.Q,T.K,T.V,T.O,T.FB+(size_t)u.bh*SEQ,T.skip_thr,lds); S.done(u); }
}
#undef SBAR
#undef WAIT_BAR
}
namespace cg = cooperative_groups;
#define LAS __attribute__((address_space(3)))
#define LDS_WAIT() asm volatile("s_waitcnt lgkmcnt(0)" ::: "memory")
constexpr int MEGA_THREADS = 512, MEGA_LDS = 147456, NWV = 8;
#define GAS __attribute__((address_space(1)))
#define XB_TMO      128
#define XB_XCNT(j)  (256  + 64 * (j))
#define XB_XSUB(j)  (1280 + 64 * (j))
#define XB_XGEN(j)  (2304 + 64 * (j))
#define XB_TOP      3328
#define XB_TOPGEN   3392
#define XCD_BAR_WORDS 3456
#define XB_SPIN_CAP (1u << 18)

__device__ __forceinline__ unsigned xb_ld(unsigned* p)              { return __hip_atomic_load(p, __ATOMIC_RELAXED, __HIP_MEMORY_SCOPE_AGENT); }
__device__ __forceinline__ unsigned xb_add(unsigned* p, unsigned v) { return __hip_atomic_fetch_add(p, v, __ATOMIC_RELAXED, __HIP_MEMORY_SCOPE_AGENT); }
__device__ __forceinline__ unsigned xb_xcc_id() { return (unsigned)__builtin_amdgcn_s_getreg((3 << 11) | 20) & 0xFu; }
#define XB_SPIN(cond, bar) do { unsigned _sp = 0; while (cond) { __builtin_amdgcn_s_sleep(1); \
    if ((++_sp & 255u) == 0u) { if (xb_ld(&(bar)[XB_TMO])) break; if (_sp > XB_SPIN_CAP) { atomicAdd(&(bar)[XB_TMO], 1u); break; } } } } while (0)

struct XcdBarrier {
    unsigned* bar; unsigned x;
    volatile LAS unsigned* st;
};

__device__ __forceinline__ XcdBarrier xcd_barrier_post(unsigned* bar, volatile LAS unsigned* st) {
    XcdBarrier b; b.bar = bar; b.x = xb_xcc_id(); b.st = st;
    if (threadIdx.x == 0) (void)xb_add(&bar[XB_XCNT(b.x)], 1u);
    return b;
}
__device__ __forceinline__ void xcd_barrier_complete(unsigned* bar, unsigned x, unsigned& nloc, unsigned& nx) {
    const unsigned G = gridDim.x * gridDim.y * gridDim.z;
    unsigned sum, cnt, mine, sp = 0u;
    for (;;) {
        sum = 0u; cnt = 0u; mine = 0u;
#pragma unroll
        for (unsigned j = 0; j < 16; ++j) { const unsigned c = xb_ld(&bar[XB_XCNT(j)]); sum += c; cnt += (c > 0u) ? 1u : 0u; mine = (j == x) ? c : mine; }
        if (sum == G) break;
        __builtin_amdgcn_s_sleep(1);
        if ((++sp & 255u) == 0u) { if (xb_ld(&bar[XB_TMO])) break; if (sp > XB_SPIN_CAP) { atomicAdd(&bar[XB_TMO], 1u); break; } }
    }
    nloc = mine > 0u ? mine : 1u; nx = cnt > 0u ? cnt : 1u;
}

__device__ __forceinline__ void xcd_barrier(const XcdBarrier& b) {
    asm volatile("s_waitcnt vmcnt(0)" ::: "memory");
    __syncthreads();
    if (threadIdx.x == 0) {
        unsigned* bar = b.bar;
        __builtin_amdgcn_s_waitcnt(0);
        unsigned nloc = b.st[0], nx = b.st[1];
        if (nloc == 0u) { xcd_barrier_complete(bar, b.x, nloc, nx); b.st[0] = nloc; b.st[1] = nx; }
        const unsigned old = xb_add(&bar[XB_XSUB(b.x)], 1u);
        const unsigned gen = old / nloc;
        if (old + 1u == (gen + 1u) * nloc) {
            __builtin_amdgcn_fence(__ATOMIC_RELEASE, "agent");
            asm volatile("s_waitcnt vmcnt(0)" ::: "memory");
            const unsigned og = xb_add(&bar[XB_TOP], 1u);
            const unsigned tg = og / nx;
            if (og + 1u == (tg + 1u) * nx) xb_add(&bar[XB_TOPGEN], 1u);
            else XB_SPIN(xb_ld(&bar[XB_TOPGEN]) == tg, bar);
            __builtin_amdgcn_fence(__ATOMIC_ACQUIRE, "agent");
            xb_add(&bar[XB_XGEN(b.x)], 1u);
            asm volatile("s_waitcnt vmcnt(0)" ::: "memory");
        } else {
            XB_SPIN(xb_ld(&bar[XB_XGEN(b.x)]) == gen, bar);
            __builtin_amdgcn_fence(__ATOMIC_ACQUIRE, "agent");
            asm volatile("s_waitcnt vmcnt(0)" ::: "memory");
        }
    }
    __syncthreads();
}
constexpr size_t WS_BAR = WS_CTL + 16384;
constexpr size_t WS_QCTR = WS_CTL + 32768;
constexpr size_t CTL_ZERO_BYTES = 65536 - 16384;
constexpr int XB_LDS_OFF = MEGA_LDS - 64;
constexpr size_t WT_IN = 0;
constexpr size_t WT_BR = WT_IN + (size_t)13312 * 1024 * 2;
constexpr size_t WT_OUT = WT_BR + (size_t)4096 * 1024 * 2;
constexpr size_t WT_UP = WT_OUT + (size_t)1024 * 1024 * 2;
constexpr size_t WT_DN = WT_UP + (size_t)5632 * 1024 * 2;
static_assert(WT_DN + (size_t)1024 * 2816 * 2 <= 72 * MiB, "weight copies");
constexpr size_t WS_WKVT = WS_GATES;
constexpr size_t WS_CB = WS_CTL + 4096;

typedef float f32x4 __attribute__((ext_vector_type(4)));
typedef unsigned u32x4 __attribute__((ext_vector_type(4)));
typedef short bf16x8_t __attribute__((ext_vector_type(8)));
typedef float f32x16_t __attribute__((ext_vector_type(16)));
__device__ __forceinline__ unsigned pk2(float lo, float hi) { return (unsigned)f2bf(lo) | ((unsigned)f2bf(hi) << 16); }
__device__ __forceinline__ float blo(unsigned u) { return __uint_as_float(u << 16); }
__device__ __forceinline__ float bhi(unsigned u) { return __uint_as_float(u & 0xffff0000u); }
__device__ __forceinline__ float fast_softplus(float x) { return fmaxf(x, 0.f) + __logf(1.f + __expf(-fabsf(x))); }
__device__ __forceinline__ float fast_sigmoid(float x) { return __builtin_amdgcn_rcpf(1.f + __expf(-x)); }
__device__ __forceinline__ float fast_tanh(float x) { const float e = __expf(-2.f * fabsf(x)); const float t = (1.f - e) * __builtin_amdgcn_rcpf(1.f + e); return x < 0.f ? -t : t; }
__device__ __forceinline__ float fast_gelu(float x) { const float u = 0.7978845608028654f * (x + 0.044715f * x * x * x); return 0.5f * x * (1.f + fast_tanh(u)); }

template <class Loc> struct LocOrder {
    pg8::StaticOrder so; Loc loc;
    __device__ __forceinline__ bool next(int i, pg8::Unit& u) const { return so.next(i, u); }
    __device__ __forceinline__ const char* aptr(const pg8::Unit& u) const { return loc.a(u); }
    __device__ __forceinline__ const char* bptr(const pg8::Unit& u) const { return loc.b(u); }
    __device__ __forceinline__ void a_ready(const pg8::Unit&) const {}
    __device__ __forceinline__ void done(const pg8::Unit&) const {}
};
struct LocStd { const char* A; const char* Bt; size_t astep, bstep;
    __device__ __forceinline__ const char* a(const pg8::Unit& u) const { return A + (size_t)u.pm * astep; }
    __device__ __forceinline__ const char* b(const pg8::Unit& u) const { return Bt + (size_t)u.pn * bstep; } };
struct LocBranch { const char* Y0; const char* Y1; const char* Y2; const char* Y3; const char* Bt;
    __device__ __forceinline__ const char* a(const pg8::Unit& u) const { const int i = u.pn >> 2; const char* y = i == 0 ? Y0 : i == 1 ? Y1 : i == 2 ? Y2 : Y3; return y + (size_t)u.pm * (256 * 1024 * 2); }
    __device__ __forceinline__ const char* b(const pg8::Unit& u) const { return Bt + (size_t)u.pn * (256 * 1024 * 2); } };
struct LocMemKV { const char* A; const char* Bt;
    __device__ __forceinline__ const char* a(const pg8::Unit& u) const { return A + (size_t)u.pm * (256 * 1024 * 2); }
    __device__ __forceinline__ const char* b(const pg8::Unit& u) const { return Bt + ((size_t)(u.pm >> 1) * 2048 + (size_t)u.pn * 256) * 2048; } };
struct LocMemS { const char* MQ; const char* MK;
    __device__ __forceinline__ const char* a(const pg8::Unit& u) const { return MQ + (size_t)u.pm * (256 * 2048) + u.pn * 512; }
    __device__ __forceinline__ const char* b(const pg8::Unit& u) const { return MK + (size_t)(u.pm >> 5) * (256 * 2048) + u.pn * 512; } };
struct LocMemPV { const char* E; const char* MVT;
    __device__ __forceinline__ const char* a(const pg8::Unit& u) const { return E + (size_t)u.pm * (256 * 2048) + u.pn * 512; }
    __device__ __forceinline__ const char* b(const pg8::Unit& u) const { return MVT + ((size_t)(u.pm >> 5) * 4 + u.pn) * (256 * 256 * 2); } };

struct BranchSched { int vcu; LocBranch loc;
    __device__ __forceinline__ bool next(int i, pg8::Unit& u) const { if (i >= 4) return false; u.pm = vcu >> 2; u.pn = i * 4 + (vcu & 3); return true; }
    __device__ __forceinline__ const char* aptr(const pg8::Unit& u) const { return loc.a(u); }
    __device__ __forceinline__ const char* bptr(const pg8::Unit& u) const { return loc.b(u); }
    __device__ __forceinline__ void a_ready(const pg8::Unit&) const {}
    __device__ __forceinline__ void done(const pg8::Unit&) const {}
};
typedef f32x4 AccT[2][2][4][2];
struct EpiProj { static constexpr bool PERM = true, AFTER_DRAIN = false; bf16_t* proj; bf16_t* gates; float* mqss;
    __device__ __forceinline__ void operator()(const AccT& acc, const pg8::Unit& u, int wr, int wc, int fr, int fq) const {
        int colt = u.pn * 256; const int grp = colt >> 10; bf16_t* base; int ldc;
        if (grp < 9) { base = proj + (size_t)grp * T * DM; ldc = DM; colt &= 1023; } else { base = gates; ldc = 4096; colt -= 9216; }
        const int row0 = u.pm * 256 + wr * 64 + fr, col0 = colt + wc * 32 + 8 * fq;
#pragma unroll
        for (int ai = 0; ai < 2; ++ai)
#pragma unroll
            for (int m = 0; m < 4; ++m) { const int row = row0 + ai * 128 + m * 16; bf16_t* rowp = base + (size_t)row * ldc + col0; float ss = 0.f;
#pragma unroll
                for (int bj = 0; bj < 2; ++bj) { const f32x4 v0 = acc[ai][bj][m][0], v1 = acc[ai][bj][m][1]; u32x4 w; w.x = pk2(v0[0], v0[1]); w.y = pk2(v0[2], v0[3]); w.z = pk2(v1[0], v1[1]); w.w = pk2(v1[2], v1[3]);
                    *(u32x4*)(rowp + bj * 128) = w;
                    if (grp == 8) { ss += blo(w.x) * blo(w.x) + bhi(w.x) * bhi(w.x) + blo(w.y) * blo(w.y) + bhi(w.y) * bhi(w.y) + blo(w.z) * blo(w.z) + bhi(w.z) * bhi(w.z) + blo(w.w) * blo(w.w) + bhi(w.w) * bhi(w.w); } }
                if (grp == 8) { ss += __shfl_xor(ss, 16); ss += __shfl_xor(ss, 32); if (fq == 0) mqss[(size_t)row * 16 + (colt >> 8) * 4 + wc] = ss; } }
    } };
struct EpiBf16P { static constexpr bool PERM = true, AFTER_DRAIN = false; bf16_t* O; int ldc; int pad;
    __device__ __forceinline__ void operator()(const AccT& acc, const pg8::Unit& u, int wr, int wc, int fr, int fq) const {
        const int row0 = u.pm * 256 + wr * 64 + fr, col0 = u.pn * 256 + wc * 32 + 8 * fq;
#pragma unroll
        for (int ai = 0; ai < 2; ++ai)
#pragma unroll
            for (int m = 0; m < 4; ++m) { bf16_t* rowp = O + (size_t)(row0 + ai * 128 + m * 16) * ldc + col0;
#pragma unroll
                for (int bj = 0; bj < 2; ++bj) { const f32x4 v0 = acc[ai][bj][m][0], v1 = acc[ai][bj][m][1]; u32x4 w; w.x = pk2(v0[0], v0[1]); w.y = pk2(v0[2], v0[3]); w.z = pk2(v1[0], v1[1]); w.w = pk2(v1[2], v1[3]);
                    *(u32x4*)(rowp + bj * 128) = w; } }
    } };
struct EpiF32 { static constexpr bool PERM = false, AFTER_DRAIN = false; float* O; int ldc; int pad;
    __device__ __forceinline__ void operator()(const AccT& acc, const pg8::Unit& u, int wr, int wc, int fr, int fq) const {
        const int row0 = u.pm * 256 + wr * 64 + fr, col0 = u.pn * 256 + wc * 32 + 4 * fq;
#pragma unroll
        for (int ai = 0; ai < 2; ++ai)
#pragma unroll
            for (int m = 0; m < 4; ++m) { float* rowp = O + (size_t)(row0 + ai * 128 + m * 16) * ldc + col0;
#pragma unroll
                for (int bj = 0; bj < 2; ++bj)
#pragma unroll
                    for (int n = 0; n < 2; ++n) *(f32x4*)(rowp + bj * 128 + n * 16) = acc[ai][bj][m][n]; }
    } };
struct EpiResid { static constexpr bool PERM = false, AFTER_DRAIN = false; const float* base; float* out;
    __device__ __forceinline__ void operator()(const AccT& acc, const pg8::Unit& u, int wr, int wc, int fr, int fq) const {
        const int row0 = u.pm * 256 + wr * 64 + fr, col0 = u.pn * 256 + wc * 32 + 4 * fq;
#pragma unroll
        for (int ai = 0; ai < 2; ++ai)
#pragma unroll
            for (int m = 0; m < 4; ++m) { const size_t off = (size_t)(row0 + ai * 128 + m * 16) * DM + col0;
#pragma unroll
                for (int bj = 0; bj < 2; ++bj)
#pragma unroll
                    for (int n = 0; n < 2; ++n) { const f32x4 b = *(const f32x4*)(base + off + bj * 128 + n * 16); *(f32x4*)(out + off + bj * 128 + n * 16) = b + acc[ai][bj][m][n]; } }
    } };
struct EpiBranch { static constexpr bool PERM = true, AFTER_DRAIN = false; const bf16_t* G; const float* bg; float* MIXF; bf16_t* MIXED;
    __device__ __forceinline__ void operator()(const AccT& acc, const pg8::Unit& u, int wr, int wc, int fr, int fq) const {
        const int i = u.pn >> 2, row0 = u.pm * 256 + wr * 64 + fr, gcol0 = u.pn * 256 + wc * 32 + 8 * fq, mcol0 = (u.pn & 3) * 256 + wc * 32 + 8 * fq;
#pragma unroll
        for (int ai = 0; ai < 2; ++ai)
#pragma unroll
            for (int m = 0; m < 4; ++m) { const int row = row0 + ai * 128 + m * 16; const bf16_t* gp = G + (size_t)row * 4096 + gcol0; const size_t mo = (size_t)row * DM + mcol0;
#pragma unroll
                for (int bj = 0; bj < 2; ++bj) { const u32x4 gw = *(const u32x4*)(gp + bj * 128); const f32x4 b0 = *(const f32x4*)(bg + gcol0 + bj * 128), b1 = *(const f32x4*)(bg + gcol0 + bj * 128 + 4);
                    f32x4 v0 = acc[ai][bj][m][0], v1 = acc[ai][bj][m][1];
                    v0[0] *= fast_sigmoid(blo(gw.x) + b0[0]); v0[1] *= fast_sigmoid(bhi(gw.x) + b0[1]); v0[2] *= fast_sigmoid(blo(gw.y) + b0[2]); v0[3] *= fast_sigmoid(bhi(gw.y) + b0[3]);
                    v1[0] *= fast_sigmoid(blo(gw.z) + b1[0]); v1[1] *= fast_sigmoid(bhi(gw.z) + b1[1]); v1[2] *= fast_sigmoid(blo(gw.w) + b1[2]); v1[3] *= fast_sigmoid(bhi(gw.w) + b1[3]);
                    if (i > 0) { v0 += *(const f32x4*)(MIXF + mo + bj * 128); v1 += *(const f32x4*)(MIXF + mo + bj * 128 + 4); }
                    if (i < 3) { *(f32x4*)(MIXF + mo + bj * 128) = v0; *(f32x4*)(MIXF + mo + bj * 128 + 4) = v1; }
                    else { u32x4 w; w.x = pk2(v0[0], v0[1]); w.y = pk2(v0[2], v0[3]); w.z = pk2(v1[0], v1[1]); w.w = pk2(v1[2], v1[3]); *(u32x4*)(MIXED + mo + bj * 128) = w; } }
                asm volatile("" ::: "memory"); }
    } };
struct EpiSexp { static constexpr bool PERM = true, AFTER_DRAIN = false; bf16_t* E; const float* mqss; float* esum; const float* cb;
    __device__ __forceinline__ void operator()(const AccT& acc, const pg8::Unit& u, int wr, int wc, int fr, int fq) const {
        const int row0 = u.pm * 256 + wr * 64 + fr, col0 = u.pn * 256 + wc * 32 + 8 * fq; const float shift = cb[0];
#pragma unroll
        for (int ai = 0; ai < 2; ++ai)
#pragma unroll
            for (int m = 0; m < 4; ++m) { const int row = row0 + ai * 128 + m * 16; const f32x4 p = *(const f32x4*)(mqss + (size_t)row * 16 + u.pn * 4);
                const float sc = rsqrtf(((p[0] + p[1]) + (p[2] + p[3])) * (1.f / 256.f) + EPS) * (1.f / 16.f); bf16_t* rowp = E + (size_t)row * DM + col0; float sum = 0.f;
#pragma unroll
                for (int bj = 0; bj < 2; ++bj) { const f32x4 v0 = acc[ai][bj][m][0], v1 = acc[ai][bj][m][1]; u32x4 w;
                    w.x = pk2(__expf(v0[0] * sc - shift), __expf(v0[1] * sc - shift)); w.y = pk2(__expf(v0[2] * sc - shift), __expf(v0[3] * sc - shift));
                    w.z = pk2(__expf(v1[0] * sc - shift), __expf(v1[1] * sc - shift)); w.w = pk2(__expf(v1[2] * sc - shift), __expf(v1[3] * sc - shift));
                    *(u32x4*)(rowp + bj * 128) = w;
                    sum += (blo(w.x) + bhi(w.x)) + (blo(w.y) + bhi(w.y)) + (blo(w.z) + bhi(w.z)) + (blo(w.w) + bhi(w.w)); }
                sum += __shfl_xor(sum, 16); sum += __shfl_xor(sum, 32); if (fq == 0) esum[(size_t)row * 16 + u.pn * 4 + wc] = sum;
                asm volatile("" ::: "memory"); }
    } };
struct EpiMemPV { static constexpr bool PERM = true, AFTER_DRAIN = false; bf16_t* Y; const float* esum;
    __device__ __forceinline__ void operator()(const AccT& acc, const pg8::Unit& u, int wr, int wc, int fr, int fq) const {
        const int row0 = u.pm * 256 + wr * 64 + fr, col0 = u.pn * 256 + wc * 32 + 8 * fq;
#pragma unroll
        for (int ai = 0; ai < 2; ++ai)
#pragma unroll
            for (int m = 0; m < 4; ++m) { const int row = row0 + ai * 128 + m * 16; const f32x4 p = *(const f32x4*)(esum + (size_t)row * 16 + u.pn * 4);
                const float il = 1.f / ((p[0] + p[1]) + (p[2] + p[3])); bf16_t* rowp = Y + (size_t)row * DM + col0;
#pragma unroll
                for (int bj = 0; bj < 2; ++bj) { const f32x4 v0 = acc[ai][bj][m][0] * il, v1 = acc[ai][bj][m][1] * il; u32x4 w; w.x = pk2(v0[0], v0[1]); w.y = pk2(v0[2], v0[3]); w.z = pk2(v1[0], v1[1]); w.w = pk2(v1[2], v1[3]);
                    *(u32x4*)(rowp + bj * 128) = w; }
                asm volatile("" ::: "memory"); }
    } };

__device__ __forceinline__ void tr_item(const float* __restrict__ W, int ldw, bf16_t* __restrict__ WT, int ldk, int nblk, LAS float* scr, int item, int lane, int ncopies, int cstride) {
    const int kb = item / nblk, nb = item % nblk, k0 = 64 * kb, n0 = 32 * nb;
#pragma unroll
    for (int i = 0; i < 32; ++i) { const int kk = 2 * i + (lane >> 5); scr[kk * 33 + (lane & 31)] = W[(size_t)(k0 + kk) * ldw + n0 + (lane & 31)]; }
    LDS_WAIT(); asm volatile("" ::: "memory");
    const int c = lane & 7;
#pragma unroll
    for (int j = 0; j < 4; ++j) { const int n = (lane >> 3) + 8 * j; const LAS float* s = scr + (8 * c) * 33 + n;
        u32x4 o; o.x = pk2(s[0 * 33], s[1 * 33]); o.y = pk2(s[2 * 33], s[3 * 33]); o.z = pk2(s[4 * 33], s[5 * 33]); o.w = pk2(s[6 * 33], s[7 * 33]);
        for (int cp = 0; cp < ncopies; ++cp) *(u32x4*)(WT + (size_t)(n0 + n) * ldk + k0 + 8 * c + cp * cstride) = o; }
    LDS_WAIT(); asm volatile("" ::: "memory");
}
__device__ __forceinline__ void norm_row(f32x4 (&v)[4], const float* __restrict__ g, bf16_t* __restrict__ hrow, const LAS float* WfT, bool do_logf, const float* __restrict__ bfg, float* __restrict__ LOGF, int row, int lane) {
    const f32x4* gr = (const f32x4*)g; float ss = 0.f;
#pragma unroll
    for (int j = 0; j < 4; ++j) ss += (v[j][0] * v[j][0] + v[j][1] * v[j][1]) + (v[j][2] * v[j][2] + v[j][3] * v[j][3]);
    ss = wave_sum(ss);
    const float rstd = rsqrtf(ss * (1.f / DM) + EPS);
#pragma unroll
    for (int j = 0; j < 4; ++j) { v[j] = v[j] * rstd * gr[lane + 64 * j];
        uint2 o; o.x = pk2(v[j][0], v[j][1]); o.y = pk2(v[j][2], v[j][3]); ((uint2*)hrow)[lane + 64 * j] = o; }
    if (do_logf) {
        float p[16];
#pragma unroll
        for (int h = 0; h < 16; ++h) { float a = 0.f;
#pragma unroll
            for (int j = 0; j < 4; ++j) { const f32x4 w = *(const LAS f32x4*)(WfT + h * 1024 + (lane + 64 * j) * 4); a += (v[j][0] * w[0] + v[j][1] * w[1]) + (v[j][2] * w[2] + v[j][3] * w[3]); }
            p[h] = a; if ((h & 3) == 3) __builtin_amdgcn_sched_barrier(0); }
        const bool b5 = lane & 32, b4 = lane & 16, b3 = lane & 8, b2 = lane & 4;
        float q8[8], q4[4], q2[2];
#pragma unroll
        for (int i = 0; i < 8; ++i) { const float send = b5 ? p[i] : p[i + 8], keep = b5 ? p[i + 8] : p[i]; q8[i] = keep + __shfl_xor(send, 32); }
#pragma unroll
        for (int i = 0; i < 4; ++i) { const float send = b4 ? q8[i] : q8[i + 4], keep = b4 ? q8[i + 4] : q8[i]; q4[i] = keep + __shfl_xor(send, 16); }
#pragma unroll
        for (int i = 0; i < 2; ++i) { const float send = b3 ? q4[i] : q4[i + 2], keep = b3 ? q4[i + 2] : q4[i]; q2[i] = keep + __shfl_xor(send, 8); }
        float q1 = (b2 ? q2[1] : q2[0]) + __shfl_xor(b2 ? q2[0] : q2[1], 4);
        q1 += __shfl_xor(q1, 2); q1 += __shfl_xor(q1, 1);
        const int h = (b5 ? 8 : 0) + (b4 ? 4 : 0) + (b3 ? 2 : 0) + (b2 ? 1 : 0);
        if ((lane & 3) == 0) { const int b = row / SEQ, t = row % SEQ; LOGF[((size_t)b * 16 + h) * SEQ + t] = logsigmoidf(q1 + bfg[h]); }
    }
}
__device__ __forceinline__ void norm_rows(const float* __restrict__ x, int nrows, int gw, int NGW, const float* __restrict__ g, bf16_t* __restrict__ H, const LAS float* WfT, bool do_logf, const float* __restrict__ bfg, float* __restrict__ LOGF, int lane) {
    f32x4 nx[4];
    if (gw < nrows) {
#pragma unroll
        for (int j = 0; j < 4; ++j) nx[j] = ((const f32x4*)(x + (size_t)gw * DM))[lane + 64 * j]; }
    for (int m = gw; m < nrows; m += NGW) {
        f32x4 v[4];
#pragma unroll
        for (int j = 0; j < 4; ++j) v[j] = nx[j];
        if (m + NGW < nrows) {
#pragma unroll
            for (int j = 0; j < 4; ++j) nx[j] = ((const f32x4*)(x + (size_t)(m + NGW) * DM))[lane + 64 * j]; }
        norm_row(v, g, H + (size_t)m * DM, WfT, do_logf, bfg, LOGF, m, lane);
    }
}
__device__ __forceinline__ void headnorm64_row(bf16_t* row, const float* __restrict__ g, float scale, int lane) {
    u32x4* p = (u32x4*)row + lane * 2; u32x4 a = p[0], b = p[1];
    float v[16] = {blo(a.x), bhi(a.x), blo(a.y), bhi(a.y), blo(a.z), bhi(a.z), blo(a.w), bhi(a.w), blo(b.x), bhi(b.x), blo(b.y), bhi(b.y), blo(b.z), bhi(b.z), blo(b.w), bhi(b.w)};
    float ss = 0.f;
#pragma unroll
    for (int i = 0; i < 16; ++i) ss += v[i] * v[i];
    ss += __shfl_xor(ss, 1); ss += __shfl_xor(ss, 2);
    const float rstd = rsqrtf(ss * (1.f / 64.f) + EPS) * scale; const f32x4* gp = (const f32x4*)(g + (lane & 3) * 16);
#pragma unroll
    for (int i = 0; i < 4; ++i) { const f32x4 gg = gp[i]; v[4 * i] *= rstd * gg[0]; v[4 * i + 1] *= rstd * gg[1]; v[4 * i + 2] *= rstd * gg[2]; v[4 * i + 3] *= rstd * gg[3]; }
    a.x = pk2(v[0], v[1]); a.y = pk2(v[2], v[3]); a.z = pk2(v[4], v[5]); a.w = pk2(v[6], v[7]); b.x = pk2(v[8], v[9]); b.y = pk2(v[10], v[11]); b.z = pk2(v[12], v[13]); b.w = pk2(v[14], v[15]);
    p[0] = a; p[1] = b;
}
__device__ __forceinline__ void cumsum_block(const float* __restrict__ src, float* __restrict__ dst, LAS float* part, int tid) {
    const int lane = tid & 63, wave = tid >> 6; const f32x4* s4 = (const f32x4*)(src + tid * 16); float v[16]; float s = 0.f;
#pragma unroll
    for (int i = 0; i < 4; ++i) { const f32x4 x = s4[i]; s += x[0]; v[4 * i] = s; s += x[1]; v[4 * i + 1] = s; s += x[2]; v[4 * i + 2] = s; s += x[3]; v[4 * i + 3] = s; }
    float incl = s;
#pragma unroll
    for (int o = 1; o < 64; o <<= 1) { const float t_ = __shfl_up(incl, o); if (lane >= o) incl += t_; }
    __syncthreads();
    if (lane == 63) part[wave] = incl;
    __syncthreads();
    float off = incl - s;
    for (int w = 0; w < wave; ++w) off += part[w];
    f32x4* d4 = (f32x4*)(dst + tid * 16);
#pragma unroll
    for (int i = 0; i < 4; ++i) d4[i] = (f32x4){off + v[4 * i], off + v[4 * i + 1], off + v[4 * i + 2], off + v[4 * i + 3]};
}

__device__ __forceinline__ float neg_expm1_small(float x) {
    const float p = -x * (1.f + x * (0.5f + x * (0.16666667f + x * (0.041666668f + x * (0.0083333338f + x * 0.0013888889f)))));
    return x > -0.25f ? p : 1.f - __expf(x);
}
constexpr int LRU_XCB = 0, LRU_WT = 9216, LRU_R = LRU_WT + 18432, LRU_SEG = LRU_R + 33792;
template <bool FINAL> __device__ __forceinline__ void lru_load(int it, int n, const bf16_t* __restrict__ LX, const bf16_t* __restrict__ LG, float (&xw)[11], float (&gl)[8], int tid) {
    const int b = it >> 11, c = (it >> 4) & 127, e = tid & 63, tg = tid >> 6, ch = n * 64 + e, t0 = c * 64 + tg * 8;
#pragma unroll
    for (int j = 0; j < 11; ++j) { const int t = t0 + j - 3; xw[j] = t >= 0 ? bf2f(LX[((size_t)b * SEQ + t) * DM + ch]) : 0.f; }
    if (FINAL) {
#pragma unroll
        for (int j = 0; j < 8; ++j) gl[j] = bf2f(LG[((size_t)b * SEQ + t0 + j) * DM + ch]); }
}
template <bool FINAL> __device__ __forceinline__ void lru_item(int b, int c, int n, const float (&xw)[11], const float (&gl)[8], bf16_t* __restrict__ YL,
        const float w0, const float w1, const float w2, const float w3, const float bc, const float bA, const float bX,
        const float spl, float* APROD, float* HEND, LAS unsigned char* lds, int tid, int par) {
    const int e = tid & 63, tg = tid >> 6, ch = n * 64 + e, lane = e, wv = tg;
    LAS float* R = (LAS float*)(lds + LRU_R);
    LAS float* segP = (LAS float*)(lds + LRU_SEG);
    LAS float* segH = segP + 512, *carP = segH + 512 + par * 1024, *carH = carP + 512;
    const int t0 = c * 64 + tg * 8; const size_t row0 = (size_t)b * SEQ + t0;
    float xc[8];
#pragma unroll
    for (int j = 0; j < 8; ++j) { xc[j] = bc + w3 * xw[j + 3] + w2 * xw[j + 2] + w1 * xw[j + 1] + w0 * xw[j]; *(LAS bf16_t*)(lds + LRU_XCB + (tg * 8 + j) * 144 + e * 2) = f2bf(xc[j]); }
    if (FINAL) {
        float cp = 1.f, chh = 0.f; const int per = (c + 7) >> 3; const int lo = tg * per; int hi = lo + per; if (hi > c) hi = c;
        for (int cc = lo; cc < hi; ++cc) { const size_t si = ((size_t)b * 128 + cc) * DM + ch; const float A = APROD[si], Hc = HEND[si]; chh = A * chh + Hc; cp *= A; }
        carP[tg * 64 + e] = cp; carH[tg * 64 + e] = chh; }
    __syncthreads();
    { const int th = wv & 1, cb = wv >> 1, r32 = lane & 31, hi = lane >> 5; f32x16_t acc = {};
#pragma unroll
        for (int ks = 0; ks < 4; ++ks) { const bf16x8_t af = *(const LAS bf16x8_t*)(lds + LRU_XCB + (32 * th + r32) * 144 + (16 * ks + 8 * hi) * 2), bfr = *(const LAS bf16x8_t*)(lds + LRU_WT + (32 * cb + r32) * 144 + (16 * ks + 8 * hi) * 2);
            acc = __builtin_amdgcn_mfma_f32_32x32x16_bf16(af, bfr, acc, 0, 0, 0); }
#pragma unroll
        for (int r = 0; r < 16; ++r) R[(32 * th + (r & 3) + 8 * (r >> 2) + 4 * hi) * 132 + 32 * cb + r32] = acc[r]; }
    __syncthreads();
    float av[8], uv[8]; float P = 1.f, Hh = 0.f;
#pragma unroll
    for (int j = 0; j < 8; ++j) { const float ra = bA + R[(tg * 8 + j) * 132 + e], ri = bX + R[(tg * 8 + j) * 132 + 64 + e];
        const float rr = fast_sigmoid(ra), ii = fast_sigmoid(ri); const float la = -8.f * rr * spl; av[j] = __expf(la); uv[j] = __builtin_amdgcn_sqrtf(neg_expm1_small(2.f * la)) * (ii * xc[j]);
        Hh = av[j] * Hh + uv[j]; P *= av[j]; }
    segP[tg * 64 + e] = P; segH[tg * 64 + e] = Hh;
    __syncthreads();
    if (FINAL) {
        float h = 0.f;
#pragma unroll
        for (int s = 0; s < 8; ++s) h = carP[s * 64 + e] * h + carH[s * 64 + e];
        for (int t2 = 0; t2 < tg; ++t2) h = segP[t2 * 64 + e] * h + segH[t2 * 64 + e];
#pragma unroll
        for (int j = 0; j < 8; ++j) { h = av[j] * h + uv[j]; YL[(row0 + j) * DM + ch] = f2bf(h * fast_gelu(gl[j])); }
    } else if (tg == 7) {
        float h = 0.f, p = 1.f;
#pragma unroll
        for (int s = 0; s < 8; ++s) { h = segP[s * 64 + e] * h + segH[s * 64 + e]; p *= segP[s * 64 + e]; }
        const size_t si = ((size_t)b * 128 + c) * DM + ch; APROD[si] = p; HEND[si] = h;
    }
}
template <bool FINAL> __device__ __forceinline__ void lru_pass(int l, int bx, int G, const float* const* in, const bf16_t* LX, const bf16_t* LG, bf16_t* YL, float* APROD, float* HEND, LAS unsigned char* lds, int tid) {
    const int n = bx & 15, e = tid & 63, ch = n * 64 + e;
    { const float* wa = in[10] + (size_t)l * 65536 + (size_t)n * 4096; const float* wx = in[12] + (size_t)l * 65536 + (size_t)n * 4096;
        for (int i = tid; i < 8192; i += MEGA_THREADS) { const int mat = i >> 12, d = (i >> 6) & 63, ee = i & 63; *(LAS bf16_t*)(lds + LRU_WT + (mat * 64 + ee) * 144 + d * 2) = f2bf(mat ? wx[i & 4095] : wa[i & 4095]); } }
    const float* cw = in[8] + (size_t)l * 4 * DM; const float w0 = cw[ch], w1 = cw[DM + ch], w2 = cw[2 * DM + ch], w3 = cw[3 * DM + ch], bc = in[9][l * DM + ch];
    const float bA = in[11][l * DM + ch], bX = in[13][l * DM + ch], spl = softplusf(-in[14][l * DM + ch]);
    float xwn[11], gln[8];
#pragma unroll
    for (int j = 0; j < 8; ++j) gln[j] = 0.f;
    lru_load<FINAL>(bx, n, LX, LG, xwn, gln, tid);
    int par = 0;
    for (int it = bx; it < 4096; it += G) {
        float xw[11], gl[8];
#pragma unroll
        for (int j = 0; j < 11; ++j) xw[j] = xwn[j];
#pragma unroll
        for (int j = 0; j < 8; ++j) gl[j] = gln[j];
        if (it + G < 4096) lru_load<FINAL>(it + G, n, LX, LG, xwn, gln, tid);
        lru_item<FINAL>(it >> 11, (it >> 4) & 127, n, xw, gl, YL, w0, w1, w2, w3, bc, bA, bX, spl, APROD, HEND, lds, tid, par); par ^= 1;
    }
    __syncthreads();
}

__device__ __forceinline__ void sb_wave(int b, int h, int qw0, const bf16_t* Q, const bf16_t* __restrict__ K, const bf16_t* __restrict__ V, bf16_t* O, LAS unsigned char* vl, int lane) {
    const int r32 = lane & 31, hi = lane >> 5; const size_t rowbase = (size_t)b * SEQ;
    const bf16_t* Qw = Q + (rowbase + qw0) * DM + h * 64;
    bf16x8_t qr[4];
#pragma unroll
    for (int d0 = 0; d0 < 4; ++d0) qr[d0] = *(const bf16x8_t*)(Qw + (size_t)r32 * DM + d0 * 16 + hi * 8);
    const bf16_t* Kh = K + rowbase * DM + h * 64; const bf16_t* Vh = V + rowbase * DM + h * 64;
    f32x16_t o0 = {}, o1 = {}; float R = 0.f; const int qabs = qw0 + r32;
    int kt = qw0 >> 5;
    bf16x8_t kf[4]; u32x4 vr[4];
#define SB_LOAD(KF, VR, kt_) do { _Pragma("unroll") for (int d0 = 0; d0 < 4; ++d0) KF[d0] = *(const bf16x8_t*)(Kh + (size_t)((kt_) * 32 + r32) * DM + d0 * 16 + hi * 8); \
        _Pragma("unroll") for (int it = 0; it < 4; ++it) { const int chunk = lane + 64 * it; VR[it] = *(const u32x4*)(Vh + (size_t)((kt_) * 32 + (chunk >> 3)) * DM + (chunk & 7) * 8); } } while (0)
    SB_LOAD(kf, vr, kt);
    const unsigned vbase = (unsigned)(size_t)vl;
    for (;;) {
        bf16x8_t kn[4]; u32x4 vn[4]; const bool more = kt > 0;
        if (more) SB_LOAD(kn, vn, kt - 1); else {
#pragma unroll
            for (int i = 0; i < 4; ++i) { kn[i] = kf[i]; vn[i] = vr[i]; } }
        f32x16_t st = {};
#pragma unroll
        for (int d0 = 0; d0 < 4; ++d0) st = __builtin_amdgcn_mfma_f32_32x32x16_bf16(kf[d0], qr[d0], st, 0, 0, 0);
#pragma unroll
        for (int it = 0; it < 4; ++it) { const int chunk = lane + 64 * it, row = chunk >> 3, c16 = chunk & 7; *(LAS u32x4*)(vl + (c16 >> 2) * 2048 + row * 64 + (c16 & 3) * 16) = vr[it]; }
        float l1[16], lb[16]; bool val[16];
#pragma unroll
        for (int r = 0; r < 16; ++r) { const int kv = kt * 32 + (r & 3) + 8 * (r >> 2) + 4 * hi; val[r] = kv < qabs; const float z = st[r] * 0.125f; const float sp = fast_softplus(z); l1[r] = val[r] ? -sp : 0.f; lb[r] = z - sp; }
        float w[16]; float tail = 0.f;
#pragma unroll
        for (int g = 3; g >= 0; --g) { const float qs = (l1[4 * g] + l1[4 * g + 1]) + (l1[4 * g + 2] + l1[4 * g + 3]); const float pq = __shfl_xor(qs, 32);
            const float after = tail + (hi == 0 ? pq : 0.f) + R; tail += qs + pq;
            const float e2 = l1[4 * g + 3], e1 = e2 + l1[4 * g + 2], e0 = e1 + l1[4 * g + 1];
            w[4 * g + 3] = val[4 * g + 3] ? __expf(lb[4 * g + 3] + after) : 0.f; w[4 * g + 2] = val[4 * g + 2] ? __expf(lb[4 * g + 2] + after + e2) : 0.f;
            w[4 * g + 1] = val[4 * g + 1] ? __expf(lb[4 * g + 1] + after + e1) : 0.f; w[4 * g] = val[4 * g] ? __expf(lb[4 * g] + after + e0) : 0.f; }
        R += tail;
        u32x4 p0, p1; p0.x = attn_body::cvtpk_s(w[0], w[1]); p0.y = attn_body::cvtpk_s(w[2], w[3]); p0.z = attn_body::cvtpk_s(w[4], w[5]); p0.w = attn_body::cvtpk_s(w[6], w[7]);
        p1.x = attn_body::cvtpk_s(w[8], w[9]); p1.y = attn_body::cvtpk_s(w[10], w[11]); p1.z = attn_body::cvtpk_s(w[12], w[13]); p1.w = attn_body::cvtpk_s(w[14], w[15]);
        const bf16x8_t pa0 = __builtin_bit_cast(bf16x8_t, p0), pa1 = __builtin_bit_cast(bf16x8_t, p1);
        const attn_body::lds_cptr vp = (attn_body::lds_cptr)vl + (4 * hi + ((lane & 15) >> 2)) * 64 + ((lane >> 4) & 1) * 32 + (lane & 3) * 8;
#define SB_VF(d0, s) ({ const attn_body::s16x4 lo_ = attn_body::vtr(vp + (d0) * 2048 + (s) * 1024), hi_ = attn_body::vtr(vp + (d0) * 2048 + (s) * 1024 + 512); \
            (bf16x8_t){lo_[0], lo_[1], lo_[2], lo_[3], hi_[0], hi_[1], hi_[2], hi_[3]}; })
        o0 = __builtin_amdgcn_mfma_f32_32x32x16_bf16(pa0, SB_VF(0, 0), o0, 0, 0, 0);
        o1 = __builtin_amdgcn_mfma_f32_32x32x16_bf16(pa0, SB_VF(1, 0), o1, 0, 0, 0);
        o0 = __builtin_amdgcn_mfma_f32_32x32x16_bf16(pa1, SB_VF(0, 1), o0, 0, 0, 0);
        o1 = __builtin_amdgcn_mfma_f32_32x32x16_bf16(pa1, SB_VF(1, 1), o1, 0, 0, 0);
        if (!more) break;
        if (__all(R < SB_THR)) break;
#pragma unroll
        for (int i = 0; i < 4; ++i) { kf[i] = kn[i]; vr[i] = vn[i]; }
        --kt;
    }
#undef SB_LOAD
#undef SB_VF
    (void)vbase;
    bf16_t* Ow = O + (rowbase + qw0) * DM + h * 64;
#pragma unroll
    for (int r = 0; r < 16; ++r) { const int q = (r & 3) + 8 * (r >> 2) + 4 * hi; Ow[(size_t)q * DM + r32] = f2bf(o0[r]); Ow[(size_t)q * DM + 32 + r32] = f2bf(o1[r]); }
}

#ifndef DBG_NOLOGF
#define DBG_NOLOGF 0
#endif
#ifndef EN_FOX
#define EN_FOX 1
#endif
#ifndef EN_SB
#define EN_SB 1
#endif
#ifndef EN_LRU
#define EN_LRU 1
#endif
#ifndef EN_GEMM
#define EN_GEMM 1
#endif
#ifndef EN_THIN
#define EN_THIN 1
#endif
enum { SUB_CONV = 1, SUB_NORM = 2, SUB_HEADNORM = 4, SUB_CUMSUM = 8, SUB_LRU = 16, SUB_SB = 32, SUB_MEM = 64, SUB_FOX = 128, SUB_ALL = 255 };
constexpr int N_PRO = 3, N_PER_LAYER = 10, N_PHASES = N_PRO + DEPTH * N_PER_LAYER;
struct MArgs { Ptrs P; int ph_lo, ph_hi, sub, pad; };

__global__ void __launch_bounds__(MEGA_THREADS, 2) mega(MArgs a) {
    extern __shared__ __attribute__((aligned(16))) unsigned char lds_raw[];
    LAS unsigned char* lds = (LAS unsigned char*)lds_raw;
    cg::grid_group grid = cg::this_grid();
    { volatile LAS unsigned* st0 = (volatile LAS unsigned*)(lds + XB_LDS_OFF); if (threadIdx.x == 0) { st0[0] = 0u; st0[1] = 0u; } __syncthreads();
      if (a.ph_hi - a.ph_lo > 2) (void)xcd_barrier_post((unsigned*)(a.P.ws + WS_BAR), st0); }
    for (int ph = a.ph_lo; ph < a.ph_hi; ++ph) {
    int tid = threadIdx.x; asm volatile("" : "+v"(tid));
    const int lane = tid & 63, wave = __builtin_amdgcn_readfirstlane(tid >> 6);
    int zs = 0; asm volatile("" : "+s"(zs));
    const int G = gridDim.x + zs, bx = blockIdx.x + zs, sub = a.sub + zs, vcu = (G % 8 == 0) ? (bx % 8) * (G / 8) + bx / 8 : bx;
    const int gw = vcu * NWV + wave, NGW = G * NWV;
    unsigned char* ws = a.P.ws + zs; const float* const* in = a.P.in + zs; float* out = a.P.out + zs;
    bf16_t* H = (bf16_t*)(ws + WS_H); bf16_t* PROJ = (bf16_t*)(ws + WS_PROJ); bf16_t* GATES = (bf16_t*)(ws + WS_GATES); bf16_t* Eb = (bf16_t*)(ws + WS_E);
    bf16_t *FQ = PROJ, *FK = PROJ + (size_t)T * DM, *FV = PROJ + 2 * (size_t)T * DM, *LX = PROJ + 3 * (size_t)T * DM, *LG = PROJ + 4 * (size_t)T * DM, *SQ = PROJ + 5 * (size_t)T * DM,
           *SK = PROJ + 6 * (size_t)T * DM, *SV = PROJ + 7 * (size_t)T * DM, *MQ = PROJ + 8 * (size_t)T * DM;
    bf16_t* YL = (bf16_t*)(ws + WS_YL);
    float *LOGF = (float*)(ws + WS_LOGF), *FB = (float*)(ws + WS_FB), *MQSS = (float*)(ws + WS_MQSS), *ESUM = (float*)(ws + WS_ESUM), *CB = (float*)(ws + WS_CB);
    bf16_t* MEMN = (bf16_t*)(ws + WS_MEMN); float* MEMRAW = (float*)(ws + WS_MEMRAW); bf16_t *MK = (bf16_t*)(ws + WS_MK), *MVT = (bf16_t*)(ws + WS_MVT);
    float *APROD = (float*)(ws + WS_LRU), *HEND = APROD + (size_t)BATCH * 128 * DM;
    bf16_t* WKVT = (bf16_t*)(ws + WS_WKVT);
    bf16_t *WIN_T = (bf16_t*)(ws + WS_WT + WT_IN), *WBR_T = (bf16_t*)(ws + WS_WT + WT_BR), *WOUT_T = (bf16_t*)(ws + WS_WT + WT_OUT), *WUP_T = (bf16_t*)(ws + WS_WT + WT_UP), *WDN_T = (bf16_t*)(ws + WS_WT + WT_DN);
    bf16_t *GV = (bf16_t*)(ws + WS_GV), *ACT = (bf16_t*)(ws + WS_ACT);

        if (ph < N_PRO) {
            if (ph == 0) {
                LAS float* scr = (LAS float*)(lds + wave * 8448);
                for (int it = gw; it < 4 * 1024; it += NGW) { const int l = it >> 10; tr_item(in[15] + (size_t)l * DM * 2048, 2048, WKVT + (size_t)l * 2048 * DM, DM, 64, scr, it & 1023, lane, 1, 0); }
                for (int l = 0; l < 4; ++l) norm_rows(in[1], 512, gw, NGW, in[3] + l * DM, MEMN + (size_t)l * 512 * DM, (const LAS float*)lds, false, nullptr, nullptr, lane);
            } else if (ph == 1) {
                LocOrder<LocMemKV> S; S.so.init(4 * 512, 2048, G, bx); S.loc = LocMemKV{(const char*)MEMN, (const char*)WKVT};
                if (EN_GEMM) pg8::gemm_phase<EpiF32, LocOrder<LocMemKV>, true, true>(lds, pg8::Gemm{DM, DM, DM}, S, EpiF32{MEMRAW, 2048, 0});
            } else {
                for (int m = gw; m < 4 * 512; m += NGW) { const int l = m >> 9, r = m & 511, b = r >> 8, mi = r & 255; const float* raw = MEMRAW + (size_t)m * 2048;
                    const f32x4 gk = *(const f32x4*)(in[17] + l * 256 + lane * 4), gq = *(const f32x4*)(in[16] + l * 256 + lane * 4); const f32x4 gg = gk * gq;
#pragma unroll
                    for (int h = 0; h < 4; ++h) { const f32x4 k = *(const f32x4*)(raw + h * 256 + lane * 4); const float ss = wave_sum((k[0] * k[0] + k[1] * k[1]) + (k[2] * k[2] + k[3] * k[3]));
                        const float rstd = rsqrtf(ss * (1.f / 256.f) + EPS); uint2 o; o.x = pk2(k[0] * rstd * gg[0], k[1] * rstd * gg[1]); o.y = pk2(k[2] * rstd * gg[2], k[3] * rstd * gg[3]);
                        *(uint2*)(MK + ((size_t)l * 512 + (size_t)b * 256 + mi) * DM + h * 256 + lane * 4) = o;
                        const f32x4 v = *(const f32x4*)(raw + 1024 + h * 256 + lane * 4); bf16_t* vt = MVT + (size_t)l * 512 * DM + (((size_t)b * 4 + h) * 256 + lane * 4) * 256 + mi;
                        vt[0] = f2bf(v[0]); vt[256] = f2bf(v[1]); vt[512] = f2bf(v[2]); vt[768] = f2bf(v[3]); }
                    if (r == 0) { float mx = fmaxf(fmaxf(fabsf(gg[0]), fabsf(gg[1])), fmaxf(fabsf(gg[2]), fabsf(gg[3])));
#pragma unroll
                        for (int o = 1; o < 64; o <<= 1) mx = fmaxf(mx, __shfl_xor(mx, o));
                        if (lane == 0) CB[l] = 16.f * mx; } }
            }
        } else {
            const int l = (ph - N_PRO) / N_PER_LAYER, sp = (ph - N_PRO) % N_PER_LAYER;
            const float* xcur = l == 0 ? in[0] : out;
            if (sp == 0) {
                if (sub & SUB_NORM) { LAS float* WfT = (LAS float*)lds; const float* wf = in[4] + (size_t)l * DM * NIN + 3072;
                    for (int i = tid; i < 16 * 1024; i += MEGA_THREADS) { const int k = i >> 4, h = i & 15; WfT[h * 1024 + k] = wf[(size_t)k * NIN + h]; } }
                __syncthreads();
                if (sub & SUB_CONV) { LAS float* scr = (LAS float*)(lds + 65536 + wave * 8448);
                    const float* win = in[4] + (size_t)l * DM * NIN;
                    for (int it = gw; it < 13440; it += NGW) { int r = it;
                        if (r < 1536) { tr_item(win, NIN, WIN_T, DM, 96, scr, r, lane, 1, 0); continue; } r -= 1536;
                        if (r < 5120) { tr_item(win + 3088, NIN, WIN_T + (size_t)3072 * DM, DM, 320, scr, r, lane, 1, 0); continue; } r -= 5120;
                        if (r < 2048) { const int i = r >> 9; tr_item(in[19] + ((size_t)l * 4 + i) * DM * DM, DM, WBR_T + (size_t)i * DM * DM, DM, 32, scr, r & 511, lane, 1, 0); continue; } r -= 2048;
                        if (r < 512) { tr_item(in[20] + (size_t)l * DM * DM, DM, WOUT_T, DM, 32, scr, r, lane, 1, 0); continue; } r -= 512;
                        if (r < 2816) { tr_item(in[22] + (size_t)l * DM * 2 * DFF, 2 * DFF, WUP_T, DM, 176, scr, r, lane, 1, 0); continue; } r -= 2816;
                        tr_item(in[25] + (size_t)l * DFF * DM, DM, WDN_T, DFF, 32, scr, r, lane, 1, 0); } }
                if (sub & SUB_NORM) norm_rows(xcur, T, gw, NGW, in[2] + l * DM, H, (const LAS float*)lds, !DBG_NOLOGF, in[5] + l * 16, LOGF, lane);
            } else if (sp == 1) {
                LocOrder<LocStd> S; S.so.init(T, 13312, G, bx); S.loc = LocStd{(const char*)H, (const char*)WIN_T, 256 * 1024 * 2, 256 * 1024 * 2};
                if (EN_GEMM) pg8::gemm_phase<EpiProj, LocOrder<LocStd>, true, true>(lds, pg8::Gemm{DM, DM, DM}, S, EpiProj{PROJ, GATES, MQSS});
            } else if (sp == 2) {
                if (sub & SUB_HEADNORM) { for (int m = gw; m < 2 * T; m += NGW) { if (m < T) headnorm64_row(FQ + (size_t)m * DM, in[6] + l * 64, C2, lane); else headnorm64_row(FK + (size_t)(m - T) * DM, in[7] + l * 64, 1.f, lane); } }
                if ((sub & SUB_CUMSUM) && bx < 32) cumsum_block(LOGF + (size_t)bx * SEQ, FB + (size_t)bx * SEQ, (LAS float*)lds, tid);
                __syncthreads();
                if (EN_LRU && (sub & SUB_LRU)) lru_pass<false>(l, bx, G, in, LX, LG, YL, APROD, HEND, lds, tid);
                if (EN_SB && (sub & SUB_SB)) for (int k = 0; k < 4; ++k) { const int bh = vcu >> 3, qb = (vcu & 7) * 4 + k; sb_wave(bh >> 4, bh & 15, qb * 256 + wave * 32, SQ, SK, SV, H, lds + wave * 4096, lane); }
                __syncthreads();
                if (sub & SUB_MEM) { LocOrder<LocMemS> S; S.so.init(T, 1024, G, bx); S.loc = LocMemS{(const char*)MQ, (const char*)(MK + (size_t)l * 512 * DM)};
                    if (EN_GEMM) pg8::gemm_phase<EpiSexp, LocOrder<LocMemS>, true, true>(lds, pg8::Gemm{DM, DM, 256 + zs}, S, EpiSexp{Eb, MQSS, ESUM, CB + l}); }
            } else if (sp == 3) {
                if (EN_FOX && (sub & SUB_FOX)) {
                    float gqm = fabsf(in[6][l * 64 + lane]), gkm = fabsf(in[7][l * 64 + lane]);
#pragma unroll
                    for (int o = 1; o < 64; o <<= 1) { gqm = fmaxf(gqm, __shfl_xor(gqm, o)); gkm = fmaxf(gkm, __shfl_xor(gkm, o)); }
                    const float thr = -(160.f + 2.f * C2 * 64.f * gqm * gkm);
                    const attn_body::AttnTensors AT{(const attn_body::bf16*)FQ, (const attn_body::bf16*)FK, (const attn_body::bf16*)FV, (attn_body::bf16*)SV, FB, thr, 0};
                    attn_body::QueueOrder S; S.ctr = (unsigned*)(ws + WS_QCTR) + (l * 8) * 64; S.xl = bx & 7; S.slot = (volatile LAS int*)(lds + XB_LDS_OFF + 16);
                    attn_body::attn_phase<attn_body::QueueOrder, 20>((char*)lds_raw, AT, S); }
                __syncthreads();
                if (EN_LRU && (sub & SUB_LRU)) lru_pass<true>(l, bx, G, in, LX, LG, YL, APROD, HEND, lds, tid);
                if (sub & SUB_MEM) { LocOrder<LocMemPV> S; S.so.init(T, 1024, G, bx); S.loc = LocMemPV{(const char*)Eb, (const char*)(MVT + (size_t)l * 512 * DM)};
                    if (EN_GEMM) pg8::gemm_phase<EpiMemPV, LocOrder<LocMemPV>, true, true>(lds, pg8::Gemm{DM, 256, 256 + zs}, S, EpiMemPV{MQ, ESUM}); }
            } else if (sp == 4) {
                BranchSched S; S.vcu = vcu; S.loc = LocBranch{(const char*)SV, (const char*)YL, (const char*)H, (const char*)MQ, (const char*)WBR_T};
                if (EN_GEMM) pg8::gemm_phase<EpiBranch, BranchSched, true, true>(lds, pg8::Gemm{DM, DM, DM}, S, EpiBranch{GATES, in[18] + (size_t)l * 4 * DM, (float*)(ws + WS_MIXF), (bf16_t*)(ws + WS_MIXED)});
            } else if (sp == 5) {
                LocOrder<LocStd> S; S.so.init(T, DM, G, bx); S.loc = LocStd{(const char*)(ws + WS_MIXED), (const char*)WOUT_T, 256 * 1024 * 2, 256 * 1024 * 2};
                if (EN_GEMM) pg8::gemm_phase<EpiResid, LocOrder<LocStd>, true, true>(lds, pg8::Gemm{DM, DM, DM}, S, EpiResid{xcur, out});
            } else if (sp == 6) {
                norm_rows(out, T, gw, NGW, in[21] + l * DM, H, (const LAS float*)lds, false, nullptr, nullptr, lane);
            } else if (sp == 7) {
                LocOrder<LocStd> S; S.so.init(T, 2 * DFF, G, bx); S.loc = LocStd{(const char*)H, (const char*)WUP_T, 256 * 1024 * 2, 256 * 1024 * 2};
                if (EN_GEMM) pg8::gemm_phase<EpiBf16P, LocOrder<LocStd>, true, true>(lds, pg8::Gemm{DM, DM, DM}, S, EpiBf16P{GV, 2 * DFF, 0});
            } else if (sp == 8) {
                const float* cw = in[23] + (size_t)l * 3 * DFF; const float* cbv = in[24] + l * DFF;
                for (int i = bx * MEGA_THREADS + tid; i < (T / 8) * (DFF / 8); i += G * MEGA_THREADS) { const int r0 = (i / (DFF / 8)) * 8, c = (i % (DFF / 8)) * 8, t0 = r0 % SEQ;
                    const bf16_t* gp = GV + (size_t)r0 * 2 * DFF + c; const u32x4 z4 = {0u, 0u, 0u, 0u};
                    const f32x4 wa0 = *(const f32x4*)(cw + c), wa1 = *(const f32x4*)(cw + c + 4), wb0 = *(const f32x4*)(cw + DFF + c), wb1 = *(const f32x4*)(cw + DFF + c + 4), wc0 = *(const f32x4*)(cw + 2 * DFF + c), wc1 = *(const f32x4*)(cw + 2 * DFF + c + 4);
                    const f32x4 bb0 = *(const f32x4*)(cbv + c), bb1 = *(const f32x4*)(cbv + c + 4);
                    u32x4 g2 = t0 >= 2 ? *(const u32x4*)(gp - 4 * DFF) : z4, g1 = t0 >= 1 ? *(const u32x4*)(gp - 2 * DFF) : z4;
                    u32x4 gg[8], vv[8];
#pragma unroll
                    for (int j = 0; j < 8; ++j) { gg[j] = *(const u32x4*)(gp + (size_t)j * 2 * DFF); vv[j] = *(const u32x4*)(gp + (size_t)j * 2 * DFF + DFF); }
#define ACT1(G0, G1, G2, VV, W0, W1, W2, BB) ({ const float pre_ = (BB) + (W2) * (G0) + (W1) * (G1) + (W0) * (G2); pre_ * fast_sigmoid(pre_) * (VV); })
#pragma unroll
                    for (int j = 0; j < 8; ++j) { const u32x4 g0 = gg[j], v_ = vv[j]; u32x4 o;
                        o.x = pk2(ACT1(blo(g0.x), blo(g1.x), blo(g2.x), blo(v_.x), wa0[0], wb0[0], wc0[0], bb0[0]), ACT1(bhi(g0.x), bhi(g1.x), bhi(g2.x), bhi(v_.x), wa0[1], wb0[1], wc0[1], bb0[1]));
                        o.y = pk2(ACT1(blo(g0.y), blo(g1.y), blo(g2.y), blo(v_.y), wa0[2], wb0[2], wc0[2], bb0[2]), ACT1(bhi(g0.y), bhi(g1.y), bhi(g2.y), bhi(v_.y), wa0[3], wb0[3], wc0[3], bb0[3]));
                        o.z = pk2(ACT1(blo(g0.z), blo(g1.z), blo(g2.z), blo(v_.z), wa1[0], wb1[0], wc1[0], bb1[0]), ACT1(bhi(g0.z), bhi(g1.z), bhi(g2.z), bhi(v_.z), wa1[1], wb1[1], wc1[1], bb1[1]));
                        o.w = pk2(ACT1(blo(g0.w), blo(g1.w), blo(g2.w), blo(v_.w), wa1[2], wb1[2], wc1[2], bb1[2]), ACT1(bhi(g0.w), bhi(g1.w), bhi(g2.w), bhi(v_.w), wa1[3], wb1[3], wc1[3], bb1[3]));
                        *(u32x4*)(ACT + (size_t)(r0 + j) * DFF + c) = o; g2 = g1; g1 = g0; }
#undef ACT1
                }
            } else {
                LocOrder<LocStd> S; S.so.init(T, DM, G, bx); S.loc = LocStd{(const char*)ACT, (const char*)WDN_T, 256 * DFF * 2, 256 * DFF * 2};
                if (EN_GEMM) pg8::gemm_phase<EpiResid, LocOrder<LocStd>, true, true>(lds, pg8::Gemm{DFF, DFF, DFF}, S, EpiResid{out, out});
            }
        }
        if (ph + 1 < a.ph_hi) {
            if (ph == a.ph_lo) grid.sync();
            else { XcdBarrier xb; xb.bar = (unsigned*)(ws + WS_BAR); xb.x = xb_xcc_id(); xb.st = (volatile LAS unsigned*)(lds + XB_LDS_OFF); xcd_barrier(xb); }
        }
    }
}
enum { C_PRO = 1, C_NORM = 2, C_WIN = 4, C_HN = 8, C_LRU = 16, C_SB = 32, C_MEM = 64, C_FOX = 128, C_BR = 256, C_WOUT = 512, C_NORM2 = 1024, C_UP = 2048, C_ACT = 4096, C_DOWN = 8192, C_ONE = 16384 };
#ifndef CFG
#define CFG 32767
#endif
#ifndef REPEAT_SP
#define REPEAT_SP (-1)
#define REPEAT_N 0
#define REPEAT_SUB 0
#endif
static int g_grid = 0;
static void launch_mega(const Ptrs& P, int lo, int hi, int sub, hipStream_t st, bool coop) {
    MArgs a{}; a.P = P; a.ph_lo = lo; a.ph_hi = hi; a.sub = sub; a.pad = 0;
    if (coop) { void* args[] = {&a}; const hipError_t e = hipLaunchCooperativeKernel((const void*)mega, dim3(g_grid), dim3(MEGA_THREADS), args, MEGA_LDS, st);
        if (e != hipSuccess) fprintf(stderr, "cooperative launch failed: %s (grid %d)\n", hipGetErrorString(e), g_grid); }
    else { hipLaunchKernelGGL(mega, dim3(g_grid), dim3(MEGA_THREADS), MEGA_LDS, st, a);
        if (REPEAT_N > 0 && hi == lo + 1 && lo >= N_PRO && (lo - N_PRO) % N_PER_LAYER == (REPEAT_SP)) { a.sub = (REPEAT_SUB); for (int r = 0; r < (REPEAT_N); ++r) hipLaunchKernelGGL(mega, dim3(g_grid), dim3(MEGA_THREADS), MEGA_LDS, st, a); } }
}
static void run_hybrid(const Ptrs& P, hipStream_t st) {
    unsigned char* ws = P.ws;
    bf16_t* H = (bf16_t*)(ws + WS_H);
    bf16_t* PR[9]; for (int i = 0; i < 9; ++i) PR[i] = (bf16_t*)(ws + WS_PROJ + i * SZ_ACT);
    bf16_t *FQ = PR[0], *FK = PR[1], *FV = PR[2], *LX = PR[3], *LG = PR[4], *SQ = PR[5], *SK = PR[6], *SV = PR[7], *MQ = PR[8];
    bf16_t* GATES = (bf16_t*)(ws + WS_GATES);
    bf16_t *YL = (bf16_t*)(ws + WS_YL), *YS = (bf16_t*)(ws + WS_YS), *YM = (bf16_t*)(ws + WS_YM), *YF = (bf16_t*)(ws + WS_YF);
    float *LOGF = (float*)(ws + WS_LOGF), *FB = (float*)(ws + WS_FB);
    bf16_t* MEMN = (bf16_t*)(ws + WS_MEMN); float* MEMRAW = (float*)(ws + WS_MEMRAW);
    bf16_t *MK = (bf16_t*)(ws + WS_MK), *MVT = (bf16_t*)(ws + WS_MVT);
    bf16_t *GV = (bf16_t*)(ws + WS_GV), *ACT = (bf16_t*)(ws + WS_ACT);
    const float* const* in = P.in;
    const int cfg = CFG;
    const bool anygemm = cfg & (C_WIN | C_BR | C_WOUT | C_UP | C_DOWN);
    if (cfg & C_PRO) { for (int p = 0; p < 3; ++p) launch_mega(P, p, p + 1, SUB_ALL, st, false); }
    else for (int l = 0; l < DEPTH; ++l) {
        n_rmsnorm<<<512 / 4, 256, 0, st>>>(in[1], in[3] + l * DM, MEMN + (size_t)l * 512 * DM, nullptr, nullptr, nullptr, 512);
        n_gemm<EStoreF32><<<dim3(2048 / 64, 512 / 64), 256, 0, st>>>(MEMN + (size_t)l * 512 * DM, in[15] + (size_t)l * DM * 2048, DM, 2048, DM, 0x7fffffff, EStoreF32{MEMRAW + (size_t)l * 512 * 2048, 2048, 0});
        n_memkv_post<<<512, 256, 0, st>>>(MEMRAW + (size_t)l * 512 * 2048, in[17] + l * 256, in[16] + l * 256, MK + (size_t)l * 512 * DM, MVT + (size_t)l * 512 * DM);
    }
    for (int l = 0; l < DEPTH; ++l) {
        const int p0 = N_PRO + l * N_PER_LAYER;
        const float* xcur = l == 0 ? in[0] : P.out;
        const float* win = in[4] + (size_t)l * DM * NIN;
        if (DBG_NOLOGF) n_rmsnorm<<<T / 4, 256, 0, st>>>(xcur, in[2] + l * DM, H, win + 3072, in[5] + l * 16, LOGF, T);
        { const int sub = (anygemm ? SUB_CONV : 0) | ((cfg & C_NORM) ? SUB_NORM : 0); if (sub) launch_mega(P, p0, p0 + 1, sub, st, false); }
        if (!(cfg & C_NORM)) n_rmsnorm<<<T / 4, 256, 0, st>>>(xcur, in[2] + l * DM, H, win + 3072, in[5] + l * 16, LOGF, T);
        if (cfg & C_WIN) launch_mega(P, p0 + 1, p0 + 2, SUB_ALL, st, false);
        else { for (int gI = 0; gI < 9; ++gI) { const int coff = gI < 3 ? gI * 1024 : gI * 1024 + 16;
                n_gemm<EStoreBf16><<<dim3(1024 / 64, T / 64), 256, 0, st>>>(H, win + coff, DM, NIN, DM, 0x7fffffff, EStoreBf16{PR[gI], DM, 0}); }
            n_gemm<EStoreBf16><<<dim3(4096 / 64, T / 64), 256, 0, st>>>(H, win + 9232, DM, NIN, DM, 0x7fffffff, EStoreBf16{GATES, 4096, 0}); }
        if (!(cfg & C_HN)) { n_headnorm<<<T * 16 / 256, 256, 0, st>>>(FQ, in[6] + l * 64, 64, C2); n_headnorm<<<T * 16 / 256, 256, 0, st>>>(FK, in[7] + l * 64, 64, 1.f); n_cumsum<<<32, 1024, 0, st>>>(LOGF, FB); }
        const int sub23 = ((cfg & C_HN) ? (SUB_HEADNORM | SUB_CUMSUM) : 0) | ((cfg & C_LRU) ? SUB_LRU : 0) | ((cfg & C_SB) ? SUB_SB : 0) | ((cfg & C_MEM) ? SUB_MEM : 0) | ((cfg & C_FOX) ? SUB_FOX : 0);
        if (sub23 & ~SUB_FOX) launch_mega(P, p0 + 2, p0 + 3, sub23, st, false);
        if (!(cfg & C_SB)) n_sb_attn<<<dim3(SEQ / 256, 32), 256, 0, st>>>(SQ, SK, SV, YS);
        if (!(cfg & C_LRU)) n_lru<<<32, 64, 0, st>>>(LX, LG, in[8] + (size_t)l * 4 * DM, in[9] + l * DM, in[10] + (size_t)l * 16 * 64 * 64, in[11] + l * DM, in[12] + (size_t)l * 16 * 64 * 64, in[13] + l * DM, in[14] + l * DM, YL);
        if (!(cfg & C_MEM)) n_mem_attn<<<T * 4, 256, 0, st>>>(MQ, MK + (size_t)l * 512 * DM, MVT + (size_t)l * 512 * DM, YM);
        if (sub23 & (SUB_FOX | SUB_LRU | SUB_MEM)) launch_mega(P, p0 + 3, p0 + 4, sub23, st, false);
        if (!(cfg & C_FOX)) n_fox_attn<<<dim3(SEQ / 256, 32), 256, 0, st>>>(FQ, FK, FV, FB, YF);
        if (cfg & C_BR) launch_mega(P, p0 + 4, p0 + 5, SUB_ALL, st, false);
        else { const bf16_t* Y[4] = {YF, YL, YS, YM};
            for (int i = 0; i < 4; ++i) n_gemm<EBranch><<<dim3(1024 / 64, T / 64), 256, 0, st>>>(Y[i], in[19] + ((size_t)l * 4 + i) * DM * DM, DM, DM, DM, 0x7fffffff, EBranch{GATES, in[18] + ((size_t)l * 4 + i) * DM, (float*)(ws + WS_MIXF), (bf16_t*)(ws + WS_MIXED), i, 0}); }
        if (cfg & C_WOUT) launch_mega(P, p0 + 5, p0 + 6, SUB_ALL, st, false);
        else n_gemm<EResid><<<dim3(1024 / 64, T / 64), 256, 0, st>>>((const bf16_t*)(ws + WS_MIXED), in[20] + (size_t)l * DM * DM, DM, DM, DM, 0x7fffffff, EResid{xcur, P.out});
        if (cfg & C_NORM2) launch_mega(P, p0 + 6, p0 + 7, SUB_ALL, st, false);
        else n_rmsnorm<<<T / 4, 256, 0, st>>>(P.out, in[21] + l * DM, H, nullptr, nullptr, nullptr, T);
        if (cfg & C_UP) launch_mega(P, p0 + 7, p0 + 8, SUB_ALL, st, false);
        else n_gemm<EStoreBf16><<<dim3(2 * DFF / 64, T / 64), 256, 0, st>>>(H, in[22] + (size_t)l * DM * 2 * DFF, DM, 2 * DFF, DM, 0x7fffffff, EStoreBf16{GV, 2 * DFF, 0});
        if (cfg & C_ACT) launch_mega(P, p0 + 8, p0 + 9, SUB_ALL, st, false);
        else n_act<<<(unsigned)(((size_t)T * DFF + 255) / 256), 256, 0, st>>>(GV, in[23] + (size_t)l * 3 * DFF, in[24] + l * DFF, ACT);
        if (cfg & C_DOWN) launch_mega(P, p0 + 9, p0 + 10, SUB_ALL, st, false);
        else n_gemm<EResid><<<dim3(1024 / 64, T / 64), 256, 0, st>>>(ACT, in[25] + (size_t)l * DFF * DM, DFF, DM, DFF, 0x7fffffff, EResid{P.out, P.out});
    }
}

extern "C" void kernel_launch(void* const* d_in, const int* in_sizes, int n_in, void* d_out, int out_size, void* d_ws, size_t ws_size, hipStream_t stream) {
    if (n_in != 26 || out_size != T * DM || ws_size < WS_NEED) { fprintf(stderr, "kernel_launch: unexpected sizes n_in %d out %d ws %zu (need %zu)\n", n_in, out_size, ws_size, (size_t)WS_NEED); return; }
    if (g_grid == 0) {
        int dev = 0, cus = 0, per_cu = 0;
        hipGetDevice(&dev); hipDeviceGetAttribute(&cus, hipDeviceAttributeMultiprocessorCount, dev);
        if (hipFuncSetAttribute((const void*)mega, hipFuncAttributeMaxDynamicSharedMemorySize, MEGA_LDS) != hipSuccess) fprintf(stderr, "kernel_launch: hipFuncSetAttribute failed\n");
        if (hipOccupancyMaxActiveBlocksPerMultiprocessor(&per_cu, (const void*)mega, MEGA_THREADS, MEGA_LDS) != hipSuccess || per_cu < 1) fprintf(stderr, "kernel_launch: occupancy query says %d\n", per_cu);
        (void)hipGetLastError();
        g_grid = cus;
        if (g_grid != 256) fprintf(stderr, "kernel_launch: %d CUs; the attention phase's static order assumes 256\n", g_grid);
    }
    Ptrs P{};
    for (int i = 0; i < 26; ++i) P.in[i] = (const float*)d_in[i];
    P.out = (float*)d_out; P.ws = (unsigned char*)d_ws;
    if ((CFG) & C_ONE) { (void)hipMemsetAsync((char*)d_ws + WS_BAR, 0, CTL_ZERO_BYTES, stream);
        launch_mega(P, 0, N_PHASES, SUB_ALL, stream, true); }
    else { (void)hipMemsetAsync((char*)d_ws + WS_BAR, 0, CTL_ZERO_BYTES, stream); run_hybrid(P, stream); }
}
```

```cpp
#include <hip/hip_runtime.h>
#include <cstdio>
#include <cstdint>
#include <hip/hip_cooperative_groups.h>

typedef unsigned short bf16_t;
constexpr int BATCH = 2, SEQ = 8192, DM = 1024, DEPTH = 4, T = BATCH * SEQ;
constexpr int NMEM = 256, NIN = 13328, DFF = 2816;
constexpr float EPS = 1e-6f;
constexpr float LOG2E = 1.4426950408889634f;
constexpr float C2 = 0.125f * LOG2E;
constexpr float SB_THR = -104.0f;

__device__ __forceinline__ float bf2f(bf16_t b) { return __uint_as_float(((unsigned)b) << 16); }
__device__ __forceinline__ bf16_t f2bf(float f) { unsigned u = __float_as_uint(f); return (bf16_t)((u + 0x7fffu + ((u >> 16) & 1u)) >> 16); }
__device__ __forceinline__ float bfr(float f) { return bf2f(f2bf(f)); }
__device__ __forceinline__ float wave_sum(float v) {
#pragma unroll
    for (int o = 1; o < 64; o <<= 1) v += __shfl_xor(v, o);
    return v;
}
__device__ __forceinline__ float softplusf(float x) { return fmaxf(x, 0.f) + log1pf(__expf(-fabsf(x))); }
__device__ __forceinline__ float logsigmoidf(float x) { return -softplusf(-x); }
__device__ __forceinline__ float sigmoidf_(float x) { return 1.f / (1.f + __expf(-x)); }
__device__ __forceinline__ float gelu_tanh(float x) { const float u = 0.7978845608028654f * (x + 0.044715f * x * x * x); return 0.5f * x * (1.f + tanhf(u)); }

__device__ __forceinline__ int mk_tid() { int t = threadIdx.x; asm volatile("" : "+v"(t)); return t; }

constexpr size_t MiB = 1u << 20;
constexpr size_t SZ_ACT = (size_t)T * DM * 2;
constexpr size_t WS_CTL = 0;
constexpr size_t WS_H = 1 * MiB;
constexpr size_t WS_PROJ = WS_H + SZ_ACT;
constexpr size_t WS_GATES = WS_PROJ + 9 * SZ_ACT;
constexpr size_t WS_E = WS_GATES + 4 * SZ_ACT;
constexpr size_t WS_LOGF = WS_E + SZ_ACT;
constexpr size_t WS_FB = WS_LOGF + 1 * MiB;
constexpr size_t WS_MQSS = WS_FB + 1 * MiB;
constexpr size_t WS_ESUM = WS_MQSS + 1 * MiB;
constexpr size_t WS_MEMN = WS_ESUM + 1 * MiB;
constexpr size_t WS_MEMRAW = WS_MEMN + 4 * MiB;
constexpr size_t WS_MK = WS_MEMRAW + 16 * MiB;
constexpr size_t WS_MVT = WS_MK + 4 * MiB;
constexpr size_t WS_LRU = WS_MVT + 4 * MiB;
constexpr size_t WS_WT = WS_LRU + 2 * MiB;
constexpr size_t WS_END = WS_WT + 72 * MiB;
constexpr size_t WS_YL = WS_PROJ + 6 * SZ_ACT, WS_YS = WS_H, WS_YM = WS_PROJ + 8 * SZ_ACT, WS_YF = WS_PROJ + 7 * SZ_ACT;
constexpr size_t WS_GV = WS_PROJ;
constexpr size_t WS_ACT = WS_GV + (size_t)T * 2 * DFF * 2;
static_assert(WS_ACT + (size_t)T * DFF * 2 <= WS_GATES, "ffn alias");
constexpr size_t WS_MIXF = WS_END;
constexpr size_t WS_MIXED = WS_PROJ;
constexpr size_t WS_NEED = WS_MIXF + (size_t)T * DM * 4;

struct Ptrs {
    const float* in[26];
    float* out;
    unsigned char* ws;
};

__global__ void __launch_bounds__(256) n_rmsnorm(const float* __restrict__ x, const float* __restrict__ g, bf16_t* __restrict__ H,
                                                 const float* __restrict__ Wf, const float* __restrict__ bfg, float* __restrict__ LOGF, int nrows) {
    const int lane = threadIdx.x & 63, row = blockIdx.x * 4 + (threadIdx.x >> 6);
    if (row >= nrows) return;
    const float4* xr = (const float4*)(x + (size_t)row * DM);
    const float4* gr = (const float4*)g;
    float4 v[4]; float ss = 0.f;
#pragma unroll
    for (int j = 0; j < 4; ++j) { v[j] = xr[lane + 64 * j]; ss += v[j].x * v[j].x + v[j].y * v[j].y + v[j].z * v[j].z + v[j].w * v[j].w; }
    ss = wave_sum(ss);
    const float rstd = rsqrtf(ss * (1.f / DM) + EPS);
#pragma unroll
    for (int j = 0; j < 4; ++j) { const float4 gg = gr[lane + 64 * j]; v[j].x *= rstd * gg.x; v[j].y *= rstd * gg.y; v[j].z *= rstd * gg.z; v[j].w *= rstd * gg.w;
        ushort4 o; o.x = f2bf(v[j].x); o.y = f2bf(v[j].y); o.z = f2bf(v[j].z); o.w = f2bf(v[j].w);
        ((ushort4*)(H + (size_t)row * DM))[lane + 64 * j] = o; }
    if (Wf) {
        float mine = 0.f;
        for (int h = 0; h < 16; ++h) {
            float p = 0.f;
#pragma unroll
            for (int j = 0; j < 4; ++j) { const int k = (lane + 64 * j) * 4;
                p += v[j].x * Wf[(size_t)k * NIN + h] + v[j].y * Wf[(size_t)(k + 1) * NIN + h] + v[j].z * Wf[(size_t)(k + 2) * NIN + h] + v[j].w * Wf[(size_t)(k + 3) * NIN + h]; }
            p = wave_sum(p);
            if (lane == h) mine = p;
        }
        if (lane < 16) { const int b = row / SEQ, t = row % SEQ; LOGF[((size_t)b * 16 + lane) * SEQ + t] = logsigmoidf(mine + bfg[lane]); }
    }
}

struct EStoreBf16 { bf16_t* O; int ldc; int pad; __device__ void operator()(int m, int n, float a) const { O[(size_t)m * ldc + n] = f2bf(a); } };
struct EStoreF32 { float* O; int ldc; int pad; __device__ void operator()(int m, int n, float a) const { O[(size_t)m * ldc + n] = a; } };
struct EBranch { const bf16_t* G; const float* bg; float* MIXF; bf16_t* MIXED; int i; int pad; __device__ void operator()(int m, int n, float a) const { float v = sigmoidf_(bf2f(G[(size_t)m * 4096 + i * 1024 + n]) + bg[n]) * a; const size_t o = (size_t)m * DM + n; if (i > 0) v += MIXF[o]; if (i < 3) MIXF[o] = v; else MIXED[o] = f2bf(v); } };
struct EResid { const float* base; float* out; __device__ void operator()(int m, int n, float a) const { out[(size_t)m * DM + n] = base[(size_t)m * DM + n] + a; } };

template <class Epi> __global__ void __launch_bounds__(256) n_gemm(const bf16_t* __restrict__ A, const float* __restrict__ W, int lda, int ldw, int K, int kmask, Epi epi) {
    __shared__ float As[16][68], Bs[16][68];
    const int tx = threadIdx.x & 15, ty = threadIdx.x >> 4, m0 = blockIdx.y * 64, n0 = blockIdx.x * 64;
    float acc[4][4];
#pragma unroll
    for (int i = 0; i < 4; ++i)
#pragma unroll
        for (int j = 0; j < 4; ++j) acc[i][j] = 0.f;
    for (int k0 = 0; k0 < K; k0 += 16) {
#pragma unroll
        for (int i = 0; i < 4; ++i) { const int idx = threadIdx.x + i * 256; { const int r = idx >> 4, c = idx & 15; As[c][r] = bf2f(A[(size_t)(m0 + r) * lda + k0 + c]); }
            { const int r = idx >> 6, c = idx & 63; Bs[r][c] = bfr(W[(size_t)((k0 + r) & kmask) * ldw + n0 + c]); } }
        __syncthreads();
#pragma unroll
        for (int kk = 0; kk < 16; ++kk) { float a[4], b[4];
#pragma unroll
            for (int i = 0; i < 4; ++i) { a[i] = As[kk][ty * 4 + i]; b[i] = Bs[kk][tx * 4 + i]; }
#pragma unroll
            for (int i = 0; i < 4; ++i)
#pragma unroll
                for (int j = 0; j < 4; ++j) acc[i][j] += a[i] * b[j]; }
        __syncthreads();
    }
#pragma unroll
    for (int i = 0; i < 4; ++i)
#pragma unroll
        for (int j = 0; j < 4; ++j) epi(m0 + ty * 4 + i, n0 + tx * 4 + j, acc[i][j]);
}

__global__ void __launch_bounds__(256) n_headnorm(bf16_t* X, const float* __restrict__ g, int HD, float scale) {
    const int idx = blockIdx.x * 256 + threadIdx.x, nh = DM / HD, row = idx / nh, h = idx % nh;
    if (row >= T) return;
    bf16_t* p = X + (size_t)row * DM + h * HD; float ss = 0.f;
    for (int d = 0; d < HD; ++d) { const float v = bf2f(p[d]); ss += v * v; }
    const float rstd = rsqrtf(ss / HD + EPS) * scale;
    for (int d = 0; d < HD; ++d) p[d] = f2bf(bf2f(p[d]) * rstd * g[d]);
}

__global__ void __launch_bounds__(1024) n_cumsum(const float* __restrict__ LOGF, float* __restrict__ FB) {
    __shared__ float part[1024];
    const int bh = blockIdx.x, tid = threadIdx.x; const float* src = LOGF + (size_t)bh * SEQ + tid * 8; float v[8]; float s = 0.f;
#pragma unroll
    for (int i = 0; i < 8; ++i) { s += src[i]; v[i] = s; }
    part[tid] = s; __syncthreads();
    if (tid == 0) { float run = 0.f; for (int i = 0; i < 1024; ++i) { const float t_ = part[i]; part[i] = run; run += t_; } }
    __syncthreads();
    const float off = part[tid]; float* dst = FB + (size_t)bh * SEQ + tid * 8;
#pragma unroll
    for (int i = 0; i < 8; ++i) dst[i] = off + v[i];
}

__global__ void __launch_bounds__(256) n_fox_attn(const bf16_t* Q, const bf16_t* __restrict__ K, const bf16_t* __restrict__ V, const float* __restrict__ FB, bf16_t* O) {
    __shared__ float Ks[64][64], Vs[64][64], Fs[64];
    const int bh = blockIdx.y, b = bh >> 4, h = bh & 15, tq = blockIdx.x * 256 + threadIdx.x;
    const size_t rowq = (size_t)b * SEQ + tq;
    float q[64], o[64];
#pragma unroll
    for (int d = 0; d < 64; ++d) { q[d] = bf2f(Q[rowq * DM + h * 64 + d]); o[d] = 0.f; }
    const float Ft = FB[(size_t)bh * SEQ + tq];
    float m = -INFINITY, l = 0.f;
    const int ntile = (blockIdx.x * 256 + 256) / 64;
    for (int kt = 0; kt < ntile; ++kt) {
        __syncthreads();
        for (int i = threadIdx.x; i < 64 * 64; i += 256) { const int r = i >> 6, c = i & 63; const size_t rk = ((size_t)b * SEQ + kt * 64 + r) * DM + h * 64 + c; Ks[r][c] = bf2f(K[rk]); Vs[r][c] = bf2f(V[rk]); }
        if (threadIdx.x < 64) Fs[threadIdx.x] = FB[(size_t)bh * SEQ + kt * 64 + threadIdx.x];
        __syncthreads();
        for (int j = 0; j < 64; ++j) {
            const int s = kt * 64 + j; if (s > tq) break;
            float z = 0.f;
#pragma unroll
            for (int d = 0; d < 64; ++d) z += q[d] * Ks[j][d];
            z += (Ft - Fs[j]) * LOG2E;
            if (z > m) { const float c = exp2f(m - z); l *= c;
#pragma unroll
                for (int d = 0; d < 64; ++d) o[d] *= c;
                m = z; }
            const float p = exp2f(z - m); l += p;
#pragma unroll
            for (int d = 0; d < 64; ++d) o[d] += p * Vs[j][d];
        }
    }
    const float il = 1.f / l;
#pragma unroll
    for (int d = 0; d < 64; ++d) O[rowq * DM + h * 64 + d] = f2bf(o[d] * il);
}

__global__ void __launch_bounds__(256) n_sb_attn(const bf16_t* Q, const bf16_t* __restrict__ K, const bf16_t* __restrict__ V, bf16_t* O) {
    __shared__ float Ks[64][64], Vs[64][64];
    const int bh = blockIdx.y, b = bh >> 4, h = bh & 15, tq = blockIdx.x * 256 + threadIdx.x;
    const size_t rowq = (size_t)b * SEQ + tq;
    float q[64], o[64];
#pragma unroll
    for (int d = 0; d < 64; ++d) { q[d] = bf2f(Q[rowq * DM + h * 64 + d]) * 0.125f; o[d] = 0.f; }
    float R = 0.f;
    for (int kt = (blockIdx.x * 256 + 255) / 64; kt >= 0; --kt) {
        if (__syncthreads_and(R < SB_THR)) break;
        for (int i = threadIdx.x; i < 64 * 64; i += 256) { const int r = i >> 6, c = i & 63; const size_t rk = ((size_t)b * SEQ + kt * 64 + r) * DM + h * 64 + c; Ks[r][c] = bf2f(K[rk]); Vs[r][c] = bf2f(V[rk]); }
        __syncthreads();
        for (int j = 63; j >= 0; --j) {
            const int s = kt * 64 + j; if (s >= tq) continue;
            float z = 0.f;
#pragma unroll
            for (int d = 0; d < 64; ++d) z += q[d] * Ks[j][d];
            const float sp = softplusf(z);
            const float w = __expf((z - sp) + R);
            R -= sp;
#pragma unroll
            for (int d = 0; d < 64; ++d) o[d] += w * Vs[j][d];
        }
    }
#pragma unroll
    for (int d = 0; d < 64; ++d) O[rowq * DM + h * 64 + d] = f2bf(o[d]);
}

__global__ void __launch_bounds__(64) n_lru(const bf16_t* LX, const bf16_t* __restrict__ LG, const float* __restrict__ cw, const float* __restrict__ cb,
                                            const float* __restrict__ wa, const float* __restrict__ ba, const float* __restrict__ wx, const float* __restrict__ bx,
                                            const float* __restrict__ lam, bf16_t* YL) {
    __shared__ float xs[64];
    const int b = blockIdx.x >> 4, n = blockIdx.x & 15, e = threadIdx.x, ch = n * 64 + e;
    float wA[64], wX[64];
#pragma unroll
    for (int d = 0; d < 64; ++d) { wA[d] = wa[((size_t)n * 64 + d) * 64 + e]; wX[d] = wx[((size_t)n * 64 + d) * 64 + e]; }
    const float w0 = cw[ch], w1 = cw[DM + ch], w2 = cw[2 * DM + ch], w3 = cw[3 * DM + ch], bc = cb[ch], bA = ba[ch], bX = bx[ch];
    const float spl = softplusf(-lam[ch]);
    float x1 = 0.f, x2 = 0.f, x3 = 0.f, hs = 0.f;
    for (int t = 0; t < SEQ; ++t) {
        const size_t r = ((size_t)b * SEQ + t) * DM + ch;
        const float x0 = bf2f(LX[r]);
        const float xc = bc + w3 * x0 + w2 * x1 + w1 * x2 + w0 * x3;
        x3 = x2; x2 = x1; x1 = x0;
        __syncthreads();
        xs[e] = xc;
        __syncthreads();
        float ra = bA, ri = bX;
#pragma unroll
        for (int d = 0; d < 64; ++d) { const float xv = xs[d]; ra += xv * wA[d]; ri += xv * wX[d]; }
        const float rr = sigmoidf_(ra), ii = sigmoidf_(ri);
        const float la = -8.f * rr * spl;
        const float a = __expf(la);
        const float u = sqrtf(-expm1f(2.f * la)) * (ii * xc);
        hs = a * hs + u;
        YL[r] = f2bf(hs * gelu_tanh(bf2f(LG[r])));
    }
}

__global__ void __launch_bounds__(256) n_memkv_post(const float* __restrict__ raw, const float* __restrict__ gk, const float* __restrict__ gq, bf16_t* __restrict__ MK, bf16_t* __restrict__ MVT) {
    const int row = blockIdx.x, b = row >> 8, m = row & 255, d = threadIdx.x;
    __shared__ float red[4];
    for (int h = 0; h < 4; ++h) {
        const float k = raw[(size_t)row * 2048 + h * 256 + d];
        float ss = wave_sum(k * k);
        __syncthreads();
        if ((threadIdx.x & 63) == 0) red[threadIdx.x >> 6] = ss;
        __syncthreads();
        ss = red[0] + red[1] + red[2] + red[3];
        const float rstd = rsqrtf(ss * (1.f / 256.f) + EPS);
        MK[((size_t)b * 256 + m) * DM + h * 256 + d] = f2bf(k * rstd * gk[d] * gq[d]);
        MVT[(((size_t)b * 4 + h) * 256 + d) * 256 + m] = f2bf(raw[(size_t)row * 2048 + 1024 + h * 256 + d]);
    }
}

__global__ void __launch_bounds__(256) n_mem_attn(const bf16_t* MQ, const bf16_t* __restrict__ MK, const bf16_t* __restrict__ MVT, bf16_t* YM) {
    __shared__ float qs[256], ps[256], red[4];
    const int row = blockIdx.x >> 2, h = blockIdx.x & 3, b = row / SEQ, tid = threadIdx.x;
    const float qv = bf2f(MQ[(size_t)row * DM + h * 256 + tid]);
    float ss = wave_sum(qv * qv);
    if ((tid & 63) == 0) red[tid >> 6] = ss;
    qs[tid] = qv;
    __syncthreads();
    const float rstd = rsqrtf((red[0] + red[1] + red[2] + red[3]) * (1.f / 256.f) + EPS);
    const bf16_t* kr = MK + ((size_t)b * 256 + tid) * DM + h * 256;
    float s = 0.f;
    for (int d = 0; d < 256; ++d) s += qs[d] * bf2f(kr[d]);
    s *= rstd * (1.f / 16.f);
    __syncthreads();
    float mx = s;
#pragma unroll
    for (int o = 1; o < 64; o <<= 1) mx = fmaxf(mx, __shfl_xor(mx, o));
    if ((tid & 63) == 0) red[tid >> 6] = mx;
    __syncthreads();
    mx = fmaxf(fmaxf(red[0], red[1]), fmaxf(red[2], red[3]));
    const float p = __expf(s - mx);
    ps[tid] = p;
    float sum = wave_sum(p);
    __syncthreads();
    if ((tid & 63) == 0) red[tid >> 6] = sum;
    __syncthreads();
    sum = red[0] + red[1] + red[2] + red[3];
    const bf16_t* vr = MVT + (((size_t)b * 4 + h) * 256 + tid) * 256;
    float o = 0.f;
    for (int m = 0; m < 256; ++m) o += ps[m] * bf2f(vr[m]);
    YM[(size_t)row * DM + h * 256 + tid] = f2bf(o / sum);
}

__global__ void __launch_bounds__(256) n_act(const bf16_t* __restrict__ GV, const float* __restrict__ cw, const float* __restrict__ cb, bf16_t* __restrict__ ACT) {
    const size_t idx = (size_t)blockIdx.x * 256 + threadIdx.x; if (idx >= (size_t)T * DFF) return;
    const int r = (int)(idx / DFF), c = (int)(idx % DFF), t = r % SEQ;
    const float g0 = bf2f(GV[(size_t)r * 2 * DFF + c]);
    const float g1 = t >= 1 ? bf2f(GV[(size_t)(r - 1) * 2 * DFF + c]) : 0.f;
    const float g2 = t >= 2 ? bf2f(GV[(size_t)(r - 2) * 2 * DFF + c]) : 0.f;
    const float pre = cb[c] + cw[2 * DFF + c] * g0 + cw[DFF + c] * g1 + cw[c] * g2;
    const float val = bf2f(GV[(size_t)r * 2 * DFF + DFF + c]);
    ACT[(size_t)r * DFF + c] = f2bf(pre * sigmoidf_(pre) * val);
}

#define CFG 32767
namespace pg8 {
#define PG8_LAS __attribute__((address_space(3)))
typedef unsigned short bf16_t;
typedef short bf16x8 __attribute__((ext_vector_type(8)));
typedef float f32x4 __attribute__((ext_vector_type(4)));
typedef unsigned u32x4 __attribute__((ext_vector_type(4)));
constexpr int BM = 256, BK = 64, HALF = 128, HTB = HALF * BK * 2  , STAGE_BYTES = 8 * HTB, NXCD = 8, WGM = 8;

__host__ __device__ __forceinline__ int lds_byte(int r, int c) { const int st = (r >> 4) * 2 + (c >> 5), rr = r & 15, cc = c & 31, ob = rr * 64 + cc * 2; return st * 1024 + (ob ^ (((ob >> 9) & 1) << 5)); }
__host__ __device__ __forceinline__ void stage_rc(int b, int& R, int& C) { const int st = b / 1024, sb = b % 1024, swz = sb ^ (((sb >> 9) & 1) << 5); R = (st >> 1) * 16 + swz / 64; C = (st & 1) * 32 + (swz % 64) / 2; }
__host__ __device__ __forceinline__ int perm32(int rho) { const int n = rho >> 4, i = rho & 15; return 8 * (i >> 2) + 4 * n + (i & 3); }

struct Unit { int pm, pn; };
struct Gemm { int lda, ldb, K; };

struct StaticOrder {
    int nM, nN, nwg, G, c;
    __host__ __device__ void init(int M, int N, int G_, int c_) { nM = M / BM; nN = N / BM; nwg = nM * nN; G = G_; c = c_; }
    __host__ __device__ bool next(int i, Unit& u) const {
        const long L = (long)i * G + c; if (L >= nwg) return false;
        int wgid = (int)L; { const int q = nwg / NXCD, r = nwg % NXCD, xcd = wgid % NXCD, off = wgid / NXCD; wgid = (xcd < r ? xcd * (q + 1) : r * (q + 1) + (xcd - r) * q) + off; }
        const int nig = WGM * nN, gid = wgid / nig, fm = gid * WGM, gsz = (nM - fm) < WGM ? (nM - fm) : WGM;
        u.pm = fm + ((wgid % nig) % gsz); u.pn = (wgid % nig) / gsz; return true;
    }
    __device__ __forceinline__ void a_ready(const Unit&) const {}
    __device__ __forceinline__ void done(const Unit&) const {}
};

__device__ __forceinline__ unsigned cvt_pk_bf16(float lo, float hi) { unsigned r; asm volatile("v_cvt_pk_bf16_f32 %0, %1, %2" : "=v"(r) : "v"(lo), "v"(hi)); return r; }
typedef float f32x2 __attribute__((ext_vector_type(2)));
__device__ __forceinline__ f32x2 gelu_pk(f32x2 v) {
    const f32x2 av = __builtin_elementwise_abs(v), d = av * 0.2316418882f + 1.0f;
    f32x2 t; t.x = __builtin_amdgcn_rcpf(d.x); t.y = __builtin_amdgcn_rcpf(d.y);
    f32x2 q = t * 0.5307027145f + (-0.7265760135f); q = q * t + 0.7107068705f; q = q * t + (-0.142248368f); q = q * t + 0.127414796f; q = q * t;
    const f32x2 s = (v * v) * (-0.72134752044f);
    f32x2 e; e.x = __builtin_amdgcn_exp2f(s.x); e.y = __builtin_amdgcn_exp2f(s.y);
    const f32x2 m = v * (q * e), r = v - m;
    f32x2 o; o.x = v.x < 0.f ? m.x : r.x; o.y = v.y < 0.f ? m.y : r.y; return o;
}

template <class Epi, class Sched, bool ALIGN_EPI = false, bool SP2 = false>
__device__ __forceinline__ void gemm_phase(PG8_LAS unsigned char* lds, const Gemm g, const Sched& S, const Epi& E) {
    const int tid = mk_tid(), wid = __builtin_amdgcn_readfirstlane(tid >> 6), lane = tid & 63, wr = wid >> 2, wc = wid & 3, fr = lane & 15, fq = lane >> 4;
    const int K = g.K, nt = K / BK;
    unsigned voffA[2], voffB[2];
#pragma unroll
    for (int i = 0; i < 2; ++i) { int R, C; stage_rc(tid * 16 + i * 8192, R, C); const int Rb = Epi::PERM ? ((R & ~31) + perm32(R & 31)) : R;
        voffA[i] = (unsigned)(R * g.lda + C) * 2u; voffB[i] = (unsigned)(Rb * g.ldb + C) * 2u; }
    const size_t kstep = (size_t)(BK * 2);
    const size_t hstepA = (size_t)HALF * g.lda * 2, hstepB = (size_t)HALF * g.ldb * 2;
    const unsigned ldsw = (unsigned)wid * 1024u;
    const int aoff = lds_byte(wr * 64 + fr, fq * 8), boff = lds_byte(wc * 32 + fr, fq * 8);
#define PG8_SA(b, h) (((b) * 2 + (h)) * HTB)
#define PG8_SB(b, h) ((4 + (b) * 2 + (h)) * HTB)
#define PG8_STAGE(bufoff, gbase, voff) do { _Pragma("unroll") for (int _i = 0; _i < 2; ++_i) \
        __builtin_amdgcn_global_load_lds((const unsigned*)((const char*)(gbase) + (voff)[_i]), (PG8_LAS unsigned*)(lds + (bufoff) + ldsw + _i * 8192), 16, 0, 0); } while (0)
#define PG8_LDA(dst, b, h) do { _Pragma("unroll") for (int m = 0; m < 4; ++m) _Pragma("unroll") for (int k = 0; k < 2; ++k) dst[m][k] = *(const PG8_LAS bf16x8*)(lds + PG8_SA(b, h) + aoff + m * 2048 + k * 1024); } while (0)
#define PG8_LDB(dst, b, h) do { _Pragma("unroll") for (int n = 0; n < 2; ++n) _Pragma("unroll") for (int k = 0; k < 2; ++k) dst[n][k] = *(const PG8_LAS bf16x8*)(lds + PG8_SB(b, h) + boff + n * 2048 + k * 1024); } while (0)
#define PG8_MMA(ai, bj, At, Bt) do { __builtin_amdgcn_s_setprio(1); _Pragma("unroll") for (int m = 0; m < 4; ++m) _Pragma("unroll") for (int n = 0; n < 2; ++n) _Pragma("unroll") for (int k = 0; k < 2; ++k) \
        acc[ai][bj][m][n] = __builtin_amdgcn_mfma_f32_16x16x32_bf16(Bt[n][k], At[m][k], acc[ai][bj][m][n], 0, 0, 0); __builtin_amdgcn_s_setprio(0); } while (0)
#define PG8_WAIT_V(n) asm volatile("s_waitcnt vmcnt(" #n ")" ::: "memory")
#define PG8_WAIT_L(n) asm volatile("s_waitcnt lgkmcnt(" #n ")" ::: "memory")
#define PG8_BAR __builtin_amdgcn_s_barrier()
#define PG8_SCHED __builtin_amdgcn_sched_barrier(0)
    Unit cur, nxt; int ui = 0;
    if (!S.next(0, cur)) return;
    f32x4 acc[2][2][4][2];
#pragma unroll
    for (int a = 0; a < 2; ++a)
#pragma unroll
        for (int b = 0; b < 2; ++b)
#pragma unroll
            for (int m = 0; m < 4; ++m)
#pragma unroll
                for (int n = 0; n < 2; ++n) acc[a][b][m][n] = (f32x4){0.f, 0.f, 0.f, 0.f};
    bf16x8 At[4][2], B0[2][2], B1[2][2];
    const char* cA = S.aptr(cur); const char* cB = S.bptr(cur);
    S.a_ready(cur);
    if constexpr (SP2) {
        PG8_STAGE(PG8_SB(0, 0), cB, voffB); PG8_STAGE(PG8_SB(0, 1), cB + hstepB, voffB); PG8_STAGE(PG8_SA(0, 0), cA, voffA); PG8_STAGE(PG8_SA(0, 1), cA + hstepA, voffA);
        if (wr == 1) PG8_BAR;
        PG8_WAIT_V(2); PG8_BAR;
        PG8_STAGE(PG8_SB(1, 0), cB + kstep, voffB); PG8_STAGE(PG8_SA(1, 0), cA + kstep, voffA); PG8_STAGE(PG8_SB(1, 1), cB + hstepB + kstep, voffB);
        PG8_WAIT_V(6); PG8_BAR;
    } else {
        PG8_STAGE(PG8_SB(0, 0), cB, voffB); PG8_STAGE(PG8_SA(0, 0), cA, voffA); PG8_STAGE(PG8_SB(0, 1), cB + hstepB, voffB); PG8_STAGE(PG8_SA(0, 1), cA + hstepA, voffA);
        if (wr == 1) PG8_BAR;
        PG8_WAIT_V(4); PG8_BAR;
        PG8_STAGE(PG8_SB(1, 0), cB + kstep, voffB); PG8_STAGE(PG8_SA(1, 0), cA + kstep, voffA); PG8_STAGE(PG8_SB(1, 1), cB + hstepB + kstep, voffB);
        PG8_WAIT_V(6); PG8_BAR;
    }
    for (;;) {
        const bool has_next = S.next(ui + 1, nxt);
        const char* nA = has_next ? S.aptr(nxt) : cA; const char* nB = has_next ? S.bptr(nxt) : cB;
        for (int t = 0; t < nt; t += 2) {
            const bool last = (t == nt - 2);
            const char* a1 = cA + (size_t)(t + 1) * kstep;
            const char* a2 = last ? nA : cA + (size_t)(t + 2) * kstep; const char* b2 = last ? nB : cB + (size_t)(t + 2) * kstep;
            const char* a3 = a2 + kstep; const char* b3 = b2 + kstep;
            if (last && has_next) S.a_ready(nxt);
            if constexpr (SP2) {
            PG8_LDB(B0, 0, 0); PG8_LDB(B1, 0, 1); PG8_SCHED; PG8_LDA(At, 0, 0); PG8_STAGE(PG8_SA(1, 1), a1 + hstepA, voffA);
            PG8_WAIT_V(8); PG8_WAIT_L(0); PG8_BAR; PG8_MMA(0, 0, At, B0); PG8_MMA(0, 1, At, B1); PG8_BAR; PG8_SCHED;
            PG8_LDA(At, 0, 1); PG8_STAGE(PG8_SB(0, 0), b2, voffB); PG8_STAGE(PG8_SB(0, 1), b2 + hstepB, voffB); PG8_STAGE(PG8_SA(0, 0), a2, voffA);
            PG8_WAIT_V(8); PG8_WAIT_L(0); PG8_BAR; PG8_MMA(1, 0, At, B0); PG8_MMA(1, 1, At, B1); PG8_BAR; PG8_SCHED;
            PG8_LDB(B0, 1, 0); PG8_LDB(B1, 1, 1); PG8_SCHED; PG8_LDA(At, 1, 0); PG8_STAGE(PG8_SA(0, 1), a2 + hstepA, voffA);
            PG8_WAIT_V(8); PG8_WAIT_L(0); PG8_BAR; PG8_MMA(0, 0, At, B0); PG8_MMA(0, 1, At, B1); PG8_BAR; PG8_SCHED;
            PG8_LDA(At, 1, 1); PG8_STAGE(PG8_SB(1, 0), b3, voffB); PG8_STAGE(PG8_SB(1, 1), b3 + hstepB, voffB); PG8_STAGE(PG8_SA(1, 0), a3, voffA);
            PG8_WAIT_V(8); PG8_WAIT_L(0); PG8_BAR; PG8_MMA(1, 0, At, B0); PG8_MMA(1, 1, At, B1); PG8_BAR; PG8_SCHED;
            } else {
            PG8_LDB(B0, 0, 0); PG8_SCHED; PG8_LDA(At, 0, 0); PG8_STAGE(PG8_SA(1, 1), a1 + hstepA, voffA);
            PG8_WAIT_L(8); PG8_BAR; PG8_WAIT_L(0); PG8_MMA(0, 0, At, B0); PG8_BAR; PG8_SCHED;
            PG8_LDB(B1, 0, 1); PG8_STAGE(PG8_SB(0, 0), b2, voffB);
            PG8_BAR; PG8_WAIT_L(0); PG8_MMA(0, 1, At, B1); PG8_BAR;
            PG8_LDA(At, 0, 1); PG8_STAGE(PG8_SA(0, 0), a2, voffA);
            PG8_BAR; PG8_WAIT_L(0); PG8_MMA(1, 0, At, B0); PG8_BAR; PG8_SCHED;
            PG8_STAGE(PG8_SB(0, 1), b2 + hstepB, voffB);
            PG8_WAIT_V(6); PG8_BAR; PG8_MMA(1, 1, At, B1); PG8_BAR;
            PG8_LDB(B0, 1, 0); PG8_SCHED; PG8_LDA(At, 1, 0); PG8_STAGE(PG8_SA(0, 1), a2 + hstepA, voffA);
            PG8_WAIT_L(8); PG8_BAR; PG8_WAIT_L(0); PG8_MMA(0, 0, At, B0); PG8_BAR; PG8_SCHED;
            PG8_LDB(B1, 1, 1); PG8_STAGE(PG8_SB(1, 0), b3, voffB);
            PG8_BAR; PG8_WAIT_L(0); PG8_MMA(0, 1, At, B1); PG8_BAR;
            PG8_LDA(At, 1, 1); PG8_STAGE(PG8_SA(1, 0), a3, voffA);
            PG8_BAR; PG8_WAIT_L(0); PG8_MMA(1, 0, At, B0); PG8_BAR; PG8_SCHED;
            PG8_STAGE(PG8_SB(1, 1), b3 + hstepB, voffB);
            PG8_WAIT_V(6); PG8_BAR; PG8_MMA(1, 1, At, B1); PG8_BAR;
            }
        }
        if constexpr (ALIGN_EPI) { if (wr == 0) PG8_BAR; }
        if constexpr (!Epi::AFTER_DRAIN) { int fr_ = fr, fq_ = fq; asm volatile("" : "+v"(fr_), "+v"(fq_));   E(acc, cur, wr, wc, fr_, fq_); S.done(cur); }
        if (!has_next) break;
#pragma unroll
        for (int a = 0; a < 2; ++a)
#pragma unroll
            for (int b = 0; b < 2; ++b)
#pragma unroll
                for (int m = 0; m < 4; ++m)
#pragma unroll
                    for (int n = 0; n < 2; ++n) acc[a][b][m][n] = (f32x4){0.f, 0.f, 0.f, 0.f};
        cur = nxt; cA = nA; cB = nB; ++ui;
        if constexpr (ALIGN_EPI) { if (wr == 1) PG8_BAR; }
    }
    PG8_WAIT_V(0);
    if constexpr (!ALIGN_EPI) { if (wr == 0) PG8_BAR; }
    PG8_BAR;
    if constexpr (Epi::AFTER_DRAIN) { E.fused(acc, cur, wr, wc, fr, fq, lds, wid, lane); S.done(cur); }
#undef PG8_SA
#undef PG8_SB
#undef PG8_STAGE
#undef PG8_LDA
#undef PG8_LDB
#undef PG8_MMA
#undef PG8_WAIT_V
#undef PG8_WAIT_L
#undef PG8_BAR
#undef PG8_SCHED
}
}
#include <hip/hip_bf16.h>
#include <cmath>
namespace attn_body {
using bf16=__hip_bfloat16;
using bf16x8=__attribute__((ext_vector_type(8)))short;
using s16x4=__attribute__((ext_vector_type(4)))short;
using f32x16=__attribute__((ext_vector_type(16)))float;
using u32x4=__attribute__((ext_vector_type(4)))unsigned;
constexpr int BATCH=2,NHEAD=16,SEQ=8192,D=64,DM=NHEAD*D;
constexpr int NW=8,QBLK=32,QB=QBLK*NW,KVBLK=64,NQB=SEQ/QB;
constexpr int ATTN_PITCH=DM, ATTN_UNIT_ROWS=QB;
__device__ __forceinline__ int crow(int r,int hi){return (r&3)+8*(r>>2)+4*hi;}
#define SBAR() __builtin_amdgcn_sched_barrier(0)
__device__ __forceinline__ void cmask(f32x16&p0,f32x16&p1,int jb,int qrel,int hi){
  const float NEG=-INFINITY; int kb=64*jb+4*hi;
  #pragma unroll
  for(int r=0;r<16;++r){int kv=kb+(r&3)+8*(r>>2); if(kv>qrel)p0[r]=NEG; if(kv+32>qrel)p1[r]=NEG;}
}

constexpr int NSLOT=3, SLOTB=8192;
constexpr int LDS_K=0, LDS_V=NSLOT*SLOTB, LDS_WS=2*NSLOT*SLOTB, LDS_OST=LDS_WS+NW*64*4, LDS_BYTES=LDS_OST+NW*4096;
constexpr int BIAS_OFF=86016;
constexpr float C2=0.125f*1.4426950408889634f;
__device__ __forceinline__ void glds16(const void*gsrc,unsigned lds_dst){unsigned keep;
  asm volatile("s_mov_b32 %0, m0\n\ts_mov_b32 m0, %2\n\ts_nop 0\n\tglobal_load_lds_dwordx4 %1, off\n\ts_mov_b32 m0, %0":"=&s"(keep):"v"(gsrc),"s"(lds_dst):"memory");}
__device__ __forceinline__ float max3f(float a,float b,float c){float r;asm("v_max3_f32 %0, %1, %2, %3":"=v"(r):"v"(a),"v"(b),"v"(c));return r;}
__device__ __forceinline__ float max2f(float a,float b){float r;asm("v_max_f32_e32 %0, %1, %2":"=v"(r):"v"(a),"v"(b));return r;}
__device__ __forceinline__ float fadd_s(float a,float b){float r;asm("v_add_f32_e32 %0, %1, %2":"=v"(r):"v"(a),"v"(b));return r;}
__device__ __forceinline__ float fsub_s(float a,float b){float r;asm("v_sub_f32_e32 %0, %1, %2":"=v"(r):"v"(a),"v"(b));return r;}
typedef float f32x2_t __attribute__((ext_vector_type(2))); typedef __bf16 bf16x2_t __attribute__((ext_vector_type(2)));
__device__ __forceinline__ unsigned cvtpk_s(float lo,float hi){f32x2_t v={lo,hi};bf16x2_t b=__builtin_convertvector(v,bf16x2_t);return __builtin_bit_cast(unsigned,b);}
#define WAIT_BAR(N) asm volatile("s_waitcnt vmcnt(" #N ") lgkmcnt(0)\n\ts_barrier":::"memory")

__device__ __forceinline__ void qkt(f32x16&p0,f32x16&p1,const char*Kslot,const bf16x8*qr,const f32x16&negm,int r32,int hi){
  const char*kb=Kslot+hi*1024+r32*16;
  #pragma unroll
  for(int d0=0;d0<4;++d0){
    const bf16x8 b0=*reinterpret_cast<const bf16x8*>(kb+d0*2048);
    const bf16x8 b1=*reinterpret_cast<const bf16x8*>(kb+d0*2048+512);
    if(d0==0){p0=__builtin_amdgcn_mfma_f32_32x32x16_bf16(b0,qr[0],negm,0,0,0);p1=__builtin_amdgcn_mfma_f32_32x32x16_bf16(b1,qr[0],negm,0,0,0);}
    else{p0=__builtin_amdgcn_mfma_f32_32x32x16_bf16(b0,qr[d0],p0,0,0,0);p1=__builtin_amdgcn_mfma_f32_32x32x16_bf16(b1,qr[d0],p1,0,0,0);}}
}
typedef __attribute__((address_space(3))) const char* lds_cptr;
typedef short v4i16_t __attribute__((ext_vector_type(4)));
__device__ __forceinline__ void kload8(bf16x8*kf,lds_cptr kp){
  kf[0]=*(const __attribute__((address_space(3))) bf16x8*)(kp);      kf[1]=*(const __attribute__((address_space(3))) bf16x8*)(kp+512);
  kf[2]=*(const __attribute__((address_space(3))) bf16x8*)(kp+2048); kf[3]=*(const __attribute__((address_space(3))) bf16x8*)(kp+2560);
  kf[4]=*(const __attribute__((address_space(3))) bf16x8*)(kp+4096); kf[5]=*(const __attribute__((address_space(3))) bf16x8*)(kp+4608);
  kf[6]=*(const __attribute__((address_space(3))) bf16x8*)(kp+6144); kf[7]=*(const __attribute__((address_space(3))) bf16x8*)(kp+6656);
}
__device__ __forceinline__ void kload2(bf16x8*kf,lds_cptr kp,int j){ kf[2*j]=*(const __attribute__((address_space(3))) bf16x8*)(kp+j*2048); kf[2*j+1]=*(const __attribute__((address_space(3))) bf16x8*)(kp+j*2048+512); }
__device__ __forceinline__ s16x4 vtr(lds_cptr p){ return __builtin_bit_cast(s16x4,__builtin_amdgcn_ds_read_tr16_b64_v4i16((__attribute__((address_space(3))) v4i16_t*)p)); }
__device__ __forceinline__ float rowmax(const f32x16&p0,const f32x16&p1){
  float a=max3f(p0[0],p0[1],p1[0]),b=max3f(p0[2],p0[3],p1[1]);a=max3f(a,p1[2],p1[3]);
  #pragma unroll
  for(int r=4;r<16;r+=4){a=max3f(a,p0[r],p0[r+1]);b=max3f(b,p0[r+2],p0[r+3]);a=max3f(a,p1[r],p1[r+1]);b=max3f(b,p1[r+2],p1[r+3]);}
  const float m=max2f(a,b);
  auto rr=__builtin_amdgcn_permlane32_swap(__float_as_uint(m),__float_as_uint(m),false,false);
  return max2f(__uint_as_float(rr[0]),__uint_as_float(rr[1]));
}
__device__ __forceinline__ void pv(f32x16*o,int vb,bf16x8 pa0,bf16x8 pa1,bf16x8 pa2,bf16x8 pa3){
  #pragma unroll
  for(int d0=0;d0<2;++d0){s16x4 lo[4],hi[4];
    #pragma unroll
    for(int ks=0;ks<4;++ks){
      asm volatile("ds_read_b64_tr_b16 %0,%1 offset:%c2":"=&v"(lo[ks]):"v"(vb),"i"(d0*4096+ks*1024):"memory");
      asm volatile("ds_read_b64_tr_b16 %0,%1 offset:%c2":"=&v"(hi[ks]):"v"(vb),"i"(d0*4096+ks*1024+512):"memory");}
    asm volatile("s_waitcnt lgkmcnt(0)":::"memory");SBAR();
    #define PK(k) (bf16x8){lo[k][0],lo[k][1],lo[k][2],lo[k][3],hi[k][0],hi[k][1],hi[k][2],hi[k][3]}
    o[d0]=__builtin_amdgcn_mfma_f32_32x32x16_bf16(pa0,PK(0),o[d0],0,0,0);
    o[d0]=__builtin_amdgcn_mfma_f32_32x32x16_bf16(pa1,PK(1),o[d0],0,0,0);
    o[d0]=__builtin_amdgcn_mfma_f32_32x32x16_bf16(pa2,PK(2),o[d0],0,0,0);
    o[d0]=__builtin_amdgcn_mfma_f32_32x32x16_bf16(pa3,PK(3),o[d0],0,0,0);
    #undef PK
  }
}

#ifndef ATTN_STORE16
#define ATTN_STORE16(p,v) (*(u32x4*)(p)=(v))
#endif
template<int THRL> __device__ __forceinline__ void attn_unit(int b,int h,int qb,const bf16*Q,const bf16*__restrict__ K,const bf16*__restrict__ V,bf16*O,const float*__restrict__ FBrow,float skip_thr,char*shm){
  const int tid=mk_tid(),lane=tid&63,r32=lane&31,hi=lane>>5; const int wid=__builtin_amdgcn_readfirstlane(tid>>6);
  const long rowbase=(long)b*SEQ; const int q0=qb*QB;
  int t_start=0;
  { const int ntf=(q0+QB)/KVBLK; const float Fq0=FBrow[q0];
    const bool c0=lane<ntf&&(Fq0-FBrow[64*(lane<ntf?lane:0)+63])*1.4426950408889634f<skip_thr;
    const bool c1=(lane+64)<ntf&&(Fq0-FBrow[64*((lane+64)<ntf?lane+64:0)+63])*1.4426950408889634f<skip_thr;
    int cnt=__popcll(__ballot(c0))+__popcll(__ballot(c1)); cnt&=~1; if(cnt>ntf-4)cnt=ntf-4; t_start=__builtin_amdgcn_readfirstlane(cnt); }
  const bf16*Qw=Q+(rowbase+q0+wid*QBLK)*DM+h*D;
  const bf16*Kh=K+(rowbase+(long)t_start*KVBLK)*DM+h*D,*Vh=V+(rowbase+(long)t_start*KVBLK)*DM+h*D;
  const lds_cptr shm3=(lds_cptr)shm;
  const unsigned lds0=(unsigned)(uintptr_t)shm;
  float*wsf=(float*)(shm+LDS_WS)+wid*64;
  const bf16*ksrc=Kh+(long)lane*DM+wid*8;
  const bf16*vsrc=Vh+(long)(16*(wid&3)+(lane>>2))*DM+(wid>>2)*32+(lane&3)*8;
  const unsigned kdst=lds0+LDS_K+wid*1024, vdst=lds0+LDS_V+wid*1024;
  #define DMA_K(t,slot) glds16(ksrc+(long)(t)*KVBLK*DM,(unsigned)__builtin_amdgcn_readfirstlane(kdst+(slot)))
  #define DMA_V(t,slot) glds16(vsrc+(long)(t)*KVBLK*DM,(unsigned)__builtin_amdgcn_readfirstlane(vdst+(slot)))
  const int vb0=(int)(lds0+LDS_V)+((lane>>4)&1)*32+(lane&3)*8+(4*hi+((lane&15)>>2))*64;
  const char*Kbase=shm+LDS_K; bf16x8 kf[8];
  const lds_cptr kp0=shm3+LDS_K+hi*1024+r32*16; const lds_cptr vp0=shm3+LDS_V+((lane>>4)&1)*32+(lane&3)*8+(4*hi+((lane&15)>>2))*64;
  const int NT=(q0+QB)/KVBLK-t_start;
  {
    typedef __attribute__((address_space(3))) float lds_f32; lds_f32* bl=(lds_f32*)(shm3+BIAS_OFF);
    const int nb=q0+QB; const float Fl=FBrow[nb-1];
    for(int i=t_start*KVBLK+tid;i<nb;i+=NW*64) bl[i]=(Fl-FBrow[i])*1.4426950408889634f;
    asm volatile("s_waitcnt vmcnt(0) lgkmcnt(0)\n\ts_barrier":::"memory"); }
  typedef float f32x4v __attribute__((ext_vector_type(4)));
  #define BIAS(P0,P1,t) do{ const __attribute__((address_space(3))) f32x4v* bp_=(const __attribute__((address_space(3))) f32x4v*)(shm3+BIAS_OFF)+((t)+t_start)*16+hi; \
    _Pragma("unroll") for(int g_=0;g_<4;++g_){ const f32x4v f0_=bp_[2*g_]+nm, f1_=bp_[8+2*g_]+nm; \
      P0[4*g_]+=f0_[0];P0[4*g_+1]+=f0_[1];P0[4*g_+2]+=f0_[2];P0[4*g_+3]+=f0_[3]; P1[4*g_]+=f1_[0];P1[4*g_+1]+=f1_[1];P1[4*g_+2]+=f1_[2];P1[4*g_+3]+=f1_[3]; } }while(0)
  DMA_K(0,0);DMA_V(0,0);DMA_K(1,SLOTB);
  bf16x8 qr[4];
  #pragma unroll
  for(int d0=0;d0<4;++d0)qr[d0]=*reinterpret_cast<const bf16x8*>(&Qw[(long)r32*DM+d0*16+hi*8]);
  float mhat=0.f,l_reg=0.f;f32x16 o[2];o[0]=f32x16{};o[1]=f32x16{};const f32x16 negm=f32x16{}; float nm=0.f;
  const int qrel=wid*QBLK+r32;
  #define CMASK(P0,P1,t) do{int jb_=(t)-(NT-4); if(jb_>=0)cmask(P0,P1,jb_,qrel,hi);}while(0)
  bool resc=false;
  #define START(P0,P1) do{ const float rm=rowmax(P0,P1); resc=false; \
    { const float dl=rm; mhat=fadd_s(mhat,dl); \
      _Pragma("unroll") for(int r=0;r<16;++r){P0[r]=fsub_s(P0[r],dl);P1[r]=fsub_s(P1[r],dl);} \
      nm=-mhat; } \
    _Pragma("unroll") for(int r=0;r<16;++r)P0[r]=__builtin_amdgcn_exp2f(P0[r]); }while(0)
  #define RESC() do{ if(resc){ asm volatile("s_waitcnt lgkmcnt(0)":::"memory"); \
      _Pragma("unroll") for(int d_=0;d_<2;++d_) _Pragma("unroll") for(int r=0;r<16;++r)o[d_][r]*=wsf[crow(r,hi)]; } }while(0)
  f32x16 pA0,pA1,pB0,pB1;
  int sl_prev=0,sl_cur=0,sl_next=SLOTB;
  #define ROT() do{sl_prev=sl_cur;sl_cur=sl_next;sl_next=(sl_next==(NSLOT-1)*SLOTB)?0:sl_next+SLOTB;}while(0)
  DMA_K(2,2*SLOTB);
  WAIT_BAR(3);
  qkt(pA0,pA1,Kbase,qr,negm,r32,hi);asm volatile("s_nop 15\n\ts_nop 7":"+v"(pA0),"+v"(pA1));BIAS(pA0,pA1,0);CMASK(pA0,pA1,0);
  START(pA0,pA1);
  _Pragma("unroll") for(int r=0;r<16;++r)pA1[r]=__builtin_amdgcn_exp2f(pA1[r]);
  WAIT_BAR(0);
  DMA_K(3,0);DMA_V(1,SLOTB);
  ROT();
  kload8(kf,kp0+sl_cur);
  WAIT_BAR(2);
  s16x4 vlo[8],vhi[8]; u32x4 pw0,pw1,pw2,pw3;
  #define PKW(P,B) cvtpk_s(P[B],P[B+1])
  #define PAF(k) __builtin_bit_cast(bf16x8,pw##k)
  #define VFR(i) (bf16x8){vlo[i][0],vlo[i][1],vlo[i][2],vlo[i][3],vhi[i][0],vhi[i][1],vhi[i][2],vhi[i][3]}
  #define PIN(x) asm volatile("":"+v"(x))
  #define MX3(a,b,c) __builtin_fmaxf(__builtin_fmaxf((a),(b)),(c))
  #define GAPA(MF,A0,A1,A2,A3,W0,W1,PW) do{ MF; sacc+=A0; sacc+=A1; sacc+=A2; sacc+=A3; PIN(sacc); W0; W1; PIN(PW); SBAR(); }while(0)
  #define EX(v) __builtin_amdgcn_exp2f(v)
  #define GAPB(MF,X,B) do{ MF; X[B]=EX(X[B]); X[B+1]=EX(X[B+1]); X[B+2]=EX(X[B+2]); X[B+3]=EX(X[B+3]); PIN(X); SBAR(); }while(0)
  #define VRD(i) do{ vlo[i]=vtr(vp_+(((i)>>2)*4096+((i)&3)*1024)); vhi[i]=vtr(vp_+(((i)>>2)*4096+((i)&3)*1024+512)); }while(0)
  #define KRD(G,j) do{ if(G){ kload2(kf,kp0+sl_next,j); SBAR(); } }while(0)
  #define STEP(C0,C1,P0,P1,t,GK,GV,GL) do{ SBAR(); \
    const lds_cptr vp_=vp0+sl_prev; \
    VRD(0); SBAR(); float sacc=(P0[0]+P0[1]); \
    GAPA(C0=__builtin_amdgcn_mfma_f32_32x32x16_bf16(kf[0],qr[0],negm,0,0,0), P0[2],P0[3],P0[4],P0[5],     pw0[0]=PKW(P0,0), pw0[1]=PKW(P0,2), pw0); \
    VRD(4); SBAR(); GAPA(C1=__builtin_amdgcn_mfma_f32_32x32x16_bf16(kf[1],qr[0],negm,0,0,0), P0[6],P0[7],P0[8],P0[9],     pw0[2]=PKW(P0,4), pw0[3]=PKW(P0,6), pw0); \
    VRD(1); SBAR(); GAPA(C0=__builtin_amdgcn_mfma_f32_32x32x16_bf16(kf[2],qr[1],C0,0,0,0),   P0[10],P0[11],P0[12],P0[13], pw1[0]=PKW(P0,8), pw1[1]=PKW(P0,10), pw1); \
    VRD(5); SBAR(); GAPA(C1=__builtin_amdgcn_mfma_f32_32x32x16_bf16(kf[3],qr[1],C1,0,0,0),   P0[14],P0[15],P1[0],P1[1],   pw1[2]=PKW(P0,12),pw1[3]=PKW(P0,14), pw1); \
    VRD(2); SBAR(); GAPA(C0=__builtin_amdgcn_mfma_f32_32x32x16_bf16(kf[4],qr[2],C0,0,0,0),   P1[2],P1[3],P1[4],P1[5],     pw2[0]=PKW(P1,0), pw2[1]=PKW(P1,2), pw2); \
    VRD(6); SBAR(); GAPA(C1=__builtin_amdgcn_mfma_f32_32x32x16_bf16(kf[5],qr[2],C1,0,0,0),   P1[6],P1[7],P1[8],P1[9],     pw2[2]=PKW(P1,4), pw2[3]=PKW(P1,6), pw2); \
    VRD(3); SBAR(); GAPA(C0=__builtin_amdgcn_mfma_f32_32x32x16_bf16(kf[6],qr[3],C0,0,0,0),   P1[10],P1[11],P1[12],P1[13], pw3[0]=PKW(P1,8), pw3[1]=PKW(P1,10), pw3); \
    VRD(7); SBAR(); GAPA(C1=__builtin_amdgcn_mfma_f32_32x32x16_bf16(kf[7],qr[3],C1,0,0,0),   P1[14],P1[15],0.f,0.f,       pw3[2]=PKW(P1,12),pw3[3]=PKW(P1,14), pw3); \
    l_reg+=sacc; \
    if(GK){DMA_K((t)+3,sl_cur);} if(GV){DMA_V((t)+1,sl_next);} \
    BIAS(C0,C1,t); CMASK(C0,C1,t); \
    { float a=MX3(C0[0],C0[1],C1[0]),b=MX3(C0[2],C0[3],C1[1]); a=MX3(a,C1[2],C1[3]); \
      _Pragma("unroll") for(int r=4;r<16;r+=4){a=MX3(a,C0[r],C0[r+1]);b=MX3(b,C0[r+2],C0[r+3]);a=MX3(a,C1[r],C1[r+1]);b=MX3(b,C1[r+2],C1[r+3]);} \
      float rm=__builtin_fmaxf(a,b); { auto rr=__builtin_amdgcn_permlane32_swap(__float_as_uint(rm),__float_as_uint(rm),false,false); rm=__builtin_fmaxf(__uint_as_float(rr[0]),__uint_as_float(rr[1])); } \
      resc=false; \
      if(__builtin_expect(__any(rm>(float)THRL),0)){ const float dl=__builtin_fmaxf(rm,0.f); mhat+=dl; \
        _Pragma("unroll") for(int r=0;r<16;++r){C0[r]-=dl;C1[r]-=dl;} \
        nm=-mhat; \
        const float f=__builtin_amdgcn_exp2f(-dl); l_reg*=f; if(hi==0)wsf[r32]=f; resc=true; } } \
    SBAR(); \
    GAPB(o[0]=__builtin_amdgcn_mfma_f32_32x32x16_bf16(PAF(0),VFR(0),o[0],0,0,0), C0,0); \
    GAPB(o[1]=__builtin_amdgcn_mfma_f32_32x32x16_bf16(PAF(0),VFR(4),o[1],0,0,0), C0,4); \
    KRD(GL,0); GAPB(o[0]=__builtin_amdgcn_mfma_f32_32x32x16_bf16(PAF(1),VFR(1),o[0],0,0,0), C0,8); \
    KRD(GL,1); GAPB(o[1]=__builtin_amdgcn_mfma_f32_32x32x16_bf16(PAF(1),VFR(5),o[1],0,0,0), C0,12); \
    KRD(GL,2); GAPB(o[0]=__builtin_amdgcn_mfma_f32_32x32x16_bf16(PAF(2),VFR(2),o[0],0,0,0), C1,0); \
    KRD(GL,3); GAPB(o[1]=__builtin_amdgcn_mfma_f32_32x32x16_bf16(PAF(2),VFR(6),o[1],0,0,0), C1,4); \
    GAPB(o[0]=__builtin_amdgcn_mfma_f32_32x32x16_bf16(PAF(3),VFR(3),o[0],0,0,0), C1,8); \
    GAPB(o[1]=__builtin_amdgcn_mfma_f32_32x32x16_bf16(PAF(3),VFR(7),o[1],0,0,0), C1,12); \
    }while(0)
  int t=1;
  #undef CMASK
  #define CMASK(P0,P1,t) do{}while(0)
  for(;t+5<NT;t+=2){
    STEP(pB0,pB1,pA0,pA1,t,true,true,true);     WAIT_BAR(2); RESC(); ROT();
    STEP(pA0,pA1,pB0,pB1,t+1,true,true,true);   WAIT_BAR(2); RESC(); ROT();
  }
  #undef CMASK
  #define CMASK(P0,P1,t) do{int jb_=(t)-(NT-4); if(jb_>=0)cmask(P0,P1,jb_,qrel,hi);}while(0)
  #define ENDW(tt) do{ if((tt)+3<NT){WAIT_BAR(2);} else if((tt)+2<NT){WAIT_BAR(1);} else {WAIT_BAR(0);} }while(0)
  for(;t+1<NT;t+=2){
    STEP(pB0,pB1,pA0,pA1,t,(t+3<NT),(t+1<NT),(t+1<NT));       ENDW(t);   RESC(); ROT();
    STEP(pA0,pA1,pB0,pB1,t+1,(t+4<NT),(t+2<NT),(t+2<NT));     ENDW(t+1); RESC(); ROT();
  }
  STEP(pB0,pB1,pA0,pA1,NT-1,false,false,false); RESC();
  { float sacc=pB0[0]+pB0[1]; _Pragma("unroll") for(int r=2;r<16;++r)sacc+=pB0[r]; _Pragma("unroll") for(int r=0;r<16;++r)sacc+=pB1[r]; l_reg+=sacc;
    pw0=(u32x4){PKW(pB0,0),PKW(pB0,2),PKW(pB0,4),PKW(pB0,6)};pw1=(u32x4){PKW(pB0,8),PKW(pB0,10),PKW(pB0,12),PKW(pB0,14)};pw2=(u32x4){PKW(pB1,0),PKW(pB1,2),PKW(pB1,4),PKW(pB1,6)};pw3=(u32x4){PKW(pB1,8),PKW(pB1,10),PKW(pB1,12),PKW(pB1,14)};
    SBAR(); pv(o,vb0+sl_cur,PAF(0),PAF(1),PAF(2),PAF(3)); }
  #undef PKW
  #undef PAF
  #undef VFR
  #undef PIN
  #undef MX3
  #undef GAPA
  #undef GAPB
  #undef EX
  #undef VRD
  #undef KRD
  #undef STEP
  #undef ENDW
  {auto rr=__builtin_amdgcn_permlane32_swap(__float_as_uint(l_reg),__float_as_uint(l_reg),false,false);l_reg=__uint_as_float(rr[0])+__uint_as_float(rr[1]);}
  if(hi==0)wsf[32+r32]=l_reg;asm volatile("s_waitcnt lgkmcnt(0)":::"memory");
  float rli[16];
  #pragma unroll
  for(int r=0;r<16;++r)rli[r]=__builtin_amdgcn_rcpf(wsf[32+crow(r,hi)]);
  bf16*Ow=O+(rowbase+q0+wid*QBLK)*DM+h*D;
  { bf16*stg=(bf16*)(shm+LDS_OST)+wid*2048;
    #pragma unroll
    for(int r=0;r<16;++r){const int orow=crow(r,hi);
      #pragma unroll
      for(int d0=0;d0<2;++d0)stg[orow*64+d0*32+r32]=__float2bfloat16(o[d0][r]*rli[r]);}
    asm volatile("s_waitcnt lgkmcnt(0)":::"memory");
    #pragma unroll
    for(int i=0;i<4;++i){const int row=i*8+(lane>>3),ch=lane&7; const u32x4 v=*(const u32x4*)(stg+row*64+ch*8); ATTN_STORE16(Ow+(long)row*DM+ch*8,v);} }
  asm volatile("s_waitcnt lgkmcnt(0)\n\ts_barrier":::"memory");
  #undef BIAS
  #undef DMA_K
  #undef DMA_V
  #undef CMASK
  #undef START
  #undef RESC
  #undef ROT
}
constexpr int ATTN_LDS_BYTES=86016+32768;
struct AttnTensors { const bf16* Q; const bf16* K; const bf16* V; bf16* O; const float* FB; float skip_thr; int pad; };
struct AttnUnit { int bh; int qb; };
struct StaticOrder {
  int vcu;
  __device__ __forceinline__ explicit StaticOrder(int grid,int block):vcu((block%8)*(grid/8)+block/8){}
  __device__ __forceinline__ bool next(int i,AttnUnit&u)const{ if(i>=4)return false; const int s=vcu&7; u.bh=vcu>>3; u.qb=(i==0)?s:(i==1)?15-s:(i==2)?16+s:31-s; return true; }
  __device__ __forceinline__ void a_ready(const AttnUnit&)const{}
  __device__ __forceinline__ void done(const AttnUnit&)const{}
};
struct QueueOrder {
  unsigned* ctr; int xl; volatile __attribute__((address_space(3))) int* slot;
  __device__ __forceinline__ bool next(int,AttnUnit&u)const{
    if(mk_tid()==0){ int got=-1;
      for(int k=0;k<8&&got<0;++k){ const int q=(xl+k)&7; const int j=(int)__hip_atomic_fetch_add(ctr+q*64,1u,__ATOMIC_RELAXED,__HIP_MEMORY_SCOPE_AGENT); if(j<128)got=q*128+j; }
      *slot=got; }
    __syncthreads(); const int g=*slot; if(g<0)return false; const int q=g>>7,j=g&127; u.bh=q*4+(j&3); u.qb=31-(j>>2); return true; }
  __device__ __forceinline__ void a_ready(const AttnUnit&)const{}
  __device__ __forceinline__ void done(const AttnUnit&)const{}
};
template<class Sched,int THRL=8> __device__ __forceinline__ void attn_phase(char*lds,const AttnTensors&T,const Sched&S){
  AttnUnit u;
  for(int i=0;S.next(i,u);++i){ S.a_ready(u); attn_unit<THRL>(u.bh/NHEAD,u.bh%NHEAD,u.qb,T.Q,T.K,T.V,T.O,T.FB+(size_t)u.bh*SEQ,T.skip_thr,lds); S.done(u); }
}
#undef SBAR
#undef WAIT_BAR
}
namespace cg = cooperative_groups;
#define LAS __attribute__((address_space(3)))
#define LDS_WAIT() asm volatile("s_waitcnt lgkmcnt(0)" ::: "memory")
#define LDS_BAR() asm volatile("s_waitcnt lgkmcnt(0)\n\ts_barrier" ::: "memory")
constexpr int MEGA_THREADS = 512, MEGA_LDS = 147456, NWV = 8;
#define GAS __attribute__((address_space(1)))
#define XB_TMO      128
#define XB_XCNT(j)  (256  + 64 * (j))
#define XB_XSUB(j)  (1280 + 64 * (j))
#define XB_XGEN(j)  (2304 + 64 * (j))
#define XB_TOP      3328
#define XB_TOPGEN   3392
#define XCD_BAR_WORDS 3456
#define XB_SPIN_CAP (1u << 18)

__device__ __forceinline__ unsigned xb_ld(unsigned* p)              { return __hip_atomic_load(p, __ATOMIC_RELAXED, __HIP_MEMORY_SCOPE_AGENT); }
__device__ __forceinline__ unsigned xb_add(unsigned* p, unsigned v) { return __hip_atomic_fetch_add(p, v, __ATOMIC_RELAXED, __HIP_MEMORY_SCOPE_AGENT); }
__device__ __forceinline__ unsigned xb_xcc_id() { return (unsigned)__builtin_amdgcn_s_getreg((3 << 11) | 20) & 0xFu; }
#define XB_SPIN(cond, bar) do { unsigned _sp = 0; while (cond) { __builtin_amdgcn_s_sleep(1); \
    if ((++_sp & 255u) == 0u) { if (xb_ld(&(bar)[XB_TMO])) break; if (_sp > XB_SPIN_CAP) { atomicAdd(&(bar)[XB_TMO], 1u); break; } } } } while (0)

struct XcdBarrier {
    unsigned* bar; unsigned x;
    volatile LAS unsigned* st;
};

__device__ __forceinline__ XcdBarrier xcd_barrier_post(unsigned* bar, volatile LAS unsigned* st) {
    XcdBarrier b; b.bar = bar; b.x = xb_xcc_id(); b.st = st;
    if (threadIdx.x == 0) (void)xb_add(&bar[XB_XCNT(b.x)], 1u);
    return b;
}
__device__ __forceinline__ void xcd_barrier_complete(unsigned* bar, unsigned x, unsigned& nloc, unsigned& nx) {
    const unsigned G = gridDim.x * gridDim.y * gridDim.z;
    unsigned sum, cnt, mine, sp = 0u;
    for (;;) {
        sum = 0u; cnt = 0u; mine = 0u;
#pragma unroll
        for (unsigned j = 0; j < 16; ++j) { const unsigned c = xb_ld(&bar[XB_XCNT(j)]); sum += c; cnt += (c > 0u) ? 1u : 0u; mine = (j == x) ? c : mine; }
        if (sum == G) break;
        __builtin_amdgcn_s_sleep(1);
        if ((++sp & 255u) == 0u) { if (xb_ld(&bar[XB_TMO])) break; if (sp > XB_SPIN_CAP) { atomicAdd(&bar[XB_TMO], 1u); break; } }
    }
    nloc = mine > 0u ? mine : 1u; nx = cnt > 0u ? cnt : 1u;
}

__device__ __forceinline__ void xcd_barrier(const XcdBarrier& b) {
    asm volatile("s_waitcnt vmcnt(0)" ::: "memory");
    __syncthreads();
    if (threadIdx.x == 0) {
        unsigned* bar = b.bar;
        __builtin_amdgcn_s_waitcnt(0);
        unsigned nloc = b.st[0], nx = b.st[1];
        if (nloc == 0u) { xcd_barrier_complete(bar, b.x, nloc, nx); b.st[0] = nloc; b.st[1] = nx; }
        const unsigned old = xb_add(&bar[XB_XSUB(b.x)], 1u);
        const unsigned gen = old / nloc;
        if (old + 1u == (gen + 1u) * nloc) {
            __builtin_amdgcn_fence(__ATOMIC_RELEASE, "agent");
            asm volatile("s_waitcnt vmcnt(0)" ::: "memory");
            const unsigned og = xb_add(&bar[XB_TOP], 1u);
            const unsigned tg = og / nx;
            if (og + 1u == (tg + 1u) * nx) xb_add(&bar[XB_TOPGEN], 1u);
            else XB_SPIN(xb_ld(&bar[XB_TOPGEN]) == tg, bar);
            __builtin_amdgcn_fence(__ATOMIC_ACQUIRE, "agent");
            xb_add(&bar[XB_XGEN(b.x)], 1u);
            asm volatile("s_waitcnt vmcnt(0)" ::: "memory");
        } else {
            XB_SPIN(xb_ld(&bar[XB_XGEN(b.x)]) == gen, bar);
            __builtin_amdgcn_fence(__ATOMIC_ACQUIRE, "agent");
            asm volatile("s_waitcnt vmcnt(0)" ::: "memory");
        }
    }
    __syncthreads();
}
constexpr size_t WS_BAR = WS_CTL + 16384;
constexpr size_t WS_QCTR = WS_CTL + 32768;
constexpr size_t CTL_ZERO_BYTES = 65536 - 16384;
constexpr int XB_LDS_OFF = MEGA_LDS - 64;
constexpr size_t WT_IN = 0;
constexpr size_t WT_BR = WT_IN + (size_t)13312 * 1024 * 2;
constexpr size_t WT_OUT = WT_BR + (size_t)4096 * 1024 * 2;
constexpr size_t WT_UP = WT_OUT + (size_t)1024 * 1024 * 2;
constexpr size_t WT_DN = WT_UP + (size_t)5632 * 1024 * 2;
static_assert(WT_DN + (size_t)1024 * 2816 * 2 <= 72 * MiB, "weight copies");
constexpr size_t WS_WKVT = WS_GATES;
constexpr size_t WS_CB = WS_CTL + 4096;

typedef float f32x4 __attribute__((ext_vector_type(4)));
typedef unsigned u32x4 __attribute__((ext_vector_type(4)));
typedef short bf16x8_t __attribute__((ext_vector_type(8)));
typedef float f32x16_t __attribute__((ext_vector_type(16)));
__device__ __forceinline__ unsigned pk2(float lo, float hi) { return (unsigned)f2bf(lo) | ((unsigned)f2bf(hi) << 16); }
__device__ __forceinline__ float blo(unsigned u) { return __uint_as_float(u << 16); }
__device__ __forceinline__ float bhi(unsigned u) { return __uint_as_float(u & 0xffff0000u); }
__device__ __forceinline__ float fast_softplus(float x) { return fmaxf(x, 0.f) + __logf(1.f + __expf(-fabsf(x))); }
__device__ __forceinline__ float fast_sigmoid(float x) { return __builtin_amdgcn_rcpf(1.f + __expf(-x)); }
__device__ __forceinline__ float fast_tanh(float x) { const float e = __expf(-2.f * fabsf(x)); const float t = (1.f - e) * __builtin_amdgcn_rcpf(1.f + e); return x < 0.f ? -t : t; }
__device__ __forceinline__ float fast_gelu(float x) { const float u = 0.7978845608028654f * (x + 0.044715f * x * x * x); return 0.5f * x * (1.f + fast_tanh(u)); }

template <class Loc> struct LocOrder {
    pg8::StaticOrder so; Loc loc;
    __device__ __forceinline__ bool next(int i, pg8::Unit& u) const { return so.next(i, u); }
    __device__ __forceinline__ const char* aptr(const pg8::Unit& u) const { return loc.a(u); }
    __device__ __forceinline__ const char* bptr(const pg8::Unit& u) const { return loc.b(u); }
    __device__ __forceinline__ void a_ready(const pg8::Unit&) const {}
    __device__ __forceinline__ void done(const pg8::Unit&) const {}
};
struct LocStd { const char* A; const char* Bt; size_t astep, bstep;
    __device__ __forceinline__ const char* a(const pg8::Unit& u) const { return A + (size_t)u.pm * astep; }
    __device__ __forceinline__ const char* b(const pg8::Unit& u) const { return Bt + (size_t)u.pn * bstep; } };
struct LocBranch { const char* Y0; const char* Y1; const char* Y2; const char* Y3; const char* Bt;
    __device__ __forceinline__ const char* a(const pg8::Unit& u) const { const int i = u.pn >> 2; const char* y = i == 0 ? Y0 : i == 1 ? Y1 : i == 2 ? Y2 : Y3; return y + (size_t)u.pm * (256 * 1024 * 2); }
    __device__ __forceinline__ const char* b(const pg8::Unit& u) const { return Bt + (size_t)u.pn * (256 * 1024 * 2); } };
struct LocMemKV { const char* A; const char* Bt;
    __device__ __forceinline__ const char* a(const pg8::Unit& u) const { return A + (size_t)u.pm * (256 * 1024 * 2); }
    __device__ __forceinline__ const char* b(const pg8::Unit& u) const { return Bt + ((size_t)(u.pm >> 1) * 2048 + (size_t)u.pn * 256) * 2048; } };
struct LocMemS { const char* MQ; const char* MK;
    __device__ __forceinline__ const char* a(const pg8::Unit& u) const { return MQ + (size_t)u.pm * (256 * 2048) + u.pn * 512; }
    __device__ __forceinline__ const char* b(const pg8::Unit& u) const { return MK + (size_t)(u.pm >> 5) * (256 * 2048) + u.pn * 512; } };
struct LocMemPV { const char* E; const char* MVT;
    __device__ __forceinline__ const char* a(const pg8::Unit& u) const { return E + (size_t)u.pm * (256 * 2048) + u.pn * 512; }
    __device__ __forceinline__ const char* b(const pg8::Unit& u) const { return MVT + ((size_t)(u.pm >> 5) * 4 + u.pn) * (256 * 256 * 2); } };

struct BranchSched { int vcu; LocBranch loc;
    __device__ __forceinline__ bool next(int i, pg8::Unit& u) const { if (i >= 4) return false; u.pm = vcu >> 2; u.pn = i * 4 + (vcu & 3); return true; }
    __device__ __forceinline__ const char* aptr(const pg8::Unit& u) const { return loc.a(u); }
    __device__ __forceinline__ const char* bptr(const pg8::Unit& u) const { return loc.b(u); }
    __device__ __forceinline__ void a_ready(const pg8::Unit&) const {}
    __device__ __forceinline__ void done(const pg8::Unit&) const {}
};
typedef f32x4 AccT[2][2][4][2];
struct EpiProj { static constexpr bool PERM = true, AFTER_DRAIN = false; bf16_t* proj; bf16_t* gates; float* mqss;
    __device__ __forceinline__ void operator()(const AccT& acc, const pg8::Unit& u, int wr, int wc, int fr, int fq) const {
        int colt = u.pn * 256; const int grp = colt >> 10; bf16_t* base; int ldc;
        if (grp < 9) { base = proj + (size_t)grp * T * DM; ldc = DM; colt &= 1023; } else { base = gates; ldc = 4096; colt -= 9216; }
        const int row0 = u.pm * 256 + wr * 64 + fr, col0 = colt + wc * 32 + 8 * fq;
#pragma unroll
        for (int ai = 0; ai < 2; ++ai)
#pragma unroll
            for (int m = 0; m < 4; ++m) { const int row = row0 + ai * 128 + m * 16; bf16_t* rowp = base + (size_t)row * ldc + col0; float ss = 0.f;
#pragma unroll
                for (int bj = 0; bj < 2; ++bj) { const f32x4 v0 = acc[ai][bj][m][0], v1 = acc[ai][bj][m][1]; u32x4 w; w.x = pk2(v0[0], v0[1]); w.y = pk2(v0[2], v0[3]); w.z = pk2(v1[0], v1[1]); w.w = pk2(v1[2], v1[3]);
                    *(u32x4*)(rowp + bj * 128) = w;
                    if (grp == 8) { ss += blo(w.x) * blo(w.x) + bhi(w.x) * bhi(w.x) + blo(w.y) * blo(w.y) + bhi(w.y) * bhi(w.y) + blo(w.z) * blo(w.z) + bhi(w.z) * bhi(w.z) + blo(w.w) * blo(w.w) + bhi(w.w) * bhi(w.w); } }
                if (grp == 8) { ss += __shfl_xor(ss, 16); ss += __shfl_xor(ss, 32); if (fq == 0) mqss[(size_t)row * 16 + (colt >> 8) * 4 + wc] = ss; } }
    } };
struct EpiBf16P { static constexpr bool PERM = true, AFTER_DRAIN = false; bf16_t* O; int ldc; int pad;
    __device__ __forceinline__ void operator()(const AccT& acc, const pg8::Unit& u, int wr, int wc, int fr, int fq) const {
        const int row0 = u.pm * 256 + wr * 64 + fr, col0 = u.pn * 256 + wc * 32 + 8 * fq;
#pragma unroll
        for (int ai = 0; ai < 2; ++ai)
#pragma unroll
            for (int m = 0; m < 4; ++m) { bf16_t* rowp = O + (size_t)(row0 + ai * 128 + m * 16) * ldc + col0;
#pragma unroll
                for (int bj = 0; bj < 2; ++bj) { const f32x4 v0 = acc[ai][bj][m][0], v1 = acc[ai][bj][m][1]; u32x4 w; w.x = pk2(v0[0], v0[1]); w.y = pk2(v0[2], v0[3]); w.z = pk2(v1[0], v1[1]); w.w = pk2(v1[2], v1[3]);
                    *(u32x4*)(rowp + bj * 128) = w; } }
    } };
struct EpiF32 { static constexpr bool PERM = false, AFTER_DRAIN = false; float* O; int ldc; int pad;
    __device__ __forceinline__ void operator()(const AccT& acc, const pg8::Unit& u, int wr, int wc, int fr, int fq) const {
        const int row0 = u.pm * 256 + wr * 64 + fr, col0 = u.pn * 256 + wc * 32 + 4 * fq;
#pragma unroll
        for (int ai = 0; ai < 2; ++ai)
#pragma unroll
            for (int m = 0; m < 4; ++m) { float* rowp = O + (size_t)(row0 + ai * 128 + m * 16) * ldc + col0;
#pragma unroll
                for (int bj = 0; bj < 2; ++bj)
#pragma unroll
                    for (int n = 0; n < 2; ++n) *(f32x4*)(rowp + bj * 128 + n * 16) = acc[ai][bj][m][n]; }
    } };
struct EpiResid { static constexpr bool PERM = false, AFTER_DRAIN = false; const float* base; float* out;
    __device__ __forceinline__ void operator()(const AccT& acc, const pg8::Unit& u, int wr, int wc, int fr, int fq) const {
        const int row0 = u.pm * 256 + wr * 64 + fr, col0 = u.pn * 256 + wc * 32 + 4 * fq;
#pragma unroll
        for (int ai = 0; ai < 2; ++ai)
#pragma unroll
            for (int m = 0; m < 4; ++m) { const size_t off = (size_t)(row0 + ai * 128 + m * 16) * DM + col0;
#pragma unroll
                for (int bj = 0; bj < 2; ++bj)
#pragma unroll
                    for (int n = 0; n < 2; ++n) { const f32x4 b = *(const f32x4*)(base + off + bj * 128 + n * 16); *(f32x4*)(out + off + bj * 128 + n * 16) = b + acc[ai][bj][m][n]; } }
    } };
struct EpiBranch { static constexpr bool PERM = true, AFTER_DRAIN = false; const bf16_t* G; const float* bg; float* MIXF; bf16_t* MIXED;
    __device__ __forceinline__ void operator()(const AccT& acc, const pg8::Unit& u, int wr, int wc, int fr, int fq) const {
        const int i = u.pn >> 2, row0 = u.pm * 256 + wr * 64 + fr, gcol0 = u.pn * 256 + wc * 32 + 8 * fq, mcol0 = (u.pn & 3) * 256 + wc * 32 + 8 * fq;
#pragma unroll
        for (int ai = 0; ai < 2; ++ai)
#pragma unroll
            for (int m = 0; m < 4; ++m) { const int row = row0 + ai * 128 + m * 16; const bf16_t* gp = G + (size_t)row * 4096 + gcol0; const size_t mo = (size_t)row * DM + mcol0;
#pragma unroll
                for (int bj = 0; bj < 2; ++bj) { const u32x4 gw = *(const u32x4*)(gp + bj * 128); const f32x4 b0 = *(const f32x4*)(bg + gcol0 + bj * 128), b1 = *(const f32x4*)(bg + gcol0 + bj * 128 + 4);
                    f32x4 v0 = acc[ai][bj][m][0], v1 = acc[ai][bj][m][1];
                    v0[0] *= fast_sigmoid(blo(gw.x) + b0[0]); v0[1] *= fast_sigmoid(bhi(gw.x) + b0[1]); v0[2] *= fast_sigmoid(blo(gw.y) + b0[2]); v0[3] *= fast_sigmoid(bhi(gw.y) + b0[3]);
                    v1[0] *= fast_sigmoid(blo(gw.z) + b1[0]); v1[1] *= fast_sigmoid(bhi(gw.z) + b1[1]); v1[2] *= fast_sigmoid(blo(gw.w) + b1[2]); v1[3] *= fast_sigmoid(bhi(gw.w) + b1[3]);
                    if (i > 0) { v0 += *(const f32x4*)(MIXF + mo + bj * 128); v1 += *(const f32x4*)(MIXF + mo + bj * 128 + 4); }
                    if (i < 3) { *(f32x4*)(MIXF + mo + bj * 128) = v0; *(f32x4*)(MIXF + mo + bj * 128 + 4) = v1; }
                    else { u32x4 w; w.x = pk2(v0[0], v0[1]); w.y = pk2(v0[2], v0[3]); w.z = pk2(v1[0], v1[1]); w.w = pk2(v1[2], v1[3]); *(u32x4*)(MIXED + mo + bj * 128) = w; } }
                asm volatile("" ::: "memory"); }
    } };
struct EpiSexp { static constexpr bool PERM = true, AFTER_DRAIN = false; bf16_t* E; const float* mqss; float* esum; const float* cb;
    __device__ __forceinline__ void operator()(const AccT& acc, const pg8::Unit& u, int wr, int wc, int fr, int fq) const {
        const int row0 = u.pm * 256 + wr * 64 + fr, col0 = u.pn * 256 + wc * 32 + 8 * fq; const float shift = cb[0];
#pragma unroll
        for (int ai = 0; ai < 2; ++ai)
#pragma unroll
            for (int m = 0; m < 4; ++m) { const int row = row0 + ai * 128 + m * 16; const f32x4 p = *(const f32x4*)(mqss + (size_t)row * 16 + u.pn * 4);
                const float sc = rsqrtf(((p[0] + p[1]) + (p[2] + p[3])) * (1.f / 256.f) + EPS) * (1.f / 16.f); bf16_t* rowp = E + (size_t)row * DM + col0; float sum = 0.f;
#pragma unroll
                for (int bj = 0; bj < 2; ++bj) { const f32x4 v0 = acc[ai][bj][m][0], v1 = acc[ai][bj][m][1]; u32x4 w;
                    w.x = pk2(__expf(v0[0] * sc - shift), __expf(v0[1] * sc - shift)); w.y = pk2(__expf(v0[2] * sc - shift), __expf(v0[3] * sc - shift));
                    w.z = pk2(__expf(v1[0] * sc - shift), __expf(v1[1] * sc - shift)); w.w = pk2(__expf(v1[2] * sc - shift), __expf(v1[3] * sc - shift));
                    *(u32x4*)(rowp + bj * 128) = w;
                    sum += (blo(w.x) + bhi(w.x)) + (blo(w.y) + bhi(w.y)) + (blo(w.z) + bhi(w.z)) + (blo(w.w) + bhi(w.w)); }
                sum += __shfl_xor(sum, 16); sum += __shfl_xor(sum, 32); if (fq == 0) esum[(size_t)row * 16 + u.pn * 4 + wc] = sum;
                asm volatile("" ::: "memory"); }
    } };
struct EpiMemPV { static constexpr bool PERM = true, AFTER_DRAIN = false; bf16_t* Y; const float* esum;
    __device__ __forceinline__ void operator()(const AccT& acc, const pg8::Unit& u, int wr, int wc, int fr, int fq) const {
        const int row0 = u.pm * 256 + wr * 64 + fr, col0 = u.pn * 256 + wc * 32 + 8 * fq;
#pragma unroll
        for (int ai = 0; ai < 2; ++ai)
#pragma unroll
            for (int m = 0; m < 4; ++m) { const int row = row0 + ai * 128 + m * 16; const f32x4 p = *(const f32x4*)(esum + (size_t)row * 16 + u.pn * 4);
                const float il = 1.f / ((p[0] + p[1]) + (p[2] + p[3])); bf16_t* rowp = Y + (size_t)row * DM + col0;
#pragma unroll
                for (int bj = 0; bj < 2; ++bj) { const f32x4 v0 = acc[ai][bj][m][0] * il, v1 = acc[ai][bj][m][1] * il; u32x4 w; w.x = pk2(v0[0], v0[1]); w.y = pk2(v0[2], v0[3]); w.z = pk2(v1[0], v1[1]); w.w = pk2(v1[2], v1[3]);
                    *(u32x4*)(rowp + bj * 128) = w; }
                asm volatile("" ::: "memory"); }
    } };

__device__ __forceinline__ void tr_item(const float* __restrict__ W, int ldw, bf16_t* __restrict__ WT, int ldk, int nblk, LAS float* scr, int item, int lane, int ncopies, int cstride) {
    const int kb = item / nblk, nb = item % nblk, k0 = 64 * kb, n0 = 32 * nb;
#pragma unroll
    for (int i = 0; i < 32; ++i) { const int kk = 2 * i + (lane >> 5); scr[kk * 33 + (lane & 31)] = W[(size_t)(k0 + kk) * ldw + n0 + (lane & 31)]; }
    LDS_WAIT(); asm volatile("" ::: "memory");
    const int c = lane & 7;
#pragma unroll
    for (int j = 0; j < 4; ++j) { const int n = (lane >> 3) + 8 * j; const LAS float* s = scr + (8 * c) * 33 + n;
        u32x4 o; o.x = pk2(s[0 * 33], s[1 * 33]); o.y = pk2(s[2 * 33], s[3 * 33]); o.z = pk2(s[4 * 33], s[5 * 33]); o.w = pk2(s[6 * 33], s[7 * 33]);
        for (int cp = 0; cp < ncopies; ++cp) *(u32x4*)(WT + (size_t)(n0 + n) * ldk + k0 + 8 * c + cp * cstride) = o; }
    LDS_WAIT(); asm volatile("" ::: "memory");
}
__device__ __forceinline__ void norm_row(f32x4 (&v)[4], const float* __restrict__ g, bf16_t* __restrict__ hrow, const LAS float* WfT, bool do_logf, const float* __restrict__ bfg, float* __restrict__ LOGF, int row, int lane) {
    const f32x4* gr = (const f32x4*)g; float ss = 0.f;
#pragma unroll
    for (int j = 0; j < 4; ++j) ss += (v[j][0] * v[j][0] + v[j][1] * v[j][1]) + (v[j][2] * v[j][2] + v[j][3] * v[j][3]);
    ss = wave_sum(ss);
    const float rstd = rsqrtf(ss * (1.f / DM) + EPS);
#pragma unroll
    for (int j = 0; j < 4; ++j) { v[j] = v[j] * rstd * gr[lane + 64 * j];
        uint2 o; o.x = pk2(v[j][0], v[j][1]); o.y = pk2(v[j][2], v[j][3]); ((uint2*)hrow)[lane + 64 * j] = o; }
    if (do_logf) {
        float p[16];
#pragma unroll
        for (int h = 0; h < 16; ++h) { float a = 0.f;
#pragma unroll
            for (int j = 0; j < 4; ++j) { const f32x4 w = *(const LAS f32x4*)(WfT + h * 1024 + (lane + 64 * j) * 4); a += (v[j][0] * w[0] + v[j][1] * w[1]) + (v[j][2] * w[2] + v[j][3] * w[3]); }
            p[h] = a; if ((h & 3) == 3) __builtin_amdgcn_sched_barrier(0); }
        const bool b5 = lane & 32, b4 = lane & 16, b3 = lane & 8, b2 = lane & 4;
        float q8[8], q4[4], q2[2];
#pragma unroll
        for (int i = 0; i < 8; ++i) { const float send = b5 ? p[i] : p[i + 8], keep = b5 ? p[i + 8] : p[i]; q8[i] = keep + __shfl_xor(send, 32); }
#pragma unroll
        for (int i = 0; i < 4; ++i) { const float send = b4 ? q8[i] : q8[i + 4], keep = b4 ? q8[i + 4] : q8[i]; q4[i] = keep + __shfl_xor(send, 16); }
#pragma unroll
        for (int i = 0; i < 2; ++i) { const float send = b3 ? q4[i] : q4[i + 2], keep = b3 ? q4[i + 2] : q4[i]; q2[i] = keep + __shfl_xor(send, 8); }
        float q1 = (b2 ? q2[1] : q2[0]) + __shfl_xor(b2 ? q2[0] : q2[1], 4);
        q1 += __shfl_xor(q1, 2); q1 += __shfl_xor(q1, 1);
        const int h = (b5 ? 8 : 0) + (b4 ? 4 : 0) + (b3 ? 2 : 0) + (b2 ? 1 : 0);
        if ((lane & 3) == 0) { const int b = row / SEQ, t = row % SEQ; LOGF[((size_t)b * 16 + h) * SEQ + t] = logsigmoidf(q1 + bfg[h]); }
    }
}
__device__ __forceinline__ void norm_rows(const float* __restrict__ x, int nrows, int gw, int NGW, const float* __restrict__ g, bf16_t* __restrict__ H, const LAS float* WfT, bool do_logf, const float* __restrict__ bfg, float* __restrict__ LOGF, int lane) {
    f32x4 nx[4];
    if (gw < nrows) {
#pragma unroll
        for (int j = 0; j < 4; ++j) nx[j] = ((const f32x4*)(x + (size_t)gw * DM))[lane + 64 * j]; }
    for (int m = gw; m < nrows; m += NGW) {
        f32x4 v[4];
#pragma unroll
        for (int j = 0; j < 4; ++j) v[j] = nx[j];
        if (m + NGW < nrows) {
#pragma unroll
            for (int j = 0; j < 4; ++j) nx[j] = ((const f32x4*)(x + (size_t)(m + NGW) * DM))[lane + 64 * j]; }
        norm_row(v, g, H + (size_t)m * DM, WfT, do_logf, bfg, LOGF, m, lane);
    }
}
__device__ __forceinline__ void headnorm64_row(bf16_t* row, const float* __restrict__ g, float scale, int lane) {
    u32x4* p = (u32x4*)row + lane * 2; u32x4 a = p[0], b = p[1];
    float v[16] = {blo(a.x), bhi(a.x), blo(a.y), bhi(a.y), blo(a.z), bhi(a.z), blo(a.w), bhi(a.w), blo(b.x), bhi(b.x), blo(b.y), bhi(b.y), blo(b.z), bhi(b.z), blo(b.w), bhi(b.w)};
    float ss = 0.f;
#pragma unroll
    for (int i = 0; i < 16; ++i) ss += v[i] * v[i];
    ss += __shfl_xor(ss, 1); ss += __shfl_xor(ss, 2);
    const float rstd = rsqrtf(ss * (1.f / 64.f) + EPS) * scale; const f32x4* gp = (const f32x4*)(g + (lane & 3) * 16);
#pragma unroll
    for (int i = 0; i < 4; ++i) { const f32x4 gg = gp[i]; v[4 * i] *= rstd * gg[0]; v[4 * i + 1] *= rstd * gg[1]; v[4 * i + 2] *= rstd * gg[2]; v[4 * i + 3] *= rstd * gg[3]; }
    a.x = pk2(v[0], v[1]); a.y = pk2(v[2], v[3]); a.z = pk2(v[4], v[5]); a.w = pk2(v[6], v[7]); b.x = pk2(v[8], v[9]); b.y = pk2(v[10], v[11]); b.z = pk2(v[12], v[13]); b.w = pk2(v[14], v[15]);
    p[0] = a; p[1] = b;
}
__device__ __forceinline__ void cumsum_block(const float* __restrict__ src, float* __restrict__ dst, LAS float* part, int tid) {
    const int lane = tid & 63, wave = tid >> 6; const f32x4* s4 = (const f32x4*)(src + tid * 16); float v[16]; float s = 0.f;
#pragma unroll
    for (int i = 0; i < 4; ++i) { const f32x4 x = s4[i]; s += x[0]; v[4 * i] = s; s += x[1]; v[4 * i + 1] = s; s += x[2]; v[4 * i + 2] = s; s += x[3]; v[4 * i + 3] = s; }
    float incl = s;
#pragma unroll
    for (int o = 1; o < 64; o <<= 1) { const float t_ = __shfl_up(incl, o); if (lane >= o) incl += t_; }
    __syncthreads();
    if (lane == 63) part[wave] = incl;
    __syncthreads();
    float off = incl - s;
    for (int w = 0; w < wave; ++w) off += part[w];
    f32x4* d4 = (f32x4*)(dst + tid * 16);
#pragma unroll
    for (int i = 0; i < 4; ++i) d4[i] = (f32x4){off + v[4 * i], off + v[4 * i + 1], off + v[4 * i + 2], off + v[4 * i + 3]};
}

__device__ __forceinline__ float neg_expm1_small(float x) {
    const float p = -x * (1.f + x * (0.5f + x * (0.16666667f + x * (0.041666668f + x * (0.0083333338f + x * 0.0013888889f)))));
    return x > -0.25f ? p : 1.f - __expf(x);
}
constexpr int LRU_XCB = 0, LRU_WT = 9216, LRU_R = LRU_WT + 18432, LRU_SEG = LRU_R + 33792;
template <bool FINAL> __device__ __forceinline__ void lru_load(int it, int n, const bf16_t* __restrict__ LX, const bf16_t* __restrict__ LG, float (&xw)[11], float (&gl)[8], int tid) {
    const int b = it >> 11, c = (it >> 4) & 127, e = tid & 63, tg = tid >> 6, ch = n * 64 + e, t0 = c * 64 + tg * 8;
#pragma unroll
    for (int j = 0; j < 11; ++j) { const int t = t0 + j - 3; xw[j] = t >= 0 ? bf2f(LX[((size_t)b * SEQ + t) * DM + ch]) : 0.f; }
    if (FINAL) {
#pragma unroll
        for (int j = 0; j < 8; ++j) gl[j] = bf2f(LG[((size_t)b * SEQ + t0 + j) * DM + ch]); }
}
template <bool FINAL> __device__ __forceinline__ void lru_item(int b, int c, int n, const float (&xw)[11], const float (&gl)[8], bf16_t* __restrict__ YL,
        const float w0, const float w1, const float w2, const float w3, const float bc, const float bA, const float bX,
        const float spl, float* APROD, float* HEND, LAS unsigned char* lds, int tid, int kseg) {
    const int e = tid & 63, tg = tid >> 6, ch = n * 64 + e, lane = e, wv = tg;
    LAS float* R = (LAS float*)(lds + LRU_R);
    LAS float* segP = (LAS float*)(lds + LRU_SEG);
    LAS float* segH = segP + 512, *carP = segH + 512 + (b * 8) * 64, *carH = carP + 1024;
    const int t0 = c * 64 + tg * 8; const size_t row0 = (size_t)b * SEQ + t0;
    float xc[8];
#pragma unroll
    for (int j = 0; j < 8; ++j) { xc[j] = bc + w3 * xw[j + 3] + w2 * xw[j + 2] + w1 * xw[j + 1] + w0 * xw[j]; *(LAS bf16_t*)(lds + LRU_XCB + (tg * 8 + j) * 144 + e * 2) = f2bf(xc[j]); }
    LDS_BAR();
    { const int th = wv & 1, cb = wv >> 1, r32 = lane & 31, hi = lane >> 5; f32x16_t acc = {};
#pragma unroll
        for (int ks = 0; ks < 4; ++ks) { const bf16x8_t af = *(const LAS bf16x8_t*)(lds + LRU_XCB + (32 * th + r32) * 144 + (16 * ks + 8 * hi) * 2), bfr = *(const LAS bf16x8_t*)(lds + LRU_WT + (32 * cb + r32) * 144 + (16 * ks + 8 * hi) * 2);
            acc = __builtin_amdgcn_mfma_f32_32x32x16_bf16(af, bfr, acc, 0, 0, 0); }
#pragma unroll
        for (int r = 0; r < 16; ++r) R[(32 * th + (r & 3) + 8 * (r >> 2) + 4 * hi) * 132 + 32 * cb + r32] = acc[r]; }
    LDS_BAR();
    float av[8], uv[8]; float P = 1.f, Hh = 0.f;
#pragma unroll
    for (int j = 0; j < 8; ++j) { const float ra = bA + R[(tg * 8 + j) * 132 + e], ri = bX + R[(tg * 8 + j) * 132 + 64 + e];
        const float rr = fast_sigmoid(ra), ii = fast_sigmoid(ri); const float la = -8.f * rr * spl; av[j] = __expf(la); uv[j] = __builtin_amdgcn_sqrtf(neg_expm1_small(2.f * la)) * (ii * xc[j]);
        Hh = av[j] * Hh + uv[j]; P *= av[j]; }
    segP[tg * 64 + e] = P; segH[tg * 64 + e] = Hh;
    LDS_BAR();
    if (FINAL) {
        float h = 0.f;
        for (int s = 0; s <= kseg; ++s) h = carP[s * 64 + e] * h + carH[s * 64 + e];
        for (int t2 = 0; t2 < tg; ++t2) h = segP[t2 * 64 + e] * h + segH[t2 * 64 + e];
#pragma unroll
        for (int j = 0; j < 8; ++j) { h = av[j] * h + uv[j]; YL[(row0 + j) * DM + ch] = f2bf(h * fast_gelu(gl[j])); }
    } else if (tg == 7) {
        float h = 0.f, p = 1.f;
#pragma unroll
        for (int s = 0; s < 8; ++s) { h = segP[s * 64 + e] * h + segH[s * 64 + e]; p *= segP[s * 64 + e]; }
        const size_t si = ((size_t)b * 128 + c) * DM + ch; APROD[si] = p; HEND[si] = h;
    }
}
template <bool FINAL> __device__ __forceinline__ void lru_pass(int l, int bx, int G, const float* const* in, const bf16_t* LX, const bf16_t* LG, bf16_t* YL, float* APROD, float* HEND, LAS unsigned char* lds, int tid) {
    const int n = bx & 15, e = tid & 63, ch = n * 64 + e;
    { const float* wa = in[10] + (size_t)l * 65536 + (size_t)n * 4096; const float* wx = in[12] + (size_t)l * 65536 + (size_t)n * 4096;
        for (int i = tid; i < 8192; i += MEGA_THREADS) { const int mat = i >> 12, d = (i >> 6) & 63, ee = i & 63; *(LAS bf16_t*)(lds + LRU_WT + (mat * 64 + ee) * 144 + d * 2) = f2bf(mat ? wx[i & 4095] : wa[i & 4095]); } }
    const float* cw = in[8] + (size_t)l * 4 * DM; const float w0 = cw[ch], w1 = cw[DM + ch], w2 = cw[2 * DM + ch], w3 = cw[3 * DM + ch], bc = in[9][l * DM + ch];
    const float bA = in[11][l * DM + ch], bX = in[13][l * DM + ch], spl = softplusf(-in[14][l * DM + ch]);
    if (FINAL) {
        const int c0 = bx >> 4, tg = tid >> 6; LAS float* carP = (LAS float*)(lds + LRU_SEG) + 1024, *carH = carP + 1024;
#pragma unroll
        for (int b = 0; b < 2; ++b) { const int lo = tg == 0 ? 0 : c0 + 16 * (tg - 1), hi = c0 + 16 * tg; float A[16], Hc[16];
#pragma unroll
            for (int i = 0; i < 16; ++i) { const int cc = lo + i; const bool ok = cc < hi; const size_t si = ((size_t)b * 128 + (ok ? cc : 0)) * DM + ch; A[i] = ok ? APROD[si] : 1.f; Hc[i] = ok ? HEND[si] : 0.f; }
            float cp = 1.f, chh = 0.f;
#pragma unroll
            for (int i = 0; i < 16; ++i) { chh = A[i] * chh + Hc[i]; cp *= A[i]; }
            carP[(b * 8 + tg) * 64 + e] = cp; carH[(b * 8 + tg) * 64 + e] = chh; }
    }
    float xwn[11], gln[8];
#pragma unroll
    for (int j = 0; j < 8; ++j) gln[j] = 0.f;
    lru_load<FINAL>(bx, n, LX, LG, xwn, gln, tid);
    __syncthreads();
    for (int it = bx; it < 4096; it += G) {
        float xw[11], gl[8];
#pragma unroll
        for (int j = 0; j < 11; ++j) xw[j] = xwn[j];
#pragma unroll
        for (int j = 0; j < 8; ++j) gl[j] = gln[j];
        if (it + G < 4096) lru_load<FINAL>(it + G, n, LX, LG, xwn, gln, tid);
        lru_item<FINAL>(it >> 11, (it >> 4) & 127, n, xw, gl, YL, w0, w1, w2, w3, bc, bA, bX, spl, APROD, HEND, lds, tid, ((it >> 4) & 127) >> 4);
    }
    __syncthreads();
}

__device__ __forceinline__ void sb_wave(int b, int h, int qw0, const bf16_t* Q, const bf16_t* __restrict__ K, const bf16_t* __restrict__ V, bf16_t* O, LAS unsigned char* vl, int lane) {
    const int r32 = lane & 31, hi = lane >> 5; const size_t rowbase = (size_t)b * SEQ;
    const bf16_t* Qw = Q + (rowbase + qw0) * DM + h * 64;
    bf16x8_t qr[4];
#pragma unroll
    for (int d0 = 0; d0 < 4; ++d0) qr[d0] = *(const bf16x8_t*)(Qw + (size_t)r32 * DM + d0 * 16 + hi * 8);
    const bf16_t* Kh = K + rowbase * DM + h * 64; const bf16_t* Vh = V + rowbase * DM + h * 64;
    f32x16_t o0 = {}, o1 = {}; float R = 0.f; const int qabs = qw0 + r32;
    int kt = qw0 >> 5;
    bf16x8_t kf[4]; u32x4 vr[4];
#define SB_LOAD(KF, VR, kt_) do { _Pragma("unroll") for (int d0 = 0; d0 < 4; ++d0) KF[d0] = *(const bf16x8_t*)(Kh + (size_t)((kt_) * 32 + r32) * DM + d0 * 16 + hi * 8); \
        _Pragma("unroll") for (int it = 0; it < 4; ++it) { const int chunk = lane + 64 * it; VR[it] = *(const u32x4*)(Vh + (size_t)((kt_) * 32 + (chunk >> 3)) * DM + (chunk & 7) * 8); } } while (0)
    SB_LOAD(kf, vr, kt);
    const unsigned vbase = (unsigned)(size_t)vl;
    for (;;) {
        bf16x8_t kn[4]; u32x4 vn[4]; const bool more = kt > 0;
        if (more) SB_LOAD(kn, vn, kt - 1); else {
#pragma unroll
            for (int i = 0; i < 4; ++i) { kn[i] = kf[i]; vn[i] = vr[i]; } }
        f32x16_t st = {};
#pragma unroll
        for (int d0 = 0; d0 < 4; ++d0) st = __builtin_amdgcn_mfma_f32_32x32x16_bf16(kf[d0], qr[d0], st, 0, 0, 0);
#pragma unroll
        for (int it = 0; it < 4; ++it) { const int chunk = lane + 64 * it, row = chunk >> 3, c16 = chunk & 7; *(LAS u32x4*)(vl + (c16 >> 2) * 2048 + row * 64 + (c16 & 3) * 16) = vr[it]; }
        float l1[16], lb[16]; bool val[16];
#pragma unroll
        for (int r = 0; r < 16; ++r) { const int kv = kt * 32 + (r & 3) + 8 * (r >> 2) + 4 * hi; val[r] = kv < qabs; const float z = st[r] * 0.125f; const float sp = fast_softplus(z); l1[r] = val[r] ? -sp : 0.f; lb[r] = z - sp; }
        float w[16]; float tail = 0.f;
#pragma unroll
        for (int g = 3; g >= 0; --g) { const float qs = (l1[4 * g] + l1[4 * g + 1]) + (l1[4 * g + 2] + l1[4 * g + 3]); const float pq = __shfl_xor(qs, 32);
            const float after = tail + (hi == 0 ? pq : 0.f) + R; tail += qs + pq;
            const float e2 = l1[4 * g + 3], e1 = e2 + l1[4 * g + 2], e0 = e1 + l1[4 * g + 1];
            w[4 * g + 3] = val[4 * g + 3] ? __expf(lb[4 * g + 3] + after) : 0.f; w[4 * g + 2] = val[4 * g + 2] ? __expf(lb[4 * g + 2] + after + e2) : 0.f;
            w[4 * g + 1] = val[4 * g + 1] ? __expf(lb[4 * g + 1] + after + e1) : 0.f; w[4 * g] = val[4 * g] ? __expf(lb[4 * g] + after + e0) : 0.f; }
        R += tail;
        u32x4 p0, p1; p0.x = attn_body::cvtpk_s(w[0], w[1]); p0.y = attn_body::cvtpk_s(w[2], w[3]); p0.z = attn_body::cvtpk_s(w[4], w[5]); p0.w = attn_body::cvtpk_s(w[6], w[7]);
        p1.x = attn_body::cvtpk_s(w[8], w[9]); p1.y = attn_body::cvtpk_s(w[10], w[11]); p1.z = attn_body::cvtpk_s(w[12], w[13]); p1.w = attn_body::cvtpk_s(w[14], w[15]);
        const bf16x8_t pa0 = __builtin_bit_cast(bf16x8_t, p0), pa1 = __builtin_bit_cast(bf16x8_t, p1);
        const attn_body::lds_cptr vp = (attn_body::lds_cptr)vl + (4 * hi + ((lane & 15) >> 2)) * 64 + ((lane >> 4) & 1) * 32 + (lane & 3) * 8;
#define SB_VF(d0, s) ({ const attn_body::s16x4 lo_ = attn_body::vtr(vp + (d0) * 2048 + (s) * 1024), hi_ = attn_body::vtr(vp + (d0) * 2048 + (s) * 1024 + 512); \
            (bf16x8_t){lo_[0], lo_[1], lo_[2], lo_[3], hi_[0], hi_[1], hi_[2], hi_[3]}; })
        o0 = __builtin_amdgcn_mfma_f32_32x32x16_bf16(pa0, SB_VF(0, 0), o0, 0, 0, 0);
        o1 = __builtin_amdgcn_mfma_f32_32x32x16_bf16(pa0, SB_VF(1, 0), o1, 0, 0, 0);
        o0 = __builtin_amdgcn_mfma_f32_32x32x16_bf16(pa1, SB_VF(0, 1), o0, 0, 0, 0);
        o1 = __builtin_amdgcn_mfma_f32_32x32x16_bf16(pa1, SB_VF(1, 1), o1, 0, 0, 0);
        if (!more) break;
        if (__all(R < SB_THR)) break;
#pragma unroll
        for (int i = 0; i < 4; ++i) { kf[i] = kn[i]; vr[i] = vn[i]; }
        --kt;
    }
#undef SB_LOAD
#undef SB_VF
    (void)vbase;
    bf16_t* Ow = O + (rowbase + qw0) * DM + h * 64;
#pragma unroll
    for (int r = 0; r < 16; ++r) { const int q = (r & 3) + 8 * (r >> 2) + 4 * hi; Ow[(size_t)q * DM + r32] = f2bf(o0[r]); Ow[(size_t)q * DM + 32 + r32] = f2bf(o1[r]); }
}

#ifndef DBG_NOLOGF
#define DBG_NOLOGF 0
#endif
#ifndef EN_FOX
#define EN_FOX 1
#endif
#ifndef EN_SB
#define EN_SB 1
#endif
#ifndef EN_LRU
#define EN_LRU 1
#endif
#ifndef EN_GEMM
#define EN_GEMM 1
#endif
#ifndef EN_THIN
#define EN_THIN 1
#endif
enum { SUB_CONV = 1, SUB_NORM = 2, SUB_HEADNORM = 4, SUB_CUMSUM = 8, SUB_LRU = 16, SUB_SB = 32, SUB_MEM = 64, SUB_FOX = 128, SUB_ALL = 255 };
constexpr int N_PRO = 3, N_PER_LAYER = 10, N_PHASES = N_PRO + DEPTH * N_PER_LAYER;
struct MArgs { Ptrs P; int ph_lo, ph_hi, sub, pad; };

__global__ void __launch_bounds__(MEGA_THREADS, 2) mega(MArgs a) {
    extern __shared__ __attribute__((aligned(16))) unsigned char lds_raw[];
    LAS unsigned char* lds = (LAS unsigned char*)lds_raw;
    cg::grid_group grid = cg::this_grid();
    { volatile LAS unsigned* st0 = (volatile LAS unsigned*)(lds + XB_LDS_OFF); if (threadIdx.x == 0) { st0[0] = 0u; st0[1] = 0u; } __syncthreads();
      if (a.ph_hi - a.ph_lo > 2) (void)xcd_barrier_post((unsigned*)(a.P.ws + WS_BAR), st0); }
    for (int ph = a.ph_lo; ph < a.ph_hi; ++ph) {
    int tid = threadIdx.x; asm volatile("" : "+v"(tid));
    const int lane = tid & 63, wave = __builtin_amdgcn_readfirstlane(tid >> 6);
    int zs = 0; asm volatile("" : "+s"(zs));
    const int G = gridDim.x + zs, bx = blockIdx.x + zs, sub = a.sub + zs, vcu = (G % 8 == 0) ? (bx % 8) * (G / 8) + bx / 8 : bx;
    const int gw = vcu * NWV + wave, NGW = G * NWV;
    unsigned char* ws = a.P.ws + zs; const float* const* in = a.P.in + zs; float* out = a.P.out + zs;
    bf16_t* H = (bf16_t*)(ws + WS_H); bf16_t* PROJ = (bf16_t*)(ws + WS_PROJ); bf16_t* GATES = (bf16_t*)(ws + WS_GATES); bf16_t* Eb = (bf16_t*)(ws + WS_E);
    bf16_t *FQ = PROJ, *FK = PROJ + (size_t)T * DM, *FV = PROJ + 2 * (size_t)T * DM, *LX = PROJ + 3 * (size_t)T * DM, *LG = PROJ + 4 * (size_t)T * DM, *SQ = PROJ + 5 * (size_t)T * DM,
           *SK = PROJ + 6 * (size_t)T * DM, *SV = PROJ + 7 * (size_t)T * DM, *MQ = PROJ + 8 * (size_t)T * DM;
    bf16_t* YL = (bf16_t*)(ws + WS_YL);
    float *LOGF = (float*)(ws + WS_LOGF), *FB = (float*)(ws + WS_FB), *MQSS = (float*)(ws + WS_MQSS), *ESUM = (float*)(ws + WS_ESUM), *CB = (float*)(ws + WS_CB);
    bf16_t* MEMN = (bf16_t*)(ws + WS_MEMN); float* MEMRAW = (float*)(ws + WS_MEMRAW); bf16_t *MK = (bf16_t*)(ws + WS_MK), *MVT = (bf16_t*)(ws + WS_MVT);
    float *APROD = (float*)(ws + WS_LRU), *HEND = APROD + (size_t)BATCH * 128 * DM;
    bf16_t* WKVT = (bf16_t*)(ws + WS_WKVT);
    bf16_t *WIN_T = (bf16_t*)(ws + WS_WT + WT_IN), *WBR_T = (bf16_t*)(ws + WS_WT + WT_BR), *WOUT_T = (bf16_t*)(ws + WS_WT + WT_OUT), *WUP_T = (bf16_t*)(ws + WS_WT + WT_UP), *WDN_T = (bf16_t*)(ws + WS_WT + WT_DN);
    bf16_t *GV = (bf16_t*)(ws + WS_GV), *ACT = (bf16_t*)(ws + WS_ACT);

        if (ph < N_PRO) {
            if (ph == 0) {
                LAS float* scr = (LAS float*)(lds + wave * 8448);
                for (int it = gw; it < 4 * 1024; it += NGW) { const int l = it >> 10; tr_item(in[15] + (size_t)l * DM * 2048, 2048, WKVT + (size_t)l * 2048 * DM, DM, 64, scr, it & 1023, lane, 1, 0); }
                for (int l = 0; l < 4; ++l) norm_rows(in[1], 512, gw, NGW, in[3] + l * DM, MEMN + (size_t)l * 512 * DM, (const LAS float*)lds, false, nullptr, nullptr, lane);
            } else if (ph == 1) {
                LocOrder<LocMemKV> S; S.so.init(4 * 512, 2048, G, bx); S.loc = LocMemKV{(const char*)MEMN, (const char*)WKVT};
                if (EN_GEMM) pg8::gemm_phase<EpiF32, LocOrder<LocMemKV>, true, true>(lds, pg8::Gemm{DM, DM, DM}, S, EpiF32{MEMRAW, 2048, 0});
            } else {
                for (int m = gw; m < 4 * 512; m += NGW) { const int l = m >> 9, r = m & 511, b = r >> 8, mi = r & 255; const float* raw = MEMRAW + (size_t)m * 2048;
                    const f32x4 gk = *(const f32x4*)(in[17] + l * 256 + lane * 4), gq = *(const f32x4*)(in[16] + l * 256 + lane * 4); const f32x4 gg = gk * gq;
#pragma unroll
                    for (int h = 0; h < 4; ++h) { const f32x4 k = *(const f32x4*)(raw + h * 256 + lane * 4); const float ss = wave_sum((k[0] * k[0] + k[1] * k[1]) + (k[2] * k[2] + k[3] * k[3]));
                        const float rstd = rsqrtf(ss * (1.f / 256.f) + EPS); uint2 o; o.x = pk2(k[0] * rstd * gg[0], k[1] * rstd * gg[1]); o.y = pk2(k[2] * rstd * gg[2], k[3] * rstd * gg[3]);
                        *(uint2*)(MK + ((size_t)l * 512 + (size_t)b * 256 + mi) * DM + h * 256 + lane * 4) = o;
                        const f32x4 v = *(const f32x4*)(raw + 1024 + h * 256 + lane * 4); bf16_t* vt = MVT + (size_t)l * 512 * DM + (((size_t)b * 4 + h) * 256 + lane * 4) * 256 + mi;
                        vt[0] = f2bf(v[0]); vt[256] = f2bf(v[1]); vt[512] = f2bf(v[2]); vt[768] = f2bf(v[3]); }
                    if (r == 0) { float mx = fmaxf(fmaxf(fabsf(gg[0]), fabsf(gg[1])), fmaxf(fabsf(gg[2]), fabsf(gg[3])));
#pragma unroll
                        for (int o = 1; o < 64; o <<= 1) mx = fmaxf(mx, __shfl_xor(mx, o));
                        if (lane == 0) CB[l] = 16.f * mx; } }
            }
        } else {
            const int l = (ph - N_PRO) / N_PER_LAYER, sp = (ph - N_PRO) % N_PER_LAYER;
            const float* xcur = l == 0 ? in[0] : out;
            if (sp == 0) {
                if (sub & SUB_NORM) { LAS float* WfT = (LAS float*)lds; const float* wf = in[4] + (size_t)l * DM * NIN + 3072;
#pragma unroll 8
                    for (int i = tid; i < 16 * 1024; i += MEGA_THREADS) { const int k = i >> 4, h = i & 15; WfT[h * 1024 + k] = wf[(size_t)k * NIN + h]; } }
                __syncthreads();
                if (sub & SUB_CONV) { LAS float* scr = (LAS float*)(lds + 65536 + wave * 8448);
                    const float* win = in[4] + (size_t)l * DM * NIN;
                    for (int it = gw; it < 13440; it += NGW) { int r = it;
                        if (r < 1536) { tr_item(win, NIN, WIN_T, DM, 96, scr, r, lane, 1, 0); continue; } r -= 1536;
                        if (r < 5120) { tr_item(win + 3088, NIN, WIN_T + (size_t)3072 * DM, DM, 320, scr, r, lane, 1, 0); continue; } r -= 5120;
                        if (r < 2048) { const int i = r >> 9; tr_item(in[19] + ((size_t)l * 4 + i) * DM * DM, DM, WBR_T + (size_t)i * DM * DM, DM, 32, scr, r & 511, lane, 1, 0); continue; } r -= 2048;
                        if (r < 512) { tr_item(in[20] + (size_t)l * DM * DM, DM, WOUT_T, DM, 32, scr, r, lane, 1, 0); continue; } r -= 512;
                        if (r < 2816) { tr_item(in[22] + (size_t)l * DM * 2 * DFF, 2 * DFF, WUP_T, DM, 176, scr, r, lane, 1, 0); continue; } r -= 2816;
                        tr_item(in[25] + (size_t)l * DFF * DM, DM, WDN_T, DFF, 32, scr, r, lane, 1, 0); } }
                if (sub & SUB_NORM) norm_rows(xcur, T, gw, NGW, in[2] + l * DM, H, (const LAS float*)lds, !DBG_NOLOGF, in[5] + l * 16, LOGF, lane);
            } else if (sp == 1) {
                LocOrder<LocStd> S; S.so.init(T, 13312, G, bx); S.loc = LocStd{(const char*)H, (const char*)WIN_T, 256 * 1024 * 2, 256 * 1024 * 2};
                if (EN_GEMM) pg8::gemm_phase<EpiProj, LocOrder<LocStd>, true, true>(lds, pg8::Gemm{DM, DM, DM}, S, EpiProj{PROJ, GATES, MQSS});
            } else if (sp == 2) {
                if (sub & SUB_HEADNORM) { for (int m = gw; m < 2 * T; m += NGW) { if (m < T) headnorm64_row(FQ + (size_t)m * DM, in[6] + l * 64, C2, lane); else headnorm64_row(FK + (size_t)(m - T) * DM, in[7] + l * 64, 1.f, lane); } }
                if ((sub & SUB_CUMSUM) && bx < 32) cumsum_block(LOGF + (size_t)bx * SEQ, FB + (size_t)bx * SEQ, (LAS float*)lds, tid);
                __syncthreads();
                if (EN_LRU && (sub & SUB_LRU)) lru_pass<false>(l, bx, G, in, LX, LG, YL, APROD, HEND, lds, tid);
                if (EN_SB && (sub & SUB_SB)) for (int k = 0; k < 4; ++k) { const int bh = vcu >> 3, qb = (vcu & 7) * 4 + k; sb_wave(bh >> 4, bh & 15, qb * 256 + wave * 32, SQ, SK, SV, H, lds + wave * 4096, lane); }
                __syncthreads();
                if (sub & SUB_MEM) { LocOrder<LocMemS> S; S.so.init(T, 1024, G, bx); S.loc = LocMemS{(const char*)MQ, (const char*)(MK + (size_t)l * 512 * DM)};
                    if (EN_GEMM) pg8::gemm_phase<EpiSexp, LocOrder<LocMemS>, true, true>(lds, pg8::Gemm{DM, DM, 256 + zs}, S, EpiSexp{Eb, MQSS, ESUM, CB + l}); }
            } else if (sp == 3) {
                if (EN_FOX && (sub & SUB_FOX)) {
                    float gqm = fabsf(in[6][l * 64 + lane]), gkm = fabsf(in[7][l * 64 + lane]);
#pragma unroll
                    for (int o = 1; o < 64; o <<= 1) { gqm = fmaxf(gqm, __shfl_xor(gqm, o)); gkm = fmaxf(gkm, __shfl_xor(gkm, o)); }
                    const float thr = -(160.f + 2.f * C2 * 64.f * gqm * gkm);
                    const attn_body::AttnTensors AT{(const attn_body::bf16*)FQ, (const attn_body::bf16*)FK, (const attn_body::bf16*)FV, (attn_body::bf16*)SV, FB, thr, 0};
                    attn_body::QueueOrder S; S.ctr = (unsigned*)(ws + WS_QCTR) + (l * 8) * 64; S.xl = bx & 7; S.slot = (volatile LAS int*)(lds + XB_LDS_OFF + 16);
                    attn_body::attn_phase<attn_body::QueueOrder, 20>((char*)lds_raw, AT, S); }
                __syncthreads();
                if (EN_LRU && (sub & SUB_LRU)) lru_pass<true>(l, bx, G, in, LX, LG, YL, APROD, HEND, lds, tid);
                if (sub & SUB_MEM) { LocOrder<LocMemPV> S; S.so.init(T, 1024, G, bx); S.loc = LocMemPV{(const char*)Eb, (const char*)(MVT + (size_t)l * 512 * DM)};
                    if (EN_GEMM) pg8::gemm_phase<EpiMemPV, LocOrder<LocMemPV>, true, true>(lds, pg8::Gemm{DM, 256, 256 + zs}, S, EpiMemPV{MQ, ESUM}); }
            } else if (sp == 4) {
                BranchSched S; S.vcu = vcu; S.loc = LocBranch{(const char*)SV, (const char*)YL, (const char*)H, (const char*)MQ, (const char*)WBR_T};
                if (EN_GEMM) pg8::gemm_phase<EpiBranch, BranchSched, true, true>(lds, pg8::Gemm{DM, DM, DM}, S, EpiBranch{GATES, in[18] + (size_t)l * 4 * DM, (float*)(ws + WS_MIXF), (bf16_t*)(ws + WS_MIXED)});
            } else if (sp == 5) {
                LocOrder<LocStd> S; S.so.init(T, DM, G, bx); S.loc = LocStd{(const char*)(ws + WS_MIXED), (const char*)WOUT_T, 256 * 1024 * 2, 256 * 1024 * 2};
                if (EN_GEMM) pg8::gemm_phase<EpiResid, LocOrder<LocStd>, true, true>(lds, pg8::Gemm{DM, DM, DM}, S, EpiResid{xcur, out});
            } else if (sp == 6) {
                norm_rows(out, T, gw, NGW, in[21] + l * DM, H, (const LAS float*)lds, false, nullptr, nullptr, lane);
            } else if (sp == 7) {
                LocOrder<LocStd> S; S.so.init(T, 2 * DFF, G, bx); S.loc = LocStd{(const char*)H, (const char*)WUP_T, 256 * 1024 * 2, 256 * 1024 * 2};
                if (EN_GEMM) pg8::gemm_phase<EpiBf16P, LocOrder<LocStd>, true, true>(lds, pg8::Gemm{DM, DM, DM}, S, EpiBf16P{GV, 2 * DFF, 0});
            } else if (sp == 8) {
                const float* cw = in[23] + (size_t)l * 3 * DFF; const float* cbv = in[24] + l * DFF;
                for (int i = bx * MEGA_THREADS + tid; i < (T / 8) * (DFF / 8); i += G * MEGA_THREADS) { const int r0 = (i / (DFF / 8)) * 8, c = (i % (DFF / 8)) * 8, t0 = r0 % SEQ;
                    const bf16_t* gp = GV + (size_t)r0 * 2 * DFF + c; const u32x4 z4 = {0u, 0u, 0u, 0u};
                    const f32x4 wa0 = *(const f32x4*)(cw + c), wa1 = *(const f32x4*)(cw + c + 4), wb0 = *(const f32x4*)(cw + DFF + c), wb1 = *(const f32x4*)(cw + DFF + c + 4), wc0 = *(const f32x4*)(cw + 2 * DFF + c), wc1 = *(const f32x4*)(cw + 2 * DFF + c + 4);
                    const f32x4 bb0 = *(const f32x4*)(cbv + c), bb1 = *(const f32x4*)(cbv + c + 4);
                    u32x4 g2 = t0 >= 2 ? *(const u32x4*)(gp - 4 * DFF) : z4, g1 = t0 >= 1 ? *(const u32x4*)(gp - 2 * DFF) : z4;
                    u32x4 gg[8], vv[8];
#pragma unroll
                    for (int j = 0; j < 8; ++j) { gg[j] = *(const u32x4*)(gp + (size_t)j * 2 * DFF); vv[j] = *(const u32x4*)(gp + (size_t)j * 2 * DFF + DFF); }
#define ACT1(G0, G1, G2, VV, W0, W1, W2, BB) ({ const float pre_ = (BB) + (W2) * (G0) + (W1) * (G1) + (W0) * (G2); pre_ * fast_sigmoid(pre_) * (VV); })
#pragma unroll
                    for (int j = 0; j < 8; ++j) { const u32x4 g0 = gg[j], v_ = vv[j]; u32x4 o;
                        o.x = pk2(ACT1(blo(g0.x), blo(g1.x), blo(g2.x), blo(v_.x), wa0[0], wb0[0], wc0[0], bb0[0]), ACT1(bhi(g0.x), bhi(g1.x), bhi(g2.x), bhi(v_.x), wa0[1], wb0[1], wc0[1], bb0[1]));
                        o.y = pk2(ACT1(blo(g0.y), blo(g1.y), blo(g2.y), blo(v_.y), wa0[2], wb0[2], wc0[2], bb0[2]), ACT1(bhi(g0.y), bhi(g1.y), bhi(g2.y), bhi(v_.y), wa0[3], wb0[3], wc0[3], bb0[3]));
                        o.z = pk2(ACT1(blo(g0.z), blo(g1.z), blo(g2.z), blo(v_.z), wa1[0], wb1[0], wc1[0], bb1[0]), ACT1(bhi(g0.z), bhi(g1.z), bhi(g2.z), bhi(v_.z), wa1[1], wb1[1], wc1[1], bb1[1]));
                        o.w = pk2(ACT1(blo(g0.w), blo(g1.w), blo(g2.w), blo(v_.w), wa1[2], wb1[2], wc1[2], bb1[2]), ACT1(bhi(g0.w), bhi(g1.w), bhi(g2.w), bhi(v_.w), wa1[3], wb1[3], wc1[3], bb1[3]));
                        *(u32x4*)(ACT + (size_t)(r0 + j) * DFF + c) = o; g2 = g1; g1 = g0; }
#undef ACT1
                }
            } else {
                LocOrder<LocStd> S; S.so.init(T, DM, G, bx); S.loc = LocStd{(const char*)ACT, (const char*)WDN_T, 256 * DFF * 2, 256 * DFF * 2};
                if (EN_GEMM) pg8::gemm_phase<EpiResid, LocOrder<LocStd>, true, true>(lds, pg8::Gemm{DFF, DFF, DFF}, S, EpiResid{out, out});
            }
        }
        if (ph + 1 < a.ph_hi) {
            if (ph == a.ph_lo) grid.sync();
            else { XcdBarrier xb; xb.bar = (unsigned*)(ws + WS_BAR); xb.x = xb_xcc_id(); xb.st = (volatile LAS unsigned*)(lds + XB_LDS_OFF); xcd_barrier(xb); }
        }
    }
}
enum { C_PRO = 1, C_NORM = 2, C_WIN = 4, C_HN = 8, C_LRU = 16, C_SB = 32, C_MEM = 64, C_FOX = 128, C_BR = 256, C_WOUT = 512, C_NORM2 = 1024, C_UP = 2048, C_ACT = 4096, C_DOWN = 8192, C_ONE = 16384 };
#ifndef CFG
#define CFG 32767
#endif
#ifndef REPEAT_SP
#define REPEAT_SP (-1)
#define REPEAT_N 0
#define REPEAT_SUB 0
#endif
static int g_grid = 0;
static void launch_mega(const Ptrs& P, int lo, int hi, int sub, hipStream_t st, bool coop) {
    MArgs a{}; a.P = P; a.ph_lo = lo; a.ph_hi = hi; a.sub = sub; a.pad = 0;
    if (coop) { void* args[] = {&a}; const hipError_t e = hipLaunchCooperativeKernel((const void*)mega, dim3(g_grid), dim3(MEGA_THREADS), args, MEGA_LDS, st);
        if (e != hipSuccess) fprintf(stderr, "cooperative launch failed: %s (grid %d)\n", hipGetErrorString(e), g_grid); }
    else { hipLaunchKernelGGL(mega, dim3(g_grid), dim3(MEGA_THREADS), MEGA_LDS, st, a);
        if (REPEAT_N > 0 && hi == lo + 1 && lo >= N_PRO && (lo - N_PRO) % N_PER_LAYER == (REPEAT_SP)) { a.sub = (REPEAT_SUB); for (int r = 0; r < (REPEAT_N); ++r) hipLaunchKernelGGL(mega, dim3(g_grid), dim3(MEGA_THREADS), MEGA_LDS, st, a); } }
}
static void run_hybrid(const Ptrs& P, hipStream_t st) {
    unsigned char* ws = P.ws;
    bf16_t* H = (bf16_t*)(ws + WS_H);
    bf16_t* PR[9]; for (int i = 0; i < 9; ++i) PR[i] = (bf16_t*)(ws + WS_PROJ + i * SZ_ACT);
    bf16_t *FQ = PR[0], *FK = PR[1], *FV = PR[2], *LX = PR[3], *LG = PR[4], *SQ = PR[5], *SK = PR[6], *SV = PR[7], *MQ = PR[8];
    bf16_t* GATES = (bf16_t*)(ws + WS_GATES);
    bf16_t *YL = (bf16_t*)(ws + WS_YL), *YS = (bf16_t*)(ws + WS_YS), *YM = (bf16_t*)(ws + WS_YM), *YF = (bf16_t*)(ws + WS_YF);
    float *LOGF = (float*)(ws + WS_LOGF), *FB = (float*)(ws + WS_FB);
    bf16_t* MEMN = (bf16_t*)(ws + WS_MEMN); float* MEMRAW = (float*)(ws + WS_MEMRAW);
    bf16_t *MK = (bf16_t*)(ws + WS_MK), *MVT = (bf16_t*)(ws + WS_MVT);
    bf16_t *GV = (bf16_t*)(ws + WS_GV), *ACT = (bf16_t*)(ws + WS_ACT);
    const float* const* in = P.in;
    const int cfg = CFG;
    const bool anygemm = cfg & (C_WIN | C_BR | C_WOUT | C_UP | C_DOWN);
    if (cfg & C_PRO) { for (int p = 0; p < 3; ++p) launch_mega(P, p, p + 1, SUB_ALL, st, false); }
    else for (int l = 0; l < DEPTH; ++l) {
        n_rmsnorm<<<512 / 4, 256, 0, st>>>(in[1], in[3] + l * DM, MEMN + (size_t)l * 512 * DM, nullptr, nullptr, nullptr, 512);
        n_gemm<EStoreF32><<<dim3(2048 / 64, 512 / 64), 256, 0, st>>>(MEMN + (size_t)l * 512 * DM, in[15] + (size_t)l * DM * 2048, DM, 2048, DM, 0x7fffffff, EStoreF32{MEMRAW + (size_t)l * 512 * 2048, 2048, 0});
        n_memkv_post<<<512, 256, 0, st>>>(MEMRAW + (size_t)l * 512 * 2048, in[17] + l * 256, in[16] + l * 256, MK + (size_t)l * 512 * DM, MVT + (size_t)l * 512 * DM);
    }
    for (int l = 0; l < DEPTH; ++l) {
        const int p0 = N_PRO + l * N_PER_LAYER;
        const float* xcur = l == 0 ? in[0] : P.out;
        const float* win = in[4] + (size_t)l * DM * NIN;
        if (DBG_NOLOGF) n_rmsnorm<<<T / 4, 256, 0, st>>>(xcur, in[2] + l * DM, H, win + 3072, in[5] + l * 16, LOGF, T);
        { const int sub = (anygemm ? SUB_CONV : 0) | ((cfg & C_NORM) ? SUB_NORM : 0); if (sub) launch_mega(P, p0, p0 + 1, sub, st, false); }
        if (!(cfg & C_NORM)) n_rmsnorm<<<T / 4, 256, 0, st>>>(xcur, in[2] + l * DM, H, win + 3072, in[5] + l * 16, LOGF, T);
        if (cfg & C_WIN) launch_mega(P, p0 + 1, p0 + 2, SUB_ALL, st, false);
        else { for (int gI = 0; gI < 9; ++gI) { const int coff = gI < 3 ? gI * 1024 : gI * 1024 + 16;
                n_gemm<EStoreBf16><<<dim3(1024 / 64, T / 64), 256, 0, st>>>(H, win + coff, DM, NIN, DM, 0x7fffffff, EStoreBf16{PR[gI], DM, 0}); }
            n_gemm<EStoreBf16><<<dim3(4096 / 64, T / 64), 256, 0, st>>>(H, win + 9232, DM, NIN, DM, 0x7fffffff, EStoreBf16{GATES, 4096, 0}); }
        if (!(cfg & C_HN)) { n_headnorm<<<T * 16 / 256, 256, 0, st>>>(FQ, in[6] + l * 64, 64, C2); n_headnorm<<<T * 16 / 256, 256, 0, st>>>(FK, in[7] + l * 64, 64, 1.f); n_cumsum<<<32, 1024, 0, st>>>(LOGF, FB); }
        const int sub23 = ((cfg & C_HN) ? (SUB_HEADNORM | SUB_CUMSUM) : 0) | ((cfg & C_LRU) ? SUB_LRU : 0) | ((cfg & C_SB) ? SUB_SB : 0) | ((cfg & C_MEM) ? SUB_MEM : 0) | ((cfg & C_FOX) ? SUB_FOX : 0);
        if (sub23 & ~SUB_FOX) launch_mega(P, p0 + 2, p0 + 3, sub23, st, false);
        if (!(cfg & C_SB)) n_sb_attn<<<dim3(SEQ / 256, 32), 256, 0, st>>>(SQ, SK, SV, YS);
        if (!(cfg & C_LRU)) n_lru<<<32, 64, 0, st>>>(LX, LG, in[8] + (size_t)l * 4 * DM, in[9] + l * DM, in[10] + (size_t)l * 16 * 64 * 64, in[11] + l * DM, in[12] + (size_t)l * 16 * 64 * 64, in[13] + l * DM, in[14] + l * DM, YL);
        if (!(cfg & C_MEM)) n_mem_attn<<<T * 4, 256, 0, st>>>(MQ, MK + (size_t)l * 512 * DM, MVT + (size_t)l * 512 * DM, YM);
        if (sub23 & (SUB_FOX | SUB_LRU | SUB_MEM)) launch_mega(P, p0 + 3, p0 + 4, sub23, st, false);
        if (!(cfg & C_FOX)) n_fox_attn<<<dim3(SEQ / 256, 32), 256, 0, st>>>(FQ, FK, FV, FB, YF);
        if (cfg & C_BR) launch_mega(P, p0 + 4, p0 + 5, SUB_ALL, st, false);
        else { const bf16_t* Y[4] = {YF, YL, YS, YM};
            for (int i = 0; i < 4; ++i) n_gemm<EBranch><<<dim3(1024 / 64, T / 64), 256, 0, st>>>(Y[i], in[19] + ((size_t)l * 4 + i) * DM * DM, DM, DM, DM, 0x7fffffff, EBranch{GATES, in[18] + ((size_t)l * 4 + i) * DM, (float*)(ws + WS_MIXF), (bf16_t*)(ws + WS_MIXED), i, 0}); }
        if (cfg & C_WOUT) launch_mega(P, p0 + 5, p0 + 6, SUB_ALL, st, false);
        else n_gemm<EResid><<<dim3(1024 / 64, T / 64), 256, 0, st>>>((const bf16_t*)(ws + WS_MIXED), in[20] + (size_t)l * DM * DM, DM, DM, DM, 0x7fffffff, EResid{xcur, P.out});
        if (cfg & C_NORM2) launch_mega(P, p0 + 6, p0 + 7, SUB_ALL, st, false);
        else n_rmsnorm<<<T / 4, 256, 0, st>>>(P.out, in[21] + l * DM, H, nullptr, nullptr, nullptr, T);
        if (cfg & C_UP) launch_mega(P, p0 + 7, p0 + 8, SUB_ALL, st, false);
        else n_gemm<EStoreBf16><<<dim3(2 * DFF / 64, T / 64), 256, 0, st>>>(H, in[22] + (size_t)l * DM * 2 * DFF, DM, 2 * DFF, DM, 0x7fffffff, EStoreBf16{GV, 2 * DFF, 0});
        if (cfg & C_ACT) launch_mega(P, p0 + 8, p0 + 9, SUB_ALL, st, false);
        else n_act<<<(unsigned)(((size_t)T * DFF + 255) / 256), 256, 0, st>>>(GV, in[23] + (size_t)l * 3 * DFF, in[24] + l * DFF, ACT);
        if (cfg & C_DOWN) launch_mega(P, p0 + 9, p0 + 10, SUB_ALL, st, false);
        else n_gemm<EResid><<<dim3(1024 / 64, T / 64), 256, 0, st>>>(ACT, in[25] + (size_t)l * DFF * DM, DFF, DM, DFF, 0x7fffffff, EResid{P.out, P.out});
    }
}

extern "C" void kernel_launch(void* const* d_in, const int* in_sizes, int n_in, void* d_out, int out_size, void* d_ws, size_t ws_size, hipStream_t stream) {
    if (n_in != 26 || out_size != T * DM || ws_size < WS_NEED) { fprintf(stderr, "kernel_launch: unexpected sizes n_in %d out %d ws %zu (need %zu)\n", n_in, out_size, ws_size, (size_t)WS_NEED); return; }
    if (g_grid == 0) {
        int dev = 0, cus = 0, per_cu = 0;
        hipGetDevice(&dev); hipDeviceGetAttribute(&cus, hipDeviceAttributeMultiprocessorCount, dev);
        if (hipFuncSetAttribute((const void*)mega, hipFuncAttributeMaxDynamicSharedMemorySize, MEGA_LDS) != hipSuccess) fprintf(stderr, "kernel_launch: hipFuncSetAttribute failed\n");
        if (hipOccupancyMaxActiveBlocksPerMultiprocessor(&per_cu, (const void*)mega, MEGA_THREADS, MEGA_LDS) != hipSuccess || per_cu < 1) fprintf(stderr, "kernel_launch: occupancy query says %d\n", per_cu);
        (void)hipGetLastError();
        g_grid = cus;
        if (g_grid != 256) fprintf(stderr, "kernel_launch: %d CUs; the attention phase's static order assumes 256\n", g_grid);
    }
    Ptrs P{};
    for (int i = 0; i < 26; ++i) P.in[i] = (const float*)d_in[i];
    P.out = (float*)d_out; P.ws = (unsigned char*)d_ws;
    if ((CFG) & C_ONE) { (void)hipMemsetAsync((char*)d_ws + WS_BAR, 0, CTL_ZERO_BYTES, stream);
        launch_mega(P, 0, N_PHASES, SUB_ALL, stream, true); }
    else { (void)hipMemsetAsync((char*)d_ws + WS_BAR, 0, CTL_ZERO_BYTES, stream); run_hybrid(P, stream); }
}
```

```cpp
#include <hip/hip_runtime.h>
#include <cstdio>
#include <cstdint>
#include <hip/hip_cooperative_groups.h>

typedef unsigned short bf16_t;
constexpr int BATCH = 2, SEQ = 8192, DM = 1024, DEPTH = 4, T = BATCH * SEQ;
constexpr int NMEM = 256, NIN = 13328, DFF = 2816;
constexpr float EPS = 1e-6f;
constexpr float LOG2E = 1.4426950408889634f;
constexpr float C2 = 0.125f * LOG2E;
constexpr float SB_THR = -104.0f;

__device__ __forceinline__ float bf2f(bf16_t b) { return __uint_as_float(((unsigned)b) << 16); }
__device__ __forceinline__ bf16_t f2bf(float f) { unsigned u = __float_as_uint(f); return (bf16_t)((u + 0x7fffu + ((u >> 16) & 1u)) >> 16); }
__device__ __forceinline__ float bfr(float f) { return bf2f(f2bf(f)); }
__device__ __forceinline__ float wave_sum(float v) {
#pragma unroll
    for (int o = 1; o < 64; o <<= 1) v += __shfl_xor(v, o);
    return v;
}
__device__ __forceinline__ float softplusf(float x) { return fmaxf(x, 0.f) + log1pf(__expf(-fabsf(x))); }
__device__ __forceinline__ float logsigmoidf(float x) { return -softplusf(-x); }
__device__ __forceinline__ float sigmoidf_(float x) { return 1.f / (1.f + __expf(-x)); }
__device__ __forceinline__ float gelu_tanh(float x) { const float u = 0.7978845608028654f * (x + 0.044715f * x * x * x); return 0.5f * x * (1.f + tanhf(u)); }

__device__ __forceinline__ int mk_tid() { int t = threadIdx.x; asm volatile("" : "+v"(t)); return t; }

constexpr size_t MiB = 1u << 20;
constexpr size_t SZ_ACT = (size_t)T * DM * 2;
constexpr size_t WS_CTL = 0;
constexpr size_t WS_H = 1 * MiB;
constexpr size_t WS_PROJ = WS_H + SZ_ACT;
constexpr size_t WS_GATES = WS_PROJ + 9 * SZ_ACT;
constexpr size_t WS_E = WS_GATES + 4 * SZ_ACT;
constexpr size_t WS_LOGF = WS_E + SZ_ACT;
constexpr size_t WS_FB = WS_LOGF + 1 * MiB;
constexpr size_t WS_MQSS = WS_FB + 1 * MiB;
constexpr size_t WS_ESUM = WS_MQSS + 1 * MiB;
constexpr size_t WS_MEMN = WS_ESUM + 1 * MiB;
constexpr size_t WS_MEMRAW = WS_MEMN + 4 * MiB;
constexpr size_t WS_MK = WS_MEMRAW + 16 * MiB;
constexpr size_t WS_MVT = WS_MK + 4 * MiB;
constexpr size_t WS_LRU = WS_MVT + 4 * MiB;
constexpr size_t WS_WT = WS_LRU + 2 * MiB;
constexpr size_t WS_END = WS_WT + 72 * MiB;
constexpr size_t WS_YL = WS_PROJ + 6 * SZ_ACT, WS_YS = WS_H, WS_YM = WS_PROJ + 8 * SZ_ACT, WS_YF = WS_PROJ + 7 * SZ_ACT;
constexpr size_t WS_GV = WS_PROJ;
constexpr size_t WS_ACT = WS_GV + (size_t)T * 2 * DFF * 2;
static_assert(WS_ACT + (size_t)T * DFF * 2 <= WS_GATES, "ffn alias");
constexpr size_t WS_MIXF = WS_END;
constexpr size_t WS_MIXED = WS_PROJ;
constexpr size_t WS_NEED = WS_MIXF + (size_t)T * DM * 4;

struct Ptrs {
    const float* in[26];
    float* out;
    unsigned char* ws;
};

__global__ void __launch_bounds__(256) n_rmsnorm(const float* __restrict__ x, const float* __restrict__ g, bf16_t* __restrict__ H,
                                                 const float* __restrict__ Wf, const float* __restrict__ bfg, float* __restrict__ LOGF, int nrows) {
    const int lane = threadIdx.x & 63, row = blockIdx.x * 4 + (threadIdx.x >> 6);
    if (row >= nrows) return;
    const float4* xr = (const float4*)(x + (size_t)row * DM);
    const float4* gr = (const float4*)g;
    float4 v[4]; float ss = 0.f;
#pragma unroll
    for (int j = 0; j < 4; ++j) { v[j] = xr[lane + 64 * j]; ss += v[j].x * v[j].x + v[j].y * v[j].y + v[j].z * v[j].z + v[j].w * v[j].w; }
    ss = wave_sum(ss);
    const float rstd = rsqrtf(ss * (1.f / DM) + EPS);
#pragma unroll
    for (int j = 0; j < 4; ++j) { const float4 gg = gr[lane + 64 * j]; v[j].x *= rstd * gg.x; v[j].y *= rstd * gg.y; v[j].z *= rstd * gg.z; v[j].w *= rstd * gg.w;
        ushort4 o; o.x = f2bf(v[j].x); o.y = f2bf(v[j].y); o.z = f2bf(v[j].z); o.w = f2bf(v[j].w);
        ((ushort4*)(H + (size_t)row * DM))[lane + 64 * j] = o; }
    if (Wf) {
        float mine = 0.f;
        for (int h = 0; h < 16; ++h) {
            float p = 0.f;
#pragma unroll
            for (int j = 0; j < 4; ++j) { const int k = (lane + 64 * j) * 4;
                p += v[j].x * Wf[(size_t)k * NIN + h] + v[j].y * Wf[(size_t)(k + 1) * NIN + h] + v[j].z * Wf[(size_t)(k + 2) * NIN + h] + v[j].w * Wf[(size_t)(k + 3) * NIN + h]; }
            p = wave_sum(p);
            if (lane == h) mine = p;
        }
        if (lane < 16) { const int b = row / SEQ, t = row % SEQ; LOGF[((size_t)b * 16 + lane) * SEQ + t] = logsigmoidf(mine + bfg[lane]); }
    }
}

struct EStoreBf16 { bf16_t* O; int ldc; int pad; __device__ void operator()(int m, int n, float a) const { O[(size_t)m * ldc + n] = f2bf(a); } };
struct EStoreF32 { float* O; int ldc; int pad; __device__ void operator()(int m, int n, float a) const { O[(size_t)m * ldc + n] = a; } };
struct EBranch { const bf16_t* G; const float* bg; float* MIXF; bf16_t* MIXED; int i; int pad; __device__ void operator()(int m, int n, float a) const { float v = sigmoidf_(bf2f(G[(size_t)m * 4096 + i * 1024 + n]) + bg[n]) * a; const size_t o = (size_t)m * DM + n; if (i > 0) v += MIXF[o]; if (i < 3) MIXF[o] = v; else MIXED[o] = f2bf(v); } };
struct EResid { const float* base; float* out; __device__ void operator()(int m, int n, float a) const { out[(size_t)m * DM + n] = base[(size_t)m * DM + n] + a; } };

template <class Epi> __global__ void __launch_bounds__(256) n_gemm(const bf16_t* __restrict__ A, const float* __restrict__ W, int lda, int ldw, int K, int kmask, Epi epi) {
    __shared__ float As[16][68], Bs[16][68];
    const int tx = threadIdx.x & 15, ty = threadIdx.x >> 4, m0 = blockIdx.y * 64, n0 = blockIdx.x * 64;
    float acc[4][4];
#pragma unroll
    for (int i = 0; i < 4; ++i)
#pragma unroll
        for (int j = 0; j < 4; ++j) acc[i][j] = 0.f;
    for (int k0 = 0; k0 < K; k0 += 16) {
#pragma unroll
        for (int i = 0; i < 4; ++i) { const int idx = threadIdx.x + i * 256; { const int r = idx >> 4, c = idx & 15; As[c][r] = bf2f(A[(size_t)(m0 + r) * lda + k0 + c]); }
            { const int r = idx >> 6, c = idx & 63; Bs[r][c] = bfr(W[(size_t)((k0 + r) & kmask) * ldw + n0 + c]); } }
        __syncthreads();
#pragma unroll
        for (int kk = 0; kk < 16; ++kk) { float a[4], b[4];
#pragma unroll
            for (int i = 0; i < 4; ++i) { a[i] = As[kk][ty * 4 + i]; b[i] = Bs[kk][tx * 4 + i]; }
#pragma unroll
            for (int i = 0; i < 4; ++i)
#pragma unroll
                for (int j = 0; j < 4; ++j) acc[i][j] += a[i] * b[j]; }
        __syncthreads();
    }
#pragma unroll
    for (int i = 0; i < 4; ++i)
#pragma unroll
        for (int j = 0; j < 4; ++j) epi(m0 + ty * 4 + i, n0 + tx * 4 + j, acc[i][j]);
}

__global__ void __launch_bounds__(256) n_headnorm(bf16_t* X, const float* __restrict__ g, int HD, float scale) {
    const int idx = blockIdx.x * 256 + threadIdx.x, nh = DM / HD, row = idx / nh, h = idx % nh;
    if (row >= T) return;
    bf16_t* p = X + (size_t)row * DM + h * HD; float ss = 0.f;
    for (int d = 0; d < HD; ++d) { const float v = bf2f(p[d]); ss += v * v; }
    const float rstd = rsqrtf(ss / HD + EPS) * scale;
    for (int d = 0; d < HD; ++d) p[d] = f2bf(bf2f(p[d]) * rstd * g[d]);
}

__global__ void __launch_bounds__(1024) n_cumsum(const float* __restrict__ LOGF, float* __restrict__ FB) {
    __shared__ float part[1024];
    const int bh = blockIdx.x, tid = threadIdx.x; const float* src = LOGF + (size_t)bh * SEQ + tid * 8; float v[8]; float s = 0.f;
#pragma unroll
    for (int i = 0; i < 8; ++i) { s += src[i]; v[i] = s; }
    part[tid] = s; __syncthreads();
    if (tid == 0) { float run = 0.f; for (int i = 0; i < 1024; ++i) { const float t_ = part[i]; part[i] = run; run += t_; } }
    __syncthreads();
    const float off = part[tid]; float* dst = FB + (size_t)bh * SEQ + tid * 8;
#pragma unroll
    for (int i = 0; i < 8; ++i) dst[i] = off + v[i];
}

__global__ void __launch_bounds__(256) n_fox_attn(const bf16_t* Q, const bf16_t* __restrict__ K, const bf16_t* __restrict__ V, const float* __restrict__ FB, bf16_t* O) {
    __shared__ float Ks[64][64], Vs[64][64], Fs[64];
    const int bh = blockIdx.y, b = bh >> 4, h = bh & 15, tq = blockIdx.x * 256 + threadIdx.x;
    const size_t rowq = (size_t)b * SEQ + tq;
    float q[64], o[64];
#pragma unroll
    for (int d = 0; d < 64; ++d) { q[d] = bf2f(Q[rowq * DM + h * 64 + d]); o[d] = 0.f; }
    const float Ft = FB[(size_t)bh * SEQ + tq];
    float m = -INFINITY, l = 0.f;
    const int ntile = (blockIdx.x * 256 + 256) / 64;
    for (int kt = 0; kt < ntile; ++kt) {
        __syncthreads();
        for (int i = threadIdx.x; i < 64 * 64; i += 256) { const int r = i >> 6, c = i & 63; const size_t rk = ((size_t)b * SEQ + kt * 64 + r) * DM + h * 64 + c; Ks[r][c] = bf2f(K[rk]); Vs[r][c] = bf2f(V[rk]); }
        if (threadIdx.x < 64) Fs[threadIdx.x] = FB[(size_t)bh * SEQ + kt * 64 + threadIdx.x];
        __syncthreads();
        for (int j = 0; j < 64; ++j) {
            const int s = kt * 64 + j; if (s > tq) break;
            float z = 0.f;
#pragma unroll
            for (int d = 0; d < 64; ++d) z += q[d] * Ks[j][d];
            z += (Ft - Fs[j]) * LOG2E;
            if (z > m) { const float c = exp2f(m - z); l *= c;
#pragma unroll
                for (int d = 0; d < 64; ++d) o[d] *= c;
                m = z; }
            const float p = exp2f(z - m); l += p;
#pragma unroll
            for (int d = 0; d < 64; ++d) o[d] += p * Vs[j][d];
        }
    }
    const float il = 1.f / l;
#pragma unroll
    for (int d = 0; d < 64; ++d) O[rowq * DM + h * 64 + d] = f2bf(o[d] * il);
}

__global__ void __launch_bounds__(256) n_sb_attn(const bf16_t* Q, const bf16_t* __restrict__ K, const bf16_t* __restrict__ V, bf16_t* O) {
    __shared__ float Ks[64][64], Vs[64][64];
    const int bh = blockIdx.y, b = bh >> 4, h = bh & 15, tq = blockIdx.x * 256 + threadIdx.x;
    const size_t rowq = (size_t)b * SEQ + tq;
    float q[64], o[64];
#pragma unroll
    for (int d = 0; d < 64; ++d) { q[d] = bf2f(Q[rowq * DM + h * 64 + d]) * 0.125f; o[d] = 0.f; }
    float R = 0.f;
    for (int kt = (blockIdx.x * 256 + 255) / 64; kt >= 0; --kt) {
        if (__syncthreads_and(R < SB_THR)) break;
        for (int i = threadIdx.x; i < 64 * 64; i += 256) { const int r = i >> 6, c = i & 63; const size_t rk = ((size_t)b * SEQ + kt * 64 + r) * DM + h * 64 + c; Ks[r][c] = bf2f(K[rk]); Vs[r][c] = bf2f(V[rk]); }
        __syncthreads();
        for (int j = 63; j >= 0; --j) {
            const int s = kt * 64 + j; if (s >= tq) continue;
            float z = 0.f;
#pragma unroll
            for (int d = 0; d < 64; ++d) z += q[d] * Ks[j][d];
            const float sp = softplusf(z);
            const float w = __expf((z - sp) + R);
            R -= sp;
#pragma unroll
            for (int d = 0; d < 64; ++d) o[d] += w * Vs[j][d];
        }
    }
#pragma unroll
    for (int d = 0; d < 64; ++d) O[rowq * DM + h * 64 + d] = f2bf(o[d]);
}

__global__ void __launch_bounds__(64) n_lru(const bf16_t* LX, const bf16_t* __restrict__ LG, const float* __restrict__ cw, const float* __restrict__ cb,
                                            const float* __restrict__ wa, const float* __restrict__ ba, const float* __restrict__ wx, const float* __restrict__ bx,
                                            const float* __restrict__ lam, bf16_t* YL) {
    __shared__ float xs[64];
    const int b = blockIdx.x >> 4, n = blockIdx.x & 15, e = threadIdx.x, ch = n * 64 + e;
    float wA[64], wX[64];
#pragma unroll
    for (int d = 0; d < 64; ++d) { wA[d] = wa[((size_t)n * 64 + d) * 64 + e]; wX[d] = wx[((size_t)n * 64 + d) * 64 + e]; }
    const float w0 = cw[ch], w1 = cw[DM + ch], w2 = cw[2 * DM + ch], w3 = cw[3 * DM + ch], bc = cb[ch], bA = ba[ch], bX = bx[ch];
    const float spl = softplusf(-lam[ch]);
    float x1 = 0.f, x2 = 0.f, x3 = 0.f, hs = 0.f;
    for (int t = 0; t < SEQ; ++t) {
        const size_t r = ((size_t)b * SEQ + t) * DM + ch;
        const float x0 = bf2f(LX[r]);
        const float xc = bc + w3 * x0 + w2 * x1 + w1 * x2 + w0 * x3;
        x3 = x2; x2 = x1; x1 = x0;
        __syncthreads();
        xs[e] = xc;
        __syncthreads();
        float ra = bA, ri = bX;
#pragma unroll
        for (int d = 0; d < 64; ++d) { const float xv = xs[d]; ra += xv * wA[d]; ri += xv * wX[d]; }
        const float rr = sigmoidf_(ra), ii = sigmoidf_(ri);
        const float la = -8.f * rr * spl;
        const float a = __expf(la);
        const float u = sqrtf(-expm1f(2.f * la)) * (ii * xc);
        hs = a * hs + u;
        YL[r] = f2bf(hs * gelu_tanh(bf2f(LG[r])));
    }
}

__global__ void __launch_bounds__(256) n_memkv_post(const float* __restrict__ raw, const float* __restrict__ gk, const float* __restrict__ gq, bf16_t* __restrict__ MK, bf16_t* __restrict__ MVT) {
    const int row = blockIdx.x, b = row >> 8, m = row & 255, d = threadIdx.x;
    __shared__ float red[4];
    for (int h = 0; h < 4; ++h) {
        const float k = raw[(size_t)row * 2048 + h * 256 + d];
        float ss = wave_sum(k * k);
        __syncthreads();
        if ((threadIdx.x & 63) == 0) red[threadIdx.x >> 6] = ss;
        __syncthreads();
        ss = red[0] + red[1] + red[2] + red[3];
        const float rstd = rsqrtf(ss * (1.f / 256.f) + EPS);
        MK[((size_t)b * 256 + m) * DM + h * 256 + d] = f2bf(k * rstd * gk[d] * gq[d]);
        MVT[(((size_t)b * 4 + h) * 256 + d) * 256 + m] = f2bf(raw[(size_t)row * 2048 + 1024 + h * 256 + d]);
    }
}

__global__ void __launch_bounds__(256) n_mem_attn(const bf16_t* MQ, const bf16_t* __restrict__ MK, const bf16_t* __restrict__ MVT, bf16_t* YM) {
    __shared__ float qs[256], ps[256], red[4];
    const int row = blockIdx.x >> 2, h = blockIdx.x & 3, b = row / SEQ, tid = threadIdx.x;
    const float qv = bf2f(MQ[(size_t)row * DM + h * 256 + tid]);
    float ss = wave_sum(qv * qv);
    if ((tid & 63) == 0) red[tid >> 6] = ss;
    qs[tid] = qv;
    __syncthreads();
    const float rstd = rsqrtf((red[0] + red[1] + red[2] + red[3]) * (1.f / 256.f) + EPS);
    const bf16_t* kr = MK + ((size_t)b * 256 + tid) * DM + h * 256;
    float s = 0.f;
    for (int d = 0; d < 256; ++d) s += qs[d] * bf2f(kr[d]);
    s *= rstd * (1.f / 16.f);
    __syncthreads();
    float mx = s;
#pragma unroll
    for (int o = 1; o < 64; o <<= 1) mx = fmaxf(mx, __shfl_xor(mx, o));
    if ((tid & 63) == 0) red[tid >> 6] = mx;
    __syncthreads();
    mx = fmaxf(fmaxf(red[0], red[1]), fmaxf(red[2], red[3]));
    const float p = __expf(s - mx);
    ps[tid] = p;
    float sum = wave_sum(p);
    __syncthreads();
    if ((tid & 63) == 0) red[tid >> 6] = sum;
    __syncthreads();
    sum = red[0] + red[1] + red[2] + red[3];
    const bf16_t* vr = MVT + (((size_t)b * 4 + h) * 256 + tid) * 256;
    float o = 0.f;
    for (int m = 0; m < 256; ++m) o += ps[m] * bf2f(vr[m]);
    YM[(size_t)row * DM + h * 256 + tid] = f2bf(o / sum);
}

__global__ void __launch_bounds__(256) n_act(const bf16_t* __restrict__ GV, const float* __restrict__ cw, const float* __restrict__ cb, bf16_t* __restrict__ ACT) {
    const size_t idx = (size_t)blockIdx.x * 256 + threadIdx.x; if (idx >= (size_t)T * DFF) return;
    const int r = (int)(idx / DFF), c = (int)(idx % DFF), t = r % SEQ;
    const float g0 = bf2f(GV[(size_t)r * 2 * DFF + c]);
    const float g1 = t >= 1 ? bf2f(GV[(size_t)(r - 1) * 2 * DFF + c]) : 0.f;
    const float g2 = t >= 2 ? bf2f(GV[(size_t)(r - 2) * 2 * DFF + c]) : 0.f;
    const float pre = cb[c] + cw[2 * DFF + c] * g0 + cw[DFF + c] * g1 + cw[c] * g2;
    const float val = bf2f(GV[(size_t)r * 2 * DFF + DFF + c]);
    ACT[(size_t)r * DFF + c] = f2bf(pre * sigmoidf_(pre) * val);
}

#define CFG 32767
namespace pg8 {
#define PG8_LAS __attribute__((address_space(3)))
typedef unsigned short bf16_t;
typedef short bf16x8 __attribute__((ext_vector_type(8)));
typedef float f32x4 __attribute__((ext_vector_type(4)));
typedef unsigned u32x4 __attribute__((ext_vector_type(4)));
constexpr int BM = 256, BK = 64, HALF = 128, HTB = HALF * BK * 2  , STAGE_BYTES = 8 * HTB, NXCD = 8, WGM = 8;

__host__ __device__ __forceinline__ int lds_byte(int r, int c) { const int st = (r >> 4) * 2 + (c >> 5), rr = r & 15, cc = c & 31, ob = rr * 64 + cc * 2; return st * 1024 + (ob ^ (((ob >> 9) & 1) << 5)); }
__host__ __device__ __forceinline__ void stage_rc(int b, int& R, int& C) { const int st = b / 1024, sb = b % 1024, swz = sb ^ (((sb >> 9) & 1) << 5); R = (st >> 1) * 16 + swz / 64; C = (st & 1) * 32 + (swz % 64) / 2; }
__host__ __device__ __forceinline__ int perm32(int rho) { const int n = rho >> 4, i = rho & 15; return 8 * (i >> 2) + 4 * n + (i & 3); }

struct Unit { int pm, pn; };
struct Gemm { int lda, ldb, K; };

struct StaticOrder {
    int nM, nN, nwg, G, c;
    __host__ __device__ void init(int M, int N, int G_, int c_) { nM = M / BM; nN = N / BM; nwg = nM * nN; G = G_; c = c_; }
    __host__ __device__ bool next(int i, Unit& u) const {
        const long L = (long)i * G + c; if (L >= nwg) return false;
        int wgid = (int)L; { const int q = nwg / NXCD, r = nwg % NXCD, xcd = wgid % NXCD, off = wgid / NXCD; wgid = (xcd < r ? xcd * (q + 1) : r * (q + 1) + (xcd - r) * q) + off; }
        const int nig = WGM * nN, gid = wgid / nig, fm = gid * WGM, gsz = (nM - fm) < WGM ? (nM - fm) : WGM;
        u.pm = fm + ((wgid % nig) % gsz); u.pn = (wgid % nig) / gsz; return true;
    }
    __device__ __forceinline__ void a_ready(const Unit&) const {}
    __device__ __forceinline__ void done(const Unit&) const {}
};

__device__ __forceinline__ unsigned cvt_pk_bf16(float lo, float hi) { unsigned r; asm volatile("v_cvt_pk_bf16_f32 %0, %1, %2" : "=v"(r) : "v"(lo), "v"(hi)); return r; }
typedef float f32x2 __attribute__((ext_vector_type(2)));
__device__ __forceinline__ f32x2 gelu_pk(f32x2 v) {
    const f32x2 av = __builtin_elementwise_abs(v), d = av * 0.2316418882f + 1.0f;
    f32x2 t; t.x = __builtin_amdgcn_rcpf(d.x); t.y = __builtin_amdgcn_rcpf(d.y);
    f32x2 q = t * 0.5307027145f + (-0.7265760135f); q = q * t + 0.7107068705f; q = q * t + (-0.142248368f); q = q * t + 0.127414796f; q = q * t;
    const f32x2 s = (v * v) * (-0.72134752044f);
    f32x2 e; e.x = __builtin_amdgcn_exp2f(s.x); e.y = __builtin_amdgcn_exp2f(s.y);
    const f32x2 m = v * (q * e), r = v - m;
    f32x2 o; o.x = v.x < 0.f ? m.x : r.x; o.y = v.y < 0.f ? m.y : r.y; return o;
}

template <class Epi, class Sched, bool ALIGN_EPI = false, bool SP2 = false>
__device__ __forceinline__ void gemm_phase(PG8_LAS unsigned char* lds, const Gemm g, const Sched& S, const Epi& E) {
    const int tid = mk_tid(), wid = __builtin_amdgcn_readfirstlane(tid >> 6), lane = tid & 63, wr = wid >> 2, wc = wid & 3, fr = lane & 15, fq = lane >> 4;
    const int K = g.K, nt = K / BK;
    unsigned voffA[2], voffB[2];
#pragma unroll
    for (int i = 0; i < 2; ++i) { int R, C; stage_rc(tid * 16 + i * 8192, R, C); const int Rb = Epi::PERM ? ((R & ~31) + perm32(R & 31)) : R;
        voffA[i] = (unsigned)(R * g.lda + C) * 2u; voffB[i] = (unsigned)(Rb * g.ldb + C) * 2u; }
    const size_t kstep = (size_t)(BK * 2);
    const size_t hstepA = (size_t)HALF * g.lda * 2, hstepB = (size_t)HALF * g.ldb * 2;
    const unsigned ldsw = (unsigned)wid * 1024u;
    const int aoff = lds_byte(wr * 64 + fr, fq * 8), boff = lds_byte(wc * 32 + fr, fq * 8);
#define PG8_SA(b, h) (((b) * 2 + (h)) * HTB)
#define PG8_SB(b, h) ((4 + (b) * 2 + (h)) * HTB)
#define PG8_STAGE(bufoff, gbase, voff) do { _Pragma("unroll") for (int _i = 0; _i < 2; ++_i) \
        __builtin_amdgcn_global_load_lds((const unsigned*)((const char*)(gbase) + (voff)[_i]), (PG8_LAS unsigned*)(lds + (bufoff) + ldsw + _i * 8192), 16, 0, 0); } while (0)
#define PG8_LDA(dst, b, h) do { _Pragma("unroll") for (int m = 0; m < 4; ++m) _Pragma("unroll") for (int k = 0; k < 2; ++k) dst[m][k] = *(const PG8_LAS bf16x8*)(lds + PG8_SA(b, h) + aoff + m * 2048 + k * 1024); } while (0)
#define PG8_LDB(dst, b, h) do { _Pragma("unroll") for (int n = 0; n < 2; ++n) _Pragma("unroll") for (int k = 0; k < 2; ++k) dst[n][k] = *(const PG8_LAS bf16x8*)(lds + PG8_SB(b, h) + boff + n * 2048 + k * 1024); } while (0)
#define PG8_MMA(ai, bj, At, Bt) do { __builtin_amdgcn_s_setprio(1); _Pragma("unroll") for (int m = 0; m < 4; ++m) _Pragma("unroll") for (int n = 0; n < 2; ++n) _Pragma("unroll") for (int k = 0; k < 2; ++k) \
        acc[ai][bj][m][n] = __builtin_amdgcn_mfma_f32_16x16x32_bf16(Bt[n][k], At[m][k], acc[ai][bj][m][n], 0, 0, 0); __builtin_amdgcn_s_setprio(0); } while (0)
#define PG8_WAIT_V(n) asm volatile("s_waitcnt vmcnt(" #n ")" ::: "memory")
#define PG8_WAIT_L(n) asm volatile("s_waitcnt lgkmcnt(" #n ")" ::: "memory")
#define PG8_BAR __builtin_amdgcn_s_barrier()
#define PG8_SCHED __builtin_amdgcn_sched_barrier(0)
    Unit cur, nxt; int ui = 0;
    if (!S.next(0, cur)) return;
    f32x4 acc[2][2][4][2];
#pragma unroll
    for (int a = 0; a < 2; ++a)
#pragma unroll
        for (int b = 0; b < 2; ++b)
#pragma unroll
            for (int m = 0; m < 4; ++m)
#pragma unroll
                for (int n = 0; n < 2; ++n) acc[a][b][m][n] = (f32x4){0.f, 0.f, 0.f, 0.f};
    bf16x8 At[4][2], B0[2][2], B1[2][2];
    const char* cA = S.aptr(cur); const char* cB = S.bptr(cur);
    S.a_ready(cur);
    if constexpr (SP2) {
        PG8_STAGE(PG8_SB(0, 0), cB, voffB); PG8_STAGE(PG8_SB(0, 1), cB + hstepB, voffB); PG8_STAGE(PG8_SA(0, 0), cA, voffA); PG8_STAGE(PG8_SA(0, 1), cA + hstepA, voffA);
        if (wr == 1) PG8_BAR;
        PG8_WAIT_V(2); PG8_BAR;
        PG8_STAGE(PG8_SB(1, 0), cB + kstep, voffB); PG8_STAGE(PG8_SA(1, 0), cA + kstep, voffA); PG8_STAGE(PG8_SB(1, 1), cB + hstepB + kstep, voffB);
        PG8_WAIT_V(6); PG8_BAR;
    } else {
        PG8_STAGE(PG8_SB(0, 0), cB, voffB); PG8_STAGE(PG8_SA(0, 0), cA, voffA); PG8_STAGE(PG8_SB(0, 1), cB + hstepB, voffB); PG8_STAGE(PG8_SA(0, 1), cA + hstepA, voffA);
        if (wr == 1) PG8_BAR;
        PG8_WAIT_V(4); PG8_BAR;
        PG8_STAGE(PG8_SB(1, 0), cB + kstep, voffB); PG8_STAGE(PG8_SA(1, 0), cA + kstep, voffA); PG8_STAGE(PG8_SB(1, 1), cB + hstepB + kstep, voffB);
        PG8_WAIT_V(6); PG8_BAR;
    }
    for (;;) {
        const bool has_next = S.next(ui + 1, nxt);
        const char* nA = has_next ? S.aptr(nxt) : cA; const char* nB = has_next ? S.bptr(nxt) : cB;
        for (int t = 0; t < nt; t += 2) {
            const bool last = (t == nt - 2);
            const char* a1 = cA + (size_t)(t + 1) * kstep;
            const char* a2 = last ? nA : cA + (size_t)(t + 2) * kstep; const char* b2 = last ? nB : cB + (size_t)(t + 2) * kstep;
            const char* a3 = a2 + kstep; const char* b3 = b2 + kstep;
            if (last && has_next) S.a_ready(nxt);
            if constexpr (SP2) {
            PG8_LDB(B0, 0, 0); PG8_LDB(B1, 0, 1); PG8_SCHED; PG8_LDA(At, 0, 0); PG8_STAGE(PG8_SA(1, 1), a1 + hstepA, voffA);
            PG8_WAIT_V(8); PG8_WAIT_L(0); PG8_BAR; PG8_MMA(0, 0, At, B0); PG8_MMA(0, 1, At, B1); PG8_BAR; PG8_SCHED;
            PG8_LDA(At, 0, 1); PG8_STAGE(PG8_SB(0, 0), b2, voffB); PG8_STAGE(PG8_SB(0, 1), b2 + hstepB, voffB); PG8_STAGE(PG8_SA(0, 0), a2, voffA);
            PG8_WAIT_V(8); PG8_WAIT_L(0); PG8_BAR; PG8_MMA(1, 0, At, B0); PG8_MMA(1, 1, At, B1); PG8_BAR; PG8_SCHED;
            PG8_LDB(B0, 1, 0); PG8_LDB(B1, 1, 1); PG8_SCHED; PG8_LDA(At, 1, 0); PG8_STAGE(PG8_SA(0, 1), a2 + hstepA, voffA);
            PG8_WAIT_V(8); PG8_WAIT_L(0); PG8_BAR; PG8_MMA(0, 0, At, B0); PG8_MMA(0, 1, At, B1); PG8_BAR; PG8_SCHED;
            PG8_LDA(At, 1, 1); PG8_STAGE(PG8_SB(1, 0), b3, voffB); PG8_STAGE(PG8_SB(1, 1), b3 + hstepB, voffB); PG8_STAGE(PG8_SA(1, 0), a3, voffA);
            PG8_WAIT_V(8); PG8_WAIT_L(0); PG8_BAR; PG8_MMA(1, 0, At, B0); PG8_MMA(1, 1, At, B1); PG8_BAR; PG8_SCHED;
            } else {
            PG8_LDB(B0, 0, 0); PG8_SCHED; PG8_LDA(At, 0, 0); PG8_STAGE(PG8_SA(1, 1), a1 + hstepA, voffA);
            PG8_WAIT_L(8); PG8_BAR; PG8_WAIT_L(0); PG8_MMA(0, 0, At, B0); PG8_BAR; PG8_SCHED;
            PG8_LDB(B1, 0, 1); PG8_STAGE(PG8_SB(0, 0), b2, voffB);
            PG8_BAR; PG8_WAIT_L(0); PG8_MMA(0, 1, At, B1); PG8_BAR;
            PG8_LDA(At, 0, 1); PG8_STAGE(PG8_SA(0, 0), a2, voffA);
            PG8_BAR; PG8_WAIT_L(0); PG8_MMA(1, 0, At, B0); PG8_BAR; PG8_SCHED;
            PG8_STAGE(PG8_SB(0, 1), b2 + hstepB, voffB);
            PG8_WAIT_V(6); PG8_BAR; PG8_MMA(1, 1, At, B1); PG8_BAR;
            PG8_LDB(B0, 1, 0); PG8_SCHED; PG8_LDA(At, 1, 0); PG8_STAGE(PG8_SA(0, 1), a2 + hstepA, voffA);
            PG8_WAIT_L(8); PG8_BAR; PG8_WAIT_L(0); PG8_MMA(0, 0, At, B0); PG8_BAR; PG8_SCHED;
            PG8_LDB(B1, 1, 1); PG8_STAGE(PG8_SB(1, 0), b3, voffB);
            PG8_BAR; PG8_WAIT_L(0); PG8_MMA(0, 1, At, B1); PG8_BAR;
            PG8_LDA(At, 1, 1); PG8_STAGE(PG8_SA(1, 0), a3, voffA);
            PG8_BAR; PG8_WAIT_L(0); PG8_MMA(1, 0, At, B0); PG8_BAR; PG8_SCHED;
            PG8_STAGE(PG8_SB(1, 1), b3 + hstepB, voffB);
            PG8_WAIT_V(6); PG8_BAR; PG8_MMA(1, 1, At, B1); PG8_BAR;
            }
        }
        if constexpr (ALIGN_EPI) { if (wr == 0) PG8_BAR; }
        if constexpr (!Epi::AFTER_DRAIN) { int fr_ = fr, fq_ = fq; asm volatile("" : "+v"(fr_), "+v"(fq_));   E(acc, cur, wr, wc, fr_, fq_); S.done(cur); }
        if (!has_next) break;
#pragma unroll
        for (int a = 0; a < 2; ++a)
#pragma unroll
            for (int b = 0; b < 2; ++b)
#pragma unroll
                for (int m = 0; m < 4; ++m)
#pragma unroll
                    for (int n = 0; n < 2; ++n) acc[a][b][m][n] = (f32x4){0.f, 0.f, 0.f, 0.f};
        cur = nxt; cA = nA; cB = nB; ++ui;
        if constexpr (ALIGN_EPI) { if (wr == 1) PG8_BAR; }
    }
    PG8_WAIT_V(0);
    if constexpr (!ALIGN_EPI) { if (wr == 0) PG8_BAR; }
    PG8_BAR;
    if constexpr (Epi::AFTER_DRAIN) { E.fused(acc, cur, wr, wc, fr, fq, lds, wid, lane); S.done(cur); }
#undef PG8_SA
#undef PG8_SB
#undef PG8_STAGE
#undef PG8_LDA
#undef PG8_LDB
#undef PG8_MMA
#undef PG8_WAIT_V
#undef PG8_WAIT_L
#undef PG8_BAR
#undef PG8_SCHED
}
}
#include <hip/hip_bf16.h>
#include <cmath>
namespace attn_body {
using bf16=__hip_bfloat16;
using bf16x8=__attribute__((ext_vector_type(8)))short;
using s16x4=__attribute__((ext_vector_type(4)))short;
using f32x16=__attribute__((ext_vector_type(16)))float;
using u32x4=__attribute__((ext_vector_type(4)))unsigned;
constexpr int BATCH=2,NHEAD=16,SEQ=8192,D=64,DM=NHEAD*D;
constexpr int NW=8,QBLK=32,QB=QBLK*NW,KVBLK=64,NQB=SEQ/QB;
constexpr int ATTN_PITCH=DM, ATTN_UNIT_ROWS=QB;
__device__ __forceinline__ int crow(int r,int hi){return (r&3)+8*(r>>2)+4*hi;}
#define SBAR() __builtin_amdgcn_sched_barrier(0)
__device__ __forceinline__ void cmask(f32x16&p0,f32x16&p1,int jb,int qrel,int hi){
  const float NEG=-INFINITY; int kb=64*jb+4*hi;
  #pragma unroll
  for(int r=0;r<16;++r){int kv=kb+(r&3)+8*(r>>2); if(kv>qrel)p0[r]=NEG; if(kv+32>qrel)p1[r]=NEG;}
}

constexpr int NSLOT=3, SLOTB=8192;
constexpr int LDS_K=0, LDS_V=NSLOT*SLOTB, LDS_WS=2*NSLOT*SLOTB, LDS_OST=LDS_WS+NW*64*4, LDS_BYTES=LDS_OST+NW*4096;
constexpr int BIAS_OFF=86016;
constexpr float C2=0.125f*1.4426950408889634f;
__device__ __forceinline__ void glds16(const void*gsrc,unsigned lds_dst){unsigned keep;
  asm volatile("s_mov_b32 %0, m0\n\ts_mov_b32 m0, %2\n\ts_nop 0\n\tglobal_load_lds_dwordx4 %1, off\n\ts_mov_b32 m0, %0":"=&s"(keep):"v"(gsrc),"s"(lds_dst):"memory");}
__device__ __forceinline__ float max3f(float a,float b,float c){float r;asm("v_max3_f32 %0, %1, %2, %3":"=v"(r):"v"(a),"v"(b),"v"(c));return r;}
__device__ __forceinline__ float max2f(float a,float b){float r;asm("v_max_f32_e32 %0, %1, %2":"=v"(r):"v"(a),"v"(b));return r;}
__device__ __forceinline__ float fadd_s(float a,float b){float r;asm("v_add_f32_e32 %0, %1, %2":"=v"(r):"v"(a),"v"(b));return r;}
__device__ __forceinline__ float fsub_s(float a,float b){float r;asm("v_sub_f32_e32 %0, %1, %2":"=v"(r):"v"(a),"v"(b));return r;}
typedef float f32x2_t __attribute__((ext_vector_type(2))); typedef __bf16 bf16x2_t __attribute__((ext_vector_type(2)));
__device__ __forceinline__ unsigned cvtpk_s(float lo,float hi){f32x2_t v={lo,hi};bf16x2_t b=__builtin_convertvector(v,bf16x2_t);return __builtin_bit_cast(unsigned,b);}
#define WAIT_BAR(N) asm volatile("s_waitcnt vmcnt(" #N ") lgkmcnt(0)\n\ts_barrier":::"memory")

__device__ __forceinline__ void qkt(f32x16&p0,f32x16&p1,const char*Kslot,const bf16x8*qr,const f32x16&negm,int r32,int hi){
  const char*kb=Kslot+hi*1024+r32*16;
  #pragma unroll
  for(int d0=0;d0<4;++d0){
    const bf16x8 b0=*reinterpret_cast<const bf16x8*>(kb+d0*2048);
    const bf16x8 b1=*reinterpret_cast<const bf16x8*>(kb+d0*2048+512);
    if(d0==0){p0=__builtin_amdgcn_mfma_f32_32x32x16_bf16(b0,qr[0],negm,0,0,0);p1=__builtin_amdgcn_mfma_f32_32x32x16_bf16(b1,qr[0],negm,0,0,0);}
    else{p0=__builtin_amdgcn_mfma_f32_32x32x16_bf16(b0,qr[d0],p0,0,0,0);p1=__builtin_amdgcn_mfma_f32_32x32x16_bf16(b1,qr[d0],p1,0,0,0);}}
}
typedef __attribute__((address_space(3))) const char* lds_cptr;
typedef short v4i16_t __attribute__((ext_vector_type(4)));
__device__ __forceinline__ void kload8(bf16x8*kf,lds_cptr kp){
  kf[0]=*(const __attribute__((address_space(3))) bf16x8*)(kp);      kf[1]=*(const __attribute__((address_space(3))) bf16x8*)(kp+512);
  kf[2]=*(const __attribute__((address_space(3))) bf16x8*)(kp+2048); kf[3]=*(const __attribute__((address_space(3))) bf16x8*)(kp+2560);
  kf[4]=*(const __attribute__((address_space(3))) bf16x8*)(kp+4096); kf[5]=*(const __attribute__((address_space(3))) bf16x8*)(kp+4608);
  kf[6]=*(const __attribute__((address_space(3))) bf16x8*)(kp+6144); kf[7]=*(const __attribute__((address_space(3))) bf16x8*)(kp+6656);
}
__device__ __forceinline__ void kload2(bf16x8*kf,lds_cptr kp,int j){ kf[2*j]=*(const __attribute__((address_space(3))) bf16x8*)(kp+j*2048); kf[2*j+1]=*(const __attribute__((address_space(3))) bf16x8*)(kp+j*2048+512); }
__device__ __forceinline__ s16x4 vtr(lds_cptr p){ return __builtin_bit_cast(s16x4,__builtin_amdgcn_ds_read_tr16_b64_v4i16((__attribute__((address_space(3))) v4i16_t*)p)); }
__device__ __forceinline__ float rowmax(const f32x16&p0,const f32x16&p1){
  float a=max3f(p0[0],p0[1],p1[0]),b=max3f(p0[2],p0[3],p1[1]);a=max3f(a,p1[2],p1[3]);
  #pragma unroll
  for(int r=4;r<16;r+=4){a=max3f(a,p0[r],p0[r+1]);b=max3f(b,p0[r+2],p0[r+3]);a=max3f(a,p1[r],p1[r+1]);b=max3f(b,p1[r+2],p1[r+3]);}
  const float m=max2f(a,b);
  auto rr=__builtin_amdgcn_permlane32_swap(__float_as_uint(m),__float_as_uint(m),false,false);
  return max2f(__uint_as_float(rr[0]),__uint_as_float(rr[1]));
}
__device__ __forceinline__ void pv(f32x16*o,int vb,bf16x8 pa0,bf16x8 pa1,bf16x8 pa2,bf16x8 pa3){
  #pragma unroll
  for(int d0=0;d0<2;++d0){s16x4 lo[4],hi[4];
    #pragma unroll
    for(int ks=0;ks<4;++ks){
      asm volatile("ds_read_b64_tr_b16 %0,%1 offset:%c2":"=&v"(lo[ks]):"v"(vb),"i"(d0*4096+ks*1024):"memory");
      asm volatile("ds_read_b64_tr_b16 %0,%1 offset:%c2":"=&v"(hi[ks]):"v"(vb),"i"(d0*4096+ks*1024+512):"memory");}
    asm volatile("s_waitcnt lgkmcnt(0)":::"memory");SBAR();
    #define PK(k) (bf16x8){lo[k][0],lo[k][1],lo[k][2],lo[k][3],hi[k][0],hi[k][1],hi[k][2],hi[k][3]}
    o[d0]=__builtin_amdgcn_mfma_f32_32x32x16_bf16(pa0,PK(0),o[d0],0,0,0);
    o[d0]=__builtin_amdgcn_mfma_f32_32x32x16_bf16(pa1,PK(1),o[d0],0,0,0);
    o[d0]=__builtin_amdgcn_mfma_f32_32x32x16_bf16(pa2,PK(2),o[d0],0,0,0);
    o[d0]=__builtin_amdgcn_mfma_f32_32x32x16_bf16(pa3,PK(3),o[d0],0,0,0);
    #undef PK
  }
}

#ifndef ATTN_STORE16
#define ATTN_STORE16(p,v) (*(u32x4*)(p)=(v))
#endif
template<int THRL> __device__ __forceinline__ void attn_unit(int b,int h,int qb,const bf16*Q,const bf16*__restrict__ K,const bf16*__restrict__ V,bf16*O,const float*__restrict__ FBrow,float skip_thr,char*shm){
  const int tid=mk_tid(),lane=tid&63,r32=lane&31,hi=lane>>5; const int wid=__builtin_amdgcn_readfirstlane(tid>>6);
  const long rowbase=(long)b*SEQ; const int q0=qb*QB;
  int t_start=0;
  { const int ntf=(q0+QB)/KVBLK; const float Fq0=FBrow[q0];
    const bool c0=lane<ntf&&(Fq0-FBrow[64*(lane<ntf?lane:0)+63])*1.4426950408889634f<skip_thr;
    const bool c1=(lane+64)<ntf&&(Fq0-FBrow[64*((lane+64)<ntf?lane+64:0)+63])*1.4426950408889634f<skip_thr;
    int cnt=__popcll(__ballot(c0))+__popcll(__ballot(c1)); cnt&=~1; if(cnt>ntf-4)cnt=ntf-4; t_start=__builtin_amdgcn_readfirstlane(cnt); }
  const bf16*Qw=Q+(rowbase+q0+wid*QBLK)*DM+h*D;
  const bf16*Kh=K+(rowbase+(long)t_start*KVBLK)*DM+h*D,*Vh=V+(rowbase+(long)t_start*KVBLK)*DM+h*D;
  const lds_cptr shm3=(lds_cptr)shm;
  const unsigned lds0=(unsigned)(uintptr_t)shm;
  float*wsf=(float*)(shm+LDS_WS)+wid*64;
  const bf16*ksrc=Kh+(long)lane*DM+wid*8;
  const bf16*vsrc=Vh+(long)(16*(wid&3)+(lane>>2))*DM+(wid>>2)*32+(lane&3)*8;
  const unsigned kdst=lds0+LDS_K+wid*1024, vdst=lds0+LDS_V+wid*1024;
  #define DMA_K(t,slot) glds16(ksrc+(long)(t)*KVBLK*DM,(unsigned)__builtin_amdgcn_readfirstlane(kdst+(slot)))
  #define DMA_V(t,slot) glds16(vsrc+(long)(t)*KVBLK*DM,(unsigned)__builtin_amdgcn_readfirstlane(vdst+(slot)))
  const int vb0=(int)(lds0+LDS_V)+((lane>>4)&1)*32+(lane&3)*8+(4*hi+((lane&15)>>2))*64;
  const char*Kbase=shm+LDS_K; bf16x8 kf[8];
  const lds_cptr kp0=shm3+LDS_K+hi*1024+r32*16; const lds_cptr vp0=shm3+LDS_V+((lane>>4)&1)*32+(lane&3)*8+(4*hi+((lane&15)>>2))*64;
  const int NT=(q0+QB)/KVBLK-t_start;
  {
    typedef __attribute__((address_space(3))) float lds_f32; lds_f32* bl=(lds_f32*)(shm3+BIAS_OFF);
    const int nb=q0+QB; const float Fl=FBrow[nb-1];
    for(int i=t_start*KVBLK+tid;i<nb;i+=NW*64) bl[i]=(Fl-FBrow[i])*1.4426950408889634f;
    asm volatile("s_waitcnt vmcnt(0) lgkmcnt(0)\n\ts_barrier":::"memory"); }
  typedef float f32x4v __attribute__((ext_vector_type(4)));
  #define BIAS(P0,P1,t) do{ const __attribute__((address_space(3))) f32x4v* bp_=(const __attribute__((address_space(3))) f32x4v*)(shm3+BIAS_OFF)+((t)+t_start)*16+hi; \
    _Pragma("unroll") for(int g_=0;g_<4;++g_){ const f32x4v f0_=bp_[2*g_]+nm, f1_=bp_[8+2*g_]+nm; \
      P0[4*g_]+=f0_[0];P0[4*g_+1]+=f0_[1];P0[4*g_+2]+=f0_[2];P0[4*g_+3]+=f0_[3]; P1[4*g_]+=f1_[0];P1[4*g_+1]+=f1_[1];P1[4*g_+2]+=f1_[2];P1[4*g_+3]+=f1_[3]; } }while(0)
  DMA_K(0,0);DMA_V(0,0);DMA_K(1,SLOTB);
  bf16x8 qr[4];
  #pragma unroll
  for(int d0=0;d0<4;++d0)qr[d0]=*reinterpret_cast<const bf16x8*>(&Qw[(long)r32*DM+d0*16+hi*8]);
  float mhat=0.f,l_reg=0.f;f32x16 o[2];o[0]=f32x16{};o[1]=f32x16{};const f32x16 negm=f32x16{}; float nm=0.f;
  const int qrel=wid*QBLK+r32;
  #define CMASK(P0,P1,t) do{int jb_=(t)-(NT-4); if(jb_>=0)cmask(P0,P1,jb_,qrel,hi);}while(0)
  bool resc=false;
  #define START(P0,P1) do{ const float rm=rowmax(P0,P1); resc=false; \
    { const float dl=rm; mhat=fadd_s(mhat,dl); \
      _Pragma("unroll") for(int r=0;r<16;++r){P0[r]=fsub_s(P0[r],dl);P1[r]=fsub_s(P1[r],dl);} \
      nm=-mhat; } \
    _Pragma("unroll") for(int r=0;r<16;++r)P0[r]=__builtin_amdgcn_exp2f(P0[r]); }while(0)
  #define RESC() do{ if(resc){ asm volatile("s_waitcnt lgkmcnt(0)":::"memory"); \
      _Pragma("unroll") for(int d_=0;d_<2;++d_) _Pragma("unroll") for(int r=0;r<16;++r)o[d_][r]*=wsf[crow(r,hi)]; } }while(0)
  f32x16 pA0,pA1,pB0,pB1;
  int sl_prev=0,sl_cur=0,sl_next=SLOTB;
  #define ROT() do{sl_prev=sl_cur;sl_cur=sl_next;sl_next=(sl_next==(NSLOT-1)*SLOTB)?0:sl_next+SLOTB;}while(0)
  DMA_K(2,2*SLOTB);
  WAIT_BAR(3);
  qkt(pA0,pA1,Kbase,qr,negm,r32,hi);asm volatile("s_nop 15\n\ts_nop 7":"+v"(pA0),"+v"(pA1));BIAS(pA0,pA1,0);CMASK(pA0,pA1,0);
  START(pA0,pA1);
  _Pragma("unroll") for(int r=0;r<16;++r)pA1[r]=__builtin_amdgcn_exp2f(pA1[r]);
  WAIT_BAR(0);
  DMA_K(3,0);DMA_V(1,SLOTB);
  ROT();
  kload8(kf,kp0+sl_cur);
  WAIT_BAR(2);
  s16x4 vlo[8],vhi[8]; u32x4 pw0,pw1,pw2,pw3;
  #define PKW(P,B) cvtpk_s(P[B],P[B+1])
  #define PAF(k) __builtin_bit_cast(bf16x8,pw##k)
  #define VFR(i) (bf16x8){vlo[i][0],vlo[i][1],vlo[i][2],vlo[i][3],vhi[i][0],vhi[i][1],vhi[i][2],vhi[i][3]}
  #define PIN(x) asm volatile("":"+v"(x))
  #define MX3(a,b,c) __builtin_fmaxf(__builtin_fmaxf((a),(b)),(c))
  #define GAPA(MF,A0,A1,A2,A3,W0,W1,PW) do{ MF; sacc+=A0; sacc+=A1; sacc+=A2; sacc+=A3; PIN(sacc); W0; W1; PIN(PW); SBAR(); }while(0)
  #define EX(v) __builtin_amdgcn_exp2f(v)
  #define GAPB(MF,X,B) do{ MF; X[B]=EX(X[B]); X[B+1]=EX(X[B+1]); X[B+2]=EX(X[B+2]); X[B+3]=EX(X[B+3]); PIN(X); SBAR(); }while(0)
  #define VRD(i) do{ vlo[i]=vtr(vp_+(((i)>>2)*4096+((i)&3)*1024)); vhi[i]=vtr(vp_+(((i)>>2)*4096+((i)&3)*1024+512)); }while(0)
  #define KRD(G,j) do{ if(G){ kload2(kf,kp0+sl_next,j); SBAR(); } }while(0)
  #define STEP(C0,C1,P0,P1,t,GK,GV,GL) do{ SBAR(); \
    const lds_cptr vp_=vp0+sl_prev; \
    VRD(0); SBAR(); float sacc=(P0[0]+P0[1]); \
    GAPA(C0=__builtin_amdgcn_mfma_f32_32x32x16_bf16(kf[0],qr[0],negm,0,0,0), P0[2],P0[3],P0[4],P0[5],     pw0[0]=PKW(P0,0), pw0[1]=PKW(P0,2), pw0); \
    VRD(4); SBAR(); GAPA(C1=__builtin_amdgcn_mfma_f32_32x32x16_bf16(kf[1],qr[0],negm,0,0,0), P0[6],P0[7],P0[8],P0[9],     pw0[2]=PKW(P0,4), pw0[3]=PKW(P0,6), pw0); \
    VRD(1); SBAR(); GAPA(C0=__builtin_amdgcn_mfma_f32_32x32x16_bf16(kf[2],qr[1],C0,0,0,0),   P0[10],P0[11],P0[12],P0[13], pw1[0]=PKW(P0,8), pw1[1]=PKW(P0,10), pw1); \
    VRD(5); SBAR(); GAPA(C1=__builtin_amdgcn_mfma_f32_32x32x16_bf16(kf[3],qr[1],C1,0,0,0),   P0[14],P0[15],P1[0],P1[1],   pw1[2]=PKW(P0,12),pw1[3]=PKW(P0,14), pw1); \
    VRD(2); SBAR(); GAPA(C0=__builtin_amdgcn_mfma_f32_32x32x16_bf16(kf[4],qr[2],C0,0,0,0),   P1[2],P1[3],P1[4],P1[5],     pw2[0]=PKW(P1,0), pw2[1]=PKW(P1,2), pw2); \
    VRD(6); SBAR(); GAPA(C1=__builtin_amdgcn_mfma_f32_32x32x16_bf16(kf[5],qr[2],C1,0,0,0),   P1[6],P1[7],P1[8],P1[9],     pw2[2]=PKW(P1,4), pw2[3]=PKW(P1,6), pw2); \
    VRD(3); SBAR(); GAPA(C0=__builtin_amdgcn_mfma_f32_32x32x16_bf16(kf[6],qr[3],C0,0,0,0),   P1[10],P1[11],P1[12],P1[13], pw3[0]=PKW(P1,8), pw3[1]=PKW(P1,10), pw3); \
    VRD(7); SBAR(); GAPA(C1=__builtin_amdgcn_mfma_f32_32x32x16_bf16(kf[7],qr[3],C1,0,0,0),   P1[14],P1[15],0.f,0.f,       pw3[2]=PKW(P1,12),pw3[3]=PKW(P1,14), pw3); \
    l_reg+=sacc; \
    if(GK){DMA_K((t)+3,sl_cur);} if(GV){DMA_V((t)+1,sl_next);} \
    BIAS(C0,C1,t); CMASK(C0,C1,t); \
    { float a=MX3(C0[0],C0[1],C1[0]),b=MX3(C0[2],C0[3],C1[1]); a=MX3(a,C1[2],C1[3]); \
      _Pragma("unroll") for(int r=4;r<16;r+=4){a=MX3(a,C0[r],C0[r+1]);b=MX3(b,C0[r+2],C0[r+3]);a=MX3(a,C1[r],C1[r+1]);b=MX3(b,C1[r+2],C1[r+3]);} \
      float rm=__builtin_fmaxf(a,b); { auto rr=__builtin_amdgcn_permlane32_swap(__float_as_uint(rm),__float_as_uint(rm),false,false); rm=__builtin_fmaxf(__uint_as_float(rr[0]),__uint_as_float(rr[1])); } \
      resc=false; \
      if(__builtin_expect(__any(rm>(float)THRL),0)){ const float dl=__builtin_fmaxf(rm,0.f); mhat+=dl; \
        _Pragma("unroll") for(int r=0;r<16;++r){C0[r]-=dl;C1[r]-=dl;} \
        nm=-mhat; \
        const float f=__builtin_amdgcn_exp2f(-dl); l_reg*=f; if(hi==0)wsf[r32]=f; resc=true; } } \
    SBAR(); \
    GAPB(o[0]=__builtin_amdgcn_mfma_f32_32x32x16_bf16(PAF(0),VFR(0),o[0],0,0,0), C0,0); \
    GAPB(o[1]=__builtin_amdgcn_mfma_f32_32x32x16_bf16(PAF(0),VFR(4),o[1],0,0,0), C0,4); \
    KRD(GL,0); GAPB(o[0]=__builtin_amdgcn_mfma_f32_32x32x16_bf16(PAF(1),VFR(1),o[0],0,0,0), C0,8); \
    KRD(GL,1); GAPB(o[1]=__builtin_amdgcn_mfma_f32_32x32x16_bf16(PAF(1),VFR(5),o[1],0,0,0), C0,12); \
    KRD(GL,2); GAPB(o[0]=__builtin_amdgcn_mfma_f32_32x32x16_bf16(PAF(2),VFR(2),o[0],0,0,0), C1,0); \
    KRD(GL,3); GAPB(o[1]=__builtin_amdgcn_mfma_f32_32x32x16_bf16(PAF(2),VFR(6),o[1],0,0,0), C1,4); \
    GAPB(o[0]=__builtin_amdgcn_mfma_f32_32x32x16_bf16(PAF(3),VFR(3),o[0],0,0,0), C1,8); \
    GAPB(o[1]=__builtin_amdgcn_mfma_f32_32x32x16_bf16(PAF(3),VFR(7),o[1],0,0,0), C1,12); \
    }while(0)
  int t=1;
  #undef CMASK
  #define CMASK(P0,P1,t) do{}while(0)
  for(;t+5<NT;t+=2){
    STEP(pB0,pB1,pA0,pA1,t,true,true,true);     WAIT_BAR(2); RESC(); ROT();
    STEP(pA0,pA1,pB0,pB1,t+1,true,true,true);   WAIT_BAR(2); RESC(); ROT();
  }
  #undef CMASK
  #define CMASK(P0,P1,t) do{int jb_=(t)-(NT-4); if(jb_>=0)cmask(P0,P1,jb_,qrel,hi);}while(0)
  #define ENDW(tt) do{ if((tt)+3<NT){WAIT_BAR(2);} else if((tt)+2<NT){WAIT_BAR(1);} else {WAIT_BAR(0);} }while(0)
  for(;t+1<NT;t+=2){
    STEP(pB0,pB1,pA0,pA1,t,(t+3<NT),(t+1<NT),(t+1<NT));       ENDW(t);   RESC(); ROT();
    STEP(pA0,pA1,pB0,pB1,t+1,(t+4<NT),(t+2<NT),(t+2<NT));     ENDW(t+1); RESC(); ROT();
  }
  STEP(pB0,pB1,pA0,pA1,NT-1,false,false,false); RESC();
  { float sacc=pB0[0]+pB0[1]; _Pragma("unroll") for(int r=2;r<16;++r)sacc+=pB0[r]; _Pragma("unroll") for(int r=0;r<16;++r)sacc+=pB1[r]; l_reg+=sacc;
    pw0=(u32x4){PKW(pB0,0),PKW(pB0,2),PKW(pB0,4),PKW(pB0,6)};pw1=(u32x4){PKW(pB0,8),PKW(pB0,10),PKW(pB0,12),PKW(pB0,14)};pw2=(u32x4){PKW(pB1,0),PKW(pB1,2),PKW(pB1,4),PKW(pB1,6)};pw3=(u32x4){PKW(pB1,8),PKW(pB1,10),PKW(pB1,12),PKW(pB1,14)};
    SBAR(); pv(o,vb0+sl_cur,PAF(0),PAF(1),PAF(2),PAF(3)); }
  #undef PKW
  #undef PAF
  #undef VFR
  #undef PIN
  #undef MX3
  #undef GAPA
  #undef GAPB
  #undef EX
  #undef VRD
  #undef KRD
  #undef STEP
  #undef ENDW
  {auto rr=__builtin_amdgcn_permlane32_swap(__float_as_uint(l_reg),__float_as_uint(l_reg),false,false);l_reg=__uint_as_float(rr[0])+__uint_as_float(rr[1]);}
  if(hi==0)wsf[32+r32]=l_reg;asm volatile("s_waitcnt lgkmcnt(0)":::"memory");
  float rli[16];
  #pragma unroll
  for(int r=0;r<16;++r)rli[r]=__builtin_amdgcn_rcpf(wsf[32+crow(r,hi)]);
  bf16*Ow=O+(rowbase+q0+wid*QBLK)*DM+h*D;
  { bf16*stg=(bf16*)(shm+LDS_OST)+wid*2048;
    #pragma unroll
    for(int r=0;r<16;++r){const int orow=crow(r,hi);
      #pragma unroll
      for(int d0=0;d0<2;++d0)stg[orow*64+d0*32+r32]=__float2bfloat16(o[d0][r]*rli[r]);}
    asm volatile("s_waitcnt lgkmcnt(0)":::"memory");
    #pragma unroll
    for(int i=0;i<4;++i){const int row=i*8+(lane>>3),ch=lane&7; const u32x4 v=*(const u32x4*)(stg+row*64+ch*8); ATTN_STORE16(Ow+(long)row*DM+ch*8,v);} }
  asm volatile("s_waitcnt lgkmcnt(0)\n\ts_barrier":::"memory");
  #undef BIAS
  #undef DMA_K
  #undef DMA_V
  #undef CMASK
  #undef START
  #undef RESC
  #undef ROT
}
constexpr int ATTN_LDS_BYTES=86016+32768;
struct AttnTensors { const bf16* Q; const bf16* K; const bf16* V; bf16* O; const float* FB; float skip_thr; int pad; };
struct AttnUnit { int bh; int qb; };
struct StaticOrder {
  int vcu;
  __device__ __forceinline__ explicit StaticOrder(int grid,int block):vcu((block%8)*(grid/8)+block/8){}
  __device__ __forceinline__ bool next(int i,AttnUnit&u)const{ if(i>=4)return false; const int s=vcu&7; u.bh=vcu>>3; u.qb=(i==0)?s:(i==1)?15-s:(i==2)?16+s:31-s; return true; }
  __device__ __forceinline__ void a_ready(const AttnUnit&)const{}
  __device__ __forceinline__ void done(const AttnUnit&)const{}
};
struct QueueOrder {
  unsigned* ctr; int xl; volatile __attribute__((address_space(3))) int* slot;
  __device__ __forceinline__ bool next(int,AttnUnit&u)const{
    if(mk_tid()==0){ int got=-1;
      for(int k=0;k<8&&got<0;++k){ const int q=(xl+k)&7; const int j=(int)__hip_atomic_fetch_add(ctr+q*64,1u,__ATOMIC_RELAXED,__HIP_MEMORY_SCOPE_AGENT); if(j<128)got=q*128+j; }
      *slot=got; }
    __syncthreads(); const int g=*slot; if(g<0)return false; const int q=g>>7,j=g&127; u.bh=q*4+(j&3); u.qb=31-(j>>2); return true; }
  __device__ __forceinline__ void a_ready(const AttnUnit&)const{}
  __device__ __forceinline__ void done(const AttnUnit&)const{}
};
template<class Sched,int THRL=8> __device__ __forceinline__ void attn_phase(char*lds,const AttnTensors&T,const Sched&S){
  AttnUnit u;
  for(int i=0;S.next(i,u);++i){ S.a_ready(u); attn_unit<THRL>(u.bh/NHEAD,u.bh%NHEAD,u.qb,T.Q,T.K,T.V,T.O,T.FB+(size_t)u.bh*SEQ,T.skip_thr,lds); S.done(u); }
}
#undef SBAR
#undef WAIT_BAR
}
namespace cg = cooperative_groups;
#define LAS __attribute__((address_space(3)))
#define LDS_WAIT() asm volatile("s_waitcnt lgkmcnt(0)" ::: "memory")
#define LDS_BAR() asm volatile("s_waitcnt lgkmcnt(0)\n\ts_barrier" ::: "memory")
constexpr int MEGA_THREADS = 512, MEGA_LDS = 147456, NWV = 8;
#define GAS __attribute__((address_space(1)))
#define XB_TMO      128
#define XB_XCNT(j)  (256  + 64 * (j))
#define XB_XSUB(j)  (1280 + 64 * (j))
#define XB_XGEN(j)  (2304 + 64 * (j))
#define XB_TOP      3328
#define XB_TOPGEN   3392
#define XCD_BAR_WORDS 3456
#define XB_SPIN_CAP (1u << 18)

__device__ __forceinline__ unsigned xb_ld(unsigned* p)              { return __hip_atomic_load(p, __ATOMIC_RELAXED, __HIP_MEMORY_SCOPE_AGENT); }
__device__ __forceinline__ unsigned xb_add(unsigned* p, unsigned v) { return __hip_atomic_fetch_add(p, v, __ATOMIC_RELAXED, __HIP_MEMORY_SCOPE_AGENT); }
__device__ __forceinline__ unsigned xb_xcc_id() { return (unsigned)__builtin_amdgcn_s_getreg((3 << 11) | 20) & 0xFu; }
#define XB_SPIN(cond, bar) do { unsigned _sp = 0; while (cond) { __builtin_amdgcn_s_sleep(1); \
    if ((++_sp & 255u) == 0u) { if (xb_ld(&(bar)[XB_TMO])) break; if (_sp > XB_SPIN_CAP) { atomicAdd(&(bar)[XB_TMO], 1u); break; } } } } while (0)

struct XcdBarrier {
    unsigned* bar; unsigned x;
    volatile LAS unsigned* st;
};

__device__ __forceinline__ XcdBarrier xcd_barrier_post(unsigned* bar, volatile LAS unsigned* st) {
    XcdBarrier b; b.bar = bar; b.x = xb_xcc_id(); b.st = st;
    if (threadIdx.x == 0) (void)xb_add(&bar[XB_XCNT(b.x)], 1u);
    return b;
}
__device__ __forceinline__ void xcd_barrier_complete(unsigned* bar, unsigned x, unsigned& nloc, unsigned& nx) {
    const unsigned G = gridDim.x * gridDim.y * gridDim.z;
    unsigned sum, cnt, mine, sp = 0u;
    for (;;) {
        sum = 0u; cnt = 0u; mine = 0u;
#pragma unroll
        for (unsigned j = 0; j < 16; ++j) { const unsigned c = xb_ld(&bar[XB_XCNT(j)]); sum += c; cnt += (c > 0u) ? 1u : 0u; mine = (j == x) ? c : mine; }
        if (sum == G) break;
        __builtin_amdgcn_s_sleep(1);
        if ((++sp & 255u) == 0u) { if (xb_ld(&bar[XB_TMO])) break; if (sp > XB_SPIN_CAP) { atomicAdd(&bar[XB_TMO], 1u); break; } }
    }
    nloc = mine > 0u ? mine : 1u; nx = cnt > 0u ? cnt : 1u;
}

__device__ __forceinline__ void xcd_barrier(const XcdBarrier& b) {
    asm volatile("s_waitcnt vmcnt(0)" ::: "memory");
    __syncthreads();
    if (threadIdx.x == 0) {
        unsigned* bar = b.bar;
        __builtin_amdgcn_s_waitcnt(0);
        unsigned nloc = b.st[0], nx = b.st[1];
        if (nloc == 0u) { xcd_barrier_complete(bar, b.x, nloc, nx); b.st[0] = nloc; b.st[1] = nx; }
        const unsigned old = xb_add(&bar[XB_XSUB(b.x)], 1u);
        const unsigned gen = old / nloc;
        if (old + 1u == (gen + 1u) * nloc) {
            __builtin_amdgcn_fence(__ATOMIC_RELEASE, "agent");
            asm volatile("s_waitcnt vmcnt(0)" ::: "memory");
            const unsigned og = xb_add(&bar[XB_TOP], 1u);
            const unsigned tg = og / nx;
            if (og + 1u == (tg + 1u) * nx) xb_add(&bar[XB_TOPGEN], 1u);
            else XB_SPIN(xb_ld(&bar[XB_TOPGEN]) == tg, bar);
            __builtin_amdgcn_fence(__ATOMIC_ACQUIRE, "agent");
            xb_add(&bar[XB_XGEN(b.x)], 1u);
            asm volatile("s_waitcnt vmcnt(0)" ::: "memory");
        } else {
            XB_SPIN(xb_ld(&bar[XB_XGEN(b.x)]) == gen, bar);
            __builtin_amdgcn_fence(__ATOMIC_ACQUIRE, "agent");
            asm volatile("s_waitcnt vmcnt(0)" ::: "memory");
        }
    }
    __syncthreads();
}
constexpr size_t WS_BAR = WS_CTL + 16384;
constexpr size_t WS_QCTR = WS_CTL + 32768;
constexpr size_t CTL_ZERO_BYTES = 65536 - 16384;
constexpr int XB_LDS_OFF = MEGA_LDS - 64;
constexpr size_t WT_IN = 0;
constexpr size_t WT_BR = WT_IN + (size_t)13312 * 1024 * 2;
constexpr size_t WT_OUT = WT_BR + (size_t)4096 * 1024 * 2;
constexpr size_t WT_UP = WT_OUT + (size_t)1024 * 1024 * 2;
constexpr size_t WT_DN = WT_UP + (size_t)5632 * 1024 * 2;
static_assert(WT_DN + (size_t)1024 * 2816 * 2 <= 72 * MiB, "weight copies");
constexpr size_t WS_WKVT = WS_GATES;
constexpr size_t WS_CB = WS_CTL + 4096;

typedef float f32x4 __attribute__((ext_vector_type(4)));
typedef unsigned u32x4 __attribute__((ext_vector_type(4)));
typedef short bf16x8_t __attribute__((ext_vector_type(8)));
typedef float f32x16_t __attribute__((ext_vector_type(16)));
__device__ __forceinline__ unsigned pk2(float lo, float hi) { return (unsigned)f2bf(lo) | ((unsigned)f2bf(hi) << 16); }
__device__ __forceinline__ float blo(unsigned u) { return __uint_as_float(u << 16); }
__device__ __forceinline__ float bhi(unsigned u) { return __uint_as_float(u & 0xffff0000u); }
__device__ __forceinline__ float fast_softplus(float x) { return fmaxf(x, 0.f) + __logf(1.f + __expf(-fabsf(x))); }
__device__ __forceinline__ float fast_sigmoid(float x) { return __builtin_amdgcn_rcpf(1.f + __expf(-x)); }
__device__ __forceinline__ float fast_tanh(float x) { const float e = __expf(-2.f * fabsf(x)); const float t = (1.f - e) * __builtin_amdgcn_rcpf(1.f + e); return x < 0.f ? -t : t; }
__device__ __forceinline__ float fast_gelu(float x) { const float u = 0.7978845608028654f * (x + 0.044715f * x * x * x); return 0.5f * x * (1.f + fast_tanh(u)); }

template <class Loc> struct LocOrder {
    pg8::StaticOrder so; Loc loc;
    __device__ __forceinline__ bool next(int i, pg8::Unit& u) const { return so.next(i, u); }
    __device__ __forceinline__ const char* aptr(const pg8::Unit& u) const { return loc.a(u); }
    __device__ __forceinline__ const char* bptr(const pg8::Unit& u) const { return loc.b(u); }
    __device__ __forceinline__ void a_ready(const pg8::Unit&) const {}
    __device__ __forceinline__ void done(const pg8::Unit&) const {}
};
struct LocStd { const char* A; const char* Bt; size_t astep, bstep;
    __device__ __forceinline__ const char* a(const pg8::Unit& u) const { return A + (size_t)u.pm * astep; }
    __device__ __forceinline__ const char* b(const pg8::Unit& u) const { return Bt + (size_t)u.pn * bstep; } };
struct LocBranch { const char* Y0; const char* Y1; const char* Y2; const char* Y3; const char* Bt;
    __device__ __forceinline__ const char* a(const pg8::Unit& u) const { const int i = u.pn >> 2; const char* y = i == 0 ? Y0 : i == 1 ? Y1 : i == 2 ? Y2 : Y3; return y + (size_t)u.pm * (256 * 1024 * 2); }
    __device__ __forceinline__ const char* b(const pg8::Unit& u) const { return Bt + (size_t)u.pn * (256 * 1024 * 2); } };
struct LocMemKV { const char* A; const char* Bt;
    __device__ __forceinline__ const char* a(const pg8::Unit& u) const { return A + (size_t)u.pm * (256 * 1024 * 2); }
    __device__ __forceinline__ const char* b(const pg8::Unit& u) const { return Bt + ((size_t)(u.pm >> 1) * 2048 + (size_t)u.pn * 256) * 2048; } };
struct LocMemS { const char* MQ; const char* MK;
    __device__ __forceinline__ const char* a(const pg8::Unit& u) const { return MQ + (size_t)u.pm * (256 * 2048) + u.pn * 512; }
    __device__ __forceinline__ const char* b(const pg8::Unit& u) const { return MK + (size_t)(u.pm >> 5) * (256 * 2048) + u.pn * 512; } };
struct LocMemPV { const char* E; const char* MVT;
    __device__ __forceinline__ const char* a(const pg8::Unit& u) const { return E + (size_t)u.pm * (256 * 2048) + u.pn * 512; }
    __device__ __forceinline__ const char* b(const pg8::Unit& u) const { return MVT + ((size_t)(u.pm >> 5) * 4 + u.pn) * (256 * 256 * 2); } };

struct BranchSched { int vcu; LocBranch loc;
    __device__ __forceinline__ bool next(int i, pg8::Unit& u) const { if (i >= 4) return false; u.pm = vcu >> 2; u.pn = i * 4 + (vcu & 3); return true; }
    __device__ __forceinline__ const char* aptr(const pg8::Unit& u) const { return loc.a(u); }
    __device__ __forceinline__ const char* bptr(const pg8::Unit& u) const { return loc.b(u); }
    __device__ __forceinline__ void a_ready(const pg8::Unit&) const {}
    __device__ __forceinline__ void done(const pg8::Unit&) const {}
};
typedef f32x4 AccT[2][2][4][2];
struct EpiProj { static constexpr bool PERM = true, AFTER_DRAIN = false; bf16_t* proj; bf16_t* gates; float* mqss;
    __device__ __forceinline__ void operator()(const AccT& acc, const pg8::Unit& u, int wr, int wc, int fr, int fq) const {
        int colt = u.pn * 256; const int grp = colt >> 10; bf16_t* base; int ldc;
        if (grp < 9) { base = proj + (size_t)grp * T * DM; ldc = DM; colt &= 1023; } else { base = gates; ldc = 4096; colt -= 9216; }
        const int row0 = u.pm * 256 + wr * 64 + fr, col0 = colt + wc * 32 + 8 * fq;
#pragma unroll
        for (int ai = 0; ai < 2; ++ai)
#pragma unroll
            for (int m = 0; m < 4; ++m) { const int row = row0 + ai * 128 + m * 16; bf16_t* rowp = base + (size_t)row * ldc + col0; float ss = 0.f;
#pragma unroll
                for (int bj = 0; bj < 2; ++bj) { const f32x4 v0 = acc[ai][bj][m][0], v1 = acc[ai][bj][m][1]; u32x4 w; w.x = pk2(v0[0], v0[1]); w.y = pk2(v0[2], v0[3]); w.z = pk2(v1[0], v1[1]); w.w = pk2(v1[2], v1[3]);
                    *(u32x4*)(rowp + bj * 128) = w;
                    if (grp == 8) { ss += blo(w.x) * blo(w.x) + bhi(w.x) * bhi(w.x) + blo(w.y) * blo(w.y) + bhi(w.y) * bhi(w.y) + blo(w.z) * blo(w.z) + bhi(w.z) * bhi(w.z) + blo(w.w) * blo(w.w) + bhi(w.w) * bhi(w.w); } }
                if (grp == 8) { ss += __shfl_xor(ss, 16); ss += __shfl_xor(ss, 32); if (fq == 0) mqss[(size_t)row * 16 + (colt >> 8) * 4 + wc] = ss; } }
    } };
struct EpiBf16P { static constexpr bool PERM = true, AFTER_DRAIN = false; bf16_t* O; int ldc; int pad;
    __device__ __forceinline__ void operator()(const AccT& acc, const pg8::Unit& u, int wr, int wc, int fr, int fq) const {
        const int row0 = u.pm * 256 + wr * 64 + fr, col0 = u.pn * 256 + wc * 32 + 8 * fq;
#pragma unroll
        for (int ai = 0; ai < 2; ++ai)
#pragma unroll
            for (int m = 0; m < 4; ++m) { bf16_t* rowp = O + (size_t)(row0 + ai * 128 + m * 16) * ldc + col0;
#pragma unroll
                for (int bj = 0; bj < 2; ++bj) { const f32x4 v0 = acc[ai][bj][m][0], v1 = acc[ai][bj][m][1]; u32x4 w; w.x = pk2(v0[0], v0[1]); w.y = pk2(v0[2], v0[3]); w.z = pk2(v1[0], v1[1]); w.w = pk2(v1[2], v1[3]);
                    *(u32x4*)(rowp + bj * 128) = w; } }
    } };
struct EpiF32 { static constexpr bool PERM = false, AFTER_DRAIN = false; float* O; int ldc; int pad;
    __device__ __forceinline__ void operator()(const AccT& acc, const pg8::Unit& u, int wr, int wc, int fr, int fq) const {
        const int row0 = u.pm * 256 + wr * 64 + fr, col0 = u.pn * 256 + wc * 32 + 4 * fq;
#pragma unroll
        for (int ai = 0; ai < 2; ++ai)
#pragma unroll
            for (int m = 0; m < 4; ++m) { float* rowp = O + (size_t)(row0 + ai * 128 + m * 16) * ldc + col0;
#pragma unroll
                for (int bj = 0; bj < 2; ++bj)
#pragma unroll
                    for (int n = 0; n < 2; ++n) *(f32x4*)(rowp + bj * 128 + n * 16) = acc[ai][bj][m][n]; }
    } };
struct EpiResid { static constexpr bool PERM = false, AFTER_DRAIN = false; const float* base; float* out;
    __device__ __forceinline__ void operator()(const AccT& acc, const pg8::Unit& u, int wr, int wc, int fr, int fq) const {
        const int row0 = u.pm * 256 + wr * 64 + fr, col0 = u.pn * 256 + wc * 32 + 4 * fq;
#pragma unroll
        for (int ai = 0; ai < 2; ++ai)
#pragma unroll
            for (int m = 0; m < 4; ++m) { const size_t off = (size_t)(row0 + ai * 128 + m * 16) * DM + col0;
#pragma unroll
                for (int bj = 0; bj < 2; ++bj)
#pragma unroll
                    for (int n = 0; n < 2; ++n) { const f32x4 b = *(const f32x4*)(base + off + bj * 128 + n * 16); *(f32x4*)(out + off + bj * 128 + n * 16) = b + acc[ai][bj][m][n]; } }
    } };
struct EpiBranch { static constexpr bool PERM = true, AFTER_DRAIN = false; const bf16_t* G; const float* bg; float* MIXF; bf16_t* MIXED;
    __device__ __forceinline__ void operator()(const AccT& acc, const pg8::Unit& u, int wr, int wc, int fr, int fq) const {
        const int i = u.pn >> 2, row0 = u.pm * 256 + wr * 64 + fr, gcol0 = u.pn * 256 + wc * 32 + 8 * fq, mcol0 = (u.pn & 3) * 256 + wc * 32 + 8 * fq;
#pragma unroll
        for (int ai = 0; ai < 2; ++ai)
#pragma unroll
            for (int m = 0; m < 4; ++m) { const int row = row0 + ai * 128 + m * 16; const bf16_t* gp = G + (size_t)row * 4096 + gcol0; const size_t mo = (size_t)row * DM + mcol0;
#pragma unroll
                for (int bj = 0; bj < 2; ++bj) { const u32x4 gw = *(const u32x4*)(gp + bj * 128); const f32x4 b0 = *(const f32x4*)(bg + gcol0 + bj * 128), b1 = *(const f32x4*)(bg + gcol0 + bj * 128 + 4);
                    f32x4 v0 = acc[ai][bj][m][0], v1 = acc[ai][bj][m][1];
                    v0[0] *= fast_sigmoid(blo(gw.x) + b0[0]); v0[1] *= fast_sigmoid(bhi(gw.x) + b0[1]); v0[2] *= fast_sigmoid(blo(gw.y) + b0[2]); v0[3] *= fast_sigmoid(bhi(gw.y) + b0[3]);
                    v1[0] *= fast_sigmoid(blo(gw.z) + b1[0]); v1[1] *= fast_sigmoid(bhi(gw.z) + b1[1]); v1[2] *= fast_sigmoid(blo(gw.w) + b1[2]); v1[3] *= fast_sigmoid(bhi(gw.w) + b1[3]);
                    if (i > 0) { v0 += *(const f32x4*)(MIXF + mo + bj * 128); v1 += *(const f32x4*)(MIXF + mo + bj * 128 + 4); }
                    if (i < 3) { *(f32x4*)(MIXF + mo + bj * 128) = v0; *(f32x4*)(MIXF + mo + bj * 128 + 4) = v1; }
                    else { u32x4 w; w.x = pk2(v0[0], v0[1]); w.y = pk2(v0[2], v0[3]); w.z = pk2(v1[0], v1[1]); w.w = pk2(v1[2], v1[3]); *(u32x4*)(MIXED + mo + bj * 128) = w; } }
                asm volatile("" ::: "memory"); }
    } };
struct EpiSexp { static constexpr bool PERM = true, AFTER_DRAIN = false; bf16_t* E; const float* mqss; float* esum; const float* cb;
    __device__ __forceinline__ void operator()(const AccT& acc, const pg8::Unit& u, int wr, int wc, int fr, int fq) const {
        const int row0 = u.pm * 256 + wr * 64 + fr, col0 = u.pn * 256 + wc * 32 + 8 * fq; const float shift = cb[0];
#pragma unroll
        for (int ai = 0; ai < 2; ++ai)
#pragma unroll
            for (int m = 0; m < 4; ++m) { const int row = row0 + ai * 128 + m * 16; const f32x4 p = *(const f32x4*)(mqss + (size_t)row * 16 + u.pn * 4);
                const float sc = rsqrtf(((p[0] + p[1]) + (p[2] + p[3])) * (1.f / 256.f) + EPS) * (1.f / 16.f); bf16_t* rowp = E + (size_t)row * DM + col0; float sum = 0.f;
#pragma unroll
                for (int bj = 0; bj < 2; ++bj) { const f32x4 v0 = acc[ai][bj][m][0], v1 = acc[ai][bj][m][1]; u32x4 w;
                    w.x = pk2(__expf(v0[0] * sc - shift), __expf(v0[1] * sc - shift)); w.y = pk2(__expf(v0[2] * sc - shift), __expf(v0[3] * sc - shift));
                    w.z = pk2(__expf(v1[0] * sc - shift), __expf(v1[1] * sc - shift)); w.w = pk2(__expf(v1[2] * sc - shift), __expf(v1[3] * sc - shift));
                    *(u32x4*)(rowp + bj * 128) = w;
                    sum += (blo(w.x) + bhi(w.x)) + (blo(w.y) + bhi(w.y)) + (blo(w.z) + bhi(w.z)) + (blo(w.w) + bhi(w.w)); }
                sum += __shfl_xor(sum, 16); sum += __shfl_xor(sum, 32); if (fq == 0) esum[(size_t)row * 16 + u.pn * 4 + wc] = sum;
                asm volatile("" ::: "memory"); }
    } };
struct EpiMemPV { static constexpr bool PERM = true, AFTER_DRAIN = false; bf16_t* Y; const float* esum;
    __device__ __forceinline__ void operator()(const AccT& acc, const pg8::Unit& u, int wr, int wc, int fr, int fq) const {
        const int row0 = u.pm * 256 + wr * 64 + fr, col0 = u.pn * 256 + wc * 32 + 8 * fq;
#pragma unroll
        for (int ai = 0; ai < 2; ++ai)
#pragma unroll
            for (int m = 0; m < 4; ++m) { const int row = row0 + ai * 128 + m * 16; const f32x4 p = *(const f32x4*)(esum + (size_t)row * 16 + u.pn * 4);
                const float il = 1.f / ((p[0] + p[1]) + (p[2] + p[3])); bf16_t* rowp = Y + (size_t)row * DM + col0;
#pragma unroll
                for (int bj = 0; bj < 2; ++bj) { const f32x4 v0 = acc[ai][bj][m][0] * il, v1 = acc[ai][bj][m][1] * il; u32x4 w; w.x = pk2(v0[0], v0[1]); w.y = pk2(v0[2], v0[3]); w.z = pk2(v1[0], v1[1]); w.w = pk2(v1[2], v1[3]);
                    *(u32x4*)(rowp + bj * 128) = w; }
                asm volatile("" ::: "memory"); }
    } };

__device__ __forceinline__ void tr_item(const float* __restrict__ W, int ldw, bf16_t* __restrict__ WT, int ldk, int nblk, LAS float* scr, int item, int lane, int ncopies, int cstride) {
    const int kb = item / nblk, nb = item % nblk, k0 = 64 * kb, n0 = 32 * nb;
#pragma unroll
    for (int i = 0; i < 32; ++i) { const int kk = 2 * i + (lane >> 5); scr[kk * 33 + (lane & 31)] = W[(size_t)(k0 + kk) * ldw + n0 + (lane & 31)]; }
    LDS_WAIT(); asm volatile("" ::: "memory");
    const int c = lane & 7;
#pragma unroll
    for (int j = 0; j < 4; ++j) { const int n = (lane >> 3) + 8 * j; const LAS float* s = scr + (8 * c) * 33 + n;
        u32x4 o; o.x = pk2(s[0 * 33], s[1 * 33]); o.y = pk2(s[2 * 33], s[3 * 33]); o.z = pk2(s[4 * 33], s[5 * 33]); o.w = pk2(s[6 * 33], s[7 * 33]);
        for (int cp = 0; cp < ncopies; ++cp) *(u32x4*)(WT + (size_t)(n0 + n) * ldk + k0 + 8 * c + cp * cstride) = o; }
    LDS_WAIT(); asm volatile("" ::: "memory");
}
__device__ __forceinline__ void norm_row(f32x4 (&v)[4], const float* __restrict__ g, bf16_t* __restrict__ hrow, const LAS float* WfT, bool do_logf, const float* __restrict__ bfg, float* __restrict__ LOGF, int row, int lane) {
    const f32x4* gr = (const f32x4*)g; float ss = 0.f;
#pragma unroll
    for (int j = 0; j < 4; ++j) ss += (v[j][0] * v[j][0] + v[j][1] * v[j][1]) + (v[j][2] * v[j][2] + v[j][3] * v[j][3]);
    ss = wave_sum(ss);
    const float rstd = rsqrtf(ss * (1.f / DM) + EPS);
#pragma unroll
    for (int j = 0; j < 4; ++j) { v[j] = v[j] * rstd * gr[lane + 64 * j];
        uint2 o; o.x = pk2(v[j][0], v[j][1]); o.y = pk2(v[j][2], v[j][3]); ((uint2*)hrow)[lane + 64 * j] = o; }
    if (do_logf) {
        float p[16];
#pragma unroll
        for (int h = 0; h < 16; ++h) { float a = 0.f;
#pragma unroll
            for (int j = 0; j < 4; ++j) { const f32x4 w = *(const LAS f32x4*)(WfT + h * 1024 + (lane + 64 * j) * 4); a += (v[j][0] * w[0] + v[j][1] * w[1]) + (v[j][2] * w[2] + v[j][3] * w[3]); }
            p[h] = a; if ((h & 3) == 3) __builtin_amdgcn_sched_barrier(0); }
        const bool b5 = lane & 32, b4 = lane & 16, b3 = lane & 8, b2 = lane & 4;
        float q8[8], q4[4], q2[2];
#pragma unroll
        for (int i = 0; i < 8; ++i) { const float send = b5 ? p[i] : p[i + 8], keep = b5 ? p[i + 8] : p[i]; q8[i] = keep + __shfl_xor(send, 32); }
#pragma unroll
        for (int i = 0; i < 4; ++i) { const float send = b4 ? q8[i] : q8[i + 4], keep = b4 ? q8[i + 4] : q8[i]; q4[i] = keep + __shfl_xor(send, 16); }
#pragma unroll
        for (int i = 0; i < 2; ++i) { const float send = b3 ? q4[i] : q4[i + 2], keep = b3 ? q4[i + 2] : q4[i]; q2[i] = keep + __shfl_xor(send, 8); }
        float q1 = (b2 ? q2[1] : q2[0]) + __shfl_xor(b2 ? q2[0] : q2[1], 4);
        q1 += __shfl_xor(q1, 2); q1 += __shfl_xor(q1, 1);
        const int h = (b5 ? 8 : 0) + (b4 ? 4 : 0) + (b3 ? 2 : 0) + (b2 ? 1 : 0);
        if ((lane & 3) == 0) { const int b = row / SEQ, t = row % SEQ; LOGF[((size_t)b * 16 + h) * SEQ + t] = logsigmoidf(q1 + bfg[h]); }
    }
}
__device__ __forceinline__ void norm_rows(const float* __restrict__ x, int nrows, int gw, int NGW, const float* __restrict__ g, bf16_t* __restrict__ H, const LAS float* WfT, bool do_logf, const float* __restrict__ bfg, float* __restrict__ LOGF, int lane) {
    f32x4 nx[4];
    if (gw < nrows) {
#pragma unroll
        for (int j = 0; j < 4; ++j) nx[j] = ((const f32x4*)(x + (size_t)gw * DM))[lane + 64 * j]; }
    for (int m = gw; m < nrows; m += NGW) {
        f32x4 v[4];
#pragma unroll
        for (int j = 0; j < 4; ++j) v[j] = nx[j];
        if (m + NGW < nrows) {
#pragma unroll
            for (int j = 0; j < 4; ++j) nx[j] = ((const f32x4*)(x + (size_t)(m + NGW) * DM))[lane + 64 * j]; }
        norm_row(v, g, H + (size_t)m * DM, WfT, do_logf, bfg, LOGF, m, lane);
    }
}
__device__ __forceinline__ void headnorm64_row(bf16_t* row, const float* __restrict__ g, float scale, int lane) {
    u32x4* p = (u32x4*)row + lane * 2; u32x4 a = p[0], b = p[1];
    float v[16] = {blo(a.x), bhi(a.x), blo(a.y), bhi(a.y), blo(a.z), bhi(a.z), blo(a.w), bhi(a.w), blo(b.x), bhi(b.x), blo(b.y), bhi(b.y), blo(b.z), bhi(b.z), blo(b.w), bhi(b.w)};
    float ss = 0.f;
#pragma unroll
    for (int i = 0; i < 16; ++i) ss += v[i] * v[i];
    ss += __shfl_xor(ss, 1); ss += __shfl_xor(ss, 2);
    const float rstd = rsqrtf(ss * (1.f / 64.f) + EPS) * scale; const f32x4* gp = (const f32x4*)(g + (lane & 3) * 16);
#pragma unroll
    for (int i = 0; i < 4; ++i) { const f32x4 gg = gp[i]; v[4 * i] *= rstd * gg[0]; v[4 * i + 1] *= rstd * gg[1]; v[4 * i + 2] *= rstd * gg[2]; v[4 * i + 3] *= rstd * gg[3]; }
    a.x = pk2(v[0], v[1]); a.y = pk2(v[2], v[3]); a.z = pk2(v[4], v[5]); a.w = pk2(v[6], v[7]); b.x = pk2(v[8], v[9]); b.y = pk2(v[10], v[11]); b.z = pk2(v[12], v[13]); b.w = pk2(v[14], v[15]);
    p[0] = a; p[1] = b;
}
__device__ __forceinline__ void cumsum_block(const float* __restrict__ src, float* __restrict__ dst, LAS float* part, int tid) {
    const int lane = tid & 63, wave = tid >> 6; const f32x4* s4 = (const f32x4*)(src + tid * 16); float v[16]; float s = 0.f;
#pragma unroll
    for (int i = 0; i < 4; ++i) { const f32x4 x = s4[i]; s += x[0]; v[4 * i] = s; s += x[1]; v[4 * i + 1] = s; s += x[2]; v[4 * i + 2] = s; s += x[3]; v[4 * i + 3] = s; }
    float incl = s;
#pragma unroll
    for (int o = 1; o < 64; o <<= 1) { const float t_ = __shfl_up(incl, o); if (lane >= o) incl += t_; }
    __syncthreads();
    if (lane == 63) part[wave] = incl;
    __syncthreads();
    float off = incl - s;
    for (int w = 0; w < wave; ++w) off += part[w];
    f32x4* d4 = (f32x4*)(dst + tid * 16);
#pragma unroll
    for (int i = 0; i < 4; ++i) d4[i] = (f32x4){off + v[4 * i], off + v[4 * i + 1], off + v[4 * i + 2], off + v[4 * i + 3]};
}

__device__ __forceinline__ float neg_expm1_small(float x) {
    const float p = -x * (1.f + x * (0.5f + x * (0.16666667f + x * (0.041666668f + x * (0.0083333338f + x * 0.0013888889f)))));
    return x > -0.25f ? p : 1.f - __expf(x);
}
constexpr int LRU_XCB = 0, LRU_WT = 9216, LRU_R = LRU_WT + 18432, LRU_SEG = LRU_R + 33792;
template <bool FINAL> __device__ __forceinline__ void lru_load(int it, int n, const bf16_t* __restrict__ LX, const bf16_t* __restrict__ LG, float (&xw)[11], float (&gl)[8], int tid) {
    const int b = it >> 11, c = (it >> 4) & 127, e = tid & 63, tg = tid >> 6, ch = n * 64 + e, t0 = c * 64 + tg * 8;
#pragma unroll
    for (int j = 0; j < 11; ++j) { const int t = t0 + j - 3; xw[j] = t >= 0 ? bf2f(LX[((size_t)b * SEQ + t) * DM + ch]) : 0.f; }
    if (FINAL) {
#pragma unroll
        for (int j = 0; j < 8; ++j) gl[j] = bf2f(LG[((size_t)b * SEQ + t0 + j) * DM + ch]); }
}
template <bool FINAL> __device__ __forceinline__ void lru_item(int b, int c, int n, const float (&xw)[11], const float (&gl)[8], bf16_t* __restrict__ YL,
        const float w0, const float w1, const float w2, const float w3, const float bc, const float bA, const float bX,
        const float spl, float* APROD, float* HEND, LAS unsigned char* lds, int tid, int kseg) {
    const int e = tid & 63, tg = tid >> 6, ch = n * 64 + e, lane = e, wv = tg;
    LAS float* R = (LAS float*)(lds + LRU_R);
    LAS float* segP = (LAS float*)(lds + LRU_SEG);
    LAS float* segH = segP + 512, *carP = segH + 512 + (b * 8) * 64, *carH = carP + 1024;
    const int t0 = c * 64 + tg * 8; const size_t row0 = (size_t)b * SEQ + t0;
    float xc[8];
#pragma unroll
    for (int j = 0; j < 8; ++j) { xc[j] = bc + w3 * xw[j + 3] + w2 * xw[j + 2] + w1 * xw[j + 1] + w0 * xw[j]; *(LAS bf16_t*)(lds + LRU_XCB + (tg * 8 + j) * 144 + e * 2) = f2bf(xc[j]); }
    LDS_BAR();
    { const int th = wv & 1, cb = wv >> 1, r32 = lane & 31, hi = lane >> 5; f32x16_t acc = {};
#pragma unroll
        for (int ks = 0; ks < 4; ++ks) { const bf16x8_t af = *(const LAS bf16x8_t*)(lds + LRU_XCB + (32 * th + r32) * 144 + (16 * ks + 8 * hi) * 2), bfr = *(const LAS bf16x8_t*)(lds + LRU_WT + (32 * cb + r32) * 144 + (16 * ks + 8 * hi) * 2);
            acc = __builtin_amdgcn_mfma_f32_32x32x16_bf16(af, bfr, acc, 0, 0, 0); }
#pragma unroll
        for (int r = 0; r < 16; ++r) R[(32 * th + (r & 3) + 8 * (r >> 2) + 4 * hi) * 132 + 32 * cb + r32] = acc[r]; }
    LDS_BAR();
    float av[8], uv[8]; float P = 1.f, Hh = 0.f;
#pragma unroll
    for (int j = 0; j < 8; ++j) { const float ra = bA + R[(tg * 8 + j) * 132 + e], ri = bX + R[(tg * 8 + j) * 132 + 64 + e];
        const float rr = fast_sigmoid(ra), ii = fast_sigmoid(ri); const float la = -8.f * rr * spl; av[j] = __expf(la); uv[j] = __builtin_amdgcn_sqrtf(neg_expm1_small(2.f * la)) * (ii * xc[j]);
        Hh = av[j] * Hh + uv[j]; P *= av[j]; }
    segP[tg * 64 + e] = P; segH[tg * 64 + e] = Hh;
    LDS_BAR();
    if (FINAL) {
        float h = 0.f;
        for (int s = 0; s <= kseg; ++s) h = carP[s * 64 + e] * h + carH[s * 64 + e];
        for (int t2 = 0; t2 < tg; ++t2) h = segP[t2 * 64 + e] * h + segH[t2 * 64 + e];
#pragma unroll
        for (int j = 0; j < 8; ++j) { h = av[j] * h + uv[j]; YL[(row0 + j) * DM + ch] = f2bf(h * fast_gelu(gl[j])); }
    } else if (tg == 7) {
        float h = 0.f, p = 1.f;
#pragma unroll
        for (int s = 0; s < 8; ++s) { h = segP[s * 64 + e] * h + segH[s * 64 + e]; p *= segP[s * 64 + e]; }
        const size_t si = ((size_t)b * 128 + c) * DM + ch; APROD[si] = p; HEND[si] = h;
    }
}
template <bool FINAL> __device__ __forceinline__ void lru_pass(int l, int bx, int G, const float* const* in, const bf16_t* LX, const bf16_t* LG, bf16_t* YL, float* APROD, float* HEND, LAS unsigned char* lds, int tid) {
    const int n = bx & 15, e = tid & 63, ch = n * 64 + e;
    { const float* wa = in[10] + (size_t)l * 65536 + (size_t)n * 4096; const float* wx = in[12] + (size_t)l * 65536 + (size_t)n * 4096;
        for (int i = tid; i < 8192; i += MEGA_THREADS) { const int mat = i >> 12, d = (i >> 6) & 63, ee = i & 63; *(LAS bf16_t*)(lds + LRU_WT + (mat * 64 + ee) * 144 + d * 2) = f2bf(mat ? wx[i & 4095] : wa[i & 4095]); } }
    const float* cw = in[8] + (size_t)l * 4 * DM; const float w0 = cw[ch], w1 = cw[DM + ch], w2 = cw[2 * DM + ch], w3 = cw[3 * DM + ch], bc = in[9][l * DM + ch];
    const float bA = in[11][l * DM + ch], bX = in[13][l * DM + ch], spl = softplusf(-in[14][l * DM + ch]);
    if (FINAL) {
        const int c0 = bx >> 4, tg = tid >> 6; LAS float* carP = (LAS float*)(lds + LRU_SEG) + 1024, *carH = carP + 1024;
#pragma unroll
        for (int b = 0; b < 2; ++b) { const int lo = tg == 0 ? 0 : c0 + 16 * (tg - 1), hi = c0 + 16 * tg; float A[16], Hc[16];
#pragma unroll
            for (int i = 0; i < 16; ++i) { const int cc = lo + i; const bool ok = cc < hi; const size_t si = ((size_t)b * 128 + (ok ? cc : 0)) * DM + ch; A[i] = ok ? APROD[si] : 1.f; Hc[i] = ok ? HEND[si] : 0.f; }
            float cp = 1.f, chh = 0.f;
#pragma unroll
            for (int i = 0; i < 16; ++i) { chh = A[i] * chh + Hc[i]; cp *= A[i]; }
            carP[(b * 8 + tg) * 64 + e] = cp; carH[(b * 8 + tg) * 64 + e] = chh; }
    }
    float xwn[11], gln[8];
#pragma unroll
    for (int j = 0; j < 8; ++j) gln[j] = 0.f;
    lru_load<FINAL>(bx, n, LX, LG, xwn, gln, tid);
    __syncthreads();
    for (int it = bx; it < 4096; it += G) {
        float xw[11], gl[8];
#pragma unroll
        for (int j = 0; j < 11; ++j) xw[j] = xwn[j];
#pragma unroll
        for (int j = 0; j < 8; ++j) gl[j] = gln[j];
        if (it + G < 4096) lru_load<FINAL>(it + G, n, LX, LG, xwn, gln, tid);
        lru_item<FINAL>(it >> 11, (it >> 4) & 127, n, xw, gl, YL, w0, w1, w2, w3, bc, bA, bX, spl, APROD, HEND, lds, tid, ((it >> 4) & 127) >> 4);
    }
    __syncthreads();
}

constexpr int SB_WIN = 13, SB_KOFF = 0, SB_VOFF = SB_WIN * 32 * 144, SB_SCR = SB_VOFF + SB_WIN * 4096;
static_assert(SB_SCR + 8 * 4096 <= MEGA_LDS - 64, "stick-breaking LDS map");
__device__ __forceinline__ void sb_wave(int b, int h, int qw0, int kt_lo, const bf16_t* Q, const bf16_t* __restrict__ K, const bf16_t* __restrict__ V, bf16_t* O, LAS unsigned char* lds, int wave, int lane) {
    const int r32 = lane & 31, hi = lane >> 5; const size_t rowbase = (size_t)b * SEQ;
    const bf16_t* Qw = Q + (rowbase + qw0) * DM + h * 64;
    bf16x8_t qr[4];
#pragma unroll
    for (int d0 = 0; d0 < 4; ++d0) qr[d0] = *(const bf16x8_t*)(Qw + (size_t)r32 * DM + d0 * 16 + hi * 8);
    const bf16_t* Kh = K + rowbase * DM + h * 64; const bf16_t* Vh = V + rowbase * DM + h * 64;
    f32x16_t o0 = {}, o1 = {}; float R = 0.f; const int qabs = qw0 + r32;
    LAS unsigned char* scr = lds + SB_SCR + wave * 4096;
    for (int kt = qw0 >> 5; kt >= 0; --kt) {
        bf16x8_t kf[4]; const LAS unsigned char* vl;
        if (kt >= kt_lo) {
#pragma unroll
            for (int d0 = 0; d0 < 4; ++d0) kf[d0] = *(const LAS bf16x8_t*)(lds + SB_KOFF + ((kt - kt_lo) * 32 + r32) * 144 + d0 * 32 + hi * 16);
            vl = lds + SB_VOFF + (kt - kt_lo) * 4096;
        } else {
#pragma unroll
            for (int d0 = 0; d0 < 4; ++d0) kf[d0] = *(const bf16x8_t*)(Kh + (size_t)(kt * 32 + r32) * DM + d0 * 16 + hi * 8);
#pragma unroll
            for (int it = 0; it < 4; ++it) { const int chunk = lane + 64 * it, row = chunk >> 3, c16 = chunk & 7; const u32x4 vq = *(const u32x4*)(Vh + (size_t)(kt * 32 + row) * DM + c16 * 8);
                *(LAS u32x4*)(scr + (c16 >> 2) * 2048 + row * 64 + (c16 & 3) * 16) = vq; }
            vl = scr;
        }
        f32x16_t st = {};
#pragma unroll
        for (int d0 = 0; d0 < 4; ++d0) st = __builtin_amdgcn_mfma_f32_32x32x16_bf16(kf[d0], qr[d0], st, 0, 0, 0);
        float l1[16], lb[16]; bool val[16];
#pragma unroll
        for (int r = 0; r < 16; ++r) { const int kv = kt * 32 + (r & 3) + 8 * (r >> 2) + 4 * hi; val[r] = kv < qabs; const float z = st[r] * 0.125f; const float sp = fast_softplus(z); l1[r] = val[r] ? -sp : 0.f; lb[r] = z - sp; }
        float w[16]; float tail = 0.f;
#pragma unroll
        for (int g = 3; g >= 0; --g) { const float qs = (l1[4 * g] + l1[4 * g + 1]) + (l1[4 * g + 2] + l1[4 * g + 3]); const float pq = __shfl_xor(qs, 32);
            const float after = tail + (hi == 0 ? pq : 0.f) + R; tail += qs + pq;
            const float e2 = l1[4 * g + 3], e1 = e2 + l1[4 * g + 2], e0 = e1 + l1[4 * g + 1];
            w[4 * g + 3] = val[4 * g + 3] ? __expf(lb[4 * g + 3] + after) : 0.f; w[4 * g + 2] = val[4 * g + 2] ? __expf(lb[4 * g + 2] + after + e2) : 0.f;
            w[4 * g + 1] = val[4 * g + 1] ? __expf(lb[4 * g + 1] + after + e1) : 0.f; w[4 * g] = val[4 * g] ? __expf(lb[4 * g] + after + e0) : 0.f; }
        R += tail;
        u32x4 p0, p1; p0.x = attn_body::cvtpk_s(w[0], w[1]); p0.y = attn_body::cvtpk_s(w[2], w[3]); p0.z = attn_body::cvtpk_s(w[4], w[5]); p0.w = attn_body::cvtpk_s(w[6], w[7]);
        p1.x = attn_body::cvtpk_s(w[8], w[9]); p1.y = attn_body::cvtpk_s(w[10], w[11]); p1.z = attn_body::cvtpk_s(w[12], w[13]); p1.w = attn_body::cvtpk_s(w[14], w[15]);
        const bf16x8_t pa0 = __builtin_bit_cast(bf16x8_t, p0), pa1 = __builtin_bit_cast(bf16x8_t, p1);
        const attn_body::lds_cptr vp = (attn_body::lds_cptr)vl + (4 * hi + ((lane & 15) >> 2)) * 64 + ((lane >> 4) & 1) * 32 + (lane & 3) * 8;
#define SB_VF(d0, s) ({ const attn_body::s16x4 lo_ = attn_body::vtr(vp + (d0) * 2048 + (s) * 1024), hi_ = attn_body::vtr(vp + (d0) * 2048 + (s) * 1024 + 512); \
            (bf16x8_t){lo_[0], lo_[1], lo_[2], lo_[3], hi_[0], hi_[1], hi_[2], hi_[3]}; })
        o0 = __builtin_amdgcn_mfma_f32_32x32x16_bf16(pa0, SB_VF(0, 0), o0, 0, 0, 0);
        o1 = __builtin_amdgcn_mfma_f32_32x32x16_bf16(pa0, SB_VF(1, 0), o1, 0, 0, 0);
        o0 = __builtin_amdgcn_mfma_f32_32x32x16_bf16(pa1, SB_VF(0, 1), o0, 0, 0, 0);
        o1 = __builtin_amdgcn_mfma_f32_32x32x16_bf16(pa1, SB_VF(1, 1), o1, 0, 0, 0);
#undef SB_VF
        if (__all(R < SB_THR)) break;
    }
    bf16_t* Ow = O + (rowbase + qw0) * DM + h * 64;
#pragma unroll
    for (int r = 0; r < 16; ++r) { const int q = (r & 3) + 8 * (r >> 2) + 4 * hi; Ow[(size_t)q * DM + r32] = f2bf(o0[r]); Ow[(size_t)q * DM + 32 + r32] = f2bf(o1[r]); }
}
__device__ __forceinline__ void sb_unit(int b, int h, int q0, const bf16_t* Q, const bf16_t* __restrict__ K, const bf16_t* __restrict__ V, bf16_t* O, LAS unsigned char* lds, int tid) {
    const int lane = tid & 63, wave = __builtin_amdgcn_readfirstlane(tid >> 6);
    const int kt_hi = (q0 >> 5) + 8, kt_lo = kt_hi - SB_WIN > 0 ? kt_hi - SB_WIN : 0, nch = (kt_hi - kt_lo) * 256;
    const bf16_t* Kh = K + ((size_t)b * SEQ + kt_lo * 32) * DM + h * 64; const bf16_t* Vh = V + ((size_t)b * SEQ + kt_lo * 32) * DM + h * 64;
#pragma unroll
    for (int hb = 0; hb < 2; ++hb) {
        u32x4 kq[4], vq[4];
#pragma unroll
        for (int i = 0; i < 4; ++i) { const int idx = tid + MEGA_THREADS * (4 * hb + i), row = idx >> 3, c16 = idx & 7;
            if (idx < nch) { kq[i] = *(const u32x4*)(Kh + (size_t)row * DM + c16 * 8); vq[i] = *(const u32x4*)(Vh + (size_t)row * DM + c16 * 8); } }
#pragma unroll
        for (int i = 0; i < 4; ++i) { const int idx = tid + MEGA_THREADS * (4 * hb + i), row = idx >> 3, c16 = idx & 7;
            if (idx < nch) { *(LAS u32x4*)(lds + SB_KOFF + row * 144 + c16 * 16) = kq[i];
                *(LAS u32x4*)(lds + SB_VOFF + (row >> 5) * 4096 + (c16 >> 2) * 2048 + (row & 31) * 64 + (c16 & 3) * 16) = vq[i]; } }
    }
    __syncthreads();
    sb_wave(b, h, q0 + wave * 32, kt_lo, Q, K, V, O, lds, wave, lane);
    __syncthreads();
}

#ifndef DBG_NOLOGF
#define DBG_NOLOGF 0
#endif
#ifndef EN_FOX
#define EN_FOX 1
#endif
#ifndef EN_SB
#define EN_SB 1
#endif
#ifndef EN_LRU
#define EN_LRU 1
#endif
#ifndef EN_GEMM
#define EN_GEMM 1
#endif
#ifndef EN_THIN
#define EN_THIN 1
#endif
enum { SUB_CONV = 1, SUB_NORM = 2, SUB_HEADNORM = 4, SUB_CUMSUM = 8, SUB_LRU = 16, SUB_SB = 32, SUB_MEM = 64, SUB_FOX = 128, SUB_ALL = 255 };
constexpr int N_PRO = 3, N_PER_LAYER = 10, N_PHASES = N_PRO + DEPTH * N_PER_LAYER;
struct MArgs { Ptrs P; int ph_lo, ph_hi, sub, pad; };

__global__ void __launch_bounds__(MEGA_THREADS, 2) mega(MArgs a) {
    extern __shared__ __attribute__((aligned(16))) unsigned char lds_raw[];
    LAS unsigned char* lds = (LAS unsigned char*)lds_raw;
    cg::grid_group grid = cg::this_grid();
    { volatile LAS unsigned* st0 = (volatile LAS unsigned*)(lds + XB_LDS_OFF); if (threadIdx.x == 0) { st0[0] = 0u; st0[1] = 0u; } __syncthreads();
      if (a.ph_hi - a.ph_lo > 2) (void)xcd_barrier_post((unsigned*)(a.P.ws + WS_BAR), st0); }
    for (int ph = a.ph_lo; ph < a.ph_hi; ++ph) {
    int tid = threadIdx.x; asm volatile("" : "+v"(tid));
    const int lane = tid & 63, wave = __builtin_amdgcn_readfirstlane(tid >> 6);
    int zs = 0; asm volatile("" : "+s"(zs));
    const int G = gridDim.x + zs, bx = blockIdx.x + zs, sub = a.sub + zs, vcu = (G % 8 == 0) ? (bx % 8) * (G / 8) + bx / 8 : bx;
    const int gw = vcu * NWV + wave, NGW = G * NWV;
    unsigned char* ws = a.P.ws + zs; const float* const* in = a.P.in + zs; float* out = a.P.out + zs;
    bf16_t* H = (bf16_t*)(ws + WS_H); bf16_t* PROJ = (bf16_t*)(ws + WS_PROJ); bf16_t* GATES = (bf16_t*)(ws + WS_GATES); bf16_t* Eb = (bf16_t*)(ws + WS_E);
    bf16_t *FQ = PROJ, *FK = PROJ + (size_t)T * DM, *FV = PROJ + 2 * (size_t)T * DM, *LX = PROJ + 3 * (size_t)T * DM, *LG = PROJ + 4 * (size_t)T * DM, *SQ = PROJ + 5 * (size_t)T * DM,
           *SK = PROJ + 6 * (size_t)T * DM, *SV = PROJ + 7 * (size_t)T * DM, *MQ = PROJ + 8 * (size_t)T * DM;
    bf16_t* YL = (bf16_t*)(ws + WS_YL);
    float *LOGF = (float*)(ws + WS_LOGF), *FB = (float*)(ws + WS_FB), *MQSS = (float*)(ws + WS_MQSS), *ESUM = (float*)(ws + WS_ESUM), *CB = (float*)(ws + WS_CB);
    bf16_t* MEMN = (bf16_t*)(ws + WS_MEMN); float* MEMRAW = (float*)(ws + WS_MEMRAW); bf16_t *MK = (bf16_t*)(ws + WS_MK), *MVT = (bf16_t*)(ws + WS_MVT);
    float *APROD = (float*)(ws + WS_LRU), *HEND = APROD + (size_t)BATCH * 128 * DM;
    bf16_t* WKVT = (bf16_t*)(ws + WS_WKVT);
    bf16_t *WIN_T = (bf16_t*)(ws + WS_WT + WT_IN), *WBR_T = (bf16_t*)(ws + WS_WT + WT_BR), *WOUT_T = (bf16_t*)(ws + WS_WT + WT_OUT), *WUP_T = (bf16_t*)(ws + WS_WT + WT_UP), *WDN_T = (bf16_t*)(ws + WS_WT + WT_DN);
    bf16_t *GV = (bf16_t*)(ws + WS_GV), *ACT = (bf16_t*)(ws + WS_ACT);

        if (ph < N_PRO) {
            if (ph == 0) {
                LAS float* scr = (LAS float*)(lds + wave * 8448);
                for (int it = gw; it < 4 * 1024; it += NGW) { const int l = it >> 10; tr_item(in[15] + (size_t)l * DM * 2048, 2048, WKVT + (size_t)l * 2048 * DM, DM, 64, scr, it & 1023, lane, 1, 0); }
                for (int l = 0; l < 4; ++l) norm_rows(in[1], 512, gw, NGW, in[3] + l * DM, MEMN + (size_t)l * 512 * DM, (const LAS float*)lds, false, nullptr, nullptr, lane);
            } else if (ph == 1) {
                LocOrder<LocMemKV> S; S.so.init(4 * 512, 2048, G, bx); S.loc = LocMemKV{(const char*)MEMN, (const char*)WKVT};
                if (EN_GEMM) pg8::gemm_phase<EpiF32, LocOrder<LocMemKV>, true, true>(lds, pg8::Gemm{DM, DM, DM}, S, EpiF32{MEMRAW, 2048, 0});
            } else {
                for (int m = gw; m < 4 * 512; m += NGW) { const int l = m >> 9, r = m & 511, b = r >> 8, mi = r & 255; const float* raw = MEMRAW + (size_t)m * 2048;
                    const f32x4 gk = *(const f32x4*)(in[17] + l * 256 + lane * 4), gq = *(const f32x4*)(in[16] + l * 256 + lane * 4); const f32x4 gg = gk * gq;
#pragma unroll
                    for (int h = 0; h < 4; ++h) { const f32x4 k = *(const f32x4*)(raw + h * 256 + lane * 4); const float ss = wave_sum((k[0] * k[0] + k[1] * k[1]) + (k[2] * k[2] + k[3] * k[3]));
                        const float rstd = rsqrtf(ss * (1.f / 256.f) + EPS); uint2 o; o.x = pk2(k[0] * rstd * gg[0], k[1] * rstd * gg[1]); o.y = pk2(k[2] * rstd * gg[2], k[3] * rstd * gg[3]);
                        *(uint2*)(MK + ((size_t)l * 512 + (size_t)b * 256 + mi) * DM + h * 256 + lane * 4) = o;
                        const f32x4 v = *(const f32x4*)(raw + 1024 + h * 256 + lane * 4); bf16_t* vt = MVT + (size_t)l * 512 * DM + (((size_t)b * 4 + h) * 256 + lane * 4) * 256 + mi;
                        vt[0] = f2bf(v[0]); vt[256] = f2bf(v[1]); vt[512] = f2bf(v[2]); vt[768] = f2bf(v[3]); }
                    if (r == 0) { float mx = fmaxf(fmaxf(fabsf(gg[0]), fabsf(gg[1])), fmaxf(fabsf(gg[2]), fabsf(gg[3])));
#pragma unroll
                        for (int o = 1; o < 64; o <<= 1) mx = fmaxf(mx, __shfl_xor(mx, o));
                        if (lane == 0) CB[l] = 16.f * mx; } }
            }
        } else {
            const int l = (ph - N_PRO) / N_PER_LAYER, sp = (ph - N_PRO) % N_PER_LAYER;
            const float* xcur = l == 0 ? in[0] : out;
            if (sp == 0) {
                if (sub & SUB_NORM) { LAS float* WfT = (LAS float*)lds; const float* wf = in[4] + (size_t)l * DM * NIN + 3072;
#pragma unroll 8
                    for (int i = tid; i < 16 * 1024; i += MEGA_THREADS) { const int k = i >> 4, h = i & 15; WfT[h * 1024 + k] = wf[(size_t)k * NIN + h]; } }
                __syncthreads();
                if (sub & SUB_CONV) { LAS float* scr = (LAS float*)(lds + 65536 + wave * 8448);
                    const float* win = in[4] + (size_t)l * DM * NIN;
                    for (int it = gw; it < 13440; it += NGW) { int r = it;
                        if (r < 1536) { tr_item(win, NIN, WIN_T, DM, 96, scr, r, lane, 1, 0); continue; } r -= 1536;
                        if (r < 5120) { tr_item(win + 3088, NIN, WIN_T + (size_t)3072 * DM, DM, 320, scr, r, lane, 1, 0); continue; } r -= 5120;
                        if (r < 2048) { const int i = r >> 9; tr_item(in[19] + ((size_t)l * 4 + i) * DM * DM, DM, WBR_T + (size_t)i * DM * DM, DM, 32, scr, r & 511, lane, 1, 0); continue; } r -= 2048;
                        if (r < 512) { tr_item(in[20] + (size_t)l * DM * DM, DM, WOUT_T, DM, 32, scr, r, lane, 1, 0); continue; } r -= 512;
                        if (r < 2816) { tr_item(in[22] + (size_t)l * DM * 2 * DFF, 2 * DFF, WUP_T, DM, 176, scr, r, lane, 1, 0); continue; } r -= 2816;
                        tr_item(in[25] + (size_t)l * DFF * DM, DM, WDN_T, DFF, 32, scr, r, lane, 1, 0); } }
                if (sub & SUB_NORM) norm_rows(xcur, T, gw, NGW, in[2] + l * DM, H, (const LAS float*)lds, !DBG_NOLOGF, in[5] + l * 16, LOGF, lane);
            } else if (sp == 1) {
                LocOrder<LocStd> S; S.so.init(T, 13312, G, bx); S.loc = LocStd{(const char*)H, (const char*)WIN_T, 256 * 1024 * 2, 256 * 1024 * 2};
                if (EN_GEMM) pg8::gemm_phase<EpiProj, LocOrder<LocStd>, true, true>(lds, pg8::Gemm{DM, DM, DM}, S, EpiProj{PROJ, GATES, MQSS});
            } else if (sp == 2) {
                if (sub & SUB_HEADNORM) { for (int m = gw; m < 2 * T; m += NGW) { if (m < T) headnorm64_row(FQ + (size_t)m * DM, in[6] + l * 64, C2, lane); else headnorm64_row(FK + (size_t)(m - T) * DM, in[7] + l * 64, 1.f, lane); } }
                if ((sub & SUB_CUMSUM) && bx < 32) cumsum_block(LOGF + (size_t)bx * SEQ, FB + (size_t)bx * SEQ, (LAS float*)lds, tid);
                __syncthreads();
                if (EN_LRU && (sub & SUB_LRU)) lru_pass<false>(l, bx, G, in, LX, LG, YL, APROD, HEND, lds, tid);
                if (EN_SB && (sub & SUB_SB))
#pragma unroll 1
                for (int k = 0; k < 4; ++k) { const int bh = vcu >> 3, qb = (vcu & 7) * 4 + k; sb_unit(bh >> 4, bh & 15, qb * 256, SQ, SK, SV, H, lds, tid); }
                __syncthreads();
                if (sub & SUB_MEM) { LocOrder<LocMemS> S; S.so.init(T, 1024, G, bx); S.loc = LocMemS{(const char*)MQ, (const char*)(MK + (size_t)l * 512 * DM)};
                    if (EN_GEMM) pg8::gemm_phase<EpiSexp, LocOrder<LocMemS>, true, true>(lds, pg8::Gemm{DM, DM, 256 + zs}, S, EpiSexp{Eb, MQSS, ESUM, CB + l}); }
            } else if (sp == 3) {
                if (EN_FOX && (sub & SUB_FOX)) {
                    float gqm = fabsf(in[6][l * 64 + lane]), gkm = fabsf(in[7][l * 64 + lane]);
#pragma unroll
                    for (int o = 1; o < 64; o <<= 1) { gqm = fmaxf(gqm, __shfl_xor(gqm, o)); gkm = fmaxf(gkm, __shfl_xor(gkm, o)); }
                    const float thr = -(160.f + 2.f * C2 * 64.f * gqm * gkm);
                    const attn_body::AttnTensors AT{(const attn_body::bf16*)FQ, (const attn_body::bf16*)FK, (const attn_body::bf16*)FV, (attn_body::bf16*)SV, FB, thr, 0};
                    attn_body::QueueOrder S; S.ctr = (unsigned*)(ws + WS_QCTR) + (l * 8) * 64; S.xl = bx & 7; S.slot = (volatile LAS int*)(lds + XB_LDS_OFF + 16);
                    attn_body::attn_phase<attn_body::QueueOrder, 20>((char*)lds_raw, AT, S); }
                __syncthreads();
                if (EN_LRU && (sub & SUB_LRU)) lru_pass<true>(l, bx, G, in, LX, LG, YL, APROD, HEND, lds, tid);
                if (sub & SUB_MEM) { LocOrder<LocMemPV> S; S.so.init(T, 1024, G, bx); S.loc = LocMemPV{(const char*)Eb, (const char*)(MVT + (size_t)l * 512 * DM)};
                    if (EN_GEMM) pg8::gemm_phase<EpiMemPV, LocOrder<LocMemPV>, true, true>(lds, pg8::Gemm{DM, 256, 256 + zs}, S, EpiMemPV{MQ, ESUM}); }
            } else if (sp == 4) {
                BranchSched S; S.vcu = vcu; S.loc = LocBranch{(const char*)SV, (const char*)YL, (const char*)H, (const char*)MQ, (const char*)WBR_T};
                if (EN_GEMM) pg8::gemm_phase<EpiBranch, BranchSched, true, true>(lds, pg8::Gemm{DM, DM, DM}, S, EpiBranch{GATES, in[18] + (size_t)l * 4 * DM, (float*)(ws + WS_MIXF), (bf16_t*)(ws + WS_MIXED)});
            } else if (sp == 5) {
                LocOrder<LocStd> S; S.so.init(T, DM, G, bx); S.loc = LocStd{(const char*)(ws + WS_MIXED), (const char*)WOUT_T, 256 * 1024 * 2, 256 * 1024 * 2};
                if (EN_GEMM) pg8::gemm_phase<EpiResid, LocOrder<LocStd>, true, true>(lds, pg8::Gemm{DM, DM, DM}, S, EpiResid{xcur, out});
            } else if (sp == 6) {
                norm_rows(out, T, gw, NGW, in[21] + l * DM, H, (const LAS float*)lds, false, nullptr, nullptr, lane);
            } else if (sp == 7) {
                LocOrder<LocStd> S; S.so.init(T, 2 * DFF, G, bx); S.loc = LocStd{(const char*)H, (const char*)WUP_T, 256 * 1024 * 2, 256 * 1024 * 2};
                if (EN_GEMM) pg8::gemm_phase<EpiBf16P, LocOrder<LocStd>, true, true>(lds, pg8::Gemm{DM, DM, DM}, S, EpiBf16P{GV, 2 * DFF, 0});
            } else if (sp == 8) {
                const float* cw = in[23] + (size_t)l * 3 * DFF; const float* cbv = in[24] + l * DFF;
                for (int i = bx * MEGA_THREADS + tid; i < (T / 8) * (DFF / 8); i += G * MEGA_THREADS) { const int r0 = (i / (DFF / 8)) * 8, c = (i % (DFF / 8)) * 8, t0 = r0 % SEQ;
                    const bf16_t* gp = GV + (size_t)r0 * 2 * DFF + c; const u32x4 z4 = {0u, 0u, 0u, 0u};
                    const f32x4 wa0 = *(const f32x4*)(cw + c), wa1 = *(const f32x4*)(cw + c + 4), wb0 = *(const f32x4*)(cw + DFF + c), wb1 = *(const f32x4*)(cw + DFF + c + 4), wc0 = *(const f32x4*)(cw + 2 * DFF + c), wc1 = *(const f32x4*)(cw + 2 * DFF + c + 4);
                    const f32x4 bb0 = *(const f32x4*)(cbv + c), bb1 = *(const f32x4*)(cbv + c + 4);
                    u32x4 g2 = t0 >= 2 ? *(const u32x4*)(gp - 4 * DFF) : z4, g1 = t0 >= 1 ? *(const u32x4*)(gp - 2 * DFF) : z4;
                    u32x4 gg[8], vv[8];
#pragma unroll
                    for (int j = 0; j < 8; ++j) { gg[j] = *(const u32x4*)(gp + (size_t)j * 2 * DFF); vv[j] = *(const u32x4*)(gp + (size_t)j * 2 * DFF + DFF); }
#define ACT1(G0, G1, G2, VV, W0, W1, W2, BB) ({ const float pre_ = (BB) + (W2) * (G0) + (W1) * (G1) + (W0) * (G2); pre_ * fast_sigmoid(pre_) * (VV); })
#pragma unroll
                    for (int j = 0; j < 8; ++j) { const u32x4 g0 = gg[j], v_ = vv[j]; u32x4 o;
                        o.x = pk2(ACT1(blo(g0.x), blo(g1.x), blo(g2.x), blo(v_.x), wa0[0], wb0[0], wc0[0], bb0[0]), ACT1(bhi(g0.x), bhi(g1.x), bhi(g2.x), bhi(v_.x), wa0[1], wb0[1], wc0[1], bb0[1]));
                        o.y = pk2(ACT1(blo(g0.y), blo(g1.y), blo(g2.y), blo(v_.y), wa0[2], wb0[2], wc0[2], bb0[2]), ACT1(bhi(g0.y), bhi(g1.y), bhi(g2.y), bhi(v_.y), wa0[3], wb0[3], wc0[3], bb0[3]));
                        o.z = pk2(ACT1(blo(g0.z), blo(g1.z), blo(g2.z), blo(v_.z), wa1[0], wb1[0], wc1[0], bb1[0]), ACT1(bhi(g0.z), bhi(g1.z), bhi(g2.z), bhi(v_.z), wa1[1], wb1[1], wc1[1], bb1[1]));
                        o.w = pk2(ACT1(blo(g0.w), blo(g1.w), blo(g2.w), blo(v_.w), wa1[2], wb1[2], wc1[2], bb1[2]), ACT1(bhi(g0.w), bhi(g1.w), bhi(g2.w), bhi(v_.w), wa1[3], wb1[3], wc1[3], bb1[3]));
                        *(u32x4*)(ACT + (size_t)(r0 + j) * DFF + c) = o; g2 = g1; g1 = g0; }
#undef ACT1
                }
            } else {
                LocOrder<LocStd> S; S.so.init(T, DM, G, bx); S.loc = LocStd{(const char*)ACT, (const char*)WDN_T, 256 * DFF * 2, 256 * DFF * 2};
                if (EN_GEMM) pg8::gemm_phase<EpiResid, LocOrder<LocStd>, true, true>(lds, pg8::Gemm{DFF, DFF, DFF}, S, EpiResid{out, out});
            }
        }
        if (ph + 1 < a.ph_hi) {
            if (ph == a.ph_lo) grid.sync();
            else { XcdBarrier xb; xb.bar = (unsigned*)(ws + WS_BAR); xb.x = xb_xcc_id(); xb.st = (volatile LAS unsigned*)(lds + XB_LDS_OFF); xcd_barrier(xb); }
        }
    }
}
enum { C_PRO = 1, C_NORM = 2, C_WIN = 4, C_HN = 8, C_LRU = 16, C_SB = 32, C_MEM = 64, C_FOX = 128, C_BR = 256, C_WOUT = 512, C_NORM2 = 1024, C_UP = 2048, C_ACT = 4096, C_DOWN = 8192, C_ONE = 16384 };
#ifndef CFG
#define CFG 32767
#endif
#ifndef REPEAT_SP
#define REPEAT_SP (-1)
#define REPEAT_N 0
#define REPEAT_SUB 0
#endif
static int g_grid = 0;
static void launch_mega(const Ptrs& P, int lo, int hi, int sub, hipStream_t st, bool coop) {
    MArgs a{}; a.P = P; a.ph_lo = lo; a.ph_hi = hi; a.sub = sub; a.pad = 0;
    if (coop) { void* args[] = {&a}; const hipError_t e = hipLaunchCooperativeKernel((const void*)mega, dim3(g_grid), dim3(MEGA_THREADS), args, MEGA_LDS, st);
        if (e != hipSuccess) fprintf(stderr, "cooperative launch failed: %s (grid %d)\n", hipGetErrorString(e), g_grid); }
    else { hipLaunchKernelGGL(mega, dim3(g_grid), dim3(MEGA_THREADS), MEGA_LDS, st, a);
        if (REPEAT_N > 0 && hi == lo + 1 && lo >= N_PRO && (lo - N_PRO) % N_PER_LAYER == (REPEAT_SP)) { a.sub = (REPEAT_SUB); for (int r = 0; r < (REPEAT_N); ++r) hipLaunchKernelGGL(mega, dim3(g_grid), dim3(MEGA_THREADS), MEGA_LDS, st, a); } }
}
static void run_hybrid(const Ptrs& P, hipStream_t st) {
    unsigned char* ws = P.ws;
    bf16_t* H = (bf16_t*)(ws + WS_H);
    bf16_t* PR[9]; for (int i = 0; i < 9; ++i) PR[i] = (bf16_t*)(ws + WS_PROJ + i * SZ_ACT);
    bf16_t *FQ = PR[0], *FK = PR[1], *FV = PR[2], *LX = PR[3], *LG = PR[4], *SQ = PR[5], *SK = PR[6], *SV = PR[7], *MQ = PR[8];
    bf16_t* GATES = (bf16_t*)(ws + WS_GATES);
    bf16_t *YL = (bf16_t*)(ws + WS_YL), *YS = (bf16_t*)(ws + WS_YS), *YM = (bf16_t*)(ws + WS_YM), *YF = (bf16_t*)(ws + WS_YF);
    float *LOGF = (float*)(ws + WS_LOGF), *FB = (float*)(ws + WS_FB);
    bf16_t* MEMN = (bf16_t*)(ws + WS_MEMN); float* MEMRAW = (float*)(ws + WS_MEMRAW);
    bf16_t *MK = (bf16_t*)(ws + WS_MK), *MVT = (bf16_t*)(ws + WS_MVT);
    bf16_t *GV = (bf16_t*)(ws + WS_GV), *ACT = (bf16_t*)(ws + WS_ACT);
    const float* const* in = P.in;
    const int cfg = CFG;
    const bool anygemm = cfg & (C_WIN | C_BR | C_WOUT | C_UP | C_DOWN);
    if (cfg & C_PRO) { for (int p = 0; p < 3; ++p) launch_mega(P, p, p + 1, SUB_ALL, st, false); }
    else for (int l = 0; l < DEPTH; ++l) {
        n_rmsnorm<<<512 / 4, 256, 0, st>>>(in[1], in[3] + l * DM, MEMN + (size_t)l * 512 * DM, nullptr, nullptr, nullptr, 512);
        n_gemm<EStoreF32><<<dim3(2048 / 64, 512 / 64), 256, 0, st>>>(MEMN + (size_t)l * 512 * DM, in[15] + (size_t)l * DM * 2048, DM, 2048, DM, 0x7fffffff, EStoreF32{MEMRAW + (size_t)l * 512 * 2048, 2048, 0});
        n_memkv_post<<<512, 256, 0, st>>>(MEMRAW + (size_t)l * 512 * 2048, in[17] + l * 256, in[16] + l * 256, MK + (size_t)l * 512 * DM, MVT + (size_t)l * 512 * DM);
    }
    for (int l = 0; l < DEPTH; ++l) {
        const int p0 = N_PRO + l * N_PER_LAYER;
        const float* xcur = l == 0 ? in[0] : P.out;
        const float* win = in[4] + (size_t)l * DM * NIN;
        if (DBG_NOLOGF) n_rmsnorm<<<T / 4, 256, 0, st>>>(xcur, in[2] + l * DM, H, win + 3072, in[5] + l * 16, LOGF, T);
        { const int sub = (anygemm ? SUB_CONV : 0) | ((cfg & C_NORM) ? SUB_NORM : 0); if (sub) launch_mega(P, p0, p0 + 1, sub, st, false); }
        if (!(cfg & C_NORM)) n_rmsnorm<<<T / 4, 256, 0, st>>>(xcur, in[2] + l * DM, H, win + 3072, in[5] + l * 16, LOGF, T);
        if (cfg & C_WIN) launch_mega(P, p0 + 1, p0 + 2, SUB_ALL, st, false);
        else { for (int gI = 0; gI < 9; ++gI) { const int coff = gI < 3 ? gI * 1024 : gI * 1024 + 16;
                n_gemm<EStoreBf16><<<dim3(1024 / 64, T / 64), 256, 0, st>>>(H, win + coff, DM, NIN, DM, 0x7fffffff, EStoreBf16{PR[gI], DM, 0}); }
            n_gemm<EStoreBf16><<<dim3(4096 / 64, T / 64), 256, 0, st>>>(H, win + 9232, DM, NIN, DM, 0x7fffffff, EStoreBf16{GATES, 4096, 0}); }
        if (!(cfg & C_HN)) { n_headnorm<<<T * 16 / 256, 256, 0, st>>>(FQ, in[6] + l * 64, 64, C2); n_headnorm<<<T * 16 / 256, 256, 0, st>>>(FK, in[7] + l * 64, 64, 1.f); n_cumsum<<<32, 1024, 0, st>>>(LOGF, FB); }
        const int sub23 = ((cfg & C_HN) ? (SUB_HEADNORM | SUB_CUMSUM) : 0) | ((cfg & C_LRU) ? SUB_LRU : 0) | ((cfg & C_SB) ? SUB_SB : 0) | ((cfg & C_MEM) ? SUB_MEM : 0) | ((cfg & C_FOX) ? SUB_FOX : 0);
        if (sub23 & ~SUB_FOX) launch_mega(P, p0 + 2, p0 + 3, sub23, st, false);
        if (!(cfg & C_SB)) n_sb_attn<<<dim3(SEQ / 256, 32), 256, 0, st>>>(SQ, SK, SV, YS);
        if (!(cfg & C_LRU)) n_lru<<<32, 64, 0, st>>>(LX, LG, in[8] + (size_t)l * 4 * DM, in[9] + l * DM, in[10] + (size_t)l * 16 * 64 * 64, in[11] + l * DM, in[12] + (size_t)l * 16 * 64 * 64, in[13] + l * DM, in[14] + l * DM, YL);
        if (!(cfg & C_MEM)) n_mem_attn<<<T * 4, 256, 0, st>>>(MQ, MK + (size_t)l * 512 * DM, MVT + (size_t)l * 512 * DM, YM);
        if (sub23 & (SUB_FOX | SUB_LRU | SUB_MEM)) launch_mega(P, p0 + 3, p0 + 4, sub23, st, false);
        if (!(cfg & C_FOX)) n_fox_attn<<<dim3(SEQ / 256, 32), 256, 0, st>>>(FQ, FK, FV, FB, YF);
        if (cfg & C_BR) launch_mega(P, p0 + 4, p0 + 5, SUB_ALL, st, false);
        else { const bf16_t* Y[4] = {YF, YL, YS, YM};
            for (int i = 0; i < 4; ++i) n_gemm<EBranch><<<dim3(1024 / 64, T / 64), 256, 0, st>>>(Y[i], in[19] + ((size_t)l * 4 + i) * DM * DM, DM, DM, DM, 0x7fffffff, EBranch{GATES, in[18] + ((size_t)l * 4 + i) * DM, (float*)(ws + WS_MIXF), (bf16_t*)(ws + WS_MIXED), i, 0}); }
        if (cfg & C_WOUT) launch_mega(P, p0 + 5, p0 + 6, SUB_ALL, st, false);
        else n_gemm<EResid><<<dim3(1024 / 64, T / 64), 256, 0, st>>>((const bf16_t*)(ws + WS_MIXED), in[20] + (size_t)l * DM * DM, DM, DM, DM, 0x7fffffff, EResid{xcur, P.out});
        if (cfg & C_NORM2) launch_mega(P, p0 + 6, p0 + 7, SUB_ALL, st, false);
        else n_rmsnorm<<<T / 4, 256, 0, st>>>(P.out, in[21] + l * DM, H, nullptr, nullptr, nullptr, T);
        if (cfg & C_UP) launch_mega(P, p0 + 7, p0 + 8, SUB_ALL, st, false);
        else n_gemm<EStoreBf16><<<dim3(2 * DFF / 64, T / 64), 256, 0, st>>>(H, in[22] + (size_t)l * DM * 2 * DFF, DM, 2 * DFF, DM, 0x7fffffff, EStoreBf16{GV, 2 * DFF, 0});
        if (cfg & C_ACT) launch_mega(P, p0 + 8, p0 + 9, SUB_ALL, st, false);
        else n_act<<<(unsigned)(((size_t)T * DFF + 255) / 256), 256, 0, st>>>(GV, in[23] + (size_t)l * 3 * DFF, in[24] + l * DFF, ACT);
        if (cfg & C_DOWN) launch_mega(P, p0 + 9, p0 + 10, SUB_ALL, st, false);
        else n_gemm<EResid><<<dim3(1024 / 64, T / 64), 256, 0, st>>>(ACT, in[25] + (size_t)l * DFF * DM, DFF, DM, DFF, 0x7fffffff, EResid{P.out, P.out});
    }
}

extern "C" void kernel_launch(void* const* d_in, const int* in_sizes, int n_in, void* d_out, int out_size, void* d_ws, size_t ws_size, hipStream_t stream) {
    if (n_in != 26 || out_size != T * DM || ws_size < WS_NEED) { fprintf(stderr, "kernel_launch: unexpected sizes n_in %d out %d ws %zu (need %zu)\n", n_in, out_size, ws_size, (size_t)WS_NEED); return; }
    if (g_grid == 0) {
        int dev = 0, cus = 0, per_cu = 0;
        hipGetDevice(&dev); hipDeviceGetAttribute(&cus, hipDeviceAttributeMultiprocessorCount, dev);
        if (hipFuncSetAttribute((const void*)mega, hipFuncAttributeMaxDynamicSharedMemorySize, MEGA_LDS) != hipSuccess) fprintf(stderr, "kernel_launch: hipFuncSetAttribute failed\n");
        if (hipOccupancyMaxActiveBlocksPerMultiprocessor(&per_cu, (const void*)mega, MEGA_THREADS, MEGA_LDS) != hipSuccess || per_cu < 1) fprintf(stderr, "kernel_launch: occupancy query says %d\n", per_cu);
        (void)hipGetLastError();
        g_grid = cus;
        if (g_grid != 256) fprintf(stderr, "kernel_launch: %d CUs; the attention phase's static order assumes 256\n", g_grid);
    }
    Ptrs P{};
    for (int i = 0; i < 26; ++i) P.in[i] = (const float*)d_in[i];
    P.out = (float*)d_out; P.ws = (unsigned char*)d_ws;
    if ((CFG) & C_ONE) { (void)hipMemsetAsync((char*)d_ws + WS_BAR, 0, CTL_ZERO_BYTES, stream);
        launch_mega(P, 0, N_PHASES, SUB_ALL, stream, true); }
    else { (void)hipMemsetAsync((char*)d_ws + WS_BAR, 0, CTL_ZERO_BYTES, stream); run_hybrid(P, stream); }
}
```

```cpp
#include <hip/hip_runtime.h>
#include <cstdio>
#include <cstdint>
#include <hip/hip_cooperative_groups.h>

typedef unsigned short bf16_t;
constexpr int BATCH = 2, SEQ = 8192, DM = 1024, DEPTH = 4, T = BATCH * SEQ;
constexpr int NMEM = 256, NIN = 13328, DFF = 2816;
constexpr float EPS = 1e-6f;
constexpr float LOG2E = 1.4426950408889634f;
constexpr float C2 = 0.125f * LOG2E;
constexpr float SB_THR = -104.0f;

__device__ __forceinline__ float bf2f(bf16_t b) { return __uint_as_float(((unsigned)b) << 16); }
__device__ __forceinline__ bf16_t f2bf(float f) { unsigned u = __float_as_uint(f); return (bf16_t)((u + 0x7fffu + ((u >> 16) & 1u)) >> 16); }
__device__ __forceinline__ float bfr(float f) { return bf2f(f2bf(f)); }
__device__ __forceinline__ float wave_sum(float v) {
#pragma unroll
    for (int o = 1; o < 64; o <<= 1) v += __shfl_xor(v, o);
    return v;
}
__device__ __forceinline__ float softplusf(float x) { return fmaxf(x, 0.f) + log1pf(__expf(-fabsf(x))); }
__device__ __forceinline__ float logsigmoidf(float x) { return -softplusf(-x); }
__device__ __forceinline__ float sigmoidf_(float x) { return 1.f / (1.f + __expf(-x)); }
__device__ __forceinline__ float gelu_tanh(float x) { const float u = 0.7978845608028654f * (x + 0.044715f * x * x * x); return 0.5f * x * (1.f + tanhf(u)); }

__device__ __forceinline__ int mk_tid() { int t = threadIdx.x; asm volatile("" : "+v"(t)); return t; }

constexpr size_t MiB = 1u << 20;
constexpr size_t SZ_ACT = (size_t)T * DM * 2;
constexpr size_t WS_CTL = 0;
constexpr size_t WS_H = 1 * MiB;
constexpr size_t WS_PROJ = WS_H + SZ_ACT;
constexpr size_t WS_GATES = WS_PROJ + 9 * SZ_ACT;
constexpr size_t WS_E = WS_GATES + 4 * SZ_ACT;
constexpr size_t WS_LOGF = WS_E + SZ_ACT;
constexpr size_t WS_FB = WS_LOGF + 1 * MiB;
constexpr size_t WS_MQSS = WS_FB + 1 * MiB;
constexpr size_t WS_ESUM = WS_MQSS + 1 * MiB;
constexpr size_t WS_MEMN = WS_ESUM + 1 * MiB;
constexpr size_t WS_MEMRAW = WS_MEMN + 4 * MiB;
constexpr size_t WS_MK = WS_MEMRAW + 16 * MiB;
constexpr size_t WS_MVT = WS_MK + 4 * MiB;
constexpr size_t WS_LRU = WS_MVT + 4 * MiB;
constexpr size_t WS_WT = WS_LRU + 2 * MiB;
constexpr size_t WS_END = WS_WT + 72 * MiB;
constexpr size_t WS_YL = WS_PROJ + 6 * SZ_ACT, WS_YS = WS_H, WS_YM = WS_PROJ + 8 * SZ_ACT, WS_YF = WS_PROJ + 7 * SZ_ACT;
constexpr size_t WS_GV = WS_PROJ;
constexpr size_t WS_ACT = WS_GV + (size_t)T * 2 * DFF * 2;
static_assert(WS_ACT + (size_t)T * DFF * 2 <= WS_GATES, "ffn alias");
constexpr size_t WS_MIXF = WS_END;
constexpr size_t WS_MIXED = WS_PROJ;
constexpr size_t WS_NEED = WS_MIXF + (size_t)T * DM * 4;

struct Ptrs {
    const float* in[26];
    float* out;
    unsigned char* ws;
};

__global__ void __launch_bounds__(256) n_rmsnorm(const float* __restrict__ x, const float* __restrict__ g, bf16_t* __restrict__ H,
                                                 const float* __restrict__ Wf, const float* __restrict__ bfg, float* __restrict__ LOGF, int nrows) {
    const int lane = threadIdx.x & 63, row = blockIdx.x * 4 + (threadIdx.x >> 6);
    if (row >= nrows) return;
    const float4* xr = (const float4*)(x + (size_t)row * DM);
    const float4* gr = (const float4*)g;
    float4 v[4]; float ss = 0.f;
#pragma unroll
    for (int j = 0; j < 4; ++j) { v[j] = xr[lane + 64 * j]; ss += v[j].x * v[j].x + v[j].y * v[j].y + v[j].z * v[j].z + v[j].w * v[j].w; }
    ss = wave_sum(ss);
    const float rstd = rsqrtf(ss * (1.f / DM) + EPS);
#pragma unroll
    for (int j = 0; j < 4; ++j) { const float4 gg = gr[lane + 64 * j]; v[j].x *= rstd * gg.x; v[j].y *= rstd * gg.y; v[j].z *= rstd * gg.z; v[j].w *= rstd * gg.w;
        ushort4 o; o.x = f2bf(v[j].x); o.y = f2bf(v[j].y); o.z = f2bf(v[j].z); o.w = f2bf(v[j].w);
        ((ushort4*)(H + (size_t)row * DM))[lane + 64 * j] = o; }
    if (Wf) {
        float mine = 0.f;
        for (int h = 0; h < 16; ++h) {
            float p = 0.f;
#pragma unroll
            for (int j = 0; j < 4; ++j) { const int k = (lane + 64 * j) * 4;
                p += v[j].x * Wf[(size_t)k * NIN + h] + v[j].y * Wf[(size_t)(k + 1) * NIN + h] + v[j].z * Wf[(size_t)(k + 2) * NIN + h] + v[j].w * Wf[(size_t)(k + 3) * NIN + h]; }
            p = wave_sum(p);
            if (lane == h) mine = p;
        }
        if (lane < 16) { const int b = row / SEQ, t = row % SEQ; LOGF[((size_t)b * 16 + lane) * SEQ + t] = logsigmoidf(mine + bfg[lane]); }
    }
}

struct EStoreBf16 { bf16_t* O; int ldc; int pad; __device__ void operator()(int m, int n, float a) const { O[(size_t)m * ldc + n] = f2bf(a); } };
struct EStoreF32 { float* O; int ldc; int pad; __device__ void operator()(int m, int n, float a) const { O[(size_t)m * ldc + n] = a; } };
struct EBranch { const bf16_t* G; const float* bg; float* MIXF; bf16_t* MIXED; int i; int pad; __device__ void operator()(int m, int n, float a) const { float v = sigmoidf_(bf2f(G[(size_t)m * 4096 + i * 1024 + n]) + bg[n]) * a; const size_t o = (size_t)m * DM + n; if (i > 0) v += MIXF[o]; if (i < 3) MIXF[o] = v; else MIXED[o] = f2bf(v); } };
struct EResid { const float* base; float* out; __device__ void operator()(int m, int n, float a) const { out[(size_t)m * DM + n] = base[(size_t)m * DM + n] + a; } };

template <class Epi> __global__ void __launch_bounds__(256) n_gemm(const bf16_t* __restrict__ A, const float* __restrict__ W, int lda, int ldw, int K, int kmask, Epi epi) {
    __shared__ float As[16][68], Bs[16][68];
    const int tx = threadIdx.x & 15, ty = threadIdx.x >> 4, m0 = blockIdx.y * 64, n0 = blockIdx.x * 64;
    float acc[4][4];
#pragma unroll
    for (int i = 0; i < 4; ++i)
#pragma unroll
        for (int j = 0; j < 4; ++j) acc[i][j] = 0.f;
    for (int k0 = 0; k0 < K; k0 += 16) {
#pragma unroll
        for (int i = 0; i < 4; ++i) { const int idx = threadIdx.x + i * 256; { const int r = idx >> 4, c = idx & 15; As[c][r] = bf2f(A[(size_t)(m0 + r) * lda + k0 + c]); }
            { const int r = idx >> 6, c = idx & 63; Bs[r][c] = bfr(W[(size_t)((k0 + r) & kmask) * ldw + n0 + c]); } }
        __syncthreads();
#pragma unroll
        for (int kk = 0; kk < 16; ++kk) { float a[4], b[4];
#pragma unroll
            for (int i = 0; i < 4; ++i) { a[i] = As[kk][ty * 4 + i]; b[i] = Bs[kk][tx * 4 + i]; }
#pragma unroll
            for (int i = 0; i < 4; ++i)
#pragma unroll
                for (int j = 0; j < 4; ++j) acc[i][j] += a[i] * b[j]; }
        __syncthreads();
    }
#pragma unroll
    for (int i = 0; i < 4; ++i)
#pragma unroll
        for (int j = 0; j < 4; ++j) epi(m0 + ty * 4 + i, n0 + tx * 4 + j, acc[i][j]);
}

__global__ void __launch_bounds__(256) n_headnorm(bf16_t* X, const float* __restrict__ g, int HD, float scale) {
    const int idx = blockIdx.x * 256 + threadIdx.x, nh = DM / HD, row = idx / nh, h = idx % nh;
    if (row >= T) return;
    bf16_t* p = X + (size_t)row * DM + h * HD; float ss = 0.f;
    for (int d = 0; d < HD; ++d) { const float v = bf2f(p[d]); ss += v * v; }
    const float rstd = rsqrtf(ss / HD + EPS) * scale;
    for (int d = 0; d < HD; ++d) p[d] = f2bf(bf2f(p[d]) * rstd * g[d]);
}

__global__ void __launch_bounds__(1024) n_cumsum(const float* __restrict__ LOGF, float* __restrict__ FB) {
    __shared__ float part[1024];
    const int bh = blockIdx.x, tid = threadIdx.x; const float* src = LOGF + (size_t)bh * SEQ + tid * 8; float v[8]; float s = 0.f;
#pragma unroll
    for (int i = 0; i < 8; ++i) { s += src[i]; v[i] = s; }
    part[tid] = s; __syncthreads();
    if (tid == 0) { float run = 0.f; for (int i = 0; i < 1024; ++i) { const float t_ = part[i]; part[i] = run; run += t_; } }
    __syncthreads();
    const float off = part[tid]; float* dst = FB + (size_t)bh * SEQ + tid * 8;
#pragma unroll
    for (int i = 0; i < 8; ++i) dst[i] = off + v[i];
}

__global__ void __launch_bounds__(256) n_fox_attn(const bf16_t* Q, const bf16_t* __restrict__ K, const bf16_t* __restrict__ V, const float* __restrict__ FB, bf16_t* O) {
    __shared__ float Ks[64][64], Vs[64][64], Fs[64];
    const int bh = blockIdx.y, b = bh >> 4, h = bh & 15, tq = blockIdx.x * 256 + threadIdx.x;
    const size_t rowq = (size_t)b * SEQ + tq;
    float q[64], o[64];
#pragma unroll
    for (int d = 0; d < 64; ++d) { q[d] = bf2f(Q[rowq * DM + h * 64 + d]); o[d] = 0.f; }
    const float Ft = FB[(size_t)bh * SEQ + tq];
    float m = -INFINITY, l = 0.f;
    const int ntile = (blockIdx.x * 256 + 256) / 64;
    for (int kt = 0; kt < ntile; ++kt) {
        __syncthreads();
        for (int i = threadIdx.x; i < 64 * 64; i += 256) { const int r = i >> 6, c = i & 63; const size_t rk = ((size_t)b * SEQ + kt * 64 + r) * DM + h * 64 + c; Ks[r][c] = bf2f(K[rk]); Vs[r][c] = bf2f(V[rk]); }
        if (threadIdx.x < 64) Fs[threadIdx.x] = FB[(size_t)bh * SEQ + kt * 64 + threadIdx.x];
        __syncthreads();
        for (int j = 0; j < 64; ++j) {
            const int s = kt * 64 + j; if (s > tq) break;
            float z = 0.f;
#pragma unroll
            for (int d = 0; d < 64; ++d) z += q[d] * Ks[j][d];
            z += (Ft - Fs[j]) * LOG2E;
            if (z > m) { const float c = exp2f(m - z); l *= c;
#pragma unroll
                for (int d = 0; d < 64; ++d) o[d] *= c;
                m = z; }
            const float p = exp2f(z - m); l += p;
#pragma unroll
            for (int d = 0; d < 64; ++d) o[d] += p * Vs[j][d];
        }
    }
    const float il = 1.f / l;
#pragma unroll
    for (int d = 0; d < 64; ++d) O[rowq * DM + h * 64 + d] = f2bf(o[d] * il);
}

__global__ void __launch_bounds__(256) n_sb_attn(const bf16_t* Q, const bf16_t* __restrict__ K, const bf16_t* __restrict__ V, bf16_t* O) {
    __shared__ float Ks[64][64], Vs[64][64];
    const int bh = blockIdx.y, b = bh >> 4, h = bh & 15, tq = blockIdx.x * 256 + threadIdx.x;
    const size_t rowq = (size_t)b * SEQ + tq;
    float q[64], o[64];
#pragma unroll
    for (int d = 0; d < 64; ++d) { q[d] = bf2f(Q[rowq * DM + h * 64 + d]) * 0.125f; o[d] = 0.f; }
    float R = 0.f;
    for (int kt = (blockIdx.x * 256 + 255) / 64; kt >= 0; --kt) {
        if (__syncthreads_and(R < SB_THR)) break;
        for (int i = threadIdx.x; i < 64 * 64; i += 256) { const int r = i >> 6, c = i & 63; const size_t rk = ((size_t)b * SEQ + kt * 64 + r) * DM + h * 64 + c; Ks[r][c] = bf2f(K[rk]); Vs[r][c] = bf2f(V[rk]); }
        __syncthreads();
        for (int j = 63; j >= 0; --j) {
            const int s = kt * 64 + j; if (s >= tq) continue;
            float z = 0.f;
#pragma unroll
            for (int d = 0; d < 64; ++d) z += q[d] * Ks[j][d];
            const float sp = softplusf(z);
            const float w = __expf((z - sp) + R);
            R -= sp;
#pragma unroll
            for (int d = 0; d < 64; ++d) o[d] += w * Vs[j][d];
        }
    }
#pragma unroll
    for (int d = 0; d < 64; ++d) O[rowq * DM + h * 64 + d] = f2bf(o[d]);
}

__global__ void __launch_bounds__(64) n_lru(const bf16_t* LX, const bf16_t* __restrict__ LG, const float* __restrict__ cw, const float* __restrict__ cb,
                                            const float* __restrict__ wa, const float* __restrict__ ba, const float* __restrict__ wx, const float* __restrict__ bx,
                                            const float* __restrict__ lam, bf16_t* YL) {
    __shared__ float xs[64];
    const int b = blockIdx.x >> 4, n = blockIdx.x & 15, e = threadIdx.x, ch = n * 64 + e;
    float wA[64], wX[64];
#pragma unroll
    for (int d = 0; d < 64; ++d) { wA[d] = wa[((size_t)n * 64 + d) * 64 + e]; wX[d] = wx[((size_t)n * 64 + d) * 64 + e]; }
    const float w0 = cw[ch], w1 = cw[DM + ch], w2 = cw[2 * DM + ch], w3 = cw[3 * DM + ch], bc = cb[ch], bA = ba[ch], bX = bx[ch];
    const float spl = softplusf(-lam[ch]);
    float x1 = 0.f, x2 = 0.f, x3 = 0.f, hs = 0.f;
    for (int t = 0; t < SEQ; ++t) {
        const size_t r = ((size_t)b * SEQ + t) * DM + ch;
        const float x0 = bf2f(LX[r]);
        const float xc = bc + w3 * x0 + w2 * x1 + w1 * x2 + w0 * x3;
        x3 = x2; x2 = x1; x1 = x0;
        __syncthreads();
        xs[e] = xc;
        __syncthreads();
        float ra = bA, ri = bX;
#pragma unroll
        for (int d = 0; d < 64; ++d) { const float xv = xs[d]; ra += xv * wA[d]; ri += xv * wX[d]; }
        const float rr = sigmoidf_(ra), ii = sigmoidf_(ri);
        const float la = -8.f * rr * spl;
        const float a = __expf(la);
        const float u = sqrtf(-expm1f(2.f * la)) * (ii * xc);
        hs = a * hs + u;
        YL[r] = f2bf(hs * gelu_tanh(bf2f(LG[r])));
    }
}

__global__ void __launch_bounds__(256) n_memkv_post(const float* __restrict__ raw, const float* __restrict__ gk, const float* __restrict__ gq, bf16_t* __restrict__ MK, bf16_t* __restrict__ MVT) {
    const int row = blockIdx.x, b = row >> 8, m = row & 255, d = threadIdx.x;
    __shared__ float red[4];
    for (int h = 0; h < 4; ++h) {
        const float k = raw[(size_t)row * 2048 + h * 256 + d];
        float ss = wave_sum(k * k);
        __syncthreads();
        if ((threadIdx.x & 63) == 0) red[threadIdx.x >> 6] = ss;
        __syncthreads();
        ss = red[0] + red[1] + red[2] + red[3];
        const float rstd = rsqrtf(ss * (1.f / 256.f) + EPS);
        MK[((size_t)b * 256 + m) * DM + h * 256 + d] = f2bf(k * rstd * gk[d] * gq[d]);
        MVT[(((size_t)b * 4 + h) * 256 + d) * 256 + m] = f2bf(raw[(size_t)row * 2048 + 1024 + h * 256 + d]);
    }
}

__global__ void __launch_bounds__(256) n_mem_attn(const bf16_t* MQ, const bf16_t* __restrict__ MK, const bf16_t* __restrict__ MVT, bf16_t* YM) {
    __shared__ float qs[256], ps[256], red[4];
    const int row = blockIdx.x >> 2, h = blockIdx.x & 3, b = row / SEQ, tid = threadIdx.x;
    const float qv = bf2f(MQ[(size_t)row * DM + h * 256 + tid]);
    float ss = wave_sum(qv * qv);
    if ((tid & 63) == 0) red[tid >> 6] = ss;
    qs[tid] = qv;
    __syncthreads();
    const float rstd = rsqrtf((red[0] + red[1] + red[2] + red[3]) * (1.f / 256.f) + EPS);
    const bf16_t* kr = MK + ((size_t)b * 256 + tid) * DM + h * 256;
    float s = 0.f;
    for (int d = 0; d < 256; ++d) s += qs[d] * bf2f(kr[d]);
    s *= rstd * (1.f / 16.f);
    __syncthreads();
    float mx = s;
#pragma unroll
    for (int o = 1; o < 64; o <<= 1) mx = fmaxf(mx, __shfl_xor(mx, o));
    if ((tid & 63) == 0) red[tid >> 6] = mx;
    __syncthreads();
    mx = fmaxf(fmaxf(red[0], red[1]), fmaxf(red[2], red[3]));
    const float p = __expf(s - mx);
    ps[tid] = p;
    float sum = wave_sum(p);
    __syncthreads();
    if ((tid & 63) == 0) red[tid >> 6] = sum;
    __syncthreads();
    sum = red[0] + red[1] + red[2] + red[3];
    const bf16_t* vr = MVT + (((size_t)b * 4 + h) * 256 + tid) * 256;
    float o = 0.f;
    for (int m = 0; m < 256; ++m) o += ps[m] * bf2f(vr[m]);
    YM[(size_t)row * DM + h * 256 + tid] = f2bf(o / sum);
}

__global__ void __launch_bounds__(256) n_act(const bf16_t* __restrict__ GV, const float* __restrict__ cw, const float* __restrict__ cb, bf16_t* __restrict__ ACT) {
    const size_t idx = (size_t)blockIdx.x * 256 + threadIdx.x; if (idx >= (size_t)T * DFF) return;
    const int r = (int)(idx / DFF), c = (int)(idx % DFF), t = r % SEQ;
    const float g0 = bf2f(GV[(size_t)r * 2 * DFF + c]);
    const float g1 = t >= 1 ? bf2f(GV[(size_t)(r - 1) * 2 * DFF + c]) : 0.f;
    const float g2 = t >= 2 ? bf2f(GV[(size_t)(r - 2) * 2 * DFF + c]) : 0.f;
    const float pre = cb[c] + cw[2 * DFF + c] * g0 + cw[DFF + c] * g1 + cw[c] * g2;
    const float val = bf2f(GV[(size_t)r * 2 * DFF + DFF + c]);
    ACT[(size_t)r * DFF + c] = f2bf(pre * sigmoidf_(pre) * val);
}

#define CFG 32767
namespace pg8 {
#define PG8_LAS __attribute__((address_space(3)))
typedef unsigned short bf16_t;
typedef short bf16x8 __attribute__((ext_vector_type(8)));
typedef float f32x4 __attribute__((ext_vector_type(4)));
typedef unsigned u32x4 __attribute__((ext_vector_type(4)));
constexpr int BM = 256, BK = 64, HALF = 128, HTB = HALF * BK * 2  , STAGE_BYTES = 8 * HTB, NXCD = 8, WGM = 8;

__host__ __device__ __forceinline__ int lds_byte(int r, int c) { const int st = (r >> 4) * 2 + (c >> 5), rr = r & 15, cc = c & 31, ob = rr * 64 + cc * 2; return st * 1024 + (ob ^ (((ob >> 9) & 1) << 5)); }
__host__ __device__ __forceinline__ void stage_rc(int b, int& R, int& C) { const int st = b / 1024, sb = b % 1024, swz = sb ^ (((sb >> 9) & 1) << 5); R = (st >> 1) * 16 + swz / 64; C = (st & 1) * 32 + (swz % 64) / 2; }
__host__ __device__ __forceinline__ int perm32(int rho) { const int n = rho >> 4, i = rho & 15; return 8 * (i >> 2) + 4 * n + (i & 3); }

struct Unit { int pm, pn; };
struct Gemm { int lda, ldb, K; };

struct StaticOrder {
    int nM, nN, nwg, G, c;
    __host__ __device__ void init(int M, int N, int G_, int c_) { nM = M / BM; nN = N / BM; nwg = nM * nN; G = G_; c = c_; }
    __host__ __device__ bool next(int i, Unit& u) const {
        const long L = (long)i * G + c; if (L >= nwg) return false;
        int wgid = (int)L; { const int q = nwg / NXCD, r = nwg % NXCD, xcd = wgid % NXCD, off = wgid / NXCD; wgid = (xcd < r ? xcd * (q + 1) : r * (q + 1) + (xcd - r) * q) + off; }
        const int nig = WGM * nN, gid = wgid / nig, fm = gid * WGM, gsz = (nM - fm) < WGM ? (nM - fm) : WGM;
        u.pm = fm + ((wgid % nig) % gsz); u.pn = (wgid % nig) / gsz; return true;
    }
    __device__ __forceinline__ void a_ready(const Unit&) const {}
    __device__ __forceinline__ void done(const Unit&) const {}
};

__device__ __forceinline__ unsigned cvt_pk_bf16(float lo, float hi) { unsigned r; asm volatile("v_cvt_pk_bf16_f32 %0, %1, %2" : "=v"(r) : "v"(lo), "v"(hi)); return r; }
typedef float f32x2 __attribute__((ext_vector_type(2)));
__device__ __forceinline__ f32x2 gelu_pk(f32x2 v) {
    const f32x2 av = __builtin_elementwise_abs(v), d = av * 0.2316418882f + 1.0f;
    f32x2 t; t.x = __builtin_amdgcn_rcpf(d.x); t.y = __builtin_amdgcn_rcpf(d.y);
    f32x2 q = t * 0.5307027145f + (-0.7265760135f); q = q * t + 0.7107068705f; q = q * t + (-0.142248368f); q = q * t + 0.127414796f; q = q * t;
    const f32x2 s = (v * v) * (-0.72134752044f);
    f32x2 e; e.x = __builtin_amdgcn_exp2f(s.x); e.y = __builtin_amdgcn_exp2f(s.y);
    const f32x2 m = v * (q * e), r = v - m;
    f32x2 o; o.x = v.x < 0.f ? m.x : r.x; o.y = v.y < 0.f ? m.y : r.y; return o;
}

template <class Epi, class Sched, bool ALIGN_EPI = false, bool SP2 = false>
__device__ __forceinline__ void gemm_phase(PG8_LAS unsigned char* lds, const Gemm g, const Sched& S, const Epi& E) {
    const int tid = mk_tid(), wid = __builtin_amdgcn_readfirstlane(tid >> 6), lane = tid & 63, wr = wid >> 2, wc = wid & 3, fr = lane & 15, fq = lane >> 4;
    const int K = g.K, nt = K / BK;
    unsigned voffA[2], voffB[2];
#pragma unroll
    for (int i = 0; i < 2; ++i) { int R, C; stage_rc(tid * 16 + i * 8192, R, C); const int Rb = Epi::PERM ? ((R & ~31) + perm32(R & 31)) : R;
        voffA[i] = (unsigned)(R * g.lda + C) * 2u; voffB[i] = (unsigned)(Rb * g.ldb + C) * 2u; }
    const size_t kstep = (size_t)(BK * 2);
    const size_t hstepA = (size_t)HALF * g.lda * 2, hstepB = (size_t)HALF * g.ldb * 2;
    const unsigned ldsw = (unsigned)wid * 1024u;
    const int aoff = lds_byte(wr * 64 + fr, fq * 8), boff = lds_byte(wc * 32 + fr, fq * 8);
#define PG8_SA(b, h) (((b) * 2 + (h)) * HTB)
#define PG8_SB(b, h) ((4 + (b) * 2 + (h)) * HTB)
#define PG8_STAGE(bufoff, gbase, voff) do { _Pragma("unroll") for (int _i = 0; _i < 2; ++_i) \
        __builtin_amdgcn_global_load_lds((const unsigned*)((const char*)(gbase) + (voff)[_i]), (PG8_LAS unsigned*)(lds + (bufoff) + ldsw + _i * 8192), 16, 0, 0); } while (0)
#define PG8_LDA(dst, b, h) do { _Pragma("unroll") for (int m = 0; m < 4; ++m) _Pragma("unroll") for (int k = 0; k < 2; ++k) dst[m][k] = *(const PG8_LAS bf16x8*)(lds + PG8_SA(b, h) + aoff + m * 2048 + k * 1024); } while (0)
#define PG8_LDB(dst, b, h) do { _Pragma("unroll") for (int n = 0; n < 2; ++n) _Pragma("unroll") for (int k = 0; k < 2; ++k) dst[n][k] = *(const PG8_LAS bf16x8*)(lds + PG8_SB(b, h) + boff + n * 2048 + k * 1024); } while (0)
#define PG8_MMA(ai, bj, At, Bt) do { __builtin_amdgcn_s_setprio(1); _Pragma("unroll") for (int m = 0; m < 4; ++m) _Pragma("unroll") for (int n = 0; n < 2; ++n) _Pragma("unroll") for (int k = 0; k < 2; ++k) \
        acc[ai][bj][m][n] = __builtin_amdgcn_mfma_f32_16x16x32_bf16(Bt[n][k], At[m][k], acc[ai][bj][m][n], 0, 0, 0); __builtin_amdgcn_s_setprio(0); } while (0)
#define PG8_WAIT_V(n) asm volatile("s_waitcnt vmcnt(" #n ")" ::: "memory")
#define PG8_WAIT_L(n) asm volatile("s_waitcnt lgkmcnt(" #n ")" ::: "memory")
#define PG8_BAR __builtin_amdgcn_s_barrier()
#define PG8_SCHED __builtin_amdgcn_sched_barrier(0)
    Unit cur, nxt; int ui = 0;
    if (!S.next(0, cur)) return;
    f32x4 acc[2][2][4][2];
#pragma unroll
    for (int a = 0; a < 2; ++a)
#pragma unroll
        for (int b = 0; b < 2; ++b)
#pragma unroll
            for (int m = 0; m < 4; ++m)
#pragma unroll
                for (int n = 0; n < 2; ++n) acc[a][b][m][n] = (f32x4){0.f, 0.f, 0.f, 0.f};
    bf16x8 At[4][2], B0[2][2], B1[2][2];
    const char* cA = S.aptr(cur); const char* cB = S.bptr(cur);
    S.a_ready(cur);
    if constexpr (SP2) {
        PG8_STAGE(PG8_SB(0, 0), cB, voffB); PG8_STAGE(PG8_SB(0, 1), cB + hstepB, voffB); PG8_STAGE(PG8_SA(0, 0), cA, voffA); PG8_STAGE(PG8_SA(0, 1), cA + hstepA, voffA);
        if (wr == 1) PG8_BAR;
        PG8_WAIT_V(2); PG8_BAR;
        PG8_STAGE(PG8_SB(1, 0), cB + kstep, voffB); PG8_STAGE(PG8_SA(1, 0), cA + kstep, voffA); PG8_STAGE(PG8_SB(1, 1), cB + hstepB + kstep, voffB);
        PG8_WAIT_V(6); PG8_BAR;
    } else {
        PG8_STAGE(PG8_SB(0, 0), cB, voffB); PG8_STAGE(PG8_SA(0, 0), cA, voffA); PG8_STAGE(PG8_SB(0, 1), cB + hstepB, voffB); PG8_STAGE(PG8_SA(0, 1), cA + hstepA, voffA);
        if (wr == 1) PG8_BAR;
        PG8_WAIT_V(4); PG8_BAR;
        PG8_STAGE(PG8_SB(1, 0), cB + kstep, voffB); PG8_STAGE(PG8_SA(1, 0), cA + kstep, voffA); PG8_STAGE(PG8_SB(1, 1), cB + hstepB + kstep, voffB);
        PG8_WAIT_V(6); PG8_BAR;
    }
    for (;;) {
        const bool has_next = S.next(ui + 1, nxt);
        const char* nA = has_next ? S.aptr(nxt) : cA; const char* nB = has_next ? S.bptr(nxt) : cB;
        for (int t = 0; t < nt; t += 2) {
            const bool last = (t == nt - 2);
            const char* a1 = cA + (size_t)(t + 1) * kstep;
            const char* a2 = last ? nA : cA + (size_t)(t + 2) * kstep; const char* b2 = last ? nB : cB + (size_t)(t + 2) * kstep;
            const char* a3 = a2 + kstep; const char* b3 = b2 + kstep;
            if (last && has_next) S.a_ready(nxt);
            if constexpr (SP2) {
            PG8_LDB(B0, 0, 0); PG8_LDB(B1, 0, 1); PG8_SCHED; PG8_LDA(At, 0, 0); PG8_STAGE(PG8_SA(1, 1), a1 + hstepA, voffA);
            PG8_WAIT_V(8); PG8_WAIT_L(0); PG8_BAR; PG8_MMA(0, 0, At, B0); PG8_MMA(0, 1, At, B1); PG8_BAR; PG8_SCHED;
            PG8_LDA(At, 0, 1); PG8_STAGE(PG8_SB(0, 0), b2, voffB); PG8_STAGE(PG8_SB(0, 1), b2 + hstepB, voffB); PG8_STAGE(PG8_SA(0, 0), a2, voffA);
            PG8_WAIT_V(8); PG8_WAIT_L(0); PG8_BAR; PG8_MMA(1, 0, At, B0); PG8_MMA(1, 1, At, B1); PG8_BAR; PG8_SCHED;
            PG8_LDB(B0, 1, 0); PG8_LDB(B1, 1, 1); PG8_SCHED; PG8_LDA(At, 1, 0); PG8_STAGE(PG8_SA(0, 1), a2 + hstepA, voffA);
            PG8_WAIT_V(8); PG8_WAIT_L(0); PG8_BAR; PG8_MMA(0, 0, At, B0); PG8_MMA(0, 1, At, B1); PG8_BAR; PG8_SCHED;
            PG8_LDA(At, 1, 1); PG8_STAGE(PG8_SB(1, 0), b3, voffB); PG8_STAGE(PG8_SB(1, 1), b3 + hstepB, voffB); PG8_STAGE(PG8_SA(1, 0), a3, voffA);
            PG8_WAIT_V(8); PG8_WAIT_L(0); PG8_BAR; PG8_MMA(1, 0, At, B0); PG8_MMA(1, 1, At, B1); PG8_BAR; PG8_SCHED;
            } else {
            PG8_LDB(B0, 0, 0); PG8_SCHED; PG8_LDA(At, 0, 0); PG8_STAGE(PG8_SA(1, 1), a1 + hstepA, voffA);
            PG8_WAIT_L(8); PG8_BAR; PG8_WAIT_L(0); PG8_MMA(0, 0, At, B0); PG8_BAR; PG8_SCHED;
            PG8_LDB(B1, 0, 1); PG8_STAGE(PG8_SB(0, 0), b2, voffB);
            PG8_BAR; PG8_WAIT_L(0); PG8_MMA(0, 1, At, B1); PG8_BAR;
            PG8_LDA(At, 0, 1); PG8_STAGE(PG8_SA(0, 0), a2, voffA);
            PG8_BAR; PG8_WAIT_L(0); PG8_MMA(1, 0, At, B0); PG8_BAR; PG8_SCHED;
            PG8_STAGE(PG8_SB(0, 1), b2 + hstepB, voffB);
            PG8_WAIT_V(6); PG8_BAR; PG8_MMA(1, 1, At, B1); PG8_BAR;
            PG8_LDB(B0, 1, 0); PG8_SCHED; PG8_LDA(At, 1, 0); PG8_STAGE(PG8_SA(0, 1), a2 + hstepA, voffA);
            PG8_WAIT_L(8); PG8_BAR; PG8_WAIT_L(0); PG8_MMA(0, 0, At, B0); PG8_BAR; PG8_SCHED;
            PG8_LDB(B1, 1, 1); PG8_STAGE(PG8_SB(1, 0), b3, voffB);
            PG8_BAR; PG8_WAIT_L(0); PG8_MMA(0, 1, At, B1); PG8_BAR;
            PG8_LDA(At, 1, 1); PG8_STAGE(PG8_SA(1, 0), a3, voffA);
            PG8_BAR; PG8_WAIT_L(0); PG8_MMA(1, 0, At, B0); PG8_BAR; PG8_SCHED;
            PG8_STAGE(PG8_SB(1, 1), b3 + hstepB, voffB);
            PG8_WAIT_V(6); PG8_BAR; PG8_MMA(1, 1, At, B1); PG8_BAR;
            }
        }
        if constexpr (ALIGN_EPI) { if (wr == 0) PG8_BAR; }
        if constexpr (!Epi::AFTER_DRAIN) { int fr_ = fr, fq_ = fq; asm volatile("" : "+v"(fr_), "+v"(fq_));   E(acc, cur, wr, wc, fr_, fq_); S.done(cur); }
        if (!has_next) break;
#pragma unroll
        for (int a = 0; a < 2; ++a)
#pragma unroll
            for (int b = 0; b < 2; ++b)
#pragma unroll
                for (int m = 0; m < 4; ++m)
#pragma unroll
                    for (int n = 0; n < 2; ++n) acc[a][b][m][n] = (f32x4){0.f, 0.f, 0.f, 0.f};
        cur = nxt; cA = nA; cB = nB; ++ui;
        if constexpr (ALIGN_EPI) { if (wr == 1) PG8_BAR; }
    }
    PG8_WAIT_V(0);
    if constexpr (!ALIGN_EPI) { if (wr == 0) PG8_BAR; }
    PG8_BAR;
    if constexpr (Epi::AFTER_DRAIN) { E.fused(acc, cur, wr, wc, fr, fq, lds, wid, lane); S.done(cur); }
#undef PG8_SA
#undef PG8_SB
#undef PG8_STAGE
#undef PG8_LDA
#undef PG8_LDB
#undef PG8_MMA
#undef PG8_WAIT_V
#undef PG8_WAIT_L
#undef PG8_BAR
#undef PG8_SCHED
}
}
#include <hip/hip_bf16.h>
#include <cmath>
namespace attn_body {
using bf16=__hip_bfloat16;
using bf16x8=__attribute__((ext_vector_type(8)))short;
using s16x4=__attribute__((ext_vector_type(4)))short;
using f32x16=__attribute__((ext_vector_type(16)))float;
using u32x4=__attribute__((ext_vector_type(4)))unsigned;
constexpr int BATCH=2,NHEAD=16,SEQ=8192,D=64,DM=NHEAD*D;
constexpr int NW=8,QBLK=32,QB=QBLK*NW,KVBLK=64,NQB=SEQ/QB;
constexpr int ATTN_PITCH=DM, ATTN_UNIT_ROWS=QB;
__device__ __forceinline__ int crow(int r,int hi){return (r&3)+8*(r>>2)+4*hi;}
#define SBAR() __builtin_amdgcn_sched_barrier(0)
__device__ __forceinline__ void cmask(f32x16&p0,f32x16&p1,int jb,int qrel,int hi){
  const float NEG=-INFINITY; int kb=64*jb+4*hi;
  #pragma unroll
  for(int r=0;r<16;++r){int kv=kb+(r&3)+8*(r>>2); if(kv>qrel)p0[r]=NEG; if(kv+32>qrel)p1[r]=NEG;}
}

constexpr int NSLOT=3, SLOTB=8192;
constexpr int LDS_K=0, LDS_V=NSLOT*SLOTB, LDS_WS=2*NSLOT*SLOTB, LDS_OST=LDS_WS+NW*64*4, LDS_BYTES=LDS_OST+NW*4096;
constexpr int BIAS_OFF=86016;
constexpr float C2=0.125f*1.4426950408889634f;
__device__ __forceinline__ void glds16(const void*gsrc,unsigned lds_dst){unsigned keep;
  asm volatile("s_mov_b32 %0, m0\n\ts_mov_b32 m0, %2\n\ts_nop 0\n\tglobal_load_lds_dwordx4 %1, off\n\ts_mov_b32 m0, %0":"=&s"(keep):"v"(gsrc),"s"(lds_dst):"memory");}
__device__ __forceinline__ float max3f(float a,float b,float c){float r;asm("v_max3_f32 %0, %1, %2, %3":"=v"(r):"v"(a),"v"(b),"v"(c));return r;}
__device__ __forceinline__ float max2f(float a,float b){float r;asm("v_max_f32_e32 %0, %1, %2":"=v"(r):"v"(a),"v"(b));return r;}
__device__ __forceinline__ float fadd_s(float a,float b){float r;asm("v_add_f32_e32 %0, %1, %2":"=v"(r):"v"(a),"v"(b));return r;}
__device__ __forceinline__ float fsub_s(float a,float b){float r;asm("v_sub_f32_e32 %0, %1, %2":"=v"(r):"v"(a),"v"(b));return r;}
typedef float f32x2_t __attribute__((ext_vector_type(2))); typedef __bf16 bf16x2_t __attribute__((ext_vector_type(2)));
__device__ __forceinline__ unsigned cvtpk_s(float lo,float hi){f32x2_t v={lo,hi};bf16x2_t b=__builtin_convertvector(v,bf16x2_t);return __builtin_bit_cast(unsigned,b);}
#define WAIT_BAR(N) asm volatile("s_waitcnt vmcnt(" #N ") lgkmcnt(0)\n\ts_barrier":::"memory")

__device__ __forceinline__ void qkt(f32x16&p0,f32x16&p1,const char*Kslot,const bf16x8*qr,const f32x16&negm,int r32,int hi){
  const char*kb=Kslot+hi*1024+r32*16;
  #pragma unroll
  for(int d0=0;d0<4;++d0){
    const bf16x8 b0=*reinterpret_cast<const bf16x8*>(kb+d0*2048);
    const bf16x8 b1=*reinterpret_cast<const bf16x8*>(kb+d0*2048+512);
    if(d0==0){p0=__builtin_amdgcn_mfma_f32_32x32x16_bf16(b0,qr[0],negm,0,0,0);p1=__builtin_amdgcn_mfma_f32_32x32x16_bf16(b1,qr[0],negm,0,0,0);}
    else{p0=__builtin_amdgcn_mfma_f32_32x32x16_bf16(b0,qr[d0],p0,0,0,0);p1=__builtin_amdgcn_mfma_f32_32x32x16_bf16(b1,qr[d0],p1,0,0,0);}}
}
typedef __attribute__((address_space(3))) const char* lds_cptr;
typedef short v4i16_t __attribute__((ext_vector_type(4)));
__device__ __forceinline__ void kload8(bf16x8*kf,lds_cptr kp){
  kf[0]=*(const __attribute__((address_space(3))) bf16x8*)(kp);      kf[1]=*(const __attribute__((address_space(3))) bf16x8*)(kp+512);
  kf[2]=*(const __attribute__((address_space(3))) bf16x8*)(kp+2048); kf[3]=*(const __attribute__((address_space(3))) bf16x8*)(kp+2560);
  kf[4]=*(const __attribute__((address_space(3))) bf16x8*)(kp+4096); kf[5]=*(const __attribute__((address_space(3))) bf16x8*)(kp+4608);
  kf[6]=*(const __attribute__((address_space(3))) bf16x8*)(kp+6144); kf[7]=*(const __attribute__((address_space(3))) bf16x8*)(kp+6656);
}
__device__ __forceinline__ void kload2(bf16x8*kf,lds_cptr kp,int j){ kf[2*j]=*(const __attribute__((address_space(3))) bf16x8*)(kp+j*2048); kf[2*j+1]=*(const __attribute__((address_space(3))) bf16x8*)(kp+j*2048+512); }
__device__ __forceinline__ s16x4 vtr(lds_cptr p){ return __builtin_bit_cast(s16x4,__builtin_amdgcn_ds_read_tr16_b64_v4i16((__attribute__((address_space(3))) v4i16_t*)p)); }
__device__ __forceinline__ float rowmax(const f32x16&p0,const f32x16&p1){
  float a=max3f(p0[0],p0[1],p1[0]),b=max3f(p0[2],p0[3],p1[1]);a=max3f(a,p1[2],p1[3]);
  #pragma unroll
  for(int r=4;r<16;r+=4){a=max3f(a,p0[r],p0[r+1]);b=max3f(b,p0[r+2],p0[r+3]);a=max3f(a,p1[r],p1[r+1]);b=max3f(b,p1[r+2],p1[r+3]);}
  const float m=max2f(a,b);
  auto rr=__builtin_amdgcn_permlane32_swap(__float_as_uint(m),__float_as_uint(m),false,false);
  return max2f(__uint_as_float(rr[0]),__uint_as_float(rr[1]));
}
__device__ __forceinline__ void pv(f32x16*o,int vb,bf16x8 pa0,bf16x8 pa1,bf16x8 pa2,bf16x8 pa3){
  #pragma unroll
  for(int d0=0;d0<2;++d0){s16x4 lo[4],hi[4];
    #pragma unroll
    for(int ks=0;ks<4;++ks){
      asm volatile("ds_read_b64_tr_b16 %0,%1 offset:%c2":"=&v"(lo[ks]):"v"(vb),"i"(d0*4096+ks*1024):"memory");
      asm volatile("ds_read_b64_tr_b16 %0,%1 offset:%c2":"=&v"(hi[ks]):"v"(vb),"i"(d0*4096+ks*1024+512):"memory");}
    asm volatile("s_waitcnt lgkmcnt(0)":::"memory");SBAR();
    #define PK(k) (bf16x8){lo[k][0],lo[k][1],lo[k][2],lo[k][3],hi[k][0],hi[k][1],hi[k][2],hi[k][3]}
    o[d0]=__builtin_amdgcn_mfma_f32_32x32x16_bf16(pa0,PK(0),o[d0],0,0,0);
    o[d0]=__builtin_amdgcn_mfma_f32_32x32x16_bf16(pa1,PK(1),o[d0],0,0,0);
    o[d0]=__builtin_amdgcn_mfma_f32_32x32x16_bf16(pa2,PK(2),o[d0],0,0,0);
    o[d0]=__builtin_amdgcn_mfma_f32_32x32x16_bf16(pa3,PK(3),o[d0],0,0,0);
    #undef PK
  }
}

#ifndef ATTN_STORE16
#define ATTN_STORE16(p,v) (*(u32x4*)(p)=(v))
#endif
template<int THRL> __device__ __forceinline__ void attn_unit(int b,int h,int qb,const bf16*Q,const bf16*__restrict__ K,const bf16*__restrict__ V,bf16*O,const float*__restrict__ FBrow,float skip_thr,char*shm){
  const int tid=mk_tid(),lane=tid&63,r32=lane&31,hi=lane>>5; const int wid=__builtin_amdgcn_readfirstlane(tid>>6);
  const long rowbase=(long)b*SEQ; const int q0=qb*QB;
  int t_start=0;
  { const int ntf=(q0+QB)/KVBLK; const float Fq0=FBrow[q0];
    const bool c0=lane<ntf&&(Fq0-FBrow[64*(lane<ntf?lane:0)+63])*1.4426950408889634f<skip_thr;
    const bool c1=(lane+64)<ntf&&(Fq0-FBrow[64*((lane+64)<ntf?lane+64:0)+63])*1.4426950408889634f<skip_thr;
    int cnt=__popcll(__ballot(c0))+__popcll(__ballot(c1)); cnt&=~1; if(cnt>ntf-4)cnt=ntf-4; t_start=__builtin_amdgcn_readfirstlane(cnt); }
  const bf16*Qw=Q+(rowbase+q0+wid*QBLK)*DM+h*D;
  const bf16*Kh=K+(rowbase+(long)t_start*KVBLK)*DM+h*D,*Vh=V+(rowbase+(long)t_start*KVBLK)*DM+h*D;
  const lds_cptr shm3=(lds_cptr)shm;
  const unsigned lds0=(unsigned)(uintptr_t)shm;
  float*wsf=(float*)(shm+LDS_WS)+wid*64;
  const bf16*ksrc=Kh+(long)lane*DM+wid*8;
  const bf16*vsrc=Vh+(long)(16*(wid&3)+(lane>>2))*DM+(wid>>2)*32+(lane&3)*8;
  const unsigned kdst=lds0+LDS_K+wid*1024, vdst=lds0+LDS_V+wid*1024;
  #define DMA_K(t,slot) glds16(ksrc+(long)(t)*KVBLK*DM,(unsigned)__builtin_amdgcn_readfirstlane(kdst+(slot)))
  #define DMA_V(t,slot) glds16(vsrc+(long)(t)*KVBLK*DM,(unsigned)__builtin_amdgcn_readfirstlane(vdst+(slot)))
  const int vb0=(int)(lds0+LDS_V)+((lane>>4)&1)*32+(lane&3)*8+(4*hi+((lane&15)>>2))*64;
  const char*Kbase=shm+LDS_K; bf16x8 kf[8];
  const lds_cptr kp0=shm3+LDS_K+hi*1024+r32*16; const lds_cptr vp0=shm3+LDS_V+((lane>>4)&1)*32+(lane&3)*8+(4*hi+((lane&15)>>2))*64;
  const int NT=(q0+QB)/KVBLK-t_start;
  {
    typedef __attribute__((address_space(3))) float lds_f32; lds_f32* bl=(lds_f32*)(shm3+BIAS_OFF);
    const int nb=q0+QB; const float Fl=FBrow[nb-1];
    for(int i=t_start*KVBLK+tid;i<nb;i+=NW*64) bl[i]=(Fl-FBrow[i])*1.4426950408889634f;
    asm volatile("s_waitcnt vmcnt(0) lgkmcnt(0)\n\ts_barrier":::"memory"); }
  typedef float f32x4v __attribute__((ext_vector_type(4)));
  #define BIAS(P0,P1,t) do{ const __attribute__((address_space(3))) f32x4v* bp_=(const __attribute__((address_space(3))) f32x4v*)(shm3+BIAS_OFF)+((t)+t_start)*16+hi; \
    _Pragma("unroll") for(int g_=0;g_<4;++g_){ const f32x4v f0_=bp_[2*g_]+nm, f1_=bp_[8+2*g_]+nm; \
      P0[4*g_]+=f0_[0];P0[4*g_+1]+=f0_[1];P0[4*g_+2]+=f0_[2];P0[4*g_+3]+=f0_[3]; P1[4*g_]+=f1_[0];P1[4*g_+1]+=f1_[1];P1[4*g_+2]+=f1_[2];P1[4*g_+3]+=f1_[3]; } }while(0)
  DMA_K(0,0);DMA_V(0,0);DMA_K(1,SLOTB);
  bf16x8 qr[4];
  #pragma unroll
  for(int d0=0;d0<4;++d0)qr[d0]=*reinterpret_cast<const bf16x8*>(&Qw[(long)r32*DM+d0*16+hi*8]);
  float mhat=0.f,l_reg=0.f;f32x16 o[2];o[0]=f32x16{};o[1]=f32x16{};const f32x16 negm=f32x16{}; float nm=0.f;
  const int qrel=wid*QBLK+r32;
  #define CMASK(P0,P1,t) do{int jb_=(t)-(NT-4); if(jb_>=0)cmask(P0,P1,jb_,qrel,hi);}while(0)
  bool resc=false;
  #define START(P0,P1) do{ const float rm=rowmax(P0,P1); resc=false; \
    { const float dl=rm; mhat=fadd_s(mhat,dl); \
      _Pragma("unroll") for(int r=0;r<16;++r){P0[r]=fsub_s(P0[r],dl);P1[r]=fsub_s(P1[r],dl);} \
      nm=-mhat; } \
    _Pragma("unroll") for(int r=0;r<16;++r)P0[r]=__builtin_amdgcn_exp2f(P0[r]); }while(0)
  #define RESC() do{ if(resc){ asm volatile("s_waitcnt lgkmcnt(0)":::"memory"); \
      _Pragma("unroll") for(int d_=0;d_<2;++d_) _Pragma("unroll") for(int r=0;r<16;++r)o[d_][r]*=wsf[crow(r,hi)]; } }while(0)
  f32x16 pA0,pA1,pB0,pB1;
  int sl_prev=0,sl_cur=0,sl_next=SLOTB;
  #define ROT() do{sl_prev=sl_cur;sl_cur=sl_next;sl_next=(sl_next==(NSLOT-1)*SLOTB)?0:sl_next+SLOTB;}while(0)
  DMA_K(2,2*SLOTB);
  WAIT_BAR(3);
  qkt(pA0,pA1,Kbase,qr,negm,r32,hi);asm volatile("s_nop 15\n\ts_nop 7":"+v"(pA0),"+v"(pA1));BIAS(pA0,pA1,0);CMASK(pA0,pA1,0);
  START(pA0,pA1);
  _Pragma("unroll") for(int r=0;r<16;++r)pA1[r]=__builtin_amdgcn_exp2f(pA1[r]);
  WAIT_BAR(0);
  DMA_K(3,0);DMA_V(1,SLOTB);
  ROT();
  kload8(kf,kp0+sl_cur);
  WAIT_BAR(2);
  s16x4 vlo[8],vhi[8]; u32x4 pw0,pw1,pw2,pw3;
  #define PKW(P,B) cvtpk_s(P[B],P[B+1])
  #define PAF(k) __builtin_bit_cast(bf16x8,pw##k)
  #define VFR(i) (bf16x8){vlo[i][0],vlo[i][1],vlo[i][2],vlo[i][3],vhi[i][0],vhi[i][1],vhi[i][2],vhi[i][3]}
  #define PIN(x) asm volatile("":"+v"(x))
  #define MX3(a,b,c) __builtin_fmaxf(__builtin_fmaxf((a),(b)),(c))
  #define GAPA(MF,A0,A1,A2,A3,W0,W1,PW) do{ MF; sacc+=A0; sacc+=A1; sacc+=A2; sacc+=A3; PIN(sacc); W0; W1; PIN(PW); SBAR(); }while(0)
  #define EX(v) __builtin_amdgcn_exp2f(v)
  #define GAPB(MF,X,B) do{ MF; X[B]=EX(X[B]); X[B+1]=EX(X[B+1]); X[B+2]=EX(X[B+2]); X[B+3]=EX(X[B+3]); PIN(X); SBAR(); }while(0)
  #define VRD(i) do{ vlo[i]=vtr(vp_+(((i)>>2)*4096+((i)&3)*1024)); vhi[i]=vtr(vp_+(((i)>>2)*4096+((i)&3)*1024+512)); }while(0)
  #define KRD(G,j) do{ if(G){ kload2(kf,kp0+sl_next,j); SBAR(); } }while(0)
  #define STEP(C0,C1,P0,P1,t,GK,GV,GL) do{ SBAR(); \
    const lds_cptr vp_=vp0+sl_prev; \
    VRD(0); SBAR(); float sacc=(P0[0]+P0[1]); \
    GAPA(C0=__builtin_amdgcn_mfma_f32_32x32x16_bf16(kf[0],qr[0],negm,0,0,0), P0[2],P0[3],P0[4],P0[5],     pw0[0]=PKW(P0,0), pw0[1]=PKW(P0,2), pw0); \
    VRD(4); SBAR(); GAPA(C1=__builtin_amdgcn_mfma_f32_32x32x16_bf16(kf[1],qr[0],negm,0,0,0), P0[6],P0[7],P0[8],P0[9],     pw0[2]=PKW(P0,4), pw0[3]=PKW(P0,6), pw0); \
    VRD(1); SBAR(); GAPA(C0=__builtin_amdgcn_mfma_f32_32x32x16_bf16(kf[2],qr[1],C0,0,0,0),   P0[10],P0[11],P0[12],P0[13], pw1[0]=PKW(P0,8), pw1[1]=PKW(P0,10), pw1); \
    VRD(5); SBAR(); GAPA(C1=__builtin_amdgcn_mfma_f32_32x32x16_bf16(kf[3],qr[1],C1,0,0,0),   P0[14],P0[15],P1[0],P1[1],   pw1[2]=PKW(P0,12),pw1[3]=PKW(P0,14), pw1); \
    VRD(2); SBAR(); GAPA(C0=__builtin_amdgcn_mfma_f32_32x32x16_bf16(kf[4],qr[2],C0,0,0,0),   P1[2],P1[3],P1[4],P1[5],     pw2[0]=PKW(P1,0), pw2[1]=PKW(P1,2), pw2); \
    VRD(6); SBAR(); GAPA(C1=__builtin_amdgcn_mfma_f32_32x32x16_bf16(kf[5],qr[2],C1,0,0,0),   P1[6],P1[7],P1[8],P1[9],     pw2[2]=PKW(P1,4), pw2[3]=PKW(P1,6), pw2); \
    VRD(3); SBAR(); GAPA(C0=__builtin_amdgcn_mfma_f32_32x32x16_bf16(kf[6],qr[3],C0,0,0,0),   P1[10],P1[11],P1[12],P1[13], pw3[0]=PKW(P1,8), pw3[1]=PKW(P1,10), pw3); \
    VRD(7); SBAR(); GAPA(C1=__builtin_amdgcn_mfma_f32_32x32x16_bf16(kf[7],qr[3],C1,0,0,0),   P1[14],P1[15],0.f,0.f,       pw3[2]=PKW(P1,12),pw3[3]=PKW(P1,14), pw3); \
    l_reg+=sacc; \
    if(GK){DMA_K((t)+3,sl_cur);} if(GV){DMA_V((t)+1,sl_next);} \
    BIAS(C0,C1,t); CMASK(C0,C1,t); \
    { float a=MX3(C0[0],C0[1],C1[0]),b=MX3(C0[2],C0[3],C1[1]); a=MX3(a,C1[2],C1[3]); \
      _Pragma("unroll") for(int r=4;r<16;r+=4){a=MX3(a,C0[r],C0[r+1]);b=MX3(b,C0[r+2],C0[r+3]);a=MX3(a,C1[r],C1[r+1]);b=MX3(b,C1[r+2],C1[r+3]);} \
      float rm=__builtin_fmaxf(a,b); { auto rr=__builtin_amdgcn_permlane32_swap(__float_as_uint(rm),__float_as_uint(rm),false,false); rm=__builtin_fmaxf(__uint_as_float(rr[0]),__uint_as_float(rr[1])); } \
      resc=false; \
      if(__builtin_expect(__any(rm>(float)THRL),0)){ const float dl=__builtin_fmaxf(rm,0.f); mhat+=dl; \
        _Pragma("unroll") for(int r=0;r<16;++r){C0[r]-=dl;C1[r]-=dl;} \
        nm=-mhat; \
        const float f=__builtin_amdgcn_exp2f(-dl); l_reg*=f; if(hi==0)wsf[r32]=f; resc=true; } } \
    SBAR(); \
    GAPB(o[0]=__builtin_amdgcn_mfma_f32_32x32x16_bf16(PAF(0),VFR(0),o[0],0,0,0), C0,0); \
    GAPB(o[1]=__builtin_amdgcn_mfma_f32_32x32x16_bf16(PAF(0),VFR(4),o[1],0,0,0), C0,4); \
    KRD(GL,0); GAPB(o[0]=__builtin_amdgcn_mfma_f32_32x32x16_bf16(PAF(1),VFR(1),o[0],0,0,0), C0,8); \
    KRD(GL,1); GAPB(o[1]=__builtin_amdgcn_mfma_f32_32x32x16_bf16(PAF(1),VFR(5),o[1],0,0,0), C0,12); \
    KRD(GL,2); GAPB(o[0]=__builtin_amdgcn_mfma_f32_32x32x16_bf16(PAF(2),VFR(2),o[0],0,0,0), C1,0); \
    KRD(GL,3); GAPB(o[1]=__builtin_amdgcn_mfma_f32_32x32x16_bf16(PAF(2),VFR(6),o[1],0,0,0), C1,4); \
    GAPB(o[0]=__builtin_amdgcn_mfma_f32_32x32x16_bf16(PAF(3),VFR(3),o[0],0,0,0), C1,8); \
    GAPB(o[1]=__builtin_amdgcn_mfma_f32_32x32x16_bf16(PAF(3),VFR(7),o[1],0,0,0), C1,12); \
    }while(0)
  int t=1;
  #undef CMASK
  #define CMASK(P0,P1,t) do{}while(0)
  for(;t+5<NT;t+=2){
    STEP(pB0,pB1,pA0,pA1,t,true,true,true);     WAIT_BAR(2); RESC(); ROT();
    STEP(pA0,pA1,pB0,pB1,t+1,true,true,true);   WAIT_BAR(2); RESC(); ROT();
  }
  #undef CMASK
  #define CMASK(P0,P1,t) do{int jb_=(t)-(NT-4); if(jb_>=0)cmask(P0,P1,jb_,qrel,hi);}while(0)
  #define ENDW(tt) do{ if((tt)+3<NT){WAIT_BAR(2);} else if((tt)+2<NT){WAIT_BAR(1);} else {WAIT_BAR(0);} }while(0)
  for(;t+1<NT;t+=2){
    STEP(pB0,pB1,pA0,pA1,t,(t+3<NT),(t+1<NT),(t+1<NT));       ENDW(t);   RESC(); ROT();
    STEP(pA0,pA1,pB0,pB1,t+1,(t+4<NT),(t+2<NT),(t+2<NT));     ENDW(t+1); RESC(); ROT();
  }
  STEP(pB0,pB1,pA0,pA1,NT-1,false,false,false); RESC();
  { float sacc=pB0[0]+pB0[1]; _Pragma("unroll") for(int r=2;r<16;++r)sacc+=pB0[r]; _Pragma("unroll") for(int r=0;r<16;++r)sacc+=pB1[r]; l_reg+=sacc;
    pw0=(u32x4){PKW(pB0,0),PKW(pB0,2),PKW(pB0,4),PKW(pB0,6)};pw1=(u32x4){PKW(pB0,8),PKW(pB0,10),PKW(pB0,12),PKW(pB0,14)};pw2=(u32x4){PKW(pB1,0),PKW(pB1,2),PKW(pB1,4),PKW(pB1,6)};pw3=(u32x4){PKW(pB1,8),PKW(pB1,10),PKW(pB1,12),PKW(pB1,14)};
    SBAR(); pv(o,vb0+sl_cur,PAF(0),PAF(1),PAF(2),PAF(3)); }
  #undef PKW
  #undef PAF
  #undef VFR
  #undef PIN
  #undef MX3
  #undef GAPA
  #undef GAPB
  #undef EX
  #undef VRD
  #undef KRD
  #undef STEP
  #undef ENDW
  {auto rr=__builtin_amdgcn_permlane32_swap(__float_as_uint(l_reg),__float_as_uint(l_reg),false,false);l_reg=__uint_as_float(rr[0])+__uint_as_float(rr[1]);}
  if(hi==0)wsf[32+r32]=l_reg;asm volatile("s_waitcnt lgkmcnt(0)":::"memory");
  float rli[16];
  #pragma unroll
  for(int r=0;r<16;++r)rli[r]=__builtin_amdgcn_rcpf(wsf[32+crow(r,hi)]);
  bf16*Ow=O+(rowbase+q0+wid*QBLK)*DM+h*D;
  { bf16*stg=(bf16*)(shm+LDS_OST)+wid*2048;
    #pragma unroll
    for(int r=0;r<16;++r){const int orow=crow(r,hi);
      #pragma unroll
      for(int d0=0;d0<2;++d0)stg[orow*64+d0*32+r32]=__float2bfloat16(o[d0][r]*rli[r]);}
    asm volatile("s_waitcnt lgkmcnt(0)":::"memory");
    #pragma unroll
    for(int i=0;i<4;++i){const int row=i*8+(lane>>3),ch=lane&7; const u32x4 v=*(const u32x4*)(stg+row*64+ch*8); ATTN_STORE16(Ow+(long)row*DM+ch*8,v);} }
  asm volatile("s_waitcnt lgkmcnt(0)\n\ts_barrier":::"memory");
  #undef BIAS
  #undef DMA_K
  #undef DMA_V
  #undef CMASK
  #undef START
  #undef RESC
  #undef ROT
}
constexpr int ATTN_LDS_BYTES=86016+32768;
struct AttnTensors { const bf16* Q; const bf16* K; const bf16* V; bf16* O; const float* FB; float skip_thr; int pad; };
struct AttnUnit { int bh; int qb; };
struct StaticOrder {
  int vcu;
  __device__ __forceinline__ explicit StaticOrder(int grid,int block):vcu((block%8)*(grid/8)+block/8){}
  __device__ __forceinline__ bool next(int i,AttnUnit&u)const{ if(i>=4)return false; const int s=vcu&7; u.bh=vcu>>3; u.qb=(i==0)?s:(i==1)?15-s:(i==2)?16+s:31-s; return true; }
  __device__ __forceinline__ void a_ready(const AttnUnit&)const{}
  __device__ __forceinline__ void done(const AttnUnit&)const{}
};
struct QueueOrder {
  unsigned* ctr; int xl; volatile __attribute__((address_space(3))) int* slot;
  __device__ __forceinline__ bool next(int,AttnUnit&u)const{
    if(mk_tid()==0){ int got=-1;
      for(int k=0;k<8&&got<0;++k){ const int q=(xl+k)&7; const int j=(int)__hip_atomic_fetch_add(ctr+q*64,1u,__ATOMIC_RELAXED,__HIP_MEMORY_SCOPE_AGENT); if(j<128)got=q*128+j; }
      *slot=got; }
    __syncthreads(); const int g=*slot; if(g<0)return false; const int q=g>>7,j=g&127; u.bh=q*4+(j&3); u.qb=31-(j>>2); return true; }
  __device__ __forceinline__ void a_ready(const AttnUnit&)const{}
  __device__ __forceinline__ void done(const AttnUnit&)const{}
};
template<class Sched,int THRL=8> __device__ __forceinline__ void attn_phase(char*lds,const AttnTensors&T,const Sched&S){
  AttnUnit u;
  for(int i=0;S.next(i,u);++i){ S.a_ready(u); attn_unit<THRL>(u.bh/NHEAD,u.bh%NHEAD,u.qb,T.Q,T.K,T.V,T.O,T.FB+(size_t)u.bh*SEQ,T.skip_thr,lds); S.done(u); }
}
#undef SBAR
#undef WAIT_BAR
}
namespace cg = cooperative_groups;
#define LAS __attribute__((address_space(3)))
#define LDS_WAIT() asm volatile("s_waitcnt lgkmcnt(0)" ::: "memory")
#define LDS_BAR() asm volatile("s_waitcnt lgkmcnt(0)\n\ts_barrier" ::: "memory")
constexpr int MEGA_THREADS = 512, MEGA_LDS = 147456, NWV = 8;
#define GAS __attribute__((address_space(1)))
#define XB_TMO      128
#define XB_XCNT(j)  (256  + 64 * (j))
#define XB_XSUB(j)  (1280 + 64 * (j))
#define XB_XGEN(j)  (2304 + 64 * (j))
#define XB_TOP      3328
#define XB_TOPGEN   3392
#define XCD_BAR_WORDS 3456
#define XB_SPIN_CAP (1u << 18)

__device__ __forceinline__ unsigned xb_ld(unsigned* p)              { return __hip_atomic_load(p, __ATOMIC_RELAXED, __HIP_MEMORY_SCOPE_AGENT); }
__device__ __forceinline__ unsigned xb_add(unsigned* p, unsigned v) { return __hip_atomic_fetch_add(p, v, __ATOMIC_RELAXED, __HIP_MEMORY_SCOPE_AGENT); }
__device__ __forceinline__ unsigned xb_xcc_id() { return (unsigned)__builtin_amdgcn_s_getreg((3 << 11) | 20) & 0xFu; }
#define XB_SPIN(cond, bar) do { unsigned _sp = 0; while (cond) { __builtin_amdgcn_s_sleep(1); \
    if ((++_sp & 255u) == 0u) { if (xb_ld(&(bar)[XB_TMO])) break; if (_sp > XB_SPIN_CAP) { atomicAdd(&(bar)[XB_TMO], 1u); break; } } } } while (0)

struct XcdBarrier {
    unsigned* bar; unsigned x;
    volatile LAS unsigned* st;
};

__device__ __forceinline__ XcdBarrier xcd_barrier_post(unsigned* bar, volatile LAS unsigned* st) {
    XcdBarrier b; b.bar = bar; b.x = xb_xcc_id(); b.st = st;
    if (threadIdx.x == 0) (void)xb_add(&bar[XB_XCNT(b.x)], 1u);
    return b;
}
__device__ __forceinline__ void xcd_barrier_complete(unsigned* bar, unsigned x, unsigned& nloc, unsigned& nx) {
    const unsigned G = gridDim.x * gridDim.y * gridDim.z;
    unsigned sum, cnt, mine, sp = 0u;
    for (;;) {
        sum = 0u; cnt = 0u; mine = 0u;
#pragma unroll
        for (unsigned j = 0; j < 16; ++j) { const unsigned c = xb_ld(&bar[XB_XCNT(j)]); sum += c; cnt += (c > 0u) ? 1u : 0u; mine = (j == x) ? c : mine; }
        if (sum == G) break;
        __builtin_amdgcn_s_sleep(1);
        if ((++sp & 255u) == 0u) { if (xb_ld(&bar[XB_TMO])) break; if (sp > XB_SPIN_CAP) { atomicAdd(&bar[XB_TMO], 1u); break; } }
    }
    nloc = mine > 0u ? mine : 1u; nx = cnt > 0u ? cnt : 1u;
}

__device__ __forceinline__ void xcd_barrier(const XcdBarrier& b) {
    asm volatile("s_waitcnt vmcnt(0)" ::: "memory");
    __syncthreads();
    if (threadIdx.x == 0) {
        unsigned* bar = b.bar;
        __builtin_amdgcn_s_waitcnt(0);
        unsigned nloc = b.st[0], nx = b.st[1];
        if (nloc == 0u) { xcd_barrier_complete(bar, b.x, nloc, nx); b.st[0] = nloc; b.st[1] = nx; }
        const unsigned old = xb_add(&bar[XB_XSUB(b.x)], 1u);
        const unsigned gen = old / nloc;
        if (old + 1u == (gen + 1u) * nloc) {
            __builtin_amdgcn_fence(__ATOMIC_RELEASE, "agent");
            asm volatile("s_waitcnt vmcnt(0)" ::: "memory");
            const unsigned og = xb_add(&bar[XB_TOP], 1u);
            const unsigned tg = og / nx;
            if (og + 1u == (tg + 1u) * nx) xb_add(&bar[XB_TOPGEN], 1u);
            else XB_SPIN(xb_ld(&bar[XB_TOPGEN]) == tg, bar);
            __builtin_amdgcn_fence(__ATOMIC_ACQUIRE, "agent");
            xb_add(&bar[XB_XGEN(b.x)], 1u);
            asm volatile("s_waitcnt vmcnt(0)" ::: "memory");
        } else {
            XB_SPIN(xb_ld(&bar[XB_XGEN(b.x)]) == gen, bar);
            __builtin_amdgcn_fence(__ATOMIC_ACQUIRE, "agent");
            asm volatile("s_waitcnt vmcnt(0)" ::: "memory");
        }
    }
    __syncthreads();
}
constexpr size_t WS_BAR = WS_CTL + 16384;
constexpr size_t WS_QCTR = WS_CTL + 32768;
constexpr size_t CTL_ZERO_BYTES = 65536 - 16384;
constexpr int XB_LDS_OFF = MEGA_LDS - 64;
constexpr size_t WT_IN = 0;
constexpr size_t WT_BR = WT_IN + (size_t)13312 * 1024 * 2;
constexpr size_t WT_OUT = WT_BR + (size_t)4096 * 1024 * 2;
constexpr size_t WT_UP = WT_OUT + (size_t)1024 * 1024 * 2;
constexpr size_t WT_DN = WT_UP + (size_t)5632 * 1024 * 2;
static_assert(WT_DN + (size_t)1024 * 2816 * 2 <= 72 * MiB, "weight copies");
constexpr size_t WS_WKVT = WS_GATES;
constexpr size_t WS_CB = WS_CTL + 4096;

typedef float f32x4 __attribute__((ext_vector_type(4)));
typedef unsigned u32x4 __attribute__((ext_vector_type(4)));
typedef short bf16x8_t __attribute__((ext_vector_type(8)));
typedef float f32x16_t __attribute__((ext_vector_type(16)));
__device__ __forceinline__ unsigned pk2(float lo, float hi) { return (unsigned)f2bf(lo) | ((unsigned)f2bf(hi) << 16); }
__device__ __forceinline__ float blo(unsigned u) { return __uint_as_float(u << 16); }
__device__ __forceinline__ float bhi(unsigned u) { return __uint_as_float(u & 0xffff0000u); }
__device__ __forceinline__ float fast_softplus(float x) { return fmaxf(x, 0.f) + __logf(1.f + __expf(-fabsf(x))); }
__device__ __forceinline__ float fast_sigmoid(float x) { return __builtin_amdgcn_rcpf(1.f + __expf(-x)); }
__device__ __forceinline__ float fast_tanh(float x) { const float e = __expf(-2.f * fabsf(x)); const float t = (1.f - e) * __builtin_amdgcn_rcpf(1.f + e); return x < 0.f ? -t : t; }
__device__ __forceinline__ float fast_gelu(float x) { const float u = 0.7978845608028654f * (x + 0.044715f * x * x * x); return 0.5f * x * (1.f + fast_tanh(u)); }

template <class Loc> struct LocOrder {
    pg8::StaticOrder so; Loc loc;
    __device__ __forceinline__ bool next(int i, pg8::Unit& u) const { return so.next(i, u); }
    __device__ __forceinline__ const char* aptr(const pg8::Unit& u) const { return loc.a(u); }
    __device__ __forceinline__ const char* bptr(const pg8::Unit& u) const { return loc.b(u); }
    __device__ __forceinline__ void a_ready(const pg8::Unit&) const {}
    __device__ __forceinline__ void done(const pg8::Unit&) const {}
};
struct LocStd { const char* A; const char* Bt; size_t astep, bstep;
    __device__ __forceinline__ const char* a(const pg8::Unit& u) const { return A + (size_t)u.pm * astep; }
    __device__ __forceinline__ const char* b(const pg8::Unit& u) const { return Bt + (size_t)u.pn * bstep; } };
struct LocBranch { const char* Y0; const char* Y1; const char* Y2; const char* Y3; const char* Bt;
    __device__ __forceinline__ const char* a(const pg8::Unit& u) const { const int i = u.pn >> 2; const char* y = i == 0 ? Y0 : i == 1 ? Y1 : i == 2 ? Y2 : Y3; return y + (size_t)u.pm * (256 * 1024 * 2); }
    __device__ __forceinline__ const char* b(const pg8::Unit& u) const { return Bt + (size_t)u.pn * (256 * 1024 * 2); } };
struct LocMemKV { const char* A; const char* Bt;
    __device__ __forceinline__ const char* a(const pg8::Unit& u) const { return A + (size_t)u.pm * (256 * 1024 * 2); }
    __device__ __forceinline__ const char* b(const pg8::Unit& u) const { return Bt + ((size_t)(u.pm >> 1) * 2048 + (size_t)u.pn * 256) * 2048; } };
struct LocMemS { const char* MQ; const char* MK;
    __device__ __forceinline__ const char* a(const pg8::Unit& u) const { return MQ + (size_t)u.pm * (256 * 2048) + u.pn * 512; }
    __device__ __forceinline__ const char* b(const pg8::Unit& u) const { return MK + (size_t)(u.pm >> 5) * (256 * 2048) + u.pn * 512; } };
struct LocMemPV { const char* E; const char* MVT;
    __device__ __forceinline__ const char* a(const pg8::Unit& u) const { return E + (size_t)u.pm * (256 * 2048) + u.pn * 512; }
    __device__ __forceinline__ const char* b(const pg8::Unit& u) const { return MVT + ((size_t)(u.pm >> 5) * 4 + u.pn) * (256 * 256 * 2); } };

struct BranchSched { int vcu; LocBranch loc;
    __device__ __forceinline__ bool next(int i, pg8::Unit& u) const { if (i >= 4) return false; u.pm = vcu >> 2; u.pn = i * 4 + (vcu & 3); return true; }
    __device__ __forceinline__ const char* aptr(const pg8::Unit& u) const { return loc.a(u); }
    __device__ __forceinline__ const char* bptr(const pg8::Unit& u) const { return loc.b(u); }
    __device__ __forceinline__ void a_ready(const pg8::Unit&) const {}
    __device__ __forceinline__ void done(const pg8::Unit&) const {}
};
typedef f32x4 AccT[2][2][4][2];
struct EpiProj { static constexpr bool PERM = true, AFTER_DRAIN = false; bf16_t* proj; bf16_t* gates; float* mqss;
    __device__ __forceinline__ void operator()(const AccT& acc, const pg8::Unit& u, int wr, int wc, int fr, int fq) const {
        int colt = u.pn * 256; const int grp = colt >> 10; bf16_t* base; int ldc;
        if (grp < 9) { base = proj + (size_t)grp * T * DM; ldc = DM; colt &= 1023; } else { base = gates; ldc = 4096; colt -= 9216; }
        const int row0 = u.pm * 256 + wr * 64 + fr, col0 = colt + wc * 32 + 8 * fq;
#pragma unroll
        for (int ai = 0; ai < 2; ++ai)
#pragma unroll
            for (int m = 0; m < 4; ++m) { const int row = row0 + ai * 128 + m * 16; bf16_t* rowp = base + (size_t)row * ldc + col0; float ss = 0.f;
#pragma unroll
                for (int bj = 0; bj < 2; ++bj) { const f32x4 v0 = acc[ai][bj][m][0], v1 = acc[ai][bj][m][1]; u32x4 w; w.x = pk2(v0[0], v0[1]); w.y = pk2(v0[2], v0[3]); w.z = pk2(v1[0], v1[1]); w.w = pk2(v1[2], v1[3]);
                    *(u32x4*)(rowp + bj * 128) = w;
                    if (grp == 8) { ss += blo(w.x) * blo(w.x) + bhi(w.x) * bhi(w.x) + blo(w.y) * blo(w.y) + bhi(w.y) * bhi(w.y) + blo(w.z) * blo(w.z) + bhi(w.z) * bhi(w.z) + blo(w.w) * blo(w.w) + bhi(w.w) * bhi(w.w); } }
                if (grp == 8) { ss += __shfl_xor(ss, 16); ss += __shfl_xor(ss, 32); if (fq == 0) mqss[(size_t)row * 16 + (colt >> 8) * 4 + wc] = ss; } }
    } };
struct EpiBf16P { static constexpr bool PERM = true, AFTER_DRAIN = false; bf16_t* O; int ldc; int pad;
    __device__ __forceinline__ void operator()(const AccT& acc, const pg8::Unit& u, int wr, int wc, int fr, int fq) const {
        const int row0 = u.pm * 256 + wr * 64 + fr, col0 = u.pn * 256 + wc * 32 + 8 * fq;
#pragma unroll
        for (int ai = 0; ai < 2; ++ai)
#pragma unroll
            for (int m = 0; m < 4; ++m) { bf16_t* rowp = O + (size_t)(row0 + ai * 128 + m * 16) * ldc + col0;
#pragma unroll
                for (int bj = 0; bj < 2; ++bj) { const f32x4 v0 = acc[ai][bj][m][0], v1 = acc[ai][bj][m][1]; u32x4 w; w.x = pk2(v0[0], v0[1]); w.y = pk2(v0[2], v0[3]); w.z = pk2(v1[0], v1[1]); w.w = pk2(v1[2], v1[3]);
                    *(u32x4*)(rowp + bj * 128) = w; } }
    } };
struct EpiF32 { static constexpr bool PERM = false, AFTER_DRAIN = false; float* O; int ldc; int pad;
    __device__ __forceinline__ void operator()(const AccT& acc, const pg8::Unit& u, int wr, int wc, int fr, int fq) const {
        const int row0 = u.pm * 256 + wr * 64 + fr, col0 = u.pn * 256 + wc * 32 + 4 * fq;
#pragma unroll
        for (int ai = 0; ai < 2; ++ai)
#pragma unroll
            for (int m = 0; m < 4; ++m) { float* rowp = O + (size_t)(row0 + ai * 128 + m * 16) * ldc + col0;
#pragma unroll
                for (int bj = 0; bj < 2; ++bj)
#pragma unroll
                    for (int n = 0; n < 2; ++n) *(f32x4*)(rowp + bj * 128 + n * 16) = acc[ai][bj][m][n]; }
    } };
struct EpiResid { static constexpr bool PERM = false, AFTER_DRAIN = false; const float* base; float* out;
    __device__ __forceinline__ void operator()(const AccT& acc, const pg8::Unit& u, int wr, int wc, int fr, int fq) const {
        const int row0 = u.pm * 256 + wr * 64 + fr, col0 = u.pn * 256 + wc * 32 + 4 * fq;
#pragma unroll
        for (int ai = 0; ai < 2; ++ai)
#pragma unroll
            for (int m = 0; m < 4; ++m) { const size_t off = (size_t)(row0 + ai * 128 + m * 16) * DM + col0;
#pragma unroll
                for (int bj = 0; bj < 2; ++bj)
#pragma unroll
                    for (int n = 0; n < 2; ++n) { const f32x4 b = *(const f32x4*)(base + off + bj * 128 + n * 16); *(f32x4*)(out + off + bj * 128 + n * 16) = b + acc[ai][bj][m][n]; } }
    } };
struct EpiBranch { static constexpr bool PERM = true, AFTER_DRAIN = false; const bf16_t* G; const float* bg; float* MIXF; bf16_t* MIXED;
    __device__ __forceinline__ void operator()(const AccT& acc, const pg8::Unit& u, int wr, int wc, int fr, int fq) const {
        const int i = u.pn >> 2, row0 = u.pm * 256 + wr * 64 + fr, gcol0 = u.pn * 256 + wc * 32 + 8 * fq, mcol0 = (u.pn & 3) * 256 + wc * 32 + 8 * fq;
#pragma unroll
        for (int ai = 0; ai < 2; ++ai)
#pragma unroll
            for (int m = 0; m < 4; ++m) { const int row = row0 + ai * 128 + m * 16; const bf16_t* gp = G + (size_t)row * 4096 + gcol0; const size_t mo = (size_t)row * DM + mcol0;
#pragma unroll
                for (int bj = 0; bj < 2; ++bj) { const u32x4 gw = *(const u32x4*)(gp + bj * 128); const f32x4 b0 = *(const f32x4*)(bg + gcol0 + bj * 128), b1 = *(const f32x4*)(bg + gcol0 + bj * 128 + 4);
                    f32x4 v0 = acc[ai][bj][m][0], v1 = acc[ai][bj][m][1];
                    v0[0] *= fast_sigmoid(blo(gw.x) + b0[0]); v0[1] *= fast_sigmoid(bhi(gw.x) + b0[1]); v0[2] *= fast_sigmoid(blo(gw.y) + b0[2]); v0[3] *= fast_sigmoid(bhi(gw.y) + b0[3]);
                    v1[0] *= fast_sigmoid(blo(gw.z) + b1[0]); v1[1] *= fast_sigmoid(bhi(gw.z) + b1[1]); v1[2] *= fast_sigmoid(blo(gw.w) + b1[2]); v1[3] *= fast_sigmoid(bhi(gw.w) + b1[3]);
                    if (i > 0) { v0 += *(const f32x4*)(MIXF + mo + bj * 128); v1 += *(const f32x4*)(MIXF + mo + bj * 128 + 4); }
                    if (i < 3) { *(f32x4*)(MIXF + mo + bj * 128) = v0; *(f32x4*)(MIXF + mo + bj * 128 + 4) = v1; }
                    else { u32x4 w; w.x = pk2(v0[0], v0[1]); w.y = pk2(v0[2], v0[3]); w.z = pk2(v1[0], v1[1]); w.w = pk2(v1[2], v1[3]); *(u32x4*)(MIXED + mo + bj * 128) = w; } }
                asm volatile("" ::: "memory"); }
    } };
struct EpiSexp { static constexpr bool PERM = true, AFTER_DRAIN = false; bf16_t* E; const float* mqss; float* esum; const float* cb;
    __device__ __forceinline__ void operator()(const AccT& acc, const pg8::Unit& u, int wr, int wc, int fr, int fq) const {
        const int row0 = u.pm * 256 + wr * 64 + fr, col0 = u.pn * 256 + wc * 32 + 8 * fq; const float shift = cb[0];
#pragma unroll
        for (int ai = 0; ai < 2; ++ai)
#pragma unroll
            for (int m = 0; m < 4; ++m) { const int row = row0 + ai * 128 + m * 16; const f32x4 p = *(const f32x4*)(mqss + (size_t)row * 16 + u.pn * 4);
                const float sc = rsqrtf(((p[0] + p[1]) + (p[2] + p[3])) * (1.f / 256.f) + EPS) * (1.f / 16.f); bf16_t* rowp = E + (size_t)row * DM + col0; float sum = 0.f;
#pragma unroll
                for (int bj = 0; bj < 2; ++bj) { const f32x4 v0 = acc[ai][bj][m][0], v1 = acc[ai][bj][m][1]; u32x4 w;
                    w.x = pk2(__expf(v0[0] * sc - shift), __expf(v0[1] * sc - shift)); w.y = pk2(__expf(v0[2] * sc - shift), __expf(v0[3] * sc - shift));
                    w.z = pk2(__expf(v1[0] * sc - shift), __expf(v1[1] * sc - shift)); w.w = pk2(__expf(v1[2] * sc - shift), __expf(v1[3] * sc - shift));
                    *(u32x4*)(rowp + bj * 128) = w;
                    sum += (blo(w.x) + bhi(w.x)) + (blo(w.y) + bhi(w.y)) + (blo(w.z) + bhi(w.z)) + (blo(w.w) + bhi(w.w)); }
                sum += __shfl_xor(sum, 16); sum += __shfl_xor(sum, 32); if (fq == 0) esum[(size_t)row * 16 + u.pn * 4 + wc] = sum;
                asm volatile("" ::: "memory"); }
    } };
struct EpiMemPV { static constexpr bool PERM = true, AFTER_DRAIN = false; bf16_t* Y; const float* esum;
    __device__ __forceinline__ void operator()(const AccT& acc, const pg8::Unit& u, int wr, int wc, int fr, int fq) const {
        const int row0 = u.pm * 256 + wr * 64 + fr, col0 = u.pn * 256 + wc * 32 + 8 * fq;
#pragma unroll
        for (int ai = 0; ai < 2; ++ai)
#pragma unroll
            for (int m = 0; m < 4; ++m) { const int row = row0 + ai * 128 + m * 16; const f32x4 p = *(const f32x4*)(esum + (size_t)row * 16 + u.pn * 4);
                const float il = 1.f / ((p[0] + p[1]) + (p[2] + p[3])); bf16_t* rowp = Y + (size_t)row * DM + col0;
#pragma unroll
                for (int bj = 0; bj < 2; ++bj) { const f32x4 v0 = acc[ai][bj][m][0] * il, v1 = acc[ai][bj][m][1] * il; u32x4 w; w.x = pk2(v0[0], v0[1]); w.y = pk2(v0[2], v0[3]); w.z = pk2(v1[0], v1[1]); w.w = pk2(v1[2], v1[3]);
                    *(u32x4*)(rowp + bj * 128) = w; }
                asm volatile("" ::: "memory"); }
    } };

__device__ __forceinline__ void tr_item(const float* __restrict__ W, int ldw, bf16_t* __restrict__ WT, int ldk, int nblk, LAS float* scr, int item, int lane, int ncopies, int cstride) {
    const int kb = item / nblk, nb = item % nblk, k0 = 64 * kb, n0 = 32 * nb;
#pragma unroll
    for (int i = 0; i < 32; ++i) { const int kk = 2 * i + (lane >> 5); scr[kk * 33 + (lane & 31)] = W[(size_t)(k0 + kk) * ldw + n0 + (lane & 31)]; }
    LDS_WAIT(); asm volatile("" ::: "memory");
    const int c = lane & 7;
#pragma unroll
    for (int j = 0; j < 4; ++j) { const int n = (lane >> 3) + 8 * j; const LAS float* s = scr + (8 * c) * 33 + n;
        u32x4 o; o.x = pk2(s[0 * 33], s[1 * 33]); o.y = pk2(s[2 * 33], s[3 * 33]); o.z = pk2(s[4 * 33], s[5 * 33]); o.w = pk2(s[6 * 33], s[7 * 33]);
        for (int cp = 0; cp < ncopies; ++cp) *(u32x4*)(WT + (size_t)(n0 + n) * ldk + k0 + 8 * c + cp * cstride) = o; }
    LDS_WAIT(); asm volatile("" ::: "memory");
}
__device__ __forceinline__ void norm_row(f32x4 (&v)[4], const float* __restrict__ g, bf16_t* __restrict__ hrow, const LAS float* WfT, bool do_logf, const float* __restrict__ bfg, float* __restrict__ LOGF, int row, int lane) {
    const f32x4* gr = (const f32x4*)g; float ss = 0.f;
#pragma unroll
    for (int j = 0; j < 4; ++j) ss += (v[j][0] * v[j][0] + v[j][1] * v[j][1]) + (v[j][2] * v[j][2] + v[j][3] * v[j][3]);
    ss = wave_sum(ss);
    const float rstd = rsqrtf(ss * (1.f / DM) + EPS);
#pragma unroll
    for (int j = 0; j < 4; ++j) { v[j] = v[j] * rstd * gr[lane + 64 * j];
        uint2 o; o.x = pk2(v[j][0], v[j][1]); o.y = pk2(v[j][2], v[j][3]); ((uint2*)hrow)[lane + 64 * j] = o; }
    if (do_logf) {
        float p[16];
#pragma unroll
        for (int h = 0; h < 16; ++h) { float a = 0.f;
#pragma unroll
            for (int j = 0; j < 4; ++j) { const f32x4 w = *(const LAS f32x4*)(WfT + h * 1024 + (lane + 64 * j) * 4); a += (v[j][0] * w[0] + v[j][1] * w[1]) + (v[j][2] * w[2] + v[j][3] * w[3]); }
            p[h] = a; if ((h & 3) == 3) __builtin_amdgcn_sched_barrier(0); }
        const bool b5 = lane & 32, b4 = lane & 16, b3 = lane & 8, b2 = lane & 4;
        float q8[8], q4[4], q2[2];
#pragma unroll
        for (int i = 0; i < 8; ++i) { const float send = b5 ? p[i] : p[i + 8], keep = b5 ? p[i + 8] : p[i]; q8[i] = keep + __shfl_xor(send, 32); }
#pragma unroll
        for (int i = 0; i < 4; ++i) { const float send = b4 ? q8[i] : q8[i + 4], keep = b4 ? q8[i + 4] : q8[i]; q4[i] = keep + __shfl_xor(send, 16); }
#pragma unroll
        for (int i = 0; i < 2; ++i) { const float send = b3 ? q4[i] : q4[i + 2], keep = b3 ? q4[i + 2] : q4[i]; q2[i] = keep + __shfl_xor(send, 8); }
        float q1 = (b2 ? q2[1] : q2[0]) + __shfl_xor(b2 ? q2[0] : q2[1], 4);
        q1 += __shfl_xor(q1, 2); q1 += __shfl_xor(q1, 1);
        const int h = (b5 ? 8 : 0) + (b4 ? 4 : 0) + (b3 ? 2 : 0) + (b2 ? 1 : 0);
        if ((lane & 3) == 0) { const int b = row / SEQ, t = row % SEQ; LOGF[((size_t)b * 16 + h) * SEQ + t] = logsigmoidf(q1 + bfg[h]); }
    }
}
__device__ __forceinline__ void norm_rows(const float* __restrict__ x, int nrows, int gw, int NGW, const float* __restrict__ g, bf16_t* __restrict__ H, const LAS float* WfT, bool do_logf, const float* __restrict__ bfg, float* __restrict__ LOGF, int lane) {
    f32x4 nx[4];
    if (gw < nrows) {
#pragma unroll
        for (int j = 0; j < 4; ++j) nx[j] = ((const f32x4*)(x + (size_t)gw * DM))[lane + 64 * j]; }
    for (int m = gw; m < nrows; m += NGW) {
        f32x4 v[4];
#pragma unroll
        for (int j = 0; j < 4; ++j) v[j] = nx[j];
        if (m + NGW < nrows) {
#pragma unroll
            for (int j = 0; j < 4; ++j) nx[j] = ((const f32x4*)(x + (size_t)(m + NGW) * DM))[lane + 64 * j]; }
        norm_row(v, g, H + (size_t)m * DM, WfT, do_logf, bfg, LOGF, m, lane);
    }
}
__device__ __forceinline__ void headnorm64_row(bf16_t* row, const float* __restrict__ g, float scale, int lane) {
    u32x4* p = (u32x4*)row + lane * 2; u32x4 a = p[0], b = p[1];
    float v[16] = {blo(a.x), bhi(a.x), blo(a.y), bhi(a.y), blo(a.z), bhi(a.z), blo(a.w), bhi(a.w), blo(b.x), bhi(b.x), blo(b.y), bhi(b.y), blo(b.z), bhi(b.z), blo(b.w), bhi(b.w)};
    float ss = 0.f;
#pragma unroll
    for (int i = 0; i < 16; ++i) ss += v[i] * v[i];
    ss += __shfl_xor(ss, 1); ss += __shfl_xor(ss, 2);
    const float rstd = rsqrtf(ss * (1.f / 64.f) + EPS) * scale; const f32x4* gp = (const f32x4*)(g + (lane & 3) * 16);
#pragma unroll
    for (int i = 0; i < 4; ++i) { const f32x4 gg = gp[i]; v[4 * i] *= rstd * gg[0]; v[4 * i + 1] *= rstd * gg[1]; v[4 * i + 2] *= rstd * gg[2]; v[4 * i + 3] *= rstd * gg[3]; }
    a.x = pk2(v[0], v[1]); a.y = pk2(v[2], v[3]); a.z = pk2(v[4], v[5]); a.w = pk2(v[6], v[7]); b.x = pk2(v[8], v[9]); b.y = pk2(v[10], v[11]); b.z = pk2(v[12], v[13]); b.w = pk2(v[14], v[15]);
    p[0] = a; p[1] = b;
}
__device__ __forceinline__ void cumsum_block(const float* __restrict__ src, float* __restrict__ dst, LAS float* part, int tid) {
    const int lane = tid & 63, wave = tid >> 6; const f32x4* s4 = (const f32x4*)(src + tid * 16); float v[16]; float s = 0.f;
#pragma unroll
    for (int i = 0; i < 4; ++i) { const f32x4 x = s4[i]; s += x[0]; v[4 * i] = s; s += x[1]; v[4 * i + 1] = s; s += x[2]; v[4 * i + 2] = s; s += x[3]; v[4 * i + 3] = s; }
    float incl = s;
#pragma unroll
    for (int o = 1; o < 64; o <<= 1) { const float t_ = __shfl_up(incl, o); if (lane >= o) incl += t_; }
    __syncthreads();
    if (lane == 63) part[wave] = incl;
    __syncthreads();
    float off = incl - s;
    for (int w = 0; w < wave; ++w) off += part[w];
    f32x4* d4 = (f32x4*)(dst + tid * 16);
#pragma unroll
    for (int i = 0; i < 4; ++i) d4[i] = (f32x4){off + v[4 * i], off + v[4 * i + 1], off + v[4 * i + 2], off + v[4 * i + 3]};
}

__device__ __forceinline__ float neg_expm1_small(float x) {
    const float p = -x * (1.f + x * (0.5f + x * (0.16666667f + x * (0.041666668f + x * (0.0083333338f + x * 0.0013888889f)))));
    return x > -0.25f ? p : 1.f - __expf(x);
}
constexpr int LRU_TK = 128, LRU_NCH = SEQ / LRU_TK;
constexpr int LRU_XCB = 0, LRU_WT = LRU_TK * 144, LRU_R = LRU_WT + 18432, LRU_SEG = LRU_R + LRU_TK * 528;
static_assert(LRU_SEG + 4096 + 4096 <= MEGA_LDS - 64, "lru LDS map");
template <bool FINAL> __device__ __forceinline__ void lru_load(int it, int n, const bf16_t* __restrict__ LX, const bf16_t* __restrict__ LG, float (&xw)[19], float (&gl)[16], int tid) {
    const int b = it >> 10, c = (it >> 4) & 63, e = tid & 63, tg = tid >> 6, ch = n * 64 + e, t0 = c * LRU_TK + tg * 16;
#pragma unroll
    for (int j = 0; j < 19; ++j) { const int t = t0 + j - 3; xw[j] = t >= 0 ? bf2f(LX[((size_t)b * SEQ + t) * DM + ch]) : 0.f; }
    if (FINAL) {
#pragma unroll
        for (int j = 0; j < 16; ++j) gl[j] = bf2f(LG[((size_t)b * SEQ + t0 + j) * DM + ch]); }
}
template <bool FINAL> __device__ __forceinline__ void lru_item(int b, int c, int n, const float (&xw)[19], const float (&gl)[16], bf16_t* __restrict__ YL,
        const float w0, const float w1, const float w2, const float w3, const float bc, const float bA, const float bX,
        const float spl, float* APROD, float* HEND, LAS unsigned char* lds, int tid, int kseg) {
    const int e = tid & 63, tg = tid >> 6, ch = n * 64 + e, lane = e, wv = tg;
    LAS float* R = (LAS float*)(lds + LRU_R);
    LAS float* segP = (LAS float*)(lds + LRU_SEG);
    LAS float* segH = segP + 512, *carP = segH + 512 + (b * 4) * 64, *carH = carP + 512;
    const int t0 = c * LRU_TK + tg * 16; const size_t row0 = (size_t)b * SEQ + t0;
    float xc[16];
#pragma unroll
    for (int j = 0; j < 16; ++j) { xc[j] = bc + w3 * xw[j + 3] + w2 * xw[j + 2] + w1 * xw[j + 1] + w0 * xw[j]; *(LAS bf16_t*)(lds + LRU_XCB + (tg * 16 + j) * 144 + e * 2) = f2bf(xc[j]); }
    LDS_BAR();
    { const int tq = wv & 3, cbh = wv >> 2, r32 = lane & 31, hi = lane >> 5; f32x16_t acc0 = {}, acc1 = {};
#pragma unroll
        for (int ks = 0; ks < 4; ++ks) { const bf16x8_t af = *(const LAS bf16x8_t*)(lds + LRU_XCB + (32 * tq + r32) * 144 + (16 * ks + 8 * hi) * 2);
            const bf16x8_t b0 = *(const LAS bf16x8_t*)(lds + LRU_WT + (64 * cbh + r32) * 144 + (16 * ks + 8 * hi) * 2), b1 = *(const LAS bf16x8_t*)(lds + LRU_WT + (64 * cbh + 32 + r32) * 144 + (16 * ks + 8 * hi) * 2);
            acc0 = __builtin_amdgcn_mfma_f32_32x32x16_bf16(af, b0, acc0, 0, 0, 0); acc1 = __builtin_amdgcn_mfma_f32_32x32x16_bf16(af, b1, acc1, 0, 0, 0); }
#pragma unroll
        for (int r = 0; r < 16; ++r) { const int ro = (32 * tq + (r & 3) + 8 * (r >> 2) + 4 * hi) * 132 + 64 * cbh + r32; R[ro] = acc0[r]; R[ro + 32] = acc1[r]; } }
    LDS_BAR();
    float av[16], uv[16]; float P = 1.f, Hh = 0.f;
#pragma unroll
    for (int j = 0; j < 16; ++j) { const float ra = bA + R[(tg * 16 + j) * 132 + e], ri = bX + R[(tg * 16 + j) * 132 + 64 + e];
        const float rr = fast_sigmoid(ra), ii = fast_sigmoid(ri); const float la = -8.f * rr * spl; av[j] = __expf(la); uv[j] = __builtin_amdgcn_sqrtf(neg_expm1_small(2.f * la)) * (ii * xc[j]);
        Hh = av[j] * Hh + uv[j]; P *= av[j]; }
    segP[tg * 64 + e] = P; segH[tg * 64 + e] = Hh;
    LDS_BAR();
    if (FINAL) {
        float h = 0.f;
        for (int s = 0; s <= kseg; ++s) h = carP[s * 64 + e] * h + carH[s * 64 + e];
        for (int t2 = 0; t2 < tg; ++t2) h = segP[t2 * 64 + e] * h + segH[t2 * 64 + e];
#pragma unroll
        for (int j = 0; j < 16; ++j) { h = av[j] * h + uv[j]; YL[(row0 + j) * DM + ch] = f2bf(h * fast_gelu(gl[j])); }
    } else if (tg == 7) {
        float h = 0.f, p = 1.f;
#pragma unroll
        for (int s = 0; s < 8; ++s) { h = segP[s * 64 + e] * h + segH[s * 64 + e]; p *= segP[s * 64 + e]; }
        const size_t si = ((size_t)b * LRU_NCH + c) * DM + ch; APROD[si] = p; HEND[si] = h;
    }
}
template <bool FINAL> __device__ __forceinline__ void lru_pass(int l, int bx, int G, const float* const* in, const bf16_t* LX, const bf16_t* LG, bf16_t* YL, float* APROD, float* HEND, LAS unsigned char* lds, int tid) {
    const int n = bx & 15, e = tid & 63, ch = n * 64 + e;
    { const float* wa = in[10] + (size_t)l * 65536 + (size_t)n * 4096; const float* wx = in[12] + (size_t)l * 65536 + (size_t)n * 4096;
        float wv_[16];
#pragma unroll
        for (int k = 0; k < 16; ++k) { const int i = tid + MEGA_THREADS * k; wv_[k] = (i >> 12) ? wx[i & 4095] : wa[i & 4095]; }
#pragma unroll
        for (int k = 0; k < 16; ++k) { const int i = tid + MEGA_THREADS * k, mat = i >> 12, d = (i >> 6) & 63, ee = i & 63; *(LAS bf16_t*)(lds + LRU_WT + (mat * 64 + ee) * 144 + d * 2) = f2bf(wv_[k]); } }
    const float* cw = in[8] + (size_t)l * 4 * DM; const float w0 = cw[ch], w1 = cw[DM + ch], w2 = cw[2 * DM + ch], w3 = cw[3 * DM + ch], bc = in[9][l * DM + ch];
    const float bA = in[11][l * DM + ch], bX = in[13][l * DM + ch], spl = softplusf(-in[14][l * DM + ch]);
    if (FINAL) {
        const int c0 = bx >> 4, tg = tid >> 6, b = tg >> 2, sg = tg & 3; LAS float* carP = (LAS float*)(lds + LRU_SEG) + 1024, *carH = carP + 512;
        const int lo = sg == 0 ? 0 : c0 + 16 * (sg - 1), hi = c0 + 16 * sg; float A[16], Hc[16];
#pragma unroll
        for (int i = 0; i < 16; ++i) { const int cc = lo + i; const bool ok = cc < hi; const size_t si = ((size_t)b * LRU_NCH + (ok ? cc : 0)) * DM + ch; A[i] = ok ? APROD[si] : 1.f; Hc[i] = ok ? HEND[si] : 0.f; }
        float cp = 1.f, chh = 0.f;
#pragma unroll
        for (int i = 0; i < 16; ++i) { chh = A[i] * chh + Hc[i]; cp *= A[i]; }
        carP[(b * 4 + sg) * 64 + e] = cp; carH[(b * 4 + sg) * 64 + e] = chh;
    }
    float xwn[19], gln[16];
#pragma unroll
    for (int j = 0; j < 16; ++j) gln[j] = 0.f;
    lru_load<FINAL>(bx, n, LX, LG, xwn, gln, tid);
    __syncthreads();
    for (int it = bx; it < 2048; it += G) {
        float xw[19], gl[16];
#pragma unroll
        for (int j = 0; j < 19; ++j) xw[j] = xwn[j];
#pragma unroll
        for (int j = 0; j < 16; ++j) gl[j] = gln[j];
        if (it + G < 2048) lru_load<FINAL>(it + G, n, LX, LG, xwn, gln, tid);
        lru_item<FINAL>(it >> 10, (it >> 4) & 63, n, xw, gl, YL, w0, w1, w2, w3, bc, bA, bX, spl, APROD, HEND, lds, tid, ((it >> 4) & 63) >> 4);
    }
    __syncthreads();
}

constexpr int SB_WIN = 13, SB_KOFF = 0, SB_VOFF = SB_WIN * 32 * 144, SB_SCR = SB_VOFF + SB_WIN * 4096;
static_assert(SB_SCR + 8 * 4096 <= MEGA_LDS - 64, "stick-breaking LDS map");
__device__ __forceinline__ void sb_wave(int b, int h, int qw0, int kt_lo, const bf16_t* Q, const bf16_t* __restrict__ K, const bf16_t* __restrict__ V, bf16_t* O, LAS unsigned char* lds, int wave, int lane) {
    const int r32 = lane & 31, hi = lane >> 5; const size_t rowbase = (size_t)b * SEQ;
    const bf16_t* Qw = Q + (rowbase + qw0) * DM + h * 64;
    bf16x8_t qr[4];
#pragma unroll
    for (int d0 = 0; d0 < 4; ++d0) qr[d0] = *(const bf16x8_t*)(Qw + (size_t)r32 * DM + d0 * 16 + hi * 8);
    const bf16_t* Kh = K + rowbase * DM + h * 64; const bf16_t* Vh = V + rowbase * DM + h * 64;
    f32x16_t o0 = {}, o1 = {}; float R = 0.f; const int qabs = qw0 + r32;
    LAS unsigned char* scr = lds + SB_SCR + wave * 4096;
    for (int kt = qw0 >> 5; kt >= 0; --kt) {
        bf16x8_t kf[4]; const LAS unsigned char* vl;
        if (kt >= kt_lo) {
#pragma unroll
            for (int d0 = 0; d0 < 4; ++d0) kf[d0] = *(const LAS bf16x8_t*)(lds + SB_KOFF + ((kt - kt_lo) * 32 + r32) * 144 + d0 * 32 + hi * 16);
            vl = lds + SB_VOFF + (kt - kt_lo) * 4096;
        } else {
#pragma unroll
            for (int d0 = 0; d0 < 4; ++d0) kf[d0] = *(const bf16x8_t*)(Kh + (size_t)(kt * 32 + r32) * DM + d0 * 16 + hi * 8);
#pragma unroll
            for (int it = 0; it < 4; ++it) { const int chunk = lane + 64 * it, row = chunk >> 3, c16 = chunk & 7; const u32x4 vq = *(const u32x4*)(Vh + (size_t)(kt * 32 + row) * DM + c16 * 8);
                *(LAS u32x4*)(scr + (c16 >> 2) * 2048 + row * 64 + (c16 & 3) * 16) = vq; }
            vl = scr;
        }
        f32x16_t st = {};
#pragma unroll
        for (int d0 = 0; d0 < 4; ++d0) st = __builtin_amdgcn_mfma_f32_32x32x16_bf16(kf[d0], qr[d0], st, 0, 0, 0);
        float l1[16], lb[16]; bool val[16];
#pragma unroll
        for (int r = 0; r < 16; ++r) { const int kv = kt * 32 + (r & 3) + 8 * (r >> 2) + 4 * hi; val[r] = kv < qabs; const float z = st[r] * 0.125f; const float sp = fast_softplus(z); l1[r] = val[r] ? -sp : 0.f; lb[r] = z - sp; }
        float w[16]; float tail = 0.f;
#pragma unroll
        for (int g = 3; g >= 0; --g) { const float qs = (l1[4 * g] + l1[4 * g + 1]) + (l1[4 * g + 2] + l1[4 * g + 3]); const float pq = __shfl_xor(qs, 32);
            const float after = tail + (hi == 0 ? pq : 0.f) + R; tail += qs + pq;
            const float e2 = l1[4 * g + 3], e1 = e2 + l1[4 * g + 2], e0 = e1 + l1[4 * g + 1];
            w[4 * g + 3] = val[4 * g + 3] ? __expf(lb[4 * g + 3] + after) : 0.f; w[4 * g + 2] = val[4 * g + 2] ? __expf(lb[4 * g + 2] + after + e2) : 0.f;
            w[4 * g + 1] = val[4 * g + 1] ? __expf(lb[4 * g + 1] + after + e1) : 0.f; w[4 * g] = val[4 * g] ? __expf(lb[4 * g] + after + e0) : 0.f; }
        R += tail;
        u32x4 p0, p1; p0.x = attn_body::cvtpk_s(w[0], w[1]); p0.y = attn_body::cvtpk_s(w[2], w[3]); p0.z = attn_body::cvtpk_s(w[4], w[5]); p0.w = attn_body::cvtpk_s(w[6], w[7]);
        p1.x = attn_body::cvtpk_s(w[8], w[9]); p1.y = attn_body::cvtpk_s(w[10], w[11]); p1.z = attn_body::cvtpk_s(w[12], w[13]); p1.w = attn_body::cvtpk_s(w[14], w[15]);
        const bf16x8_t pa0 = __builtin_bit_cast(bf16x8_t, p0), pa1 = __builtin_bit_cast(bf16x8_t, p1);
        const attn_body::lds_cptr vp = (attn_body::lds_cptr)vl + (4 * hi + ((lane & 15) >> 2)) * 64 + ((lane >> 4) & 1) * 32 + (lane & 3) * 8;
#define SB_VF(d0, s) ({ const attn_body::s16x4 lo_ = attn_body::vtr(vp + (d0) * 2048 + (s) * 1024), hi_ = attn_body::vtr(vp + (d0) * 2048 + (s) * 1024 + 512); \
            (bf16x8_t){lo_[0], lo_[1], lo_[2], lo_[3], hi_[0], hi_[1], hi_[2], hi_[3]}; })
        o0 = __builtin_amdgcn_mfma_f32_32x32x16_bf16(pa0, SB_VF(0, 0), o0, 0, 0, 0);
        o1 = __builtin_amdgcn_mfma_f32_32x32x16_bf16(pa0, SB_VF(1, 0), o1, 0, 0, 0);
        o0 = __builtin_amdgcn_mfma_f32_32x32x16_bf16(pa1, SB_VF(0, 1), o0, 0, 0, 0);
        o1 = __builtin_amdgcn_mfma_f32_32x32x16_bf16(pa1, SB_VF(1, 1), o1, 0, 0, 0);
#undef SB_VF
        if (__all(R < SB_THR)) break;
    }
    bf16_t* Ow = O + (rowbase + qw0) * DM + h * 64;
#pragma unroll
    for (int r = 0; r < 16; ++r) { const int q = (r & 3) + 8 * (r >> 2) + 4 * hi; Ow[(size_t)q * DM + r32] = f2bf(o0[r]); Ow[(size_t)q * DM + 32 + r32] = f2bf(o1[r]); }
}
__device__ __forceinline__ void sb_unit(int b, int h, int q0, const bf16_t* Q, const bf16_t* __restrict__ K, const bf16_t* __restrict__ V, bf16_t* O, LAS unsigned char* lds, int tid) {
    const int lane = tid & 63, wave = __builtin_amdgcn_readfirstlane(tid >> 6);
    const int kt_hi = (q0 >> 5) + 8, kt_lo = kt_hi - SB_WIN > 0 ? kt_hi - SB_WIN : 0, nch = (kt_hi - kt_lo) * 256;
    const bf16_t* Kh = K + ((size_t)b * SEQ + kt_lo * 32) * DM + h * 64; const bf16_t* Vh = V + ((size_t)b * SEQ + kt_lo * 32) * DM + h * 64;
#pragma unroll
    for (int hb = 0; hb < 2; ++hb) {
        u32x4 kq[4], vq[4];
#pragma unroll
        for (int i = 0; i < 4; ++i) { const int idx = tid + MEGA_THREADS * (4 * hb + i), row = idx >> 3, c16 = idx & 7;
            if (idx < nch) { kq[i] = *(const u32x4*)(Kh + (size_t)row * DM + c16 * 8); vq[i] = *(const u32x4*)(Vh + (size_t)row * DM + c16 * 8); } }
#pragma unroll
        for (int i = 0; i < 4; ++i) { const int idx = tid + MEGA_THREADS * (4 * hb + i), row = idx >> 3, c16 = idx & 7;
            if (idx < nch) { *(LAS u32x4*)(lds + SB_KOFF + row * 144 + c16 * 16) = kq[i];
                *(LAS u32x4*)(lds + SB_VOFF + (row >> 5) * 4096 + (c16 >> 2) * 2048 + (row & 31) * 64 + (c16 & 3) * 16) = vq[i]; } }
    }
    __syncthreads();
    sb_wave(b, h, q0 + wave * 32, kt_lo, Q, K, V, O, lds, wave, lane);
    __syncthreads();
}

#ifndef DBG_NOLOGF
#define DBG_NOLOGF 0
#endif
#ifndef EN_FOX
#define EN_FOX 1
#endif
#ifndef EN_SB
#define EN_SB 1
#endif
#ifndef EN_LRU
#define EN_LRU 1
#endif
#ifndef EN_GEMM
#define EN_GEMM 1
#endif
#ifndef EN_THIN
#define EN_THIN 1
#endif
enum { SUB_CONV = 1, SUB_NORM = 2, SUB_HEADNORM = 4, SUB_CUMSUM = 8, SUB_LRU = 16, SUB_SB = 32, SUB_MEM = 64, SUB_FOX = 128, SUB_ALL = 255 };
constexpr int N_PRO = 3, N_PER_LAYER = 10, N_PHASES = N_PRO + DEPTH * N_PER_LAYER;
struct MArgs { Ptrs P; int ph_lo, ph_hi, sub, pad; };

__global__ void __launch_bounds__(MEGA_THREADS, 2) mega(MArgs a) {
    extern __shared__ __attribute__((aligned(16))) unsigned char lds_raw[];
    LAS unsigned char* lds = (LAS unsigned char*)lds_raw;
    cg::grid_group grid = cg::this_grid();
    { volatile LAS unsigned* st0 = (volatile LAS unsigned*)(lds + XB_LDS_OFF); if (threadIdx.x == 0) { st0[0] = 0u; st0[1] = 0u; } __syncthreads();
      if (a.ph_hi - a.ph_lo > 2) (void)xcd_barrier_post((unsigned*)(a.P.ws + WS_BAR), st0); }
    for (int ph = a.ph_lo; ph < a.ph_hi; ++ph) {
    int tid = threadIdx.x; asm volatile("" : "+v"(tid));
    const int lane = tid & 63, wave = __builtin_amdgcn_readfirstlane(tid >> 6);
    int zs = 0; asm volatile("" : "+s"(zs));
    const int G = gridDim.x + zs, bx = blockIdx.x + zs, sub = a.sub + zs, vcu = (G % 8 == 0) ? (bx % 8) * (G / 8) + bx / 8 : bx;
    const int gw = vcu * NWV + wave, NGW = G * NWV;
    unsigned char* ws = a.P.ws + zs; const float* const* in = a.P.in + zs; float* out = a.P.out + zs;
    bf16_t* H = (bf16_t*)(ws + WS_H); bf16_t* PROJ = (bf16_t*)(ws + WS_PROJ); bf16_t* GATES = (bf16_t*)(ws + WS_GATES); bf16_t* Eb = (bf16_t*)(ws + WS_E);
    bf16_t *FQ = PROJ, *FK = PROJ + (size_t)T * DM, *FV = PROJ + 2 * (size_t)T * DM, *LX = PROJ + 3 * (size_t)T * DM, *LG = PROJ + 4 * (size_t)T * DM, *SQ = PROJ + 5 * (size_t)T * DM,
           *SK = PROJ + 6 * (size_t)T * DM, *SV = PROJ + 7 * (size_t)T * DM, *MQ = PROJ + 8 * (size_t)T * DM;
    bf16_t* YL = (bf16_t*)(ws + WS_YL);
    float *LOGF = (float*)(ws + WS_LOGF), *FB = (float*)(ws + WS_FB), *MQSS = (float*)(ws + WS_MQSS), *ESUM = (float*)(ws + WS_ESUM), *CB = (float*)(ws + WS_CB);
    bf16_t* MEMN = (bf16_t*)(ws + WS_MEMN); float* MEMRAW = (float*)(ws + WS_MEMRAW); bf16_t *MK = (bf16_t*)(ws + WS_MK), *MVT = (bf16_t*)(ws + WS_MVT);
    float *APROD = (float*)(ws + WS_LRU), *HEND = APROD + (size_t)BATCH * 128 * DM;
    bf16_t* WKVT = (bf16_t*)(ws + WS_WKVT);
    bf16_t *WIN_T = (bf16_t*)(ws + WS_WT + WT_IN), *WBR_T = (bf16_t*)(ws + WS_WT + WT_BR), *WOUT_T = (bf16_t*)(ws + WS_WT + WT_OUT), *WUP_T = (bf16_t*)(ws + WS_WT + WT_UP), *WDN_T = (bf16_t*)(ws + WS_WT + WT_DN);
    bf16_t *GV = (bf16_t*)(ws + WS_GV), *ACT = (bf16_t*)(ws + WS_ACT);

        if (ph < N_PRO) {
            if (ph == 0) {
                LAS float* scr = (LAS float*)(lds + wave * 8448);
                for (int it = gw; it < 4 * 1024; it += NGW) { const int l = it >> 10; tr_item(in[15] + (size_t)l * DM * 2048, 2048, WKVT + (size_t)l * 2048 * DM, DM, 64, scr, it & 1023, lane, 1, 0); }
                for (int l = 0; l < 4; ++l) norm_rows(in[1], 512, gw, NGW, in[3] + l * DM, MEMN + (size_t)l * 512 * DM, (const LAS float*)lds, false, nullptr, nullptr, lane);
            } else if (ph == 1) {
                LocOrder<LocMemKV> S; S.so.init(4 * 512, 2048, G, bx); S.loc = LocMemKV{(const char*)MEMN, (const char*)WKVT};
                if (EN_GEMM) pg8::gemm_phase<EpiF32, LocOrder<LocMemKV>, true, true>(lds, pg8::Gemm{DM, DM, DM}, S, EpiF32{MEMRAW, 2048, 0});
            } else {
                for (int m = gw; m < 4 * 512; m += NGW) { const int l = m >> 9, r = m & 511, b = r >> 8, mi = r & 255; const float* raw = MEMRAW + (size_t)m * 2048;
                    const f32x4 gk = *(const f32x4*)(in[17] + l * 256 + lane * 4), gq = *(const f32x4*)(in[16] + l * 256 + lane * 4); const f32x4 gg = gk * gq;
#pragma unroll
                    for (int h = 0; h < 4; ++h) { const f32x4 k = *(const f32x4*)(raw + h * 256 + lane * 4); const float ss = wave_sum((k[0] * k[0] + k[1] * k[1]) + (k[2] * k[2] + k[3] * k[3]));
                        const float rstd = rsqrtf(ss * (1.f / 256.f) + EPS); uint2 o; o.x = pk2(k[0] * rstd * gg[0], k[1] * rstd * gg[1]); o.y = pk2(k[2] * rstd * gg[2], k[3] * rstd * gg[3]);
                        *(uint2*)(MK + ((size_t)l * 512 + (size_t)b * 256 + mi) * DM + h * 256 + lane * 4) = o;
                        const f32x4 v = *(const f32x4*)(raw + 1024 + h * 256 + lane * 4); bf16_t* vt = MVT + (size_t)l * 512 * DM + (((size_t)b * 4 + h) * 256 + lane * 4) * 256 + mi;
                        vt[0] = f2bf(v[0]); vt[256] = f2bf(v[1]); vt[512] = f2bf(v[2]); vt[768] = f2bf(v[3]); }
                    if (r == 0) { float mx = fmaxf(fmaxf(fabsf(gg[0]), fabsf(gg[1])), fmaxf(fabsf(gg[2]), fabsf(gg[3])));
#pragma unroll
                        for (int o = 1; o < 64; o <<= 1) mx = fmaxf(mx, __shfl_xor(mx, o));
                        if (lane == 0) CB[l] = 16.f * mx; } }
            }
        } else {
            const int l = (ph - N_PRO) / N_PER_LAYER, sp = (ph - N_PRO) % N_PER_LAYER;
            const float* xcur = l == 0 ? in[0] : out;
            if (sp == 0) {
                if (sub & SUB_NORM) { LAS float* WfT = (LAS float*)lds; const float* wf = in[4] + (size_t)l * DM * NIN + 3072;
#pragma unroll 8
                    for (int i = tid; i < 16 * 1024; i += MEGA_THREADS) { const int k = i >> 4, h = i & 15; WfT[h * 1024 + k] = wf[(size_t)k * NIN + h]; } }
                __syncthreads();
                if (sub & SUB_CONV) { LAS float* scr = (LAS float*)(lds + 65536 + wave * 8448);
                    const float* win = in[4] + (size_t)l * DM * NIN;
                    for (int it = gw; it < 13440; it += NGW) { int r = it;
                        if (r < 1536) { tr_item(win, NIN, WIN_T, DM, 96, scr, r, lane, 1, 0); continue; } r -= 1536;
                        if (r < 5120) { tr_item(win + 3088, NIN, WIN_T + (size_t)3072 * DM, DM, 320, scr, r, lane, 1, 0); continue; } r -= 5120;
                        if (r < 2048) { const int i = r >> 9; tr_item(in[19] + ((size_t)l * 4 + i) * DM * DM, DM, WBR_T + (size_t)i * DM * DM, DM, 32, scr, r & 511, lane, 1, 0); continue; } r -= 2048;
                        if (r < 512) { tr_item(in[20] + (size_t)l * DM * DM, DM, WOUT_T, DM, 32, scr, r, lane, 1, 0); continue; } r -= 512;
                        if (r < 2816) { tr_item(in[22] + (size_t)l * DM * 2 * DFF, 2 * DFF, WUP_T, DM, 176, scr, r, lane, 1, 0); continue; } r -= 2816;
                        tr_item(in[25] + (size_t)l * DFF * DM, DM, WDN_T, DFF, 32, scr, r, lane, 1, 0); } }
                if (sub & SUB_NORM) norm_rows(xcur, T, gw, NGW, in[2] + l * DM, H, (const LAS float*)lds, !DBG_NOLOGF, in[5] + l * 16, LOGF, lane);
            } else if (sp == 1) {
                LocOrder<LocStd> S; S.so.init(T, 13312, G, bx); S.loc = LocStd{(const char*)H, (const char*)WIN_T, 256 * 1024 * 2, 256 * 1024 * 2};
                if (EN_GEMM) pg8::gemm_phase<EpiProj, LocOrder<LocStd>, true, true>(lds, pg8::Gemm{DM, DM, DM}, S, EpiProj{PROJ, GATES, MQSS});
            } else if (sp == 2) {
                if (sub & SUB_HEADNORM) { for (int m = gw; m < 2 * T; m += NGW) { if (m < T) headnorm64_row(FQ + (size_t)m * DM, in[6] + l * 64, C2, lane); else headnorm64_row(FK + (size_t)(m - T) * DM, in[7] + l * 64, 1.f, lane); } }
                if ((sub & SUB_CUMSUM) && bx < 32) cumsum_block(LOGF + (size_t)bx * SEQ, FB + (size_t)bx * SEQ, (LAS float*)lds, tid);
                __syncthreads();
                if (EN_LRU && (sub & SUB_LRU)) lru_pass<false>(l, bx, G, in, LX, LG, YL, APROD, HEND, lds, tid);
                if (EN_SB && (sub & SUB_SB))
#pragma unroll 1
                for (int k = 0; k < 4; ++k) { const int bh = vcu >> 3, qb = (vcu & 7) * 4 + k; sb_unit(bh >> 4, bh & 15, qb * 256, SQ, SK, SV, H, lds, tid); }
                __syncthreads();
                if (sub & SUB_MEM) { LocOrder<LocMemS> S; S.so.init(T, 1024, G, bx); S.loc = LocMemS{(const char*)MQ, (const char*)(MK + (size_t)l * 512 * DM)};
                    if (EN_GEMM) pg8::gemm_phase<EpiSexp, LocOrder<LocMemS>, true, true>(lds, pg8::Gemm{DM, DM, 256 + zs}, S, EpiSexp{Eb, MQSS, ESUM, CB + l}); }
            } else if (sp == 3) {
                if (EN_FOX && (sub & SUB_FOX)) {
                    float gqm = fabsf(in[6][l * 64 + lane]), gkm = fabsf(in[7][l * 64 + lane]);
#pragma unroll
                    for (int o = 1; o < 64; o <<= 1) { gqm = fmaxf(gqm, __shfl_xor(gqm, o)); gkm = fmaxf(gkm, __shfl_xor(gkm, o)); }
                    const float thr = -(160.f + 2.f * C2 * 64.f * gqm * gkm);
                    const attn_body::AttnTensors AT{(const attn_body::bf16*)FQ, (const attn_body::bf16*)FK, (const attn_body::bf16*)FV, (attn_body::bf16*)SV, FB, thr, 0};
                    attn_body::QueueOrder S; S.ctr = (unsigned*)(ws + WS_QCTR) + (l * 8) * 64; S.xl = bx & 7; S.slot = (volatile LAS int*)(lds + XB_LDS_OFF + 16);
                    attn_body::attn_phase<attn_body::QueueOrder, 20>((char*)lds_raw, AT, S); }
                __syncthreads();
                if (EN_LRU && (sub & SUB_LRU)) lru_pass<true>(l, bx, G, in, LX, LG, YL, APROD, HEND, lds, tid);
                if (sub & SUB_MEM) { LocOrder<LocMemPV> S; S.so.init(T, 1024, G, bx); S.loc = LocMemPV{(const char*)Eb, (const char*)(MVT + (size_t)l * 512 * DM)};
                    if (EN_GEMM) pg8::gemm_phase<EpiMemPV, LocOrder<LocMemPV>, true, true>(lds, pg8::Gemm{DM, 256, 256 + zs}, S, EpiMemPV{MQ, ESUM}); }
            } else if (sp == 4) {
                BranchSched S; S.vcu = vcu; S.loc = LocBranch{(const char*)SV, (const char*)YL, (const char*)H, (const char*)MQ, (const char*)WBR_T};
                if (EN_GEMM) pg8::gemm_phase<EpiBranch, BranchSched, true, true>(lds, pg8::Gemm{DM, DM, DM}, S, EpiBranch{GATES, in[18] + (size_t)l * 4 * DM, (float*)(ws + WS_MIXF), (bf16_t*)(ws + WS_MIXED)});
            } else if (sp == 5) {
                LocOrder<LocStd> S; S.so.init(T, DM, G, bx); S.loc = LocStd{(const char*)(ws + WS_MIXED), (const char*)WOUT_T, 256 * 1024 * 2, 256 * 1024 * 2};
                if (EN_GEMM) pg8::gemm_phase<EpiResid, LocOrder<LocStd>, true, true>(lds, pg8::Gemm{DM, DM, DM}, S, EpiResid{xcur, out});
            } else if (sp == 6) {
                norm_rows(out, T, gw, NGW, in[21] + l * DM, H, (const LAS float*)lds, false, nullptr, nullptr, lane);
            } else if (sp == 7) {
                LocOrder<LocStd> S; S.so.init(T, 2 * DFF, G, bx); S.loc = LocStd{(const char*)H, (const char*)WUP_T, 256 * 1024 * 2, 256 * 1024 * 2};
                if (EN_GEMM) pg8::gemm_phase<EpiBf16P, LocOrder<LocStd>, true, true>(lds, pg8::Gemm{DM, DM, DM}, S, EpiBf16P{GV, 2 * DFF, 0});
            } else if (sp == 8) {
                const float* cw = in[23] + (size_t)l * 3 * DFF; const float* cbv = in[24] + l * DFF;
                for (int i = bx * MEGA_THREADS + tid; i < (T / 8) * (DFF / 8); i += G * MEGA_THREADS) { const int r0 = (i / (DFF / 8)) * 8, c = (i % (DFF / 8)) * 8, t0 = r0 % SEQ;
                    const bf16_t* gp = GV + (size_t)r0 * 2 * DFF + c; const u32x4 z4 = {0u, 0u, 0u, 0u};
                    const f32x4 wa0 = *(const f32x4*)(cw + c), wa1 = *(const f32x4*)(cw + c + 4), wb0 = *(const f32x4*)(cw + DFF + c), wb1 = *(const f32x4*)(cw + DFF + c + 4), wc0 = *(const f32x4*)(cw + 2 * DFF + c), wc1 = *(const f32x4*)(cw + 2 * DFF + c + 4);
                    const f32x4 bb0 = *(const f32x4*)(cbv + c), bb1 = *(const f32x4*)(cbv + c + 4);
                    u32x4 g2 = t0 >= 2 ? *(const u32x4*)(gp - 4 * DFF) : z4, g1 = t0 >= 1 ? *(const u32x4*)(gp - 2 * DFF) : z4;
                    u32x4 gg[8], vv[8];
#pragma unroll
                    for (int j = 0; j < 8; ++j) { gg[j] = *(const u32x4*)(gp + (size_t)j * 2 * DFF); vv[j] = *(const u32x4*)(gp + (size_t)j * 2 * DFF + DFF); }
#define ACT1(G0, G1, G2, VV, W0, W1, W2, BB) ({ const float pre_ = (BB) + (W2) * (G0) + (W1) * (G1) + (W0) * (G2); pre_ * fast_sigmoid(pre_) * (VV); })
#pragma unroll
                    for (int j = 0; j < 8; ++j) { const u32x4 g0 = gg[j], v_ = vv[j]; u32x4 o;
                        o.x = pk2(ACT1(blo(g0.x), blo(g1.x), blo(g2.x), blo(v_.x), wa0[0], wb0[0], wc0[0], bb0[0]), ACT1(bhi(g0.x), bhi(g1.x), bhi(g2.x), bhi(v_.x), wa0[1], wb0[1], wc0[1], bb0[1]));
                        o.y = pk2(ACT1(blo(g0.y), blo(g1.y), blo(g2.y), blo(v_.y), wa0[2], wb0[2], wc0[2], bb0[2]), ACT1(bhi(g0.y), bhi(g1.y), bhi(g2.y), bhi(v_.y), wa0[3], wb0[3], wc0[3], bb0[3]));
                        o.z = pk2(ACT1(blo(g0.z), blo(g1.z), blo(g2.z), blo(v_.z), wa1[0], wb1[0], wc1[0], bb1[0]), ACT1(bhi(g0.z), bhi(g1.z), bhi(g2.z), bhi(v_.z), wa1[1], wb1[1], wc1[1], bb1[1]));
                        o.w = pk2(ACT1(blo(g0.w), blo(g1.w), blo(g2.w), blo(v_.w), wa1[2], wb1[2], wc1[2], bb1[2]), ACT1(bhi(g0.w), bhi(g1.w), bhi(g2.w), bhi(v_.w), wa1[3], wb1[3], wc1[3], bb1[3]));
                        *(u32x4*)(ACT + (size_t)(r0 + j) * DFF + c) = o; g2 = g1; g1 = g0; }
#undef ACT1
                }
            } else {
                LocOrder<LocStd> S; S.so.init(T, DM, G, bx); S.loc = LocStd{(const char*)ACT, (const char*)WDN_T, 256 * DFF * 2, 256 * DFF * 2};
                if (EN_GEMM) pg8::gemm_phase<EpiResid, LocOrder<LocStd>, true, true>(lds, pg8::Gemm{DFF, DFF, DFF}, S, EpiResid{out, out});
            }
        }
        if (ph + 1 < a.ph_hi) {
            if (ph == a.ph_lo) grid.sync();
            else { XcdBarrier xb; xb.bar = (unsigned*)(ws + WS_BAR); xb.x = xb_xcc_id(); xb.st = (volatile LAS unsigned*)(lds + XB_LDS_OFF); xcd_barrier(xb); }
        }
    }
}
enum { C_PRO = 1, C_NORM = 2, C_WIN = 4, C_HN = 8, C_LRU = 16, C_SB = 32, C_MEM = 64, C_FOX = 128, C_BR = 256, C_WOUT = 512, C_NORM2 = 1024, C_UP = 2048, C_ACT = 4096, C_DOWN = 8192, C_ONE = 16384 };
#ifndef CFG
#define CFG 32767
#endif
#ifndef REPEAT_SP
#define REPEAT_SP (-1)
#define REPEAT_N 0
#define REPEAT_SUB 0
#endif
static int g_grid = 0;
static void launch_mega(const Ptrs& P, int lo, int hi, int sub, hipStream_t st, bool coop) {
    MArgs a{}; a.P = P; a.ph_lo = lo; a.ph_hi = hi; a.sub = sub; a.pad = 0;
    if (coop) { void* args[] = {&a}; const hipError_t e = hipLaunchCooperativeKernel((const void*)mega, dim3(g_grid), dim3(MEGA_THREADS), args, MEGA_LDS, st);
        if (e != hipSuccess) fprintf(stderr, "cooperative launch failed: %s (grid %d)\n", hipGetErrorString(e), g_grid); }
    else { hipLaunchKernelGGL(mega, dim3(g_grid), dim3(MEGA_THREADS), MEGA_LDS, st, a);
        if (REPEAT_N > 0 && hi == lo + 1 && lo >= N_PRO && (lo - N_PRO) % N_PER_LAYER == (REPEAT_SP)) { a.sub = (REPEAT_SUB); for (int r = 0; r < (REPEAT_N); ++r) hipLaunchKernelGGL(mega, dim3(g_grid), dim3(MEGA_THREADS), MEGA_LDS, st, a); } }
}
static void run_hybrid(const Ptrs& P, hipStream_t st) {
    unsigned char* ws = P.ws;
    bf16_t* H = (bf16_t*)(ws + WS_H);
    bf16_t* PR[9]; for (int i = 0; i < 9; ++i) PR[i] = (bf16_t*)(ws + WS_PROJ + i * SZ_ACT);
    bf16_t *FQ = PR[0], *FK = PR[1], *FV = PR[2], *LX = PR[3], *LG = PR[4], *SQ = PR[5], *SK = PR[6], *SV = PR[7], *MQ = PR[8];
    bf16_t* GATES = (bf16_t*)(ws + WS_GATES);
    bf16_t *YL = (bf16_t*)(ws + WS_YL), *YS = (bf16_t*)(ws + WS_YS), *YM = (bf16_t*)(ws + WS_YM), *YF = (bf16_t*)(ws + WS_YF);
    float *LOGF = (float*)(ws + WS_LOGF), *FB = (float*)(ws + WS_FB);
    bf16_t* MEMN = (bf16_t*)(ws + WS_MEMN); float* MEMRAW = (float*)(ws + WS_MEMRAW);
    bf16_t *MK = (bf16_t*)(ws + WS_MK), *MVT = (bf16_t*)(ws + WS_MVT);
    bf16_t *GV = (bf16_t*)(ws + WS_GV), *ACT = (bf16_t*)(ws + WS_ACT);
    const float* const* in = P.in;
    const int cfg = CFG;
    const bool anygemm = cfg & (C_WIN | C_BR | C_WOUT | C_UP | C_DOWN);
    if (cfg & C_PRO) { for (int p = 0; p < 3; ++p) launch_mega(P, p, p + 1, SUB_ALL, st, false); }
    else for (int l = 0; l < DEPTH; ++l) {
        n_rmsnorm<<<512 / 4, 256, 0, st>>>(in[1], in[3] + l * DM, MEMN + (size_t)l * 512 * DM, nullptr, nullptr, nullptr, 512);
        n_gemm<EStoreF32><<<dim3(2048 / 64, 512 / 64), 256, 0, st>>>(MEMN + (size_t)l * 512 * DM, in[15] + (size_t)l * DM * 2048, DM, 2048, DM, 0x7fffffff, EStoreF32{MEMRAW + (size_t)l * 512 * 2048, 2048, 0});
        n_memkv_post<<<512, 256, 0, st>>>(MEMRAW + (size_t)l * 512 * 2048, in[17] + l * 256, in[16] + l * 256, MK + (size_t)l * 512 * DM, MVT + (size_t)l * 512 * DM);
    }
    for (int l = 0; l < DEPTH; ++l) {
        const int p0 = N_PRO + l * N_PER_LAYER;
        const float* xcur = l == 0 ? in[0] : P.out;
        const float* win = in[4] + (size_t)l * DM * NIN;
        if (DBG_NOLOGF) n_rmsnorm<<<T / 4, 256, 0, st>>>(xcur, in[2] + l * DM, H, win + 3072, in[5] + l * 16, LOGF, T);
        { const int sub = (anygemm ? SUB_CONV : 0) | ((cfg & C_NORM) ? SUB_NORM : 0); if (sub) launch_mega(P, p0, p0 + 1, sub, st, false); }
        if (!(cfg & C_NORM)) n_rmsnorm<<<T / 4, 256, 0, st>>>(xcur, in[2] + l * DM, H, win + 3072, in[5] + l * 16, LOGF, T);
        if (cfg & C_WIN) launch_mega(P, p0 + 1, p0 + 2, SUB_ALL, st, false);
        else { for (int gI = 0; gI < 9; ++gI) { const int coff = gI < 3 ? gI * 1024 : gI * 1024 + 16;
                n_gemm<EStoreBf16><<<dim3(1024 / 64, T / 64), 256, 0, st>>>(H, win + coff, DM, NIN, DM, 0x7fffffff, EStoreBf16{PR[gI], DM, 0}); }
            n_gemm<EStoreBf16><<<dim3(4096 / 64, T / 64), 256, 0, st>>>(H, win + 9232, DM, NIN, DM, 0x7fffffff, EStoreBf16{GATES, 4096, 0}); }
        if (!(cfg & C_HN)) { n_headnorm<<<T * 16 / 256, 256, 0, st>>>(FQ, in[6] + l * 64, 64, C2); n_headnorm<<<T * 16 / 256, 256, 0, st>>>(FK, in[7] + l * 64, 64, 1.f); n_cumsum<<<32, 1024, 0, st>>>(LOGF, FB); }
        const int sub23 = ((cfg & C_HN) ? (SUB_HEADNORM | SUB_CUMSUM) : 0) | ((cfg & C_LRU) ? SUB_LRU : 0) | ((cfg & C_SB) ? SUB_SB : 0) | ((cfg & C_MEM) ? SUB_MEM : 0) | ((cfg & C_FOX) ? SUB_FOX : 0);
        if (sub23 & ~SUB_FOX) launch_mega(P, p0 + 2, p0 + 3, sub23, st, false);
        if (!(cfg & C_SB)) n_sb_attn<<<dim3(SEQ / 256, 32), 256, 0, st>>>(SQ, SK, SV, YS);
        if (!(cfg & C_LRU)) n_lru<<<32, 64, 0, st>>>(LX, LG, in[8] + (size_t)l * 4 * DM, in[9] + l * DM, in[10] + (size_t)l * 16 * 64 * 64, in[11] + l * DM, in[12] + (size_t)l * 16 * 64 * 64, in[13] + l * DM, in[14] + l * DM, YL);
        if (!(cfg & C_MEM)) n_mem_attn<<<T * 4, 256, 0, st>>>(MQ, MK + (size_t)l * 512 * DM, MVT + (size_t)l * 512 * DM, YM);
        if (sub23 & (SUB_FOX | SUB_LRU | SUB_MEM)) launch_mega(P, p0 + 3, p0 + 4, sub23, st, false);
        if (!(cfg & C_FOX)) n_fox_attn<<<dim3(SEQ / 256, 32), 256, 0, st>>>(FQ, FK, FV, FB, YF);
        if (cfg & C_BR) launch_mega(P, p0 + 4, p0 + 5, SUB_ALL, st, false);
        else { const bf16_t* Y[4] = {YF, YL, YS, YM};
            for (int i = 0; i < 4; ++i) n_gemm<EBranch><<<dim3(1024 / 64, T / 64), 256, 0, st>>>(Y[i], in[19] + ((size_t)l * 4 + i) * DM * DM, DM, DM, DM, 0x7fffffff, EBranch{GATES, in[18] + ((size_t)l * 4 + i) * DM, (float*)(ws + WS_MIXF), (bf16_t*)(ws + WS_MIXED), i, 0}); }
        if (cfg & C_WOUT) launch_mega(P, p0 + 5, p0 + 6, SUB_ALL, st, false);
        else n_gemm<EResid><<<dim3(1024 / 64, T / 64), 256, 0, st>>>((const bf16_t*)(ws + WS_MIXED), in[20] + (size_t)l * DM * DM, DM, DM, DM, 0x7fffffff, EResid{xcur, P.out});
        if (cfg & C_NORM2) launch_mega(P, p0 + 6, p0 + 7, SUB_ALL, st, false);
        else n_rmsnorm<<<T / 4, 256, 0, st>>>(P.out, in[21] + l * DM, H, nullptr, nullptr, nullptr, T);
        if (cfg & C_UP) launch_mega(P, p0 + 7, p0 + 8, SUB_ALL, st, false);
        else n_gemm<EStoreBf16><<<dim3(2 * DFF / 64, T / 64), 256, 0, st>>>(H, in[22] + (size_t)l * DM * 2 * DFF, DM, 2 * DFF, DM, 0x7fffffff, EStoreBf16{GV, 2 * DFF, 0});
        if (cfg & C_ACT) launch_mega(P, p0 + 8, p0 + 9, SUB_ALL, st, false);
        else n_act<<<(unsigned)(((size_t)T * DFF + 255) / 256), 256, 0, st>>>(GV, in[23] + (size_t)l * 3 * DFF, in[24] + l * DFF, ACT);
        if (cfg & C_DOWN) launch_mega(P, p0 + 9, p0 + 10, SUB_ALL, st, false);
        else n_gemm<EResid><<<dim3(1024 / 64, T / 64), 256, 0, st>>>(ACT, in[25] + (size_t)l * DFF * DM, DFF, DM, DFF, 0x7fffffff, EResid{P.out, P.out});
    }
}

extern "C" void kernel_launch(void* const* d_in, const int* in_sizes, int n_in, void* d_out, int out_size, void* d_ws, size_t ws_size, hipStream_t stream) {
    if (n_in != 26 || out_size != T * DM || ws_size < WS_NEED) { fprintf(stderr, "kernel_launch: unexpected sizes n_in %d out %d ws %zu (need %zu)\n", n_in, out_size, ws_size, (size_t)WS_NEED); return; }
    if (g_grid == 0) {
        int dev = 0, cus = 0, per_cu = 0;
        hipGetDevice(&dev); hipDeviceGetAttribute(&cus, hipDeviceAttributeMultiprocessorCount, dev);
        if (hipFuncSetAttribute((const void*)mega, hipFuncAttributeMaxDynamicSharedMemorySize, MEGA_LDS) != hipSuccess) fprintf(stderr, "kernel_launch: hipFuncSetAttribute failed\n");
        if (hipOccupancyMaxActiveBlocksPerMultiprocessor(&per_cu, (const void*)mega, MEGA_THREADS, MEGA_LDS) != hipSuccess || per_cu < 1) fprintf(stderr, "kernel_launch: occupancy query says %d\n", per_cu);
        (void)hipGetLastError();
        g_grid = cus;
        if (g_grid != 256) fprintf(stderr, "kernel_launch: %d CUs; the attention phase's static order assumes 256\n", g_grid);
    }
    Ptrs P{};
    for (int i = 0; i < 26; ++i) P.in[i] = (const float*)d_in[i];
    P.out = (float*)d_out; P.ws = (unsigned char*)d_ws;
    if ((CFG) & C_ONE) { (void)hipMemsetAsync((char*)d_ws + WS_BAR, 0, CTL_ZERO_BYTES, stream);
        launch_mega(P, 0, N_PHASES, SUB_ALL, stream, true); }
    else { (void)hipMemsetAsync((char*)d_ws + WS_BAR, 0, CTL_ZERO_BYTES, stream); run_hybrid(P, stream); }
}
```

```cpp
#include <hip/hip_runtime.h>
#include <cstdio>
#include <cstdint>
#include <hip/hip_cooperative_groups.h>

typedef unsigned short bf16_t;
constexpr int BATCH = 2, SEQ = 8192, DM = 1024, DEPTH = 4, T = BATCH * SEQ;
constexpr int NMEM = 256, NIN = 13328, DFF = 2816;
constexpr float EPS = 1e-6f;
constexpr float LOG2E = 1.4426950408889634f;
constexpr float C2 = 0.125f * LOG2E;
constexpr float SB_THR = -104.0f;

__device__ __forceinline__ float bf2f(bf16_t b) { return __uint_as_float(((unsigned)b) << 16); }
__device__ __forceinline__ bf16_t f2bf(float f) { unsigned u = __float_as_uint(f); return (bf16_t)((u + 0x7fffu + ((u >> 16) & 1u)) >> 16); }
__device__ __forceinline__ float bfr(float f) { return bf2f(f2bf(f)); }
__device__ __forceinline__ float wave_sum(float v) {
#pragma unroll
    for (int o = 1; o < 64; o <<= 1) v += __shfl_xor(v, o);
    return v;
}
__device__ __forceinline__ float softplusf(float x) { return fmaxf(x, 0.f) + log1pf(__expf(-fabsf(x))); }
__device__ __forceinline__ float logsigmoidf(float x) { return -softplusf(-x); }
__device__ __forceinline__ float sigmoidf_(float x) { return 1.f / (1.f + __expf(-x)); }
__device__ __forceinline__ float gelu_tanh(float x) { const float u = 0.7978845608028654f * (x + 0.044715f * x * x * x); return 0.5f * x * (1.f + tanhf(u)); }

__device__ __forceinline__ int mk_tid() { int t = threadIdx.x; asm volatile("" : "+v"(t)); return t; }

constexpr size_t MiB = 1u << 20;
constexpr size_t SZ_ACT = (size_t)T * DM * 2;
constexpr size_t WS_CTL = 0;
constexpr size_t WS_H = 1 * MiB;
constexpr size_t WS_PROJ = WS_H + SZ_ACT;
constexpr size_t WS_GATES = WS_PROJ + 9 * SZ_ACT;
constexpr size_t WS_E = WS_GATES + 4 * SZ_ACT;
constexpr size_t WS_LOGF = WS_E + SZ_ACT;
constexpr size_t WS_FB = WS_LOGF + 1 * MiB;
constexpr size_t WS_MQSS = WS_FB + 1 * MiB;
constexpr size_t WS_ESUM = WS_MQSS + 1 * MiB;
constexpr size_t WS_MEMN = WS_ESUM + 1 * MiB;
constexpr size_t WS_MEMRAW = WS_MEMN + 4 * MiB;
constexpr size_t WS_MK = WS_MEMRAW + 16 * MiB;
constexpr size_t WS_MVT = WS_MK + 4 * MiB;
constexpr size_t WS_LRU = WS_MVT + 4 * MiB;
constexpr size_t WS_WT = WS_LRU + 2 * MiB;
constexpr size_t WS_END = WS_WT + 72 * MiB;
constexpr size_t WS_YL = WS_PROJ + 6 * SZ_ACT, WS_YS = WS_H, WS_YM = WS_PROJ + 8 * SZ_ACT, WS_YF = WS_PROJ + 7 * SZ_ACT;
constexpr size_t WS_GV = WS_PROJ;
constexpr size_t WS_ACT = WS_GV + (size_t)T * 2 * DFF * 2;
static_assert(WS_ACT + (size_t)T * DFF * 2 <= WS_GATES, "ffn alias");
constexpr size_t WS_MIXF = WS_END;
constexpr size_t WS_MIXED = WS_PROJ;
constexpr size_t WS_NEED = WS_MIXF + (size_t)T * DM * 4;

struct Ptrs {
    const float* in[26];
    float* out;
    unsigned char* ws;
};

__global__ void __launch_bounds__(256) n_rmsnorm(const float* __restrict__ x, const float* __restrict__ g, bf16_t* __restrict__ H,
                                                 const float* __restrict__ Wf, const float* __restrict__ bfg, float* __restrict__ LOGF, int nrows) {
    const int lane = threadIdx.x & 63, row = blockIdx.x * 4 + (threadIdx.x >> 6);
    if (row >= nrows) return;
    const float4* xr = (const float4*)(x + (size_t)row * DM);
    const float4* gr = (const float4*)g;
    float4 v[4]; float ss = 0.f;
#pragma unroll
    for (int j = 0; j < 4; ++j) { v[j] = xr[lane + 64 * j]; ss += v[j].x * v[j].x + v[j].y * v[j].y + v[j].z * v[j].z + v[j].w * v[j].w; }
    ss = wave_sum(ss);
    const float rstd = rsqrtf(ss * (1.f / DM) + EPS);
#pragma unroll
    for (int j = 0; j < 4; ++j) { const float4 gg = gr[lane + 64 * j]; v[j].x *= rstd * gg.x; v[j].y *= rstd * gg.y; v[j].z *= rstd * gg.z; v[j].w *= rstd * gg.w;
        ushort4 o; o.x = f2bf(v[j].x); o.y = f2bf(v[j].y); o.z = f2bf(v[j].z); o.w = f2bf(v[j].w);
        ((ushort4*)(H + (size_t)row * DM))[lane + 64 * j] = o; }
    if (Wf) {
        float mine = 0.f;
        for (int h = 0; h < 16; ++h) {
            float p = 0.f;
#pragma unroll
            for (int j = 0; j < 4; ++j) { const int k = (lane + 64 * j) * 4;
                p += v[j].x * Wf[(size_t)k * NIN + h] + v[j].y * Wf[(size_t)(k + 1) * NIN + h] + v[j].z * Wf[(size_t)(k + 2) * NIN + h] + v[j].w * Wf[(size_t)(k + 3) * NIN + h]; }
            p = wave_sum(p);
            if (lane == h) mine = p;
        }
        if (lane < 16) { const int b = row / SEQ, t = row % SEQ; LOGF[((size_t)b * 16 + lane) * SEQ + t] = logsigmoidf(mine + bfg[lane]); }
    }
}

struct EStoreBf16 { bf16_t* O; int ldc; int pad; __device__ void operator()(int m, int n, float a) const { O[(size_t)m * ldc + n] = f2bf(a); } };
struct EStoreF32 { float* O; int ldc; int pad; __device__ void operator()(int m, int n, float a) const { O[(size_t)m * ldc + n] = a; } };
struct EBranch { const bf16_t* G; const float* bg; float* MIXF; bf16_t* MIXED; int i; int pad; __device__ void operator()(int m, int n, float a) const { float v = sigmoidf_(bf2f(G[(size_t)m * 4096 + i * 1024 + n]) + bg[n]) * a; const size_t o = (size_t)m * DM + n; if (i > 0) v += MIXF[o]; if (i < 3) MIXF[o] = v; else MIXED[o] = f2bf(v); } };
struct EResid { const float* base; float* out; __device__ void operator()(int m, int n, float a) const { out[(size_t)m * DM + n] = base[(size_t)m * DM + n] + a; } };

template <class Epi> __global__ void __launch_bounds__(256) n_gemm(const bf16_t* __restrict__ A, const float* __restrict__ W, int lda, int ldw, int K, int kmask, Epi epi) {
    __shared__ float As[16][68], Bs[16][68];
    const int tx = threadIdx.x & 15, ty = threadIdx.x >> 4, m0 = blockIdx.y * 64, n0 = blockIdx.x * 64;
    float acc[4][4];
#pragma unroll
    for (int i = 0; i < 4; ++i)
#pragma unroll
        for (int j = 0; j < 4; ++j) acc[i][j] = 0.f;
    for (int k0 = 0; k0 < K; k0 += 16) {
#pragma unroll
        for (int i = 0; i < 4; ++i) { const int idx = threadIdx.x + i * 256; { const int r = idx >> 4, c = idx & 15; As[c][r] = bf2f(A[(size_t)(m0 + r) * lda + k0 + c]); }
            { const int r = idx >> 6, c = idx & 63; Bs[r][c] = bfr(W[(size_t)((k0 + r) & kmask) * ldw + n0 + c]); } }
        __syncthreads();
#pragma unroll
        for (int kk = 0; kk < 16; ++kk) { float a[4], b[4];
#pragma unroll
            for (int i = 0; i < 4; ++i) { a[i] = As[kk][ty * 4 + i]; b[i] = Bs[kk][tx * 4 + i]; }
#pragma unroll
            for (int i = 0; i < 4; ++i)
#pragma unroll
                for (int j = 0; j < 4; ++j) acc[i][j] += a[i] * b[j]; }
        __syncthreads();
    }
#pragma unroll
    for (int i = 0; i < 4; ++i)
#pragma unroll
        for (int j = 0; j < 4; ++j) epi(m0 + ty * 4 + i, n0 + tx * 4 + j, acc[i][j]);
}

__global__ void __launch_bounds__(256) n_headnorm(bf16_t* X, const float* __restrict__ g, int HD, float scale) {
    const int idx = blockIdx.x * 256 + threadIdx.x, nh = DM / HD, row = idx / nh, h = idx % nh;
    if (row >= T) return;
    bf16_t* p = X + (size_t)row * DM + h * HD; float ss = 0.f;
    for (int d = 0; d < HD; ++d) { const float v = bf2f(p[d]); ss += v * v; }
    const float rstd = rsqrtf(ss / HD + EPS) * scale;
    for (int d = 0; d < HD; ++d) p[d] = f2bf(bf2f(p[d]) * rstd * g[d]);
}

__global__ void __launch_bounds__(1024) n_cumsum(const float* __restrict__ LOGF, float* __restrict__ FB) {
    __shared__ float part[1024];
    const int bh = blockIdx.x, tid = threadIdx.x; const float* src = LOGF + (size_t)bh * SEQ + tid * 8; float v[8]; float s = 0.f;
#pragma unroll
    for (int i = 0; i < 8; ++i) { s += src[i]; v[i] = s; }
    part[tid] = s; __syncthreads();
    if (tid == 0) { float run = 0.f; for (int i = 0; i < 1024; ++i) { const float t_ = part[i]; part[i] = run; run += t_; } }
    __syncthreads();
    const float off = part[tid]; float* dst = FB + (size_t)bh * SEQ + tid * 8;
#pragma unroll
    for (int i = 0; i < 8; ++i) dst[i] = off + v[i];
}

__global__ void __launch_bounds__(256) n_fox_attn(const bf16_t* Q, const bf16_t* __restrict__ K, const bf16_t* __restrict__ V, const float* __restrict__ FB, bf16_t* O) {
    __shared__ float Ks[64][64], Vs[64][64], Fs[64];
    const int bh = blockIdx.y, b = bh >> 4, h = bh & 15, tq = blockIdx.x * 256 + threadIdx.x;
    const size_t rowq = (size_t)b * SEQ + tq;
    float q[64], o[64];
#pragma unroll
    for (int d = 0; d < 64; ++d) { q[d] = bf2f(Q[rowq * DM + h * 64 + d]); o[d] = 0.f; }
    const float Ft = FB[(size_t)bh * SEQ + tq];
    float m = -INFINITY, l = 0.f;
    const int ntile = (blockIdx.x * 256 + 256) / 64;
    for (int kt = 0; kt < ntile; ++kt) {
        __syncthreads();
        for (int i = threadIdx.x; i < 64 * 64; i += 256) { const int r = i >> 6, c = i & 63; const size_t rk = ((size_t)b * SEQ + kt * 64 + r) * DM + h * 64 + c; Ks[r][c] = bf2f(K[rk]); Vs[r][c] = bf2f(V[rk]); }
        if (threadIdx.x < 64) Fs[threadIdx.x] = FB[(size_t)bh * SEQ + kt * 64 + threadIdx.x];
        __syncthreads();
        for (int j = 0; j < 64; ++j) {
            const int s = kt * 64 + j; if (s > tq) break;
            float z = 0.f;
#pragma unroll
            for (int d = 0; d < 64; ++d) z += q[d] * Ks[j][d];
            z += (Ft - Fs[j]) * LOG2E;
            if (z > m) { const float c = exp2f(m - z); l *= c;
#pragma unroll
                for (int d = 0; d < 64; ++d) o[d] *= c;
                m = z; }
            const float p = exp2f(z - m); l += p;
#pragma unroll
            for (int d = 0; d < 64; ++d) o[d] += p * Vs[j][d];
        }
    }
    const float il = 1.f / l;
#pragma unroll
    for (int d = 0; d < 64; ++d) O[rowq * DM + h * 64 + d] = f2bf(o[d] * il);
}

__global__ void __launch_bounds__(256) n_sb_attn(const bf16_t* Q, const bf16_t* __restrict__ K, const bf16_t* __restrict__ V, bf16_t* O) {
    __shared__ float Ks[64][64], Vs[64][64];
    const int bh = blockIdx.y, b = bh >> 4, h = bh & 15, tq = blockIdx.x * 256 + threadIdx.x;
    const size_t rowq = (size_t)b * SEQ + tq;
    float q[64], o[64];
#pragma unroll
    for (int d = 0; d < 64; ++d) { q[d] = bf2f(Q[rowq * DM + h * 64 + d]) * 0.125f; o[d] = 0.f; }
    float R = 0.f;
    for (int kt = (blockIdx.x * 256 + 255) / 64; kt >= 0; --kt) {
        if (__syncthreads_and(R < SB_THR)) break;
        for (int i = threadIdx.x; i < 64 * 64; i += 256) { const int r = i >> 6, c = i & 63; const size_t rk = ((size_t)b * SEQ + kt * 64 + r) * DM + h * 64 + c; Ks[r][c] = bf2f(K[rk]); Vs[r][c] = bf2f(V[rk]); }
        __syncthreads();
        for (int j = 63; j >= 0; --j) {
            const int s = kt * 64 + j; if (s >= tq) continue;
            float z = 0.f;
#pragma unroll
            for (int d = 0; d < 64; ++d) z += q[d] * Ks[j][d];
            const float sp = softplusf(z);
            const float w = __expf((z - sp) + R);
            R -= sp;
#pragma unroll
            for (int d = 0; d < 64; ++d) o[d] += w * Vs[j][d];
        }
    }
#pragma unroll
    for (int d = 0; d < 64; ++d) O[rowq * DM + h * 64 + d] = f2bf(o[d]);
}

__global__ void __launch_bounds__(64) n_lru(const bf16_t* LX, const bf16_t* __restrict__ LG, const float* __restrict__ cw, const float* __restrict__ cb,
                                            const float* __restrict__ wa, const float* __restrict__ ba, const float* __restrict__ wx, const float* __restrict__ bx,
                                            const float* __restrict__ lam, bf16_t* YL) {
    __shared__ float xs[64];
    const int b = blockIdx.x >> 4, n = blockIdx.x & 15, e = threadIdx.x, ch = n * 64 + e;
    float wA[64], wX[64];
#pragma unroll
    for (int d = 0; d < 64; ++d) { wA[d] = wa[((size_t)n * 64 + d) * 64 + e]; wX[d] = wx[((size_t)n * 64 + d) * 64 + e]; }
    const float w0 = cw[ch], w1 = cw[DM + ch], w2 = cw[2 * DM + ch], w3 = cw[3 * DM + ch], bc = cb[ch], bA = ba[ch], bX = bx[ch];
    const float spl = softplusf(-lam[ch]);
    float x1 = 0.f, x2 = 0.f, x3 = 0.f, hs = 0.f;
    for (int t = 0; t < SEQ; ++t) {
        const size_t r = ((size_t)b * SEQ + t) * DM + ch;
        const float x0 = bf2f(LX[r]);
        const float xc = bc + w3 * x0 + w2 * x1 + w1 * x2 + w0 * x3;
        x3 = x2; x2 = x1; x1 = x0;
        __syncthreads();
        xs[e] = xc;
        __syncthreads();
        float ra = bA, ri = bX;
#pragma unroll
        for (int d = 0; d < 64; ++d) { const float xv = xs[d]; ra += xv * wA[d]; ri += xv * wX[d]; }
        const float rr = sigmoidf_(ra), ii = sigmoidf_(ri);
        const float la = -8.f * rr * spl;
        const float a = __expf(la);
        const float u = sqrtf(-expm1f(2.f * la)) * (ii * xc);
        hs = a * hs + u;
        YL[r] = f2bf(hs * gelu_tanh(bf2f(LG[r])));
    }
}

__global__ void __launch_bounds__(256) n_memkv_post(const float* __restrict__ raw, const float* __restrict__ gk, const float* __restrict__ gq, bf16_t* __restrict__ MK, bf16_t* __restrict__ MVT) {
    const int row = blockIdx.x, b = row >> 8, m = row & 255, d = threadIdx.x;
    __shared__ float red[4];
    for (int h = 0; h < 4; ++h) {
        const float k = raw[(size_t)row * 2048 + h * 256 + d];
        float ss = wave_sum(k * k);
        __syncthreads();
        if ((threadIdx.x & 63) == 0) red[threadIdx.x >> 6] = ss;
        __syncthreads();
        ss = red[0] + red[1] + red[2] + red[3];
        const float rstd = rsqrtf(ss * (1.f / 256.f) + EPS);
        MK[((size_t)b * 256 + m) * DM + h * 256 + d] = f2bf(k * rstd * gk[d] * gq[d]);
        MVT[(((size_t)b * 4 + h) * 256 + d) * 256 + m] = f2bf(raw[(size_t)row * 2048 + 1024 + h * 256 + d]);
    }
}

__global__ void __launch_bounds__(256) n_mem_attn(const bf16_t* MQ, const bf16_t* __restrict__ MK, const bf16_t* __restrict__ MVT, bf16_t* YM) {
    __shared__ float qs[256], ps[256], red[4];
    const int row = blockIdx.x >> 2, h = blockIdx.x & 3, b = row / SEQ, tid = threadIdx.x;
    const float qv = bf2f(MQ[(size_t)row * DM + h * 256 + tid]);
    float ss = wave_sum(qv * qv);
    if ((tid & 63) == 0) red[tid >> 6] = ss;
    qs[tid] = qv;
    __syncthreads();
    const float rstd = rsqrtf((red[0] + red[1] + red[2] + red[3]) * (1.f / 256.f) + EPS);
    const bf16_t* kr = MK + ((size_t)b * 256 + tid) * DM + h * 256;
    float s = 0.f;
    for (int d = 0; d < 256; ++d) s += qs[d] * bf2f(kr[d]);
    s *= rstd * (1.f / 16.f);
    __syncthreads();
    float mx = s;
#pragma unroll
    for (int o = 1; o < 64; o <<= 1) mx = fmaxf(mx, __shfl_xor(mx, o));
    if ((tid & 63) == 0) red[tid >> 6] = mx;
    __syncthreads();
    mx = fmaxf(fmaxf(red[0], red[1]), fmaxf(red[2], red[3]));
    const float p = __expf(s - mx);
    ps[tid] = p;
    float sum = wave_sum(p);
    __syncthreads();
    if ((tid & 63) == 0) red[tid >> 6] = sum;
    __syncthreads();
    sum = red[0] + red[1] + red[2] + red[3];
    const bf16_t* vr = MVT + (((size_t)b * 4 + h) * 256 + tid) * 256;
    float o = 0.f;
    for (int m = 0; m < 256; ++m) o += ps[m] * bf2f(vr[m]);
    YM[(size_t)row * DM + h * 256 + tid] = f2bf(o / sum);
}

__global__ void __launch_bounds__(256) n_act(const bf16_t* __restrict__ GV, const float* __restrict__ cw, const float* __restrict__ cb, bf16_t* __restrict__ ACT) {
    const size_t idx = (size_t)blockIdx.x * 256 + threadIdx.x; if (idx >= (size_t)T * DFF) return;
    const int r = (int)(idx / DFF), c = (int)(idx % DFF), t = r % SEQ;
    const float g0 = bf2f(GV[(size_t)r * 2 * DFF + c]);
    const float g1 = t >= 1 ? bf2f(GV[(size_t)(r - 1) * 2 * DFF + c]) : 0.f;
    const float g2 = t >= 2 ? bf2f(GV[(size_t)(r - 2) * 2 * DFF + c]) : 0.f;
    const float pre = cb[c] + cw[2 * DFF + c] * g0 + cw[DFF + c] * g1 + cw[c] * g2;
    const float val = bf2f(GV[(size_t)r * 2 * DFF + DFF + c]);
    ACT[(size_t)r * DFF + c] = f2bf(pre * sigmoidf_(pre) * val);
}

#define CFG 32767
namespace pg8 {
#define PG8_LAS __attribute__((address_space(3)))
typedef unsigned short bf16_t;
typedef short bf16x8 __attribute__((ext_vector_type(8)));
typedef float f32x4 __attribute__((ext_vector_type(4)));
typedef unsigned u32x4 __attribute__((ext_vector_type(4)));
constexpr int BM = 256, BK = 64, HALF = 128, HTB = HALF * BK * 2  , STAGE_BYTES = 8 * HTB, NXCD = 8, WGM = 8;

__host__ __device__ __forceinline__ int lds_byte(int r, int c) { const int st = (r >> 4) * 2 + (c >> 5), rr = r & 15, cc = c & 31, ob = rr * 64 + cc * 2; return st * 1024 + (ob ^ (((ob >> 9) & 1) << 5)); }
__host__ __device__ __forceinline__ void stage_rc(int b, int& R, int& C) { const int st = b / 1024, sb = b % 1024, swz = sb ^ (((sb >> 9) & 1) << 5); R = (st >> 1) * 16 + swz / 64; C = (st & 1) * 32 + (swz % 64) / 2; }
__host__ __device__ __forceinline__ int perm32(int rho) { const int n = rho >> 4, i = rho & 15; return 8 * (i >> 2) + 4 * n + (i & 3); }

struct Unit { int pm, pn; };
struct Gemm { int lda, ldb, K; };

struct StaticOrder {
    int nM, nN, nwg, G, c;
    __host__ __device__ void init(int M, int N, int G_, int c_) { nM = M / BM; nN = N / BM; nwg = nM * nN; G = G_; c = c_; }
    __host__ __device__ bool next(int i, Unit& u) const {
        const long L = (long)i * G + c; if (L >= nwg) return false;
        int wgid = (int)L; { const int q = nwg / NXCD, r = nwg % NXCD, xcd = wgid % NXCD, off = wgid / NXCD; wgid = (xcd < r ? xcd * (q + 1) : r * (q + 1) + (xcd - r) * q) + off; }
        const int nig = WGM * nN, gid = wgid / nig, fm = gid * WGM, gsz = (nM - fm) < WGM ? (nM - fm) : WGM;
        u.pm = fm + ((wgid % nig) % gsz); u.pn = (wgid % nig) / gsz; return true;
    }
    __device__ __forceinline__ void a_ready(const Unit&) const {}
    __device__ __forceinline__ void done(const Unit&) const {}
};

__device__ __forceinline__ unsigned cvt_pk_bf16(float lo, float hi) { unsigned r; asm volatile("v_cvt_pk_bf16_f32 %0, %1, %2" : "=v"(r) : "v"(lo), "v"(hi)); return r; }
typedef float f32x2 __attribute__((ext_vector_type(2)));
__device__ __forceinline__ f32x2 gelu_pk(f32x2 v) {
    const f32x2 av = __builtin_elementwise_abs(v), d = av * 0.2316418882f + 1.0f;
    f32x2 t; t.x = __builtin_amdgcn_rcpf(d.x); t.y = __builtin_amdgcn_rcpf(d.y);
    f32x2 q = t * 0.5307027145f + (-0.7265760135f); q = q * t + 0.7107068705f; q = q * t + (-0.142248368f); q = q * t + 0.127414796f; q = q * t;
    const f32x2 s = (v * v) * (-0.72134752044f);
    f32x2 e; e.x = __builtin_amdgcn_exp2f(s.x); e.y = __builtin_amdgcn_exp2f(s.y);
    const f32x2 m = v * (q * e), r = v - m;
    f32x2 o; o.x = v.x < 0.f ? m.x : r.x; o.y = v.y < 0.f ? m.y : r.y; return o;
}

template <class Epi, class Sched, bool ALIGN_EPI = false, bool SP2 = false>
__device__ __forceinline__ void gemm_phase(PG8_LAS unsigned char* lds, const Gemm g, const Sched& S, const Epi& E) {
    const int tid = mk_tid(), wid = __builtin_amdgcn_readfirstlane(tid >> 6), lane = tid & 63, wr = wid >> 2, wc = wid & 3, fr = lane & 15, fq = lane >> 4;
    const int K = g.K, nt = K / BK;
    unsigned voffA[2], voffB[2];
#pragma unroll
    for (int i = 0; i < 2; ++i) { int R, C; stage_rc(tid * 16 + i * 8192, R, C); const int Rb = Epi::PERM ? ((R & ~31) + perm32(R & 31)) : R;
        voffA[i] = (unsigned)(R * g.lda + C) * 2u; voffB[i] = (unsigned)(Rb * g.ldb + C) * 2u; }
    const size_t kstep = (size_t)(BK * 2);
    const size_t hstepA = (size_t)HALF * g.lda * 2, hstepB = (size_t)HALF * g.ldb * 2;
    const unsigned ldsw = (unsigned)wid * 1024u;
    const int aoff = lds_byte(wr * 64 + fr, fq * 8), boff = lds_byte(wc * 32 + fr, fq * 8);
#define PG8_SA(b, h) (((b) * 2 + (h)) * HTB)
#define PG8_SB(b, h) ((4 + (b) * 2 + (h)) * HTB)
#define PG8_STAGE(bufoff, gbase, voff) do { _Pragma("unroll") for (int _i = 0; _i < 2; ++_i) \
        __builtin_amdgcn_global_load_lds((const unsigned*)((const char*)(gbase) + (voff)[_i]), (PG8_LAS unsigned*)(lds + (bufoff) + ldsw + _i * 8192), 16, 0, 0); } while (0)
#define PG8_LDA(dst, b, h) do { _Pragma("unroll") for (int m = 0; m < 4; ++m) _Pragma("unroll") for (int k = 0; k < 2; ++k) dst[m][k] = *(const PG8_LAS bf16x8*)(lds + PG8_SA(b, h) + aoff + m * 2048 + k * 1024); } while (0)
#define PG8_LDB(dst, b, h) do { _Pragma("unroll") for (int n = 0; n < 2; ++n) _Pragma("unroll") for (int k = 0; k < 2; ++k) dst[n][k] = *(const PG8_LAS bf16x8*)(lds + PG8_SB(b, h) + boff + n * 2048 + k * 1024); } while (0)
#define PG8_MMA(ai, bj, At, Bt) do { __builtin_amdgcn_s_setprio(1); _Pragma("unroll") for (int m = 0; m < 4; ++m) _Pragma("unroll") for (int n = 0; n < 2; ++n) _Pragma("unroll") for (int k = 0; k < 2; ++k) \
        acc[ai][bj][m][n] = __builtin_amdgcn_mfma_f32_16x16x32_bf16(Bt[n][k], At[m][k], acc[ai][bj][m][n], 0, 0, 0); __builtin_amdgcn_s_setprio(0); } while (0)
#define PG8_WAIT_V(n) asm volatile("s_waitcnt vmcnt(" #n ")" ::: "memory")
#define PG8_WAIT_L(n) asm volatile("s_waitcnt lgkmcnt(" #n ")" ::: "memory")
#define PG8_BAR __builtin_amdgcn_s_barrier()
#define PG8_SCHED __builtin_amdgcn_sched_barrier(0)
    Unit cur, nxt; int ui = 0;
    if (!S.next(0, cur)) return;
    f32x4 acc[2][2][4][2];
#pragma unroll
    for (int a = 0; a < 2; ++a)
#pragma unroll
        for (int b = 0; b < 2; ++b)
#pragma unroll
            for (int m = 0; m < 4; ++m)
#pragma unroll
                for (int n = 0; n < 2; ++n) acc[a][b][m][n] = (f32x4){0.f, 0.f, 0.f, 0.f};
    bf16x8 At[4][2], B0[2][2], B1[2][2];
    const char* cA = S.aptr(cur); const char* cB = S.bptr(cur);
    S.a_ready(cur);
    if constexpr (SP2) {
        PG8_STAGE(PG8_SB(0, 0), cB, voffB); PG8_STAGE(PG8_SB(0, 1), cB + hstepB, voffB); PG8_STAGE(PG8_SA(0, 0), cA, voffA); PG8_STAGE(PG8_SA(0, 1), cA + hstepA, voffA);
        if (wr == 1) PG8_BAR;
        PG8_WAIT_V(2); PG8_BAR;
        PG8_STAGE(PG8_SB(1, 0), cB + kstep, voffB); PG8_STAGE(PG8_SA(1, 0), cA + kstep, voffA); PG8_STAGE(PG8_SB(1, 1), cB + hstepB + kstep, voffB);
        PG8_WAIT_V(6); PG8_BAR;
    } else {
        PG8_STAGE(PG8_SB(0, 0), cB, voffB); PG8_STAGE(PG8_SA(0, 0), cA, voffA); PG8_STAGE(PG8_SB(0, 1), cB + hstepB, voffB); PG8_STAGE(PG8_SA(0, 1), cA + hstepA, voffA);
        if (wr == 1) PG8_BAR;
        PG8_WAIT_V(4); PG8_BAR;
        PG8_STAGE(PG8_SB(1, 0), cB + kstep, voffB); PG8_STAGE(PG8_SA(1, 0), cA + kstep, voffA); PG8_STAGE(PG8_SB(1, 1), cB + hstepB + kstep, voffB);
        PG8_WAIT_V(6); PG8_BAR;
    }
    for (;;) {
        const bool has_next = S.next(ui + 1, nxt);
        const char* nA = has_next ? S.aptr(nxt) : cA; const char* nB = has_next ? S.bptr(nxt) : cB;
        for (int t = 0; t < nt; t += 2) {
            const bool last = (t == nt - 2);
            const char* a1 = cA + (size_t)(t + 1) * kstep;
            const char* a2 = last ? nA : cA + (size_t)(t + 2) * kstep; const char* b2 = last ? nB : cB + (size_t)(t + 2) * kstep;
            const char* a3 = a2 + kstep; const char* b3 = b2 + kstep;
            if (last && has_next) S.a_ready(nxt);
            if constexpr (SP2) {
            PG8_LDB(B0, 0, 0); PG8_LDB(B1, 0, 1); PG8_SCHED; PG8_LDA(At, 0, 0); PG8_STAGE(PG8_SA(1, 1), a1 + hstepA, voffA);
            PG8_WAIT_V(8); PG8_WAIT_L(0); PG8_BAR; PG8_MMA(0, 0, At, B0); PG8_MMA(0, 1, At, B1); PG8_BAR; PG8_SCHED;
            PG8_LDA(At, 0, 1); PG8_STAGE(PG8_SB(0, 0), b2, voffB); PG8_STAGE(PG8_SB(0, 1), b2 + hstepB, voffB); PG8_STAGE(PG8_SA(0, 0), a2, voffA);
            PG8_WAIT_V(8); PG8_WAIT_L(0); PG8_BAR; PG8_MMA(1, 0, At, B0); PG8_MMA(1, 1, At, B1); PG8_BAR; PG8_SCHED;
            PG8_LDB(B0, 1, 0); PG8_LDB(B1, 1, 1); PG8_SCHED; PG8_LDA(At, 1, 0); PG8_STAGE(PG8_SA(0, 1), a2 + hstepA, voffA);
            PG8_WAIT_V(8); PG8_WAIT_L(0); PG8_BAR; PG8_MMA(0, 0, At, B0); PG8_MMA(0, 1, At, B1); PG8_BAR; PG8_SCHED;
            PG8_LDA(At, 1, 1); PG8_STAGE(PG8_SB(1, 0), b3, voffB); PG8_STAGE(PG8_SB(1, 1), b3 + hstepB, voffB); PG8_STAGE(PG8_SA(1, 0), a3, voffA);
            PG8_WAIT_V(8); PG8_WAIT_L(0); PG8_BAR; PG8_MMA(1, 0, At, B0); PG8_MMA(1, 1, At, B1); PG8_BAR; PG8_SCHED;
            } else {
            PG8_LDB(B0, 0, 0); PG8_SCHED; PG8_LDA(At, 0, 0); PG8_STAGE(PG8_SA(1, 1), a1 + hstepA, voffA);
            PG8_WAIT_L(8); PG8_BAR; PG8_WAIT_L(0); PG8_MMA(0, 0, At, B0); PG8_BAR; PG8_SCHED;
            PG8_LDB(B1, 0, 1); PG8_STAGE(PG8_SB(0, 0), b2, voffB);
            PG8_BAR; PG8_WAIT_L(0); PG8_MMA(0, 1, At, B1); PG8_BAR;
            PG8_LDA(At, 0, 1); PG8_STAGE(PG8_SA(0, 0), a2, voffA);
            PG8_BAR; PG8_WAIT_L(0); PG8_MMA(1, 0, At, B0); PG8_BAR; PG8_SCHED;
            PG8_STAGE(PG8_SB(0, 1), b2 + hstepB, voffB);
            PG8_WAIT_V(6); PG8_BAR; PG8_MMA(1, 1, At, B1); PG8_BAR;
            PG8_LDB(B0, 1, 0); PG8_SCHED; PG8_LDA(At, 1, 0); PG8_STAGE(PG8_SA(0, 1), a2 + hstepA, voffA);
            PG8_WAIT_L(8); PG8_BAR; PG8_WAIT_L(0); PG8_MMA(0, 0, At, B0); PG8_BAR; PG8_SCHED;
            PG8_LDB(B1, 1, 1); PG8_STAGE(PG8_SB(1, 0), b3, voffB);
            PG8_BAR; PG8_WAIT_L(0); PG8_MMA(0, 1, At, B1); PG8_BAR;
            PG8_LDA(At, 1, 1); PG8_STAGE(PG8_SA(1, 0), a3, voffA);
            PG8_BAR; PG8_WAIT_L(0); PG8_MMA(1, 0, At, B0); PG8_BAR; PG8_SCHED;
            PG8_STAGE(PG8_SB(1, 1), b3 + hstepB, voffB);
            PG8_WAIT_V(6); PG8_BAR; PG8_MMA(1, 1, At, B1); PG8_BAR;
            }
        }
        if constexpr (ALIGN_EPI) { if (wr == 0) PG8_BAR; }
        if constexpr (!Epi::AFTER_DRAIN) { int fr_ = fr, fq_ = fq; asm volatile("" : "+v"(fr_), "+v"(fq_));   E(acc, cur, wr, wc, fr_, fq_); S.done(cur); }
        if (!has_next) break;
#pragma unroll
        for (int a = 0; a < 2; ++a)
#pragma unroll
            for (int b = 0; b < 2; ++b)
#pragma unroll
                for (int m = 0; m < 4; ++m)
#pragma unroll
                    for (int n = 0; n < 2; ++n) acc[a][b][m][n] = (f32x4){0.f, 0.f, 0.f, 0.f};
        cur = nxt; cA = nA; cB = nB; ++ui;
        if constexpr (ALIGN_EPI) { if (wr == 1) PG8_BAR; }
    }
    PG8_WAIT_V(0);
    if constexpr (!ALIGN_EPI) { if (wr == 0) PG8_BAR; }
    PG8_BAR;
    if constexpr (Epi::AFTER_DRAIN) { E.fused(acc, cur, wr, wc, fr, fq, lds, wid, lane); S.done(cur); }
#undef PG8_SA
#undef PG8_SB
#undef PG8_STAGE
#undef PG8_LDA
#undef PG8_LDB
#undef PG8_MMA
#undef PG8_WAIT_V
#undef PG8_WAIT_L
#undef PG8_BAR
#undef PG8_SCHED
}
}
#include <hip/hip_bf16.h>
#include <cmath>
namespace attn_body {
using bf16=__hip_bfloat16;
using bf16x8=__attribute__((ext_vector_type(8)))short;
using s16x4=__attribute__((ext_vector_type(4)))short;
using f32x16=__attribute__((ext_vector_type(16)))float;
using u32x4=__attribute__((ext_vector_type(4)))unsigned;
constexpr int BATCH=2,NHEAD=16,SEQ=8192,D=64,DM=NHEAD*D;
constexpr int NW=8,QBLK=32,QB=QBLK*NW,KVBLK=64,NQB=SEQ/QB;
constexpr int ATTN_PITCH=DM, ATTN_UNIT_ROWS=QB;
__device__ __forceinline__ int crow(int r,int hi){return (r&3)+8*(r>>2)+4*hi;}
#define SBAR() __builtin_amdgcn_sched_barrier(0)
__device__ __forceinline__ void cmask(f32x16&p0,f32x16&p1,int jb,int qrel,int hi){
  const float NEG=-INFINITY; int kb=64*jb+4*hi;
  #pragma unroll
  for(int r=0;r<16;++r){int kv=kb+(r&3)+8*(r>>2); if(kv>qrel)p0[r]=NEG; if(kv+32>qrel)p1[r]=NEG;}
}

constexpr int NSLOT=3, SLOTB=8192;
constexpr int LDS_K=0, LDS_V=NSLOT*SLOTB, LDS_WS=2*NSLOT*SLOTB, LDS_OST=LDS_WS+NW*64*4, LDS_BYTES=LDS_OST+NW*4096;
constexpr int BIAS_OFF=86016;
constexpr float C2=0.125f*1.4426950408889634f;
__device__ __forceinline__ void glds16(const void*gsrc,unsigned lds_dst){unsigned keep;
  asm volatile("s_mov_b32 %0, m0\n\ts_mov_b32 m0, %2\n\ts_nop 0\n\tglobal_load_lds_dwordx4 %1, off\n\ts_mov_b32 m0, %0":"=&s"(keep):"v"(gsrc),"s"(lds_dst):"memory");}
__device__ __forceinline__ float max3f(float a,float b,float c){float r;asm("v_max3_f32 %0, %1, %2, %3":"=v"(r):"v"(a),"v"(b),"v"(c));return r;}
__device__ __forceinline__ float max2f(float a,float b){float r;asm("v_max_f32_e32 %0, %1, %2":"=v"(r):"v"(a),"v"(b));return r;}
__device__ __forceinline__ float fadd_s(float a,float b){float r;asm("v_add_f32_e32 %0, %1, %2":"=v"(r):"v"(a),"v"(b));return r;}
__device__ __forceinline__ float fsub_s(float a,float b){float r;asm("v_sub_f32_e32 %0, %1, %2":"=v"(r):"v"(a),"v"(b));return r;}
typedef float f32x2_t __attribute__((ext_vector_type(2))); typedef __bf16 bf16x2_t __attribute__((ext_vector_type(2)));
__device__ __forceinline__ unsigned cvtpk_s(float lo,float hi){f32x2_t v={lo,hi};bf16x2_t b=__builtin_convertvector(v,bf16x2_t);return __builtin_bit_cast(unsigned,b);}
#define WAIT_BAR(N) asm volatile("s_waitcnt vmcnt(" #N ") lgkmcnt(0)\n\ts_barrier":::"memory")

__device__ __forceinline__ void qkt(f32x16&p0,f32x16&p1,const char*Kslot,const bf16x8*qr,const f32x16&negm,int r32,int hi){
  const char*kb=Kslot+hi*1024+r32*16;
  #pragma unroll
  for(int d0=0;d0<4;++d0){
    const bf16x8 b0=*reinterpret_cast<const bf16x8*>(kb+d0*2048);
    const bf16x8 b1=*reinterpret_cast<const bf16x8*>(kb+d0*2048+512);
    if(d0==0){p0=__builtin_amdgcn_mfma_f32_32x32x16_bf16(b0,qr[0],negm,0,0,0);p1=__builtin_amdgcn_mfma_f32_32x32x16_bf16(b1,qr[0],negm,0,0,0);}
    else{p0=__builtin_amdgcn_mfma_f32_32x32x16_bf16(b0,qr[d0],p0,0,0,0);p1=__builtin_amdgcn_mfma_f32_32x32x16_bf16(b1,qr[d0],p1,0,0,0);}}
}
typedef __attribute__((address_space(3))) const char* lds_cptr;
typedef short v4i16_t __attribute__((ext_vector_type(4)));
__device__ __forceinline__ void kload8(bf16x8*kf,lds_cptr kp){
  kf[0]=*(const __attribute__((address_space(3))) bf16x8*)(kp);      kf[1]=*(const __attribute__((address_space(3))) bf16x8*)(kp+512);
  kf[2]=*(const __attribute__((address_space(3))) bf16x8*)(kp+2048); kf[3]=*(const __attribute__((address_space(3))) bf16x8*)(kp+2560);
  kf[4]=*(const __attribute__((address_space(3))) bf16x8*)(kp+4096); kf[5]=*(const __attribute__((address_space(3))) bf16x8*)(kp+4608);
  kf[6]=*(const __attribute__((address_space(3))) bf16x8*)(kp+6144); kf[7]=*(const __attribute__((address_space(3))) bf16x8*)(kp+6656);
}
__device__ __forceinline__ void kload2(bf16x8*kf,lds_cptr kp,int j){ kf[2*j]=*(const __attribute__((address_space(3))) bf16x8*)(kp+j*2048); kf[2*j+1]=*(const __attribute__((address_space(3))) bf16x8*)(kp+j*2048+512); }
__device__ __forceinline__ s16x4 vtr(lds_cptr p){ return __builtin_bit_cast(s16x4,__builtin_amdgcn_ds_read_tr16_b64_v4i16((__attribute__((address_space(3))) v4i16_t*)p)); }
__device__ __forceinline__ float rowmax(const f32x16&p0,const f32x16&p1){
  float a=max3f(p0[0],p0[1],p1[0]),b=max3f(p0[2],p0[3],p1[1]);a=max3f(a,p1[2],p1[3]);
  #pragma unroll
  for(int r=4;r<16;r+=4){a=max3f(a,p0[r],p0[r+1]);b=max3f(b,p0[r+2],p0[r+3]);a=max3f(a,p1[r],p1[r+1]);b=max3f(b,p1[r+2],p1[r+3]);}
  const float m=max2f(a,b);
  auto rr=__builtin_amdgcn_permlane32_swap(__float_as_uint(m),__float_as_uint(m),false,false);
  return max2f(__uint_as_float(rr[0]),__uint_as_float(rr[1]));
}
__device__ __forceinline__ void pv(f32x16*o,int vb,bf16x8 pa0,bf16x8 pa1,bf16x8 pa2,bf16x8 pa3){
  #pragma unroll
  for(int d0=0;d0<2;++d0){s16x4 lo[4],hi[4];
    #pragma unroll
    for(int ks=0;ks<4;++ks){
      asm volatile("ds_read_b64_tr_b16 %0,%1 offset:%c2":"=&v"(lo[ks]):"v"(vb),"i"(d0*4096+ks*1024):"memory");
      asm volatile("ds_read_b64_tr_b16 %0,%1 offset:%c2":"=&v"(hi[ks]):"v"(vb),"i"(d0*4096+ks*1024+512):"memory");}
    asm volatile("s_waitcnt lgkmcnt(0)":::"memory");SBAR();
    #define PK(k) (bf16x8){lo[k][0],lo[k][1],lo[k][2],lo[k][3],hi[k][0],hi[k][1],hi[k][2],hi[k][3]}
    o[d0]=__builtin_amdgcn_mfma_f32_32x32x16_bf16(pa0,PK(0),o[d0],0,0,0);
    o[d0]=__builtin_amdgcn_mfma_f32_32x32x16_bf16(pa1,PK(1),o[d0],0,0,0);
    o[d0]=__builtin_amdgcn_mfma_f32_32x32x16_bf16(pa2,PK(2),o[d0],0,0,0);
    o[d0]=__builtin_amdgcn_mfma_f32_32x32x16_bf16(pa3,PK(3),o[d0],0,0,0);
    #undef PK
  }
}

#ifndef ATTN_STORE16
#define ATTN_STORE16(p,v) (*(u32x4*)(p)=(v))
#endif
template<int THRL> __device__ __forceinline__ void attn_unit(int b,int h,int qb,const bf16*Q,const bf16*__restrict__ K,const bf16*__restrict__ V,bf16*O,const float*__restrict__ FBrow,float skip_thr,char*shm){
  const int tid=mk_tid(),lane=tid&63,r32=lane&31,hi=lane>>5; const int wid=__builtin_amdgcn_readfirstlane(tid>>6);
  const long rowbase=(long)b*SEQ; const int q0=qb*QB;
  int t_start=0;
  { const int ntf=(q0+QB)/KVBLK; const float Fq0=FBrow[q0];
    const bool c0=lane<ntf&&(Fq0-FBrow[64*(lane<ntf?lane:0)+63])*1.4426950408889634f<skip_thr;
    const bool c1=(lane+64)<ntf&&(Fq0-FBrow[64*((lane+64)<ntf?lane+64:0)+63])*1.4426950408889634f<skip_thr;
    int cnt=__popcll(__ballot(c0))+__popcll(__ballot(c1)); cnt&=~1; if(cnt>ntf-4)cnt=ntf-4; t_start=__builtin_amdgcn_readfirstlane(cnt); }
  const bf16*Qw=Q+(rowbase+q0+wid*QBLK)*DM+h*D;
  const bf16*Kh=K+(rowbase+(long)t_start*KVBLK)*DM+h*D,*Vh=V+(rowbase+(long)t_start*KVBLK)*DM+h*D;
  const lds_cptr shm3=(lds_cptr)shm;
  const unsigned lds0=(unsigned)(uintptr_t)shm;
  float*wsf=(float*)(shm+LDS_WS)+wid*64;
  const bf16*ksrc=Kh+(long)lane*DM+wid*8;
  const bf16*vsrc=Vh+(long)(16*(wid&3)+(lane>>2))*DM+(wid>>2)*32+(lane&3)*8;
  const unsigned kdst=lds0+LDS_K+wid*1024, vdst=lds0+LDS_V+wid*1024;
  #define DMA_K(t,slot) glds16(ksrc+(long)(t)*KVBLK*DM,(unsigned)__builtin_amdgcn_readfirstlane(kdst+(slot)))
  #define DMA_V(t,slot) glds16(vsrc+(long)(t)*KVBLK*DM,(unsigned)__builtin_amdgcn_readfirstlane(vdst+(slot)))
  const int vb0=(int)(lds0+LDS_V)+((lane>>4)&1)*32+(lane&3)*8+(4*hi+((lane&15)>>2))*64;
  const char*Kbase=shm+LDS_K; bf16x8 kf[8];
  const lds_cptr kp0=shm3+LDS_K+hi*1024+r32*16; const lds_cptr vp0=shm3+LDS_V+((lane>>4)&1)*32+(lane&3)*8+(4*hi+((lane&15)>>2))*64;
  const int NT=(q0+QB)/KVBLK-t_start;
  {
    typedef __attribute__((address_space(3))) float lds_f32; lds_f32* bl=(lds_f32*)(shm3+BIAS_OFF);
    const int nb=q0+QB; const float Fl=FBrow[nb-1];
    for(int i=t_start*KVBLK+tid;i<nb;i+=NW*64) bl[i]=(Fl-FBrow[i])*1.4426950408889634f;
    asm volatile("s_waitcnt vmcnt(0) lgkmcnt(0)\n\ts_barrier":::"memory"); }
  typedef float f32x4v __attribute__((ext_vector_type(4)));
  #define BIAS(P0,P1,t) do{ const __attribute__((address_space(3))) f32x4v* bp_=(const __attribute__((address_space(3))) f32x4v*)(shm3+BIAS_OFF)+((t)+t_start)*16+hi; \
    _Pragma("unroll") for(int g_=0;g_<4;++g_){ const f32x4v f0_=bp_[2*g_]+nm, f1_=bp_[8+2*g_]+nm; \
      P0[4*g_]+=f0_[0];P0[4*g_+1]+=f0_[1];P0[4*g_+2]+=f0_[2];P0[4*g_+3]+=f0_[3]; P1[4*g_]+=f1_[0];P1[4*g_+1]+=f1_[1];P1[4*g_+2]+=f1_[2];P1[4*g_+3]+=f1_[3]; } }while(0)
  DMA_K(0,0);DMA_V(0,0);DMA_K(1,SLOTB);
  bf16x8 qr[4];
  #pragma unroll
  for(int d0=0;d0<4;++d0)qr[d0]=*reinterpret_cast<const bf16x8*>(&Qw[(long)r32*DM+d0*16+hi*8]);
  float mhat=0.f,l_reg=0.f;f32x16 o[2];o[0]=f32x16{};o[1]=f32x16{};const f32x16 negm=f32x16{}; float nm=0.f;
  const int qrel=wid*QBLK+r32;
  #define CMASK(P0,P1,t) do{int jb_=(t)-(NT-4); if(jb_>=0)cmask(P0,P1,jb_,qrel,hi);}while(0)
  bool resc=false;
  #define START(P0,P1) do{ const float rm=rowmax(P0,P1); resc=false; \
    { const float dl=rm; mhat=fadd_s(mhat,dl); \
      _Pragma("unroll") for(int r=0;r<16;++r){P0[r]=fsub_s(P0[r],dl);P1[r]=fsub_s(P1[r],dl);} \
      nm=-mhat; } \
    _Pragma("unroll") for(int r=0;r<16;++r)P0[r]=__builtin_amdgcn_exp2f(P0[r]); }while(0)
  #define RESC() do{ if(resc){ asm volatile("s_waitcnt lgkmcnt(0)":::"memory"); \
      _Pragma("unroll") for(int d_=0;d_<2;++d_) _Pragma("unroll") for(int r=0;r<16;++r)o[d_][r]*=wsf[crow(r,hi)]; } }while(0)
  f32x16 pA0,pA1,pB0,pB1;
  int sl_prev=0,sl_cur=0,sl_next=SLOTB;
  #define ROT() do{sl_prev=sl_cur;sl_cur=sl_next;sl_next=(sl_next==(NSLOT-1)*SLOTB)?0:sl_next+SLOTB;}while(0)
  DMA_K(2,2*SLOTB);
  WAIT_BAR(3);
  qkt(pA0,pA1,Kbase,qr,negm,r32,hi);asm volatile("s_nop 15\n\ts_nop 7":"+v"(pA0),"+v"(pA1));BIAS(pA0,pA1,0);CMASK(pA0,pA1,0);
  START(pA0,pA1);
  _Pragma("unroll") for(int r=0;r<16;++r)pA1[r]=__builtin_amdgcn_exp2f(pA1[r]);
  WAIT_BAR(0);
  DMA_K(3,0);DMA_V(1,SLOTB);
  ROT();
  kload8(kf,kp0+sl_cur);
  WAIT_BAR(2);
  s16x4 vlo[8],vhi[8]; u32x4 pw0,pw1,pw2,pw3;
  #define PKW(P,B) cvtpk_s(P[B],P[B+1])
  #define PAF(k) __builtin_bit_cast(bf16x8,pw##k)
  #define VFR(i) (bf16x8){vlo[i][0],vlo[i][1],vlo[i][2],vlo[i][3],vhi[i][0],vhi[i][1],vhi[i][2],vhi[i][3]}
  #define PIN(x) asm volatile("":"+v"(x))
  #define MX3(a,b,c) __builtin_fmaxf(__builtin_fmaxf((a),(b)),(c))
  #define GAPA(MF,A0,A1,A2,A3,W0,W1,PW) do{ MF; sacc+=A0; sacc+=A1; sacc+=A2; sacc+=A3; PIN(sacc); W0; W1; PIN(PW); SBAR(); }while(0)
  #define EX(v) __builtin_amdgcn_exp2f(v)
  #define GAPB(MF,X,B) do{ MF; X[B]=EX(X[B]); X[B+1]=EX(X[B+1]); X[B+2]=EX(X[B+2]); X[B+3]=EX(X[B+3]); PIN(X); SBAR(); }while(0)
  #define VRD(i) do{ vlo[i]=vtr(vp_+(((i)>>2)*4096+((i)&3)*1024)); vhi[i]=vtr(vp_+(((i)>>2)*4096+((i)&3)*1024+512)); }while(0)
  #define KRD(G,j) do{ if(G){ kload2(kf,kp0+sl_next,j); SBAR(); } }while(0)
  #define STEP(C0,C1,P0,P1,t,GK,GV,GL) do{ SBAR(); \
    const lds_cptr vp_=vp0+sl_prev; \
    VRD(0); SBAR(); float sacc=(P0[0]+P0[1]); \
    GAPA(C0=__builtin_amdgcn_mfma_f32_32x32x16_bf16(kf[0],qr[0],negm,0,0,0), P0[2],P0[3],P0[4],P0[5],     pw0[0]=PKW(P0,0), pw0[1]=PKW(P0,2), pw0); \
    VRD(4); SBAR(); GAPA(C1=__builtin_amdgcn_mfma_f32_32x32x16_bf16(kf[1],qr[0],negm,0,0,0), P0[6],P0[7],P0[8],P0[9],     pw0[2]=PKW(P0,4), pw0[3]=PKW(P0,6), pw0); \
    VRD(1); SBAR(); GAPA(C0=__builtin_amdgcn_mfma_f32_32x32x16_bf16(kf[2],qr[1],C0,0,0,0),   P0[10],P0[11],P0[12],P0[13], pw1[0]=PKW(P0,8), pw1[1]=PKW(P0,10), pw1); \
    VRD(5); SBAR(); GAPA(C1=__builtin_amdgcn_mfma_f32_32x32x16_bf16(kf[3],qr[1],C1,0,0,0),   P0[14],P0[15],P1[0],P1[1],   pw1[2]=PKW(P0,12),pw1[3]=PKW(P0,14), pw1); \
    VRD(2); SBAR(); GAPA(C0=__builtin_amdgcn_mfma_f32_32x32x16_bf16(kf[4],qr[2],C0,0,0,0),   P1[2],P1[3],P1[4],P1[5],     pw2[0]=PKW(P1,0), pw2[1]=PKW(P1,2), pw2); \
    VRD(6); SBAR(); GAPA(C1=__builtin_amdgcn_mfma_f32_32x32x16_bf16(kf[5],qr[2],C1,0,0,0),   P1[6],P1[7],P1[8],P1[9],     pw2[2]=PKW(P1,4), pw2[3]=PKW(P1,6), pw2); \
    VRD(3); SBAR(); GAPA(C0=__builtin_amdgcn_mfma_f32_32x32x16_bf16(kf[6],qr[3],C0,0,0,0),   P1[10],P1[11],P1[12],P1[13], pw3[0]=PKW(P1,8), pw3[1]=PKW(P1,10), pw3); \
    VRD(7); SBAR(); GAPA(C1=__builtin_amdgcn_mfma_f32_32x32x16_bf16(kf[7],qr[3],C1,0,0,0),   P1[14],P1[15],0.f,0.f,       pw3[2]=PKW(P1,12),pw3[3]=PKW(P1,14), pw3); \
    l_reg+=sacc; \
    if(GK){DMA_K((t)+3,sl_cur);} if(GV){DMA_V((t)+1,sl_next);} \
    BIAS(C0,C1,t); CMASK(C0,C1,t); \
    { float a=MX3(C0[0],C0[1],C1[0]),b=MX3(C0[2],C0[3],C1[1]); a=MX3(a,C1[2],C1[3]); \
      _Pragma("unroll") for(int r=4;r<16;r+=4){a=MX3(a,C0[r],C0[r+1]);b=MX3(b,C0[r+2],C0[r+3]);a=MX3(a,C1[r],C1[r+1]);b=MX3(b,C1[r+2],C1[r+3]);} \
      float rm=__builtin_fmaxf(a,b); { auto rr=__builtin_amdgcn_permlane32_swap(__float_as_uint(rm),__float_as_uint(rm),false,false); rm=__builtin_fmaxf(__uint_as_float(rr[0]),__uint_as_float(rr[1])); } \
      resc=false; \
      if(__builtin_expect(__any(rm>(float)THRL),0)){ const float dl=__builtin_fmaxf(rm,0.f); mhat+=dl; \
        _Pragma("unroll") for(int r=0;r<16;++r){C0[r]-=dl;C1[r]-=dl;} \
        nm=-mhat; \
        const float f=__builtin_amdgcn_exp2f(-dl); l_reg*=f; if(hi==0)wsf[r32]=f; resc=true; } } \
    SBAR(); \
    GAPB(o[0]=__builtin_amdgcn_mfma_f32_32x32x16_bf16(PAF(0),VFR(0),o[0],0,0,0), C0,0); \
    GAPB(o[1]=__builtin_amdgcn_mfma_f32_32x32x16_bf16(PAF(0),VFR(4),o[1],0,0,0), C0,4); \
    KRD(GL,0); GAPB(o[0]=__builtin_amdgcn_mfma_f32_32x32x16_bf16(PAF(1),VFR(1),o[0],0,0,0), C0,8); \
    KRD(GL,1); GAPB(o[1]=__builtin_amdgcn_mfma_f32_32x32x16_bf16(PAF(1),VFR(5),o[1],0,0,0), C0,12); \
    KRD(GL,2); GAPB(o[0]=__builtin_amdgcn_mfma_f32_32x32x16_bf16(PAF(2),VFR(2),o[0],0,0,0), C1,0); \
    KRD(GL,3); GAPB(o[1]=__builtin_amdgcn_mfma_f32_32x32x16_bf16(PAF(2),VFR(6),o[1],0,0,0), C1,4); \
    GAPB(o[0]=__builtin_amdgcn_mfma_f32_32x32x16_bf16(PAF(3),VFR(3),o[0],0,0,0), C1,8); \
    GAPB(o[1]=__builtin_amdgcn_mfma_f32_32x32x16_bf16(PAF(3),VFR(7),o[1],0,0,0), C1,12); \
    }while(0)
  int t=1;
  #undef CMASK
  #define CMASK(P0,P1,t) do{}while(0)
  for(;t+5<NT;t+=2){
    STEP(pB0,pB1,pA0,pA1,t,true,true,true);     WAIT_BAR(2); RESC(); ROT();
    STEP(pA0,pA1,pB0,pB1,t+1,true,true,true);   WAIT_BAR(2); RESC(); ROT();
  }
  #undef CMASK
  #define CMASK(P0,P1,t) do{int jb_=(t)-(NT-4); if(jb_>=0)cmask(P0,P1,jb_,qrel,hi);}while(0)
  #define ENDW(tt) do{ if((tt)+3<NT){WAIT_BAR(2);} else if((tt)+2<NT){WAIT_BAR(1);} else {WAIT_BAR(0);} }while(0)
  for(;t+1<NT;t+=2){
    STEP(pB0,pB1,pA0,pA1,t,(t+3<NT),(t+1<NT),(t+1<NT));       ENDW(t);   RESC(); ROT();
    STEP(pA0,pA1,pB0,pB1,t+1,(t+4<NT),(t+2<NT),(t+2<NT));     ENDW(t+1); RESC(); ROT();
  }
  STEP(pB0,pB1,pA0,pA1,NT-1,false,false,false); RESC();
  { float sacc=pB0[0]+pB0[1]; _Pragma("unroll") for(int r=2;r<16;++r)sacc+=pB0[r]; _Pragma("unroll") for(int r=0;r<16;++r)sacc+=pB1[r]; l_reg+=sacc;
    pw0=(u32x4){PKW(pB0,0),PKW(pB0,2),PKW(pB0,4),PKW(pB0,6)};pw1=(u32x4){PKW(pB0,8),PKW(pB0,10),PKW(pB0,12),PKW(pB0,14)};pw2=(u32x4){PKW(pB1,0),PKW(pB1,2),PKW(pB1,4),PKW(pB1,6)};pw3=(u32x4){PKW(pB1,8),PKW(pB1,10),PKW(pB1,12),PKW(pB1,14)};
    SBAR(); pv(o,vb0+sl_cur,PAF(0),PAF(1),PAF(2),PAF(3)); }
  #undef PKW
  #undef PAF
  #undef VFR
  #undef PIN
  #undef MX3
  #undef GAPA
  #undef GAPB
  #undef EX
  #undef VRD
  #undef KRD
  #undef STEP
  #undef ENDW
  {auto rr=__builtin_amdgcn_permlane32_swap(__float_as_uint(l_reg),__float_as_uint(l_reg),false,false);l_reg=__uint_as_float(rr[0])+__uint_as_float(rr[1]);}
  if(hi==0)wsf[32+r32]=l_reg;asm volatile("s_waitcnt lgkmcnt(0)":::"memory");
  float rli[16];
  #pragma unroll
  for(int r=0;r<16;++r)rli[r]=__builtin_amdgcn_rcpf(wsf[32+crow(r,hi)]);
  bf16*Ow=O+(rowbase+q0+wid*QBLK)*DM+h*D;
  { bf16*stg=(bf16*)(shm+LDS_OST)+wid*2048;
    #pragma unroll
    for(int r=0;r<16;++r){const int orow=crow(r,hi);
      #pragma unroll
      for(int d0=0;d0<2;++d0)stg[orow*64+d0*32+r32]=__float2bfloat16(o[d0][r]*rli[r]);}
    asm volatile("s_waitcnt lgkmcnt(0)":::"memory");
    #pragma unroll
    for(int i=0;i<4;++i){const int row=i*8+(lane>>3),ch=lane&7; const u32x4 v=*(const u32x4*)(stg+row*64+ch*8); ATTN_STORE16(Ow+(long)row*DM+ch*8,v);} }
  asm volatile("s_waitcnt lgkmcnt(0)\n\ts_barrier":::"memory");
  #undef BIAS
  #undef DMA_K
  #undef DMA_V
  #undef CMASK
  #undef START
  #undef RESC
  #undef ROT
}
constexpr int ATTN_LDS_BYTES=86016+32768;
struct AttnTensors { const bf16* Q; const bf16* K; const bf16* V; bf16* O; const float* FB; float skip_thr; int pad; };
struct AttnUnit { int bh; int qb; };
struct StaticOrder {
  int vcu;
  __device__ __forceinline__ explicit StaticOrder(int grid,int block):vcu((block%8)*(grid/8)+block/8){}
  __device__ __forceinline__ bool next(int i,AttnUnit&u)const{ if(i>=4)return false; const int s=vcu&7; u.bh=vcu>>3; u.qb=(i==0)?s:(i==1)?15-s:(i==2)?16+s:31-s; return true; }
  __device__ __forceinline__ void a_ready(const AttnUnit&)const{}
  __device__ __forceinline__ void done(const AttnUnit&)const{}
};
struct QueueOrder {
  unsigned* ctr; int xl; volatile __attribute__((address_space(3))) int* slot;
  __device__ __forceinline__ bool next(int,AttnUnit&u)const{
    if(mk_tid()==0){ int got=-1;
      for(int k=0;k<8&&got<0;++k){ const int q=(xl+k)&7; const int j=(int)__hip_atomic_fetch_add(ctr+q*64,1u,__ATOMIC_RELAXED,__HIP_MEMORY_SCOPE_AGENT); if(j<128)got=q*128+j; }
      *slot=got; }
    __syncthreads(); const int g=*slot; if(g<0)return false; const int q=g>>7,j=g&127; u.bh=q*4+(j&3); u.qb=31-(j>>2); return true; }
  __device__ __forceinline__ void a_ready(const AttnUnit&)const{}
  __device__ __forceinline__ void done(const AttnUnit&)const{}
};
template<class Sched,int THRL=8> __device__ __forceinline__ void attn_phase(char*lds,const AttnTensors&T,const Sched&S){
  AttnUnit u;
  for(int i=0;S.next(i,u);++i){ S.a_ready(u); attn_unit<THRL>(u.bh/NHEAD,u.bh%NHEAD,u.qb,T.Q,T.K,T.V,T.O,T.FB+(size_t)u.bh*SEQ,T.skip_thr,lds); S.done(u); }
}
#undef SBAR
#undef WAIT_BAR
}
namespace cg = cooperative_groups;
#define LAS __attribute__((address_space(3)))
#define LDS_WAIT() asm volatile("s_waitcnt lgkmcnt(0)" ::: "memory")
#define LDS_BAR() asm volatile("s_waitcnt lgkmcnt(0)\n\ts_barrier" ::: "memory")
constexpr int MEGA_THREADS = 512, MEGA_LDS = 147456, NWV = 8;
#define GAS __attribute__((address_space(1)))
#define XB_TMO      128
#define XB_XCNT(j)  (256  + 64 * (j))
#define XB_XSUB(j)  (1280 + 64 * (j))
#define XB_XGEN(j)  (2304 + 64 * (j))
#define XB_TOP      3328
#define XB_TOPGEN   3392
#define XCD_BAR_WORDS 3456
#define XB_SPIN_CAP (1u << 18)

__device__ __forceinline__ unsigned xb_ld(unsigned* p)              { return __hip_atomic_load(p, __ATOMIC_RELAXED, __HIP_MEMORY_SCOPE_AGENT); }
__device__ __forceinline__ unsigned xb_add(unsigned* p, unsigned v) { return __hip_atomic_fetch_add(p, v, __ATOMIC_RELAXED, __HIP_MEMORY_SCOPE_AGENT); }
__device__ __forceinline__ unsigned xb_xcc_id() { return (unsigned)__builtin_amdgcn_s_getreg((3 << 11) | 20) & 0xFu; }
#define XB_SPIN(cond, bar) do { unsigned _sp = 0; while (cond) { __builtin_amdgcn_s_sleep(1); \
    if ((++_sp & 255u) == 0u) { if (xb_ld(&(bar)[XB_TMO])) break; if (_sp > XB_SPIN_CAP) { atomicAdd(&(bar)[XB_TMO], 1u); break; } } } } while (0)

struct XcdBarrier {
    unsigned* bar; unsigned x;
    volatile LAS unsigned* st;
};

__device__ __forceinline__ XcdBarrier xcd_barrier_post(unsigned* bar, volatile LAS unsigned* st) {
    XcdBarrier b; b.bar = bar; b.x = xb_xcc_id(); b.st = st;
    if (threadIdx.x == 0) (void)xb_add(&bar[XB_XCNT(b.x)], 1u);
    return b;
}
__device__ __forceinline__ void xcd_barrier_complete(unsigned* bar, unsigned x, unsigned& nloc, unsigned& nx) {
    const unsigned G = gridDim.x * gridDim.y * gridDim.z;
    unsigned sum, cnt, mine, sp = 0u;
    for (;;) {
        sum = 0u; cnt = 0u; mine = 0u;
#pragma unroll
        for (unsigned j = 0; j < 16; ++j) { const unsigned c = xb_ld(&bar[XB_XCNT(j)]); sum += c; cnt += (c > 0u) ? 1u : 0u; mine = (j == x) ? c : mine; }
        if (sum == G) break;
        __builtin_amdgcn_s_sleep(1);
        if ((++sp & 255u) == 0u) { if (xb_ld(&bar[XB_TMO])) break; if (sp > XB_SPIN_CAP) { atomicAdd(&bar[XB_TMO], 1u); break; } }
    }
    nloc = mine > 0u ? mine : 1u; nx = cnt > 0u ? cnt : 1u;
}

__device__ __forceinline__ void xcd_barrier(const XcdBarrier& b) {
    asm volatile("s_waitcnt vmcnt(0)" ::: "memory");
    __syncthreads();
    if (threadIdx.x == 0) {
        unsigned* bar = b.bar;
        __builtin_amdgcn_s_waitcnt(0);
        unsigned nloc = b.st[0], nx = b.st[1];
        if (nloc == 0u) { xcd_barrier_complete(bar, b.x, nloc, nx); b.st[0] = nloc; b.st[1] = nx; }
        const unsigned old = xb_add(&bar[XB_XSUB(b.x)], 1u);
        const unsigned gen = old / nloc;
        if (old + 1u == (gen + 1u) * nloc) {
            __builtin_amdgcn_fence(__ATOMIC_RELEASE, "agent");
            asm volatile("s_waitcnt vmcnt(0)" ::: "memory");
            const unsigned og = xb_add(&bar[XB_TOP], 1u);
            const unsigned tg = og / nx;
            if (og + 1u == (tg + 1u) * nx) xb_add(&bar[XB_TOPGEN], 1u);
            else XB_SPIN(xb_ld(&bar[XB_TOPGEN]) == tg, bar);
            __builtin_amdgcn_fence(__ATOMIC_ACQUIRE, "agent");
            xb_add(&bar[XB_XGEN(b.x)], 1u);
            asm volatile("s_waitcnt vmcnt(0)" ::: "memory");
        } else {
            XB_SPIN(xb_ld(&bar[XB_XGEN(b.x)]) == gen, bar);
            __builtin_amdgcn_fence(__ATOMIC_ACQUIRE, "agent");
            asm volatile("s_waitcnt vmcnt(0)" ::: "memory");
        }
    }
    __syncthreads();
}
constexpr size_t WS_BAR = WS_CTL + 16384;
constexpr size_t WS_QCTR = WS_CTL + 32768;
constexpr size_t CTL_ZERO_BYTES = 65536 - 16384;
constexpr int XB_LDS_OFF = MEGA_LDS - 64;
constexpr size_t WT_IN = 0;
constexpr size_t WT_BR = WT_IN + (size_t)13312 * 1024 * 2;
constexpr size_t WT_OUT = WT_BR + (size_t)4096 * 1024 * 2;
constexpr size_t WT_UP = WT_OUT + (size_t)1024 * 1024 * 2;
constexpr size_t WT_DN = WT_UP + (size_t)5632 * 1024 * 2;
static_assert(WT_DN + (size_t)1024 * 2816 * 2 <= 72 * MiB, "weight copies");
constexpr size_t WS_WKVT = WS_GATES;
constexpr size_t WS_CB = WS_CTL + 4096;

typedef float f32x4 __attribute__((ext_vector_type(4)));
typedef unsigned u32x4 __attribute__((ext_vector_type(4)));
typedef short bf16x8_t __attribute__((ext_vector_type(8)));
typedef float f32x16_t __attribute__((ext_vector_type(16)));
__device__ __forceinline__ unsigned pk2(float lo, float hi) { return (unsigned)f2bf(lo) | ((unsigned)f2bf(hi) << 16); }
__device__ __forceinline__ float blo(unsigned u) { return __uint_as_float(u << 16); }
__device__ __forceinline__ float bhi(unsigned u) { return __uint_as_float(u & 0xffff0000u); }
__device__ __forceinline__ float fast_softplus(float x) { return fmaxf(x, 0.f) + __logf(1.f + __expf(-fabsf(x))); }
__device__ __forceinline__ float fast_sigmoid(float x) { return __builtin_amdgcn_rcpf(1.f + __expf(-x)); }
__device__ __forceinline__ float fast_tanh(float x) { const float e = __expf(-2.f * fabsf(x)); const float t = (1.f - e) * __builtin_amdgcn_rcpf(1.f + e); return x < 0.f ? -t : t; }
__device__ __forceinline__ float fast_gelu(float x) { const float u = 0.7978845608028654f * (x + 0.044715f * x * x * x); return 0.5f * x * (1.f + fast_tanh(u)); }

template <class Loc> struct LocOrder {
    pg8::StaticOrder so; Loc loc;
    __device__ __forceinline__ bool next(int i, pg8::Unit& u) const { return so.next(i, u); }
    __device__ __forceinline__ const char* aptr(const pg8::Unit& u) const { return loc.a(u); }
    __device__ __forceinline__ const char* bptr(const pg8::Unit& u) const { return loc.b(u); }
    __device__ __forceinline__ void a_ready(const pg8::Unit&) const {}
    __device__ __forceinline__ void done(const pg8::Unit&) const {}
};
struct LocStd { const char* A; const char* Bt; size_t astep, bstep;
    __device__ __forceinline__ const char* a(const pg8::Unit& u) const { return A + (size_t)u.pm * astep; }
    __device__ __forceinline__ const char* b(const pg8::Unit& u) const { return Bt + (size_t)u.pn * bstep; } };
struct LocBranch { const char* Y0; const char* Y1; const char* Y2; const char* Y3; const char* Bt;
    __device__ __forceinline__ const char* a(const pg8::Unit& u) const { const int i = u.pn >> 2; const char* y = i == 0 ? Y0 : i == 1 ? Y1 : i == 2 ? Y2 : Y3; return y + (size_t)u.pm * (256 * 1024 * 2); }
    __device__ __forceinline__ const char* b(const pg8::Unit& u) const { return Bt + (size_t)u.pn * (256 * 1024 * 2); } };
struct LocMemKV { const char* A; const char* Bt;
    __device__ __forceinline__ const char* a(const pg8::Unit& u) const { return A + (size_t)u.pm * (256 * 1024 * 2); }
    __device__ __forceinline__ const char* b(const pg8::Unit& u) const { return Bt + ((size_t)(u.pm >> 1) * 2048 + (size_t)u.pn * 256) * 2048; } };
struct LocMemS { const char* MQ; const char* MK;
    __device__ __forceinline__ const char* a(const pg8::Unit& u) const { return MQ + (size_t)u.pm * (256 * 2048) + u.pn * 512; }
    __device__ __forceinline__ const char* b(const pg8::Unit& u) const { return MK + (size_t)(u.pm >> 5) * (256 * 2048) + u.pn * 512; } };
struct LocMemPV { const char* E; const char* MVT;
    __device__ __forceinline__ const char* a(const pg8::Unit& u) const { return E + (size_t)u.pm * (256 * 2048) + u.pn * 512; }
    __device__ __forceinline__ const char* b(const pg8::Unit& u) const { return MVT + ((size_t)(u.pm >> 5) * 4 + u.pn) * (256 * 256 * 2); } };

struct BranchSched { int vcu; LocBranch loc;
    __device__ __forceinline__ bool next(int i, pg8::Unit& u) const { if (i >= 4) return false; u.pm = vcu >> 2; u.pn = i * 4 + (vcu & 3); return true; }
    __device__ __forceinline__ const char* aptr(const pg8::Unit& u) const { return loc.a(u); }
    __device__ __forceinline__ const char* bptr(const pg8::Unit& u) const { return loc.b(u); }
    __device__ __forceinline__ void a_ready(const pg8::Unit&) const {}
    __device__ __forceinline__ void done(const pg8::Unit&) const {}
};
typedef f32x4 AccT[2][2][4][2];
struct EpiProj { static constexpr bool PERM = true, AFTER_DRAIN = false; bf16_t* proj; bf16_t* gates; float* mqss;
    __device__ __forceinline__ void operator()(const AccT& acc, const pg8::Unit& u, int wr, int wc, int fr, int fq) const {
        int colt = u.pn * 256; const int grp = colt >> 10; bf16_t* base; int ldc;
        if (grp < 9) { base = proj + (size_t)grp * T * DM; ldc = DM; colt &= 1023; } else { base = gates; ldc = 4096; colt -= 9216; }
        const int row0 = u.pm * 256 + wr * 64 + fr, col0 = colt + wc * 32 + 8 * fq;
#pragma unroll
        for (int ai = 0; ai < 2; ++ai)
#pragma unroll
            for (int m = 0; m < 4; ++m) { const int row = row0 + ai * 128 + m * 16; bf16_t* rowp = base + (size_t)row * ldc + col0; float ss = 0.f;
#pragma unroll
                for (int bj = 0; bj < 2; ++bj) { const f32x4 v0 = acc[ai][bj][m][0], v1 = acc[ai][bj][m][1]; u32x4 w; w.x = pk2(v0[0], v0[1]); w.y = pk2(v0[2], v0[3]); w.z = pk2(v1[0], v1[1]); w.w = pk2(v1[2], v1[3]);
                    *(u32x4*)(rowp + bj * 128) = w;
                    if (grp == 8) { ss += blo(w.x) * blo(w.x) + bhi(w.x) * bhi(w.x) + blo(w.y) * blo(w.y) + bhi(w.y) * bhi(w.y) + blo(w.z) * blo(w.z) + bhi(w.z) * bhi(w.z) + blo(w.w) * blo(w.w) + bhi(w.w) * bhi(w.w); } }
                if (grp == 8) { ss += __shfl_xor(ss, 16); ss += __shfl_xor(ss, 32); if (fq == 0) mqss[(size_t)row * 16 + (colt >> 8) * 4 + wc] = ss; } }
    } };
struct EpiBf16P { static constexpr bool PERM = true, AFTER_DRAIN = false; bf16_t* O; int ldc; int pad;
    __device__ __forceinline__ void operator()(const AccT& acc, const pg8::Unit& u, int wr, int wc, int fr, int fq) const {
        const int row0 = u.pm * 256 + wr * 64 + fr, col0 = u.pn * 256 + wc * 32 + 8 * fq;
#pragma unroll
        for (int ai = 0; ai < 2; ++ai)
#pragma unroll
            for (int m = 0; m < 4; ++m) { bf16_t* rowp = O + (size_t)(row0 + ai * 128 + m * 16) * ldc + col0;
#pragma unroll
                for (int bj = 0; bj < 2; ++bj) { const f32x4 v0 = acc[ai][bj][m][0], v1 = acc[ai][bj][m][1]; u32x4 w; w.x = pk2(v0[0], v0[1]); w.y = pk2(v0[2], v0[3]); w.z = pk2(v1[0], v1[1]); w.w = pk2(v1[2], v1[3]);
                    *(u32x4*)(rowp + bj * 128) = w; } }
    } };
struct EpiF32 { static constexpr bool PERM = false, AFTER_DRAIN = false; float* O; int ldc; int pad;
    __device__ __forceinline__ void operator()(const AccT& acc, const pg8::Unit& u, int wr, int wc, int fr, int fq) const {
        const int row0 = u.pm * 256 + wr * 64 + fr, col0 = u.pn * 256 + wc * 32 + 4 * fq;
#pragma unroll
        for (int ai = 0; ai < 2; ++ai)
#pragma unroll
            for (int m = 0; m < 4; ++m) { float* rowp = O + (size_t)(row0 + ai * 128 + m * 16) * ldc + col0;
#pragma unroll
                for (int bj = 0; bj < 2; ++bj)
#pragma unroll
                    for (int n = 0; n < 2; ++n) *(f32x4*)(rowp + bj * 128 + n * 16) = acc[ai][bj][m][n]; }
    } };
struct EpiResid { static constexpr bool PERM = false, AFTER_DRAIN = false; const float* base; float* out;
    __device__ __forceinline__ void operator()(const AccT& acc, const pg8::Unit& u, int wr, int wc, int fr, int fq) const {
        const int row0 = u.pm * 256 + wr * 64 + fr, col0 = u.pn * 256 + wc * 32 + 4 * fq;
        const float* __restrict__ bp = base; float* __restrict__ op = out;
#pragma unroll
        for (int ai = 0; ai < 2; ++ai)
#pragma unroll
            for (int mp = 0; mp < 2; ++mp) { f32x4 bv[2][2][2];
#pragma unroll
                for (int mm = 0; mm < 2; ++mm) { const size_t off = (size_t)(row0 + ai * 128 + (2 * mp + mm) * 16) * DM + col0;
#pragma unroll
                    for (int bj = 0; bj < 2; ++bj)
#pragma unroll
                        for (int n = 0; n < 2; ++n) bv[mm][bj][n] = *(const f32x4*)(bp + off + bj * 128 + n * 16); }
                __builtin_amdgcn_sched_barrier(0);
#pragma unroll
                for (int mm = 0; mm < 2; ++mm) { const size_t off = (size_t)(row0 + ai * 128 + (2 * mp + mm) * 16) * DM + col0;
#pragma unroll
                    for (int bj = 0; bj < 2; ++bj)
#pragma unroll
                        for (int n = 0; n < 2; ++n) *(f32x4*)(op + off + bj * 128 + n * 16) = bv[mm][bj][n] + acc[ai][bj][2 * mp + mm][n]; }
                asm volatile("" ::: "memory"); }
    } };
struct EpiBranch { static constexpr bool PERM = true, AFTER_DRAIN = false; const bf16_t* G; const float* bg; float* MIXF; bf16_t* MIXED;
    __device__ __forceinline__ void operator()(const AccT& acc, const pg8::Unit& u, int wr, int wc, int fr, int fq) const {
        const int i = u.pn >> 2, row0 = u.pm * 256 + wr * 64 + fr, gcol0 = u.pn * 256 + wc * 32 + 8 * fq, mcol0 = (u.pn & 3) * 256 + wc * 32 + 8 * fq;
        const float* __restrict__ mfr = MIXF; float* __restrict__ mfw = MIXF; bf16_t* __restrict__ mxw = MIXED; const bf16_t* __restrict__ gr = G;
        f32x4 b0[2], b1[2];
#pragma unroll
        for (int bj = 0; bj < 2; ++bj) { b0[bj] = *(const f32x4*)(bg + gcol0 + bj * 128); b1[bj] = *(const f32x4*)(bg + gcol0 + bj * 128 + 4); }
#pragma unroll
        for (int ai = 0; ai < 2; ++ai)
#pragma unroll
            for (int m = 0; m < 4; ++m) { const int row = row0 + ai * 128 + m * 16; const bf16_t* gp = gr + (size_t)row * 4096 + gcol0; const size_t mo = (size_t)row * DM + mcol0;
                u32x4 gw[2]; f32x4 p0[2], p1[2];
#pragma unroll
                for (int bj = 0; bj < 2; ++bj) { gw[bj] = *(const u32x4*)(gp + bj * 128);
                    if (i > 0) { p0[bj] = *(const f32x4*)(mfr + mo + bj * 128); p1[bj] = *(const f32x4*)(mfr + mo + bj * 128 + 4); } else { p0[bj] = (f32x4){0.f, 0.f, 0.f, 0.f}; p1[bj] = (f32x4){0.f, 0.f, 0.f, 0.f}; } }
                __builtin_amdgcn_sched_barrier(0);
#pragma unroll
                for (int bj = 0; bj < 2; ++bj) { f32x4 v0 = acc[ai][bj][m][0], v1 = acc[ai][bj][m][1]; const u32x4 g = gw[bj];
                    v0[0] *= fast_sigmoid(blo(g.x) + b0[bj][0]); v0[1] *= fast_sigmoid(bhi(g.x) + b0[bj][1]); v0[2] *= fast_sigmoid(blo(g.y) + b0[bj][2]); v0[3] *= fast_sigmoid(bhi(g.y) + b0[bj][3]);
                    v1[0] *= fast_sigmoid(blo(g.z) + b1[bj][0]); v1[1] *= fast_sigmoid(bhi(g.z) + b1[bj][1]); v1[2] *= fast_sigmoid(blo(g.w) + b1[bj][2]); v1[3] *= fast_sigmoid(bhi(g.w) + b1[bj][3]);
                    v0 += p0[bj]; v1 += p1[bj];
                    if (i < 3) { *(f32x4*)(mfw + mo + bj * 128) = v0; *(f32x4*)(mfw + mo + bj * 128 + 4) = v1; }
                    else { u32x4 w; w.x = pk2(v0[0], v0[1]); w.y = pk2(v0[2], v0[3]); w.z = pk2(v1[0], v1[1]); w.w = pk2(v1[2], v1[3]); *(u32x4*)(mxw + mo + bj * 128) = w; } }
                asm volatile("" ::: "memory"); }
    } };
struct EpiSexp { static constexpr bool PERM = true, AFTER_DRAIN = false; bf16_t* E; const float* mqss; float* esum; const float* cb;
    __device__ __forceinline__ void operator()(const AccT& acc, const pg8::Unit& u, int wr, int wc, int fr, int fq) const {
        const int row0 = u.pm * 256 + wr * 64 + fr, col0 = u.pn * 256 + wc * 32 + 8 * fq; const float shift = cb[0];
#pragma unroll
        for (int ai = 0; ai < 2; ++ai)
#pragma unroll
            for (int m = 0; m < 4; ++m) { const int row = row0 + ai * 128 + m * 16; const f32x4 p = *(const f32x4*)(mqss + (size_t)row * 16 + u.pn * 4);
                const float sc = rsqrtf(((p[0] + p[1]) + (p[2] + p[3])) * (1.f / 256.f) + EPS) * (1.f / 16.f); bf16_t* rowp = E + (size_t)row * DM + col0; float sum = 0.f;
#pragma unroll
                for (int bj = 0; bj < 2; ++bj) { const f32x4 v0 = acc[ai][bj][m][0], v1 = acc[ai][bj][m][1]; u32x4 w;
                    w.x = pk2(__expf(v0[0] * sc - shift), __expf(v0[1] * sc - shift)); w.y = pk2(__expf(v0[2] * sc - shift), __expf(v0[3] * sc - shift));
                    w.z = pk2(__expf(v1[0] * sc - shift), __expf(v1[1] * sc - shift)); w.w = pk2(__expf(v1[2] * sc - shift), __expf(v1[3] * sc - shift));
                    *(u32x4*)(rowp + bj * 128) = w;
                    sum += (blo(w.x) + bhi(w.x)) + (blo(w.y) + bhi(w.y)) + (blo(w.z) + bhi(w.z)) + (blo(w.w) + bhi(w.w)); }
                sum += __shfl_xor(sum, 16); sum += __shfl_xor(sum, 32); if (fq == 0) esum[(size_t)row * 16 + u.pn * 4 + wc] = sum;
                asm volatile("" ::: "memory"); }
    } };
struct EpiMemPV { static constexpr bool PERM = true, AFTER_DRAIN = false; bf16_t* Y; const float* esum;
    __device__ __forceinline__ void operator()(const AccT& acc, const pg8::Unit& u, int wr, int wc, int fr, int fq) const {
        const int row0 = u.pm * 256 + wr * 64 + fr, col0 = u.pn * 256 + wc * 32 + 8 * fq;
#pragma unroll
        for (int ai = 0; ai < 2; ++ai)
#pragma unroll
            for (int m = 0; m < 4; ++m) { const int row = row0 + ai * 128 + m * 16; const f32x4 p = *(const f32x4*)(esum + (size_t)row * 16 + u.pn * 4);
                const float il = 1.f / ((p[0] + p[1]) + (p[2] + p[3])); bf16_t* rowp = Y + (size_t)row * DM + col0;
#pragma unroll
                for (int bj = 0; bj < 2; ++bj) { const f32x4 v0 = acc[ai][bj][m][0] * il, v1 = acc[ai][bj][m][1] * il; u32x4 w; w.x = pk2(v0[0], v0[1]); w.y = pk2(v0[2], v0[3]); w.z = pk2(v1[0], v1[1]); w.w = pk2(v1[2], v1[3]);
                    *(u32x4*)(rowp + bj * 128) = w; }
                asm volatile("" ::: "memory"); }
    } };

__device__ __forceinline__ void tr_item(const float* __restrict__ W, int ldw, bf16_t* __restrict__ WT, int ldk, int nblk, LAS float* scr, int item, int lane, int ncopies, int cstride) {
    const int kb = item / nblk, nb = item % nblk, k0 = 64 * kb, n0 = 32 * nb;
    float tmp[32];
#pragma unroll
    for (int i = 0; i < 32; ++i) { const int kk = 2 * i + (lane >> 5); tmp[i] = W[(size_t)(k0 + kk) * ldw + n0 + (lane & 31)]; }
    __builtin_amdgcn_sched_barrier(0);
#pragma unroll
    for (int i = 0; i < 32; ++i) { const int kk = 2 * i + (lane >> 5); scr[kk * 33 + (lane & 31)] = tmp[i]; }
    LDS_WAIT(); asm volatile("" ::: "memory");
    const int c = lane & 7;
#pragma unroll
    for (int j = 0; j < 4; ++j) { const int n = (lane >> 3) + 8 * j; const LAS float* s = scr + (8 * c) * 33 + n;
        u32x4 o; o.x = pk2(s[0 * 33], s[1 * 33]); o.y = pk2(s[2 * 33], s[3 * 33]); o.z = pk2(s[4 * 33], s[5 * 33]); o.w = pk2(s[6 * 33], s[7 * 33]);
        for (int cp = 0; cp < ncopies; ++cp) *(u32x4*)(WT + (size_t)(n0 + n) * ldk + k0 + 8 * c + cp * cstride) = o; }
    LDS_WAIT(); asm volatile("" ::: "memory");
}
__device__ __forceinline__ void norm_row(f32x4 (&v)[4], const float* __restrict__ g, bf16_t* __restrict__ hrow, const LAS float* WfT, bool do_logf, const float* __restrict__ bfg, float* __restrict__ LOGF, int row, int lane) {
    const f32x4* gr = (const f32x4*)g; float ss = 0.f;
#pragma unroll
    for (int j = 0; j < 4; ++j) ss += (v[j][0] * v[j][0] + v[j][1] * v[j][1]) + (v[j][2] * v[j][2] + v[j][3] * v[j][3]);
    ss = wave_sum(ss);
    const float rstd = rsqrtf(ss * (1.f / DM) + EPS);
#pragma unroll
    for (int j = 0; j < 4; ++j) { v[j] = v[j] * rstd * gr[lane + 64 * j];
        uint2 o; o.x = pk2(v[j][0], v[j][1]); o.y = pk2(v[j][2], v[j][3]); ((uint2*)hrow)[lane + 64 * j] = o; }
    if (do_logf) {
        float p[16];
#pragma unroll
        for (int h = 0; h < 16; ++h) { float a = 0.f;
#pragma unroll
            for (int j = 0; j < 4; ++j) { const f32x4 w = *(const LAS f32x4*)(WfT + h * 1024 + (lane + 64 * j) * 4); a += (v[j][0] * w[0] + v[j][1] * w[1]) + (v[j][2] * w[2] + v[j][3] * w[3]); }
            p[h] = a; if ((h & 3) == 3) __builtin_amdgcn_sched_barrier(0); }
        const bool b5 = lane & 32, b4 = lane & 16, b3 = lane & 8, b2 = lane & 4;
        float q8[8], q4[4], q2[2];
#pragma unroll
        for (int i = 0; i < 8; ++i) { const float send = b5 ? p[i] : p[i + 8], keep = b5 ? p[i + 8] : p[i]; q8[i] = keep + __shfl_xor(send, 32); }
#pragma unroll
        for (int i = 0; i < 4; ++i) { const float send = b4 ? q8[i] : q8[i + 4], keep = b4 ? q8[i + 4] : q8[i]; q4[i] = keep + __shfl_xor(send, 16); }
#pragma unroll
        for (int i = 0; i < 2; ++i) { const float send = b3 ? q4[i] : q4[i + 2], keep = b3 ? q4[i + 2] : q4[i]; q2[i] = keep + __shfl_xor(send, 8); }
        float q1 = (b2 ? q2[1] : q2[0]) + __shfl_xor(b2 ? q2[0] : q2[1], 4);
        q1 += __shfl_xor(q1, 2); q1 += __shfl_xor(q1, 1);
        const int h = (b5 ? 8 : 0) + (b4 ? 4 : 0) + (b3 ? 2 : 0) + (b2 ? 1 : 0);
        if ((lane & 3) == 0) { const int b = row / SEQ, t = row % SEQ; LOGF[((size_t)b * 16 + h) * SEQ + t] = logsigmoidf(q1 + bfg[h]); }
    }
}
__device__ __forceinline__ void norm_rows(const float* __restrict__ x, int nrows, int gw, int NGW, const float* __restrict__ g, bf16_t* __restrict__ H, const LAS float* WfT, bool do_logf, const float* __restrict__ bfg, float* __restrict__ LOGF, int lane) {
    f32x4 nx[4];
    if (gw < nrows) {
#pragma unroll
        for (int j = 0; j < 4; ++j) nx[j] = ((const f32x4*)(x + (size_t)gw * DM))[lane + 64 * j]; }
    for (int m = gw; m < nrows; m += NGW) {
        f32x4 v[4];
#pragma unroll
        for (int j = 0; j < 4; ++j) v[j] = nx[j];
        if (m + NGW < nrows) {
#pragma unroll
            for (int j = 0; j < 4; ++j) nx[j] = ((const f32x4*)(x + (size_t)(m + NGW) * DM))[lane + 64 * j]; }
        norm_row(v, g, H + (size_t)m * DM, WfT, do_logf, bfg, LOGF, m, lane);
    }
}
__device__ __forceinline__ void headnorm64_row(bf16_t* row, const float* __restrict__ g, float scale, int lane) {
    u32x4* p = (u32x4*)row + lane * 2; u32x4 a = p[0], b = p[1];
    float v[16] = {blo(a.x), bhi(a.x), blo(a.y), bhi(a.y), blo(a.z), bhi(a.z), blo(a.w), bhi(a.w), blo(b.x), bhi(b.x), blo(b.y), bhi(b.y), blo(b.z), bhi(b.z), blo(b.w), bhi(b.w)};
    float ss = 0.f;
#pragma unroll
    for (int i = 0; i < 16; ++i) ss += v[i] * v[i];
    ss += __shfl_xor(ss, 1); ss += __shfl_xor(ss, 2);
    const float rstd = rsqrtf(ss * (1.f / 64.f) + EPS) * scale; const f32x4* gp = (const f32x4*)(g + (lane & 3) * 16);
#pragma unroll
    for (int i = 0; i < 4; ++i) { const f32x4 gg = gp[i]; v[4 * i] *= rstd * gg[0]; v[4 * i + 1] *= rstd * gg[1]; v[4 * i + 2] *= rstd * gg[2]; v[4 * i + 3] *= rstd * gg[3]; }
    a.x = pk2(v[0], v[1]); a.y = pk2(v[2], v[3]); a.z = pk2(v[4], v[5]); a.w = pk2(v[6], v[7]); b.x = pk2(v[8], v[9]); b.y = pk2(v[10], v[11]); b.z = pk2(v[12], v[13]); b.w = pk2(v[14], v[15]);
    p[0] = a; p[1] = b;
}
__device__ __forceinline__ void cumsum_block(const float* __restrict__ src, float* __restrict__ dst, LAS float* part, int tid) {
    const int lane = tid & 63, wave = tid >> 6; const f32x4* s4 = (const f32x4*)(src + tid * 16); float v[16]; float s = 0.f;
#pragma unroll
    for (int i = 0; i < 4; ++i) { const f32x4 x = s4[i]; s += x[0]; v[4 * i] = s; s += x[1]; v[4 * i + 1] = s; s += x[2]; v[4 * i + 2] = s; s += x[3]; v[4 * i + 3] = s; }
    float incl = s;
#pragma unroll
    for (int o = 1; o < 64; o <<= 1) { const float t_ = __shfl_up(incl, o); if (lane >= o) incl += t_; }
    __syncthreads();
    if (lane == 63) part[wave] = incl;
    __syncthreads();
    float off = incl - s;
    for (int w = 0; w < wave; ++w) off += part[w];
    f32x4* d4 = (f32x4*)(dst + tid * 16);
#pragma unroll
    for (int i = 0; i < 4; ++i) d4[i] = (f32x4){off + v[4 * i], off + v[4 * i + 1], off + v[4 * i + 2], off + v[4 * i + 3]};
}

__device__ __forceinline__ float neg_expm1_small(float x) {
    const float p = -x * (1.f + x * (0.5f + x * (0.16666667f + x * (0.041666668f + x * (0.0083333338f + x * 0.0013888889f)))));
    return x > -0.25f ? p : 1.f - __expf(x);
}
constexpr int LRU_TK = 128, LRU_NCH = SEQ / LRU_TK;
constexpr int LRU_XCB = 0, LRU_WT = LRU_TK * 144, LRU_R = LRU_WT + 18432, LRU_SEG = LRU_R + LRU_TK * 528;
static_assert(LRU_SEG + 4096 + 4096 <= MEGA_LDS - 64, "lru LDS map");
template <bool FINAL> __device__ __forceinline__ void lru_load(int it, int n, const bf16_t* __restrict__ LX, const bf16_t* __restrict__ LG, float (&xw)[19], float (&gl)[16], int tid) {
    const int b = it >> 10, c = (it >> 4) & 63, e = tid & 63, tg = tid >> 6, ch = n * 64 + e, t0 = c * LRU_TK + tg * 16;
    bf16_t raw[19];
#pragma unroll
    for (int j = 0; j < 19; ++j) { const int t = t0 + j - 3; raw[j] = LX[((size_t)b * SEQ + (t >= 0 ? t : 0)) * DM + ch]; }
    bf16_t rawg[16];
    if (FINAL) {
#pragma unroll
        for (int j = 0; j < 16; ++j) rawg[j] = LG[((size_t)b * SEQ + t0 + j) * DM + ch]; }
    __builtin_amdgcn_sched_barrier(0);
#pragma unroll
    for (int j = 0; j < 19; ++j) xw[j] = (t0 + j - 3) >= 0 ? bf2f(raw[j]) : 0.f;
    if (FINAL) {
#pragma unroll
        for (int j = 0; j < 16; ++j) gl[j] = bf2f(rawg[j]); }
}
template <bool FINAL> __device__ __forceinline__ void lru_item(int b, int c, int n, const float (&xw)[19], const float (&gl)[16], bf16_t* __restrict__ YL,
        const float w0, const float w1, const float w2, const float w3, const float bc, const float bA, const float bX,
        const float spl, float* APROD, float* HEND, LAS unsigned char* lds, int tid, int kseg) {
    const int e = tid & 63, tg = tid >> 6, ch = n * 64 + e, lane = e, wv = tg;
    LAS float* R = (LAS float*)(lds + LRU_R);
    LAS float* segP = (LAS float*)(lds + LRU_SEG);
    LAS float* segH = segP + 512, *carP = segH + 512 + (b * 4) * 64, *carH = carP + 512;
    const int t0 = c * LRU_TK + tg * 16; const size_t row0 = (size_t)b * SEQ + t0;
    float xc[16];
#pragma unroll
    for (int j = 0; j < 16; ++j) { xc[j] = bc + w3 * xw[j + 3] + w2 * xw[j + 2] + w1 * xw[j + 1] + w0 * xw[j]; *(LAS bf16_t*)(lds + LRU_XCB + (tg * 16 + j) * 144 + e * 2) = f2bf(xc[j]); }
    LDS_BAR();
    { const int tq = wv & 3, cbh = wv >> 2, r32 = lane & 31, hi = lane >> 5; f32x16_t acc0 = {}, acc1 = {};
#pragma unroll
        for (int ks = 0; ks < 4; ++ks) { const bf16x8_t af = *(const LAS bf16x8_t*)(lds + LRU_XCB + (32 * tq + r32) * 144 + (16 * ks + 8 * hi) * 2);
            const bf16x8_t b0 = *(const LAS bf16x8_t*)(lds + LRU_WT + (64 * cbh + r32) * 144 + (16 * ks + 8 * hi) * 2), b1 = *(const LAS bf16x8_t*)(lds + LRU_WT + (64 * cbh + 32 + r32) * 144 + (16 * ks + 8 * hi) * 2);
            acc0 = __builtin_amdgcn_mfma_f32_32x32x16_bf16(af, b0, acc0, 0, 0, 0); acc1 = __builtin_amdgcn_mfma_f32_32x32x16_bf16(af, b1, acc1, 0, 0, 0); }
#pragma unroll
        for (int r = 0; r < 16; ++r) { const int ro = (32 * tq + (r & 3) + 8 * (r >> 2) + 4 * hi) * 132 + 64 * cbh + r32; R[ro] = acc0[r]; R[ro + 32] = acc1[r]; } }
    LDS_BAR();
    float av[16], uv[16]; float P = 1.f, Hh = 0.f;
#pragma unroll
    for (int j = 0; j < 16; ++j) { const float ra = bA + R[(tg * 16 + j) * 132 + e], ri = bX + R[(tg * 16 + j) * 132 + 64 + e];
        const float rr = fast_sigmoid(ra), ii = fast_sigmoid(ri); const float la = -8.f * rr * spl; av[j] = __expf(la); uv[j] = __builtin_amdgcn_sqrtf(neg_expm1_small(2.f * la)) * (ii * xc[j]);
        Hh = av[j] * Hh + uv[j]; P *= av[j]; }
    segP[tg * 64 + e] = P; segH[tg * 64 + e] = Hh;
    LDS_BAR();
    if (FINAL) {
        float h = 0.f;
        for (int s = 0; s <= kseg; ++s) h = carP[s * 64 + e] * h + carH[s * 64 + e];
        for (int t2 = 0; t2 < tg; ++t2) h = segP[t2 * 64 + e] * h + segH[t2 * 64 + e];
#pragma unroll
        for (int j = 0; j < 16; ++j) { h = av[j] * h + uv[j]; YL[(row0 + j) * DM + ch] = f2bf(h * fast_gelu(gl[j])); }
    } else if (tg == 7) {
        float h = 0.f, p = 1.f;
#pragma unroll
        for (int s = 0; s < 8; ++s) { h = segP[s * 64 + e] * h + segH[s * 64 + e]; p *= segP[s * 64 + e]; }
        const size_t si = ((size_t)b * LRU_NCH + c) * DM + ch; APROD[si] = p; HEND[si] = h;
    }
}
template <bool FINAL> __device__ __forceinline__ void lru_pass(int l, int bx, int G, const float* const* in, const bf16_t* LX, const bf16_t* LG, bf16_t* YL, float* APROD, float* HEND, LAS unsigned char* lds, int tid) {
    const int n = bx & 15, e = tid & 63, ch = n * 64 + e;
    { const float* wa = in[10] + (size_t)l * 65536 + (size_t)n * 4096; const float* wx = in[12] + (size_t)l * 65536 + (size_t)n * 4096;
        float wv_[16];
#pragma unroll
        for (int k = 0; k < 16; ++k) { const int i = tid + MEGA_THREADS * k; wv_[k] = (i >> 12) ? wx[i & 4095] : wa[i & 4095]; }
#pragma unroll
        for (int k = 0; k < 16; ++k) { const int i = tid + MEGA_THREADS * k, mat = i >> 12, d = (i >> 6) & 63, ee = i & 63; *(LAS bf16_t*)(lds + LRU_WT + (mat * 64 + ee) * 144 + d * 2) = f2bf(wv_[k]); } }
    const float* cw = in[8] + (size_t)l * 4 * DM; const float w0 = cw[ch], w1 = cw[DM + ch], w2 = cw[2 * DM + ch], w3 = cw[3 * DM + ch], bc = in[9][l * DM + ch];
    const float bA = in[11][l * DM + ch], bX = in[13][l * DM + ch], spl = softplusf(-in[14][l * DM + ch]);
    if (FINAL) {
        const int c0 = bx >> 4, tg = tid >> 6, b = tg >> 2, sg = tg & 3; LAS float* carP = (LAS float*)(lds + LRU_SEG) + 1024, *carH = carP + 512;
        const int lo = sg == 0 ? 0 : c0 + 16 * (sg - 1), hi = c0 + 16 * sg; float A[16], Hc[16];
#pragma unroll
        for (int i = 0; i < 16; ++i) { const int cc = lo + i; const bool ok = cc < hi; const size_t si = ((size_t)b * LRU_NCH + (ok ? cc : 0)) * DM + ch; const float a_ = APROD[si], h_ = HEND[si]; A[i] = ok ? a_ : 1.f; Hc[i] = ok ? h_ : 0.f; }
        float cp = 1.f, chh = 0.f;
#pragma unroll
        for (int i = 0; i < 16; ++i) { chh = A[i] * chh + Hc[i]; cp *= A[i]; }
        carP[(b * 4 + sg) * 64 + e] = cp; carH[(b * 4 + sg) * 64 + e] = chh;
    }
    float xwn[19], gln[16];
#pragma unroll
    for (int j = 0; j < 16; ++j) gln[j] = 0.f;
    lru_load<FINAL>(bx, n, LX, LG, xwn, gln, tid);
    __syncthreads();
    for (int it = bx; it < 2048; it += G) {
        float xw[19], gl[16];
#pragma unroll
        for (int j = 0; j < 19; ++j) xw[j] = xwn[j];
#pragma unroll
        for (int j = 0; j < 16; ++j) gl[j] = gln[j];
        if (it + G < 2048) lru_load<FINAL>(it + G, n, LX, LG, xwn, gln, tid);
        lru_item<FINAL>(it >> 10, (it >> 4) & 63, n, xw, gl, YL, w0, w1, w2, w3, bc, bA, bX, spl, APROD, HEND, lds, tid, ((it >> 4) & 63) >> 4);
    }
    __syncthreads();
}

constexpr int SB_WIN = 13, SB_KOFF = 0, SB_VOFF = SB_WIN * 32 * 144, SB_SCR = SB_VOFF + SB_WIN * 4096;
static_assert(SB_SCR + 8 * 4096 <= MEGA_LDS - 64, "stick-breaking LDS map");
__device__ __forceinline__ void sb_wave(int b, int h, int qw0, int kt_lo, const bf16_t* Q, const bf16_t* __restrict__ K, const bf16_t* __restrict__ V, bf16_t* O, LAS unsigned char* lds, int wave, int lane) {
    const int r32 = lane & 31, hi = lane >> 5; const size_t rowbase = (size_t)b * SEQ;
    const bf16_t* Qw = Q + (rowbase + qw0) * DM + h * 64;
    bf16x8_t qr[4];
#pragma unroll
    for (int d0 = 0; d0 < 4; ++d0) qr[d0] = *(const bf16x8_t*)(Qw + (size_t)r32 * DM + d0 * 16 + hi * 8);
    const bf16_t* Kh = K + rowbase * DM + h * 64; const bf16_t* Vh = V + rowbase * DM + h * 64;
    f32x16_t o0 = {}, o1 = {}; float R = 0.f; const int qabs = qw0 + r32;
    LAS unsigned char* scr = lds + SB_SCR + wave * 4096;
    for (int kt = qw0 >> 5; kt >= 0; --kt) {
        bf16x8_t kf[4]; const LAS unsigned char* vl;
        if (kt >= kt_lo) {
#pragma unroll
            for (int d0 = 0; d0 < 4; ++d0) kf[d0] = *(const LAS bf16x8_t*)(lds + SB_KOFF + ((kt - kt_lo) * 32 + r32) * 144 + d0 * 32 + hi * 16);
            vl = lds + SB_VOFF + (kt - kt_lo) * 4096;
        } else {
#pragma unroll
            for (int d0 = 0; d0 < 4; ++d0) kf[d0] = *(const bf16x8_t*)(Kh + (size_t)(kt * 32 + r32) * DM + d0 * 16 + hi * 8);
#pragma unroll
            for (int it = 0; it < 4; ++it) { const int chunk = lane + 64 * it, row = chunk >> 3, c16 = chunk & 7; const u32x4 vq = *(const u32x4*)(Vh + (size_t)(kt * 32 + row) * DM + c16 * 8);
                *(LAS u32x4*)(scr + (c16 >> 2) * 2048 + row * 64 + (c16 & 3) * 16) = vq; }
            vl = scr;
        }
        f32x16_t st = {};
#pragma unroll
        for (int d0 = 0; d0 < 4; ++d0) st = __builtin_amdgcn_mfma_f32_32x32x16_bf16(kf[d0], qr[d0], st, 0, 0, 0);
        float l1[16], lb[16]; bool val[16];
#pragma unroll
        for (int r = 0; r < 16; ++r) { const int kv = kt * 32 + (r & 3) + 8 * (r >> 2) + 4 * hi; val[r] = kv < qabs; const float z = st[r] * 0.125f; const float sp = fast_softplus(z); l1[r] = val[r] ? -sp : 0.f; lb[r] = z - sp; }
        float w[16]; float tail = 0.f;
#pragma unroll
        for (int g = 3; g >= 0; --g) { const float qs = (l1[4 * g] + l1[4 * g + 1]) + (l1[4 * g + 2] + l1[4 * g + 3]); const float pq = __shfl_xor(qs, 32);
            const float after = tail + (hi == 0 ? pq : 0.f) + R; tail += qs + pq;
            const float e2 = l1[4 * g + 3], e1 = e2 + l1[4 * g + 2], e0 = e1 + l1[4 * g + 1];
            w[4 * g + 3] = val[4 * g + 3] ? __expf(lb[4 * g + 3] + after) : 0.f; w[4 * g + 2] = val[4 * g + 2] ? __expf(lb[4 * g + 2] + after + e2) : 0.f;
            w[4 * g + 1] = val[4 * g + 1] ? __expf(lb[4 * g + 1] + after + e1) : 0.f; w[4 * g] = val[4 * g] ? __expf(lb[4 * g] + after + e0) : 0.f; }
        R += tail;
        u32x4 p0, p1; p0.x = attn_body::cvtpk_s(w[0], w[1]); p0.y = attn_body::cvtpk_s(w[2], w[3]); p0.z = attn_body::cvtpk_s(w[4], w[5]); p0.w = attn_body::cvtpk_s(w[6], w[7]);
        p1.x = attn_body::cvtpk_s(w[8], w[9]); p1.y = attn_body::cvtpk_s(w[10], w[11]); p1.z = attn_body::cvtpk_s(w[12], w[13]); p1.w = attn_body::cvtpk_s(w[14], w[15]);
        const bf16x8_t pa0 = __builtin_bit_cast(bf16x8_t, p0), pa1 = __builtin_bit_cast(bf16x8_t, p1);
        const attn_body::lds_cptr vp = (attn_body::lds_cptr)vl + (4 * hi + ((lane & 15) >> 2)) * 64 + ((lane >> 4) & 1) * 32 + (lane & 3) * 8;
#define SB_VF(d0, s) ({ const attn_body::s16x4 lo_ = attn_body::vtr(vp + (d0) * 2048 + (s) * 1024), hi_ = attn_body::vtr(vp + (d0) * 2048 + (s) * 1024 + 512); \
            (bf16x8_t){lo_[0], lo_[1], lo_[2], lo_[3], hi_[0], hi_[1], hi_[2], hi_[3]}; })
        o0 = __builtin_amdgcn_mfma_f32_32x32x16_bf16(pa0, SB_VF(0, 0), o0, 0, 0, 0);
        o1 = __builtin_amdgcn_mfma_f32_32x32x16_bf16(pa0, SB_VF(1, 0), o1, 0, 0, 0);
        o0 = __builtin_amdgcn_mfma_f32_32x32x16_bf16(pa1, SB_VF(0, 1), o0, 0, 0, 0);
        o1 = __builtin_amdgcn_mfma_f32_32x32x16_bf16(pa1, SB_VF(1, 1), o1, 0, 0, 0);
#undef SB_VF
        if (__all(R < SB_THR)) break;
    }
    bf16_t* Ow = O + (rowbase + qw0) * DM + h * 64;
#pragma unroll
    for (int r = 0; r < 16; ++r) { const int q = (r & 3) + 8 * (r >> 2) + 4 * hi; Ow[(size_t)q * DM + r32] = f2bf(o0[r]); Ow[(size_t)q * DM + 32 + r32] = f2bf(o1[r]); }
}
__device__ __forceinline__ void sb_unit(int b, int h, int q0, const bf16_t* Q, const bf16_t* __restrict__ K, const bf16_t* __restrict__ V, bf16_t* O, LAS unsigned char* lds, int tid) {
    const int lane = tid & 63, wave = __builtin_amdgcn_readfirstlane(tid >> 6);
    const int kt_hi = (q0 >> 5) + 8, kt_lo = kt_hi - SB_WIN > 0 ? kt_hi - SB_WIN : 0, nch = (kt_hi - kt_lo) * 256;
    const bf16_t* Kh = K + ((size_t)b * SEQ + kt_lo * 32) * DM + h * 64; const bf16_t* Vh = V + ((size_t)b * SEQ + kt_lo * 32) * DM + h * 64;
#pragma unroll
    for (int hb = 0; hb < 2; ++hb) {
        u32x4 kq[4], vq[4];
#pragma unroll
        for (int i = 0; i < 4; ++i) { const int idx = tid + MEGA_THREADS * (4 * hb + i), row = idx >> 3, c16 = idx & 7;
            const int rc = idx < nch ? row : 0; kq[i] = *(const u32x4*)(Kh + (size_t)rc * DM + c16 * 8); vq[i] = *(const u32x4*)(Vh + (size_t)rc * DM + c16 * 8); }
#pragma unroll
        for (int i = 0; i < 4; ++i) { const int idx = tid + MEGA_THREADS * (4 * hb + i), row = idx >> 3, c16 = idx & 7;
            if (idx < nch) { *(LAS u32x4*)(lds + SB_KOFF + row * 144 + c16 * 16) = kq[i];
                *(LAS u32x4*)(lds + SB_VOFF + (row >> 5) * 4096 + (c16 >> 2) * 2048 + (row & 31) * 64 + (c16 & 3) * 16) = vq[i]; } }
    }
    __syncthreads();
    sb_wave(b, h, q0 + wave * 32, kt_lo, Q, K, V, O, lds, wave, lane);
    __syncthreads();
}

#ifndef DBG_NOLOGF
#define DBG_NOLOGF 0
#endif
#ifndef EN_FOX
#define EN_FOX 1
#endif
#ifndef EN_SB
#define EN_SB 1
#endif
#ifndef EN_LRU
#define EN_LRU 1
#endif
#ifndef EN_GEMM
#define EN_GEMM 1
#endif
#ifndef EN_THIN
#define EN_THIN 1
#endif
enum { SUB_CONV = 1, SUB_NORM = 2, SUB_HEADNORM = 4, SUB_CUMSUM = 8, SUB_LRU = 16, SUB_SB = 32, SUB_MEM = 64, SUB_FOX = 128, SUB_ALL = 255 };
constexpr int N_PRO = 3, N_PER_LAYER = 10, N_PHASES = N_PRO + DEPTH * N_PER_LAYER;
struct MArgs { Ptrs P; int ph_lo, ph_hi, sub, pad; };

__global__ void __launch_bounds__(MEGA_THREADS, 2) mega(MArgs a) {
    extern __shared__ __attribute__((aligned(16))) unsigned char lds_raw[];
    LAS unsigned char* lds = (LAS unsigned char*)lds_raw;
    cg::grid_group grid = cg::this_grid();
    { volatile LAS unsigned* st0 = (volatile LAS unsigned*)(lds + XB_LDS_OFF); if (threadIdx.x == 0) { st0[0] = 0u; st0[1] = 0u; } __syncthreads();
      if (a.ph_hi - a.ph_lo > 2) (void)xcd_barrier_post((unsigned*)(a.P.ws + WS_BAR), st0); }
    for (int ph = a.ph_lo; ph < a.ph_hi; ++ph) {
    int tid = threadIdx.x; asm volatile("" : "+v"(tid));
    const int lane = tid & 63, wave = __builtin_amdgcn_readfirstlane(tid >> 6);
    int zs = 0; asm volatile("" : "+s"(zs));
    const int G = gridDim.x + zs, bx = blockIdx.x + zs, sub = a.sub + zs, vcu = (G % 8 == 0) ? (bx % 8) * (G / 8) + bx / 8 : bx;
    const int gw = vcu * NWV + wave, NGW = G * NWV;
    unsigned char* ws = a.P.ws + zs; const float* const* in = a.P.in + zs; float* out = a.P.out + zs;
    bf16_t* H = (bf16_t*)(ws + WS_H); bf16_t* PROJ = (bf16_t*)(ws + WS_PROJ); bf16_t* GATES = (bf16_t*)(ws + WS_GATES); bf16_t* Eb = (bf16_t*)(ws + WS_E);
    bf16_t *FQ = PROJ, *FK = PROJ + (size_t)T * DM, *FV = PROJ + 2 * (size_t)T * DM, *LX = PROJ + 3 * (size_t)T * DM, *LG = PROJ + 4 * (size_t)T * DM, *SQ = PROJ + 5 * (size_t)T * DM,
           *SK = PROJ + 6 * (size_t)T * DM, *SV = PROJ + 7 * (size_t)T * DM, *MQ = PROJ + 8 * (size_t)T * DM;
    bf16_t* YL = (bf16_t*)(ws + WS_YL);
    float *LOGF = (float*)(ws + WS_LOGF), *FB = (float*)(ws + WS_FB), *MQSS = (float*)(ws + WS_MQSS), *ESUM = (float*)(ws + WS_ESUM), *CB = (float*)(ws + WS_CB);
    bf16_t* MEMN = (bf16_t*)(ws + WS_MEMN); float* MEMRAW = (float*)(ws + WS_MEMRAW); bf16_t *MK = (bf16_t*)(ws + WS_MK), *MVT = (bf16_t*)(ws + WS_MVT);
    float *APROD = (float*)(ws + WS_LRU), *HEND = APROD + (size_t)BATCH * 128 * DM;
    bf16_t* WKVT = (bf16_t*)(ws + WS_WKVT);
    bf16_t *WIN_T = (bf16_t*)(ws + WS_WT + WT_IN), *WBR_T = (bf16_t*)(ws + WS_WT + WT_BR), *WOUT_T = (bf16_t*)(ws + WS_WT + WT_OUT), *WUP_T = (bf16_t*)(ws + WS_WT + WT_UP), *WDN_T = (bf16_t*)(ws + WS_WT + WT_DN);
    bf16_t *GV = (bf16_t*)(ws + WS_GV), *ACT = (bf16_t*)(ws + WS_ACT);

        if (ph < N_PRO) {
            if (ph == 0) {
                LAS float* scr = (LAS float*)(lds + wave * 8448);
                for (int it = gw; it < 4 * 1024; it += NGW) { const int l = it >> 10; tr_item(in[15] + (size_t)l * DM * 2048, 2048, WKVT + (size_t)l * 2048 * DM, DM, 64, scr, it & 1023, lane, 1, 0); }
                for (int l = 0; l < 4; ++l) norm_rows(in[1], 512, gw, NGW, in[3] + l * DM, MEMN + (size_t)l * 512 * DM, (const LAS float*)lds, false, nullptr, nullptr, lane);
            } else if (ph == 1) {
                LocOrder<LocMemKV> S; S.so.init(4 * 512, 2048, G, bx); S.loc = LocMemKV{(const char*)MEMN, (const char*)WKVT};
                if (EN_GEMM) pg8::gemm_phase<EpiF32, LocOrder<LocMemKV>, true, true>(lds, pg8::Gemm{DM, DM, DM}, S, EpiF32{MEMRAW, 2048, 0});
            } else {
                for (int m = gw; m < 4 * 512; m += NGW) { const int l = m >> 9, r = m & 511, b = r >> 8, mi = r & 255; const float* raw = MEMRAW + (size_t)m * 2048;
                    const f32x4 gk = *(const f32x4*)(in[17] + l * 256 + lane * 4), gq = *(const f32x4*)(in[16] + l * 256 + lane * 4); const f32x4 gg = gk * gq;
#pragma unroll
                    for (int h = 0; h < 4; ++h) { const f32x4 k = *(const f32x4*)(raw + h * 256 + lane * 4); const float ss = wave_sum((k[0] * k[0] + k[1] * k[1]) + (k[2] * k[2] + k[3] * k[3]));
                        const float rstd = rsqrtf(ss * (1.f / 256.f) + EPS); uint2 o; o.x = pk2(k[0] * rstd * gg[0], k[1] * rstd * gg[1]); o.y = pk2(k[2] * rstd * gg[2], k[3] * rstd * gg[3]);
                        *(uint2*)(MK + ((size_t)l * 512 + (size_t)b * 256 + mi) * DM + h * 256 + lane * 4) = o;
                        const f32x4 v = *(const f32x4*)(raw + 1024 + h * 256 + lane * 4); bf16_t* vt = MVT + (size_t)l * 512 * DM + (((size_t)b * 4 + h) * 256 + lane * 4) * 256 + mi;
                        vt[0] = f2bf(v[0]); vt[256] = f2bf(v[1]); vt[512] = f2bf(v[2]); vt[768] = f2bf(v[3]); }
                    if (r == 0) { float mx = fmaxf(fmaxf(fabsf(gg[0]), fabsf(gg[1])), fmaxf(fabsf(gg[2]), fabsf(gg[3])));
#pragma unroll
                        for (int o = 1; o < 64; o <<= 1) mx = fmaxf(mx, __shfl_xor(mx, o));
                        if (lane == 0) CB[l] = 16.f * mx; } }
            }
        } else {
            const int l = (ph - N_PRO) / N_PER_LAYER, sp = (ph - N_PRO) % N_PER_LAYER;
            const float* xcur = l == 0 ? in[0] : out;
            if (sp == 0) {
                if (sub & SUB_NORM) { LAS float* WfT = (LAS float*)lds; const float* wf = in[4] + (size_t)l * DM * NIN + 3072;
#pragma unroll
                    for (int hb = 0; hb < 2; ++hb) { float tmp[16];
#pragma unroll
                        for (int q = 0; q < 16; ++q) { const int i = tid + MEGA_THREADS * (16 * hb + q); tmp[q] = wf[(size_t)(i >> 4) * NIN + (i & 15)]; }
                        __builtin_amdgcn_sched_barrier(0);
#pragma unroll
                        for (int q = 0; q < 16; ++q) { const int i = tid + MEGA_THREADS * (16 * hb + q); WfT[(i & 15) * 1024 + (i >> 4)] = tmp[q]; } } }
                __syncthreads();
                if (sub & SUB_CONV) { LAS float* scr = (LAS float*)(lds + 65536 + wave * 8448);
                    const float* win = in[4] + (size_t)l * DM * NIN;
                    for (int it = gw; it < 13440; it += NGW) { int r = it;
                        if (r < 1536) { tr_item(win, NIN, WIN_T, DM, 96, scr, r, lane, 1, 0); continue; } r -= 1536;
                        if (r < 5120) { tr_item(win + 3088, NIN, WIN_T + (size_t)3072 * DM, DM, 320, scr, r, lane, 1, 0); continue; } r -= 5120;
                        if (r < 2048) { const int i = r >> 9; tr_item(in[19] + ((size_t)l * 4 + i) * DM * DM, DM, WBR_T + (size_t)i * DM * DM, DM, 32, scr, r & 511, lane, 1, 0); continue; } r -= 2048;
                        if (r < 512) { tr_item(in[20] + (size_t)l * DM * DM, DM, WOUT_T, DM, 32, scr, r, lane, 1, 0); continue; } r -= 512;
                        if (r < 2816) { tr_item(in[22] + (size_t)l * DM * 2 * DFF, 2 * DFF, WUP_T, DM, 176, scr, r, lane, 1, 0); continue; } r -= 2816;
                        tr_item(in[25] + (size_t)l * DFF * DM, DM, WDN_T, DFF, 32, scr, r, lane, 1, 0); } }
                if (sub & SUB_NORM) norm_rows(xcur, T, gw, NGW, in[2] + l * DM, H, (const LAS float*)lds, !DBG_NOLOGF, in[5] + l * 16, LOGF, lane);
            } else if (sp == 1) {
                LocOrder<LocStd> S; S.so.init(T, 13312, G, bx); S.loc = LocStd{(const char*)H, (const char*)WIN_T, 256 * 1024 * 2, 256 * 1024 * 2};
                if (EN_GEMM) pg8::gemm_phase<EpiProj, LocOrder<LocStd>, true, true>(lds, pg8::Gemm{DM, DM, DM}, S, EpiProj{PROJ, GATES, MQSS});
            } else if (sp == 2) {
                if (sub & SUB_HEADNORM) { for (int m = gw; m < 2 * T; m += NGW) { if (m < T) headnorm64_row(FQ + (size_t)m * DM, in[6] + l * 64, C2, lane); else headnorm64_row(FK + (size_t)(m - T) * DM, in[7] + l * 64, 1.f, lane); } }
                if ((sub & SUB_CUMSUM) && bx < 32) cumsum_block(LOGF + (size_t)bx * SEQ, FB + (size_t)bx * SEQ, (LAS float*)lds, tid);
                __syncthreads();
                if (EN_LRU && (sub & SUB_LRU)) lru_pass<false>(l, bx, G, in, LX, LG, YL, APROD, HEND, lds, tid);
                if (EN_SB && (sub & SUB_SB))
#pragma unroll 1
                for (int k = 0; k < 4; ++k) { const int bh = vcu >> 3, qb = (vcu & 7) * 4 + k; sb_unit(bh >> 4, bh & 15, qb * 256, SQ, SK, SV, H, lds, tid); }
                __syncthreads();
                if (sub & SUB_MEM) { LocOrder<LocMemS> S; S.so.init(T, 1024, G, bx); S.loc = LocMemS{(const char*)MQ, (const char*)(MK + (size_t)l * 512 * DM)};
                    if (EN_GEMM) pg8::gemm_phase<EpiSexp, LocOrder<LocMemS>, true, true>(lds, pg8::Gemm{DM, DM, 256 + zs}, S, EpiSexp{Eb, MQSS, ESUM, CB + l}); }
            } else if (sp == 3) {
                if (EN_FOX && (sub & SUB_FOX)) {
                    float gqm = fabsf(in[6][l * 64 + lane]), gkm = fabsf(in[7][l * 64 + lane]);
#pragma unroll
                    for (int o = 1; o < 64; o <<= 1) { gqm = fmaxf(gqm, __shfl_xor(gqm, o)); gkm = fmaxf(gkm, __shfl_xor(gkm, o)); }
                    const float thr = -(160.f + 2.f * C2 * 64.f * gqm * gkm);
                    const attn_body::AttnTensors AT{(const attn_body::bf16*)FQ, (const attn_body::bf16*)FK, (const attn_body::bf16*)FV, (attn_body::bf16*)SV, FB, thr, 0};
                    attn_body::QueueOrder S; S.ctr = (unsigned*)(ws + WS_QCTR) + (l * 8) * 64; S.xl = bx & 7; S.slot = (volatile LAS int*)(lds + XB_LDS_OFF + 16);
                    attn_body::attn_phase<attn_body::QueueOrder, 20>((char*)lds_raw, AT, S); }
                __syncthreads();
                if (EN_LRU && (sub & SUB_LRU)) lru_pass<true>(l, bx, G, in, LX, LG, YL, APROD, HEND, lds, tid);
                if (sub & SUB_MEM) { LocOrder<LocMemPV> S; S.so.init(T, 1024, G, bx); S.loc = LocMemPV{(const char*)Eb, (const char*)(MVT + (size_t)l * 512 * DM)};
                    if (EN_GEMM) pg8::gemm_phase<EpiMemPV, LocOrder<LocMemPV>, true, true>(lds, pg8::Gemm{DM, 256, 256 + zs}, S, EpiMemPV{MQ, ESUM}); }
            } else if (sp == 4) {
                BranchSched S; S.vcu = vcu; S.loc = LocBranch{(const char*)SV, (const char*)YL, (const char*)H, (const char*)MQ, (const char*)WBR_T};
                if (EN_GEMM) pg8::gemm_phase<EpiBranch, BranchSched, true, true>(lds, pg8::Gemm{DM, DM, DM}, S, EpiBranch{GATES, in[18] + (size_t)l * 4 * DM, (float*)(ws + WS_MIXF), (bf16_t*)(ws + WS_MIXED)});
            } else if (sp == 5) {
                LocOrder<LocStd> S; S.so.init(T, DM, G, bx); S.loc = LocStd{(const char*)(ws + WS_MIXED), (const char*)WOUT_T, 256 * 1024 * 2, 256 * 1024 * 2};
                if (EN_GEMM) pg8::gemm_phase<EpiResid, LocOrder<LocStd>, true, true>(lds, pg8::Gemm{DM, DM, DM}, S, EpiResid{xcur, out});
            } else if (sp == 6) {
                norm_rows(out, T, gw, NGW, in[21] + l * DM, H, (const LAS float*)lds, false, nullptr, nullptr, lane);
            } else if (sp == 7) {
                LocOrder<LocStd> S; S.so.init(T, 2 * DFF, G, bx); S.loc = LocStd{(const char*)H, (const char*)WUP_T, 256 * 1024 * 2, 256 * 1024 * 2};
                if (EN_GEMM) pg8::gemm_phase<EpiBf16P, LocOrder<LocStd>, true, true>(lds, pg8::Gemm{DM, DM, DM}, S, EpiBf16P{GV, 2 * DFF, 0});
            } else if (sp == 8) {
                const float* cw = in[23] + (size_t)l * 3 * DFF; const float* cbv = in[24] + l * DFF;
                for (int i = bx * MEGA_THREADS + tid; i < (T / 8) * (DFF / 8); i += G * MEGA_THREADS) { const int r0 = (i / (DFF / 8)) * 8, c = (i % (DFF / 8)) * 8, t0 = r0 % SEQ;
                    const bf16_t* gp = GV + (size_t)r0 * 2 * DFF + c; const u32x4 z4 = {0u, 0u, 0u, 0u};
                    const f32x4 wa0 = *(const f32x4*)(cw + c), wa1 = *(const f32x4*)(cw + c + 4), wb0 = *(const f32x4*)(cw + DFF + c), wb1 = *(const f32x4*)(cw + DFF + c + 4), wc0 = *(const f32x4*)(cw + 2 * DFF + c), wc1 = *(const f32x4*)(cw + 2 * DFF + c + 4);
                    const f32x4 bb0 = *(const f32x4*)(cbv + c), bb1 = *(const f32x4*)(cbv + c + 4);
                    const u32x4 g2l = *(const u32x4*)(gp - (t0 >= 2 ? 4 * DFF : 0)), g1l = *(const u32x4*)(gp - (t0 >= 1 ? 2 * DFF : 0));
                    u32x4 g2 = t0 >= 2 ? g2l : z4, g1 = t0 >= 1 ? g1l : z4;
                    u32x4 gg[8], vv[8];
#pragma unroll
                    for (int j = 0; j < 8; ++j) { gg[j] = *(const u32x4*)(gp + (size_t)j * 2 * DFF); vv[j] = *(const u32x4*)(gp + (size_t)j * 2 * DFF + DFF); }
#define ACT1(G0, G1, G2, VV, W0, W1, W2, BB) ({ const float pre_ = (BB) + (W2) * (G0) + (W1) * (G1) + (W0) * (G2); pre_ * fast_sigmoid(pre_) * (VV); })
#pragma unroll
                    for (int j = 0; j < 8; ++j) { const u32x4 g0 = gg[j], v_ = vv[j]; u32x4 o;
                        o.x = pk2(ACT1(blo(g0.x), blo(g1.x), blo(g2.x), blo(v_.x), wa0[0], wb0[0], wc0[0], bb0[0]), ACT1(bhi(g0.x), bhi(g1.x), bhi(g2.x), bhi(v_.x), wa0[1], wb0[1], wc0[1], bb0[1]));
                        o.y = pk2(ACT1(blo(g0.y), blo(g1.y), blo(g2.y), blo(v_.y), wa0[2], wb0[2], wc0[2], bb0[2]), ACT1(bhi(g0.y), bhi(g1.y), bhi(g2.y), bhi(v_.y), wa0[3], wb0[3], wc0[3], bb0[3]));
                        o.z = pk2(ACT1(blo(g0.z), blo(g1.z), blo(g2.z), blo(v_.z), wa1[0], wb1[0], wc1[0], bb1[0]), ACT1(bhi(g0.z), bhi(g1.z), bhi(g2.z), bhi(v_.z), wa1[1], wb1[1], wc1[1], bb1[1]));
                        o.w = pk2(ACT1(blo(g0.w), blo(g1.w), blo(g2.w), blo(v_.w), wa1[2], wb1[2], wc1[2], bb1[2]), ACT1(bhi(g0.w), bhi(g1.w), bhi(g2.w), bhi(v_.w), wa1[3], wb1[3], wc1[3], bb1[3]));
                        *(u32x4*)(ACT + (size_t)(r0 + j) * DFF + c) = o; g2 = g1; g1 = g0; }
#undef ACT1
                }
            } else {
                LocOrder<LocStd> S; S.so.init(T, DM, G, bx); S.loc = LocStd{(const char*)ACT, (const char*)WDN_T, 256 * DFF * 2, 256 * DFF * 2};
                if (EN_GEMM) pg8::gemm_phase<EpiResid, LocOrder<LocStd>, true, true>(lds, pg8::Gemm{DFF, DFF, DFF}, S, EpiResid{out, out});
            }
        }
        if (ph + 1 < a.ph_hi) {
            if (ph == a.ph_lo) grid.sync();
            else { XcdBarrier xb; xb.bar = (unsigned*)(ws + WS_BAR); xb.x = xb_xcc_id(); xb.st = (volatile LAS unsigned*)(lds + XB_LDS_OFF); xcd_barrier(xb); }
        }
    }
}
enum { C_PRO = 1, C_NORM = 2, C_WIN = 4, C_HN = 8, C_LRU = 16, C_SB = 32, C_MEM = 64, C_FOX = 128, C_BR = 256, C_WOUT = 512, C_NORM2 = 1024, C_UP = 2048, C_ACT = 4096, C_DOWN = 8192, C_ONE = 16384 };
#ifndef CFG
#define CFG 32767
#endif
#ifndef REPEAT_SP
#define REPEAT_SP (-1)
#define REPEAT_N 0
#define REPEAT_SUB 0
#endif
static int g_grid = 0;
static void launch_mega(const Ptrs& P, int lo, int hi, int sub, hipStream_t st, bool coop) {
    MArgs a{}; a.P = P; a.ph_lo = lo; a.ph_hi = hi; a.sub = sub; a.pad = 0;
    if (coop) { void* args[] = {&a}; const hipError_t e = hipLaunchCooperativeKernel((const void*)mega, dim3(g_grid), dim3(MEGA_THREADS), args, MEGA_LDS, st);
        if (e != hipSuccess) fprintf(stderr, "cooperative launch failed: %s (grid %d)\n", hipGetErrorString(e), g_grid); }
    else { hipLaunchKernelGGL(mega, dim3(g_grid), dim3(MEGA_THREADS), MEGA_LDS, st, a);
        if (REPEAT_N > 0 && hi == lo + 1 && lo >= N_PRO && (lo - N_PRO) % N_PER_LAYER == (REPEAT_SP)) { a.sub = (REPEAT_SUB); for (int r = 0; r < (REPEAT_N); ++r) hipLaunchKernelGGL(mega, dim3(g_grid), dim3(MEGA_THREADS), MEGA_LDS, st, a); } }
}
static void run_hybrid(const Ptrs& P, hipStream_t st) {
    unsigned char* ws = P.ws;
    bf16_t* H = (bf16_t*)(ws + WS_H);
    bf16_t* PR[9]; for (int i = 0; i < 9; ++i) PR[i] = (bf16_t*)(ws + WS_PROJ + i * SZ_ACT);
    bf16_t *FQ = PR[0], *FK = PR[1], *FV = PR[2], *LX = PR[3], *LG = PR[4], *SQ = PR[5], *SK = PR[6], *SV = PR[7], *MQ = PR[8];
    bf16_t* GATES = (bf16_t*)(ws + WS_GATES);
    bf16_t *YL = (bf16_t*)(ws + WS_YL), *YS = (bf16_t*)(ws + WS_YS), *YM = (bf16_t*)(ws + WS_YM), *YF = (bf16_t*)(ws + WS_YF);
    float *LOGF = (float*)(ws + WS_LOGF), *FB = (float*)(ws + WS_FB);
    bf16_t* MEMN = (bf16_t*)(ws + WS_MEMN); float* MEMRAW = (float*)(ws + WS_MEMRAW);
    bf16_t *MK = (bf16_t*)(ws + WS_MK), *MVT = (bf16_t*)(ws + WS_MVT);
    bf16_t *GV = (bf16_t*)(ws + WS_GV), *ACT = (bf16_t*)(ws + WS_ACT);
    const float* const* in = P.in;
    const int cfg = CFG;
    const bool anygemm = cfg & (C_WIN | C_BR | C_WOUT | C_UP | C_DOWN);
    if (cfg & C_PRO) { for (int p = 0; p < 3; ++p) launch_mega(P, p, p + 1, SUB_ALL, st, false); }
    else for (int l = 0; l < DEPTH; ++l) {
        n_rmsnorm<<<512 / 4, 256, 0, st>>>(in[1], in[3] + l * DM, MEMN + (size_t)l * 512 * DM, nullptr, nullptr, nullptr, 512);
        n_gemm<EStoreF32><<<dim3(2048 / 64, 512 / 64), 256, 0, st>>>(MEMN + (size_t)l * 512 * DM, in[15] + (size_t)l * DM * 2048, DM, 2048, DM, 0x7fffffff, EStoreF32{MEMRAW + (size_t)l * 512 * 2048, 2048, 0});
        n_memkv_post<<<512, 256, 0, st>>>(MEMRAW + (size_t)l * 512 * 2048, in[17] + l * 256, in[16] + l * 256, MK + (size_t)l * 512 * DM, MVT + (size_t)l * 512 * DM);
    }
    for (int l = 0; l < DEPTH; ++l) {
        const int p0 = N_PRO + l * N_PER_LAYER;
        const float* xcur = l == 0 ? in[0] : P.out;
        const float* win = in[4] + (size_t)l * DM * NIN;
        if (DBG_NOLOGF) n_rmsnorm<<<T / 4, 256, 0, st>>>(xcur, in[2] + l * DM, H, win + 3072, in[5] + l * 16, LOGF, T);
        { const int sub = (anygemm ? SUB_CONV : 0) | ((cfg & C_NORM) ? SUB_NORM : 0); if (sub) launch_mega(P, p0, p0 + 1, sub, st, false); }
        if (!(cfg & C_NORM)) n_rmsnorm<<<T / 4, 256, 0, st>>>(xcur, in[2] + l * DM, H, win + 3072, in[5] + l * 16, LOGF, T);
        if (cfg & C_WIN) launch_mega(P, p0 + 1, p0 + 2, SUB_ALL, st, false);
        else { for (int gI = 0; gI < 9; ++gI) { const int coff = gI < 3 ? gI * 1024 : gI * 1024 + 16;
                n_gemm<EStoreBf16><<<dim3(1024 / 64, T / 64), 256, 0, st>>>(H, win + coff, DM, NIN, DM, 0x7fffffff, EStoreBf16{PR[gI], DM, 0}); }
            n_gemm<EStoreBf16><<<dim3(4096 / 64, T / 64), 256, 0, st>>>(H, win + 9232, DM, NIN, DM, 0x7fffffff, EStoreBf16{GATES, 4096, 0}); }
        if (!(cfg & C_HN)) { n_headnorm<<<T * 16 / 256, 256, 0, st>>>(FQ, in[6] + l * 64, 64, C2); n_headnorm<<<T * 16 / 256, 256, 0, st>>>(FK, in[7] + l * 64, 64, 1.f); n_cumsum<<<32, 1024, 0, st>>>(LOGF, FB); }
        const int sub23 = ((cfg & C_HN) ? (SUB_HEADNORM | SUB_CUMSUM) : 0) | ((cfg & C_LRU) ? SUB_LRU : 0) | ((cfg & C_SB) ? SUB_SB : 0) | ((cfg & C_MEM) ? SUB_MEM : 0) | ((cfg & C_FOX) ? SUB_FOX : 0);
        if (sub23 & ~SUB_FOX) launch_mega(P, p0 + 2, p0 + 3, sub23, st, false);
        if (!(cfg & C_SB)) n_sb_attn<<<dim3(SEQ / 256, 32), 256, 0, st>>>(SQ, SK, SV, YS);
        if (!(cfg & C_LRU)) n_lru<<<32, 64, 0, st>>>(LX, LG, in[8] + (size_t)l * 4 * DM, in[9] + l * DM, in[10] + (size_t)l * 16 * 64 * 64, in[11] + l * DM, in[12] + (size_t)l * 16 * 64 * 64, in[13] + l * DM, in[14] + l * DM, YL);
        if (!(cfg & C_MEM)) n_mem_attn<<<T * 4, 256, 0, st>>>(MQ, MK + (size_t)l * 512 * DM, MVT + (size_t)l * 512 * DM, YM);
        if (sub23 & (SUB_FOX | SUB_LRU | SUB_MEM)) launch_mega(P, p0 + 3, p0 + 4, sub23, st, false);
        if (!(cfg & C_FOX)) n_fox_attn<<<dim3(SEQ / 256, 32), 256, 0, st>>>(FQ, FK, FV, FB, YF);
        if (cfg & C_BR) launch_mega(P, p0 + 4, p0 + 5, SUB_ALL, st, false);
        else { const bf16_t* Y[4] = {YF, YL, YS, YM};
            for (int i = 0; i < 4; ++i) n_gemm<EBranch><<<dim3(1024 / 64, T / 64), 256, 0, st>>>(Y[i], in[19] + ((size_t)l * 4 + i) * DM * DM, DM, DM, DM, 0x7fffffff, EBranch{GATES, in[18] + ((size_t)l * 4 + i) * DM, (float*)(ws + WS_MIXF), (bf16_t*)(ws + WS_MIXED), i, 0}); }
        if (cfg & C_WOUT) launch_mega(P, p0 + 5, p0 + 6, SUB_ALL, st, false);
        else n_gemm<EResid><<<dim3(1024 / 64, T / 64), 256, 0, st>>>((const bf16_t*)(ws + WS_MIXED), in[20] + (size_t)l * DM * DM, DM, DM, DM, 0x7fffffff, EResid{xcur, P.out});
        if (cfg & C_NORM2) launch_mega(P, p0 + 6, p0 + 7, SUB_ALL, st, false);
        else n_rmsnorm<<<T / 4, 256, 0, st>>>(P.out, in[21] + l * DM, H, nullptr, nullptr, nullptr, T);
        if (cfg & C_UP) launch_mega(P, p0 + 7, p0 + 8, SUB_ALL, st, false);
        else n_gemm<EStoreBf16><<<dim3(2 * DFF / 64, T / 64), 256, 0, st>>>(H, in[22] + (size_t)l * DM * 2 * DFF, DM, 2 * DFF, DM, 0x7fffffff, EStoreBf16{GV, 2 * DFF, 0});
        if (cfg & C_ACT) launch_mega(P, p0 + 8, p0 + 9, SUB_ALL, st, false);
        else n_act<<<(unsigned)(((size_t)T * DFF + 255) / 256), 256, 0, st>>>(GV, in[23] + (size_t)l * 3 * DFF, in[24] + l * DFF, ACT);
        if (cfg & C_DOWN) launch_mega(P, p0 + 9, p0 + 10, SUB_ALL, st, false);
        else n_gemm<EResid><<<dim3(1024 / 64, T / 64), 256, 0, st>>>(ACT, in[25] + (size_t)l * DFF * DM, DFF, DM, DFF, 0x7fffffff, EResid{P.out, P.out});
    }
}

extern "C" void kernel_launch(void* const* d_in, const int* in_sizes, int n_in, void* d_out, int out_size, void* d_ws, size_t ws_size, hipStream_t stream) {
    if (n_in != 26 || out_size != T * DM || ws_size < WS_NEED) { fprintf(stderr, "kernel_launch: unexpected sizes n_in %d out %d ws %zu (need %zu)\n", n_in, out_size, ws_size, (size_t)WS_NEED); return; }
    if (g_grid == 0) {
        int dev = 0, cus = 0, per_cu = 0;
        hipGetDevice(&dev); hipDeviceGetAttribute(&cus, hipDeviceAttributeMultiprocessorCount, dev);
        if (hipFuncSetAttribute((const void*)mega, hipFuncAttributeMaxDynamicSharedMemorySize, MEGA_LDS) != hipSuccess) fprintf(stderr, "kernel_launch: hipFuncSetAttribute failed\n");
        if (hipOccupancyMaxActiveBlocksPerMultiprocessor(&per_cu, (const void*)mega, MEGA_THREADS, MEGA_LDS) != hipSuccess || per_cu < 1) fprintf(stderr, "kernel_launch: occupancy query says %d\n", per_cu);
        (void)hipGetLastError();
        g_grid = cus;
        if (g_grid != 256) fprintf(stderr, "kernel_launch: %d CUs; the attention phase's static order assumes 256\n", g_grid);
    }
    Ptrs P{};
    for (int i = 0; i < 26; ++i) P.in[i] = (const float*)d_in[i];
    P.out = (float*)d_out; P.ws = (unsigned char*)d_ws;
    if ((CFG) & C_ONE) { (void)hipMemsetAsync((char*)d_ws + WS_BAR, 0, CTL_ZERO_BYTES, stream);
        launch_mega(P, 0, N_PHASES, SUB_ALL, stream, true); }
    else { (void)hipMemsetAsync((char*)d_ws + WS_BAR, 0, CTL_ZERO_BYTES, stream); run_hybrid(P, stream); }
}
```

```cpp
#include <hip/hip_runtime.h>
#include <cstdio>
#include <cstdint>
#include <hip/hip_cooperative_groups.h>

typedef unsigned short bf16_t;
constexpr int BATCH = 2, SEQ = 8192, DM = 1024, DEPTH = 4, T = BATCH * SEQ;
constexpr int NMEM = 256, NIN = 13328, DFF = 2816;
constexpr float EPS = 1e-6f;
constexpr float LOG2E = 1.4426950408889634f;
constexpr float C2 = 0.125f * LOG2E;
constexpr float SB_THR = -104.0f;

__device__ __forceinline__ float bf2f(bf16_t b) { return __uint_as_float(((unsigned)b) << 16); }
__device__ __forceinline__ bf16_t f2bf(float f) { unsigned u = __float_as_uint(f); return (bf16_t)((u + 0x7fffu + ((u >> 16) & 1u)) >> 16); }
__device__ __forceinline__ float bfr(float f) { return bf2f(f2bf(f)); }
__device__ __forceinline__ float wave_sum(float v) {
#pragma unroll
    for (int o = 1; o < 64; o <<= 1) v += __shfl_xor(v, o);
    return v;
}
__device__ __forceinline__ float softplusf(float x) { return fmaxf(x, 0.f) + log1pf(__expf(-fabsf(x))); }
__device__ __forceinline__ float logsigmoidf(float x) { return -softplusf(-x); }
__device__ __forceinline__ float sigmoidf_(float x) { return 1.f / (1.f + __expf(-x)); }
__device__ __forceinline__ float gelu_tanh(float x) { const float u = 0.7978845608028654f * (x + 0.044715f * x * x * x); return 0.5f * x * (1.f + tanhf(u)); }

__device__ __forceinline__ int mk_tid() { int t = threadIdx.x; asm volatile("" : "+v"(t)); return t; }

constexpr size_t MiB = 1u << 20;
constexpr size_t SZ_ACT = (size_t)T * DM * 2;
constexpr size_t WS_CTL = 0;
constexpr size_t WS_H = 1 * MiB;
constexpr size_t WS_PROJ = WS_H + SZ_ACT;
constexpr size_t WS_GATES = WS_PROJ + 9 * SZ_ACT;
constexpr size_t WS_E = WS_GATES + 4 * SZ_ACT;
constexpr size_t WS_LOGF = WS_E + SZ_ACT;
constexpr size_t WS_FB = WS_LOGF + 1 * MiB;
constexpr size_t WS_MQSS = WS_FB + 1 * MiB;
constexpr size_t WS_ESUM = WS_MQSS + 1 * MiB;
constexpr size_t WS_MEMN = WS_ESUM + 1 * MiB;
constexpr size_t WS_MEMRAW = WS_MEMN + 4 * MiB;
constexpr size_t WS_MK = WS_MEMRAW + 16 * MiB;
constexpr size_t WS_MVT = WS_MK + 4 * MiB;
constexpr size_t WS_LRU = WS_MVT + 4 * MiB;
constexpr size_t WS_WT = WS_LRU + 2 * MiB;
constexpr size_t WS_END = WS_WT + 72 * MiB;
constexpr size_t WS_YL = WS_PROJ + 6 * SZ_ACT, WS_YS = WS_H, WS_YM = WS_PROJ + 8 * SZ_ACT, WS_YF = WS_PROJ + 7 * SZ_ACT;
constexpr size_t WS_GV = WS_PROJ;
constexpr size_t WS_ACT = WS_GV + (size_t)T * 2 * DFF * 2;
static_assert(WS_ACT + (size_t)T * DFF * 2 <= WS_GATES, "ffn alias");
constexpr size_t WS_MIXF = WS_END;
constexpr size_t WS_MIXED = WS_PROJ;
constexpr size_t WS_NEED = WS_MIXF + (size_t)T * DM * 4;

struct Ptrs {
    const float* in[26];
    float* out;
    unsigned char* ws;
};

__global__ void __launch_bounds__(256) n_rmsnorm(const float* __restrict__ x, const float* __restrict__ g, bf16_t* __restrict__ H,
                                                 const float* __restrict__ Wf, const float* __restrict__ bfg, float* __restrict__ LOGF, int nrows) {
    const int lane = threadIdx.x & 63, row = blockIdx.x * 4 + (threadIdx.x >> 6);
    if (row >= nrows) return;
    const float4* xr = (const float4*)(x + (size_t)row * DM);
    const float4* gr = (const float4*)g;
    float4 v[4]; float ss = 0.f;
#pragma unroll
    for (int j = 0; j < 4; ++j) { v[j] = xr[lane + 64 * j]; ss += v[j].x * v[j].x + v[j].y * v[j].y + v[j].z * v[j].z + v[j].w * v[j].w; }
    ss = wave_sum(ss);
    const float rstd = rsqrtf(ss * (1.f / DM) + EPS);
#pragma unroll
    for (int j = 0; j < 4; ++j) { const float4 gg = gr[lane + 64 * j]; v[j].x *= rstd * gg.x; v[j].y *= rstd * gg.y; v[j].z *= rstd * gg.z; v[j].w *= rstd * gg.w;
        ushort4 o; o.x = f2bf(v[j].x); o.y = f2bf(v[j].y); o.z = f2bf(v[j].z); o.w = f2bf(v[j].w);
        ((ushort4*)(H + (size_t)row * DM))[lane + 64 * j] = o; }
    if (Wf) {
        float mine = 0.f;
        for (int h = 0; h < 16; ++h) {
            float p = 0.f;
#pragma unroll
            for (int j = 0; j < 4; ++j) { const int k = (lane + 64 * j) * 4;
                p += v[j].x * Wf[(size_t)k * NIN + h] + v[j].y * Wf[(size_t)(k + 1) * NIN + h] + v[j].z * Wf[(size_t)(k + 2) * NIN + h] + v[j].w * Wf[(size_t)(k + 3) * NIN + h]; }
            p = wave_sum(p);
            if (lane == h) mine = p;
        }
        if (lane < 16) { const int b = row / SEQ, t = row % SEQ; LOGF[((size_t)b * 16 + lane) * SEQ + t] = logsigmoidf(mine + bfg[lane]); }
    }
}

struct EStoreBf16 { bf16_t* O; int ldc; int pad; __device__ void operator()(int m, int n, float a) const { O[(size_t)m * ldc + n] = f2bf(a); } };
struct EStoreF32 { float* O; int ldc; int pad; __device__ void operator()(int m, int n, float a) const { O[(size_t)m * ldc + n] = a; } };
struct EBranch { const bf16_t* G; const float* bg; float* MIXF; bf16_t* MIXED; int i; int pad; __device__ void operator()(int m, int n, float a) const { float v = sigmoidf_(bf2f(G[(size_t)m * 4096 + i * 1024 + n]) + bg[n]) * a; const size_t o = (size_t)m * DM + n; if (i > 0) v += MIXF[o]; if (i < 3) MIXF[o] = v; else MIXED[o] = f2bf(v); } };
struct EResid { const float* base; float* out; __device__ void operator()(int m, int n, float a) const { out[(size_t)m * DM + n] = base[(size_t)m * DM + n] + a; } };

template <class Epi> __global__ void __launch_bounds__(256) n_gemm(const bf16_t* __restrict__ A, const float* __restrict__ W, int lda, int ldw, int K, int kmask, Epi epi) {
    __shared__ float As[16][68], Bs[16][68];
    const int tx = threadIdx.x & 15, ty = threadIdx.x >> 4, m0 = blockIdx.y * 64, n0 = blockIdx.x * 64;
    float acc[4][4];
#pragma unroll
    for (int i = 0; i < 4; ++i)
#pragma unroll
        for (int j = 0; j < 4; ++j) acc[i][j] = 0.f;
    for (int k0 = 0; k0 < K; k0 += 16) {
#pragma unroll
        for (int i = 0; i < 4; ++i) { const int idx = threadIdx.x + i * 256; { const int r = idx >> 4, c = idx & 15; As[c][r] = bf2f(A[(size_t)(m0 + r) * lda + k0 + c]); }
            { const int r = idx >> 6, c = idx & 63; Bs[r][c] = bfr(W[(size_t)((k0 + r) & kmask) * ldw + n0 + c]); } }
        __syncthreads();
#pragma unroll
        for (int kk = 0; kk < 16; ++kk) { float a[4], b[4];
#pragma unroll
            for (int i = 0; i < 4; ++i) { a[i] = As[kk][ty * 4 + i]; b[i] = Bs[kk][tx * 4 + i]; }
#pragma unroll
            for (int i = 0; i < 4; ++i)
#pragma unroll
                for (int j = 0; j < 4; ++j) acc[i][j] += a[i] * b[j]; }
        __syncthreads();
    }
#pragma unroll
    for (int i = 0; i < 4; ++i)
#pragma unroll
        for (int j = 0; j < 4; ++j) epi(m0 + ty * 4 + i, n0 + tx * 4 + j, acc[i][j]);
}

__global__ void __launch_bounds__(256) n_headnorm(bf16_t* X, const float* __restrict__ g, int HD, float scale) {
    const int idx = blockIdx.x * 256 + threadIdx.x, nh = DM / HD, row = idx / nh, h = idx % nh;
    if (row >= T) return;
    bf16_t* p = X + (size_t)row * DM + h * HD; float ss = 0.f;
    for (int d = 0; d < HD; ++d) { const float v = bf2f(p[d]); ss += v * v; }
    const float rstd = rsqrtf(ss / HD + EPS) * scale;
    for (int d = 0; d < HD; ++d) p[d] = f2bf(bf2f(p[d]) * rstd * g[d]);
}

__global__ void __launch_bounds__(1024) n_cumsum(const float* __restrict__ LOGF, float* __restrict__ FB) {
    __shared__ float part[1024];
    const int bh = blockIdx.x, tid = threadIdx.x; const float* src = LOGF + (size_t)bh * SEQ + tid * 8; float v[8]; float s = 0.f;
#pragma unroll
    for (int i = 0; i < 8; ++i) { s += src[i]; v[i] = s; }
    part[tid] = s; __syncthreads();
    if (tid == 0) { float run = 0.f; for (int i = 0; i < 1024; ++i) { const float t_ = part[i]; part[i] = run; run += t_; } }
    __syncthreads();
    const float off = part[tid]; float* dst = FB + (size_t)bh * SEQ + tid * 8;
#pragma unroll
    for (int i = 0; i < 8; ++i) dst[i] = off + v[i];
}

__global__ void __launch_bounds__(256) n_fox_attn(const bf16_t* Q, const bf16_t* __restrict__ K, const bf16_t* __restrict__ V, const float* __restrict__ FB, bf16_t* O) {
    __shared__ float Ks[64][64], Vs[64][64], Fs[64];
    const int bh = blockIdx.y, b = bh >> 4, h = bh & 15, tq = blockIdx.x * 256 + threadIdx.x;
    const size_t rowq = (size_t)b * SEQ + tq;
    float q[64], o[64];
#pragma unroll
    for (int d = 0; d < 64; ++d) { q[d] = bf2f(Q[rowq * DM + h * 64 + d]); o[d] = 0.f; }
    const float Ft = FB[(size_t)bh * SEQ + tq];
    float m = -INFINITY, l = 0.f;
    const int ntile = (blockIdx.x * 256 + 256) / 64;
    for (int kt = 0; kt < ntile; ++kt) {
        __syncthreads();
        for (int i = threadIdx.x; i < 64 * 64; i += 256) { const int r = i >> 6, c = i & 63; const size_t rk = ((size_t)b * SEQ + kt * 64 + r) * DM + h * 64 + c; Ks[r][c] = bf2f(K[rk]); Vs[r][c] = bf2f(V[rk]); }
        if (threadIdx.x < 64) Fs[threadIdx.x] = FB[(size_t)bh * SEQ + kt * 64 + threadIdx.x];
        __syncthreads();
        for (int j = 0; j < 64; ++j) {
            const int s = kt * 64 + j; if (s > tq) break;
            float z = 0.f;
#pragma unroll
            for (int d = 0; d < 64; ++d) z += q[d] * Ks[j][d];
            z += (Ft - Fs[j]) * LOG2E;
            if (z > m) { const float c = exp2f(m - z); l *= c;
#pragma unroll
                for (int d = 0; d < 64; ++d) o[d] *= c;
                m = z; }
            const float p = exp2f(z - m); l += p;
#pragma unroll
            for (int d = 0; d < 64; ++d) o[d] += p * Vs[j][d];
        }
    }
    const float il = 1.f / l;
#pragma unroll
    for (int d = 0; d < 64; ++d) O[rowq * DM + h * 64 + d] = f2bf(o[d] * il);
}

__global__ void __launch_bounds__(256) n_sb_attn(const bf16_t* Q, const bf16_t* __restrict__ K, const bf16_t* __restrict__ V, bf16_t* O) {
    __shared__ float Ks[64][64], Vs[64][64];
    const int bh = blockIdx.y, b = bh >> 4, h = bh & 15, tq = blockIdx.x * 256 + threadIdx.x;
    const size_t rowq = (size_t)b * SEQ + tq;
    float q[64], o[64];
#pragma unroll
    for (int d = 0; d < 64; ++d) { q[d] = bf2f(Q[rowq * DM + h * 64 + d]) * 0.125f; o[d] = 0.f; }
    float R = 0.f;
    for (int kt = (blockIdx.x * 256 + 255) / 64; kt >= 0; --kt) {
        if (__syncthreads_and(R < SB_THR)) break;
        for (int i = threadIdx.x; i < 64 * 64; i += 256) { const int r = i >> 6, c = i & 63; const size_t rk = ((size_t)b * SEQ + kt * 64 + r) * DM + h * 64 + c; Ks[r][c] = bf2f(K[rk]); Vs[r][c] = bf2f(V[rk]); }
        __syncthreads();
        for (int j = 63; j >= 0; --j) {
            const int s = kt * 64 + j; if (s >= tq) continue;
            float z = 0.f;
#pragma unroll
            for (int d = 0; d < 64; ++d) z += q[d] * Ks[j][d];
            const float sp = softplusf(z);
            const float w = __expf((z - sp) + R);
            R -= sp;
#pragma unroll
            for (int d = 0; d < 64; ++d) o[d] += w * Vs[j][d];
        }
    }
#pragma unroll
    for (int d = 0; d < 64; ++d) O[rowq * DM + h * 64 + d] = f2bf(o[d]);
}

__global__ void __launch_bounds__(64) n_lru(const bf16_t* LX, const bf16_t* __restrict__ LG, const float* __restrict__ cw, const float* __restrict__ cb,
                                            const float* __restrict__ wa, const float* __restrict__ ba, const float* __restrict__ wx, const float* __restrict__ bx,
                                            const float* __restrict__ lam, bf16_t* YL) {
    __shared__ float xs[64];
    const int b = blockIdx.x >> 4, n = blockIdx.x & 15, e = threadIdx.x, ch = n * 64 + e;
    float wA[64], wX[64];
#pragma unroll
    for (int d = 0; d < 64; ++d) { wA[d] = wa[((size_t)n * 64 + d) * 64 + e]; wX[d] = wx[((size_t)n * 64 + d) * 64 + e]; }
    const float w0 = cw[ch], w1 = cw[DM + ch], w2 = cw[2 * DM + ch], w3 = cw[3 * DM + ch], bc = cb[ch], bA = ba[ch], bX = bx[ch];
    const float spl = softplusf(-lam[ch]);
    float x1 = 0.f, x2 = 0.f, x3 = 0.f, hs = 0.f;
    for (int t = 0; t < SEQ; ++t) {
        const size_t r = ((size_t)b * SEQ + t) * DM + ch;
        const float x0 = bf2f(LX[r]);
        const float xc = bc + w3 * x0 + w2 * x1 + w1 * x2 + w0 * x3;
        x3 = x2; x2 = x1; x1 = x0;
        __syncthreads();
        xs[e] = xc;
        __syncthreads();
        float ra = bA, ri = bX;
#pragma unroll
        for (int d = 0; d < 64; ++d) { const float xv = xs[d]; ra += xv * wA[d]; ri += xv * wX[d]; }
        const float rr = sigmoidf_(ra), ii = sigmoidf_(ri);
        const float la = -8.f * rr * spl;
        const float a = __expf(la);
        const float u = sqrtf(-expm1f(2.f * la)) * (ii * xc);
        hs = a * hs + u;
        YL[r] = f2bf(hs * gelu_tanh(bf2f(LG[r])));
    }
}

__global__ void __launch_bounds__(256) n_memkv_post(const float* __restrict__ raw, const float* __restrict__ gk, const float* __restrict__ gq, bf16_t* __restrict__ MK, bf16_t* __restrict__ MVT) {
    const int row = blockIdx.x, b = row >> 8, m = row & 255, d = threadIdx.x;
    __shared__ float red[4];
    for (int h = 0; h < 4; ++h) {
        const float k = raw[(size_t)row * 2048 + h * 256 + d];
        float ss = wave_sum(k * k);
        __syncthreads();
        if ((threadIdx.x & 63) == 0) red[threadIdx.x >> 6] = ss;
        __syncthreads();
        ss = red[0] + red[1] + red[2] + red[3];
        const float rstd = rsqrtf(ss * (1.f / 256.f) + EPS);
        MK[((size_t)b * 256 + m) * DM + h * 256 + d] = f2bf(k * rstd * gk[d] * gq[d]);
        MVT[(((size_t)b * 4 + h) * 256 + d) * 256 + m] = f2bf(raw[(size_t)row * 2048 + 1024 + h * 256 + d]);
    }
}

__global__ void __launch_bounds__(256) n_mem_attn(const bf16_t* MQ, const bf16_t* __restrict__ MK, const bf16_t* __restrict__ MVT, bf16_t* YM) {
    __shared__ float qs[256], ps[256], red[4];
    const int row = blockIdx.x >> 2, h = blockIdx.x & 3, b = row / SEQ, tid = threadIdx.x;
    const float qv = bf2f(MQ[(size_t)row * DM + h * 256 + tid]);
    float ss = wave_sum(qv * qv);
    if ((tid & 63) == 0) red[tid >> 6] = ss;
    qs[tid] = qv;
    __syncthreads();
    const float rstd = rsqrtf((red[0] + red[1] + red[2] + red[3]) * (1.f / 256.f) + EPS);
    const bf16_t* kr = MK + ((size_t)b * 256 + tid) * DM + h * 256;
    float s = 0.f;
    for (int d = 0; d < 256; ++d) s += qs[d] * bf2f(kr[d]);
    s *= rstd * (1.f / 16.f);
    __syncthreads();
    float mx = s;
#pragma unroll
    for (int o = 1; o < 64; o <<= 1) mx = fmaxf(mx, __shfl_xor(mx, o));
    if ((tid & 63) == 0) red[tid >> 6] = mx;
    __syncthreads();
    mx = fmaxf(fmaxf(red[0], red[1]), fmaxf(red[2], red[3]));
    const float p = __expf(s - mx);
    ps[tid] = p;
    float sum = wave_sum(p);
    __syncthreads();
    if ((tid & 63) == 0) red[tid >> 6] = sum;
    __syncthreads();
    sum = red[0] + red[1] + red[2] + red[3];
    const bf16_t* vr = MVT + (((size_t)b * 4 + h) * 256 + tid) * 256;
    float o = 0.f;
    for (int m = 0; m < 256; ++m) o += ps[m] * bf2f(vr[m]);
    YM[(size_t)row * DM + h * 256 + tid] = f2bf(o / sum);
}

__global__ void __launch_bounds__(256) n_act(const bf16_t* __restrict__ GV, const float* __restrict__ cw, const float* __restrict__ cb, bf16_t* __restrict__ ACT) {
    const size_t idx = (size_t)blockIdx.x * 256 + threadIdx.x; if (idx >= (size_t)T * DFF) return;
    const int r = (int)(idx / DFF), c = (int)(idx % DFF), t = r % SEQ;
    const float g0 = bf2f(GV[(size_t)r * 2 * DFF + c]);
    const float g1 = t >= 1 ? bf2f(GV[(size_t)(r - 1) * 2 * DFF + c]) : 0.f;
    const float g2 = t >= 2 ? bf2f(GV[(size_t)(r - 2) * 2 * DFF + c]) : 0.f;
    const float pre = cb[c] + cw[2 * DFF + c] * g0 + cw[DFF + c] * g1 + cw[c] * g2;
    const float val = bf2f(GV[(size_t)r * 2 * DFF + DFF + c]);
    ACT[(size_t)r * DFF + c] = f2bf(pre * sigmoidf_(pre) * val);
}

#define CFG 32767
namespace pg8 {
#define PG8_LAS __attribute__((address_space(3)))
typedef unsigned short bf16_t;
typedef short bf16x8 __attribute__((ext_vector_type(8)));
typedef float f32x4 __attribute__((ext_vector_type(4)));
typedef unsigned u32x4 __attribute__((ext_vector_type(4)));
constexpr int BM = 256, BK = 64, HALF = 128, HTB = HALF * BK * 2  , STAGE_BYTES = 8 * HTB, NXCD = 8, WGM = 8;

__host__ __device__ __forceinline__ int lds_byte(int r, int c) { const int st = (r >> 4) * 2 + (c >> 5), rr = r & 15, cc = c & 31, ob = rr * 64 + cc * 2; return st * 1024 + (ob ^ (((ob >> 9) & 1) << 5)); }
__host__ __device__ __forceinline__ void stage_rc(int b, int& R, int& C) { const int st = b / 1024, sb = b % 1024, swz = sb ^ (((sb >> 9) & 1) << 5); R = (st >> 1) * 16 + swz / 64; C = (st & 1) * 32 + (swz % 64) / 2; }
__host__ __device__ __forceinline__ int perm32(int rho) { const int n = rho >> 4, i = rho & 15; return 8 * (i >> 2) + 4 * n + (i & 3); }

struct Unit { int pm, pn; };
struct Gemm { int lda, ldb, K; };

struct StaticOrder {
    int nM, nN, nwg, G, c;
    __host__ __device__ void init(int M, int N, int G_, int c_) { nM = M / BM; nN = N / BM; nwg = nM * nN; G = G_; c = c_; }
    __host__ __device__ bool next(int i, Unit& u) const {
        const long L = (long)i * G + c; if (L >= nwg) return false;
        int wgid = (int)L; { const int q = nwg / NXCD, r = nwg % NXCD, xcd = wgid % NXCD, off = wgid / NXCD; wgid = (xcd < r ? xcd * (q + 1) : r * (q + 1) + (xcd - r) * q) + off; }
        const int nig = WGM * nN, gid = wgid / nig, fm = gid * WGM, gsz = (nM - fm) < WGM ? (nM - fm) : WGM;
        u.pm = fm + ((wgid % nig) % gsz); u.pn = (wgid % nig) / gsz; return true;
    }
    __device__ __forceinline__ void a_ready(const Unit&) const {}
    __device__ __forceinline__ void done(const Unit&) const {}
};

__device__ __forceinline__ unsigned cvt_pk_bf16(float lo, float hi) { unsigned r; asm volatile("v_cvt_pk_bf16_f32 %0, %1, %2" : "=v"(r) : "v"(lo), "v"(hi)); return r; }
typedef float f32x2 __attribute__((ext_vector_type(2)));
__device__ __forceinline__ f32x2 gelu_pk(f32x2 v) {
    const f32x2 av = __builtin_elementwise_abs(v), d = av * 0.2316418882f + 1.0f;
    f32x2 t; t.x = __builtin_amdgcn_rcpf(d.x); t.y = __builtin_amdgcn_rcpf(d.y);
    f32x2 q = t * 0.5307027145f + (-0.7265760135f); q = q * t + 0.7107068705f; q = q * t + (-0.142248368f); q = q * t + 0.127414796f; q = q * t;
    const f32x2 s = (v * v) * (-0.72134752044f);
    f32x2 e; e.x = __builtin_amdgcn_exp2f(s.x); e.y = __builtin_amdgcn_exp2f(s.y);
    const f32x2 m = v * (q * e), r = v - m;
    f32x2 o; o.x = v.x < 0.f ? m.x : r.x; o.y = v.y < 0.f ? m.y : r.y; return o;
}

template <class Epi, class Sched, bool ALIGN_EPI = false, bool SP2 = false>
__device__ __forceinline__ void gemm_phase(PG8_LAS unsigned char* lds, const Gemm g, const Sched& S, const Epi& E) {
    const int tid = mk_tid(), wid = __builtin_amdgcn_readfirstlane(tid >> 6), lane = tid & 63, wr = wid >> 2, wc = wid & 3, fr = lane & 15, fq = lane >> 4;
    const int K = g.K, nt = K / BK;
    unsigned voffA[2], voffB[2];
#pragma unroll
    for (int i = 0; i < 2; ++i) { int R, C; stage_rc(tid * 16 + i * 8192, R, C); const int Rb = Epi::PERM ? ((R & ~31) + perm32(R & 31)) : R;
        voffA[i] = (unsigned)(R * g.lda + C) * 2u; voffB[i] = (unsigned)(Rb * g.ldb + C) * 2u; }
    const size_t kstep = (size_t)(BK * 2);
    const size_t hstepA = (size_t)HALF * g.lda * 2, hstepB = (size_t)HALF * g.ldb * 2;
    const unsigned ldsw = (unsigned)wid * 1024u;
    const int aoff = lds_byte(wr * 64 + fr, fq * 8), boff = lds_byte(wc * 32 + fr, fq * 8);
#define PG8_SA(b, h) (((b) * 2 + (h)) * HTB)
#define PG8_SB(b, h) ((4 + (b) * 2 + (h)) * HTB)
#define PG8_STAGE(bufoff, gbase, voff) do { _Pragma("unroll") for (int _i = 0; _i < 2; ++_i) \
        __builtin_amdgcn_global_load_lds((const unsigned*)((const char*)(gbase) + (voff)[_i]), (PG8_LAS unsigned*)(lds + (bufoff) + ldsw + _i * 8192), 16, 0, 0); } while (0)
#define PG8_LDA(dst, b, h) do { _Pragma("unroll") for (int m = 0; m < 4; ++m) _Pragma("unroll") for (int k = 0; k < 2; ++k) dst[m][k] = *(const PG8_LAS bf16x8*)(lds + PG8_SA(b, h) + aoff + m * 2048 + k * 1024); } while (0)
#define PG8_LDB(dst, b, h) do { _Pragma("unroll") for (int n = 0; n < 2; ++n) _Pragma("unroll") for (int k = 0; k < 2; ++k) dst[n][k] = *(const PG8_LAS bf16x8*)(lds + PG8_SB(b, h) + boff + n * 2048 + k * 1024); } while (0)
#define PG8_MMA(ai, bj, At, Bt) do { __builtin_amdgcn_s_setprio(1); _Pragma("unroll") for (int m = 0; m < 4; ++m) _Pragma("unroll") for (int n = 0; n < 2; ++n) _Pragma("unroll") for (int k = 0; k < 2; ++k) \
        acc[ai][bj][m][n] = __builtin_amdgcn_mfma_f32_16x16x32_bf16(Bt[n][k], At[m][k], acc[ai][bj][m][n], 0, 0, 0); __builtin_amdgcn_s_setprio(0); } while (0)
#define PG8_WAIT_V(n) asm volatile("s_waitcnt vmcnt(" #n ")" ::: "memory")
#define PG8_WAIT_L(n) asm volatile("s_waitcnt lgkmcnt(" #n ")" ::: "memory")
#define PG8_BAR __builtin_amdgcn_s_barrier()
#define PG8_SCHED __builtin_amdgcn_sched_barrier(0)
    Unit cur, nxt; int ui = 0;
    if (!S.next(0, cur)) return;
    f32x4 acc[2][2][4][2];
#pragma unroll
    for (int a = 0; a < 2; ++a)
#pragma unroll
        for (int b = 0; b < 2; ++b)
#pragma unroll
            for (int m = 0; m < 4; ++m)
#pragma unroll
                for (int n = 0; n < 2; ++n) acc[a][b][m][n] = (f32x4){0.f, 0.f, 0.f, 0.f};
    bf16x8 At[4][2], B0[2][2], B1[2][2];
    const char* cA = S.aptr(cur); const char* cB = S.bptr(cur);
    S.a_ready(cur);
    if constexpr (SP2) {
        PG8_STAGE(PG8_SB(0, 0), cB, voffB); PG8_STAGE(PG8_SB(0, 1), cB + hstepB, voffB); PG8_STAGE(PG8_SA(0, 0), cA, voffA); PG8_STAGE(PG8_SA(0, 1), cA + hstepA, voffA);
        if (wr == 1) PG8_BAR;
        PG8_WAIT_V(2); PG8_BAR;
        PG8_STAGE(PG8_SB(1, 0), cB + kstep, voffB); PG8_STAGE(PG8_SA(1, 0), cA + kstep, voffA); PG8_STAGE(PG8_SB(1, 1), cB + hstepB + kstep, voffB);
        PG8_WAIT_V(6); PG8_BAR;
    } else {
        PG8_STAGE(PG8_SB(0, 0), cB, voffB); PG8_STAGE(PG8_SA(0, 0), cA, voffA); PG8_STAGE(PG8_SB(0, 1), cB + hstepB, voffB); PG8_STAGE(PG8_SA(0, 1), cA + hstepA, voffA);
        if (wr == 1) PG8_BAR;
        PG8_WAIT_V(4); PG8_BAR;
        PG8_STAGE(PG8_SB(1, 0), cB + kstep, voffB); PG8_STAGE(PG8_SA(1, 0), cA + kstep, voffA); PG8_STAGE(PG8_SB(1, 1), cB + hstepB + kstep, voffB);
        PG8_WAIT_V(6); PG8_BAR;
    }
    for (;;) {
        const bool has_next = S.next(ui + 1, nxt);
        const char* nA = has_next ? S.aptr(nxt) : cA; const char* nB = has_next ? S.bptr(nxt) : cB;
        for (int t = 0; t < nt; t += 2) {
            const bool last = (t == nt - 2);
            const char* a1 = cA + (size_t)(t + 1) * kstep;
            const char* a2 = last ? nA : cA + (size_t)(t + 2) * kstep; const char* b2 = last ? nB : cB + (size_t)(t + 2) * kstep;
            const char* a3 = a2 + kstep; const char* b3 = b2 + kstep;
            if (last && has_next) S.a_ready(nxt);
            if constexpr (SP2) {
            PG8_LDB(B0, 0, 0); PG8_LDB(B1, 0, 1); PG8_SCHED; PG8_LDA(At, 0, 0); PG8_STAGE(PG8_SA(1, 1), a1 + hstepA, voffA);
            PG8_WAIT_V(8); PG8_WAIT_L(0); PG8_BAR; PG8_MMA(0, 0, At, B0); PG8_MMA(0, 1, At, B1); PG8_BAR; PG8_SCHED;
            PG8_LDA(At, 0, 1); PG8_STAGE(PG8_SB(0, 0), b2, voffB); PG8_STAGE(PG8_SB(0, 1), b2 + hstepB, voffB); PG8_STAGE(PG8_SA(0, 0), a2, voffA);
            PG8_WAIT_V(8); PG8_WAIT_L(0); PG8_BAR; PG8_MMA(1, 0, At, B0); PG8_MMA(1, 1, At, B1); PG8_BAR; PG8_SCHED;
            PG8_LDB(B0, 1, 0); PG8_LDB(B1, 1, 1); PG8_SCHED; PG8_LDA(At, 1, 0); PG8_STAGE(PG8_SA(0, 1), a2 + hstepA, voffA);
            PG8_WAIT_V(8); PG8_WAIT_L(0); PG8_BAR; PG8_MMA(0, 0, At, B0); PG8_MMA(0, 1, At, B1); PG8_BAR; PG8_SCHED;
            PG8_LDA(At, 1, 1); PG8_STAGE(PG8_SB(1, 0), b3, voffB); PG8_STAGE(PG8_SB(1, 1), b3 + hstepB, voffB); PG8_STAGE(PG8_SA(1, 0), a3, voffA);
            PG8_WAIT_V(8); PG8_WAIT_L(0); PG8_BAR; PG8_MMA(1, 0, At, B0); PG8_MMA(1, 1, At, B1); PG8_BAR; PG8_SCHED;
            } else {
            PG8_LDB(B0, 0, 0); PG8_SCHED; PG8_LDA(At, 0, 0); PG8_STAGE(PG8_SA(1, 1), a1 + hstepA, voffA);
            PG8_WAIT_L(8); PG8_BAR; PG8_WAIT_L(0); PG8_MMA(0, 0, At, B0); PG8_BAR; PG8_SCHED;
            PG8_LDB(B1, 0, 1); PG8_STAGE(PG8_SB(0, 0), b2, voffB);
            PG8_BAR; PG8_WAIT_L(0); PG8_MMA(0, 1, At, B1); PG8_BAR;
            PG8_LDA(At, 0, 1); PG8_STAGE(PG8_SA(0, 0), a2, voffA);
            PG8_BAR; PG8_WAIT_L(0); PG8_MMA(1, 0, At, B0); PG8_BAR; PG8_SCHED;
            PG8_STAGE(PG8_SB(0, 1), b2 + hstepB, voffB);
            PG8_WAIT_V(6); PG8_BAR; PG8_MMA(1, 1, At, B1); PG8_BAR;
            PG8_LDB(B0, 1, 0); PG8_SCHED; PG8_LDA(At, 1, 0); PG8_STAGE(PG8_SA(0, 1), a2 + hstepA, voffA);
            PG8_WAIT_L(8); PG8_BAR; PG8_WAIT_L(0); PG8_MMA(0, 0, At, B0); PG8_BAR; PG8_SCHED;
            PG8_LDB(B1, 1, 1); PG8_STAGE(PG8_SB(1, 0), b3, voffB);
            PG8_BAR; PG8_WAIT_L(0); PG8_MMA(0, 1, At, B1); PG8_BAR;
            PG8_LDA(At, 1, 1); PG8_STAGE(PG8_SA(1, 0), a3, voffA);
            PG8_BAR; PG8_WAIT_L(0); PG8_MMA(1, 0, At, B0); PG8_BAR; PG8_SCHED;
            PG8_STAGE(PG8_SB(1, 1), b3 + hstepB, voffB);
            PG8_WAIT_V(6); PG8_BAR; PG8_MMA(1, 1, At, B1); PG8_BAR;
            }
        }
        if constexpr (ALIGN_EPI) { if (wr == 0) PG8_BAR; }
        if constexpr (!Epi::AFTER_DRAIN) { int fr_ = fr, fq_ = fq; asm volatile("" : "+v"(fr_), "+v"(fq_));   E(acc, cur, wr, wc, fr_, fq_); S.done(cur); }
        if (!has_next) break;
#pragma unroll
        for (int a = 0; a < 2; ++a)
#pragma unroll
            for (int b = 0; b < 2; ++b)
#pragma unroll
                for (int m = 0; m < 4; ++m)
#pragma unroll
                    for (int n = 0; n < 2; ++n) acc[a][b][m][n] = (f32x4){0.f, 0.f, 0.f, 0.f};
        cur = nxt; cA = nA; cB = nB; ++ui;
        if constexpr (ALIGN_EPI) { if (wr == 1) PG8_BAR; }
    }
    PG8_WAIT_V(0);
    if constexpr (!ALIGN_EPI) { if (wr == 0) PG8_BAR; }
    PG8_BAR;
    if constexpr (Epi::AFTER_DRAIN) { E.fused(acc, cur, wr, wc, fr, fq, lds, wid, lane); S.done(cur); }
#undef PG8_SA
#undef PG8_SB
#undef PG8_STAGE
#undef PG8_LDA
#undef PG8_LDB
#undef PG8_MMA
#undef PG8_WAIT_V
#undef PG8_WAIT_L
#undef PG8_BAR
#undef PG8_SCHED
}
}
#include <hip/hip_bf16.h>
#include <cmath>
namespace attn_body {
using bf16=__hip_bfloat16;
using bf16x8=__attribute__((ext_vector_type(8)))short;
using s16x4=__attribute__((ext_vector_type(4)))short;
using f32x16=__attribute__((ext_vector_type(16)))float;
using u32x4=__attribute__((ext_vector_type(4)))unsigned;
constexpr int BATCH=2,NHEAD=16,SEQ=8192,D=64,DM=NHEAD*D;
constexpr int NW=8,QBLK=32,QB=QBLK*NW,KVBLK=64,NQB=SEQ/QB;
constexpr int ATTN_PITCH=DM, ATTN_UNIT_ROWS=QB;
__device__ __forceinline__ int crow(int r,int hi){return (r&3)+8*(r>>2)+4*hi;}
#define SBAR() __builtin_amdgcn_sched_barrier(0)
__device__ __forceinline__ void cmask(f32x16&p0,f32x16&p1,int jb,int qrel,int hi){
  const float NEG=-INFINITY; int kb=64*jb+4*hi;
  #pragma unroll
  for(int r=0;r<16;++r){int kv=kb+(r&3)+8*(r>>2); if(kv>qrel)p0[r]=NEG; if(kv+32>qrel)p1[r]=NEG;}
}

constexpr int NSLOT=3, SLOTB=8192;
constexpr int LDS_K=0, LDS_V=NSLOT*SLOTB, LDS_WS=2*NSLOT*SLOTB, LDS_OST=LDS_WS+NW*64*4, LDS_BYTES=LDS_OST+NW*4096;
constexpr int BIAS_OFF=86016;
constexpr float C2=0.125f*1.4426950408889634f;
__device__ __forceinline__ void glds16(const void*gsrc,unsigned lds_dst){unsigned keep;
  asm volatile("s_mov_b32 %0, m0\n\ts_mov_b32 m0, %2\n\ts_nop 0\n\tglobal_load_lds_dwordx4 %1, off\n\ts_mov_b32 m0, %0":"=&s"(keep):"v"(gsrc),"s"(lds_dst):"memory");}
__device__ __forceinline__ float max3f(float a,float b,float c){float r;asm("v_max3_f32 %0, %1, %2, %3":"=v"(r):"v"(a),"v"(b),"v"(c));return r;}
__device__ __forceinline__ float max2f(float a,float b){float r;asm("v_max_f32_e32 %0, %1, %2":"=v"(r):"v"(a),"v"(b));return r;}
__device__ __forceinline__ float fadd_s(float a,float b){float r;asm("v_add_f32_e32 %0, %1, %2":"=v"(r):"v"(a),"v"(b));return r;}
__device__ __forceinline__ float fsub_s(float a,float b){float r;asm("v_sub_f32_e32 %0, %1, %2":"=v"(r):"v"(a),"v"(b));return r;}
typedef float f32x2_t __attribute__((ext_vector_type(2))); typedef __bf16 bf16x2_t __attribute__((ext_vector_type(2)));
__device__ __forceinline__ unsigned cvtpk_s(float lo,float hi){f32x2_t v={lo,hi};bf16x2_t b=__builtin_convertvector(v,bf16x2_t);return __builtin_bit_cast(unsigned,b);}
#define WAIT_BAR(N) asm volatile("s_waitcnt vmcnt(" #N ") lgkmcnt(0)\n\ts_barrier":::"memory")

__device__ __forceinline__ void qkt(f32x16&p0,f32x16&p1,const char*Kslot,const bf16x8*qr,const f32x16&negm,int r32,int hi){
  const char*kb=Kslot+hi*1024+r32*16;
  #pragma unroll
  for(int d0=0;d0<4;++d0){
    const bf16x8 b0=*reinterpret_cast<const bf16x8*>(kb+d0*2048);
    const bf16x8 b1=*reinterpret_cast<const bf16x8*>(kb+d0*2048+512);
    if(d0==0){p0=__builtin_amdgcn_mfma_f32_32x32x16_bf16(b0,qr[0],negm,0,0,0);p1=__builtin_amdgcn_mfma_f32_32x32x16_bf16(b1,qr[0],negm,0,0,0);}
    else{p0=__builtin_amdgcn_mfma_f32_32x32x16_bf16(b0,qr[d0],p0,0,0,0);p1=__builtin_amdgcn_mfma_f32_32x32x16_bf16(b1,qr[d0],p1,0,0,0);}}
}
typedef __attribute__((address_space(3))) const char* lds_cptr;
typedef short v4i16_t __attribute__((ext_vector_type(4)));
__device__ __forceinline__ void kload8(bf16x8*kf,lds_cptr kp){
  kf[0]=*(const __attribute__((address_space(3))) bf16x8*)(kp);      kf[1]=*(const __attribute__((address_space(3))) bf16x8*)(kp+512);
  kf[2]=*(const __attribute__((address_space(3))) bf16x8*)(kp+2048); kf[3]=*(const __attribute__((address_space(3))) bf16x8*)(kp+2560);
  kf[4]=*(const __attribute__((address_space(3))) bf16x8*)(kp+4096); kf[5]=*(const __attribute__((address_space(3))) bf16x8*)(kp+4608);
  kf[6]=*(const __attribute__((address_space(3))) bf16x8*)(kp+6144); kf[7]=*(const __attribute__((address_space(3))) bf16x8*)(kp+6656);
}
__device__ __forceinline__ void kload2(bf16x8*kf,lds_cptr kp,int j){ kf[2*j]=*(const __attribute__((address_space(3))) bf16x8*)(kp+j*2048); kf[2*j+1]=*(const __attribute__((address_space(3))) bf16x8*)(kp+j*2048+512); }
__device__ __forceinline__ s16x4 vtr(lds_cptr p){ return __builtin_bit_cast(s16x4,__builtin_amdgcn_ds_read_tr16_b64_v4i16((__attribute__((address_space(3))) v4i16_t*)p)); }
__device__ __forceinline__ float rowmax(const f32x16&p0,const f32x16&p1){
  float a=max3f(p0[0],p0[1],p1[0]),b=max3f(p0[2],p0[3],p1[1]);a=max3f(a,p1[2],p1[3]);
  #pragma unroll
  for(int r=4;r<16;r+=4){a=max3f(a,p0[r],p0[r+1]);b=max3f(b,p0[r+2],p0[r+3]);a=max3f(a,p1[r],p1[r+1]);b=max3f(b,p1[r+2],p1[r+3]);}
  const float m=max2f(a,b);
  auto rr=__builtin_amdgcn_permlane32_swap(__float_as_uint(m),__float_as_uint(m),false,false);
  return max2f(__uint_as_float(rr[0]),__uint_as_float(rr[1]));
}
__device__ __forceinline__ void pv(f32x16*o,int vb,bf16x8 pa0,bf16x8 pa1,bf16x8 pa2,bf16x8 pa3){
  #pragma unroll
  for(int d0=0;d0<2;++d0){s16x4 lo[4],hi[4];
    #pragma unroll
    for(int ks=0;ks<4;++ks){
      asm volatile("ds_read_b64_tr_b16 %0,%1 offset:%c2":"=&v"(lo[ks]):"v"(vb),"i"(d0*4096+ks*1024):"memory");
      asm volatile("ds_read_b64_tr_b16 %0,%1 offset:%c2":"=&v"(hi[ks]):"v"(vb),"i"(d0*4096+ks*1024+512):"memory");}
    asm volatile("s_waitcnt lgkmcnt(0)":::"memory");SBAR();
    #define PK(k) (bf16x8){lo[k][0],lo[k][1],lo[k][2],lo[k][3],hi[k][0],hi[k][1],hi[k][2],hi[k][3]}
    o[d0]=__builtin_amdgcn_mfma_f32_32x32x16_bf16(pa0,PK(0),o[d0],0,0,0);
    o[d0]=__builtin_amdgcn_mfma_f32_32x32x16_bf16(pa1,PK(1),o[d0],0,0,0);
    o[d0]=__builtin_amdgcn_mfma_f32_32x32x16_bf16(pa2,PK(2),o[d0],0,0,0);
    o[d0]=__builtin_amdgcn_mfma_f32_32x32x16_bf16(pa3,PK(3),o[d0],0,0,0);
    #undef PK
  }
}

#ifndef ATTN_STORE16
#define ATTN_STORE16(p,v) (*(u32x4*)(p)=(v))
#endif
template<int THRL> __device__ __forceinline__ void attn_unit(int b,int h,int qb,const bf16*Q,const bf16*__restrict__ K,const bf16*__restrict__ V,bf16*O,const float*__restrict__ FBrow,float skip_thr,char*shm){
  const int tid=mk_tid(),lane=tid&63,r32=lane&31,hi=lane>>5; const int wid=__builtin_amdgcn_readfirstlane(tid>>6);
  const long rowbase=(long)b*SEQ; const int q0=qb*QB;
  int t_start=0;
  { const int ntf=(q0+QB)/KVBLK; const float Fq0=FBrow[q0];
    const bool c0=lane<ntf&&(Fq0-FBrow[64*(lane<ntf?lane:0)+63])*1.4426950408889634f<skip_thr;
    const bool c1=(lane+64)<ntf&&(Fq0-FBrow[64*((lane+64)<ntf?lane+64:0)+63])*1.4426950408889634f<skip_thr;
    int cnt=__popcll(__ballot(c0))+__popcll(__ballot(c1)); cnt&=~1; if(cnt>ntf-4)cnt=ntf-4; t_start=__builtin_amdgcn_readfirstlane(cnt); }
  const bf16*Qw=Q+(rowbase+q0+wid*QBLK)*DM+h*D;
  const bf16*Kh=K+(rowbase+(long)t_start*KVBLK)*DM+h*D,*Vh=V+(rowbase+(long)t_start*KVBLK)*DM+h*D;
  const lds_cptr shm3=(lds_cptr)shm;
  const unsigned lds0=(unsigned)(uintptr_t)shm;
  float*wsf=(float*)(shm+LDS_WS)+wid*64;
  const bf16*ksrc=Kh+(long)lane*DM+wid*8;
  const bf16*vsrc=Vh+(long)(16*(wid&3)+(lane>>2))*DM+(wid>>2)*32+(lane&3)*8;
  const unsigned kdst=lds0+LDS_K+wid*1024, vdst=lds0+LDS_V+wid*1024;
  #define DMA_K(t,slot) glds16(ksrc+(long)(t)*KVBLK*DM,(unsigned)__builtin_amdgcn_readfirstlane(kdst+(slot)))
  #define DMA_V(t,slot) glds16(vsrc+(long)(t)*KVBLK*DM,(unsigned)__builtin_amdgcn_readfirstlane(vdst+(slot)))
  const int vb0=(int)(lds0+LDS_V)+((lane>>4)&1)*32+(lane&3)*8+(4*hi+((lane&15)>>2))*64;
  const char*Kbase=shm+LDS_K; bf16x8 kf[8];
  const lds_cptr kp0=shm3+LDS_K+hi*1024+r32*16; const lds_cptr vp0=shm3+LDS_V+((lane>>4)&1)*32+(lane&3)*8+(4*hi+((lane&15)>>2))*64;
  const int NT=(q0+QB)/KVBLK-t_start;
  {
    typedef __attribute__((address_space(3))) float lds_f32; lds_f32* bl=(lds_f32*)(shm3+BIAS_OFF);
    const int nb=q0+QB; const float Fl=FBrow[nb-1];
    for(int i0=t_start*KVBLK+tid;i0<nb;i0+=8*NW*64){ float fv[8];
      _Pragma("unroll") for(int q=0;q<8;++q){ const int i=i0+q*NW*64; fv[q]=FBrow[i<nb?i:nb-1]; }
      __builtin_amdgcn_sched_barrier(0);
      _Pragma("unroll") for(int q=0;q<8;++q){ const int i=i0+q*NW*64; if(i<nb) bl[i]=(Fl-fv[q])*1.4426950408889634f; } }
    asm volatile("s_waitcnt vmcnt(0) lgkmcnt(0)\n\ts_barrier":::"memory"); }
  typedef float f32x4v __attribute__((ext_vector_type(4)));
  #define BIAS(P0,P1,t) do{ const __attribute__((address_space(3))) f32x4v* bp_=(const __attribute__((address_space(3))) f32x4v*)(shm3+BIAS_OFF)+((t)+t_start)*16+hi; \
    _Pragma("unroll") for(int g_=0;g_<4;++g_){ const f32x4v f0_=bp_[2*g_]+nm, f1_=bp_[8+2*g_]+nm; \
      P0[4*g_]+=f0_[0];P0[4*g_+1]+=f0_[1];P0[4*g_+2]+=f0_[2];P0[4*g_+3]+=f0_[3]; P1[4*g_]+=f1_[0];P1[4*g_+1]+=f1_[1];P1[4*g_+2]+=f1_[2];P1[4*g_+3]+=f1_[3]; } }while(0)
  DMA_K(0,0);DMA_V(0,0);DMA_K(1,SLOTB);
  bf16x8 qr[4];
  #pragma unroll
  for(int d0=0;d0<4;++d0)qr[d0]=*reinterpret_cast<const bf16x8*>(&Qw[(long)r32*DM+d0*16+hi*8]);
  float mhat=0.f,l_reg=0.f;f32x16 o[2];o[0]=f32x16{};o[1]=f32x16{};const f32x16 negm=f32x16{}; float nm=0.f;
  const int qrel=wid*QBLK+r32;
  #define CMASK(P0,P1,t) do{int jb_=(t)-(NT-4); if(jb_>=0)cmask(P0,P1,jb_,qrel,hi);}while(0)
  bool resc=false;
  #define START(P0,P1) do{ const float rm=rowmax(P0,P1); resc=false; \
    { const float dl=rm; mhat=fadd_s(mhat,dl); \
      _Pragma("unroll") for(int r=0;r<16;++r){P0[r]=fsub_s(P0[r],dl);P1[r]=fsub_s(P1[r],dl);} \
      nm=-mhat; } \
    _Pragma("unroll") for(int r=0;r<16;++r)P0[r]=__builtin_amdgcn_exp2f(P0[r]); }while(0)
  #define RESC() do{ if(resc){ asm volatile("s_waitcnt lgkmcnt(0)":::"memory"); \
      _Pragma("unroll") for(int d_=0;d_<2;++d_) _Pragma("unroll") for(int r=0;r<16;++r)o[d_][r]*=wsf[crow(r,hi)]; } }while(0)
  f32x16 pA0,pA1,pB0,pB1;
  int sl_prev=0,sl_cur=0,sl_next=SLOTB;
  #define ROT() do{sl_prev=sl_cur;sl_cur=sl_next;sl_next=(sl_next==(NSLOT-1)*SLOTB)?0:sl_next+SLOTB;}while(0)
  DMA_K(2,2*SLOTB);
  WAIT_BAR(3);
  qkt(pA0,pA1,Kbase,qr,negm,r32,hi);asm volatile("s_nop 15\n\ts_nop 7":"+v"(pA0),"+v"(pA1));BIAS(pA0,pA1,0);CMASK(pA0,pA1,0);
  START(pA0,pA1);
  _Pragma("unroll") for(int r=0;r<16;++r)pA1[r]=__builtin_amdgcn_exp2f(pA1[r]);
  WAIT_BAR(0);
  DMA_K(3,0);DMA_V(1,SLOTB);
  ROT();
  kload8(kf,kp0+sl_cur);
  WAIT_BAR(2);
  s16x4 vlo[8],vhi[8]; u32x4 pw0,pw1,pw2,pw3;
  #define PKW(P,B) cvtpk_s(P[B],P[B+1])
  #define PAF(k) __builtin_bit_cast(bf16x8,pw##k)
  #define VFR(i) (bf16x8){vlo[i][0],vlo[i][1],vlo[i][2],vlo[i][3],vhi[i][0],vhi[i][1],vhi[i][2],vhi[i][3]}
  #define PIN(x) asm volatile("":"+v"(x))
  #define MX3(a,b,c) __builtin_fmaxf(__builtin_fmaxf((a),(b)),(c))
  #define GAPA(MF,A0,A1,A2,A3,W0,W1,PW) do{ MF; sacc+=A0; sacc+=A1; sacc+=A2; sacc+=A3; PIN(sacc); W0; W1; PIN(PW); SBAR(); }while(0)
  #define EX(v) __builtin_amdgcn_exp2f(v)
  #define GAPB(MF,X,B) do{ MF; X[B]=EX(X[B]); X[B+1]=EX(X[B+1]); X[B+2]=EX(X[B+2]); X[B+3]=EX(X[B+3]); PIN(X); SBAR(); }while(0)
  #define VRD(i) do{ vlo[i]=vtr(vp_+(((i)>>2)*4096+((i)&3)*1024)); vhi[i]=vtr(vp_+(((i)>>2)*4096+((i)&3)*1024+512)); }while(0)
  #define KRD(G,j) do{ if(G){ kload2(kf,kp0+sl_next,j); SBAR(); } }while(0)
  #define STEP(C0,C1,P0,P1,t,GK,GV,GL) do{ SBAR(); \
    const lds_cptr vp_=vp0+sl_prev; \
    VRD(0); SBAR(); float sacc=(P0[0]+P0[1]); \
    GAPA(C0=__builtin_amdgcn_mfma_f32_32x32x16_bf16(kf[0],qr[0],negm,0,0,0), P0[2],P0[3],P0[4],P0[5],     pw0[0]=PKW(P0,0), pw0[1]=PKW(P0,2), pw0); \
    VRD(4); SBAR(); GAPA(C1=__builtin_amdgcn_mfma_f32_32x32x16_bf16(kf[1],qr[0],negm,0,0,0), P0[6],P0[7],P0[8],P0[9],     pw0[2]=PKW(P0,4), pw0[3]=PKW(P0,6), pw0); \
    VRD(1); SBAR(); GAPA(C0=__builtin_amdgcn_mfma_f32_32x32x16_bf16(kf[2],qr[1],C0,0,0,0),   P0[10],P0[11],P0[12],P0[13], pw1[0]=PKW(P0,8), pw1[1]=PKW(P0,10), pw1); \
    VRD(5); SBAR(); GAPA(C1=__builtin_amdgcn_mfma_f32_32x32x16_bf16(kf[3],qr[1],C1,0,0,0),   P0[14],P0[15],P1[0],P1[1],   pw1[2]=PKW(P0,12),pw1[3]=PKW(P0,14), pw1); \
    VRD(2); SBAR(); GAPA(C0=__builtin_amdgcn_mfma_f32_32x32x16_bf16(kf[4],qr[2],C0,0,0,0),   P1[2],P1[3],P1[4],P1[5],     pw2[0]=PKW(P1,0), pw2[1]=PKW(P1,2), pw2); \
    VRD(6); SBAR(); GAPA(C1=__builtin_amdgcn_mfma_f32_32x32x16_bf16(kf[5],qr[2],C1,0,0,0),   P1[6],P1[7],P1[8],P1[9],     pw2[2]=PKW(P1,4), pw2[3]=PKW(P1,6), pw2); \
    VRD(3); SBAR(); GAPA(C0=__builtin_amdgcn_mfma_f32_32x32x16_bf16(kf[6],qr[3],C0,0,0,0),   P1[10],P1[11],P1[12],P1[13], pw3[0]=PKW(P1,8), pw3[1]=PKW(P1,10), pw3); \
    VRD(7); SBAR(); GAPA(C1=__builtin_amdgcn_mfma_f32_32x32x16_bf16(kf[7],qr[3],C1,0,0,0),   P1[14],P1[15],0.f,0.f,       pw3[2]=PKW(P1,12),pw3[3]=PKW(P1,14), pw3); \
    l_reg+=sacc; \
    if(GK){DMA_K((t)+3,sl_cur);} if(GV){DMA_V((t)+1,sl_next);} \
    BIAS(C0,C1,t); CMASK(C0,C1,t); \
    { float a=MX3(C0[0],C0[1],C1[0]),b=MX3(C0[2],C0[3],C1[1]); a=MX3(a,C1[2],C1[3]); \
      _Pragma("unroll") for(int r=4;r<16;r+=4){a=MX3(a,C0[r],C0[r+1]);b=MX3(b,C0[r+2],C0[r+3]);a=MX3(a,C1[r],C1[r+1]);b=MX3(b,C1[r+2],C1[r+3]);} \
      float rm=__builtin_fmaxf(a,b); { auto rr=__builtin_amdgcn_permlane32_swap(__float_as_uint(rm),__float_as_uint(rm),false,false); rm=__builtin_fmaxf(__uint_as_float(rr[0]),__uint_as_float(rr[1])); } \
      resc=false; \
      if(__builtin_expect(__any(rm>(float)THRL),0)){ const float dl=__builtin_fmaxf(rm,0.f); mhat+=dl; \
        _Pragma("unroll") for(int r=0;r<16;++r){C0[r]-=dl;C1[r]-=dl;} \
        nm=-mhat; \
        const float f=__builtin_amdgcn_exp2f(-dl); l_reg*=f; if(hi==0)wsf[r32]=f; resc=true; } } \
    SBAR(); \
    GAPB(o[0]=__builtin_amdgcn_mfma_f32_32x32x16_bf16(PAF(0),VFR(0),o[0],0,0,0), C0,0); \
    GAPB(o[1]=__builtin_amdgcn_mfma_f32_32x32x16_bf16(PAF(0),VFR(4),o[1],0,0,0), C0,4); \
    KRD(GL,0); GAPB(o[0]=__builtin_amdgcn_mfma_f32_32x32x16_bf16(PAF(1),VFR(1),o[0],0,0,0), C0,8); \
    KRD(GL,1); GAPB(o[1]=__builtin_amdgcn_mfma_f32_32x32x16_bf16(PAF(1),VFR(5),o[1],0,0,0), C0,12); \
    KRD(GL,2); GAPB(o[0]=__builtin_amdgcn_mfma_f32_32x32x16_bf16(PAF(2),VFR(2),o[0],0,0,0), C1,0); \
    KRD(GL,3); GAPB(o[1]=__builtin_amdgcn_mfma_f32_32x32x16_bf16(PAF(2),VFR(6),o[1],0,0,0), C1,4); \
    GAPB(o[0]=__builtin_amdgcn_mfma_f32_32x32x16_bf16(PAF(3),VFR(3),o[0],0,0,0), C1,8); \
    GAPB(o[1]=__builtin_amdgcn_mfma_f32_32x32x16_bf16(PAF(3),VFR(7),o[1],0,0,0), C1,12); \
    }while(0)
  int t=1;
  #undef CMASK
  #define CMASK(P0,P1,t) do{}while(0)
  for(;t+5<NT;t+=2){
    STEP(pB0,pB1,pA0,pA1,t,true,true,true);     WAIT_BAR(2); RESC(); ROT();
    STEP(pA0,pA1,pB0,pB1,t+1,true,true,true);   WAIT_BAR(2); RESC(); ROT();
  }
  #undef CMASK
  #define CMASK(P0,P1,t) do{int jb_=(t)-(NT-4); if(jb_>=0)cmask(P0,P1,jb_,qrel,hi);}while(0)
  #define ENDW(tt) do{ if((tt)+3<NT){WAIT_BAR(2);} else if((tt)+2<NT){WAIT_BAR(1);} else {WAIT_BAR(0);} }while(0)
  for(;t+1<NT;t+=2){
    STEP(pB0,pB1,pA0,pA1,t,(t+3<NT),(t+1<NT),(t+1<NT));       ENDW(t);   RESC(); ROT();
    STEP(pA0,pA1,pB0,pB1,t+1,(t+4<NT),(t+2<NT),(t+2<NT));     ENDW(t+1); RESC(); ROT();
  }
  STEP(pB0,pB1,pA0,pA1,NT-1,false,false,false); RESC();
  { float sacc=pB0[0]+pB0[1]; _Pragma("unroll") for(int r=2;r<16;++r)sacc+=pB0[r]; _Pragma("unroll") for(int r=0;r<16;++r)sacc+=pB1[r]; l_reg+=sacc;
    pw0=(u32x4){PKW(pB0,0),PKW(pB0,2),PKW(pB0,4),PKW(pB0,6)};pw1=(u32x4){PKW(pB0,8),PKW(pB0,10),PKW(pB0,12),PKW(pB0,14)};pw2=(u32x4){PKW(pB1,0),PKW(pB1,2),PKW(pB1,4),PKW(pB1,6)};pw3=(u32x4){PKW(pB1,8),PKW(pB1,10),PKW(pB1,12),PKW(pB1,14)};
    SBAR(); pv(o,vb0+sl_cur,PAF(0),PAF(1),PAF(2),PAF(3)); }
  #undef PKW
  #undef PAF
  #undef VFR
  #undef PIN
  #undef MX3
  #undef GAPA
  #undef GAPB
  #undef EX
  #undef VRD
  #undef KRD
  #undef STEP
  #undef ENDW
  {auto rr=__builtin_amdgcn_permlane32_swap(__float_as_uint(l_reg),__float_as_uint(l_reg),false,false);l_reg=__uint_as_float(rr[0])+__uint_as_float(rr[1]);}
  if(hi==0)wsf[32+r32]=l_reg;asm volatile("s_waitcnt lgkmcnt(0)":::"memory");
  float rli[16];
  #pragma unroll
  for(int r=0;r<16;++r)rli[r]=__builtin_amdgcn_rcpf(wsf[32+crow(r,hi)]);
  bf16*Ow=O+(rowbase+q0+wid*QBLK)*DM+h*D;
  { bf16*stg=(bf16*)(shm+LDS_OST)+wid*2048;
    #pragma unroll
    for(int r=0;r<16;++r){const int orow=crow(r,hi);
      #pragma unroll
      for(int d0=0;d0<2;++d0)stg[orow*64+d0*32+r32]=__float2bfloat16(o[d0][r]*rli[r]);}
    asm volatile("s_waitcnt lgkmcnt(0)":::"memory");
    #pragma unroll
    for(int i=0;i<4;++i){const int row=i*8+(lane>>3),ch=lane&7; const u32x4 v=*(const u32x4*)(stg+row*64+ch*8); ATTN_STORE16(Ow+(long)row*DM+ch*8,v);} }
  asm volatile("s_waitcnt lgkmcnt(0)\n\ts_barrier":::"memory");
  #undef BIAS
  #undef DMA_K
  #undef DMA_V
  #undef CMASK
  #undef START
  #undef RESC
  #undef ROT
}
constexpr int ATTN_LDS_BYTES=86016+32768;
struct AttnTensors { const bf16* Q; const bf16* K; const bf16* V; bf16* O; const float* FB; float skip_thr; int pad; };
struct AttnUnit { int bh; int qb; };
struct StaticOrder {
  int vcu;
  __device__ __forceinline__ explicit StaticOrder(int grid,int block):vcu((block%8)*(grid/8)+block/8){}
  __device__ __forceinline__ bool next(int i,AttnUnit&u)const{ if(i>=4)return false; const int s=vcu&7; u.bh=vcu>>3; u.qb=(i==0)?s:(i==1)?15-s:(i==2)?16+s:31-s; return true; }
  __device__ __forceinline__ void a_ready(const AttnUnit&)const{}
  __device__ __forceinline__ void done(const AttnUnit&)const{}
};
struct QueueOrder {
  unsigned* ctr; int xl; volatile __attribute__((address_space(3))) int* slot;
  __device__ __forceinline__ bool next(int,AttnUnit&u)const{
    if(mk_tid()==0){ int got=-1;
      for(int k=0;k<8&&got<0;++k){ const int q=(xl+k)&7; const int j=(int)__hip_atomic_fetch_add(ctr+q*64,1u,__ATOMIC_RELAXED,__HIP_MEMORY_SCOPE_AGENT); if(j<128)got=q*128+j; }
      *slot=got; }
    __syncthreads(); const int g=*slot; if(g<0)return false; const int q=g>>7,j=g&127; u.bh=q*4+(j&3); u.qb=31-(j>>2); return true; }
  __device__ __forceinline__ void a_ready(const AttnUnit&)const{}
  __device__ __forceinline__ void done(const AttnUnit&)const{}
};
template<class Sched,int THRL=8> __device__ __forceinline__ void attn_phase(char*lds,const AttnTensors&T,const Sched&S){
  AttnUnit u;
  for(int i=0;S.next(i,u);++i){ S.a_ready(u); attn_unit<THRL>(u.bh/NHEAD,u.bh%NHEAD,u.qb,T.Q,T.K,T.V,T.O,T.FB+(size_t)u.bh*SEQ,T.skip_thr,lds); S.done(u); }
}
#undef SBAR
#undef WAIT_BAR
}
namespace cg = cooperative_groups;
#define LAS __attribute__((address_space(3)))
#define LDS_WAIT() asm volatile("s_waitcnt lgkmcnt(0)" ::: "memory")
#define LDS_BAR() asm volatile("s_waitcnt lgkmcnt(0)\n\ts_barrier" ::: "memory")
constexpr int MEGA_THREADS = 512, MEGA_LDS = 147456, NWV = 8;
#define GAS __attribute__((address_space(1)))
#define XB_TMO      128
#define XB_XCNT(j)  (256  + 64 * (j))
#define XB_XSUB(j)  (1280 + 64 * (j))
#define XB_XGEN(j)  (2304 + 64 * (j))
#define XB_TOP      3328
#define XB_TOPGEN   3392
#define XCD_BAR_WORDS 3456
#define XB_SPIN_CAP (1u << 18)

__device__ __forceinline__ unsigned xb_ld(unsigned* p)              { return __hip_atomic_load(p, __ATOMIC_RELAXED, __HIP_MEMORY_SCOPE_AGENT); }
__device__ __forceinline__ unsigned xb_add(unsigned* p, unsigned v) { return __hip_atomic_fetch_add(p, v, __ATOMIC_RELAXED, __HIP_MEMORY_SCOPE_AGENT); }
__device__ __forceinline__ unsigned xb_xcc_id() { return (unsigned)__builtin_amdgcn_s_getreg((3 << 11) | 20) & 0xFu; }
#define XB_SPIN(cond, bar) do { unsigned _sp = 0; while (cond) { __builtin_amdgcn_s_sleep(1); \
    if ((++_sp & 255u) == 0u) { if (xb_ld(&(bar)[XB_TMO])) break; if (_sp > XB_SPIN_CAP) { atomicAdd(&(bar)[XB_TMO], 1u); break; } } } } while (0)

struct XcdBarrier {
    unsigned* bar; unsigned x;
    volatile LAS unsigned* st;
};

__device__ __forceinline__ XcdBarrier xcd_barrier_post(unsigned* bar, volatile LAS unsigned* st) {
    XcdBarrier b; b.bar = bar; b.x = xb_xcc_id(); b.st = st;
    if (threadIdx.x == 0) (void)xb_add(&bar[XB_XCNT(b.x)], 1u);
    return b;
}
__device__ __forceinline__ void xcd_barrier_complete(unsigned* bar, unsigned x, unsigned& nloc, unsigned& nx) {
    const unsigned G = gridDim.x * gridDim.y * gridDim.z;
    unsigned sum, cnt, mine, sp = 0u;
    for (;;) {
        sum = 0u; cnt = 0u; mine = 0u;
#pragma unroll
        for (unsigned j = 0; j < 16; ++j) { const unsigned c = xb_ld(&bar[XB_XCNT(j)]); sum += c; cnt += (c > 0u) ? 1u : 0u; mine = (j == x) ? c : mine; }
        if (sum == G) break;
        __builtin_amdgcn_s_sleep(1);
        if ((++sp & 255u) == 0u) { if (xb_ld(&bar[XB_TMO])) break; if (sp > XB_SPIN_CAP) { atomicAdd(&bar[XB_TMO], 1u); break; } }
    }
    nloc = mine > 0u ? mine : 1u; nx = cnt > 0u ? cnt : 1u;
}

__device__ __forceinline__ void xcd_barrier(const XcdBarrier& b) {
    asm volatile("s_waitcnt vmcnt(0)" ::: "memory");
    __syncthreads();
    if (threadIdx.x == 0) {
        unsigned* bar = b.bar;
        __builtin_amdgcn_s_waitcnt(0);
        unsigned nloc = b.st[0], nx = b.st[1];
        if (nloc == 0u) { xcd_barrier_complete(bar, b.x, nloc, nx); b.st[0] = nloc; b.st[1] = nx; }
        const unsigned old = xb_add(&bar[XB_XSUB(b.x)], 1u);
        const unsigned gen = old / nloc;
        if (old + 1u == (gen + 1u) * nloc) {
            __builtin_amdgcn_fence(__ATOMIC_RELEASE, "agent");
            asm volatile("s_waitcnt vmcnt(0)" ::: "memory");
            const unsigned og = xb_add(&bar[XB_TOP], 1u);
            const unsigned tg = og / nx;
            if (og + 1u == (tg + 1u) * nx) xb_add(&bar[XB_TOPGEN], 1u);
            else XB_SPIN(xb_ld(&bar[XB_TOPGEN]) == tg, bar);
            __builtin_amdgcn_fence(__ATOMIC_ACQUIRE, "agent");
            xb_add(&bar[XB_XGEN(b.x)], 1u);
            asm volatile("s_waitcnt vmcnt(0)" ::: "memory");
        } else {
            XB_SPIN(xb_ld(&bar[XB_XGEN(b.x)]) == gen, bar);
            __builtin_amdgcn_fence(__ATOMIC_ACQUIRE, "agent");
            asm volatile("s_waitcnt vmcnt(0)" ::: "memory");
        }
    }
    __syncthreads();
}
constexpr size_t WS_BAR = WS_CTL + 16384;
constexpr size_t WS_QCTR = WS_CTL + 32768;
constexpr size_t CTL_ZERO_BYTES = 65536 - 16384;
constexpr int XB_LDS_OFF = MEGA_LDS - 64;
constexpr size_t WT_IN = 0;
constexpr size_t WT_BR = WT_IN + (size_t)13312 * 1024 * 2;
constexpr size_t WT_OUT = WT_BR + (size_t)4096 * 1024 * 2;
constexpr size_t WT_UP = WT_OUT + (size_t)1024 * 1024 * 2;
constexpr size_t WT_DN = WT_UP + (size_t)5632 * 1024 * 2;
static_assert(WT_DN + (size_t)1024 * 2816 * 2 <= 72 * MiB, "weight copies");
constexpr size_t WS_WKVT = WS_GATES;
constexpr size_t WS_CB = WS_CTL + 4096;

typedef float f32x4 __attribute__((ext_vector_type(4)));
typedef unsigned u32x4 __attribute__((ext_vector_type(4)));
typedef short bf16x8_t __attribute__((ext_vector_type(8)));
typedef float f32x16_t __attribute__((ext_vector_type(16)));
__device__ __forceinline__ unsigned pk2(float lo, float hi) { return (unsigned)f2bf(lo) | ((unsigned)f2bf(hi) << 16); }
__device__ __forceinline__ float blo(unsigned u) { return __uint_as_float(u << 16); }
__device__ __forceinline__ float bhi(unsigned u) { return __uint_as_float(u & 0xffff0000u); }
__device__ __forceinline__ float fast_softplus(float x) { return fmaxf(x, 0.f) + __logf(1.f + __expf(-fabsf(x))); }
__device__ __forceinline__ float fast_sigmoid(float x) { return __builtin_amdgcn_rcpf(1.f + __expf(-x)); }
__device__ __forceinline__ float fast_tanh(float x) { const float e = __expf(-2.f * fabsf(x)); const float t = (1.f - e) * __builtin_amdgcn_rcpf(1.f + e); return x < 0.f ? -t : t; }
__device__ __forceinline__ float fast_gelu(float x) { const float u = 0.7978845608028654f * (x + 0.044715f * x * x * x); return 0.5f * x * (1.f + fast_tanh(u)); }

template <class Loc> struct LocOrder {
    pg8::StaticOrder so; Loc loc;
    __device__ __forceinline__ bool next(int i, pg8::Unit& u) const { return so.next(i, u); }
    __device__ __forceinline__ const char* aptr(const pg8::Unit& u) const { return loc.a(u); }
    __device__ __forceinline__ const char* bptr(const pg8::Unit& u) const { return loc.b(u); }
    __device__ __forceinline__ void a_ready(const pg8::Unit&) const {}
    __device__ __forceinline__ void done(const pg8::Unit&) const {}
};
struct LocStd { const char* A; const char* Bt; size_t astep, bstep;
    __device__ __forceinline__ const char* a(const pg8::Unit& u) const { return A + (size_t)u.pm * astep; }
    __device__ __forceinline__ const char* b(const pg8::Unit& u) const { return Bt + (size_t)u.pn * bstep; } };
struct LocBranch { const char* Y0; const char* Y1; const char* Y2; const char* Y3; const char* Bt;
    __device__ __forceinline__ const char* a(const pg8::Unit& u) const { const int i = u.pn >> 2; const char* y = i == 0 ? Y0 : i == 1 ? Y1 : i == 2 ? Y2 : Y3; return y + (size_t)u.pm * (256 * 1024 * 2); }
    __device__ __forceinline__ const char* b(const pg8::Unit& u) const { return Bt + (size_t)u.pn * (256 * 1024 * 2); } };
struct LocMemKV { const char* A; const char* Bt;
    __device__ __forceinline__ const char* a(const pg8::Unit& u) const { return A + (size_t)u.pm * (256 * 1024 * 2); }
    __device__ __forceinline__ const char* b(const pg8::Unit& u) const { return Bt + ((size_t)(u.pm >> 1) * 2048 + (size_t)u.pn * 256) * 2048; } };
struct LocMemS { const char* MQ; const char* MK;
    __device__ __forceinline__ const char* a(const pg8::Unit& u) const { return MQ + (size_t)u.pm * (256 * 2048) + u.pn * 512; }
    __device__ __forceinline__ const char* b(const pg8::Unit& u) const { return MK + (size_t)(u.pm >> 5) * (256 * 2048) + u.pn * 512; } };
struct LocMemPV { const char* E; const char* MVT;
    __device__ __forceinline__ const char* a(const pg8::Unit& u) const { return E + (size_t)u.pm * (256 * 2048) + u.pn * 512; }
    __device__ __forceinline__ const char* b(const pg8::Unit& u) const { return MVT + ((size_t)(u.pm >> 5) * 4 + u.pn) * (256 * 256 * 2); } };

struct BranchSched { int vcu; LocBranch loc;
    __device__ __forceinline__ bool next(int i, pg8::Unit& u) const { if (i >= 4) return false; u.pm = vcu >> 2; u.pn = i * 4 + (vcu & 3); return true; }
    __device__ __forceinline__ const char* aptr(const pg8::Unit& u) const { return loc.a(u); }
    __device__ __forceinline__ const char* bptr(const pg8::Unit& u) const { return loc.b(u); }
    __device__ __forceinline__ void a_ready(const pg8::Unit&) const {}
    __device__ __forceinline__ void done(const pg8::Unit&) const {}
};
typedef f32x4 AccT[2][2][4][2];
struct EpiProj { static constexpr bool PERM = true, AFTER_DRAIN = false; bf16_t* proj; bf16_t* gates; float* mqss;
    __device__ __forceinline__ void operator()(const AccT& acc, const pg8::Unit& u, int wr, int wc, int fr, int fq) const {
        int colt = u.pn * 256; const int grp = colt >> 10; bf16_t* base; int ldc;
        if (grp < 9) { base = proj + (size_t)grp * T * DM; ldc = DM; colt &= 1023; } else { base = gates; ldc = 4096; colt -= 9216; }
        const int row0 = u.pm * 256 + wr * 64 + fr, col0 = colt + wc * 32 + 8 * fq;
#pragma unroll
        for (int ai = 0; ai < 2; ++ai)
#pragma unroll
            for (int m = 0; m < 4; ++m) { const int row = row0 + ai * 128 + m * 16; bf16_t* rowp = base + (size_t)row * ldc + col0; float ss = 0.f;
#pragma unroll
                for (int bj = 0; bj < 2; ++bj) { const f32x4 v0 = acc[ai][bj][m][0], v1 = acc[ai][bj][m][1]; u32x4 w; w.x = pk2(v0[0], v0[1]); w.y = pk2(v0[2], v0[3]); w.z = pk2(v1[0], v1[1]); w.w = pk2(v1[2], v1[3]);
                    *(u32x4*)(rowp + bj * 128) = w;
                    if (grp == 8) { ss += blo(w.x) * blo(w.x) + bhi(w.x) * bhi(w.x) + blo(w.y) * blo(w.y) + bhi(w.y) * bhi(w.y) + blo(w.z) * blo(w.z) + bhi(w.z) * bhi(w.z) + blo(w.w) * blo(w.w) + bhi(w.w) * bhi(w.w); } }
                if (grp == 8) { ss += __shfl_xor(ss, 16); ss += __shfl_xor(ss, 32); if (fq == 0) mqss[(size_t)row * 16 + (colt >> 8) * 4 + wc] = ss; } }
    } };
struct EpiBf16P { static constexpr bool PERM = true, AFTER_DRAIN = false; bf16_t* O; int ldc; int pad;
    __device__ __forceinline__ void operator()(const AccT& acc, const pg8::Unit& u, int wr, int wc, int fr, int fq) const {
        const int row0 = u.pm * 256 + wr * 64 + fr, col0 = u.pn * 256 + wc * 32 + 8 * fq;
#pragma unroll
        for (int ai = 0; ai < 2; ++ai)
#pragma unroll
            for (int m = 0; m < 4; ++m) { bf16_t* rowp = O + (size_t)(row0 + ai * 128 + m * 16) * ldc + col0;
#pragma unroll
                for (int bj = 0; bj < 2; ++bj) { const f32x4 v0 = acc[ai][bj][m][0], v1 = acc[ai][bj][m][1]; u32x4 w; w.x = pk2(v0[0], v0[1]); w.y = pk2(v0[2], v0[3]); w.z = pk2(v1[0], v1[1]); w.w = pk2(v1[2], v1[3]);
                    *(u32x4*)(rowp + bj * 128) = w; } }
    } };
struct EpiF32 { static constexpr bool PERM = false, AFTER_DRAIN = false; float* O; int ldc; int pad;
    __device__ __forceinline__ void operator()(const AccT& acc, const pg8::Unit& u, int wr, int wc, int fr, int fq) const {
        const int row0 = u.pm * 256 + wr * 64 + fr, col0 = u.pn * 256 + wc * 32 + 4 * fq;
#pragma unroll
        for (int ai = 0; ai < 2; ++ai)
#pragma unroll
            for (int m = 0; m < 4; ++m) { float* rowp = O + (size_t)(row0 + ai * 128 + m * 16) * ldc + col0;
#pragma unroll
                for (int bj = 0; bj < 2; ++bj)
#pragma unroll
                    for (int n = 0; n < 2; ++n) *(f32x4*)(rowp + bj * 128 + n * 16) = acc[ai][bj][m][n]; }
    } };
struct EpiResid { static constexpr bool PERM = false, AFTER_DRAIN = false; const float* base; float* out;
    __device__ __forceinline__ void operator()(const AccT& acc, const pg8::Unit& u, int wr, int wc, int fr, int fq) const {
        const int row0 = u.pm * 256 + wr * 64 + fr, col0 = u.pn * 256 + wc * 32 + 4 * fq;
        const float* __restrict__ bp = base; float* __restrict__ op = out;
#pragma unroll
        for (int ai = 0; ai < 2; ++ai)
#pragma unroll
            for (int mp = 0; mp < 2; ++mp) { f32x4 bv[2][2][2];
#pragma unroll
                for (int mm = 0; mm < 2; ++mm) { const size_t off = (size_t)(row0 + ai * 128 + (2 * mp + mm) * 16) * DM + col0;
#pragma unroll
                    for (int bj = 0; bj < 2; ++bj)
#pragma unroll
                        for (int n = 0; n < 2; ++n) bv[mm][bj][n] = *(const f32x4*)(bp + off + bj * 128 + n * 16); }
                __builtin_amdgcn_sched_barrier(0);
#pragma unroll
                for (int mm = 0; mm < 2; ++mm) { const size_t off = (size_t)(row0 + ai * 128 + (2 * mp + mm) * 16) * DM + col0;
#pragma unroll
                    for (int bj = 0; bj < 2; ++bj)
#pragma unroll
                        for (int n = 0; n < 2; ++n) *(f32x4*)(op + off + bj * 128 + n * 16) = bv[mm][bj][n] + acc[ai][bj][2 * mp + mm][n]; }
                asm volatile("" ::: "memory"); }
    } };
struct EpiBranch { static constexpr bool PERM = true, AFTER_DRAIN = false; const bf16_t* G; const float* bg; float* MIXF; bf16_t* MIXED;
    __device__ __forceinline__ void operator()(const AccT& acc, const pg8::Unit& u, int wr, int wc, int fr, int fq) const {
        const int i = u.pn >> 2, row0 = u.pm * 256 + wr * 64 + fr, gcol0 = u.pn * 256 + wc * 32 + 8 * fq, mcol0 = (u.pn & 3) * 256 + wc * 32 + 8 * fq;
        const float* __restrict__ mfr = MIXF; float* __restrict__ mfw = MIXF; bf16_t* __restrict__ mxw = MIXED; const bf16_t* __restrict__ gr = G;
        f32x4 b0[2], b1[2];
#pragma unroll
        for (int bj = 0; bj < 2; ++bj) { b0[bj] = *(const f32x4*)(bg + gcol0 + bj * 128); b1[bj] = *(const f32x4*)(bg + gcol0 + bj * 128 + 4); }
#pragma unroll
        for (int ai = 0; ai < 2; ++ai)
#pragma unroll
            for (int m = 0; m < 4; ++m) { const int row = row0 + ai * 128 + m * 16; const bf16_t* gp = gr + (size_t)row * 4096 + gcol0; const size_t mo = (size_t)row * DM + mcol0;
                u32x4 gw[2]; f32x4 p0[2], p1[2];
#pragma unroll
                for (int bj = 0; bj < 2; ++bj) { gw[bj] = *(const u32x4*)(gp + bj * 128);
                    if (i > 0) { p0[bj] = *(const f32x4*)(mfr + mo + bj * 128); p1[bj] = *(const f32x4*)(mfr + mo + bj * 128 + 4); } else { p0[bj] = (f32x4){0.f, 0.f, 0.f, 0.f}; p1[bj] = (f32x4){0.f, 0.f, 0.f, 0.f}; } }
                __builtin_amdgcn_sched_barrier(0);
#pragma unroll
                for (int bj = 0; bj < 2; ++bj) { f32x4 v0 = acc[ai][bj][m][0], v1 = acc[ai][bj][m][1]; const u32x4 g = gw[bj];
                    v0[0] *= fast_sigmoid(blo(g.x) + b0[bj][0]); v0[1] *= fast_sigmoid(bhi(g.x) + b0[bj][1]); v0[2] *= fast_sigmoid(blo(g.y) + b0[bj][2]); v0[3] *= fast_sigmoid(bhi(g.y) + b0[bj][3]);
                    v1[0] *= fast_sigmoid(blo(g.z) + b1[bj][0]); v1[1] *= fast_sigmoid(bhi(g.z) + b1[bj][1]); v1[2] *= fast_sigmoid(blo(g.w) + b1[bj][2]); v1[3] *= fast_sigmoid(bhi(g.w) + b1[bj][3]);
                    v0 += p0[bj]; v1 += p1[bj];
                    if (i < 3) { *(f32x4*)(mfw + mo + bj * 128) = v0; *(f32x4*)(mfw + mo + bj * 128 + 4) = v1; }
                    else { u32x4 w; w.x = pk2(v0[0], v0[1]); w.y = pk2(v0[2], v0[3]); w.z = pk2(v1[0], v1[1]); w.w = pk2(v1[2], v1[3]); *(u32x4*)(mxw + mo + bj * 128) = w; } }
                asm volatile("" ::: "memory"); }
    } };
struct EpiSexp { static constexpr bool PERM = true, AFTER_DRAIN = false; bf16_t* E; const float* mqss; float* esum; const float* cb;
    __device__ __forceinline__ void operator()(const AccT& acc, const pg8::Unit& u, int wr, int wc, int fr, int fq) const {
        const int row0 = u.pm * 256 + wr * 64 + fr, col0 = u.pn * 256 + wc * 32 + 8 * fq; const float shift = cb[0];
        f32x4 pq[2][4];
#pragma unroll
        for (int ai = 0; ai < 2; ++ai)
#pragma unroll
            for (int m = 0; m < 4; ++m) pq[ai][m] = *(const f32x4*)(mqss + (size_t)(row0 + ai * 128 + m * 16) * 16 + u.pn * 4);
#pragma unroll
        for (int ai = 0; ai < 2; ++ai)
#pragma unroll
            for (int m = 0; m < 4; ++m) { const int row = row0 + ai * 128 + m * 16; const f32x4 p = pq[ai][m];
                const float sc = rsqrtf(((p[0] + p[1]) + (p[2] + p[3])) * (1.f / 256.f) + EPS) * (1.f / 16.f); bf16_t* rowp = E + (size_t)row * DM + col0; float sum = 0.f;
#pragma unroll
                for (int bj = 0; bj < 2; ++bj) { const f32x4 v0 = acc[ai][bj][m][0], v1 = acc[ai][bj][m][1]; u32x4 w;
                    w.x = pk2(__expf(v0[0] * sc - shift), __expf(v0[1] * sc - shift)); w.y = pk2(__expf(v0[2] * sc - shift), __expf(v0[3] * sc - shift));
                    w.z = pk2(__expf(v1[0] * sc - shift), __expf(v1[1] * sc - shift)); w.w = pk2(__expf(v1[2] * sc - shift), __expf(v1[3] * sc - shift));
                    *(u32x4*)(rowp + bj * 128) = w;
                    sum += (blo(w.x) + bhi(w.x)) + (blo(w.y) + bhi(w.y)) + (blo(w.z) + bhi(w.z)) + (blo(w.w) + bhi(w.w)); }
                sum += __shfl_xor(sum, 16); sum += __shfl_xor(sum, 32); if (fq == 0) esum[(size_t)row * 16 + u.pn * 4 + wc] = sum;
                asm volatile("" ::: "memory"); }
    } };
struct EpiMemPV { static constexpr bool PERM = true, AFTER_DRAIN = false; bf16_t* Y; const float* esum;
    __device__ __forceinline__ void operator()(const AccT& acc, const pg8::Unit& u, int wr, int wc, int fr, int fq) const {
        const int row0 = u.pm * 256 + wr * 64 + fr, col0 = u.pn * 256 + wc * 32 + 8 * fq;
        f32x4 pq[2][4];
#pragma unroll
        for (int ai = 0; ai < 2; ++ai)
#pragma unroll
            for (int m = 0; m < 4; ++m) pq[ai][m] = *(const f32x4*)(esum + (size_t)(row0 + ai * 128 + m * 16) * 16 + u.pn * 4);
#pragma unroll
        for (int ai = 0; ai < 2; ++ai)
#pragma unroll
            for (int m = 0; m < 4; ++m) { const int row = row0 + ai * 128 + m * 16; const f32x4 p = pq[ai][m];
                const float il = 1.f / ((p[0] + p[1]) + (p[2] + p[3])); bf16_t* rowp = Y + (size_t)row * DM + col0;
#pragma unroll
                for (int bj = 0; bj < 2; ++bj) { const f32x4 v0 = acc[ai][bj][m][0] * il, v1 = acc[ai][bj][m][1] * il; u32x4 w; w.x = pk2(v0[0], v0[1]); w.y = pk2(v0[2], v0[3]); w.z = pk2(v1[0], v1[1]); w.w = pk2(v1[2], v1[3]);
                    *(u32x4*)(rowp + bj * 128) = w; }
                asm volatile("" ::: "memory"); }
    } };

__device__ __forceinline__ void tr_item(const float* __restrict__ W, int ldw, bf16_t* __restrict__ WT, int ldk, int nblk, LAS float* scr, int item, int lane, int ncopies, int cstride) {
    const int kb = item / nblk, nb = item % nblk, k0 = 64 * kb, n0 = 32 * nb;
    float tmp[32];
#pragma unroll
    for (int i = 0; i < 32; ++i) { const int kk = 2 * i + (lane >> 5); tmp[i] = W[(size_t)(k0 + kk) * ldw + n0 + (lane & 31)]; }
    __builtin_amdgcn_sched_barrier(0);
#pragma unroll
    for (int i = 0; i < 32; ++i) { const int kk = 2 * i + (lane >> 5); scr[kk * 33 + (lane & 31)] = tmp[i]; }
    LDS_WAIT(); asm volatile("" ::: "memory");
    const int c = lane & 7;
#pragma unroll
    for (int j = 0; j < 4; ++j) { const int n = (lane >> 3) + 8 * j; const LAS float* s = scr + (8 * c) * 33 + n;
        u32x4 o; o.x = pk2(s[0 * 33], s[1 * 33]); o.y = pk2(s[2 * 33], s[3 * 33]); o.z = pk2(s[4 * 33], s[5 * 33]); o.w = pk2(s[6 * 33], s[7 * 33]);
        for (int cp = 0; cp < ncopies; ++cp) *(u32x4*)(WT + (size_t)(n0 + n) * ldk + k0 + 8 * c + cp * cstride) = o; }
    LDS_WAIT(); asm volatile("" ::: "memory");
}
__device__ __forceinline__ void norm_row(f32x4 (&v)[4], const float* __restrict__ g, bf16_t* __restrict__ hrow, const LAS float* WfT, bool do_logf, const float* __restrict__ bfg, float* __restrict__ LOGF, int row, int lane) {
    const f32x4* gr = (const f32x4*)g; float ss = 0.f;
#pragma unroll
    for (int j = 0; j < 4; ++j) ss += (v[j][0] * v[j][0] + v[j][1] * v[j][1]) + (v[j][2] * v[j][2] + v[j][3] * v[j][3]);
    ss = wave_sum(ss);
    const float rstd = rsqrtf(ss * (1.f / DM) + EPS);
#pragma unroll
    for (int j = 0; j < 4; ++j) { v[j] = v[j] * rstd * gr[lane + 64 * j];
        uint2 o; o.x = pk2(v[j][0], v[j][1]); o.y = pk2(v[j][2], v[j][3]); ((uint2*)hrow)[lane + 64 * j] = o; }
    if (do_logf) {
        float p[16];
#pragma unroll
        for (int h = 0; h < 16; ++h) { float a = 0.f;
#pragma unroll
            for (int j = 0; j < 4; ++j) { const f32x4 w = *(const LAS f32x4*)(WfT + h * 1024 + (lane + 64 * j) * 4); a += (v[j][0] * w[0] + v[j][1] * w[1]) + (v[j][2] * w[2] + v[j][3] * w[3]); }
            p[h] = a; if ((h & 3) == 3) __builtin_amdgcn_sched_barrier(0); }
        const bool b5 = lane & 32, b4 = lane & 16, b3 = lane & 8, b2 = lane & 4;
        float q8[8], q4[4], q2[2];
#pragma unroll
        for (int i = 0; i < 8; ++i) { const float send = b5 ? p[i] : p[i + 8], keep = b5 ? p[i + 8] : p[i]; q8[i] = keep + __shfl_xor(send, 32); }
#pragma unroll
        for (int i = 0; i < 4; ++i) { const float send = b4 ? q8[i] : q8[i + 4], keep = b4 ? q8[i + 4] : q8[i]; q4[i] = keep + __shfl_xor(send, 16); }
#pragma unroll
        for (int i = 0; i < 2; ++i) { const float send = b3 ? q4[i] : q4[i + 2], keep = b3 ? q4[i + 2] : q4[i]; q2[i] = keep + __shfl_xor(send, 8); }
        float q1 = (b2 ? q2[1] : q2[0]) + __shfl_xor(b2 ? q2[0] : q2[1], 4);
        q1 += __shfl_xor(q1, 2); q1 += __shfl_xor(q1, 1);
        const int h = (b5 ? 8 : 0) + (b4 ? 4 : 0) + (b3 ? 2 : 0) + (b2 ? 1 : 0);
        if ((lane & 3) == 0) { const int b = row / SEQ, t = row % SEQ; LOGF[((size_t)b * 16 + h) * SEQ + t] = logsigmoidf(q1 + bfg[h]); }
    }
}
__device__ __forceinline__ void norm_rows(const float* __restrict__ x, int nrows, int gw, int NGW, const float* __restrict__ g, bf16_t* __restrict__ H, const LAS float* WfT, bool do_logf, const float* __restrict__ bfg, float* __restrict__ LOGF, int lane) {
    f32x4 nx[4];
    if (gw < nrows) {
#pragma unroll
        for (int j = 0; j < 4; ++j) nx[j] = ((const f32x4*)(x + (size_t)gw * DM))[lane + 64 * j]; }
    for (int m = gw; m < nrows; m += NGW) {
        f32x4 v[4];
#pragma unroll
        for (int j = 0; j < 4; ++j) v[j] = nx[j];
        if (m + NGW < nrows) {
#pragma unroll
            for (int j = 0; j < 4; ++j) nx[j] = ((const f32x4*)(x + (size_t)(m + NGW) * DM))[lane + 64 * j]; }
        norm_row(v, g, H + (size_t)m * DM, WfT, do_logf, bfg, LOGF, m, lane);
    }
}
__device__ __forceinline__ void headnorm64_row(bf16_t* row, u32x4 a, u32x4 b, const float* __restrict__ g, float scale, int lane) {
    u32x4* p = (u32x4*)row + lane * 2;
    float v[16] = {blo(a.x), bhi(a.x), blo(a.y), bhi(a.y), blo(a.z), bhi(a.z), blo(a.w), bhi(a.w), blo(b.x), bhi(b.x), blo(b.y), bhi(b.y), blo(b.z), bhi(b.z), blo(b.w), bhi(b.w)};
    float ss = 0.f;
#pragma unroll
    for (int i = 0; i < 16; ++i) ss += v[i] * v[i];
    ss += __shfl_xor(ss, 1); ss += __shfl_xor(ss, 2);
    const float rstd = rsqrtf(ss * (1.f / 64.f) + EPS) * scale; const f32x4* gp = (const f32x4*)(g + (lane & 3) * 16);
#pragma unroll
    for (int i = 0; i < 4; ++i) { const f32x4 gg = gp[i]; v[4 * i] *= rstd * gg[0]; v[4 * i + 1] *= rstd * gg[1]; v[4 * i + 2] *= rstd * gg[2]; v[4 * i + 3] *= rstd * gg[3]; }
    a.x = pk2(v[0], v[1]); a.y = pk2(v[2], v[3]); a.z = pk2(v[4], v[5]); a.w = pk2(v[6], v[7]); b.x = pk2(v[8], v[9]); b.y = pk2(v[10], v[11]); b.z = pk2(v[12], v[13]); b.w = pk2(v[14], v[15]);
    p[0] = a; p[1] = b;
}
__device__ __forceinline__ void headnorm_rows(bf16_t* FQ, bf16_t* FK, int gw, int NGW, const float* __restrict__ gq, const float* __restrict__ gk, int lane) {
    u32x4 na, nb;
    { bf16_t* r = gw < T ? FQ + (size_t)gw * DM : FK + (size_t)(gw - T) * DM; na = ((const u32x4*)r)[lane * 2]; nb = ((const u32x4*)r)[lane * 2 + 1]; }
    for (int m = gw; m < 2 * T; m += NGW) {
        const u32x4 a = na, b = nb; const int mn = m + NGW;
        if (mn < 2 * T) { const bf16_t* r = mn < T ? FQ + (size_t)mn * DM : FK + (size_t)(mn - T) * DM; na = ((const u32x4*)r)[lane * 2]; nb = ((const u32x4*)r)[lane * 2 + 1]; }
        if (m < T) headnorm64_row(FQ + (size_t)m * DM, a, b, gq, C2, lane); else headnorm64_row(FK + (size_t)(m - T) * DM, a, b, gk, 1.f, lane);
    }
}
__device__ __forceinline__ void cumsum_block(const float* __restrict__ src, float* __restrict__ dst, LAS float* part, int tid) {
    const int lane = tid & 63, wave = tid >> 6; const f32x4* s4 = (const f32x4*)(src + tid * 16); float v[16]; float s = 0.f;
#pragma unroll
    for (int i = 0; i < 4; ++i) { const f32x4 x = s4[i]; s += x[0]; v[4 * i] = s; s += x[1]; v[4 * i + 1] = s; s += x[2]; v[4 * i + 2] = s; s += x[3]; v[4 * i + 3] = s; }
    float incl = s;
#pragma unroll
    for (int o = 1; o < 64; o <<= 1) { const float t_ = __shfl_up(incl, o); if (lane >= o) incl += t_; }
    __syncthreads();
    if (lane == 63) part[wave] = incl;
    __syncthreads();
    float off = incl - s;
    for (int w = 0; w < wave; ++w) off += part[w];
    f32x4* d4 = (f32x4*)(dst + tid * 16);
#pragma unroll
    for (int i = 0; i < 4; ++i) d4[i] = (f32x4){off + v[4 * i], off + v[4 * i + 1], off + v[4 * i + 2], off + v[4 * i + 3]};
}

__device__ __forceinline__ float neg_expm1_small(float x) {
    const float p = -x * (1.f + x * (0.5f + x * (0.16666667f + x * (0.041666668f + x * (0.0083333338f + x * 0.0013888889f)))));
    return x > -0.25f ? p : 1.f - __expf(x);
}
constexpr int LRU_TK = 128, LRU_NCH = SEQ / LRU_TK;
constexpr int LRU_XCB = 0, LRU_WT = LRU_TK * 144, LRU_R = LRU_WT + 18432, LRU_SEG = LRU_R + LRU_TK * 528;
static_assert(LRU_SEG + 4096 + 4096 <= MEGA_LDS - 64, "lru LDS map");
template <bool FINAL> __device__ __forceinline__ void lru_load(int it, int n, const bf16_t* __restrict__ LX, const bf16_t* __restrict__ LG, float (&xw)[19], float (&gl)[16], int tid) {
    const int b = it >> 10, c = (it >> 4) & 63, e = tid & 63, tg = tid >> 6, ch = n * 64 + e, t0 = c * LRU_TK + tg * 16;
    bf16_t raw[19];
#pragma unroll
    for (int j = 0; j < 19; ++j) { const int t = t0 + j - 3; raw[j] = LX[((size_t)b * SEQ + (t >= 0 ? t : 0)) * DM + ch]; }
    bf16_t rawg[16];
    if (FINAL) {
#pragma unroll
        for (int j = 0; j < 16; ++j) rawg[j] = LG[((size_t)b * SEQ + t0 + j) * DM + ch]; }
    __builtin_amdgcn_sched_barrier(0);
#pragma unroll
    for (int j = 0; j < 19; ++j) xw[j] = (t0 + j - 3) >= 0 ? bf2f(raw[j]) : 0.f;
    if (FINAL) {
#pragma unroll
        for (int j = 0; j < 16; ++j) gl[j] = bf2f(rawg[j]); }
}
template <bool FINAL> __device__ __forceinline__ void lru_item(int b, int c, int n, const float (&xw)[19], const float (&gl)[16], bf16_t* __restrict__ YL,
        const float w0, const float w1, const float w2, const float w3, const float bc, const float bA, const float bX,
        const float spl, float* APROD, float* HEND, LAS unsigned char* lds, int tid, int kseg) {
    const int e = tid & 63, tg = tid >> 6, ch = n * 64 + e, lane = e, wv = tg;
    LAS float* R = (LAS float*)(lds + LRU_R);
    LAS float* segP = (LAS float*)(lds + LRU_SEG);
    LAS float* segH = segP + 512, *carP = segH + 512 + (b * 4) * 64, *carH = carP + 512;
    const int t0 = c * LRU_TK + tg * 16; const size_t row0 = (size_t)b * SEQ + t0;
    float xc[16];
#pragma unroll
    for (int j = 0; j < 16; ++j) { xc[j] = bc + w3 * xw[j + 3] + w2 * xw[j + 2] + w1 * xw[j + 1] + w0 * xw[j]; *(LAS bf16_t*)(lds + LRU_XCB + (tg * 16 + j) * 144 + e * 2) = f2bf(xc[j]); }
    LDS_BAR();
    { const int tq = wv & 3, cbh = wv >> 2, r32 = lane & 31, hi = lane >> 5; f32x16_t acc0 = {}, acc1 = {};
#pragma unroll
        for (int ks = 0; ks < 4; ++ks) { const bf16x8_t af = *(const LAS bf16x8_t*)(lds + LRU_XCB + (32 * tq + r32) * 144 + (16 * ks + 8 * hi) * 2);
            const bf16x8_t b0 = *(const LAS bf16x8_t*)(lds + LRU_WT + (64 * cbh + r32) * 144 + (16 * ks + 8 * hi) * 2), b1 = *(const LAS bf16x8_t*)(lds + LRU_WT + (64 * cbh + 32 + r32) * 144 + (16 * ks + 8 * hi) * 2);
            acc0 = __builtin_amdgcn_mfma_f32_32x32x16_bf16(af, b0, acc0, 0, 0, 0); acc1 = __builtin_amdgcn_mfma_f32_32x32x16_bf16(af, b1, acc1, 0, 0, 0); }
#pragma unroll
        for (int r = 0; r < 16; ++r) { const int ro = (32 * tq + (r & 3) + 8 * (r >> 2) + 4 * hi) * 132 + 64 * cbh + r32; R[ro] = acc0[r]; R[ro + 32] = acc1[r]; } }
    LDS_BAR();
    float av[16], uv[16]; float P = 1.f, Hh = 0.f;
#pragma unroll
    for (int j = 0; j < 16; ++j) { const float ra = bA + R[(tg * 16 + j) * 132 + e], ri = bX + R[(tg * 16 + j) * 132 + 64 + e];
        const float rr = fast_sigmoid(ra), ii = fast_sigmoid(ri); const float la = -8.f * rr * spl; av[j] = __expf(la); uv[j] = __builtin_amdgcn_sqrtf(neg_expm1_small(2.f * la)) * (ii * xc[j]);
        Hh = av[j] * Hh + uv[j]; P *= av[j]; }
    segP[tg * 64 + e] = P; segH[tg * 64 + e] = Hh;
    LDS_BAR();
    if (FINAL) {
        float h = 0.f;
        for (int s = 0; s <= kseg; ++s) h = carP[s * 64 + e] * h + carH[s * 64 + e];
        for (int t2 = 0; t2 < tg; ++t2) h = segP[t2 * 64 + e] * h + segH[t2 * 64 + e];
#pragma unroll
        for (int j = 0; j < 16; ++j) { h = av[j] * h + uv[j]; YL[(row0 + j) * DM + ch] = f2bf(h * fast_gelu(gl[j])); }
    } else if (tg == 7) {
        float h = 0.f, p = 1.f;
#pragma unroll
        for (int s = 0; s < 8; ++s) { h = segP[s * 64 + e] * h + segH[s * 64 + e]; p *= segP[s * 64 + e]; }
        const size_t si = ((size_t)b * LRU_NCH + c) * DM + ch; APROD[si] = p; HEND[si] = h;
    }
}
template <bool FINAL> __device__ __forceinline__ void lru_pass(int l, int bx, int G, const float* const* in, const bf16_t* LX, const bf16_t* LG, bf16_t* YL, float* APROD, float* HEND, LAS unsigned char* lds, int tid) {
    const int n = bx & 15, e = tid & 63, ch = n * 64 + e;
    { const float* wa = in[10] + (size_t)l * 65536 + (size_t)n * 4096; const float* wx = in[12] + (size_t)l * 65536 + (size_t)n * 4096;
        float wv_[16];
#pragma unroll
        for (int k = 0; k < 16; ++k) { const int i = tid + MEGA_THREADS * k; wv_[k] = (i >> 12) ? wx[i & 4095] : wa[i & 4095]; }
#pragma unroll
        for (int k = 0; k < 16; ++k) { const int i = tid + MEGA_THREADS * k, mat = i >> 12, d = (i >> 6) & 63, ee = i & 63; *(LAS bf16_t*)(lds + LRU_WT + (mat * 64 + ee) * 144 + d * 2) = f2bf(wv_[k]); } }
    const float* cw = in[8] + (size_t)l * 4 * DM; const float w0 = cw[ch], w1 = cw[DM + ch], w2 = cw[2 * DM + ch], w3 = cw[3 * DM + ch], bc = in[9][l * DM + ch];
    const float bA = in[11][l * DM + ch], bX = in[13][l * DM + ch], spl = softplusf(-in[14][l * DM + ch]);
    if (FINAL) {
        const int c0 = bx >> 4, tg = tid >> 6, b = tg >> 2, sg = tg & 3; LAS float* carP = (LAS float*)(lds + LRU_SEG) + 1024, *carH = carP + 512;
        const int lo = sg == 0 ? 0 : c0 + 16 * (sg - 1), hi = c0 + 16 * sg; float A[16], Hc[16];
#pragma unroll
        for (int i = 0; i < 16; ++i) { const int cc = lo + i; const bool ok = cc < hi; const size_t si = ((size_t)b * LRU_NCH + (ok ? cc : 0)) * DM + ch; const float a_ = APROD[si], h_ = HEND[si]; A[i] = ok ? a_ : 1.f; Hc[i] = ok ? h_ : 0.f; }
        float cp = 1.f, chh = 0.f;
#pragma unroll
        for (int i = 0; i < 16; ++i) { chh = A[i] * chh + Hc[i]; cp *= A[i]; }
        carP[(b * 4 + sg) * 64 + e] = cp; carH[(b * 4 + sg) * 64 + e] = chh;
    }
    float xwn[19], gln[16];
#pragma unroll
    for (int j = 0; j < 16; ++j) gln[j] = 0.f;
    lru_load<FINAL>(bx, n, LX, LG, xwn, gln, tid);
    __syncthreads();
    for (int it = bx; it < 2048; it += G) {
        float xw[19], gl[16];
#pragma unroll
        for (int j = 0; j < 19; ++j) xw[j] = xwn[j];
#pragma unroll
        for (int j = 0; j < 16; ++j) gl[j] = gln[j];
        if (it + G < 2048) lru_load<FINAL>(it + G, n, LX, LG, xwn, gln, tid);
        lru_item<FINAL>(it >> 10, (it >> 4) & 63, n, xw, gl, YL, w0, w1, w2, w3, bc, bA, bX, spl, APROD, HEND, lds, tid, ((it >> 4) & 63) >> 4);
    }
    __syncthreads();
}

constexpr int SB_WIN = 13, SB_KOFF = 0, SB_VOFF = SB_WIN * 32 * 144, SB_SCR = SB_VOFF + SB_WIN * 4096;
static_assert(SB_SCR + 8 * 4096 <= MEGA_LDS - 64, "stick-breaking LDS map");
__device__ __forceinline__ void sb_wave(int b, int h, int qw0, int kt_lo, const bf16x8_t (&qr)[4], const bf16_t* __restrict__ K, const bf16_t* __restrict__ V, bf16_t* O, LAS unsigned char* lds, int wave, int lane) {
    const int r32 = lane & 31, hi = lane >> 5; const size_t rowbase = (size_t)b * SEQ;
    const bf16_t* Kh = K + rowbase * DM + h * 64; const bf16_t* Vh = V + rowbase * DM + h * 64;
    f32x16_t o0 = {}, o1 = {}; float R = 0.f; const int qabs = qw0 + r32;
    LAS unsigned char* scr = lds + SB_SCR + wave * 4096;
    for (int kt = qw0 >> 5; kt >= 0; --kt) {
        bf16x8_t kf[4]; const LAS unsigned char* vl;
        if (kt >= kt_lo) {
#pragma unroll
            for (int d0 = 0; d0 < 4; ++d0) kf[d0] = *(const LAS bf16x8_t*)(lds + SB_KOFF + ((kt - kt_lo) * 32 + r32) * 144 + d0 * 32 + hi * 16);
            vl = lds + SB_VOFF + (kt - kt_lo) * 4096;
        } else {
#pragma unroll
            for (int d0 = 0; d0 < 4; ++d0) kf[d0] = *(const bf16x8_t*)(Kh + (size_t)(kt * 32 + r32) * DM + d0 * 16 + hi * 8);
#pragma unroll
            for (int it = 0; it < 4; ++it) { const int chunk = lane + 64 * it, row = chunk >> 3, c16 = chunk & 7; const u32x4 vq = *(const u32x4*)(Vh + (size_t)(kt * 32 + row) * DM + c16 * 8);
                *(LAS u32x4*)(scr + (c16 >> 2) * 2048 + row * 64 + (c16 & 3) * 16) = vq; }
            vl = scr;
        }
        f32x16_t st = {};
#pragma unroll
        for (int d0 = 0; d0 < 4; ++d0) st = __builtin_amdgcn_mfma_f32_32x32x16_bf16(kf[d0], qr[d0], st, 0, 0, 0);
        float l1[16], lb[16]; bool val[16];
#pragma unroll
        for (int r = 0; r < 16; ++r) { const int kv = kt * 32 + (r & 3) + 8 * (r >> 2) + 4 * hi; val[r] = kv < qabs; const float z = st[r] * 0.125f; const float sp = fast_softplus(z); l1[r] = val[r] ? -sp : 0.f; lb[r] = z - sp; }
        float w[16]; float tail = 0.f;
#pragma unroll
        for (int g = 3; g >= 0; --g) { const float qs = (l1[4 * g] + l1[4 * g + 1]) + (l1[4 * g + 2] + l1[4 * g + 3]); const float pq = __shfl_xor(qs, 32);
            const float after = tail + (hi == 0 ? pq : 0.f) + R; tail += qs + pq;
            const float e2 = l1[4 * g + 3], e1 = e2 + l1[4 * g + 2], e0 = e1 + l1[4 * g + 1];
            w[4 * g + 3] = val[4 * g + 3] ? __expf(lb[4 * g + 3] + after) : 0.f; w[4 * g + 2] = val[4 * g + 2] ? __expf(lb[4 * g + 2] + after + e2) : 0.f;
            w[4 * g + 1] = val[4 * g + 1] ? __expf(lb[4 * g + 1] + after + e1) : 0.f; w[4 * g] = val[4 * g] ? __expf(lb[4 * g] + after + e0) : 0.f; }
        R += tail;
        u32x4 p0, p1; p0.x = attn_body::cvtpk_s(w[0], w[1]); p0.y = attn_body::cvtpk_s(w[2], w[3]); p0.z = attn_body::cvtpk_s(w[4], w[5]); p0.w = attn_body::cvtpk_s(w[6], w[7]);
        p1.x = attn_body::cvtpk_s(w[8], w[9]); p1.y = attn_body::cvtpk_s(w[10], w[11]); p1.z = attn_body::cvtpk_s(w[12], w[13]); p1.w = attn_body::cvtpk_s(w[14], w[15]);
        const bf16x8_t pa0 = __builtin_bit_cast(bf16x8_t, p0), pa1 = __builtin_bit_cast(bf16x8_t, p1);
        const attn_body::lds_cptr vp = (attn_body::lds_cptr)vl + (4 * hi + ((lane & 15) >> 2)) * 64 + ((lane >> 4) & 1) * 32 + (lane & 3) * 8;
#define SB_VF(d0, s) ({ const attn_body::s16x4 lo_ = attn_body::vtr(vp + (d0) * 2048 + (s) * 1024), hi_ = attn_body::vtr(vp + (d0) * 2048 + (s) * 1024 + 512); \
            (bf16x8_t){lo_[0], lo_[1], lo_[2], lo_[3], hi_[0], hi_[1], hi_[2], hi_[3]}; })
        o0 = __builtin_amdgcn_mfma_f32_32x32x16_bf16(pa0, SB_VF(0, 0), o0, 0, 0, 0);
        o1 = __builtin_amdgcn_mfma_f32_32x32x16_bf16(pa0, SB_VF(1, 0), o1, 0, 0, 0);
        o0 = __builtin_amdgcn_mfma_f32_32x32x16_bf16(pa1, SB_VF(0, 1), o0, 0, 0, 0);
        o1 = __builtin_amdgcn_mfma_f32_32x32x16_bf16(pa1, SB_VF(1, 1), o1, 0, 0, 0);
#undef SB_VF
        if (__all(R < SB_THR)) break;
    }
    bf16_t* Ow = O + (rowbase + qw0) * DM + h * 64;
#pragma unroll
    for (int r = 0; r < 16; ++r) { const int q = (r & 3) + 8 * (r >> 2) + 4 * hi; Ow[(size_t)q * DM + r32] = f2bf(o0[r]); Ow[(size_t)q * DM + 32 + r32] = f2bf(o1[r]); }
}
__device__ __forceinline__ void sb_unit(int b, int h, int q0, const bf16_t* Q, const bf16_t* __restrict__ K, const bf16_t* __restrict__ V, bf16_t* O, LAS unsigned char* lds, int tid) {
    const int lane = tid & 63, wave = __builtin_amdgcn_readfirstlane(tid >> 6);
    const int kt_hi = (q0 >> 5) + 8, kt_lo = kt_hi - SB_WIN > 0 ? kt_hi - SB_WIN : 0, nch = (kt_hi - kt_lo) * 256;
    const bf16_t* Kh = K + ((size_t)b * SEQ + kt_lo * 32) * DM + h * 64; const bf16_t* Vh = V + ((size_t)b * SEQ + kt_lo * 32) * DM + h * 64;
    bf16x8_t qr[4];
#pragma unroll
    for (int d0 = 0; d0 < 4; ++d0) qr[d0] = *(const bf16x8_t*)(Q + ((size_t)b * SEQ + q0 + wave * 32 + (lane & 31)) * DM + h * 64 + d0 * 16 + (lane >> 5) * 8);
#pragma unroll
    for (int hb = 0; hb < 2; ++hb) {
        u32x4 kq[4], vq[4];
#pragma unroll
        for (int i = 0; i < 4; ++i) { const int idx = tid + MEGA_THREADS * (4 * hb + i), row = idx >> 3, c16 = idx & 7;
            const int rc = idx < nch ? row : 0; kq[i] = *(const u32x4*)(Kh + (size_t)rc * DM + c16 * 8); vq[i] = *(const u32x4*)(Vh + (size_t)rc * DM + c16 * 8); }
#pragma unroll
        for (int i = 0; i < 4; ++i) { const int idx = tid + MEGA_THREADS * (4 * hb + i), row = idx >> 3, c16 = idx & 7;
            if (idx < nch) { *(LAS u32x4*)(lds + SB_KOFF + row * 144 + c16 * 16) = kq[i];
                *(LAS u32x4*)(lds + SB_VOFF + (row >> 5) * 4096 + (c16 >> 2) * 2048 + (row & 31) * 64 + (c16 & 3) * 16) = vq[i]; } }
    }
    __syncthreads();
    sb_wave(b, h, q0 + wave * 32, kt_lo, qr, K, V, O, lds, wave, lane);
    __syncthreads();
}

#ifndef DBG_NOLOGF
#define DBG_NOLOGF 0
#endif
#ifndef EN_FOX
#define EN_FOX 1
#endif
#ifndef EN_SB
#define EN_SB 1
#endif
#ifndef EN_LRU
#define EN_LRU 1
#endif
#ifndef EN_GEMM
#define EN_GEMM 1
#endif
#ifndef EN_THIN
#define EN_THIN 1
#endif
enum { SUB_CONV = 1, SUB_NORM = 2, SUB_HEADNORM = 4, SUB_CUMSUM = 8, SUB_LRU = 16, SUB_SB = 32, SUB_MEM = 64, SUB_FOX = 128, SUB_ALL = 255 };
constexpr int N_PRO = 3, N_PER_LAYER = 10, N_PHASES = N_PRO + DEPTH * N_PER_LAYER;
struct MArgs { Ptrs P; int ph_lo, ph_hi, sub, pad; };

__global__ void __launch_bounds__(MEGA_THREADS, 2) mega(MArgs a) {
    extern __shared__ __attribute__((aligned(16))) unsigned char lds_raw[];
    LAS unsigned char* lds = (LAS unsigned char*)lds_raw;
    cg::grid_group grid = cg::this_grid();
    { volatile LAS unsigned* st0 = (volatile LAS unsigned*)(lds + XB_LDS_OFF); if (threadIdx.x == 0) { st0[0] = 0u; st0[1] = 0u; } __syncthreads();
      if (a.ph_hi - a.ph_lo > 2) (void)xcd_barrier_post((unsigned*)(a.P.ws + WS_BAR), st0); }
    for (int ph = a.ph_lo; ph < a.ph_hi; ++ph) {
    int tid = threadIdx.x; asm volatile("" : "+v"(tid));
    const int lane = tid & 63, wave = __builtin_amdgcn_readfirstlane(tid >> 6);
    int zs = 0; asm volatile("" : "+s"(zs));
    const int G = gridDim.x + zs, bx = blockIdx.x + zs, sub = a.sub + zs, vcu = (G % 8 == 0) ? (bx % 8) * (G / 8) + bx / 8 : bx;
    const int gw = vcu * NWV + wave, NGW = G * NWV;
    unsigned char* ws = a.P.ws + zs; const float* const* in = a.P.in + zs; float* out = a.P.out + zs;
    bf16_t* H = (bf16_t*)(ws + WS_H); bf16_t* PROJ = (bf16_t*)(ws + WS_PROJ); bf16_t* GATES = (bf16_t*)(ws + WS_GATES); bf16_t* Eb = (bf16_t*)(ws + WS_E);
    bf16_t *FQ = PROJ, *FK = PROJ + (size_t)T * DM, *FV = PROJ + 2 * (size_t)T * DM, *LX = PROJ + 3 * (size_t)T * DM, *LG = PROJ + 4 * (size_t)T * DM, *SQ = PROJ + 5 * (size_t)T * DM,
           *SK = PROJ + 6 * (size_t)T * DM, *SV = PROJ + 7 * (size_t)T * DM, *MQ = PROJ + 8 * (size_t)T * DM;
    bf16_t* YL = (bf16_t*)(ws + WS_YL);
    float *LOGF = (float*)(ws + WS_LOGF), *FB = (float*)(ws + WS_FB), *MQSS = (float*)(ws + WS_MQSS), *ESUM = (float*)(ws + WS_ESUM), *CB = (float*)(ws + WS_CB);
    bf16_t* MEMN = (bf16_t*)(ws + WS_MEMN); float* MEMRAW = (float*)(ws + WS_MEMRAW); bf16_t *MK = (bf16_t*)(ws + WS_MK), *MVT = (bf16_t*)(ws + WS_MVT);
    float *APROD = (float*)(ws + WS_LRU), *HEND = APROD + (size_t)BATCH * 128 * DM;
    bf16_t* WKVT = (bf16_t*)(ws + WS_WKVT);
    bf16_t *WIN_T = (bf16_t*)(ws + WS_WT + WT_IN), *WBR_T = (bf16_t*)(ws + WS_WT + WT_BR), *WOUT_T = (bf16_t*)(ws + WS_WT + WT_OUT), *WUP_T = (bf16_t*)(ws + WS_WT + WT_UP), *WDN_T = (bf16_t*)(ws + WS_WT + WT_DN);
    bf16_t *GV = (bf16_t*)(ws + WS_GV), *ACT = (bf16_t*)(ws + WS_ACT);

        if (ph < N_PRO) {
            if (ph == 0) {
                LAS float* scr = (LAS float*)(lds + wave * 8448);
                for (int it = gw; it < 4 * 1024; it += NGW) { const int l = it >> 10; tr_item(in[15] + (size_t)l * DM * 2048, 2048, WKVT + (size_t)l * 2048 * DM, DM, 64, scr, it & 1023, lane, 1, 0); }
                for (int l = 0; l < 4; ++l) norm_rows(in[1], 512, gw, NGW, in[3] + l * DM, MEMN + (size_t)l * 512 * DM, (const LAS float*)lds, false, nullptr, nullptr, lane);
            } else if (ph == 1) {
                LocOrder<LocMemKV> S; S.so.init(4 * 512, 2048, G, bx); S.loc = LocMemKV{(const char*)MEMN, (const char*)WKVT};
                if (EN_GEMM) pg8::gemm_phase<EpiF32, LocOrder<LocMemKV>, true, true>(lds, pg8::Gemm{DM, DM, DM}, S, EpiF32{MEMRAW, 2048, 0});
            } else {
                for (int m = gw; m < 4 * 512; m += NGW) { const int l = m >> 9, r = m & 511, b = r >> 8, mi = r & 255; const float* raw = MEMRAW + (size_t)m * 2048;
                    const f32x4 gk = *(const f32x4*)(in[17] + l * 256 + lane * 4), gq = *(const f32x4*)(in[16] + l * 256 + lane * 4); const f32x4 gg = gk * gq;
#pragma unroll
                    for (int h = 0; h < 4; ++h) { const f32x4 k = *(const f32x4*)(raw + h * 256 + lane * 4); const float ss = wave_sum((k[0] * k[0] + k[1] * k[1]) + (k[2] * k[2] + k[3] * k[3]));
                        const float rstd = rsqrtf(ss * (1.f / 256.f) + EPS); uint2 o; o.x = pk2(k[0] * rstd * gg[0], k[1] * rstd * gg[1]); o.y = pk2(k[2] * rstd * gg[2], k[3] * rstd * gg[3]);
                        *(uint2*)(MK + ((size_t)l * 512 + (size_t)b * 256 + mi) * DM + h * 256 + lane * 4) = o;
                        const f32x4 v = *(const f32x4*)(raw + 1024 + h * 256 + lane * 4); bf16_t* vt = MVT + (size_t)l * 512 * DM + (((size_t)b * 4 + h) * 256 + lane * 4) * 256 + mi;
                        vt[0] = f2bf(v[0]); vt[256] = f2bf(v[1]); vt[512] = f2bf(v[2]); vt[768] = f2bf(v[3]); }
                    if (r == 0) { float mx = fmaxf(fmaxf(fabsf(gg[0]), fabsf(gg[1])), fmaxf(fabsf(gg[2]), fabsf(gg[3])));
#pragma unroll
                        for (int o = 1; o < 64; o <<= 1) mx = fmaxf(mx, __shfl_xor(mx, o));
                        if (lane == 0) CB[l] = 16.f * mx; } }
            }
        } else {
            const int l = (ph - N_PRO) / N_PER_LAYER, sp = (ph - N_PRO) % N_PER_LAYER;
            const float* xcur = l == 0 ? in[0] : out;
            if (sp == 0) {
                if (sub & SUB_NORM) { LAS float* WfT = (LAS float*)lds; const float* wf = in[4] + (size_t)l * DM * NIN + 3072;
#pragma unroll
                    for (int hb = 0; hb < 2; ++hb) { float tmp[16];
#pragma unroll
                        for (int q = 0; q < 16; ++q) { const int i = tid + MEGA_THREADS * (16 * hb + q); tmp[q] = wf[(size_t)(i >> 4) * NIN + (i & 15)]; }
                        __builtin_amdgcn_sched_barrier(0);
#pragma unroll
                        for (int q = 0; q < 16; ++q) { const int i = tid + MEGA_THREADS * (16 * hb + q); WfT[(i & 15) * 1024 + (i >> 4)] = tmp[q]; } } }
                __syncthreads();
                if (sub & SUB_CONV) { LAS float* scr = (LAS float*)(lds + 65536 + wave * 8448);
                    const float* win = in[4] + (size_t)l * DM * NIN;
                    for (int it = gw; it < 13440; it += NGW) { int r = it;
                        if (r < 1536) { tr_item(win, NIN, WIN_T, DM, 96, scr, r, lane, 1, 0); continue; } r -= 1536;
                        if (r < 5120) { tr_item(win + 3088, NIN, WIN_T + (size_t)3072 * DM, DM, 320, scr, r, lane, 1, 0); continue; } r -= 5120;
                        if (r < 2048) { const int i = r >> 9; tr_item(in[19] + ((size_t)l * 4 + i) * DM * DM, DM, WBR_T + (size_t)i * DM * DM, DM, 32, scr, r & 511, lane, 1, 0); continue; } r -= 2048;
                        if (r < 512) { tr_item(in[20] + (size_t)l * DM * DM, DM, WOUT_T, DM, 32, scr, r, lane, 1, 0); continue; } r -= 512;
                        if (r < 2816) { tr_item(in[22] + (size_t)l * DM * 2 * DFF, 2 * DFF, WUP_T, DM, 176, scr, r, lane, 1, 0); continue; } r -= 2816;
                        tr_item(in[25] + (size_t)l * DFF * DM, DM, WDN_T, DFF, 32, scr, r, lane, 1, 0); } }
                if (sub & SUB_NORM) norm_rows(xcur, T, gw, NGW, in[2] + l * DM, H, (const LAS float*)lds, !DBG_NOLOGF, in[5] + l * 16, LOGF, lane);
            } else if (sp == 1) {
                LocOrder<LocStd> S; S.so.init(T, 13312, G, bx); S.loc = LocStd{(const char*)H, (const char*)WIN_T, 256 * 1024 * 2, 256 * 1024 * 2};
                if (EN_GEMM) pg8::gemm_phase<EpiProj, LocOrder<LocStd>, true, true>(lds, pg8::Gemm{DM, DM, DM}, S, EpiProj{PROJ, GATES, MQSS});
            } else if (sp == 2) {
                if (sub & SUB_HEADNORM) headnorm_rows(FQ, FK, gw, NGW, in[6] + l * 64, in[7] + l * 64, lane);
                if ((sub & SUB_CUMSUM) && bx < 32) cumsum_block(LOGF + (size_t)bx * SEQ, FB + (size_t)bx * SEQ, (LAS float*)lds, tid);
                __syncthreads();
                if (EN_LRU && (sub & SUB_LRU)) lru_pass<false>(l, bx, G, in, LX, LG, YL, APROD, HEND, lds, tid);
                if (EN_SB && (sub & SUB_SB))
#pragma unroll 1
                for (int k = 0; k < 4; ++k) { const int bh = vcu >> 3, qb = (vcu & 7) * 4 + k; sb_unit(bh >> 4, bh & 15, qb * 256, SQ, SK, SV, H, lds, tid); }
                __syncthreads();
                if (sub & SUB_MEM) { LocOrder<LocMemS> S; S.so.init(T, 1024, G, bx); S.loc = LocMemS{(const char*)MQ, (const char*)(MK + (size_t)l * 512 * DM)};
                    if (EN_GEMM) pg8::gemm_phase<EpiSexp, LocOrder<LocMemS>, true, true>(lds, pg8::Gemm{DM, DM, 256 + zs}, S, EpiSexp{Eb, MQSS, ESUM, CB + l}); }
            } else if (sp == 3) {
                if (EN_FOX && (sub & SUB_FOX)) {
                    float gqm = fabsf(in[6][l * 64 + lane]), gkm = fabsf(in[7][l * 64 + lane]);
#pragma unroll
                    for (int o = 1; o < 64; o <<= 1) { gqm = fmaxf(gqm, __shfl_xor(gqm, o)); gkm = fmaxf(gkm, __shfl_xor(gkm, o)); }
                    const float thr = -(160.f + 2.f * C2 * 64.f * gqm * gkm);
                    const attn_body::AttnTensors AT{(const attn_body::bf16*)FQ, (const attn_body::bf16*)FK, (const attn_body::bf16*)FV, (attn_body::bf16*)SV, FB, thr, 0};
                    attn_body::QueueOrder S; S.ctr = (unsigned*)(ws + WS_QCTR) + (l * 8) * 64; S.xl = bx & 7; S.slot = (volatile LAS int*)(lds + XB_LDS_OFF + 16);
                    attn_body::attn_phase<attn_body::QueueOrder, 20>((char*)lds_raw, AT, S); }
                __syncthreads();
                if (EN_LRU && (sub & SUB_LRU)) lru_pass<true>(l, bx, G, in, LX, LG, YL, APROD, HEND, lds, tid);
                if (sub & SUB_MEM) { LocOrder<LocMemPV> S; S.so.init(T, 1024, G, bx); S.loc = LocMemPV{(const char*)Eb, (const char*)(MVT + (size_t)l * 512 * DM)};
                    if (EN_GEMM) pg8::gemm_phase<EpiMemPV, LocOrder<LocMemPV>, true, true>(lds, pg8::Gemm{DM, 256, 256 + zs}, S, EpiMemPV{MQ, ESUM}); }
            } else if (sp == 4) {
                BranchSched S; S.vcu = vcu; S.loc = LocBranch{(const char*)SV, (const char*)YL, (const char*)H, (const char*)MQ, (const char*)WBR_T};
                if (EN_GEMM) pg8::gemm_phase<EpiBranch, BranchSched, true, true>(lds, pg8::Gemm{DM, DM, DM}, S, EpiBranch{GATES, in[18] + (size_t)l * 4 * DM, (float*)(ws + WS_MIXF), (bf16_t*)(ws + WS_MIXED)});
            } else if (sp == 5) {
                LocOrder<LocStd> S; S.so.init(T, DM, G, bx); S.loc = LocStd{(const char*)(ws + WS_MIXED), (const char*)WOUT_T, 256 * 1024 * 2, 256 * 1024 * 2};
                if (EN_GEMM) pg8::gemm_phase<EpiResid, LocOrder<LocStd>, true, true>(lds, pg8::Gemm{DM, DM, DM}, S, EpiResid{xcur, out});
            } else if (sp == 6) {
                norm_rows(out, T, gw, NGW, in[21] + l * DM, H, (const LAS float*)lds, false, nullptr, nullptr, lane);
            } else if (sp == 7) {
                LocOrder<LocStd> S; S.so.init(T, 2 * DFF, G, bx); S.loc = LocStd{(const char*)H, (const char*)WUP_T, 256 * 1024 * 2, 256 * 1024 * 2};
                if (EN_GEMM) pg8::gemm_phase<EpiBf16P, LocOrder<LocStd>, true, true>(lds, pg8::Gemm{DM, DM, DM}, S, EpiBf16P{GV, 2 * DFF, 0});
            } else if (sp == 8) {
                const float* cw = in[23] + (size_t)l * 3 * DFF; const float* cbv = in[24] + l * DFF;
                for (int i = bx * MEGA_THREADS + tid; i < (T / 8) * (DFF / 8); i += G * MEGA_THREADS) { const int r0 = (i / (DFF / 8)) * 8, c = (i % (DFF / 8)) * 8, t0 = r0 % SEQ;
                    const bf16_t* gp = GV + (size_t)r0 * 2 * DFF + c; const u32x4 z4 = {0u, 0u, 0u, 0u};
                    const f32x4 wa0 = *(const f32x4*)(cw + c), wa1 = *(const f32x4*)(cw + c + 4), wb0 = *(const f32x4*)(cw + DFF + c), wb1 = *(const f32x4*)(cw + DFF + c + 4), wc0 = *(const f32x4*)(cw + 2 * DFF + c), wc1 = *(const f32x4*)(cw + 2 * DFF + c + 4);
                    const f32x4 bb0 = *(const f32x4*)(cbv + c), bb1 = *(const f32x4*)(cbv + c + 4);
                    const u32x4 g2l = *(const u32x4*)(gp - (t0 >= 2 ? 4 * DFF : 0)), g1l = *(const u32x4*)(gp - (t0 >= 1 ? 2 * DFF : 0));
                    u32x4 g2 = t0 >= 2 ? g2l : z4, g1 = t0 >= 1 ? g1l : z4;
                    u32x4 gg[8], vv[8];
#pragma unroll
                    for (int j = 0; j < 8; ++j) { gg[j] = *(const u32x4*)(gp + (size_t)j * 2 * DFF); vv[j] = *(const u32x4*)(gp + (size_t)j * 2 * DFF + DFF); }
#define ACT1(G0, G1, G2, VV, W0, W1, W2, BB) ({ const float pre_ = (BB) + (W2) * (G0) + (W1) * (G1) + (W0) * (G2); pre_ * fast_sigmoid(pre_) * (VV); })
#pragma unroll
                    for (int j = 0; j < 8; ++j) { const u32x4 g0 = gg[j], v_ = vv[j]; u32x4 o;
                        o.x = pk2(ACT1(blo(g0.x), blo(g1.x), blo(g2.x), blo(v_.x), wa0[0], wb0[0], wc0[0], bb0[0]), ACT1(bhi(g0.x), bhi(g1.x), bhi(g2.x), bhi(v_.x), wa0[1], wb0[1], wc0[1], bb0[1]));
                        o.y = pk2(ACT1(blo(g0.y), blo(g1.y), blo(g2.y), blo(v_.y), wa0[2], wb0[2], wc0[2], bb0[2]), ACT1(bhi(g0.y), bhi(g1.y), bhi(g2.y), bhi(v_.y), wa0[3], wb0[3], wc0[3], bb0[3]));
                        o.z = pk2(ACT1(blo(g0.z), blo(g1.z), blo(g2.z), blo(v_.z), wa1[0], wb1[0], wc1[0], bb1[0]), ACT1(bhi(g0.z), bhi(g1.z), bhi(g2.z), bhi(v_.z), wa1[1], wb1[1], wc1[1], bb1[1]));
                        o.w = pk2(ACT1(blo(g0.w), blo(g1.w), blo(g2.w), blo(v_.w), wa1[2], wb1[2], wc1[2], bb1[2]), ACT1(bhi(g0.w), bhi(g1.w), bhi(g2.w), bhi(v_.w), wa1[3], wb1[3], wc1[3], bb1[3]));
                        *(u32x4*)(ACT + (size_t)(r0 + j) * DFF + c) = o; g2 = g1; g1 = g0; }
#undef ACT1
                }
            } else {
                LocOrder<LocStd> S; S.so.init(T, DM, G, bx); S.loc = LocStd{(const char*)ACT, (const char*)WDN_T, 256 * DFF * 2, 256 * DFF * 2};
                if (EN_GEMM) pg8::gemm_phase<EpiResid, LocOrder<LocStd>, true, true>(lds, pg8::Gemm{DFF, DFF, DFF}, S, EpiResid{out, out});
            }
        }
        if (ph + 1 < a.ph_hi) {
            if (ph == a.ph_lo) grid.sync();
            else { XcdBarrier xb; xb.bar = (unsigned*)(ws + WS_BAR); xb.x = xb_xcc_id(); xb.st = (volatile LAS unsigned*)(lds + XB_LDS_OFF); xcd_barrier(xb); }
        }
    }
}
enum { C_PRO = 1, C_NORM = 2, C_WIN = 4, C_HN = 8, C_LRU = 16, C_SB = 32, C_MEM = 64, C_FOX = 128, C_BR = 256, C_WOUT = 512, C_NORM2 = 1024, C_UP = 2048, C_ACT = 4096, C_DOWN = 8192, C_ONE = 16384 };
#ifndef CFG
#define CFG 32767
#endif
#ifndef REPEAT_SP
#define REPEAT_SP (-1)
#define REPEAT_N 0
#define REPEAT_SUB 0
#endif
static int g_grid = 0;
static void launch_mega(const Ptrs& P, int lo, int hi, int sub, hipStream_t st, bool coop) {
    MArgs a{}; a.P = P; a.ph_lo = lo; a.ph_hi = hi; a.sub = sub; a.pad = 0;
    if (coop) { void* args[] = {&a}; const hipError_t e = hipLaunchCooperativeKernel((const void*)mega, dim3(g_grid), dim3(MEGA_THREADS), args, MEGA_LDS, st);
        if (e != hipSuccess) fprintf(stderr, "cooperative launch failed: %s (grid %d)\n", hipGetErrorString(e), g_grid); }
    else { hipLaunchKernelGGL(mega, dim3(g_grid), dim3(MEGA_THREADS), MEGA_LDS, st, a);
        if (REPEAT_N > 0 && hi == lo + 1 && lo >= N_PRO && (lo - N_PRO) % N_PER_LAYER == (REPEAT_SP)) { a.sub = (REPEAT_SUB); for (int r = 0; r < (REPEAT_N); ++r) hipLaunchKernelGGL(mega, dim3(g_grid), dim3(MEGA_THREADS), MEGA_LDS, st, a); } }
}
static void run_hybrid(const Ptrs& P, hipStream_t st) {
    unsigned char* ws = P.ws;
    bf16_t* H = (bf16_t*)(ws + WS_H);
    bf16_t* PR[9]; for (int i = 0; i < 9; ++i) PR[i] = (bf16_t*)(ws + WS_PROJ + i * SZ_ACT);
    bf16_t *FQ = PR[0], *FK = PR[1], *FV = PR[2], *LX = PR[3], *LG = PR[4], *SQ = PR[5], *SK = PR[6], *SV = PR[7], *MQ = PR[8];
    bf16_t* GATES = (bf16_t*)(ws + WS_GATES);
    bf16_t *YL = (bf16_t*)(ws + WS_YL), *YS = (bf16_t*)(ws + WS_YS), *YM = (bf16_t*)(ws + WS_YM), *YF = (bf16_t*)(ws + WS_YF);
    float *LOGF = (float*)(ws + WS_LOGF), *FB = (float*)(ws + WS_FB);
    bf16_t* MEMN = (bf16_t*)(ws + WS_MEMN); float* MEMRAW = (float*)(ws + WS_MEMRAW);
    bf16_t *MK = (bf16_t*)(ws + WS_MK), *MVT = (bf16_t*)(ws + WS_MVT);
    bf16_t *GV = (bf16_t*)(ws + WS_GV), *ACT = (bf16_t*)(ws + WS_ACT);
    const float* const* in = P.in;
    const int cfg = CFG;
    const bool anygemm = cfg & (C_WIN | C_BR | C_WOUT | C_UP | C_DOWN);
    if (cfg & C_PRO) { for (int p = 0; p < 3; ++p) launch_mega(P, p, p + 1, SUB_ALL, st, false); }
    else for (int l = 0; l < DEPTH; ++l) {
        n_rmsnorm<<<512 / 4, 256, 0, st>>>(in[1], in[3] + l * DM, MEMN + (size_t)l * 512 * DM, nullptr, nullptr, nullptr, 512);
        n_gemm<EStoreF32><<<dim3(2048 / 64, 512 / 64), 256, 0, st>>>(MEMN + (size_t)l * 512 * DM, in[15] + (size_t)l * DM * 2048, DM, 2048, DM, 0x7fffffff, EStoreF32{MEMRAW + (size_t)l * 512 * 2048, 2048, 0});
        n_memkv_post<<<512, 256, 0, st>>>(MEMRAW + (size_t)l * 512 * 2048, in[17] + l * 256, in[16] + l * 256, MK + (size_t)l * 512 * DM, MVT + (size_t)l * 512 * DM);
    }
    for (int l = 0; l < DEPTH; ++l) {
        const int p0 = N_PRO + l * N_PER_LAYER;
        const float* xcur = l == 0 ? in[0] : P.out;
        const float* win = in[4] + (size_t)l * DM * NIN;
        if (DBG_NOLOGF) n_rmsnorm<<<T / 4, 256, 0, st>>>(xcur, in[2] + l * DM, H, win + 3072, in[5] + l * 16, LOGF, T);
        { const int sub = (anygemm ? SUB_CONV : 0) | ((cfg & C_NORM) ? SUB_NORM : 0); if (sub) launch_mega(P, p0, p0 + 1, sub, st, false); }
        if (!(cfg & C_NORM)) n_rmsnorm<<<T / 4, 256, 0, st>>>(xcur, in[2] + l * DM, H, win + 3072, in[5] + l * 16, LOGF, T);
        if (cfg & C_WIN) launch_mega(P, p0 + 1, p0 + 2, SUB_ALL, st, false);
        else { for (int gI = 0; gI < 9; ++gI) { const int coff = gI < 3 ? gI * 1024 : gI * 1024 + 16;
                n_gemm<EStoreBf16><<<dim3(1024 / 64, T / 64), 256, 0, st>>>(H, win + coff, DM, NIN, DM, 0x7fffffff, EStoreBf16{PR[gI], DM, 0}); }
            n_gemm<EStoreBf16><<<dim3(4096 / 64, T / 64), 256, 0, st>>>(H, win + 9232, DM, NIN, DM, 0x7fffffff, EStoreBf16{GATES, 4096, 0}); }
        if (!(cfg & C_HN)) { n_headnorm<<<T * 16 / 256, 256, 0, st>>>(FQ, in[6] + l * 64, 64, C2); n_headnorm<<<T * 16 / 256, 256, 0, st>>>(FK, in[7] + l * 64, 64, 1.f); n_cumsum<<<32, 1024, 0, st>>>(LOGF, FB); }
        const int sub23 = ((cfg & C_HN) ? (SUB_HEADNORM | SUB_CUMSUM) : 0) | ((cfg & C_LRU) ? SUB_LRU : 0) | ((cfg & C_SB) ? SUB_SB : 0) | ((cfg & C_MEM) ? SUB_MEM : 0) | ((cfg & C_FOX) ? SUB_FOX : 0);
        if (sub23 & ~SUB_FOX) launch_mega(P, p0 + 2, p0 + 3, sub23, st, false);
        if (!(cfg & C_SB)) n_sb_attn<<<dim3(SEQ / 256, 32), 256, 0, st>>>(SQ, SK, SV, YS);
        if (!(cfg & C_LRU)) n_lru<<<32, 64, 0, st>>>(LX, LG, in[8] + (size_t)l * 4 * DM, in[9] + l * DM, in[10] + (size_t)l * 16 * 64 * 64, in[11] + l * DM, in[12] + (size_t)l * 16 * 64 * 64, in[13] + l * DM, in[14] + l * DM, YL);
        if (!(cfg & C_MEM)) n_mem_attn<<<T * 4, 256, 0, st>>>(MQ, MK + (size_t)l * 512 * DM, MVT + (size_t)l * 512 * DM, YM);
        if (sub23 & (SUB_FOX | SUB_LRU | SUB_MEM)) launch_mega(P, p0 + 3, p0 + 4, sub23, st, false);
        if (!(cfg & C_FOX)) n_fox_attn<<<dim3(SEQ / 256, 32), 256, 0, st>>>(FQ, FK, FV, FB, YF);
        if (cfg & C_BR) launch_mega(P, p0 + 4, p0 + 5, SUB_ALL, st, false);
        else { const bf16_t* Y[4] = {YF, YL, YS, YM};
            for (int i = 0; i < 4; ++i) n_gemm<EBranch><<<dim3(1024 / 64, T / 64), 256, 0, st>>>(Y[i], in[19] + ((size_t)l * 4 + i) * DM * DM, DM, DM, DM, 0x7fffffff, EBranch{GATES, in[18] + ((size_t)l * 4 + i) * DM, (float*)(ws + WS_MIXF), (bf16_t*)(ws + WS_MIXED), i, 0}); }
        if (cfg & C_WOUT) launch_mega(P, p0 + 5, p0 + 6, SUB_ALL, st, false);
        else n_gemm<EResid><<<dim3(1024 / 64, T / 64), 256, 0, st>>>((const bf16_t*)(ws + WS_MIXED), in[20] + (size_t)l * DM * DM, DM, DM, DM, 0x7fffffff, EResid{xcur, P.out});
        if (cfg & C_NORM2) launch_mega(P, p0 + 6, p0 + 7, SUB_ALL, st, false);
        else n_rmsnorm<<<T / 4, 256, 0, st>>>(P.out, in[21] + l * DM, H, nullptr, nullptr, nullptr, T);
        if (cfg & C_UP) launch_mega(P, p0 + 7, p0 + 8, SUB_ALL, st, false);
        else n_gemm<EStoreBf16><<<dim3(2 * DFF / 64, T / 64), 256, 0, st>>>(H, in[22] + (size_t)l * DM * 2 * DFF, DM, 2 * DFF, DM, 0x7fffffff, EStoreBf16{GV, 2 * DFF, 0});
        if (cfg & C_ACT) launch_mega(P, p0 + 8, p0 + 9, SUB_ALL, st, false);
        else n_act<<<(unsigned)(((size_t)T * DFF + 255) / 256), 256, 0, st>>>(GV, in[23] + (size_t)l * 3 * DFF, in[24] + l * DFF, ACT);
        if (cfg & C_DOWN) launch_mega(P, p0 + 9, p0 + 10, SUB_ALL, st, false);
        else n_gemm<EResid><<<dim3(1024 / 64, T / 64), 256, 0, st>>>(ACT, in[25] + (size_t)l * DFF * DM, DFF, DM, DFF, 0x7fffffff, EResid{P.out, P.out});
    }
}

extern "C" void kernel_launch(void* const* d_in, const int* in_sizes, int n_in, void* d_out, int out_size, void* d_ws, size_t ws_size, hipStream_t stream) {
    if (n_in != 26 || out_size != T * DM || ws_size < WS_NEED) { fprintf(stderr, "kernel_launch: unexpected sizes n_in %d out %d ws %zu (need %zu)\n", n_in, out_size, ws_size, (size_t)WS_NEED); return; }
    if (g_grid == 0) {
        int dev = 0, cus = 0, per_cu = 0;
        hipGetDevice(&dev); hipDeviceGetAttribute(&cus, hipDeviceAttributeMultiprocessorCount, dev);
        if (hipFuncSetAttribute((const void*)mega, hipFuncAttributeMaxDynamicSharedMemorySize, MEGA_LDS) != hipSuccess) fprintf(stderr, "kernel_launch: hipFuncSetAttribute failed\n");
        if (hipOccupancyMaxActiveBlocksPerMultiprocessor(&per_cu, (const void*)mega, MEGA_THREADS, MEGA_LDS) != hipSuccess || per_cu < 1) fprintf(stderr, "kernel_launch: occupancy query says %d\n", per_cu);
        (void)hipGetLastError();
        g_grid = cus;
        if (g_grid != 256) fprintf(stderr, "kernel_launch: %d CUs; the attention phase's static order assumes 256\n", g_grid);
    }
    Ptrs P{};
    for (int i = 0; i < 26; ++i) P.in[i] = (const float*)d_in[i];
    P.out = (float*)d_out; P.ws = (unsigned char*)d_ws;
    if ((CFG) & C_ONE) { (void)hipMemsetAsync((char*)d_ws + WS_BAR, 0, CTL_ZERO_BYTES, stream);
        launch_mega(P, 0, N_PHASES, SUB_ALL, stream, true); }
    else { (void)hipMemsetAsync((char*)d_ws + WS_BAR, 0, CTL_ZERO_BYTES, stream); run_hybrid(P, stream); }
}
```

```cpp
#include <hip/hip_runtime.h>
#include <cstdio>
#include <cstdint>
#include <hip/hip_cooperative_groups.h>

typedef unsigned short bf16_t;
constexpr int BATCH = 2, SEQ = 8192, DM = 1024, DEPTH = 4, T = BATCH * SEQ;
constexpr int NMEM = 256, NIN = 13328, DFF = 2816;
constexpr float EPS = 1e-6f;
constexpr float LOG2E = 1.4426950408889634f;
constexpr float C2 = 0.125f * LOG2E;
constexpr float SB_THR = -104.0f;

__device__ __forceinline__ float bf2f(bf16_t b) { return __uint_as_float(((unsigned)b) << 16); }
__device__ __forceinline__ bf16_t f2bf(float f) { unsigned u = __float_as_uint(f); return (bf16_t)((u + 0x7fffu + ((u >> 16) & 1u)) >> 16); }
__device__ __forceinline__ float bfr(float f) { return bf2f(f2bf(f)); }
__device__ __forceinline__ float wave_sum(float v) {
#pragma unroll
    for (int o = 1; o < 64; o <<= 1) v += __shfl_xor(v, o);
    return v;
}
__device__ __forceinline__ float softplusf(float x) { return fmaxf(x, 0.f) + log1pf(__expf(-fabsf(x))); }
__device__ __forceinline__ float logsigmoidf(float x) { return -softplusf(-x); }
__device__ __forceinline__ float sigmoidf_(float x) { return 1.f / (1.f + __expf(-x)); }
__device__ __forceinline__ float gelu_tanh(float x) { const float u = 0.7978845608028654f * (x + 0.044715f * x * x * x); return 0.5f * x * (1.f + tanhf(u)); }

__device__ __forceinline__ int mk_tid() { int t = threadIdx.x; asm volatile("" : "+v"(t)); return t; }

constexpr size_t MiB = 1u << 20;
constexpr size_t SZ_ACT = (size_t)T * DM * 2;
constexpr size_t WS_CTL = 0;
constexpr size_t WS_H = 1 * MiB;
constexpr size_t WS_PROJ = WS_H + SZ_ACT;
constexpr size_t WS_GATES = WS_PROJ + 9 * SZ_ACT;
constexpr size_t WS_E = WS_GATES + 4 * SZ_ACT;
constexpr size_t WS_LOGF = WS_E + SZ_ACT;
constexpr size_t WS_FB = WS_LOGF + 1 * MiB;
constexpr size_t WS_MQSS = WS_FB + 1 * MiB;
constexpr size_t WS_ESUM = WS_MQSS + 1 * MiB;
constexpr size_t WS_MEMN = WS_ESUM + 1 * MiB;
constexpr size_t WS_MEMRAW = WS_MEMN + 4 * MiB;
constexpr size_t WS_MK = WS_MEMRAW + 16 * MiB;
constexpr size_t WS_MVT = WS_MK + 4 * MiB;
constexpr size_t WS_LRU = WS_MVT + 4 * MiB;
constexpr size_t WS_WT = WS_LRU + 2 * MiB;
constexpr size_t WS_END = WS_WT + 72 * MiB;
constexpr size_t WS_YL = WS_PROJ + 6 * SZ_ACT, WS_YS = WS_H, WS_YM = WS_PROJ + 8 * SZ_ACT, WS_YF = WS_PROJ + 7 * SZ_ACT;
constexpr size_t WS_GV = WS_PROJ;
constexpr size_t WS_ACT = WS_GV + (size_t)T * 2 * DFF * 2;
static_assert(WS_ACT + (size_t)T * DFF * 2 <= WS_GATES, "ffn alias");
constexpr size_t WS_MIXF = WS_END;
constexpr size_t WS_MIXED = WS_PROJ;
constexpr size_t WS_NEED = WS_MIXF + (size_t)T * DM * 4;

struct Ptrs {
    const float* in[26];
    float* out;
    unsigned char* ws;
};

__global__ void __launch_bounds__(256) n_rmsnorm(const float* __restrict__ x, const float* __restrict__ g, bf16_t* __restrict__ H,
                                                 const float* __restrict__ Wf, const float* __restrict__ bfg, float* __restrict__ LOGF, int nrows) {
    const int lane = threadIdx.x & 63, row = blockIdx.x * 4 + (threadIdx.x >> 6);
    if (row >= nrows) return;
    const float4* xr = (const float4*)(x + (size_t)row * DM);
    const float4* gr = (const float4*)g;
    float4 v[4]; float ss = 0.f;
#pragma unroll
    for (int j = 0; j < 4; ++j) { v[j] = xr[lane + 64 * j]; ss += v[j].x * v[j].x + v[j].y * v[j].y + v[j].z * v[j].z + v[j].w * v[j].w; }
    ss = wave_sum(ss);
    const float rstd = rsqrtf(ss * (1.f / DM) + EPS);
#pragma unroll
    for (int j = 0; j < 4; ++j) { const float4 gg = gr[lane + 64 * j]; v[j].x *= rstd * gg.x; v[j].y *= rstd * gg.y; v[j].z *= rstd * gg.z; v[j].w *= rstd * gg.w;
        ushort4 o; o.x = f2bf(v[j].x); o.y = f2bf(v[j].y); o.z = f2bf(v[j].z); o.w = f2bf(v[j].w);
        ((ushort4*)(H + (size_t)row * DM))[lane + 64 * j] = o; }
    if (Wf) {
        float mine = 0.f;
        for (int h = 0; h < 16; ++h) {
            float p = 0.f;
#pragma unroll
            for (int j = 0; j < 4; ++j) { const int k = (lane + 64 * j) * 4;
                p += v[j].x * Wf[(size_t)k * NIN + h] + v[j].y * Wf[(size_t)(k + 1) * NIN + h] + v[j].z * Wf[(size_t)(k + 2) * NIN + h] + v[j].w * Wf[(size_t)(k + 3) * NIN + h]; }
            p = wave_sum(p);
            if (lane == h) mine = p;
        }
        if (lane < 16) { const int b = row / SEQ, t = row % SEQ; LOGF[((size_t)b * 16 + lane) * SEQ + t] = logsigmoidf(mine + bfg[lane]); }
    }
}

struct EStoreBf16 { bf16_t* O; int ldc; int pad; __device__ void operator()(int m, int n, float a) const { O[(size_t)m * ldc + n] = f2bf(a); } };
struct EStoreF32 { float* O; int ldc; int pad; __device__ void operator()(int m, int n, float a) const { O[(size_t)m * ldc + n] = a; } };
struct EBranch { const bf16_t* G; const float* bg; float* MIXF; bf16_t* MIXED; int i; int pad; __device__ void operator()(int m, int n, float a) const { float v = sigmoidf_(bf2f(G[(size_t)m * 4096 + i * 1024 + n]) + bg[n]) * a; const size_t o = (size_t)m * DM + n; if (i > 0) v += MIXF[o]; if (i < 3) MIXF[o] = v; else MIXED[o] = f2bf(v); } };
struct EResid { const float* base; float* out; __device__ void operator()(int m, int n, float a) const { out[(size_t)m * DM + n] = base[(size_t)m * DM + n] + a; } };

template <class Epi> __global__ void __launch_bounds__(256) n_gemm(const bf16_t* __restrict__ A, const float* __restrict__ W, int lda, int ldw, int K, int kmask, Epi epi) {
    __shared__ float As[16][68], Bs[16][68];
    const int tx = threadIdx.x & 15, ty = threadIdx.x >> 4, m0 = blockIdx.y * 64, n0 = blockIdx.x * 64;
    float acc[4][4];
#pragma unroll
    for (int i = 0; i < 4; ++i)
#pragma unroll
        for (int j = 0; j < 4; ++j) acc[i][j] = 0.f;
    for (int k0 = 0; k0 < K; k0 += 16) {
#pragma unroll
        for (int i = 0; i < 4; ++i) { const int idx = threadIdx.x + i * 256; { const int r = idx >> 4, c = idx & 15; As[c][r] = bf2f(A[(size_t)(m0 + r) * lda + k0 + c]); }
            { const int r = idx >> 6, c = idx & 63; Bs[r][c] = bfr(W[(size_t)((k0 + r) & kmask) * ldw + n0 + c]); } }
        __syncthreads();
#pragma unroll
        for (int kk = 0; kk < 16; ++kk) { float a[4], b[4];
#pragma unroll
            for (int i = 0; i < 4; ++i) { a[i] = As[kk][ty * 4 + i]; b[i] = Bs[kk][tx * 4 + i]; }
#pragma unroll
            for (int i = 0; i < 4; ++i)
#pragma unroll
                for (int j = 0; j < 4; ++j) acc[i][j] += a[i] * b[j]; }
        __syncthreads();
    }
#pragma unroll
    for (int i = 0; i < 4; ++i)
#pragma unroll
        for (int j = 0; j < 4; ++j) epi(m0 + ty * 4 + i, n0 + tx * 4 + j, acc[i][j]);
}

__global__ void __launch_bounds__(256) n_headnorm(bf16_t* X, const float* __restrict__ g, int HD, float scale) {
    const int idx = blockIdx.x * 256 + threadIdx.x, nh = DM / HD, row = idx / nh, h = idx % nh;
    if (row >= T) return;
    bf16_t* p = X + (size_t)row * DM + h * HD; float ss = 0.f;
    for (int d = 0; d < HD; ++d) { const float v = bf2f(p[d]); ss += v * v; }
    const float rstd = rsqrtf(ss / HD + EPS) * scale;
    for (int d = 0; d < HD; ++d) p[d] = f2bf(bf2f(p[d]) * rstd * g[d]);
}

__global__ void __launch_bounds__(1024) n_cumsum(const float* __restrict__ LOGF, float* __restrict__ FB) {
    __shared__ float part[1024];
    const int bh = blockIdx.x, tid = threadIdx.x; const float* src = LOGF + (size_t)bh * SEQ + tid * 8; float v[8]; float s = 0.f;
#pragma unroll
    for (int i = 0; i < 8; ++i) { s += src[i]; v[i] = s; }
    part[tid] = s; __syncthreads();
    if (tid == 0) { float run = 0.f; for (int i = 0; i < 1024; ++i) { const float t_ = part[i]; part[i] = run; run += t_; } }
    __syncthreads();
    const float off = part[tid]; float* dst = FB + (size_t)bh * SEQ + tid * 8;
#pragma unroll
    for (int i = 0; i < 8; ++i) dst[i] = off + v[i];
}

__global__ void __launch_bounds__(256) n_fox_attn(const bf16_t* Q, const bf16_t* __restrict__ K, const bf16_t* __restrict__ V, const float* __restrict__ FB, bf16_t* O) {
    __shared__ float Ks[64][64], Vs[64][64], Fs[64];
    const int bh = blockIdx.y, b = bh >> 4, h = bh & 15, tq = blockIdx.x * 256 + threadIdx.x;
    const size_t rowq = (size_t)b * SEQ + tq;
    float q[64], o[64];
#pragma unroll
    for (int d = 0; d < 64; ++d) { q[d] = bf2f(Q[rowq * DM + h * 64 + d]); o[d] = 0.f; }
    const float Ft = FB[(size_t)bh * SEQ + tq];
    float m = -INFINITY, l = 0.f;
    const int ntile = (blockIdx.x * 256 + 256) / 64;
    for (int kt = 0; kt < ntile; ++kt) {
        __syncthreads();
        for (int i = threadIdx.x; i < 64 * 64; i += 256) { const int r = i >> 6, c = i & 63; const size_t rk = ((size_t)b * SEQ + kt * 64 + r) * DM + h * 64 + c; Ks[r][c] = bf2f(K[rk]); Vs[r][c] = bf2f(V[rk]); }
        if (threadIdx.x < 64) Fs[threadIdx.x] = FB[(size_t)bh * SEQ + kt * 64 + threadIdx.x];
        __syncthreads();
        for (int j = 0; j < 64; ++j) {
            const int s = kt * 64 + j; if (s > tq) break;
            float z = 0.f;
#pragma unroll
            for (int d = 0; d < 64; ++d) z += q[d] * Ks[j][d];
            z += (Ft - Fs[j]) * LOG2E;
            if (z > m) { const float c = exp2f(m - z); l *= c;
#pragma unroll
                for (int d = 0; d < 64; ++d) o[d] *= c;
                m = z; }
            const float p = exp2f(z - m); l += p;
#pragma unroll
            for (int d = 0; d < 64; ++d) o[d] += p * Vs[j][d];
        }
    }
    const float il = 1.f / l;
#pragma unroll
    for (int d = 0; d < 64; ++d) O[rowq * DM + h * 64 + d] = f2bf(o[d] * il);
}

__global__ void __launch_bounds__(256) n_sb_attn(const bf16_t* Q, const bf16_t* __restrict__ K, const bf16_t* __restrict__ V, bf16_t* O) {
    __shared__ float Ks[64][64], Vs[64][64];
    const int bh = blockIdx.y, b = bh >> 4, h = bh & 15, tq = blockIdx.x * 256 + threadIdx.x;
    const size_t rowq = (size_t)b * SEQ + tq;
    float q[64], o[64];
#pragma unroll
    for (int d = 0; d < 64; ++d) { q[d] = bf2f(Q[rowq * DM + h * 64 + d]) * 0.125f; o[d] = 0.f; }
    float R = 0.f;
    for (int kt = (blockIdx.x * 256 + 255) / 64; kt >= 0; --kt) {
        if (__syncthreads_and(R < SB_THR)) break;
        for (int i = threadIdx.x; i < 64 * 64; i += 256) { const int r = i >> 6, c = i & 63; const size_t rk = ((size_t)b * SEQ + kt * 64 + r) * DM + h * 64 + c; Ks[r][c] = bf2f(K[rk]); Vs[r][c] = bf2f(V[rk]); }
        __syncthreads();
        for (int j = 63; j >= 0; --j) {
            const int s = kt * 64 + j; if (s >= tq) continue;
            float z = 0.f;
#pragma unroll
            for (int d = 0; d < 64; ++d) z += q[d] * Ks[j][d];
            const float sp = softplusf(z);
            const float w = __expf((z - sp) + R);
            R -= sp;
#pragma unroll
            for (int d = 0; d < 64; ++d) o[d] += w * Vs[j][d];
        }
    }
#pragma unroll
    for (int d = 0; d < 64; ++d) O[rowq * DM + h * 64 + d] = f2bf(o[d]);
}

__global__ void __launch_bounds__(64) n_lru(const bf16_t* LX, const bf16_t* __restrict__ LG, const float* __restrict__ cw, const float* __restrict__ cb,
                                            const float* __restrict__ wa, const float* __restrict__ ba, const float* __restrict__ wx, const float* __restrict__ bx,
                                            const float* __restrict__ lam, bf16_t* YL) {
    __shared__ float xs[64];
    const int b = blockIdx.x >> 4, n = blockIdx.x & 15, e = threadIdx.x, ch = n * 64 + e;
    float wA[64], wX[64];
#pragma unroll
    for (int d = 0; d < 64; ++d) { wA[d] = wa[((size_t)n * 64 + d) * 64 + e]; wX[d] = wx[((size_t)n * 64 + d) * 64 + e]; }
    const float w0 = cw[ch], w1 = cw[DM + ch], w2 = cw[2 * DM + ch], w3 = cw[3 * DM + ch], bc = cb[ch], bA = ba[ch], bX = bx[ch];
    const float spl = softplusf(-lam[ch]);
    float x1 = 0.f, x2 = 0.f, x3 = 0.f, hs = 0.f;
    for (int t = 0; t < SEQ; ++t) {
        const size_t r = ((size_t)b * SEQ + t) * DM + ch;
        const float x0 = bf2f(LX[r]);
        const float xc = bc + w3 * x0 + w2 * x1 + w1 * x2 + w0 * x3;
        x3 = x2; x2 = x1; x1 = x0;
        __syncthreads();
        xs[e] = xc;
        __syncthreads();
        float ra = bA, ri = bX;
#pragma unroll
        for (int d = 0; d < 64; ++d) { const float xv = xs[d]; ra += xv * wA[d]; ri += xv * wX[d]; }
        const float rr = sigmoidf_(ra), ii = sigmoidf_(ri);
        const float la = -8.f * rr * spl;
        const float a = __expf(la);
        const float u = sqrtf(-expm1f(2.f * la)) * (ii * xc);
        hs = a * hs + u;
        YL[r] = f2bf(hs * gelu_tanh(bf2f(LG[r])));
    }
}

__global__ void __launch_bounds__(256) n_memkv_post(const float* __restrict__ raw, const float* __restrict__ gk, const float* __restrict__ gq, bf16_t* __restrict__ MK, bf16_t* __restrict__ MVT) {
    const int row = blockIdx.x, b = row >> 8, m = row & 255, d = threadIdx.x;
    __shared__ float red[4];
    for (int h = 0; h < 4; ++h) {
        const float k = raw[(size_t)row * 2048 + h * 256 + d];
        float ss = wave_sum(k * k);
        __syncthreads();
        if ((threadIdx.x & 63) == 0) red[threadIdx.x >> 6] = ss;
        __syncthreads();
        ss = red[0] + red[1] + red[2] + red[3];
        const float rstd = rsqrtf(ss * (1.f / 256.f) + EPS);
        MK[((size_t)b * 256 + m) * DM + h * 256 + d] = f2bf(k * rstd * gk[d] * gq[d]);
        MVT[(((size_t)b * 4 + h) * 256 + d) * 256 + m] = f2bf(raw[(size_t)row * 2048 + 1024 + h * 256 + d]);
    }
}

__global__ void __launch_bounds__(256) n_mem_attn(const bf16_t* MQ, const bf16_t* __restrict__ MK, const bf16_t* __restrict__ MVT, bf16_t* YM) {
    __shared__ float qs[256], ps[256], red[4];
    const int row = blockIdx.x >> 2, h = blockIdx.x & 3, b = row / SEQ, tid = threadIdx.x;
    const float qv = bf2f(MQ[(size_t)row * DM + h * 256 + tid]);
    float ss = wave_sum(qv * qv);
    if ((tid & 63) == 0) red[tid >> 6] = ss;
    qs[tid] = qv;
    __syncthreads();
    const float rstd = rsqrtf((red[0] + red[1] + red[2] + red[3]) * (1.f / 256.f) + EPS);
    const bf16_t* kr = MK + ((size_t)b * 256 + tid) * DM + h * 256;
    float s = 0.f;
    for (int d = 0; d < 256; ++d) s += qs[d] * bf2f(kr[d]);
    s *= rstd * (1.f / 16.f);
    __syncthreads();
    float mx = s;
#pragma unroll
    for (int o = 1; o < 64; o <<= 1) mx = fmaxf(mx, __shfl_xor(mx, o));
    if ((tid & 63) == 0) red[tid >> 6] = mx;
    __syncthreads();
    mx = fmaxf(fmaxf(red[0], red[1]), fmaxf(red[2], red[3]));
    const float p = __expf(s - mx);
    ps[tid] = p;
    float sum = wave_sum(p);
    __syncthreads();
    if ((tid & 63) == 0) red[tid >> 6] = sum;
    __syncthreads();
    sum = red[0] + red[1] + red[2] + red[3];
    const bf16_t* vr = MVT + (((size_t)b * 4 + h) * 256 + tid) * 256;
    float o = 0.f;
    for (int m = 0; m < 256; ++m) o += ps[m] * bf2f(vr[m]);
    YM[(size_t)row * DM + h * 256 + tid] = f2bf(o / sum);
}

__global__ void __launch_bounds__(256) n_act(const bf16_t* __restrict__ GV, const float* __restrict__ cw, const float* __restrict__ cb, bf16_t* __restrict__ ACT) {
    const size_t idx = (size_t)blockIdx.x * 256 + threadIdx.x; if (idx >= (size_t)T * DFF) return;
    const int r = (int)(idx / DFF), c = (int)(idx % DFF), t = r % SEQ;
    const float g0 = bf2f(GV[(size_t)r * 2 * DFF + c]);
    const float g1 = t >= 1 ? bf2f(GV[(size_t)(r - 1) * 2 * DFF + c]) : 0.f;
    const float g2 = t >= 2 ? bf2f(GV[(size_t)(r - 2) * 2 * DFF + c]) : 0.f;
    const float pre = cb[c] + cw[2 * DFF + c] * g0 + cw[DFF + c] * g1 + cw[c] * g2;
    const float val = bf2f(GV[(size_t)r * 2 * DFF + DFF + c]);
    ACT[(size_t)r * DFF + c] = f2bf(pre * sigmoidf_(pre) * val);
}

#define CFG 32767
namespace pg8 {
#define PG8_LAS __attribute__((address_space(3)))
typedef unsigned short bf16_t;
typedef short bf16x8 __attribute__((ext_vector_type(8)));
typedef float f32x4 __attribute__((ext_vector_type(4)));
typedef unsigned u32x4 __attribute__((ext_vector_type(4)));
constexpr int BM = 256, BK = 64, HALF = 128, HTB = HALF * BK * 2  , STAGE_BYTES = 8 * HTB, NXCD = 8, WGM = 8;

__host__ __device__ __forceinline__ int lds_byte(int r, int c) { const int st = (r >> 4) * 2 + (c >> 5), rr = r & 15, cc = c & 31, ob = rr * 64 + cc * 2; return st * 1024 + (ob ^ (((ob >> 9) & 1) << 5)); }
__host__ __device__ __forceinline__ void stage_rc(int b, int& R, int& C) { const int st = b / 1024, sb = b % 1024, swz = sb ^ (((sb >> 9) & 1) << 5); R = (st >> 1) * 16 + swz / 64; C = (st & 1) * 32 + (swz % 64) / 2; }
__host__ __device__ __forceinline__ int perm32(int rho) { const int n = rho >> 4, i = rho & 15; return 8 * (i >> 2) + 4 * n + (i & 3); }

struct Unit { int pm, pn; };
struct Gemm { int lda, ldb, K; };

struct StaticOrder {
    int nM, nN, nwg, G, c;
    __host__ __device__ void init(int M, int N, int G_, int c_) { nM = M / BM; nN = N / BM; nwg = nM * nN; G = G_; c = c_; }
    __host__ __device__ bool next(int i, Unit& u) const {
        const long L = (long)i * G + c; if (L >= nwg) return false;
        int wgid = (int)L; { const int q = nwg / NXCD, r = nwg % NXCD, xcd = wgid % NXCD, off = wgid / NXCD; wgid = (xcd < r ? xcd * (q + 1) : r * (q + 1) + (xcd - r) * q) + off; }
        const int nig = WGM * nN, gid = wgid / nig, fm = gid * WGM, gsz = (nM - fm) < WGM ? (nM - fm) : WGM;
        u.pm = fm + ((wgid % nig) % gsz); u.pn = (wgid % nig) / gsz; return true;
    }
    __device__ __forceinline__ void a_ready(const Unit&) const {}
    __device__ __forceinline__ void done(const Unit&) const {}
};

__device__ __forceinline__ unsigned cvt_pk_bf16(float lo, float hi) { unsigned r; asm volatile("v_cvt_pk_bf16_f32 %0, %1, %2" : "=v"(r) : "v"(lo), "v"(hi)); return r; }
typedef float f32x2 __attribute__((ext_vector_type(2)));
__device__ __forceinline__ f32x2 gelu_pk(f32x2 v) {
    const f32x2 av = __builtin_elementwise_abs(v), d = av * 0.2316418882f + 1.0f;
    f32x2 t; t.x = __builtin_amdgcn_rcpf(d.x); t.y = __builtin_amdgcn_rcpf(d.y);
    f32x2 q = t * 0.5307027145f + (-0.7265760135f); q = q * t + 0.7107068705f; q = q * t + (-0.142248368f); q = q * t + 0.127414796f; q = q * t;
    const f32x2 s = (v * v) * (-0.72134752044f);
    f32x2 e; e.x = __builtin_amdgcn_exp2f(s.x); e.y = __builtin_amdgcn_exp2f(s.y);
    const f32x2 m = v * (q * e), r = v - m;
    f32x2 o; o.x = v.x < 0.f ? m.x : r.x; o.y = v.y < 0.f ? m.y : r.y; return o;
}

template <class Epi, class Sched, bool ALIGN_EPI = false, bool SP2 = false>
__device__ __forceinline__ void gemm_phase(PG8_LAS unsigned char* lds, const Gemm g, const Sched& S, const Epi& E) {
    const int tid = mk_tid(), wid = __builtin_amdgcn_readfirstlane(tid >> 6), lane = tid & 63, wr = wid >> 2, wc = wid & 3, fr = lane & 15, fq = lane >> 4;
    const int K = g.K, nt = K / BK;
    unsigned voffA[2], voffB[2];
#pragma unroll
    for (int i = 0; i < 2; ++i) { int R, C; stage_rc(tid * 16 + i * 8192, R, C); const int Rb = Epi::PERM ? ((R & ~31) + perm32(R & 31)) : R;
        voffA[i] = (unsigned)(R * g.lda + C) * 2u; voffB[i] = (unsigned)(Rb * g.ldb + C) * 2u; }
    const size_t kstep = (size_t)(BK * 2);
    const size_t hstepA = (size_t)HALF * g.lda * 2, hstepB = (size_t)HALF * g.ldb * 2;
    const unsigned ldsw = (unsigned)wid * 1024u;
    const int aoff = lds_byte(wr * 64 + fr, fq * 8), boff = lds_byte(wc * 32 + fr, fq * 8);
#define PG8_SA(b, h) (((b) * 2 + (h)) * HTB)
#define PG8_SB(b, h) ((4 + (b) * 2 + (h)) * HTB)
#define PG8_STAGE(bufoff, gbase, voff) do { _Pragma("unroll") for (int _i = 0; _i < 2; ++_i) \
        __builtin_amdgcn_global_load_lds((const unsigned*)((const char*)(gbase) + (voff)[_i]), (PG8_LAS unsigned*)(lds + (bufoff) + ldsw + _i * 8192), 16, 0, 0); } while (0)
#define PG8_LDA(dst, b, h) do { _Pragma("unroll") for (int m = 0; m < 4; ++m) _Pragma("unroll") for (int k = 0; k < 2; ++k) dst[m][k] = *(const PG8_LAS bf16x8*)(lds + PG8_SA(b, h) + aoff + m * 2048 + k * 1024); } while (0)
#define PG8_LDB(dst, b, h) do { _Pragma("unroll") for (int n = 0; n < 2; ++n) _Pragma("unroll") for (int k = 0; k < 2; ++k) dst[n][k] = *(const PG8_LAS bf16x8*)(lds + PG8_SB(b, h) + boff + n * 2048 + k * 1024); } while (0)
#define PG8_MMA(ai, bj, At, Bt) do { __builtin_amdgcn_s_setprio(1); _Pragma("unroll") for (int m = 0; m < 4; ++m) _Pragma("unroll") for (int n = 0; n < 2; ++n) _Pragma("unroll") for (int k = 0; k < 2; ++k) \
        acc[ai][bj][m][n] = __builtin_amdgcn_mfma_f32_16x16x32_bf16(Bt[n][k], At[m][k], acc[ai][bj][m][n], 0, 0, 0); __builtin_amdgcn_s_setprio(0); } while (0)
#define PG8_WAIT_V(n) asm volatile("s_waitcnt vmcnt(" #n ")" ::: "memory")
#define PG8_WAIT_L(n) asm volatile("s_waitcnt lgkmcnt(" #n ")" ::: "memory")
#define PG8_BAR __builtin_amdgcn_s_barrier()
#define PG8_SCHED __builtin_amdgcn_sched_barrier(0)
    Unit cur, nxt; int ui = 0;
    if (!S.next(0, cur)) return;
    f32x4 acc[2][2][4][2];
#pragma unroll
    for (int a = 0; a < 2; ++a)
#pragma unroll
        for (int b = 0; b < 2; ++b)
#pragma unroll
            for (int m = 0; m < 4; ++m)
#pragma unroll
                for (int n = 0; n < 2; ++n) acc[a][b][m][n] = (f32x4){0.f, 0.f, 0.f, 0.f};
    bf16x8 At[4][2], B0[2][2], B1[2][2];
    const char* cA = S.aptr(cur); const char* cB = S.bptr(cur);
    S.a_ready(cur);
    if constexpr (SP2) {
        PG8_STAGE(PG8_SB(0, 0), cB, voffB); PG8_STAGE(PG8_SB(0, 1), cB + hstepB, voffB); PG8_STAGE(PG8_SA(0, 0), cA, voffA); PG8_STAGE(PG8_SA(0, 1), cA + hstepA, voffA);
        if (wr == 1) PG8_BAR;
        PG8_WAIT_V(2); PG8_BAR;
        PG8_STAGE(PG8_SB(1, 0), cB + kstep, voffB); PG8_STAGE(PG8_SA(1, 0), cA + kstep, voffA); PG8_STAGE(PG8_SB(1, 1), cB + hstepB + kstep, voffB);
        PG8_WAIT_V(6); PG8_BAR;
    } else {
        PG8_STAGE(PG8_SB(0, 0), cB, voffB); PG8_STAGE(PG8_SA(0, 0), cA, voffA); PG8_STAGE(PG8_SB(0, 1), cB + hstepB, voffB); PG8_STAGE(PG8_SA(0, 1), cA + hstepA, voffA);
        if (wr == 1) PG8_BAR;
        PG8_WAIT_V(4); PG8_BAR;
        PG8_STAGE(PG8_SB(1, 0), cB + kstep, voffB); PG8_STAGE(PG8_SA(1, 0), cA + kstep, voffA); PG8_STAGE(PG8_SB(1, 1), cB + hstepB + kstep, voffB);
        PG8_WAIT_V(6); PG8_BAR;
    }
    for (;;) {
        const bool has_next = S.next(ui + 1, nxt);
        const char* nA = has_next ? S.aptr(nxt) : cA; const char* nB = has_next ? S.bptr(nxt) : cB;
        for (int t = 0; t < nt; t += 2) {
            const bool last = (t == nt - 2);
            const char* a1 = cA + (size_t)(t + 1) * kstep;
            const char* a2 = last ? nA : cA + (size_t)(t + 2) * kstep; const char* b2 = last ? nB : cB + (size_t)(t + 2) * kstep;
            const char* a3 = a2 + kstep; const char* b3 = b2 + kstep;
            if (last && has_next) S.a_ready(nxt);
            if constexpr (SP2) {
            PG8_LDB(B0, 0, 0); PG8_LDB(B1, 0, 1); PG8_SCHED; PG8_LDA(At, 0, 0); PG8_STAGE(PG8_SA(1, 1), a1 + hstepA, voffA);
            PG8_WAIT_V(8); PG8_WAIT_L(0); PG8_BAR; PG8_MMA(0, 0, At, B0); PG8_MMA(0, 1, At, B1); PG8_BAR; PG8_SCHED;
            PG8_LDA(At, 0, 1); PG8_STAGE(PG8_SB(0, 0), b2, voffB); PG8_STAGE(PG8_SB(0, 1), b2 + hstepB, voffB); PG8_STAGE(PG8_SA(0, 0), a2, voffA);
            PG8_WAIT_V(8); PG8_WAIT_L(0); PG8_BAR; PG8_MMA(1, 0, At, B0); PG8_MMA(1, 1, At, B1); PG8_BAR; PG8_SCHED;
            PG8_LDB(B0, 1, 0); PG8_LDB(B1, 1, 1); PG8_SCHED; PG8_LDA(At, 1, 0); PG8_STAGE(PG8_SA(0, 1), a2 + hstepA, voffA);
            PG8_WAIT_V(8); PG8_WAIT_L(0); PG8_BAR; PG8_MMA(0, 0, At, B0); PG8_MMA(0, 1, At, B1); PG8_BAR; PG8_SCHED;
            PG8_LDA(At, 1, 1); PG8_STAGE(PG8_SB(1, 0), b3, voffB); PG8_STAGE(PG8_SB(1, 1), b3 + hstepB, voffB); PG8_STAGE(PG8_SA(1, 0), a3, voffA);
            PG8_WAIT_V(8); PG8_WAIT_L(0); PG8_BAR; PG8_MMA(1, 0, At, B0); PG8_MMA(1, 1, At, B1); PG8_BAR; PG8_SCHED;
            } else {
            PG8_LDB(B0, 0, 0); PG8_SCHED; PG8_LDA(At, 0, 0); PG8_STAGE(PG8_SA(1, 1), a1 + hstepA, voffA);
            PG8_WAIT_L(8); PG8_BAR; PG8_WAIT_L(0); PG8_MMA(0, 0, At, B0); PG8_BAR; PG8_SCHED;
            PG8_LDB(B1, 0, 1); PG8_STAGE(PG8_SB(0, 0), b2, voffB);
            PG8_BAR; PG8_WAIT_L(0); PG8_MMA(0, 1, At, B1); PG8_BAR;
            PG8_LDA(At, 0, 1); PG8_STAGE(PG8_SA(0, 0), a2, voffA);
            PG8_BAR; PG8_WAIT_L(0); PG8_MMA(1, 0, At, B0); PG8_BAR; PG8_SCHED;
            PG8_STAGE(PG8_SB(0, 1), b2 + hstepB, voffB);
            PG8_WAIT_V(6); PG8_BAR; PG8_MMA(1, 1, At, B1); PG8_BAR;
            PG8_LDB(B0, 1, 0); PG8_SCHED; PG8_LDA(At, 1, 0); PG8_STAGE(PG8_SA(0, 1), a2 + hstepA, voffA);
            PG8_WAIT_L(8); PG8_BAR; PG8_WAIT_L(0); PG8_MMA(0, 0, At, B0); PG8_BAR; PG8_SCHED;
            PG8_LDB(B1, 1, 1); PG8_STAGE(PG8_SB(1, 0), b3, voffB);
            PG8_BAR; PG8_WAIT_L(0); PG8_MMA(0, 1, At, B1); PG8_BAR;
            PG8_LDA(At, 1, 1); PG8_STAGE(PG8_SA(1, 0), a3, voffA);
            PG8_BAR; PG8_WAIT_L(0); PG8_MMA(1, 0, At, B0); PG8_BAR; PG8_SCHED;
            PG8_STAGE(PG8_SB(1, 1), b3 + hstepB, voffB);
            PG8_WAIT_V(6); PG8_BAR; PG8_MMA(1, 1, At, B1); PG8_BAR;
            }
        }
        if constexpr (ALIGN_EPI) { if (wr == 0) PG8_BAR; }
        if constexpr (!Epi::AFTER_DRAIN) { int fr_ = fr, fq_ = fq; asm volatile("" : "+v"(fr_), "+v"(fq_));   E(acc, cur, wr, wc, fr_, fq_); S.done(cur); }
        if (!has_next) break;
#pragma unroll
        for (int a = 0; a < 2; ++a)
#pragma unroll
            for (int b = 0; b < 2; ++b)
#pragma unroll
                for (int m = 0; m < 4; ++m)
#pragma unroll
                    for (int n = 0; n < 2; ++n) acc[a][b][m][n] = (f32x4){0.f, 0.f, 0.f, 0.f};
        cur = nxt; cA = nA; cB = nB; ++ui;
        if constexpr (ALIGN_EPI) { if (wr == 1) PG8_BAR; }
    }
    PG8_WAIT_V(0);
    if constexpr (!ALIGN_EPI) { if (wr == 0) PG8_BAR; }
    PG8_BAR;
    if constexpr (Epi::AFTER_DRAIN) { E.fused(acc, cur, wr, wc, fr, fq, lds, wid, lane); S.done(cur); }
#undef PG8_SA
#undef PG8_SB
#undef PG8_STAGE
#undef PG8_LDA
#undef PG8_LDB
#undef PG8_MMA
#undef PG8_WAIT_V
#undef PG8_WAIT_L
#undef PG8_BAR
#undef PG8_SCHED
}
}
#include <hip/hip_bf16.h>
#include <cmath>
namespace attn_body {
using bf16=__hip_bfloat16;
using bf16x8=__attribute__((ext_vector_type(8)))short;
using s16x4=__attribute__((ext_vector_type(4)))short;
using f32x16=__attribute__((ext_vector_type(16)))float;
using u32x4=__attribute__((ext_vector_type(4)))unsigned;
constexpr int BATCH=2,NHEAD=16,SEQ=8192,D=64,DM=NHEAD*D;
constexpr int NW=8,QBLK=32,QB=QBLK*NW,KVBLK=64,NQB=SEQ/QB;
constexpr int ATTN_PITCH=DM, ATTN_UNIT_ROWS=QB;
__device__ __forceinline__ int crow(int r,int hi){return (r&3)+8*(r>>2)+4*hi;}
#define SBAR() __builtin_amdgcn_sched_barrier(0)
__device__ __forceinline__ void cmask(f32x16&p0,f32x16&p1,int jb,int qrel,int hi){
  const float NEG=-INFINITY; int kb=64*jb+4*hi;
  #pragma unroll
  for(int r=0;r<16;++r){int kv=kb+(r&3)+8*(r>>2); if(kv>qrel)p0[r]=NEG; if(kv+32>qrel)p1[r]=NEG;}
}

constexpr int NSLOT=3, SLOTB=8192;
constexpr int LDS_K=0, LDS_V=NSLOT*SLOTB, LDS_WS=2*NSLOT*SLOTB, LDS_OST=LDS_WS+NW*64*4, LDS_BYTES=LDS_OST+NW*4096;
constexpr int BIAS_OFF=86016;
constexpr float C2=0.125f*1.4426950408889634f;
__device__ __forceinline__ void glds16(const void*gsrc,unsigned lds_dst){unsigned keep;
  asm volatile("s_mov_b32 %0, m0\n\ts_mov_b32 m0, %2\n\ts_nop 0\n\tglobal_load_lds_dwordx4 %1, off\n\ts_mov_b32 m0, %0":"=&s"(keep):"v"(gsrc),"s"(lds_dst):"memory");}
__device__ __forceinline__ float max3f(float a,float b,float c){float r;asm("v_max3_f32 %0, %1, %2, %3":"=v"(r):"v"(a),"v"(b),"v"(c));return r;}
__device__ __forceinline__ float max2f(float a,float b){float r;asm("v_max_f32_e32 %0, %1, %2":"=v"(r):"v"(a),"v"(b));return r;}
__device__ __forceinline__ float fadd_s(float a,float b){float r;asm("v_add_f32_e32 %0, %1, %2":"=v"(r):"v"(a),"v"(b));return r;}
__device__ __forceinline__ float fsub_s(float a,float b){float r;asm("v_sub_f32_e32 %0, %1, %2":"=v"(r):"v"(a),"v"(b));return r;}
typedef float f32x2_t __attribute__((ext_vector_type(2))); typedef __bf16 bf16x2_t __attribute__((ext_vector_type(2)));
__device__ __forceinline__ unsigned cvtpk_s(float lo,float hi){f32x2_t v={lo,hi};bf16x2_t b=__builtin_convertvector(v,bf16x2_t);return __builtin_bit_cast(unsigned,b);}
#define WAIT_BAR(N) asm volatile("s_waitcnt vmcnt(" #N ") lgkmcnt(0)\n\ts_barrier":::"memory")

__device__ __forceinline__ void qkt(f32x16&p0,f32x16&p1,const char*Kslot,const bf16x8*qr,const f32x16&negm,int r32,int hi){
  const char*kb=Kslot+hi*1024+r32*16;
  #pragma unroll
  for(int d0=0;d0<4;++d0){
    const bf16x8 b0=*reinterpret_cast<const bf16x8*>(kb+d0*2048);
    const bf16x8 b1=*reinterpret_cast<const bf16x8*>(kb+d0*2048+512);
    if(d0==0){p0=__builtin_amdgcn_mfma_f32_32x32x16_bf16(b0,qr[0],negm,0,0,0);p1=__builtin_amdgcn_mfma_f32_32x32x16_bf16(b1,qr[0],negm,0,0,0);}
    else{p0=__builtin_amdgcn_mfma_f32_32x32x16_bf16(b0,qr[d0],p0,0,0,0);p1=__builtin_amdgcn_mfma_f32_32x32x16_bf16(b1,qr[d0],p1,0,0,0);}}
}
typedef __attribute__((address_space(3))) const char* lds_cptr;
typedef short v4i16_t __attribute__((ext_vector_type(4)));
__device__ __forceinline__ void kload8(bf16x8*kf,lds_cptr kp){
  kf[0]=*(const __attribute__((address_space(3))) bf16x8*)(kp);      kf[1]=*(const __attribute__((address_space(3))) bf16x8*)(kp+512);
  kf[2]=*(const __attribute__((address_space(3))) bf16x8*)(kp+2048); kf[3]=*(const __attribute__((address_space(3))) bf16x8*)(kp+2560);
  kf[4]=*(const __attribute__((address_space(3))) bf16x8*)(kp+4096); kf[5]=*(const __attribute__((address_space(3))) bf16x8*)(kp+4608);
  kf[6]=*(const __attribute__((address_space(3))) bf16x8*)(kp+6144); kf[7]=*(const __attribute__((address_space(3))) bf16x8*)(kp+6656);
}
__device__ __forceinline__ void kload2(bf16x8*kf,lds_cptr kp,int j){ kf[2*j]=*(const __attribute__((address_space(3))) bf16x8*)(kp+j*2048); kf[2*j+1]=*(const __attribute__((address_space(3))) bf16x8*)(kp+j*2048+512); }
__device__ __forceinline__ s16x4 vtr(lds_cptr p){ return __builtin_bit_cast(s16x4,__builtin_amdgcn_ds_read_tr16_b64_v4i16((__attribute__((address_space(3))) v4i16_t*)p)); }
__device__ __forceinline__ float rowmax(const f32x16&p0,const f32x16&p1){
  float a=max3f(p0[0],p0[1],p1[0]),b=max3f(p0[2],p0[3],p1[1]);a=max3f(a,p1[2],p1[3]);
  #pragma unroll
  for(int r=4;r<16;r+=4){a=max3f(a,p0[r],p0[r+1]);b=max3f(b,p0[r+2],p0[r+3]);a=max3f(a,p1[r],p1[r+1]);b=max3f(b,p1[r+2],p1[r+3]);}
  const float m=max2f(a,b);
  auto rr=__builtin_amdgcn_permlane32_swap(__float_as_uint(m),__float_as_uint(m),false,false);
  return max2f(__uint_as_float(rr[0]),__uint_as_float(rr[1]));
}
__device__ __forceinline__ void pv(f32x16*o,int vb,bf16x8 pa0,bf16x8 pa1,bf16x8 pa2,bf16x8 pa3){
  #pragma unroll
  for(int d0=0;d0<2;++d0){s16x4 lo[4],hi[4];
    #pragma unroll
    for(int ks=0;ks<4;++ks){
      asm volatile("ds_read_b64_tr_b16 %0,%1 offset:%c2":"=&v"(lo[ks]):"v"(vb),"i"(d0*4096+ks*1024):"memory");
      asm volatile("ds_read_b64_tr_b16 %0,%1 offset:%c2":"=&v"(hi[ks]):"v"(vb),"i"(d0*4096+ks*1024+512):"memory");}
    asm volatile("s_waitcnt lgkmcnt(0)":::"memory");SBAR();
    #define PK(k) (bf16x8){lo[k][0],lo[k][1],lo[k][2],lo[k][3],hi[k][0],hi[k][1],hi[k][2],hi[k][3]}
    o[d0]=__builtin_amdgcn_mfma_f32_32x32x16_bf16(pa0,PK(0),o[d0],0,0,0);
    o[d0]=__builtin_amdgcn_mfma_f32_32x32x16_bf16(pa1,PK(1),o[d0],0,0,0);
    o[d0]=__builtin_amdgcn_mfma_f32_32x32x16_bf16(pa2,PK(2),o[d0],0,0,0);
    o[d0]=__builtin_amdgcn_mfma_f32_32x32x16_bf16(pa3,PK(3),o[d0],0,0,0);
    #undef PK
  }
}

#ifndef ATTN_STORE16
#define ATTN_STORE16(p,v) (*(u32x4*)(p)=(v))
#endif
template<int THRL> __device__ __forceinline__ void attn_unit(int b,int h,int qb,const bf16*Q,const bf16*__restrict__ K,const bf16*__restrict__ V,bf16*O,const float*__restrict__ FBrow,float skip_thr,char*shm){
  const int tid=mk_tid(),lane=tid&63,r32=lane&31,hi=lane>>5; const int wid=__builtin_amdgcn_readfirstlane(tid>>6);
  const long rowbase=(long)b*SEQ; const int q0=qb*QB;
  int t_start=0;
  { const int ntf=(q0+QB)/KVBLK; const float Fq0=FBrow[q0];
    const bool c0=lane<ntf&&(Fq0-FBrow[64*(lane<ntf?lane:0)+63])*1.4426950408889634f<skip_thr;
    const bool c1=(lane+64)<ntf&&(Fq0-FBrow[64*((lane+64)<ntf?lane+64:0)+63])*1.4426950408889634f<skip_thr;
    int cnt=__popcll(__ballot(c0))+__popcll(__ballot(c1)); cnt&=~1; if(cnt>ntf-4)cnt=ntf-4; t_start=__builtin_amdgcn_readfirstlane(cnt); }
  const bf16*Qw=Q+(rowbase+q0+wid*QBLK)*DM+h*D;
  const bf16*Kh=K+(rowbase+(long)t_start*KVBLK)*DM+h*D,*Vh=V+(rowbase+(long)t_start*KVBLK)*DM+h*D;
  const lds_cptr shm3=(lds_cptr)shm;
  const unsigned lds0=(unsigned)(uintptr_t)shm;
  float*wsf=(float*)(shm+LDS_WS)+wid*64;
  const bf16*ksrc=Kh+(long)lane*DM+wid*8;
  const bf16*vsrc=Vh+(long)(16*(wid&3)+(lane>>2))*DM+(wid>>2)*32+(lane&3)*8;
  const unsigned kdst=lds0+LDS_K+wid*1024, vdst=lds0+LDS_V+wid*1024;
  #define DMA_K(t,slot) glds16(ksrc+(long)(t)*KVBLK*DM,(unsigned)__builtin_amdgcn_readfirstlane(kdst+(slot)))
  #define DMA_V(t,slot) glds16(vsrc+(long)(t)*KVBLK*DM,(unsigned)__builtin_amdgcn_readfirstlane(vdst+(slot)))
  const int vb0=(int)(lds0+LDS_V)+((lane>>4)&1)*32+(lane&3)*8+(4*hi+((lane&15)>>2))*64;
  const char*Kbase=shm+LDS_K; bf16x8 kf[8];
  const lds_cptr kp0=shm3+LDS_K+hi*1024+r32*16; const lds_cptr vp0=shm3+LDS_V+((lane>>4)&1)*32+(lane&3)*8+(4*hi+((lane&15)>>2))*64;
  const int NT=(q0+QB)/KVBLK-t_start;
  {
    typedef __attribute__((address_space(3))) float lds_f32; lds_f32* bl=(lds_f32*)(shm3+BIAS_OFF);
    const int nb=q0+QB; const float Fl=FBrow[nb-1];
    for(int i0=t_start*KVBLK+tid;i0<nb;i0+=8*NW*64){ float fv[8];
      _Pragma("unroll") for(int q=0;q<8;++q){ const int i=i0+q*NW*64; fv[q]=FBrow[i<nb?i:nb-1]; }
      __builtin_amdgcn_sched_barrier(0);
      _Pragma("unroll") for(int q=0;q<8;++q){ const int i=i0+q*NW*64; if(i<nb) bl[i]=(Fl-fv[q])*1.4426950408889634f; } }
    asm volatile("s_waitcnt vmcnt(0) lgkmcnt(0)\n\ts_barrier":::"memory"); }
  typedef float f32x4v __attribute__((ext_vector_type(4)));
  #define BIAS(P0,P1,t) do{ const __attribute__((address_space(3))) f32x4v* bp_=(const __attribute__((address_space(3))) f32x4v*)(shm3+BIAS_OFF)+((t)+t_start)*16+hi; \
    _Pragma("unroll") for(int g_=0;g_<4;++g_){ const f32x4v f0_=bp_[2*g_]+nm, f1_=bp_[8+2*g_]+nm; \
      P0[4*g_]+=f0_[0];P0[4*g_+1]+=f0_[1];P0[4*g_+2]+=f0_[2];P0[4*g_+3]+=f0_[3]; P1[4*g_]+=f1_[0];P1[4*g_+1]+=f1_[1];P1[4*g_+2]+=f1_[2];P1[4*g_+3]+=f1_[3]; } }while(0)
  DMA_K(0,0);DMA_V(0,0);DMA_K(1,SLOTB);
  bf16x8 qr[4];
  #pragma unroll
  for(int d0=0;d0<4;++d0)qr[d0]=*reinterpret_cast<const bf16x8*>(&Qw[(long)r32*DM+d0*16+hi*8]);
  float mhat=0.f,l_reg=0.f;f32x16 o[2];o[0]=f32x16{};o[1]=f32x16{};const f32x16 negm=f32x16{}; float nm=0.f;
  const int qrel=wid*QBLK+r32;
  #define CMASK(P0,P1,t) do{int jb_=(t)-(NT-4); if(jb_>=0)cmask(P0,P1,jb_,qrel,hi);}while(0)
  bool resc=false;
  #define START(P0,P1) do{ const float rm=rowmax(P0,P1); resc=false; \
    { const float dl=rm; mhat=fadd_s(mhat,dl); \
      _Pragma("unroll") for(int r=0;r<16;++r){P0[r]=fsub_s(P0[r],dl);P1[r]=fsub_s(P1[r],dl);} \
      nm=-mhat; } \
    _Pragma("unroll") for(int r=0;r<16;++r)P0[r]=__builtin_amdgcn_exp2f(P0[r]); }while(0)
  #define RESC() do{ if(resc){ asm volatile("s_waitcnt lgkmcnt(0)":::"memory"); \
      _Pragma("unroll") for(int d_=0;d_<2;++d_) _Pragma("unroll") for(int r=0;r<16;++r)o[d_][r]*=wsf[crow(r,hi)]; } }while(0)
  f32x16 pA0,pA1,pB0,pB1;
  int sl_prev=0,sl_cur=0,sl_next=SLOTB;
  #define ROT() do{sl_prev=sl_cur;sl_cur=sl_next;sl_next=(sl_next==(NSLOT-1)*SLOTB)?0:sl_next+SLOTB;}while(0)
  DMA_K(2,2*SLOTB);
  WAIT_BAR(3);
  qkt(pA0,pA1,Kbase,qr,negm,r32,hi);asm volatile("s_nop 15\n\ts_nop 7":"+v"(pA0),"+v"(pA1));BIAS(pA0,pA1,0);CMASK(pA0,pA1,0);
  START(pA0,pA1);
  _Pragma("unroll") for(int r=0;r<16;++r)pA1[r]=__builtin_amdgcn_exp2f(pA1[r]);
  WAIT_BAR(0);
  DMA_K(3,0);DMA_V(1,SLOTB);
  ROT();
  kload8(kf,kp0+sl_cur);
  WAIT_BAR(2);
  s16x4 vlo[8],vhi[8]; u32x4 pw0,pw1,pw2,pw3;
  #define PKW(P,B) cvtpk_s(P[B],P[B+1])
  #define PAF(k) __builtin_bit_cast(bf16x8,pw##k)
  #define VFR(i) (bf16x8){vlo[i][0],vlo[i][1],vlo[i][2],vlo[i][3],vhi[i][0],vhi[i][1],vhi[i][2],vhi[i][3]}
  #define PIN(x) asm volatile("":"+v"(x))
  #define MX3(a,b,c) __builtin_fmaxf(__builtin_fmaxf((a),(b)),(c))
  #define GAPA(MF,A0,A1,A2,A3,W0,W1,PW) do{ MF; sacc+=A0; sacc+=A1; sacc+=A2; sacc+=A3; PIN(sacc); W0; W1; PIN(PW); SBAR(); }while(0)
  #define EX(v) __builtin_amdgcn_exp2f(v)
  #define GAPB(MF,X,B) do{ MF; X[B]=EX(X[B]); X[B+1]=EX(X[B+1]); X[B+2]=EX(X[B+2]); X[B+3]=EX(X[B+3]); PIN(X); SBAR(); }while(0)
  #define VRD(i) do{ vlo[i]=vtr(vp_+(((i)>>2)*4096+((i)&3)*1024)); vhi[i]=vtr(vp_+(((i)>>2)*4096+((i)&3)*1024+512)); }while(0)
  #define KRD(G,j) do{ if(G){ kload2(kf,kp0+sl_next,j); SBAR(); } }while(0)
  #define STEP(C0,C1,P0,P1,t,GK,GV,GL) do{ SBAR(); \
    const lds_cptr vp_=vp0+sl_prev; \
    VRD(0); SBAR(); float sacc=(P0[0]+P0[1]); \
    GAPA(C0=__builtin_amdgcn_mfma_f32_32x32x16_bf16(kf[0],qr[0],negm,0,0,0), P0[2],P0[3],P0[4],P0[5],     pw0[0]=PKW(P0,0), pw0[1]=PKW(P0,2), pw0); \
    VRD(4); SBAR(); GAPA(C1=__builtin_amdgcn_mfma_f32_32x32x16_bf16(kf[1],qr[0],negm,0,0,0), P0[6],P0[7],P0[8],P0[9],     pw0[2]=PKW(P0,4), pw0[3]=PKW(P0,6), pw0); \
    VRD(1); SBAR(); GAPA(C0=__builtin_amdgcn_mfma_f32_32x32x16_bf16(kf[2],qr[1],C0,0,0,0),   P0[10],P0[11],P0[12],P0[13], pw1[0]=PKW(P0,8), pw1[1]=PKW(P0,10), pw1); \
    VRD(5); SBAR(); GAPA(C1=__builtin_amdgcn_mfma_f32_32x32x16_bf16(kf[3],qr[1],C1,0,0,0),   P0[14],P0[15],P1[0],P1[1],   pw1[2]=PKW(P0,12),pw1[3]=PKW(P0,14), pw1); \
    VRD(2); SBAR(); GAPA(C0=__builtin_amdgcn_mfma_f32_32x32x16_bf16(kf[4],qr[2],C0,0,0,0),   P1[2],P1[3],P1[4],P1[5],     pw2[0]=PKW(P1,0), pw2[1]=PKW(P1,2), pw2); \
    VRD(6); SBAR(); GAPA(C1=__builtin_amdgcn_mfma_f32_32x32x16_bf16(kf[5],qr[2],C1,0,0,0),   P1[6],P1[7],P1[8],P1[9],     pw2[2]=PKW(P1,4), pw2[3]=PKW(P1,6), pw2); \
    VRD(3); SBAR(); GAPA(C0=__builtin_amdgcn_mfma_f32_32x32x16_bf16(kf[6],qr[3],C0,0,0,0),   P1[10],P1[11],P1[12],P1[13], pw3[0]=PKW(P1,8), pw3[1]=PKW(P1,10), pw3); \
    VRD(7); SBAR(); GAPA(C1=__builtin_amdgcn_mfma_f32_32x32x16_bf16(kf[7],qr[3],C1,0,0,0),   P1[14],P1[15],0.f,0.f,       pw3[2]=PKW(P1,12),pw3[3]=PKW(P1,14), pw3); \
    l_reg+=sacc; \
    if(GK){DMA_K((t)+3,sl_cur);} if(GV){DMA_V((t)+1,sl_next);} \
    BIAS(C0,C1,t); CMASK(C0,C1,t); \
    { float a=MX3(C0[0],C0[1],C1[0]),b=MX3(C0[2],C0[3],C1[1]); a=MX3(a,C1[2],C1[3]); \
      _Pragma("unroll") for(int r=4;r<16;r+=4){a=MX3(a,C0[r],C0[r+1]);b=MX3(b,C0[r+2],C0[r+3]);a=MX3(a,C1[r],C1[r+1]);b=MX3(b,C1[r+2],C1[r+3]);} \
      float rm=__builtin_fmaxf(a,b); { auto rr=__builtin_amdgcn_permlane32_swap(__float_as_uint(rm),__float_as_uint(rm),false,false); rm=__builtin_fmaxf(__uint_as_float(rr[0]),__uint_as_float(rr[1])); } \
      resc=false; \
      if(__builtin_expect(__any(rm>(float)THRL),0)){ const float dl=__builtin_fmaxf(rm,0.f); mhat+=dl; \
        _Pragma("unroll") for(int r=0;r<16;++r){C0[r]-=dl;C1[r]-=dl;} \
        nm=-mhat; \
        const float f=__builtin_amdgcn_exp2f(-dl); l_reg*=f; if(hi==0)wsf[r32]=f; resc=true; } } \
    SBAR(); \
    GAPB(o[0]=__builtin_amdgcn_mfma_f32_32x32x16_bf16(PAF(0),VFR(0),o[0],0,0,0), C0,0); \
    GAPB(o[1]=__builtin_amdgcn_mfma_f32_32x32x16_bf16(PAF(0),VFR(4),o[1],0,0,0), C0,4); \
    KRD(GL,0); GAPB(o[0]=__builtin_amdgcn_mfma_f32_32x32x16_bf16(PAF(1),VFR(1),o[0],0,0,0), C0,8); \
    KRD(GL,1); GAPB(o[1]=__builtin_amdgcn_mfma_f32_32x32x16_bf16(PAF(1),VFR(5),o[1],0,0,0), C0,12); \
    KRD(GL,2); GAPB(o[0]=__builtin_amdgcn_mfma_f32_32x32x16_bf16(PAF(2),VFR(2),o[0],0,0,0), C1,0); \
    KRD(GL,3); GAPB(o[1]=__builtin_amdgcn_mfma_f32_32x32x16_bf16(PAF(2),VFR(6),o[1],0,0,0), C1,4); \
    GAPB(o[0]=__builtin_amdgcn_mfma_f32_32x32x16_bf16(PAF(3),VFR(3),o[0],0,0,0), C1,8); \
    GAPB(o[1]=__builtin_amdgcn_mfma_f32_32x32x16_bf16(PAF(3),VFR(7),o[1],0,0,0), C1,12); \
    }while(0)
  int t=1;
  #undef CMASK
  #define CMASK(P0,P1,t) do{}while(0)
  for(;t+5<NT;t+=2){
    STEP(pB0,pB1,pA0,pA1,t,true,true,true);     WAIT_BAR(2); RESC(); ROT();
    STEP(pA0,pA1,pB0,pB1,t+1,true,true,true);   WAIT_BAR(2); RESC(); ROT();
  }
  #undef CMASK
  #define CMASK(P0,P1,t) do{int jb_=(t)-(NT-4); if(jb_>=0)cmask(P0,P1,jb_,qrel,hi);}while(0)
  #define ENDW(tt) do{ if((tt)+3<NT){WAIT_BAR(2);} else if((tt)+2<NT){WAIT_BAR(1);} else {WAIT_BAR(0);} }while(0)
  for(;t+1<NT;t+=2){
    STEP(pB0,pB1,pA0,pA1,t,(t+3<NT),(t+1<NT),(t+1<NT));       ENDW(t);   RESC(); ROT();
    STEP(pA0,pA1,pB0,pB1,t+1,(t+4<NT),(t+2<NT),(t+2<NT));     ENDW(t+1); RESC(); ROT();
  }
  STEP(pB0,pB1,pA0,pA1,NT-1,false,false,false); RESC();
  { float sacc=pB0[0]+pB0[1]; _Pragma("unroll") for(int r=2;r<16;++r)sacc+=pB0[r]; _Pragma("unroll") for(int r=0;r<16;++r)sacc+=pB1[r]; l_reg+=sacc;
    pw0=(u32x4){PKW(pB0,0),PKW(pB0,2),PKW(pB0,4),PKW(pB0,6)};pw1=(u32x4){PKW(pB0,8),PKW(pB0,10),PKW(pB0,12),PKW(pB0,14)};pw2=(u32x4){PKW(pB1,0),PKW(pB1,2),PKW(pB1,4),PKW(pB1,6)};pw3=(u32x4){PKW(pB1,8),PKW(pB1,10),PKW(pB1,12),PKW(pB1,14)};
    SBAR(); pv(o,vb0+sl_cur,PAF(0),PAF(1),PAF(2),PAF(3)); }
  #undef PKW
  #undef PAF
  #undef VFR
  #undef PIN
  #undef MX3
  #undef GAPA
  #undef GAPB
  #undef EX
  #undef VRD
  #undef KRD
  #undef STEP
  #undef ENDW
  {auto rr=__builtin_amdgcn_permlane32_swap(__float_as_uint(l_reg),__float_as_uint(l_reg),false,false);l_reg=__uint_as_float(rr[0])+__uint_as_float(rr[1]);}
  if(hi==0)wsf[32+r32]=l_reg;asm volatile("s_waitcnt lgkmcnt(0)":::"memory");
  float rli[16];
  #pragma unroll
  for(int r=0;r<16;++r)rli[r]=__builtin_amdgcn_rcpf(wsf[32+crow(r,hi)]);
  bf16*Ow=O+(rowbase+q0+wid*QBLK)*DM+h*D;
  { bf16*stg=(bf16*)(shm+LDS_OST)+wid*2048;
    #pragma unroll
    for(int r=0;r<16;++r){const int orow=crow(r,hi);
      #pragma unroll
      for(int d0=0;d0<2;++d0)stg[orow*64+d0*32+r32]=__float2bfloat16(o[d0][r]*rli[r]);}
    asm volatile("s_waitcnt lgkmcnt(0)":::"memory");
    #pragma unroll
    for(int i=0;i<4;++i){const int row=i*8+(lane>>3),ch=lane&7; const u32x4 v=*(const u32x4*)(stg+row*64+ch*8); ATTN_STORE16(Ow+(long)row*DM+ch*8,v);} }
  asm volatile("s_waitcnt lgkmcnt(0)\n\ts_barrier":::"memory");
  #undef BIAS
  #undef DMA_K
  #undef DMA_V
  #undef CMASK
  #undef START
  #undef RESC
  #undef ROT
}
constexpr int ATTN_LDS_BYTES=86016+32768;
struct AttnTensors { const bf16* Q; const bf16* K; const bf16* V; bf16* O; const float* FB; float skip_thr; int pad; };
struct AttnUnit { int bh; int qb; };
struct StaticOrder {
  int vcu;
  __device__ __forceinline__ explicit StaticOrder(int grid,int block):vcu((block%8)*(grid/8)+block/8){}
  __device__ __forceinline__ bool next(int i,AttnUnit&u)const{ if(i>=4)return false; const int s=vcu&7; u.bh=vcu>>3; u.qb=(i==0)?s:(i==1)?15-s:(i==2)?16+s:31-s; return true; }
  __device__ __forceinline__ void a_ready(const AttnUnit&)const{}
  __device__ __forceinline__ void done(const AttnUnit&)const{}
};
struct QueueOrder {
  unsigned* ctr; int xl; volatile __attribute__((address_space(3))) int* slot;
  __device__ __forceinline__ bool next(int,AttnUnit&u)const{
    if(mk_tid()==0){ int got=-1;
      for(int k=0;k<8&&got<0;++k){ const int q=(xl+k)&7; const int j=(int)__hip_atomic_fetch_add(ctr+q*64,1u,__ATOMIC_RELAXED,__HIP_MEMORY_SCOPE_AGENT); if(j<128)got=q*128+j; }
      *slot=got; }
    __syncthreads(); const int g=*slot; if(g<0)return false; const int q=g>>7,j=g&127; u.bh=q*4+(j&3); u.qb=31-(j>>2); return true; }
  __device__ __forceinline__ void a_ready(const AttnUnit&)const{}
  __device__ __forceinline__ void done(const AttnUnit&)const{}
};
template<class Sched,int THRL=8> __device__ __forceinline__ void attn_phase(char*lds,const AttnTensors&T,const Sched&S){
  AttnUnit u;
  for(int i=0;S.next(i,u);++i){ S.a_ready(u); attn_unit<THRL>(u.bh/NHEAD,u.bh%NHEAD,u.qb,T.Q,T.K,T.V,T.O,T.FB+(size_t)u.bh*SEQ,T.skip_thr,lds); S.done(u); }
}
#undef SBAR
#undef WAIT_BAR
}
namespace cg = cooperative_groups;
#define LAS __attribute__((address_space(3)))
#define LDS_WAIT() asm volatile("s_waitcnt lgkmcnt(0)" ::: "memory")
#define LDS_BAR() asm volatile("s_waitcnt lgkmcnt(0)\n\ts_barrier" ::: "memory")
constexpr int MEGA_THREADS = 512, MEGA_LDS = 147456, NWV = 8;
#define GAS __attribute__((address_space(1)))
#define XB_TMO      128
#define XB_XCNT(j)  (256  + 64 * (j))
#define XB_XSUB(j)  (1280 + 64 * (j))
#define XB_XGEN(j)  (2304 + 64 * (j))
#define XB_TOP      3328
#define XB_TOPGEN   3392
#define XCD_BAR_WORDS 3456
#define XB_SPIN_CAP (1u << 18)

__device__ __forceinline__ unsigned xb_ld(unsigned* p)              { return __hip_atomic_load(p, __ATOMIC_RELAXED, __HIP_MEMORY_SCOPE_AGENT); }
__device__ __forceinline__ unsigned xb_add(unsigned* p, unsigned v) { return __hip_atomic_fetch_add(p, v, __ATOMIC_RELAXED, __HIP_MEMORY_SCOPE_AGENT); }
__device__ __forceinline__ unsigned xb_xcc_id() { return (unsigned)__builtin_amdgcn_s_getreg((3 << 11) | 20) & 0xFu; }
#define XB_SPIN(cond, bar) do { unsigned _sp = 0; while (cond) { __builtin_amdgcn_s_sleep(1); \
    if ((++_sp & 255u) == 0u) { if (xb_ld(&(bar)[XB_TMO])) break; if (_sp > XB_SPIN_CAP) { atomicAdd(&(bar)[XB_TMO], 1u); break; } } } } while (0)

struct XcdBarrier {
    unsigned* bar; unsigned x;
    volatile LAS unsigned* st;
};

__device__ __forceinline__ XcdBarrier xcd_barrier_post(unsigned* bar, volatile LAS unsigned* st) {
    XcdBarrier b; b.bar = bar; b.x = xb_xcc_id(); b.st = st;
    if (threadIdx.x == 0) (void)xb_add(&bar[XB_XCNT(b.x)], 1u);
    return b;
}
__device__ __forceinline__ void xcd_barrier_complete(unsigned* bar, unsigned x, unsigned& nloc, unsigned& nx) {
    const unsigned G = gridDim.x * gridDim.y * gridDim.z;
    unsigned sum, cnt, mine, sp = 0u;
    for (;;) {
        sum = 0u; cnt = 0u; mine = 0u;
#pragma unroll
        for (unsigned j = 0; j < 16; ++j) { const unsigned c = xb_ld(&bar[XB_XCNT(j)]); sum += c; cnt += (c > 0u) ? 1u : 0u; mine = (j == x) ? c : mine; }
        if (sum == G) break;
        __builtin_amdgcn_s_sleep(1);
        if ((++sp & 255u) == 0u) { if (xb_ld(&bar[XB_TMO])) break; if (sp > XB_SPIN_CAP) { atomicAdd(&bar[XB_TMO], 1u); break; } }
    }
    nloc = mine > 0u ? mine : 1u; nx = cnt > 0u ? cnt : 1u;
}

__device__ __forceinline__ void xcd_barrier(const XcdBarrier& b) {
    asm volatile("s_waitcnt vmcnt(0)" ::: "memory");
    __syncthreads();
    if (threadIdx.x == 0) {
        unsigned* bar = b.bar;
        __builtin_amdgcn_s_waitcnt(0);
        unsigned nloc = b.st[0], nx = b.st[1];
        if (nloc == 0u) { xcd_barrier_complete(bar, b.x, nloc, nx); b.st[0] = nloc; b.st[1] = nx; }
        const unsigned old = xb_add(&bar[XB_XSUB(b.x)], 1u);
        const unsigned gen = old / nloc;
        if (old + 1u == (gen + 1u) * nloc) {
            __builtin_amdgcn_fence(__ATOMIC_RELEASE, "agent");
            asm volatile("s_waitcnt vmcnt(0)" ::: "memory");
            const unsigned og = xb_add(&bar[XB_TOP], 1u);
            const unsigned tg = og / nx;
            if (og + 1u == (tg + 1u) * nx) xb_add(&bar[XB_TOPGEN], 1u);
            else XB_SPIN(xb_ld(&bar[XB_TOPGEN]) == tg, bar);
            __builtin_amdgcn_fence(__ATOMIC_ACQUIRE, "agent");
            xb_add(&bar[XB_XGEN(b.x)], 1u);
            asm volatile("s_waitcnt vmcnt(0)" ::: "memory");
        } else {
            XB_SPIN(xb_ld(&bar[XB_XGEN(b.x)]) == gen, bar);
            __builtin_amdgcn_fence(__ATOMIC_ACQUIRE, "agent");
            asm volatile("s_waitcnt vmcnt(0)" ::: "memory");
        }
    }
    __syncthreads();
}
constexpr size_t WS_BAR = WS_CTL + 16384;
constexpr size_t WS_QCTR = WS_CTL + 32768;
constexpr size_t CTL_ZERO_BYTES = 65536 - 16384;
constexpr int XB_LDS_OFF = MEGA_LDS - 64;
constexpr size_t WT_IN = 0;
constexpr size_t WT_BR = WT_IN + (size_t)13312 * 1024 * 2;
constexpr size_t WT_OUT = WT_BR + (size_t)4096 * 1024 * 2;
constexpr size_t WT_UP = WT_OUT + (size_t)1024 * 1024 * 2;
constexpr size_t WT_DN = WT_UP + (size_t)5632 * 1024 * 2;
static_assert(WT_DN + (size_t)1024 * 2816 * 2 <= 72 * MiB, "weight copies");
constexpr size_t WS_WKVT = WS_GATES;
constexpr size_t WS_CB = WS_CTL + 4096;

typedef float f32x4 __attribute__((ext_vector_type(4)));
typedef unsigned u32x4 __attribute__((ext_vector_type(4)));
typedef short bf16x8_t __attribute__((ext_vector_type(8)));
typedef float f32x16_t __attribute__((ext_vector_type(16)));
__device__ __forceinline__ unsigned pk2(float lo, float hi) { return (unsigned)f2bf(lo) | ((unsigned)f2bf(hi) << 16); }
__device__ __forceinline__ float blo(unsigned u) { return __uint_as_float(u << 16); }
__device__ __forceinline__ float bhi(unsigned u) { return __uint_as_float(u & 0xffff0000u); }
__device__ __forceinline__ float fast_exp(float x) { return __builtin_amdgcn_exp2f(x * LOG2E); }
__device__ __forceinline__ float fast_log(float x) { return __builtin_amdgcn_logf(x) * 0.6931471805599453f; }
__device__ __forceinline__ float fast_softplus(float x) { return fmaxf(x, 0.f) + fast_log(1.f + fast_exp(-fabsf(x))); }
__device__ __forceinline__ float fast_sigmoid(float x) { return __builtin_amdgcn_rcpf(1.f + fast_exp(-x)); }
__device__ __forceinline__ float fast_tanh(float x) { const float e = fast_exp(-2.f * fabsf(x)); const float t = (1.f - e) * __builtin_amdgcn_rcpf(1.f + e); return x < 0.f ? -t : t; }
__device__ __forceinline__ float fast_gelu(float x) { const float u = 0.7978845608028654f * (x + 0.044715f * x * x * x); return 0.5f * x * (1.f + fast_tanh(u)); }

template <class Loc> struct LocOrder {
    pg8::StaticOrder so; Loc loc;
    __device__ __forceinline__ bool next(int i, pg8::Unit& u) const { return so.next(i, u); }
    __device__ __forceinline__ const char* aptr(const pg8::Unit& u) const { return loc.a(u); }
    __device__ __forceinline__ const char* bptr(const pg8::Unit& u) const { return loc.b(u); }
    __device__ __forceinline__ void a_ready(const pg8::Unit&) const {}
    __device__ __forceinline__ void done(const pg8::Unit&) const {}
};
struct LocStd { const char* A; const char* Bt; size_t astep, bstep;
    __device__ __forceinline__ const char* a(const pg8::Unit& u) const { return A + (size_t)u.pm * astep; }
    __device__ __forceinline__ const char* b(const pg8::Unit& u) const { return Bt + (size_t)u.pn * bstep; } };
struct LocBranch { const char* Y0; const char* Y1; const char* Y2; const char* Y3; const char* Bt;
    __device__ __forceinline__ const char* a(const pg8::Unit& u) const { const int i = u.pn >> 2; const char* y = i == 0 ? Y0 : i == 1 ? Y1 : i == 2 ? Y2 : Y3; return y + (size_t)u.pm * (256 * 1024 * 2); }
    __device__ __forceinline__ const char* b(const pg8::Unit& u) const { return Bt + (size_t)u.pn * (256 * 1024 * 2); } };
struct LocMemKV { const char* A; const char* Bt;
    __device__ __forceinline__ const char* a(const pg8::Unit& u) const { return A + (size_t)u.pm * (256 * 1024 * 2); }
    __device__ __forceinline__ const char* b(const pg8::Unit& u) const { return Bt + ((size_t)(u.pm >> 1) * 2048 + (size_t)u.pn * 256) * 2048; } };
struct LocMemS { const char* MQ; const char* MK;
    __device__ __forceinline__ const char* a(const pg8::Unit& u) const { return MQ + (size_t)u.pm * (256 * 2048) + u.pn * 512; }
    __device__ __forceinline__ const char* b(const pg8::Unit& u) const { return MK + (size_t)(u.pm >> 5) * (256 * 2048) + u.pn * 512; } };
struct LocMemPV { const char* E; const char* MVT;
    __device__ __forceinline__ const char* a(const pg8::Unit& u) const { return E + (size_t)u.pm * (256 * 2048) + u.pn * 512; }
    __device__ __forceinline__ const char* b(const pg8::Unit& u) const { return MVT + ((size_t)(u.pm >> 5) * 4 + u.pn) * (256 * 256 * 2); } };

struct BranchSched { int vcu; LocBranch loc;
    __device__ __forceinline__ bool next(int i, pg8::Unit& u) const { if (i >= 4) return false; u.pm = vcu >> 2; u.pn = i * 4 + (vcu & 3); return true; }
    __device__ __forceinline__ const char* aptr(const pg8::Unit& u) const { return loc.a(u); }
    __device__ __forceinline__ const char* bptr(const pg8::Unit& u) const { return loc.b(u); }
    __device__ __forceinline__ void a_ready(const pg8::Unit&) const {}
    __device__ __forceinline__ void done(const pg8::Unit&) const {}
};
typedef f32x4 AccT[2][2][4][2];
struct EpiProj { static constexpr bool PERM = true, AFTER_DRAIN = false; bf16_t* proj; bf16_t* gates; float* mqss;
    __device__ __forceinline__ void operator()(const AccT& acc, const pg8::Unit& u, int wr, int wc, int fr, int fq) const {
        int colt = u.pn * 256; const int grp = colt >> 10; bf16_t* base; int ldc;
        if (grp < 9) { base = proj + (size_t)grp * T * DM; ldc = DM; colt &= 1023; } else { base = gates; ldc = 4096; colt -= 9216; }
        const int row0 = u.pm * 256 + wr * 64 + fr, col0 = colt + wc * 32 + 8 * fq;
#pragma unroll
        for (int ai = 0; ai < 2; ++ai)
#pragma unroll
            for (int m = 0; m < 4; ++m) { const int row = row0 + ai * 128 + m * 16; bf16_t* rowp = base + (size_t)row * ldc + col0; float ss = 0.f;
#pragma unroll
                for (int bj = 0; bj < 2; ++bj) { const f32x4 v0 = acc[ai][bj][m][0], v1 = acc[ai][bj][m][1]; u32x4 w; w.x = pk2(v0[0], v0[1]); w.y = pk2(v0[2], v0[3]); w.z = pk2(v1[0], v1[1]); w.w = pk2(v1[2], v1[3]);
                    *(u32x4*)(rowp + bj * 128) = w;
                    if (grp == 8) { ss += blo(w.x) * blo(w.x) + bhi(w.x) * bhi(w.x) + blo(w.y) * blo(w.y) + bhi(w.y) * bhi(w.y) + blo(w.z) * blo(w.z) + bhi(w.z) * bhi(w.z) + blo(w.w) * blo(w.w) + bhi(w.w) * bhi(w.w); } }
                if (grp == 8) { ss += __shfl_xor(ss, 16); ss += __shfl_xor(ss, 32); if (fq == 0) mqss[(size_t)row * 16 + (colt >> 8) * 4 + wc] = ss; } }
    } };
struct EpiBf16P { static constexpr bool PERM = true, AFTER_DRAIN = false; bf16_t* O; int ldc; int pad;
    __device__ __forceinline__ void operator()(const AccT& acc, const pg8::Unit& u, int wr, int wc, int fr, int fq) const {
        const int row0 = u.pm * 256 + wr * 64 + fr, col0 = u.pn * 256 + wc * 32 + 8 * fq;
#pragma unroll
        for (int ai = 0; ai < 2; ++ai)
#pragma unroll
            for (int m = 0; m < 4; ++m) { bf16_t* rowp = O + (size_t)(row0 + ai * 128 + m * 16) * ldc + col0;
#pragma unroll
                for (int bj = 0; bj < 2; ++bj) { const f32x4 v0 = acc[ai][bj][m][0], v1 = acc[ai][bj][m][1]; u32x4 w; w.x = pk2(v0[0], v0[1]); w.y = pk2(v0[2], v0[3]); w.z = pk2(v1[0], v1[1]); w.w = pk2(v1[2], v1[3]);
                    *(u32x4*)(rowp + bj * 128) = w; } }
    } };
struct EpiF32 { static constexpr bool PERM = false, AFTER_DRAIN = false; float* O; int ldc; int pad;
    __device__ __forceinline__ void operator()(const AccT& acc, const pg8::Unit& u, int wr, int wc, int fr, int fq) const {
        const int row0 = u.pm * 256 + wr * 64 + fr, col0 = u.pn * 256 + wc * 32 + 4 * fq;
#pragma unroll
        for (int ai = 0; ai < 2; ++ai)
#pragma unroll
            for (int m = 0; m < 4; ++m) { float* rowp = O + (size_t)(row0 + ai * 128 + m * 16) * ldc + col0;
#pragma unroll
                for (int bj = 0; bj < 2; ++bj)
#pragma unroll
                    for (int n = 0; n < 2; ++n) *(f32x4*)(rowp + bj * 128 + n * 16) = acc[ai][bj][m][n]; }
    } };
struct EpiResid { static constexpr bool PERM = false, AFTER_DRAIN = false; const float* base; float* out;
    __device__ __forceinline__ void operator()(const AccT& acc, const pg8::Unit& u, int wr, int wc, int fr, int fq) const {
        const int row0 = u.pm * 256 + wr * 64 + fr, col0 = u.pn * 256 + wc * 32 + 4 * fq;
        const float* __restrict__ bp = base; float* __restrict__ op = out;
#pragma unroll
        for (int ai = 0; ai < 2; ++ai)
#pragma unroll
            for (int mp = 0; mp < 2; ++mp) { f32x4 bv[2][2][2];
#pragma unroll
                for (int mm = 0; mm < 2; ++mm) { const size_t off = (size_t)(row0 + ai * 128 + (2 * mp + mm) * 16) * DM + col0;
#pragma unroll
                    for (int bj = 0; bj < 2; ++bj)
#pragma unroll
                        for (int n = 0; n < 2; ++n) bv[mm][bj][n] = *(const f32x4*)(bp + off + bj * 128 + n * 16); }
                __builtin_amdgcn_sched_barrier(0);
#pragma unroll
                for (int mm = 0; mm < 2; ++mm) { const size_t off = (size_t)(row0 + ai * 128 + (2 * mp + mm) * 16) * DM + col0;
#pragma unroll
                    for (int bj = 0; bj < 2; ++bj)
#pragma unroll
                        for (int n = 0; n < 2; ++n) *(f32x4*)(op + off + bj * 128 + n * 16) = bv[mm][bj][n] + acc[ai][bj][2 * mp + mm][n]; }
                asm volatile("" ::: "memory"); }
    } };
struct EpiBranch { static constexpr bool PERM = true, AFTER_DRAIN = false; const bf16_t* G; const float* bg; float* MIXF; bf16_t* MIXED;
    __device__ __forceinline__ void operator()(const AccT& acc, const pg8::Unit& u, int wr, int wc, int fr, int fq) const {
        const int i = u.pn >> 2, row0 = u.pm * 256 + wr * 64 + fr, gcol0 = u.pn * 256 + wc * 32 + 8 * fq, mcol0 = (u.pn & 3) * 256 + wc * 32 + 8 * fq;
        const float* __restrict__ mfr = MIXF; float* __restrict__ mfw = MIXF; bf16_t* __restrict__ mxw = MIXED; const bf16_t* __restrict__ gr = G;
        f32x4 b0[2], b1[2];
#pragma unroll
        for (int bj = 0; bj < 2; ++bj) { b0[bj] = *(const f32x4*)(bg + gcol0 + bj * 128); b1[bj] = *(const f32x4*)(bg + gcol0 + bj * 128 + 4); }
#pragma unroll
        for (int ai = 0; ai < 2; ++ai)
#pragma unroll
            for (int m = 0; m < 4; ++m) { const int row = row0 + ai * 128 + m * 16; const bf16_t* gp = gr + (size_t)row * 4096 + gcol0; const size_t mo = (size_t)row * DM + mcol0;
                u32x4 gw[2]; f32x4 p0[2], p1[2];
#pragma unroll
                for (int bj = 0; bj < 2; ++bj) { gw[bj] = *(const u32x4*)(gp + bj * 128);
                    if (i > 0) { p0[bj] = *(const f32x4*)(mfr + mo + bj * 128); p1[bj] = *(const f32x4*)(mfr + mo + bj * 128 + 4); } else { p0[bj] = (f32x4){0.f, 0.f, 0.f, 0.f}; p1[bj] = (f32x4){0.f, 0.f, 0.f, 0.f}; } }
                __builtin_amdgcn_sched_barrier(0);
#pragma unroll
                for (int bj = 0; bj < 2; ++bj) { f32x4 v0 = acc[ai][bj][m][0], v1 = acc[ai][bj][m][1]; const u32x4 g = gw[bj];
                    v0[0] *= fast_sigmoid(blo(g.x) + b0[bj][0]); v0[1] *= fast_sigmoid(bhi(g.x) + b0[bj][1]); v0[2] *= fast_sigmoid(blo(g.y) + b0[bj][2]); v0[3] *= fast_sigmoid(bhi(g.y) + b0[bj][3]);
                    v1[0] *= fast_sigmoid(blo(g.z) + b1[bj][0]); v1[1] *= fast_sigmoid(bhi(g.z) + b1[bj][1]); v1[2] *= fast_sigmoid(blo(g.w) + b1[bj][2]); v1[3] *= fast_sigmoid(bhi(g.w) + b1[bj][3]);
                    v0 += p0[bj]; v1 += p1[bj];
                    if (i < 3) { *(f32x4*)(mfw + mo + bj * 128) = v0; *(f32x4*)(mfw + mo + bj * 128 + 4) = v1; }
                    else { u32x4 w; w.x = pk2(v0[0], v0[1]); w.y = pk2(v0[2], v0[3]); w.z = pk2(v1[0], v1[1]); w.w = pk2(v1[2], v1[3]); *(u32x4*)(mxw + mo + bj * 128) = w; } }
                asm volatile("" ::: "memory"); }
    } };
struct EpiSexp { static constexpr bool PERM = true, AFTER_DRAIN = false; bf16_t* E; const float* mqss; float* esum; const float* cb;
    __device__ __forceinline__ void operator()(const AccT& acc, const pg8::Unit& u, int wr, int wc, int fr, int fq) const {
        const int row0 = u.pm * 256 + wr * 64 + fr, col0 = u.pn * 256 + wc * 32 + 8 * fq; const float shift = cb[0];
        f32x4 pq[2][4];
#pragma unroll
        for (int ai = 0; ai < 2; ++ai)
#pragma unroll
            for (int m = 0; m < 4; ++m) pq[ai][m] = *(const f32x4*)(mqss + (size_t)(row0 + ai * 128 + m * 16) * 16 + u.pn * 4);
#pragma unroll
        for (int ai = 0; ai < 2; ++ai)
#pragma unroll
            for (int m = 0; m < 4; ++m) { const int row = row0 + ai * 128 + m * 16; const f32x4 p = pq[ai][m];
                const float sc = rsqrtf(((p[0] + p[1]) + (p[2] + p[3])) * (1.f / 256.f) + EPS) * (1.f / 16.f); bf16_t* rowp = E + (size_t)row * DM + col0; float sum = 0.f;
#pragma unroll
                for (int bj = 0; bj < 2; ++bj) { const f32x4 v0 = acc[ai][bj][m][0], v1 = acc[ai][bj][m][1]; u32x4 w;
                    w.x = pk2(fast_exp(v0[0] * sc - shift), fast_exp(v0[1] * sc - shift)); w.y = pk2(fast_exp(v0[2] * sc - shift), fast_exp(v0[3] * sc - shift));
                    w.z = pk2(fast_exp(v1[0] * sc - shift), fast_exp(v1[1] * sc - shift)); w.w = pk2(fast_exp(v1[2] * sc - shift), fast_exp(v1[3] * sc - shift));
                    *(u32x4*)(rowp + bj * 128) = w;
                    sum += (blo(w.x) + bhi(w.x)) + (blo(w.y) + bhi(w.y)) + (blo(w.z) + bhi(w.z)) + (blo(w.w) + bhi(w.w)); }
                sum += __shfl_xor(sum, 16); sum += __shfl_xor(sum, 32); if (fq == 0) esum[(size_t)row * 16 + u.pn * 4 + wc] = sum;
                asm volatile("" ::: "memory"); }
    } };
struct EpiMemPV { static constexpr bool PERM = true, AFTER_DRAIN = false; bf16_t* Y; const float* esum;
    __device__ __forceinline__ void operator()(const AccT& acc, const pg8::Unit& u, int wr, int wc, int fr, int fq) const {
        const int row0 = u.pm * 256 + wr * 64 + fr, col0 = u.pn * 256 + wc * 32 + 8 * fq;
        f32x4 pq[2][4];
#pragma unroll
        for (int ai = 0; ai < 2; ++ai)
#pragma unroll
            for (int m = 0; m < 4; ++m) pq[ai][m] = *(const f32x4*)(esum + (size_t)(row0 + ai * 128 + m * 16) * 16 + u.pn * 4);
#pragma unroll
        for (int ai = 0; ai < 2; ++ai)
#pragma unroll
            for (int m = 0; m < 4; ++m) { const int row = row0 + ai * 128 + m * 16; const f32x4 p = pq[ai][m];
                const float il = 1.f / ((p[0] + p[1]) + (p[2] + p[3])); bf16_t* rowp = Y + (size_t)row * DM + col0;
#pragma unroll
                for (int bj = 0; bj < 2; ++bj) { const f32x4 v0 = acc[ai][bj][m][0] * il, v1 = acc[ai][bj][m][1] * il; u32x4 w; w.x = pk2(v0[0], v0[1]); w.y = pk2(v0[2], v0[3]); w.z = pk2(v1[0], v1[1]); w.w = pk2(v1[2], v1[3]);
                    *(u32x4*)(rowp + bj * 128) = w; }
                asm volatile("" ::: "memory"); }
    } };

__device__ __forceinline__ void tr_item(const float* __restrict__ W, int ldw, bf16_t* __restrict__ WT, int ldk, int nblk, LAS float* scr, int item, int lane, int ncopies, int cstride) {
    const int kb = item / nblk, nb = item % nblk, k0 = 64 * kb, n0 = 32 * nb;
    float tmp[32];
#pragma unroll
    for (int i = 0; i < 32; ++i) { const int kk = 2 * i + (lane >> 5); tmp[i] = W[(size_t)(k0 + kk) * ldw + n0 + (lane & 31)]; }
    __builtin_amdgcn_sched_barrier(0);
#pragma unroll
    for (int i = 0; i < 32; ++i) { const int kk = 2 * i + (lane >> 5); scr[kk * 33 + (lane & 31)] = tmp[i]; }
    LDS_WAIT(); asm volatile("" ::: "memory");
    const int c = lane & 7;
#pragma unroll
    for (int j = 0; j < 4; ++j) { const int n = (lane >> 3) + 8 * j; const LAS float* s = scr + (8 * c) * 33 + n;
        u32x4 o; o.x = pk2(s[0 * 33], s[1 * 33]); o.y = pk2(s[2 * 33], s[3 * 33]); o.z = pk2(s[4 * 33], s[5 * 33]); o.w = pk2(s[6 * 33], s[7 * 33]);
        for (int cp = 0; cp < ncopies; ++cp) *(u32x4*)(WT + (size_t)(n0 + n) * ldk + k0 + 8 * c + cp * cstride) = o; }
    LDS_WAIT(); asm volatile("" ::: "memory");
}
__device__ __forceinline__ void norm_row(f32x4 (&v)[4], const float* __restrict__ g, bf16_t* __restrict__ hrow, const LAS float* WfT, bool do_logf, const float* __restrict__ bfg, float* __restrict__ LOGF, int row, int lane) {
    const f32x4* gr = (const f32x4*)g; float ss = 0.f;
#pragma unroll
    for (int j = 0; j < 4; ++j) ss += (v[j][0] * v[j][0] + v[j][1] * v[j][1]) + (v[j][2] * v[j][2] + v[j][3] * v[j][3]);
    ss = wave_sum(ss);
    const float rstd = rsqrtf(ss * (1.f / DM) + EPS);
#pragma unroll
    for (int j = 0; j < 4; ++j) { v[j] = v[j] * rstd * gr[lane + 64 * j];
        uint2 o; o.x = pk2(v[j][0], v[j][1]); o.y = pk2(v[j][2], v[j][3]); ((uint2*)hrow)[lane + 64 * j] = o; }
    if (do_logf) {
        float p[16];
#pragma unroll
        for (int h = 0; h < 16; ++h) { float a = 0.f;
#pragma unroll
            for (int j = 0; j < 4; ++j) { const f32x4 w = *(const LAS f32x4*)(WfT + h * 1024 + (lane + 64 * j) * 4); a += (v[j][0] * w[0] + v[j][1] * w[1]) + (v[j][2] * w[2] + v[j][3] * w[3]); }
            p[h] = a; if ((h & 3) == 3) __builtin_amdgcn_sched_barrier(0); }
        const bool b5 = lane & 32, b4 = lane & 16, b3 = lane & 8, b2 = lane & 4;
        float q8[8], q4[4], q2[2];
#pragma unroll
        for (int i = 0; i < 8; ++i) { const float send = b5 ? p[i] : p[i + 8], keep = b5 ? p[i + 8] : p[i]; q8[i] = keep + __shfl_xor(send, 32); }
#pragma unroll
        for (int i = 0; i < 4; ++i) { const float send = b4 ? q8[i] : q8[i + 4], keep = b4 ? q8[i + 4] : q8[i]; q4[i] = keep + __shfl_xor(send, 16); }
#pragma unroll
        for (int i = 0; i < 2; ++i) { const float send = b3 ? q4[i] : q4[i + 2], keep = b3 ? q4[i + 2] : q4[i]; q2[i] = keep + __shfl_xor(send, 8); }
        float q1 = (b2 ? q2[1] : q2[0]) + __shfl_xor(b2 ? q2[0] : q2[1], 4);
        q1 += __shfl_xor(q1, 2); q1 += __shfl_xor(q1, 1);
        const int h = (b5 ? 8 : 0) + (b4 ? 4 : 0) + (b3 ? 2 : 0) + (b2 ? 1 : 0);
        if ((lane & 3) == 0) { const int b = row / SEQ, t = row % SEQ; LOGF[((size_t)b * 16 + h) * SEQ + t] = logsigmoidf(q1 + bfg[h]); }
    }
}
__device__ __forceinline__ void norm_rows(const float* __restrict__ x, int nrows, int gw, int NGW, const float* __restrict__ g, bf16_t* __restrict__ H, const LAS float* WfT, bool do_logf, const float* __restrict__ bfg, float* __restrict__ LOGF, int lane) {
    f32x4 nx[4];
    if (gw < nrows) {
#pragma unroll
        for (int j = 0; j < 4; ++j) nx[j] = ((const f32x4*)(x + (size_t)gw * DM))[lane + 64 * j]; }
    for (int m = gw; m < nrows; m += NGW) {
        f32x4 v[4];
#pragma unroll
        for (int j = 0; j < 4; ++j) v[j] = nx[j];
        if (m + NGW < nrows) {
#pragma unroll
            for (int j = 0; j < 4; ++j) nx[j] = ((const f32x4*)(x + (size_t)(m + NGW) * DM))[lane + 64 * j]; }
        norm_row(v, g, H + (size_t)m * DM, WfT, do_logf, bfg, LOGF, m, lane);
    }
}
__device__ __forceinline__ void headnorm64_row(bf16_t* row, u32x4 a, u32x4 b, const float* __restrict__ g, float scale, int lane) {
    u32x4* p = (u32x4*)row + lane * 2;
    float v[16] = {blo(a.x), bhi(a.x), blo(a.y), bhi(a.y), blo(a.z), bhi(a.z), blo(a.w), bhi(a.w), blo(b.x), bhi(b.x), blo(b.y), bhi(b.y), blo(b.z), bhi(b.z), blo(b.w), bhi(b.w)};
    float ss = 0.f;
#pragma unroll
    for (int i = 0; i < 16; ++i) ss += v[i] * v[i];
    ss += __shfl_xor(ss, 1); ss += __shfl_xor(ss, 2);
    const float rstd = rsqrtf(ss * (1.f / 64.f) + EPS) * scale; const f32x4* gp = (const f32x4*)(g + (lane & 3) * 16);
#pragma unroll
    for (int i = 0; i < 4; ++i) { const f32x4 gg = gp[i]; v[4 * i] *= rstd * gg[0]; v[4 * i + 1] *= rstd * gg[1]; v[4 * i + 2] *= rstd * gg[2]; v[4 * i + 3] *= rstd * gg[3]; }
    a.x = pk2(v[0], v[1]); a.y = pk2(v[2], v[3]); a.z = pk2(v[4], v[5]); a.w = pk2(v[6], v[7]); b.x = pk2(v[8], v[9]); b.y = pk2(v[10], v[11]); b.z = pk2(v[12], v[13]); b.w = pk2(v[14], v[15]);
    p[0] = a; p[1] = b;
}
__device__ __forceinline__ void headnorm_rows(bf16_t* FQ, bf16_t* FK, int gw, int NGW, const float* __restrict__ gq, const float* __restrict__ gk, int lane) {
    u32x4 na, nb;
    { bf16_t* r = gw < T ? FQ + (size_t)gw * DM : FK + (size_t)(gw - T) * DM; na = ((const u32x4*)r)[lane * 2]; nb = ((const u32x4*)r)[lane * 2 + 1]; }
    for (int m = gw; m < 2 * T; m += NGW) {
        const u32x4 a = na, b = nb; const int mn = m + NGW;
        if (mn < 2 * T) { const bf16_t* r = mn < T ? FQ + (size_t)mn * DM : FK + (size_t)(mn - T) * DM; na = ((const u32x4*)r)[lane * 2]; nb = ((const u32x4*)r)[lane * 2 + 1]; }
        if (m < T) headnorm64_row(FQ + (size_t)m * DM, a, b, gq, C2, lane); else headnorm64_row(FK + (size_t)(m - T) * DM, a, b, gk, 1.f, lane);
    }
}
__device__ __forceinline__ void cumsum_block(const float* __restrict__ src, float* __restrict__ dst, LAS float* part, int tid) {
    const int lane = tid & 63, wave = tid >> 6; const f32x4* s4 = (const f32x4*)(src + tid * 16); float v[16]; float s = 0.f;
#pragma unroll
    for (int i = 0; i < 4; ++i) { const f32x4 x = s4[i]; s += x[0]; v[4 * i] = s; s += x[1]; v[4 * i + 1] = s; s += x[2]; v[4 * i + 2] = s; s += x[3]; v[4 * i + 3] = s; }
    float incl = s;
#pragma unroll
    for (int o = 1; o < 64; o <<= 1) { const float t_ = __shfl_up(incl, o); if (lane >= o) incl += t_; }
    __syncthreads();
    if (lane == 63) part[wave] = incl;
    __syncthreads();
    float off = incl - s;
    for (int w = 0; w < wave; ++w) off += part[w];
    f32x4* d4 = (f32x4*)(dst + tid * 16);
#pragma unroll
    for (int i = 0; i < 4; ++i) d4[i] = (f32x4){off + v[4 * i], off + v[4 * i + 1], off + v[4 * i + 2], off + v[4 * i + 3]};
}

__device__ __forceinline__ float neg_expm1_small(float x) {
    const float p = -x * (1.f + x * (0.5f + x * (0.16666667f + x * (0.041666668f + x * (0.0083333338f + x * 0.0013888889f)))));
    return x > -0.25f ? p : 1.f - fast_exp(x);
}
constexpr int LRU_TK = 128, LRU_NCH = SEQ / LRU_TK;
constexpr int LRU_XCB = 0, LRU_WT = LRU_TK * 144, LRU_R = LRU_WT + 18432, LRU_SEG = LRU_R + LRU_TK * 528;
static_assert(LRU_SEG + 4096 + 4096 <= MEGA_LDS - 64, "lru LDS map");
template <bool FINAL> __device__ __forceinline__ void lru_load(int it, int n, const bf16_t* __restrict__ LX, const bf16_t* __restrict__ LG, float (&xw)[19], float (&gl)[16], int tid) {
    const int b = it >> 10, c = (it >> 4) & 63, e = tid & 63, tg = tid >> 6, ch = n * 64 + e, t0 = c * LRU_TK + tg * 16;
    bf16_t raw[19];
#pragma unroll
    for (int j = 0; j < 19; ++j) { const int t = t0 + j - 3; raw[j] = LX[((size_t)b * SEQ + (t >= 0 ? t : 0)) * DM + ch]; }
    bf16_t rawg[16];
    if (FINAL) {
#pragma unroll
        for (int j = 0; j < 16; ++j) rawg[j] = LG[((size_t)b * SEQ + t0 + j) * DM + ch]; }
    __builtin_amdgcn_sched_barrier(0);
#pragma unroll
    for (int j = 0; j < 19; ++j) xw[j] = (t0 + j - 3) >= 0 ? bf2f(raw[j]) : 0.f;
    if (FINAL) {
#pragma unroll
        for (int j = 0; j < 16; ++j) gl[j] = bf2f(rawg[j]); }
}
template <bool FINAL> __device__ __forceinline__ void lru_item(int b, int c, int n, const float (&xw)[19], const float (&gl)[16], bf16_t* __restrict__ YL,
        const float w0, const float w1, const float w2, const float w3, const float bc, const float bA, const float bX,
        const float spl, float* APROD, float* HEND, LAS unsigned char* lds, int tid, int kseg) {
    const int e = tid & 63, tg = tid >> 6, ch = n * 64 + e, lane = e, wv = tg;
    LAS float* R = (LAS float*)(lds + LRU_R);
    LAS float* segP = (LAS float*)(lds + LRU_SEG);
    LAS float* segH = segP + 512, *carP = segH + 512 + (b * 4) * 64, *carH = carP + 512;
    const int t0 = c * LRU_TK + tg * 16; const size_t row0 = (size_t)b * SEQ + t0;
    float xc[16];
#pragma unroll
    for (int j = 0; j < 16; ++j) { xc[j] = bc + w3 * xw[j + 3] + w2 * xw[j + 2] + w1 * xw[j + 1] + w0 * xw[j]; *(LAS bf16_t*)(lds + LRU_XCB + (tg * 16 + j) * 144 + e * 2) = f2bf(xc[j]); }
    LDS_BAR();
    { const int tq = wv & 3, cbh = wv >> 2, r32 = lane & 31, hi = lane >> 5; f32x16_t acc0 = {}, acc1 = {};
#pragma unroll
        for (int ks = 0; ks < 4; ++ks) { const bf16x8_t af = *(const LAS bf16x8_t*)(lds + LRU_XCB + (32 * tq + r32) * 144 + (16 * ks + 8 * hi) * 2);
            const bf16x8_t b0 = *(const LAS bf16x8_t*)(lds + LRU_WT + (64 * cbh + r32) * 144 + (16 * ks + 8 * hi) * 2), b1 = *(const LAS bf16x8_t*)(lds + LRU_WT + (64 * cbh + 32 + r32) * 144 + (16 * ks + 8 * hi) * 2);
            acc0 = __builtin_amdgcn_mfma_f32_32x32x16_bf16(af, b0, acc0, 0, 0, 0); acc1 = __builtin_amdgcn_mfma_f32_32x32x16_bf16(af, b1, acc1, 0, 0, 0); }
#pragma unroll
        for (int r = 0; r < 16; ++r) { const int ro = (32 * tq + (r & 3) + 8 * (r >> 2) + 4 * hi) * 132 + 64 * cbh + r32; R[ro] = acc0[r]; R[ro + 32] = acc1[r]; } }
    LDS_BAR();
    float av[16], uv[16]; float P = 1.f, Hh = 0.f;
#pragma unroll
    for (int j = 0; j < 16; ++j) { const float ra = bA + R[(tg * 16 + j) * 132 + e], ri = bX + R[(tg * 16 + j) * 132 + 64 + e];
        const float rr = fast_sigmoid(ra), ii = fast_sigmoid(ri); const float la = -8.f * rr * spl; av[j] = fast_exp(la); uv[j] = __builtin_amdgcn_sqrtf(neg_expm1_small(2.f * la)) * (ii * xc[j]);
        Hh = av[j] * Hh + uv[j]; P *= av[j]; }
    segP[tg * 64 + e] = P; segH[tg * 64 + e] = Hh;
    LDS_BAR();
    if (FINAL) {
        float h = 0.f;
        for (int s = 0; s <= kseg; ++s) h = carP[s * 64 + e] * h + carH[s * 64 + e];
        for (int t2 = 0; t2 < tg; ++t2) h = segP[t2 * 64 + e] * h + segH[t2 * 64 + e];
#pragma unroll
        for (int j = 0; j < 16; ++j) { h = av[j] * h + uv[j]; YL[(row0 + j) * DM + ch] = f2bf(h * fast_gelu(gl[j])); }
    } else if (tg == 7) {
        float h = 0.f, p = 1.f;
#pragma unroll
        for (int s = 0; s < 8; ++s) { h = segP[s * 64 + e] * h + segH[s * 64 + e]; p *= segP[s * 64 + e]; }
        const size_t si = ((size_t)b * LRU_NCH + c) * DM + ch; APROD[si] = p; HEND[si] = h;
    }
}
template <bool FINAL> __device__ __forceinline__ void lru_pass(int l, int bx, int G, const float* const* in, const bf16_t* LX, const bf16_t* LG, bf16_t* YL, float* APROD, float* HEND, LAS unsigned char* lds, int tid) {
    const int n = bx & 15, e = tid & 63, ch = n * 64 + e;
    { const float* wa = in[10] + (size_t)l * 65536 + (size_t)n * 4096; const float* wx = in[12] + (size_t)l * 65536 + (size_t)n * 4096;
        float wv_[16];
#pragma unroll
        for (int k = 0; k < 16; ++k) { const int i = tid + MEGA_THREADS * k; wv_[k] = (i >> 12) ? wx[i & 4095] : wa[i & 4095]; }
#pragma unroll
        for (int k = 0; k < 16; ++k) { const int i = tid + MEGA_THREADS * k, mat = i >> 12, d = (i >> 6) & 63, ee = i & 63; *(LAS bf16_t*)(lds + LRU_WT + (mat * 64 + ee) * 144 + d * 2) = f2bf(wv_[k]); } }
    const float* cw = in[8] + (size_t)l * 4 * DM; const float w0 = cw[ch], w1 = cw[DM + ch], w2 = cw[2 * DM + ch], w3 = cw[3 * DM + ch], bc = in[9][l * DM + ch];
    const float bA = in[11][l * DM + ch], bX = in[13][l * DM + ch], spl = softplusf(-in[14][l * DM + ch]);
    if (FINAL) {
        const int c0 = bx >> 4, tg = tid >> 6, b = tg >> 2, sg = tg & 3; LAS float* carP = (LAS float*)(lds + LRU_SEG) + 1024, *carH = carP + 512;
        const int lo = sg == 0 ? 0 : c0 + 16 * (sg - 1), hi = c0 + 16 * sg; float A[16], Hc[16];
#pragma unroll
        for (int i = 0; i < 16; ++i) { const int cc = lo + i; const bool ok = cc < hi; const size_t si = ((size_t)b * LRU_NCH + (ok ? cc : 0)) * DM + ch; const float a_ = APROD[si], h_ = HEND[si]; A[i] = ok ? a_ : 1.f; Hc[i] = ok ? h_ : 0.f; }
        float cp = 1.f, chh = 0.f;
#pragma unroll
        for (int i = 0; i < 16; ++i) { chh = A[i] * chh + Hc[i]; cp *= A[i]; }
        carP[(b * 4 + sg) * 64 + e] = cp; carH[(b * 4 + sg) * 64 + e] = chh;
    }
    float xwn[19], gln[16];
#pragma unroll
    for (int j = 0; j < 16; ++j) gln[j] = 0.f;
    lru_load<FINAL>(bx, n, LX, LG, xwn, gln, tid);
    __syncthreads();
    for (int it = bx; it < 2048; it += G) {
        float xw[19], gl[16];
#pragma unroll
        for (int j = 0; j < 19; ++j) xw[j] = xwn[j];
#pragma unroll
        for (int j = 0; j < 16; ++j) gl[j] = gln[j];
        if (it + G < 2048) lru_load<FINAL>(it + G, n, LX, LG, xwn, gln, tid);
        lru_item<FINAL>(it >> 10, (it >> 4) & 63, n, xw, gl, YL, w0, w1, w2, w3, bc, bA, bX, spl, APROD, HEND, lds, tid, ((it >> 4) & 63) >> 4);
    }
    __syncthreads();
}

constexpr int SB_WIN = 13, SB_KOFF = 0, SB_VOFF = SB_WIN * 32 * 144, SB_SCR = SB_VOFF + SB_WIN * 4096;
static_assert(SB_SCR + 8 * 4096 <= MEGA_LDS - 64, "stick-breaking LDS map");
__device__ __forceinline__ void sb_wave(int b, int h, int qw0, int kt_lo, const bf16x8_t (&qr)[4], const bf16_t* __restrict__ K, const bf16_t* __restrict__ V, bf16_t* O, LAS unsigned char* lds, int wave, int lane) {
    const int r32 = lane & 31, hi = lane >> 5; const size_t rowbase = (size_t)b * SEQ;
    const bf16_t* Kh = K + rowbase * DM + h * 64; const bf16_t* Vh = V + rowbase * DM + h * 64;
    f32x16_t o0 = {}, o1 = {}; float R = 0.f; const int qabs = qw0 + r32;
    LAS unsigned char* scr = lds + SB_SCR + wave * 4096;
    for (int kt = qw0 >> 5; kt >= 0; --kt) {
        bf16x8_t kf[4]; const LAS unsigned char* vl;
        if (kt >= kt_lo) {
#pragma unroll
            for (int d0 = 0; d0 < 4; ++d0) kf[d0] = *(const LAS bf16x8_t*)(lds + SB_KOFF + ((kt - kt_lo) * 32 + r32) * 144 + d0 * 32 + hi * 16);
            vl = lds + SB_VOFF + (kt - kt_lo) * 4096;
        } else {
#pragma unroll
            for (int d0 = 0; d0 < 4; ++d0) kf[d0] = *(const bf16x8_t*)(Kh + (size_t)(kt * 32 + r32) * DM + d0 * 16 + hi * 8);
#pragma unroll
            for (int it = 0; it < 4; ++it) { const int chunk = lane + 64 * it, row = chunk >> 3, c16 = chunk & 7; const u32x4 vq = *(const u32x4*)(Vh + (size_t)(kt * 32 + row) * DM + c16 * 8);
                *(LAS u32x4*)(scr + (c16 >> 2) * 2048 + row * 64 + (c16 & 3) * 16) = vq; }
            vl = scr;
        }
        f32x16_t st = {};
#pragma unroll
        for (int d0 = 0; d0 < 4; ++d0) st = __builtin_amdgcn_mfma_f32_32x32x16_bf16(kf[d0], qr[d0], st, 0, 0, 0);
        float l1[16], lb[16]; bool val[16];
#pragma unroll
        for (int r = 0; r < 16; ++r) { const int kv = kt * 32 + (r & 3) + 8 * (r >> 2) + 4 * hi; val[r] = kv < qabs; const float z = st[r] * (0.125f * LOG2E); const float sp = fmaxf(z, 0.f) + __builtin_amdgcn_logf(1.f + __builtin_amdgcn_exp2f(-fabsf(z))); l1[r] = val[r] ? -sp : 0.f; lb[r] = z - sp; }
        float w[16]; float tail = 0.f;
#pragma unroll
        for (int g = 3; g >= 0; --g) { const float qs = (l1[4 * g] + l1[4 * g + 1]) + (l1[4 * g + 2] + l1[4 * g + 3]); const float pq = __shfl_xor(qs, 32);
            const float after = tail + (hi == 0 ? pq : 0.f) + R; tail += qs + pq;
            const float e2 = l1[4 * g + 3], e1 = e2 + l1[4 * g + 2], e0 = e1 + l1[4 * g + 1];
            w[4 * g + 3] = val[4 * g + 3] ? __builtin_amdgcn_exp2f(lb[4 * g + 3] + after) : 0.f; w[4 * g + 2] = val[4 * g + 2] ? __builtin_amdgcn_exp2f(lb[4 * g + 2] + after + e2) : 0.f;
            w[4 * g + 1] = val[4 * g + 1] ? __builtin_amdgcn_exp2f(lb[4 * g + 1] + after + e1) : 0.f; w[4 * g] = val[4 * g] ? __builtin_amdgcn_exp2f(lb[4 * g] + after + e0) : 0.f; }
        R += tail;
        u32x4 p0, p1; p0.x = attn_body::cvtpk_s(w[0], w[1]); p0.y = attn_body::cvtpk_s(w[2], w[3]); p0.z = attn_body::cvtpk_s(w[4], w[5]); p0.w = attn_body::cvtpk_s(w[6], w[7]);
        p1.x = attn_body::cvtpk_s(w[8], w[9]); p1.y = attn_body::cvtpk_s(w[10], w[11]); p1.z = attn_body::cvtpk_s(w[12], w[13]); p1.w = attn_body::cvtpk_s(w[14], w[15]);
        const bf16x8_t pa0 = __builtin_bit_cast(bf16x8_t, p0), pa1 = __builtin_bit_cast(bf16x8_t, p1);
        const attn_body::lds_cptr vp = (attn_body::lds_cptr)vl + (4 * hi + ((lane & 15) >> 2)) * 64 + ((lane >> 4) & 1) * 32 + (lane & 3) * 8;
#define SB_VF(d0, s) ({ const attn_body::s16x4 lo_ = attn_body::vtr(vp + (d0) * 2048 + (s) * 1024), hi_ = attn_body::vtr(vp + (d0) * 2048 + (s) * 1024 + 512); \
            (bf16x8_t){lo_[0], lo_[1], lo_[2], lo_[3], hi_[0], hi_[1], hi_[2], hi_[3]}; })
        o0 = __builtin_amdgcn_mfma_f32_32x32x16_bf16(pa0, SB_VF(0, 0), o0, 0, 0, 0);
        o1 = __builtin_amdgcn_mfma_f32_32x32x16_bf16(pa0, SB_VF(1, 0), o1, 0, 0, 0);
        o0 = __builtin_amdgcn_mfma_f32_32x32x16_bf16(pa1, SB_VF(0, 1), o0, 0, 0, 0);
        o1 = __builtin_amdgcn_mfma_f32_32x32x16_bf16(pa1, SB_VF(1, 1), o1, 0, 0, 0);
#undef SB_VF
        if (__all(R < SB_THR * LOG2E)) break;
    }
    bf16_t* Ow = O + (rowbase + qw0) * DM + h * 64;
#pragma unroll
    for (int r = 0; r < 16; ++r) { const int q = (r & 3) + 8 * (r >> 2) + 4 * hi; Ow[(size_t)q * DM + r32] = f2bf(o0[r]); Ow[(size_t)q * DM + 32 + r32] = f2bf(o1[r]); }
}
__device__ __forceinline__ void sb_unit(int b, int h, int q0, const bf16_t* Q, const bf16_t* __restrict__ K, const bf16_t* __restrict__ V, bf16_t* O, LAS unsigned char* lds, int tid) {
    const int lane = tid & 63, wave = __builtin_amdgcn_readfirstlane(tid >> 6);
    const int kt_hi = (q0 >> 5) + 8, kt_lo = kt_hi - SB_WIN > 0 ? kt_hi - SB_WIN : 0, nch = (kt_hi - kt_lo) * 256;
    const bf16_t* Kh = K + ((size_t)b * SEQ + kt_lo * 32) * DM + h * 64; const bf16_t* Vh = V + ((size_t)b * SEQ + kt_lo * 32) * DM + h * 64;
    bf16x8_t qr[4];
#pragma unroll
    for (int d0 = 0; d0 < 4; ++d0) qr[d0] = *(const bf16x8_t*)(Q + ((size_t)b * SEQ + q0 + wave * 32 + (lane & 31)) * DM + h * 64 + d0 * 16 + (lane >> 5) * 8);
#pragma unroll
    for (int hb = 0; hb < 2; ++hb) {
        u32x4 kq[4], vq[4];
#pragma unroll
        for (int i = 0; i < 4; ++i) { const int idx = tid + MEGA_THREADS * (4 * hb + i), row = idx >> 3, c16 = idx & 7;
            const int rc = idx < nch ? row : 0; kq[i] = *(const u32x4*)(Kh + (size_t)rc * DM + c16 * 8); vq[i] = *(const u32x4*)(Vh + (size_t)rc * DM + c16 * 8); }
#pragma unroll
        for (int i = 0; i < 4; ++i) { const int idx = tid + MEGA_THREADS * (4 * hb + i), row = idx >> 3, c16 = idx & 7;
            if (idx < nch) { *(LAS u32x4*)(lds + SB_KOFF + row * 144 + c16 * 16) = kq[i];
                *(LAS u32x4*)(lds + SB_VOFF + (row >> 5) * 4096 + (c16 >> 2) * 2048 + (row & 31) * 64 + (c16 & 3) * 16) = vq[i]; } }
    }
    __syncthreads();
    sb_wave(b, h, q0 + wave * 32, kt_lo, qr, K, V, O, lds, wave, lane);
    __syncthreads();
}

#ifndef DBG_NOLOGF
#define DBG_NOLOGF 0
#endif
#ifndef EN_FOX
#define EN_FOX 1
#endif
#ifndef EN_SB
#define EN_SB 1
#endif
#ifndef EN_LRU
#define EN_LRU 1
#endif
#ifndef EN_GEMM
#define EN_GEMM 1
#endif
#ifndef EN_THIN
#define EN_THIN 1
#endif
enum { SUB_CONV = 1, SUB_NORM = 2, SUB_HEADNORM = 4, SUB_CUMSUM = 8, SUB_LRU = 16, SUB_SB = 32, SUB_MEM = 64, SUB_FOX = 128, SUB_ALL = 255 };
constexpr int N_PRO = 3, N_PER_LAYER = 10, N_PHASES = N_PRO + DEPTH * N_PER_LAYER;
struct MArgs { Ptrs P; int ph_lo, ph_hi, sub, pad; };

__global__ void __launch_bounds__(MEGA_THREADS, 2) mega(MArgs a) {
    extern __shared__ __attribute__((aligned(16))) unsigned char lds_raw[];
    LAS unsigned char* lds = (LAS unsigned char*)lds_raw;
    cg::grid_group grid = cg::this_grid();
    { volatile LAS unsigned* st0 = (volatile LAS unsigned*)(lds + XB_LDS_OFF); if (threadIdx.x == 0) { st0[0] = 0u; st0[1] = 0u; } __syncthreads();
      if (a.ph_hi - a.ph_lo > 2) (void)xcd_barrier_post((unsigned*)(a.P.ws + WS_BAR), st0); }
    for (int ph = a.ph_lo; ph < a.ph_hi; ++ph) {
    int tid = threadIdx.x; asm volatile("" : "+v"(tid));
    const int lane = tid & 63, wave = __builtin_amdgcn_readfirstlane(tid >> 6);
    int zs = 0; asm volatile("" : "+s"(zs));
    const int G = gridDim.x + zs, bx = blockIdx.x + zs, sub = a.sub + zs, vcu = (G % 8 == 0) ? (bx % 8) * (G / 8) + bx / 8 : bx;
    const int gw = vcu * NWV + wave, NGW = G * NWV;
    unsigned char* ws = a.P.ws + zs; const float* const* in = a.P.in + zs; float* out = a.P.out + zs;
    bf16_t* H = (bf16_t*)(ws + WS_H); bf16_t* PROJ = (bf16_t*)(ws + WS_PROJ); bf16_t* GATES = (bf16_t*)(ws + WS_GATES); bf16_t* Eb = (bf16_t*)(ws + WS_E);
    bf16_t *FQ = PROJ, *FK = PROJ + (size_t)T * DM, *FV = PROJ + 2 * (size_t)T * DM, *LX = PROJ + 3 * (size_t)T * DM, *LG = PROJ + 4 * (size_t)T * DM, *SQ = PROJ + 5 * (size_t)T * DM,
           *SK = PROJ + 6 * (size_t)T * DM, *SV = PROJ + 7 * (size_t)T * DM, *MQ = PROJ + 8 * (size_t)T * DM;
    bf16_t* YL = (bf16_t*)(ws + WS_YL);
    float *LOGF = (float*)(ws + WS_LOGF), *FB = (float*)(ws + WS_FB), *MQSS = (float*)(ws + WS_MQSS), *ESUM = (float*)(ws + WS_ESUM), *CB = (float*)(ws + WS_CB);
    bf16_t* MEMN = (bf16_t*)(ws + WS_MEMN); float* MEMRAW = (float*)(ws + WS_MEMRAW); bf16_t *MK = (bf16_t*)(ws + WS_MK), *MVT = (bf16_t*)(ws + WS_MVT);
    float *APROD = (float*)(ws + WS_LRU), *HEND = APROD + (size_t)BATCH * 128 * DM;
    bf16_t* WKVT = (bf16_t*)(ws + WS_WKVT);
    bf16_t *WIN_T = (bf16_t*)(ws + WS_WT + WT_IN), *WBR_T = (bf16_t*)(ws + WS_WT + WT_BR), *WOUT_T = (bf16_t*)(ws + WS_WT + WT_OUT), *WUP_T = (bf16_t*)(ws + WS_WT + WT_UP), *WDN_T = (bf16_t*)(ws + WS_WT + WT_DN);
    bf16_t *GV = (bf16_t*)(ws + WS_GV), *ACT = (bf16_t*)(ws + WS_ACT);

        if (ph < N_PRO) {
            if (ph == 0) {
                LAS float* scr = (LAS float*)(lds + wave * 8448);
                for (int it = gw; it < 4 * 1024; it += NGW) { const int l = it >> 10; tr_item(in[15] + (size_t)l * DM * 2048, 2048, WKVT + (size_t)l * 2048 * DM, DM, 64, scr, it & 1023, lane, 1, 0); }
                for (int l = 0; l < 4; ++l) norm_rows(in[1], 512, gw, NGW, in[3] + l * DM, MEMN + (size_t)l * 512 * DM, (const LAS float*)lds, false, nullptr, nullptr, lane);
            } else if (ph == 1) {
                LocOrder<LocMemKV> S; S.so.init(4 * 512, 2048, G, bx); S.loc = LocMemKV{(const char*)MEMN, (const char*)WKVT};
                if (EN_GEMM) pg8::gemm_phase<EpiF32, LocOrder<LocMemKV>, true, true>(lds, pg8::Gemm{DM, DM, DM}, S, EpiF32{MEMRAW, 2048, 0});
            } else {
                for (int m = gw; m < 4 * 512; m += NGW) { const int l = m >> 9, r = m & 511, b = r >> 8, mi = r & 255; const float* raw = MEMRAW + (size_t)m * 2048;
                    const f32x4 gk = *(const f32x4*)(in[17] + l * 256 + lane * 4), gq = *(const f32x4*)(in[16] + l * 256 + lane * 4); const f32x4 gg = gk * gq;
#pragma unroll
                    for (int h = 0; h < 4; ++h) { const f32x4 k = *(const f32x4*)(raw + h * 256 + lane * 4); const float ss = wave_sum((k[0] * k[0] + k[1] * k[1]) + (k[2] * k[2] + k[3] * k[3]));
                        const float rstd = rsqrtf(ss * (1.f / 256.f) + EPS); uint2 o; o.x = pk2(k[0] * rstd * gg[0], k[1] * rstd * gg[1]); o.y = pk2(k[2] * rstd * gg[2], k[3] * rstd * gg[3]);
                        *(uint2*)(MK + ((size_t)l * 512 + (size_t)b * 256 + mi) * DM + h * 256 + lane * 4) = o;
                        const f32x4 v = *(const f32x4*)(raw + 1024 + h * 256 + lane * 4); bf16_t* vt = MVT + (size_t)l * 512 * DM + (((size_t)b * 4 + h) * 256 + lane * 4) * 256 + mi;
                        vt[0] = f2bf(v[0]); vt[256] = f2bf(v[1]); vt[512] = f2bf(v[2]); vt[768] = f2bf(v[3]); }
                    if (r == 0) { float mx = fmaxf(fmaxf(fabsf(gg[0]), fabsf(gg[1])), fmaxf(fabsf(gg[2]), fabsf(gg[3])));
#pragma unroll
                        for (int o = 1; o < 64; o <<= 1) mx = fmaxf(mx, __shfl_xor(mx, o));
                        if (lane == 0) CB[l] = 16.f * mx; } }
            }
        } else {
            const int l = (ph - N_PRO) / N_PER_LAYER, sp = (ph - N_PRO) % N_PER_LAYER;
            const float* xcur = l == 0 ? in[0] : out;
            if (sp == 0) {
                if (sub & SUB_NORM) { LAS float* WfT = (LAS float*)lds; const float* wf = in[4] + (size_t)l * DM * NIN + 3072;
#pragma unroll
                    for (int hb = 0; hb < 2; ++hb) { float tmp[16];
#pragma unroll
                        for (int q = 0; q < 16; ++q) { const int i = tid + MEGA_THREADS * (16 * hb + q); tmp[q] = wf[(size_t)(i >> 4) * NIN + (i & 15)]; }
                        __builtin_amdgcn_sched_barrier(0);
#pragma unroll
                        for (int q = 0; q < 16; ++q) { const int i = tid + MEGA_THREADS * (16 * hb + q); WfT[(i & 15) * 1024 + (i >> 4)] = tmp[q]; } } }
                __syncthreads();
                if (sub & SUB_CONV) { LAS float* scr = (LAS float*)(lds + 65536 + wave * 8448);
                    const float* win = in[4] + (size_t)l * DM * NIN;
                    for (int it = gw; it < 13440; it += NGW) { int r = it;
                        if (r < 1536) { tr_item(win, NIN, WIN_T, DM, 96, scr, r, lane, 1, 0); continue; } r -= 1536;
                        if (r < 5120) { tr_item(win + 3088, NIN, WIN_T + (size_t)3072 * DM, DM, 320, scr, r, lane, 1, 0); continue; } r -= 5120;
                        if (r < 2048) { const int i = r >> 9; tr_item(in[19] + ((size_t)l * 4 + i) * DM * DM, DM, WBR_T + (size_t)i * DM * DM, DM, 32, scr, r & 511, lane, 1, 0); continue; } r -= 2048;
                        if (r < 512) { tr_item(in[20] + (size_t)l * DM * DM, DM, WOUT_T, DM, 32, scr, r, lane, 1, 0); continue; } r -= 512;
                        if (r < 2816) { tr_item(in[22] + (size_t)l * DM * 2 * DFF, 2 * DFF, WUP_T, DM, 176, scr, r, lane, 1, 0); continue; } r -= 2816;
                        tr_item(in[25] + (size_t)l * DFF * DM, DM, WDN_T, DFF, 32, scr, r, lane, 1, 0); } }
                if (sub & SUB_NORM) norm_rows(xcur, T, gw, NGW, in[2] + l * DM, H, (const LAS float*)lds, !DBG_NOLOGF, in[5] + l * 16, LOGF, lane);
            } else if (sp == 1) {
                LocOrder<LocStd> S; S.so.init(T, 13312, G, bx); S.loc = LocStd{(const char*)H, (const char*)WIN_T, 256 * 1024 * 2, 256 * 1024 * 2};
                if (EN_GEMM) pg8::gemm_phase<EpiProj, LocOrder<LocStd>, true, true>(lds, pg8::Gemm{DM, DM, DM}, S, EpiProj{PROJ, GATES, MQSS});
            } else if (sp == 2) {
                if (sub & SUB_HEADNORM) headnorm_rows(FQ, FK, gw, NGW, in[6] + l * 64, in[7] + l * 64, lane);
                if ((sub & SUB_CUMSUM) && bx < 32) cumsum_block(LOGF + (size_t)bx * SEQ, FB + (size_t)bx * SEQ, (LAS float*)lds, tid);
                __syncthreads();
                if (EN_LRU && (sub & SUB_LRU)) lru_pass<false>(l, bx, G, in, LX, LG, YL, APROD, HEND, lds, tid);
                if (EN_SB && (sub & SUB_SB))
#pragma unroll 1
                for (int k = 0; k < 4; ++k) { const int bh = vcu >> 3, qb = (vcu & 7) * 4 + k; sb_unit(bh >> 4, bh & 15, qb * 256, SQ, SK, SV, H, lds, tid); }
                __syncthreads();
                if (sub & SUB_MEM) { LocOrder<LocMemS> S; S.so.init(T, 1024, G, bx); S.loc = LocMemS{(const char*)MQ, (const char*)(MK + (size_t)l * 512 * DM)};
                    if (EN_GEMM) pg8::gemm_phase<EpiSexp, LocOrder<LocMemS>, true, true>(lds, pg8::Gemm{DM, DM, 256 + zs}, S, EpiSexp{Eb, MQSS, ESUM, CB + l}); }
            } else if (sp == 3) {
                if (EN_FOX && (sub & SUB_FOX)) {
                    float gqm = fabsf(in[6][l * 64 + lane]), gkm = fabsf(in[7][l * 64 + lane]);
#pragma unroll
                    for (int o = 1; o < 64; o <<= 1) { gqm = fmaxf(gqm, __shfl_xor(gqm, o)); gkm = fmaxf(gkm, __shfl_xor(gkm, o)); }
                    const float thr = -(160.f + 2.f * C2 * 64.f * gqm * gkm);
                    const attn_body::AttnTensors AT{(const attn_body::bf16*)FQ, (const attn_body::bf16*)FK, (const attn_body::bf16*)FV, (attn_body::bf16*)SV, FB, thr, 0};
                    attn_body::QueueOrder S; S.ctr = (unsigned*)(ws + WS_QCTR) + (l * 8) * 64; S.xl = bx & 7; S.slot = (volatile LAS int*)(lds + XB_LDS_OFF + 16);
                    attn_body::attn_phase<attn_body::QueueOrder, 20>((char*)lds_raw, AT, S); }
                __syncthreads();
                if (EN_LRU && (sub & SUB_LRU)) lru_pass<true>(l, bx, G, in, LX, LG, YL, APROD, HEND, lds, tid);
                if (sub & SUB_MEM) { LocOrder<LocMemPV> S; S.so.init(T, 1024, G, bx); S.loc = LocMemPV{(const char*)Eb, (const char*)(MVT + (size_t)l * 512 * DM)};
                    if (EN_GEMM) pg8::gemm_phase<EpiMemPV, LocOrder<LocMemPV>, true, true>(lds, pg8::Gemm{DM, 256, 256 + zs}, S, EpiMemPV{MQ, ESUM}); }
            } else if (sp == 4) {
                BranchSched S; S.vcu = vcu; S.loc = LocBranch{(const char*)SV, (const char*)YL, (const char*)H, (const char*)MQ, (const char*)WBR_T};
                if (EN_GEMM) pg8::gemm_phase<EpiBranch, BranchSched, true, true>(lds, pg8::Gemm{DM, DM, DM}, S, EpiBranch{GATES, in[18] + (size_t)l * 4 * DM, (float*)(ws + WS_MIXF), (bf16_t*)(ws + WS_MIXED)});
            } else if (sp == 5) {
                LocOrder<LocStd> S; S.so.init(T, DM, G, bx); S.loc = LocStd{(const char*)(ws + WS_MIXED), (const char*)WOUT_T, 256 * 1024 * 2, 256 * 1024 * 2};
                if (EN_GEMM) pg8::gemm_phase<EpiResid, LocOrder<LocStd>, true, true>(lds, pg8::Gemm{DM, DM, DM}, S, EpiResid{xcur, out});
            } else if (sp == 6) {
                norm_rows(out, T, gw, NGW, in[21] + l * DM, H, (const LAS float*)lds, false, nullptr, nullptr, lane);
            } else if (sp == 7) {
                LocOrder<LocStd> S; S.so.init(T, 2 * DFF, G, bx); S.loc = LocStd{(const char*)H, (const char*)WUP_T, 256 * 1024 * 2, 256 * 1024 * 2};
                if (EN_GEMM) pg8::gemm_phase<EpiBf16P, LocOrder<LocStd>, true, true>(lds, pg8::Gemm{DM, DM, DM}, S, EpiBf16P{GV, 2 * DFF, 0});
            } else if (sp == 8) {
                const float* cw = in[23] + (size_t)l * 3 * DFF; const float* cbv = in[24] + l * DFF;
                for (int i = bx * MEGA_THREADS + tid; i < (T / 8) * (DFF / 8); i += G * MEGA_THREADS) { const int r0 = (i / (DFF / 8)) * 8, c = (i % (DFF / 8)) * 8, t0 = r0 % SEQ;
                    const bf16_t* gp = GV + (size_t)r0 * 2 * DFF + c; const u32x4 z4 = {0u, 0u, 0u, 0u};
                    const f32x4 wa0 = *(const f32x4*)(cw + c), wa1 = *(const f32x4*)(cw + c + 4), wb0 = *(const f32x4*)(cw + DFF + c), wb1 = *(const f32x4*)(cw + DFF + c + 4), wc0 = *(const f32x4*)(cw + 2 * DFF + c), wc1 = *(const f32x4*)(cw + 2 * DFF + c + 4);
                    const f32x4 bb0 = *(const f32x4*)(cbv + c), bb1 = *(const f32x4*)(cbv + c + 4);
                    const u32x4 g2l = *(const u32x4*)(gp - (t0 >= 2 ? 4 * DFF : 0)), g1l = *(const u32x4*)(gp - (t0 >= 1 ? 2 * DFF : 0));
                    u32x4 g2 = t0 >= 2 ? g2l : z4, g1 = t0 >= 1 ? g1l : z4;
                    u32x4 gg[8], vv[8];
#pragma unroll
                    for (int j = 0; j < 8; ++j) { gg[j] = *(const u32x4*)(gp + (size_t)j * 2 * DFF); vv[j] = *(const u32x4*)(gp + (size_t)j * 2 * DFF + DFF); }
#define ACT1(G0, G1, G2, VV, W0, W1, W2, BB) ({ const float pre_ = (BB) + (W2) * (G0) + (W1) * (G1) + (W0) * (G2); pre_ * fast_sigmoid(pre_) * (VV); })
#pragma unroll
                    for (int j = 0; j < 8; ++j) { const u32x4 g0 = gg[j], v_ = vv[j]; u32x4 o;
                        o.x = pk2(ACT1(blo(g0.x), blo(g1.x), blo(g2.x), blo(v_.x), wa0[0], wb0[0], wc0[0], bb0[0]), ACT1(bhi(g0.x), bhi(g1.x), bhi(g2.x), bhi(v_.x), wa0[1], wb0[1], wc0[1], bb0[1]));
                        o.y = pk2(ACT1(blo(g0.y), blo(g1.y), blo(g2.y), blo(v_.y), wa0[2], wb0[2], wc0[2], bb0[2]), ACT1(bhi(g0.y), bhi(g1.y), bhi(g2.y), bhi(v_.y), wa0[3], wb0[3], wc0[3], bb0[3]));
                        o.z = pk2(ACT1(blo(g0.z), blo(g1.z), blo(g2.z), blo(v_.z), wa1[0], wb1[0], wc1[0], bb1[0]), ACT1(bhi(g0.z), bhi(g1.z), bhi(g2.z), bhi(v_.z), wa1[1], wb1[1], wc1[1], bb1[1]));
                        o.w = pk2(ACT1(blo(g0.w), blo(g1.w), blo(g2.w), blo(v_.w), wa1[2], wb1[2], wc1[2], bb1[2]), ACT1(bhi(g0.w), bhi(g1.w), bhi(g2.w), bhi(v_.w), wa1[3], wb1[3], wc1[3], bb1[3]));
                        *(u32x4*)(ACT + (size_t)(r0 + j) * DFF + c) = o; g2 = g1; g1 = g0; }
#undef ACT1
                }
            } else {
                LocOrder<LocStd> S; S.so.init(T, DM, G, bx); S.loc = LocStd{(const char*)ACT, (const char*)WDN_T, 256 * DFF * 2, 256 * DFF * 2};
                if (EN_GEMM) pg8::gemm_phase<EpiResid, LocOrder<LocStd>, true, true>(lds, pg8::Gemm{DFF, DFF, DFF}, S, EpiResid{out, out});
            }
        }
        if (ph + 1 < a.ph_hi) {
            if (ph == a.ph_lo) grid.sync();
            else { XcdBarrier xb; xb.bar = (unsigned*)(ws + WS_BAR); xb.x = xb_xcc_id(); xb.st = (volatile LAS unsigned*)(lds + XB_LDS_OFF); xcd_barrier(xb); }
        }
    }
}
enum { C_PRO = 1, C_NORM = 2, C_WIN = 4, C_HN = 8, C_LRU = 16, C_SB = 32, C_MEM = 64, C_FOX = 128, C_BR = 256, C_WOUT = 512, C_NORM2 = 1024, C_UP = 2048, C_ACT = 4096, C_DOWN = 8192, C_ONE = 16384 };
#ifndef CFG
#define CFG 32767
#endif
#ifndef REPEAT_SP
#define REPEAT_SP (-1)
#define REPEAT_N 0
#define REPEAT_SUB 0
#endif
static int g_grid = 0;
static void launch_mega(const Ptrs& P, int lo, int hi, int sub, hipStream_t st, bool coop) {
    MArgs a{}; a.P = P; a.ph_lo = lo; a.ph_hi = hi; a.sub = sub; a.pad = 0;
    if (coop) { void* args[] = {&a}; const hipError_t e = hipLaunchCooperativeKernel((const void*)mega, dim3(g_grid), dim3(MEGA_THREADS), args, MEGA_LDS, st);
        if (e != hipSuccess) fprintf(stderr, "cooperative launch failed: %s (grid %d)\n", hipGetErrorString(e), g_grid); }
    else { hipLaunchKernelGGL(mega, dim3(g_grid), dim3(MEGA_THREADS), MEGA_LDS, st, a);
        if (REPEAT_N > 0 && hi == lo + 1 && lo >= N_PRO && (lo - N_PRO) % N_PER_LAYER == (REPEAT_SP)) { a.sub = (REPEAT_SUB); for (int r = 0; r < (REPEAT_N); ++r) hipLaunchKernelGGL(mega, dim3(g_grid), dim3(MEGA_THREADS), MEGA_LDS, st, a); } }
}
static void run_hybrid(const Ptrs& P, hipStream_t st) {
    unsigned char* ws = P.ws;
    bf16_t* H = (bf16_t*)(ws + WS_H);
    bf16_t* PR[9]; for (int i = 0; i < 9; ++i) PR[i] = (bf16_t*)(ws + WS_PROJ + i * SZ_ACT);
    bf16_t *FQ = PR[0], *FK = PR[1], *FV = PR[2], *LX = PR[3], *LG = PR[4], *SQ = PR[5], *SK = PR[6], *SV = PR[7], *MQ = PR[8];
    bf16_t* GATES = (bf16_t*)(ws + WS_GATES);
    bf16_t *YL = (bf16_t*)(ws + WS_YL), *YS = (bf16_t*)(ws + WS_YS), *YM = (bf16_t*)(ws + WS_YM), *YF = (bf16_t*)(ws + WS_YF);
    float *LOGF = (float*)(ws + WS_LOGF), *FB = (float*)(ws + WS_FB);
    bf16_t* MEMN = (bf16_t*)(ws + WS_MEMN); float* MEMRAW = (float*)(ws + WS_MEMRAW);
    bf16_t *MK = (bf16_t*)(ws + WS_MK), *MVT = (bf16_t*)(ws + WS_MVT);
    bf16_t *GV = (bf16_t*)(ws + WS_GV), *ACT = (bf16_t*)(ws + WS_ACT);
    const float* const* in = P.in;
    const int cfg = CFG;
    const bool anygemm = cfg & (C_WIN | C_BR | C_WOUT | C_UP | C_DOWN);
    if (cfg & C_PRO) { for (int p = 0; p < 3; ++p) launch_mega(P, p, p + 1, SUB_ALL, st, false); }
    else for (int l = 0; l < DEPTH; ++l) {
        n_rmsnorm<<<512 / 4, 256, 0, st>>>(in[1], in[3] + l * DM, MEMN + (size_t)l * 512 * DM, nullptr, nullptr, nullptr, 512);
        n_gemm<EStoreF32><<<dim3(2048 / 64, 512 / 64), 256, 0, st>>>(MEMN + (size_t)l * 512 * DM, in[15] + (size_t)l * DM * 2048, DM, 2048, DM, 0x7fffffff, EStoreF32{MEMRAW + (size_t)l * 512 * 2048, 2048, 0});
        n_memkv_post<<<512, 256, 0, st>>>(MEMRAW + (size_t)l * 512 * 2048, in[17] + l * 256, in[16] + l * 256, MK + (size_t)l * 512 * DM, MVT + (size_t)l * 512 * DM);
    }
    for (int l = 0; l < DEPTH; ++l) {
        const int p0 = N_PRO + l * N_PER_LAYER;
        const float* xcur = l == 0 ? in[0] : P.out;
        const float* win = in[4] + (size_t)l * DM * NIN;
        if (DBG_NOLOGF) n_rmsnorm<<<T / 4, 256, 0, st>>>(xcur, in[2] + l * DM, H, win + 3072, in[5] + l * 16, LOGF, T);
        { const int sub = (anygemm ? SUB_CONV : 0) | ((cfg & C_NORM) ? SUB_NORM : 0); if (sub) launch_mega(P, p0, p0 + 1, sub, st, false); }
        if (!(cfg & C_NORM)) n_rmsnorm<<<T / 4, 256, 0, st>>>(xcur, in[2] + l * DM, H, win + 3072, in[5] + l * 16, LOGF, T);
        if (cfg & C_WIN) launch_mega(P, p0 + 1, p0 + 2, SUB_ALL, st, false);
        else { for (int gI = 0; gI < 9; ++gI) { const int coff = gI < 3 ? gI * 1024 : gI * 1024 + 16;
                n_gemm<EStoreBf16><<<dim3(1024 / 64, T / 64), 256, 0, st>>>(H, win + coff, DM, NIN, DM, 0x7fffffff, EStoreBf16{PR[gI], DM, 0}); }
            n_gemm<EStoreBf16><<<dim3(4096 / 64, T / 64), 256, 0, st>>>(H, win + 9232, DM, NIN, DM, 0x7fffffff, EStoreBf16{GATES, 4096, 0}); }
        if (!(cfg & C_HN)) { n_headnorm<<<T * 16 / 256, 256, 0, st>>>(FQ, in[6] + l * 64, 64, C2); n_headnorm<<<T * 16 / 256, 256, 0, st>>>(FK, in[7] + l * 64, 64, 1.f); n_cumsum<<<32, 1024, 0, st>>>(LOGF, FB); }
        const int sub23 = ((cfg & C_HN) ? (SUB_HEADNORM | SUB_CUMSUM) : 0) | ((cfg & C_LRU) ? SUB_LRU : 0) | ((cfg & C_SB) ? SUB_SB : 0) | ((cfg & C_MEM) ? SUB_MEM : 0) | ((cfg & C_FOX) ? SUB_FOX : 0);
        if (sub23 & ~SUB_FOX) launch_mega(P, p0 + 2, p0 + 3, sub23, st, false);
        if (!(cfg & C_SB)) n_sb_attn<<<dim3(SEQ / 256, 32), 256, 0, st>>>(SQ, SK, SV, YS);
        if (!(cfg & C_LRU)) n_lru<<<32, 64, 0, st>>>(LX, LG, in[8] + (size_t)l * 4 * DM, in[9] + l * DM, in[10] + (size_t)l * 16 * 64 * 64, in[11] + l * DM, in[12] + (size_t)l * 16 * 64 * 64, in[13] + l * DM, in[14] + l * DM, YL);
        if (!(cfg & C_MEM)) n_mem_attn<<<T * 4, 256, 0, st>>>(MQ, MK + (size_t)l * 512 * DM, MVT + (size_t)l * 512 * DM, YM);
        if (sub23 & (SUB_FOX | SUB_LRU | SUB_MEM)) launch_mega(P, p0 + 3, p0 + 4, sub23, st, false);
        if (!(cfg & C_FOX)) n_fox_attn<<<dim3(SEQ / 256, 32), 256, 0, st>>>(FQ, FK, FV, FB, YF);
        if (cfg & C_BR) launch_mega(P, p0 + 4, p0 + 5, SUB_ALL, st, false);
        else { const bf16_t* Y[4] = {YF, YL, YS, YM};
            for (int i = 0; i < 4; ++i) n_gemm<EBranch><<<dim3(1024 / 64, T / 64), 256, 0, st>>>(Y[i], in[19] + ((size_t)l * 4 + i) * DM * DM, DM, DM, DM, 0x7fffffff, EBranch{GATES, in[18] + ((size_t)l * 4 + i) * DM, (float*)(ws + WS_MIXF), (bf16_t*)(ws + WS_MIXED), i, 0}); }
        if (cfg & C_WOUT) launch_mega(P, p0 + 5, p0 + 6, SUB_ALL, st, false);
        else n_gemm<EResid><<<dim3(1024 / 64, T / 64), 256, 0, st>>>((const bf16_t*)(ws + WS_MIXED), in[20] + (size_t)l * DM * DM, DM, DM, DM, 0x7fffffff, EResid{xcur, P.out});
        if (cfg & C_NORM2) launch_mega(P, p0 + 6, p0 + 7, SUB_ALL, st, false);
        else n_rmsnorm<<<T / 4, 256, 0, st>>>(P.out, in[21] + l * DM, H, nullptr, nullptr, nullptr, T);
        if (cfg & C_UP) launch_mega(P, p0 + 7, p0 + 8, SUB_ALL, st, false);
        else n_gemm<EStoreBf16><<<dim3(2 * DFF / 64, T / 64), 256, 0, st>>>(H, in[22] + (size_t)l * DM * 2 * DFF, DM, 2 * DFF, DM, 0x7fffffff, EStoreBf16{GV, 2 * DFF, 0});
        if (cfg & C_ACT) launch_mega(P, p0 + 8, p0 + 9, SUB_ALL, st, false);
        else n_act<<<(unsigned)(((size_t)T * DFF + 255) / 256), 256, 0, st>>>(GV, in[23] + (size_t)l * 3 * DFF, in[24] + l * DFF, ACT);
        if (cfg & C_DOWN) launch_mega(P, p0 + 9, p0 + 10, SUB_ALL, st, false);
        else n_gemm<EResid><<<dim3(1024 / 64, T / 64), 256, 0, st>>>(ACT, in[25] + (size_t)l * DFF * DM, DFF, DM, DFF, 0x7fffffff, EResid{P.out, P.out});
    }
}

extern "C" void kernel_launch(void* const* d_in, const int* in_sizes, int n_in, void* d_out, int out_size, void* d_ws, size_t ws_size, hipStream_t stream) {
    if (n_in != 26 || out_size != T * DM || ws_size < WS_NEED) { fprintf(stderr, "kernel_launch: unexpected sizes n_in %d out %d ws %zu (need %zu)\n", n_in, out_size, ws_size, (size_t)WS_NEED); return; }
    if (g_grid == 0) {
        int dev = 0, cus = 0, per_cu = 0;
        hipGetDevice(&dev); hipDeviceGetAttribute(&cus, hipDeviceAttributeMultiprocessorCount, dev);
        if (hipFuncSetAttribute((const void*)mega, hipFuncAttributeMaxDynamicSharedMemorySize, MEGA_LDS) != hipSuccess) fprintf(stderr, "kernel_launch: hipFuncSetAttribute failed\n");
        if (hipOccupancyMaxActiveBlocksPerMultiprocessor(&per_cu, (const void*)mega, MEGA_THREADS, MEGA_LDS) != hipSuccess || per_cu < 1) fprintf(stderr, "kernel_launch: occupancy query says %d\n", per_cu);
        (void)hipGetLastError();
        g_grid = cus;
        if (g_grid != 256) fprintf(stderr, "kernel_launch: %d CUs; the attention phase's static order assumes 256\n", g_grid);
    }
    Ptrs P{};
    for (int i = 0; i < 26; ++i) P.in[i] = (const float*)d_in[i];
    P.out = (float*)d_out; P.ws = (unsigned char*)d_ws;
    if ((CFG) & C_ONE) { (void)hipMemsetAsync((char*)d_ws + WS_BAR, 0, CTL_ZERO_BYTES, stream);
        launch_mega(P, 0, N_PHASES, SUB_ALL, stream, true); }
    else { (void)hipMemsetAsync((char*)d_ws + WS_BAR, 0, CTL_ZERO_BYTES, stream); run_hybrid(P, stream); }
}
```
